# Optimizing an MI355X kernel written in HIP

```python
import jax, jax.numpy as jnp
from jax import lax
import numpy as np

D_MODEL = 1024
BATCH = 16
SEQ = 2048
DEPTH = 2

CHUNK = 64
HEAD_DIM = 64
N_HEADS = D_MODEL // HEAD_DIM
N_HEADS_A = N_HEADS // 2
N_HEADS_B = N_HEADS - N_HEADS_A
WIDTH_A = N_HEADS_A * HEAD_DIM
WIDTH_B = N_HEADS_B * HEAD_DIM
IN_COLS = 3 * WIDTH_A + 4 * WIDTH_B
LEFT_CHUNKS = 8
BAND = (LEFT_CHUNKS + 1) * CHUNK
MAX_REL = 128
ROPE_BASE = 10000.0
CONV_WIDTH = 31
PEER_HEADS = 8
PEER_NKEYS = 128
PEER_EXPERTS = PEER_NKEYS * PEER_NKEYS
PEER_QDIM = 128
PEER_TOPK = 16
PEER_BLOCK = 128
N_EVEN = (DEPTH + 1) // 2
N_ODD = DEPTH // 2
EPS = 1e-6

kernel_name = "hybrid_chunkattn_retention_conformerconv_peer"


def rms_norm(x, g):
    x32 = x.astype(jnp.float32)
    y = x32 * lax.rsqrt(jnp.mean(x32 * x32, axis=-1, keepdims=True) + EPS)
    return (y * g.astype(jnp.float32)).astype(x.dtype)


def layer_norm(x, g, b):
    x32 = x.astype(jnp.float32)
    mu = jnp.mean(x32, axis=-1, keepdims=True)
    var = jnp.mean(jnp.square(x32 - mu), axis=-1, keepdims=True)
    y = (x32 - mu) * lax.rsqrt(var + EPS)
    return (y * g.astype(jnp.float32) + b.astype(jnp.float32)).astype(x.dtype)


def rope(t, pos):
    half = HEAD_DIM // 2
    inv = ROPE_BASE ** (-jnp.arange(half, dtype=jnp.float32) / half)
    ang = pos.astype(jnp.float32)[:, None] * inv[None, :]
    cos = jnp.cos(ang)[None, :, None, :]
    sin = jnp.sin(ang)[None, :, None, :]
    t1 = t[..., :half].astype(jnp.float32)
    t2 = t[..., half:].astype(jnp.float32)
    return jnp.concatenate([t1 * cos - t2 * sin, t1 * sin + t2 * cos], axis=-1).astype(t.dtype)


def chunk_attention(q, k, v, rel_table):
    b, s, h, dh = q.shape
    nc = s // CHUNK
    qi = jnp.arange(CHUNK)[:, None]
    kj = jnp.arange(BAND)[None, :]
    rel = jnp.clip(LEFT_CHUNKS * CHUNK + qi - kj, -MAX_REL, MAX_REL) + MAX_REL
    bias = rel_table[:, rel].astype(jnp.float32)
    pad = jnp.zeros((b, LEFT_CHUNKS * CHUNK, h, dh), k.dtype)
    k_pad = jnp.concatenate([pad, k], axis=1)
    v_pad = jnp.concatenate([pad, v], axis=1)
    scale = dh ** -0.5

    def one_chunk(c):
        start = c * CHUNK
        q_c = lax.dynamic_slice_in_dim(q, start, CHUNK, axis=1)
        k_c = lax.dynamic_slice_in_dim(k_pad, start, BAND, axis=1)
        v_c = lax.dynamic_slice_in_dim(v_pad, start, BAND, axis=1)
        sc = jnp.einsum('bihd,bjhd->bhij', q_c, k_c).astype(jnp.float32) * scale + bias[None]
        valid = jnp.arange(BAND) >= (LEFT_CHUNKS - c) * CHUNK
        sc = jnp.where(valid[None, None, None, :], sc, -jnp.inf)
        p = jax.nn.softmax(sc, axis=-1).astype(v.dtype)
        return jnp.einsum('bhij,bjhd->bihd', p, v_c)

    out = lax.map(one_chunk, jnp.arange(nc))
    return out.transpose(1, 0, 2, 3, 4).reshape(b, s, h, dh)


def retention(q, k, v, g):
    b, s, h, dh = q.shape
    nc = s // CHUNK
    pos = jnp.arange(s)
    q = rope(q, pos)
    k = (rope(k, pos).astype(jnp.float32) * dh ** -0.5).astype(q.dtype)
    gamma = 1.0 - 2.0 ** (-5.0 - jnp.arange(h, dtype=jnp.float32))
    log_g = jnp.log(gamma)
    idx = jnp.arange(CHUNK, dtype=jnp.float32)
    intra_decay = jnp.exp(log_g[:, None, None] * jnp.abs(idx[:, None] - idx[None, :])).astype(q.dtype)
    kv_decay = jnp.exp(log_g[None, :] * (CHUNK - 1 - idx)[:, None]).astype(q.dtype)
    q_decay = jnp.exp(log_g[None, :] * (idx + 1.0)[:, None]).astype(q.dtype)
    chunk_decay = jnp.exp(log_g * CHUNK).astype(q.dtype)

    qc = q.reshape(b, nc, CHUNK, h, dh)
    kc = k.reshape(b, nc, CHUNK, h, dh)
    vc = v.reshape(b, nc, CHUNK, h, dh)

    scores = jnp.einsum('bnihd,bnjhd->bnhij', qc, kc) * intra_decay[None, None]
    intra = jnp.einsum('bnhij,bnjhe->bnihe', scores, vc)

    kv = jnp.einsum('bnjhd,bnjhe->nbhde', kc * kv_decay[None, None, :, :, None], vc)

    def step(state, kv_n):
        return chunk_decay[None, :, None, None] * state + kv_n, state

    _, prev = lax.scan(step, jnp.zeros_like(kv[0]), kv)
    cross = jnp.einsum('bnihd,nbhde->bnihe', qc, prev) * q_decay[None, None, :, :, None]

    o32 = (intra + cross).astype(jnp.float32)
    mu = jnp.mean(o32, axis=-1, keepdims=True)
    var = jnp.mean(jnp.square(o32 - mu), axis=-1, keepdims=True)
    o = ((o32 - mu) * lax.rsqrt(var + EPS)).reshape(b, s, h, dh)
    return (o * jax.nn.silu(g.astype(jnp.float32))).astype(q.dtype)


def hybrid_mixer(xn, w_in, w_out, rel_table):
    b, s, _ = xn.shape
    proj = xn @ w_in
    cuts = [WIDTH_A, 2 * WIDTH_A, 3 * WIDTH_A, 3 * WIDTH_A + WIDTH_B,
            3 * WIDTH_A + 2 * WIDTH_B, 3 * WIDTH_A + 3 * WIDTH_B]
    qa, ka, va, qb, kb, vb, gb = jnp.split(proj, cuts, axis=-1)
    heads_a = lambda t: t.reshape(b, s, N_HEADS_A, HEAD_DIM)
    heads_b = lambda t: t.reshape(b, s, N_HEADS_B, HEAD_DIM)
    oa = chunk_attention(heads_a(qa), heads_a(ka), heads_a(va), rel_table)
    ob = retention(heads_b(qb), heads_b(kb), heads_b(vb), heads_b(gb))
    o = jnp.concatenate([oa.reshape(b, s, WIDTH_A), ob.reshape(b, s, WIDTH_B)], axis=-1)
    return o @ w_out


def conv_module(xn, w1, b1, w_dw, b_dw, ln_g, ln_b, w2, b2):
    hid = xn @ w1 + b1
    a, gate = jnp.split(hid, 2, axis=-1)
    hid = a * jax.nn.sigmoid(gate)
    hid = lax.conv_general_dilated(
        hid, w_dw[:, None, :], window_strides=(1,), padding=[(CONV_WIDTH - 1, 0)],
        dimension_numbers=('NWC', 'WIO', 'NWC'), feature_group_count=D_MODEL) + b_dw
    hid = jax.nn.silu(layer_norm(hid, ln_g, ln_b))
    return hid @ w2 + b2


def peer(xn, w_q, sub_keys, u, v):
    b, s, d = xn.shape
    t = b * s
    xf = xn.reshape(t, d)
    q = (xf @ w_q).reshape(t, PEER_HEADS, PEER_QDIM)
    half = PEER_QDIM // 2
    s1 = jnp.einsum('thd,kd->thk', q[..., :half], sub_keys[0]).astype(jnp.float32)
    s2 = jnp.einsum('thd,kd->thk', q[..., half:], sub_keys[1]).astype(jnp.float32)
    top1, i1 = lax.top_k(s1, PEER_TOPK)
    top2, i2 = lax.top_k(s2, PEER_TOPK)
    cand = (top1[..., :, None] + top2[..., None, :]).reshape(t, PEER_HEADS, PEER_TOPK * PEER_TOPK)
    cidx = (i1[..., :, None] * PEER_NKEYS + i2[..., None, :]).reshape(t, PEER_HEADS, PEER_TOPK * PEER_TOPK)
    best, pos = lax.top_k(cand, PEER_TOPK)
    eidx = jnp.take_along_axis(cidx, pos, axis=-1)
    gates = jax.nn.softmax(best, axis=-1).astype(xn.dtype)
    nsel = PEER_HEADS * PEER_TOPK
    nb = t // PEER_BLOCK
    xb = xf.reshape(nb, PEER_BLOCK, d)
    ib = eidx.reshape(nb, PEER_BLOCK, nsel)
    gbk = gates.reshape(nb, PEER_BLOCK, nsel)

    def expert_block(args):
        x_blk, i_blk, g_blk = args
        u_sel = u[i_blk]
        act = jax.nn.gelu(jnp.einsum('pkd,pd->pk', u_sel, x_blk), approximate=False) * g_blk
        return jnp.einsum('pk,pkd->pd', act, v[i_blk])

    out = lax.map(expert_block, (xb, ib, gbk))
    return out.reshape(b, s, d)


def setup_inputs(seed: int = 0) -> dict:
    key = jax.random.key(seed)
    ks = jax.random.split(key, 24)
    D = D_MODEL

    def nrm(k, shape, scale):
        return jax.random.normal(k, shape, jnp.float32) * scale

    return {
        "x": nrm(ks[0], (BATCH, SEQ, D), 1.0),
        "mix_norm": 1.0 + nrm(ks[1], (DEPTH, D), 0.01),
        "ffn_norm": 1.0 + nrm(ks[2], (DEPTH, D), 0.01),
        "final_norm": 1.0 + nrm(ks[3], (D,), 0.01),
        "w_in": nrm(ks[4], (N_EVEN, D, IN_COLS), D ** -0.5),
        "w_out": nrm(ks[5], (N_EVEN, D, D), D ** -0.5),
        "rel_bias": nrm(ks[6], (N_EVEN, N_HEADS_A, 2 * MAX_REL + 1), 0.1),
        "conv_w1": nrm(ks[7], (N_ODD, D, 2 * D), D ** -0.5),
        "conv_b1": nrm(ks[8], (N_ODD, 2 * D), 0.01),
        "conv_dw": nrm(ks[9], (N_ODD, CONV_WIDTH, D), CONV_WIDTH ** -0.5),
        "conv_dw_b": nrm(ks[10], (N_ODD, D), 0.01),
        "conv_ln_g": 1.0 + nrm(ks[11], (N_ODD, D), 0.01),
        "conv_ln_b": nrm(ks[12], (N_ODD, D), 0.01),
        "conv_w2": nrm(ks[13], (N_ODD, D, D), D ** -0.5),
        "conv_b2": nrm(ks[14], (N_ODD, D), 0.01),
        "peer_wq": nrm(ks[15], (DEPTH, D, PEER_HEADS * PEER_QDIM), D ** -0.5),
        "peer_keys": nrm(ks[16], (DEPTH, 2, PEER_NKEYS, PEER_QDIM // 2), (PEER_QDIM // 2) ** -0.5),
        "peer_u": nrm(ks[17], (DEPTH, PEER_EXPERTS, D), D ** -0.5),
        "peer_v": nrm(ks[18], (DEPTH, PEER_EXPERTS, D), PEER_HEADS ** -0.5),
    }


def reference(x, mix_norm, ffn_norm, final_norm, w_in, w_out, rel_bias,
              conv_w1, conv_b1, conv_dw, conv_dw_b, conv_ln_g, conv_ln_b, conv_w2, conv_b2,
              peer_wq, peer_keys, peer_u, peer_v):
    h = x
    for layer in range(DEPTH):
        xn = rms_norm(h, mix_norm[layer])
        if layer % 2 == 0:
            e = layer // 2
            h = h + hybrid_mixer(xn, w_in[e], w_out[e], rel_bias[e])
        else:
            o = layer // 2
            h = h + conv_module(xn, conv_w1[o], conv_b1[o], conv_dw[o], conv_dw_b[o],
                                conv_ln_g[o], conv_ln_b[o], conv_w2[o], conv_b2[o])
        xn = rms_norm(h, ffn_norm[layer])
        h = h + peer(xn, peer_wq[layer], peer_keys[layer], peer_u[layer], peer_v[layer])
    return rms_norm(h, final_norm)
```

```cpp
#include <hip/hip_runtime.h>
#include <cstdio>
#include <cstdint>

#ifndef MK_ONE_LAUNCH
#define MK_ONE_LAUNCH 1
#endif

#define GAS __attribute__((address_space(1)))
#define LAS __attribute__((address_space(3)))
#define DI __device__ __forceinline__
typedef unsigned short bf16;
typedef float f32x2 __attribute__((ext_vector_type(2)));
typedef float f32x4 __attribute__((ext_vector_type(4)));
typedef unsigned u32x2 __attribute__((ext_vector_type(2)));
typedef unsigned u32x4 __attribute__((ext_vector_type(4)));

constexpr int NB = 16, SEQ = 2048, DM = 1024, T = NB * SEQ;
constexpr int CHUNK = 64, HD = 64, NHA = 8, NHB = 8, INC = 3584, NCH = SEQ / CHUNK;
constexpr int PH = 8, PK = 128, PE = PK * PK, PQD = 128, PTOP = 16, NSEL = PH * PTOP;
constexpr int CW = 31;
constexpr float EPS = 1e-6f;
constexpr int NWAVES = 8, NTHR = NWAVES * 64;

constexpr int C_QA = 0, C_KA = 512, C_VA = 1024, C_QB = 1536, C_KB = 2048, C_VB = 2560, C_GB = 3072;

constexpr size_t MiB = 1u << 20;
constexpr size_t WS_CTL = 0, CTL_ZERO_BYTES = 1 * MiB;
constexpr size_t WS_ROPE = 22 * MiB;
constexpr size_t WS_PART = 23 * MiB;
constexpr size_t WS_EIDX = 26 * MiB;
constexpr size_t WS_GATE = 42 * MiB;
constexpr size_t WS_XB = 128 * MiB;
constexpr size_t WS_R = 192 * MiB;
constexpr size_t WS_O = 416 * MiB;
constexpr size_t WS_Q = 192 * MiB;
constexpr size_t WS_HID = 256 * MiB;
constexpr size_t WS_GLU = 384 * MiB;
constexpr size_t WS_HID2 = 448 * MiB;
constexpr size_t WS_END = 512 * MiB;
constexpr int CW_BAR = 4096;

constexpr int RING_BYTES = 131072, LDSCTL_OFF = RING_BYTES, MISC_OFF = LDSCTL_OFF + 320, LDS_BYTES = 147456;

DI float bf2f(bf16 v) { return __uint_as_float(((unsigned)v) << 16); }
DI unsigned f2bf(float f) { unsigned u = __float_as_uint(f); return (u + 0x7fffu + ((u >> 16) & 1u)) >> 16; }
DI unsigned pk2(float lo, float hi) { return f2bf(lo) | (f2bf(hi) << 16); }
DI float wave_sum(float v) {
#pragma unroll
    for (int o = 1; o < 64; o <<= 1) v += __shfl_xor(v, o);
    return v;
}
DI float wave_max(float v) {
#pragma unroll
    for (int o = 1; o < 64; o <<= 1) v = fmaxf(v, __shfl_xor(v, o));
    return v;
}
DI float block_sum(float v, LAS float* red, int tid) {
    v = wave_sum(v);
    __syncthreads();
    if ((tid & 63) == 0) red[tid >> 6] = v;
    __syncthreads();
    float s = 0.f;
#pragma unroll
    for (int i = 0; i < NWAVES; ++i) s += red[i];
    return s;
}
DI float gelu_erf(float x) { return 0.5f * x * (1.f + erff(x * 0.70710678118654752f)); }
DI float sigmoidf(float x) { return 1.f / (1.f + __expf(-x)); }

#define XB_TMO      128
#define XB_XCNT(j)  (256  + 64 * (j))
#define XB_XSUB(j)  (1280 + 64 * (j))
#define XB_XGEN(j)  (2304 + 64 * (j))
#define XB_TOP      3328
#define XB_TOPGEN   3392
#define XCD_BAR_WORDS 3456
#define XB_SPIN_CAP (1u << 22)
DI unsigned xb_ld(unsigned* p)              { return __hip_atomic_load(p, __ATOMIC_RELAXED, __HIP_MEMORY_SCOPE_AGENT); }
DI unsigned xb_add(unsigned* p, unsigned v) { return __hip_atomic_fetch_add(p, v, __ATOMIC_RELAXED, __HIP_MEMORY_SCOPE_AGENT); }
DI unsigned xb_xcc_id() { return (unsigned)__builtin_amdgcn_s_getreg((3 << 11) | 20) & 0xFu; }
#define XB_SPIN(cond, bar) do { unsigned _sp = 0; while (cond) { __builtin_amdgcn_s_sleep(1); \
    if ((++_sp & 255u) == 0u) { if (xb_ld(&(bar)[XB_TMO])) break; if (_sp > XB_SPIN_CAP) { atomicAdd(&(bar)[XB_TMO], 1u); break; } } } } while (0)
struct XcdBarrier { unsigned* bar; unsigned x; volatile LAS unsigned* st; };
DI XcdBarrier xcd_barrier_post(unsigned* bar, volatile LAS unsigned* st) {
    XcdBarrier b; b.bar = bar; b.x = xb_xcc_id(); b.st = st;
    if (threadIdx.x == 0) (void)xb_add(&bar[XB_XCNT(b.x)], 1u);
    return b;
}
DI void xcd_barrier_complete(unsigned* bar, unsigned x, unsigned& nloc, unsigned& nx) {
    const unsigned G = gridDim.x * gridDim.y * gridDim.z;
    unsigned sum, cnt, mine, sp = 0u;
    for (;;) {
        sum = 0u; cnt = 0u; mine = 0u;
#pragma unroll
        for (unsigned j = 0; j < 16; ++j) { const unsigned c = xb_ld(&bar[XB_XCNT(j)]); sum += c; cnt += (c > 0u) ? 1u : 0u; mine = (j == x) ? c : mine; }
        if (sum == G) break;
        __builtin_amdgcn_s_sleep(1);
        if ((++sp & 255u) == 0u) { if (xb_ld(&bar[XB_TMO])) break; if (sp > XB_SPIN_CAP) { atomicAdd(&bar[XB_TMO], 1u); break; } }
    }
    nloc = mine > 0u ? mine : 1u; nx = cnt > 0u ? cnt : 1u;
}
DI void xcd_barrier(const XcdBarrier& b) {
    asm volatile("s_waitcnt vmcnt(0)" ::: "memory");
    __syncthreads();
    if (threadIdx.x == 0) {
        unsigned* bar = b.bar;
        __builtin_amdgcn_s_waitcnt(0);
        unsigned nloc = b.st[0], nx = b.st[1];
        if (nloc == 0u) { xcd_barrier_complete(bar, b.x, nloc, nx); b.st[0] = nloc; b.st[1] = nx; }
        const unsigned old = xb_add(&bar[XB_XSUB(b.x)], 1u);
        const unsigned gen = old / nloc;
        if (old + 1u == (gen + 1u) * nloc) {
            __builtin_amdgcn_fence(__ATOMIC_RELEASE, "agent");
            asm volatile("s_waitcnt vmcnt(0)" ::: "memory");
            const unsigned og = xb_add(&bar[XB_TOP], 1u);
            const unsigned tg = og / nx;
            if (og + 1u == (tg + 1u) * nx) xb_add(&bar[XB_TOPGEN], 1u);
            else XB_SPIN(xb_ld(&bar[XB_TOPGEN]) == tg, bar);
            __builtin_amdgcn_fence(__ATOMIC_ACQUIRE, "agent");
            xb_add(&bar[XB_XGEN(b.x)], 1u);
            asm volatile("s_waitcnt vmcnt(0)" ::: "memory");
        } else {
            XB_SPIN(xb_ld(&bar[XB_XGEN(b.x)]) == gen, bar);
            __builtin_amdgcn_fence(__ATOMIC_ACQUIRE, "agent");
            asm volatile("s_waitcnt vmcnt(0)" ::: "memory");
        }
    }
    __syncthreads();
}

struct Frame {
    LAS unsigned char* lds;
    int tid, lane, wave, G, bid;
    const float *x, *mix_norm, *ffn_norm, *final_norm, *w_in, *w_out, *rel_bias, *conv_w1, *conv_b1, *conv_dw, *conv_dw_b, *conv_ln_g, *conv_ln_b, *conv_w2, *conv_b2,
        *peer_wq, *peer_keys, *peer_u, *peer_v;
    float* out;
    unsigned char* ws;
};
DI float gamma_of(int h) { return 1.f - exp2f(-5.f - (float)h); }

DI void p0_prep(Frame& F) {
    const int gw = F.bid * NWAVES + F.wave, NGW = F.G * NWAVES;
    f32x2* rope = (f32x2*)(F.ws + WS_ROPE);
    for (int i = F.bid * NTHR + F.tid; i < SEQ * 32; i += F.G * NTHR) {
        const int s = i >> 5, j = i & 31;
        const float inv = powf(10000.f, -(float)j / 32.f);
        const float ang = (float)s * inv;
        float sn, cs; sincosf(ang, &sn, &cs);
        rope[i] = (f32x2){cs, sn};
    }
    bf16* xb = (bf16*)(F.ws + WS_XB); float* part = (float*)(F.ws + WS_PART);
    for (int m = gw; m < T; m += NGW) {
        const f32x4* xr = (const f32x4*)(F.x + (size_t)m * DM) + F.lane;
        u32x2* o = (u32x2*)(xb + (size_t)m * DM) + F.lane;
        float s = 0.f;
#pragma unroll
        for (int j = 0; j < 4; ++j) { const f32x4 v = xr[64 * j]; s += v.x * v.x + v.y * v.y + v.z * v.z + v.w * v.w; o[64 * j] = (u32x2){pk2(v.x, v.y), pk2(v.z, v.w)}; }
        s = wave_sum(s);
        if (F.lane < 16) part[(size_t)m * 16 + F.lane] = (F.lane == 0) ? s : 0.f;
    }
}
DI float row_rstd(const float* part, int m) {
    const f32x4* p = (const f32x4*)(part + (size_t)m * 16);
    const f32x4 a = p[0], b = p[1], c = p[2], d = p[3];
    const float s = ((a.x + a.y) + (a.z + a.w)) + ((b.x + b.y) + (b.z + b.w)) + ((c.x + c.y) + (c.z + c.w)) + ((d.x + d.y) + (d.z + d.w));
    return 1.f / sqrtf(s * (1.f / DM) + EPS);
}

enum { EP_PROJ = 0, EP_RES = 1, EP_Q = 2, EP_HID = 3 };
template <int EP>
DI void naive_gemm(Frame& F, const bf16* A, const float* W, int N, const float* gain, const float* bias, bf16* Ob, int ldo) {
    LAS float* As = (LAS float*)F.lds;
    LAS float* Bs = As + 16 * 129;
    LAS float* rs = Bs + 16 * 64;
    const float* part = (const float*)(F.ws + WS_PART);
    const f32x2* rope = (const f32x2*)(F.ws + WS_ROPE);
    bf16* hb = (bf16*)(F.ws + WS_XB);
    const int tid = F.tid, tx = tid & 15, ty = tid >> 4;
    const int nN = N / 64, nItems = (T / 128) * nN;
    for (int it = F.bid; it < nItems; it += F.G) {
        const int m0 = (it / nN) * 128, n0 = (it % nN) * 64;
        __syncthreads();
        if (EP != EP_RES) { if (tid < 128) rs[tid] = row_rstd(part, m0 + tid); }
        float acc[4][4];
#pragma unroll
        for (int i = 0; i < 4; ++i)
#pragma unroll
            for (int j = 0; j < 4; ++j) acc[i][j] = 0.f;
        for (int k0 = 0; k0 < DM; k0 += 16) {
            {   const int r = tid >> 2, kk = (tid & 3) * 4;
                const u32x2 v = *(const u32x2*)(A + (size_t)(m0 + r) * DM + k0 + kk);
                As[(kk + 0) * 129 + r] = __uint_as_float(v.x << 16); As[(kk + 1) * 129 + r] = __uint_as_float(v.x & 0xffff0000u);
                As[(kk + 2) * 129 + r] = __uint_as_float(v.y << 16); As[(kk + 3) * 129 + r] = __uint_as_float(v.y & 0xffff0000u); }
            {   const int kk = tid >> 5, c = (tid & 31) * 2;
                const f32x2 v = *(const f32x2*)(W + (size_t)(k0 + kk) * N + n0 + c);
                const float g = gain ? gain[k0 + kk] : 1.f;
                Bs[kk * 64 + c] = v.x * g; Bs[kk * 64 + c + 1] = v.y * g; }
            __syncthreads();
#pragma unroll
            for (int kk = 0; kk < 16; ++kk) {
                float a[4], b[4];
#pragma unroll
                for (int i = 0; i < 4; ++i) a[i] = As[kk * 129 + ty * 4 + i];
                b[0] = Bs[kk * 64 + 2 * tx]; b[1] = Bs[kk * 64 + 2 * tx + 1]; b[2] = Bs[kk * 64 + 32 + 2 * tx]; b[3] = Bs[kk * 64 + 33 + 2 * tx];
#pragma unroll
                for (int i = 0; i < 4; ++i)
#pragma unroll
                    for (int j = 0; j < 4; ++j) acc[i][j] += a[i] * b[j];
            }
            __syncthreads();
        }
#pragma unroll
        for (int i = 0; i < 4; ++i) {
            const int m = m0 + ty * 4 + i;
            const int cols[4] = {n0 + 2 * tx, n0 + 2 * tx + 1, n0 + 32 + 2 * tx, n0 + 33 + 2 * tx};
            float v[4] = {acc[i][0], acc[i][1], acc[i][2], acc[i][3]};
            if (EP == EP_PROJ) {
                const float r = rs[ty * 4 + i];
#pragma unroll
                for (int j = 0; j < 4; ++j) v[j] *= r;
                const int type = n0 / 512;
                if (type == 3 || type == 4) {
                    const int s = m % SEQ;
#pragma unroll
                    for (int j = 0; j < 2; ++j) {
                        const f32x2 cs = rope[s * 32 + 2 * tx + j];
                        const float t1 = v[j], t2 = v[j + 2];
                        v[j] = t1 * cs.x - t2 * cs.y; v[j + 2] = t1 * cs.y + t2 * cs.x;
                    }
                }
                if (type == 0 || type == 4) {
#pragma unroll
                    for (int j = 0; j < 4; ++j) v[j] *= 0.125f;
                }
#pragma unroll
                for (int j = 0; j < 4; ++j) Ob[(size_t)m * ldo + cols[j]] = (bf16)f2bf(v[j]);
            } else if (EP == EP_RES) {
#pragma unroll
                for (int j = 0; j < 4; ++j) {
                    const size_t o = (size_t)m * DM + cols[j];
                    const float base = (Ob == nullptr) ? F.x[o] : F.out[o];
                    const float hn = base + v[j] + (bias ? bias[cols[j]] : 0.f);
                    F.out[o] = hn; hb[o] = (bf16)f2bf(hn);
                }
            } else if (EP == EP_Q) {
                const float r = rs[ty * 4 + i];
#pragma unroll
                for (int j = 0; j < 4; ++j) Ob[(size_t)m * ldo + cols[j]] = (bf16)f2bf(v[j] * r);
            } else {
                const float r = rs[ty * 4 + i];
#pragma unroll
                for (int j = 0; j < 4; ++j) Ob[(size_t)m * ldo + cols[j]] = (bf16)f2bf(v[j] * r + bias[cols[j]]);
            }
        }
    }
}

DI void naive_rowstat(Frame& F) {
    const int gw = F.bid * NWAVES + F.wave, NGW = F.G * NWAVES;
    float* part = (float*)(F.ws + WS_PART);
    for (int m = gw; m < T; m += NGW) {
        const f32x4* xr = (const f32x4*)(F.out + (size_t)m * DM) + F.lane;
        float s = 0.f;
#pragma unroll
        for (int j = 0; j < 4; ++j) { const f32x4 v = xr[64 * j]; s += v.x * v.x + v.y * v.y + v.z * v.z + v.w * v.w; }
        s = wave_sum(s);
        if (F.lane < 16) part[(size_t)m * 16 + F.lane] = (F.lane == 0) ? s : 0.f;
    }
}

DI void naive_attn(Frame& F) {
    const bf16* R = (const bf16*)(F.ws + WS_R); bf16* O = (bf16*)(F.ws + WS_O);
    LAS float* Ks = (LAS float*)F.lds;
    LAS float* Vs = Ks + 64 * 65;
    LAS float* bs = Vs + 64 * 65;
    const int tid = F.tid;
    for (int it = F.bid; it < NB * NHA * 4; it += F.G) {
        const int b = it / (NHA * 4), h = (it / 4) % NHA, cg = it % 4;
        const int c = cg * 8 + (tid >> 6), i = tid & 63;
        __syncthreads();
        for (int k = tid; k < 257; k += NTHR) bs[k] = F.rel_bias[h * 257 + k];
        float q[64], acc[64];
        {   const bf16* qp = R + (size_t)(b * SEQ + c * 64 + i) * INC + C_QA + h * 64;
#pragma unroll
            for (int d = 0; d < 64; ++d) { q[d] = bf2f(qp[d]); acc[d] = 0.f; } }
        float mx = -1e30f, l = 0.f;
        const int t_lo = (cg * 8 - 8) < 0 ? 0 : (cg * 8 - 8), t_hi = cg * 8 + 7;
        for (int tc = t_lo; tc <= t_hi; ++tc) {
            __syncthreads();
            for (int e = tid; e < 64 * 64; e += NTHR) {
                const int j = e >> 6, d = e & 63;
                const size_t row = (size_t)(b * SEQ + tc * 64 + j) * INC;
                Ks[j * 65 + d] = bf2f(R[row + C_KA + h * 64 + d]);
                Vs[j * 65 + d] = bf2f(R[row + C_VA + h * 64 + d]);
            }
            __syncthreads();
            if (tc <= c && tc >= c - 8) {
                for (int j = 0; j < 64; ++j) {
                    float s = 0.f;
#pragma unroll
                    for (int d = 0; d < 64; ++d) s += q[d] * Ks[j * 65 + d];
                    int rel = (c * 64 + i) - (tc * 64 + j); rel = rel < -128 ? -128 : (rel > 128 ? 128 : rel);
                    s += bs[rel + 128];
                    const float mn = fmaxf(mx, s), corr = __expf(mx - mn), p = __expf(s - mn);
                    l = l * corr + p;
#pragma unroll
                    for (int d = 0; d < 64; ++d) acc[d] = acc[d] * corr + p * Vs[j * 65 + d];
                    mx = mn;
                }
            }
        }
        const float inv = 1.f / l;
        bf16* op = O + (size_t)(b * SEQ + c * 64 + i) * DM + h * 64;
#pragma unroll
        for (int d = 0; d < 64; ++d) op[d] = (bf16)f2bf(acc[d] * inv);
    }
}

DI void naive_ret(Frame& F) {
    const bf16* R = (const bf16*)(F.ws + WS_R); bf16* O = (bf16*)(F.ws + WS_O);
    LAS float* St = (LAS float*)F.lds;
    LAS float* Qs = St + 4096;
    LAS float* Ks = Qs + 64 * 65;
    LAS float* Vs = Ks + 64 * 65;
    LAS float* Sc = Vs + 64 * 65;
    LAS float* Ot = Sc + 64 * 65;
    const int tid = F.tid;
    for (int it = F.G - 1 - F.bid; it < NB * NHB; it += F.G) {
        const int b = it / NHB, h = it % NHB;
        const float lg = logf(gamma_of(h));
        const float cd = __expf(lg * 64.f);
        __syncthreads();
        for (int e = tid; e < 4096; e += NTHR) St[e] = 0.f;
        for (int n = 0; n < NCH; ++n) {
            __syncthreads();
            for (int e = tid; e < 4096; e += NTHR) {
                const int j = e >> 6, d = e & 63;
                const size_t row = (size_t)(b * SEQ + n * 64 + j) * INC;
                Qs[j * 65 + d] = bf2f(R[row + C_QB + h * 64 + d]);
                Ks[j * 65 + d] = bf2f(R[row + C_KB + h * 64 + d]);
                Vs[j * 65 + d] = bf2f(R[row + C_VB + h * 64 + d]);
            }
            __syncthreads();
            for (int e = tid; e < 4096; e += NTHR) {
                const int i = e >> 6, j = e & 63;
                float s = 0.f;
#pragma unroll
                for (int d = 0; d < 64; ++d) s += Qs[i * 65 + d] * Ks[j * 65 + d];
                const int ad = i > j ? i - j : j - i;
                Sc[i * 65 + j] = s * __expf(lg * (float)ad);
            }
            __syncthreads();
            for (int e = tid; e < 4096; e += NTHR) {
                const int i = e >> 6, ee = e & 63;
                float s = 0.f, cr = 0.f;
#pragma unroll
                for (int j = 0; j < 64; ++j) s += Sc[i * 65 + j] * Vs[j * 65 + ee];
#pragma unroll
                for (int d = 0; d < 64; ++d) cr += Qs[i * 65 + d] * St[d * 64 + ee];
                Ot[i * 65 + ee] = s + cr * __expf(lg * (float)(i + 1));
            }
            __syncthreads();
            for (int e = tid; e < 4096; e += NTHR) {
                const int d = e >> 6, ee = e & 63;
                float s = 0.f;
                for (int j = 0; j < 64; ++j) s += Ks[j * 65 + d] * __expf(lg * (float)(63 - j)) * Vs[j * 65 + ee];
                St[d * 64 + ee] = cd * St[d * 64 + ee] + s;
            }
            for (int r = 0; r < 8; ++r) {
                const int i = F.wave * 8 + r;
                const float v = Ot[i * 65 + F.lane];
                const float mu = wave_sum(v) * (1.f / 64.f);
                const float dv = v - mu;
                const float var = wave_sum(dv * dv) * (1.f / 64.f);
                const size_t row = (size_t)(b * SEQ + n * 64 + i);
                const float g = bf2f(R[row * INC + C_GB + h * 64 + F.lane]);
                const float o = dv * (1.f / sqrtf(var + EPS)) * (g * sigmoidf(g));
                O[row * DM + 512 + h * 64 + F.lane] = (bf16)f2bf(o);
            }
        }
    }
}

DI void naive_route(Frame& F, int layer) {
    const bf16* Q = (const bf16*)(F.ws + WS_Q);
    int* eidx = (int*)(F.ws + WS_EIDX); float* gate = (float*)(F.ws + WS_GATE);
    const float* keys = F.peer_keys + (size_t)layer * 2 * PK * 64;
    LAS float* sc = (LAS float*)F.lds;
    LAS int* i1s = (LAS int*)(sc + 256 * 64);
    LAS int* i2s = i1s + 16 * 64;
    LAS float* qs = (LAS float*)(i2s + 16 * 64);
    const int p = F.tid;
    for (int it = F.bid; it < T / 8; it += F.G) {
        if (p < 64) {
            const int t = it * 8 + (p >> 3), hh = p & 7;
            float top1[16], top2[16];
#pragma unroll
            for (int side = 0; side < 2; ++side) {
                const bf16* qp = Q + (size_t)t * DM + hh * 128 + side * 64;
                for (int d = 0; d < 64; ++d) qs[d * 64 + p] = bf2f(qp[d]);
                for (int k = 0; k < PK; ++k) {
                    const float* kp = keys + ((size_t)side * PK + k) * 64;
                    float s = 0.f;
#pragma unroll 8
                    for (int d = 0; d < 64; ++d) s += qs[d * 64 + p] * kp[d];
                    sc[k * 64 + p] = s;
                }
#pragma unroll
                for (int a = 0; a < 16; ++a) {
                    float best = -INFINITY; int bi = 0;
                    for (int k = 0; k < PK; ++k) { const float v = sc[k * 64 + p]; if (v > best) { best = v; bi = k; } }
                    sc[bi * 64 + p] = -INFINITY;
                    if (side == 0) { top1[a] = best; i1s[a * 64 + p] = bi; } else { top2[a] = best; i2s[a * 64 + p] = bi; }
                }
            }
#pragma unroll
            for (int a = 0; a < 16; ++a)
#pragma unroll
                for (int b = 0; b < 16; ++b) sc[(a * 16 + b) * 64 + p] = top1[a] + top2[b];
            float bv[16]; int be[16];
#pragma unroll
            for (int a = 0; a < 16; ++a) {
                float best = -INFINITY; int bi = 0;
                for (int k = 0; k < 256; ++k) { const float v = sc[k * 64 + p]; if (v > best) { best = v; bi = k; } }
                sc[bi * 64 + p] = -INFINITY;
                bv[a] = best; be[a] = i1s[(bi >> 4) * 64 + p] * PK + i2s[(bi & 15) * 64 + p];
            }
            float sum = 0.f; const float bmax = bv[0];
#pragma unroll
            for (int a = 0; a < 16; ++a) { bv[a] = __expf(bv[a] - bmax); sum += bv[a]; }
            const float inv = 1.f / sum;
#pragma unroll
            for (int a = 0; a < 16; ++a) { eidx[(size_t)t * NSEL + hh * 16 + a] = be[a]; gate[(size_t)t * NSEL + hh * 16 + a] = bv[a] * inv; }
        }
    }
}

DI void naive_gather(Frame& F, int layer, bool final_norm) {
    const int* eidx = (const int*)(F.ws + WS_EIDX); const float* gate = (const float*)(F.ws + WS_GATE);
    float* part = (float*)(F.ws + WS_PART); bf16* hb = (bf16*)(F.ws + WS_XB);
    const float* U = F.peer_u + (size_t)layer * PE * DM; const float* V = F.peer_v + (size_t)layer * PE * DM;
    const float* gn = F.ffn_norm + layer * DM;
    LAS float* xs = (LAS float*)F.lds;
    LAS float* as = xs + 1024;
    LAS int* es = (LAS int*)(as + 128);
    LAS float* red = (LAS float*)(es + 128);
    const int tid = F.tid;
    for (int t = F.bid; t < T; t += F.G) {
        __syncthreads();
        const float rstd = row_rstd(part, t);
        const f32x2 hv = *(const f32x2*)(F.out + (size_t)t * DM + 2 * tid);
        xs[2 * tid] = hv.x * rstd * gn[2 * tid]; xs[2 * tid + 1] = hv.y * rstd * gn[2 * tid + 1];
        if (tid < 128) es[tid] = eidx[(size_t)t * NSEL + tid];
        __syncthreads();
        for (int k = F.wave; k < NSEL; k += NWAVES) {
            const f32x4* ur = (const f32x4*)(U + (size_t)es[k] * DM) + F.lane;
            float s = 0.f;
#pragma unroll
            for (int j = 0; j < 4; ++j) { const f32x4 u = ur[64 * j]; const int c = 4 * F.lane + 256 * j; s += u.x * xs[c] + u.y * xs[c + 1] + u.z * xs[c + 2] + u.w * xs[c + 3]; }
            s = wave_sum(s);
            if (F.lane == 0) as[k] = gelu_erf(s) * gate[(size_t)t * NSEL + k];
        }
        __syncthreads();
        float o0 = 0.f, o1 = 0.f;
        for (int k = 0; k < NSEL; ++k) { const f32x2 v = *(const f32x2*)(V + (size_t)es[k] * DM + 2 * tid); const float a = as[k]; o0 += a * v.x; o1 += a * v.y; }
        const float h0 = hv.x + o0, h1 = hv.y + o1;
        const float ss = block_sum(h0 * h0 + h1 * h1, red, tid);
        if (final_norm) {
            const float r = 1.f / sqrtf(ss * (1.f / DM) + EPS);
            *(f32x2*)(F.out + (size_t)t * DM + 2 * tid) = (f32x2){h0 * r * F.final_norm[2 * tid], h1 * r * F.final_norm[2 * tid + 1]};
        } else {
            *(f32x2*)(F.out + (size_t)t * DM + 2 * tid) = (f32x2){h0, h1};
            *(unsigned*)(hb + (size_t)t * DM + 2 * tid) = pk2(h0, h1);
            if (tid < 16) part[(size_t)t * 16 + tid] = (tid == 0) ? ss : 0.f;
        }
    }
}

DI void naive_glu(Frame& F) {
    const bf16* H = (const bf16*)(F.ws + WS_HID); bf16* G = (bf16*)(F.ws + WS_GLU);
    for (size_t i = (size_t)F.bid * NTHR + F.tid; i < (size_t)T * DM; i += (size_t)F.G * NTHR) {
        const size_t m = i / DM; const int c = (int)(i % DM);
        const float a = bf2f(H[m * 2048 + c]), g = bf2f(H[m * 2048 + 1024 + c]);
        G[i] = (bf16)f2bf(a * sigmoidf(g));
    }
}
DI void naive_conv(Frame& F) {
    const bf16* G = (const bf16*)(F.ws + WS_GLU); bf16* H2 = (bf16*)(F.ws + WS_HID2);
    LAS float* red = (LAS float*)F.lds;
    const int tid = F.tid;
    for (int t = F.bid; t < T; t += F.G) {
        const int s = t % SEQ;
        float y[2];
#pragma unroll
        for (int u = 0; u < 2; ++u) {
            const int c = 2 * tid + u;
            float a = F.conv_dw_b[c];
            for (int j = 0; j < CW; ++j) { const int sp = s - (CW - 1) + j; if (sp >= 0) a += F.conv_dw[j * DM + c] * bf2f(G[(size_t)(t - (CW - 1) + j) * DM + c]); }
            y[u] = a;
        }
        const float mu = block_sum(y[0] + y[1], red, tid) * (1.f / DM);
        const float d0 = y[0] - mu, d1 = y[1] - mu;
        const float var = block_sum(d0 * d0 + d1 * d1, red, tid) * (1.f / DM);
        const float r = 1.f / sqrtf(var + EPS);
        const float z0 = d0 * r * F.conv_ln_g[2 * tid] + F.conv_ln_b[2 * tid], z1 = d1 * r * F.conv_ln_g[2 * tid + 1] + F.conv_ln_b[2 * tid + 1];
        *(unsigned*)(H2 + (size_t)t * DM + 2 * tid) = pk2(z0 * sigmoidf(z0), z1 * sigmoidf(z1));
    }
}

enum Phase { PH_PREP = 0, PH_PROJ, PH_MIX, PH_WOUT, PH_STAT0, PH_Q0, PH_ROUTE0, PH_GATHER0, PH_W1, PH_GLU, PH_CONV, PH_W2, PH_STAT1, PH_Q1, PH_ROUTE1, PH_GATHER1, PH_COUNT };
struct Args { const float* in[19]; float* out; unsigned char* ws; int ph_lo, ph_hi; };

__global__ void __launch_bounds__(NTHR, 2) mega_fwd(Args args) {
    extern __shared__ __attribute__((aligned(16))) unsigned char lds[];
    Frame F;
    F.lds = (LAS unsigned char*)lds;
    F.tid = threadIdx.x; F.lane = F.tid & 63; F.wave = __builtin_amdgcn_readfirstlane(F.tid >> 6);
    F.G = gridDim.x; F.bid = blockIdx.x;
    F.x = args.in[0]; F.mix_norm = args.in[1]; F.ffn_norm = args.in[2]; F.final_norm = args.in[3]; F.w_in = args.in[4]; F.w_out = args.in[5]; F.rel_bias = args.in[6];
    F.conv_w1 = args.in[7]; F.conv_b1 = args.in[8]; F.conv_dw = args.in[9]; F.conv_dw_b = args.in[10]; F.conv_ln_g = args.in[11]; F.conv_ln_b = args.in[12];
    F.conv_w2 = args.in[13]; F.conv_b2 = args.in[14]; F.peer_wq = args.in[15]; F.peer_keys = args.in[16]; F.peer_u = args.in[17]; F.peer_v = args.in[18];
    F.out = args.out; F.ws = args.ws;
    volatile LAS unsigned* MISC = (volatile LAS unsigned*)(F.lds + MISC_OFF);
    for (int u = F.tid; u < (LDS_BYTES - LDSCTL_OFF) / 4; u += NTHR) ((LAS unsigned*)(F.lds + LDSCTL_OFF))[u] = 0u;
    __syncthreads();
    const int lo = args.ph_lo, hi = args.ph_hi;
    XcdBarrier bar; bar.bar = (unsigned*)(F.ws + WS_CTL) + CW_BAR; bar.x = 0; bar.st = nullptr;
    if (hi - lo > 1) bar = xcd_barrier_post((unsigned*)(F.ws + WS_CTL) + CW_BAR, MISC + 8);
#ifndef TEST_PHASE
#define TEST_PHASE -1
#endif
#define IN(k) ((TEST_PHASE < 0 || TEST_PHASE == (k)) && lo <= (k) && (k) < hi)
#define SEAM(k) do { if (IN(k) && IN((k) + 1)) xcd_barrier(bar); } while (0)
    bf16* XB = (bf16*)(F.ws + WS_XB);
    if (IN(PH_PREP)) { p0_prep(F); } SEAM(PH_PREP);
    if (IN(PH_PROJ)) { naive_gemm<EP_PROJ>(F, XB, F.w_in, INC, F.mix_norm, nullptr, (bf16*)(F.ws + WS_R), INC); } SEAM(PH_PROJ);
    if (IN(PH_MIX)) { naive_ret(F); naive_attn(F); } SEAM(PH_MIX);
    if (IN(PH_WOUT)) { naive_gemm<EP_RES>(F, (const bf16*)(F.ws + WS_O), F.w_out, DM, nullptr, nullptr, nullptr, DM); } SEAM(PH_WOUT);
    if (IN(PH_STAT0)) { naive_rowstat(F); } SEAM(PH_STAT0);
    if (IN(PH_Q0)) { naive_gemm<EP_Q>(F, XB, F.peer_wq, DM, F.ffn_norm, nullptr, (bf16*)(F.ws + WS_Q), DM); } SEAM(PH_Q0);
    if (IN(PH_ROUTE0)) { naive_route(F, 0); } SEAM(PH_ROUTE0);
    if (IN(PH_GATHER0)) { naive_gather(F, 0, false); } SEAM(PH_GATHER0);
    if (IN(PH_W1)) { naive_gemm<EP_HID>(F, XB, F.conv_w1, 2 * DM, F.mix_norm + DM, F.conv_b1, (bf16*)(F.ws + WS_HID), 2 * DM); } SEAM(PH_W1);
    if (IN(PH_GLU)) { naive_glu(F); } SEAM(PH_GLU);
    if (IN(PH_CONV)) { naive_conv(F); } SEAM(PH_CONV);
    if (IN(PH_W2)) { naive_gemm<EP_RES>(F, (const bf16*)(F.ws + WS_HID2), F.conv_w2, DM, nullptr, F.conv_b2, XB  , DM); } SEAM(PH_W2);
    if (IN(PH_STAT1)) { naive_rowstat(F); } SEAM(PH_STAT1);
    if (IN(PH_Q1)) { naive_gemm<EP_Q>(F, XB, F.peer_wq + (size_t)DM * DM, DM, F.ffn_norm + DM, nullptr, (bf16*)(F.ws + WS_Q), DM); } SEAM(PH_Q1);
    if (IN(PH_ROUTE1)) { naive_route(F, 1); } SEAM(PH_ROUTE1);
    if (IN(PH_GATHER1)) { naive_gather(F, 1, true); }
#undef IN
#undef SEAM
}

extern "C" void kernel_launch(void* const* d_in, const int* in_sizes, int n_in, void* d_out, int out_size, void* d_ws, size_t ws_size, hipStream_t stream) {
    static int grid = 0;
    if (grid == 0) {
        if (n_in != 19 || out_size != T * DM || ws_size < WS_END) { fprintf(stderr, "kernel_launch: unexpected shapes (n_in %d out %d ws %zu)\n", n_in, out_size, ws_size); grid = -1; return; }
        int dev = 0, cus = 0;
        if (hipGetDevice(&dev) != hipSuccess || hipDeviceGetAttribute(&cus, hipDeviceAttributeMultiprocessorCount, dev) != hipSuccess) { grid = -1; return; }
        if (hipFuncSetAttribute((const void*)mega_fwd, hipFuncAttributeMaxDynamicSharedMemorySize, LDS_BYTES) != hipSuccess) { fprintf(stderr, "kernel_launch: hipFuncSetAttribute failed\n"); grid = -1; return; }
        (void)hipGetLastError();
        grid = cus;
    }
    if (grid < 0) return;
    (void)hipMemsetAsync((char*)d_ws + WS_CTL, 0, CTL_ZERO_BYTES, stream);
    Args a{};
    for (int i = 0; i < 19; ++i) a.in[i] = (const float*)d_in[i];
    a.out = (float*)d_out; a.ws = (unsigned char*)d_ws;
#if MK_ONE_LAUNCH
    a.ph_lo = 0; a.ph_hi = PH_COUNT;
    hipLaunchKernelGGL(mega_fwd, dim3(grid), dim3(NTHR), LDS_BYTES, stream, a);
#else
    for (int p = 0; p < PH_COUNT; ++p) { a.ph_lo = p; a.ph_hi = p + 1; hipLaunchKernelGGL(mega_fwd, dim3(grid), dim3(NTHR), LDS_BYTES, stream, a); }
#endif
}
```

```cpp
#include <hip/hip_runtime.h>
#include <cstdio>
#include <cstdint>

#ifndef OPT_GEMM
#define OPT_GEMM 1
#endif
#ifndef MK_ONE_LAUNCH
#define MK_ONE_LAUNCH 1
#endif

#define GAS __attribute__((address_space(1)))
#define LAS __attribute__((address_space(3)))
#define DI __device__ __forceinline__
typedef unsigned short bf16;
typedef float f32x2 __attribute__((ext_vector_type(2)));
typedef float f32x4 __attribute__((ext_vector_type(4)));
typedef unsigned u32x2 __attribute__((ext_vector_type(2)));
typedef unsigned u32x4 __attribute__((ext_vector_type(4)));

constexpr int NB = 16, SEQ = 2048, DM = 1024, T = NB * SEQ;
constexpr int CHUNK = 64, HD = 64, NHA = 8, NHB = 8, INC = 3584, NCH = SEQ / CHUNK;
constexpr int PH = 8, PK = 128, PE = PK * PK, PQD = 128, PTOP = 16, NSEL = PH * PTOP;
constexpr int CW = 31;
constexpr float EPS = 1e-6f;
constexpr int NWAVES = 8, NTHR = NWAVES * 64;

constexpr int C_QA = 0, C_KA = 512, C_VA = 1024, C_QB = 1536, C_KB = 2048, C_VB = 2560, C_GB = 3072;

constexpr size_t MiB = 1u << 20;
constexpr size_t WS_CTL = 0, CTL_ZERO_BYTES = 1 * MiB;
constexpr size_t WS_WIN = 2 * MiB, WS_WOUT = 9 * MiB, WS_W1 = 11 * MiB, WS_W2 = 15 * MiB, WS_WQ = 17 * MiB;
constexpr size_t WS_ROPE = 22 * MiB;
constexpr size_t WS_PART = 23 * MiB;
constexpr size_t WS_EIDX = 26 * MiB;
constexpr size_t WS_GATE = 42 * MiB;
constexpr size_t WS_XB = 128 * MiB;
constexpr size_t WS_R = 192 * MiB;
constexpr size_t WS_O = 416 * MiB;
constexpr size_t WS_Q = 192 * MiB;
constexpr size_t WS_HID = 256 * MiB;
constexpr size_t WS_GLU = 384 * MiB;
constexpr size_t WS_HID2 = 448 * MiB;
constexpr size_t WS_END = 512 * MiB;
constexpr int CW_BAR = 4096;

constexpr int RING_BYTES = 131072, LDSCTL_OFF = RING_BYTES, MISC_OFF = LDSCTL_OFF + 320, LDS_BYTES = 147456;

DI float bf2f(bf16 v) { return __uint_as_float(((unsigned)v) << 16); }
DI unsigned f2bf(float f) { unsigned u = __float_as_uint(f); return (u + 0x7fffu + ((u >> 16) & 1u)) >> 16; }
DI unsigned pk2(float lo, float hi) { return f2bf(lo) | (f2bf(hi) << 16); }
DI float wave_sum(float v) {
#pragma unroll
    for (int o = 1; o < 64; o <<= 1) v += __shfl_xor(v, o);
    return v;
}
DI float wave_max(float v) {
#pragma unroll
    for (int o = 1; o < 64; o <<= 1) v = fmaxf(v, __shfl_xor(v, o));
    return v;
}
DI float block_sum(float v, LAS float* red, int tid) {
    v = wave_sum(v);
    __syncthreads();
    if ((tid & 63) == 0) red[tid >> 6] = v;
    __syncthreads();
    float s = 0.f;
#pragma unroll
    for (int i = 0; i < NWAVES; ++i) s += red[i];
    return s;
}
DI float gelu_erf(float x) { return 0.5f * x * (1.f + erff(x * 0.70710678118654752f)); }
DI float sigmoidf(float x) { return 1.f / (1.f + __expf(-x)); }

DI int lane_id() { return (int)__builtin_amdgcn_mbcnt_hi(~0u, __builtin_amdgcn_mbcnt_lo(~0u, 0u)); }
#define XB_TMO      128
#define XB_XCNT(j)  (256  + 64 * (j))
#define XB_XSUB(j)  (1280 + 64 * (j))
#define XB_XGEN(j)  (2304 + 64 * (j))
#define XB_TOP      3328
#define XB_TOPGEN   3392
#define XCD_BAR_WORDS 3456
#define XB_SPIN_CAP (1u << 22)
DI unsigned xb_ld(unsigned* p)              { return __hip_atomic_load(p, __ATOMIC_RELAXED, __HIP_MEMORY_SCOPE_AGENT); }
DI unsigned xb_add(unsigned* p, unsigned v) { return __hip_atomic_fetch_add(p, v, __ATOMIC_RELAXED, __HIP_MEMORY_SCOPE_AGENT); }
DI unsigned xb_xcc_id() { return (unsigned)__builtin_amdgcn_s_getreg((3 << 11) | 20) & 0xFu; }
#define XB_SPIN(cond, bar) do { unsigned _sp = 0; while (cond) { __builtin_amdgcn_s_sleep(1); \
    if ((++_sp & 255u) == 0u) { if (xb_ld(&(bar)[XB_TMO])) break; if (_sp > XB_SPIN_CAP) { atomicAdd(&(bar)[XB_TMO], 1u); break; } } } } while (0)
struct XcdBarrier { unsigned* bar; unsigned x; volatile LAS unsigned* st; };
DI XcdBarrier xcd_barrier_post(unsigned* bar, volatile LAS unsigned* st) {
    XcdBarrier b; b.bar = bar; b.x = xb_xcc_id(); b.st = st;
    if (threadIdx.x == 0) (void)xb_add(&bar[XB_XCNT(b.x)], 1u);
    return b;
}
DI void xcd_barrier_complete(unsigned* bar, unsigned x, unsigned& nloc, unsigned& nx) {
    const unsigned G = gridDim.x * gridDim.y * gridDim.z;
    unsigned sum, cnt, mine, sp = 0u;
    for (;;) {
        sum = 0u; cnt = 0u; mine = 0u;
#pragma unroll
        for (unsigned j = 0; j < 16; ++j) { const unsigned c = xb_ld(&bar[XB_XCNT(j)]); sum += c; cnt += (c > 0u) ? 1u : 0u; mine = (j == x) ? c : mine; }
        if (sum == G) break;
        __builtin_amdgcn_s_sleep(1);
        if ((++sp & 255u) == 0u) { if (xb_ld(&bar[XB_TMO])) break; if (sp > XB_SPIN_CAP) { atomicAdd(&bar[XB_TMO], 1u); break; } }
    }
    nloc = mine > 0u ? mine : 1u; nx = cnt > 0u ? cnt : 1u;
}
DI void xcd_barrier(const XcdBarrier& b, const int wave_id) {
    asm volatile("s_waitcnt vmcnt(0)" ::: "memory");
    __syncthreads();
    if (wave_id == 0 && lane_id() == 0) {
        unsigned* bar = b.bar;
        __builtin_amdgcn_s_waitcnt(0);
        unsigned nloc = b.st[0], nx = b.st[1];
        if (nloc == 0u) { xcd_barrier_complete(bar, b.x, nloc, nx); b.st[0] = nloc; b.st[1] = nx; }
        const unsigned old = xb_add(&bar[XB_XSUB(b.x)], 1u);
        const unsigned gen = old / nloc;
        if (old + 1u == (gen + 1u) * nloc) {
            __builtin_amdgcn_fence(__ATOMIC_RELEASE, "agent");
            asm volatile("s_waitcnt vmcnt(0)" ::: "memory");
            const unsigned og = xb_add(&bar[XB_TOP], 1u);
            const unsigned tg = og / nx;
            if (og + 1u == (tg + 1u) * nx) xb_add(&bar[XB_TOPGEN], 1u);
            else XB_SPIN(xb_ld(&bar[XB_TOPGEN]) == tg, bar);
            __builtin_amdgcn_fence(__ATOMIC_ACQUIRE, "agent");
            xb_add(&bar[XB_XGEN(b.x)], 1u);
            asm volatile("s_waitcnt vmcnt(0)" ::: "memory");
        } else {
            XB_SPIN(xb_ld(&bar[XB_XGEN(b.x)]) == gen, bar);
            __builtin_amdgcn_fence(__ATOMIC_ACQUIRE, "agent");
            asm volatile("s_waitcnt vmcnt(0)" ::: "memory");
        }
    }
    __syncthreads();
}

namespace pg8 {
#define PG8_LAS __attribute__((address_space(3)))
typedef unsigned short bf16_t;
typedef short bf16x8 __attribute__((ext_vector_type(8)));
typedef float f32x4 __attribute__((ext_vector_type(4)));
typedef unsigned u32x4 __attribute__((ext_vector_type(4)));
constexpr int BM = 256, BK = 64, HALF = 128, HTB = HALF * BK * 2  , STAGE_BYTES = 8 * HTB, NXCD = 8, WGM = 8;

__host__ __device__ __forceinline__ int lds_byte(int r, int c) { const int st = (r >> 4) * 2 + (c >> 5), rr = r & 15, cc = c & 31, ob = rr * 64 + cc * 2; return st * 1024 + (ob ^ (((ob >> 9) & 1) << 5)); }
__host__ __device__ __forceinline__ void stage_rc(int b, int& R, int& C) { const int st = b / 1024, sb = b % 1024, swz = sb ^ (((sb >> 9) & 1) << 5); R = (st >> 1) * 16 + swz / 64; C = (st & 1) * 32 + (swz % 64) / 2; }
__host__ __device__ __forceinline__ int perm32(int rho) { const int n = rho >> 4, i = rho & 15; return 8 * (i >> 2) + 4 * n + (i & 3); }

struct Unit { int pm, pn; };
struct Gemm { const bf16_t* A; const bf16_t* Bt; int M, N, K; };

struct StaticOrder {
    int nM, nN, nwg, G, c;
    __host__ __device__ void init(int M, int N, int G_, int c_) { nM = M / BM; nN = N / BM; nwg = nM * nN; G = G_; c = c_; }
    __host__ __device__ bool next(int i, Unit& u) const {
        const long L = (long)i * G + c; if (L >= nwg) return false;
        int wgid = (int)L; { const int q = nwg / NXCD, r = nwg % NXCD, xcd = wgid % NXCD, off = wgid / NXCD; wgid = (xcd < r ? xcd * (q + 1) : r * (q + 1) + (xcd - r) * q) + off; }
        const int nig = WGM * nN, gid = wgid / nig, fm = gid * WGM, gsz = (nM - fm) < WGM ? (nM - fm) : WGM;
        u.pm = fm + ((wgid % nig) % gsz); u.pn = (wgid % nig) / gsz; return true;
    }
    __device__ __forceinline__ void a_ready(const Unit&) const {}
    __device__ __forceinline__ void done(const Unit&) const {}
};

__device__ __forceinline__ unsigned cvt_pk_bf16(float lo, float hi) { unsigned r; asm volatile("v_cvt_pk_bf16_f32 %0, %1, %2" : "=v"(r) : "v"(lo), "v"(hi)); return r; }
__device__ __forceinline__ float rstd16(const float* part, int r) {
    const f32x4* p = (const f32x4*)(part + (size_t)r * 16);
    const f32x4 a = p[0], b = p[1], c = p[2], d = p[3];
    const float s = ((a[0] + a[1]) + (a[2] + a[3])) + ((b[0] + b[1]) + (b[2] + b[3])) + ((c[0] + c[1]) + (c[2] + c[3])) + ((d[0] + d[1]) + (d[2] + d[3]));
    return 1.f / sqrtf(s * (1.f / 1024.f) + 1e-6f);
}
__device__ __forceinline__ u32x4 pack8(const f32x4 a, const f32x4 b) { u32x4 w; w.x = cvt_pk_bf16(a[0], a[1]); w.y = cvt_pk_bf16(a[2], a[3]); w.z = cvt_pk_bf16(b[0], b[1]); w.w = cvt_pk_bf16(b[2], b[3]); return w; }
#define rot(t1, t2, c, s) do { const float a_ = (t1) * (c) - (t2) * (s), b_ = (t1) * (s) + (t2) * (c); (t1) = a_; (t2) = b_; } while (0)

struct EpiProj {
    static constexpr bool PERM = true, AFTER_DRAIN = false;
    bf16_t* R; const float* part; const float* rope;
    __device__ __forceinline__ void operator()(const f32x4 (&acc)[2][2][4][2], const Unit& u, int wr, int wc, int fr, int fq) const {
        const int type = u.pn >> 1, hg = u.pn & 1;
        const int colbase = type * 512 + (4 * hg + wc) * 64 + 8 * fq;
        const bool do_rope = (type == 3) || (type == 4);
#pragma unroll
        for (int ai = 0; ai < 2; ++ai)
#pragma unroll
            for (int m = 0; m < 4; ++m) {
                const int r = u.pm * BM + ai * HALF + wr * 64 + m * 16 + fr;
                const float rs = rstd16(part, r);
                f32x4 a0 = acc[ai][0][m][0] * rs, a1 = acc[ai][0][m][1] * rs, b0 = acc[ai][1][m][0] * rs, b1 = acc[ai][1][m][1] * rs;
                if (do_rope) {
                    const f32x4* rp = (const f32x4*)(rope + ((size_t)(r & 2047) * 32 + 8 * fq) * 2);
                    const f32x4 c0 = rp[0], c1 = rp[1], c2 = rp[2], c3 = rp[3];
                    rot(a0[0], b0[0], c0[0], c0[1]); rot(a0[1], b0[1], c0[2], c0[3]); rot(a0[2], b0[2], c1[0], c1[1]); rot(a0[3], b0[3], c1[2], c1[3]);
                    rot(a1[0], b1[0], c2[0], c2[1]); rot(a1[1], b1[1], c2[2], c2[3]); rot(a1[2], b1[2], c3[0], c3[1]); rot(a1[3], b1[3], c3[2], c3[3]);
                }
                bf16_t* rowp = R + (size_t)r * 3584 + colbase;
                *(u32x4*)(rowp) = pack8(a0, a1);
                *(u32x4*)(rowp + 32) = pack8(b0, b1);
            }
    }
};
struct EpiRes {
    static constexpr bool PERM = true, AFTER_DRAIN = false;
    const float* base; float* out; bf16_t* hb; float* part; const float* bias;
    __device__ __forceinline__ void operator()(const f32x4 (&acc)[2][2][4][2], const Unit& u, int wr, int wc, int fr, int fq) const {
        const int col0 = u.pn * BM + wc * 32 + 8 * fq;
        f32x4 bv[2][2];
#pragma unroll
        for (int bj = 0; bj < 2; ++bj)
#pragma unroll
            for (int n = 0; n < 2; ++n) bv[bj][n] = bias ? *(const f32x4*)(bias + col0 + bj * HALF + 4 * n) : (f32x4){0.f, 0.f, 0.f, 0.f};
#pragma unroll
        for (int ai = 0; ai < 2; ++ai)
#pragma unroll
            for (int m = 0; m < 4; ++m) {
                const int r = u.pm * BM + ai * HALF + wr * 64 + m * 16 + fr;
                const size_t off = (size_t)r * 1024 + col0;
                float ss = 0.f;
#pragma unroll
                for (int bj = 0; bj < 2; ++bj) {
                    const f32x4 x0 = *(const f32x4*)(base + off + bj * HALF), x1 = *(const f32x4*)(base + off + bj * HALF + 4);
                    const f32x4 h0 = x0 + acc[ai][bj][m][0] + bv[bj][0], h1 = x1 + acc[ai][bj][m][1] + bv[bj][1];
                    *(f32x4*)(out + off + bj * HALF) = h0; *(f32x4*)(out + off + bj * HALF + 4) = h1;
                    *(u32x4*)(hb + off + bj * HALF) = pack8(h0, h1);
                    ss += (h0[0] * h0[0] + h0[1] * h0[1]) + (h0[2] * h0[2] + h0[3] * h0[3]) + (h1[0] * h1[0] + h1[1] * h1[1]) + (h1[2] * h1[2] + h1[3] * h1[3]);
                }
                ss += __shfl_xor(ss, 16); ss += __shfl_xor(ss, 32);
                if (fq == 0) part[(size_t)r * 16 + 4 * u.pn + wc] = ss;
            }
    }
};
struct EpiQ {
    static constexpr bool PERM = true, AFTER_DRAIN = false;
    bf16_t* O; const float* part;
    __device__ __forceinline__ void operator()(const f32x4 (&acc)[2][2][4][2], const Unit& u, int wr, int wc, int fr, int fq) const {
        const int col0 = u.pn * BM + wc * 32 + 8 * fq;
#pragma unroll
        for (int ai = 0; ai < 2; ++ai)
#pragma unroll
            for (int m = 0; m < 4; ++m) {
                const int r = u.pm * BM + ai * HALF + wr * 64 + m * 16 + fr;
                const float rs = rstd16(part, r);
                bf16_t* rowp = O + (size_t)r * 1024 + col0;
#pragma unroll
                for (int bj = 0; bj < 2; ++bj) *(u32x4*)(rowp + bj * HALF) = pack8(acc[ai][bj][m][0] * rs, acc[ai][bj][m][1] * rs);
            }
    }
};
struct EpiGlu {
    static constexpr bool PERM = true, AFTER_DRAIN = false;
    bf16_t* G; const float* part; const float* b1;
    __device__ __forceinline__ void operator()(const f32x4 (&acc)[2][2][4][2], const Unit& u, int wr, int wc, int fr, int fq) const {
        const int col = u.pn * 128 + wc * 32 + 8 * fq;
        f32x4 ba[2], bg[2];
#pragma unroll
        for (int n = 0; n < 2; ++n) { ba[n] = *(const f32x4*)(b1 + col + 4 * n); bg[n] = *(const f32x4*)(b1 + 1024 + col + 4 * n); }
#pragma unroll
        for (int ai = 0; ai < 2; ++ai)
#pragma unroll
            for (int m = 0; m < 4; ++m) {
                const int r = u.pm * BM + ai * HALF + wr * 64 + m * 16 + fr;
                const float rs = rstd16(part, r);
                f32x4 y[2];
#pragma unroll
                for (int n = 0; n < 2; ++n) {
                    const f32x4 a = acc[ai][0][m][n] * rs + ba[n], g = acc[ai][1][m][n] * rs + bg[n];
#pragma unroll
                    for (int i = 0; i < 4; ++i) y[n][i] = a[i] / (1.f + __expf(-g[i]));
                }
                *(u32x4*)(G + (size_t)r * 1024 + col) = pack8(y[0], y[1]);
            }
    }
};
template <class Epi, class Sched, bool ALIGN_EPI = false, bool SP2 = false>
__device__ __forceinline__ void gemm_phase(PG8_LAS unsigned char* lds, const Gemm g, const Sched& S, const Epi& E, const int wave_id) {
    const int lane = (int)__builtin_amdgcn_mbcnt_hi(~0u, __builtin_amdgcn_mbcnt_lo(~0u, 0u)), wid = wave_id, tid = wid * 64 + lane, wr = wid >> 2, wc = wid & 3, fr = lane & 15, fq = lane >> 4;
    const int K = g.K, nt = K / BK;
    unsigned voffA[2], voffB[2];
#pragma unroll
    for (int i = 0; i < 2; ++i) { int R, C; stage_rc(tid * 16 + i * 8192, R, C); const int Rb = Epi::PERM ? ((R & ~31) + perm32(R & 31)) : R;
        voffA[i] = (unsigned)(R * K + C) * 2u; voffB[i] = (unsigned)(Rb * K + C) * 2u; }
    const size_t kstep = (size_t)(BK * 2);
    const size_t hstep = (size_t)HALF * K * 2;
    const size_t tstep = 2 * hstep;
    const unsigned ldsw = (unsigned)wid * 1024u;
    const int aoff = lds_byte(wr * 64 + fr, fq * 8), boff = lds_byte(wc * 32 + fr, fq * 8);
#define PG8_SA(b, h) (((b) * 2 + (h)) * HTB)
#define PG8_SB(b, h) ((4 + (b) * 2 + (h)) * HTB)
#define PG8_STAGE(bufoff, gbase, voff) do { _Pragma("unroll") for (int _i = 0; _i < 2; ++_i) \
        __builtin_amdgcn_global_load_lds((const unsigned*)((const char*)(gbase) + (voff)[_i]), (PG8_LAS unsigned*)(lds + (bufoff) + ldsw + _i * 8192), 16, 0, 0); } while (0)
#define PG8_LDA(dst, b, h) do { _Pragma("unroll") for (int m = 0; m < 4; ++m) _Pragma("unroll") for (int k = 0; k < 2; ++k) dst[m][k] = *(const PG8_LAS bf16x8*)(lds + PG8_SA(b, h) + aoff + m * 2048 + k * 1024); } while (0)
#define PG8_LDB(dst, b, h) do { _Pragma("unroll") for (int n = 0; n < 2; ++n) _Pragma("unroll") for (int k = 0; k < 2; ++k) dst[n][k] = *(const PG8_LAS bf16x8*)(lds + PG8_SB(b, h) + boff + n * 2048 + k * 1024); } while (0)
#define PG8_MMA(ai, bj, At, Bt) do { __builtin_amdgcn_s_setprio(1); _Pragma("unroll") for (int m = 0; m < 4; ++m) _Pragma("unroll") for (int n = 0; n < 2; ++n) _Pragma("unroll") for (int k = 0; k < 2; ++k) \
        acc[ai][bj][m][n] = __builtin_amdgcn_mfma_f32_16x16x32_bf16(Bt[n][k], At[m][k], acc[ai][bj][m][n], 0, 0, 0); __builtin_amdgcn_s_setprio(0); } while (0)
#define PG8_WAIT_V(n) asm volatile("s_waitcnt vmcnt(" #n ")" ::: "memory")
#define PG8_WAIT_L(n) asm volatile("s_waitcnt lgkmcnt(" #n ")" ::: "memory")
#define PG8_BAR __builtin_amdgcn_s_barrier()
#define PG8_SCHED __builtin_amdgcn_sched_barrier(0)
    Unit cur, nxt; int ui = 0;
    if (!S.next(0, cur)) return;
    f32x4 acc[2][2][4][2];
#pragma unroll
    for (int a = 0; a < 2; ++a)
#pragma unroll
        for (int b = 0; b < 2; ++b)
#pragma unroll
            for (int m = 0; m < 4; ++m)
#pragma unroll
                for (int n = 0; n < 2; ++n) acc[a][b][m][n] = (f32x4){0.f, 0.f, 0.f, 0.f};
    bf16x8 At[4][2], B0[2][2], B1[2][2];
    const char* cA = (const char*)g.A + (size_t)cur.pm * tstep; const char* cB = (const char*)g.Bt + (size_t)cur.pn * tstep;
    S.a_ready(cur);
    if constexpr (SP2) {
        PG8_STAGE(PG8_SB(0, 0), cB, voffB); PG8_STAGE(PG8_SB(0, 1), cB + hstep, voffB); PG8_STAGE(PG8_SA(0, 0), cA, voffA); PG8_STAGE(PG8_SA(0, 1), cA + hstep, voffA);
        if (wr == 1) PG8_BAR;
        PG8_WAIT_V(2); PG8_BAR;
        PG8_STAGE(PG8_SB(1, 0), cB + kstep, voffB); PG8_STAGE(PG8_SA(1, 0), cA + kstep, voffA); PG8_STAGE(PG8_SB(1, 1), cB + hstep + kstep, voffB);
        PG8_WAIT_V(6); PG8_BAR;
    } else {
        PG8_STAGE(PG8_SB(0, 0), cB, voffB); PG8_STAGE(PG8_SA(0, 0), cA, voffA); PG8_STAGE(PG8_SB(0, 1), cB + hstep, voffB); PG8_STAGE(PG8_SA(0, 1), cA + hstep, voffA);
        if (wr == 1) PG8_BAR;
        PG8_WAIT_V(4); PG8_BAR;
        PG8_STAGE(PG8_SB(1, 0), cB + kstep, voffB); PG8_STAGE(PG8_SA(1, 0), cA + kstep, voffA); PG8_STAGE(PG8_SB(1, 1), cB + hstep + kstep, voffB);
        PG8_WAIT_V(6); PG8_BAR;
    }
    for (;;) {
        const bool has_next = S.next(ui + 1, nxt);
        const char* nA = has_next ? (const char*)g.A + (size_t)nxt.pm * tstep : cA; const char* nB = has_next ? (const char*)g.Bt + (size_t)nxt.pn * tstep : cB;
        for (int t = 0; t < nt; t += 2) {
            const bool last = (t == nt - 2);
            const char* a1 = cA + (size_t)(t + 1) * kstep;
            const char* a2 = last ? nA : cA + (size_t)(t + 2) * kstep; const char* b2 = last ? nB : cB + (size_t)(t + 2) * kstep;
            const char* a3 = a2 + kstep; const char* b3 = b2 + kstep;
            if (last && has_next) S.a_ready(nxt);
            if constexpr (SP2) {
            PG8_LDB(B0, 0, 0); PG8_LDB(B1, 0, 1); PG8_SCHED; PG8_LDA(At, 0, 0); PG8_STAGE(PG8_SA(1, 1), a1 + hstep, voffA);
            PG8_WAIT_V(8); PG8_WAIT_L(0); PG8_BAR; PG8_MMA(0, 0, At, B0); PG8_MMA(0, 1, At, B1); PG8_BAR; PG8_SCHED;
            PG8_LDA(At, 0, 1); PG8_STAGE(PG8_SB(0, 0), b2, voffB); PG8_STAGE(PG8_SB(0, 1), b2 + hstep, voffB); PG8_STAGE(PG8_SA(0, 0), a2, voffA);
            PG8_WAIT_V(8); PG8_WAIT_L(0); PG8_BAR; PG8_MMA(1, 0, At, B0); PG8_MMA(1, 1, At, B1); PG8_BAR; PG8_SCHED;
            PG8_LDB(B0, 1, 0); PG8_LDB(B1, 1, 1); PG8_SCHED; PG8_LDA(At, 1, 0); PG8_STAGE(PG8_SA(0, 1), a2 + hstep, voffA);
            PG8_WAIT_V(8); PG8_WAIT_L(0); PG8_BAR; PG8_MMA(0, 0, At, B0); PG8_MMA(0, 1, At, B1); PG8_BAR; PG8_SCHED;
            PG8_LDA(At, 1, 1); PG8_STAGE(PG8_SB(1, 0), b3, voffB); PG8_STAGE(PG8_SB(1, 1), b3 + hstep, voffB); PG8_STAGE(PG8_SA(1, 0), a3, voffA);
            PG8_WAIT_V(8); PG8_WAIT_L(0); PG8_BAR; PG8_MMA(1, 0, At, B0); PG8_MMA(1, 1, At, B1); PG8_BAR; PG8_SCHED;
            } else {
            PG8_LDB(B0, 0, 0); PG8_SCHED; PG8_LDA(At, 0, 0); PG8_STAGE(PG8_SA(1, 1), a1 + hstep, voffA);
            PG8_WAIT_L(8); PG8_BAR; PG8_WAIT_L(0); PG8_MMA(0, 0, At, B0); PG8_BAR; PG8_SCHED;
            PG8_LDB(B1, 0, 1); PG8_STAGE(PG8_SB(0, 0), b2, voffB);
            PG8_BAR; PG8_WAIT_L(0); PG8_MMA(0, 1, At, B1); PG8_BAR;
            PG8_LDA(At, 0, 1); PG8_STAGE(PG8_SA(0, 0), a2, voffA);
            PG8_BAR; PG8_WAIT_L(0); PG8_MMA(1, 0, At, B0); PG8_BAR; PG8_SCHED;
            PG8_STAGE(PG8_SB(0, 1), b2 + hstep, voffB);
            PG8_WAIT_V(6); PG8_BAR; PG8_MMA(1, 1, At, B1); PG8_BAR;
            PG8_LDB(B0, 1, 0); PG8_SCHED; PG8_LDA(At, 1, 0); PG8_STAGE(PG8_SA(0, 1), a2 + hstep, voffA);
            PG8_WAIT_L(8); PG8_BAR; PG8_WAIT_L(0); PG8_MMA(0, 0, At, B0); PG8_BAR; PG8_SCHED;
            PG8_LDB(B1, 1, 1); PG8_STAGE(PG8_SB(1, 0), b3, voffB);
            PG8_BAR; PG8_WAIT_L(0); PG8_MMA(0, 1, At, B1); PG8_BAR;
            PG8_LDA(At, 1, 1); PG8_STAGE(PG8_SA(1, 0), a3, voffA);
            PG8_BAR; PG8_WAIT_L(0); PG8_MMA(1, 0, At, B0); PG8_BAR; PG8_SCHED;
            PG8_STAGE(PG8_SB(1, 1), b3 + hstep, voffB);
            PG8_WAIT_V(6); PG8_BAR; PG8_MMA(1, 1, At, B1); PG8_BAR;
            }
        }
        if constexpr (ALIGN_EPI) { if (wr == 0) PG8_BAR; }
        if constexpr (!Epi::AFTER_DRAIN) { E(acc, cur, wr, wc, fr, fq); S.done(cur); }
        if (!has_next) break;
#pragma unroll
        for (int a = 0; a < 2; ++a)
#pragma unroll
            for (int b = 0; b < 2; ++b)
#pragma unroll
                for (int m = 0; m < 4; ++m)
#pragma unroll
                    for (int n = 0; n < 2; ++n) acc[a][b][m][n] = (f32x4){0.f, 0.f, 0.f, 0.f};
        cur = nxt; cA = nA; cB = nB; ++ui;
        if constexpr (ALIGN_EPI) { if (wr == 1) PG8_BAR; }
    }
    PG8_WAIT_V(0);
    if constexpr (!ALIGN_EPI) { if (wr == 0) PG8_BAR; }
    PG8_BAR;
    if constexpr (Epi::AFTER_DRAIN) { E.fused(acc, cur, wr, wc, fr, fq, lds, wid, lane); S.done(cur); }
#undef PG8_SA
#undef PG8_SB
#undef PG8_STAGE
#undef PG8_LDA
#undef PG8_LDB
#undef PG8_MMA
#undef PG8_WAIT_V
#undef PG8_WAIT_L
#undef PG8_BAR
#undef PG8_SCHED
}
}

struct Frame {
    LAS unsigned char* lds;
    int wave, G, bid;
    const float *x, *mix_norm, *ffn_norm, *final_norm, *w_in, *w_out, *rel_bias, *conv_w1, *conv_b1, *conv_dw, *conv_dw_b, *conv_ln_g, *conv_ln_b, *conv_w2, *conv_b2,
        *peer_wq, *peer_keys, *peer_u, *peer_v;
    float* out;
    unsigned char* ws;
};
#define FRAME_IDS const int f_lane = lane_id(); const int f_tid = F.wave * 64 + f_lane; (void)f_tid
DI float gamma_of(int h) { return 1.f - exp2f(-5.f - (float)h); }

DI void p0_prep(Frame& F) {
    FRAME_IDS;
    const int gw = F.bid * NWAVES + F.wave, NGW = F.G * NWAVES;
    f32x2* rope = (f32x2*)(F.ws + WS_ROPE);
    for (int i = F.bid * NTHR + f_tid; i < SEQ * 32; i += F.G * NTHR) {
        const int s = i >> 5, j = i & 31;
        const float inv = powf(10000.f, -(float)j / 32.f);
        const float ang = (float)s * inv;
        float sn, cs; sincosf(ang, &sn, &cs);
        rope[i] = (f32x2){cs, sn};
    }
    bf16* xb = (bf16*)(F.ws + WS_XB); float* part = (float*)(F.ws + WS_PART);
    for (int m = gw; m < T; m += NGW) {
        const f32x4* xr = (const f32x4*)(F.x + (size_t)m * DM) + f_lane;
        u32x2* o = (u32x2*)(xb + (size_t)m * DM) + f_lane;
        float s = 0.f;
#pragma unroll
        for (int j = 0; j < 4; ++j) { const f32x4 v = xr[64 * j]; s += v.x * v.x + v.y * v.y + v.z * v.z + v.w * v.w; o[64 * j] = (u32x2){pk2(v.x, v.y), pk2(v.z, v.w)}; }
        s = wave_sum(s);
        if (f_lane < 16) part[(size_t)m * 16 + f_lane] = (f_lane == 0) ? s : 0.f;
    }
}
DI void p0_transpose_item(const float* W, int K, int N, bf16* WT, int prow0, const float* gain, float scale, LAS float* scr, int k0, int n0, int lane) {
#pragma unroll 8
    for (int i = 0; i < 32; ++i) { const int kk = 2 * i + (lane >> 5); scr[kk * 33 + (lane & 31)] = W[(size_t)(k0 + kk) * N + n0 + (lane & 31)] * (gain ? gain[k0 + kk] : 1.f) * scale; }
    asm volatile("s_waitcnt lgkmcnt(0)" ::: "memory");
    const int c = lane & 7;
#pragma unroll
    for (int j = 0; j < 4; ++j) { const int n = (lane >> 3) + 8 * j; const LAS float* q = scr + (8 * c) * 33 + n;
        u32x4 o; o.x = pk2(q[0 * 33], q[1 * 33]); o.y = pk2(q[2 * 33], q[3 * 33]); o.z = pk2(q[4 * 33], q[5 * 33]); o.w = pk2(q[6 * 33], q[7 * 33]);
        *(u32x4*)(WT + (size_t)(prow0 + n) * K + k0 + 8 * c) = o; }
    asm volatile("s_waitcnt lgkmcnt(0)" ::: "memory");
}
DI void p0_weights(Frame& F) {
    FRAME_IDS;
    LAS float* scr = (LAS float*)(F.lds + F.wave * 16384);
    const int gw = F.bid * NWAVES + F.wave, NGW = F.G * NWAVES;
    constexpr int I_IN = 16 * (INC / 32), I_SQ = 16 * (DM / 32), I_W1 = 16 * (2 * DM / 32);
    constexpr int NITEMS = I_IN + I_SQ + I_W1 + I_SQ + 2 * I_SQ;
    for (int it = gw; it < NITEMS; it += NGW) {
        int r = it;
        if (r < I_IN) { const int nb = r % (INC / 32), kb = r / (INC / 32), n0 = nb * 32;
            const int type = n0 / 512, head = (n0 % 512) / 64, bj = (n0 % 64) / 32;
            const int prow0 = 256 * (2 * type + head / 4) + 128 * bj + 32 * (head % 4);
            p0_transpose_item(F.w_in, DM, INC, (bf16*)(F.ws + WS_WIN), prow0, F.mix_norm, (type == 0 || type == 4) ? 0.125f : 1.f, scr, kb * 64, n0, f_lane); continue; }
        r -= I_IN;
        if (r < I_SQ) { const int nb = r % 32, kb = r / 32; p0_transpose_item(F.w_out, DM, DM, (bf16*)(F.ws + WS_WOUT), nb * 32, nullptr, 1.f, scr, kb * 64, nb * 32, f_lane); continue; }
        r -= I_SQ;
        if (r < I_W1) { const int nb = r % 64, kb = r / 64, n0 = nb * 32; const int bj = n0 / 1024, rem = n0 % 1024;
            p0_transpose_item(F.conv_w1, DM, 2 * DM, (bf16*)(F.ws + WS_W1), 256 * (rem / 128) + 128 * bj + (rem % 128), F.mix_norm + DM, 1.f, scr, kb * 64, n0, f_lane); continue; }
        r -= I_W1;
        if (r < I_SQ) { const int nb = r % 32, kb = r / 32; p0_transpose_item(F.conv_w2, DM, DM, (bf16*)(F.ws + WS_W2), nb * 32, nullptr, 1.f, scr, kb * 64, nb * 32, f_lane); continue; }
        r -= I_SQ;
        { const int layer = r / I_SQ; r %= I_SQ; const int nb = r % 32, kb = r / 32;
          p0_transpose_item(F.peer_wq + (size_t)layer * DM * DM, DM, DM, (bf16*)(F.ws + WS_WQ) + (size_t)layer * DM * DM, nb * 32, F.ffn_norm + layer * DM, 1.f, scr, kb * 64, nb * 32, f_lane); }
    }
}
DI float row_rstd(const float* part, int m) {
    const f32x4* p = (const f32x4*)(part + (size_t)m * 16);
    const f32x4 a = p[0], b = p[1], c = p[2], d = p[3];
    const float s = ((a.x + a.y) + (a.z + a.w)) + ((b.x + b.y) + (b.z + b.w)) + ((c.x + c.y) + (c.z + c.w)) + ((d.x + d.y) + (d.z + d.w));
    return 1.f / sqrtf(s * (1.f / DM) + EPS);
}

enum { EP_PROJ = 0, EP_RES = 1, EP_Q = 2, EP_HID = 3 };
template <int EP>
DI void naive_gemm(Frame& F, const bf16* A, const float* W, int N, const float* gain, const float* bias, bf16* Ob, int ldo) {
    FRAME_IDS;
    LAS float* As = (LAS float*)F.lds;
    LAS float* Bs = As + 16 * 129;
    LAS float* rs = Bs + 16 * 64;
    const float* part = (const float*)(F.ws + WS_PART);
    const f32x2* rope = (const f32x2*)(F.ws + WS_ROPE);
    bf16* hb = (bf16*)(F.ws + WS_XB);
    const int tid = f_tid, tx = tid & 15, ty = tid >> 4;
    const int nN = N / 64, nItems = (T / 128) * nN;
    for (int it = F.bid; it < nItems; it += F.G) {
        const int m0 = (it / nN) * 128, n0 = (it % nN) * 64;
        __syncthreads();
        if (EP != EP_RES) { if (tid < 128) rs[tid] = row_rstd(part, m0 + tid); }
        float acc[4][4];
#pragma unroll
        for (int i = 0; i < 4; ++i)
#pragma unroll
            for (int j = 0; j < 4; ++j) acc[i][j] = 0.f;
        for (int k0 = 0; k0 < DM; k0 += 16) {
            {   const int r = tid >> 2, kk = (tid & 3) * 4;
                const u32x2 v = *(const u32x2*)(A + (size_t)(m0 + r) * DM + k0 + kk);
                As[(kk + 0) * 129 + r] = __uint_as_float(v.x << 16); As[(kk + 1) * 129 + r] = __uint_as_float(v.x & 0xffff0000u);
                As[(kk + 2) * 129 + r] = __uint_as_float(v.y << 16); As[(kk + 3) * 129 + r] = __uint_as_float(v.y & 0xffff0000u); }
            {   const int kk = tid >> 5, c = (tid & 31) * 2;
                const f32x2 v = *(const f32x2*)(W + (size_t)(k0 + kk) * N + n0 + c);
                const float g = gain ? gain[k0 + kk] : 1.f;
                Bs[kk * 64 + c] = v.x * g; Bs[kk * 64 + c + 1] = v.y * g; }
            __syncthreads();
#pragma unroll
            for (int kk = 0; kk < 16; ++kk) {
                float a[4], b[4];
#pragma unroll
                for (int i = 0; i < 4; ++i) a[i] = As[kk * 129 + ty * 4 + i];
                b[0] = Bs[kk * 64 + 2 * tx]; b[1] = Bs[kk * 64 + 2 * tx + 1]; b[2] = Bs[kk * 64 + 32 + 2 * tx]; b[3] = Bs[kk * 64 + 33 + 2 * tx];
#pragma unroll
                for (int i = 0; i < 4; ++i)
#pragma unroll
                    for (int j = 0; j < 4; ++j) acc[i][j] += a[i] * b[j];
            }
            __syncthreads();
        }
#pragma unroll
        for (int i = 0; i < 4; ++i) {
            const int m = m0 + ty * 4 + i;
            const int cols[4] = {n0 + 2 * tx, n0 + 2 * tx + 1, n0 + 32 + 2 * tx, n0 + 33 + 2 * tx};
            float v[4] = {acc[i][0], acc[i][1], acc[i][2], acc[i][3]};
            if (EP == EP_PROJ) {
                const float r = rs[ty * 4 + i];
#pragma unroll
                for (int j = 0; j < 4; ++j) v[j] *= r;
                const int type = n0 / 512;
                if (type == 3 || type == 4) {
                    const int s = m % SEQ;
#pragma unroll
                    for (int j = 0; j < 2; ++j) {
                        const f32x2 cs = rope[s * 32 + 2 * tx + j];
                        const float t1 = v[j], t2 = v[j + 2];
                        v[j] = t1 * cs.x - t2 * cs.y; v[j + 2] = t1 * cs.y + t2 * cs.x;
                    }
                }
                if (type == 0 || type == 4) {
#pragma unroll
                    for (int j = 0; j < 4; ++j) v[j] *= 0.125f;
                }
#pragma unroll
                for (int j = 0; j < 4; ++j) Ob[(size_t)m * ldo + cols[j]] = (bf16)f2bf(v[j]);
            } else if (EP == EP_RES) {
#pragma unroll
                for (int j = 0; j < 4; ++j) {
                    const size_t o = (size_t)m * DM + cols[j];
                    const float base = (Ob == nullptr) ? F.x[o] : F.out[o];
                    const float hn = base + v[j] + (bias ? bias[cols[j]] : 0.f);
                    F.out[o] = hn; hb[o] = (bf16)f2bf(hn);
                }
            } else if (EP == EP_Q) {
                const float r = rs[ty * 4 + i];
#pragma unroll
                for (int j = 0; j < 4; ++j) Ob[(size_t)m * ldo + cols[j]] = (bf16)f2bf(v[j] * r);
            } else {
                const float r = rs[ty * 4 + i];
#pragma unroll
                for (int j = 0; j < 4; ++j) Ob[(size_t)m * ldo + cols[j]] = (bf16)f2bf(v[j] * r + bias[cols[j]]);
            }
        }
    }
}

DI void naive_rowstat(Frame& F) {
    FRAME_IDS;
    const int gw = F.bid * NWAVES + F.wave, NGW = F.G * NWAVES;
    float* part = (float*)(F.ws + WS_PART);
    for (int m = gw; m < T; m += NGW) {
        const f32x4* xr = (const f32x4*)(F.out + (size_t)m * DM) + f_lane;
        float s = 0.f;
#pragma unroll
        for (int j = 0; j < 4; ++j) { const f32x4 v = xr[64 * j]; s += v.x * v.x + v.y * v.y + v.z * v.z + v.w * v.w; }
        s = wave_sum(s);
        if (f_lane < 16) part[(size_t)m * 16 + f_lane] = (f_lane == 0) ? s : 0.f;
    }
}

DI void naive_attn(Frame& F) {
    FRAME_IDS;
    const bf16* R = (const bf16*)(F.ws + WS_R); bf16* O = (bf16*)(F.ws + WS_O);
    LAS float* Ks = (LAS float*)F.lds;
    LAS float* Vs = Ks + 64 * 65;
    LAS float* bs = Vs + 64 * 65;
    const int tid = f_tid;
    for (int it = F.bid; it < NB * NHA * 4; it += F.G) {
        const int b = it / (NHA * 4), h = (it / 4) % NHA, cg = it % 4;
        const int c = cg * 8 + (tid >> 6), i = tid & 63;
        __syncthreads();
        for (int k = tid; k < 257; k += NTHR) bs[k] = F.rel_bias[h * 257 + k];
        float q[64], acc[64];
        {   const bf16* qp = R + (size_t)(b * SEQ + c * 64 + i) * INC + C_QA + h * 64;
#pragma unroll
            for (int d = 0; d < 64; ++d) { q[d] = bf2f(qp[d]); acc[d] = 0.f; } }
        float mx = -1e30f, l = 0.f;
        const int t_lo = (cg * 8 - 8) < 0 ? 0 : (cg * 8 - 8), t_hi = cg * 8 + 7;
        for (int tc = t_lo; tc <= t_hi; ++tc) {
            __syncthreads();
            for (int e = tid; e < 64 * 64; e += NTHR) {
                const int j = e >> 6, d = e & 63;
                const size_t row = (size_t)(b * SEQ + tc * 64 + j) * INC;
                Ks[j * 65 + d] = bf2f(R[row + C_KA + h * 64 + d]);
                Vs[j * 65 + d] = bf2f(R[row + C_VA + h * 64 + d]);
            }
            __syncthreads();
            if (tc <= c && tc >= c - 8) {
                for (int j = 0; j < 64; ++j) {
                    float s = 0.f;
#pragma unroll
                    for (int d = 0; d < 64; ++d) s += q[d] * Ks[j * 65 + d];
                    int rel = (c * 64 + i) - (tc * 64 + j); rel = rel < -128 ? -128 : (rel > 128 ? 128 : rel);
                    s += bs[rel + 128];
                    const float mn = fmaxf(mx, s), corr = __expf(mx - mn), p = __expf(s - mn);
                    l = l * corr + p;
#pragma unroll
                    for (int d = 0; d < 64; ++d) acc[d] = acc[d] * corr + p * Vs[j * 65 + d];
                    mx = mn;
                }
            }
        }
        const float inv = 1.f / l;
        bf16* op = O + (size_t)(b * SEQ + c * 64 + i) * DM + h * 64;
#pragma unroll
        for (int d = 0; d < 64; ++d) op[d] = (bf16)f2bf(acc[d] * inv);
    }
}

DI void naive_ret(Frame& F) {
    FRAME_IDS;
    const bf16* R = (const bf16*)(F.ws + WS_R); bf16* O = (bf16*)(F.ws + WS_O);
    LAS float* St = (LAS float*)F.lds;
    LAS float* Qs = St + 4096;
    LAS float* Ks = Qs + 64 * 65;
    LAS float* Vs = Ks + 64 * 65;
    LAS float* Sc = Vs + 64 * 65;
    LAS float* Ot = Sc + 64 * 65;
    const int tid = f_tid;
    for (int it = F.G - 1 - F.bid; it < NB * NHB; it += F.G) {
        const int b = it / NHB, h = it % NHB;
        const float lg = logf(gamma_of(h));
        const float cd = __expf(lg * 64.f);
        __syncthreads();
        for (int e = tid; e < 4096; e += NTHR) St[e] = 0.f;
        for (int n = 0; n < NCH; ++n) {
            __syncthreads();
            for (int e = tid; e < 4096; e += NTHR) {
                const int j = e >> 6, d = e & 63;
                const size_t row = (size_t)(b * SEQ + n * 64 + j) * INC;
                Qs[j * 65 + d] = bf2f(R[row + C_QB + h * 64 + d]);
                Ks[j * 65 + d] = bf2f(R[row + C_KB + h * 64 + d]);
                Vs[j * 65 + d] = bf2f(R[row + C_VB + h * 64 + d]);
            }
            __syncthreads();
            for (int e = tid; e < 4096; e += NTHR) {
                const int i = e >> 6, j = e & 63;
                float s = 0.f;
#pragma unroll
                for (int d = 0; d < 64; ++d) s += Qs[i * 65 + d] * Ks[j * 65 + d];
                const int ad = i > j ? i - j : j - i;
                Sc[i * 65 + j] = s * __expf(lg * (float)ad);
            }
            __syncthreads();
            for (int e = tid; e < 4096; e += NTHR) {
                const int i = e >> 6, ee = e & 63;
                float s = 0.f, cr = 0.f;
#pragma unroll
                for (int j = 0; j < 64; ++j) s += Sc[i * 65 + j] * Vs[j * 65 + ee];
#pragma unroll
                for (int d = 0; d < 64; ++d) cr += Qs[i * 65 + d] * St[d * 64 + ee];
                Ot[i * 65 + ee] = s + cr * __expf(lg * (float)(i + 1));
            }
            __syncthreads();
            for (int e = tid; e < 4096; e += NTHR) {
                const int d = e >> 6, ee = e & 63;
                float s = 0.f;
                for (int j = 0; j < 64; ++j) s += Ks[j * 65 + d] * __expf(lg * (float)(63 - j)) * Vs[j * 65 + ee];
                St[d * 64 + ee] = cd * St[d * 64 + ee] + s;
            }
            for (int r = 0; r < 8; ++r) {
                const int i = F.wave * 8 + r;
                const float v = Ot[i * 65 + f_lane];
                const float mu = wave_sum(v) * (1.f / 64.f);
                const float dv = v - mu;
                const float var = wave_sum(dv * dv) * (1.f / 64.f);
                const size_t row = (size_t)(b * SEQ + n * 64 + i);
                const float g = bf2f(R[row * INC + C_GB + h * 64 + f_lane]);
                const float o = dv * (1.f / sqrtf(var + EPS)) * (g * sigmoidf(g));
                O[row * DM + 512 + h * 64 + f_lane] = (bf16)f2bf(o);
            }
        }
    }
}

DI void naive_route(Frame& F, int layer) {
    FRAME_IDS;
    const bf16* Q = (const bf16*)(F.ws + WS_Q);
    int* eidx = (int*)(F.ws + WS_EIDX); float* gate = (float*)(F.ws + WS_GATE);
    const float* keys = F.peer_keys + (size_t)layer * 2 * PK * 64;
    LAS float* sc = (LAS float*)F.lds;
    LAS int* i1s = (LAS int*)(sc + 256 * 64);
    LAS int* i2s = i1s + 16 * 64;
    LAS float* qs = (LAS float*)(i2s + 16 * 64);
    const int p = f_tid;
    for (int it = F.bid; it < T / 8; it += F.G) {
        if (p < 64) {
            const int t = it * 8 + (p >> 3), hh = p & 7;
            float top1[16], top2[16];
#pragma unroll
            for (int side = 0; side < 2; ++side) {
                const bf16* qp = Q + (size_t)t * DM + hh * 128 + side * 64;
                for (int d = 0; d < 64; ++d) qs[d * 64 + p] = bf2f(qp[d]);
                for (int k = 0; k < PK; ++k) {
                    const float* kp = keys + ((size_t)side * PK + k) * 64;
                    float s = 0.f;
#pragma unroll 8
                    for (int d = 0; d < 64; ++d) s += qs[d * 64 + p] * kp[d];
                    sc[k * 64 + p] = s;
                }
#pragma unroll
                for (int a = 0; a < 16; ++a) {
                    float best = -INFINITY; int bi = 0;
                    for (int k = 0; k < PK; ++k) { const float v = sc[k * 64 + p]; if (v > best) { best = v; bi = k; } }
                    sc[bi * 64 + p] = -INFINITY;
                    if (side == 0) { top1[a] = best; i1s[a * 64 + p] = bi; } else { top2[a] = best; i2s[a * 64 + p] = bi; }
                }
            }
#pragma unroll
            for (int a = 0; a < 16; ++a)
#pragma unroll
                for (int b = 0; b < 16; ++b) sc[(a * 16 + b) * 64 + p] = top1[a] + top2[b];
            float bv[16]; int be[16];
#pragma unroll
            for (int a = 0; a < 16; ++a) {
                float best = -INFINITY; int bi = 0;
                for (int k = 0; k < 256; ++k) { const float v = sc[k * 64 + p]; if (v > best) { best = v; bi = k; } }
                sc[bi * 64 + p] = -INFINITY;
                bv[a] = best; be[a] = i1s[(bi >> 4) * 64 + p] * PK + i2s[(bi & 15) * 64 + p];
            }
            float sum = 0.f; const float bmax = bv[0];
#pragma unroll
            for (int a = 0; a < 16; ++a) { bv[a] = __expf(bv[a] - bmax); sum += bv[a]; }
            const float inv = 1.f / sum;
#pragma unroll
            for (int a = 0; a < 16; ++a) { eidx[(size_t)t * NSEL + hh * 16 + a] = be[a]; gate[(size_t)t * NSEL + hh * 16 + a] = bv[a] * inv; }
        }
    }
}

DI void naive_gather(Frame& F, int layer, bool final_norm) {
    FRAME_IDS;
    const int* eidx = (const int*)(F.ws + WS_EIDX); const float* gate = (const float*)(F.ws + WS_GATE);
    float* part = (float*)(F.ws + WS_PART); bf16* hb = (bf16*)(F.ws + WS_XB);
    const float* U = F.peer_u + (size_t)layer * PE * DM; const float* V = F.peer_v + (size_t)layer * PE * DM;
    const float* gn = F.ffn_norm + layer * DM;
    LAS float* xs = (LAS float*)F.lds;
    LAS float* as = xs + 1024;
    LAS int* es = (LAS int*)(as + 128);
    LAS float* red = (LAS float*)(es + 128);
    const int tid = f_tid;
    for (int t = F.bid; t < T; t += F.G) {
        __syncthreads();
        const float rstd = row_rstd(part, t);
        const f32x2 hv = *(const f32x2*)(F.out + (size_t)t * DM + 2 * tid);
        xs[2 * tid] = hv.x * rstd * gn[2 * tid]; xs[2 * tid + 1] = hv.y * rstd * gn[2 * tid + 1];
        if (tid < 128) es[tid] = eidx[(size_t)t * NSEL + tid];
        __syncthreads();
        for (int k = F.wave; k < NSEL; k += NWAVES) {
            const f32x4* ur = (const f32x4*)(U + (size_t)es[k] * DM) + f_lane;
            float s = 0.f;
#pragma unroll
            for (int j = 0; j < 4; ++j) { const f32x4 u = ur[64 * j]; const int c = 4 * f_lane + 256 * j; s += u.x * xs[c] + u.y * xs[c + 1] + u.z * xs[c + 2] + u.w * xs[c + 3]; }
            s = wave_sum(s);
            if (f_lane == 0) as[k] = gelu_erf(s) * gate[(size_t)t * NSEL + k];
        }
        __syncthreads();
        float o0 = 0.f, o1 = 0.f;
        for (int k = 0; k < NSEL; ++k) { const f32x2 v = *(const f32x2*)(V + (size_t)es[k] * DM + 2 * tid); const float a = as[k]; o0 += a * v.x; o1 += a * v.y; }
        const float h0 = hv.x + o0, h1 = hv.y + o1;
        const float ss = block_sum(h0 * h0 + h1 * h1, red, tid);
        if (final_norm) {
            const float r = 1.f / sqrtf(ss * (1.f / DM) + EPS);
            *(f32x2*)(F.out + (size_t)t * DM + 2 * tid) = (f32x2){h0 * r * F.final_norm[2 * tid], h1 * r * F.final_norm[2 * tid + 1]};
        } else {
            *(f32x2*)(F.out + (size_t)t * DM + 2 * tid) = (f32x2){h0, h1};
            *(unsigned*)(hb + (size_t)t * DM + 2 * tid) = pk2(h0, h1);
            if (tid < 16) part[(size_t)t * 16 + tid] = (tid == 0) ? ss : 0.f;
        }
    }
}

DI void naive_glu(Frame& F) {
    FRAME_IDS;
    const bf16* H = (const bf16*)(F.ws + WS_HID); bf16* G = (bf16*)(F.ws + WS_GLU);
    for (size_t i = (size_t)F.bid * NTHR + f_tid; i < (size_t)T * DM; i += (size_t)F.G * NTHR) {
        const size_t m = i / DM; const int c = (int)(i % DM);
        const float a = bf2f(H[m * 2048 + c]), g = bf2f(H[m * 2048 + 1024 + c]);
        G[i] = (bf16)f2bf(a * sigmoidf(g));
    }
}
DI void naive_conv(Frame& F) {
    FRAME_IDS;
    const bf16* G = (const bf16*)(F.ws + WS_GLU); bf16* H2 = (bf16*)(F.ws + WS_HID2);
    LAS float* red = (LAS float*)F.lds;
    const int tid = f_tid;
    for (int t = F.bid; t < T; t += F.G) {
        const int s = t % SEQ;
        float y[2];
#pragma unroll
        for (int u = 0; u < 2; ++u) {
            const int c = 2 * tid + u;
            float a = F.conv_dw_b[c];
            for (int j = 0; j < CW; ++j) { const int sp = s - (CW - 1) + j; if (sp >= 0) a += F.conv_dw[j * DM + c] * bf2f(G[(size_t)(t - (CW - 1) + j) * DM + c]); }
            y[u] = a;
        }
        const float mu = block_sum(y[0] + y[1], red, tid) * (1.f / DM);
        const float d0 = y[0] - mu, d1 = y[1] - mu;
        const float var = block_sum(d0 * d0 + d1 * d1, red, tid) * (1.f / DM);
        const float r = 1.f / sqrtf(var + EPS);
        const float z0 = d0 * r * F.conv_ln_g[2 * tid] + F.conv_ln_b[2 * tid], z1 = d1 * r * F.conv_ln_g[2 * tid + 1] + F.conv_ln_b[2 * tid + 1];
        *(unsigned*)(H2 + (size_t)t * DM + 2 * tid) = pk2(z0 * sigmoidf(z0), z1 * sigmoidf(z1));
    }
}

#if OPT_GEMM
enum Phase { PH_PREP = 0, PH_PROJ, PH_MIX, PH_WOUT, PH_Q0, PH_ROUTE0, PH_GATHER0, PH_W1, PH_CONV, PH_W2, PH_Q1, PH_ROUTE1, PH_GATHER1, PH_COUNT };
#else
enum Phase { PH_PREP = 0, PH_PROJ, PH_MIX, PH_WOUT, PH_STAT0, PH_Q0, PH_ROUTE0, PH_GATHER0, PH_W1, PH_GLU, PH_CONV, PH_W2, PH_STAT1, PH_Q1, PH_ROUTE1, PH_GATHER1, PH_COUNT };
#endif
struct Args { const float* in[19]; float* out; unsigned char* ws; int ph_lo, ph_hi; };

__global__ void __launch_bounds__(NTHR, 2) mega_fwd(Args args) {
    extern __shared__ __attribute__((aligned(16))) unsigned char lds[];
    Frame F;
    F.lds = (LAS unsigned char*)lds;
    F.wave = __builtin_amdgcn_readfirstlane((int)threadIdx.x >> 6); FRAME_IDS;
    F.G = gridDim.x; F.bid = blockIdx.x;
    F.x = args.in[0]; F.mix_norm = args.in[1]; F.ffn_norm = args.in[2]; F.final_norm = args.in[3]; F.w_in = args.in[4]; F.w_out = args.in[5]; F.rel_bias = args.in[6];
    F.conv_w1 = args.in[7]; F.conv_b1 = args.in[8]; F.conv_dw = args.in[9]; F.conv_dw_b = args.in[10]; F.conv_ln_g = args.in[11]; F.conv_ln_b = args.in[12];
    F.conv_w2 = args.in[13]; F.conv_b2 = args.in[14]; F.peer_wq = args.in[15]; F.peer_keys = args.in[16]; F.peer_u = args.in[17]; F.peer_v = args.in[18];
    F.out = args.out; F.ws = args.ws;
    volatile LAS unsigned* MISC = (volatile LAS unsigned*)(F.lds + MISC_OFF);
    for (int u = f_tid; u < (LDS_BYTES - LDSCTL_OFF) / 4; u += NTHR) ((LAS unsigned*)(F.lds + LDSCTL_OFF))[u] = 0u;
    __syncthreads();
    const int lo = args.ph_lo, hi = args.ph_hi;
    XcdBarrier bar; bar.bar = (unsigned*)(F.ws + WS_CTL) + CW_BAR; bar.x = 0; bar.st = nullptr;
    if (hi - lo > 1) bar = xcd_barrier_post((unsigned*)(F.ws + WS_CTL) + CW_BAR, MISC + 8);
#ifndef TEST_PHASE
#define TEST_PHASE -1
#endif
#define IN(k) ((TEST_PHASE < 0 || TEST_PHASE == (k)) && lo <= (k) && (k) < hi)
#define SEAM(k) do { if (IN(k) && IN((k) + 1)) xcd_barrier(bar, F.wave); } while (0)
    bf16* XB = (bf16*)(F.ws + WS_XB);
    const float* PART = (const float*)(F.ws + WS_PART); const float* ROPE = (const float*)(F.ws + WS_ROPE);
    if (IN(PH_PREP)) { p0_prep(F);
#if OPT_GEMM
        p0_weights(F);
#endif
    } SEAM(PH_PREP);
#if OPT_GEMM
#define GEMM_PHASE(EPI, Aptr, Bptr, NN, ...) do { pg8::Gemm g{(const bf16*)(Aptr), (const bf16*)(Bptr), T, (NN), DM}; pg8::StaticOrder S; S.init(T, (NN), F.G, F.bid); \
        pg8::EPI E{__VA_ARGS__}; pg8::gemm_phase<pg8::EPI, pg8::StaticOrder, true, true>(F.lds, g, S, E, F.wave); } while (0)
    if (IN(PH_PROJ)) { GEMM_PHASE(EpiProj, XB, F.ws + WS_WIN, INC, (bf16*)(F.ws + WS_R), PART, ROPE); } SEAM(PH_PROJ);
#else
    if (IN(PH_PROJ)) { naive_gemm<EP_PROJ>(F, XB, F.w_in, INC, F.mix_norm, nullptr, (bf16*)(F.ws + WS_R), INC); } SEAM(PH_PROJ);
#endif
    if (IN(PH_MIX)) { naive_ret(F); naive_attn(F); } SEAM(PH_MIX);
#if OPT_GEMM
    if (IN(PH_WOUT)) { GEMM_PHASE(EpiRes, F.ws + WS_O, F.ws + WS_WOUT, DM, F.x, F.out, XB, (float*)(F.ws + WS_PART), nullptr); } SEAM(PH_WOUT);
    if (IN(PH_Q0)) { GEMM_PHASE(EpiQ, XB, F.ws + WS_WQ, DM, (bf16*)(F.ws + WS_Q), PART); } SEAM(PH_Q0);
#else
    if (IN(PH_WOUT)) { naive_gemm<EP_RES>(F, (const bf16*)(F.ws + WS_O), F.w_out, DM, nullptr, nullptr, nullptr, DM); } SEAM(PH_WOUT);
    if (IN(PH_STAT0)) { naive_rowstat(F); } SEAM(PH_STAT0);
    if (IN(PH_Q0)) { naive_gemm<EP_Q>(F, XB, F.peer_wq, DM, F.ffn_norm, nullptr, (bf16*)(F.ws + WS_Q), DM); } SEAM(PH_Q0);
#endif
    if (IN(PH_ROUTE0)) { naive_route(F, 0); } SEAM(PH_ROUTE0);
    if (IN(PH_GATHER0)) { naive_gather(F, 0, false); } SEAM(PH_GATHER0);
#if OPT_GEMM
    if (IN(PH_W1)) { GEMM_PHASE(EpiGlu, XB, F.ws + WS_W1, 2 * DM, (bf16*)(F.ws + WS_GLU), PART, F.conv_b1); } SEAM(PH_W1);
#else
    if (IN(PH_W1)) { naive_gemm<EP_HID>(F, XB, F.conv_w1, 2 * DM, F.mix_norm + DM, F.conv_b1, (bf16*)(F.ws + WS_HID), 2 * DM); } SEAM(PH_W1);
    if (IN(PH_GLU)) { naive_glu(F); } SEAM(PH_GLU);
#endif
    if (IN(PH_CONV)) { naive_conv(F); } SEAM(PH_CONV);
#if OPT_GEMM
    if (IN(PH_W2)) { GEMM_PHASE(EpiRes, F.ws + WS_HID2, F.ws + WS_W2, DM, F.out, F.out, XB, (float*)(F.ws + WS_PART), F.conv_b2); } SEAM(PH_W2);
    if (IN(PH_Q1)) { GEMM_PHASE(EpiQ, XB, F.ws + WS_WQ + (size_t)DM * DM * 2, DM, (bf16*)(F.ws + WS_Q), PART); } SEAM(PH_Q1);
#else
    if (IN(PH_W2)) { naive_gemm<EP_RES>(F, (const bf16*)(F.ws + WS_HID2), F.conv_w2, DM, nullptr, F.conv_b2, XB  , DM); } SEAM(PH_W2);
    if (IN(PH_STAT1)) { naive_rowstat(F); } SEAM(PH_STAT1);
    if (IN(PH_Q1)) { naive_gemm<EP_Q>(F, XB, F.peer_wq + (size_t)DM * DM, DM, F.ffn_norm + DM, nullptr, (bf16*)(F.ws + WS_Q), DM); } SEAM(PH_Q1);
#endif
    if (IN(PH_ROUTE1)) { naive_route(F, 1); } SEAM(PH_ROUTE1);
    if (IN(PH_GATHER1)) { naive_gather(F, 1, true); }
#undef IN
#undef SEAM
}

extern "C" void kernel_launch(void* const* d_in, const int* in_sizes, int n_in, void* d_out, int out_size, void* d_ws, size_t ws_size, hipStream_t stream) {
    static int grid = 0;
    if (grid == 0) {
        if (n_in != 19 || out_size != T * DM || ws_size < WS_END) { fprintf(stderr, "kernel_launch: unexpected shapes (n_in %d out %d ws %zu)\n", n_in, out_size, ws_size); grid = -1; return; }
        int dev = 0, cus = 0;
        if (hipGetDevice(&dev) != hipSuccess || hipDeviceGetAttribute(&cus, hipDeviceAttributeMultiprocessorCount, dev) != hipSuccess) { grid = -1; return; }
        if (hipFuncSetAttribute((const void*)mega_fwd, hipFuncAttributeMaxDynamicSharedMemorySize, LDS_BYTES) != hipSuccess) { fprintf(stderr, "kernel_launch: hipFuncSetAttribute failed\n"); grid = -1; return; }
        (void)hipGetLastError();
        grid = cus;
    }
    if (grid < 0) return;
    (void)hipMemsetAsync((char*)d_ws + WS_CTL, 0, CTL_ZERO_BYTES, stream);
    Args a{};
    for (int i = 0; i < 19; ++i) a.in[i] = (const float*)d_in[i];
    a.out = (float*)d_out; a.ws = (unsigned char*)d_ws;
#if MK_ONE_LAUNCH
    a.ph_lo = 0; a.ph_hi = PH_COUNT;
    hipLaunchKernelGGL(mega_fwd, dim3(grid), dim3(NTHR), LDS_BYTES, stream, a);
#else
    for (int p = 0; p < PH_COUNT; ++p) { a.ph_lo = p; a.ph_hi = p + 1; hipLaunchKernelGGL(mega_fwd, dim3(grid), dim3(NTHR), LDS_BYTES, stream, a); }
#endif
}
```

```cpp
#include <hip/hip_runtime.h>
#include <cstdio>
#include <cstdint>

#ifndef OPT_GEMM
#define OPT_GEMM 1
#endif
#ifndef OPT_GATHER
#define OPT_GATHER 1
#endif
#ifndef MK_ONE_LAUNCH
#define MK_ONE_LAUNCH 1
#endif

#define GAS __attribute__((address_space(1)))
#define LAS __attribute__((address_space(3)))
#define DI __device__ __forceinline__
typedef unsigned short bf16;
typedef float f32x2 __attribute__((ext_vector_type(2)));
typedef float f32x4 __attribute__((ext_vector_type(4)));
typedef unsigned u32x2 __attribute__((ext_vector_type(2)));
typedef unsigned u32x4 __attribute__((ext_vector_type(4)));

constexpr int NB = 16, SEQ = 2048, DM = 1024, T = NB * SEQ;
constexpr int CHUNK = 64, HD = 64, NHA = 8, NHB = 8, INC = 3584, NCH = SEQ / CHUNK;
constexpr int PH = 8, PK = 128, PE = PK * PK, PQD = 128, PTOP = 16, NSEL = PH * PTOP;
constexpr int CW = 31;
constexpr float EPS = 1e-6f;
constexpr float U8_SCALE = 256.f, V8_SCALE = 16.f;
constexpr int NWAVES = 8, NTHR = NWAVES * 64;

constexpr int C_QA = 0, C_KA = 512, C_VA = 1024, C_QB = 1536, C_KB = 2048, C_VB = 2560, C_GB = 3072;

constexpr size_t MiB = 1u << 20;
constexpr size_t WS_CTL = 0, CTL_ZERO_BYTES = 1 * MiB;
constexpr size_t WS_WIN = 2 * MiB, WS_WOUT = 9 * MiB, WS_W1 = 11 * MiB, WS_W2 = 15 * MiB, WS_WQ = 17 * MiB;
constexpr size_t WS_ROPE = 22 * MiB;
constexpr size_t WS_PART = 23 * MiB;
constexpr size_t WS_EIDX = 26 * MiB;
constexpr size_t WS_GATE = 42 * MiB;
constexpr size_t WS_U8 = 64 * MiB, WS_V8 = 96 * MiB;
constexpr size_t WS_XB = 128 * MiB;
constexpr size_t WS_R = 192 * MiB;
constexpr size_t WS_O = 416 * MiB;
constexpr size_t WS_Q = 192 * MiB;
constexpr size_t WS_HID = 256 * MiB;
constexpr size_t WS_GLU = 384 * MiB;
constexpr size_t WS_HID2 = 448 * MiB;
constexpr size_t WS_END = 512 * MiB;
constexpr int CW_BAR = 4096;

constexpr int RING_BYTES = 131072, LDSCTL_OFF = RING_BYTES, MISC_OFF = LDSCTL_OFF + 320, LDS_BYTES = 147456;

DI float bf2f(bf16 v) { return __uint_as_float(((unsigned)v) << 16); }
DI unsigned f2bf(float f) { unsigned u = __float_as_uint(f); return (u + 0x7fffu + ((u >> 16) & 1u)) >> 16; }
DI unsigned pk2(float lo, float hi) { return f2bf(lo) | (f2bf(hi) << 16); }
DI float wave_sum(float v) {
#pragma unroll
    for (int o = 1; o < 64; o <<= 1) v += __shfl_xor(v, o);
    return v;
}
DI float wave_max(float v) {
#pragma unroll
    for (int o = 1; o < 64; o <<= 1) v = fmaxf(v, __shfl_xor(v, o));
    return v;
}
DI float block_sum(float v, LAS float* red, int tid) {
    v = wave_sum(v);
    __syncthreads();
    if ((tid & 63) == 0) red[tid >> 6] = v;
    __syncthreads();
    float s = 0.f;
#pragma unroll
    for (int i = 0; i < NWAVES; ++i) s += red[i];
    return s;
}
DI float gelu_erf(float x) { return 0.5f * x * (1.f + erff(x * 0.70710678118654752f)); }
DI float sigmoidf(float x) { return 1.f / (1.f + __expf(-x)); }

DI int lane_id() { return (int)__builtin_amdgcn_mbcnt_hi(~0u, __builtin_amdgcn_mbcnt_lo(~0u, 0u)); }
#define XB_TMO      128
#define XB_XCNT(j)  (256  + 64 * (j))
#define XB_XSUB(j)  (1280 + 64 * (j))
#define XB_XGEN(j)  (2304 + 64 * (j))
#define XB_TOP      3328
#define XB_TOPGEN   3392
#define XCD_BAR_WORDS 3456
#define XB_SPIN_CAP (1u << 22)
DI unsigned xb_ld(unsigned* p)              { return __hip_atomic_load(p, __ATOMIC_RELAXED, __HIP_MEMORY_SCOPE_AGENT); }
DI unsigned xb_add(unsigned* p, unsigned v) { return __hip_atomic_fetch_add(p, v, __ATOMIC_RELAXED, __HIP_MEMORY_SCOPE_AGENT); }
DI unsigned xb_xcc_id() { return (unsigned)__builtin_amdgcn_s_getreg((3 << 11) | 20) & 0xFu; }
#define XB_SPIN(cond, bar) do { unsigned _sp = 0; while (cond) { __builtin_amdgcn_s_sleep(1); \
    if ((++_sp & 255u) == 0u) { if (xb_ld(&(bar)[XB_TMO])) break; if (_sp > XB_SPIN_CAP) { atomicAdd(&(bar)[XB_TMO], 1u); break; } } } } while (0)
struct XcdBarrier { unsigned* bar; unsigned x; volatile LAS unsigned* st; };
DI XcdBarrier xcd_barrier_post(unsigned* bar, volatile LAS unsigned* st) {
    XcdBarrier b; b.bar = bar; b.x = xb_xcc_id(); b.st = st;
    if (threadIdx.x == 0) (void)xb_add(&bar[XB_XCNT(b.x)], 1u);
    return b;
}
DI void xcd_barrier_complete(unsigned* bar, unsigned x, unsigned& nloc, unsigned& nx) {
    const unsigned G = gridDim.x * gridDim.y * gridDim.z;
    unsigned sum, cnt, mine, sp = 0u;
    for (;;) {
        sum = 0u; cnt = 0u; mine = 0u;
#pragma unroll
        for (unsigned j = 0; j < 16; ++j) { const unsigned c = xb_ld(&bar[XB_XCNT(j)]); sum += c; cnt += (c > 0u) ? 1u : 0u; mine = (j == x) ? c : mine; }
        if (sum == G) break;
        __builtin_amdgcn_s_sleep(1);
        if ((++sp & 255u) == 0u) { if (xb_ld(&bar[XB_TMO])) break; if (sp > XB_SPIN_CAP) { atomicAdd(&bar[XB_TMO], 1u); break; } }
    }
    nloc = mine > 0u ? mine : 1u; nx = cnt > 0u ? cnt : 1u;
}
DI void xcd_barrier(const XcdBarrier& b, const int wave_id) {
    asm volatile("s_waitcnt vmcnt(0)" ::: "memory");
    __syncthreads();
    if (wave_id == 0 && lane_id() == 0) {
        unsigned* bar = b.bar;
        __builtin_amdgcn_s_waitcnt(0);
        unsigned nloc = b.st[0], nx = b.st[1];
        if (nloc == 0u) { xcd_barrier_complete(bar, b.x, nloc, nx); b.st[0] = nloc; b.st[1] = nx; }
        const unsigned old = xb_add(&bar[XB_XSUB(b.x)], 1u);
        const unsigned gen = old / nloc;
        if (old + 1u == (gen + 1u) * nloc) {
            __builtin_amdgcn_fence(__ATOMIC_RELEASE, "agent");
            asm volatile("s_waitcnt vmcnt(0)" ::: "memory");
            const unsigned og = xb_add(&bar[XB_TOP], 1u);
            const unsigned tg = og / nx;
            if (og + 1u == (tg + 1u) * nx) xb_add(&bar[XB_TOPGEN], 1u);
            else XB_SPIN(xb_ld(&bar[XB_TOPGEN]) == tg, bar);
            __builtin_amdgcn_fence(__ATOMIC_ACQUIRE, "agent");
            xb_add(&bar[XB_XGEN(b.x)], 1u);
            asm volatile("s_waitcnt vmcnt(0)" ::: "memory");
        } else {
            XB_SPIN(xb_ld(&bar[XB_XGEN(b.x)]) == gen, bar);
            __builtin_amdgcn_fence(__ATOMIC_ACQUIRE, "agent");
            asm volatile("s_waitcnt vmcnt(0)" ::: "memory");
        }
    }
    __syncthreads();
}

namespace pg8 {
#define PG8_LAS __attribute__((address_space(3)))
typedef unsigned short bf16_t;
typedef short bf16x8 __attribute__((ext_vector_type(8)));
typedef float f32x4 __attribute__((ext_vector_type(4)));
typedef unsigned u32x4 __attribute__((ext_vector_type(4)));
constexpr int BM = 256, BK = 64, HALF = 128, HTB = HALF * BK * 2  , STAGE_BYTES = 8 * HTB, NXCD = 8, WGM = 8;

__host__ __device__ __forceinline__ int lds_byte(int r, int c) { const int st = (r >> 4) * 2 + (c >> 5), rr = r & 15, cc = c & 31, ob = rr * 64 + cc * 2; return st * 1024 + (ob ^ (((ob >> 9) & 1) << 5)); }
__host__ __device__ __forceinline__ void stage_rc(int b, int& R, int& C) { const int st = b / 1024, sb = b % 1024, swz = sb ^ (((sb >> 9) & 1) << 5); R = (st >> 1) * 16 + swz / 64; C = (st & 1) * 32 + (swz % 64) / 2; }
__host__ __device__ __forceinline__ int perm32(int rho) { const int n = rho >> 4, i = rho & 15; return 8 * (i >> 2) + 4 * n + (i & 3); }

struct Unit { int pm, pn; };
struct Gemm { const bf16_t* A; const bf16_t* Bt; int M, N, K; };

struct StaticOrder {
    int nM, nN, nwg, G, c;
    __host__ __device__ void init(int M, int N, int G_, int c_) { nM = M / BM; nN = N / BM; nwg = nM * nN; G = G_; c = c_; }
    __host__ __device__ bool next(int i, Unit& u) const {
        const long L = (long)i * G + c; if (L >= nwg) return false;
        int wgid = (int)L; { const int q = nwg / NXCD, r = nwg % NXCD, xcd = wgid % NXCD, off = wgid / NXCD; wgid = (xcd < r ? xcd * (q + 1) : r * (q + 1) + (xcd - r) * q) + off; }
        const int nig = WGM * nN, gid = wgid / nig, fm = gid * WGM, gsz = (nM - fm) < WGM ? (nM - fm) : WGM;
        u.pm = fm + ((wgid % nig) % gsz); u.pn = (wgid % nig) / gsz; return true;
    }
    __device__ __forceinline__ void a_ready(const Unit&) const {}
    __device__ __forceinline__ void done(const Unit&) const {}
};

__device__ __forceinline__ unsigned cvt_pk_bf16(float lo, float hi) { unsigned r; asm volatile("v_cvt_pk_bf16_f32 %0, %1, %2" : "=v"(r) : "v"(lo), "v"(hi)); return r; }
__device__ __forceinline__ float rstd16(const float* part, int r) {
    const f32x4* p = (const f32x4*)(part + (size_t)r * 16);
    const f32x4 a = p[0], b = p[1], c = p[2], d = p[3];
    const float s = ((a[0] + a[1]) + (a[2] + a[3])) + ((b[0] + b[1]) + (b[2] + b[3])) + ((c[0] + c[1]) + (c[2] + c[3])) + ((d[0] + d[1]) + (d[2] + d[3]));
    return 1.f / sqrtf(s * (1.f / 1024.f) + 1e-6f);
}
__device__ __forceinline__ u32x4 pack8(const f32x4 a, const f32x4 b) { u32x4 w; w.x = cvt_pk_bf16(a[0], a[1]); w.y = cvt_pk_bf16(a[2], a[3]); w.z = cvt_pk_bf16(b[0], b[1]); w.w = cvt_pk_bf16(b[2], b[3]); return w; }
#define rot(t1, t2, c, s) do { const float a_ = (t1) * (c) - (t2) * (s), b_ = (t1) * (s) + (t2) * (c); (t1) = a_; (t2) = b_; } while (0)

struct EpiProj {
    static constexpr bool PERM = true, AFTER_DRAIN = false;
    bf16_t* R; const float* part; const float* rope;
    __device__ __forceinline__ void operator()(const f32x4 (&acc)[2][2][4][2], const Unit& u, int wr, int wc, int fr, int fq) const {
        const int type = u.pn >> 1, hg = u.pn & 1;
        const int colbase = type * 512 + (4 * hg + wc) * 64 + 8 * fq;
        const bool do_rope = (type == 3) || (type == 4);
#pragma unroll
        for (int ai = 0; ai < 2; ++ai)
#pragma unroll
            for (int m = 0; m < 4; ++m) {
                const int r = u.pm * BM + ai * HALF + wr * 64 + m * 16 + fr;
                const float rs = rstd16(part, r);
                f32x4 a0 = acc[ai][0][m][0] * rs, a1 = acc[ai][0][m][1] * rs, b0 = acc[ai][1][m][0] * rs, b1 = acc[ai][1][m][1] * rs;
                if (do_rope) {
                    const f32x4* rp = (const f32x4*)(rope + ((size_t)(r & 2047) * 32 + 8 * fq) * 2);
                    const f32x4 c0 = rp[0], c1 = rp[1], c2 = rp[2], c3 = rp[3];
                    rot(a0[0], b0[0], c0[0], c0[1]); rot(a0[1], b0[1], c0[2], c0[3]); rot(a0[2], b0[2], c1[0], c1[1]); rot(a0[3], b0[3], c1[2], c1[3]);
                    rot(a1[0], b1[0], c2[0], c2[1]); rot(a1[1], b1[1], c2[2], c2[3]); rot(a1[2], b1[2], c3[0], c3[1]); rot(a1[3], b1[3], c3[2], c3[3]);
                }
                bf16_t* rowp = R + (size_t)r * 3584 + colbase;
                *(u32x4*)(rowp) = pack8(a0, a1);
                *(u32x4*)(rowp + 32) = pack8(b0, b1);
            }
    }
};
struct EpiRes {
    static constexpr bool PERM = true, AFTER_DRAIN = false;
    const float* base; float* out; bf16_t* hb; float* part; const float* bias;
    __device__ __forceinline__ void operator()(const f32x4 (&acc)[2][2][4][2], const Unit& u, int wr, int wc, int fr, int fq) const {
        const int col0 = u.pn * BM + wc * 32 + 8 * fq;
        f32x4 bv[2][2];
#pragma unroll
        for (int bj = 0; bj < 2; ++bj)
#pragma unroll
            for (int n = 0; n < 2; ++n) bv[bj][n] = bias ? *(const f32x4*)(bias + col0 + bj * HALF + 4 * n) : (f32x4){0.f, 0.f, 0.f, 0.f};
#pragma unroll
        for (int ai = 0; ai < 2; ++ai)
#pragma unroll
            for (int m = 0; m < 4; ++m) {
                const int r = u.pm * BM + ai * HALF + wr * 64 + m * 16 + fr;
                const size_t off = (size_t)r * 1024 + col0;
                float ss = 0.f;
#pragma unroll
                for (int bj = 0; bj < 2; ++bj) {
                    const f32x4 x0 = *(const f32x4*)(base + off + bj * HALF), x1 = *(const f32x4*)(base + off + bj * HALF + 4);
                    const f32x4 h0 = x0 + acc[ai][bj][m][0] + bv[bj][0], h1 = x1 + acc[ai][bj][m][1] + bv[bj][1];
                    *(f32x4*)(out + off + bj * HALF) = h0; *(f32x4*)(out + off + bj * HALF + 4) = h1;
                    *(u32x4*)(hb + off + bj * HALF) = pack8(h0, h1);
                    ss += (h0[0] * h0[0] + h0[1] * h0[1]) + (h0[2] * h0[2] + h0[3] * h0[3]) + (h1[0] * h1[0] + h1[1] * h1[1]) + (h1[2] * h1[2] + h1[3] * h1[3]);
                }
                ss += __shfl_xor(ss, 16); ss += __shfl_xor(ss, 32);
                if (fq == 0) part[(size_t)r * 16 + 4 * u.pn + wc] = ss;
            }
    }
};
struct EpiQ {
    static constexpr bool PERM = true, AFTER_DRAIN = false;
    bf16_t* O; const float* part;
    __device__ __forceinline__ void operator()(const f32x4 (&acc)[2][2][4][2], const Unit& u, int wr, int wc, int fr, int fq) const {
        const int col0 = u.pn * BM + wc * 32 + 8 * fq;
#pragma unroll
        for (int ai = 0; ai < 2; ++ai)
#pragma unroll
            for (int m = 0; m < 4; ++m) {
                const int r = u.pm * BM + ai * HALF + wr * 64 + m * 16 + fr;
                const float rs = rstd16(part, r);
                bf16_t* rowp = O + (size_t)r * 1024 + col0;
#pragma unroll
                for (int bj = 0; bj < 2; ++bj) *(u32x4*)(rowp + bj * HALF) = pack8(acc[ai][bj][m][0] * rs, acc[ai][bj][m][1] * rs);
            }
    }
};
struct EpiGlu {
    static constexpr bool PERM = true, AFTER_DRAIN = false;
    bf16_t* G; const float* part; const float* b1;
    __device__ __forceinline__ void operator()(const f32x4 (&acc)[2][2][4][2], const Unit& u, int wr, int wc, int fr, int fq) const {
        const int col = u.pn * 128 + wc * 32 + 8 * fq;
        f32x4 ba[2], bg[2];
#pragma unroll
        for (int n = 0; n < 2; ++n) { ba[n] = *(const f32x4*)(b1 + col + 4 * n); bg[n] = *(const f32x4*)(b1 + 1024 + col + 4 * n); }
#pragma unroll
        for (int ai = 0; ai < 2; ++ai)
#pragma unroll
            for (int m = 0; m < 4; ++m) {
                const int r = u.pm * BM + ai * HALF + wr * 64 + m * 16 + fr;
                const float rs = rstd16(part, r);
                f32x4 y[2];
#pragma unroll
                for (int n = 0; n < 2; ++n) {
                    const f32x4 a = acc[ai][0][m][n] * rs + ba[n], g = acc[ai][1][m][n] * rs + bg[n];
#pragma unroll
                    for (int i = 0; i < 4; ++i) y[n][i] = a[i] / (1.f + __expf(-g[i]));
                }
                *(u32x4*)(G + (size_t)r * 1024 + col) = pack8(y[0], y[1]);
            }
    }
};
template <class Epi, class Sched, bool ALIGN_EPI = false, bool SP2 = false>
__device__ __forceinline__ void gemm_phase(PG8_LAS unsigned char* lds, const Gemm g, const Sched& S, const Epi& E, const int wave_id) {
    const int lane = (int)__builtin_amdgcn_mbcnt_hi(~0u, __builtin_amdgcn_mbcnt_lo(~0u, 0u)), wid = wave_id, tid = wid * 64 + lane, wr = wid >> 2, wc = wid & 3, fr = lane & 15, fq = lane >> 4;
    const int K = g.K, nt = K / BK;
    unsigned voffA[2], voffB[2];
#pragma unroll
    for (int i = 0; i < 2; ++i) { int R, C; stage_rc(tid * 16 + i * 8192, R, C); const int Rb = Epi::PERM ? ((R & ~31) + perm32(R & 31)) : R;
        voffA[i] = (unsigned)(R * K + C) * 2u; voffB[i] = (unsigned)(Rb * K + C) * 2u; }
    const size_t kstep = (size_t)(BK * 2);
    const size_t hstep = (size_t)HALF * K * 2;
    const size_t tstep = 2 * hstep;
    const unsigned ldsw = (unsigned)wid * 1024u;
    const int aoff = lds_byte(wr * 64 + fr, fq * 8), boff = lds_byte(wc * 32 + fr, fq * 8);
#define PG8_SA(b, h) (((b) * 2 + (h)) * HTB)
#define PG8_SB(b, h) ((4 + (b) * 2 + (h)) * HTB)
#define PG8_STAGE(bufoff, gbase, voff) do { _Pragma("unroll") for (int _i = 0; _i < 2; ++_i) \
        __builtin_amdgcn_global_load_lds((const unsigned*)((const char*)(gbase) + (voff)[_i]), (PG8_LAS unsigned*)(lds + (bufoff) + ldsw + _i * 8192), 16, 0, 0); } while (0)
#define PG8_LDA(dst, b, h) do { _Pragma("unroll") for (int m = 0; m < 4; ++m) _Pragma("unroll") for (int k = 0; k < 2; ++k) dst[m][k] = *(const PG8_LAS bf16x8*)(lds + PG8_SA(b, h) + aoff + m * 2048 + k * 1024); } while (0)
#define PG8_LDB(dst, b, h) do { _Pragma("unroll") for (int n = 0; n < 2; ++n) _Pragma("unroll") for (int k = 0; k < 2; ++k) dst[n][k] = *(const PG8_LAS bf16x8*)(lds + PG8_SB(b, h) + boff + n * 2048 + k * 1024); } while (0)
#define PG8_MMA(ai, bj, At, Bt) do { __builtin_amdgcn_s_setprio(1); _Pragma("unroll") for (int m = 0; m < 4; ++m) _Pragma("unroll") for (int n = 0; n < 2; ++n) _Pragma("unroll") for (int k = 0; k < 2; ++k) \
        acc[ai][bj][m][n] = __builtin_amdgcn_mfma_f32_16x16x32_bf16(Bt[n][k], At[m][k], acc[ai][bj][m][n], 0, 0, 0); __builtin_amdgcn_s_setprio(0); } while (0)
#define PG8_WAIT_V(n) asm volatile("s_waitcnt vmcnt(" #n ")" ::: "memory")
#define PG8_WAIT_L(n) asm volatile("s_waitcnt lgkmcnt(" #n ")" ::: "memory")
#define PG8_BAR __builtin_amdgcn_s_barrier()
#define PG8_SCHED __builtin_amdgcn_sched_barrier(0)
    Unit cur, nxt; int ui = 0;
    if (!S.next(0, cur)) return;
    f32x4 acc[2][2][4][2];
#pragma unroll
    for (int a = 0; a < 2; ++a)
#pragma unroll
        for (int b = 0; b < 2; ++b)
#pragma unroll
            for (int m = 0; m < 4; ++m)
#pragma unroll
                for (int n = 0; n < 2; ++n) acc[a][b][m][n] = (f32x4){0.f, 0.f, 0.f, 0.f};
    bf16x8 At[4][2], B0[2][2], B1[2][2];
    const char* cA = (const char*)g.A + (size_t)cur.pm * tstep; const char* cB = (const char*)g.Bt + (size_t)cur.pn * tstep;
    S.a_ready(cur);
    if constexpr (SP2) {
        PG8_STAGE(PG8_SB(0, 0), cB, voffB); PG8_STAGE(PG8_SB(0, 1), cB + hstep, voffB); PG8_STAGE(PG8_SA(0, 0), cA, voffA); PG8_STAGE(PG8_SA(0, 1), cA + hstep, voffA);
        if (wr == 1) PG8_BAR;
        PG8_WAIT_V(2); PG8_BAR;
        PG8_STAGE(PG8_SB(1, 0), cB + kstep, voffB); PG8_STAGE(PG8_SA(1, 0), cA + kstep, voffA); PG8_STAGE(PG8_SB(1, 1), cB + hstep + kstep, voffB);
        PG8_WAIT_V(6); PG8_BAR;
    } else {
        PG8_STAGE(PG8_SB(0, 0), cB, voffB); PG8_STAGE(PG8_SA(0, 0), cA, voffA); PG8_STAGE(PG8_SB(0, 1), cB + hstep, voffB); PG8_STAGE(PG8_SA(0, 1), cA + hstep, voffA);
        if (wr == 1) PG8_BAR;
        PG8_WAIT_V(4); PG8_BAR;
        PG8_STAGE(PG8_SB(1, 0), cB + kstep, voffB); PG8_STAGE(PG8_SA(1, 0), cA + kstep, voffA); PG8_STAGE(PG8_SB(1, 1), cB + hstep + kstep, voffB);
        PG8_WAIT_V(6); PG8_BAR;
    }
    for (;;) {
        const bool has_next = S.next(ui + 1, nxt);
        const char* nA = has_next ? (const char*)g.A + (size_t)nxt.pm * tstep : cA; const char* nB = has_next ? (const char*)g.Bt + (size_t)nxt.pn * tstep : cB;
        for (int t = 0; t < nt; t += 2) {
            const bool last = (t == nt - 2);
            const char* a1 = cA + (size_t)(t + 1) * kstep;
            const char* a2 = last ? nA : cA + (size_t)(t + 2) * kstep; const char* b2 = last ? nB : cB + (size_t)(t + 2) * kstep;
            const char* a3 = a2 + kstep; const char* b3 = b2 + kstep;
            if (last && has_next) S.a_ready(nxt);
            if constexpr (SP2) {
            PG8_LDB(B0, 0, 0); PG8_LDB(B1, 0, 1); PG8_SCHED; PG8_LDA(At, 0, 0); PG8_STAGE(PG8_SA(1, 1), a1 + hstep, voffA);
            PG8_WAIT_V(8); PG8_WAIT_L(0); PG8_BAR; PG8_MMA(0, 0, At, B0); PG8_MMA(0, 1, At, B1); PG8_BAR; PG8_SCHED;
            PG8_LDA(At, 0, 1); PG8_STAGE(PG8_SB(0, 0), b2, voffB); PG8_STAGE(PG8_SB(0, 1), b2 + hstep, voffB); PG8_STAGE(PG8_SA(0, 0), a2, voffA);
            PG8_WAIT_V(8); PG8_WAIT_L(0); PG8_BAR; PG8_MMA(1, 0, At, B0); PG8_MMA(1, 1, At, B1); PG8_BAR; PG8_SCHED;
            PG8_LDB(B0, 1, 0); PG8_LDB(B1, 1, 1); PG8_SCHED; PG8_LDA(At, 1, 0); PG8_STAGE(PG8_SA(0, 1), a2 + hstep, voffA);
            PG8_WAIT_V(8); PG8_WAIT_L(0); PG8_BAR; PG8_MMA(0, 0, At, B0); PG8_MMA(0, 1, At, B1); PG8_BAR; PG8_SCHED;
            PG8_LDA(At, 1, 1); PG8_STAGE(PG8_SB(1, 0), b3, voffB); PG8_STAGE(PG8_SB(1, 1), b3 + hstep, voffB); PG8_STAGE(PG8_SA(1, 0), a3, voffA);
            PG8_WAIT_V(8); PG8_WAIT_L(0); PG8_BAR; PG8_MMA(1, 0, At, B0); PG8_MMA(1, 1, At, B1); PG8_BAR; PG8_SCHED;
            } else {
            PG8_LDB(B0, 0, 0); PG8_SCHED; PG8_LDA(At, 0, 0); PG8_STAGE(PG8_SA(1, 1), a1 + hstep, voffA);
            PG8_WAIT_L(8); PG8_BAR; PG8_WAIT_L(0); PG8_MMA(0, 0, At, B0); PG8_BAR; PG8_SCHED;
            PG8_LDB(B1, 0, 1); PG8_STAGE(PG8_SB(0, 0), b2, voffB);
            PG8_BAR; PG8_WAIT_L(0); PG8_MMA(0, 1, At, B1); PG8_BAR;
            PG8_LDA(At, 0, 1); PG8_STAGE(PG8_SA(0, 0), a2, voffA);
            PG8_BAR; PG8_WAIT_L(0); PG8_MMA(1, 0, At, B0); PG8_BAR; PG8_SCHED;
            PG8_STAGE(PG8_SB(0, 1), b2 + hstep, voffB);
            PG8_WAIT_V(6); PG8_BAR; PG8_MMA(1, 1, At, B1); PG8_BAR;
            PG8_LDB(B0, 1, 0); PG8_SCHED; PG8_LDA(At, 1, 0); PG8_STAGE(PG8_SA(0, 1), a2 + hstep, voffA);
            PG8_WAIT_L(8); PG8_BAR; PG8_WAIT_L(0); PG8_MMA(0, 0, At, B0); PG8_BAR; PG8_SCHED;
            PG8_LDB(B1, 1, 1); PG8_STAGE(PG8_SB(1, 0), b3, voffB);
            PG8_BAR; PG8_WAIT_L(0); PG8_MMA(0, 1, At, B1); PG8_BAR;
            PG8_LDA(At, 1, 1); PG8_STAGE(PG8_SA(1, 0), a3, voffA);
            PG8_BAR; PG8_WAIT_L(0); PG8_MMA(1, 0, At, B0); PG8_BAR; PG8_SCHED;
            PG8_STAGE(PG8_SB(1, 1), b3 + hstep, voffB);
            PG8_WAIT_V(6); PG8_BAR; PG8_MMA(1, 1, At, B1); PG8_BAR;
            }
        }
        if constexpr (ALIGN_EPI) { if (wr == 0) PG8_BAR; }
        if constexpr (!Epi::AFTER_DRAIN) { E(acc, cur, wr, wc, fr, fq); S.done(cur); }
        if (!has_next) break;
#pragma unroll
        for (int a = 0; a < 2; ++a)
#pragma unroll
            for (int b = 0; b < 2; ++b)
#pragma unroll
                for (int m = 0; m < 4; ++m)
#pragma unroll
                    for (int n = 0; n < 2; ++n) acc[a][b][m][n] = (f32x4){0.f, 0.f, 0.f, 0.f};
        cur = nxt; cA = nA; cB = nB; ++ui;
        if constexpr (ALIGN_EPI) { if (wr == 1) PG8_BAR; }
    }
    PG8_WAIT_V(0);
    if constexpr (!ALIGN_EPI) { if (wr == 0) PG8_BAR; }
    PG8_BAR;
    if constexpr (Epi::AFTER_DRAIN) { E.fused(acc, cur, wr, wc, fr, fq, lds, wid, lane); S.done(cur); }
#undef PG8_SA
#undef PG8_SB
#undef PG8_STAGE
#undef PG8_LDA
#undef PG8_LDB
#undef PG8_MMA
#undef PG8_WAIT_V
#undef PG8_WAIT_L
#undef PG8_BAR
#undef PG8_SCHED
}
}

struct Frame {
    LAS unsigned char* lds;
    int wave, G, bid;
    const float *x, *mix_norm, *ffn_norm, *final_norm, *w_in, *w_out, *rel_bias, *conv_w1, *conv_b1, *conv_dw, *conv_dw_b, *conv_ln_g, *conv_ln_b, *conv_w2, *conv_b2,
        *peer_wq, *peer_keys, *peer_u, *peer_v;
    float* out;
    unsigned char* ws;
};
#define FRAME_IDS const int f_lane = lane_id(); const int f_tid = F.wave * 64 + f_lane; (void)f_tid
DI float gamma_of(int h) { return 1.f - exp2f(-5.f - (float)h); }

DI void p0_prep(Frame& F) {
    FRAME_IDS;
    const int gw = F.bid * NWAVES + F.wave, NGW = F.G * NWAVES;
    f32x2* rope = (f32x2*)(F.ws + WS_ROPE);
    for (int i = F.bid * NTHR + f_tid; i < SEQ * 32; i += F.G * NTHR) {
        const int s = i >> 5, j = i & 31;
        const float inv = powf(10000.f, -(float)j / 32.f);
        const float ang = (float)s * inv;
        float sn, cs; sincosf(ang, &sn, &cs);
        rope[i] = (f32x2){cs, sn};
    }
    bf16* xb = (bf16*)(F.ws + WS_XB); float* part = (float*)(F.ws + WS_PART);
    for (int m = gw; m < T; m += NGW) {
        const f32x4* xr = (const f32x4*)(F.x + (size_t)m * DM) + f_lane;
        u32x2* o = (u32x2*)(xb + (size_t)m * DM) + f_lane;
        float s = 0.f;
#pragma unroll
        for (int j = 0; j < 4; ++j) { const f32x4 v = xr[64 * j]; s += v.x * v.x + v.y * v.y + v.z * v.z + v.w * v.w; o[64 * j] = (u32x2){pk2(v.x, v.y), pk2(v.z, v.w)}; }
        s = wave_sum(s);
        if (f_lane < 16) part[(size_t)m * 16 + f_lane] = (f_lane == 0) ? s : 0.f;
    }
}
DI void p0_transpose_item(const float* W, int K, int N, bf16* WT, int prow0, const float* gain, float scale, LAS float* scr, int k0, int n0, int lane) {
#pragma unroll 8
    for (int i = 0; i < 32; ++i) { const int kk = 2 * i + (lane >> 5); scr[kk * 33 + (lane & 31)] = W[(size_t)(k0 + kk) * N + n0 + (lane & 31)] * (gain ? gain[k0 + kk] : 1.f) * scale; }
    asm volatile("s_waitcnt lgkmcnt(0)" ::: "memory");
    const int c = lane & 7;
#pragma unroll
    for (int j = 0; j < 4; ++j) { const int n = (lane >> 3) + 8 * j; const LAS float* q = scr + (8 * c) * 33 + n;
        u32x4 o; o.x = pk2(q[0 * 33], q[1 * 33]); o.y = pk2(q[2 * 33], q[3 * 33]); o.z = pk2(q[4 * 33], q[5 * 33]); o.w = pk2(q[6 * 33], q[7 * 33]);
        *(u32x4*)(WT + (size_t)(prow0 + n) * K + k0 + 8 * c) = o; }
    asm volatile("s_waitcnt lgkmcnt(0)" ::: "memory");
}
DI void p0_weights(Frame& F) {
    FRAME_IDS;
    LAS float* scr = (LAS float*)(F.lds + F.wave * 16384);
    const int gw = F.bid * NWAVES + F.wave, NGW = F.G * NWAVES;
    constexpr int I_IN = 16 * (INC / 32), I_SQ = 16 * (DM / 32), I_W1 = 16 * (2 * DM / 32);
    constexpr int NITEMS = I_IN + I_SQ + I_W1 + I_SQ + 2 * I_SQ;
    for (int it = gw; it < NITEMS; it += NGW) {
        int r = it;
        if (r < I_IN) { const int nb = r % (INC / 32), kb = r / (INC / 32), n0 = nb * 32;
            const int type = n0 / 512, head = (n0 % 512) / 64, bj = (n0 % 64) / 32;
            const int prow0 = 256 * (2 * type + head / 4) + 128 * bj + 32 * (head % 4);
            p0_transpose_item(F.w_in, DM, INC, (bf16*)(F.ws + WS_WIN), prow0, F.mix_norm, (type == 0 || type == 4) ? 0.125f : 1.f, scr, kb * 64, n0, f_lane); continue; }
        r -= I_IN;
        if (r < I_SQ) { const int nb = r % 32, kb = r / 32; p0_transpose_item(F.w_out, DM, DM, (bf16*)(F.ws + WS_WOUT), nb * 32, nullptr, 1.f, scr, kb * 64, nb * 32, f_lane); continue; }
        r -= I_SQ;
        if (r < I_W1) { const int nb = r % 64, kb = r / 64, n0 = nb * 32; const int bj = n0 / 1024, rem = n0 % 1024;
            p0_transpose_item(F.conv_w1, DM, 2 * DM, (bf16*)(F.ws + WS_W1), 256 * (rem / 128) + 128 * bj + (rem % 128), F.mix_norm + DM, 1.f, scr, kb * 64, n0, f_lane); continue; }
        r -= I_W1;
        if (r < I_SQ) { const int nb = r % 32, kb = r / 32; p0_transpose_item(F.conv_w2, DM, DM, (bf16*)(F.ws + WS_W2), nb * 32, nullptr, 1.f, scr, kb * 64, nb * 32, f_lane); continue; }
        r -= I_SQ;
        { const int layer = r / I_SQ; r %= I_SQ; const int nb = r % 32, kb = r / 32;
          p0_transpose_item(F.peer_wq + (size_t)layer * DM * DM, DM, DM, (bf16*)(F.ws + WS_WQ) + (size_t)layer * DM * DM, nb * 32, F.ffn_norm + layer * DM, 1.f, scr, kb * 64, nb * 32, f_lane); }
    }
}
DI float row_rstd(const float* part, int m) {
    const f32x4* p = (const f32x4*)(part + (size_t)m * 16);
    const f32x4 a = p[0], b = p[1], c = p[2], d = p[3];
    const float s = ((a.x + a.y) + (a.z + a.w)) + ((b.x + b.y) + (b.z + b.w)) + ((c.x + c.y) + (c.z + c.w)) + ((d.x + d.y) + (d.z + d.w));
    return 1.f / sqrtf(s * (1.f / DM) + EPS);
}

enum { EP_PROJ = 0, EP_RES = 1, EP_Q = 2, EP_HID = 3 };
template <int EP>
DI void naive_gemm(Frame& F, const bf16* A, const float* W, int N, const float* gain, const float* bias, bf16* Ob, int ldo) {
    FRAME_IDS;
    LAS float* As = (LAS float*)F.lds;
    LAS float* Bs = As + 16 * 129;
    LAS float* rs = Bs + 16 * 64;
    const float* part = (const float*)(F.ws + WS_PART);
    const f32x2* rope = (const f32x2*)(F.ws + WS_ROPE);
    bf16* hb = (bf16*)(F.ws + WS_XB);
    const int tid = f_tid, tx = tid & 15, ty = tid >> 4;
    const int nN = N / 64, nItems = (T / 128) * nN;
    for (int it = F.bid; it < nItems; it += F.G) {
        const int m0 = (it / nN) * 128, n0 = (it % nN) * 64;
        __syncthreads();
        if (EP != EP_RES) { if (tid < 128) rs[tid] = row_rstd(part, m0 + tid); }
        float acc[4][4];
#pragma unroll
        for (int i = 0; i < 4; ++i)
#pragma unroll
            for (int j = 0; j < 4; ++j) acc[i][j] = 0.f;
        for (int k0 = 0; k0 < DM; k0 += 16) {
            {   const int r = tid >> 2, kk = (tid & 3) * 4;
                const u32x2 v = *(const u32x2*)(A + (size_t)(m0 + r) * DM + k0 + kk);
                As[(kk + 0) * 129 + r] = __uint_as_float(v.x << 16); As[(kk + 1) * 129 + r] = __uint_as_float(v.x & 0xffff0000u);
                As[(kk + 2) * 129 + r] = __uint_as_float(v.y << 16); As[(kk + 3) * 129 + r] = __uint_as_float(v.y & 0xffff0000u); }
            {   const int kk = tid >> 5, c = (tid & 31) * 2;
                const f32x2 v = *(const f32x2*)(W + (size_t)(k0 + kk) * N + n0 + c);
                const float g = gain ? gain[k0 + kk] : 1.f;
                Bs[kk * 64 + c] = v.x * g; Bs[kk * 64 + c + 1] = v.y * g; }
            __syncthreads();
#pragma unroll
            for (int kk = 0; kk < 16; ++kk) {
                float a[4], b[4];
#pragma unroll
                for (int i = 0; i < 4; ++i) a[i] = As[kk * 129 + ty * 4 + i];
                b[0] = Bs[kk * 64 + 2 * tx]; b[1] = Bs[kk * 64 + 2 * tx + 1]; b[2] = Bs[kk * 64 + 32 + 2 * tx]; b[3] = Bs[kk * 64 + 33 + 2 * tx];
#pragma unroll
                for (int i = 0; i < 4; ++i)
#pragma unroll
                    for (int j = 0; j < 4; ++j) acc[i][j] += a[i] * b[j];
            }
            __syncthreads();
        }
#pragma unroll
        for (int i = 0; i < 4; ++i) {
            const int m = m0 + ty * 4 + i;
            const int cols[4] = {n0 + 2 * tx, n0 + 2 * tx + 1, n0 + 32 + 2 * tx, n0 + 33 + 2 * tx};
            float v[4] = {acc[i][0], acc[i][1], acc[i][2], acc[i][3]};
            if (EP == EP_PROJ) {
                const float r = rs[ty * 4 + i];
#pragma unroll
                for (int j = 0; j < 4; ++j) v[j] *= r;
                const int type = n0 / 512;
                if (type == 3 || type == 4) {
                    const int s = m % SEQ;
#pragma unroll
                    for (int j = 0; j < 2; ++j) {
                        const f32x2 cs = rope[s * 32 + 2 * tx + j];
                        const float t1 = v[j], t2 = v[j + 2];
                        v[j] = t1 * cs.x - t2 * cs.y; v[j + 2] = t1 * cs.y + t2 * cs.x;
                    }
                }
                if (type == 0 || type == 4) {
#pragma unroll
                    for (int j = 0; j < 4; ++j) v[j] *= 0.125f;
                }
#pragma unroll
                for (int j = 0; j < 4; ++j) Ob[(size_t)m * ldo + cols[j]] = (bf16)f2bf(v[j]);
            } else if (EP == EP_RES) {
#pragma unroll
                for (int j = 0; j < 4; ++j) {
                    const size_t o = (size_t)m * DM + cols[j];
                    const float base = (Ob == nullptr) ? F.x[o] : F.out[o];
                    const float hn = base + v[j] + (bias ? bias[cols[j]] : 0.f);
                    F.out[o] = hn; hb[o] = (bf16)f2bf(hn);
                }
            } else if (EP == EP_Q) {
                const float r = rs[ty * 4 + i];
#pragma unroll
                for (int j = 0; j < 4; ++j) Ob[(size_t)m * ldo + cols[j]] = (bf16)f2bf(v[j] * r);
            } else {
                const float r = rs[ty * 4 + i];
#pragma unroll
                for (int j = 0; j < 4; ++j) Ob[(size_t)m * ldo + cols[j]] = (bf16)f2bf(v[j] * r + bias[cols[j]]);
            }
        }
    }
}

DI void naive_rowstat(Frame& F) {
    FRAME_IDS;
    const int gw = F.bid * NWAVES + F.wave, NGW = F.G * NWAVES;
    float* part = (float*)(F.ws + WS_PART);
    for (int m = gw; m < T; m += NGW) {
        const f32x4* xr = (const f32x4*)(F.out + (size_t)m * DM) + f_lane;
        float s = 0.f;
#pragma unroll
        for (int j = 0; j < 4; ++j) { const f32x4 v = xr[64 * j]; s += v.x * v.x + v.y * v.y + v.z * v.z + v.w * v.w; }
        s = wave_sum(s);
        if (f_lane < 16) part[(size_t)m * 16 + f_lane] = (f_lane == 0) ? s : 0.f;
    }
}

DI void naive_attn(Frame& F) {
    FRAME_IDS;
    const bf16* R = (const bf16*)(F.ws + WS_R); bf16* O = (bf16*)(F.ws + WS_O);
    LAS float* Ks = (LAS float*)F.lds;
    LAS float* Vs = Ks + 64 * 65;
    LAS float* bs = Vs + 64 * 65;
    const int tid = f_tid;
    for (int it = F.bid; it < NB * NHA * 4; it += F.G) {
        const int b = it / (NHA * 4), h = (it / 4) % NHA, cg = it % 4;
        const int c = cg * 8 + (tid >> 6), i = tid & 63;
        __syncthreads();
        for (int k = tid; k < 257; k += NTHR) bs[k] = F.rel_bias[h * 257 + k];
        float q[64], acc[64];
        {   const bf16* qp = R + (size_t)(b * SEQ + c * 64 + i) * INC + C_QA + h * 64;
#pragma unroll
            for (int d = 0; d < 64; ++d) { q[d] = bf2f(qp[d]); acc[d] = 0.f; } }
        float mx = -1e30f, l = 0.f;
        const int t_lo = (cg * 8 - 8) < 0 ? 0 : (cg * 8 - 8), t_hi = cg * 8 + 7;
        for (int tc = t_lo; tc <= t_hi; ++tc) {
            __syncthreads();
            for (int e = tid; e < 64 * 64; e += NTHR) {
                const int j = e >> 6, d = e & 63;
                const size_t row = (size_t)(b * SEQ + tc * 64 + j) * INC;
                Ks[j * 65 + d] = bf2f(R[row + C_KA + h * 64 + d]);
                Vs[j * 65 + d] = bf2f(R[row + C_VA + h * 64 + d]);
            }
            __syncthreads();
            if (tc <= c && tc >= c - 8) {
                for (int j = 0; j < 64; ++j) {
                    float s = 0.f;
#pragma unroll
                    for (int d = 0; d < 64; ++d) s += q[d] * Ks[j * 65 + d];
                    int rel = (c * 64 + i) - (tc * 64 + j); rel = rel < -128 ? -128 : (rel > 128 ? 128 : rel);
                    s += bs[rel + 128];
                    const float mn = fmaxf(mx, s), corr = __expf(mx - mn), p = __expf(s - mn);
                    l = l * corr + p;
#pragma unroll
                    for (int d = 0; d < 64; ++d) acc[d] = acc[d] * corr + p * Vs[j * 65 + d];
                    mx = mn;
                }
            }
        }
        const float inv = 1.f / l;
        bf16* op = O + (size_t)(b * SEQ + c * 64 + i) * DM + h * 64;
#pragma unroll
        for (int d = 0; d < 64; ++d) op[d] = (bf16)f2bf(acc[d] * inv);
    }
}

DI void naive_ret(Frame& F) {
    FRAME_IDS;
    const bf16* R = (const bf16*)(F.ws + WS_R); bf16* O = (bf16*)(F.ws + WS_O);
    LAS float* St = (LAS float*)F.lds;
    LAS float* Qs = St + 4096;
    LAS float* Ks = Qs + 64 * 65;
    LAS float* Vs = Ks + 64 * 65;
    LAS float* Sc = Vs + 64 * 65;
    LAS float* Ot = Sc + 64 * 65;
    const int tid = f_tid;
    for (int it = F.G - 1 - F.bid; it < NB * NHB; it += F.G) {
        const int b = it / NHB, h = it % NHB;
        const float lg = logf(gamma_of(h));
        const float cd = __expf(lg * 64.f);
        __syncthreads();
        for (int e = tid; e < 4096; e += NTHR) St[e] = 0.f;
        for (int n = 0; n < NCH; ++n) {
            __syncthreads();
            for (int e = tid; e < 4096; e += NTHR) {
                const int j = e >> 6, d = e & 63;
                const size_t row = (size_t)(b * SEQ + n * 64 + j) * INC;
                Qs[j * 65 + d] = bf2f(R[row + C_QB + h * 64 + d]);
                Ks[j * 65 + d] = bf2f(R[row + C_KB + h * 64 + d]);
                Vs[j * 65 + d] = bf2f(R[row + C_VB + h * 64 + d]);
            }
            __syncthreads();
            for (int e = tid; e < 4096; e += NTHR) {
                const int i = e >> 6, j = e & 63;
                float s = 0.f;
#pragma unroll
                for (int d = 0; d < 64; ++d) s += Qs[i * 65 + d] * Ks[j * 65 + d];
                const int ad = i > j ? i - j : j - i;
                Sc[i * 65 + j] = s * __expf(lg * (float)ad);
            }
            __syncthreads();
            for (int e = tid; e < 4096; e += NTHR) {
                const int i = e >> 6, ee = e & 63;
                float s = 0.f, cr = 0.f;
#pragma unroll
                for (int j = 0; j < 64; ++j) s += Sc[i * 65 + j] * Vs[j * 65 + ee];
#pragma unroll
                for (int d = 0; d < 64; ++d) cr += Qs[i * 65 + d] * St[d * 64 + ee];
                Ot[i * 65 + ee] = s + cr * __expf(lg * (float)(i + 1));
            }
            __syncthreads();
            for (int e = tid; e < 4096; e += NTHR) {
                const int d = e >> 6, ee = e & 63;
                float s = 0.f;
                for (int j = 0; j < 64; ++j) s += Ks[j * 65 + d] * __expf(lg * (float)(63 - j)) * Vs[j * 65 + ee];
                St[d * 64 + ee] = cd * St[d * 64 + ee] + s;
            }
            for (int r = 0; r < 8; ++r) {
                const int i = F.wave * 8 + r;
                const float v = Ot[i * 65 + f_lane];
                const float mu = wave_sum(v) * (1.f / 64.f);
                const float dv = v - mu;
                const float var = wave_sum(dv * dv) * (1.f / 64.f);
                const size_t row = (size_t)(b * SEQ + n * 64 + i);
                const float g = bf2f(R[row * INC + C_GB + h * 64 + f_lane]);
                const float o = dv * (1.f / sqrtf(var + EPS)) * (g * sigmoidf(g));
                O[row * DM + 512 + h * 64 + f_lane] = (bf16)f2bf(o);
            }
        }
    }
}

DI void naive_route(Frame& F, int layer) {
    FRAME_IDS;
    const bf16* Q = (const bf16*)(F.ws + WS_Q);
    int* eidx = (int*)(F.ws + WS_EIDX); float* gate = (float*)(F.ws + WS_GATE);
    const float* keys = F.peer_keys + (size_t)layer * 2 * PK * 64;
    LAS float* sc = (LAS float*)F.lds;
    LAS int* i1s = (LAS int*)(sc + 256 * 64);
    LAS int* i2s = i1s + 16 * 64;
    LAS float* qs = (LAS float*)(i2s + 16 * 64);
    const int p = f_tid;
    for (int it = F.bid; it < T / 8; it += F.G) {
        if (p < 64) {
            const int t = it * 8 + (p >> 3), hh = p & 7;
            float top1[16], top2[16];
#pragma unroll
            for (int side = 0; side < 2; ++side) {
                const bf16* qp = Q + (size_t)t * DM + hh * 128 + side * 64;
                for (int d = 0; d < 64; ++d) qs[d * 64 + p] = bf2f(qp[d]);
                for (int k = 0; k < PK; ++k) {
                    const float* kp = keys + ((size_t)side * PK + k) * 64;
                    float s = 0.f;
#pragma unroll 8
                    for (int d = 0; d < 64; ++d) s += qs[d * 64 + p] * kp[d];
                    sc[k * 64 + p] = s;
                }
#pragma unroll
                for (int a = 0; a < 16; ++a) {
                    float best = -INFINITY; int bi = 0;
                    for (int k = 0; k < PK; ++k) { const float v = sc[k * 64 + p]; if (v > best) { best = v; bi = k; } }
                    sc[bi * 64 + p] = -INFINITY;
                    if (side == 0) { top1[a] = best; i1s[a * 64 + p] = bi; } else { top2[a] = best; i2s[a * 64 + p] = bi; }
                }
            }
#pragma unroll
            for (int a = 0; a < 16; ++a)
#pragma unroll
                for (int b = 0; b < 16; ++b) sc[(a * 16 + b) * 64 + p] = top1[a] + top2[b];
            float bv[16]; int be[16];
#pragma unroll
            for (int a = 0; a < 16; ++a) {
                float best = -INFINITY; int bi = 0;
                for (int k = 0; k < 256; ++k) { const float v = sc[k * 64 + p]; if (v > best) { best = v; bi = k; } }
                sc[bi * 64 + p] = -INFINITY;
                bv[a] = best; be[a] = i1s[(bi >> 4) * 64 + p] * PK + i2s[(bi & 15) * 64 + p];
            }
            float sum = 0.f; const float bmax = bv[0];
#pragma unroll
            for (int a = 0; a < 16; ++a) { bv[a] = __expf(bv[a] - bmax); sum += bv[a]; }
            const float inv = 1.f / sum;
#pragma unroll
            for (int a = 0; a < 16; ++a) { eidx[(size_t)t * NSEL + hh * 16 + a] = be[a]; gate[(size_t)t * NSEL + hh * 16 + a] = bv[a] * inv; }
        }
    }
}

DI void naive_gather(Frame& F, int layer, bool final_norm) {
    FRAME_IDS;
    const int* eidx = (const int*)(F.ws + WS_EIDX); const float* gate = (const float*)(F.ws + WS_GATE);
    float* part = (float*)(F.ws + WS_PART); bf16* hb = (bf16*)(F.ws + WS_XB);
    const float* U = F.peer_u + (size_t)layer * PE * DM; const float* V = F.peer_v + (size_t)layer * PE * DM;
    const float* gn = F.ffn_norm + layer * DM;
    LAS float* xs = (LAS float*)F.lds;
    LAS float* as = xs + 1024;
    LAS int* es = (LAS int*)(as + 128);
    LAS float* red = (LAS float*)(es + 128);
    const int tid = f_tid;
    for (int t = F.bid; t < T; t += F.G) {
        __syncthreads();
        const float rstd = row_rstd(part, t);
        const f32x2 hv = *(const f32x2*)(F.out + (size_t)t * DM + 2 * tid);
        xs[2 * tid] = hv.x * rstd * gn[2 * tid]; xs[2 * tid + 1] = hv.y * rstd * gn[2 * tid + 1];
        if (tid < 128) es[tid] = eidx[(size_t)t * NSEL + tid];
        __syncthreads();
        for (int k = F.wave; k < NSEL; k += NWAVES) {
            const f32x4* ur = (const f32x4*)(U + (size_t)es[k] * DM) + f_lane;
            float s = 0.f;
#pragma unroll
            for (int j = 0; j < 4; ++j) { const f32x4 u = ur[64 * j]; const int c = 4 * f_lane + 256 * j; s += u.x * xs[c] + u.y * xs[c + 1] + u.z * xs[c + 2] + u.w * xs[c + 3]; }
            s = wave_sum(s);
            if (f_lane == 0) as[k] = gelu_erf(s) * gate[(size_t)t * NSEL + k];
        }
        __syncthreads();
        float o0 = 0.f, o1 = 0.f;
        for (int k = 0; k < NSEL; ++k) { const f32x2 v = *(const f32x2*)(V + (size_t)es[k] * DM + 2 * tid); const float a = as[k]; o0 += a * v.x; o1 += a * v.y; }
        const float h0 = hv.x + o0, h1 = hv.y + o1;
        const float ss = block_sum(h0 * h0 + h1 * h1, red, tid);
        if (final_norm) {
            const float r = 1.f / sqrtf(ss * (1.f / DM) + EPS);
            *(f32x2*)(F.out + (size_t)t * DM + 2 * tid) = (f32x2){h0 * r * F.final_norm[2 * tid], h1 * r * F.final_norm[2 * tid + 1]};
        } else {
            *(f32x2*)(F.out + (size_t)t * DM + 2 * tid) = (f32x2){h0, h1};
            *(unsigned*)(hb + (size_t)t * DM + 2 * tid) = pk2(h0, h1);
            if (tid < 16) part[(size_t)t * 16 + tid] = (tid == 0) ? ss : 0.f;
        }
    }
}


DI unsigned fp8x4(f32x4 v) {
    const float a = __builtin_amdgcn_fmed3f(v[0], -448.f, 448.f), b = __builtin_amdgcn_fmed3f(v[1], -448.f, 448.f), c = __builtin_amdgcn_fmed3f(v[2], -448.f, 448.f), d = __builtin_amdgcn_fmed3f(v[3], -448.f, 448.f);
    unsigned w = 0u;
    w = (unsigned)__builtin_amdgcn_cvt_pk_fp8_f32(a, b, (int)w, false);
    w = (unsigned)__builtin_amdgcn_cvt_pk_fp8_f32(c, d, (int)w, true);
    return w;
}
DI void p0_fp8(Frame& F) {
    FRAME_IDS;
    const int gw = F.bid * NWAVES + F.wave, NGW = F.G * NWAVES;
    for (int row = gw; row < 4 * PE; row += NGW) {
        const int tab = row / PE, e = row % PE, layer = tab & 1, isv = tab >> 1;
        const float* src = (isv ? F.peer_v : F.peer_u) + ((size_t)layer * PE + e) * DM;
        unsigned* dst = (unsigned*)(F.ws + (isv ? WS_V8 : WS_U8) + ((size_t)layer * PE + e) * DM);
        const f32x4* sp = (const f32x4*)src + f_lane;
        const f32x4* gp = (const f32x4*)(F.ffn_norm + layer * DM) + f_lane;
#pragma unroll
        for (int j = 0; j < 4; ++j) {
            f32x4 v = sp[64 * j];
            if (!isv) v = v * gp[64 * j] * U8_SCALE; else v = v * V8_SCALE;
            dst[f_lane + 64 * j] = fp8x4(v);
        }
    }
}
DI float dot16_fp8(const u32x4 r, const float (&xs)[16]) {
    float s0 = 0.f, s1 = 0.f;
#pragma unroll
    for (int w = 0; w < 4; ++w) {
        const f32x2 lo = __builtin_amdgcn_cvt_pk_f32_fp8((int)r[w], false), hi = __builtin_amdgcn_cvt_pk_f32_fp8((int)r[w], true);
        s0 = fmaf(lo[0], xs[4 * w + 0], s0); s1 = fmaf(lo[1], xs[4 * w + 1], s1); s0 = fmaf(hi[0], xs[4 * w + 2], s0); s1 = fmaf(hi[1], xs[4 * w + 3], s1);
    }
    return s0 + s1;
}
DI void axpy16_fp8(const u32x4 r, const float a, float (&o)[16]) {
#pragma unroll
    for (int w = 0; w < 4; ++w) {
        const f32x2 lo = __builtin_amdgcn_cvt_pk_f32_fp8((int)r[w], false), hi = __builtin_amdgcn_cvt_pk_f32_fp8((int)r[w], true);
        o[4 * w + 0] = fmaf(a, lo[0], o[4 * w + 0]); o[4 * w + 1] = fmaf(a, lo[1], o[4 * w + 1]); o[4 * w + 2] = fmaf(a, hi[0], o[4 * w + 2]); o[4 * w + 3] = fmaf(a, hi[1], o[4 * w + 3]);
    }
}
DI float red_combine(const int level, const float a, const float b, const int lane) {
    const int M = 32 >> level; const bool bit = (lane & M) != 0;
    const float send = bit ? a : b, keep = bit ? b : a;
    return keep + __shfl_xor(send, M);
}
constexpr int brev6(int k) { return ((k & 1) << 5) | ((k & 2) << 3) | ((k & 4) << 1) | ((k & 8) >> 1) | ((k & 16) >> 3) | ((k & 32) >> 5); }
DI void opt_gather(Frame& F, int layer, bool final_norm) {
    FRAME_IDS;
    const int* eidx = (const int*)(F.ws + WS_EIDX); const float* gate = (const float*)(F.ws + WS_GATE);
    float* part = (float*)(F.ws + WS_PART); bf16* hb = (bf16*)(F.ws + WS_XB);
    const __amdgpu_buffer_rsrc_t U8 = __builtin_amdgcn_make_buffer_rsrc((void*)(F.ws + WS_U8 + (size_t)layer * PE * DM), 0, PE * DM, 0x00020000);
    const __amdgpu_buffer_rsrc_t V8 = __builtin_amdgcn_make_buffer_rsrc((void*)(F.ws + WS_V8 + (size_t)layer * PE * DM), 0, PE * DM, 0x00020000);
    const int voff = f_lane * 16;
    const int gw = F.bid * NWAVES + F.wave, NGW = F.G * NWAVES;
    for (int t = gw; t < T; t += NGW) {
        float* hrow = F.out + (size_t)t * DM + 16 * f_lane;
        float xs[16];
        { const f32x4 h0 = ((const f32x4*)hrow)[0], h1 = ((const f32x4*)hrow)[1], h2 = ((const f32x4*)hrow)[2], h3 = ((const f32x4*)hrow)[3];
#pragma unroll
          for (int i = 0; i < 4; ++i) { xs[i] = h0[i]; xs[4 + i] = h1[i]; xs[8 + i] = h2[i]; xs[12 + i] = h3[i]; } }
        const float pv = (f_lane < 16) ? part[(size_t)t * 16 + f_lane] : 0.f;
        const float rstd = 1.f / sqrtf(wave_sum(pv) * (1.f / DM) + EPS);
        int ev[2]; float gv[2], av[2];
        ev[0] = eidx[(size_t)t * NSEL + f_lane]; ev[1] = eidx[(size_t)t * NSEL + 64 + f_lane];
        gv[0] = gate[(size_t)t * NSEL + f_lane]; gv[1] = gate[(size_t)t * NSEL + 64 + f_lane];
        constexpr int GR = 4, NG = 64 / GR;
#pragma unroll
        for (int b = 0; b < 2; ++b) {
            float st[6]; float red = 0.f;
            u32x4 buf[2][GR];
#pragma unroll
            for (int j = 0; j < GR; ++j) { const int e = __builtin_amdgcn_readlane(ev[b], brev6(j)); buf[0][j] = __builtin_amdgcn_raw_buffer_load_b128(U8, voff, e * DM, 0); }
            asm volatile("" ::: "memory");
#pragma unroll
            for (int g = 0; g < NG; ++g) {
                if (g + 1 < NG) {
#pragma unroll
                    for (int j = 0; j < GR; ++j) { const int e = __builtin_amdgcn_readlane(ev[b], brev6(GR * (g + 1) + j)); buf[(g + 1) & 1][j] = __builtin_amdgcn_raw_buffer_load_b128(U8, voff, e * DM, 0); }
                }
                asm volatile("" ::: "memory");
#pragma unroll
                for (int j = 0; j < GR; ++j) {
                    const int k = GR * g + j;
                    float v = dot16_fp8(buf[g & 1][j], xs);
                    int kk = k, lvl = 0;
#pragma unroll
                    for (int q = 0; q < 6; ++q) { if (kk & 1) { v = red_combine(lvl, st[lvl], v, f_lane); kk >>= 1; ++lvl; } }
                    if (k == 63) red = v; else st[lvl] = v;
                }
                asm volatile("" ::: "memory");
            }
            const float d = red * (rstd * (1.f / U8_SCALE));
            av[b] = gelu_erf(d) * gv[b] * (1.f / V8_SCALE);
        }
        float o[16];
#pragma unroll
        for (int i = 0; i < 16; ++i) o[i] = 0.f;
#pragma unroll
        for (int b = 0; b < 2; ++b) {
            u32x4 buf[2][GR];
#pragma unroll
            for (int j = 0; j < GR; ++j) { const int e = __builtin_amdgcn_readlane(ev[b], j); buf[0][j] = __builtin_amdgcn_raw_buffer_load_b128(V8, voff, e * DM, 0); }
            asm volatile("" ::: "memory");
#pragma unroll
            for (int g = 0; g < NG; ++g) {
                if (g + 1 < NG) {
#pragma unroll
                    for (int j = 0; j < GR; ++j) { const int e = __builtin_amdgcn_readlane(ev[b], GR * (g + 1) + j); buf[(g + 1) & 1][j] = __builtin_amdgcn_raw_buffer_load_b128(V8, voff, e * DM, 0); }
                }
                asm volatile("" ::: "memory");
#pragma unroll
                for (int j = 0; j < GR; ++j) { const float a = __builtin_bit_cast(float, __builtin_amdgcn_readlane(__builtin_bit_cast(int, av[b]), GR * g + j)); axpy16_fp8(buf[g & 1][j], a, o); }
                asm volatile("" ::: "memory");
            }
        }
        float ss = 0.f;
#pragma unroll
        for (int i = 0; i < 16; ++i) { o[i] += xs[i]; ss = fmaf(o[i], o[i], ss); }
        ss = wave_sum(ss);
        if (final_norm) {
            const float r = 1.f / sqrtf(ss * (1.f / DM) + EPS);
            const f32x4* fn = (const f32x4*)(F.final_norm + 16 * f_lane);
#pragma unroll
            for (int q = 0; q < 4; ++q) { const f32x4 g = fn[q]; ((f32x4*)hrow)[q] = (f32x4){o[4 * q] * r * g[0], o[4 * q + 1] * r * g[1], o[4 * q + 2] * r * g[2], o[4 * q + 3] * r * g[3]}; }
        } else {
#pragma unroll
            for (int q = 0; q < 4; ++q) ((f32x4*)hrow)[q] = (f32x4){o[4 * q], o[4 * q + 1], o[4 * q + 2], o[4 * q + 3]};
            u32x4* hbp = (u32x4*)(hb + (size_t)t * DM + 16 * f_lane);
            hbp[0] = (u32x4){pk2(o[0], o[1]), pk2(o[2], o[3]), pk2(o[4], o[5]), pk2(o[6], o[7])};
            hbp[1] = (u32x4){pk2(o[8], o[9]), pk2(o[10], o[11]), pk2(o[12], o[13]), pk2(o[14], o[15])};
            if (f_lane < 16) part[(size_t)t * 16 + f_lane] = (f_lane == 0) ? ss : 0.f;
        }
    }
}
DI void naive_glu(Frame& F) {
    FRAME_IDS;
    const bf16* H = (const bf16*)(F.ws + WS_HID); bf16* G = (bf16*)(F.ws + WS_GLU);
    for (size_t i = (size_t)F.bid * NTHR + f_tid; i < (size_t)T * DM; i += (size_t)F.G * NTHR) {
        const size_t m = i / DM; const int c = (int)(i % DM);
        const float a = bf2f(H[m * 2048 + c]), g = bf2f(H[m * 2048 + 1024 + c]);
        G[i] = (bf16)f2bf(a * sigmoidf(g));
    }
}
DI void naive_conv(Frame& F) {
    FRAME_IDS;
    const bf16* G = (const bf16*)(F.ws + WS_GLU); bf16* H2 = (bf16*)(F.ws + WS_HID2);
    LAS float* red = (LAS float*)F.lds;
    const int tid = f_tid;
    for (int t = F.bid; t < T; t += F.G) {
        const int s = t % SEQ;
        float y[2];
#pragma unroll
        for (int u = 0; u < 2; ++u) {
            const int c = 2 * tid + u;
            float a = F.conv_dw_b[c];
            for (int j = 0; j < CW; ++j) { const int sp = s - (CW - 1) + j; if (sp >= 0) a += F.conv_dw[j * DM + c] * bf2f(G[(size_t)(t - (CW - 1) + j) * DM + c]); }
            y[u] = a;
        }
        const float mu = block_sum(y[0] + y[1], red, tid) * (1.f / DM);
        const float d0 = y[0] - mu, d1 = y[1] - mu;
        const float var = block_sum(d0 * d0 + d1 * d1, red, tid) * (1.f / DM);
        const float r = 1.f / sqrtf(var + EPS);
        const float z0 = d0 * r * F.conv_ln_g[2 * tid] + F.conv_ln_b[2 * tid], z1 = d1 * r * F.conv_ln_g[2 * tid + 1] + F.conv_ln_b[2 * tid + 1];
        *(unsigned*)(H2 + (size_t)t * DM + 2 * tid) = pk2(z0 * sigmoidf(z0), z1 * sigmoidf(z1));
    }
}

#if OPT_GEMM
enum Phase { PH_PREP = 0, PH_PROJ, PH_MIX, PH_WOUT, PH_Q0, PH_ROUTE0, PH_GATHER0, PH_W1, PH_CONV, PH_W2, PH_Q1, PH_ROUTE1, PH_GATHER1, PH_COUNT };
#else
enum Phase { PH_PREP = 0, PH_PROJ, PH_MIX, PH_WOUT, PH_STAT0, PH_Q0, PH_ROUTE0, PH_GATHER0, PH_W1, PH_GLU, PH_CONV, PH_W2, PH_STAT1, PH_Q1, PH_ROUTE1, PH_GATHER1, PH_COUNT };
#endif
struct Args { const float* in[19]; float* out; unsigned char* ws; int ph_lo, ph_hi; };

__global__ void __launch_bounds__(NTHR, 2) mega_fwd(Args args) {
    extern __shared__ __attribute__((aligned(16))) unsigned char lds[];
    Frame F;
    F.lds = (LAS unsigned char*)lds;
    F.wave = __builtin_amdgcn_readfirstlane((int)threadIdx.x >> 6); FRAME_IDS;
    F.G = gridDim.x; F.bid = blockIdx.x;
    F.x = args.in[0]; F.mix_norm = args.in[1]; F.ffn_norm = args.in[2]; F.final_norm = args.in[3]; F.w_in = args.in[4]; F.w_out = args.in[5]; F.rel_bias = args.in[6];
    F.conv_w1 = args.in[7]; F.conv_b1 = args.in[8]; F.conv_dw = args.in[9]; F.conv_dw_b = args.in[10]; F.conv_ln_g = args.in[11]; F.conv_ln_b = args.in[12];
    F.conv_w2 = args.in[13]; F.conv_b2 = args.in[14]; F.peer_wq = args.in[15]; F.peer_keys = args.in[16]; F.peer_u = args.in[17]; F.peer_v = args.in[18];
    F.out = args.out; F.ws = args.ws;
    volatile LAS unsigned* MISC = (volatile LAS unsigned*)(F.lds + MISC_OFF);
    for (int u = f_tid; u < (LDS_BYTES - LDSCTL_OFF) / 4; u += NTHR) ((LAS unsigned*)(F.lds + LDSCTL_OFF))[u] = 0u;
    __syncthreads();
    const int lo = args.ph_lo, hi = args.ph_hi;
    XcdBarrier bar; bar.bar = (unsigned*)(F.ws + WS_CTL) + CW_BAR; bar.x = 0; bar.st = nullptr;
    if (hi - lo > 1) bar = xcd_barrier_post((unsigned*)(F.ws + WS_CTL) + CW_BAR, MISC + 8);
#ifndef TEST_PHASE
#define TEST_PHASE -1
#endif
#define IN(k) ((TEST_PHASE < 0 || TEST_PHASE == (k)) && lo <= (k) && (k) < hi)
#define SEAM(k) do { if (IN(k) && IN((k) + 1)) xcd_barrier(bar, F.wave); } while (0)
    bf16* XB = (bf16*)(F.ws + WS_XB);
    const float* PART = (const float*)(F.ws + WS_PART); const float* ROPE = (const float*)(F.ws + WS_ROPE);
    if (IN(PH_PREP)) { p0_prep(F);
#if OPT_GEMM
        p0_weights(F);
#endif
#if OPT_GATHER
        p0_fp8(F);
#endif
    } SEAM(PH_PREP);
#if OPT_GEMM
#define GEMM_PHASE(EPI, Aptr, Bptr, NN, ...) do { pg8::Gemm g{(const bf16*)(Aptr), (const bf16*)(Bptr), T, (NN), DM}; pg8::StaticOrder S; S.init(T, (NN), F.G, F.bid); \
        pg8::EPI E{__VA_ARGS__}; pg8::gemm_phase<pg8::EPI, pg8::StaticOrder, true, true>(F.lds, g, S, E, F.wave); } while (0)
    if (IN(PH_PROJ)) { GEMM_PHASE(EpiProj, XB, F.ws + WS_WIN, INC, (bf16*)(F.ws + WS_R), PART, ROPE); } SEAM(PH_PROJ);
#else
    if (IN(PH_PROJ)) { naive_gemm<EP_PROJ>(F, XB, F.w_in, INC, F.mix_norm, nullptr, (bf16*)(F.ws + WS_R), INC); } SEAM(PH_PROJ);
#endif
    if (IN(PH_MIX)) { naive_ret(F); naive_attn(F); } SEAM(PH_MIX);
#if OPT_GEMM
    if (IN(PH_WOUT)) { GEMM_PHASE(EpiRes, F.ws + WS_O, F.ws + WS_WOUT, DM, F.x, F.out, XB, (float*)(F.ws + WS_PART), nullptr); } SEAM(PH_WOUT);
    if (IN(PH_Q0)) { GEMM_PHASE(EpiQ, XB, F.ws + WS_WQ, DM, (bf16*)(F.ws + WS_Q), PART); } SEAM(PH_Q0);
#else
    if (IN(PH_WOUT)) { naive_gemm<EP_RES>(F, (const bf16*)(F.ws + WS_O), F.w_out, DM, nullptr, nullptr, nullptr, DM); } SEAM(PH_WOUT);
    if (IN(PH_STAT0)) { naive_rowstat(F); } SEAM(PH_STAT0);
    if (IN(PH_Q0)) { naive_gemm<EP_Q>(F, XB, F.peer_wq, DM, F.ffn_norm, nullptr, (bf16*)(F.ws + WS_Q), DM); } SEAM(PH_Q0);
#endif
    if (IN(PH_ROUTE0)) { naive_route(F, 0); } SEAM(PH_ROUTE0);
#if OPT_GATHER
    if (IN(PH_GATHER0)) { opt_gather(F, 0, false); } SEAM(PH_GATHER0);
#else
    if (IN(PH_GATHER0)) { naive_gather(F, 0, false); } SEAM(PH_GATHER0);
#endif
#if OPT_GEMM
    if (IN(PH_W1)) { GEMM_PHASE(EpiGlu, XB, F.ws + WS_W1, 2 * DM, (bf16*)(F.ws + WS_GLU), PART, F.conv_b1); } SEAM(PH_W1);
#else
    if (IN(PH_W1)) { naive_gemm<EP_HID>(F, XB, F.conv_w1, 2 * DM, F.mix_norm + DM, F.conv_b1, (bf16*)(F.ws + WS_HID), 2 * DM); } SEAM(PH_W1);
    if (IN(PH_GLU)) { naive_glu(F); } SEAM(PH_GLU);
#endif
    if (IN(PH_CONV)) { naive_conv(F); } SEAM(PH_CONV);
#if OPT_GEMM
    if (IN(PH_W2)) { GEMM_PHASE(EpiRes, F.ws + WS_HID2, F.ws + WS_W2, DM, F.out, F.out, XB, (float*)(F.ws + WS_PART), F.conv_b2); } SEAM(PH_W2);
    if (IN(PH_Q1)) { GEMM_PHASE(EpiQ, XB, F.ws + WS_WQ + (size_t)DM * DM * 2, DM, (bf16*)(F.ws + WS_Q), PART); } SEAM(PH_Q1);
#else
    if (IN(PH_W2)) { naive_gemm<EP_RES>(F, (const bf16*)(F.ws + WS_HID2), F.conv_w2, DM, nullptr, F.conv_b2, XB  , DM); } SEAM(PH_W2);
    if (IN(PH_STAT1)) { naive_rowstat(F); } SEAM(PH_STAT1);
    if (IN(PH_Q1)) { naive_gemm<EP_Q>(F, XB, F.peer_wq + (size_t)DM * DM, DM, F.ffn_norm + DM, nullptr, (bf16*)(F.ws + WS_Q), DM); } SEAM(PH_Q1);
#endif
    if (IN(PH_ROUTE1)) { naive_route(F, 1); } SEAM(PH_ROUTE1);
#if OPT_GATHER
    if (IN(PH_GATHER1)) { opt_gather(F, 1, true); }
#else
    if (IN(PH_GATHER1)) { naive_gather(F, 1, true); }
#endif
#undef IN
#undef SEAM
}

extern "C" void kernel_launch(void* const* d_in, const int* in_sizes, int n_in, void* d_out, int out_size, void* d_ws, size_t ws_size, hipStream_t stream) {
    static int grid = 0;
    if (grid == 0) {
        if (n_in != 19 || out_size != T * DM || ws_size < WS_END) { fprintf(stderr, "kernel_launch: unexpected shapes (n_in %d out %d ws %zu)\n", n_in, out_size, ws_size); grid = -1; return; }
        int dev = 0, cus = 0;
        if (hipGetDevice(&dev) != hipSuccess || hipDeviceGetAttribute(&cus, hipDeviceAttributeMultiprocessorCount, dev) != hipSuccess) { grid = -1; return; }
        if (hipFuncSetAttribute((const void*)mega_fwd, hipFuncAttributeMaxDynamicSharedMemorySize, LDS_BYTES) != hipSuccess) { fprintf(stderr, "kernel_launch: hipFuncSetAttribute failed\n"); grid = -1; return; }
        (void)hipGetLastError();
        grid = cus;
    }
    if (grid < 0) return;
    (void)hipMemsetAsync((char*)d_ws + WS_CTL, 0, CTL_ZERO_BYTES, stream);
    Args a{};
    for (int i = 0; i < 19; ++i) a.in[i] = (const float*)d_in[i];
    a.out = (float*)d_out; a.ws = (unsigned char*)d_ws;
#if MK_ONE_LAUNCH
    a.ph_lo = 0; a.ph_hi = PH_COUNT;
    hipLaunchKernelGGL(mega_fwd, dim3(grid), dim3(NTHR), LDS_BYTES, stream, a);
#else
    for (int p = 0; p < PH_COUNT; ++p) { a.ph_lo = p; a.ph_hi = p + 1; hipLaunchKernelGGL(mega_fwd, dim3(grid), dim3(NTHR), LDS_BYTES, stream, a); }
#endif
}
```

```cpp
#include <hip/hip_runtime.h>
#include <cstdio>
#include <cstdint>

#ifndef OPT_GEMM
#define OPT_GEMM 1
#endif
#ifndef OPT_GATHER
#define OPT_GATHER 1
#endif
#ifndef OPT_ROUTE
#define OPT_ROUTE 1
#endif
#ifndef MK_ONE_LAUNCH
#define MK_ONE_LAUNCH 1
#endif

#define GAS __attribute__((address_space(1)))
#define LAS __attribute__((address_space(3)))
#define DI __device__ __forceinline__
typedef unsigned short bf16;
typedef float f32x2 __attribute__((ext_vector_type(2)));
typedef float f32x4 __attribute__((ext_vector_type(4)));
typedef unsigned u32x2 __attribute__((ext_vector_type(2)));
typedef unsigned u32x4 __attribute__((ext_vector_type(4)));

constexpr int NB = 16, SEQ = 2048, DM = 1024, T = NB * SEQ;
constexpr int CHUNK = 64, HD = 64, NHA = 8, NHB = 8, INC = 3584, NCH = SEQ / CHUNK;
constexpr int PH = 8, PK = 128, PE = PK * PK, PQD = 128, PTOP = 16, NSEL = PH * PTOP;
constexpr int CW = 31;
constexpr float EPS = 1e-6f;
constexpr float U8_SCALE = 256.f, V8_SCALE = 16.f;
constexpr int NWAVES = 8, NTHR = NWAVES * 64;

constexpr int C_QA = 0, C_KA = 512, C_VA = 1024, C_QB = 1536, C_KB = 2048, C_VB = 2560, C_GB = 3072;

constexpr size_t MiB = 1u << 20;
constexpr size_t WS_CTL = 0, CTL_ZERO_BYTES = 1 * MiB;
constexpr size_t WS_WIN = 2 * MiB, WS_WOUT = 9 * MiB, WS_W1 = 11 * MiB, WS_W2 = 15 * MiB, WS_WQ = 17 * MiB;
constexpr size_t WS_ROPE = 22 * MiB;
constexpr size_t WS_PART = 23 * MiB;
constexpr size_t WS_EIDX = 26 * MiB;
constexpr size_t WS_GATE = 42 * MiB;
constexpr size_t WS_U8 = 64 * MiB, WS_V8 = 96 * MiB;
constexpr size_t WS_XB = 128 * MiB;
constexpr size_t WS_R = 192 * MiB;
constexpr size_t WS_O = 416 * MiB;
constexpr size_t WS_Q = 192 * MiB;
constexpr size_t WS_HID = 256 * MiB;
constexpr size_t WS_GLU = 384 * MiB;
constexpr size_t WS_HID2 = 448 * MiB;
constexpr size_t WS_END = 512 * MiB;
constexpr int CW_BAR = 4096;

constexpr int RING_BYTES = 131072, LDSCTL_OFF = RING_BYTES, MISC_OFF = LDSCTL_OFF + 320, LDS_BYTES = 147456;

DI float bf2f(bf16 v) { return __uint_as_float(((unsigned)v) << 16); }
DI unsigned f2bf(float f) { unsigned u = __float_as_uint(f); return (u + 0x7fffu + ((u >> 16) & 1u)) >> 16; }
DI unsigned pk2(float lo, float hi) { return f2bf(lo) | (f2bf(hi) << 16); }
DI float wave_sum(float v) {
#pragma unroll
    for (int o = 1; o < 64; o <<= 1) v += __shfl_xor(v, o);
    return v;
}
DI float wave_max(float v) {
#pragma unroll
    for (int o = 1; o < 64; o <<= 1) v = fmaxf(v, __shfl_xor(v, o));
    return v;
}
DI float block_sum(float v, LAS float* red, int tid) {
    v = wave_sum(v);
    __syncthreads();
    if ((tid & 63) == 0) red[tid >> 6] = v;
    __syncthreads();
    float s = 0.f;
#pragma unroll
    for (int i = 0; i < NWAVES; ++i) s += red[i];
    return s;
}
DI float gelu_erf(float x) { return 0.5f * x * (1.f + erff(x * 0.70710678118654752f)); }
DI float sigmoidf(float x) { return 1.f / (1.f + __expf(-x)); }

DI int lane_id() { return (int)__builtin_amdgcn_mbcnt_hi(~0u, __builtin_amdgcn_mbcnt_lo(~0u, 0u)); }
#define XB_TMO      128
#define XB_XCNT(j)  (256  + 64 * (j))
#define XB_XSUB(j)  (1280 + 64 * (j))
#define XB_XGEN(j)  (2304 + 64 * (j))
#define XB_TOP      3328
#define XB_TOPGEN   3392
#define XCD_BAR_WORDS 3456
#define XB_SPIN_CAP (1u << 22)
DI unsigned xb_ld(unsigned* p)              { return __hip_atomic_load(p, __ATOMIC_RELAXED, __HIP_MEMORY_SCOPE_AGENT); }
DI unsigned xb_add(unsigned* p, unsigned v) { return __hip_atomic_fetch_add(p, v, __ATOMIC_RELAXED, __HIP_MEMORY_SCOPE_AGENT); }
DI unsigned xb_xcc_id() { return (unsigned)__builtin_amdgcn_s_getreg((3 << 11) | 20) & 0xFu; }
#define XB_SPIN(cond, bar) do { unsigned _sp = 0; while (cond) { __builtin_amdgcn_s_sleep(1); \
    if ((++_sp & 255u) == 0u) { if (xb_ld(&(bar)[XB_TMO])) break; if (_sp > XB_SPIN_CAP) { atomicAdd(&(bar)[XB_TMO], 1u); break; } } } } while (0)
struct XcdBarrier { unsigned* bar; unsigned x; volatile LAS unsigned* st; };
DI XcdBarrier xcd_barrier_post(unsigned* bar, volatile LAS unsigned* st) {
    XcdBarrier b; b.bar = bar; b.x = xb_xcc_id(); b.st = st;
    if (threadIdx.x == 0) (void)xb_add(&bar[XB_XCNT(b.x)], 1u);
    return b;
}
DI void xcd_barrier_complete(unsigned* bar, unsigned x, unsigned& nloc, unsigned& nx) {
    const unsigned G = gridDim.x * gridDim.y * gridDim.z;
    unsigned sum, cnt, mine, sp = 0u;
    for (;;) {
        sum = 0u; cnt = 0u; mine = 0u;
#pragma unroll
        for (unsigned j = 0; j < 16; ++j) { const unsigned c = xb_ld(&bar[XB_XCNT(j)]); sum += c; cnt += (c > 0u) ? 1u : 0u; mine = (j == x) ? c : mine; }
        if (sum == G) break;
        __builtin_amdgcn_s_sleep(1);
        if ((++sp & 255u) == 0u) { if (xb_ld(&bar[XB_TMO])) break; if (sp > XB_SPIN_CAP) { atomicAdd(&bar[XB_TMO], 1u); break; } }
    }
    nloc = mine > 0u ? mine : 1u; nx = cnt > 0u ? cnt : 1u;
}
DI void xcd_barrier(const XcdBarrier& b, const int wave_id) {
    asm volatile("s_waitcnt vmcnt(0)" ::: "memory");
    __syncthreads();
    if (wave_id == 0 && lane_id() == 0) {
        unsigned* bar = b.bar;
        __builtin_amdgcn_s_waitcnt(0);
        unsigned nloc = b.st[0], nx = b.st[1];
        if (nloc == 0u) { xcd_barrier_complete(bar, b.x, nloc, nx); b.st[0] = nloc; b.st[1] = nx; }
        const unsigned old = xb_add(&bar[XB_XSUB(b.x)], 1u);
        const unsigned gen = old / nloc;
        if (old + 1u == (gen + 1u) * nloc) {
            __builtin_amdgcn_fence(__ATOMIC_RELEASE, "agent");
            asm volatile("s_waitcnt vmcnt(0)" ::: "memory");
            const unsigned og = xb_add(&bar[XB_TOP], 1u);
            const unsigned tg = og / nx;
            if (og + 1u == (tg + 1u) * nx) xb_add(&bar[XB_TOPGEN], 1u);
            else XB_SPIN(xb_ld(&bar[XB_TOPGEN]) == tg, bar);
            __builtin_amdgcn_fence(__ATOMIC_ACQUIRE, "agent");
            xb_add(&bar[XB_XGEN(b.x)], 1u);
            asm volatile("s_waitcnt vmcnt(0)" ::: "memory");
        } else {
            XB_SPIN(xb_ld(&bar[XB_XGEN(b.x)]) == gen, bar);
            __builtin_amdgcn_fence(__ATOMIC_ACQUIRE, "agent");
            asm volatile("s_waitcnt vmcnt(0)" ::: "memory");
        }
    }
    __syncthreads();
}

namespace pg8 {
#define PG8_LAS __attribute__((address_space(3)))
typedef unsigned short bf16_t;
typedef short bf16x8 __attribute__((ext_vector_type(8)));
typedef float f32x4 __attribute__((ext_vector_type(4)));
typedef unsigned u32x4 __attribute__((ext_vector_type(4)));
constexpr int BM = 256, BK = 64, HALF = 128, HTB = HALF * BK * 2  , STAGE_BYTES = 8 * HTB, NXCD = 8, WGM = 8;

__host__ __device__ __forceinline__ int lds_byte(int r, int c) { const int st = (r >> 4) * 2 + (c >> 5), rr = r & 15, cc = c & 31, ob = rr * 64 + cc * 2; return st * 1024 + (ob ^ (((ob >> 9) & 1) << 5)); }
__host__ __device__ __forceinline__ void stage_rc(int b, int& R, int& C) { const int st = b / 1024, sb = b % 1024, swz = sb ^ (((sb >> 9) & 1) << 5); R = (st >> 1) * 16 + swz / 64; C = (st & 1) * 32 + (swz % 64) / 2; }
__host__ __device__ __forceinline__ int perm32(int rho) { const int n = rho >> 4, i = rho & 15; return 8 * (i >> 2) + 4 * n + (i & 3); }

struct Unit { int pm, pn; };
struct Gemm { const bf16_t* A; const bf16_t* Bt; int M, N, K; };

struct StaticOrder {
    int nM, nN, nwg, G, c;
    __host__ __device__ void init(int M, int N, int G_, int c_) { nM = M / BM; nN = N / BM; nwg = nM * nN; G = G_; c = c_; }
    __host__ __device__ bool next(int i, Unit& u) const {
        const long L = (long)i * G + c; if (L >= nwg) return false;
        int wgid = (int)L; { const int q = nwg / NXCD, r = nwg % NXCD, xcd = wgid % NXCD, off = wgid / NXCD; wgid = (xcd < r ? xcd * (q + 1) : r * (q + 1) + (xcd - r) * q) + off; }
        const int nig = WGM * nN, gid = wgid / nig, fm = gid * WGM, gsz = (nM - fm) < WGM ? (nM - fm) : WGM;
        u.pm = fm + ((wgid % nig) % gsz); u.pn = (wgid % nig) / gsz; return true;
    }
    __device__ __forceinline__ void a_ready(const Unit&) const {}
    __device__ __forceinline__ void done(const Unit&) const {}
};

__device__ __forceinline__ unsigned cvt_pk_bf16(float lo, float hi) { unsigned r; asm volatile("v_cvt_pk_bf16_f32 %0, %1, %2" : "=v"(r) : "v"(lo), "v"(hi)); return r; }
__device__ __forceinline__ float rstd16(const float* part, int r) {
    const f32x4* p = (const f32x4*)(part + (size_t)r * 16);
    const f32x4 a = p[0], b = p[1], c = p[2], d = p[3];
    const float s = ((a[0] + a[1]) + (a[2] + a[3])) + ((b[0] + b[1]) + (b[2] + b[3])) + ((c[0] + c[1]) + (c[2] + c[3])) + ((d[0] + d[1]) + (d[2] + d[3]));
    return 1.f / sqrtf(s * (1.f / 1024.f) + 1e-6f);
}
__device__ __forceinline__ u32x4 pack8(const f32x4 a, const f32x4 b) { u32x4 w; w.x = cvt_pk_bf16(a[0], a[1]); w.y = cvt_pk_bf16(a[2], a[3]); w.z = cvt_pk_bf16(b[0], b[1]); w.w = cvt_pk_bf16(b[2], b[3]); return w; }
#define rot(t1, t2, c, s) do { const float a_ = (t1) * (c) - (t2) * (s), b_ = (t1) * (s) + (t2) * (c); (t1) = a_; (t2) = b_; } while (0)

struct EpiProj {
    static constexpr bool PERM = true, AFTER_DRAIN = false;
    bf16_t* R; const float* part; const float* rope;
    __device__ __forceinline__ void operator()(const f32x4 (&acc)[2][2][4][2], const Unit& u, int wr, int wc, int fr, int fq) const {
        const int type = u.pn >> 1, hg = u.pn & 1;
        const int colbase = type * 512 + (4 * hg + wc) * 64 + 8 * fq;
        const bool do_rope = (type == 3) || (type == 4);
#pragma unroll
        for (int ai = 0; ai < 2; ++ai)
#pragma unroll
            for (int m = 0; m < 4; ++m) {
                const int r = u.pm * BM + ai * HALF + wr * 64 + m * 16 + fr;
                const float rs = rstd16(part, r);
                f32x4 a0 = acc[ai][0][m][0] * rs, a1 = acc[ai][0][m][1] * rs, b0 = acc[ai][1][m][0] * rs, b1 = acc[ai][1][m][1] * rs;
                if (do_rope) {
                    const f32x4* rp = (const f32x4*)(rope + ((size_t)(r & 2047) * 32 + 8 * fq) * 2);
                    const f32x4 c0 = rp[0], c1 = rp[1], c2 = rp[2], c3 = rp[3];
                    rot(a0[0], b0[0], c0[0], c0[1]); rot(a0[1], b0[1], c0[2], c0[3]); rot(a0[2], b0[2], c1[0], c1[1]); rot(a0[3], b0[3], c1[2], c1[3]);
                    rot(a1[0], b1[0], c2[0], c2[1]); rot(a1[1], b1[1], c2[2], c2[3]); rot(a1[2], b1[2], c3[0], c3[1]); rot(a1[3], b1[3], c3[2], c3[3]);
                }
                bf16_t* rowp = R + (size_t)r * 3584 + colbase;
                *(u32x4*)(rowp) = pack8(a0, a1);
                *(u32x4*)(rowp + 32) = pack8(b0, b1);
            }
    }
};
struct EpiRes {
    static constexpr bool PERM = true, AFTER_DRAIN = false;
    const float* base; float* out; bf16_t* hb; float* part; const float* bias;
    __device__ __forceinline__ void operator()(const f32x4 (&acc)[2][2][4][2], const Unit& u, int wr, int wc, int fr, int fq) const {
        const int col0 = u.pn * BM + wc * 32 + 8 * fq;
        f32x4 bv[2][2];
#pragma unroll
        for (int bj = 0; bj < 2; ++bj)
#pragma unroll
            for (int n = 0; n < 2; ++n) bv[bj][n] = bias ? *(const f32x4*)(bias + col0 + bj * HALF + 4 * n) : (f32x4){0.f, 0.f, 0.f, 0.f};
#pragma unroll
        for (int ai = 0; ai < 2; ++ai)
#pragma unroll
            for (int m = 0; m < 4; ++m) {
                const int r = u.pm * BM + ai * HALF + wr * 64 + m * 16 + fr;
                const size_t off = (size_t)r * 1024 + col0;
                float ss = 0.f;
#pragma unroll
                for (int bj = 0; bj < 2; ++bj) {
                    const f32x4 x0 = *(const f32x4*)(base + off + bj * HALF), x1 = *(const f32x4*)(base + off + bj * HALF + 4);
                    const f32x4 h0 = x0 + acc[ai][bj][m][0] + bv[bj][0], h1 = x1 + acc[ai][bj][m][1] + bv[bj][1];
                    *(f32x4*)(out + off + bj * HALF) = h0; *(f32x4*)(out + off + bj * HALF + 4) = h1;
                    *(u32x4*)(hb + off + bj * HALF) = pack8(h0, h1);
                    ss += (h0[0] * h0[0] + h0[1] * h0[1]) + (h0[2] * h0[2] + h0[3] * h0[3]) + (h1[0] * h1[0] + h1[1] * h1[1]) + (h1[2] * h1[2] + h1[3] * h1[3]);
                }
                ss += __shfl_xor(ss, 16); ss += __shfl_xor(ss, 32);
                if (fq == 0) part[(size_t)r * 16 + 4 * u.pn + wc] = ss;
            }
    }
};
struct EpiQ {
    static constexpr bool PERM = true, AFTER_DRAIN = false;
    bf16_t* O; const float* part;
    __device__ __forceinline__ void operator()(const f32x4 (&acc)[2][2][4][2], const Unit& u, int wr, int wc, int fr, int fq) const {
        const int col0 = u.pn * BM + wc * 32 + 8 * fq;
#pragma unroll
        for (int ai = 0; ai < 2; ++ai)
#pragma unroll
            for (int m = 0; m < 4; ++m) {
                const int r = u.pm * BM + ai * HALF + wr * 64 + m * 16 + fr;
                const float rs = rstd16(part, r);
                bf16_t* rowp = O + (size_t)r * 1024 + col0;
#pragma unroll
                for (int bj = 0; bj < 2; ++bj) *(u32x4*)(rowp + bj * HALF) = pack8(acc[ai][bj][m][0] * rs, acc[ai][bj][m][1] * rs);
            }
    }
};
struct EpiGlu {
    static constexpr bool PERM = true, AFTER_DRAIN = false;
    bf16_t* G; const float* part; const float* b1;
    __device__ __forceinline__ void operator()(const f32x4 (&acc)[2][2][4][2], const Unit& u, int wr, int wc, int fr, int fq) const {
        const int col = u.pn * 128 + wc * 32 + 8 * fq;
        f32x4 ba[2], bg[2];
#pragma unroll
        for (int n = 0; n < 2; ++n) { ba[n] = *(const f32x4*)(b1 + col + 4 * n); bg[n] = *(const f32x4*)(b1 + 1024 + col + 4 * n); }
#pragma unroll
        for (int ai = 0; ai < 2; ++ai)
#pragma unroll
            for (int m = 0; m < 4; ++m) {
                const int r = u.pm * BM + ai * HALF + wr * 64 + m * 16 + fr;
                const float rs = rstd16(part, r);
                f32x4 y[2];
#pragma unroll
                for (int n = 0; n < 2; ++n) {
                    const f32x4 a = acc[ai][0][m][n] * rs + ba[n], g = acc[ai][1][m][n] * rs + bg[n];
#pragma unroll
                    for (int i = 0; i < 4; ++i) y[n][i] = a[i] / (1.f + __expf(-g[i]));
                }
                *(u32x4*)(G + (size_t)r * 1024 + col) = pack8(y[0], y[1]);
            }
    }
};
template <class Epi, class Sched, bool ALIGN_EPI = false, bool SP2 = false>
__device__ __forceinline__ void gemm_phase(PG8_LAS unsigned char* lds, const Gemm g, const Sched& S, const Epi& E, const int wave_id) {
    const int lane = (int)__builtin_amdgcn_mbcnt_hi(~0u, __builtin_amdgcn_mbcnt_lo(~0u, 0u)), wid = wave_id, tid = wid * 64 + lane, wr = wid >> 2, wc = wid & 3, fr = lane & 15, fq = lane >> 4;
    const int K = g.K, nt = K / BK;
    unsigned voffA[2], voffB[2];
#pragma unroll
    for (int i = 0; i < 2; ++i) { int R, C; stage_rc(tid * 16 + i * 8192, R, C); const int Rb = Epi::PERM ? ((R & ~31) + perm32(R & 31)) : R;
        voffA[i] = (unsigned)(R * K + C) * 2u; voffB[i] = (unsigned)(Rb * K + C) * 2u; }
    const size_t kstep = (size_t)(BK * 2);
    const size_t hstep = (size_t)HALF * K * 2;
    const size_t tstep = 2 * hstep;
    const unsigned ldsw = (unsigned)wid * 1024u;
    const int aoff = lds_byte(wr * 64 + fr, fq * 8), boff = lds_byte(wc * 32 + fr, fq * 8);
#define PG8_SA(b, h) (((b) * 2 + (h)) * HTB)
#define PG8_SB(b, h) ((4 + (b) * 2 + (h)) * HTB)
#define PG8_STAGE(bufoff, gbase, voff) do { _Pragma("unroll") for (int _i = 0; _i < 2; ++_i) \
        __builtin_amdgcn_global_load_lds((const unsigned*)((const char*)(gbase) + (voff)[_i]), (PG8_LAS unsigned*)(lds + (bufoff) + ldsw + _i * 8192), 16, 0, 0); } while (0)
#define PG8_LDA(dst, b, h) do { _Pragma("unroll") for (int m = 0; m < 4; ++m) _Pragma("unroll") for (int k = 0; k < 2; ++k) dst[m][k] = *(const PG8_LAS bf16x8*)(lds + PG8_SA(b, h) + aoff + m * 2048 + k * 1024); } while (0)
#define PG8_LDB(dst, b, h) do { _Pragma("unroll") for (int n = 0; n < 2; ++n) _Pragma("unroll") for (int k = 0; k < 2; ++k) dst[n][k] = *(const PG8_LAS bf16x8*)(lds + PG8_SB(b, h) + boff + n * 2048 + k * 1024); } while (0)
#define PG8_MMA(ai, bj, At, Bt) do { __builtin_amdgcn_s_setprio(1); _Pragma("unroll") for (int m = 0; m < 4; ++m) _Pragma("unroll") for (int n = 0; n < 2; ++n) _Pragma("unroll") for (int k = 0; k < 2; ++k) \
        acc[ai][bj][m][n] = __builtin_amdgcn_mfma_f32_16x16x32_bf16(Bt[n][k], At[m][k], acc[ai][bj][m][n], 0, 0, 0); __builtin_amdgcn_s_setprio(0); } while (0)
#define PG8_WAIT_V(n) asm volatile("s_waitcnt vmcnt(" #n ")" ::: "memory")
#define PG8_WAIT_L(n) asm volatile("s_waitcnt lgkmcnt(" #n ")" ::: "memory")
#define PG8_BAR __builtin_amdgcn_s_barrier()
#define PG8_SCHED __builtin_amdgcn_sched_barrier(0)
    Unit cur, nxt; int ui = 0;
    if (!S.next(0, cur)) return;
    f32x4 acc[2][2][4][2];
#pragma unroll
    for (int a = 0; a < 2; ++a)
#pragma unroll
        for (int b = 0; b < 2; ++b)
#pragma unroll
            for (int m = 0; m < 4; ++m)
#pragma unroll
                for (int n = 0; n < 2; ++n) acc[a][b][m][n] = (f32x4){0.f, 0.f, 0.f, 0.f};
    bf16x8 At[4][2], B0[2][2], B1[2][2];
    const char* cA = (const char*)g.A + (size_t)cur.pm * tstep; const char* cB = (const char*)g.Bt + (size_t)cur.pn * tstep;
    S.a_ready(cur);
    if constexpr (SP2) {
        PG8_STAGE(PG8_SB(0, 0), cB, voffB); PG8_STAGE(PG8_SB(0, 1), cB + hstep, voffB); PG8_STAGE(PG8_SA(0, 0), cA, voffA); PG8_STAGE(PG8_SA(0, 1), cA + hstep, voffA);
        if (wr == 1) PG8_BAR;
        PG8_WAIT_V(2); PG8_BAR;
        PG8_STAGE(PG8_SB(1, 0), cB + kstep, voffB); PG8_STAGE(PG8_SA(1, 0), cA + kstep, voffA); PG8_STAGE(PG8_SB(1, 1), cB + hstep + kstep, voffB);
        PG8_WAIT_V(6); PG8_BAR;
    } else {
        PG8_STAGE(PG8_SB(0, 0), cB, voffB); PG8_STAGE(PG8_SA(0, 0), cA, voffA); PG8_STAGE(PG8_SB(0, 1), cB + hstep, voffB); PG8_STAGE(PG8_SA(0, 1), cA + hstep, voffA);
        if (wr == 1) PG8_BAR;
        PG8_WAIT_V(4); PG8_BAR;
        PG8_STAGE(PG8_SB(1, 0), cB + kstep, voffB); PG8_STAGE(PG8_SA(1, 0), cA + kstep, voffA); PG8_STAGE(PG8_SB(1, 1), cB + hstep + kstep, voffB);
        PG8_WAIT_V(6); PG8_BAR;
    }
    for (;;) {
        const bool has_next = S.next(ui + 1, nxt);
        const char* nA = has_next ? (const char*)g.A + (size_t)nxt.pm * tstep : cA; const char* nB = has_next ? (const char*)g.Bt + (size_t)nxt.pn * tstep : cB;
        for (int t = 0; t < nt; t += 2) {
            const bool last = (t == nt - 2);
            const char* a1 = cA + (size_t)(t + 1) * kstep;
            const char* a2 = last ? nA : cA + (size_t)(t + 2) * kstep; const char* b2 = last ? nB : cB + (size_t)(t + 2) * kstep;
            const char* a3 = a2 + kstep; const char* b3 = b2 + kstep;
            if (last && has_next) S.a_ready(nxt);
            if constexpr (SP2) {
            PG8_LDB(B0, 0, 0); PG8_LDB(B1, 0, 1); PG8_SCHED; PG8_LDA(At, 0, 0); PG8_STAGE(PG8_SA(1, 1), a1 + hstep, voffA);
            PG8_WAIT_V(8); PG8_WAIT_L(0); PG8_BAR; PG8_MMA(0, 0, At, B0); PG8_MMA(0, 1, At, B1); PG8_BAR; PG8_SCHED;
            PG8_LDA(At, 0, 1); PG8_STAGE(PG8_SB(0, 0), b2, voffB); PG8_STAGE(PG8_SB(0, 1), b2 + hstep, voffB); PG8_STAGE(PG8_SA(0, 0), a2, voffA);
            PG8_WAIT_V(8); PG8_WAIT_L(0); PG8_BAR; PG8_MMA(1, 0, At, B0); PG8_MMA(1, 1, At, B1); PG8_BAR; PG8_SCHED;
            PG8_LDB(B0, 1, 0); PG8_LDB(B1, 1, 1); PG8_SCHED; PG8_LDA(At, 1, 0); PG8_STAGE(PG8_SA(0, 1), a2 + hstep, voffA);
            PG8_WAIT_V(8); PG8_WAIT_L(0); PG8_BAR; PG8_MMA(0, 0, At, B0); PG8_MMA(0, 1, At, B1); PG8_BAR; PG8_SCHED;
            PG8_LDA(At, 1, 1); PG8_STAGE(PG8_SB(1, 0), b3, voffB); PG8_STAGE(PG8_SB(1, 1), b3 + hstep, voffB); PG8_STAGE(PG8_SA(1, 0), a3, voffA);
            PG8_WAIT_V(8); PG8_WAIT_L(0); PG8_BAR; PG8_MMA(1, 0, At, B0); PG8_MMA(1, 1, At, B1); PG8_BAR; PG8_SCHED;
            } else {
            PG8_LDB(B0, 0, 0); PG8_SCHED; PG8_LDA(At, 0, 0); PG8_STAGE(PG8_SA(1, 1), a1 + hstep, voffA);
            PG8_WAIT_L(8); PG8_BAR; PG8_WAIT_L(0); PG8_MMA(0, 0, At, B0); PG8_BAR; PG8_SCHED;
            PG8_LDB(B1, 0, 1); PG8_STAGE(PG8_SB(0, 0), b2, voffB);
            PG8_BAR; PG8_WAIT_L(0); PG8_MMA(0, 1, At, B1); PG8_BAR;
            PG8_LDA(At, 0, 1); PG8_STAGE(PG8_SA(0, 0), a2, voffA);
            PG8_BAR; PG8_WAIT_L(0); PG8_MMA(1, 0, At, B0); PG8_BAR; PG8_SCHED;
            PG8_STAGE(PG8_SB(0, 1), b2 + hstep, voffB);
            PG8_WAIT_V(6); PG8_BAR; PG8_MMA(1, 1, At, B1); PG8_BAR;
            PG8_LDB(B0, 1, 0); PG8_SCHED; PG8_LDA(At, 1, 0); PG8_STAGE(PG8_SA(0, 1), a2 + hstep, voffA);
            PG8_WAIT_L(8); PG8_BAR; PG8_WAIT_L(0); PG8_MMA(0, 0, At, B0); PG8_BAR; PG8_SCHED;
            PG8_LDB(B1, 1, 1); PG8_STAGE(PG8_SB(1, 0), b3, voffB);
            PG8_BAR; PG8_WAIT_L(0); PG8_MMA(0, 1, At, B1); PG8_BAR;
            PG8_LDA(At, 1, 1); PG8_STAGE(PG8_SA(1, 0), a3, voffA);
            PG8_BAR; PG8_WAIT_L(0); PG8_MMA(1, 0, At, B0); PG8_BAR; PG8_SCHED;
            PG8_STAGE(PG8_SB(1, 1), b3 + hstep, voffB);
            PG8_WAIT_V(6); PG8_BAR; PG8_MMA(1, 1, At, B1); PG8_BAR;
            }
        }
        if constexpr (ALIGN_EPI) { if (wr == 0) PG8_BAR; }
        if constexpr (!Epi::AFTER_DRAIN) { E(acc, cur, wr, wc, fr, fq); S.done(cur); }
        if (!has_next) break;
#pragma unroll
        for (int a = 0; a < 2; ++a)
#pragma unroll
            for (int b = 0; b < 2; ++b)
#pragma unroll
                for (int m = 0; m < 4; ++m)
#pragma unroll
                    for (int n = 0; n < 2; ++n) acc[a][b][m][n] = (f32x4){0.f, 0.f, 0.f, 0.f};
        cur = nxt; cA = nA; cB = nB; ++ui;
        if constexpr (ALIGN_EPI) { if (wr == 1) PG8_BAR; }
    }
    PG8_WAIT_V(0);
    if constexpr (!ALIGN_EPI) { if (wr == 0) PG8_BAR; }
    PG8_BAR;
    if constexpr (Epi::AFTER_DRAIN) { E.fused(acc, cur, wr, wc, fr, fq, lds, wid, lane); S.done(cur); }
#undef PG8_SA
#undef PG8_SB
#undef PG8_STAGE
#undef PG8_LDA
#undef PG8_LDB
#undef PG8_MMA
#undef PG8_WAIT_V
#undef PG8_WAIT_L
#undef PG8_BAR
#undef PG8_SCHED
}
}

struct Frame {
    LAS unsigned char* lds;
    int wave, G, bid;
    const float *x, *mix_norm, *ffn_norm, *final_norm, *w_in, *w_out, *rel_bias, *conv_w1, *conv_b1, *conv_dw, *conv_dw_b, *conv_ln_g, *conv_ln_b, *conv_w2, *conv_b2,
        *peer_wq, *peer_keys, *peer_u, *peer_v;
    float* out;
    unsigned char* ws;
};
#define FRAME_IDS const int f_lane = lane_id(); const int f_tid = F.wave * 64 + f_lane; (void)f_tid
DI float gamma_of(int h) { return 1.f - exp2f(-5.f - (float)h); }

DI void p0_prep(Frame& F) {
    FRAME_IDS;
    const int gw = F.bid * NWAVES + F.wave, NGW = F.G * NWAVES;
    f32x2* rope = (f32x2*)(F.ws + WS_ROPE);
    for (int i = F.bid * NTHR + f_tid; i < SEQ * 32; i += F.G * NTHR) {
        const int s = i >> 5, j = i & 31;
        const float inv = powf(10000.f, -(float)j / 32.f);
        const float ang = (float)s * inv;
        float sn, cs; sincosf(ang, &sn, &cs);
        rope[i] = (f32x2){cs, sn};
    }
    bf16* xb = (bf16*)(F.ws + WS_XB); float* part = (float*)(F.ws + WS_PART);
    for (int m = gw; m < T; m += NGW) {
        const f32x4* xr = (const f32x4*)(F.x + (size_t)m * DM) + f_lane;
        u32x2* o = (u32x2*)(xb + (size_t)m * DM) + f_lane;
        float s = 0.f;
#pragma unroll
        for (int j = 0; j < 4; ++j) { const f32x4 v = xr[64 * j]; s += v.x * v.x + v.y * v.y + v.z * v.z + v.w * v.w; o[64 * j] = (u32x2){pk2(v.x, v.y), pk2(v.z, v.w)}; }
        s = wave_sum(s);
        if (f_lane < 16) part[(size_t)m * 16 + f_lane] = (f_lane == 0) ? s : 0.f;
    }
}
DI void p0_transpose_item(const float* W, int K, int N, bf16* WT, int prow0, const float* gain, float scale, LAS float* scr, int k0, int n0, int lane) {
#pragma unroll 8
    for (int i = 0; i < 32; ++i) { const int kk = 2 * i + (lane >> 5); scr[kk * 33 + (lane & 31)] = W[(size_t)(k0 + kk) * N + n0 + (lane & 31)] * (gain ? gain[k0 + kk] : 1.f) * scale; }
    asm volatile("s_waitcnt lgkmcnt(0)" ::: "memory");
    const int c = lane & 7;
#pragma unroll
    for (int j = 0; j < 4; ++j) { const int n = (lane >> 3) + 8 * j; const LAS float* q = scr + (8 * c) * 33 + n;
        u32x4 o; o.x = pk2(q[0 * 33], q[1 * 33]); o.y = pk2(q[2 * 33], q[3 * 33]); o.z = pk2(q[4 * 33], q[5 * 33]); o.w = pk2(q[6 * 33], q[7 * 33]);
        *(u32x4*)(WT + (size_t)(prow0 + n) * K + k0 + 8 * c) = o; }
    asm volatile("s_waitcnt lgkmcnt(0)" ::: "memory");
}
DI void p0_weights(Frame& F) {
    FRAME_IDS;
    LAS float* scr = (LAS float*)(F.lds + F.wave * 16384);
    const int gw = F.bid * NWAVES + F.wave, NGW = F.G * NWAVES;
    constexpr int I_IN = 16 * (INC / 32), I_SQ = 16 * (DM / 32), I_W1 = 16 * (2 * DM / 32);
    constexpr int NITEMS = I_IN + I_SQ + I_W1 + I_SQ + 2 * I_SQ;
    for (int it = gw; it < NITEMS; it += NGW) {
        int r = it;
        if (r < I_IN) { const int nb = r % (INC / 32), kb = r / (INC / 32), n0 = nb * 32;
            const int type = n0 / 512, head = (n0 % 512) / 64, bj = (n0 % 64) / 32;
            const int prow0 = 256 * (2 * type + head / 4) + 128 * bj + 32 * (head % 4);
            p0_transpose_item(F.w_in, DM, INC, (bf16*)(F.ws + WS_WIN), prow0, F.mix_norm, (type == 0 || type == 4) ? 0.125f : 1.f, scr, kb * 64, n0, f_lane); continue; }
        r -= I_IN;
        if (r < I_SQ) { const int nb = r % 32, kb = r / 32; p0_transpose_item(F.w_out, DM, DM, (bf16*)(F.ws + WS_WOUT), nb * 32, nullptr, 1.f, scr, kb * 64, nb * 32, f_lane); continue; }
        r -= I_SQ;
        if (r < I_W1) { const int nb = r % 64, kb = r / 64, n0 = nb * 32; const int bj = n0 / 1024, rem = n0 % 1024;
            p0_transpose_item(F.conv_w1, DM, 2 * DM, (bf16*)(F.ws + WS_W1), 256 * (rem / 128) + 128 * bj + (rem % 128), F.mix_norm + DM, 1.f, scr, kb * 64, n0, f_lane); continue; }
        r -= I_W1;
        if (r < I_SQ) { const int nb = r % 32, kb = r / 32; p0_transpose_item(F.conv_w2, DM, DM, (bf16*)(F.ws + WS_W2), nb * 32, nullptr, 1.f, scr, kb * 64, nb * 32, f_lane); continue; }
        r -= I_SQ;
        { const int layer = r / I_SQ; r %= I_SQ; const int nb = r % 32, kb = r / 32;
          p0_transpose_item(F.peer_wq + (size_t)layer * DM * DM, DM, DM, (bf16*)(F.ws + WS_WQ) + (size_t)layer * DM * DM, nb * 32, F.ffn_norm + layer * DM, 1.f, scr, kb * 64, nb * 32, f_lane); }
    }
}
DI float row_rstd(const float* part, int m) {
    const f32x4* p = (const f32x4*)(part + (size_t)m * 16);
    const f32x4 a = p[0], b = p[1], c = p[2], d = p[3];
    const float s = ((a.x + a.y) + (a.z + a.w)) + ((b.x + b.y) + (b.z + b.w)) + ((c.x + c.y) + (c.z + c.w)) + ((d.x + d.y) + (d.z + d.w));
    return 1.f / sqrtf(s * (1.f / DM) + EPS);
}

enum { EP_PROJ = 0, EP_RES = 1, EP_Q = 2, EP_HID = 3 };
template <int EP>
DI void naive_gemm(Frame& F, const bf16* A, const float* W, int N, const float* gain, const float* bias, bf16* Ob, int ldo) {
    FRAME_IDS;
    LAS float* As = (LAS float*)F.lds;
    LAS float* Bs = As + 16 * 129;
    LAS float* rs = Bs + 16 * 64;
    const float* part = (const float*)(F.ws + WS_PART);
    const f32x2* rope = (const f32x2*)(F.ws + WS_ROPE);
    bf16* hb = (bf16*)(F.ws + WS_XB);
    const int tid = f_tid, tx = tid & 15, ty = tid >> 4;
    const int nN = N / 64, nItems = (T / 128) * nN;
    for (int it = F.bid; it < nItems; it += F.G) {
        const int m0 = (it / nN) * 128, n0 = (it % nN) * 64;
        __syncthreads();
        if (EP != EP_RES) { if (tid < 128) rs[tid] = row_rstd(part, m0 + tid); }
        float acc[4][4];
#pragma unroll
        for (int i = 0; i < 4; ++i)
#pragma unroll
            for (int j = 0; j < 4; ++j) acc[i][j] = 0.f;
        for (int k0 = 0; k0 < DM; k0 += 16) {
            {   const int r = tid >> 2, kk = (tid & 3) * 4;
                const u32x2 v = *(const u32x2*)(A + (size_t)(m0 + r) * DM + k0 + kk);
                As[(kk + 0) * 129 + r] = __uint_as_float(v.x << 16); As[(kk + 1) * 129 + r] = __uint_as_float(v.x & 0xffff0000u);
                As[(kk + 2) * 129 + r] = __uint_as_float(v.y << 16); As[(kk + 3) * 129 + r] = __uint_as_float(v.y & 0xffff0000u); }
            {   const int kk = tid >> 5, c = (tid & 31) * 2;
                const f32x2 v = *(const f32x2*)(W + (size_t)(k0 + kk) * N + n0 + c);
                const float g = gain ? gain[k0 + kk] : 1.f;
                Bs[kk * 64 + c] = v.x * g; Bs[kk * 64 + c + 1] = v.y * g; }
            __syncthreads();
#pragma unroll
            for (int kk = 0; kk < 16; ++kk) {
                float a[4], b[4];
#pragma unroll
                for (int i = 0; i < 4; ++i) a[i] = As[kk * 129 + ty * 4 + i];
                b[0] = Bs[kk * 64 + 2 * tx]; b[1] = Bs[kk * 64 + 2 * tx + 1]; b[2] = Bs[kk * 64 + 32 + 2 * tx]; b[3] = Bs[kk * 64 + 33 + 2 * tx];
#pragma unroll
                for (int i = 0; i < 4; ++i)
#pragma unroll
                    for (int j = 0; j < 4; ++j) acc[i][j] += a[i] * b[j];
            }
            __syncthreads();
        }
#pragma unroll
        for (int i = 0; i < 4; ++i) {
            const int m = m0 + ty * 4 + i;
            const int cols[4] = {n0 + 2 * tx, n0 + 2 * tx + 1, n0 + 32 + 2 * tx, n0 + 33 + 2 * tx};
            float v[4] = {acc[i][0], acc[i][1], acc[i][2], acc[i][3]};
            if (EP == EP_PROJ) {
                const float r = rs[ty * 4 + i];
#pragma unroll
                for (int j = 0; j < 4; ++j) v[j] *= r;
                const int type = n0 / 512;
                if (type == 3 || type == 4) {
                    const int s = m % SEQ;
#pragma unroll
                    for (int j = 0; j < 2; ++j) {
                        const f32x2 cs = rope[s * 32 + 2 * tx + j];
                        const float t1 = v[j], t2 = v[j + 2];
                        v[j] = t1 * cs.x - t2 * cs.y; v[j + 2] = t1 * cs.y + t2 * cs.x;
                    }
                }
                if (type == 0 || type == 4) {
#pragma unroll
                    for (int j = 0; j < 4; ++j) v[j] *= 0.125f;
                }
#pragma unroll
                for (int j = 0; j < 4; ++j) Ob[(size_t)m * ldo + cols[j]] = (bf16)f2bf(v[j]);
            } else if (EP == EP_RES) {
#pragma unroll
                for (int j = 0; j < 4; ++j) {
                    const size_t o = (size_t)m * DM + cols[j];
                    const float base = (Ob == nullptr) ? F.x[o] : F.out[o];
                    const float hn = base + v[j] + (bias ? bias[cols[j]] : 0.f);
                    F.out[o] = hn; hb[o] = (bf16)f2bf(hn);
                }
            } else if (EP == EP_Q) {
                const float r = rs[ty * 4 + i];
#pragma unroll
                for (int j = 0; j < 4; ++j) Ob[(size_t)m * ldo + cols[j]] = (bf16)f2bf(v[j] * r);
            } else {
                const float r = rs[ty * 4 + i];
#pragma unroll
                for (int j = 0; j < 4; ++j) Ob[(size_t)m * ldo + cols[j]] = (bf16)f2bf(v[j] * r + bias[cols[j]]);
            }
        }
    }
}

DI void naive_rowstat(Frame& F) {
    FRAME_IDS;
    const int gw = F.bid * NWAVES + F.wave, NGW = F.G * NWAVES;
    float* part = (float*)(F.ws + WS_PART);
    for (int m = gw; m < T; m += NGW) {
        const f32x4* xr = (const f32x4*)(F.out + (size_t)m * DM) + f_lane;
        float s = 0.f;
#pragma unroll
        for (int j = 0; j < 4; ++j) { const f32x4 v = xr[64 * j]; s += v.x * v.x + v.y * v.y + v.z * v.z + v.w * v.w; }
        s = wave_sum(s);
        if (f_lane < 16) part[(size_t)m * 16 + f_lane] = (f_lane == 0) ? s : 0.f;
    }
}

DI void naive_attn(Frame& F) {
    FRAME_IDS;
    const bf16* R = (const bf16*)(F.ws + WS_R); bf16* O = (bf16*)(F.ws + WS_O);
    LAS float* Ks = (LAS float*)F.lds;
    LAS float* Vs = Ks + 64 * 65;
    LAS float* bs = Vs + 64 * 65;
    const int tid = f_tid;
    for (int it = F.bid; it < NB * NHA * 4; it += F.G) {
        const int b = it / (NHA * 4), h = (it / 4) % NHA, cg = it % 4;
        const int c = cg * 8 + (tid >> 6), i = tid & 63;
        __syncthreads();
        for (int k = tid; k < 257; k += NTHR) bs[k] = F.rel_bias[h * 257 + k];
        float q[64], acc[64];
        {   const bf16* qp = R + (size_t)(b * SEQ + c * 64 + i) * INC + C_QA + h * 64;
#pragma unroll
            for (int d = 0; d < 64; ++d) { q[d] = bf2f(qp[d]); acc[d] = 0.f; } }
        float mx = -1e30f, l = 0.f;
        const int t_lo = (cg * 8 - 8) < 0 ? 0 : (cg * 8 - 8), t_hi = cg * 8 + 7;
        for (int tc = t_lo; tc <= t_hi; ++tc) {
            __syncthreads();
            for (int e = tid; e < 64 * 64; e += NTHR) {
                const int j = e >> 6, d = e & 63;
                const size_t row = (size_t)(b * SEQ + tc * 64 + j) * INC;
                Ks[j * 65 + d] = bf2f(R[row + C_KA + h * 64 + d]);
                Vs[j * 65 + d] = bf2f(R[row + C_VA + h * 64 + d]);
            }
            __syncthreads();
            if (tc <= c && tc >= c - 8) {
                for (int j = 0; j < 64; ++j) {
                    float s = 0.f;
#pragma unroll
                    for (int d = 0; d < 64; ++d) s += q[d] * Ks[j * 65 + d];
                    int rel = (c * 64 + i) - (tc * 64 + j); rel = rel < -128 ? -128 : (rel > 128 ? 128 : rel);
                    s += bs[rel + 128];
                    const float mn = fmaxf(mx, s), corr = __expf(mx - mn), p = __expf(s - mn);
                    l = l * corr + p;
#pragma unroll
                    for (int d = 0; d < 64; ++d) acc[d] = acc[d] * corr + p * Vs[j * 65 + d];
                    mx = mn;
                }
            }
        }
        const float inv = 1.f / l;
        bf16* op = O + (size_t)(b * SEQ + c * 64 + i) * DM + h * 64;
#pragma unroll
        for (int d = 0; d < 64; ++d) op[d] = (bf16)f2bf(acc[d] * inv);
    }
}

DI void naive_ret(Frame& F) {
    FRAME_IDS;
    const bf16* R = (const bf16*)(F.ws + WS_R); bf16* O = (bf16*)(F.ws + WS_O);
    LAS float* St = (LAS float*)F.lds;
    LAS float* Qs = St + 4096;
    LAS float* Ks = Qs + 64 * 65;
    LAS float* Vs = Ks + 64 * 65;
    LAS float* Sc = Vs + 64 * 65;
    LAS float* Ot = Sc + 64 * 65;
    const int tid = f_tid;
    for (int it = F.G - 1 - F.bid; it < NB * NHB; it += F.G) {
        const int b = it / NHB, h = it % NHB;
        const float lg = logf(gamma_of(h));
        const float cd = __expf(lg * 64.f);
        __syncthreads();
        for (int e = tid; e < 4096; e += NTHR) St[e] = 0.f;
        for (int n = 0; n < NCH; ++n) {
            __syncthreads();
            for (int e = tid; e < 4096; e += NTHR) {
                const int j = e >> 6, d = e & 63;
                const size_t row = (size_t)(b * SEQ + n * 64 + j) * INC;
                Qs[j * 65 + d] = bf2f(R[row + C_QB + h * 64 + d]);
                Ks[j * 65 + d] = bf2f(R[row + C_KB + h * 64 + d]);
                Vs[j * 65 + d] = bf2f(R[row + C_VB + h * 64 + d]);
            }
            __syncthreads();
            for (int e = tid; e < 4096; e += NTHR) {
                const int i = e >> 6, j = e & 63;
                float s = 0.f;
#pragma unroll
                for (int d = 0; d < 64; ++d) s += Qs[i * 65 + d] * Ks[j * 65 + d];
                const int ad = i > j ? i - j : j - i;
                Sc[i * 65 + j] = s * __expf(lg * (float)ad);
            }
            __syncthreads();
            for (int e = tid; e < 4096; e += NTHR) {
                const int i = e >> 6, ee = e & 63;
                float s = 0.f, cr = 0.f;
#pragma unroll
                for (int j = 0; j < 64; ++j) s += Sc[i * 65 + j] * Vs[j * 65 + ee];
#pragma unroll
                for (int d = 0; d < 64; ++d) cr += Qs[i * 65 + d] * St[d * 64 + ee];
                Ot[i * 65 + ee] = s + cr * __expf(lg * (float)(i + 1));
            }
            __syncthreads();
            for (int e = tid; e < 4096; e += NTHR) {
                const int d = e >> 6, ee = e & 63;
                float s = 0.f;
                for (int j = 0; j < 64; ++j) s += Ks[j * 65 + d] * __expf(lg * (float)(63 - j)) * Vs[j * 65 + ee];
                St[d * 64 + ee] = cd * St[d * 64 + ee] + s;
            }
            for (int r = 0; r < 8; ++r) {
                const int i = F.wave * 8 + r;
                const float v = Ot[i * 65 + f_lane];
                const float mu = wave_sum(v) * (1.f / 64.f);
                const float dv = v - mu;
                const float var = wave_sum(dv * dv) * (1.f / 64.f);
                const size_t row = (size_t)(b * SEQ + n * 64 + i);
                const float g = bf2f(R[row * INC + C_GB + h * 64 + f_lane]);
                const float o = dv * (1.f / sqrtf(var + EPS)) * (g * sigmoidf(g));
                O[row * DM + 512 + h * 64 + f_lane] = (bf16)f2bf(o);
            }
        }
    }
}

DI void naive_route(Frame& F, int layer) {
    FRAME_IDS;
    const bf16* Q = (const bf16*)(F.ws + WS_Q);
    int* eidx = (int*)(F.ws + WS_EIDX); float* gate = (float*)(F.ws + WS_GATE);
    const float* keys = F.peer_keys + (size_t)layer * 2 * PK * 64;
    LAS float* sc = (LAS float*)F.lds;
    LAS int* i1s = (LAS int*)(sc + 256 * 64);
    LAS int* i2s = i1s + 16 * 64;
    LAS float* qs = (LAS float*)(i2s + 16 * 64);
    const int p = f_tid;
    for (int it = F.bid; it < T / 8; it += F.G) {
        if (p < 64) {
            const int t = it * 8 + (p >> 3), hh = p & 7;
            float top1[16], top2[16];
#pragma unroll
            for (int side = 0; side < 2; ++side) {
                const bf16* qp = Q + (size_t)t * DM + hh * 128 + side * 64;
                for (int d = 0; d < 64; ++d) qs[d * 64 + p] = bf2f(qp[d]);
                for (int k = 0; k < PK; ++k) {
                    const float* kp = keys + ((size_t)side * PK + k) * 64;
                    float s = 0.f;
#pragma unroll 8
                    for (int d = 0; d < 64; ++d) s += qs[d * 64 + p] * kp[d];
                    sc[k * 64 + p] = s;
                }
#pragma unroll
                for (int a = 0; a < 16; ++a) {
                    float best = -INFINITY; int bi = 0;
                    for (int k = 0; k < PK; ++k) { const float v = sc[k * 64 + p]; if (v > best) { best = v; bi = k; } }
                    sc[bi * 64 + p] = -INFINITY;
                    if (side == 0) { top1[a] = best; i1s[a * 64 + p] = bi; } else { top2[a] = best; i2s[a * 64 + p] = bi; }
                }
            }
#pragma unroll
            for (int a = 0; a < 16; ++a)
#pragma unroll
                for (int b = 0; b < 16; ++b) sc[(a * 16 + b) * 64 + p] = top1[a] + top2[b];
            float bv[16]; int be[16];
#pragma unroll
            for (int a = 0; a < 16; ++a) {
                float best = -INFINITY; int bi = 0;
                for (int k = 0; k < 256; ++k) { const float v = sc[k * 64 + p]; if (v > best) { best = v; bi = k; } }
                sc[bi * 64 + p] = -INFINITY;
                bv[a] = best; be[a] = i1s[(bi >> 4) * 64 + p] * PK + i2s[(bi & 15) * 64 + p];
            }
            float sum = 0.f; const float bmax = bv[0];
#pragma unroll
            for (int a = 0; a < 16; ++a) { bv[a] = __expf(bv[a] - bmax); sum += bv[a]; }
            const float inv = 1.f / sum;
#pragma unroll
            for (int a = 0; a < 16; ++a) { eidx[(size_t)t * NSEL + hh * 16 + a] = be[a]; gate[(size_t)t * NSEL + hh * 16 + a] = bv[a] * inv; }
        }
    }
}


typedef short bf16x8 __attribute__((ext_vector_type(8)));
typedef float f32x16 __attribute__((ext_vector_type(16)));
DI float fmax_raw(float a, float b) { float r; asm("v_max_f32_e32 %0, %1, %2" : "=v"(r) : "v"(a), "v"(b)); return r; }
DI float fmin_raw(float a, float b) { float r; asm("v_min_f32_e32 %0, %1, %2" : "=v"(r) : "v"(a), "v"(b)); return r; }
#define CE_DESC(x, y) do { const float hi_ = fmax_raw((x), (y)), lo_ = fmin_raw((x), (y)); (x) = hi_; (y) = lo_; } while (0)
template <int N> DI void sort_desc(float* v) {
#pragma unroll
    for (int k = 2; k <= N; k <<= 1)
#pragma unroll
        for (int j = k >> 1; j > 0; j >>= 1)
#pragma unroll
            for (int i = 0; i < N; ++i) { const int l = i ^ j; if (l > i) { if ((i & k) == 0 || k == N) CE_DESC(v[i], v[l]); else CE_DESC(v[l], v[i]); } }
}
DI void merge16(float* a, const float* b) {
#pragma unroll
    for (int i = 0; i < 16; ++i) a[i] = fmax_raw(a[i], b[15 - i]);
#pragma unroll
    for (int j = 8; j > 0; j >>= 1)
#pragma unroll
        for (int i = 0; i < 16; ++i) { const int l = i ^ j; if (l > i) CE_DESC(a[i], a[l]); }
}
DI float key_pack(float v, unsigned keep_mask, unsigned idx) { return __uint_as_float((__float_as_uint(v) & keep_mask) | idx); }
DI void opt_route(Frame& F, int layer) {
    FRAME_IDS;
    const bf16* Q = (const bf16*)(F.ws + WS_Q);
    int* eidx = (int*)(F.ws + WS_EIDX); float* gate = (float*)(F.ws + WS_GATE);
    const float* keys = F.peer_keys + (size_t)layer * 2 * PK * 64;
    LAS unsigned char* kl = F.lds;
    __syncthreads();
    for (int idx = f_tid; idx < 2 * PK * 8; idx += NTHR) {
        const int row = idx >> 3, ch = idx & 7;
        const f32x4 a = *(const f32x4*)(keys + (size_t)row * 64 + ch * 8), b = *(const f32x4*)(keys + (size_t)row * 64 + ch * 8 + 4);
        *(LAS u32x4*)(kl + row * 144 + ch * 16) = (u32x4){pk2(a[0], a[1]), pk2(a[2], a[3]), pk2(b[0], b[1]), pk2(b[2], b[3])};
    }
    __syncthreads();
    LAS int* lut = (LAS int*)(F.lds + 40960 + F.wave * 8192);
    const int c = f_lane & 31, h = f_lane >> 5;
    const int gw = F.bid * NWAVES + F.wave, NGW = F.G * NWAVES;
    for (int task = gw; task < (T / 32) * PH; task += NGW) {
        const int tile = task >> 3, hh = task & 7, t = tile * 32 + c;
        float tk[2][16];
#pragma unroll
        for (int side = 0; side < 2; ++side) {
            bf16x8 qf[4];
#pragma unroll
            for (int ks = 0; ks < 4; ++ks) qf[ks] = *(const bf16x8*)(Q + (size_t)t * DM + hh * PQD + side * 64 + 16 * ks + 8 * h);
            float v[64];
#pragma unroll
            for (int kt = 0; kt < 4; ++kt) {
                f32x16 acc = {};
#pragma unroll
                for (int ks = 0; ks < 4; ++ks) {
                    const bf16x8 a = *(const LAS bf16x8*)(kl + (side * PK + 32 * kt + c) * 144 + (16 * ks + 8 * h) * 2);
                    acc = __builtin_amdgcn_mfma_f32_32x32x16_bf16(a, qf[ks], acc, 0, 0, 0);
                }
#pragma unroll
                for (int r = 0; r < 16; ++r) v[16 * kt + r] = key_pack(acc[r], 0xFFFFFF80u, (unsigned)(32 * kt + (r & 3) + 8 * (r >> 2) + 4 * h));
            }
            sort_desc<16>(v); sort_desc<16>(v + 16); sort_desc<16>(v + 32); sort_desc<16>(v + 48);
            merge16(v, v + 16); merge16(v + 32, v + 48); merge16(v, v + 32);
            float pr[16];
#pragma unroll
            for (int i = 0; i < 16; ++i) pr[i] = __shfl_xor(v[i], 32);
            merge16(v, pr);
#pragma unroll
            for (int i = 0; i < 16; ++i) { tk[side][i] = v[i]; lut[(side * 16 + i) * 64 + f_lane] = (int)(__float_as_uint(v[i]) & 0x7Fu); }
        }
        float cd[64];
        {   int n = 0;
#pragma unroll
            for (int a = 0; a < 16; ++a)
#pragma unroll
                for (int b = 0; b < 16; ++b) if ((a + 1) * (b + 1) <= 16) { cd[n] = key_pack(tk[0][a] + tk[1][b], 0xFFFFFF00u, (unsigned)(a * 16 + b)); ++n; }
#pragma unroll
            for (int i = 50; i < 64; ++i) cd[i] = -INFINITY;
        }
        sort_desc<16>(cd); sort_desc<16>(cd + 16); sort_desc<16>(cd + 32); CE_DESC(cd[48], cd[49]);
        merge16(cd, cd + 16); merge16(cd + 32, cd + 48); merge16(cd, cd + 32);
        int ex[16]; float gv[16]; float sum = 0.f;
        const float top = __uint_as_float(__float_as_uint(cd[0]) & 0xFFFFFF00u);
#pragma unroll
        for (int i = 0; i < 16; ++i) {
            const unsigned bits = __float_as_uint(cd[i]);
            const int a = (bits >> 4) & 15, b = bits & 15;
            ex[i] = lut[a * 64 + f_lane] * PK + lut[(16 + b) * 64 + f_lane];
            gv[i] = __expf(__uint_as_float(bits & 0xFFFFFF00u) - top); sum += gv[i];
        }
        const float inv = 1.f / sum;
        if (h == 0) {
            u32x4* ep = (u32x4*)(eidx + (size_t)t * NSEL + hh * 16);
#pragma unroll
            for (int q = 0; q < 4; ++q) ep[q] = (u32x4){(unsigned)ex[4 * q], (unsigned)ex[4 * q + 1], (unsigned)ex[4 * q + 2], (unsigned)ex[4 * q + 3]};
        } else {
            f32x4* gp = (f32x4*)(gate + (size_t)t * NSEL + hh * 16);
#pragma unroll
            for (int q = 0; q < 4; ++q) gp[q] = (f32x4){gv[4 * q] * inv, gv[4 * q + 1] * inv, gv[4 * q + 2] * inv, gv[4 * q + 3] * inv};
        }
    }
    __syncthreads();
}
DI void naive_gather(Frame& F, int layer, bool final_norm) {
    FRAME_IDS;
    const int* eidx = (const int*)(F.ws + WS_EIDX); const float* gate = (const float*)(F.ws + WS_GATE);
    float* part = (float*)(F.ws + WS_PART); bf16* hb = (bf16*)(F.ws + WS_XB);
    const float* U = F.peer_u + (size_t)layer * PE * DM; const float* V = F.peer_v + (size_t)layer * PE * DM;
    const float* gn = F.ffn_norm + layer * DM;
    LAS float* xs = (LAS float*)F.lds;
    LAS float* as = xs + 1024;
    LAS int* es = (LAS int*)(as + 128);
    LAS float* red = (LAS float*)(es + 128);
    const int tid = f_tid;
    for (int t = F.bid; t < T; t += F.G) {
        __syncthreads();
        const float rstd = row_rstd(part, t);
        const f32x2 hv = *(const f32x2*)(F.out + (size_t)t * DM + 2 * tid);
        xs[2 * tid] = hv.x * rstd * gn[2 * tid]; xs[2 * tid + 1] = hv.y * rstd * gn[2 * tid + 1];
        if (tid < 128) es[tid] = eidx[(size_t)t * NSEL + tid];
        __syncthreads();
        for (int k = F.wave; k < NSEL; k += NWAVES) {
            const f32x4* ur = (const f32x4*)(U + (size_t)es[k] * DM) + f_lane;
            float s = 0.f;
#pragma unroll
            for (int j = 0; j < 4; ++j) { const f32x4 u = ur[64 * j]; const int c = 4 * f_lane + 256 * j; s += u.x * xs[c] + u.y * xs[c + 1] + u.z * xs[c + 2] + u.w * xs[c + 3]; }
            s = wave_sum(s);
            if (f_lane == 0) as[k] = gelu_erf(s) * gate[(size_t)t * NSEL + k];
        }
        __syncthreads();
        float o0 = 0.f, o1 = 0.f;
        for (int k = 0; k < NSEL; ++k) { const f32x2 v = *(const f32x2*)(V + (size_t)es[k] * DM + 2 * tid); const float a = as[k]; o0 += a * v.x; o1 += a * v.y; }
        const float h0 = hv.x + o0, h1 = hv.y + o1;
        const float ss = block_sum(h0 * h0 + h1 * h1, red, tid);
        if (final_norm) {
            const float r = 1.f / sqrtf(ss * (1.f / DM) + EPS);
            *(f32x2*)(F.out + (size_t)t * DM + 2 * tid) = (f32x2){h0 * r * F.final_norm[2 * tid], h1 * r * F.final_norm[2 * tid + 1]};
        } else {
            *(f32x2*)(F.out + (size_t)t * DM + 2 * tid) = (f32x2){h0, h1};
            *(unsigned*)(hb + (size_t)t * DM + 2 * tid) = pk2(h0, h1);
            if (tid < 16) part[(size_t)t * 16 + tid] = (tid == 0) ? ss : 0.f;
        }
    }
}


DI unsigned fp8x4(f32x4 v) {
    const float a = __builtin_amdgcn_fmed3f(v[0], -448.f, 448.f), b = __builtin_amdgcn_fmed3f(v[1], -448.f, 448.f), c = __builtin_amdgcn_fmed3f(v[2], -448.f, 448.f), d = __builtin_amdgcn_fmed3f(v[3], -448.f, 448.f);
    unsigned w = 0u;
    w = (unsigned)__builtin_amdgcn_cvt_pk_fp8_f32(a, b, (int)w, false);
    w = (unsigned)__builtin_amdgcn_cvt_pk_fp8_f32(c, d, (int)w, true);
    return w;
}
DI void p0_fp8(Frame& F) {
    FRAME_IDS;
    const int gw = F.bid * NWAVES + F.wave, NGW = F.G * NWAVES;
    for (int row = gw; row < 4 * PE; row += NGW) {
        const int tab = row / PE, e = row % PE, layer = tab & 1, isv = tab >> 1;
        const float* src = (isv ? F.peer_v : F.peer_u) + ((size_t)layer * PE + e) * DM;
        unsigned* dst = (unsigned*)(F.ws + (isv ? WS_V8 : WS_U8) + ((size_t)layer * PE + e) * DM);
        const f32x4* sp = (const f32x4*)src + f_lane;
        const f32x4* gp = (const f32x4*)(F.ffn_norm + layer * DM) + f_lane;
#pragma unroll
        for (int j = 0; j < 4; ++j) {
            f32x4 v = sp[64 * j];
            if (!isv) v = v * gp[64 * j] * U8_SCALE; else v = v * V8_SCALE;
            dst[f_lane + 64 * j] = fp8x4(v);
        }
    }
}
DI float dot16_fp8(const u32x4 r, const float (&xs)[16]) {
    float s0 = 0.f, s1 = 0.f;
#pragma unroll
    for (int w = 0; w < 4; ++w) {
        const f32x2 lo = __builtin_amdgcn_cvt_pk_f32_fp8((int)r[w], false), hi = __builtin_amdgcn_cvt_pk_f32_fp8((int)r[w], true);
        s0 = fmaf(lo[0], xs[4 * w + 0], s0); s1 = fmaf(lo[1], xs[4 * w + 1], s1); s0 = fmaf(hi[0], xs[4 * w + 2], s0); s1 = fmaf(hi[1], xs[4 * w + 3], s1);
    }
    return s0 + s1;
}
DI void axpy16_fp8(const u32x4 r, const float a, float (&o)[16]) {
#pragma unroll
    for (int w = 0; w < 4; ++w) {
        const f32x2 lo = __builtin_amdgcn_cvt_pk_f32_fp8((int)r[w], false), hi = __builtin_amdgcn_cvt_pk_f32_fp8((int)r[w], true);
        o[4 * w + 0] = fmaf(a, lo[0], o[4 * w + 0]); o[4 * w + 1] = fmaf(a, lo[1], o[4 * w + 1]); o[4 * w + 2] = fmaf(a, hi[0], o[4 * w + 2]); o[4 * w + 3] = fmaf(a, hi[1], o[4 * w + 3]);
    }
}
DI float red_combine(const int level, const float a, const float b, const int lane) {
    const int M = 32 >> level; const bool bit = (lane & M) != 0;
    const float send = bit ? a : b, keep = bit ? b : a;
    return keep + __shfl_xor(send, M);
}
constexpr int brev6(int k) { return ((k & 1) << 5) | ((k & 2) << 3) | ((k & 4) << 1) | ((k & 8) >> 1) | ((k & 16) >> 3) | ((k & 32) >> 5); }
DI void opt_gather(Frame& F, int layer, bool final_norm) {
    FRAME_IDS;
    const int* eidx = (const int*)(F.ws + WS_EIDX); const float* gate = (const float*)(F.ws + WS_GATE);
    float* part = (float*)(F.ws + WS_PART); bf16* hb = (bf16*)(F.ws + WS_XB);
    const __amdgpu_buffer_rsrc_t U8 = __builtin_amdgcn_make_buffer_rsrc((void*)(F.ws + WS_U8 + (size_t)layer * PE * DM), 0, PE * DM, 0x00020000);
    const __amdgpu_buffer_rsrc_t V8 = __builtin_amdgcn_make_buffer_rsrc((void*)(F.ws + WS_V8 + (size_t)layer * PE * DM), 0, PE * DM, 0x00020000);
    const int voff = f_lane * 16;
    const int gw = F.bid * NWAVES + F.wave, NGW = F.G * NWAVES;
    for (int t = gw; t < T; t += NGW) {
        float* hrow = F.out + (size_t)t * DM + 16 * f_lane;
        float xs[16];
        { const f32x4 h0 = ((const f32x4*)hrow)[0], h1 = ((const f32x4*)hrow)[1], h2 = ((const f32x4*)hrow)[2], h3 = ((const f32x4*)hrow)[3];
#pragma unroll
          for (int i = 0; i < 4; ++i) { xs[i] = h0[i]; xs[4 + i] = h1[i]; xs[8 + i] = h2[i]; xs[12 + i] = h3[i]; } }
        const float pv = (f_lane < 16) ? part[(size_t)t * 16 + f_lane] : 0.f;
        const float rstd = 1.f / sqrtf(wave_sum(pv) * (1.f / DM) + EPS);
        int ev[2]; float gv[2], av[2];
        ev[0] = eidx[(size_t)t * NSEL + f_lane]; ev[1] = eidx[(size_t)t * NSEL + 64 + f_lane];
        gv[0] = gate[(size_t)t * NSEL + f_lane]; gv[1] = gate[(size_t)t * NSEL + 64 + f_lane];
        constexpr int GR = 4, NG = 64 / GR;
#pragma unroll
        for (int b = 0; b < 2; ++b) {
            float st[6]; float red = 0.f;
            u32x4 buf[2][GR];
#pragma unroll
            for (int j = 0; j < GR; ++j) { const int e = __builtin_amdgcn_readlane(ev[b], brev6(j)); buf[0][j] = __builtin_amdgcn_raw_buffer_load_b128(U8, voff, e * DM, 0); }
            asm volatile("" ::: "memory");
#pragma unroll
            for (int g = 0; g < NG; ++g) {
                if (g + 1 < NG) {
#pragma unroll
                    for (int j = 0; j < GR; ++j) { const int e = __builtin_amdgcn_readlane(ev[b], brev6(GR * (g + 1) + j)); buf[(g + 1) & 1][j] = __builtin_amdgcn_raw_buffer_load_b128(U8, voff, e * DM, 0); }
                }
                asm volatile("" ::: "memory");
#pragma unroll
                for (int j = 0; j < GR; ++j) {
                    const int k = GR * g + j;
                    float v = dot16_fp8(buf[g & 1][j], xs);
                    int kk = k, lvl = 0;
#pragma unroll
                    for (int q = 0; q < 6; ++q) { if (kk & 1) { v = red_combine(lvl, st[lvl], v, f_lane); kk >>= 1; ++lvl; } }
                    if (k == 63) red = v; else st[lvl] = v;
                }
                asm volatile("" ::: "memory");
            }
            const float d = red * (rstd * (1.f / U8_SCALE));
            av[b] = gelu_erf(d) * gv[b] * (1.f / V8_SCALE);
        }
        float o[16];
#pragma unroll
        for (int i = 0; i < 16; ++i) o[i] = 0.f;
#pragma unroll
        for (int b = 0; b < 2; ++b) {
            u32x4 buf[2][GR];
#pragma unroll
            for (int j = 0; j < GR; ++j) { const int e = __builtin_amdgcn_readlane(ev[b], j); buf[0][j] = __builtin_amdgcn_raw_buffer_load_b128(V8, voff, e * DM, 0); }
            asm volatile("" ::: "memory");
#pragma unroll
            for (int g = 0; g < NG; ++g) {
                if (g + 1 < NG) {
#pragma unroll
                    for (int j = 0; j < GR; ++j) { const int e = __builtin_amdgcn_readlane(ev[b], GR * (g + 1) + j); buf[(g + 1) & 1][j] = __builtin_amdgcn_raw_buffer_load_b128(V8, voff, e * DM, 0); }
                }
                asm volatile("" ::: "memory");
#pragma unroll
                for (int j = 0; j < GR; ++j) { const float a = __builtin_bit_cast(float, __builtin_amdgcn_readlane(__builtin_bit_cast(int, av[b]), GR * g + j)); axpy16_fp8(buf[g & 1][j], a, o); }
                asm volatile("" ::: "memory");
            }
        }
        float ss = 0.f;
#pragma unroll
        for (int i = 0; i < 16; ++i) { o[i] += xs[i]; ss = fmaf(o[i], o[i], ss); }
        ss = wave_sum(ss);
        if (final_norm) {
            const float r = 1.f / sqrtf(ss * (1.f / DM) + EPS);
            const f32x4* fn = (const f32x4*)(F.final_norm + 16 * f_lane);
#pragma unroll
            for (int q = 0; q < 4; ++q) { const f32x4 g = fn[q]; ((f32x4*)hrow)[q] = (f32x4){o[4 * q] * r * g[0], o[4 * q + 1] * r * g[1], o[4 * q + 2] * r * g[2], o[4 * q + 3] * r * g[3]}; }
        } else {
#pragma unroll
            for (int q = 0; q < 4; ++q) ((f32x4*)hrow)[q] = (f32x4){o[4 * q], o[4 * q + 1], o[4 * q + 2], o[4 * q + 3]};
            u32x4* hbp = (u32x4*)(hb + (size_t)t * DM + 16 * f_lane);
            hbp[0] = (u32x4){pk2(o[0], o[1]), pk2(o[2], o[3]), pk2(o[4], o[5]), pk2(o[6], o[7])};
            hbp[1] = (u32x4){pk2(o[8], o[9]), pk2(o[10], o[11]), pk2(o[12], o[13]), pk2(o[14], o[15])};
            if (f_lane < 16) part[(size_t)t * 16 + f_lane] = (f_lane == 0) ? ss : 0.f;
        }
    }
}
DI void naive_glu(Frame& F) {
    FRAME_IDS;
    const bf16* H = (const bf16*)(F.ws + WS_HID); bf16* G = (bf16*)(F.ws + WS_GLU);
    for (size_t i = (size_t)F.bid * NTHR + f_tid; i < (size_t)T * DM; i += (size_t)F.G * NTHR) {
        const size_t m = i / DM; const int c = (int)(i % DM);
        const float a = bf2f(H[m * 2048 + c]), g = bf2f(H[m * 2048 + 1024 + c]);
        G[i] = (bf16)f2bf(a * sigmoidf(g));
    }
}
DI void naive_conv(Frame& F) {
    FRAME_IDS;
    const bf16* G = (const bf16*)(F.ws + WS_GLU); bf16* H2 = (bf16*)(F.ws + WS_HID2);
    LAS float* red = (LAS float*)F.lds;
    const int tid = f_tid;
    for (int t = F.bid; t < T; t += F.G) {
        const int s = t % SEQ;
        float y[2];
#pragma unroll
        for (int u = 0; u < 2; ++u) {
            const int c = 2 * tid + u;
            float a = F.conv_dw_b[c];
            for (int j = 0; j < CW; ++j) { const int sp = s - (CW - 1) + j; if (sp >= 0) a += F.conv_dw[j * DM + c] * bf2f(G[(size_t)(t - (CW - 1) + j) * DM + c]); }
            y[u] = a;
        }
        const float mu = block_sum(y[0] + y[1], red, tid) * (1.f / DM);
        const float d0 = y[0] - mu, d1 = y[1] - mu;
        const float var = block_sum(d0 * d0 + d1 * d1, red, tid) * (1.f / DM);
        const float r = 1.f / sqrtf(var + EPS);
        const float z0 = d0 * r * F.conv_ln_g[2 * tid] + F.conv_ln_b[2 * tid], z1 = d1 * r * F.conv_ln_g[2 * tid + 1] + F.conv_ln_b[2 * tid + 1];
        *(unsigned*)(H2 + (size_t)t * DM + 2 * tid) = pk2(z0 * sigmoidf(z0), z1 * sigmoidf(z1));
    }
}

#if OPT_GEMM
enum Phase { PH_PREP = 0, PH_PROJ, PH_MIX, PH_WOUT, PH_Q0, PH_ROUTE0, PH_GATHER0, PH_W1, PH_CONV, PH_W2, PH_Q1, PH_ROUTE1, PH_GATHER1, PH_COUNT };
#else
enum Phase { PH_PREP = 0, PH_PROJ, PH_MIX, PH_WOUT, PH_STAT0, PH_Q0, PH_ROUTE0, PH_GATHER0, PH_W1, PH_GLU, PH_CONV, PH_W2, PH_STAT1, PH_Q1, PH_ROUTE1, PH_GATHER1, PH_COUNT };
#endif
struct Args { const float* in[19]; float* out; unsigned char* ws; int ph_lo, ph_hi; };

__global__ void __launch_bounds__(NTHR, 2) mega_fwd(Args args) {
    extern __shared__ __attribute__((aligned(16))) unsigned char lds[];
    Frame F;
    F.lds = (LAS unsigned char*)lds;
    F.wave = __builtin_amdgcn_readfirstlane((int)threadIdx.x >> 6); FRAME_IDS;
    F.G = gridDim.x; F.bid = blockIdx.x;
    F.x = args.in[0]; F.mix_norm = args.in[1]; F.ffn_norm = args.in[2]; F.final_norm = args.in[3]; F.w_in = args.in[4]; F.w_out = args.in[5]; F.rel_bias = args.in[6];
    F.conv_w1 = args.in[7]; F.conv_b1 = args.in[8]; F.conv_dw = args.in[9]; F.conv_dw_b = args.in[10]; F.conv_ln_g = args.in[11]; F.conv_ln_b = args.in[12];
    F.conv_w2 = args.in[13]; F.conv_b2 = args.in[14]; F.peer_wq = args.in[15]; F.peer_keys = args.in[16]; F.peer_u = args.in[17]; F.peer_v = args.in[18];
    F.out = args.out; F.ws = args.ws;
    volatile LAS unsigned* MISC = (volatile LAS unsigned*)(F.lds + MISC_OFF);
    for (int u = f_tid; u < (LDS_BYTES - LDSCTL_OFF) / 4; u += NTHR) ((LAS unsigned*)(F.lds + LDSCTL_OFF))[u] = 0u;
    __syncthreads();
    const int lo = args.ph_lo, hi = args.ph_hi;
    XcdBarrier bar; bar.bar = (unsigned*)(F.ws + WS_CTL) + CW_BAR; bar.x = 0; bar.st = nullptr;
    if (hi - lo > 1) bar = xcd_barrier_post((unsigned*)(F.ws + WS_CTL) + CW_BAR, MISC + 8);
#ifndef TEST_PHASE
#define TEST_PHASE -1
#endif
#define IN(k) ((TEST_PHASE < 0 || TEST_PHASE == (k)) && lo <= (k) && (k) < hi)
#define SEAM(k) do { if (IN(k) && IN((k) + 1)) xcd_barrier(bar, F.wave); } while (0)
    bf16* XB = (bf16*)(F.ws + WS_XB);
    const float* PART = (const float*)(F.ws + WS_PART); const float* ROPE = (const float*)(F.ws + WS_ROPE);
    if (IN(PH_PREP)) { p0_prep(F);
#if OPT_GEMM
        p0_weights(F);
#endif
#if OPT_GATHER
        p0_fp8(F);
#endif
    } SEAM(PH_PREP);
#if OPT_GEMM
#define GEMM_PHASE(EPI, Aptr, Bptr, NN, ...) do { pg8::Gemm g{(const bf16*)(Aptr), (const bf16*)(Bptr), T, (NN), DM}; pg8::StaticOrder S; S.init(T, (NN), F.G, F.bid); \
        pg8::EPI E{__VA_ARGS__}; pg8::gemm_phase<pg8::EPI, pg8::StaticOrder, true, true>(F.lds, g, S, E, F.wave); } while (0)
    if (IN(PH_PROJ)) { GEMM_PHASE(EpiProj, XB, F.ws + WS_WIN, INC, (bf16*)(F.ws + WS_R), PART, ROPE); } SEAM(PH_PROJ);
#else
    if (IN(PH_PROJ)) { naive_gemm<EP_PROJ>(F, XB, F.w_in, INC, F.mix_norm, nullptr, (bf16*)(F.ws + WS_R), INC); } SEAM(PH_PROJ);
#endif
    if (IN(PH_MIX)) { naive_ret(F); naive_attn(F); } SEAM(PH_MIX);
#if OPT_GEMM
    if (IN(PH_WOUT)) { GEMM_PHASE(EpiRes, F.ws + WS_O, F.ws + WS_WOUT, DM, F.x, F.out, XB, (float*)(F.ws + WS_PART), nullptr); } SEAM(PH_WOUT);
    if (IN(PH_Q0)) { GEMM_PHASE(EpiQ, XB, F.ws + WS_WQ, DM, (bf16*)(F.ws + WS_Q), PART); } SEAM(PH_Q0);
#else
    if (IN(PH_WOUT)) { naive_gemm<EP_RES>(F, (const bf16*)(F.ws + WS_O), F.w_out, DM, nullptr, nullptr, nullptr, DM); } SEAM(PH_WOUT);
    if (IN(PH_STAT0)) { naive_rowstat(F); } SEAM(PH_STAT0);
    if (IN(PH_Q0)) { naive_gemm<EP_Q>(F, XB, F.peer_wq, DM, F.ffn_norm, nullptr, (bf16*)(F.ws + WS_Q), DM); } SEAM(PH_Q0);
#endif
#if OPT_ROUTE
    if (IN(PH_ROUTE0)) { opt_route(F, 0); } SEAM(PH_ROUTE0);
#else
    if (IN(PH_ROUTE0)) { naive_route(F, 0); } SEAM(PH_ROUTE0);
#endif
#if OPT_GATHER
    if (IN(PH_GATHER0)) { opt_gather(F, 0, false); } SEAM(PH_GATHER0);
#else
    if (IN(PH_GATHER0)) { naive_gather(F, 0, false); } SEAM(PH_GATHER0);
#endif
#if OPT_GEMM
    if (IN(PH_W1)) { GEMM_PHASE(EpiGlu, XB, F.ws + WS_W1, 2 * DM, (bf16*)(F.ws + WS_GLU), PART, F.conv_b1); } SEAM(PH_W1);
#else
    if (IN(PH_W1)) { naive_gemm<EP_HID>(F, XB, F.conv_w1, 2 * DM, F.mix_norm + DM, F.conv_b1, (bf16*)(F.ws + WS_HID), 2 * DM); } SEAM(PH_W1);
    if (IN(PH_GLU)) { naive_glu(F); } SEAM(PH_GLU);
#endif
    if (IN(PH_CONV)) { naive_conv(F); } SEAM(PH_CONV);
#if OPT_GEMM
    if (IN(PH_W2)) { GEMM_PHASE(EpiRes, F.ws + WS_HID2, F.ws + WS_W2, DM, F.out, F.out, XB, (float*)(F.ws + WS_PART), F.conv_b2); } SEAM(PH_W2);
    if (IN(PH_Q1)) { GEMM_PHASE(EpiQ, XB, F.ws + WS_WQ + (size_t)DM * DM * 2, DM, (bf16*)(F.ws + WS_Q), PART); } SEAM(PH_Q1);
#else
    if (IN(PH_W2)) { naive_gemm<EP_RES>(F, (const bf16*)(F.ws + WS_HID2), F.conv_w2, DM, nullptr, F.conv_b2, XB  , DM); } SEAM(PH_W2);
    if (IN(PH_STAT1)) { naive_rowstat(F); } SEAM(PH_STAT1);
    if (IN(PH_Q1)) { naive_gemm<EP_Q>(F, XB, F.peer_wq + (size_t)DM * DM, DM, F.ffn_norm + DM, nullptr, (bf16*)(F.ws + WS_Q), DM); } SEAM(PH_Q1);
#endif
#if OPT_ROUTE
    if (IN(PH_ROUTE1)) { opt_route(F, 1); } SEAM(PH_ROUTE1);
#else
    if (IN(PH_ROUTE1)) { naive_route(F, 1); } SEAM(PH_ROUTE1);
#endif
#if OPT_GATHER
    if (IN(PH_GATHER1)) { opt_gather(F, 1, true); }
#else
    if (IN(PH_GATHER1)) { naive_gather(F, 1, true); }
#endif
#undef IN
#undef SEAM
}

extern "C" void kernel_launch(void* const* d_in, const int* in_sizes, int n_in, void* d_out, int out_size, void* d_ws, size_t ws_size, hipStream_t stream) {
    static int grid = 0;
    if (grid == 0) {
        if (n_in != 19 || out_size != T * DM || ws_size < WS_END) { fprintf(stderr, "kernel_launch: unexpected shapes (n_in %d out %d ws %zu)\n", n_in, out_size, ws_size); grid = -1; return; }
        int dev = 0, cus = 0;
        if (hipGetDevice(&dev) != hipSuccess || hipDeviceGetAttribute(&cus, hipDeviceAttributeMultiprocessorCount, dev) != hipSuccess) { grid = -1; return; }
        if (hipFuncSetAttribute((const void*)mega_fwd, hipFuncAttributeMaxDynamicSharedMemorySize, LDS_BYTES) != hipSuccess) { fprintf(stderr, "kernel_launch: hipFuncSetAttribute failed\n"); grid = -1; return; }
        (void)hipGetLastError();
        grid = cus;
    }
    if (grid < 0) return;
    (void)hipMemsetAsync((char*)d_ws + WS_CTL, 0, CTL_ZERO_BYTES, stream);
    Args a{};
    for (int i = 0; i < 19; ++i) a.in[i] = (const float*)d_in[i];
    a.out = (float*)d_out; a.ws = (unsigned char*)d_ws;
#if MK_ONE_LAUNCH
    a.ph_lo = 0; a.ph_hi = PH_COUNT;
    hipLaunchKernelGGL(mega_fwd, dim3(grid), dim3(NTHR), LDS_BYTES, stream, a);
#else
    for (int p = 0; p < PH_COUNT; ++p) { a.ph_lo = p; a.ph_hi = p + 1; hipLaunchKernelGGL(mega_fwd, dim3(grid), dim3(NTHR), LDS_BYTES, stream, a); }
#endif
}
```

```cpp
#include <hip/hip_runtime.h>
#include <cstdio>
#include <cstdint>

#ifndef OPT_GEMM
#define OPT_GEMM 1
#endif
#ifndef OPT_GATHER
#define OPT_GATHER 1
#endif
#ifndef OPT_ROUTE
#define OPT_ROUTE 1
#endif
#ifndef OPT_ATTN
#define OPT_ATTN 1
#endif
#ifndef MK_ONE_LAUNCH
#define MK_ONE_LAUNCH 1
#endif

#define GAS __attribute__((address_space(1)))
#define LAS __attribute__((address_space(3)))
#define DI __device__ __forceinline__
typedef unsigned short bf16;
typedef float f32x2 __attribute__((ext_vector_type(2)));
typedef float f32x4 __attribute__((ext_vector_type(4)));
typedef unsigned u32x2 __attribute__((ext_vector_type(2)));
typedef unsigned u32x4 __attribute__((ext_vector_type(4)));
typedef short bf16x8 __attribute__((ext_vector_type(8)));
typedef float f32x16 __attribute__((ext_vector_type(16)));

constexpr int NB = 16, SEQ = 2048, DM = 1024, T = NB * SEQ;
constexpr int CHUNK = 64, HD = 64, NHA = 8, NHB = 8, INC = 3584, NCH = SEQ / CHUNK;
constexpr int PH = 8, PK = 128, PE = PK * PK, PQD = 128, PTOP = 16, NSEL = PH * PTOP;
constexpr int CW = 31;
constexpr float EPS = 1e-6f;
constexpr float U8_SCALE = 256.f, V8_SCALE = 16.f;
constexpr int NWAVES = 8, NTHR = NWAVES * 64;

constexpr int C_QA = 0, C_KA = 512, C_VA = 1024, C_QB = 1536, C_KB = 2048, C_VB = 2560, C_GB = 3072;

constexpr size_t MiB = 1u << 20;
constexpr size_t WS_CTL = 0, CTL_ZERO_BYTES = 1 * MiB;
constexpr size_t WS_WIN = 2 * MiB, WS_WOUT = 9 * MiB, WS_W1 = 11 * MiB, WS_W2 = 15 * MiB, WS_WQ = 17 * MiB;
constexpr size_t WS_ROPE = 22 * MiB;
constexpr size_t WS_PART = 23 * MiB;
constexpr size_t WS_EIDX = 26 * MiB;
constexpr size_t WS_GATE = 42 * MiB;
constexpr size_t WS_U8 = 64 * MiB, WS_V8 = 96 * MiB;
constexpr size_t WS_XB = 128 * MiB;
constexpr size_t WS_R = 192 * MiB;
constexpr size_t WS_O = 416 * MiB;
constexpr size_t WS_Q = 192 * MiB;
constexpr size_t WS_HID = 256 * MiB;
constexpr size_t WS_GLU = 384 * MiB;
constexpr size_t WS_HID2 = 448 * MiB;
constexpr size_t WS_END = 512 * MiB;
constexpr int CW_BAR = 4096;

constexpr int RING_BYTES = 131072, LDSCTL_OFF = RING_BYTES, MISC_OFF = LDSCTL_OFF + 320, LDS_BYTES = 147456;

DI float bf2f(bf16 v) { return __uint_as_float(((unsigned)v) << 16); }
DI unsigned f2bf(float f) { unsigned u = __float_as_uint(f); return (u + 0x7fffu + ((u >> 16) & 1u)) >> 16; }
DI unsigned pk2(float lo, float hi) { return f2bf(lo) | (f2bf(hi) << 16); }
DI float wave_sum(float v) {
#pragma unroll
    for (int o = 1; o < 64; o <<= 1) v += __shfl_xor(v, o);
    return v;
}
DI float wave_max(float v) {
#pragma unroll
    for (int o = 1; o < 64; o <<= 1) v = fmaxf(v, __shfl_xor(v, o));
    return v;
}
DI float block_sum(float v, LAS float* red, int tid) {
    v = wave_sum(v);
    __syncthreads();
    if ((tid & 63) == 0) red[tid >> 6] = v;
    __syncthreads();
    float s = 0.f;
#pragma unroll
    for (int i = 0; i < NWAVES; ++i) s += red[i];
    return s;
}
DI float gelu_erf(float x) { return 0.5f * x * (1.f + erff(x * 0.70710678118654752f)); }
DI float sigmoidf(float x) { return 1.f / (1.f + __expf(-x)); }

DI int lane_id() { return (int)__builtin_amdgcn_mbcnt_hi(~0u, __builtin_amdgcn_mbcnt_lo(~0u, 0u)); }
#define XB_TMO      128
#define XB_XCNT(j)  (256  + 64 * (j))
#define XB_XSUB(j)  (1280 + 64 * (j))
#define XB_XGEN(j)  (2304 + 64 * (j))
#define XB_TOP      3328
#define XB_TOPGEN   3392
#define XCD_BAR_WORDS 3456
#define XB_SPIN_CAP (1u << 22)
DI unsigned xb_ld(unsigned* p)              { return __hip_atomic_load(p, __ATOMIC_RELAXED, __HIP_MEMORY_SCOPE_AGENT); }
DI unsigned xb_add(unsigned* p, unsigned v) { return __hip_atomic_fetch_add(p, v, __ATOMIC_RELAXED, __HIP_MEMORY_SCOPE_AGENT); }
DI unsigned xb_xcc_id() { return (unsigned)__builtin_amdgcn_s_getreg((3 << 11) | 20) & 0xFu; }
#define XB_SPIN(cond, bar) do { unsigned _sp = 0; while (cond) { __builtin_amdgcn_s_sleep(1); \
    if ((++_sp & 255u) == 0u) { if (xb_ld(&(bar)[XB_TMO])) break; if (_sp > XB_SPIN_CAP) { atomicAdd(&(bar)[XB_TMO], 1u); break; } } } } while (0)
struct XcdBarrier { unsigned* bar; unsigned x; volatile LAS unsigned* st; };
DI XcdBarrier xcd_barrier_post(unsigned* bar, volatile LAS unsigned* st) {
    XcdBarrier b; b.bar = bar; b.x = xb_xcc_id(); b.st = st;
    if (threadIdx.x == 0) (void)xb_add(&bar[XB_XCNT(b.x)], 1u);
    return b;
}
DI void xcd_barrier_complete(unsigned* bar, unsigned x, unsigned& nloc, unsigned& nx) {
    const unsigned G = gridDim.x * gridDim.y * gridDim.z;
    unsigned sum, cnt, mine, sp = 0u;
    for (;;) {
        sum = 0u; cnt = 0u; mine = 0u;
#pragma unroll
        for (unsigned j = 0; j < 16; ++j) { const unsigned c = xb_ld(&bar[XB_XCNT(j)]); sum += c; cnt += (c > 0u) ? 1u : 0u; mine = (j == x) ? c : mine; }
        if (sum == G) break;
        __builtin_amdgcn_s_sleep(1);
        if ((++sp & 255u) == 0u) { if (xb_ld(&bar[XB_TMO])) break; if (sp > XB_SPIN_CAP) { atomicAdd(&bar[XB_TMO], 1u); break; } }
    }
    nloc = mine > 0u ? mine : 1u; nx = cnt > 0u ? cnt : 1u;
}
DI void xcd_barrier(const XcdBarrier& b, const int wave_id) {
    asm volatile("s_waitcnt vmcnt(0)" ::: "memory");
    __syncthreads();
    if (wave_id == 0 && lane_id() == 0) {
        unsigned* bar = b.bar;
        __builtin_amdgcn_s_waitcnt(0);
        unsigned nloc = b.st[0], nx = b.st[1];
        if (nloc == 0u) { xcd_barrier_complete(bar, b.x, nloc, nx); b.st[0] = nloc; b.st[1] = nx; }
        const unsigned old = xb_add(&bar[XB_XSUB(b.x)], 1u);
        const unsigned gen = old / nloc;
        if (old + 1u == (gen + 1u) * nloc) {
            __builtin_amdgcn_fence(__ATOMIC_RELEASE, "agent");
            asm volatile("s_waitcnt vmcnt(0)" ::: "memory");
            const unsigned og = xb_add(&bar[XB_TOP], 1u);
            const unsigned tg = og / nx;
            if (og + 1u == (tg + 1u) * nx) xb_add(&bar[XB_TOPGEN], 1u);
            else XB_SPIN(xb_ld(&bar[XB_TOPGEN]) == tg, bar);
            __builtin_amdgcn_fence(__ATOMIC_ACQUIRE, "agent");
            xb_add(&bar[XB_XGEN(b.x)], 1u);
            asm volatile("s_waitcnt vmcnt(0)" ::: "memory");
        } else {
            XB_SPIN(xb_ld(&bar[XB_XGEN(b.x)]) == gen, bar);
            __builtin_amdgcn_fence(__ATOMIC_ACQUIRE, "agent");
            asm volatile("s_waitcnt vmcnt(0)" ::: "memory");
        }
    }
    __syncthreads();
}

namespace pg8 {
#define PG8_LAS __attribute__((address_space(3)))
typedef unsigned short bf16_t;
typedef short bf16x8 __attribute__((ext_vector_type(8)));
typedef float f32x4 __attribute__((ext_vector_type(4)));
typedef unsigned u32x4 __attribute__((ext_vector_type(4)));
constexpr int BM = 256, BK = 64, HALF = 128, HTB = HALF * BK * 2  , STAGE_BYTES = 8 * HTB, NXCD = 8, WGM = 8;

__host__ __device__ __forceinline__ int lds_byte(int r, int c) { const int st = (r >> 4) * 2 + (c >> 5), rr = r & 15, cc = c & 31, ob = rr * 64 + cc * 2; return st * 1024 + (ob ^ (((ob >> 9) & 1) << 5)); }
__host__ __device__ __forceinline__ void stage_rc(int b, int& R, int& C) { const int st = b / 1024, sb = b % 1024, swz = sb ^ (((sb >> 9) & 1) << 5); R = (st >> 1) * 16 + swz / 64; C = (st & 1) * 32 + (swz % 64) / 2; }
__host__ __device__ __forceinline__ int perm32(int rho) { const int n = rho >> 4, i = rho & 15; return 8 * (i >> 2) + 4 * n + (i & 3); }

struct Unit { int pm, pn; };
struct Gemm { const bf16_t* A; const bf16_t* Bt; int M, N, K; };

struct StaticOrder {
    int nM, nN, nwg, G, c;
    __host__ __device__ void init(int M, int N, int G_, int c_) { nM = M / BM; nN = N / BM; nwg = nM * nN; G = G_; c = c_; }
    __host__ __device__ bool next(int i, Unit& u) const {
        const long L = (long)i * G + c; if (L >= nwg) return false;
        int wgid = (int)L; { const int q = nwg / NXCD, r = nwg % NXCD, xcd = wgid % NXCD, off = wgid / NXCD; wgid = (xcd < r ? xcd * (q + 1) : r * (q + 1) + (xcd - r) * q) + off; }
        const int nig = WGM * nN, gid = wgid / nig, fm = gid * WGM, gsz = (nM - fm) < WGM ? (nM - fm) : WGM;
        u.pm = fm + ((wgid % nig) % gsz); u.pn = (wgid % nig) / gsz; return true;
    }
    __device__ __forceinline__ void a_ready(const Unit&) const {}
    __device__ __forceinline__ void done(const Unit&) const {}
};

__device__ __forceinline__ unsigned cvt_pk_bf16(float lo, float hi) { unsigned r; asm volatile("v_cvt_pk_bf16_f32 %0, %1, %2" : "=v"(r) : "v"(lo), "v"(hi)); return r; }
__device__ __forceinline__ float rstd16(const float* part, int r) {
    const f32x4* p = (const f32x4*)(part + (size_t)r * 16);
    const f32x4 a = p[0], b = p[1], c = p[2], d = p[3];
    const float s = ((a[0] + a[1]) + (a[2] + a[3])) + ((b[0] + b[1]) + (b[2] + b[3])) + ((c[0] + c[1]) + (c[2] + c[3])) + ((d[0] + d[1]) + (d[2] + d[3]));
    return 1.f / sqrtf(s * (1.f / 1024.f) + 1e-6f);
}
__device__ __forceinline__ u32x4 pack8(const f32x4 a, const f32x4 b) { u32x4 w; w.x = cvt_pk_bf16(a[0], a[1]); w.y = cvt_pk_bf16(a[2], a[3]); w.z = cvt_pk_bf16(b[0], b[1]); w.w = cvt_pk_bf16(b[2], b[3]); return w; }
#define rot(t1, t2, c, s) do { const float a_ = (t1) * (c) - (t2) * (s), b_ = (t1) * (s) + (t2) * (c); (t1) = a_; (t2) = b_; } while (0)

struct EpiProj {
    static constexpr bool PERM = true, AFTER_DRAIN = false;
    bf16_t* R; const float* part; const float* rope;
    __device__ __forceinline__ void operator()(const f32x4 (&acc)[2][2][4][2], const Unit& u, int wr, int wc, int fr, int fq) const {
        const int type = u.pn >> 1, hg = u.pn & 1;
        const int colbase = type * 512 + (4 * hg + wc) * 64 + 8 * fq;
        const bool do_rope = (type == 3) || (type == 4);
#pragma unroll
        for (int ai = 0; ai < 2; ++ai)
#pragma unroll
            for (int m = 0; m < 4; ++m) {
                const int r = u.pm * BM + ai * HALF + wr * 64 + m * 16 + fr;
                const float rs = rstd16(part, r);
                f32x4 a0 = acc[ai][0][m][0] * rs, a1 = acc[ai][0][m][1] * rs, b0 = acc[ai][1][m][0] * rs, b1 = acc[ai][1][m][1] * rs;
                if (do_rope) {
                    const f32x4* rp = (const f32x4*)(rope + ((size_t)(r & 2047) * 32 + 8 * fq) * 2);
                    const f32x4 c0 = rp[0], c1 = rp[1], c2 = rp[2], c3 = rp[3];
                    rot(a0[0], b0[0], c0[0], c0[1]); rot(a0[1], b0[1], c0[2], c0[3]); rot(a0[2], b0[2], c1[0], c1[1]); rot(a0[3], b0[3], c1[2], c1[3]);
                    rot(a1[0], b1[0], c2[0], c2[1]); rot(a1[1], b1[1], c2[2], c2[3]); rot(a1[2], b1[2], c3[0], c3[1]); rot(a1[3], b1[3], c3[2], c3[3]);
                }
                bf16_t* rowp = R + (size_t)r * 3584 + colbase;
                *(u32x4*)(rowp) = pack8(a0, a1);
                *(u32x4*)(rowp + 32) = pack8(b0, b1);
            }
    }
};
struct EpiRes {
    static constexpr bool PERM = true, AFTER_DRAIN = false;
    const float* base; float* out; bf16_t* hb; float* part; const float* bias;
    __device__ __forceinline__ void operator()(const f32x4 (&acc)[2][2][4][2], const Unit& u, int wr, int wc, int fr, int fq) const {
        const int col0 = u.pn * BM + wc * 32 + 8 * fq;
        f32x4 bv[2][2];
#pragma unroll
        for (int bj = 0; bj < 2; ++bj)
#pragma unroll
            for (int n = 0; n < 2; ++n) bv[bj][n] = bias ? *(const f32x4*)(bias + col0 + bj * HALF + 4 * n) : (f32x4){0.f, 0.f, 0.f, 0.f};
#pragma unroll
        for (int ai = 0; ai < 2; ++ai)
#pragma unroll
            for (int m = 0; m < 4; ++m) {
                const int r = u.pm * BM + ai * HALF + wr * 64 + m * 16 + fr;
                const size_t off = (size_t)r * 1024 + col0;
                float ss = 0.f;
#pragma unroll
                for (int bj = 0; bj < 2; ++bj) {
                    const f32x4 x0 = *(const f32x4*)(base + off + bj * HALF), x1 = *(const f32x4*)(base + off + bj * HALF + 4);
                    const f32x4 h0 = x0 + acc[ai][bj][m][0] + bv[bj][0], h1 = x1 + acc[ai][bj][m][1] + bv[bj][1];
                    *(f32x4*)(out + off + bj * HALF) = h0; *(f32x4*)(out + off + bj * HALF + 4) = h1;
                    *(u32x4*)(hb + off + bj * HALF) = pack8(h0, h1);
                    ss += (h0[0] * h0[0] + h0[1] * h0[1]) + (h0[2] * h0[2] + h0[3] * h0[3]) + (h1[0] * h1[0] + h1[1] * h1[1]) + (h1[2] * h1[2] + h1[3] * h1[3]);
                }
                ss += __shfl_xor(ss, 16); ss += __shfl_xor(ss, 32);
                if (fq == 0) part[(size_t)r * 16 + 4 * u.pn + wc] = ss;
            }
    }
};
struct EpiQ {
    static constexpr bool PERM = true, AFTER_DRAIN = false;
    bf16_t* O; const float* part;
    __device__ __forceinline__ void operator()(const f32x4 (&acc)[2][2][4][2], const Unit& u, int wr, int wc, int fr, int fq) const {
        const int col0 = u.pn * BM + wc * 32 + 8 * fq;
#pragma unroll
        for (int ai = 0; ai < 2; ++ai)
#pragma unroll
            for (int m = 0; m < 4; ++m) {
                const int r = u.pm * BM + ai * HALF + wr * 64 + m * 16 + fr;
                const float rs = rstd16(part, r);
                bf16_t* rowp = O + (size_t)r * 1024 + col0;
#pragma unroll
                for (int bj = 0; bj < 2; ++bj) *(u32x4*)(rowp + bj * HALF) = pack8(acc[ai][bj][m][0] * rs, acc[ai][bj][m][1] * rs);
            }
    }
};
struct EpiGlu {
    static constexpr bool PERM = true, AFTER_DRAIN = false;
    bf16_t* G; const float* part; const float* b1;
    __device__ __forceinline__ void operator()(const f32x4 (&acc)[2][2][4][2], const Unit& u, int wr, int wc, int fr, int fq) const {
        const int col = u.pn * 128 + wc * 32 + 8 * fq;
        f32x4 ba[2], bg[2];
#pragma unroll
        for (int n = 0; n < 2; ++n) { ba[n] = *(const f32x4*)(b1 + col + 4 * n); bg[n] = *(const f32x4*)(b1 + 1024 + col + 4 * n); }
#pragma unroll
        for (int ai = 0; ai < 2; ++ai)
#pragma unroll
            for (int m = 0; m < 4; ++m) {
                const int r = u.pm * BM + ai * HALF + wr * 64 + m * 16 + fr;
                const float rs = rstd16(part, r);
                f32x4 y[2];
#pragma unroll
                for (int n = 0; n < 2; ++n) {
                    const f32x4 a = acc[ai][0][m][n] * rs + ba[n], g = acc[ai][1][m][n] * rs + bg[n];
#pragma unroll
                    for (int i = 0; i < 4; ++i) y[n][i] = a[i] / (1.f + __expf(-g[i]));
                }
                *(u32x4*)(G + (size_t)r * 1024 + col) = pack8(y[0], y[1]);
            }
    }
};
template <class Epi, class Sched, bool ALIGN_EPI = false, bool SP2 = false>
__device__ __forceinline__ void gemm_phase(PG8_LAS unsigned char* lds, const Gemm g, const Sched& S, const Epi& E, const int wave_id) {
    const int lane = (int)__builtin_amdgcn_mbcnt_hi(~0u, __builtin_amdgcn_mbcnt_lo(~0u, 0u)), wid = wave_id, tid = wid * 64 + lane, wr = wid >> 2, wc = wid & 3, fr = lane & 15, fq = lane >> 4;
    const int K = g.K, nt = K / BK;
    unsigned voffA[2], voffB[2];
#pragma unroll
    for (int i = 0; i < 2; ++i) { int R, C; stage_rc(tid * 16 + i * 8192, R, C); const int Rb = Epi::PERM ? ((R & ~31) + perm32(R & 31)) : R;
        voffA[i] = (unsigned)(R * K + C) * 2u; voffB[i] = (unsigned)(Rb * K + C) * 2u; }
    const size_t kstep = (size_t)(BK * 2);
    const size_t hstep = (size_t)HALF * K * 2;
    const size_t tstep = 2 * hstep;
    const unsigned ldsw = (unsigned)wid * 1024u;
    const int aoff = lds_byte(wr * 64 + fr, fq * 8), boff = lds_byte(wc * 32 + fr, fq * 8);
#define PG8_SA(b, h) (((b) * 2 + (h)) * HTB)
#define PG8_SB(b, h) ((4 + (b) * 2 + (h)) * HTB)
#define PG8_STAGE(bufoff, gbase, voff) do { _Pragma("unroll") for (int _i = 0; _i < 2; ++_i) \
        __builtin_amdgcn_global_load_lds((const unsigned*)((const char*)(gbase) + (voff)[_i]), (PG8_LAS unsigned*)(lds + (bufoff) + ldsw + _i * 8192), 16, 0, 0); } while (0)
#define PG8_LDA(dst, b, h) do { _Pragma("unroll") for (int m = 0; m < 4; ++m) _Pragma("unroll") for (int k = 0; k < 2; ++k) dst[m][k] = *(const PG8_LAS bf16x8*)(lds + PG8_SA(b, h) + aoff + m * 2048 + k * 1024); } while (0)
#define PG8_LDB(dst, b, h) do { _Pragma("unroll") for (int n = 0; n < 2; ++n) _Pragma("unroll") for (int k = 0; k < 2; ++k) dst[n][k] = *(const PG8_LAS bf16x8*)(lds + PG8_SB(b, h) + boff + n * 2048 + k * 1024); } while (0)
#define PG8_MMA(ai, bj, At, Bt) do { __builtin_amdgcn_s_setprio(1); _Pragma("unroll") for (int m = 0; m < 4; ++m) _Pragma("unroll") for (int n = 0; n < 2; ++n) _Pragma("unroll") for (int k = 0; k < 2; ++k) \
        acc[ai][bj][m][n] = __builtin_amdgcn_mfma_f32_16x16x32_bf16(Bt[n][k], At[m][k], acc[ai][bj][m][n], 0, 0, 0); __builtin_amdgcn_s_setprio(0); } while (0)
#define PG8_WAIT_V(n) asm volatile("s_waitcnt vmcnt(" #n ")" ::: "memory")
#define PG8_WAIT_L(n) asm volatile("s_waitcnt lgkmcnt(" #n ")" ::: "memory")
#define PG8_BAR __builtin_amdgcn_s_barrier()
#define PG8_SCHED __builtin_amdgcn_sched_barrier(0)
    Unit cur, nxt; int ui = 0;
    if (!S.next(0, cur)) return;
    f32x4 acc[2][2][4][2];
#pragma unroll
    for (int a = 0; a < 2; ++a)
#pragma unroll
        for (int b = 0; b < 2; ++b)
#pragma unroll
            for (int m = 0; m < 4; ++m)
#pragma unroll
                for (int n = 0; n < 2; ++n) acc[a][b][m][n] = (f32x4){0.f, 0.f, 0.f, 0.f};
    bf16x8 At[4][2], B0[2][2], B1[2][2];
    const char* cA = (const char*)g.A + (size_t)cur.pm * tstep; const char* cB = (const char*)g.Bt + (size_t)cur.pn * tstep;
    S.a_ready(cur);
    if constexpr (SP2) {
        PG8_STAGE(PG8_SB(0, 0), cB, voffB); PG8_STAGE(PG8_SB(0, 1), cB + hstep, voffB); PG8_STAGE(PG8_SA(0, 0), cA, voffA); PG8_STAGE(PG8_SA(0, 1), cA + hstep, voffA);
        if (wr == 1) PG8_BAR;
        PG8_WAIT_V(2); PG8_BAR;
        PG8_STAGE(PG8_SB(1, 0), cB + kstep, voffB); PG8_STAGE(PG8_SA(1, 0), cA + kstep, voffA); PG8_STAGE(PG8_SB(1, 1), cB + hstep + kstep, voffB);
        PG8_WAIT_V(6); PG8_BAR;
    } else {
        PG8_STAGE(PG8_SB(0, 0), cB, voffB); PG8_STAGE(PG8_SA(0, 0), cA, voffA); PG8_STAGE(PG8_SB(0, 1), cB + hstep, voffB); PG8_STAGE(PG8_SA(0, 1), cA + hstep, voffA);
        if (wr == 1) PG8_BAR;
        PG8_WAIT_V(4); PG8_BAR;
        PG8_STAGE(PG8_SB(1, 0), cB + kstep, voffB); PG8_STAGE(PG8_SA(1, 0), cA + kstep, voffA); PG8_STAGE(PG8_SB(1, 1), cB + hstep + kstep, voffB);
        PG8_WAIT_V(6); PG8_BAR;
    }
    for (;;) {
        const bool has_next = S.next(ui + 1, nxt);
        const char* nA = has_next ? (const char*)g.A + (size_t)nxt.pm * tstep : cA; const char* nB = has_next ? (const char*)g.Bt + (size_t)nxt.pn * tstep : cB;
        for (int t = 0; t < nt; t += 2) {
            const bool last = (t == nt - 2);
            const char* a1 = cA + (size_t)(t + 1) * kstep;
            const char* a2 = last ? nA : cA + (size_t)(t + 2) * kstep; const char* b2 = last ? nB : cB + (size_t)(t + 2) * kstep;
            const char* a3 = a2 + kstep; const char* b3 = b2 + kstep;
            if (last && has_next) S.a_ready(nxt);
            if constexpr (SP2) {
            PG8_LDB(B0, 0, 0); PG8_LDB(B1, 0, 1); PG8_SCHED; PG8_LDA(At, 0, 0); PG8_STAGE(PG8_SA(1, 1), a1 + hstep, voffA);
            PG8_WAIT_V(8); PG8_WAIT_L(0); PG8_BAR; PG8_MMA(0, 0, At, B0); PG8_MMA(0, 1, At, B1); PG8_BAR; PG8_SCHED;
            PG8_LDA(At, 0, 1); PG8_STAGE(PG8_SB(0, 0), b2, voffB); PG8_STAGE(PG8_SB(0, 1), b2 + hstep, voffB); PG8_STAGE(PG8_SA(0, 0), a2, voffA);
            PG8_WAIT_V(8); PG8_WAIT_L(0); PG8_BAR; PG8_MMA(1, 0, At, B0); PG8_MMA(1, 1, At, B1); PG8_BAR; PG8_SCHED;
            PG8_LDB(B0, 1, 0); PG8_LDB(B1, 1, 1); PG8_SCHED; PG8_LDA(At, 1, 0); PG8_STAGE(PG8_SA(0, 1), a2 + hstep, voffA);
            PG8_WAIT_V(8); PG8_WAIT_L(0); PG8_BAR; PG8_MMA(0, 0, At, B0); PG8_MMA(0, 1, At, B1); PG8_BAR; PG8_SCHED;
            PG8_LDA(At, 1, 1); PG8_STAGE(PG8_SB(1, 0), b3, voffB); PG8_STAGE(PG8_SB(1, 1), b3 + hstep, voffB); PG8_STAGE(PG8_SA(1, 0), a3, voffA);
            PG8_WAIT_V(8); PG8_WAIT_L(0); PG8_BAR; PG8_MMA(1, 0, At, B0); PG8_MMA(1, 1, At, B1); PG8_BAR; PG8_SCHED;
            } else {
            PG8_LDB(B0, 0, 0); PG8_SCHED; PG8_LDA(At, 0, 0); PG8_STAGE(PG8_SA(1, 1), a1 + hstep, voffA);
            PG8_WAIT_L(8); PG8_BAR; PG8_WAIT_L(0); PG8_MMA(0, 0, At, B0); PG8_BAR; PG8_SCHED;
            PG8_LDB(B1, 0, 1); PG8_STAGE(PG8_SB(0, 0), b2, voffB);
            PG8_BAR; PG8_WAIT_L(0); PG8_MMA(0, 1, At, B1); PG8_BAR;
            PG8_LDA(At, 0, 1); PG8_STAGE(PG8_SA(0, 0), a2, voffA);
            PG8_BAR; PG8_WAIT_L(0); PG8_MMA(1, 0, At, B0); PG8_BAR; PG8_SCHED;
            PG8_STAGE(PG8_SB(0, 1), b2 + hstep, voffB);
            PG8_WAIT_V(6); PG8_BAR; PG8_MMA(1, 1, At, B1); PG8_BAR;
            PG8_LDB(B0, 1, 0); PG8_SCHED; PG8_LDA(At, 1, 0); PG8_STAGE(PG8_SA(0, 1), a2 + hstep, voffA);
            PG8_WAIT_L(8); PG8_BAR; PG8_WAIT_L(0); PG8_MMA(0, 0, At, B0); PG8_BAR; PG8_SCHED;
            PG8_LDB(B1, 1, 1); PG8_STAGE(PG8_SB(1, 0), b3, voffB);
            PG8_BAR; PG8_WAIT_L(0); PG8_MMA(0, 1, At, B1); PG8_BAR;
            PG8_LDA(At, 1, 1); PG8_STAGE(PG8_SA(1, 0), a3, voffA);
            PG8_BAR; PG8_WAIT_L(0); PG8_MMA(1, 0, At, B0); PG8_BAR; PG8_SCHED;
            PG8_STAGE(PG8_SB(1, 1), b3 + hstep, voffB);
            PG8_WAIT_V(6); PG8_BAR; PG8_MMA(1, 1, At, B1); PG8_BAR;
            }
        }
        if constexpr (ALIGN_EPI) { if (wr == 0) PG8_BAR; }
        if constexpr (!Epi::AFTER_DRAIN) { E(acc, cur, wr, wc, fr, fq); S.done(cur); }
        if (!has_next) break;
#pragma unroll
        for (int a = 0; a < 2; ++a)
#pragma unroll
            for (int b = 0; b < 2; ++b)
#pragma unroll
                for (int m = 0; m < 4; ++m)
#pragma unroll
                    for (int n = 0; n < 2; ++n) acc[a][b][m][n] = (f32x4){0.f, 0.f, 0.f, 0.f};
        cur = nxt; cA = nA; cB = nB; ++ui;
        if constexpr (ALIGN_EPI) { if (wr == 1) PG8_BAR; }
    }
    PG8_WAIT_V(0);
    if constexpr (!ALIGN_EPI) { if (wr == 0) PG8_BAR; }
    PG8_BAR;
    if constexpr (Epi::AFTER_DRAIN) { E.fused(acc, cur, wr, wc, fr, fq, lds, wid, lane); S.done(cur); }
#undef PG8_SA
#undef PG8_SB
#undef PG8_STAGE
#undef PG8_LDA
#undef PG8_LDB
#undef PG8_MMA
#undef PG8_WAIT_V
#undef PG8_WAIT_L
#undef PG8_BAR
#undef PG8_SCHED
}
}

struct Frame {
    LAS unsigned char* lds;
    int wave, G, bid;
    const float *x, *mix_norm, *ffn_norm, *final_norm, *w_in, *w_out, *rel_bias, *conv_w1, *conv_b1, *conv_dw, *conv_dw_b, *conv_ln_g, *conv_ln_b, *conv_w2, *conv_b2,
        *peer_wq, *peer_keys, *peer_u, *peer_v;
    float* out;
    unsigned char* ws;
};
#define FRAME_IDS const int f_lane = lane_id(); const int f_tid = F.wave * 64 + f_lane; (void)f_tid
DI float gamma_of(int h) { return 1.f - exp2f(-5.f - (float)h); }

DI void p0_prep(Frame& F) {
    FRAME_IDS;
    const int gw = F.bid * NWAVES + F.wave, NGW = F.G * NWAVES;
    f32x2* rope = (f32x2*)(F.ws + WS_ROPE);
    for (int i = F.bid * NTHR + f_tid; i < SEQ * 32; i += F.G * NTHR) {
        const int s = i >> 5, j = i & 31;
        const float inv = powf(10000.f, -(float)j / 32.f);
        const float ang = (float)s * inv;
        float sn, cs; sincosf(ang, &sn, &cs);
        rope[i] = (f32x2){cs, sn};
    }
    bf16* xb = (bf16*)(F.ws + WS_XB); float* part = (float*)(F.ws + WS_PART);
    for (int m = gw; m < T; m += NGW) {
        const f32x4* xr = (const f32x4*)(F.x + (size_t)m * DM) + f_lane;
        u32x2* o = (u32x2*)(xb + (size_t)m * DM) + f_lane;
        float s = 0.f;
#pragma unroll
        for (int j = 0; j < 4; ++j) { const f32x4 v = xr[64 * j]; s += v.x * v.x + v.y * v.y + v.z * v.z + v.w * v.w; o[64 * j] = (u32x2){pk2(v.x, v.y), pk2(v.z, v.w)}; }
        s = wave_sum(s);
        if (f_lane < 16) part[(size_t)m * 16 + f_lane] = (f_lane == 0) ? s : 0.f;
    }
}
DI void p0_transpose_item(const float* W, int K, int N, bf16* WT, int prow0, const float* gain, float scale, LAS float* scr, int k0, int n0, int lane) {
#pragma unroll 8
    for (int i = 0; i < 32; ++i) { const int kk = 2 * i + (lane >> 5); scr[kk * 33 + (lane & 31)] = W[(size_t)(k0 + kk) * N + n0 + (lane & 31)] * (gain ? gain[k0 + kk] : 1.f) * scale; }
    asm volatile("s_waitcnt lgkmcnt(0)" ::: "memory");
    const int c = lane & 7;
#pragma unroll
    for (int j = 0; j < 4; ++j) { const int n = (lane >> 3) + 8 * j; const LAS float* q = scr + (8 * c) * 33 + n;
        u32x4 o; o.x = pk2(q[0 * 33], q[1 * 33]); o.y = pk2(q[2 * 33], q[3 * 33]); o.z = pk2(q[4 * 33], q[5 * 33]); o.w = pk2(q[6 * 33], q[7 * 33]);
        *(u32x4*)(WT + (size_t)(prow0 + n) * K + k0 + 8 * c) = o; }
    asm volatile("s_waitcnt lgkmcnt(0)" ::: "memory");
}
DI void p0_weights(Frame& F) {
    FRAME_IDS;
    LAS float* scr = (LAS float*)(F.lds + F.wave * 16384);
    const int gw = F.bid * NWAVES + F.wave, NGW = F.G * NWAVES;
    constexpr int I_IN = 16 * (INC / 32), I_SQ = 16 * (DM / 32), I_W1 = 16 * (2 * DM / 32);
    constexpr int NITEMS = I_IN + I_SQ + I_W1 + I_SQ + 2 * I_SQ;
    for (int it = gw; it < NITEMS; it += NGW) {
        int r = it;
        if (r < I_IN) { const int nb = r % (INC / 32), kb = r / (INC / 32), n0 = nb * 32;
            const int type = n0 / 512, head = (n0 % 512) / 64, bj = (n0 % 64) / 32;
            const int prow0 = 256 * (2 * type + head / 4) + 128 * bj + 32 * (head % 4);
            p0_transpose_item(F.w_in, DM, INC, (bf16*)(F.ws + WS_WIN), prow0, F.mix_norm, (type == 0 || type == 4) ? 0.125f : 1.f, scr, kb * 64, n0, f_lane); continue; }
        r -= I_IN;
        if (r < I_SQ) { const int nb = r % 32, kb = r / 32; p0_transpose_item(F.w_out, DM, DM, (bf16*)(F.ws + WS_WOUT), nb * 32, nullptr, 1.f, scr, kb * 64, nb * 32, f_lane); continue; }
        r -= I_SQ;
        if (r < I_W1) { const int nb = r % 64, kb = r / 64, n0 = nb * 32; const int bj = n0 / 1024, rem = n0 % 1024;
            p0_transpose_item(F.conv_w1, DM, 2 * DM, (bf16*)(F.ws + WS_W1), 256 * (rem / 128) + 128 * bj + (rem % 128), F.mix_norm + DM, 1.f, scr, kb * 64, n0, f_lane); continue; }
        r -= I_W1;
        if (r < I_SQ) { const int nb = r % 32, kb = r / 32; p0_transpose_item(F.conv_w2, DM, DM, (bf16*)(F.ws + WS_W2), nb * 32, nullptr, 1.f, scr, kb * 64, nb * 32, f_lane); continue; }
        r -= I_SQ;
        { const int layer = r / I_SQ; r %= I_SQ; const int nb = r % 32, kb = r / 32;
          p0_transpose_item(F.peer_wq + (size_t)layer * DM * DM, DM, DM, (bf16*)(F.ws + WS_WQ) + (size_t)layer * DM * DM, nb * 32, F.ffn_norm + layer * DM, 1.f, scr, kb * 64, nb * 32, f_lane); }
    }
}
DI float row_rstd(const float* part, int m) {
    const f32x4* p = (const f32x4*)(part + (size_t)m * 16);
    const f32x4 a = p[0], b = p[1], c = p[2], d = p[3];
    const float s = ((a.x + a.y) + (a.z + a.w)) + ((b.x + b.y) + (b.z + b.w)) + ((c.x + c.y) + (c.z + c.w)) + ((d.x + d.y) + (d.z + d.w));
    return 1.f / sqrtf(s * (1.f / DM) + EPS);
}

enum { EP_PROJ = 0, EP_RES = 1, EP_Q = 2, EP_HID = 3 };
template <int EP>
DI void naive_gemm(Frame& F, const bf16* A, const float* W, int N, const float* gain, const float* bias, bf16* Ob, int ldo) {
    FRAME_IDS;
    LAS float* As = (LAS float*)F.lds;
    LAS float* Bs = As + 16 * 129;
    LAS float* rs = Bs + 16 * 64;
    const float* part = (const float*)(F.ws + WS_PART);
    const f32x2* rope = (const f32x2*)(F.ws + WS_ROPE);
    bf16* hb = (bf16*)(F.ws + WS_XB);
    const int tid = f_tid, tx = tid & 15, ty = tid >> 4;
    const int nN = N / 64, nItems = (T / 128) * nN;
    for (int it = F.bid; it < nItems; it += F.G) {
        const int m0 = (it / nN) * 128, n0 = (it % nN) * 64;
        __syncthreads();
        if (EP != EP_RES) { if (tid < 128) rs[tid] = row_rstd(part, m0 + tid); }
        float acc[4][4];
#pragma unroll
        for (int i = 0; i < 4; ++i)
#pragma unroll
            for (int j = 0; j < 4; ++j) acc[i][j] = 0.f;
        for (int k0 = 0; k0 < DM; k0 += 16) {
            {   const int r = tid >> 2, kk = (tid & 3) * 4;
                const u32x2 v = *(const u32x2*)(A + (size_t)(m0 + r) * DM + k0 + kk);
                As[(kk + 0) * 129 + r] = __uint_as_float(v.x << 16); As[(kk + 1) * 129 + r] = __uint_as_float(v.x & 0xffff0000u);
                As[(kk + 2) * 129 + r] = __uint_as_float(v.y << 16); As[(kk + 3) * 129 + r] = __uint_as_float(v.y & 0xffff0000u); }
            {   const int kk = tid >> 5, c = (tid & 31) * 2;
                const f32x2 v = *(const f32x2*)(W + (size_t)(k0 + kk) * N + n0 + c);
                const float g = gain ? gain[k0 + kk] : 1.f;
                Bs[kk * 64 + c] = v.x * g; Bs[kk * 64 + c + 1] = v.y * g; }
            __syncthreads();
#pragma unroll
            for (int kk = 0; kk < 16; ++kk) {
                float a[4], b[4];
#pragma unroll
                for (int i = 0; i < 4; ++i) a[i] = As[kk * 129 + ty * 4 + i];
                b[0] = Bs[kk * 64 + 2 * tx]; b[1] = Bs[kk * 64 + 2 * tx + 1]; b[2] = Bs[kk * 64 + 32 + 2 * tx]; b[3] = Bs[kk * 64 + 33 + 2 * tx];
#pragma unroll
                for (int i = 0; i < 4; ++i)
#pragma unroll
                    for (int j = 0; j < 4; ++j) acc[i][j] += a[i] * b[j];
            }
            __syncthreads();
        }
#pragma unroll
        for (int i = 0; i < 4; ++i) {
            const int m = m0 + ty * 4 + i;
            const int cols[4] = {n0 + 2 * tx, n0 + 2 * tx + 1, n0 + 32 + 2 * tx, n0 + 33 + 2 * tx};
            float v[4] = {acc[i][0], acc[i][1], acc[i][2], acc[i][3]};
            if (EP == EP_PROJ) {
                const float r = rs[ty * 4 + i];
#pragma unroll
                for (int j = 0; j < 4; ++j) v[j] *= r;
                const int type = n0 / 512;
                if (type == 3 || type == 4) {
                    const int s = m % SEQ;
#pragma unroll
                    for (int j = 0; j < 2; ++j) {
                        const f32x2 cs = rope[s * 32 + 2 * tx + j];
                        const float t1 = v[j], t2 = v[j + 2];
                        v[j] = t1 * cs.x - t2 * cs.y; v[j + 2] = t1 * cs.y + t2 * cs.x;
                    }
                }
                if (type == 0 || type == 4) {
#pragma unroll
                    for (int j = 0; j < 4; ++j) v[j] *= 0.125f;
                }
#pragma unroll
                for (int j = 0; j < 4; ++j) Ob[(size_t)m * ldo + cols[j]] = (bf16)f2bf(v[j]);
            } else if (EP == EP_RES) {
#pragma unroll
                for (int j = 0; j < 4; ++j) {
                    const size_t o = (size_t)m * DM + cols[j];
                    const float base = (Ob == nullptr) ? F.x[o] : F.out[o];
                    const float hn = base + v[j] + (bias ? bias[cols[j]] : 0.f);
                    F.out[o] = hn; hb[o] = (bf16)f2bf(hn);
                }
            } else if (EP == EP_Q) {
                const float r = rs[ty * 4 + i];
#pragma unroll
                for (int j = 0; j < 4; ++j) Ob[(size_t)m * ldo + cols[j]] = (bf16)f2bf(v[j] * r);
            } else {
                const float r = rs[ty * 4 + i];
#pragma unroll
                for (int j = 0; j < 4; ++j) Ob[(size_t)m * ldo + cols[j]] = (bf16)f2bf(v[j] * r + bias[cols[j]]);
            }
        }
    }
}

DI void naive_rowstat(Frame& F) {
    FRAME_IDS;
    const int gw = F.bid * NWAVES + F.wave, NGW = F.G * NWAVES;
    float* part = (float*)(F.ws + WS_PART);
    for (int m = gw; m < T; m += NGW) {
        const f32x4* xr = (const f32x4*)(F.out + (size_t)m * DM) + f_lane;
        float s = 0.f;
#pragma unroll
        for (int j = 0; j < 4; ++j) { const f32x4 v = xr[64 * j]; s += v.x * v.x + v.y * v.y + v.z * v.z + v.w * v.w; }
        s = wave_sum(s);
        if (f_lane < 16) part[(size_t)m * 16 + f_lane] = (f_lane == 0) ? s : 0.f;
    }
}

DI void naive_attn(Frame& F) {
    FRAME_IDS;
    const bf16* R = (const bf16*)(F.ws + WS_R); bf16* O = (bf16*)(F.ws + WS_O);
    LAS float* Ks = (LAS float*)F.lds;
    LAS float* Vs = Ks + 64 * 65;
    LAS float* bs = Vs + 64 * 65;
    const int tid = f_tid;
    for (int it = F.bid; it < NB * NHA * 4; it += F.G) {
        const int b = it / (NHA * 4), h = (it / 4) % NHA, cg = it % 4;
        const int c = cg * 8 + (tid >> 6), i = tid & 63;
        __syncthreads();
        for (int k = tid; k < 257; k += NTHR) bs[k] = F.rel_bias[h * 257 + k];
        float q[64], acc[64];
        {   const bf16* qp = R + (size_t)(b * SEQ + c * 64 + i) * INC + C_QA + h * 64;
#pragma unroll
            for (int d = 0; d < 64; ++d) { q[d] = bf2f(qp[d]); acc[d] = 0.f; } }
        float mx = -1e30f, l = 0.f;
        const int t_lo = (cg * 8 - 8) < 0 ? 0 : (cg * 8 - 8), t_hi = cg * 8 + 7;
        for (int tc = t_lo; tc <= t_hi; ++tc) {
            __syncthreads();
            for (int e = tid; e < 64 * 64; e += NTHR) {
                const int j = e >> 6, d = e & 63;
                const size_t row = (size_t)(b * SEQ + tc * 64 + j) * INC;
                Ks[j * 65 + d] = bf2f(R[row + C_KA + h * 64 + d]);
                Vs[j * 65 + d] = bf2f(R[row + C_VA + h * 64 + d]);
            }
            __syncthreads();
            if (tc <= c && tc >= c - 8) {
                for (int j = 0; j < 64; ++j) {
                    float s = 0.f;
#pragma unroll
                    for (int d = 0; d < 64; ++d) s += q[d] * Ks[j * 65 + d];
                    int rel = (c * 64 + i) - (tc * 64 + j); rel = rel < -128 ? -128 : (rel > 128 ? 128 : rel);
                    s += bs[rel + 128];
                    const float mn = fmaxf(mx, s), corr = __expf(mx - mn), p = __expf(s - mn);
                    l = l * corr + p;
#pragma unroll
                    for (int d = 0; d < 64; ++d) acc[d] = acc[d] * corr + p * Vs[j * 65 + d];
                    mx = mn;
                }
            }
        }
        const float inv = 1.f / l;
        bf16* op = O + (size_t)(b * SEQ + c * 64 + i) * DM + h * 64;
#pragma unroll
        for (int d = 0; d < 64; ++d) op[d] = (bf16)f2bf(acc[d] * inv);
    }
}


typedef short v4i16 __attribute__((ext_vector_type(4)));
typedef __bf16 bf16x2_t __attribute__((ext_vector_type(2)));
DI unsigned cvtpk(float lo, float hi) { f32x2 v = {lo, hi}; bf16x2_t b = __builtin_convertvector(v, bf16x2_t); return __builtin_bit_cast(unsigned, b); }
DI v4i16 ds_tr16(LAS const unsigned char* p) { return __builtin_amdgcn_ds_read_tr16_b64_v4i16((LAS v4i16*)p); }
DI int crow(int r, int h) { return (r & 3) + 8 * (r >> 2) + 4 * h; }
DI bf16x8 pack_step(const f32x16& x, const int s) {
    u32x4 w = {cvtpk(x[8 * s + 0], x[8 * s + 1]), cvtpk(x[8 * s + 2], x[8 * s + 3]), cvtpk(x[8 * s + 4], x[8 * s + 5]), cvtpk(x[8 * s + 6], x[8 * s + 7])};
    return __builtin_bit_cast(bf16x8, w);
}
constexpr int AT_KB = 64 * 144, AT_VB = 8192, AT_BUF = AT_KB + AT_VB, AT_BIAS = 2 * AT_BUF;
DI void opt_attn(Frame& F) {
    FRAME_IDS;
    const bf16* R = (const bf16*)(F.ws + WS_R); bf16* O = (bf16*)(F.ws + WS_O);
    LAS unsigned char* lds = F.lds;
    LAS float* bias_s = (LAS float*)(lds + AT_BIAS);
    const int q32 = f_lane & 31, h = f_lane >> 5, w = F.wave;
    const int srow = f_tid >> 3, sch = f_tid & 7;
    const int vtr_off = ((f_lane & 15) >> 2) * 64 + (16 * ((f_lane >> 4) & 1) + 4 * (f_lane & 3)) * 2;
    for (int it = F.bid; it < NB * NHA * 8; it += F.G) {
        const int b = it / (NHA * 8), hd = (it / 8) % NHA, c0 = (it % 8) * 4;
        const int c = c0 + (w >> 1), qrow0 = 32 * (w & 1);
        const size_t tq = (size_t)b * SEQ + c * 64 + qrow0 + q32;
        __syncthreads();
        for (int k = f_tid; k < 257; k += NTHR) bias_s[k] = F.rel_bias[hd * 257 + k];
        bf16x8 qf[4];
#pragma unroll
        for (int ks = 0; ks < 4; ++ks) qf[ks] = *(const bf16x8*)(R + tq * INC + C_QA + hd * 64 + 16 * ks + 8 * h);
        const int t_lo = c0 - 8 < 0 ? 0 : c0 - 8, t_hi = c0 + 3, ntile = t_hi - t_lo + 1;
        const bf16* kbase = R + ((size_t)b * SEQ + srow) * INC + C_KA + hd * 64 + 8 * sch;
        const bf16* vbase = R + ((size_t)b * SEQ + srow) * INC + C_VA + hd * 64 + 8 * sch;
        u32x4 kreg = *(const u32x4*)(kbase + (size_t)t_lo * 64 * INC), vreg = *(const u32x4*)(vbase + (size_t)t_lo * 64 * INC);
        *(LAS u32x4*)(lds + srow * 144 + sch * 16) = kreg;
        *(LAS u32x4*)(lds + AT_KB + (sch >> 2) * 4096 + srow * 64 + (sch & 3) * 16) = vreg;
        __syncthreads();
        const float bias_far = bias_s[256];
        float m = -1e30f, l = 0.f;
        f32x16 o0 = {}, o1 = {};
        for (int i = 0; i < ntile; ++i) {
            const int tc = t_lo + i;
            LAS unsigned char* kb = lds + (i & 1) * AT_BUF; LAS unsigned char* vb = kb + AT_KB;
            if (i + 1 < ntile) { kreg = *(const u32x4*)(kbase + (size_t)(tc + 1) * 64 * INC); vreg = *(const u32x4*)(vbase + (size_t)(tc + 1) * 64 * INC); }
            const int D = c - tc;
            if (D >= 0 && D <= 8) {
                const float init = D >= 3 ? bias_far : 0.f;
                f32x16 p0, p1;
#pragma unroll
                for (int r = 0; r < 16; ++r) { p0[r] = init; p1[r] = init; }
#pragma unroll
                for (int ks = 0; ks < 4; ++ks) {
                    const bf16x8 k0 = *(const LAS bf16x8*)(kb + q32 * 144 + (16 * ks + 8 * h) * 2);
                    const bf16x8 k1 = *(const LAS bf16x8*)(kb + (32 + q32) * 144 + (16 * ks + 8 * h) * 2);
                    p0 = __builtin_amdgcn_mfma_f32_32x32x16_bf16(k0, qf[ks], p0, 0, 0, 0);
                    p1 = __builtin_amdgcn_mfma_f32_32x32x16_bf16(k1, qf[ks], p1, 0, 0, 0);
                }
                if (D < 3) {
                    const int relb = D * 64 + qrow0 + q32 - 4 * h + 128;
#pragma unroll
                    for (int r = 0; r < 16; ++r) {
                        const int r0 = relb - ((r & 3) + 8 * (r >> 2));
                        const int i0 = r0 < 0 ? 0 : (r0 > 256 ? 256 : r0), r1 = r0 - 32, i1 = r1 < 0 ? 0 : (r1 > 256 ? 256 : r1);
                        p0[r] += bias_s[i0]; p1[r] += bias_s[i1];
                    }
                }
                float tm = fmaxf(p0[0], p1[0]);
#pragma unroll
                for (int r = 1; r < 16; ++r) tm = fmaxf(tm, fmaxf(p0[r], p1[r]));
                tm = fmaxf(tm, __shfl_xor(tm, 32));
                const float mn = fmaxf(m, tm), alpha = __expf(m - mn);
                m = mn;
                float ps = 0.f;
#pragma unroll
                for (int r = 0; r < 16; ++r) { p0[r] = __expf(p0[r] - mn); p1[r] = __expf(p1[r] - mn); ps += p0[r] + p1[r]; }
                l = l * alpha + ps;
#pragma unroll
                for (int r = 0; r < 16; ++r) { o0[r] *= alpha; o1[r] *= alpha; }
                bf16x8 pf[4];
                pf[0] = pack_step(p0, 0); pf[1] = pack_step(p0, 1); pf[2] = pack_step(p1, 0); pf[3] = pack_step(p1, 1);
#pragma unroll
                for (int kk = 0; kk < 4; ++kk) {
                    const int key0 = 16 * kk + 4 * h;
                    const v4i16 a0l = ds_tr16(vb + key0 * 64 + vtr_off), a0h = ds_tr16(vb + (key0 + 8) * 64 + vtr_off);
                    const v4i16 a1l = ds_tr16(vb + 4096 + key0 * 64 + vtr_off), a1h = ds_tr16(vb + 4096 + (key0 + 8) * 64 + vtr_off);
                    const bf16x8 a0 = __builtin_shufflevector(a0l, a0h, 0, 1, 2, 3, 4, 5, 6, 7), a1 = __builtin_shufflevector(a1l, a1h, 0, 1, 2, 3, 4, 5, 6, 7);
                    o0 = __builtin_amdgcn_mfma_f32_32x32x16_bf16(a0, pf[kk], o0, 0, 0, 0);
                    o1 = __builtin_amdgcn_mfma_f32_32x32x16_bf16(a1, pf[kk], o1, 0, 0, 0);
                }
            }
            if (i + 1 < ntile) {
                LAS unsigned char* nb = lds + ((i + 1) & 1) * AT_BUF;
                *(LAS u32x4*)(nb + srow * 144 + sch * 16) = kreg;
                *(LAS u32x4*)(nb + AT_KB + (sch >> 2) * 4096 + srow * 64 + (sch & 3) * 16) = vreg;
            }
            __syncthreads();
        }
        l += __shfl_xor(l, 32);
        const float inv = 1.f / l;
        bf16* op = O + tq * DM + hd * 64 + 4 * h;
#pragma unroll
        for (int g = 0; g < 4; ++g) {
            *(u32x2*)(op + 8 * g) = (u32x2){cvtpk(o0[4 * g] * inv, o0[4 * g + 1] * inv), cvtpk(o0[4 * g + 2] * inv, o0[4 * g + 3] * inv)};
            *(u32x2*)(op + 32 + 8 * g) = (u32x2){cvtpk(o1[4 * g] * inv, o1[4 * g + 1] * inv), cvtpk(o1[4 * g + 2] * inv, o1[4 * g + 3] * inv)};
        }
    }
    __syncthreads();
}
DI void naive_ret(Frame& F) {
    FRAME_IDS;
    const bf16* R = (const bf16*)(F.ws + WS_R); bf16* O = (bf16*)(F.ws + WS_O);
    LAS float* St = (LAS float*)F.lds;
    LAS float* Qs = St + 4096;
    LAS float* Ks = Qs + 64 * 65;
    LAS float* Vs = Ks + 64 * 65;
    LAS float* Sc = Vs + 64 * 65;
    LAS float* Ot = Sc + 64 * 65;
    const int tid = f_tid;
    for (int it = F.G - 1 - F.bid; it < NB * NHB; it += F.G) {
        const int b = it / NHB, h = it % NHB;
        const float lg = logf(gamma_of(h));
        const float cd = __expf(lg * 64.f);
        __syncthreads();
        for (int e = tid; e < 4096; e += NTHR) St[e] = 0.f;
        for (int n = 0; n < NCH; ++n) {
            __syncthreads();
            for (int e = tid; e < 4096; e += NTHR) {
                const int j = e >> 6, d = e & 63;
                const size_t row = (size_t)(b * SEQ + n * 64 + j) * INC;
                Qs[j * 65 + d] = bf2f(R[row + C_QB + h * 64 + d]);
                Ks[j * 65 + d] = bf2f(R[row + C_KB + h * 64 + d]);
                Vs[j * 65 + d] = bf2f(R[row + C_VB + h * 64 + d]);
            }
            __syncthreads();
            for (int e = tid; e < 4096; e += NTHR) {
                const int i = e >> 6, j = e & 63;
                float s = 0.f;
#pragma unroll
                for (int d = 0; d < 64; ++d) s += Qs[i * 65 + d] * Ks[j * 65 + d];
                const int ad = i > j ? i - j : j - i;
                Sc[i * 65 + j] = s * __expf(lg * (float)ad);
            }
            __syncthreads();
            for (int e = tid; e < 4096; e += NTHR) {
                const int i = e >> 6, ee = e & 63;
                float s = 0.f, cr = 0.f;
#pragma unroll
                for (int j = 0; j < 64; ++j) s += Sc[i * 65 + j] * Vs[j * 65 + ee];
#pragma unroll
                for (int d = 0; d < 64; ++d) cr += Qs[i * 65 + d] * St[d * 64 + ee];
                Ot[i * 65 + ee] = s + cr * __expf(lg * (float)(i + 1));
            }
            __syncthreads();
            for (int e = tid; e < 4096; e += NTHR) {
                const int d = e >> 6, ee = e & 63;
                float s = 0.f;
                for (int j = 0; j < 64; ++j) s += Ks[j * 65 + d] * __expf(lg * (float)(63 - j)) * Vs[j * 65 + ee];
                St[d * 64 + ee] = cd * St[d * 64 + ee] + s;
            }
            for (int r = 0; r < 8; ++r) {
                const int i = F.wave * 8 + r;
                const float v = Ot[i * 65 + f_lane];
                const float mu = wave_sum(v) * (1.f / 64.f);
                const float dv = v - mu;
                const float var = wave_sum(dv * dv) * (1.f / 64.f);
                const size_t row = (size_t)(b * SEQ + n * 64 + i);
                const float g = bf2f(R[row * INC + C_GB + h * 64 + f_lane]);
                const float o = dv * (1.f / sqrtf(var + EPS)) * (g * sigmoidf(g));
                O[row * DM + 512 + h * 64 + f_lane] = (bf16)f2bf(o);
            }
        }
    }
}

DI void naive_route(Frame& F, int layer) {
    FRAME_IDS;
    const bf16* Q = (const bf16*)(F.ws + WS_Q);
    int* eidx = (int*)(F.ws + WS_EIDX); float* gate = (float*)(F.ws + WS_GATE);
    const float* keys = F.peer_keys + (size_t)layer * 2 * PK * 64;
    LAS float* sc = (LAS float*)F.lds;
    LAS int* i1s = (LAS int*)(sc + 256 * 64);
    LAS int* i2s = i1s + 16 * 64;
    LAS float* qs = (LAS float*)(i2s + 16 * 64);
    const int p = f_tid;
    for (int it = F.bid; it < T / 8; it += F.G) {
        if (p < 64) {
            const int t = it * 8 + (p >> 3), hh = p & 7;
            float top1[16], top2[16];
#pragma unroll
            for (int side = 0; side < 2; ++side) {
                const bf16* qp = Q + (size_t)t * DM + hh * 128 + side * 64;
                for (int d = 0; d < 64; ++d) qs[d * 64 + p] = bf2f(qp[d]);
                for (int k = 0; k < PK; ++k) {
                    const float* kp = keys + ((size_t)side * PK + k) * 64;
                    float s = 0.f;
#pragma unroll 8
                    for (int d = 0; d < 64; ++d) s += qs[d * 64 + p] * kp[d];
                    sc[k * 64 + p] = s;
                }
#pragma unroll
                for (int a = 0; a < 16; ++a) {
                    float best = -INFINITY; int bi = 0;
                    for (int k = 0; k < PK; ++k) { const float v = sc[k * 64 + p]; if (v > best) { best = v; bi = k; } }
                    sc[bi * 64 + p] = -INFINITY;
                    if (side == 0) { top1[a] = best; i1s[a * 64 + p] = bi; } else { top2[a] = best; i2s[a * 64 + p] = bi; }
                }
            }
#pragma unroll
            for (int a = 0; a < 16; ++a)
#pragma unroll
                for (int b = 0; b < 16; ++b) sc[(a * 16 + b) * 64 + p] = top1[a] + top2[b];
            float bv[16]; int be[16];
#pragma unroll
            for (int a = 0; a < 16; ++a) {
                float best = -INFINITY; int bi = 0;
                for (int k = 0; k < 256; ++k) { const float v = sc[k * 64 + p]; if (v > best) { best = v; bi = k; } }
                sc[bi * 64 + p] = -INFINITY;
                bv[a] = best; be[a] = i1s[(bi >> 4) * 64 + p] * PK + i2s[(bi & 15) * 64 + p];
            }
            float sum = 0.f; const float bmax = bv[0];
#pragma unroll
            for (int a = 0; a < 16; ++a) { bv[a] = __expf(bv[a] - bmax); sum += bv[a]; }
            const float inv = 1.f / sum;
#pragma unroll
            for (int a = 0; a < 16; ++a) { eidx[(size_t)t * NSEL + hh * 16 + a] = be[a]; gate[(size_t)t * NSEL + hh * 16 + a] = bv[a] * inv; }
        }
    }
}


DI float fmax_raw(float a, float b) { float r; asm("v_max_f32_e32 %0, %1, %2" : "=v"(r) : "v"(a), "v"(b)); return r; }
DI float fmin_raw(float a, float b) { float r; asm("v_min_f32_e32 %0, %1, %2" : "=v"(r) : "v"(a), "v"(b)); return r; }
#define CE_DESC(x, y) do { const float hi_ = fmax_raw((x), (y)), lo_ = fmin_raw((x), (y)); (x) = hi_; (y) = lo_; } while (0)
template <int N> DI void sort_desc(float* v) {
#pragma unroll
    for (int k = 2; k <= N; k <<= 1)
#pragma unroll
        for (int j = k >> 1; j > 0; j >>= 1)
#pragma unroll
            for (int i = 0; i < N; ++i) { const int l = i ^ j; if (l > i) { if ((i & k) == 0 || k == N) CE_DESC(v[i], v[l]); else CE_DESC(v[l], v[i]); } }
}
DI void merge16(float* a, const float* b) {
#pragma unroll
    for (int i = 0; i < 16; ++i) a[i] = fmax_raw(a[i], b[15 - i]);
#pragma unroll
    for (int j = 8; j > 0; j >>= 1)
#pragma unroll
        for (int i = 0; i < 16; ++i) { const int l = i ^ j; if (l > i) CE_DESC(a[i], a[l]); }
}
DI float key_pack(float v, unsigned keep_mask, unsigned idx) { return __uint_as_float((__float_as_uint(v) & keep_mask) | idx); }
DI void opt_route(Frame& F, int layer) {
    FRAME_IDS;
    const bf16* Q = (const bf16*)(F.ws + WS_Q);
    int* eidx = (int*)(F.ws + WS_EIDX); float* gate = (float*)(F.ws + WS_GATE);
    const float* keys = F.peer_keys + (size_t)layer * 2 * PK * 64;
    LAS unsigned char* kl = F.lds;
    __syncthreads();
    for (int idx = f_tid; idx < 2 * PK * 8; idx += NTHR) {
        const int row = idx >> 3, ch = idx & 7;
        const f32x4 a = *(const f32x4*)(keys + (size_t)row * 64 + ch * 8), b = *(const f32x4*)(keys + (size_t)row * 64 + ch * 8 + 4);
        *(LAS u32x4*)(kl + row * 144 + ch * 16) = (u32x4){pk2(a[0], a[1]), pk2(a[2], a[3]), pk2(b[0], b[1]), pk2(b[2], b[3])};
    }
    __syncthreads();
    LAS int* lut = (LAS int*)(F.lds + 40960 + F.wave * 8192);
    const int c = f_lane & 31, h = f_lane >> 5;
    const int gw = F.bid * NWAVES + F.wave, NGW = F.G * NWAVES;
    for (int task = gw; task < (T / 32) * PH; task += NGW) {
        const int tile = task >> 3, hh = task & 7, t = tile * 32 + c;
        float tk[2][16];
#pragma unroll
        for (int side = 0; side < 2; ++side) {
            bf16x8 qf[4];
#pragma unroll
            for (int ks = 0; ks < 4; ++ks) qf[ks] = *(const bf16x8*)(Q + (size_t)t * DM + hh * PQD + side * 64 + 16 * ks + 8 * h);
            float v[64];
#pragma unroll
            for (int kt = 0; kt < 4; ++kt) {
                f32x16 acc = {};
#pragma unroll
                for (int ks = 0; ks < 4; ++ks) {
                    const bf16x8 a = *(const LAS bf16x8*)(kl + (side * PK + 32 * kt + c) * 144 + (16 * ks + 8 * h) * 2);
                    acc = __builtin_amdgcn_mfma_f32_32x32x16_bf16(a, qf[ks], acc, 0, 0, 0);
                }
#pragma unroll
                for (int r = 0; r < 16; ++r) v[16 * kt + r] = key_pack(acc[r], 0xFFFFFF80u, (unsigned)(32 * kt + (r & 3) + 8 * (r >> 2) + 4 * h));
            }
            sort_desc<16>(v); sort_desc<16>(v + 16); sort_desc<16>(v + 32); sort_desc<16>(v + 48);
            merge16(v, v + 16); merge16(v + 32, v + 48); merge16(v, v + 32);
            float pr[16];
#pragma unroll
            for (int i = 0; i < 16; ++i) pr[i] = __shfl_xor(v[i], 32);
            merge16(v, pr);
#pragma unroll
            for (int i = 0; i < 16; ++i) { tk[side][i] = v[i]; lut[(side * 16 + i) * 64 + f_lane] = (int)(__float_as_uint(v[i]) & 0x7Fu); }
        }
        float cd[64];
        {   int n = 0;
#pragma unroll
            for (int a = 0; a < 16; ++a)
#pragma unroll
                for (int b = 0; b < 16; ++b) if ((a + 1) * (b + 1) <= 16) { cd[n] = key_pack(tk[0][a] + tk[1][b], 0xFFFFFF00u, (unsigned)(a * 16 + b)); ++n; }
#pragma unroll
            for (int i = 50; i < 64; ++i) cd[i] = -INFINITY;
        }
        sort_desc<16>(cd); sort_desc<16>(cd + 16); sort_desc<16>(cd + 32); CE_DESC(cd[48], cd[49]);
        merge16(cd, cd + 16); merge16(cd + 32, cd + 48); merge16(cd, cd + 32);
        int ex[16]; float gv[16]; float sum = 0.f;
        const float top = __uint_as_float(__float_as_uint(cd[0]) & 0xFFFFFF00u);
#pragma unroll
        for (int i = 0; i < 16; ++i) {
            const unsigned bits = __float_as_uint(cd[i]);
            const int a = (bits >> 4) & 15, b = bits & 15;
            ex[i] = lut[a * 64 + f_lane] * PK + lut[(16 + b) * 64 + f_lane];
            gv[i] = __expf(__uint_as_float(bits & 0xFFFFFF00u) - top); sum += gv[i];
        }
        const float inv = 1.f / sum;
        if (h == 0) {
            u32x4* ep = (u32x4*)(eidx + (size_t)t * NSEL + hh * 16);
#pragma unroll
            for (int q = 0; q < 4; ++q) ep[q] = (u32x4){(unsigned)ex[4 * q], (unsigned)ex[4 * q + 1], (unsigned)ex[4 * q + 2], (unsigned)ex[4 * q + 3]};
        } else {
            f32x4* gp = (f32x4*)(gate + (size_t)t * NSEL + hh * 16);
#pragma unroll
            for (int q = 0; q < 4; ++q) gp[q] = (f32x4){gv[4 * q] * inv, gv[4 * q + 1] * inv, gv[4 * q + 2] * inv, gv[4 * q + 3] * inv};
        }
    }
    __syncthreads();
}
DI void naive_gather(Frame& F, int layer, bool final_norm) {
    FRAME_IDS;
    const int* eidx = (const int*)(F.ws + WS_EIDX); const float* gate = (const float*)(F.ws + WS_GATE);
    float* part = (float*)(F.ws + WS_PART); bf16* hb = (bf16*)(F.ws + WS_XB);
    const float* U = F.peer_u + (size_t)layer * PE * DM; const float* V = F.peer_v + (size_t)layer * PE * DM;
    const float* gn = F.ffn_norm + layer * DM;
    LAS float* xs = (LAS float*)F.lds;
    LAS float* as = xs + 1024;
    LAS int* es = (LAS int*)(as + 128);
    LAS float* red = (LAS float*)(es + 128);
    const int tid = f_tid;
    for (int t = F.bid; t < T; t += F.G) {
        __syncthreads();
        const float rstd = row_rstd(part, t);
        const f32x2 hv = *(const f32x2*)(F.out + (size_t)t * DM + 2 * tid);
        xs[2 * tid] = hv.x * rstd * gn[2 * tid]; xs[2 * tid + 1] = hv.y * rstd * gn[2 * tid + 1];
        if (tid < 128) es[tid] = eidx[(size_t)t * NSEL + tid];
        __syncthreads();
        for (int k = F.wave; k < NSEL; k += NWAVES) {
            const f32x4* ur = (const f32x4*)(U + (size_t)es[k] * DM) + f_lane;
            float s = 0.f;
#pragma unroll
            for (int j = 0; j < 4; ++j) { const f32x4 u = ur[64 * j]; const int c = 4 * f_lane + 256 * j; s += u.x * xs[c] + u.y * xs[c + 1] + u.z * xs[c + 2] + u.w * xs[c + 3]; }
            s = wave_sum(s);
            if (f_lane == 0) as[k] = gelu_erf(s) * gate[(size_t)t * NSEL + k];
        }
        __syncthreads();
        float o0 = 0.f, o1 = 0.f;
        for (int k = 0; k < NSEL; ++k) { const f32x2 v = *(const f32x2*)(V + (size_t)es[k] * DM + 2 * tid); const float a = as[k]; o0 += a * v.x; o1 += a * v.y; }
        const float h0 = hv.x + o0, h1 = hv.y + o1;
        const float ss = block_sum(h0 * h0 + h1 * h1, red, tid);
        if (final_norm) {
            const float r = 1.f / sqrtf(ss * (1.f / DM) + EPS);
            *(f32x2*)(F.out + (size_t)t * DM + 2 * tid) = (f32x2){h0 * r * F.final_norm[2 * tid], h1 * r * F.final_norm[2 * tid + 1]};
        } else {
            *(f32x2*)(F.out + (size_t)t * DM + 2 * tid) = (f32x2){h0, h1};
            *(unsigned*)(hb + (size_t)t * DM + 2 * tid) = pk2(h0, h1);
            if (tid < 16) part[(size_t)t * 16 + tid] = (tid == 0) ? ss : 0.f;
        }
    }
}


DI unsigned fp8x4(f32x4 v) {
    const float a = __builtin_amdgcn_fmed3f(v[0], -448.f, 448.f), b = __builtin_amdgcn_fmed3f(v[1], -448.f, 448.f), c = __builtin_amdgcn_fmed3f(v[2], -448.f, 448.f), d = __builtin_amdgcn_fmed3f(v[3], -448.f, 448.f);
    unsigned w = 0u;
    w = (unsigned)__builtin_amdgcn_cvt_pk_fp8_f32(a, b, (int)w, false);
    w = (unsigned)__builtin_amdgcn_cvt_pk_fp8_f32(c, d, (int)w, true);
    return w;
}
DI void p0_fp8(Frame& F) {
    FRAME_IDS;
    const int gw = F.bid * NWAVES + F.wave, NGW = F.G * NWAVES;
    for (int row = gw; row < 4 * PE; row += NGW) {
        const int tab = row / PE, e = row % PE, layer = tab & 1, isv = tab >> 1;
        const float* src = (isv ? F.peer_v : F.peer_u) + ((size_t)layer * PE + e) * DM;
        unsigned* dst = (unsigned*)(F.ws + (isv ? WS_V8 : WS_U8) + ((size_t)layer * PE + e) * DM);
        const f32x4* sp = (const f32x4*)src + f_lane;
        const f32x4* gp = (const f32x4*)(F.ffn_norm + layer * DM) + f_lane;
#pragma unroll
        for (int j = 0; j < 4; ++j) {
            f32x4 v = sp[64 * j];
            if (!isv) v = v * gp[64 * j] * U8_SCALE; else v = v * V8_SCALE;
            dst[f_lane + 64 * j] = fp8x4(v);
        }
    }
}
DI float dot16_fp8(const u32x4 r, const float (&xs)[16]) {
    float s0 = 0.f, s1 = 0.f;
#pragma unroll
    for (int w = 0; w < 4; ++w) {
        const f32x2 lo = __builtin_amdgcn_cvt_pk_f32_fp8((int)r[w], false), hi = __builtin_amdgcn_cvt_pk_f32_fp8((int)r[w], true);
        s0 = fmaf(lo[0], xs[4 * w + 0], s0); s1 = fmaf(lo[1], xs[4 * w + 1], s1); s0 = fmaf(hi[0], xs[4 * w + 2], s0); s1 = fmaf(hi[1], xs[4 * w + 3], s1);
    }
    return s0 + s1;
}
DI void axpy16_fp8(const u32x4 r, const float a, float (&o)[16]) {
#pragma unroll
    for (int w = 0; w < 4; ++w) {
        const f32x2 lo = __builtin_amdgcn_cvt_pk_f32_fp8((int)r[w], false), hi = __builtin_amdgcn_cvt_pk_f32_fp8((int)r[w], true);
        o[4 * w + 0] = fmaf(a, lo[0], o[4 * w + 0]); o[4 * w + 1] = fmaf(a, lo[1], o[4 * w + 1]); o[4 * w + 2] = fmaf(a, hi[0], o[4 * w + 2]); o[4 * w + 3] = fmaf(a, hi[1], o[4 * w + 3]);
    }
}
DI float red_combine(const int level, const float a, const float b, const int lane) {
    const int M = 32 >> level; const bool bit = (lane & M) != 0;
    const float send = bit ? a : b, keep = bit ? b : a;
    return keep + __shfl_xor(send, M);
}
constexpr int brev6(int k) { return ((k & 1) << 5) | ((k & 2) << 3) | ((k & 4) << 1) | ((k & 8) >> 1) | ((k & 16) >> 3) | ((k & 32) >> 5); }
DI void opt_gather(Frame& F, int layer, bool final_norm) {
    FRAME_IDS;
    const int* eidx = (const int*)(F.ws + WS_EIDX); const float* gate = (const float*)(F.ws + WS_GATE);
    float* part = (float*)(F.ws + WS_PART); bf16* hb = (bf16*)(F.ws + WS_XB);
    const __amdgpu_buffer_rsrc_t U8 = __builtin_amdgcn_make_buffer_rsrc((void*)(F.ws + WS_U8 + (size_t)layer * PE * DM), 0, PE * DM, 0x00020000);
    const __amdgpu_buffer_rsrc_t V8 = __builtin_amdgcn_make_buffer_rsrc((void*)(F.ws + WS_V8 + (size_t)layer * PE * DM), 0, PE * DM, 0x00020000);
    const int voff = f_lane * 16;
    const int gw = F.bid * NWAVES + F.wave, NGW = F.G * NWAVES;
    for (int t = gw; t < T; t += NGW) {
        float* hrow = F.out + (size_t)t * DM + 16 * f_lane;
        float xs[16];
        { const f32x4 h0 = ((const f32x4*)hrow)[0], h1 = ((const f32x4*)hrow)[1], h2 = ((const f32x4*)hrow)[2], h3 = ((const f32x4*)hrow)[3];
#pragma unroll
          for (int i = 0; i < 4; ++i) { xs[i] = h0[i]; xs[4 + i] = h1[i]; xs[8 + i] = h2[i]; xs[12 + i] = h3[i]; } }
        const float pv = (f_lane < 16) ? part[(size_t)t * 16 + f_lane] : 0.f;
        const float rstd = 1.f / sqrtf(wave_sum(pv) * (1.f / DM) + EPS);
        int ev[2]; float gv[2], av[2];
        ev[0] = eidx[(size_t)t * NSEL + f_lane]; ev[1] = eidx[(size_t)t * NSEL + 64 + f_lane];
        gv[0] = gate[(size_t)t * NSEL + f_lane]; gv[1] = gate[(size_t)t * NSEL + 64 + f_lane];
        constexpr int GR = 4, NG = 64 / GR;
#pragma unroll
        for (int b = 0; b < 2; ++b) {
            float st[6]; float red = 0.f;
            u32x4 buf[2][GR];
#pragma unroll
            for (int j = 0; j < GR; ++j) { const int e = __builtin_amdgcn_readlane(ev[b], brev6(j)); buf[0][j] = __builtin_amdgcn_raw_buffer_load_b128(U8, voff, e * DM, 0); }
            asm volatile("" ::: "memory");
#pragma unroll
            for (int g = 0; g < NG; ++g) {
                if (g + 1 < NG) {
#pragma unroll
                    for (int j = 0; j < GR; ++j) { const int e = __builtin_amdgcn_readlane(ev[b], brev6(GR * (g + 1) + j)); buf[(g + 1) & 1][j] = __builtin_amdgcn_raw_buffer_load_b128(U8, voff, e * DM, 0); }
                }
                asm volatile("" ::: "memory");
#pragma unroll
                for (int j = 0; j < GR; ++j) {
                    const int k = GR * g + j;
                    float v = dot16_fp8(buf[g & 1][j], xs);
                    int kk = k, lvl = 0;
#pragma unroll
                    for (int q = 0; q < 6; ++q) { if (kk & 1) { v = red_combine(lvl, st[lvl], v, f_lane); kk >>= 1; ++lvl; } }
                    if (k == 63) red = v; else st[lvl] = v;
                }
                asm volatile("" ::: "memory");
            }
            const float d = red * (rstd * (1.f / U8_SCALE));
            av[b] = gelu_erf(d) * gv[b] * (1.f / V8_SCALE);
        }
        float o[16];
#pragma unroll
        for (int i = 0; i < 16; ++i) o[i] = 0.f;
#pragma unroll
        for (int b = 0; b < 2; ++b) {
            u32x4 buf[2][GR];
#pragma unroll
            for (int j = 0; j < GR; ++j) { const int e = __builtin_amdgcn_readlane(ev[b], j); buf[0][j] = __builtin_amdgcn_raw_buffer_load_b128(V8, voff, e * DM, 0); }
            asm volatile("" ::: "memory");
#pragma unroll
            for (int g = 0; g < NG; ++g) {
                if (g + 1 < NG) {
#pragma unroll
                    for (int j = 0; j < GR; ++j) { const int e = __builtin_amdgcn_readlane(ev[b], GR * (g + 1) + j); buf[(g + 1) & 1][j] = __builtin_amdgcn_raw_buffer_load_b128(V8, voff, e * DM, 0); }
                }
                asm volatile("" ::: "memory");
#pragma unroll
                for (int j = 0; j < GR; ++j) { const float a = __builtin_bit_cast(float, __builtin_amdgcn_readlane(__builtin_bit_cast(int, av[b]), GR * g + j)); axpy16_fp8(buf[g & 1][j], a, o); }
                asm volatile("" ::: "memory");
            }
        }
        float ss = 0.f;
#pragma unroll
        for (int i = 0; i < 16; ++i) { o[i] += xs[i]; ss = fmaf(o[i], o[i], ss); }
        ss = wave_sum(ss);
        if (final_norm) {
            const float r = 1.f / sqrtf(ss * (1.f / DM) + EPS);
            const f32x4* fn = (const f32x4*)(F.final_norm + 16 * f_lane);
#pragma unroll
            for (int q = 0; q < 4; ++q) { const f32x4 g = fn[q]; ((f32x4*)hrow)[q] = (f32x4){o[4 * q] * r * g[0], o[4 * q + 1] * r * g[1], o[4 * q + 2] * r * g[2], o[4 * q + 3] * r * g[3]}; }
        } else {
#pragma unroll
            for (int q = 0; q < 4; ++q) ((f32x4*)hrow)[q] = (f32x4){o[4 * q], o[4 * q + 1], o[4 * q + 2], o[4 * q + 3]};
            u32x4* hbp = (u32x4*)(hb + (size_t)t * DM + 16 * f_lane);
            hbp[0] = (u32x4){pk2(o[0], o[1]), pk2(o[2], o[3]), pk2(o[4], o[5]), pk2(o[6], o[7])};
            hbp[1] = (u32x4){pk2(o[8], o[9]), pk2(o[10], o[11]), pk2(o[12], o[13]), pk2(o[14], o[15])};
            if (f_lane < 16) part[(size_t)t * 16 + f_lane] = (f_lane == 0) ? ss : 0.f;
        }
    }
}
DI void naive_glu(Frame& F) {
    FRAME_IDS;
    const bf16* H = (const bf16*)(F.ws + WS_HID); bf16* G = (bf16*)(F.ws + WS_GLU);
    for (size_t i = (size_t)F.bid * NTHR + f_tid; i < (size_t)T * DM; i += (size_t)F.G * NTHR) {
        const size_t m = i / DM; const int c = (int)(i % DM);
        const float a = bf2f(H[m * 2048 + c]), g = bf2f(H[m * 2048 + 1024 + c]);
        G[i] = (bf16)f2bf(a * sigmoidf(g));
    }
}
DI void naive_conv(Frame& F) {
    FRAME_IDS;
    const bf16* G = (const bf16*)(F.ws + WS_GLU); bf16* H2 = (bf16*)(F.ws + WS_HID2);
    LAS float* red = (LAS float*)F.lds;
    const int tid = f_tid;
    for (int t = F.bid; t < T; t += F.G) {
        const int s = t % SEQ;
        float y[2];
#pragma unroll
        for (int u = 0; u < 2; ++u) {
            const int c = 2 * tid + u;
            float a = F.conv_dw_b[c];
            for (int j = 0; j < CW; ++j) { const int sp = s - (CW - 1) + j; if (sp >= 0) a += F.conv_dw[j * DM + c] * bf2f(G[(size_t)(t - (CW - 1) + j) * DM + c]); }
            y[u] = a;
        }
        const float mu = block_sum(y[0] + y[1], red, tid) * (1.f / DM);
        const float d0 = y[0] - mu, d1 = y[1] - mu;
        const float var = block_sum(d0 * d0 + d1 * d1, red, tid) * (1.f / DM);
        const float r = 1.f / sqrtf(var + EPS);
        const float z0 = d0 * r * F.conv_ln_g[2 * tid] + F.conv_ln_b[2 * tid], z1 = d1 * r * F.conv_ln_g[2 * tid + 1] + F.conv_ln_b[2 * tid + 1];
        *(unsigned*)(H2 + (size_t)t * DM + 2 * tid) = pk2(z0 * sigmoidf(z0), z1 * sigmoidf(z1));
    }
}

#if OPT_GEMM
enum Phase { PH_PREP = 0, PH_PROJ, PH_MIX, PH_WOUT, PH_Q0, PH_ROUTE0, PH_GATHER0, PH_W1, PH_CONV, PH_W2, PH_Q1, PH_ROUTE1, PH_GATHER1, PH_COUNT };
#else
enum Phase { PH_PREP = 0, PH_PROJ, PH_MIX, PH_WOUT, PH_STAT0, PH_Q0, PH_ROUTE0, PH_GATHER0, PH_W1, PH_GLU, PH_CONV, PH_W2, PH_STAT1, PH_Q1, PH_ROUTE1, PH_GATHER1, PH_COUNT };
#endif
struct Args { const float* in[19]; float* out; unsigned char* ws; int ph_lo, ph_hi; };

__global__ void __launch_bounds__(NTHR, 2) mega_fwd(Args args) {
    extern __shared__ __attribute__((aligned(16))) unsigned char lds[];
    Frame F;
    F.lds = (LAS unsigned char*)lds;
    F.wave = __builtin_amdgcn_readfirstlane((int)threadIdx.x >> 6); FRAME_IDS;
    F.G = gridDim.x; F.bid = blockIdx.x;
    F.x = args.in[0]; F.mix_norm = args.in[1]; F.ffn_norm = args.in[2]; F.final_norm = args.in[3]; F.w_in = args.in[4]; F.w_out = args.in[5]; F.rel_bias = args.in[6];
    F.conv_w1 = args.in[7]; F.conv_b1 = args.in[8]; F.conv_dw = args.in[9]; F.conv_dw_b = args.in[10]; F.conv_ln_g = args.in[11]; F.conv_ln_b = args.in[12];
    F.conv_w2 = args.in[13]; F.conv_b2 = args.in[14]; F.peer_wq = args.in[15]; F.peer_keys = args.in[16]; F.peer_u = args.in[17]; F.peer_v = args.in[18];
    F.out = args.out; F.ws = args.ws;
    volatile LAS unsigned* MISC = (volatile LAS unsigned*)(F.lds + MISC_OFF);
    for (int u = f_tid; u < (LDS_BYTES - LDSCTL_OFF) / 4; u += NTHR) ((LAS unsigned*)(F.lds + LDSCTL_OFF))[u] = 0u;
    __syncthreads();
    const int lo = args.ph_lo, hi = args.ph_hi;
    XcdBarrier bar; bar.bar = (unsigned*)(F.ws + WS_CTL) + CW_BAR; bar.x = 0; bar.st = nullptr;
    if (hi - lo > 1) bar = xcd_barrier_post((unsigned*)(F.ws + WS_CTL) + CW_BAR, MISC + 8);
#ifndef TEST_PHASE
#define TEST_PHASE -1
#endif
#define IN(k) ((TEST_PHASE < 0 || TEST_PHASE == (k)) && lo <= (k) && (k) < hi)
#define SEAM(k) do { if (IN(k) && IN((k) + 1)) xcd_barrier(bar, F.wave); } while (0)
    bf16* XB = (bf16*)(F.ws + WS_XB);
    const float* PART = (const float*)(F.ws + WS_PART); const float* ROPE = (const float*)(F.ws + WS_ROPE);
    if (IN(PH_PREP)) { p0_prep(F);
#if OPT_GEMM
        p0_weights(F);
#endif
#if OPT_GATHER
        p0_fp8(F);
#endif
    } SEAM(PH_PREP);
#if OPT_GEMM
#define GEMM_PHASE(EPI, Aptr, Bptr, NN, ...) do { pg8::Gemm g{(const bf16*)(Aptr), (const bf16*)(Bptr), T, (NN), DM}; pg8::StaticOrder S; S.init(T, (NN), F.G, F.bid); \
        pg8::EPI E{__VA_ARGS__}; pg8::gemm_phase<pg8::EPI, pg8::StaticOrder, true, true>(F.lds, g, S, E, F.wave); } while (0)
    if (IN(PH_PROJ)) { GEMM_PHASE(EpiProj, XB, F.ws + WS_WIN, INC, (bf16*)(F.ws + WS_R), PART, ROPE); } SEAM(PH_PROJ);
#else
    if (IN(PH_PROJ)) { naive_gemm<EP_PROJ>(F, XB, F.w_in, INC, F.mix_norm, nullptr, (bf16*)(F.ws + WS_R), INC); } SEAM(PH_PROJ);
#endif
#if OPT_ATTN
    if (IN(PH_MIX)) { naive_ret(F); opt_attn(F); } SEAM(PH_MIX);
#else
    if (IN(PH_MIX)) { naive_ret(F); naive_attn(F); } SEAM(PH_MIX);
#endif
#if OPT_GEMM
    if (IN(PH_WOUT)) { GEMM_PHASE(EpiRes, F.ws + WS_O, F.ws + WS_WOUT, DM, F.x, F.out, XB, (float*)(F.ws + WS_PART), nullptr); } SEAM(PH_WOUT);
    if (IN(PH_Q0)) { GEMM_PHASE(EpiQ, XB, F.ws + WS_WQ, DM, (bf16*)(F.ws + WS_Q), PART); } SEAM(PH_Q0);
#else
    if (IN(PH_WOUT)) { naive_gemm<EP_RES>(F, (const bf16*)(F.ws + WS_O), F.w_out, DM, nullptr, nullptr, nullptr, DM); } SEAM(PH_WOUT);
    if (IN(PH_STAT0)) { naive_rowstat(F); } SEAM(PH_STAT0);
    if (IN(PH_Q0)) { naive_gemm<EP_Q>(F, XB, F.peer_wq, DM, F.ffn_norm, nullptr, (bf16*)(F.ws + WS_Q), DM); } SEAM(PH_Q0);
#endif
#if OPT_ROUTE
    if (IN(PH_ROUTE0)) { opt_route(F, 0); } SEAM(PH_ROUTE0);
#else
    if (IN(PH_ROUTE0)) { naive_route(F, 0); } SEAM(PH_ROUTE0);
#endif
#if OPT_GATHER
    if (IN(PH_GATHER0)) { opt_gather(F, 0, false); } SEAM(PH_GATHER0);
#else
    if (IN(PH_GATHER0)) { naive_gather(F, 0, false); } SEAM(PH_GATHER0);
#endif
#if OPT_GEMM
    if (IN(PH_W1)) { GEMM_PHASE(EpiGlu, XB, F.ws + WS_W1, 2 * DM, (bf16*)(F.ws + WS_GLU), PART, F.conv_b1); } SEAM(PH_W1);
#else
    if (IN(PH_W1)) { naive_gemm<EP_HID>(F, XB, F.conv_w1, 2 * DM, F.mix_norm + DM, F.conv_b1, (bf16*)(F.ws + WS_HID), 2 * DM); } SEAM(PH_W1);
    if (IN(PH_GLU)) { naive_glu(F); } SEAM(PH_GLU);
#endif
    if (IN(PH_CONV)) { naive_conv(F); } SEAM(PH_CONV);
#if OPT_GEMM
    if (IN(PH_W2)) { GEMM_PHASE(EpiRes, F.ws + WS_HID2, F.ws + WS_W2, DM, F.out, F.out, XB, (float*)(F.ws + WS_PART), F.conv_b2); } SEAM(PH_W2);
    if (IN(PH_Q1)) { GEMM_PHASE(EpiQ, XB, F.ws + WS_WQ + (size_t)DM * DM * 2, DM, (bf16*)(F.ws + WS_Q), PART); } SEAM(PH_Q1);
#else
    if (IN(PH_W2)) { naive_gemm<EP_RES>(F, (const bf16*)(F.ws + WS_HID2), F.conv_w2, DM, nullptr, F.conv_b2, XB  , DM); } SEAM(PH_W2);
    if (IN(PH_STAT1)) { naive_rowstat(F); } SEAM(PH_STAT1);
    if (IN(PH_Q1)) { naive_gemm<EP_Q>(F, XB, F.peer_wq + (size_t)DM * DM, DM, F.ffn_norm + DM, nullptr, (bf16*)(F.ws + WS_Q), DM); } SEAM(PH_Q1);
#endif
#if OPT_ROUTE
    if (IN(PH_ROUTE1)) { opt_route(F, 1); } SEAM(PH_ROUTE1);
#else
    if (IN(PH_ROUTE1)) { naive_route(F, 1); } SEAM(PH_ROUTE1);
#endif
#if OPT_GATHER
    if (IN(PH_GATHER1)) { opt_gather(F, 1, true); }
#else
    if (IN(PH_GATHER1)) { naive_gather(F, 1, true); }
#endif
#undef IN
#undef SEAM
}

extern "C" void kernel_launch(void* const* d_in, const int* in_sizes, int n_in, void* d_out, int out_size, void* d_ws, size_t ws_size, hipStream_t stream) {
    static int grid = 0;
    if (grid == 0) {
        if (n_in != 19 || out_size != T * DM || ws_size < WS_END) { fprintf(stderr, "kernel_launch: unexpected shapes (n_in %d out %d ws %zu)\n", n_in, out_size, ws_size); grid = -1; return; }
        int dev = 0, cus = 0;
        if (hipGetDevice(&dev) != hipSuccess || hipDeviceGetAttribute(&cus, hipDeviceAttributeMultiprocessorCount, dev) != hipSuccess) { grid = -1; return; }
        if (hipFuncSetAttribute((const void*)mega_fwd, hipFuncAttributeMaxDynamicSharedMemorySize, LDS_BYTES) != hipSuccess) { fprintf(stderr, "kernel_launch: hipFuncSetAttribute failed\n"); grid = -1; return; }
        (void)hipGetLastError();
        grid = cus;
    }
    if (grid < 0) return;
    (void)hipMemsetAsync((char*)d_ws + WS_CTL, 0, CTL_ZERO_BYTES, stream);
    Args a{};
    for (int i = 0; i < 19; ++i) a.in[i] = (const float*)d_in[i];
    a.out = (float*)d_out; a.ws = (unsigned char*)d_ws;
#if MK_ONE_LAUNCH
    a.ph_lo = 0; a.ph_hi = PH_COUNT;
    hipLaunchKernelGGL(mega_fwd, dim3(grid), dim3(NTHR), LDS_BYTES, stream, a);
#else
    for (int p = 0; p < PH_COUNT; ++p) { a.ph_lo = p; a.ph_hi = p + 1; hipLaunchKernelGGL(mega_fwd, dim3(grid), dim3(NTHR), LDS_BYTES, stream, a); }
#endif
}
```

```cpp
#include <hip/hip_runtime.h>
#include <cstdio>
#include <cstdint>

#ifndef OPT_GEMM
#define OPT_GEMM 1
#endif
#ifndef OPT_GATHER
#define OPT_GATHER 1
#endif
#ifndef OPT_ROUTE
#define OPT_ROUTE 1
#endif
#ifndef OPT_ATTN
#define OPT_ATTN 1
#endif
#ifndef MK_ONE_LAUNCH
#define MK_ONE_LAUNCH 1
#endif

#define GAS __attribute__((address_space(1)))
#define LAS __attribute__((address_space(3)))
#define DI __device__ __forceinline__
typedef unsigned short bf16;
typedef float f32x2 __attribute__((ext_vector_type(2)));
typedef float f32x4 __attribute__((ext_vector_type(4)));
typedef unsigned u32x2 __attribute__((ext_vector_type(2)));
typedef unsigned u32x4 __attribute__((ext_vector_type(4)));
typedef short bf16x8 __attribute__((ext_vector_type(8)));
typedef float f32x16 __attribute__((ext_vector_type(16)));

constexpr int NB = 16, SEQ = 2048, DM = 1024, T = NB * SEQ;
constexpr int CHUNK = 64, HD = 64, NHA = 8, NHB = 8, INC = 3584, NCH = SEQ / CHUNK;
constexpr int PH = 8, PK = 128, PE = PK * PK, PQD = 128, PTOP = 16, NSEL = PH * PTOP;
constexpr int CW = 31;
constexpr float EPS = 1e-6f;
constexpr float U8_SCALE = 256.f, V8_SCALE = 16.f;
constexpr int NWAVES = 8, NTHR = NWAVES * 64;

constexpr int C_QA = 0, C_KA = 512, C_VA = 1024, C_QB = 1536, C_KB = 2048, C_VB = 2560, C_GB = 3072;

constexpr size_t MiB = 1u << 20;
constexpr size_t WS_CTL = 0, CTL_ZERO_BYTES = 1 * MiB;
constexpr size_t WS_WIN = 2 * MiB, WS_WOUT = 9 * MiB, WS_W1 = 11 * MiB, WS_W2 = 15 * MiB, WS_WQ = 17 * MiB;
constexpr size_t WS_ROPE = 22 * MiB;
constexpr size_t WS_PART = 23 * MiB;
constexpr size_t WS_EIDX = 26 * MiB;
constexpr size_t WS_GATE = 42 * MiB;
constexpr size_t WS_U8 = 64 * MiB, WS_V8 = 96 * MiB;
constexpr size_t WS_XB = 128 * MiB;
constexpr size_t WS_R = 192 * MiB;
constexpr size_t WS_O = 416 * MiB;
constexpr size_t WS_Q = 192 * MiB;
constexpr size_t WS_HID = 256 * MiB;
constexpr size_t WS_GLU = 384 * MiB;
constexpr size_t WS_HID2 = 448 * MiB;
constexpr size_t WS_END = 512 * MiB;
constexpr int CW_BAR = 4096, CW_QUEUE = 8192;

constexpr int RING_BYTES = 131072, LDSCTL_OFF = RING_BYTES, MISC_OFF = LDSCTL_OFF + 320, LDS_BYTES = 147456;

DI float bf2f(bf16 v) { return __uint_as_float(((unsigned)v) << 16); }
DI unsigned f2bf(float f) { unsigned u = __float_as_uint(f); return (u + 0x7fffu + ((u >> 16) & 1u)) >> 16; }
DI unsigned pk2(float lo, float hi) { return f2bf(lo) | (f2bf(hi) << 16); }
DI float wave_sum(float v) {
#pragma unroll
    for (int o = 1; o < 64; o <<= 1) v += __shfl_xor(v, o);
    return v;
}
DI float wave_max(float v) {
#pragma unroll
    for (int o = 1; o < 64; o <<= 1) v = fmaxf(v, __shfl_xor(v, o));
    return v;
}
DI float block_sum(float v, LAS float* red, int tid) {
    v = wave_sum(v);
    __syncthreads();
    if ((tid & 63) == 0) red[tid >> 6] = v;
    __syncthreads();
    float s = 0.f;
#pragma unroll
    for (int i = 0; i < NWAVES; ++i) s += red[i];
    return s;
}
DI float gelu_erf(float x) { return 0.5f * x * (1.f + erff(x * 0.70710678118654752f)); }
DI float sigmoidf(float x) { return 1.f / (1.f + __expf(-x)); }

DI int lane_id() { return (int)__builtin_amdgcn_mbcnt_hi(~0u, __builtin_amdgcn_mbcnt_lo(~0u, 0u)); }
#define XB_TMO      128
#define XB_XCNT(j)  (256  + 64 * (j))
#define XB_XSUB(j)  (1280 + 64 * (j))
#define XB_XGEN(j)  (2304 + 64 * (j))
#define XB_TOP      3328
#define XB_TOPGEN   3392
#define XCD_BAR_WORDS 3456
#define XB_SPIN_CAP (1u << 22)
DI unsigned xb_ld(unsigned* p)              { return __hip_atomic_load(p, __ATOMIC_RELAXED, __HIP_MEMORY_SCOPE_AGENT); }
DI unsigned xb_add(unsigned* p, unsigned v) { return __hip_atomic_fetch_add(p, v, __ATOMIC_RELAXED, __HIP_MEMORY_SCOPE_AGENT); }
DI unsigned xb_xcc_id() { return (unsigned)__builtin_amdgcn_s_getreg((3 << 11) | 20) & 0xFu; }
#define XB_SPIN(cond, bar) do { unsigned _sp = 0; while (cond) { __builtin_amdgcn_s_sleep(1); \
    if ((++_sp & 255u) == 0u) { if (xb_ld(&(bar)[XB_TMO])) break; if (_sp > XB_SPIN_CAP) { atomicAdd(&(bar)[XB_TMO], 1u); break; } } } } while (0)
struct XcdBarrier { unsigned* bar; unsigned x; volatile LAS unsigned* st; };
DI XcdBarrier xcd_barrier_post(unsigned* bar, volatile LAS unsigned* st) {
    XcdBarrier b; b.bar = bar; b.x = xb_xcc_id(); b.st = st;
    if (threadIdx.x == 0) (void)xb_add(&bar[XB_XCNT(b.x)], 1u);
    return b;
}
DI void xcd_barrier_complete(unsigned* bar, unsigned x, unsigned& nloc, unsigned& nx) {
    const unsigned G = gridDim.x * gridDim.y * gridDim.z;
    unsigned sum, cnt, mine, sp = 0u;
    for (;;) {
        sum = 0u; cnt = 0u; mine = 0u;
#pragma unroll
        for (unsigned j = 0; j < 16; ++j) { const unsigned c = xb_ld(&bar[XB_XCNT(j)]); sum += c; cnt += (c > 0u) ? 1u : 0u; mine = (j == x) ? c : mine; }
        if (sum == G) break;
        __builtin_amdgcn_s_sleep(1);
        if ((++sp & 255u) == 0u) { if (xb_ld(&bar[XB_TMO])) break; if (sp > XB_SPIN_CAP) { atomicAdd(&bar[XB_TMO], 1u); break; } }
    }
    nloc = mine > 0u ? mine : 1u; nx = cnt > 0u ? cnt : 1u;
}
DI void xcd_barrier(const XcdBarrier& b, const int wave_id) {
    asm volatile("s_waitcnt vmcnt(0)" ::: "memory");
    __syncthreads();
    if (wave_id == 0 && lane_id() == 0) {
        unsigned* bar = b.bar;
        __builtin_amdgcn_s_waitcnt(0);
        unsigned nloc = b.st[0], nx = b.st[1];
        if (nloc == 0u) { xcd_barrier_complete(bar, b.x, nloc, nx); b.st[0] = nloc; b.st[1] = nx; }
        const unsigned old = xb_add(&bar[XB_XSUB(b.x)], 1u);
        const unsigned gen = old / nloc;
        if (old + 1u == (gen + 1u) * nloc) {
            __builtin_amdgcn_fence(__ATOMIC_RELEASE, "agent");
            asm volatile("s_waitcnt vmcnt(0)" ::: "memory");
            const unsigned og = xb_add(&bar[XB_TOP], 1u);
            const unsigned tg = og / nx;
            if (og + 1u == (tg + 1u) * nx) xb_add(&bar[XB_TOPGEN], 1u);
            else XB_SPIN(xb_ld(&bar[XB_TOPGEN]) == tg, bar);
            __builtin_amdgcn_fence(__ATOMIC_ACQUIRE, "agent");
            xb_add(&bar[XB_XGEN(b.x)], 1u);
            asm volatile("s_waitcnt vmcnt(0)" ::: "memory");
        } else {
            XB_SPIN(xb_ld(&bar[XB_XGEN(b.x)]) == gen, bar);
            __builtin_amdgcn_fence(__ATOMIC_ACQUIRE, "agent");
            asm volatile("s_waitcnt vmcnt(0)" ::: "memory");
        }
    }
    __syncthreads();
}

namespace pg8 {
#define PG8_LAS __attribute__((address_space(3)))
typedef unsigned short bf16_t;
typedef short bf16x8 __attribute__((ext_vector_type(8)));
typedef float f32x4 __attribute__((ext_vector_type(4)));
typedef unsigned u32x4 __attribute__((ext_vector_type(4)));
constexpr int BM = 256, BK = 64, HALF = 128, HTB = HALF * BK * 2  , STAGE_BYTES = 8 * HTB, NXCD = 8, WGM = 8;

__host__ __device__ __forceinline__ int lds_byte(int r, int c) { const int st = (r >> 4) * 2 + (c >> 5), rr = r & 15, cc = c & 31, ob = rr * 64 + cc * 2; return st * 1024 + (ob ^ (((ob >> 9) & 1) << 5)); }
__host__ __device__ __forceinline__ void stage_rc(int b, int& R, int& C) { const int st = b / 1024, sb = b % 1024, swz = sb ^ (((sb >> 9) & 1) << 5); R = (st >> 1) * 16 + swz / 64; C = (st & 1) * 32 + (swz % 64) / 2; }
__host__ __device__ __forceinline__ int perm32(int rho) { const int n = rho >> 4, i = rho & 15; return 8 * (i >> 2) + 4 * n + (i & 3); }

struct Unit { int pm, pn; };
struct Gemm { const bf16_t* A; const bf16_t* Bt; int M, N, K; };

struct StaticOrder {
    int nM, nN, nwg, G, c;
    __host__ __device__ void init(int M, int N, int G_, int c_) { nM = M / BM; nN = N / BM; nwg = nM * nN; G = G_; c = c_; }
    __host__ __device__ bool next(int i, Unit& u) const {
        const long L = (long)i * G + c; if (L >= nwg) return false;
        int wgid = (int)L; { const int q = nwg / NXCD, r = nwg % NXCD, xcd = wgid % NXCD, off = wgid / NXCD; wgid = (xcd < r ? xcd * (q + 1) : r * (q + 1) + (xcd - r) * q) + off; }
        const int nig = WGM * nN, gid = wgid / nig, fm = gid * WGM, gsz = (nM - fm) < WGM ? (nM - fm) : WGM;
        u.pm = fm + ((wgid % nig) % gsz); u.pn = (wgid % nig) / gsz; return true;
    }
    __device__ __forceinline__ void a_ready(const Unit&) const {}
    __device__ __forceinline__ void done(const Unit&) const {}
};

__device__ __forceinline__ unsigned cvt_pk_bf16(float lo, float hi) { unsigned r; asm volatile("v_cvt_pk_bf16_f32 %0, %1, %2" : "=v"(r) : "v"(lo), "v"(hi)); return r; }
__device__ __forceinline__ float rstd16(const float* part, int r) {
    const f32x4* p = (const f32x4*)(part + (size_t)r * 16);
    const f32x4 a = p[0], b = p[1], c = p[2], d = p[3];
    const float s = ((a[0] + a[1]) + (a[2] + a[3])) + ((b[0] + b[1]) + (b[2] + b[3])) + ((c[0] + c[1]) + (c[2] + c[3])) + ((d[0] + d[1]) + (d[2] + d[3]));
    return 1.f / sqrtf(s * (1.f / 1024.f) + 1e-6f);
}
__device__ __forceinline__ u32x4 pack8(const f32x4 a, const f32x4 b) { u32x4 w; w.x = cvt_pk_bf16(a[0], a[1]); w.y = cvt_pk_bf16(a[2], a[3]); w.z = cvt_pk_bf16(b[0], b[1]); w.w = cvt_pk_bf16(b[2], b[3]); return w; }
#define rot(t1, t2, c, s) do { const float a_ = (t1) * (c) - (t2) * (s), b_ = (t1) * (s) + (t2) * (c); (t1) = a_; (t2) = b_; } while (0)

struct EpiProj {
    static constexpr bool PERM = true, AFTER_DRAIN = false;
    bf16_t* R; const float* part; const float* rope;
    __device__ __forceinline__ void operator()(const f32x4 (&acc)[2][2][4][2], const Unit& u, int wr, int wc, int fr, int fq) const {
        const int type = u.pn >> 1, hg = u.pn & 1;
        const int colbase = type * 512 + (4 * hg + wc) * 64 + 8 * fq;
        const bool do_rope = (type == 3) || (type == 4);
#pragma unroll
        for (int ai = 0; ai < 2; ++ai)
#pragma unroll
            for (int m = 0; m < 4; ++m) {
                const int r = u.pm * BM + ai * HALF + wr * 64 + m * 16 + fr;
                const float rs = rstd16(part, r);
                f32x4 a0 = acc[ai][0][m][0] * rs, a1 = acc[ai][0][m][1] * rs, b0 = acc[ai][1][m][0] * rs, b1 = acc[ai][1][m][1] * rs;
                if (do_rope) {
                    const f32x4* rp = (const f32x4*)(rope + ((size_t)(r & 2047) * 32 + 8 * fq) * 2);
                    const f32x4 c0 = rp[0], c1 = rp[1], c2 = rp[2], c3 = rp[3];
                    rot(a0[0], b0[0], c0[0], c0[1]); rot(a0[1], b0[1], c0[2], c0[3]); rot(a0[2], b0[2], c1[0], c1[1]); rot(a0[3], b0[3], c1[2], c1[3]);
                    rot(a1[0], b1[0], c2[0], c2[1]); rot(a1[1], b1[1], c2[2], c2[3]); rot(a1[2], b1[2], c3[0], c3[1]); rot(a1[3], b1[3], c3[2], c3[3]);
                }
                bf16_t* rowp = R + (size_t)r * 3584 + colbase;
                *(u32x4*)(rowp) = pack8(a0, a1);
                *(u32x4*)(rowp + 32) = pack8(b0, b1);
            }
    }
};
struct EpiRes {
    static constexpr bool PERM = true, AFTER_DRAIN = false;
    const float* base; float* out; bf16_t* hb; float* part; const float* bias;
    __device__ __forceinline__ void operator()(const f32x4 (&acc)[2][2][4][2], const Unit& u, int wr, int wc, int fr, int fq) const {
        const int col0 = u.pn * BM + wc * 32 + 8 * fq;
        f32x4 bv[2][2];
#pragma unroll
        for (int bj = 0; bj < 2; ++bj)
#pragma unroll
            for (int n = 0; n < 2; ++n) bv[bj][n] = bias ? *(const f32x4*)(bias + col0 + bj * HALF + 4 * n) : (f32x4){0.f, 0.f, 0.f, 0.f};
#pragma unroll
        for (int ai = 0; ai < 2; ++ai)
#pragma unroll
            for (int m = 0; m < 4; ++m) {
                const int r = u.pm * BM + ai * HALF + wr * 64 + m * 16 + fr;
                const size_t off = (size_t)r * 1024 + col0;
                float ss = 0.f;
#pragma unroll
                for (int bj = 0; bj < 2; ++bj) {
                    const f32x4 x0 = *(const f32x4*)(base + off + bj * HALF), x1 = *(const f32x4*)(base + off + bj * HALF + 4);
                    const f32x4 h0 = x0 + acc[ai][bj][m][0] + bv[bj][0], h1 = x1 + acc[ai][bj][m][1] + bv[bj][1];
                    *(f32x4*)(out + off + bj * HALF) = h0; *(f32x4*)(out + off + bj * HALF + 4) = h1;
                    *(u32x4*)(hb + off + bj * HALF) = pack8(h0, h1);
                    ss += (h0[0] * h0[0] + h0[1] * h0[1]) + (h0[2] * h0[2] + h0[3] * h0[3]) + (h1[0] * h1[0] + h1[1] * h1[1]) + (h1[2] * h1[2] + h1[3] * h1[3]);
                }
                ss += __shfl_xor(ss, 16); ss += __shfl_xor(ss, 32);
                if (fq == 0) part[(size_t)r * 16 + 4 * u.pn + wc] = ss;
            }
    }
};
struct EpiQ {
    static constexpr bool PERM = true, AFTER_DRAIN = false;
    bf16_t* O; const float* part;
    __device__ __forceinline__ void operator()(const f32x4 (&acc)[2][2][4][2], const Unit& u, int wr, int wc, int fr, int fq) const {
        const int col0 = u.pn * BM + wc * 32 + 8 * fq;
#pragma unroll
        for (int ai = 0; ai < 2; ++ai)
#pragma unroll
            for (int m = 0; m < 4; ++m) {
                const int r = u.pm * BM + ai * HALF + wr * 64 + m * 16 + fr;
                const float rs = rstd16(part, r);
                bf16_t* rowp = O + (size_t)r * 1024 + col0;
#pragma unroll
                for (int bj = 0; bj < 2; ++bj) *(u32x4*)(rowp + bj * HALF) = pack8(acc[ai][bj][m][0] * rs, acc[ai][bj][m][1] * rs);
            }
    }
};
struct EpiGlu {
    static constexpr bool PERM = true, AFTER_DRAIN = false;
    bf16_t* G; const float* part; const float* b1;
    __device__ __forceinline__ void operator()(const f32x4 (&acc)[2][2][4][2], const Unit& u, int wr, int wc, int fr, int fq) const {
        const int col = u.pn * 128 + wc * 32 + 8 * fq;
        f32x4 ba[2], bg[2];
#pragma unroll
        for (int n = 0; n < 2; ++n) { ba[n] = *(const f32x4*)(b1 + col + 4 * n); bg[n] = *(const f32x4*)(b1 + 1024 + col + 4 * n); }
#pragma unroll
        for (int ai = 0; ai < 2; ++ai)
#pragma unroll
            for (int m = 0; m < 4; ++m) {
                const int r = u.pm * BM + ai * HALF + wr * 64 + m * 16 + fr;
                const float rs = rstd16(part, r);
                f32x4 y[2];
#pragma unroll
                for (int n = 0; n < 2; ++n) {
                    const f32x4 a = acc[ai][0][m][n] * rs + ba[n], g = acc[ai][1][m][n] * rs + bg[n];
#pragma unroll
                    for (int i = 0; i < 4; ++i) y[n][i] = a[i] / (1.f + __expf(-g[i]));
                }
                *(u32x4*)(G + (size_t)r * 1024 + col) = pack8(y[0], y[1]);
            }
    }
};
template <class Epi, class Sched, bool ALIGN_EPI = false, bool SP2 = false>
__device__ __forceinline__ void gemm_phase(PG8_LAS unsigned char* lds, const Gemm g, const Sched& S, const Epi& E, const int wave_id) {
    const int lane = (int)__builtin_amdgcn_mbcnt_hi(~0u, __builtin_amdgcn_mbcnt_lo(~0u, 0u)), wid = wave_id, tid = wid * 64 + lane, wr = wid >> 2, wc = wid & 3, fr = lane & 15, fq = lane >> 4;
    const int K = g.K, nt = K / BK;
    unsigned voffA[2], voffB[2];
#pragma unroll
    for (int i = 0; i < 2; ++i) { int R, C; stage_rc(tid * 16 + i * 8192, R, C); const int Rb = Epi::PERM ? ((R & ~31) + perm32(R & 31)) : R;
        voffA[i] = (unsigned)(R * K + C) * 2u; voffB[i] = (unsigned)(Rb * K + C) * 2u; }
    const size_t kstep = (size_t)(BK * 2);
    const size_t hstep = (size_t)HALF * K * 2;
    const size_t tstep = 2 * hstep;
    const unsigned ldsw = (unsigned)wid * 1024u;
    const int aoff = lds_byte(wr * 64 + fr, fq * 8), boff = lds_byte(wc * 32 + fr, fq * 8);
#define PG8_SA(b, h) (((b) * 2 + (h)) * HTB)
#define PG8_SB(b, h) ((4 + (b) * 2 + (h)) * HTB)
#define PG8_STAGE(bufoff, gbase, voff) do { _Pragma("unroll") for (int _i = 0; _i < 2; ++_i) \
        __builtin_amdgcn_global_load_lds((const unsigned*)((const char*)(gbase) + (voff)[_i]), (PG8_LAS unsigned*)(lds + (bufoff) + ldsw + _i * 8192), 16, 0, 0); } while (0)
#define PG8_LDA(dst, b, h) do { _Pragma("unroll") for (int m = 0; m < 4; ++m) _Pragma("unroll") for (int k = 0; k < 2; ++k) dst[m][k] = *(const PG8_LAS bf16x8*)(lds + PG8_SA(b, h) + aoff + m * 2048 + k * 1024); } while (0)
#define PG8_LDB(dst, b, h) do { _Pragma("unroll") for (int n = 0; n < 2; ++n) _Pragma("unroll") for (int k = 0; k < 2; ++k) dst[n][k] = *(const PG8_LAS bf16x8*)(lds + PG8_SB(b, h) + boff + n * 2048 + k * 1024); } while (0)
#define PG8_MMA(ai, bj, At, Bt) do { __builtin_amdgcn_s_setprio(1); _Pragma("unroll") for (int m = 0; m < 4; ++m) _Pragma("unroll") for (int n = 0; n < 2; ++n) _Pragma("unroll") for (int k = 0; k < 2; ++k) \
        acc[ai][bj][m][n] = __builtin_amdgcn_mfma_f32_16x16x32_bf16(Bt[n][k], At[m][k], acc[ai][bj][m][n], 0, 0, 0); __builtin_amdgcn_s_setprio(0); } while (0)
#define PG8_WAIT_V(n) asm volatile("s_waitcnt vmcnt(" #n ")" ::: "memory")
#define PG8_WAIT_L(n) asm volatile("s_waitcnt lgkmcnt(" #n ")" ::: "memory")
#define PG8_BAR __builtin_amdgcn_s_barrier()
#define PG8_SCHED __builtin_amdgcn_sched_barrier(0)
    Unit cur, nxt; int ui = 0;
    if (!S.next(0, cur)) return;
    f32x4 acc[2][2][4][2];
#pragma unroll
    for (int a = 0; a < 2; ++a)
#pragma unroll
        for (int b = 0; b < 2; ++b)
#pragma unroll
            for (int m = 0; m < 4; ++m)
#pragma unroll
                for (int n = 0; n < 2; ++n) acc[a][b][m][n] = (f32x4){0.f, 0.f, 0.f, 0.f};
    bf16x8 At[4][2], B0[2][2], B1[2][2];
    const char* cA = (const char*)g.A + (size_t)cur.pm * tstep; const char* cB = (const char*)g.Bt + (size_t)cur.pn * tstep;
    S.a_ready(cur);
    if constexpr (SP2) {
        PG8_STAGE(PG8_SB(0, 0), cB, voffB); PG8_STAGE(PG8_SB(0, 1), cB + hstep, voffB); PG8_STAGE(PG8_SA(0, 0), cA, voffA); PG8_STAGE(PG8_SA(0, 1), cA + hstep, voffA);
        if (wr == 1) PG8_BAR;
        PG8_WAIT_V(2); PG8_BAR;
        PG8_STAGE(PG8_SB(1, 0), cB + kstep, voffB); PG8_STAGE(PG8_SA(1, 0), cA + kstep, voffA); PG8_STAGE(PG8_SB(1, 1), cB + hstep + kstep, voffB);
        PG8_WAIT_V(6); PG8_BAR;
    } else {
        PG8_STAGE(PG8_SB(0, 0), cB, voffB); PG8_STAGE(PG8_SA(0, 0), cA, voffA); PG8_STAGE(PG8_SB(0, 1), cB + hstep, voffB); PG8_STAGE(PG8_SA(0, 1), cA + hstep, voffA);
        if (wr == 1) PG8_BAR;
        PG8_WAIT_V(4); PG8_BAR;
        PG8_STAGE(PG8_SB(1, 0), cB + kstep, voffB); PG8_STAGE(PG8_SA(1, 0), cA + kstep, voffA); PG8_STAGE(PG8_SB(1, 1), cB + hstep + kstep, voffB);
        PG8_WAIT_V(6); PG8_BAR;
    }
    for (;;) {
        const bool has_next = S.next(ui + 1, nxt);
        const char* nA = has_next ? (const char*)g.A + (size_t)nxt.pm * tstep : cA; const char* nB = has_next ? (const char*)g.Bt + (size_t)nxt.pn * tstep : cB;
        for (int t = 0; t < nt; t += 2) {
            const bool last = (t == nt - 2);
            const char* a1 = cA + (size_t)(t + 1) * kstep;
            const char* a2 = last ? nA : cA + (size_t)(t + 2) * kstep; const char* b2 = last ? nB : cB + (size_t)(t + 2) * kstep;
            const char* a3 = a2 + kstep; const char* b3 = b2 + kstep;
            if (last && has_next) S.a_ready(nxt);
            if constexpr (SP2) {
            PG8_LDB(B0, 0, 0); PG8_LDB(B1, 0, 1); PG8_SCHED; PG8_LDA(At, 0, 0); PG8_STAGE(PG8_SA(1, 1), a1 + hstep, voffA);
            PG8_WAIT_V(8); PG8_WAIT_L(0); PG8_BAR; PG8_MMA(0, 0, At, B0); PG8_MMA(0, 1, At, B1); PG8_BAR; PG8_SCHED;
            PG8_LDA(At, 0, 1); PG8_STAGE(PG8_SB(0, 0), b2, voffB); PG8_STAGE(PG8_SB(0, 1), b2 + hstep, voffB); PG8_STAGE(PG8_SA(0, 0), a2, voffA);
            PG8_WAIT_V(8); PG8_WAIT_L(0); PG8_BAR; PG8_MMA(1, 0, At, B0); PG8_MMA(1, 1, At, B1); PG8_BAR; PG8_SCHED;
            PG8_LDB(B0, 1, 0); PG8_LDB(B1, 1, 1); PG8_SCHED; PG8_LDA(At, 1, 0); PG8_STAGE(PG8_SA(0, 1), a2 + hstep, voffA);
            PG8_WAIT_V(8); PG8_WAIT_L(0); PG8_BAR; PG8_MMA(0, 0, At, B0); PG8_MMA(0, 1, At, B1); PG8_BAR; PG8_SCHED;
            PG8_LDA(At, 1, 1); PG8_STAGE(PG8_SB(1, 0), b3, voffB); PG8_STAGE(PG8_SB(1, 1), b3 + hstep, voffB); PG8_STAGE(PG8_SA(1, 0), a3, voffA);
            PG8_WAIT_V(8); PG8_WAIT_L(0); PG8_BAR; PG8_MMA(1, 0, At, B0); PG8_MMA(1, 1, At, B1); PG8_BAR; PG8_SCHED;
            } else {
            PG8_LDB(B0, 0, 0); PG8_SCHED; PG8_LDA(At, 0, 0); PG8_STAGE(PG8_SA(1, 1), a1 + hstep, voffA);
            PG8_WAIT_L(8); PG8_BAR; PG8_WAIT_L(0); PG8_MMA(0, 0, At, B0); PG8_BAR; PG8_SCHED;
            PG8_LDB(B1, 0, 1); PG8_STAGE(PG8_SB(0, 0), b2, voffB);
            PG8_BAR; PG8_WAIT_L(0); PG8_MMA(0, 1, At, B1); PG8_BAR;
            PG8_LDA(At, 0, 1); PG8_STAGE(PG8_SA(0, 0), a2, voffA);
            PG8_BAR; PG8_WAIT_L(0); PG8_MMA(1, 0, At, B0); PG8_BAR; PG8_SCHED;
            PG8_STAGE(PG8_SB(0, 1), b2 + hstep, voffB);
            PG8_WAIT_V(6); PG8_BAR; PG8_MMA(1, 1, At, B1); PG8_BAR;
            PG8_LDB(B0, 1, 0); PG8_SCHED; PG8_LDA(At, 1, 0); PG8_STAGE(PG8_SA(0, 1), a2 + hstep, voffA);
            PG8_WAIT_L(8); PG8_BAR; PG8_WAIT_L(0); PG8_MMA(0, 0, At, B0); PG8_BAR; PG8_SCHED;
            PG8_LDB(B1, 1, 1); PG8_STAGE(PG8_SB(1, 0), b3, voffB);
            PG8_BAR; PG8_WAIT_L(0); PG8_MMA(0, 1, At, B1); PG8_BAR;
            PG8_LDA(At, 1, 1); PG8_STAGE(PG8_SA(1, 0), a3, voffA);
            PG8_BAR; PG8_WAIT_L(0); PG8_MMA(1, 0, At, B0); PG8_BAR; PG8_SCHED;
            PG8_STAGE(PG8_SB(1, 1), b3 + hstep, voffB);
            PG8_WAIT_V(6); PG8_BAR; PG8_MMA(1, 1, At, B1); PG8_BAR;
            }
        }
        if constexpr (ALIGN_EPI) { if (wr == 0) PG8_BAR; }
        if constexpr (!Epi::AFTER_DRAIN) { E(acc, cur, wr, wc, fr, fq); S.done(cur); }
        if (!has_next) break;
#pragma unroll
        for (int a = 0; a < 2; ++a)
#pragma unroll
            for (int b = 0; b < 2; ++b)
#pragma unroll
                for (int m = 0; m < 4; ++m)
#pragma unroll
                    for (int n = 0; n < 2; ++n) acc[a][b][m][n] = (f32x4){0.f, 0.f, 0.f, 0.f};
        cur = nxt; cA = nA; cB = nB; ++ui;
        if constexpr (ALIGN_EPI) { if (wr == 1) PG8_BAR; }
    }
    PG8_WAIT_V(0);
    if constexpr (!ALIGN_EPI) { if (wr == 0) PG8_BAR; }
    PG8_BAR;
    if constexpr (Epi::AFTER_DRAIN) { E.fused(acc, cur, wr, wc, fr, fq, lds, wid, lane); S.done(cur); }
#undef PG8_SA
#undef PG8_SB
#undef PG8_STAGE
#undef PG8_LDA
#undef PG8_LDB
#undef PG8_MMA
#undef PG8_WAIT_V
#undef PG8_WAIT_L
#undef PG8_BAR
#undef PG8_SCHED
}
}

struct Frame {
    LAS unsigned char* lds;
    int wave, G, bid;
    const float *x, *mix_norm, *ffn_norm, *final_norm, *w_in, *w_out, *rel_bias, *conv_w1, *conv_b1, *conv_dw, *conv_dw_b, *conv_ln_g, *conv_ln_b, *conv_w2, *conv_b2,
        *peer_wq, *peer_keys, *peer_u, *peer_v;
    float* out;
    unsigned char* ws;
};
#define FRAME_IDS const int f_lane = lane_id(); const int f_tid = F.wave * 64 + f_lane; (void)f_tid
DI float gamma_of(int h) { return 1.f - exp2f(-5.f - (float)h); }

DI void p0_prep(Frame& F) {
    FRAME_IDS;
    const int gw = F.bid * NWAVES + F.wave, NGW = F.G * NWAVES;
    f32x2* rope = (f32x2*)(F.ws + WS_ROPE);
    for (int i = F.bid * NTHR + f_tid; i < SEQ * 32; i += F.G * NTHR) {
        const int s = i >> 5, j = i & 31;
        const float inv = powf(10000.f, -(float)j / 32.f);
        const float ang = (float)s * inv;
        float sn, cs; sincosf(ang, &sn, &cs);
        rope[i] = (f32x2){cs, sn};
    }
    bf16* xb = (bf16*)(F.ws + WS_XB); float* part = (float*)(F.ws + WS_PART);
    for (int m = gw; m < T; m += NGW) {
        const f32x4* xr = (const f32x4*)(F.x + (size_t)m * DM) + f_lane;
        u32x2* o = (u32x2*)(xb + (size_t)m * DM) + f_lane;
        float s = 0.f;
#pragma unroll
        for (int j = 0; j < 4; ++j) { const f32x4 v = xr[64 * j]; s += v.x * v.x + v.y * v.y + v.z * v.z + v.w * v.w; o[64 * j] = (u32x2){pk2(v.x, v.y), pk2(v.z, v.w)}; }
        s = wave_sum(s);
        if (f_lane < 16) part[(size_t)m * 16 + f_lane] = (f_lane == 0) ? s : 0.f;
    }
}
DI void p0_transpose_item(const float* W, int K, int N, bf16* WT, int prow0, const float* gain, float scale, LAS float* scr, int k0, int n0, int lane) {
#pragma unroll 8
    for (int i = 0; i < 32; ++i) { const int kk = 2 * i + (lane >> 5); scr[kk * 33 + (lane & 31)] = W[(size_t)(k0 + kk) * N + n0 + (lane & 31)] * (gain ? gain[k0 + kk] : 1.f) * scale; }
    asm volatile("s_waitcnt lgkmcnt(0)" ::: "memory");
    const int c = lane & 7;
#pragma unroll
    for (int j = 0; j < 4; ++j) { const int n = (lane >> 3) + 8 * j; const LAS float* q = scr + (8 * c) * 33 + n;
        u32x4 o; o.x = pk2(q[0 * 33], q[1 * 33]); o.y = pk2(q[2 * 33], q[3 * 33]); o.z = pk2(q[4 * 33], q[5 * 33]); o.w = pk2(q[6 * 33], q[7 * 33]);
        *(u32x4*)(WT + (size_t)(prow0 + n) * K + k0 + 8 * c) = o; }
    asm volatile("s_waitcnt lgkmcnt(0)" ::: "memory");
}
DI void p0_weights(Frame& F) {
    FRAME_IDS;
    LAS float* scr = (LAS float*)(F.lds + F.wave * 16384);
    const int gw = F.bid * NWAVES + F.wave, NGW = F.G * NWAVES;
    constexpr int I_IN = 16 * (INC / 32), I_SQ = 16 * (DM / 32), I_W1 = 16 * (2 * DM / 32);
    constexpr int NITEMS = I_IN + I_SQ + I_W1 + I_SQ + 2 * I_SQ;
    for (int it = gw; it < NITEMS; it += NGW) {
        int r = it;
        if (r < I_IN) { const int nb = r % (INC / 32), kb = r / (INC / 32), n0 = nb * 32;
            const int type = n0 / 512, head = (n0 % 512) / 64, bj = (n0 % 64) / 32;
            const int prow0 = 256 * (2 * type + head / 4) + 128 * bj + 32 * (head % 4);
            p0_transpose_item(F.w_in, DM, INC, (bf16*)(F.ws + WS_WIN), prow0, F.mix_norm, (type == 0 || type == 4) ? 0.125f : 1.f, scr, kb * 64, n0, f_lane); continue; }
        r -= I_IN;
        if (r < I_SQ) { const int nb = r % 32, kb = r / 32; p0_transpose_item(F.w_out, DM, DM, (bf16*)(F.ws + WS_WOUT), nb * 32, nullptr, 1.f, scr, kb * 64, nb * 32, f_lane); continue; }
        r -= I_SQ;
        if (r < I_W1) { const int nb = r % 64, kb = r / 64, n0 = nb * 32; const int bj = n0 / 1024, rem = n0 % 1024;
            p0_transpose_item(F.conv_w1, DM, 2 * DM, (bf16*)(F.ws + WS_W1), 256 * (rem / 128) + 128 * bj + (rem % 128), F.mix_norm + DM, 1.f, scr, kb * 64, n0, f_lane); continue; }
        r -= I_W1;
        if (r < I_SQ) { const int nb = r % 32, kb = r / 32; p0_transpose_item(F.conv_w2, DM, DM, (bf16*)(F.ws + WS_W2), nb * 32, nullptr, 1.f, scr, kb * 64, nb * 32, f_lane); continue; }
        r -= I_SQ;
        { const int layer = r / I_SQ; r %= I_SQ; const int nb = r % 32, kb = r / 32;
          p0_transpose_item(F.peer_wq + (size_t)layer * DM * DM, DM, DM, (bf16*)(F.ws + WS_WQ) + (size_t)layer * DM * DM, nb * 32, F.ffn_norm + layer * DM, 1.f, scr, kb * 64, nb * 32, f_lane); }
    }
}
DI float row_rstd(const float* part, int m) {
    const f32x4* p = (const f32x4*)(part + (size_t)m * 16);
    const f32x4 a = p[0], b = p[1], c = p[2], d = p[3];
    const float s = ((a.x + a.y) + (a.z + a.w)) + ((b.x + b.y) + (b.z + b.w)) + ((c.x + c.y) + (c.z + c.w)) + ((d.x + d.y) + (d.z + d.w));
    return 1.f / sqrtf(s * (1.f / DM) + EPS);
}

enum { EP_PROJ = 0, EP_RES = 1, EP_Q = 2, EP_HID = 3 };
template <int EP>
DI void naive_gemm(Frame& F, const bf16* A, const float* W, int N, const float* gain, const float* bias, bf16* Ob, int ldo) {
    FRAME_IDS;
    LAS float* As = (LAS float*)F.lds;
    LAS float* Bs = As + 16 * 129;
    LAS float* rs = Bs + 16 * 64;
    const float* part = (const float*)(F.ws + WS_PART);
    const f32x2* rope = (const f32x2*)(F.ws + WS_ROPE);
    bf16* hb = (bf16*)(F.ws + WS_XB);
    const int tid = f_tid, tx = tid & 15, ty = tid >> 4;
    const int nN = N / 64, nItems = (T / 128) * nN;
    for (int it = F.bid; it < nItems; it += F.G) {
        const int m0 = (it / nN) * 128, n0 = (it % nN) * 64;
        __syncthreads();
        if (EP != EP_RES) { if (tid < 128) rs[tid] = row_rstd(part, m0 + tid); }
        float acc[4][4];
#pragma unroll
        for (int i = 0; i < 4; ++i)
#pragma unroll
            for (int j = 0; j < 4; ++j) acc[i][j] = 0.f;
        for (int k0 = 0; k0 < DM; k0 += 16) {
            {   const int r = tid >> 2, kk = (tid & 3) * 4;
                const u32x2 v = *(const u32x2*)(A + (size_t)(m0 + r) * DM + k0 + kk);
                As[(kk + 0) * 129 + r] = __uint_as_float(v.x << 16); As[(kk + 1) * 129 + r] = __uint_as_float(v.x & 0xffff0000u);
                As[(kk + 2) * 129 + r] = __uint_as_float(v.y << 16); As[(kk + 3) * 129 + r] = __uint_as_float(v.y & 0xffff0000u); }
            {   const int kk = tid >> 5, c = (tid & 31) * 2;
                const f32x2 v = *(const f32x2*)(W + (size_t)(k0 + kk) * N + n0 + c);
                const float g = gain ? gain[k0 + kk] : 1.f;
                Bs[kk * 64 + c] = v.x * g; Bs[kk * 64 + c + 1] = v.y * g; }
            __syncthreads();
#pragma unroll
            for (int kk = 0; kk < 16; ++kk) {
                float a[4], b[4];
#pragma unroll
                for (int i = 0; i < 4; ++i) a[i] = As[kk * 129 + ty * 4 + i];
                b[0] = Bs[kk * 64 + 2 * tx]; b[1] = Bs[kk * 64 + 2 * tx + 1]; b[2] = Bs[kk * 64 + 32 + 2 * tx]; b[3] = Bs[kk * 64 + 33 + 2 * tx];
#pragma unroll
                for (int i = 0; i < 4; ++i)
#pragma unroll
                    for (int j = 0; j < 4; ++j) acc[i][j] += a[i] * b[j];
            }
            __syncthreads();
        }
#pragma unroll
        for (int i = 0; i < 4; ++i) {
            const int m = m0 + ty * 4 + i;
            const int cols[4] = {n0 + 2 * tx, n0 + 2 * tx + 1, n0 + 32 + 2 * tx, n0 + 33 + 2 * tx};
            float v[4] = {acc[i][0], acc[i][1], acc[i][2], acc[i][3]};
            if (EP == EP_PROJ) {
                const float r = rs[ty * 4 + i];
#pragma unroll
                for (int j = 0; j < 4; ++j) v[j] *= r;
                const int type = n0 / 512;
                if (type == 3 || type == 4) {
                    const int s = m % SEQ;
#pragma unroll
                    for (int j = 0; j < 2; ++j) {
                        const f32x2 cs = rope[s * 32 + 2 * tx + j];
                        const float t1 = v[j], t2 = v[j + 2];
                        v[j] = t1 * cs.x - t2 * cs.y; v[j + 2] = t1 * cs.y + t2 * cs.x;
                    }
                }
                if (type == 0 || type == 4) {
#pragma unroll
                    for (int j = 0; j < 4; ++j) v[j] *= 0.125f;
                }
#pragma unroll
                for (int j = 0; j < 4; ++j) Ob[(size_t)m * ldo + cols[j]] = (bf16)f2bf(v[j]);
            } else if (EP == EP_RES) {
#pragma unroll
                for (int j = 0; j < 4; ++j) {
                    const size_t o = (size_t)m * DM + cols[j];
                    const float base = (Ob == nullptr) ? F.x[o] : F.out[o];
                    const float hn = base + v[j] + (bias ? bias[cols[j]] : 0.f);
                    F.out[o] = hn; hb[o] = (bf16)f2bf(hn);
                }
            } else if (EP == EP_Q) {
                const float r = rs[ty * 4 + i];
#pragma unroll
                for (int j = 0; j < 4; ++j) Ob[(size_t)m * ldo + cols[j]] = (bf16)f2bf(v[j] * r);
            } else {
                const float r = rs[ty * 4 + i];
#pragma unroll
                for (int j = 0; j < 4; ++j) Ob[(size_t)m * ldo + cols[j]] = (bf16)f2bf(v[j] * r + bias[cols[j]]);
            }
        }
    }
}

DI void naive_rowstat(Frame& F) {
    FRAME_IDS;
    const int gw = F.bid * NWAVES + F.wave, NGW = F.G * NWAVES;
    float* part = (float*)(F.ws + WS_PART);
    for (int m = gw; m < T; m += NGW) {
        const f32x4* xr = (const f32x4*)(F.out + (size_t)m * DM) + f_lane;
        float s = 0.f;
#pragma unroll
        for (int j = 0; j < 4; ++j) { const f32x4 v = xr[64 * j]; s += v.x * v.x + v.y * v.y + v.z * v.z + v.w * v.w; }
        s = wave_sum(s);
        if (f_lane < 16) part[(size_t)m * 16 + f_lane] = (f_lane == 0) ? s : 0.f;
    }
}

DI void naive_attn(Frame& F) {
    FRAME_IDS;
    const bf16* R = (const bf16*)(F.ws + WS_R); bf16* O = (bf16*)(F.ws + WS_O);
    LAS float* Ks = (LAS float*)F.lds;
    LAS float* Vs = Ks + 64 * 65;
    LAS float* bs = Vs + 64 * 65;
    const int tid = f_tid;
    for (int it = F.bid; it < NB * NHA * 4; it += F.G) {
        const int b = it / (NHA * 4), h = (it / 4) % NHA, cg = it % 4;
        const int c = cg * 8 + (tid >> 6), i = tid & 63;
        __syncthreads();
        for (int k = tid; k < 257; k += NTHR) bs[k] = F.rel_bias[h * 257 + k];
        float q[64], acc[64];
        {   const bf16* qp = R + (size_t)(b * SEQ + c * 64 + i) * INC + C_QA + h * 64;
#pragma unroll
            for (int d = 0; d < 64; ++d) { q[d] = bf2f(qp[d]); acc[d] = 0.f; } }
        float mx = -1e30f, l = 0.f;
        const int t_lo = (cg * 8 - 8) < 0 ? 0 : (cg * 8 - 8), t_hi = cg * 8 + 7;
        for (int tc = t_lo; tc <= t_hi; ++tc) {
            __syncthreads();
            for (int e = tid; e < 64 * 64; e += NTHR) {
                const int j = e >> 6, d = e & 63;
                const size_t row = (size_t)(b * SEQ + tc * 64 + j) * INC;
                Ks[j * 65 + d] = bf2f(R[row + C_KA + h * 64 + d]);
                Vs[j * 65 + d] = bf2f(R[row + C_VA + h * 64 + d]);
            }
            __syncthreads();
            if (tc <= c && tc >= c - 8) {
                for (int j = 0; j < 64; ++j) {
                    float s = 0.f;
#pragma unroll
                    for (int d = 0; d < 64; ++d) s += q[d] * Ks[j * 65 + d];
                    int rel = (c * 64 + i) - (tc * 64 + j); rel = rel < -128 ? -128 : (rel > 128 ? 128 : rel);
                    s += bs[rel + 128];
                    const float mn = fmaxf(mx, s), corr = __expf(mx - mn), p = __expf(s - mn);
                    l = l * corr + p;
#pragma unroll
                    for (int d = 0; d < 64; ++d) acc[d] = acc[d] * corr + p * Vs[j * 65 + d];
                    mx = mn;
                }
            }
        }
        const float inv = 1.f / l;
        bf16* op = O + (size_t)(b * SEQ + c * 64 + i) * DM + h * 64;
#pragma unroll
        for (int d = 0; d < 64; ++d) op[d] = (bf16)f2bf(acc[d] * inv);
    }
}


typedef short v4i16 __attribute__((ext_vector_type(4)));
typedef __bf16 bf16x2_t __attribute__((ext_vector_type(2)));
DI unsigned cvtpk(float lo, float hi) { f32x2 v = {lo, hi}; bf16x2_t b = __builtin_convertvector(v, bf16x2_t); return __builtin_bit_cast(unsigned, b); }
DI v4i16 ds_tr16(LAS const unsigned char* p) { return __builtin_amdgcn_ds_read_tr16_b64_v4i16((LAS v4i16*)p); }
DI int crow(int r, int h) { return (r & 3) + 8 * (r >> 2) + 4 * h; }
DI bf16x8 pack_step(const f32x16& x, const int s) {
    u32x4 w = {cvtpk(x[8 * s + 0], x[8 * s + 1]), cvtpk(x[8 * s + 2], x[8 * s + 3]), cvtpk(x[8 * s + 4], x[8 * s + 5]), cvtpk(x[8 * s + 6], x[8 * s + 7])};
    return __builtin_bit_cast(bf16x8, w);
}
constexpr int AT_KB = 64 * 144, AT_VB = 8192, AT_BUF = AT_KB + AT_VB, AT_BIAS = 2 * AT_BUF;
DI void attn_item(Frame& F, const int it) {
    FRAME_IDS;
    const bf16* R = (const bf16*)(F.ws + WS_R); bf16* O = (bf16*)(F.ws + WS_O);
    LAS unsigned char* lds = F.lds;
    LAS float* bias_s = (LAS float*)(lds + AT_BIAS);
    const int q32 = f_lane & 31, h = f_lane >> 5, w = F.wave;
    const int srow = f_tid >> 3, sch = f_tid & 7;
    const int vtr_off = ((f_lane & 15) >> 2) * 64 + (16 * ((f_lane >> 4) & 1) + 4 * (f_lane & 3)) * 2;
    {
        const int b = it / (NHA * 8), hd = (it / 8) % NHA, c0 = (it % 8) * 4;
        const int c = c0 + (w >> 1), qrow0 = 32 * (w & 1);
        const size_t tq = (size_t)b * SEQ + c * 64 + qrow0 + q32;
        __syncthreads();
        for (int k = f_tid; k < 257; k += NTHR) bias_s[k] = F.rel_bias[hd * 257 + k];
        bf16x8 qf[4];
#pragma unroll
        for (int ks = 0; ks < 4; ++ks) qf[ks] = *(const bf16x8*)(R + tq * INC + C_QA + hd * 64 + 16 * ks + 8 * h);
        const int t_lo = c0 - 8 < 0 ? 0 : c0 - 8, t_hi = c0 + 3, ntile = t_hi - t_lo + 1;
        const bf16* kbase = R + ((size_t)b * SEQ + srow) * INC + C_KA + hd * 64 + 8 * sch;
        const bf16* vbase = R + ((size_t)b * SEQ + srow) * INC + C_VA + hd * 64 + 8 * sch;
        u32x4 kreg = *(const u32x4*)(kbase + (size_t)t_lo * 64 * INC), vreg = *(const u32x4*)(vbase + (size_t)t_lo * 64 * INC);
        *(LAS u32x4*)(lds + srow * 144 + sch * 16) = kreg;
        *(LAS u32x4*)(lds + AT_KB + (sch >> 2) * 4096 + srow * 64 + (sch & 3) * 16) = vreg;
        __syncthreads();
        const float bias_far = bias_s[256];
        float m = -1e30f, l = 0.f;
        f32x16 o0 = {}, o1 = {};
        for (int i = 0; i < ntile; ++i) {
            const int tc = t_lo + i;
            LAS unsigned char* kb = lds + (i & 1) * AT_BUF; LAS unsigned char* vb = kb + AT_KB;
            if (i + 1 < ntile) { kreg = *(const u32x4*)(kbase + (size_t)(tc + 1) * 64 * INC); vreg = *(const u32x4*)(vbase + (size_t)(tc + 1) * 64 * INC); }
            const int D = c - tc;
            if (D >= 0 && D <= 8) {
                const float init = D >= 3 ? bias_far : 0.f;
                f32x16 p0, p1;
#pragma unroll
                for (int r = 0; r < 16; ++r) { p0[r] = init; p1[r] = init; }
#pragma unroll
                for (int ks = 0; ks < 4; ++ks) {
                    const bf16x8 k0 = *(const LAS bf16x8*)(kb + q32 * 144 + (16 * ks + 8 * h) * 2);
                    const bf16x8 k1 = *(const LAS bf16x8*)(kb + (32 + q32) * 144 + (16 * ks + 8 * h) * 2);
                    p0 = __builtin_amdgcn_mfma_f32_32x32x16_bf16(k0, qf[ks], p0, 0, 0, 0);
                    p1 = __builtin_amdgcn_mfma_f32_32x32x16_bf16(k1, qf[ks], p1, 0, 0, 0);
                }
                if (D < 3) {
                    const int relb = D * 64 + qrow0 + q32 - 4 * h + 128;
#pragma unroll
                    for (int r = 0; r < 16; ++r) {
                        const int r0 = relb - ((r & 3) + 8 * (r >> 2));
                        const int i0 = r0 < 0 ? 0 : (r0 > 256 ? 256 : r0), r1 = r0 - 32, i1 = r1 < 0 ? 0 : (r1 > 256 ? 256 : r1);
                        p0[r] += bias_s[i0]; p1[r] += bias_s[i1];
                    }
                }
                float tm = fmaxf(p0[0], p1[0]);
#pragma unroll
                for (int r = 1; r < 16; ++r) tm = fmaxf(tm, fmaxf(p0[r], p1[r]));
                tm = fmaxf(tm, __shfl_xor(tm, 32));
                const float mn = fmaxf(m, tm), alpha = __expf(m - mn);
                m = mn;
                float ps = 0.f;
#pragma unroll
                for (int r = 0; r < 16; ++r) { p0[r] = __expf(p0[r] - mn); p1[r] = __expf(p1[r] - mn); ps += p0[r] + p1[r]; }
                l = l * alpha + ps;
#pragma unroll
                for (int r = 0; r < 16; ++r) { o0[r] *= alpha; o1[r] *= alpha; }
                bf16x8 pf[4];
                pf[0] = pack_step(p0, 0); pf[1] = pack_step(p0, 1); pf[2] = pack_step(p1, 0); pf[3] = pack_step(p1, 1);
#pragma unroll
                for (int kk = 0; kk < 4; ++kk) {
                    const int key0 = 16 * kk + 4 * h;
                    const v4i16 a0l = ds_tr16(vb + key0 * 64 + vtr_off), a0h = ds_tr16(vb + (key0 + 8) * 64 + vtr_off);
                    const v4i16 a1l = ds_tr16(vb + 4096 + key0 * 64 + vtr_off), a1h = ds_tr16(vb + 4096 + (key0 + 8) * 64 + vtr_off);
                    const bf16x8 a0 = __builtin_shufflevector(a0l, a0h, 0, 1, 2, 3, 4, 5, 6, 7), a1 = __builtin_shufflevector(a1l, a1h, 0, 1, 2, 3, 4, 5, 6, 7);
                    o0 = __builtin_amdgcn_mfma_f32_32x32x16_bf16(a0, pf[kk], o0, 0, 0, 0);
                    o1 = __builtin_amdgcn_mfma_f32_32x32x16_bf16(a1, pf[kk], o1, 0, 0, 0);
                }
            }
            if (i + 1 < ntile) {
                LAS unsigned char* nb = lds + ((i + 1) & 1) * AT_BUF;
                *(LAS u32x4*)(nb + srow * 144 + sch * 16) = kreg;
                *(LAS u32x4*)(nb + AT_KB + (sch >> 2) * 4096 + srow * 64 + (sch & 3) * 16) = vreg;
            }
            __syncthreads();
        }
        l += __shfl_xor(l, 32);
        const float inv = 1.f / l;
        bf16* op = O + tq * DM + hd * 64 + 4 * h;
#pragma unroll
        for (int g = 0; g < 4; ++g) {
            *(u32x2*)(op + 8 * g) = (u32x2){cvtpk(o0[4 * g] * inv, o0[4 * g + 1] * inv), cvtpk(o0[4 * g + 2] * inv, o0[4 * g + 3] * inv)};
            *(u32x2*)(op + 32 + 8 * g) = (u32x2){cvtpk(o1[4 * g] * inv, o1[4 * g + 1] * inv), cvtpk(o1[4 * g + 2] * inv, o1[4 * g + 3] * inv)};
        }
    }
    __syncthreads();
}

constexpr int RT_Q = 0, RT_K = 9216, RT_KD = 18432, RT_V = 26624, RT_BUF = 34816, RT_ZS = 2 * RT_BUF, RT_CS = RT_ZS + 64 * 66 * 4;
DI void ret_item(Frame& F, const int it) {
    FRAME_IDS;
    const bf16* R = (const bf16*)(F.ws + WS_R); bf16* O = (bf16*)(F.ws + WS_O);
    LAS unsigned char* lds = F.lds;
    LAS float* Zs = (LAS float*)(lds + RT_ZS); LAS float* Cs = (LAS float*)(lds + RT_CS);
    const int b = it / NHB, hd = it % NHB;
    const int q32 = f_lane & 31, h = f_lane >> 5, w = F.wave;
    const int role = w >> 2, itile = (w >> 1) & 1, etile = w & 1;
    const int srow = f_tid >> 3, sch = f_tid & 7;
    const int vtr_off = ((f_lane & 15) >> 2) * 64 + (16 * ((f_lane >> 4) & 1) + 4 * (f_lane & 3)) * 2;
    const float l2g = log2f(gamma_of(hd));
    const float cd = exp2f(l2g * 64.f), sdec = exp2f(l2g * (float)(63 - srow));
    float qdv[16];
#pragma unroll
    for (int r = 0; r < 16; ++r) qdv[r] = exp2f(l2g * (float)(32 * itile + crow(r, h) + 1));
    f32x16 xs0 = {}, xs1 = {};
    const size_t trow0 = (size_t)b * SEQ;
    const bf16* gq = R + (trow0 + srow) * INC + hd * 64 + 8 * sch;
    u32x4 qreg = *(const u32x4*)(gq + C_QB), kreg = *(const u32x4*)(gq + C_KB), vreg = *(const u32x4*)(gq + C_VB);
    __syncthreads();
#define RT_STAGE(bufp) do { LAS unsigned char* bp_ = (bufp); \
        *(LAS u32x4*)(bp_ + RT_Q + srow * 144 + sch * 16) = qreg; *(LAS u32x4*)(bp_ + RT_K + srow * 144 + sch * 16) = kreg; \
        *(LAS u32x4*)(bp_ + RT_V + (sch >> 2) * 4096 + srow * 64 + (sch & 3) * 16) = vreg; \
        u32x4 kd_; \
        _Pragma("unroll") for (int e_ = 0; e_ < 4; ++e_) kd_[e_] = cvtpk(__uint_as_float(kreg[e_] << 16) * sdec, __uint_as_float(kreg[e_] & 0xffff0000u) * sdec); \
        *(LAS u32x4*)(bp_ + RT_KD + (sch >> 2) * 4096 + srow * 64 + (sch & 3) * 16) = kd_; } while (0)
    RT_STAGE(lds);
    __syncthreads();
    for (int n = 0; n < NCH; ++n) {
        LAS unsigned char* bp = lds + (n & 1) * RT_BUF;
        if (n + 1 < NCH) { const bf16* g1 = gq + (size_t)(n + 1) * 64 * INC; qreg = *(const u32x4*)(g1 + C_QB); kreg = *(const u32x4*)(g1 + C_KB); vreg = *(const u32x4*)(g1 + C_VB); }
        unsigned short gr[8];
#pragma unroll
        for (int r = 0; r < 8; ++r) gr[r] = R[(trow0 + n * 64 + 8 * w + r) * INC + C_GB + hd * 64 + f_lane];
        if (role == 0) {
            bf16x8 qf[4];
#pragma unroll
            for (int ks = 0; ks < 4; ++ks) qf[ks] = *(const LAS bf16x8*)(bp + RT_Q + (32 * itile + q32) * 144 + (16 * ks + 8 * h) * 2);
            f32x16 st0 = {}, st1 = {};
#pragma unroll
            for (int ks = 0; ks < 4; ++ks) {
                const bf16x8 k0 = *(const LAS bf16x8*)(bp + RT_K + q32 * 144 + (16 * ks + 8 * h) * 2);
                const bf16x8 k1 = *(const LAS bf16x8*)(bp + RT_K + (32 + q32) * 144 + (16 * ks + 8 * h) * 2);
                st0 = __builtin_amdgcn_mfma_f32_32x32x16_bf16(k0, qf[ks], st0, 0, 0, 0);
                st1 = __builtin_amdgcn_mfma_f32_32x32x16_bf16(k1, qf[ks], st1, 0, 0, 0);
            }
            int iiv = 32 * itile + q32 - 4 * h; asm volatile("" : "+v"(iiv));
#pragma unroll
            for (int r = 0; r < 16; ++r) {
                const int dd = iiv - ((r & 3) + 8 * (r >> 2));
                st0[r] *= __builtin_amdgcn_exp2f(l2g * fabsf((float)dd));
                st1[r] *= __builtin_amdgcn_exp2f(l2g * fabsf((float)(dd - 32)));
            }
            f32x16 z = {};
#pragma unroll
            for (int kk = 0; kk < 4; ++kk) {
                const int key0 = 16 * kk + 4 * h;
                const v4i16 bl = ds_tr16(bp + RT_V + etile * 4096 + key0 * 64 + vtr_off), bh = ds_tr16(bp + RT_V + etile * 4096 + (key0 + 8) * 64 + vtr_off);
                const bf16x8 vb = __builtin_shufflevector(bl, bh, 0, 1, 2, 3, 4, 5, 6, 7);
                const bf16x8 xa = (kk < 2) ? pack_step(st0, kk & 1) : pack_step(st1, kk & 1);
                z = __builtin_amdgcn_mfma_f32_32x32x16_bf16(xa, vb, z, 0, 0, 0);
            }
            int zb = (32 * itile + 4 * h) * 66 + 32 * etile + q32; asm volatile("" : "+v"(zb));
#pragma unroll
            for (int r = 0; r < 16; ++r) Zs[zb + ((r & 3) + 8 * (r >> 2)) * 66] = z[r];
        } else {
            f32x16 cr = {};
#pragma unroll
            for (int kk = 0; kk < 4; ++kk) {
                const LAS unsigned char* qp = bp + RT_Q + (32 * itile + q32) * 144 + (16 * kk + 4 * h) * 2;
                const v4i16 al = *(const LAS v4i16*)qp, ah = *(const LAS v4i16*)(qp + 16);
                const bf16x8 qa = __builtin_shufflevector(al, ah, 0, 1, 2, 3, 4, 5, 6, 7);
                const bf16x8 xb = (kk < 2) ? pack_step(xs0, kk & 1) : pack_step(xs1, kk & 1);
                cr = __builtin_amdgcn_mfma_f32_32x32x16_bf16(qa, xb, cr, 0, 0, 0);
            }
            int cb = (32 * itile + 4 * h) * 66 + 32 * etile + q32; asm volatile("" : "+v"(cb));
#pragma unroll
            for (int r = 0; r < 16; ++r) Cs[cb + ((r & 3) + 8 * (r >> 2)) * 66] = cr[r] * qdv[r];
#pragma unroll
            for (int r = 0; r < 16; ++r) { xs0[r] *= cd; xs1[r] *= cd; }
#pragma unroll
            for (int s4 = 0; s4 < 4; ++s4) {
                const int key0 = 16 * s4 + 8 * h;
                const v4i16 vl = ds_tr16(bp + RT_V + etile * 4096 + key0 * 64 + vtr_off), vh = ds_tr16(bp + RT_V + etile * 4096 + (key0 + 4) * 64 + vtr_off);
                const bf16x8 vb = __builtin_shufflevector(vl, vh, 0, 1, 2, 3, 4, 5, 6, 7);
                const v4i16 a0l = ds_tr16(bp + RT_KD + key0 * 64 + vtr_off), a0h = ds_tr16(bp + RT_KD + (key0 + 4) * 64 + vtr_off);
                const v4i16 a1l = ds_tr16(bp + RT_KD + 4096 + key0 * 64 + vtr_off), a1h = ds_tr16(bp + RT_KD + 4096 + (key0 + 4) * 64 + vtr_off);
                const bf16x8 ka0 = __builtin_shufflevector(a0l, a0h, 0, 1, 2, 3, 4, 5, 6, 7), ka1 = __builtin_shufflevector(a1l, a1h, 0, 1, 2, 3, 4, 5, 6, 7);
                xs0 = __builtin_amdgcn_mfma_f32_32x32x16_bf16(ka0, vb, xs0, 0, 0, 0);
                xs1 = __builtin_amdgcn_mfma_f32_32x32x16_bf16(ka1, vb, xs1, 0, 0, 0);
            }
        }
        __syncthreads();
#pragma unroll
        for (int r = 0; r < 8; ++r) {
            const int i = 8 * w + r;
            const float v = Zs[i * 66 + f_lane] + Cs[i * 66 + f_lane];
            const float mu = wave_sum(v) * (1.f / 64.f);
            const float dv = v - mu;
            const float var = wave_sum(dv * dv) * (1.f / 64.f);
            const float g = bf2f(gr[r]);
            O[(trow0 + n * 64 + i) * DM + 512 + hd * 64 + f_lane] = (bf16)f2bf(dv * (1.f / sqrtf(var + EPS)) * (g / (1.f + __expf(-g))));
        }
        if (n + 1 < NCH) RT_STAGE(lds + ((n + 1) & 1) * RT_BUF);
        __syncthreads();
    }
#undef RT_STAGE
}
DI void mix_phase(Frame& F) {
    FRAME_IDS;
    unsigned* ctr = (unsigned*)(F.ws + WS_CTL) + CW_QUEUE;
    volatile LAS unsigned* slot = (volatile LAS unsigned*)(F.lds + MISC_OFF) + 16;
    for (;;) {
        __syncthreads();
        if (f_tid == 0) slot[0] = __hip_atomic_fetch_add(ctr, 1u, __ATOMIC_RELAXED, __HIP_MEMORY_SCOPE_AGENT);
        __syncthreads();
        const int idx = (int)slot[0];
        if (idx >= NB * NHB + NB * NHA * 8) break;
        if (idx < NB * NHB) ret_item(F, idx); else attn_item(F, idx - NB * NHB);
    }
}
DI void naive_ret(Frame& F) {
    FRAME_IDS;
    const bf16* R = (const bf16*)(F.ws + WS_R); bf16* O = (bf16*)(F.ws + WS_O);
    LAS float* St = (LAS float*)F.lds;
    LAS float* Qs = St + 4096;
    LAS float* Ks = Qs + 64 * 65;
    LAS float* Vs = Ks + 64 * 65;
    LAS float* Sc = Vs + 64 * 65;
    LAS float* Ot = Sc + 64 * 65;
    const int tid = f_tid;
    for (int it = F.G - 1 - F.bid; it < NB * NHB; it += F.G) {
        const int b = it / NHB, h = it % NHB;
        const float lg = logf(gamma_of(h));
        const float cd = __expf(lg * 64.f);
        __syncthreads();
        for (int e = tid; e < 4096; e += NTHR) St[e] = 0.f;
        for (int n = 0; n < NCH; ++n) {
            __syncthreads();
            for (int e = tid; e < 4096; e += NTHR) {
                const int j = e >> 6, d = e & 63;
                const size_t row = (size_t)(b * SEQ + n * 64 + j) * INC;
                Qs[j * 65 + d] = bf2f(R[row + C_QB + h * 64 + d]);
                Ks[j * 65 + d] = bf2f(R[row + C_KB + h * 64 + d]);
                Vs[j * 65 + d] = bf2f(R[row + C_VB + h * 64 + d]);
            }
            __syncthreads();
            for (int e = tid; e < 4096; e += NTHR) {
                const int i = e >> 6, j = e & 63;
                float s = 0.f;
#pragma unroll
                for (int d = 0; d < 64; ++d) s += Qs[i * 65 + d] * Ks[j * 65 + d];
                const int ad = i > j ? i - j : j - i;
                Sc[i * 65 + j] = s * __expf(lg * (float)ad);
            }
            __syncthreads();
            for (int e = tid; e < 4096; e += NTHR) {
                const int i = e >> 6, ee = e & 63;
                float s = 0.f, cr = 0.f;
#pragma unroll
                for (int j = 0; j < 64; ++j) s += Sc[i * 65 + j] * Vs[j * 65 + ee];
#pragma unroll
                for (int d = 0; d < 64; ++d) cr += Qs[i * 65 + d] * St[d * 64 + ee];
                Ot[i * 65 + ee] = s + cr * __expf(lg * (float)(i + 1));
            }
            __syncthreads();
            for (int e = tid; e < 4096; e += NTHR) {
                const int d = e >> 6, ee = e & 63;
                float s = 0.f;
                for (int j = 0; j < 64; ++j) s += Ks[j * 65 + d] * __expf(lg * (float)(63 - j)) * Vs[j * 65 + ee];
                St[d * 64 + ee] = cd * St[d * 64 + ee] + s;
            }
            for (int r = 0; r < 8; ++r) {
                const int i = F.wave * 8 + r;
                const float v = Ot[i * 65 + f_lane];
                const float mu = wave_sum(v) * (1.f / 64.f);
                const float dv = v - mu;
                const float var = wave_sum(dv * dv) * (1.f / 64.f);
                const size_t row = (size_t)(b * SEQ + n * 64 + i);
                const float g = bf2f(R[row * INC + C_GB + h * 64 + f_lane]);
                const float o = dv * (1.f / sqrtf(var + EPS)) * (g * sigmoidf(g));
                O[row * DM + 512 + h * 64 + f_lane] = (bf16)f2bf(o);
            }
        }
    }
}

DI void naive_route(Frame& F, int layer) {
    FRAME_IDS;
    const bf16* Q = (const bf16*)(F.ws + WS_Q);
    int* eidx = (int*)(F.ws + WS_EIDX); float* gate = (float*)(F.ws + WS_GATE);
    const float* keys = F.peer_keys + (size_t)layer * 2 * PK * 64;
    LAS float* sc = (LAS float*)F.lds;
    LAS int* i1s = (LAS int*)(sc + 256 * 64);
    LAS int* i2s = i1s + 16 * 64;
    LAS float* qs = (LAS float*)(i2s + 16 * 64);
    const int p = f_tid;
    for (int it = F.bid; it < T / 8; it += F.G) {
        if (p < 64) {
            const int t = it * 8 + (p >> 3), hh = p & 7;
            float top1[16], top2[16];
#pragma unroll
            for (int side = 0; side < 2; ++side) {
                const bf16* qp = Q + (size_t)t * DM + hh * 128 + side * 64;
                for (int d = 0; d < 64; ++d) qs[d * 64 + p] = bf2f(qp[d]);
                for (int k = 0; k < PK; ++k) {
                    const float* kp = keys + ((size_t)side * PK + k) * 64;
                    float s = 0.f;
#pragma unroll 8
                    for (int d = 0; d < 64; ++d) s += qs[d * 64 + p] * kp[d];
                    sc[k * 64 + p] = s;
                }
#pragma unroll
                for (int a = 0; a < 16; ++a) {
                    float best = -INFINITY; int bi = 0;
                    for (int k = 0; k < PK; ++k) { const float v = sc[k * 64 + p]; if (v > best) { best = v; bi = k; } }
                    sc[bi * 64 + p] = -INFINITY;
                    if (side == 0) { top1[a] = best; i1s[a * 64 + p] = bi; } else { top2[a] = best; i2s[a * 64 + p] = bi; }
                }
            }
#pragma unroll
            for (int a = 0; a < 16; ++a)
#pragma unroll
                for (int b = 0; b < 16; ++b) sc[(a * 16 + b) * 64 + p] = top1[a] + top2[b];
            float bv[16]; int be[16];
#pragma unroll
            for (int a = 0; a < 16; ++a) {
                float best = -INFINITY; int bi = 0;
                for (int k = 0; k < 256; ++k) { const float v = sc[k * 64 + p]; if (v > best) { best = v; bi = k; } }
                sc[bi * 64 + p] = -INFINITY;
                bv[a] = best; be[a] = i1s[(bi >> 4) * 64 + p] * PK + i2s[(bi & 15) * 64 + p];
            }
            float sum = 0.f; const float bmax = bv[0];
#pragma unroll
            for (int a = 0; a < 16; ++a) { bv[a] = __expf(bv[a] - bmax); sum += bv[a]; }
            const float inv = 1.f / sum;
#pragma unroll
            for (int a = 0; a < 16; ++a) { eidx[(size_t)t * NSEL + hh * 16 + a] = be[a]; gate[(size_t)t * NSEL + hh * 16 + a] = bv[a] * inv; }
        }
    }
}


DI float fmax_raw(float a, float b) { float r; asm("v_max_f32_e32 %0, %1, %2" : "=v"(r) : "v"(a), "v"(b)); return r; }
DI float fmin_raw(float a, float b) { float r; asm("v_min_f32_e32 %0, %1, %2" : "=v"(r) : "v"(a), "v"(b)); return r; }
#define CE_DESC(x, y) do { const float hi_ = fmax_raw((x), (y)), lo_ = fmin_raw((x), (y)); (x) = hi_; (y) = lo_; } while (0)
template <int N> DI void sort_desc(float* v) {
#pragma unroll
    for (int k = 2; k <= N; k <<= 1)
#pragma unroll
        for (int j = k >> 1; j > 0; j >>= 1)
#pragma unroll
            for (int i = 0; i < N; ++i) { const int l = i ^ j; if (l > i) { if ((i & k) == 0 || k == N) CE_DESC(v[i], v[l]); else CE_DESC(v[l], v[i]); } }
}
DI void merge16(float* a, const float* b) {
#pragma unroll
    for (int i = 0; i < 16; ++i) a[i] = fmax_raw(a[i], b[15 - i]);
#pragma unroll
    for (int j = 8; j > 0; j >>= 1)
#pragma unroll
        for (int i = 0; i < 16; ++i) { const int l = i ^ j; if (l > i) CE_DESC(a[i], a[l]); }
}
DI float key_pack(float v, unsigned keep_mask, unsigned idx) { return __uint_as_float((__float_as_uint(v) & keep_mask) | idx); }
DI void opt_route(Frame& F, int layer) {
    FRAME_IDS;
    const bf16* Q = (const bf16*)(F.ws + WS_Q);
    int* eidx = (int*)(F.ws + WS_EIDX); float* gate = (float*)(F.ws + WS_GATE);
    const float* keys = F.peer_keys + (size_t)layer * 2 * PK * 64;
    LAS unsigned char* kl = F.lds;
    __syncthreads();
    for (int idx = f_tid; idx < 2 * PK * 8; idx += NTHR) {
        const int row = idx >> 3, ch = idx & 7;
        const f32x4 a = *(const f32x4*)(keys + (size_t)row * 64 + ch * 8), b = *(const f32x4*)(keys + (size_t)row * 64 + ch * 8 + 4);
        *(LAS u32x4*)(kl + row * 144 + ch * 16) = (u32x4){pk2(a[0], a[1]), pk2(a[2], a[3]), pk2(b[0], b[1]), pk2(b[2], b[3])};
    }
    __syncthreads();
    LAS int* lut = (LAS int*)(F.lds + 40960 + F.wave * 8192);
    const int c = f_lane & 31, h = f_lane >> 5;
    const int gw = F.bid * NWAVES + F.wave, NGW = F.G * NWAVES;
    for (int task = gw; task < (T / 32) * PH; task += NGW) {
        const int tile = task >> 3, hh = task & 7, t = tile * 32 + c;
        float tk[2][16];
#pragma unroll
        for (int side = 0; side < 2; ++side) {
            bf16x8 qf[4];
#pragma unroll
            for (int ks = 0; ks < 4; ++ks) qf[ks] = *(const bf16x8*)(Q + (size_t)t * DM + hh * PQD + side * 64 + 16 * ks + 8 * h);
            float v[64];
#pragma unroll
            for (int kt = 0; kt < 4; ++kt) {
                f32x16 acc = {};
#pragma unroll
                for (int ks = 0; ks < 4; ++ks) {
                    const bf16x8 a = *(const LAS bf16x8*)(kl + (side * PK + 32 * kt + c) * 144 + (16 * ks + 8 * h) * 2);
                    acc = __builtin_amdgcn_mfma_f32_32x32x16_bf16(a, qf[ks], acc, 0, 0, 0);
                }
#pragma unroll
                for (int r = 0; r < 16; ++r) v[16 * kt + r] = key_pack(acc[r], 0xFFFFFF80u, (unsigned)(32 * kt + (r & 3) + 8 * (r >> 2) + 4 * h));
            }
            sort_desc<16>(v); sort_desc<16>(v + 16); sort_desc<16>(v + 32); sort_desc<16>(v + 48);
            merge16(v, v + 16); merge16(v + 32, v + 48); merge16(v, v + 32);
            float pr[16];
#pragma unroll
            for (int i = 0; i < 16; ++i) pr[i] = __shfl_xor(v[i], 32);
            merge16(v, pr);
#pragma unroll
            for (int i = 0; i < 16; ++i) { tk[side][i] = v[i]; lut[(side * 16 + i) * 64 + f_lane] = (int)(__float_as_uint(v[i]) & 0x7Fu); }
        }
        float cd[64];
        {   int n = 0;
#pragma unroll
            for (int a = 0; a < 16; ++a)
#pragma unroll
                for (int b = 0; b < 16; ++b) if ((a + 1) * (b + 1) <= 16) { cd[n] = key_pack(tk[0][a] + tk[1][b], 0xFFFFFF00u, (unsigned)(a * 16 + b)); ++n; }
#pragma unroll
            for (int i = 50; i < 64; ++i) cd[i] = -INFINITY;
        }
        sort_desc<16>(cd); sort_desc<16>(cd + 16); sort_desc<16>(cd + 32); CE_DESC(cd[48], cd[49]);
        merge16(cd, cd + 16); merge16(cd + 32, cd + 48); merge16(cd, cd + 32);
        int ex[16]; float gv[16]; float sum = 0.f;
        const float top = __uint_as_float(__float_as_uint(cd[0]) & 0xFFFFFF00u);
#pragma unroll
        for (int i = 0; i < 16; ++i) {
            const unsigned bits = __float_as_uint(cd[i]);
            const int a = (bits >> 4) & 15, b = bits & 15;
            ex[i] = lut[a * 64 + f_lane] * PK + lut[(16 + b) * 64 + f_lane];
            gv[i] = __expf(__uint_as_float(bits & 0xFFFFFF00u) - top); sum += gv[i];
        }
        const float inv = 1.f / sum;
        if (h == 0) {
            u32x4* ep = (u32x4*)(eidx + (size_t)t * NSEL + hh * 16);
#pragma unroll
            for (int q = 0; q < 4; ++q) ep[q] = (u32x4){(unsigned)ex[4 * q], (unsigned)ex[4 * q + 1], (unsigned)ex[4 * q + 2], (unsigned)ex[4 * q + 3]};
        } else {
            f32x4* gp = (f32x4*)(gate + (size_t)t * NSEL + hh * 16);
#pragma unroll
            for (int q = 0; q < 4; ++q) gp[q] = (f32x4){gv[4 * q] * inv, gv[4 * q + 1] * inv, gv[4 * q + 2] * inv, gv[4 * q + 3] * inv};
        }
    }
    __syncthreads();
}
DI void naive_gather(Frame& F, int layer, bool final_norm) {
    FRAME_IDS;
    const int* eidx = (const int*)(F.ws + WS_EIDX); const float* gate = (const float*)(F.ws + WS_GATE);
    float* part = (float*)(F.ws + WS_PART); bf16* hb = (bf16*)(F.ws + WS_XB);
    const float* U = F.peer_u + (size_t)layer * PE * DM; const float* V = F.peer_v + (size_t)layer * PE * DM;
    const float* gn = F.ffn_norm + layer * DM;
    LAS float* xs = (LAS float*)F.lds;
    LAS float* as = xs + 1024;
    LAS int* es = (LAS int*)(as + 128);
    LAS float* red = (LAS float*)(es + 128);
    const int tid = f_tid;
    for (int t = F.bid; t < T; t += F.G) {
        __syncthreads();
        const float rstd = row_rstd(part, t);
        const f32x2 hv = *(const f32x2*)(F.out + (size_t)t * DM + 2 * tid);
        xs[2 * tid] = hv.x * rstd * gn[2 * tid]; xs[2 * tid + 1] = hv.y * rstd * gn[2 * tid + 1];
        if (tid < 128) es[tid] = eidx[(size_t)t * NSEL + tid];
        __syncthreads();
        for (int k = F.wave; k < NSEL; k += NWAVES) {
            const f32x4* ur = (const f32x4*)(U + (size_t)es[k] * DM) + f_lane;
            float s = 0.f;
#pragma unroll
            for (int j = 0; j < 4; ++j) { const f32x4 u = ur[64 * j]; const int c = 4 * f_lane + 256 * j; s += u.x * xs[c] + u.y * xs[c + 1] + u.z * xs[c + 2] + u.w * xs[c + 3]; }
            s = wave_sum(s);
            if (f_lane == 0) as[k] = gelu_erf(s) * gate[(size_t)t * NSEL + k];
        }
        __syncthreads();
        float o0 = 0.f, o1 = 0.f;
        for (int k = 0; k < NSEL; ++k) { const f32x2 v = *(const f32x2*)(V + (size_t)es[k] * DM + 2 * tid); const float a = as[k]; o0 += a * v.x; o1 += a * v.y; }
        const float h0 = hv.x + o0, h1 = hv.y + o1;
        const float ss = block_sum(h0 * h0 + h1 * h1, red, tid);
        if (final_norm) {
            const float r = 1.f / sqrtf(ss * (1.f / DM) + EPS);
            *(f32x2*)(F.out + (size_t)t * DM + 2 * tid) = (f32x2){h0 * r * F.final_norm[2 * tid], h1 * r * F.final_norm[2 * tid + 1]};
        } else {
            *(f32x2*)(F.out + (size_t)t * DM + 2 * tid) = (f32x2){h0, h1};
            *(unsigned*)(hb + (size_t)t * DM + 2 * tid) = pk2(h0, h1);
            if (tid < 16) part[(size_t)t * 16 + tid] = (tid == 0) ? ss : 0.f;
        }
    }
}


DI unsigned fp8x4(f32x4 v) {
    const float a = __builtin_amdgcn_fmed3f(v[0], -448.f, 448.f), b = __builtin_amdgcn_fmed3f(v[1], -448.f, 448.f), c = __builtin_amdgcn_fmed3f(v[2], -448.f, 448.f), d = __builtin_amdgcn_fmed3f(v[3], -448.f, 448.f);
    unsigned w = 0u;
    w = (unsigned)__builtin_amdgcn_cvt_pk_fp8_f32(a, b, (int)w, false);
    w = (unsigned)__builtin_amdgcn_cvt_pk_fp8_f32(c, d, (int)w, true);
    return w;
}
DI void p0_fp8(Frame& F) {
    FRAME_IDS;
    const int gw = F.bid * NWAVES + F.wave, NGW = F.G * NWAVES;
    for (int row = gw; row < 4 * PE; row += NGW) {
        const int tab = row / PE, e = row % PE, layer = tab & 1, isv = tab >> 1;
        const float* src = (isv ? F.peer_v : F.peer_u) + ((size_t)layer * PE + e) * DM;
        unsigned* dst = (unsigned*)(F.ws + (isv ? WS_V8 : WS_U8) + ((size_t)layer * PE + e) * DM);
        const f32x4* sp = (const f32x4*)src + f_lane;
        const f32x4* gp = (const f32x4*)(F.ffn_norm + layer * DM) + f_lane;
#pragma unroll
        for (int j = 0; j < 4; ++j) {
            f32x4 v = sp[64 * j];
            if (!isv) v = v * gp[64 * j] * U8_SCALE; else v = v * V8_SCALE;
            dst[f_lane + 64 * j] = fp8x4(v);
        }
    }
}
DI float dot16_fp8(const u32x4 r, const float (&xs)[16]) {
    float s0 = 0.f, s1 = 0.f;
#pragma unroll
    for (int w = 0; w < 4; ++w) {
        const f32x2 lo = __builtin_amdgcn_cvt_pk_f32_fp8((int)r[w], false), hi = __builtin_amdgcn_cvt_pk_f32_fp8((int)r[w], true);
        s0 = fmaf(lo[0], xs[4 * w + 0], s0); s1 = fmaf(lo[1], xs[4 * w + 1], s1); s0 = fmaf(hi[0], xs[4 * w + 2], s0); s1 = fmaf(hi[1], xs[4 * w + 3], s1);
    }
    return s0 + s1;
}
DI void axpy16_fp8(const u32x4 r, const float a, float (&o)[16]) {
#pragma unroll
    for (int w = 0; w < 4; ++w) {
        const f32x2 lo = __builtin_amdgcn_cvt_pk_f32_fp8((int)r[w], false), hi = __builtin_amdgcn_cvt_pk_f32_fp8((int)r[w], true);
        o[4 * w + 0] = fmaf(a, lo[0], o[4 * w + 0]); o[4 * w + 1] = fmaf(a, lo[1], o[4 * w + 1]); o[4 * w + 2] = fmaf(a, hi[0], o[4 * w + 2]); o[4 * w + 3] = fmaf(a, hi[1], o[4 * w + 3]);
    }
}
DI float red_combine(const int level, const float a, const float b, const int lane) {
    const int M = 32 >> level; const bool bit = (lane & M) != 0;
    const float send = bit ? a : b, keep = bit ? b : a;
    return keep + __shfl_xor(send, M);
}
constexpr int brev6(int k) { return ((k & 1) << 5) | ((k & 2) << 3) | ((k & 4) << 1) | ((k & 8) >> 1) | ((k & 16) >> 3) | ((k & 32) >> 5); }
DI void opt_gather(Frame& F, int layer, bool final_norm) {
    FRAME_IDS;
    const int* eidx = (const int*)(F.ws + WS_EIDX); const float* gate = (const float*)(F.ws + WS_GATE);
    float* part = (float*)(F.ws + WS_PART); bf16* hb = (bf16*)(F.ws + WS_XB);
    const __amdgpu_buffer_rsrc_t U8 = __builtin_amdgcn_make_buffer_rsrc((void*)(F.ws + WS_U8 + (size_t)layer * PE * DM), 0, PE * DM, 0x00020000);
    const __amdgpu_buffer_rsrc_t V8 = __builtin_amdgcn_make_buffer_rsrc((void*)(F.ws + WS_V8 + (size_t)layer * PE * DM), 0, PE * DM, 0x00020000);
    const int voff = f_lane * 16;
    const int gw = F.bid * NWAVES + F.wave, NGW = F.G * NWAVES;
    for (int t = gw; t < T; t += NGW) {
        float* hrow = F.out + (size_t)t * DM + 16 * f_lane;
        float xs[16];
        { const f32x4 h0 = ((const f32x4*)hrow)[0], h1 = ((const f32x4*)hrow)[1], h2 = ((const f32x4*)hrow)[2], h3 = ((const f32x4*)hrow)[3];
#pragma unroll
          for (int i = 0; i < 4; ++i) { xs[i] = h0[i]; xs[4 + i] = h1[i]; xs[8 + i] = h2[i]; xs[12 + i] = h3[i]; } }
        const float pv = (f_lane < 16) ? part[(size_t)t * 16 + f_lane] : 0.f;
        const float rstd = 1.f / sqrtf(wave_sum(pv) * (1.f / DM) + EPS);
        int ev[2]; float gv[2], av[2];
        ev[0] = eidx[(size_t)t * NSEL + f_lane]; ev[1] = eidx[(size_t)t * NSEL + 64 + f_lane];
        gv[0] = gate[(size_t)t * NSEL + f_lane]; gv[1] = gate[(size_t)t * NSEL + 64 + f_lane];
        constexpr int GR = 4, NG = 64 / GR;
#pragma unroll
        for (int b = 0; b < 2; ++b) {
            float st[6]; float red = 0.f;
            u32x4 buf[2][GR];
#pragma unroll
            for (int j = 0; j < GR; ++j) { const int e = __builtin_amdgcn_readlane(ev[b], brev6(j)); buf[0][j] = __builtin_amdgcn_raw_buffer_load_b128(U8, voff, e * DM, 0); }
            asm volatile("" ::: "memory");
#pragma unroll
            for (int g = 0; g < NG; ++g) {
                if (g + 1 < NG) {
#pragma unroll
                    for (int j = 0; j < GR; ++j) { const int e = __builtin_amdgcn_readlane(ev[b], brev6(GR * (g + 1) + j)); buf[(g + 1) & 1][j] = __builtin_amdgcn_raw_buffer_load_b128(U8, voff, e * DM, 0); }
                }
                asm volatile("" ::: "memory");
#pragma unroll
                for (int j = 0; j < GR; ++j) {
                    const int k = GR * g + j;
                    float v = dot16_fp8(buf[g & 1][j], xs);
                    int kk = k, lvl = 0;
#pragma unroll
                    for (int q = 0; q < 6; ++q) { if (kk & 1) { v = red_combine(lvl, st[lvl], v, f_lane); kk >>= 1; ++lvl; } }
                    if (k == 63) red = v; else st[lvl] = v;
                }
                asm volatile("" ::: "memory");
            }
            const float d = red * (rstd * (1.f / U8_SCALE));
            av[b] = gelu_erf(d) * gv[b] * (1.f / V8_SCALE);
        }
        float o[16];
#pragma unroll
        for (int i = 0; i < 16; ++i) o[i] = 0.f;
#pragma unroll
        for (int b = 0; b < 2; ++b) {
            u32x4 buf[2][GR];
#pragma unroll
            for (int j = 0; j < GR; ++j) { const int e = __builtin_amdgcn_readlane(ev[b], j); buf[0][j] = __builtin_amdgcn_raw_buffer_load_b128(V8, voff, e * DM, 0); }
            asm volatile("" ::: "memory");
#pragma unroll
            for (int g = 0; g < NG; ++g) {
                if (g + 1 < NG) {
#pragma unroll
                    for (int j = 0; j < GR; ++j) { const int e = __builtin_amdgcn_readlane(ev[b], GR * (g + 1) + j); buf[(g + 1) & 1][j] = __builtin_amdgcn_raw_buffer_load_b128(V8, voff, e * DM, 0); }
                }
                asm volatile("" ::: "memory");
#pragma unroll
                for (int j = 0; j < GR; ++j) { const float a = __builtin_bit_cast(float, __builtin_amdgcn_readlane(__builtin_bit_cast(int, av[b]), GR * g + j)); axpy16_fp8(buf[g & 1][j], a, o); }
                asm volatile("" ::: "memory");
            }
        }
        float ss = 0.f;
#pragma unroll
        for (int i = 0; i < 16; ++i) { o[i] += xs[i]; ss = fmaf(o[i], o[i], ss); }
        ss = wave_sum(ss);
        if (final_norm) {
            const float r = 1.f / sqrtf(ss * (1.f / DM) + EPS);
            const f32x4* fn = (const f32x4*)(F.final_norm + 16 * f_lane);
#pragma unroll
            for (int q = 0; q < 4; ++q) { const f32x4 g = fn[q]; ((f32x4*)hrow)[q] = (f32x4){o[4 * q] * r * g[0], o[4 * q + 1] * r * g[1], o[4 * q + 2] * r * g[2], o[4 * q + 3] * r * g[3]}; }
        } else {
#pragma unroll
            for (int q = 0; q < 4; ++q) ((f32x4*)hrow)[q] = (f32x4){o[4 * q], o[4 * q + 1], o[4 * q + 2], o[4 * q + 3]};
            u32x4* hbp = (u32x4*)(hb + (size_t)t * DM + 16 * f_lane);
            hbp[0] = (u32x4){pk2(o[0], o[1]), pk2(o[2], o[3]), pk2(o[4], o[5]), pk2(o[6], o[7])};
            hbp[1] = (u32x4){pk2(o[8], o[9]), pk2(o[10], o[11]), pk2(o[12], o[13]), pk2(o[14], o[15])};
            if (f_lane < 16) part[(size_t)t * 16 + f_lane] = (f_lane == 0) ? ss : 0.f;
        }
    }
}
DI void naive_glu(Frame& F) {
    FRAME_IDS;
    const bf16* H = (const bf16*)(F.ws + WS_HID); bf16* G = (bf16*)(F.ws + WS_GLU);
    for (size_t i = (size_t)F.bid * NTHR + f_tid; i < (size_t)T * DM; i += (size_t)F.G * NTHR) {
        const size_t m = i / DM; const int c = (int)(i % DM);
        const float a = bf2f(H[m * 2048 + c]), g = bf2f(H[m * 2048 + 1024 + c]);
        G[i] = (bf16)f2bf(a * sigmoidf(g));
    }
}
DI void naive_conv(Frame& F) {
    FRAME_IDS;
    const bf16* G = (const bf16*)(F.ws + WS_GLU); bf16* H2 = (bf16*)(F.ws + WS_HID2);
    LAS float* red = (LAS float*)F.lds;
    const int tid = f_tid;
    for (int t = F.bid; t < T; t += F.G) {
        const int s = t % SEQ;
        float y[2];
#pragma unroll
        for (int u = 0; u < 2; ++u) {
            const int c = 2 * tid + u;
            float a = F.conv_dw_b[c];
            for (int j = 0; j < CW; ++j) { const int sp = s - (CW - 1) + j; if (sp >= 0) a += F.conv_dw[j * DM + c] * bf2f(G[(size_t)(t - (CW - 1) + j) * DM + c]); }
            y[u] = a;
        }
        const float mu = block_sum(y[0] + y[1], red, tid) * (1.f / DM);
        const float d0 = y[0] - mu, d1 = y[1] - mu;
        const float var = block_sum(d0 * d0 + d1 * d1, red, tid) * (1.f / DM);
        const float r = 1.f / sqrtf(var + EPS);
        const float z0 = d0 * r * F.conv_ln_g[2 * tid] + F.conv_ln_b[2 * tid], z1 = d1 * r * F.conv_ln_g[2 * tid + 1] + F.conv_ln_b[2 * tid + 1];
        *(unsigned*)(H2 + (size_t)t * DM + 2 * tid) = pk2(z0 * sigmoidf(z0), z1 * sigmoidf(z1));
    }
}

#if OPT_GEMM
enum Phase { PH_PREP = 0, PH_PROJ, PH_MIX, PH_WOUT, PH_Q0, PH_ROUTE0, PH_GATHER0, PH_W1, PH_CONV, PH_W2, PH_Q1, PH_ROUTE1, PH_GATHER1, PH_COUNT };
#else
enum Phase { PH_PREP = 0, PH_PROJ, PH_MIX, PH_WOUT, PH_STAT0, PH_Q0, PH_ROUTE0, PH_GATHER0, PH_W1, PH_GLU, PH_CONV, PH_W2, PH_STAT1, PH_Q1, PH_ROUTE1, PH_GATHER1, PH_COUNT };
#endif
struct Args { const float* in[19]; float* out; unsigned char* ws; int ph_lo, ph_hi; };

__global__ void __launch_bounds__(NTHR, 2) mega_fwd(Args args) {
    extern __shared__ __attribute__((aligned(16))) unsigned char lds[];
    Frame F;
    F.lds = (LAS unsigned char*)lds;
    F.wave = __builtin_amdgcn_readfirstlane((int)threadIdx.x >> 6); FRAME_IDS;
    F.G = gridDim.x; F.bid = blockIdx.x;
    F.x = args.in[0]; F.mix_norm = args.in[1]; F.ffn_norm = args.in[2]; F.final_norm = args.in[3]; F.w_in = args.in[4]; F.w_out = args.in[5]; F.rel_bias = args.in[6];
    F.conv_w1 = args.in[7]; F.conv_b1 = args.in[8]; F.conv_dw = args.in[9]; F.conv_dw_b = args.in[10]; F.conv_ln_g = args.in[11]; F.conv_ln_b = args.in[12];
    F.conv_w2 = args.in[13]; F.conv_b2 = args.in[14]; F.peer_wq = args.in[15]; F.peer_keys = args.in[16]; F.peer_u = args.in[17]; F.peer_v = args.in[18];
    F.out = args.out; F.ws = args.ws;
    volatile LAS unsigned* MISC = (volatile LAS unsigned*)(F.lds + MISC_OFF);
    for (int u = f_tid; u < (LDS_BYTES - LDSCTL_OFF) / 4; u += NTHR) ((LAS unsigned*)(F.lds + LDSCTL_OFF))[u] = 0u;
    __syncthreads();
    const int lo = args.ph_lo, hi = args.ph_hi;
    XcdBarrier bar; bar.bar = (unsigned*)(F.ws + WS_CTL) + CW_BAR; bar.x = 0; bar.st = nullptr;
    if (hi - lo > 1) bar = xcd_barrier_post((unsigned*)(F.ws + WS_CTL) + CW_BAR, MISC + 8);
#ifndef TEST_PHASE
#define TEST_PHASE -1
#endif
#define IN(k) ((TEST_PHASE < 0 || TEST_PHASE == (k)) && lo <= (k) && (k) < hi)
#define SEAM(k) do { if (IN(k) && IN((k) + 1)) xcd_barrier(bar, F.wave); } while (0)
    bf16* XB = (bf16*)(F.ws + WS_XB);
    const float* PART = (const float*)(F.ws + WS_PART); const float* ROPE = (const float*)(F.ws + WS_ROPE);
    if (IN(PH_PREP)) { p0_prep(F);
#if OPT_GEMM
        p0_weights(F);
#endif
#if OPT_GATHER
        p0_fp8(F);
#endif
    } SEAM(PH_PREP);
#if OPT_GEMM
#define GEMM_PHASE(EPI, Aptr, Bptr, NN, ...) do { pg8::Gemm g{(const bf16*)(Aptr), (const bf16*)(Bptr), T, (NN), DM}; pg8::StaticOrder S; S.init(T, (NN), F.G, F.bid); \
        pg8::EPI E{__VA_ARGS__}; pg8::gemm_phase<pg8::EPI, pg8::StaticOrder, true, true>(F.lds, g, S, E, F.wave); } while (0)
    if (IN(PH_PROJ)) { GEMM_PHASE(EpiProj, XB, F.ws + WS_WIN, INC, (bf16*)(F.ws + WS_R), PART, ROPE); } SEAM(PH_PROJ);
#else
    if (IN(PH_PROJ)) { naive_gemm<EP_PROJ>(F, XB, F.w_in, INC, F.mix_norm, nullptr, (bf16*)(F.ws + WS_R), INC); } SEAM(PH_PROJ);
#endif
#if OPT_ATTN
    if (IN(PH_MIX)) { mix_phase(F); } SEAM(PH_MIX);
#else
    if (IN(PH_MIX)) { naive_ret(F); naive_attn(F); } SEAM(PH_MIX);
#endif
#if OPT_GEMM
    if (IN(PH_WOUT)) { GEMM_PHASE(EpiRes, F.ws + WS_O, F.ws + WS_WOUT, DM, F.x, F.out, XB, (float*)(F.ws + WS_PART), nullptr); } SEAM(PH_WOUT);
    if (IN(PH_Q0)) { GEMM_PHASE(EpiQ, XB, F.ws + WS_WQ, DM, (bf16*)(F.ws + WS_Q), PART); } SEAM(PH_Q0);
#else
    if (IN(PH_WOUT)) { naive_gemm<EP_RES>(F, (const bf16*)(F.ws + WS_O), F.w_out, DM, nullptr, nullptr, nullptr, DM); } SEAM(PH_WOUT);
    if (IN(PH_STAT0)) { naive_rowstat(F); } SEAM(PH_STAT0);
    if (IN(PH_Q0)) { naive_gemm<EP_Q>(F, XB, F.peer_wq, DM, F.ffn_norm, nullptr, (bf16*)(F.ws + WS_Q), DM); } SEAM(PH_Q0);
#endif
#if OPT_ROUTE
    if (IN(PH_ROUTE0)) { opt_route(F, 0); } SEAM(PH_ROUTE0);
#else
    if (IN(PH_ROUTE0)) { naive_route(F, 0); } SEAM(PH_ROUTE0);
#endif
#if OPT_GATHER
    if (IN(PH_GATHER0)) { opt_gather(F, 0, false); } SEAM(PH_GATHER0);
#else
    if (IN(PH_GATHER0)) { naive_gather(F, 0, false); } SEAM(PH_GATHER0);
#endif
#if OPT_GEMM
    if (IN(PH_W1)) { GEMM_PHASE(EpiGlu, XB, F.ws + WS_W1, 2 * DM, (bf16*)(F.ws + WS_GLU), PART, F.conv_b1); } SEAM(PH_W1);
#else
    if (IN(PH_W1)) { naive_gemm<EP_HID>(F, XB, F.conv_w1, 2 * DM, F.mix_norm + DM, F.conv_b1, (bf16*)(F.ws + WS_HID), 2 * DM); } SEAM(PH_W1);
    if (IN(PH_GLU)) { naive_glu(F); } SEAM(PH_GLU);
#endif
    if (IN(PH_CONV)) { naive_conv(F); } SEAM(PH_CONV);
#if OPT_GEMM
    if (IN(PH_W2)) { GEMM_PHASE(EpiRes, F.ws + WS_HID2, F.ws + WS_W2, DM, F.out, F.out, XB, (float*)(F.ws + WS_PART), F.conv_b2); } SEAM(PH_W2);
    if (IN(PH_Q1)) { GEMM_PHASE(EpiQ, XB, F.ws + WS_WQ + (size_t)DM * DM * 2, DM, (bf16*)(F.ws + WS_Q), PART); } SEAM(PH_Q1);
#else
    if (IN(PH_W2)) { naive_gemm<EP_RES>(F, (const bf16*)(F.ws + WS_HID2), F.conv_w2, DM, nullptr, F.conv_b2, XB  , DM); } SEAM(PH_W2);
    if (IN(PH_STAT1)) { naive_rowstat(F); } SEAM(PH_STAT1);
    if (IN(PH_Q1)) { naive_gemm<EP_Q>(F, XB, F.peer_wq + (size_t)DM * DM, DM, F.ffn_norm + DM, nullptr, (bf16*)(F.ws + WS_Q), DM); } SEAM(PH_Q1);
#endif
#if OPT_ROUTE
    if (IN(PH_ROUTE1)) { opt_route(F, 1); } SEAM(PH_ROUTE1);
#else
    if (IN(PH_ROUTE1)) { naive_route(F, 1); } SEAM(PH_ROUTE1);
#endif
#if OPT_GATHER
    if (IN(PH_GATHER1)) { opt_gather(F, 1, true); }
#else
    if (IN(PH_GATHER1)) { naive_gather(F, 1, true); }
#endif
#undef IN
#undef SEAM
}

extern "C" void kernel_launch(void* const* d_in, const int* in_sizes, int n_in, void* d_out, int out_size, void* d_ws, size_t ws_size, hipStream_t stream) {
    static int grid = 0;
    if (grid == 0) {
        if (n_in != 19 || out_size != T * DM || ws_size < WS_END) { fprintf(stderr, "kernel_launch: unexpected shapes (n_in %d out %d ws %zu)\n", n_in, out_size, ws_size); grid = -1; return; }
        int dev = 0, cus = 0;
        if (hipGetDevice(&dev) != hipSuccess || hipDeviceGetAttribute(&cus, hipDeviceAttributeMultiprocessorCount, dev) != hipSuccess) { grid = -1; return; }
        if (hipFuncSetAttribute((const void*)mega_fwd, hipFuncAttributeMaxDynamicSharedMemorySize, LDS_BYTES) != hipSuccess) { fprintf(stderr, "kernel_launch: hipFuncSetAttribute failed\n"); grid = -1; return; }
        (void)hipGetLastError();
        grid = cus;
    }
    if (grid < 0) return;
    (void)hipMemsetAsync((char*)d_ws + WS_CTL, 0, CTL_ZERO_BYTES, stream);
    Args a{};
    for (int i = 0; i < 19; ++i) a.in[i] = (const float*)d_in[i];
    a.out = (float*)d_out; a.ws = (unsigned char*)d_ws;
#if MK_ONE_LAUNCH
    a.ph_lo = 0; a.ph_hi = PH_COUNT;
    hipLaunchKernelGGL(mega_fwd, dim3(grid), dim3(NTHR), LDS_BYTES, stream, a);
#else
    for (int p = 0; p < PH_COUNT; ++p) { a.ph_lo = p; a.ph_hi = p + 1; hipLaunchKernelGGL(mega_fwd, dim3(grid), dim3(NTHR), LDS_BYTES, stream, a); }
#endif
}
```

```cpp
#include <hip/hip_runtime.h>
#include <cstdio>
#include <cstdint>

#ifndef OPT_GEMM
#define OPT_GEMM 1
#endif
#ifndef OPT_GATHER
#define OPT_GATHER 1
#endif
#ifndef OPT_ROUTE
#define OPT_ROUTE 1
#endif
#ifndef OPT_ATTN
#define OPT_ATTN 1
#endif
#ifndef OPT_CONV
#define OPT_CONV 1
#endif
#ifndef MK_ONE_LAUNCH
#define MK_ONE_LAUNCH 1
#endif

#define GAS __attribute__((address_space(1)))
#define LAS __attribute__((address_space(3)))
#define DI __device__ __forceinline__
typedef unsigned short bf16;
typedef float f32x2 __attribute__((ext_vector_type(2)));
typedef float f32x4 __attribute__((ext_vector_type(4)));
typedef unsigned u32x2 __attribute__((ext_vector_type(2)));
typedef unsigned u32x4 __attribute__((ext_vector_type(4)));
typedef short bf16x8 __attribute__((ext_vector_type(8)));
typedef float f32x16 __attribute__((ext_vector_type(16)));

constexpr int NB = 16, SEQ = 2048, DM = 1024, T = NB * SEQ;
constexpr int CHUNK = 64, HD = 64, NHA = 8, NHB = 8, INC = 3584, NCH = SEQ / CHUNK;
constexpr int PH = 8, PK = 128, PE = PK * PK, PQD = 128, PTOP = 16, NSEL = PH * PTOP;
constexpr int CW = 31;
constexpr float EPS = 1e-6f;
constexpr float U8_SCALE = 256.f, V8_SCALE = 16.f;
constexpr int NWAVES = 8, NTHR = NWAVES * 64;

constexpr int C_QA = 0, C_KA = 512, C_VA = 1024, C_QB = 1536, C_KB = 2048, C_VB = 2560, C_GB = 3072;

constexpr size_t MiB = 1u << 20;
constexpr size_t WS_CTL = 0, CTL_ZERO_BYTES = 1 * MiB;
constexpr size_t WS_WIN = 2 * MiB, WS_WOUT = 9 * MiB, WS_W1 = 11 * MiB, WS_W2 = 15 * MiB, WS_WQ = 17 * MiB;
constexpr size_t WS_ROPE = 22 * MiB;
constexpr size_t WS_PART = 23 * MiB;
constexpr size_t WS_EIDX = 26 * MiB;
constexpr size_t WS_GATE = 42 * MiB;
constexpr size_t WS_U8 = 64 * MiB, WS_V8 = 96 * MiB;
constexpr size_t WS_XB = 128 * MiB;
constexpr size_t WS_R = 192 * MiB;
constexpr size_t WS_O = 416 * MiB;
constexpr size_t WS_Q = 192 * MiB;
constexpr size_t WS_HID = 256 * MiB;
constexpr size_t WS_GLU = 384 * MiB;
constexpr size_t WS_HID2 = 448 * MiB;
constexpr size_t WS_END = 512 * MiB;
constexpr int CW_BAR = 4096, CW_QUEUE = 8192;

constexpr int RING_BYTES = 131072, LDSCTL_OFF = RING_BYTES, MISC_OFF = LDSCTL_OFF + 320, LDS_BYTES = 147456;

DI float bf2f(bf16 v) { return __uint_as_float(((unsigned)v) << 16); }
DI unsigned f2bf(float f) { unsigned u = __float_as_uint(f); return (u + 0x7fffu + ((u >> 16) & 1u)) >> 16; }
DI unsigned pk2(float lo, float hi) { return f2bf(lo) | (f2bf(hi) << 16); }
DI float wave_sum(float v) {
#pragma unroll
    for (int o = 1; o < 64; o <<= 1) v += __shfl_xor(v, o);
    return v;
}
DI float wave_max(float v) {
#pragma unroll
    for (int o = 1; o < 64; o <<= 1) v = fmaxf(v, __shfl_xor(v, o));
    return v;
}
DI float block_sum(float v, LAS float* red, int tid) {
    v = wave_sum(v);
    __syncthreads();
    if ((tid & 63) == 0) red[tid >> 6] = v;
    __syncthreads();
    float s = 0.f;
#pragma unroll
    for (int i = 0; i < NWAVES; ++i) s += red[i];
    return s;
}
DI float gelu_erf(float x) { return 0.5f * x * (1.f + erff(x * 0.70710678118654752f)); }
DI float sigmoidf(float x) { return 1.f / (1.f + __expf(-x)); }

DI int lane_id() { return (int)__builtin_amdgcn_mbcnt_hi(~0u, __builtin_amdgcn_mbcnt_lo(~0u, 0u)); }
#define XB_TMO      128
#define XB_XCNT(j)  (256  + 64 * (j))
#define XB_XSUB(j)  (1280 + 64 * (j))
#define XB_XGEN(j)  (2304 + 64 * (j))
#define XB_TOP      3328
#define XB_TOPGEN   3392
#define XCD_BAR_WORDS 3456
#define XB_SPIN_CAP (1u << 22)
DI unsigned xb_ld(unsigned* p)              { return __hip_atomic_load(p, __ATOMIC_RELAXED, __HIP_MEMORY_SCOPE_AGENT); }
DI unsigned xb_add(unsigned* p, unsigned v) { return __hip_atomic_fetch_add(p, v, __ATOMIC_RELAXED, __HIP_MEMORY_SCOPE_AGENT); }
DI unsigned xb_xcc_id() { return (unsigned)__builtin_amdgcn_s_getreg((3 << 11) | 20) & 0xFu; }
#define XB_SPIN(cond, bar) do { unsigned _sp = 0; while (cond) { __builtin_amdgcn_s_sleep(1); \
    if ((++_sp & 255u) == 0u) { if (xb_ld(&(bar)[XB_TMO])) break; if (_sp > XB_SPIN_CAP) { atomicAdd(&(bar)[XB_TMO], 1u); break; } } } } while (0)
struct XcdBarrier { unsigned* bar; unsigned x; volatile LAS unsigned* st; };
DI XcdBarrier xcd_barrier_post(unsigned* bar, volatile LAS unsigned* st) {
    XcdBarrier b; b.bar = bar; b.x = xb_xcc_id(); b.st = st;
    if (threadIdx.x == 0) (void)xb_add(&bar[XB_XCNT(b.x)], 1u);
    return b;
}
DI void xcd_barrier_complete(unsigned* bar, unsigned x, unsigned& nloc, unsigned& nx) {
    const unsigned G = gridDim.x * gridDim.y * gridDim.z;
    unsigned sum, cnt, mine, sp = 0u;
    for (;;) {
        sum = 0u; cnt = 0u; mine = 0u;
#pragma unroll
        for (unsigned j = 0; j < 16; ++j) { const unsigned c = xb_ld(&bar[XB_XCNT(j)]); sum += c; cnt += (c > 0u) ? 1u : 0u; mine = (j == x) ? c : mine; }
        if (sum == G) break;
        __builtin_amdgcn_s_sleep(1);
        if ((++sp & 255u) == 0u) { if (xb_ld(&bar[XB_TMO])) break; if (sp > XB_SPIN_CAP) { atomicAdd(&bar[XB_TMO], 1u); break; } }
    }
    nloc = mine > 0u ? mine : 1u; nx = cnt > 0u ? cnt : 1u;
}
DI void xcd_barrier(const XcdBarrier& b, const int wave_id) {
    asm volatile("s_waitcnt vmcnt(0)" ::: "memory");
    __syncthreads();
    if (wave_id == 0 && lane_id() == 0) {
        unsigned* bar = b.bar;
        __builtin_amdgcn_s_waitcnt(0);
        unsigned nloc = b.st[0], nx = b.st[1];
        if (nloc == 0u) { xcd_barrier_complete(bar, b.x, nloc, nx); b.st[0] = nloc; b.st[1] = nx; }
        const unsigned old = xb_add(&bar[XB_XSUB(b.x)], 1u);
        const unsigned gen = old / nloc;
        if (old + 1u == (gen + 1u) * nloc) {
            __builtin_amdgcn_fence(__ATOMIC_RELEASE, "agent");
            asm volatile("s_waitcnt vmcnt(0)" ::: "memory");
            const unsigned og = xb_add(&bar[XB_TOP], 1u);
            const unsigned tg = og / nx;
            if (og + 1u == (tg + 1u) * nx) xb_add(&bar[XB_TOPGEN], 1u);
            else XB_SPIN(xb_ld(&bar[XB_TOPGEN]) == tg, bar);
            __builtin_amdgcn_fence(__ATOMIC_ACQUIRE, "agent");
            xb_add(&bar[XB_XGEN(b.x)], 1u);
            asm volatile("s_waitcnt vmcnt(0)" ::: "memory");
        } else {
            XB_SPIN(xb_ld(&bar[XB_XGEN(b.x)]) == gen, bar);
            __builtin_amdgcn_fence(__ATOMIC_ACQUIRE, "agent");
            asm volatile("s_waitcnt vmcnt(0)" ::: "memory");
        }
    }
    __syncthreads();
}

namespace pg8 {
#define PG8_LAS __attribute__((address_space(3)))
typedef unsigned short bf16_t;
typedef short bf16x8 __attribute__((ext_vector_type(8)));
typedef float f32x4 __attribute__((ext_vector_type(4)));
typedef unsigned u32x4 __attribute__((ext_vector_type(4)));
constexpr int BM = 256, BK = 64, HALF = 128, HTB = HALF * BK * 2  , STAGE_BYTES = 8 * HTB, NXCD = 8, WGM = 8;

__host__ __device__ __forceinline__ int lds_byte(int r, int c) { const int st = (r >> 4) * 2 + (c >> 5), rr = r & 15, cc = c & 31, ob = rr * 64 + cc * 2; return st * 1024 + (ob ^ (((ob >> 9) & 1) << 5)); }
__host__ __device__ __forceinline__ void stage_rc(int b, int& R, int& C) { const int st = b / 1024, sb = b % 1024, swz = sb ^ (((sb >> 9) & 1) << 5); R = (st >> 1) * 16 + swz / 64; C = (st & 1) * 32 + (swz % 64) / 2; }
__host__ __device__ __forceinline__ int perm32(int rho) { const int n = rho >> 4, i = rho & 15; return 8 * (i >> 2) + 4 * n + (i & 3); }

struct Unit { int pm, pn; };
struct Gemm { const bf16_t* A; const bf16_t* Bt; int M, N, K; };

struct StaticOrder {
    int nM, nN, nwg, G, c;
    __host__ __device__ void init(int M, int N, int G_, int c_) { nM = M / BM; nN = N / BM; nwg = nM * nN; G = G_; c = c_; }
    __host__ __device__ bool next(int i, Unit& u) const {
        const long L = (long)i * G + c; if (L >= nwg) return false;
        int wgid = (int)L; { const int q = nwg / NXCD, r = nwg % NXCD, xcd = wgid % NXCD, off = wgid / NXCD; wgid = (xcd < r ? xcd * (q + 1) : r * (q + 1) + (xcd - r) * q) + off; }
        const int nig = WGM * nN, gid = wgid / nig, fm = gid * WGM, gsz = (nM - fm) < WGM ? (nM - fm) : WGM;
        u.pm = fm + ((wgid % nig) % gsz); u.pn = (wgid % nig) / gsz; return true;
    }
    __device__ __forceinline__ void a_ready(const Unit&) const {}
    __device__ __forceinline__ void done(const Unit&) const {}
};

__device__ __forceinline__ unsigned cvt_pk_bf16(float lo, float hi) { unsigned r; asm volatile("v_cvt_pk_bf16_f32 %0, %1, %2" : "=v"(r) : "v"(lo), "v"(hi)); return r; }
__device__ __forceinline__ float rstd16(const float* part, int r) {
    const f32x4* p = (const f32x4*)(part + (size_t)r * 16);
    const f32x4 a = p[0], b = p[1], c = p[2], d = p[3];
    const float s = ((a[0] + a[1]) + (a[2] + a[3])) + ((b[0] + b[1]) + (b[2] + b[3])) + ((c[0] + c[1]) + (c[2] + c[3])) + ((d[0] + d[1]) + (d[2] + d[3]));
    return 1.f / sqrtf(s * (1.f / 1024.f) + 1e-6f);
}
__device__ __forceinline__ u32x4 pack8(const f32x4 a, const f32x4 b) { u32x4 w; w.x = cvt_pk_bf16(a[0], a[1]); w.y = cvt_pk_bf16(a[2], a[3]); w.z = cvt_pk_bf16(b[0], b[1]); w.w = cvt_pk_bf16(b[2], b[3]); return w; }
#define rot(t1, t2, c, s) do { const float a_ = (t1) * (c) - (t2) * (s), b_ = (t1) * (s) + (t2) * (c); (t1) = a_; (t2) = b_; } while (0)

struct EpiProj {
    static constexpr bool PERM = true, AFTER_DRAIN = false;
    bf16_t* R; const float* part; const float* rope;
    __device__ __forceinline__ void operator()(const f32x4 (&acc)[2][2][4][2], const Unit& u, int wr, int wc, int fr, int fq) const {
        const int type = u.pn >> 1, hg = u.pn & 1;
        const int colbase = type * 512 + (4 * hg + wc) * 64 + 8 * fq;
        const bool do_rope = (type == 3) || (type == 4);
#pragma unroll
        for (int ai = 0; ai < 2; ++ai)
#pragma unroll
            for (int m = 0; m < 4; ++m) {
                const int r = u.pm * BM + ai * HALF + wr * 64 + m * 16 + fr;
                const float rs = rstd16(part, r);
                f32x4 a0 = acc[ai][0][m][0] * rs, a1 = acc[ai][0][m][1] * rs, b0 = acc[ai][1][m][0] * rs, b1 = acc[ai][1][m][1] * rs;
                if (do_rope) {
                    const f32x4* rp = (const f32x4*)(rope + ((size_t)(r & 2047) * 32 + 8 * fq) * 2);
                    const f32x4 c0 = rp[0], c1 = rp[1], c2 = rp[2], c3 = rp[3];
                    rot(a0[0], b0[0], c0[0], c0[1]); rot(a0[1], b0[1], c0[2], c0[3]); rot(a0[2], b0[2], c1[0], c1[1]); rot(a0[3], b0[3], c1[2], c1[3]);
                    rot(a1[0], b1[0], c2[0], c2[1]); rot(a1[1], b1[1], c2[2], c2[3]); rot(a1[2], b1[2], c3[0], c3[1]); rot(a1[3], b1[3], c3[2], c3[3]);
                }
                bf16_t* rowp = R + (size_t)r * 3584 + colbase;
                *(u32x4*)(rowp) = pack8(a0, a1);
                *(u32x4*)(rowp + 32) = pack8(b0, b1);
            }
    }
};
struct EpiRes {
    static constexpr bool PERM = true, AFTER_DRAIN = false;
    const float* base; float* out; bf16_t* hb; float* part; const float* bias;
    __device__ __forceinline__ void operator()(const f32x4 (&acc)[2][2][4][2], const Unit& u, int wr, int wc, int fr, int fq) const {
        const int col0 = u.pn * BM + wc * 32 + 8 * fq;
        f32x4 bv[2][2];
#pragma unroll
        for (int bj = 0; bj < 2; ++bj)
#pragma unroll
            for (int n = 0; n < 2; ++n) bv[bj][n] = bias ? *(const f32x4*)(bias + col0 + bj * HALF + 4 * n) : (f32x4){0.f, 0.f, 0.f, 0.f};
#pragma unroll
        for (int ai = 0; ai < 2; ++ai)
#pragma unroll
            for (int m = 0; m < 4; ++m) {
                const int r = u.pm * BM + ai * HALF + wr * 64 + m * 16 + fr;
                const size_t off = (size_t)r * 1024 + col0;
                float ss = 0.f;
#pragma unroll
                for (int bj = 0; bj < 2; ++bj) {
                    const f32x4 x0 = *(const f32x4*)(base + off + bj * HALF), x1 = *(const f32x4*)(base + off + bj * HALF + 4);
                    const f32x4 h0 = x0 + acc[ai][bj][m][0] + bv[bj][0], h1 = x1 + acc[ai][bj][m][1] + bv[bj][1];
                    *(f32x4*)(out + off + bj * HALF) = h0; *(f32x4*)(out + off + bj * HALF + 4) = h1;
                    *(u32x4*)(hb + off + bj * HALF) = pack8(h0, h1);
                    ss += (h0[0] * h0[0] + h0[1] * h0[1]) + (h0[2] * h0[2] + h0[3] * h0[3]) + (h1[0] * h1[0] + h1[1] * h1[1]) + (h1[2] * h1[2] + h1[3] * h1[3]);
                }
                ss += __shfl_xor(ss, 16); ss += __shfl_xor(ss, 32);
                if (fq == 0) part[(size_t)r * 16 + 4 * u.pn + wc] = ss;
            }
    }
};
struct EpiQ {
    static constexpr bool PERM = true, AFTER_DRAIN = false;
    bf16_t* O; const float* part;
    __device__ __forceinline__ void operator()(const f32x4 (&acc)[2][2][4][2], const Unit& u, int wr, int wc, int fr, int fq) const {
        const int col0 = u.pn * BM + wc * 32 + 8 * fq;
#pragma unroll
        for (int ai = 0; ai < 2; ++ai)
#pragma unroll
            for (int m = 0; m < 4; ++m) {
                const int r = u.pm * BM + ai * HALF + wr * 64 + m * 16 + fr;
                const float rs = rstd16(part, r);
                bf16_t* rowp = O + (size_t)r * 1024 + col0;
#pragma unroll
                for (int bj = 0; bj < 2; ++bj) *(u32x4*)(rowp + bj * HALF) = pack8(acc[ai][bj][m][0] * rs, acc[ai][bj][m][1] * rs);
            }
    }
};
struct EpiGlu {
    static constexpr bool PERM = true, AFTER_DRAIN = false;
    bf16_t* G; const float* part; const float* b1;
    __device__ __forceinline__ void operator()(const f32x4 (&acc)[2][2][4][2], const Unit& u, int wr, int wc, int fr, int fq) const {
        const int col = u.pn * 128 + wc * 32 + 8 * fq;
        f32x4 ba[2], bg[2];
#pragma unroll
        for (int n = 0; n < 2; ++n) { ba[n] = *(const f32x4*)(b1 + col + 4 * n); bg[n] = *(const f32x4*)(b1 + 1024 + col + 4 * n); }
#pragma unroll
        for (int ai = 0; ai < 2; ++ai)
#pragma unroll
            for (int m = 0; m < 4; ++m) {
                const int r = u.pm * BM + ai * HALF + wr * 64 + m * 16 + fr;
                const float rs = rstd16(part, r);
                f32x4 y[2];
#pragma unroll
                for (int n = 0; n < 2; ++n) {
                    const f32x4 a = acc[ai][0][m][n] * rs + ba[n], g = acc[ai][1][m][n] * rs + bg[n];
#pragma unroll
                    for (int i = 0; i < 4; ++i) y[n][i] = a[i] / (1.f + __expf(-g[i]));
                }
                *(u32x4*)(G + (size_t)r * 1024 + col) = pack8(y[0], y[1]);
            }
    }
};
template <class Epi, class Sched, bool ALIGN_EPI = false, bool SP2 = false>
__device__ __forceinline__ void gemm_phase(PG8_LAS unsigned char* lds, const Gemm g, const Sched& S, const Epi& E, const int wave_id) {
    const int lane = (int)__builtin_amdgcn_mbcnt_hi(~0u, __builtin_amdgcn_mbcnt_lo(~0u, 0u)), wid = wave_id, tid = wid * 64 + lane, wr = wid >> 2, wc = wid & 3, fr = lane & 15, fq = lane >> 4;
    const int K = g.K, nt = K / BK;
    unsigned voffA[2], voffB[2];
#pragma unroll
    for (int i = 0; i < 2; ++i) { int R, C; stage_rc(tid * 16 + i * 8192, R, C); const int Rb = Epi::PERM ? ((R & ~31) + perm32(R & 31)) : R;
        voffA[i] = (unsigned)(R * K + C) * 2u; voffB[i] = (unsigned)(Rb * K + C) * 2u; }
    const size_t kstep = (size_t)(BK * 2);
    const size_t hstep = (size_t)HALF * K * 2;
    const size_t tstep = 2 * hstep;
    const unsigned ldsw = (unsigned)wid * 1024u;
    const int aoff = lds_byte(wr * 64 + fr, fq * 8), boff = lds_byte(wc * 32 + fr, fq * 8);
#define PG8_SA(b, h) (((b) * 2 + (h)) * HTB)
#define PG8_SB(b, h) ((4 + (b) * 2 + (h)) * HTB)
#define PG8_STAGE(bufoff, gbase, voff) do { _Pragma("unroll") for (int _i = 0; _i < 2; ++_i) \
        __builtin_amdgcn_global_load_lds((const unsigned*)((const char*)(gbase) + (voff)[_i]), (PG8_LAS unsigned*)(lds + (bufoff) + ldsw + _i * 8192), 16, 0, 0); } while (0)
#define PG8_LDA(dst, b, h) do { _Pragma("unroll") for (int m = 0; m < 4; ++m) _Pragma("unroll") for (int k = 0; k < 2; ++k) dst[m][k] = *(const PG8_LAS bf16x8*)(lds + PG8_SA(b, h) + aoff + m * 2048 + k * 1024); } while (0)
#define PG8_LDB(dst, b, h) do { _Pragma("unroll") for (int n = 0; n < 2; ++n) _Pragma("unroll") for (int k = 0; k < 2; ++k) dst[n][k] = *(const PG8_LAS bf16x8*)(lds + PG8_SB(b, h) + boff + n * 2048 + k * 1024); } while (0)
#define PG8_MMA(ai, bj, At, Bt) do { __builtin_amdgcn_s_setprio(1); _Pragma("unroll") for (int m = 0; m < 4; ++m) _Pragma("unroll") for (int n = 0; n < 2; ++n) _Pragma("unroll") for (int k = 0; k < 2; ++k) \
        acc[ai][bj][m][n] = __builtin_amdgcn_mfma_f32_16x16x32_bf16(Bt[n][k], At[m][k], acc[ai][bj][m][n], 0, 0, 0); __builtin_amdgcn_s_setprio(0); } while (0)
#define PG8_WAIT_V(n) asm volatile("s_waitcnt vmcnt(" #n ")" ::: "memory")
#define PG8_WAIT_L(n) asm volatile("s_waitcnt lgkmcnt(" #n ")" ::: "memory")
#define PG8_BAR __builtin_amdgcn_s_barrier()
#define PG8_SCHED __builtin_amdgcn_sched_barrier(0)
    Unit cur, nxt; int ui = 0;
    if (!S.next(0, cur)) return;
    f32x4 acc[2][2][4][2];
#pragma unroll
    for (int a = 0; a < 2; ++a)
#pragma unroll
        for (int b = 0; b < 2; ++b)
#pragma unroll
            for (int m = 0; m < 4; ++m)
#pragma unroll
                for (int n = 0; n < 2; ++n) acc[a][b][m][n] = (f32x4){0.f, 0.f, 0.f, 0.f};
    bf16x8 At[4][2], B0[2][2], B1[2][2];
    const char* cA = (const char*)g.A + (size_t)cur.pm * tstep; const char* cB = (const char*)g.Bt + (size_t)cur.pn * tstep;
    S.a_ready(cur);
    if constexpr (SP2) {
        PG8_STAGE(PG8_SB(0, 0), cB, voffB); PG8_STAGE(PG8_SB(0, 1), cB + hstep, voffB); PG8_STAGE(PG8_SA(0, 0), cA, voffA); PG8_STAGE(PG8_SA(0, 1), cA + hstep, voffA);
        if (wr == 1) PG8_BAR;
        PG8_WAIT_V(2); PG8_BAR;
        PG8_STAGE(PG8_SB(1, 0), cB + kstep, voffB); PG8_STAGE(PG8_SA(1, 0), cA + kstep, voffA); PG8_STAGE(PG8_SB(1, 1), cB + hstep + kstep, voffB);
        PG8_WAIT_V(6); PG8_BAR;
    } else {
        PG8_STAGE(PG8_SB(0, 0), cB, voffB); PG8_STAGE(PG8_SA(0, 0), cA, voffA); PG8_STAGE(PG8_SB(0, 1), cB + hstep, voffB); PG8_STAGE(PG8_SA(0, 1), cA + hstep, voffA);
        if (wr == 1) PG8_BAR;
        PG8_WAIT_V(4); PG8_BAR;
        PG8_STAGE(PG8_SB(1, 0), cB + kstep, voffB); PG8_STAGE(PG8_SA(1, 0), cA + kstep, voffA); PG8_STAGE(PG8_SB(1, 1), cB + hstep + kstep, voffB);
        PG8_WAIT_V(6); PG8_BAR;
    }
    for (;;) {
        const bool has_next = S.next(ui + 1, nxt);
        const char* nA = has_next ? (const char*)g.A + (size_t)nxt.pm * tstep : cA; const char* nB = has_next ? (const char*)g.Bt + (size_t)nxt.pn * tstep : cB;
        for (int t = 0; t < nt; t += 2) {
            const bool last = (t == nt - 2);
            const char* a1 = cA + (size_t)(t + 1) * kstep;
            const char* a2 = last ? nA : cA + (size_t)(t + 2) * kstep; const char* b2 = last ? nB : cB + (size_t)(t + 2) * kstep;
            const char* a3 = a2 + kstep; const char* b3 = b2 + kstep;
            if (last && has_next) S.a_ready(nxt);
            if constexpr (SP2) {
            PG8_LDB(B0, 0, 0); PG8_LDB(B1, 0, 1); PG8_SCHED; PG8_LDA(At, 0, 0); PG8_STAGE(PG8_SA(1, 1), a1 + hstep, voffA);
            PG8_WAIT_V(8); PG8_WAIT_L(0); PG8_BAR; PG8_MMA(0, 0, At, B0); PG8_MMA(0, 1, At, B1); PG8_BAR; PG8_SCHED;
            PG8_LDA(At, 0, 1); PG8_STAGE(PG8_SB(0, 0), b2, voffB); PG8_STAGE(PG8_SB(0, 1), b2 + hstep, voffB); PG8_STAGE(PG8_SA(0, 0), a2, voffA);
            PG8_WAIT_V(8); PG8_WAIT_L(0); PG8_BAR; PG8_MMA(1, 0, At, B0); PG8_MMA(1, 1, At, B1); PG8_BAR; PG8_SCHED;
            PG8_LDB(B0, 1, 0); PG8_LDB(B1, 1, 1); PG8_SCHED; PG8_LDA(At, 1, 0); PG8_STAGE(PG8_SA(0, 1), a2 + hstep, voffA);
            PG8_WAIT_V(8); PG8_WAIT_L(0); PG8_BAR; PG8_MMA(0, 0, At, B0); PG8_MMA(0, 1, At, B1); PG8_BAR; PG8_SCHED;
            PG8_LDA(At, 1, 1); PG8_STAGE(PG8_SB(1, 0), b3, voffB); PG8_STAGE(PG8_SB(1, 1), b3 + hstep, voffB); PG8_STAGE(PG8_SA(1, 0), a3, voffA);
            PG8_WAIT_V(8); PG8_WAIT_L(0); PG8_BAR; PG8_MMA(1, 0, At, B0); PG8_MMA(1, 1, At, B1); PG8_BAR; PG8_SCHED;
            } else {
            PG8_LDB(B0, 0, 0); PG8_SCHED; PG8_LDA(At, 0, 0); PG8_STAGE(PG8_SA(1, 1), a1 + hstep, voffA);
            PG8_WAIT_L(8); PG8_BAR; PG8_WAIT_L(0); PG8_MMA(0, 0, At, B0); PG8_BAR; PG8_SCHED;
            PG8_LDB(B1, 0, 1); PG8_STAGE(PG8_SB(0, 0), b2, voffB);
            PG8_BAR; PG8_WAIT_L(0); PG8_MMA(0, 1, At, B1); PG8_BAR;
            PG8_LDA(At, 0, 1); PG8_STAGE(PG8_SA(0, 0), a2, voffA);
            PG8_BAR; PG8_WAIT_L(0); PG8_MMA(1, 0, At, B0); PG8_BAR; PG8_SCHED;
            PG8_STAGE(PG8_SB(0, 1), b2 + hstep, voffB);
            PG8_WAIT_V(6); PG8_BAR; PG8_MMA(1, 1, At, B1); PG8_BAR;
            PG8_LDB(B0, 1, 0); PG8_SCHED; PG8_LDA(At, 1, 0); PG8_STAGE(PG8_SA(0, 1), a2 + hstep, voffA);
            PG8_WAIT_L(8); PG8_BAR; PG8_WAIT_L(0); PG8_MMA(0, 0, At, B0); PG8_BAR; PG8_SCHED;
            PG8_LDB(B1, 1, 1); PG8_STAGE(PG8_SB(1, 0), b3, voffB);
            PG8_BAR; PG8_WAIT_L(0); PG8_MMA(0, 1, At, B1); PG8_BAR;
            PG8_LDA(At, 1, 1); PG8_STAGE(PG8_SA(1, 0), a3, voffA);
            PG8_BAR; PG8_WAIT_L(0); PG8_MMA(1, 0, At, B0); PG8_BAR; PG8_SCHED;
            PG8_STAGE(PG8_SB(1, 1), b3 + hstep, voffB);
            PG8_WAIT_V(6); PG8_BAR; PG8_MMA(1, 1, At, B1); PG8_BAR;
            }
        }
        if constexpr (ALIGN_EPI) { if (wr == 0) PG8_BAR; }
        if constexpr (!Epi::AFTER_DRAIN) { E(acc, cur, wr, wc, fr, fq); S.done(cur); }
        if (!has_next) break;
#pragma unroll
        for (int a = 0; a < 2; ++a)
#pragma unroll
            for (int b = 0; b < 2; ++b)
#pragma unroll
                for (int m = 0; m < 4; ++m)
#pragma unroll
                    for (int n = 0; n < 2; ++n) acc[a][b][m][n] = (f32x4){0.f, 0.f, 0.f, 0.f};
        cur = nxt; cA = nA; cB = nB; ++ui;
        if constexpr (ALIGN_EPI) { if (wr == 1) PG8_BAR; }
    }
    PG8_WAIT_V(0);
    if constexpr (!ALIGN_EPI) { if (wr == 0) PG8_BAR; }
    PG8_BAR;
    if constexpr (Epi::AFTER_DRAIN) { E.fused(acc, cur, wr, wc, fr, fq, lds, wid, lane); S.done(cur); }
#undef PG8_SA
#undef PG8_SB
#undef PG8_STAGE
#undef PG8_LDA
#undef PG8_LDB
#undef PG8_MMA
#undef PG8_WAIT_V
#undef PG8_WAIT_L
#undef PG8_BAR
#undef PG8_SCHED
}
}

struct Frame {
    LAS unsigned char* lds;
    int wave, G, bid;
    const float *x, *mix_norm, *ffn_norm, *final_norm, *w_in, *w_out, *rel_bias, *conv_w1, *conv_b1, *conv_dw, *conv_dw_b, *conv_ln_g, *conv_ln_b, *conv_w2, *conv_b2,
        *peer_wq, *peer_keys, *peer_u, *peer_v;
    float* out;
    unsigned char* ws;
};
#define FRAME_IDS const int f_lane = lane_id(); const int f_tid = F.wave * 64 + f_lane; (void)f_tid
DI float gamma_of(int h) { return 1.f - exp2f(-5.f - (float)h); }

DI void p0_prep(Frame& F) {
    FRAME_IDS;
    const int gw = F.bid * NWAVES + F.wave, NGW = F.G * NWAVES;
    f32x2* rope = (f32x2*)(F.ws + WS_ROPE);
    for (int i = F.bid * NTHR + f_tid; i < SEQ * 32; i += F.G * NTHR) {
        const int s = i >> 5, j = i & 31;
        const float inv = powf(10000.f, -(float)j / 32.f);
        const float ang = (float)s * inv;
        float sn, cs; sincosf(ang, &sn, &cs);
        rope[i] = (f32x2){cs, sn};
    }
    bf16* xb = (bf16*)(F.ws + WS_XB); float* part = (float*)(F.ws + WS_PART);
    for (int m = gw; m < T; m += NGW) {
        const f32x4* xr = (const f32x4*)(F.x + (size_t)m * DM) + f_lane;
        u32x2* o = (u32x2*)(xb + (size_t)m * DM) + f_lane;
        float s = 0.f;
#pragma unroll
        for (int j = 0; j < 4; ++j) { const f32x4 v = xr[64 * j]; s += v.x * v.x + v.y * v.y + v.z * v.z + v.w * v.w; o[64 * j] = (u32x2){pk2(v.x, v.y), pk2(v.z, v.w)}; }
        s = wave_sum(s);
        if (f_lane < 16) part[(size_t)m * 16 + f_lane] = (f_lane == 0) ? s : 0.f;
    }
}
DI void p0_transpose_item(const float* W, int K, int N, bf16* WT, int prow0, const float* gain, float scale, LAS float* scr, int k0, int n0, int lane) {
#pragma unroll 8
    for (int i = 0; i < 32; ++i) { const int kk = 2 * i + (lane >> 5); scr[kk * 33 + (lane & 31)] = W[(size_t)(k0 + kk) * N + n0 + (lane & 31)] * (gain ? gain[k0 + kk] : 1.f) * scale; }
    asm volatile("s_waitcnt lgkmcnt(0)" ::: "memory");
    const int c = lane & 7;
#pragma unroll
    for (int j = 0; j < 4; ++j) { const int n = (lane >> 3) + 8 * j; const LAS float* q = scr + (8 * c) * 33 + n;
        u32x4 o; o.x = pk2(q[0 * 33], q[1 * 33]); o.y = pk2(q[2 * 33], q[3 * 33]); o.z = pk2(q[4 * 33], q[5 * 33]); o.w = pk2(q[6 * 33], q[7 * 33]);
        *(u32x4*)(WT + (size_t)(prow0 + n) * K + k0 + 8 * c) = o; }
    asm volatile("s_waitcnt lgkmcnt(0)" ::: "memory");
}
DI void p0_weights(Frame& F) {
    FRAME_IDS;
    LAS float* scr = (LAS float*)(F.lds + F.wave * 16384);
    const int gw = F.bid * NWAVES + F.wave, NGW = F.G * NWAVES;
    constexpr int I_IN = 16 * (INC / 32), I_SQ = 16 * (DM / 32), I_W1 = 16 * (2 * DM / 32);
    constexpr int NITEMS = I_IN + I_SQ + I_W1 + I_SQ + 2 * I_SQ;
    for (int it = gw; it < NITEMS; it += NGW) {
        int r = it;
        if (r < I_IN) { const int nb = r % (INC / 32), kb = r / (INC / 32), n0 = nb * 32;
            const int type = n0 / 512, head = (n0 % 512) / 64, bj = (n0 % 64) / 32;
            const int prow0 = 256 * (2 * type + head / 4) + 128 * bj + 32 * (head % 4);
            p0_transpose_item(F.w_in, DM, INC, (bf16*)(F.ws + WS_WIN), prow0, F.mix_norm, (type == 0 || type == 4) ? 0.125f : 1.f, scr, kb * 64, n0, f_lane); continue; }
        r -= I_IN;
        if (r < I_SQ) { const int nb = r % 32, kb = r / 32; p0_transpose_item(F.w_out, DM, DM, (bf16*)(F.ws + WS_WOUT), nb * 32, nullptr, 1.f, scr, kb * 64, nb * 32, f_lane); continue; }
        r -= I_SQ;
        if (r < I_W1) { const int nb = r % 64, kb = r / 64, n0 = nb * 32; const int bj = n0 / 1024, rem = n0 % 1024;
            p0_transpose_item(F.conv_w1, DM, 2 * DM, (bf16*)(F.ws + WS_W1), 256 * (rem / 128) + 128 * bj + (rem % 128), F.mix_norm + DM, 1.f, scr, kb * 64, n0, f_lane); continue; }
        r -= I_W1;
        if (r < I_SQ) { const int nb = r % 32, kb = r / 32; p0_transpose_item(F.conv_w2, DM, DM, (bf16*)(F.ws + WS_W2), nb * 32, nullptr, 1.f, scr, kb * 64, nb * 32, f_lane); continue; }
        r -= I_SQ;
        { const int layer = r / I_SQ; r %= I_SQ; const int nb = r % 32, kb = r / 32;
          p0_transpose_item(F.peer_wq + (size_t)layer * DM * DM, DM, DM, (bf16*)(F.ws + WS_WQ) + (size_t)layer * DM * DM, nb * 32, F.ffn_norm + layer * DM, 1.f, scr, kb * 64, nb * 32, f_lane); }
    }
}
DI float row_rstd(const float* part, int m) {
    const f32x4* p = (const f32x4*)(part + (size_t)m * 16);
    const f32x4 a = p[0], b = p[1], c = p[2], d = p[3];
    const float s = ((a.x + a.y) + (a.z + a.w)) + ((b.x + b.y) + (b.z + b.w)) + ((c.x + c.y) + (c.z + c.w)) + ((d.x + d.y) + (d.z + d.w));
    return 1.f / sqrtf(s * (1.f / DM) + EPS);
}

enum { EP_PROJ = 0, EP_RES = 1, EP_Q = 2, EP_HID = 3 };
template <int EP>
DI void naive_gemm(Frame& F, const bf16* A, const float* W, int N, const float* gain, const float* bias, bf16* Ob, int ldo) {
    FRAME_IDS;
    LAS float* As = (LAS float*)F.lds;
    LAS float* Bs = As + 16 * 129;
    LAS float* rs = Bs + 16 * 64;
    const float* part = (const float*)(F.ws + WS_PART);
    const f32x2* rope = (const f32x2*)(F.ws + WS_ROPE);
    bf16* hb = (bf16*)(F.ws + WS_XB);
    const int tid = f_tid, tx = tid & 15, ty = tid >> 4;
    const int nN = N / 64, nItems = (T / 128) * nN;
    for (int it = F.bid; it < nItems; it += F.G) {
        const int m0 = (it / nN) * 128, n0 = (it % nN) * 64;
        __syncthreads();
        if (EP != EP_RES) { if (tid < 128) rs[tid] = row_rstd(part, m0 + tid); }
        float acc[4][4];
#pragma unroll
        for (int i = 0; i < 4; ++i)
#pragma unroll
            for (int j = 0; j < 4; ++j) acc[i][j] = 0.f;
        for (int k0 = 0; k0 < DM; k0 += 16) {
            {   const int r = tid >> 2, kk = (tid & 3) * 4;
                const u32x2 v = *(const u32x2*)(A + (size_t)(m0 + r) * DM + k0 + kk);
                As[(kk + 0) * 129 + r] = __uint_as_float(v.x << 16); As[(kk + 1) * 129 + r] = __uint_as_float(v.x & 0xffff0000u);
                As[(kk + 2) * 129 + r] = __uint_as_float(v.y << 16); As[(kk + 3) * 129 + r] = __uint_as_float(v.y & 0xffff0000u); }
            {   const int kk = tid >> 5, c = (tid & 31) * 2;
                const f32x2 v = *(const f32x2*)(W + (size_t)(k0 + kk) * N + n0 + c);
                const float g = gain ? gain[k0 + kk] : 1.f;
                Bs[kk * 64 + c] = v.x * g; Bs[kk * 64 + c + 1] = v.y * g; }
            __syncthreads();
#pragma unroll
            for (int kk = 0; kk < 16; ++kk) {
                float a[4], b[4];
#pragma unroll
                for (int i = 0; i < 4; ++i) a[i] = As[kk * 129 + ty * 4 + i];
                b[0] = Bs[kk * 64 + 2 * tx]; b[1] = Bs[kk * 64 + 2 * tx + 1]; b[2] = Bs[kk * 64 + 32 + 2 * tx]; b[3] = Bs[kk * 64 + 33 + 2 * tx];
#pragma unroll
                for (int i = 0; i < 4; ++i)
#pragma unroll
                    for (int j = 0; j < 4; ++j) acc[i][j] += a[i] * b[j];
            }
            __syncthreads();
        }
#pragma unroll
        for (int i = 0; i < 4; ++i) {
            const int m = m0 + ty * 4 + i;
            const int cols[4] = {n0 + 2 * tx, n0 + 2 * tx + 1, n0 + 32 + 2 * tx, n0 + 33 + 2 * tx};
            float v[4] = {acc[i][0], acc[i][1], acc[i][2], acc[i][3]};
            if (EP == EP_PROJ) {
                const float r = rs[ty * 4 + i];
#pragma unroll
                for (int j = 0; j < 4; ++j) v[j] *= r;
                const int type = n0 / 512;
                if (type == 3 || type == 4) {
                    const int s = m % SEQ;
#pragma unroll
                    for (int j = 0; j < 2; ++j) {
                        const f32x2 cs = rope[s * 32 + 2 * tx + j];
                        const float t1 = v[j], t2 = v[j + 2];
                        v[j] = t1 * cs.x - t2 * cs.y; v[j + 2] = t1 * cs.y + t2 * cs.x;
                    }
                }
                if (type == 0 || type == 4) {
#pragma unroll
                    for (int j = 0; j < 4; ++j) v[j] *= 0.125f;
                }
#pragma unroll
                for (int j = 0; j < 4; ++j) Ob[(size_t)m * ldo + cols[j]] = (bf16)f2bf(v[j]);
            } else if (EP == EP_RES) {
#pragma unroll
                for (int j = 0; j < 4; ++j) {
                    const size_t o = (size_t)m * DM + cols[j];
                    const float base = (Ob == nullptr) ? F.x[o] : F.out[o];
                    const float hn = base + v[j] + (bias ? bias[cols[j]] : 0.f);
                    F.out[o] = hn; hb[o] = (bf16)f2bf(hn);
                }
            } else if (EP == EP_Q) {
                const float r = rs[ty * 4 + i];
#pragma unroll
                for (int j = 0; j < 4; ++j) Ob[(size_t)m * ldo + cols[j]] = (bf16)f2bf(v[j] * r);
            } else {
                const float r = rs[ty * 4 + i];
#pragma unroll
                for (int j = 0; j < 4; ++j) Ob[(size_t)m * ldo + cols[j]] = (bf16)f2bf(v[j] * r + bias[cols[j]]);
            }
        }
    }
}

DI void naive_rowstat(Frame& F) {
    FRAME_IDS;
    const int gw = F.bid * NWAVES + F.wave, NGW = F.G * NWAVES;
    float* part = (float*)(F.ws + WS_PART);
    for (int m = gw; m < T; m += NGW) {
        const f32x4* xr = (const f32x4*)(F.out + (size_t)m * DM) + f_lane;
        float s = 0.f;
#pragma unroll
        for (int j = 0; j < 4; ++j) { const f32x4 v = xr[64 * j]; s += v.x * v.x + v.y * v.y + v.z * v.z + v.w * v.w; }
        s = wave_sum(s);
        if (f_lane < 16) part[(size_t)m * 16 + f_lane] = (f_lane == 0) ? s : 0.f;
    }
}

DI void naive_attn(Frame& F) {
    FRAME_IDS;
    const bf16* R = (const bf16*)(F.ws + WS_R); bf16* O = (bf16*)(F.ws + WS_O);
    LAS float* Ks = (LAS float*)F.lds;
    LAS float* Vs = Ks + 64 * 65;
    LAS float* bs = Vs + 64 * 65;
    const int tid = f_tid;
    for (int it = F.bid; it < NB * NHA * 4; it += F.G) {
        const int b = it / (NHA * 4), h = (it / 4) % NHA, cg = it % 4;
        const int c = cg * 8 + (tid >> 6), i = tid & 63;
        __syncthreads();
        for (int k = tid; k < 257; k += NTHR) bs[k] = F.rel_bias[h * 257 + k];
        float q[64], acc[64];
        {   const bf16* qp = R + (size_t)(b * SEQ + c * 64 + i) * INC + C_QA + h * 64;
#pragma unroll
            for (int d = 0; d < 64; ++d) { q[d] = bf2f(qp[d]); acc[d] = 0.f; } }
        float mx = -1e30f, l = 0.f;
        const int t_lo = (cg * 8 - 8) < 0 ? 0 : (cg * 8 - 8), t_hi = cg * 8 + 7;
        for (int tc = t_lo; tc <= t_hi; ++tc) {
            __syncthreads();
            for (int e = tid; e < 64 * 64; e += NTHR) {
                const int j = e >> 6, d = e & 63;
                const size_t row = (size_t)(b * SEQ + tc * 64 + j) * INC;
                Ks[j * 65 + d] = bf2f(R[row + C_KA + h * 64 + d]);
                Vs[j * 65 + d] = bf2f(R[row + C_VA + h * 64 + d]);
            }
            __syncthreads();
            if (tc <= c && tc >= c - 8) {
                for (int j = 0; j < 64; ++j) {
                    float s = 0.f;
#pragma unroll
                    for (int d = 0; d < 64; ++d) s += q[d] * Ks[j * 65 + d];
                    int rel = (c * 64 + i) - (tc * 64 + j); rel = rel < -128 ? -128 : (rel > 128 ? 128 : rel);
                    s += bs[rel + 128];
                    const float mn = fmaxf(mx, s), corr = __expf(mx - mn), p = __expf(s - mn);
                    l = l * corr + p;
#pragma unroll
                    for (int d = 0; d < 64; ++d) acc[d] = acc[d] * corr + p * Vs[j * 65 + d];
                    mx = mn;
                }
            }
        }
        const float inv = 1.f / l;
        bf16* op = O + (size_t)(b * SEQ + c * 64 + i) * DM + h * 64;
#pragma unroll
        for (int d = 0; d < 64; ++d) op[d] = (bf16)f2bf(acc[d] * inv);
    }
}


typedef short v4i16 __attribute__((ext_vector_type(4)));
typedef __bf16 bf16x2_t __attribute__((ext_vector_type(2)));
DI unsigned cvtpk(float lo, float hi) { f32x2 v = {lo, hi}; bf16x2_t b = __builtin_convertvector(v, bf16x2_t); return __builtin_bit_cast(unsigned, b); }
DI v4i16 ds_tr16(LAS const unsigned char* p) { return __builtin_amdgcn_ds_read_tr16_b64_v4i16((LAS v4i16*)p); }
DI int crow(int r, int h) { return (r & 3) + 8 * (r >> 2) + 4 * h; }
DI bf16x8 pack_step(const f32x16& x, const int s) {
    u32x4 w = {cvtpk(x[8 * s + 0], x[8 * s + 1]), cvtpk(x[8 * s + 2], x[8 * s + 3]), cvtpk(x[8 * s + 4], x[8 * s + 5]), cvtpk(x[8 * s + 6], x[8 * s + 7])};
    return __builtin_bit_cast(bf16x8, w);
}
constexpr int AT_KB = 64 * 144, AT_VB = 8192, AT_BUF = AT_KB + AT_VB, AT_BIAS = 2 * AT_BUF;
DI void attn_item(Frame& F, const int it) {
    FRAME_IDS;
    const bf16* R = (const bf16*)(F.ws + WS_R); bf16* O = (bf16*)(F.ws + WS_O);
    LAS unsigned char* lds = F.lds;
    LAS float* bias_s = (LAS float*)(lds + AT_BIAS);
    const int q32 = f_lane & 31, h = f_lane >> 5, w = F.wave;
    const int srow = f_tid >> 3, sch = f_tid & 7;
    const int vtr_off = ((f_lane & 15) >> 2) * 64 + (16 * ((f_lane >> 4) & 1) + 4 * (f_lane & 3)) * 2;
    {
        const int b = it / (NHA * 8), hd = (it / 8) % NHA, c0 = (it % 8) * 4;
        const int c = c0 + (w >> 1), qrow0 = 32 * (w & 1);
        const size_t tq = (size_t)b * SEQ + c * 64 + qrow0 + q32;
        __syncthreads();
        for (int k = f_tid; k < 257; k += NTHR) bias_s[k] = F.rel_bias[hd * 257 + k];
        bf16x8 qf[4];
#pragma unroll
        for (int ks = 0; ks < 4; ++ks) qf[ks] = *(const bf16x8*)(R + tq * INC + C_QA + hd * 64 + 16 * ks + 8 * h);
        const int t_lo = c0 - 8 < 0 ? 0 : c0 - 8, t_hi = c0 + 3, ntile = t_hi - t_lo + 1;
        const bf16* kbase = R + ((size_t)b * SEQ + srow) * INC + C_KA + hd * 64 + 8 * sch;
        const bf16* vbase = R + ((size_t)b * SEQ + srow) * INC + C_VA + hd * 64 + 8 * sch;
        u32x4 kreg = *(const u32x4*)(kbase + (size_t)t_lo * 64 * INC), vreg = *(const u32x4*)(vbase + (size_t)t_lo * 64 * INC);
        *(LAS u32x4*)(lds + srow * 144 + sch * 16) = kreg;
        *(LAS u32x4*)(lds + AT_KB + (sch >> 2) * 4096 + srow * 64 + (sch & 3) * 16) = vreg;
        __syncthreads();
        const float bias_far = bias_s[256];
        float m = -1e30f, l = 0.f;
        f32x16 o0 = {}, o1 = {};
        for (int i = 0; i < ntile; ++i) {
            const int tc = t_lo + i;
            LAS unsigned char* kb = lds + (i & 1) * AT_BUF; LAS unsigned char* vb = kb + AT_KB;
            if (i + 1 < ntile) { kreg = *(const u32x4*)(kbase + (size_t)(tc + 1) * 64 * INC); vreg = *(const u32x4*)(vbase + (size_t)(tc + 1) * 64 * INC); }
            const int D = c - tc;
            if (D >= 0 && D <= 8) {
                const float init = D >= 3 ? bias_far : 0.f;
                f32x16 p0, p1;
#pragma unroll
                for (int r = 0; r < 16; ++r) { p0[r] = init; p1[r] = init; }
#pragma unroll
                for (int ks = 0; ks < 4; ++ks) {
                    const bf16x8 k0 = *(const LAS bf16x8*)(kb + q32 * 144 + (16 * ks + 8 * h) * 2);
                    const bf16x8 k1 = *(const LAS bf16x8*)(kb + (32 + q32) * 144 + (16 * ks + 8 * h) * 2);
                    p0 = __builtin_amdgcn_mfma_f32_32x32x16_bf16(k0, qf[ks], p0, 0, 0, 0);
                    p1 = __builtin_amdgcn_mfma_f32_32x32x16_bf16(k1, qf[ks], p1, 0, 0, 0);
                }
                if (D < 3) {
                    const int relb = D * 64 + qrow0 + q32 - 4 * h + 128;
#pragma unroll
                    for (int r = 0; r < 16; ++r) {
                        const int r0 = relb - ((r & 3) + 8 * (r >> 2));
                        const int i0 = r0 < 0 ? 0 : (r0 > 256 ? 256 : r0), r1 = r0 - 32, i1 = r1 < 0 ? 0 : (r1 > 256 ? 256 : r1);
                        p0[r] += bias_s[i0]; p1[r] += bias_s[i1];
                    }
                }
                float tm = fmaxf(p0[0], p1[0]);
#pragma unroll
                for (int r = 1; r < 16; ++r) tm = fmaxf(tm, fmaxf(p0[r], p1[r]));
                tm = fmaxf(tm, __shfl_xor(tm, 32));
                const float mn = fmaxf(m, tm), alpha = __expf(m - mn);
                m = mn;
                float ps = 0.f;
#pragma unroll
                for (int r = 0; r < 16; ++r) { p0[r] = __expf(p0[r] - mn); p1[r] = __expf(p1[r] - mn); ps += p0[r] + p1[r]; }
                l = l * alpha + ps;
#pragma unroll
                for (int r = 0; r < 16; ++r) { o0[r] *= alpha; o1[r] *= alpha; }
                bf16x8 pf[4];
                pf[0] = pack_step(p0, 0); pf[1] = pack_step(p0, 1); pf[2] = pack_step(p1, 0); pf[3] = pack_step(p1, 1);
#pragma unroll
                for (int kk = 0; kk < 4; ++kk) {
                    const int key0 = 16 * kk + 4 * h;
                    const v4i16 a0l = ds_tr16(vb + key0 * 64 + vtr_off), a0h = ds_tr16(vb + (key0 + 8) * 64 + vtr_off);
                    const v4i16 a1l = ds_tr16(vb + 4096 + key0 * 64 + vtr_off), a1h = ds_tr16(vb + 4096 + (key0 + 8) * 64 + vtr_off);
                    const bf16x8 a0 = __builtin_shufflevector(a0l, a0h, 0, 1, 2, 3, 4, 5, 6, 7), a1 = __builtin_shufflevector(a1l, a1h, 0, 1, 2, 3, 4, 5, 6, 7);
                    o0 = __builtin_amdgcn_mfma_f32_32x32x16_bf16(a0, pf[kk], o0, 0, 0, 0);
                    o1 = __builtin_amdgcn_mfma_f32_32x32x16_bf16(a1, pf[kk], o1, 0, 0, 0);
                }
            }
            if (i + 1 < ntile) {
                LAS unsigned char* nb = lds + ((i + 1) & 1) * AT_BUF;
                *(LAS u32x4*)(nb + srow * 144 + sch * 16) = kreg;
                *(LAS u32x4*)(nb + AT_KB + (sch >> 2) * 4096 + srow * 64 + (sch & 3) * 16) = vreg;
            }
            __syncthreads();
        }
        l += __shfl_xor(l, 32);
        const float inv = 1.f / l;
        bf16* op = O + tq * DM + hd * 64 + 4 * h;
#pragma unroll
        for (int g = 0; g < 4; ++g) {
            *(u32x2*)(op + 8 * g) = (u32x2){cvtpk(o0[4 * g] * inv, o0[4 * g + 1] * inv), cvtpk(o0[4 * g + 2] * inv, o0[4 * g + 3] * inv)};
            *(u32x2*)(op + 32 + 8 * g) = (u32x2){cvtpk(o1[4 * g] * inv, o1[4 * g + 1] * inv), cvtpk(o1[4 * g + 2] * inv, o1[4 * g + 3] * inv)};
        }
    }
    __syncthreads();
}

constexpr int RT_Q = 0, RT_K = 9216, RT_KD = 18432, RT_V = 26624, RT_BUF = 34816, RT_ZS = 2 * RT_BUF, RT_CS = RT_ZS + 64 * 66 * 4;
DI void ret_item(Frame& F, const int it) {
    FRAME_IDS;
    const bf16* R = (const bf16*)(F.ws + WS_R); bf16* O = (bf16*)(F.ws + WS_O);
    LAS unsigned char* lds = F.lds;
    LAS float* Zs = (LAS float*)(lds + RT_ZS); LAS float* Cs = (LAS float*)(lds + RT_CS);
    const int b = it / NHB, hd = it % NHB;
    const int q32 = f_lane & 31, h = f_lane >> 5, w = F.wave;
    const int role = w >> 2, itile = (w >> 1) & 1, etile = w & 1;
    const int srow = f_tid >> 3, sch = f_tid & 7;
    const int vtr_off = ((f_lane & 15) >> 2) * 64 + (16 * ((f_lane >> 4) & 1) + 4 * (f_lane & 3)) * 2;
    const float l2g = log2f(gamma_of(hd));
    const float cd = exp2f(l2g * 64.f), sdec = exp2f(l2g * (float)(63 - srow));
    float qdv[16];
#pragma unroll
    for (int r = 0; r < 16; ++r) qdv[r] = exp2f(l2g * (float)(32 * itile + crow(r, h) + 1));
    f32x16 xs0 = {}, xs1 = {};
    const size_t trow0 = (size_t)b * SEQ;
    const bf16* gq = R + (trow0 + srow) * INC + hd * 64 + 8 * sch;
    u32x4 qreg = *(const u32x4*)(gq + C_QB), kreg = *(const u32x4*)(gq + C_KB), vreg = *(const u32x4*)(gq + C_VB);
    __syncthreads();
#define RT_STAGE(bufp) do { LAS unsigned char* bp_ = (bufp); \
        *(LAS u32x4*)(bp_ + RT_Q + srow * 144 + sch * 16) = qreg; *(LAS u32x4*)(bp_ + RT_K + srow * 144 + sch * 16) = kreg; \
        *(LAS u32x4*)(bp_ + RT_V + (sch >> 2) * 4096 + srow * 64 + (sch & 3) * 16) = vreg; \
        u32x4 kd_; \
        _Pragma("unroll") for (int e_ = 0; e_ < 4; ++e_) kd_[e_] = cvtpk(__uint_as_float(kreg[e_] << 16) * sdec, __uint_as_float(kreg[e_] & 0xffff0000u) * sdec); \
        *(LAS u32x4*)(bp_ + RT_KD + (sch >> 2) * 4096 + srow * 64 + (sch & 3) * 16) = kd_; } while (0)
    RT_STAGE(lds);
    __syncthreads();
    for (int n = 0; n < NCH; ++n) {
        LAS unsigned char* bp = lds + (n & 1) * RT_BUF;
        if (n + 1 < NCH) { const bf16* g1 = gq + (size_t)(n + 1) * 64 * INC; qreg = *(const u32x4*)(g1 + C_QB); kreg = *(const u32x4*)(g1 + C_KB); vreg = *(const u32x4*)(g1 + C_VB); }
        unsigned short gr[8];
#pragma unroll
        for (int r = 0; r < 8; ++r) gr[r] = R[(trow0 + n * 64 + 8 * w + r) * INC + C_GB + hd * 64 + f_lane];
        if (role == 0) {
            bf16x8 qf[4];
#pragma unroll
            for (int ks = 0; ks < 4; ++ks) qf[ks] = *(const LAS bf16x8*)(bp + RT_Q + (32 * itile + q32) * 144 + (16 * ks + 8 * h) * 2);
            f32x16 st0 = {}, st1 = {};
#pragma unroll
            for (int ks = 0; ks < 4; ++ks) {
                const bf16x8 k0 = *(const LAS bf16x8*)(bp + RT_K + q32 * 144 + (16 * ks + 8 * h) * 2);
                const bf16x8 k1 = *(const LAS bf16x8*)(bp + RT_K + (32 + q32) * 144 + (16 * ks + 8 * h) * 2);
                st0 = __builtin_amdgcn_mfma_f32_32x32x16_bf16(k0, qf[ks], st0, 0, 0, 0);
                st1 = __builtin_amdgcn_mfma_f32_32x32x16_bf16(k1, qf[ks], st1, 0, 0, 0);
            }
            int iiv = 32 * itile + q32 - 4 * h; asm volatile("" : "+v"(iiv));
#pragma unroll
            for (int r = 0; r < 16; ++r) {
                const int dd = iiv - ((r & 3) + 8 * (r >> 2));
                st0[r] *= __builtin_amdgcn_exp2f(l2g * fabsf((float)dd));
                st1[r] *= __builtin_amdgcn_exp2f(l2g * fabsf((float)(dd - 32)));
            }
            f32x16 z = {};
#pragma unroll
            for (int kk = 0; kk < 4; ++kk) {
                const int key0 = 16 * kk + 4 * h;
                const v4i16 bl = ds_tr16(bp + RT_V + etile * 4096 + key0 * 64 + vtr_off), bh = ds_tr16(bp + RT_V + etile * 4096 + (key0 + 8) * 64 + vtr_off);
                const bf16x8 vb = __builtin_shufflevector(bl, bh, 0, 1, 2, 3, 4, 5, 6, 7);
                const bf16x8 xa = (kk < 2) ? pack_step(st0, kk & 1) : pack_step(st1, kk & 1);
                z = __builtin_amdgcn_mfma_f32_32x32x16_bf16(xa, vb, z, 0, 0, 0);
            }
            int zb = (32 * itile + 4 * h) * 66 + 32 * etile + q32; asm volatile("" : "+v"(zb));
#pragma unroll
            for (int r = 0; r < 16; ++r) Zs[zb + ((r & 3) + 8 * (r >> 2)) * 66] = z[r];
        } else {
            f32x16 cr = {};
#pragma unroll
            for (int kk = 0; kk < 4; ++kk) {
                const LAS unsigned char* qp = bp + RT_Q + (32 * itile + q32) * 144 + (16 * kk + 4 * h) * 2;
                const v4i16 al = *(const LAS v4i16*)qp, ah = *(const LAS v4i16*)(qp + 16);
                const bf16x8 qa = __builtin_shufflevector(al, ah, 0, 1, 2, 3, 4, 5, 6, 7);
                const bf16x8 xb = (kk < 2) ? pack_step(xs0, kk & 1) : pack_step(xs1, kk & 1);
                cr = __builtin_amdgcn_mfma_f32_32x32x16_bf16(qa, xb, cr, 0, 0, 0);
            }
            int cb = (32 * itile + 4 * h) * 66 + 32 * etile + q32; asm volatile("" : "+v"(cb));
#pragma unroll
            for (int r = 0; r < 16; ++r) Cs[cb + ((r & 3) + 8 * (r >> 2)) * 66] = cr[r] * qdv[r];
#pragma unroll
            for (int r = 0; r < 16; ++r) { xs0[r] *= cd; xs1[r] *= cd; }
#pragma unroll
            for (int s4 = 0; s4 < 4; ++s4) {
                const int key0 = 16 * s4 + 8 * h;
                const v4i16 vl = ds_tr16(bp + RT_V + etile * 4096 + key0 * 64 + vtr_off), vh = ds_tr16(bp + RT_V + etile * 4096 + (key0 + 4) * 64 + vtr_off);
                const bf16x8 vb = __builtin_shufflevector(vl, vh, 0, 1, 2, 3, 4, 5, 6, 7);
                const v4i16 a0l = ds_tr16(bp + RT_KD + key0 * 64 + vtr_off), a0h = ds_tr16(bp + RT_KD + (key0 + 4) * 64 + vtr_off);
                const v4i16 a1l = ds_tr16(bp + RT_KD + 4096 + key0 * 64 + vtr_off), a1h = ds_tr16(bp + RT_KD + 4096 + (key0 + 4) * 64 + vtr_off);
                const bf16x8 ka0 = __builtin_shufflevector(a0l, a0h, 0, 1, 2, 3, 4, 5, 6, 7), ka1 = __builtin_shufflevector(a1l, a1h, 0, 1, 2, 3, 4, 5, 6, 7);
                xs0 = __builtin_amdgcn_mfma_f32_32x32x16_bf16(ka0, vb, xs0, 0, 0, 0);
                xs1 = __builtin_amdgcn_mfma_f32_32x32x16_bf16(ka1, vb, xs1, 0, 0, 0);
            }
        }
        __syncthreads();
#pragma unroll
        for (int r = 0; r < 8; ++r) {
            const int i = 8 * w + r;
            const float v = Zs[i * 66 + f_lane] + Cs[i * 66 + f_lane];
            const float mu = wave_sum(v) * (1.f / 64.f);
            const float dv = v - mu;
            const float var = wave_sum(dv * dv) * (1.f / 64.f);
            const float g = bf2f(gr[r]);
            O[(trow0 + n * 64 + i) * DM + 512 + hd * 64 + f_lane] = (bf16)f2bf(dv * (1.f / sqrtf(var + EPS)) * (g / (1.f + __expf(-g))));
        }
        if (n + 1 < NCH) RT_STAGE(lds + ((n + 1) & 1) * RT_BUF);
        __syncthreads();
    }
#undef RT_STAGE
}
DI void mix_phase(Frame& F) {
    FRAME_IDS;
    unsigned* ctr = (unsigned*)(F.ws + WS_CTL) + CW_QUEUE;
    volatile LAS unsigned* slot = (volatile LAS unsigned*)(F.lds + MISC_OFF) + 16;
    for (;;) {
        __syncthreads();
        if (f_tid == 0) slot[0] = __hip_atomic_fetch_add(ctr, 1u, __ATOMIC_RELAXED, __HIP_MEMORY_SCOPE_AGENT);
        __syncthreads();
        const int idx = (int)slot[0];
        if (idx >= NB * NHB + NB * NHA * 8) break;
        if (idx < NB * NHB) ret_item(F, idx); else attn_item(F, idx - NB * NHB);
    }
}
DI void naive_ret(Frame& F) {
    FRAME_IDS;
    const bf16* R = (const bf16*)(F.ws + WS_R); bf16* O = (bf16*)(F.ws + WS_O);
    LAS float* St = (LAS float*)F.lds;
    LAS float* Qs = St + 4096;
    LAS float* Ks = Qs + 64 * 65;
    LAS float* Vs = Ks + 64 * 65;
    LAS float* Sc = Vs + 64 * 65;
    LAS float* Ot = Sc + 64 * 65;
    const int tid = f_tid;
    for (int it = F.G - 1 - F.bid; it < NB * NHB; it += F.G) {
        const int b = it / NHB, h = it % NHB;
        const float lg = logf(gamma_of(h));
        const float cd = __expf(lg * 64.f);
        __syncthreads();
        for (int e = tid; e < 4096; e += NTHR) St[e] = 0.f;
        for (int n = 0; n < NCH; ++n) {
            __syncthreads();
            for (int e = tid; e < 4096; e += NTHR) {
                const int j = e >> 6, d = e & 63;
                const size_t row = (size_t)(b * SEQ + n * 64 + j) * INC;
                Qs[j * 65 + d] = bf2f(R[row + C_QB + h * 64 + d]);
                Ks[j * 65 + d] = bf2f(R[row + C_KB + h * 64 + d]);
                Vs[j * 65 + d] = bf2f(R[row + C_VB + h * 64 + d]);
            }
            __syncthreads();
            for (int e = tid; e < 4096; e += NTHR) {
                const int i = e >> 6, j = e & 63;
                float s = 0.f;
#pragma unroll
                for (int d = 0; d < 64; ++d) s += Qs[i * 65 + d] * Ks[j * 65 + d];
                const int ad = i > j ? i - j : j - i;
                Sc[i * 65 + j] = s * __expf(lg * (float)ad);
            }
            __syncthreads();
            for (int e = tid; e < 4096; e += NTHR) {
                const int i = e >> 6, ee = e & 63;
                float s = 0.f, cr = 0.f;
#pragma unroll
                for (int j = 0; j < 64; ++j) s += Sc[i * 65 + j] * Vs[j * 65 + ee];
#pragma unroll
                for (int d = 0; d < 64; ++d) cr += Qs[i * 65 + d] * St[d * 64 + ee];
                Ot[i * 65 + ee] = s + cr * __expf(lg * (float)(i + 1));
            }
            __syncthreads();
            for (int e = tid; e < 4096; e += NTHR) {
                const int d = e >> 6, ee = e & 63;
                float s = 0.f;
                for (int j = 0; j < 64; ++j) s += Ks[j * 65 + d] * __expf(lg * (float)(63 - j)) * Vs[j * 65 + ee];
                St[d * 64 + ee] = cd * St[d * 64 + ee] + s;
            }
            for (int r = 0; r < 8; ++r) {
                const int i = F.wave * 8 + r;
                const float v = Ot[i * 65 + f_lane];
                const float mu = wave_sum(v) * (1.f / 64.f);
                const float dv = v - mu;
                const float var = wave_sum(dv * dv) * (1.f / 64.f);
                const size_t row = (size_t)(b * SEQ + n * 64 + i);
                const float g = bf2f(R[row * INC + C_GB + h * 64 + f_lane]);
                const float o = dv * (1.f / sqrtf(var + EPS)) * (g * sigmoidf(g));
                O[row * DM + 512 + h * 64 + f_lane] = (bf16)f2bf(o);
            }
        }
    }
}

DI void naive_route(Frame& F, int layer) {
    FRAME_IDS;
    const bf16* Q = (const bf16*)(F.ws + WS_Q);
    int* eidx = (int*)(F.ws + WS_EIDX); float* gate = (float*)(F.ws + WS_GATE);
    const float* keys = F.peer_keys + (size_t)layer * 2 * PK * 64;
    LAS float* sc = (LAS float*)F.lds;
    LAS int* i1s = (LAS int*)(sc + 256 * 64);
    LAS int* i2s = i1s + 16 * 64;
    LAS float* qs = (LAS float*)(i2s + 16 * 64);
    const int p = f_tid;
    for (int it = F.bid; it < T / 8; it += F.G) {
        if (p < 64) {
            const int t = it * 8 + (p >> 3), hh = p & 7;
            float top1[16], top2[16];
#pragma unroll
            for (int side = 0; side < 2; ++side) {
                const bf16* qp = Q + (size_t)t * DM + hh * 128 + side * 64;
                for (int d = 0; d < 64; ++d) qs[d * 64 + p] = bf2f(qp[d]);
                for (int k = 0; k < PK; ++k) {
                    const float* kp = keys + ((size_t)side * PK + k) * 64;
                    float s = 0.f;
#pragma unroll 8
                    for (int d = 0; d < 64; ++d) s += qs[d * 64 + p] * kp[d];
                    sc[k * 64 + p] = s;
                }
#pragma unroll
                for (int a = 0; a < 16; ++a) {
                    float best = -INFINITY; int bi = 0;
                    for (int k = 0; k < PK; ++k) { const float v = sc[k * 64 + p]; if (v > best) { best = v; bi = k; } }
                    sc[bi * 64 + p] = -INFINITY;
                    if (side == 0) { top1[a] = best; i1s[a * 64 + p] = bi; } else { top2[a] = best; i2s[a * 64 + p] = bi; }
                }
            }
#pragma unroll
            for (int a = 0; a < 16; ++a)
#pragma unroll
                for (int b = 0; b < 16; ++b) sc[(a * 16 + b) * 64 + p] = top1[a] + top2[b];
            float bv[16]; int be[16];
#pragma unroll
            for (int a = 0; a < 16; ++a) {
                float best = -INFINITY; int bi = 0;
                for (int k = 0; k < 256; ++k) { const float v = sc[k * 64 + p]; if (v > best) { best = v; bi = k; } }
                sc[bi * 64 + p] = -INFINITY;
                bv[a] = best; be[a] = i1s[(bi >> 4) * 64 + p] * PK + i2s[(bi & 15) * 64 + p];
            }
            float sum = 0.f; const float bmax = bv[0];
#pragma unroll
            for (int a = 0; a < 16; ++a) { bv[a] = __expf(bv[a] - bmax); sum += bv[a]; }
            const float inv = 1.f / sum;
#pragma unroll
            for (int a = 0; a < 16; ++a) { eidx[(size_t)t * NSEL + hh * 16 + a] = be[a]; gate[(size_t)t * NSEL + hh * 16 + a] = bv[a] * inv; }
        }
    }
}


DI float fmax_raw(float a, float b) { float r; asm("v_max_f32_e32 %0, %1, %2" : "=v"(r) : "v"(a), "v"(b)); return r; }
DI float fmin_raw(float a, float b) { float r; asm("v_min_f32_e32 %0, %1, %2" : "=v"(r) : "v"(a), "v"(b)); return r; }
#define CE_DESC(x, y) do { const float hi_ = fmax_raw((x), (y)), lo_ = fmin_raw((x), (y)); (x) = hi_; (y) = lo_; } while (0)
template <int N> DI void sort_desc(float* v) {
#pragma unroll
    for (int k = 2; k <= N; k <<= 1)
#pragma unroll
        for (int j = k >> 1; j > 0; j >>= 1)
#pragma unroll
            for (int i = 0; i < N; ++i) { const int l = i ^ j; if (l > i) { if ((i & k) == 0 || k == N) CE_DESC(v[i], v[l]); else CE_DESC(v[l], v[i]); } }
}
DI void merge16(float* a, const float* b) {
#pragma unroll
    for (int i = 0; i < 16; ++i) a[i] = fmax_raw(a[i], b[15 - i]);
#pragma unroll
    for (int j = 8; j > 0; j >>= 1)
#pragma unroll
        for (int i = 0; i < 16; ++i) { const int l = i ^ j; if (l > i) CE_DESC(a[i], a[l]); }
}
DI float key_pack(float v, unsigned keep_mask, unsigned idx) { return __uint_as_float((__float_as_uint(v) & keep_mask) | idx); }
DI void opt_route(Frame& F, int layer) {
    FRAME_IDS;
    const bf16* Q = (const bf16*)(F.ws + WS_Q);
    int* eidx = (int*)(F.ws + WS_EIDX); float* gate = (float*)(F.ws + WS_GATE);
    const float* keys = F.peer_keys + (size_t)layer * 2 * PK * 64;
    LAS unsigned char* kl = F.lds;
    __syncthreads();
    for (int idx = f_tid; idx < 2 * PK * 8; idx += NTHR) {
        const int row = idx >> 3, ch = idx & 7;
        const f32x4 a = *(const f32x4*)(keys + (size_t)row * 64 + ch * 8), b = *(const f32x4*)(keys + (size_t)row * 64 + ch * 8 + 4);
        *(LAS u32x4*)(kl + row * 144 + ch * 16) = (u32x4){pk2(a[0], a[1]), pk2(a[2], a[3]), pk2(b[0], b[1]), pk2(b[2], b[3])};
    }
    __syncthreads();
    LAS int* lut = (LAS int*)(F.lds + 40960 + F.wave * 8192);
    const int c = f_lane & 31, h = f_lane >> 5;
    const int gw = F.bid * NWAVES + F.wave, NGW = F.G * NWAVES;
    for (int task = gw; task < (T / 32) * PH; task += NGW) {
        const int tile = task >> 3, hh = task & 7, t = tile * 32 + c;
        float tk[2][16];
#pragma unroll
        for (int side = 0; side < 2; ++side) {
            bf16x8 qf[4];
#pragma unroll
            for (int ks = 0; ks < 4; ++ks) qf[ks] = *(const bf16x8*)(Q + (size_t)t * DM + hh * PQD + side * 64 + 16 * ks + 8 * h);
            float v[64];
#pragma unroll
            for (int kt = 0; kt < 4; ++kt) {
                f32x16 acc = {};
#pragma unroll
                for (int ks = 0; ks < 4; ++ks) {
                    const bf16x8 a = *(const LAS bf16x8*)(kl + (side * PK + 32 * kt + c) * 144 + (16 * ks + 8 * h) * 2);
                    acc = __builtin_amdgcn_mfma_f32_32x32x16_bf16(a, qf[ks], acc, 0, 0, 0);
                }
#pragma unroll
                for (int r = 0; r < 16; ++r) v[16 * kt + r] = key_pack(acc[r], 0xFFFFFF80u, (unsigned)(32 * kt + (r & 3) + 8 * (r >> 2) + 4 * h));
            }
            sort_desc<16>(v); sort_desc<16>(v + 16); sort_desc<16>(v + 32); sort_desc<16>(v + 48);
            merge16(v, v + 16); merge16(v + 32, v + 48); merge16(v, v + 32);
            float pr[16];
#pragma unroll
            for (int i = 0; i < 16; ++i) pr[i] = __shfl_xor(v[i], 32);
            merge16(v, pr);
#pragma unroll
            for (int i = 0; i < 16; ++i) { tk[side][i] = v[i]; lut[(side * 16 + i) * 64 + f_lane] = (int)(__float_as_uint(v[i]) & 0x7Fu); }
        }
        float cd[64];
        {   int n = 0;
#pragma unroll
            for (int a = 0; a < 16; ++a)
#pragma unroll
                for (int b = 0; b < 16; ++b) if ((a + 1) * (b + 1) <= 16) { cd[n] = key_pack(tk[0][a] + tk[1][b], 0xFFFFFF00u, (unsigned)(a * 16 + b)); ++n; }
#pragma unroll
            for (int i = 50; i < 64; ++i) cd[i] = -INFINITY;
        }
        sort_desc<16>(cd); sort_desc<16>(cd + 16); sort_desc<16>(cd + 32); CE_DESC(cd[48], cd[49]);
        merge16(cd, cd + 16); merge16(cd + 32, cd + 48); merge16(cd, cd + 32);
        int ex[16]; float gv[16]; float sum = 0.f;
        const float top = __uint_as_float(__float_as_uint(cd[0]) & 0xFFFFFF00u);
#pragma unroll
        for (int i = 0; i < 16; ++i) {
            const unsigned bits = __float_as_uint(cd[i]);
            const int a = (bits >> 4) & 15, b = bits & 15;
            ex[i] = lut[a * 64 + f_lane] * PK + lut[(16 + b) * 64 + f_lane];
            gv[i] = __expf(__uint_as_float(bits & 0xFFFFFF00u) - top); sum += gv[i];
        }
        const float inv = 1.f / sum;
        if (h == 0) {
            u32x4* ep = (u32x4*)(eidx + (size_t)t * NSEL + hh * 16);
#pragma unroll
            for (int q = 0; q < 4; ++q) ep[q] = (u32x4){(unsigned)ex[4 * q], (unsigned)ex[4 * q + 1], (unsigned)ex[4 * q + 2], (unsigned)ex[4 * q + 3]};
        } else {
            f32x4* gp = (f32x4*)(gate + (size_t)t * NSEL + hh * 16);
#pragma unroll
            for (int q = 0; q < 4; ++q) gp[q] = (f32x4){gv[4 * q] * inv, gv[4 * q + 1] * inv, gv[4 * q + 2] * inv, gv[4 * q + 3] * inv};
        }
    }
    __syncthreads();
}
DI void naive_gather(Frame& F, int layer, bool final_norm) {
    FRAME_IDS;
    const int* eidx = (const int*)(F.ws + WS_EIDX); const float* gate = (const float*)(F.ws + WS_GATE);
    float* part = (float*)(F.ws + WS_PART); bf16* hb = (bf16*)(F.ws + WS_XB);
    const float* U = F.peer_u + (size_t)layer * PE * DM; const float* V = F.peer_v + (size_t)layer * PE * DM;
    const float* gn = F.ffn_norm + layer * DM;
    LAS float* xs = (LAS float*)F.lds;
    LAS float* as = xs + 1024;
    LAS int* es = (LAS int*)(as + 128);
    LAS float* red = (LAS float*)(es + 128);
    const int tid = f_tid;
    for (int t = F.bid; t < T; t += F.G) {
        __syncthreads();
        const float rstd = row_rstd(part, t);
        const f32x2 hv = *(const f32x2*)(F.out + (size_t)t * DM + 2 * tid);
        xs[2 * tid] = hv.x * rstd * gn[2 * tid]; xs[2 * tid + 1] = hv.y * rstd * gn[2 * tid + 1];
        if (tid < 128) es[tid] = eidx[(size_t)t * NSEL + tid];
        __syncthreads();
        for (int k = F.wave; k < NSEL; k += NWAVES) {
            const f32x4* ur = (const f32x4*)(U + (size_t)es[k] * DM) + f_lane;
            float s = 0.f;
#pragma unroll
            for (int j = 0; j < 4; ++j) { const f32x4 u = ur[64 * j]; const int c = 4 * f_lane + 256 * j; s += u.x * xs[c] + u.y * xs[c + 1] + u.z * xs[c + 2] + u.w * xs[c + 3]; }
            s = wave_sum(s);
            if (f_lane == 0) as[k] = gelu_erf(s) * gate[(size_t)t * NSEL + k];
        }
        __syncthreads();
        float o0 = 0.f, o1 = 0.f;
        for (int k = 0; k < NSEL; ++k) { const f32x2 v = *(const f32x2*)(V + (size_t)es[k] * DM + 2 * tid); const float a = as[k]; o0 += a * v.x; o1 += a * v.y; }
        const float h0 = hv.x + o0, h1 = hv.y + o1;
        const float ss = block_sum(h0 * h0 + h1 * h1, red, tid);
        if (final_norm) {
            const float r = 1.f / sqrtf(ss * (1.f / DM) + EPS);
            *(f32x2*)(F.out + (size_t)t * DM + 2 * tid) = (f32x2){h0 * r * F.final_norm[2 * tid], h1 * r * F.final_norm[2 * tid + 1]};
        } else {
            *(f32x2*)(F.out + (size_t)t * DM + 2 * tid) = (f32x2){h0, h1};
            *(unsigned*)(hb + (size_t)t * DM + 2 * tid) = pk2(h0, h1);
            if (tid < 16) part[(size_t)t * 16 + tid] = (tid == 0) ? ss : 0.f;
        }
    }
}


DI unsigned fp8x4(f32x4 v) {
    const float a = __builtin_amdgcn_fmed3f(v[0], -448.f, 448.f), b = __builtin_amdgcn_fmed3f(v[1], -448.f, 448.f), c = __builtin_amdgcn_fmed3f(v[2], -448.f, 448.f), d = __builtin_amdgcn_fmed3f(v[3], -448.f, 448.f);
    unsigned w = 0u;
    w = (unsigned)__builtin_amdgcn_cvt_pk_fp8_f32(a, b, (int)w, false);
    w = (unsigned)__builtin_amdgcn_cvt_pk_fp8_f32(c, d, (int)w, true);
    return w;
}
DI void p0_fp8(Frame& F) {
    FRAME_IDS;
    const int gw = F.bid * NWAVES + F.wave, NGW = F.G * NWAVES;
    for (int row = gw; row < 4 * PE; row += NGW) {
        const int tab = row / PE, e = row % PE, layer = tab & 1, isv = tab >> 1;
        const float* src = (isv ? F.peer_v : F.peer_u) + ((size_t)layer * PE + e) * DM;
        unsigned* dst = (unsigned*)(F.ws + (isv ? WS_V8 : WS_U8) + ((size_t)layer * PE + e) * DM);
        const f32x4* sp = (const f32x4*)src + f_lane;
        const f32x4* gp = (const f32x4*)(F.ffn_norm + layer * DM) + f_lane;
#pragma unroll
        for (int j = 0; j < 4; ++j) {
            f32x4 v = sp[64 * j];
            if (!isv) v = v * gp[64 * j] * U8_SCALE; else v = v * V8_SCALE;
            dst[f_lane + 64 * j] = fp8x4(v);
        }
    }
}
DI float dot16_fp8(const u32x4 r, const float (&xs)[16]) {
    float s0 = 0.f, s1 = 0.f;
#pragma unroll
    for (int w = 0; w < 4; ++w) {
        const f32x2 lo = __builtin_amdgcn_cvt_pk_f32_fp8((int)r[w], false), hi = __builtin_amdgcn_cvt_pk_f32_fp8((int)r[w], true);
        s0 = fmaf(lo[0], xs[4 * w + 0], s0); s1 = fmaf(lo[1], xs[4 * w + 1], s1); s0 = fmaf(hi[0], xs[4 * w + 2], s0); s1 = fmaf(hi[1], xs[4 * w + 3], s1);
    }
    return s0 + s1;
}
DI void axpy16_fp8(const u32x4 r, const float a, float (&o)[16]) {
#pragma unroll
    for (int w = 0; w < 4; ++w) {
        const f32x2 lo = __builtin_amdgcn_cvt_pk_f32_fp8((int)r[w], false), hi = __builtin_amdgcn_cvt_pk_f32_fp8((int)r[w], true);
        o[4 * w + 0] = fmaf(a, lo[0], o[4 * w + 0]); o[4 * w + 1] = fmaf(a, lo[1], o[4 * w + 1]); o[4 * w + 2] = fmaf(a, hi[0], o[4 * w + 2]); o[4 * w + 3] = fmaf(a, hi[1], o[4 * w + 3]);
    }
}
DI float red_combine(const int level, const float a, const float b, const int lane) {
    const int M = 32 >> level; const bool bit = (lane & M) != 0;
    const float send = bit ? a : b, keep = bit ? b : a;
    return keep + __shfl_xor(send, M);
}
constexpr int brev6(int k) { return ((k & 1) << 5) | ((k & 2) << 3) | ((k & 4) << 1) | ((k & 8) >> 1) | ((k & 16) >> 3) | ((k & 32) >> 5); }
DI void opt_gather(Frame& F, int layer, bool final_norm) {
    FRAME_IDS;
    const int* eidx = (const int*)(F.ws + WS_EIDX); const float* gate = (const float*)(F.ws + WS_GATE);
    float* part = (float*)(F.ws + WS_PART); bf16* hb = (bf16*)(F.ws + WS_XB);
    const __amdgpu_buffer_rsrc_t U8 = __builtin_amdgcn_make_buffer_rsrc((void*)(F.ws + WS_U8 + (size_t)layer * PE * DM), 0, PE * DM, 0x00020000);
    const __amdgpu_buffer_rsrc_t V8 = __builtin_amdgcn_make_buffer_rsrc((void*)(F.ws + WS_V8 + (size_t)layer * PE * DM), 0, PE * DM, 0x00020000);
    const int voff = f_lane * 16;
    const int gw = F.bid * NWAVES + F.wave, NGW = F.G * NWAVES;
    for (int t = gw; t < T; t += NGW) {
        float* hrow = F.out + (size_t)t * DM + 16 * f_lane;
        float xs[16];
        { const f32x4 h0 = ((const f32x4*)hrow)[0], h1 = ((const f32x4*)hrow)[1], h2 = ((const f32x4*)hrow)[2], h3 = ((const f32x4*)hrow)[3];
#pragma unroll
          for (int i = 0; i < 4; ++i) { xs[i] = h0[i]; xs[4 + i] = h1[i]; xs[8 + i] = h2[i]; xs[12 + i] = h3[i]; } }
        const float pv = (f_lane < 16) ? part[(size_t)t * 16 + f_lane] : 0.f;
        const float rstd = 1.f / sqrtf(wave_sum(pv) * (1.f / DM) + EPS);
        int ev[2]; float gv[2], av[2];
        ev[0] = eidx[(size_t)t * NSEL + f_lane]; ev[1] = eidx[(size_t)t * NSEL + 64 + f_lane];
        gv[0] = gate[(size_t)t * NSEL + f_lane]; gv[1] = gate[(size_t)t * NSEL + 64 + f_lane];
        constexpr int GR = 4, NG = 64 / GR;
#pragma unroll
        for (int b = 0; b < 2; ++b) {
            float st[6]; float red = 0.f;
            u32x4 buf[2][GR];
#pragma unroll
            for (int j = 0; j < GR; ++j) { const int e = __builtin_amdgcn_readlane(ev[b], brev6(j)); buf[0][j] = __builtin_amdgcn_raw_buffer_load_b128(U8, voff, e * DM, 0); }
            asm volatile("" ::: "memory");
#pragma unroll
            for (int g = 0; g < NG; ++g) {
                if (g + 1 < NG) {
#pragma unroll
                    for (int j = 0; j < GR; ++j) { const int e = __builtin_amdgcn_readlane(ev[b], brev6(GR * (g + 1) + j)); buf[(g + 1) & 1][j] = __builtin_amdgcn_raw_buffer_load_b128(U8, voff, e * DM, 0); }
                }
                asm volatile("" ::: "memory");
#pragma unroll
                for (int j = 0; j < GR; ++j) {
                    const int k = GR * g + j;
                    float v = dot16_fp8(buf[g & 1][j], xs);
                    int kk = k, lvl = 0;
#pragma unroll
                    for (int q = 0; q < 6; ++q) { if (kk & 1) { v = red_combine(lvl, st[lvl], v, f_lane); kk >>= 1; ++lvl; } }
                    if (k == 63) red = v; else st[lvl] = v;
                }
                asm volatile("" ::: "memory");
            }
            const float d = red * (rstd * (1.f / U8_SCALE));
            av[b] = gelu_erf(d) * gv[b] * (1.f / V8_SCALE);
        }
        float o[16];
#pragma unroll
        for (int i = 0; i < 16; ++i) o[i] = 0.f;
#pragma unroll
        for (int b = 0; b < 2; ++b) {
            u32x4 buf[2][GR];
#pragma unroll
            for (int j = 0; j < GR; ++j) { const int e = __builtin_amdgcn_readlane(ev[b], j); buf[0][j] = __builtin_amdgcn_raw_buffer_load_b128(V8, voff, e * DM, 0); }
            asm volatile("" ::: "memory");
#pragma unroll
            for (int g = 0; g < NG; ++g) {
                if (g + 1 < NG) {
#pragma unroll
                    for (int j = 0; j < GR; ++j) { const int e = __builtin_amdgcn_readlane(ev[b], GR * (g + 1) + j); buf[(g + 1) & 1][j] = __builtin_amdgcn_raw_buffer_load_b128(V8, voff, e * DM, 0); }
                }
                asm volatile("" ::: "memory");
#pragma unroll
                for (int j = 0; j < GR; ++j) { const float a = __builtin_bit_cast(float, __builtin_amdgcn_readlane(__builtin_bit_cast(int, av[b]), GR * g + j)); axpy16_fp8(buf[g & 1][j], a, o); }
                asm volatile("" ::: "memory");
            }
        }
        float ss = 0.f;
#pragma unroll
        for (int i = 0; i < 16; ++i) { o[i] += xs[i]; ss = fmaf(o[i], o[i], ss); }
        ss = wave_sum(ss);
        if (final_norm) {
            const float r = 1.f / sqrtf(ss * (1.f / DM) + EPS);
            const f32x4* fn = (const f32x4*)(F.final_norm + 16 * f_lane);
#pragma unroll
            for (int q = 0; q < 4; ++q) { const f32x4 g = fn[q]; ((f32x4*)hrow)[q] = (f32x4){o[4 * q] * r * g[0], o[4 * q + 1] * r * g[1], o[4 * q + 2] * r * g[2], o[4 * q + 3] * r * g[3]}; }
        } else {
#pragma unroll
            for (int q = 0; q < 4; ++q) ((f32x4*)hrow)[q] = (f32x4){o[4 * q], o[4 * q + 1], o[4 * q + 2], o[4 * q + 3]};
            u32x4* hbp = (u32x4*)(hb + (size_t)t * DM + 16 * f_lane);
            hbp[0] = (u32x4){pk2(o[0], o[1]), pk2(o[2], o[3]), pk2(o[4], o[5]), pk2(o[6], o[7])};
            hbp[1] = (u32x4){pk2(o[8], o[9]), pk2(o[10], o[11]), pk2(o[12], o[13]), pk2(o[14], o[15])};
            if (f_lane < 16) part[(size_t)t * 16 + f_lane] = (f_lane == 0) ? ss : 0.f;
        }
    }
}

DI void opt_conv(Frame& F) {
    FRAME_IDS;
    const bf16* G = (const bf16*)(F.ws + WS_GLU); bf16* H2 = (bf16*)(F.ws + WS_HID2);
    LAS float* ys = (LAS float*)F.lds;
    float wt0[CW], wt1[CW];
#pragma unroll
    for (int j = 0; j < CW; ++j) { const f32x2 wv = *(const f32x2*)(F.conv_dw + j * DM + 2 * f_tid); wt0[j] = wv[0]; wt1[j] = wv[1]; }
    const f32x2 bdw = *(const f32x2*)(F.conv_dw_b + 2 * f_tid);
    for (int it = F.bid; it < T / 128; it += F.G) {
        const int s0 = (it % (SEQ / 128)) * 128;
        const size_t row0 = (size_t)it * 128;
        const unsigned* gp = (const unsigned*)G + f_tid;
        unsigned win[CW];
#pragma unroll
        for (int u = 0; u < CW - 1; ++u) { const int sp = s0 - (CW - 1) + u; win[u + 1] = sp >= 0 ? gp[(row0 - (CW - 1) + u) * 512] : 0u; }
        win[0] = 0u;
        for (int bt = 0; bt < 5; ++bt) {
            unsigned nx[CW];
#pragma unroll
            for (int u = 0; u < CW; ++u) { const int sl = 31 * bt + u; nx[u] = (s0 + sl < SEQ) ? gp[(row0 + sl) * 512] : 0u; }
            __syncthreads();
#pragma unroll
            for (int u = 0; u < CW; ++u) {
                win[u] = nx[u];
                float a0 = bdw[0], a1 = bdw[1];
#pragma unroll
                for (int j = 0; j < CW; ++j) {
                    const unsigned xv = win[(u + 1 + j) % CW];
                    a0 = fmaf(wt0[j], __uint_as_float(xv << 16), a0); a1 = fmaf(wt1[j], __uint_as_float(xv & 0xffff0000u), a1);
                }
                *(LAS f32x2*)(ys + u * DM + 2 * f_tid) = (f32x2){a0, a1};
            }
            __syncthreads();
            for (int u = F.wave; u < CW; u += NWAVES) {
                const int sl = 31 * bt + u;
                if (sl < 128) {
                    f32x4 v[4]; float sm = 0.f;
#pragma unroll
                    for (int k = 0; k < 4; ++k) { v[k] = *(const LAS f32x4*)(ys + u * DM + 256 * k + 4 * f_lane); sm += (v[k][0] + v[k][1]) + (v[k][2] + v[k][3]); }
                    const float mu = wave_sum(sm) * (1.f / DM);
                    float sq = 0.f;
#pragma unroll
                    for (int k = 0; k < 4; ++k) { v[k] = v[k] - mu; sq += (v[k][0] * v[k][0] + v[k][1] * v[k][1]) + (v[k][2] * v[k][2] + v[k][3] * v[k][3]); }
                    const float rs = 1.f / sqrtf(wave_sum(sq) * (1.f / DM) + EPS);
#pragma unroll
                    for (int k = 0; k < 4; ++k) {
                        const f32x4 g = *(const f32x4*)(F.conv_ln_g + 256 * k + 4 * f_lane), bb = *(const f32x4*)(F.conv_ln_b + 256 * k + 4 * f_lane);
                        f32x4 z = v[k] * rs * g + bb;
#pragma unroll
                        for (int e = 0; e < 4; ++e) z[e] = z[e] / (1.f + __expf(-z[e]));
                        *(u32x2*)(H2 + (row0 + sl) * DM + 256 * k + 4 * f_lane) = (u32x2){cvtpk(z[0], z[1]), cvtpk(z[2], z[3])};
                    }
                }
            }
        }
    }
    __syncthreads();
}
DI void naive_glu(Frame& F) {
    FRAME_IDS;
    const bf16* H = (const bf16*)(F.ws + WS_HID); bf16* G = (bf16*)(F.ws + WS_GLU);
    for (size_t i = (size_t)F.bid * NTHR + f_tid; i < (size_t)T * DM; i += (size_t)F.G * NTHR) {
        const size_t m = i / DM; const int c = (int)(i % DM);
        const float a = bf2f(H[m * 2048 + c]), g = bf2f(H[m * 2048 + 1024 + c]);
        G[i] = (bf16)f2bf(a * sigmoidf(g));
    }
}
DI void naive_conv(Frame& F) {
    FRAME_IDS;
    const bf16* G = (const bf16*)(F.ws + WS_GLU); bf16* H2 = (bf16*)(F.ws + WS_HID2);
    LAS float* red = (LAS float*)F.lds;
    const int tid = f_tid;
    for (int t = F.bid; t < T; t += F.G) {
        const int s = t % SEQ;
        float y[2];
#pragma unroll
        for (int u = 0; u < 2; ++u) {
            const int c = 2 * tid + u;
            float a = F.conv_dw_b[c];
            for (int j = 0; j < CW; ++j) { const int sp = s - (CW - 1) + j; if (sp >= 0) a += F.conv_dw[j * DM + c] * bf2f(G[(size_t)(t - (CW - 1) + j) * DM + c]); }
            y[u] = a;
        }
        const float mu = block_sum(y[0] + y[1], red, tid) * (1.f / DM);
        const float d0 = y[0] - mu, d1 = y[1] - mu;
        const float var = block_sum(d0 * d0 + d1 * d1, red, tid) * (1.f / DM);
        const float r = 1.f / sqrtf(var + EPS);
        const float z0 = d0 * r * F.conv_ln_g[2 * tid] + F.conv_ln_b[2 * tid], z1 = d1 * r * F.conv_ln_g[2 * tid + 1] + F.conv_ln_b[2 * tid + 1];
        *(unsigned*)(H2 + (size_t)t * DM + 2 * tid) = pk2(z0 * sigmoidf(z0), z1 * sigmoidf(z1));
    }
}

#if OPT_GEMM
enum Phase { PH_PREP = 0, PH_PROJ, PH_MIX, PH_WOUT, PH_Q0, PH_ROUTE0, PH_GATHER0, PH_W1, PH_CONV, PH_W2, PH_Q1, PH_ROUTE1, PH_GATHER1, PH_COUNT };
#else
enum Phase { PH_PREP = 0, PH_PROJ, PH_MIX, PH_WOUT, PH_STAT0, PH_Q0, PH_ROUTE0, PH_GATHER0, PH_W1, PH_GLU, PH_CONV, PH_W2, PH_STAT1, PH_Q1, PH_ROUTE1, PH_GATHER1, PH_COUNT };
#endif
struct Args { const float* in[19]; float* out; unsigned char* ws; int ph_lo, ph_hi; };

__global__ void __launch_bounds__(NTHR, 2) mega_fwd(Args args) {
    extern __shared__ __attribute__((aligned(16))) unsigned char lds[];
    Frame F;
    F.lds = (LAS unsigned char*)lds;
    F.wave = __builtin_amdgcn_readfirstlane((int)threadIdx.x >> 6); FRAME_IDS;
    F.G = gridDim.x; F.bid = blockIdx.x;
    F.x = args.in[0]; F.mix_norm = args.in[1]; F.ffn_norm = args.in[2]; F.final_norm = args.in[3]; F.w_in = args.in[4]; F.w_out = args.in[5]; F.rel_bias = args.in[6];
    F.conv_w1 = args.in[7]; F.conv_b1 = args.in[8]; F.conv_dw = args.in[9]; F.conv_dw_b = args.in[10]; F.conv_ln_g = args.in[11]; F.conv_ln_b = args.in[12];
    F.conv_w2 = args.in[13]; F.conv_b2 = args.in[14]; F.peer_wq = args.in[15]; F.peer_keys = args.in[16]; F.peer_u = args.in[17]; F.peer_v = args.in[18];
    F.out = args.out; F.ws = args.ws;
    volatile LAS unsigned* MISC = (volatile LAS unsigned*)(F.lds + MISC_OFF);
    for (int u = f_tid; u < (LDS_BYTES - LDSCTL_OFF) / 4; u += NTHR) ((LAS unsigned*)(F.lds + LDSCTL_OFF))[u] = 0u;
    __syncthreads();
    const int lo = args.ph_lo, hi = args.ph_hi;
    XcdBarrier bar; bar.bar = (unsigned*)(F.ws + WS_CTL) + CW_BAR; bar.x = 0; bar.st = nullptr;
    if (hi - lo > 1) bar = xcd_barrier_post((unsigned*)(F.ws + WS_CTL) + CW_BAR, MISC + 8);
#ifndef TEST_PHASE
#define TEST_PHASE -1
#endif
#define IN(k) ((TEST_PHASE < 0 || TEST_PHASE == (k)) && lo <= (k) && (k) < hi)
#define SEAM(k) do { if (IN(k) && IN((k) + 1)) xcd_barrier(bar, F.wave); } while (0)
    bf16* XB = (bf16*)(F.ws + WS_XB);
    const float* PART = (const float*)(F.ws + WS_PART); const float* ROPE = (const float*)(F.ws + WS_ROPE);
    if (IN(PH_PREP)) { p0_prep(F);
#if OPT_GEMM
        p0_weights(F);
#endif
#if OPT_GATHER
        p0_fp8(F);
#endif
    } SEAM(PH_PREP);
#if OPT_GEMM
#define GEMM_PHASE(EPI, Aptr, Bptr, NN, ...) do { pg8::Gemm g{(const bf16*)(Aptr), (const bf16*)(Bptr), T, (NN), DM}; pg8::StaticOrder S; S.init(T, (NN), F.G, F.bid); \
        pg8::EPI E{__VA_ARGS__}; pg8::gemm_phase<pg8::EPI, pg8::StaticOrder, true, true>(F.lds, g, S, E, F.wave); } while (0)
    if (IN(PH_PROJ)) { GEMM_PHASE(EpiProj, XB, F.ws + WS_WIN, INC, (bf16*)(F.ws + WS_R), PART, ROPE); } SEAM(PH_PROJ);
#else
    if (IN(PH_PROJ)) { naive_gemm<EP_PROJ>(F, XB, F.w_in, INC, F.mix_norm, nullptr, (bf16*)(F.ws + WS_R), INC); } SEAM(PH_PROJ);
#endif
#if OPT_ATTN
    if (IN(PH_MIX)) { mix_phase(F); } SEAM(PH_MIX);
#else
    if (IN(PH_MIX)) { naive_ret(F); naive_attn(F); } SEAM(PH_MIX);
#endif
#if OPT_GEMM
    if (IN(PH_WOUT)) { GEMM_PHASE(EpiRes, F.ws + WS_O, F.ws + WS_WOUT, DM, F.x, F.out, XB, (float*)(F.ws + WS_PART), nullptr); } SEAM(PH_WOUT);
    if (IN(PH_Q0)) { GEMM_PHASE(EpiQ, XB, F.ws + WS_WQ, DM, (bf16*)(F.ws + WS_Q), PART); } SEAM(PH_Q0);
#else
    if (IN(PH_WOUT)) { naive_gemm<EP_RES>(F, (const bf16*)(F.ws + WS_O), F.w_out, DM, nullptr, nullptr, nullptr, DM); } SEAM(PH_WOUT);
    if (IN(PH_STAT0)) { naive_rowstat(F); } SEAM(PH_STAT0);
    if (IN(PH_Q0)) { naive_gemm<EP_Q>(F, XB, F.peer_wq, DM, F.ffn_norm, nullptr, (bf16*)(F.ws + WS_Q), DM); } SEAM(PH_Q0);
#endif
#if OPT_ROUTE
    if (IN(PH_ROUTE0)) { opt_route(F, 0); } SEAM(PH_ROUTE0);
#else
    if (IN(PH_ROUTE0)) { naive_route(F, 0); } SEAM(PH_ROUTE0);
#endif
#if OPT_GATHER
    if (IN(PH_GATHER0)) { opt_gather(F, 0, false); } SEAM(PH_GATHER0);
#else
    if (IN(PH_GATHER0)) { naive_gather(F, 0, false); } SEAM(PH_GATHER0);
#endif
#if OPT_GEMM
    if (IN(PH_W1)) { GEMM_PHASE(EpiGlu, XB, F.ws + WS_W1, 2 * DM, (bf16*)(F.ws + WS_GLU), PART, F.conv_b1); } SEAM(PH_W1);
#else
    if (IN(PH_W1)) { naive_gemm<EP_HID>(F, XB, F.conv_w1, 2 * DM, F.mix_norm + DM, F.conv_b1, (bf16*)(F.ws + WS_HID), 2 * DM); } SEAM(PH_W1);
    if (IN(PH_GLU)) { naive_glu(F); } SEAM(PH_GLU);
#endif
#if OPT_CONV
    if (IN(PH_CONV)) { opt_conv(F); } SEAM(PH_CONV);
#else
    if (IN(PH_CONV)) { naive_conv(F); } SEAM(PH_CONV);
#endif
#if OPT_GEMM
    if (IN(PH_W2)) { GEMM_PHASE(EpiRes, F.ws + WS_HID2, F.ws + WS_W2, DM, F.out, F.out, XB, (float*)(F.ws + WS_PART), F.conv_b2); } SEAM(PH_W2);
    if (IN(PH_Q1)) { GEMM_PHASE(EpiQ, XB, F.ws + WS_WQ + (size_t)DM * DM * 2, DM, (bf16*)(F.ws + WS_Q), PART); } SEAM(PH_Q1);
#else
    if (IN(PH_W2)) { naive_gemm<EP_RES>(F, (const bf16*)(F.ws + WS_HID2), F.conv_w2, DM, nullptr, F.conv_b2, XB  , DM); } SEAM(PH_W2);
    if (IN(PH_STAT1)) { naive_rowstat(F); } SEAM(PH_STAT1);
    if (IN(PH_Q1)) { naive_gemm<EP_Q>(F, XB, F.peer_wq + (size_t)DM * DM, DM, F.ffn_norm + DM, nullptr, (bf16*)(F.ws + WS_Q), DM); } SEAM(PH_Q1);
#endif
#if OPT_ROUTE
    if (IN(PH_ROUTE1)) { opt_route(F, 1); } SEAM(PH_ROUTE1);
#else
    if (IN(PH_ROUTE1)) { naive_route(F, 1); } SEAM(PH_ROUTE1);
#endif
#if OPT_GATHER
    if (IN(PH_GATHER1)) { opt_gather(F, 1, true); }
#else
    if (IN(PH_GATHER1)) { naive_gather(F, 1, true); }
#endif
#undef IN
#undef SEAM
}

extern "C" void kernel_launch(void* const* d_in, const int* in_sizes, int n_in, void* d_out, int out_size, void* d_ws, size_t ws_size, hipStream_t stream) {
    static int grid = 0;
    if (grid == 0) {
        if (n_in != 19 || out_size != T * DM || ws_size < WS_END) { fprintf(stderr, "kernel_launch: unexpected shapes (n_in %d out %d ws %zu)\n", n_in, out_size, ws_size); grid = -1; return; }
        int dev = 0, cus = 0;
        if (hipGetDevice(&dev) != hipSuccess || hipDeviceGetAttribute(&cus, hipDeviceAttributeMultiprocessorCount, dev) != hipSuccess) { grid = -1; return; }
        if (hipFuncSetAttribute((const void*)mega_fwd, hipFuncAttributeMaxDynamicSharedMemorySize, LDS_BYTES) != hipSuccess) { fprintf(stderr, "kernel_launch: hipFuncSetAttribute failed\n"); grid = -1; return; }
        (void)hipGetLastError();
        grid = cus;
    }
    if (grid < 0) return;
    (void)hipMemsetAsync((char*)d_ws + WS_CTL, 0, CTL_ZERO_BYTES, stream);
    Args a{};
    for (int i = 0; i < 19; ++i) a.in[i] = (const float*)d_in[i];
    a.out = (float*)d_out; a.ws = (unsigned char*)d_ws;
#if MK_ONE_LAUNCH
    a.ph_lo = 0; a.ph_hi = PH_COUNT;
    hipLaunchKernelGGL(mega_fwd, dim3(grid), dim3(NTHR), LDS_BYTES, stream, a);
#else
    for (int p = 0; p < PH_COUNT; ++p) { a.ph_lo = p; a.ph_hi = p + 1; hipLaunchKernelGGL(mega_fwd, dim3(grid), dim3(NTHR), LDS_BYTES, stream, a); }
#endif
}
```

```cpp
#include <hip/hip_runtime.h>
#include <cstdio>
#include <cstdint>

#ifndef MK_ONE_LAUNCH
#define MK_ONE_LAUNCH 1
#endif

#define GAS __attribute__((address_space(1)))
#define LAS __attribute__((address_space(3)))
#define DI __device__ __forceinline__
typedef unsigned short bf16;
typedef float f32x2 __attribute__((ext_vector_type(2)));
typedef float f32x4 __attribute__((ext_vector_type(4)));
typedef unsigned u32x2 __attribute__((ext_vector_type(2)));
typedef unsigned u32x4 __attribute__((ext_vector_type(4)));
typedef short bf16x8 __attribute__((ext_vector_type(8)));
typedef float f32x16 __attribute__((ext_vector_type(16)));

constexpr int NB = 16, SEQ = 2048, DM = 1024, T = NB * SEQ;
constexpr int CHUNK = 64, HD = 64, NHA = 8, NHB = 8, INC = 3584, NCH = SEQ / CHUNK;
constexpr int PH = 8, PK = 128, PE = PK * PK, PQD = 128, PTOP = 16, NSEL = PH * PTOP;
constexpr int CW = 31;
constexpr float EPS = 1e-6f;
constexpr float XQ = 127.f / 6.f;
constexpr int NWAVES = 8, NTHR = NWAVES * 64;

constexpr int C_QA = 0, C_KA = 512, C_VA = 1024, C_QB = 1536, C_KB = 2048, C_VB = 2560, C_GB = 3072;

constexpr size_t MiB = 1u << 20;
constexpr size_t WS_CTL = 0, CTL_ZERO_BYTES = 1 * MiB;
constexpr size_t WS_WIN = 2 * MiB, WS_WOUT = 9 * MiB, WS_W1 = 11 * MiB, WS_W2 = 15 * MiB, WS_WQ = 17 * MiB;
constexpr size_t WS_ROPE = 22 * MiB;
constexpr size_t WS_PART = 23 * MiB;
constexpr size_t WS_EIDX = 26 * MiB;
constexpr size_t WS_GATE = 42 * MiB;
constexpr size_t WS_U8 = 64 * MiB, WS_V8 = 96 * MiB;
constexpr size_t WS_SC = 25 * MiB;
constexpr size_t WS_SA = 58 * MiB;
constexpr size_t WS_PU = 256 * MiB;
constexpr size_t WS_A = 384 * MiB;
constexpr size_t WS_XB = 128 * MiB;
constexpr size_t WS_R = 192 * MiB;
constexpr size_t WS_O = 416 * MiB;
constexpr size_t WS_Q = 192 * MiB;
constexpr size_t WS_HID = 256 * MiB;
constexpr size_t WS_GLU = 384 * MiB;
constexpr size_t WS_HID2 = 448 * MiB;
constexpr size_t WS_END = 512 * MiB;
constexpr int CW_BAR = 4096, CW_QUEUE = 8192;

constexpr int RING_BYTES = 131072, LDSCTL_OFF = RING_BYTES, MISC_OFF = LDSCTL_OFF + 320, LDS_BYTES = 147456;

DI float bf2f(bf16 v) { return __uint_as_float(((unsigned)v) << 16); }
DI unsigned f2bf(float f) { unsigned u = __float_as_uint(f); return (u + 0x7fffu + ((u >> 16) & 1u)) >> 16; }
DI unsigned pk2(float lo, float hi) { return f2bf(lo) | (f2bf(hi) << 16); }
DI float wave_sum(float v) {
#pragma unroll
    for (int o = 1; o < 64; o <<= 1) v += __shfl_xor(v, o);
    return v;
}
DI float wave_max(float v) {
#pragma unroll
    for (int o = 1; o < 64; o <<= 1) v = fmaxf(v, __shfl_xor(v, o));
    return v;
}
DI float block_sum(float v, LAS float* red, int tid) {
    v = wave_sum(v);
    __syncthreads();
    if ((tid & 63) == 0) red[tid >> 6] = v;
    __syncthreads();
    float s = 0.f;
#pragma unroll
    for (int i = 0; i < NWAVES; ++i) s += red[i];
    return s;
}
DI float gelu_erf(float x) { return 0.5f * x * (1.f + erff(x * 0.70710678118654752f)); }
DI float sigmoidf(float x) { return 1.f / (1.f + __expf(-x)); }

DI int lane_id() { int r; asm volatile("v_mbcnt_lo_u32_b32 %0, -1, 0\n\tv_mbcnt_hi_u32_b32 %0, -1, %0" : "=v"(r)); return r; }
#define XB_TMO      128
#define XB_XCNT(j)  (256  + 64 * (j))
#define XB_XSUB(j)  (1280 + 64 * (j))
#define XB_XGEN(j)  (2304 + 64 * (j))
#define XB_TOP      3328
#define XB_TOPGEN   3392
#define XCD_BAR_WORDS 3456
#define XB_SPIN_CAP (1u << 22)
DI unsigned xb_ld(unsigned* p)              { return __hip_atomic_load(p, __ATOMIC_RELAXED, __HIP_MEMORY_SCOPE_AGENT); }
DI unsigned xb_add(unsigned* p, unsigned v) { return __hip_atomic_fetch_add(p, v, __ATOMIC_RELAXED, __HIP_MEMORY_SCOPE_AGENT); }
DI unsigned xb_xcc_id() { return (unsigned)__builtin_amdgcn_s_getreg((3 << 11) | 20) & 0xFu; }
#define XB_SPIN(cond, bar) do { unsigned _sp = 0; while (cond) { __builtin_amdgcn_s_sleep(1); \
    if ((++_sp & 255u) == 0u) { if (xb_ld(&(bar)[XB_TMO])) break; if (_sp > XB_SPIN_CAP) { atomicAdd(&(bar)[XB_TMO], 1u); break; } } } } while (0)
struct XcdBarrier { unsigned* bar; unsigned x; volatile LAS unsigned* st; };
DI XcdBarrier xcd_barrier_post(unsigned* bar, volatile LAS unsigned* st) {
    XcdBarrier b; b.bar = bar; b.x = xb_xcc_id(); b.st = st;
    if (threadIdx.x == 0) st[4] = xb_add(&bar[XB_XCNT(b.x)], 1u);
    return b;
}
DI void xcd_barrier_complete(unsigned* bar, unsigned x, unsigned& nloc, unsigned& nx) {
    const unsigned G = gridDim.x * gridDim.y * gridDim.z;
    unsigned sum, cnt, mine, sp = 0u;
    for (;;) {
        sum = 0u; cnt = 0u; mine = 0u;
#pragma unroll
        for (unsigned j = 0; j < 16; ++j) { const unsigned c = xb_ld(&bar[XB_XCNT(j)]); sum += c; cnt += (c > 0u) ? 1u : 0u; mine = (j == x) ? c : mine; }
        if (sum == G) break;
        __builtin_amdgcn_s_sleep(1);
        if ((++sp & 255u) == 0u) { if (xb_ld(&bar[XB_TMO])) break; if (sp > XB_SPIN_CAP) { atomicAdd(&bar[XB_TMO], 1u); break; } }
    }
    nloc = mine > 0u ? mine : 1u; nx = cnt > 0u ? cnt : 1u;
}
DI void xcd_barrier(const XcdBarrier& b, const int wave_id) {
    asm volatile("s_waitcnt vmcnt(0)" ::: "memory");
    __syncthreads();
    if (wave_id == 0 && lane_id() == 0) {
        unsigned* bar = b.bar;
        __builtin_amdgcn_s_waitcnt(0);
        unsigned nloc = b.st[0], nx = b.st[1];
        if (nloc == 0u) { xcd_barrier_complete(bar, b.x, nloc, nx); b.st[0] = nloc; b.st[1] = nx; }
        const unsigned old = xb_add(&bar[XB_XSUB(b.x)], 1u);
        const unsigned gen = old / nloc;
        if (old + 1u == (gen + 1u) * nloc) {
            __builtin_amdgcn_fence(__ATOMIC_RELEASE, "agent");
            asm volatile("s_waitcnt vmcnt(0)" ::: "memory");
            const unsigned og = xb_add(&bar[XB_TOP], 1u);
            const unsigned tg = og / nx;
            if (og + 1u == (tg + 1u) * nx) xb_add(&bar[XB_TOPGEN], 1u);
            else XB_SPIN(xb_ld(&bar[XB_TOPGEN]) == tg, bar);
            __builtin_amdgcn_fence(__ATOMIC_ACQUIRE, "agent");
            xb_add(&bar[XB_XGEN(b.x)], 1u);
            asm volatile("s_waitcnt vmcnt(0)" ::: "memory");
        } else {
            XB_SPIN(xb_ld(&bar[XB_XGEN(b.x)]) == gen, bar);
            __builtin_amdgcn_fence(__ATOMIC_ACQUIRE, "agent");
            asm volatile("s_waitcnt vmcnt(0)" ::: "memory");
        }
    }
    __syncthreads();
}

namespace pg8 {
#define PG8_LAS __attribute__((address_space(3)))
typedef unsigned short bf16_t;
typedef short bf16x8 __attribute__((ext_vector_type(8)));
typedef float f32x4 __attribute__((ext_vector_type(4)));
typedef unsigned u32x4 __attribute__((ext_vector_type(4)));
constexpr int BM = 256, BK = 64, HALF = 128, HTB = HALF * BK * 2  , STAGE_BYTES = 8 * HTB, NXCD = 8, WGM = 8;

__host__ __device__ __forceinline__ int lds_byte(int r, int c) { const int st = (r >> 4) * 2 + (c >> 5), rr = r & 15, cc = c & 31, ob = rr * 64 + cc * 2; return st * 1024 + (ob ^ (((ob >> 9) & 1) << 5)); }
__host__ __device__ __forceinline__ void stage_rc(int b, int& R, int& C) { const int st = b / 1024, sb = b % 1024, swz = sb ^ (((sb >> 9) & 1) << 5); R = (st >> 1) * 16 + swz / 64; C = (st & 1) * 32 + (swz % 64) / 2; }
__host__ __device__ __forceinline__ int perm32(int rho) { const int n = rho >> 4, i = rho & 15; return 8 * (i >> 2) + 4 * n + (i & 3); }

struct Unit { int pm, pn; };
struct Gemm { const bf16_t* A; const bf16_t* Bt; int M, N, K; };

struct StaticOrder {
    int nM, nN, nwg, G, c;
    __host__ __device__ void init(int M, int N, int G_, int c_) { nM = M / BM; nN = N / BM; nwg = nM * nN; G = G_; c = c_; }
    __host__ __device__ bool next(int i, Unit& u) const {
        const long L = (long)i * G + c; if (L >= nwg) return false;
        int wgid = (int)L; { const int q = nwg / NXCD, r = nwg % NXCD, xcd = wgid % NXCD, off = wgid / NXCD; wgid = (xcd < r ? xcd * (q + 1) : r * (q + 1) + (xcd - r) * q) + off; }
        const int nig = WGM * nN, gid = wgid / nig, fm = gid * WGM, gsz = (nM - fm) < WGM ? (nM - fm) : WGM;
        u.pm = fm + ((wgid % nig) % gsz); u.pn = (wgid % nig) / gsz; return true;
    }
    __device__ __forceinline__ void a_ready(const Unit&) const {}
    __device__ __forceinline__ void done(const Unit&) const {}
};

__device__ __forceinline__ unsigned cvt_pk_bf16(float lo, float hi) { unsigned r; asm volatile("v_cvt_pk_bf16_f32 %0, %1, %2" : "=v"(r) : "v"(lo), "v"(hi)); return r; }
__device__ __forceinline__ float rstd16(const float* part, int r) {
    const f32x4* p = (const f32x4*)(part + (size_t)r * 16);
    const f32x4 a = p[0], b = p[1], c = p[2], d = p[3];
    const float s = ((a[0] + a[1]) + (a[2] + a[3])) + ((b[0] + b[1]) + (b[2] + b[3])) + ((c[0] + c[1]) + (c[2] + c[3])) + ((d[0] + d[1]) + (d[2] + d[3]));
    return 1.f / sqrtf(s * (1.f / 1024.f) + 1e-6f);
}
__device__ __forceinline__ u32x4 pack8(const f32x4 a, const f32x4 b) { u32x4 w; w.x = cvt_pk_bf16(a[0], a[1]); w.y = cvt_pk_bf16(a[2], a[3]); w.z = cvt_pk_bf16(b[0], b[1]); w.w = cvt_pk_bf16(b[2], b[3]); return w; }
#define rot(t1, t2, c, s) do { const float a_ = (t1) * (c) - (t2) * (s), b_ = (t1) * (s) + (t2) * (c); (t1) = a_; (t2) = b_; } while (0)

struct EpiProj {
    static constexpr bool PERM = true, AFTER_DRAIN = false;
    bf16_t* R; const float* part; const float* rope;
    __device__ __forceinline__ void operator()(const f32x4 (&acc)[2][2][4][2], const Unit& u, int wr, int wc, int fr, int fq) const {
        const int type = u.pn >> 1, hg = u.pn & 1;
        const int colbase = type * 512 + (4 * hg + wc) * 64 + 8 * fq;
        const bool do_rope = (type == 3) || (type == 4);
#pragma unroll
        for (int ai = 0; ai < 2; ++ai)
#pragma unroll
            for (int m = 0; m < 4; ++m) {
                const int r = u.pm * BM + ai * HALF + wr * 64 + m * 16 + fr;
                const float rs = rstd16(part, r);
                f32x4 a0 = acc[ai][0][m][0] * rs, a1 = acc[ai][0][m][1] * rs, b0 = acc[ai][1][m][0] * rs, b1 = acc[ai][1][m][1] * rs;
                if (do_rope) {
                    const f32x4* rp = (const f32x4*)(rope + ((size_t)(r & 2047) * 32 + 8 * fq) * 2);
                    const f32x4 c0 = rp[0], c1 = rp[1], c2 = rp[2], c3 = rp[3];
                    rot(a0[0], b0[0], c0[0], c0[1]); rot(a0[1], b0[1], c0[2], c0[3]); rot(a0[2], b0[2], c1[0], c1[1]); rot(a0[3], b0[3], c1[2], c1[3]);
                    rot(a1[0], b1[0], c2[0], c2[1]); rot(a1[1], b1[1], c2[2], c2[3]); rot(a1[2], b1[2], c3[0], c3[1]); rot(a1[3], b1[3], c3[2], c3[3]);
                }
                bf16_t* rowp = R + (size_t)r * 3584 + colbase;
                *(u32x4*)(rowp) = pack8(a0, a1);
                *(u32x4*)(rowp + 32) = pack8(b0, b1);
            }
    }
};
struct EpiRes {
    static constexpr bool PERM = true, AFTER_DRAIN = false;
    const float* base; float* out; bf16_t* hb; float* part; const float* bias;
    __device__ __forceinline__ void operator()(const f32x4 (&acc)[2][2][4][2], const Unit& u, int wr, int wc, int fr, int fq) const {
        const int col0 = u.pn * BM + wc * 32 + 8 * fq;
        f32x4 bv[2][2];
#pragma unroll
        for (int bj = 0; bj < 2; ++bj)
#pragma unroll
            for (int n = 0; n < 2; ++n) bv[bj][n] = bias ? *(const f32x4*)(bias + col0 + bj * HALF + 4 * n) : (f32x4){0.f, 0.f, 0.f, 0.f};
#pragma unroll
        for (int ai = 0; ai < 2; ++ai)
#pragma unroll
            for (int m = 0; m < 4; ++m) {
                const int r = u.pm * BM + ai * HALF + wr * 64 + m * 16 + fr;
                const size_t off = (size_t)r * 1024 + col0;
                float ss = 0.f;
#pragma unroll
                for (int bj = 0; bj < 2; ++bj) {
                    const f32x4 x0 = *(const f32x4*)(base + off + bj * HALF), x1 = *(const f32x4*)(base + off + bj * HALF + 4);
                    const f32x4 h0 = x0 + acc[ai][bj][m][0] + bv[bj][0], h1 = x1 + acc[ai][bj][m][1] + bv[bj][1];
                    *(f32x4*)(out + off + bj * HALF) = h0; *(f32x4*)(out + off + bj * HALF + 4) = h1;
                    *(u32x4*)(hb + off + bj * HALF) = pack8(h0, h1);
                    ss += (h0[0] * h0[0] + h0[1] * h0[1]) + (h0[2] * h0[2] + h0[3] * h0[3]) + (h1[0] * h1[0] + h1[1] * h1[1]) + (h1[2] * h1[2] + h1[3] * h1[3]);
                }
                ss += __shfl_xor(ss, 16); ss += __shfl_xor(ss, 32);
                if (fq == 0) part[(size_t)r * 16 + 4 * u.pn + wc] = ss;
            }
    }
};
struct EpiQ {
    static constexpr bool PERM = true, AFTER_DRAIN = false;
    bf16_t* O; const float* part;
    __device__ __forceinline__ void operator()(const f32x4 (&acc)[2][2][4][2], const Unit& u, int wr, int wc, int fr, int fq) const {
        const int col0 = u.pn * BM + wc * 32 + 8 * fq;
#pragma unroll
        for (int ai = 0; ai < 2; ++ai)
#pragma unroll
            for (int m = 0; m < 4; ++m) {
                const int r = u.pm * BM + ai * HALF + wr * 64 + m * 16 + fr;
                const float rs = rstd16(part, r);
                bf16_t* rowp = O + (size_t)r * 1024 + col0;
#pragma unroll
                for (int bj = 0; bj < 2; ++bj) *(u32x4*)(rowp + bj * HALF) = pack8(acc[ai][bj][m][0] * rs, acc[ai][bj][m][1] * rs);
            }
    }
};
struct EpiGlu {
    static constexpr bool PERM = true, AFTER_DRAIN = false;
    bf16_t* G; const float* part; const float* b1;
    __device__ __forceinline__ void operator()(const f32x4 (&acc)[2][2][4][2], const Unit& u, int wr, int wc, int fr, int fq) const {
        const int col = u.pn * 128 + wc * 32 + 8 * fq;
        f32x4 ba[2], bg[2];
#pragma unroll
        for (int n = 0; n < 2; ++n) { ba[n] = *(const f32x4*)(b1 + col + 4 * n); bg[n] = *(const f32x4*)(b1 + 1024 + col + 4 * n); }
#pragma unroll
        for (int ai = 0; ai < 2; ++ai)
#pragma unroll
            for (int m = 0; m < 4; ++m) {
                const int r = u.pm * BM + ai * HALF + wr * 64 + m * 16 + fr;
                const float rs = rstd16(part, r);
                f32x4 y[2];
#pragma unroll
                for (int n = 0; n < 2; ++n) {
                    const f32x4 a = acc[ai][0][m][n] * rs + ba[n], g = acc[ai][1][m][n] * rs + bg[n];
#pragma unroll
                    for (int i = 0; i < 4; ++i) y[n][i] = a[i] / (1.f + __expf(-g[i]));
                }
                *(u32x4*)(G + (size_t)r * 1024 + col) = pack8(y[0], y[1]);
            }
    }
};
template <class Epi, class Sched, bool ALIGN_EPI = false, bool SP2 = false>
__device__ __forceinline__ void gemm_phase(PG8_LAS unsigned char* lds, const Gemm g, const Sched& S, const Epi& E, const int wave_id) {
    const int lane = lane_id(), wid = wave_id, tid = wid * 64 + lane, wr = wid >> 2, wc = wid & 3, fr = lane & 15, fq = lane >> 4;
    const int K = g.K, nt = K / BK;
    unsigned voffA[2], voffB[2];
#pragma unroll
    for (int i = 0; i < 2; ++i) { int R, C; stage_rc(tid * 16 + i * 8192, R, C); const int Rb = Epi::PERM ? ((R & ~31) + perm32(R & 31)) : R;
        voffA[i] = (unsigned)(R * K + C) * 2u; voffB[i] = (unsigned)(Rb * K + C) * 2u; }
    const size_t kstep = (size_t)(BK * 2);
    const size_t hstep = (size_t)HALF * K * 2;
    const size_t tstep = 2 * hstep;
    const unsigned ldsw = (unsigned)wid * 1024u;
    const int aoff = lds_byte(wr * 64 + fr, fq * 8), boff = lds_byte(wc * 32 + fr, fq * 8);
#define PG8_SA(b, h) (((b) * 2 + (h)) * HTB)
#define PG8_SB(b, h) ((4 + (b) * 2 + (h)) * HTB)
#define PG8_STAGE(bufoff, gbase, voff) do { _Pragma("unroll") for (int _i = 0; _i < 2; ++_i) \
        __builtin_amdgcn_global_load_lds((const unsigned*)((const char*)(gbase) + (voff)[_i]), (PG8_LAS unsigned*)(lds + (bufoff) + ldsw + _i * 8192), 16, 0, 0); } while (0)
#define PG8_LDA(dst, b, h) do { _Pragma("unroll") for (int m = 0; m < 4; ++m) _Pragma("unroll") for (int k = 0; k < 2; ++k) dst[m][k] = *(const PG8_LAS bf16x8*)(lds + PG8_SA(b, h) + aoff + m * 2048 + k * 1024); } while (0)
#define PG8_LDB(dst, b, h) do { _Pragma("unroll") for (int n = 0; n < 2; ++n) _Pragma("unroll") for (int k = 0; k < 2; ++k) dst[n][k] = *(const PG8_LAS bf16x8*)(lds + PG8_SB(b, h) + boff + n * 2048 + k * 1024); } while (0)
#define PG8_MMA(ai, bj, At, Bt) do { __builtin_amdgcn_s_setprio(1); _Pragma("unroll") for (int m = 0; m < 4; ++m) _Pragma("unroll") for (int n = 0; n < 2; ++n) _Pragma("unroll") for (int k = 0; k < 2; ++k) \
        acc[ai][bj][m][n] = __builtin_amdgcn_mfma_f32_16x16x32_bf16(Bt[n][k], At[m][k], acc[ai][bj][m][n], 0, 0, 0); __builtin_amdgcn_s_setprio(0); } while (0)
#define PG8_WAIT_V(n) asm volatile("s_waitcnt vmcnt(" #n ")" ::: "memory")
#define PG8_WAIT_L(n) asm volatile("s_waitcnt lgkmcnt(" #n ")" ::: "memory")
#define PG8_BAR __builtin_amdgcn_s_barrier()
#define PG8_SCHED __builtin_amdgcn_sched_barrier(0)
    Unit cur, nxt; int ui = 0;
    if (!S.next(0, cur)) return;
    f32x4 acc[2][2][4][2];
#pragma unroll
    for (int a = 0; a < 2; ++a)
#pragma unroll
        for (int b = 0; b < 2; ++b)
#pragma unroll
            for (int m = 0; m < 4; ++m)
#pragma unroll
                for (int n = 0; n < 2; ++n) acc[a][b][m][n] = (f32x4){0.f, 0.f, 0.f, 0.f};
    bf16x8 At[4][2], B0[2][2], B1[2][2];
    const char* cA = (const char*)g.A + (size_t)cur.pm * tstep; const char* cB = (const char*)g.Bt + (size_t)cur.pn * tstep;
    S.a_ready(cur);
    if constexpr (SP2) {
        PG8_STAGE(PG8_SB(0, 0), cB, voffB); PG8_STAGE(PG8_SB(0, 1), cB + hstep, voffB); PG8_STAGE(PG8_SA(0, 0), cA, voffA); PG8_STAGE(PG8_SA(0, 1), cA + hstep, voffA);
        if (wr == 1) PG8_BAR;
        PG8_WAIT_V(2); PG8_BAR;
        PG8_STAGE(PG8_SB(1, 0), cB + kstep, voffB); PG8_STAGE(PG8_SA(1, 0), cA + kstep, voffA); PG8_STAGE(PG8_SB(1, 1), cB + hstep + kstep, voffB);
        PG8_WAIT_V(6); PG8_BAR;
    } else {
        PG8_STAGE(PG8_SB(0, 0), cB, voffB); PG8_STAGE(PG8_SA(0, 0), cA, voffA); PG8_STAGE(PG8_SB(0, 1), cB + hstep, voffB); PG8_STAGE(PG8_SA(0, 1), cA + hstep, voffA);
        if (wr == 1) PG8_BAR;
        PG8_WAIT_V(4); PG8_BAR;
        PG8_STAGE(PG8_SB(1, 0), cB + kstep, voffB); PG8_STAGE(PG8_SA(1, 0), cA + kstep, voffA); PG8_STAGE(PG8_SB(1, 1), cB + hstep + kstep, voffB);
        PG8_WAIT_V(6); PG8_BAR;
    }
    for (;;) {
        const bool has_next = S.next(ui + 1, nxt);
        const char* nA = has_next ? (const char*)g.A + (size_t)nxt.pm * tstep : cA; const char* nB = has_next ? (const char*)g.Bt + (size_t)nxt.pn * tstep : cB;
        for (int t = 0; t < nt; t += 2) {
            const bool last = (t == nt - 2);
            const char* a1 = cA + (size_t)(t + 1) * kstep;
            const char* a2 = last ? nA : cA + (size_t)(t + 2) * kstep; const char* b2 = last ? nB : cB + (size_t)(t + 2) * kstep;
            const char* a3 = a2 + kstep; const char* b3 = b2 + kstep;
            if (last && has_next) S.a_ready(nxt);
            if constexpr (SP2) {
            PG8_LDB(B0, 0, 0); PG8_LDB(B1, 0, 1); PG8_SCHED; PG8_LDA(At, 0, 0); PG8_STAGE(PG8_SA(1, 1), a1 + hstep, voffA);
            PG8_WAIT_V(8); PG8_WAIT_L(0); PG8_BAR; PG8_MMA(0, 0, At, B0); PG8_MMA(0, 1, At, B1); PG8_BAR; PG8_SCHED;
            PG8_LDA(At, 0, 1); PG8_STAGE(PG8_SB(0, 0), b2, voffB); PG8_STAGE(PG8_SB(0, 1), b2 + hstep, voffB); PG8_STAGE(PG8_SA(0, 0), a2, voffA);
            PG8_WAIT_V(8); PG8_WAIT_L(0); PG8_BAR; PG8_MMA(1, 0, At, B0); PG8_MMA(1, 1, At, B1); PG8_BAR; PG8_SCHED;
            PG8_LDB(B0, 1, 0); PG8_LDB(B1, 1, 1); PG8_SCHED; PG8_LDA(At, 1, 0); PG8_STAGE(PG8_SA(0, 1), a2 + hstep, voffA);
            PG8_WAIT_V(8); PG8_WAIT_L(0); PG8_BAR; PG8_MMA(0, 0, At, B0); PG8_MMA(0, 1, At, B1); PG8_BAR; PG8_SCHED;
            PG8_LDA(At, 1, 1); PG8_STAGE(PG8_SB(1, 0), b3, voffB); PG8_STAGE(PG8_SB(1, 1), b3 + hstep, voffB); PG8_STAGE(PG8_SA(1, 0), a3, voffA);
            PG8_WAIT_V(8); PG8_WAIT_L(0); PG8_BAR; PG8_MMA(1, 0, At, B0); PG8_MMA(1, 1, At, B1); PG8_BAR; PG8_SCHED;
            } else {
            PG8_LDB(B0, 0, 0); PG8_SCHED; PG8_LDA(At, 0, 0); PG8_STAGE(PG8_SA(1, 1), a1 + hstep, voffA);
            PG8_WAIT_L(8); PG8_BAR; PG8_WAIT_L(0); PG8_MMA(0, 0, At, B0); PG8_BAR; PG8_SCHED;
            PG8_LDB(B1, 0, 1); PG8_STAGE(PG8_SB(0, 0), b2, voffB);
            PG8_BAR; PG8_WAIT_L(0); PG8_MMA(0, 1, At, B1); PG8_BAR;
            PG8_LDA(At, 0, 1); PG8_STAGE(PG8_SA(0, 0), a2, voffA);
            PG8_BAR; PG8_WAIT_L(0); PG8_MMA(1, 0, At, B0); PG8_BAR; PG8_SCHED;
            PG8_STAGE(PG8_SB(0, 1), b2 + hstep, voffB);
            PG8_WAIT_V(6); PG8_BAR; PG8_MMA(1, 1, At, B1); PG8_BAR;
            PG8_LDB(B0, 1, 0); PG8_SCHED; PG8_LDA(At, 1, 0); PG8_STAGE(PG8_SA(0, 1), a2 + hstep, voffA);
            PG8_WAIT_L(8); PG8_BAR; PG8_WAIT_L(0); PG8_MMA(0, 0, At, B0); PG8_BAR; PG8_SCHED;
            PG8_LDB(B1, 1, 1); PG8_STAGE(PG8_SB(1, 0), b3, voffB);
            PG8_BAR; PG8_WAIT_L(0); PG8_MMA(0, 1, At, B1); PG8_BAR;
            PG8_LDA(At, 1, 1); PG8_STAGE(PG8_SA(1, 0), a3, voffA);
            PG8_BAR; PG8_WAIT_L(0); PG8_MMA(1, 0, At, B0); PG8_BAR; PG8_SCHED;
            PG8_STAGE(PG8_SB(1, 1), b3 + hstep, voffB);
            PG8_WAIT_V(6); PG8_BAR; PG8_MMA(1, 1, At, B1); PG8_BAR;
            }
        }
        if constexpr (ALIGN_EPI) { if (wr == 0) PG8_BAR; }
        if constexpr (!Epi::AFTER_DRAIN) { E(acc, cur, wr, wc, fr, fq); S.done(cur); }
        if (!has_next) break;
#pragma unroll
        for (int a = 0; a < 2; ++a)
#pragma unroll
            for (int b = 0; b < 2; ++b)
#pragma unroll
                for (int m = 0; m < 4; ++m)
#pragma unroll
                    for (int n = 0; n < 2; ++n) acc[a][b][m][n] = (f32x4){0.f, 0.f, 0.f, 0.f};
        cur = nxt; cA = nA; cB = nB; ++ui;
        if constexpr (ALIGN_EPI) { if (wr == 1) PG8_BAR; }
    }
    PG8_WAIT_V(0);
    if constexpr (!ALIGN_EPI) { if (wr == 0) PG8_BAR; }
    PG8_BAR;
    if constexpr (Epi::AFTER_DRAIN) { E.fused(acc, cur, wr, wc, fr, fq, lds, wid, lane); S.done(cur); }
#undef PG8_SA
#undef PG8_SB
#undef PG8_STAGE
#undef PG8_LDA
#undef PG8_LDB
#undef PG8_MMA
#undef PG8_WAIT_V
#undef PG8_WAIT_L
#undef PG8_BAR
#undef PG8_SCHED
}
}

struct Frame {
    LAS unsigned char* lds;
    int wave, G, bid;
    const float *x, *mix_norm, *ffn_norm, *final_norm, *w_in, *w_out, *rel_bias, *conv_w1, *conv_b1, *conv_dw, *conv_dw_b, *conv_ln_g, *conv_ln_b, *conv_w2, *conv_b2,
        *peer_wq, *peer_keys, *peer_u, *peer_v;
    float* out;
    unsigned char* ws;
};
#define FRAME_IDS const int f_lane = lane_id(); const int f_tid = F.wave * 64 + f_lane; (void)f_tid
DI float gamma_of(int h) { return 1.f - exp2f(-5.f - (float)h); }

DI void p0_prep(Frame& F) {
    FRAME_IDS;
    const int gw = F.bid * NWAVES + F.wave, NGW = F.G * NWAVES;
    f32x2* rope = (f32x2*)(F.ws + WS_ROPE);
    for (int i = F.bid * NTHR + f_tid; i < SEQ * 32; i += F.G * NTHR) {
        const int s = i >> 5, j = i & 31;
        const float inv = powf(10000.f, -(float)j / 32.f);
        const float ang = (float)s * inv;
        float sn, cs; sincosf(ang, &sn, &cs);
        rope[i] = (f32x2){cs, sn};
    }
    bf16* xb = (bf16*)(F.ws + WS_XB); float* part = (float*)(F.ws + WS_PART);
    for (int m = gw; m < T; m += NGW) {
        const f32x4* xr = (const f32x4*)(F.x + (size_t)m * DM) + f_lane;
        u32x2* o = (u32x2*)(xb + (size_t)m * DM) + f_lane;
        float s = 0.f;
#pragma unroll
        for (int j = 0; j < 4; ++j) { const f32x4 v = xr[64 * j]; s += v.x * v.x + v.y * v.y + v.z * v.z + v.w * v.w; o[64 * j] = (u32x2){pk2(v.x, v.y), pk2(v.z, v.w)}; }
        s = wave_sum(s);
        if (f_lane < 16) part[(size_t)m * 16 + f_lane] = (f_lane == 0) ? s : 0.f;
    }
}
DI void p0_transpose_item(const float* W, int K, int N, bf16* WT, int prow0, const float* gain, float scale, LAS float* scr, int k0, int n0, int lane) {
#pragma unroll 8
    for (int i = 0; i < 32; ++i) { const int kk = 2 * i + (lane >> 5); scr[kk * 33 + (lane & 31)] = W[(size_t)(k0 + kk) * N + n0 + (lane & 31)] * (gain ? gain[k0 + kk] : 1.f) * scale; }
    asm volatile("s_waitcnt lgkmcnt(0)" ::: "memory");
    const int c = lane & 7;
#pragma unroll
    for (int j = 0; j < 4; ++j) { const int n = (lane >> 3) + 8 * j; const LAS float* q = scr + (8 * c) * 33 + n;
        u32x4 o; o.x = pk2(q[0 * 33], q[1 * 33]); o.y = pk2(q[2 * 33], q[3 * 33]); o.z = pk2(q[4 * 33], q[5 * 33]); o.w = pk2(q[6 * 33], q[7 * 33]);
        *(u32x4*)(WT + (size_t)(prow0 + n) * K + k0 + 8 * c) = o; }
    asm volatile("s_waitcnt lgkmcnt(0)" ::: "memory");
}
DI void p0_weights(Frame& F) {
    FRAME_IDS;
    LAS float* scr = (LAS float*)(F.lds + F.wave * 16384);
    const int gw = F.bid * NWAVES + F.wave, NGW = F.G * NWAVES;
    constexpr int I_IN = 16 * (INC / 32), I_SQ = 16 * (DM / 32), I_W1 = 16 * (2 * DM / 32);
    constexpr int NITEMS = I_IN + I_SQ + I_W1 + I_SQ + 2 * I_SQ;
    for (int it = gw; it < NITEMS; it += NGW) {
        int r = it;
        if (r < I_IN) { const int nb = r % (INC / 32), kb = r / (INC / 32), n0 = nb * 32;
            const int type = n0 / 512, head = (n0 % 512) / 64, bj = (n0 % 64) / 32;
            const int prow0 = 256 * (2 * type + head / 4) + 128 * bj + 32 * (head % 4);
            p0_transpose_item(F.w_in, DM, INC, (bf16*)(F.ws + WS_WIN), prow0, F.mix_norm, (type == 0 || type == 4) ? 0.125f : 1.f, scr, kb * 64, n0, f_lane); continue; }
        r -= I_IN;
        if (r < I_SQ) { const int nb = r % 32, kb = r / 32; p0_transpose_item(F.w_out, DM, DM, (bf16*)(F.ws + WS_WOUT), nb * 32, nullptr, 1.f, scr, kb * 64, nb * 32, f_lane); continue; }
        r -= I_SQ;
        if (r < I_W1) { const int nb = r % 64, kb = r / 64, n0 = nb * 32; const int bj = n0 / 1024, rem = n0 % 1024;
            p0_transpose_item(F.conv_w1, DM, 2 * DM, (bf16*)(F.ws + WS_W1), 256 * (rem / 128) + 128 * bj + (rem % 128), F.mix_norm + DM, 1.f, scr, kb * 64, n0, f_lane); continue; }
        r -= I_W1;
        if (r < I_SQ) { const int nb = r % 32, kb = r / 32; p0_transpose_item(F.conv_w2, DM, DM, (bf16*)(F.ws + WS_W2), nb * 32, nullptr, 1.f, scr, kb * 64, nb * 32, f_lane); continue; }
        r -= I_SQ;
        { const int layer = r / I_SQ; r %= I_SQ; const int nb = r % 32, kb = r / 32;
          p0_transpose_item(F.peer_wq + (size_t)layer * DM * DM, DM, DM, (bf16*)(F.ws + WS_WQ) + (size_t)layer * DM * DM, nb * 32, F.ffn_norm + layer * DM, 1.f, scr, kb * 64, nb * 32, f_lane); }
    }
}
DI float row_rstd(const float* part, int m) {
    const f32x4* p = (const f32x4*)(part + (size_t)m * 16);
    const f32x4 a = p[0], b = p[1], c = p[2], d = p[3];
    const float s = ((a.x + a.y) + (a.z + a.w)) + ((b.x + b.y) + (b.z + b.w)) + ((c.x + c.y) + (c.z + c.w)) + ((d.x + d.y) + (d.z + d.w));
    return 1.f / sqrtf(s * (1.f / DM) + EPS);
}

typedef short v4i16 __attribute__((ext_vector_type(4)));
typedef __bf16 bf16x2_t __attribute__((ext_vector_type(2)));
DI unsigned cvtpk(float lo, float hi) { f32x2 v = {lo, hi}; bf16x2_t b = __builtin_convertvector(v, bf16x2_t); return __builtin_bit_cast(unsigned, b); }
DI v4i16 ds_tr16(LAS const unsigned char* p) { return __builtin_amdgcn_ds_read_tr16_b64_v4i16((LAS v4i16*)p); }
DI int crow(int r, int h) { return (r & 3) + 8 * (r >> 2) + 4 * h; }
DI bf16x8 pack_step(const f32x16& x, const int s) {
    u32x4 w = {cvtpk(x[8 * s + 0], x[8 * s + 1]), cvtpk(x[8 * s + 2], x[8 * s + 3]), cvtpk(x[8 * s + 4], x[8 * s + 5]), cvtpk(x[8 * s + 6], x[8 * s + 7])};
    return __builtin_bit_cast(bf16x8, w);
}
constexpr int AT_KB = 64 * 144, AT_VB = 8192, AT_BUF = AT_KB + AT_VB, AT_BIAS = 2 * AT_BUF;
DI void attn_item(Frame& F, const int it) {
    FRAME_IDS;
    const bf16* R = (const bf16*)(F.ws + WS_R); bf16* O = (bf16*)(F.ws + WS_O);
    LAS unsigned char* lds = F.lds;
    LAS float* bias_s = (LAS float*)(lds + AT_BIAS);
    const int q32 = f_lane & 31, h = f_lane >> 5, w = F.wave;
    const int srow = f_tid >> 3, sch = f_tid & 7;
    const int vtr_off = ((f_lane & 15) >> 2) * 64 + (16 * ((f_lane >> 4) & 1) + 4 * (f_lane & 3)) * 2;
    {
        const int b = it / (NHA * 8), hd = (it / 8) % NHA, c0 = (it % 8) * 4;
        const int c = c0 + (w >> 1), qrow0 = 32 * (w & 1);
        const size_t tq = (size_t)b * SEQ + c * 64 + qrow0 + q32;
        __syncthreads();
        for (int k = f_tid; k < 257; k += NTHR) bias_s[k] = F.rel_bias[hd * 257 + k];
        bf16x8 qf[4];
#pragma unroll
        for (int ks = 0; ks < 4; ++ks) qf[ks] = *(const bf16x8*)(R + tq * INC + C_QA + hd * 64 + 16 * ks + 8 * h);
        const int t_lo = c0 - 8 < 0 ? 0 : c0 - 8, t_hi = c0 + 3, ntile = t_hi - t_lo + 1;
        const bf16* kbase = R + ((size_t)b * SEQ + srow) * INC + C_KA + hd * 64 + 8 * sch;
        const bf16* vbase = R + ((size_t)b * SEQ + srow) * INC + C_VA + hd * 64 + 8 * sch;
        u32x4 kreg = *(const u32x4*)(kbase + (size_t)t_lo * 64 * INC), vreg = *(const u32x4*)(vbase + (size_t)t_lo * 64 * INC);
        *(LAS u32x4*)(lds + srow * 144 + sch * 16) = kreg;
        *(LAS u32x4*)(lds + AT_KB + (sch >> 2) * 4096 + srow * 64 + (sch & 3) * 16) = vreg;
        __syncthreads();
        const float bias_far = bias_s[256];
        float m = -1e30f, l = 0.f;
        f32x16 o0 = {}, o1 = {};
        for (int i = 0; i < ntile; ++i) {
            const int tc = t_lo + i;
            LAS unsigned char* kb = lds + (i & 1) * AT_BUF; LAS unsigned char* vb = kb + AT_KB;
            if (i + 1 < ntile) { kreg = *(const u32x4*)(kbase + (size_t)(tc + 1) * 64 * INC); vreg = *(const u32x4*)(vbase + (size_t)(tc + 1) * 64 * INC); }
            const int D = c - tc;
            if (D >= 0 && D <= 8) {
                const float init = D >= 3 ? bias_far : 0.f;
                f32x16 p0, p1;
#pragma unroll
                for (int r = 0; r < 16; ++r) { p0[r] = init; p1[r] = init; }
#pragma unroll
                for (int ks = 0; ks < 4; ++ks) {
                    const bf16x8 k0 = *(const LAS bf16x8*)(kb + q32 * 144 + (16 * ks + 8 * h) * 2);
                    const bf16x8 k1 = *(const LAS bf16x8*)(kb + (32 + q32) * 144 + (16 * ks + 8 * h) * 2);
                    p0 = __builtin_amdgcn_mfma_f32_32x32x16_bf16(k0, qf[ks], p0, 0, 0, 0);
                    p1 = __builtin_amdgcn_mfma_f32_32x32x16_bf16(k1, qf[ks], p1, 0, 0, 0);
                }
                if (D < 3) {
                    const int relb = D * 64 + qrow0 + q32 - 4 * h + 128;
#pragma unroll
                    for (int r = 0; r < 16; ++r) {
                        const int r0 = relb - ((r & 3) + 8 * (r >> 2));
                        const int i0 = r0 < 0 ? 0 : (r0 > 256 ? 256 : r0), r1 = r0 - 32, i1 = r1 < 0 ? 0 : (r1 > 256 ? 256 : r1);
                        p0[r] += bias_s[i0]; p1[r] += bias_s[i1];
                    }
                }
                float tm = fmaxf(p0[0], p1[0]);
#pragma unroll
                for (int r = 1; r < 16; ++r) tm = fmaxf(tm, fmaxf(p0[r], p1[r]));
                tm = fmaxf(tm, __shfl_xor(tm, 32));
                const float mn = fmaxf(m, tm), alpha = __expf(m - mn);
                m = mn;
                float ps = 0.f;
#pragma unroll
                for (int r = 0; r < 16; ++r) { p0[r] = __expf(p0[r] - mn); p1[r] = __expf(p1[r] - mn); ps += p0[r] + p1[r]; }
                l = l * alpha + ps;
#pragma unroll
                for (int r = 0; r < 16; ++r) { o0[r] *= alpha; o1[r] *= alpha; }
                bf16x8 pf[4];
                pf[0] = pack_step(p0, 0); pf[1] = pack_step(p0, 1); pf[2] = pack_step(p1, 0); pf[3] = pack_step(p1, 1);
#pragma unroll
                for (int kk = 0; kk < 4; ++kk) {
                    const int key0 = 16 * kk + 4 * h;
                    const v4i16 a0l = ds_tr16(vb + key0 * 64 + vtr_off), a0h = ds_tr16(vb + (key0 + 8) * 64 + vtr_off);
                    const v4i16 a1l = ds_tr16(vb + 4096 + key0 * 64 + vtr_off), a1h = ds_tr16(vb + 4096 + (key0 + 8) * 64 + vtr_off);
                    const bf16x8 a0 = __builtin_shufflevector(a0l, a0h, 0, 1, 2, 3, 4, 5, 6, 7), a1 = __builtin_shufflevector(a1l, a1h, 0, 1, 2, 3, 4, 5, 6, 7);
                    o0 = __builtin_amdgcn_mfma_f32_32x32x16_bf16(a0, pf[kk], o0, 0, 0, 0);
                    o1 = __builtin_amdgcn_mfma_f32_32x32x16_bf16(a1, pf[kk], o1, 0, 0, 0);
                }
            }
            if (i + 1 < ntile) {
                LAS unsigned char* nb = lds + ((i + 1) & 1) * AT_BUF;
                *(LAS u32x4*)(nb + srow * 144 + sch * 16) = kreg;
                *(LAS u32x4*)(nb + AT_KB + (sch >> 2) * 4096 + srow * 64 + (sch & 3) * 16) = vreg;
            }
            __syncthreads();
        }
        l += __shfl_xor(l, 32);
        const float inv = 1.f / l;
        bf16* op = O + tq * DM + hd * 64 + 4 * h;
#pragma unroll
        for (int g = 0; g < 4; ++g) {
            *(u32x2*)(op + 8 * g) = (u32x2){cvtpk(o0[4 * g] * inv, o0[4 * g + 1] * inv), cvtpk(o0[4 * g + 2] * inv, o0[4 * g + 3] * inv)};
            *(u32x2*)(op + 32 + 8 * g) = (u32x2){cvtpk(o1[4 * g] * inv, o1[4 * g + 1] * inv), cvtpk(o1[4 * g + 2] * inv, o1[4 * g + 3] * inv)};
        }
    }
    __syncthreads();
}

constexpr int RT_Q = 0, RT_K = 9216, RT_KD = 18432, RT_V = 26624, RT_BUF = 34816, RT_ZS = 2 * RT_BUF, RT_CS = RT_ZS + 64 * 66 * 4;
DI void ret_item(Frame& F, const int it) {
    FRAME_IDS;
    const bf16* R = (const bf16*)(F.ws + WS_R); bf16* O = (bf16*)(F.ws + WS_O);
    LAS unsigned char* lds = F.lds;
    LAS float* Zs = (LAS float*)(lds + RT_ZS); LAS float* Cs = (LAS float*)(lds + RT_CS);
    const int b = it / NHB, hd = it % NHB;
    const int q32 = f_lane & 31, h = f_lane >> 5, w = F.wave;
    const int role = w >> 2, itile = (w >> 1) & 1, etile = w & 1;
    const int srow = f_tid >> 3, sch = f_tid & 7;
    const int vtr_off = ((f_lane & 15) >> 2) * 64 + (16 * ((f_lane >> 4) & 1) + 4 * (f_lane & 3)) * 2;
    const float l2g = log2f(gamma_of(hd));
    const float cd = exp2f(l2g * 64.f), sdec = exp2f(l2g * (float)(63 - srow));
    float qdv[16];
#pragma unroll
    for (int r = 0; r < 16; ++r) qdv[r] = exp2f(l2g * (float)(32 * itile + crow(r, h) + 1));
    f32x16 xs0 = {}, xs1 = {};
    const size_t trow0 = (size_t)b * SEQ;
    const bf16* gq = R + (trow0 + srow) * INC + hd * 64 + 8 * sch;
    u32x4 qreg = *(const u32x4*)(gq + C_QB), kreg = *(const u32x4*)(gq + C_KB), vreg = *(const u32x4*)(gq + C_VB);
    __syncthreads();
#define RT_STAGE(bufp) do { LAS unsigned char* bp_ = (bufp); \
        *(LAS u32x4*)(bp_ + RT_Q + srow * 144 + sch * 16) = qreg; *(LAS u32x4*)(bp_ + RT_K + srow * 144 + sch * 16) = kreg; \
        *(LAS u32x4*)(bp_ + RT_V + (sch >> 2) * 4096 + srow * 64 + (sch & 3) * 16) = vreg; \
        u32x4 kd_; \
        _Pragma("unroll") for (int e_ = 0; e_ < 4; ++e_) kd_[e_] = cvtpk(__uint_as_float(kreg[e_] << 16) * sdec, __uint_as_float(kreg[e_] & 0xffff0000u) * sdec); \
        *(LAS u32x4*)(bp_ + RT_KD + (sch >> 2) * 4096 + srow * 64 + (sch & 3) * 16) = kd_; } while (0)
    RT_STAGE(lds);
    __syncthreads();
    for (int n = 0; n < NCH; ++n) {
        LAS unsigned char* bp = lds + (n & 1) * RT_BUF;
        if (n + 1 < NCH) { const bf16* g1 = gq + (size_t)(n + 1) * 64 * INC; qreg = *(const u32x4*)(g1 + C_QB); kreg = *(const u32x4*)(g1 + C_KB); vreg = *(const u32x4*)(g1 + C_VB); }
        unsigned short gr[8];
#pragma unroll
        for (int r = 0; r < 8; ++r) gr[r] = R[(trow0 + n * 64 + 8 * w + r) * INC + C_GB + hd * 64 + f_lane];
        if (role == 0) {
            bf16x8 qf[4];
#pragma unroll
            for (int ks = 0; ks < 4; ++ks) qf[ks] = *(const LAS bf16x8*)(bp + RT_Q + (32 * itile + q32) * 144 + (16 * ks + 8 * h) * 2);
            f32x16 st0 = {}, st1 = {};
#pragma unroll
            for (int ks = 0; ks < 4; ++ks) {
                const bf16x8 k0 = *(const LAS bf16x8*)(bp + RT_K + q32 * 144 + (16 * ks + 8 * h) * 2);
                const bf16x8 k1 = *(const LAS bf16x8*)(bp + RT_K + (32 + q32) * 144 + (16 * ks + 8 * h) * 2);
                st0 = __builtin_amdgcn_mfma_f32_32x32x16_bf16(k0, qf[ks], st0, 0, 0, 0);
                st1 = __builtin_amdgcn_mfma_f32_32x32x16_bf16(k1, qf[ks], st1, 0, 0, 0);
            }
            int iiv = 32 * itile + q32 - 4 * h; asm volatile("" : "+v"(iiv));
#pragma unroll
            for (int r = 0; r < 16; ++r) {
                const int dd = iiv - ((r & 3) + 8 * (r >> 2));
                st0[r] *= __builtin_amdgcn_exp2f(l2g * fabsf((float)dd));
                st1[r] *= __builtin_amdgcn_exp2f(l2g * fabsf((float)(dd - 32)));
            }
            f32x16 z = {};
#pragma unroll
            for (int kk = 0; kk < 4; ++kk) {
                const int key0 = 16 * kk + 4 * h;
                const v4i16 bl = ds_tr16(bp + RT_V + etile * 4096 + key0 * 64 + vtr_off), bh = ds_tr16(bp + RT_V + etile * 4096 + (key0 + 8) * 64 + vtr_off);
                const bf16x8 vb = __builtin_shufflevector(bl, bh, 0, 1, 2, 3, 4, 5, 6, 7);
                const bf16x8 xa = (kk < 2) ? pack_step(st0, kk & 1) : pack_step(st1, kk & 1);
                z = __builtin_amdgcn_mfma_f32_32x32x16_bf16(xa, vb, z, 0, 0, 0);
            }
            int zb = (32 * itile + 4 * h) * 66 + 32 * etile + q32; asm volatile("" : "+v"(zb));
#pragma unroll
            for (int r = 0; r < 16; ++r) Zs[zb + ((r & 3) + 8 * (r >> 2)) * 66] = z[r];
        } else {
            f32x16 cr = {};
#pragma unroll
            for (int kk = 0; kk < 4; ++kk) {
                const LAS unsigned char* qp = bp + RT_Q + (32 * itile + q32) * 144 + (16 * kk + 4 * h) * 2;
                const v4i16 al = *(const LAS v4i16*)qp, ah = *(const LAS v4i16*)(qp + 16);
                const bf16x8 qa = __builtin_shufflevector(al, ah, 0, 1, 2, 3, 4, 5, 6, 7);
                const bf16x8 xb = (kk < 2) ? pack_step(xs0, kk & 1) : pack_step(xs1, kk & 1);
                cr = __builtin_amdgcn_mfma_f32_32x32x16_bf16(qa, xb, cr, 0, 0, 0);
            }
            int cb = (32 * itile + 4 * h) * 66 + 32 * etile + q32; asm volatile("" : "+v"(cb));
#pragma unroll
            for (int r = 0; r < 16; ++r) Cs[cb + ((r & 3) + 8 * (r >> 2)) * 66] = cr[r] * qdv[r];
#pragma unroll
            for (int r = 0; r < 16; ++r) { xs0[r] *= cd; xs1[r] *= cd; }
#pragma unroll
            for (int s4 = 0; s4 < 4; ++s4) {
                const int key0 = 16 * s4 + 8 * h;
                const v4i16 vl = ds_tr16(bp + RT_V + etile * 4096 + key0 * 64 + vtr_off), vh = ds_tr16(bp + RT_V + etile * 4096 + (key0 + 4) * 64 + vtr_off);
                const bf16x8 vb = __builtin_shufflevector(vl, vh, 0, 1, 2, 3, 4, 5, 6, 7);
                const v4i16 a0l = ds_tr16(bp + RT_KD + key0 * 64 + vtr_off), a0h = ds_tr16(bp + RT_KD + (key0 + 4) * 64 + vtr_off);
                const v4i16 a1l = ds_tr16(bp + RT_KD + 4096 + key0 * 64 + vtr_off), a1h = ds_tr16(bp + RT_KD + 4096 + (key0 + 4) * 64 + vtr_off);
                const bf16x8 ka0 = __builtin_shufflevector(a0l, a0h, 0, 1, 2, 3, 4, 5, 6, 7), ka1 = __builtin_shufflevector(a1l, a1h, 0, 1, 2, 3, 4, 5, 6, 7);
                xs0 = __builtin_amdgcn_mfma_f32_32x32x16_bf16(ka0, vb, xs0, 0, 0, 0);
                xs1 = __builtin_amdgcn_mfma_f32_32x32x16_bf16(ka1, vb, xs1, 0, 0, 0);
            }
        }
        __syncthreads();
#pragma unroll
        for (int r = 0; r < 8; ++r) {
            const int i = 8 * w + r;
            const float v = Zs[i * 66 + f_lane] + Cs[i * 66 + f_lane];
            const float mu = wave_sum(v) * (1.f / 64.f);
            const float dv = v - mu;
            const float var = wave_sum(dv * dv) * (1.f / 64.f);
            const float g = bf2f(gr[r]);
            O[(trow0 + n * 64 + i) * DM + 512 + hd * 64 + f_lane] = (bf16)f2bf(dv * (1.f / sqrtf(var + EPS)) * (g / (1.f + __expf(-g))));
        }
        if (n + 1 < NCH) RT_STAGE(lds + ((n + 1) & 1) * RT_BUF);
        __syncthreads();
    }
#undef RT_STAGE
}
DI void mix_phase(Frame& F, const int rep) {
    FRAME_IDS;
    unsigned* ctr = (unsigned*)(F.ws + WS_CTL) + CW_QUEUE + 64 * rep;
    volatile LAS unsigned* slot = (volatile LAS unsigned*)(F.lds + MISC_OFF) + 16;
    for (;;) {
        __syncthreads();
        if (f_tid == 0) slot[0] = __hip_atomic_fetch_add(ctr, 1u, __ATOMIC_RELAXED, __HIP_MEMORY_SCOPE_AGENT);
        __syncthreads();
        const int idx = (int)slot[0];
        if (idx >= NB * NHB + NB * NHA * 8) break;
        if (idx < NB * NHB) ret_item(F, idx); else attn_item(F, idx - NB * NHB);
    }
}
DI float fmax_raw(float a, float b) { float r; asm("v_max_f32_e32 %0, %1, %2" : "=v"(r) : "v"(a), "v"(b)); return r; }
DI float fmin_raw(float a, float b) { float r; asm("v_min_f32_e32 %0, %1, %2" : "=v"(r) : "v"(a), "v"(b)); return r; }
#define CE_DESC(x, y) do { const float hi_ = fmax_raw((x), (y)), lo_ = fmin_raw((x), (y)); (x) = hi_; (y) = lo_; } while (0)
template <int N> DI void sort_desc(float* v) {
#pragma unroll
    for (int k = 2; k <= N; k <<= 1)
#pragma unroll
        for (int j = k >> 1; j > 0; j >>= 1)
#pragma unroll
            for (int i = 0; i < N; ++i) { const int l = i ^ j; if (l > i) { if ((i & k) == 0 || k == N) CE_DESC(v[i], v[l]); else CE_DESC(v[l], v[i]); } }
}
DI void merge16(float* a, const float* b) {
#pragma unroll
    for (int i = 0; i < 16; ++i) a[i] = fmax_raw(a[i], b[15 - i]);
#pragma unroll
    for (int j = 8; j > 0; j >>= 1)
#pragma unroll
        for (int i = 0; i < 16; ++i) { const int l = i ^ j; if (l > i) CE_DESC(a[i], a[l]); }
}
DI float key_pack(float v, unsigned keep_mask, unsigned idx) { return __uint_as_float((__float_as_uint(v) & keep_mask) | idx); }
DI void opt_route(Frame& F, int layer) {
    FRAME_IDS;
    const bf16* Q = (const bf16*)(F.ws + WS_Q);
    int* eidx = (int*)(F.ws + WS_EIDX); float* gate = (float*)(F.ws + WS_GATE);
    const float* keys = F.peer_keys + (size_t)layer * 2 * PK * 64;
    LAS unsigned char* kl = F.lds;
    __syncthreads();
    for (int idx = f_tid; idx < 2 * PK * 8; idx += NTHR) {
        const int row = idx >> 3, ch = idx & 7;
        const f32x4 a = *(const f32x4*)(keys + (size_t)row * 64 + ch * 8), b = *(const f32x4*)(keys + (size_t)row * 64 + ch * 8 + 4);
        *(LAS u32x4*)(kl + row * 144 + ch * 16) = (u32x4){pk2(a[0], a[1]), pk2(a[2], a[3]), pk2(b[0], b[1]), pk2(b[2], b[3])};
    }
    __syncthreads();
    LAS int* lut = (LAS int*)(F.lds + 40960 + F.wave * 8192);
    const int c = f_lane & 31, h = f_lane >> 5;
    const int gw = F.bid * NWAVES + F.wave, NGW = F.G * NWAVES;
    for (int task = gw; task < (T / 32) * PH; task += NGW) {
        const int tile = task >> 3, hh = task & 7, t = tile * 32 + c;
        float tk[2][16];
#pragma unroll
        for (int side = 0; side < 2; ++side) {
            bf16x8 qf[4];
#pragma unroll
            for (int ks = 0; ks < 4; ++ks) qf[ks] = *(const bf16x8*)(Q + (size_t)t * DM + hh * PQD + side * 64 + 16 * ks + 8 * h);
            float v[64];
#pragma unroll
            for (int kt = 0; kt < 4; ++kt) {
                f32x16 acc = {};
#pragma unroll
                for (int ks = 0; ks < 4; ++ks) {
                    const bf16x8 a = *(const LAS bf16x8*)(kl + (side * PK + 32 * kt + c) * 144 + (16 * ks + 8 * h) * 2);
                    acc = __builtin_amdgcn_mfma_f32_32x32x16_bf16(a, qf[ks], acc, 0, 0, 0);
                }
#pragma unroll
                for (int r = 0; r < 16; ++r) v[16 * kt + r] = key_pack(acc[r], 0xFFFFFF80u, (unsigned)(32 * kt + (r & 3) + 8 * (r >> 2) + 4 * h));
            }
            sort_desc<16>(v); sort_desc<16>(v + 16); sort_desc<16>(v + 32); sort_desc<16>(v + 48);
            merge16(v, v + 16); merge16(v + 32, v + 48); merge16(v, v + 32);
            float pr[16];
#pragma unroll
            for (int i = 0; i < 16; ++i) pr[i] = __shfl_xor(v[i], 32);
            merge16(v, pr);
#pragma unroll
            for (int i = 0; i < 16; ++i) { tk[side][i] = v[i]; lut[(side * 16 + i) * 64 + f_lane] = (int)(__float_as_uint(v[i]) & 0x7Fu); }
        }
        float cd[64];
        {   int n = 0;
#pragma unroll
            for (int a = 0; a < 16; ++a)
#pragma unroll
                for (int b = 0; b < 16; ++b) if ((a + 1) * (b + 1) <= 16) { cd[n] = key_pack(tk[0][a] + tk[1][b], 0xFFFFFF00u, (unsigned)(a * 16 + b)); ++n; }
#pragma unroll
            for (int i = 50; i < 64; ++i) cd[i] = -INFINITY;
        }
        sort_desc<16>(cd); sort_desc<16>(cd + 16); sort_desc<16>(cd + 32); CE_DESC(cd[48], cd[49]);
        merge16(cd, cd + 16); merge16(cd + 32, cd + 48); merge16(cd, cd + 32);
        int ex[16]; float gv[16]; float sum = 0.f;
        const float top = __uint_as_float(__float_as_uint(cd[0]) & 0xFFFFFF00u);
#pragma unroll
        for (int i = 0; i < 16; ++i) {
            const unsigned bits = __float_as_uint(cd[i]);
            const int a = (bits >> 4) & 15, b = bits & 15;
            ex[i] = lut[a * 64 + f_lane] * PK + lut[(16 + b) * 64 + f_lane];
            gv[i] = __expf(__uint_as_float(bits & 0xFFFFFF00u) - top); sum += gv[i];
        }
        const float inv = 1.f / sum;
        if (h == 0) {
            u32x4* ep = (u32x4*)(eidx + (size_t)t * NSEL + hh * 16);
#pragma unroll
            for (int q = 0; q < 4; ++q) ep[q] = (u32x4){(unsigned)ex[4 * q], (unsigned)ex[4 * q + 1], (unsigned)ex[4 * q + 2], (unsigned)ex[4 * q + 3]};
        } else {
            f32x4* gp = (f32x4*)(gate + (size_t)t * NSEL + hh * 16);
#pragma unroll
            for (int q = 0; q < 4; ++q) gp[q] = (f32x4){gv[4 * q] * inv, gv[4 * q + 1] * inv, gv[4 * q + 2] * inv, gv[4 * q + 3] * inv};
        }
    }
    __syncthreads();
}
DI unsigned q8x4(f32x4 v, const float sc) {
    const int a = (int)rintf(v[0] * sc), b = (int)rintf(v[1] * sc), c = (int)rintf(v[2] * sc), d = (int)rintf(v[3] * sc);
    return ((unsigned)a & 0xFFu) | (((unsigned)b & 0xFFu) << 8) | (((unsigned)c & 0xFFu) << 16) | ((unsigned)d << 24);
}
DI void p0_int8(Frame& F) {
    FRAME_IDS;
    const int gw = F.bid * NWAVES + F.wave, NGW = F.G * NWAVES;
    float* SC = (float*)(F.ws + WS_SC);
    for (int row = gw; row < 4 * PE; row += NGW) {
        const int tab = row / PE, e = row % PE, layer = tab & 1, isv = tab >> 1;
        const float* src = (isv ? F.peer_v : F.peer_u) + ((size_t)layer * PE + e) * DM;
        unsigned* dst = (unsigned*)(F.ws + (isv ? WS_V8 : WS_U8)) + (size_t)layer * 8 * PE * 32;
        const f32x4* sp = (const f32x4*)src + f_lane;
        const f32x4* gp = (const f32x4*)(F.ffn_norm + layer * DM) + f_lane;
        f32x4 v[4]; float am = 0.f;
#pragma unroll
        for (int j = 0; j < 4; ++j) { v[j] = sp[64 * j]; if (!isv) v[j] = v[j] * gp[64 * j]; am = fmaxf(am, fmaxf(fmaxf(fabsf(v[j][0]), fabsf(v[j][1])), fmaxf(fabsf(v[j][2]), fabsf(v[j][3])))); }
        am = wave_max(am);
        const float sc = am > 0.f ? 127.f / am : 0.f;
#pragma unroll
        for (int j = 0; j < 4; ++j) dst[((size_t)(2 * j + (f_lane >> 5)) * PE + e) * 32 + (f_lane & 31)] = q8x4(v[j], sc);
        if (f_lane == 0) SC[tab * PE + e] = am * (1.f / 127.f);
    }
}
DI float dot16_fp8(const u32x4 r, const float (&xs)[16]) {
    float s0 = 0.f, s1 = 0.f;
#pragma unroll
    for (int w = 0; w < 4; ++w) {
        const f32x2 lo = __builtin_amdgcn_cvt_pk_f32_fp8((int)r[w], false), hi = __builtin_amdgcn_cvt_pk_f32_fp8((int)r[w], true);
        s0 = fmaf(lo[0], xs[4 * w + 0], s0); s1 = fmaf(lo[1], xs[4 * w + 1], s1); s0 = fmaf(hi[0], xs[4 * w + 2], s0); s1 = fmaf(hi[1], xs[4 * w + 3], s1);
    }
    return s0 + s1;
}
DI void axpy16_fp8(const u32x4 r, const float a, float (&o)[16]) {
#pragma unroll
    for (int w = 0; w < 4; ++w) {
        const f32x2 lo = __builtin_amdgcn_cvt_pk_f32_fp8((int)r[w], false), hi = __builtin_amdgcn_cvt_pk_f32_fp8((int)r[w], true);
        o[4 * w + 0] = fmaf(a, lo[0], o[4 * w + 0]); o[4 * w + 1] = fmaf(a, lo[1], o[4 * w + 1]); o[4 * w + 2] = fmaf(a, hi[0], o[4 * w + 2]); o[4 * w + 3] = fmaf(a, hi[1], o[4 * w + 3]);
    }
}
DI float red_combine(const int level, const float a, const float b, const int lane) {
    const int M = 32 >> level; const bool bit = (lane & M) != 0;
    const float send = bit ? a : b, keep = bit ? b : a;
    return keep + __shfl_xor(send, M);
}
constexpr int brev6(int k) { return ((k & 1) << 5) | ((k & 2) << 3) | ((k & 4) << 1) | ((k & 8) >> 1) | ((k & 16) >> 3) | ((k & 32) >> 5); }
struct XInfo { int xrank, nx, rank, nloc; };
DI XInfo get_xinfo(Frame& F, const bool census) {
    FRAME_IDS;
    volatile LAS unsigned* M = (volatile LAS unsigned*)(F.lds + MISC_OFF);
    __syncthreads();
    if (f_tid == 0) {
        unsigned xr = (unsigned)F.bid & 7u, nx = 8u, rk = (unsigned)F.bid >> 3, nl = ((unsigned)F.G + 7u - ((unsigned)F.bid & 7u)) >> 3;
        if (census) {
            unsigned* bar = (unsigned*)(F.ws + WS_CTL) + CW_BAR; const unsigned x = xb_xcc_id();
            unsigned cnt = 0u, below = 0u, mine = 0u;
#pragma unroll
            for (unsigned j = 0; j < 16; ++j) { const unsigned c = xb_ld(&bar[XB_XCNT(j)]); cnt += (c > 0u); below += (c > 0u && j < x); mine = (j == x) ? c : mine; }
            if (cnt > 0u && mine > 0u) { xr = below; nx = cnt; rk = M[12]; nl = mine; }
        }
        M[20] = xr; M[21] = nx; M[22] = rk; M[23] = nl;
    }
    __syncthreads();
    XInfo xi; xi.xrank = (int)M[20]; xi.nx = (int)M[21]; xi.rank = (int)M[22]; xi.nloc = (int)M[23];
    return xi;
}
DI int comb_c(const int level, const int a, const int b, const int lane) {
    const int M = 4 >> level; const bool bit = (lane & M) != 0;
    const int send = bit ? a : b, keep = bit ? b : a;
    return keep + __shfl_xor(send, M);
}
DI int dot16_i8(const u32x4 r, const u32x4 x) {
    int s = __builtin_amdgcn_sdot4((int)r[0], (int)x[0], 0, false);
    s = __builtin_amdgcn_sdot4((int)r[1], (int)x[1], s, false); s = __builtin_amdgcn_sdot4((int)r[2], (int)x[2], s, false); s = __builtin_amdgcn_sdot4((int)r[3], (int)x[3], s, false);
    return s;
}
DI int half_dots(const u32x4 (&rows)[8], const u32x4 xq, const int lane) {
    int p[8];
#pragma unroll
    for (int i = 0; i < 8; ++i) p[i] = dot16_i8(rows[i], xq);
#pragma unroll
    for (int i = 0; i < 4; ++i) p[i] = comb_c(0, p[2 * i], p[2 * i + 1], lane);
    p[0] = comb_c(1, p[0], p[1], lane); p[1] = comb_c(1, p[2], p[3], lane);
    return comb_c(2, p[0], p[1], lane);
}
DI u32x4 xquant(const f32x4 (&hv)[4], const float rstd) {
    u32x4 o;
#pragma unroll
    for (int w = 0; w < 4; ++w) {
        const f32x4 x = hv[w] * (rstd * XQ);
        const int a = (int)rintf(__builtin_amdgcn_fmed3f(x[0], -127.f, 127.f)), b = (int)rintf(__builtin_amdgcn_fmed3f(x[1], -127.f, 127.f)), c = (int)rintf(__builtin_amdgcn_fmed3f(x[2], -127.f, 127.f)), d = (int)rintf(__builtin_amdgcn_fmed3f(x[3], -127.f, 127.f));
        o[w] = ((unsigned)a & 0xFFu) | (((unsigned)b & 0xFFu) << 8) | (((unsigned)c & 0xFFu) << 16) | ((unsigned)d << 24);
    }
    return o;
}
DI float rstd_bcast(const float* part, const int t) {
    const f32x4* p = (const f32x4*)(part + (size_t)t * 16);
    const f32x4 a = p[0], b = p[1], c = p[2], d = p[3];
    const float s = ((a[0] + a[1]) + (a[2] + a[3])) + ((b[0] + b[1]) + (b[2] + b[3])) + ((c[0] + c[1]) + (c[2] + c[3])) + ((d[0] + d[1]) + (d[2] + d[3]));
    return 1.f / sqrtf(s * (1.f / DM) + EPS);
}
#ifndef PROBE_MODE
#define PROBE_MODE 1
#endif
DI void gather_u(Frame& F, const int layer, const XInfo xi, const bool dry) {
    FRAME_IDS;
    const unsigned emask = (dry && PROBE_MODE == 2) ? 15u : 0xFFFFFFFFu;
    const int* eidx = (const int*)(F.ws + WS_EIDX); int* PU = (int*)(F.ws + (dry ? WS_R : WS_PU)); const float* part = (const float*)(F.ws + WS_PART);
    const int g = f_lane >> 3, c = f_lane & 7, c16 = c * 16;
    const int kst = 16 * g + (((c & 1) << 2) | (c & 2) | ((c & 4) >> 2));
    const int gwl = xi.rank * NWAVES + F.wave, NGWL = xi.nloc * NWAVES;
    LAS unsigned char* wl = F.lds + F.wave * 2048;
    __syncthreads();
    for (int j = xi.xrank; j < 8; j += xi.nx) {
        const __amdgpu_buffer_rsrc_t U8 = __builtin_amdgcn_make_buffer_rsrc((void*)(F.ws + WS_U8 + ((size_t)(layer * 8 + j) * PE) * 128), 0, PE * 128, 0x00020000);
        int t = gwl;
        if (t >= T) continue;
#define U_LOAD(tt, ri, rh, rp) do { ri = *(const u32x2*)(eidx + (size_t)(tt) * NSEL + 2 * f_lane) & emask; rh = *(const f32x2*)(F.out + (size_t)(tt) * DM + 128 * j + 2 * f_lane); \
            rp = part[(size_t)(tt) * 16 + (f_lane & 15)]; } while (0)
#define U_SPREAD(slot, ri, rh, rp, e, xqv) do { \
            float ps_ = rp; ps_ += __shfl_xor(ps_, 1); ps_ += __shfl_xor(ps_, 2); ps_ += __shfl_xor(ps_, 4); ps_ += __shfl_xor(ps_, 8); \
            const float rs_ = (1.f / sqrtf(ps_ * (1.f / DM) + EPS)) * XQ; \
            const int q0_ = (int)rintf(__builtin_amdgcn_fmed3f(rh[0] * rs_, -127.f, 127.f)), q1_ = (int)rintf(__builtin_amdgcn_fmed3f(rh[1] * rs_, -127.f, 127.f)); \
            LAS unsigned char* sl_ = wl + (slot) * 1024; \
            *(LAS u32x2*)(sl_ + 8 * f_lane) = ri; *(LAS unsigned short*)(sl_ + 512 + 2 * f_lane) = (unsigned short)(((unsigned)q0_ & 0xFFu) | (((unsigned)q1_ & 0xFFu) << 8)); \
            asm volatile("s_waitcnt lgkmcnt(0)" ::: "memory"); \
            _Pragma("unroll") for (int q_ = 0; q_ < 4; ++q_) e[q_] = *(const LAS u32x4*)(sl_ + 64 * g + 16 * q_); \
            xqv = *(const LAS u32x4*)(sl_ + 512 + c16); } while (0)
        u32x2 ri; f32x2 rh; float rp;
        u32x4 e0[4], e1[4], xq, xq1;
        U_LOAD(t, ri, rh, rp); U_SPREAD(0, ri, rh, rp, e0, xq);
        { const int t1 = (t + NGWL < T) ? t + NGWL : t; U_LOAD(t1, ri, rh, rp); U_SPREAD(1, ri, rh, rp, e1, xq1); }
        { const int t2 = (t + 2 * NGWL < T) ? t + 2 * NGWL : t; U_LOAD(t2, ri, rh, rp); }
        u32x4 A0[8], B0[8], A1[8], B1[8];
#pragma unroll
        for (int i = 0; i < 8; ++i) A0[i] = __builtin_amdgcn_raw_buffer_load_b128(U8, (int)e0[i >> 2][i & 3] * 128 + c16, 0, 0);
#pragma unroll
        for (int i = 0; i < 8; ++i) B0[i] = __builtin_amdgcn_raw_buffer_load_b128(U8, (int)e0[2 + (i >> 2)][i & 3] * 128 + c16, 0, 0);
#define U_ITEM(CA, CB, NA, NB, slot) do { \
            _Pragma("unroll") for (int i = 0; i < 8; ++i) NA[i] = __builtin_amdgcn_raw_buffer_load_b128(U8, (int)e1[i >> 2][i & 3] * 128 + c16, 0, 0); \
            asm volatile("" ::: "memory"); \
            const int r0 = half_dots(CA, xq, f_lane); \
            _Pragma("unroll") for (int i = 0; i < 8; ++i) NB[i] = __builtin_amdgcn_raw_buffer_load_b128(U8, (int)e1[2 + (i >> 2)][i & 3] * 128 + c16, 0, 0); \
            asm volatile("" ::: "memory"); \
            const int rr1 = half_dots(CB, xq, f_lane); \
            int* pp = PU + ((size_t)t * 8 + j) * NSEL + kst; \
            pp[0] = r0; pp[8] = rr1; \
            xq = xq1; \
            U_SPREAD(slot, ri, rh, rp, e1, xq1);                        \
            { const int t3 = (t + 3 * NGWL < T) ? t + 3 * NGWL : t; U_LOAD(t3, ri, rh, rp); } } while (0)
        for (;;) {
            U_ITEM(A0, B0, A1, B1, 0); t += NGWL; if (t >= T) break;
            U_ITEM(A1, B1, A0, B0, 1); t += NGWL; if (t >= T) break;
        }
#undef U_ITEM
#undef U_LOAD
#undef U_SPREAD
    }
    __syncthreads();
}
DI void gather_r(Frame& F, const int layer) {
    FRAME_IDS;
    const int* PU = (const int*)(F.ws + WS_PU); const float* gate = (const float*)(F.ws + WS_GATE); const int* eidx = (const int*)(F.ws + WS_EIDX);
    const float* SCu = (const float*)(F.ws + WS_SC) + (size_t)layer * PE; const float* SCv = (const float*)(F.ws + WS_SC) + (size_t)(2 + layer) * PE;
    signed char* A8 = (signed char*)(F.ws + WS_A); float* SA = (float*)(F.ws + WS_SA);
    const int gw = F.bid * NWAVES + F.wave, NGW = F.G * NWAVES;
    for (int t = gw; t < T; t += NGW) {
#pragma unroll
        for (int hf = 0; hf < 2; ++hf) {
            const int k = 64 * hf + f_lane;
            int sacc = 0;
#pragma unroll
            for (int j = 0; j < 8; ++j) sacc += PU[((size_t)t * 8 + j) * NSEL + k];
            const int e = eidx[(size_t)t * NSEL + k];
            const float d = (float)sacc * (SCu[e] * (1.f / XQ));
            const float a = gelu_erf(d) * gate[(size_t)t * NSEL + k] * SCv[e];
            float am = fabsf(a);
#pragma unroll
            for (int o = 1; o < 16; o <<= 1) am = fmaxf(am, __shfl_xor(am, o));
            const float sc = am > 0.f ? 127.f / am : 0.f;
            A8[(size_t)t * NSEL + k] = (signed char)(int)rintf(a * sc);
            if ((f_lane & 15) == 0) SA[(size_t)t * 8 + (k >> 4)] = am * (1.f / 127.f);
        }
    }
}
DI void tr4x4(const unsigned w0, const unsigned w1, const unsigned w2, const unsigned w3, unsigned (&cdw)[4]) {
    const unsigned t01l = __builtin_amdgcn_perm(w1, w0, 0x05010400u), t01h = __builtin_amdgcn_perm(w1, w0, 0x07030602u);
    const unsigned t23l = __builtin_amdgcn_perm(w3, w2, 0x05010400u), t23h = __builtin_amdgcn_perm(w3, w2, 0x07030602u);
    cdw[0] = __builtin_amdgcn_perm(t23l, t01l, 0x05040100u); cdw[1] = __builtin_amdgcn_perm(t23l, t01l, 0x07060302u);
    cdw[2] = __builtin_amdgcn_perm(t23h, t01h, 0x05040100u); cdw[3] = __builtin_amdgcn_perm(t23h, t01h, 0x07060302u);
}
DI void axpy4rows(const u32x4 r0, const u32x4 r1, const u32x4 r2, const u32x4 r3, const unsigned a4, int (&acc)[16]) {
#pragma unroll
    for (int d = 0; d < 4; ++d) {
        unsigned cdw[4];
        tr4x4(r0[d], r1[d], r2[d], r3[d], cdw);
#pragma unroll
        for (int i = 0; i < 4; ++i) acc[4 * d + i] = __builtin_amdgcn_sdot4((int)cdw[i], (int)a4, acc[4 * d + i], false);
    }
}
DI void gather_v(Frame& F, const int layer, const XInfo xi, const bool dry) {
    FRAME_IDS;
    const int* eidx = (const int*)(F.ws + WS_EIDX); const unsigned char* A8 = F.ws + WS_A; const float* SA = (const float*)(F.ws + WS_SA);
    float* part_w = dry ? (float*)(F.ws + WS_R) : (float*)(F.ws + WS_PART); bf16* hb_w = dry ? (bf16*)(F.ws + WS_HID2) : (bf16*)(F.ws + WS_XB); float* out_w = dry ? (float*)(F.ws + WS_PU) : F.out;
    const int g = f_lane >> 3, c = f_lane & 7, c16 = c * 16;
    const int cc = 16 * c + 8 * (g >> 2) + 4 * ((g >> 1) & 1) + 2 * (g & 1);
    const int gwl = xi.rank * NWAVES + F.wave, NGWL = xi.nloc * NWAVES;
    const bool b5 = (f_lane & 32) != 0, b4 = (f_lane & 16) != 0, b3 = (f_lane & 8) != 0;
    LAS unsigned char* wl = F.lds + F.wave * 2048;
    __syncthreads();
    for (int j = xi.xrank; j < 8; j += xi.nx) {
        const __amdgpu_buffer_rsrc_t V8 = __builtin_amdgcn_make_buffer_rsrc((void*)(F.ws + WS_V8 + ((size_t)(layer * 8 + j) * PE) * 128), 0, PE * 128, 0x00020000);
        int t = gwl;
        if (t >= T) continue;
#define V_LOAD(tt, ri, ra, rs) do { ri = *(const u32x2*)(eidx + (size_t)(tt) * NSEL + 2 * f_lane); ra = *(const unsigned short*)(A8 + (size_t)(tt) * NSEL + 2 * f_lane); rs = SA[(size_t)(tt) * 8 + (f_lane & 7)]; } while (0)
#define V_SPREAD(slot, ri, ra, rs, e, avv, sav) do { \
            LAS unsigned char* sl_ = wl + (slot) * 1024; \
            *(LAS u32x2*)(sl_ + 8 * f_lane) = ri; *(LAS unsigned short*)(sl_ + 512 + 2 * f_lane) = ra; if (f_lane < 8) *(LAS float*)(sl_ + 640 + 4 * f_lane) = rs; \
            asm volatile("s_waitcnt lgkmcnt(0)" ::: "memory"); \
            _Pragma("unroll") for (int q_ = 0; q_ < 4; ++q_) e[q_] = *(const LAS u32x4*)(sl_ + 64 * g + 16 * q_); \
            avv = *(const LAS u32x4*)(sl_ + 512 + 16 * g); sav = *(const LAS float*)(sl_ + 640 + 4 * g); } while (0)
        u32x2 ri; unsigned short ra; float rs;
        u32x4 e0[4], e1[4], av, a1; float sa, sa1; f32x2 hold;
        V_LOAD(t, ri, ra, rs); V_SPREAD(0, ri, ra, rs, e0, av, sa);
        { const int t1 = (t + NGWL < T) ? t + NGWL : t; V_LOAD(t1, ri, ra, rs); V_SPREAD(1, ri, ra, rs, e1, a1, sa1); }
        { const int t2 = (t + 2 * NGWL < T) ? t + 2 * NGWL : t; V_LOAD(t2, ri, ra, rs); }
        hold = *(const f32x2*)(F.out + (size_t)t * DM + 128 * j + cc);
        u32x4 A0[8], B0[8], A1[8], B1[8];
#pragma unroll
        for (int i = 0; i < 8; ++i) A0[i] = __builtin_amdgcn_raw_buffer_load_b128(V8, (int)e0[i >> 2][i & 3] * 128 + c16, 0, 0);
#pragma unroll
        for (int i = 0; i < 8; ++i) B0[i] = __builtin_amdgcn_raw_buffer_load_b128(V8, (int)e0[2 + (i >> 2)][i & 3] * 128 + c16, 0, 0);
#define V_ITEM(CA, CB, NA, NB, slot) do { \
            const int t1 = (t + NGWL < T) ? t + NGWL : t; \
            const f32x2 hold1 = *(const f32x2*)(F.out + (size_t)t1 * DM + 128 * j + cc); \
            _Pragma("unroll") for (int i = 0; i < 8; ++i) NA[i] = __builtin_amdgcn_raw_buffer_load_b128(V8, (int)e1[i >> 2][i & 3] * 128 + c16, 0, 0); \
            asm volatile("" ::: "memory"); \
            int acc[16]; \
            _Pragma("unroll") for (int n = 0; n < 16; ++n) acc[n] = 0; \
            axpy4rows(CA[0], CA[1], CA[2], CA[3], av[0], acc); axpy4rows(CA[4], CA[5], CA[6], CA[7], av[1], acc); \
            _Pragma("unroll") for (int i = 0; i < 8; ++i) NB[i] = __builtin_amdgcn_raw_buffer_load_b128(V8, (int)e1[2 + (i >> 2)][i & 3] * 128 + c16, 0, 0); \
            asm volatile("" ::: "memory"); \
            axpy4rows(CB[0], CB[1], CB[2], CB[3], av[2], acc); axpy4rows(CB[4], CB[5], CB[6], CB[7], av[3], acc); \
            float o[16]; \
            _Pragma("unroll") for (int n = 0; n < 16; ++n) o[n] = (float)acc[n] * sa; \
            float r8[8], r4[4], r2[2]; \
            _Pragma("unroll") for (int n = 0; n < 8; ++n) { const float keep = b5 ? o[8 + n] : o[n], send = b5 ? o[n] : o[8 + n]; r8[n] = keep + __shfl_xor(send, 32); } \
            _Pragma("unroll") for (int n = 0; n < 4; ++n) { const float keep = b4 ? r8[4 + n] : r8[n], send = b4 ? r8[n] : r8[4 + n]; r4[n] = keep + __shfl_xor(send, 16); } \
            _Pragma("unroll") for (int n = 0; n < 2; ++n) { const float keep = b3 ? r4[2 + n] : r4[n], send = b3 ? r4[n] : r4[2 + n]; r2[n] = keep + __shfl_xor(send, 8); } \
            const float h0 = hold[0] + r2[0], h1v = hold[1] + r2[1]; \
            const float ss = wave_sum(h0 * h0 + h1v * h1v); \
            *(f32x2*)(out_w + (size_t)t * DM + 128 * j + cc) = (f32x2){h0, h1v}; \
            *(unsigned*)(hb_w + (size_t)t * DM + 128 * j + cc) = cvtpk(h0, h1v); \
            if (f_lane == 0) part_w[(size_t)t * 16 + j] = ss; \
            if (j == 0 && f_lane >= 8 && f_lane < 16) part_w[(size_t)t * 16 + f_lane] = 0.f; \
            av = a1; sa = sa1; hold = hold1; \
            V_SPREAD(slot, ri, ra, rs, e1, a1, sa1); \
            { const int t3 = (t + 3 * NGWL < T) ? t + 3 * NGWL : t; V_LOAD(t3, ri, ra, rs); } } while (0)
        for (;;) {
            V_ITEM(A0, B0, A1, B1, 0); t += NGWL; if (t >= T) break;
            V_ITEM(A1, B1, A0, B0, 1); t += NGWL; if (t >= T) break;
        }
#undef V_ITEM
#undef V_LOAD
#undef V_SPREAD
    }
    __syncthreads();
}
DI void final_norm(Frame& F) {
    FRAME_IDS;
    const float* part = (const float*)(F.ws + WS_PART);
    const int gw = F.bid * NWAVES + F.wave, NGW = F.G * NWAVES;
    for (int t = gw; t < T; t += NGW) {
        const float r = row_rstd(part, t);
        f32x4* hp = (f32x4*)(F.out + (size_t)t * DM) + f_lane;
        const f32x4* gp = (const f32x4*)F.final_norm + f_lane;
#pragma unroll
        for (int q = 0; q < 4; ++q) hp[64 * q] = hp[64 * q] * r * gp[64 * q];
    }
}
DI void opt_conv(Frame& F) {
    FRAME_IDS;
    const bf16* G = (const bf16*)(F.ws + WS_GLU); bf16* H2 = (bf16*)(F.ws + WS_HID2);
    LAS float* ys = (LAS float*)F.lds;
    float wt0[CW], wt1[CW];
#pragma unroll
    for (int j = 0; j < CW; ++j) { const f32x2 wv = *(const f32x2*)(F.conv_dw + j * DM + 2 * f_tid); wt0[j] = wv[0]; wt1[j] = wv[1]; }
    const f32x2 bdw = *(const f32x2*)(F.conv_dw_b + 2 * f_tid);
    for (int it = F.bid; it < T / 128; it += F.G) {
        const int s0 = (it % (SEQ / 128)) * 128;
        const size_t row0 = (size_t)it * 128;
        const unsigned* gp = (const unsigned*)G + f_tid;
        unsigned win[CW];
#pragma unroll
        for (int u = 0; u < CW - 1; ++u) { const int sp = s0 - (CW - 1) + u; win[u + 1] = sp >= 0 ? gp[(row0 - (CW - 1) + u) * 512] : 0u; }
        win[0] = 0u;
        for (int bt = 0; bt < 5; ++bt) {
            unsigned nx[CW];
#pragma unroll
            for (int u = 0; u < CW; ++u) { const int sl = 31 * bt + u; nx[u] = (s0 + sl < SEQ) ? gp[(row0 + sl) * 512] : 0u; }
            __syncthreads();
#pragma unroll
            for (int u = 0; u < CW; ++u) {
                win[u] = nx[u];
                float a0 = bdw[0], a1 = bdw[1];
#pragma unroll
                for (int j = 0; j < CW; ++j) {
                    const unsigned xv = win[(u + 1 + j) % CW];
                    a0 = fmaf(wt0[j], __uint_as_float(xv << 16), a0); a1 = fmaf(wt1[j], __uint_as_float(xv & 0xffff0000u), a1);
                }
                *(LAS f32x2*)(ys + u * DM + 2 * f_tid) = (f32x2){a0, a1};
            }
            __syncthreads();
            for (int u = F.wave; u < CW; u += NWAVES) {
                const int sl = 31 * bt + u;
                if (sl < 128) {
                    f32x4 v[4]; float sm = 0.f;
#pragma unroll
                    for (int k = 0; k < 4; ++k) { v[k] = *(const LAS f32x4*)(ys + u * DM + 256 * k + 4 * f_lane); sm += (v[k][0] + v[k][1]) + (v[k][2] + v[k][3]); }
                    const float mu = wave_sum(sm) * (1.f / DM);
                    float sq = 0.f;
#pragma unroll
                    for (int k = 0; k < 4; ++k) { v[k] = v[k] - mu; sq += (v[k][0] * v[k][0] + v[k][1] * v[k][1]) + (v[k][2] * v[k][2] + v[k][3] * v[k][3]); }
                    const float rs = 1.f / sqrtf(wave_sum(sq) * (1.f / DM) + EPS);
#pragma unroll
                    for (int k = 0; k < 4; ++k) {
                        const f32x4 g = *(const f32x4*)(F.conv_ln_g + 256 * k + 4 * f_lane), bb = *(const f32x4*)(F.conv_ln_b + 256 * k + 4 * f_lane);
                        f32x4 z = v[k] * rs * g + bb;
#pragma unroll
                        for (int e = 0; e < 4; ++e) z[e] = z[e] / (1.f + __expf(-z[e]));
                        *(u32x2*)(H2 + (row0 + sl) * DM + 256 * k + 4 * f_lane) = (u32x2){cvtpk(z[0], z[1]), cvtpk(z[2], z[3])};
                    }
                }
            }
        }
    }
    __syncthreads();
}
enum Phase { PH_PREP = 0, PH_PROJ, PH_MIX, PH_WOUT, PH_Q0, PH_ROUTE0, PH_GU0, PH_GR0, PH_GV0, PH_W1, PH_CONV, PH_W2, PH_Q1, PH_ROUTE1, PH_GU1, PH_GR1, PH_GV1, PH_FINAL, PH_COUNT };
struct Args { const float* in[19]; float* out; unsigned char* ws; int ph_lo, ph_hi; };
#ifndef TEST_PHASE
#define TEST_PHASE -1
#endif
#ifndef REP_PHASE
#define REP_PHASE -1
#endif

__global__ void __launch_bounds__(NTHR, 2) mega_fwd(Args args) {
    extern __shared__ __attribute__((aligned(16))) unsigned char lds[];
    Frame F;
    F.lds = (LAS unsigned char*)lds;
    F.wave = __builtin_amdgcn_readfirstlane((int)threadIdx.x >> 6); FRAME_IDS;
    F.G = gridDim.x; F.bid = blockIdx.x;
    F.x = args.in[0]; F.mix_norm = args.in[1]; F.ffn_norm = args.in[2]; F.final_norm = args.in[3]; F.w_in = args.in[4]; F.w_out = args.in[5]; F.rel_bias = args.in[6];
    F.conv_w1 = args.in[7]; F.conv_b1 = args.in[8]; F.conv_dw = args.in[9]; F.conv_dw_b = args.in[10]; F.conv_ln_g = args.in[11]; F.conv_ln_b = args.in[12];
    F.conv_w2 = args.in[13]; F.conv_b2 = args.in[14]; F.peer_wq = args.in[15]; F.peer_keys = args.in[16]; F.peer_u = args.in[17]; F.peer_v = args.in[18];
    F.out = args.out; F.ws = args.ws;
    volatile LAS unsigned* MISC = (volatile LAS unsigned*)(F.lds + MISC_OFF);
    for (int u = f_tid; u < (LDS_BYTES - LDSCTL_OFF) / 4; u += NTHR) ((LAS unsigned*)(F.lds + LDSCTL_OFF))[u] = 0u;
    __syncthreads();
    const int lo = args.ph_lo, hi = args.ph_hi;
    XcdBarrier bar; bar.bar = (unsigned*)(F.ws + WS_CTL) + CW_BAR; bar.x = 0; bar.st = nullptr;
    if (hi - lo > 1) bar = xcd_barrier_post((unsigned*)(F.ws + WS_CTL) + CW_BAR, MISC + 8);
#define IN(k) ((TEST_PHASE < 0 || TEST_PHASE == (k)) && lo <= (k) && (k) < hi)
#define SEAM(k) do { if (IN(k) && IN((k) + 1)) xcd_barrier(bar, F.wave); } while (0)
#define REPS(k) for (int rep_ = ((k) == REP_PHASE ? 0 : 1); rep_ < 2; ++rep_)
#define GEMM_PHASE(EPI, Aptr, Bptr, NN, ...) do { pg8::Gemm g{(const bf16*)(Aptr), (const bf16*)(Bptr), T, (NN), DM}; pg8::StaticOrder S; S.init(T, (NN), F.G, F.bid); \
        pg8::EPI E{__VA_ARGS__}; pg8::gemm_phase<pg8::EPI, pg8::StaticOrder, true, true>(F.lds, g, S, E, F.wave); } while (0)
    bf16* XB = (bf16*)(F.ws + WS_XB);
    float* PART = (float*)(F.ws + WS_PART); const float* ROPE = (const float*)(F.ws + WS_ROPE);
    if (IN(PH_PREP)) REPS(PH_PREP) { p0_prep(F); p0_weights(F); p0_int8(F); } SEAM(PH_PREP);
    if (IN(PH_PROJ)) REPS(PH_PROJ) { GEMM_PHASE(EpiProj, XB, F.ws + WS_WIN, INC, (bf16*)(F.ws + WS_R), PART, ROPE); } SEAM(PH_PROJ);
    if (IN(PH_MIX)) REPS(PH_MIX) { mix_phase(F, rep_); } SEAM(PH_MIX);
    if (IN(PH_WOUT)) REPS(PH_WOUT) { GEMM_PHASE(EpiRes, F.ws + WS_O, F.ws + WS_WOUT, DM, F.x, F.out, XB, PART, nullptr); } SEAM(PH_WOUT);
    if (IN(PH_Q0)) REPS(PH_Q0) { GEMM_PHASE(EpiQ, XB, F.ws + WS_WQ, DM, (bf16*)(F.ws + WS_Q), PART); } SEAM(PH_Q0);
    if (IN(PH_ROUTE0)) REPS(PH_ROUTE0) { opt_route(F, 0); } SEAM(PH_ROUTE0);
    const bool census = (hi - lo > 1);
    if (IN(PH_GU0)) REPS(PH_GU0) { gather_u(F, 0, get_xinfo(F, census), rep_ == 0); } SEAM(PH_GU0);
    if (IN(PH_GR0)) REPS(PH_GR0) { gather_r(F, 0); } SEAM(PH_GR0);
    if (IN(PH_GV0)) REPS(PH_GV0) { gather_v(F, 0, get_xinfo(F, census), rep_ == 0); } SEAM(PH_GV0);
    if (IN(PH_W1)) REPS(PH_W1) { GEMM_PHASE(EpiGlu, XB, F.ws + WS_W1, 2 * DM, (bf16*)(F.ws + WS_GLU), PART, F.conv_b1); } SEAM(PH_W1);
    if (IN(PH_CONV)) REPS(PH_CONV) { opt_conv(F); } SEAM(PH_CONV);
    if (IN(PH_W2)) { GEMM_PHASE(EpiRes, F.ws + WS_HID2, F.ws + WS_W2, DM, F.out, F.out, XB, PART, F.conv_b2); } SEAM(PH_W2);
    if (IN(PH_Q1)) REPS(PH_Q1) { GEMM_PHASE(EpiQ, XB, F.ws + WS_WQ + (size_t)DM * DM * 2, DM, (bf16*)(F.ws + WS_Q), PART); } SEAM(PH_Q1);
    if (IN(PH_ROUTE1)) REPS(PH_ROUTE1) { opt_route(F, 1); } SEAM(PH_ROUTE1);
    if (IN(PH_GU1)) REPS(PH_GU1) { gather_u(F, 1, get_xinfo(F, census), rep_ == 0); } SEAM(PH_GU1);
    if (IN(PH_GR1)) REPS(PH_GR1) { gather_r(F, 1); } SEAM(PH_GR1);
    if (IN(PH_GV1)) REPS(PH_GV1) { gather_v(F, 1, get_xinfo(F, census), rep_ == 0); } SEAM(PH_GV1);
    if (IN(PH_FINAL)) { final_norm(F); }
#undef IN
#undef SEAM
}

extern "C" void kernel_launch(void* const* d_in, const int* in_sizes, int n_in, void* d_out, int out_size, void* d_ws, size_t ws_size, hipStream_t stream) {
    static int grid = 0;
    if (grid == 0) {
        if (n_in != 19 || out_size != T * DM || ws_size < WS_END) { fprintf(stderr, "kernel_launch: unexpected shapes (n_in %d out %d ws %zu)\n", n_in, out_size, ws_size); grid = -1; return; }
        int dev = 0, cus = 0;
        if (hipGetDevice(&dev) != hipSuccess || hipDeviceGetAttribute(&cus, hipDeviceAttributeMultiprocessorCount, dev) != hipSuccess) { grid = -1; return; }
        if (hipFuncSetAttribute((const void*)mega_fwd, hipFuncAttributeMaxDynamicSharedMemorySize, LDS_BYTES) != hipSuccess) { fprintf(stderr, "kernel_launch: hipFuncSetAttribute failed\n"); grid = -1; return; }
        (void)hipGetLastError();
        grid = cus;
    }
    if (grid < 0) return;
    (void)hipMemsetAsync((char*)d_ws + WS_CTL, 0, CTL_ZERO_BYTES, stream);
    Args a{};
    for (int i = 0; i < 19; ++i) a.in[i] = (const float*)d_in[i];
    a.out = (float*)d_out; a.ws = (unsigned char*)d_ws;
#if MK_ONE_LAUNCH
    a.ph_lo = 0; a.ph_hi = PH_COUNT;
    hipLaunchKernelGGL(mega_fwd, dim3(grid), dim3(NTHR), LDS_BYTES, stream, a);
#else
    for (int p = 0; p < PH_COUNT; ++p) { a.ph_lo = p; a.ph_hi = p + 1; hipLaunchKernelGGL(mega_fwd, dim3(grid), dim3(NTHR), LDS_BYTES, stream, a); }
#endif
}
```

```cpp
#include <hip/hip_runtime.h>
#include <cstdio>
#include <cstdint>

#ifndef MK_ONE_LAUNCH
#define MK_ONE_LAUNCH 1
#endif

#define GAS __attribute__((address_space(1)))
#define LAS __attribute__((address_space(3)))
#define DI __device__ __forceinline__
typedef unsigned short bf16;
typedef float f32x2 __attribute__((ext_vector_type(2)));
typedef float f32x4 __attribute__((ext_vector_type(4)));
typedef unsigned u32x2 __attribute__((ext_vector_type(2)));
typedef unsigned u32x4 __attribute__((ext_vector_type(4)));
typedef short bf16x8 __attribute__((ext_vector_type(8)));
typedef float f32x16 __attribute__((ext_vector_type(16)));

constexpr int NB = 16, SEQ = 2048, DM = 1024, T = NB * SEQ;
constexpr int CHUNK = 64, HD = 64, NHA = 8, NHB = 8, INC = 3584, NCH = SEQ / CHUNK;
constexpr int PH = 8, PK = 128, PE = PK * PK, PQD = 128, PTOP = 16, NSEL = PH * PTOP;
constexpr int CW = 31;
constexpr float EPS = 1e-6f;
constexpr float XQ = 127.f / 6.f;
constexpr int NWAVES = 8, NTHR = NWAVES * 64;

constexpr int C_QA = 0, C_KA = 512, C_VA = 1024, C_QB = 1536, C_KB = 2048, C_VB = 2560, C_GB = 3072;

constexpr size_t MiB = 1u << 20;
constexpr size_t WS_CTL = 0, CTL_ZERO_BYTES = 1 * MiB;
constexpr size_t WS_WIN = 2 * MiB, WS_WOUT = 9 * MiB, WS_W1 = 11 * MiB, WS_W2 = 15 * MiB, WS_WQ = 17 * MiB;
constexpr size_t WS_ROPE = 22 * MiB;
constexpr size_t WS_PART = 23 * MiB;
constexpr size_t WS_EIDX = 26 * MiB;
constexpr size_t WS_GATE = 42 * MiB;
constexpr size_t WS_U8 = 64 * MiB, WS_V8 = 96 * MiB;
constexpr size_t WS_SC = 25 * MiB;
constexpr size_t WS_SA = 58 * MiB;
constexpr size_t WS_PU = 256 * MiB;
constexpr size_t WS_A = 384 * MiB;
constexpr size_t WS_XB = 128 * MiB;
constexpr size_t WS_R = 192 * MiB;
constexpr size_t WS_O = 416 * MiB;
constexpr size_t WS_Q = 192 * MiB;
constexpr size_t WS_HID = 256 * MiB;
constexpr size_t WS_GLU = 384 * MiB;
constexpr size_t WS_HID2 = 448 * MiB;
constexpr size_t WS_END = 512 * MiB;
constexpr int CW_BAR = 4096, CW_QUEUE = 8192;

constexpr int RING_BYTES = 131072, LDSCTL_OFF = RING_BYTES, MISC_OFF = LDSCTL_OFF + 320, LDS_BYTES = 147456;

DI float bf2f(bf16 v) { return __uint_as_float(((unsigned)v) << 16); }
DI unsigned f2bf(float f) { unsigned u = __float_as_uint(f); return (u + 0x7fffu + ((u >> 16) & 1u)) >> 16; }
DI unsigned pk2(float lo, float hi) { return f2bf(lo) | (f2bf(hi) << 16); }
DI float wave_sum(float v) {
#pragma unroll
    for (int o = 1; o < 64; o <<= 1) v += __shfl_xor(v, o);
    return v;
}
DI float wave_max(float v) {
#pragma unroll
    for (int o = 1; o < 64; o <<= 1) v = fmaxf(v, __shfl_xor(v, o));
    return v;
}
DI float block_sum(float v, LAS float* red, int tid) {
    v = wave_sum(v);
    __syncthreads();
    if ((tid & 63) == 0) red[tid >> 6] = v;
    __syncthreads();
    float s = 0.f;
#pragma unroll
    for (int i = 0; i < NWAVES; ++i) s += red[i];
    return s;
}
DI float gelu_erf(float x) { return 0.5f * x * (1.f + erff(x * 0.70710678118654752f)); }
DI float sigmoidf(float x) { return 1.f / (1.f + __expf(-x)); }

DI int lane_id() { int r; asm volatile("v_mbcnt_lo_u32_b32 %0, -1, 0\n\tv_mbcnt_hi_u32_b32 %0, -1, %0" : "=v"(r)); return r; }
#define XB_TMO      128
#define XB_XCNT(j)  (256  + 64 * (j))
#define XB_XSUB(j)  (1280 + 64 * (j))
#define XB_XGEN(j)  (2304 + 64 * (j))
#define XB_TOP      3328
#define XB_TOPGEN   3392
#define XCD_BAR_WORDS 3456
#define XB_SPIN_CAP (1u << 22)
DI unsigned xb_ld(unsigned* p)              { return __hip_atomic_load(p, __ATOMIC_RELAXED, __HIP_MEMORY_SCOPE_AGENT); }
DI unsigned xb_add(unsigned* p, unsigned v) { return __hip_atomic_fetch_add(p, v, __ATOMIC_RELAXED, __HIP_MEMORY_SCOPE_AGENT); }
DI unsigned xb_xcc_id() { return (unsigned)__builtin_amdgcn_s_getreg((3 << 11) | 20) & 0xFu; }
#define XB_SPIN(cond, bar) do { unsigned _sp = 0; while (cond) { __builtin_amdgcn_s_sleep(1); \
    if ((++_sp & 255u) == 0u) { if (xb_ld(&(bar)[XB_TMO])) break; if (_sp > XB_SPIN_CAP) { atomicAdd(&(bar)[XB_TMO], 1u); break; } } } } while (0)
struct XcdBarrier { unsigned* bar; unsigned x; volatile LAS unsigned* st; };
DI XcdBarrier xcd_barrier_post(unsigned* bar, volatile LAS unsigned* st) {
    XcdBarrier b; b.bar = bar; b.x = xb_xcc_id(); b.st = st;
    if (threadIdx.x == 0) st[4] = xb_add(&bar[XB_XCNT(b.x)], 1u);
    return b;
}
DI void xcd_barrier_complete(unsigned* bar, unsigned x, unsigned& nloc, unsigned& nx) {
    const unsigned G = gridDim.x * gridDim.y * gridDim.z;
    unsigned sum, cnt, mine, sp = 0u;
    for (;;) {
        sum = 0u; cnt = 0u; mine = 0u;
#pragma unroll
        for (unsigned j = 0; j < 16; ++j) { const unsigned c = xb_ld(&bar[XB_XCNT(j)]); sum += c; cnt += (c > 0u) ? 1u : 0u; mine = (j == x) ? c : mine; }
        if (sum == G) break;
        __builtin_amdgcn_s_sleep(1);
        if ((++sp & 255u) == 0u) { if (xb_ld(&bar[XB_TMO])) break; if (sp > XB_SPIN_CAP) { atomicAdd(&bar[XB_TMO], 1u); break; } }
    }
    nloc = mine > 0u ? mine : 1u; nx = cnt > 0u ? cnt : 1u;
}
DI void xcd_barrier(const XcdBarrier& b, const int wave_id) {
    asm volatile("s_waitcnt vmcnt(0)" ::: "memory");
    __syncthreads();
    if (wave_id == 0 && lane_id() == 0) {
        unsigned* bar = b.bar;
        __builtin_amdgcn_s_waitcnt(0);
        unsigned nloc = b.st[0], nx = b.st[1];
        if (nloc == 0u) { xcd_barrier_complete(bar, b.x, nloc, nx); b.st[0] = nloc; b.st[1] = nx; }
        const unsigned old = xb_add(&bar[XB_XSUB(b.x)], 1u);
        const unsigned gen = old / nloc;
        if (old + 1u == (gen + 1u) * nloc) {
            __builtin_amdgcn_fence(__ATOMIC_RELEASE, "agent");
            asm volatile("s_waitcnt vmcnt(0)" ::: "memory");
            const unsigned og = xb_add(&bar[XB_TOP], 1u);
            const unsigned tg = og / nx;
            if (og + 1u == (tg + 1u) * nx) xb_add(&bar[XB_TOPGEN], 1u);
            else XB_SPIN(xb_ld(&bar[XB_TOPGEN]) == tg, bar);
            __builtin_amdgcn_fence(__ATOMIC_ACQUIRE, "agent");
            xb_add(&bar[XB_XGEN(b.x)], 1u);
            asm volatile("s_waitcnt vmcnt(0)" ::: "memory");
        } else {
            XB_SPIN(xb_ld(&bar[XB_XGEN(b.x)]) == gen, bar);
            __builtin_amdgcn_fence(__ATOMIC_ACQUIRE, "agent");
            asm volatile("s_waitcnt vmcnt(0)" ::: "memory");
        }
    }
    __syncthreads();
}

namespace pg8 {
#define PG8_LAS __attribute__((address_space(3)))
typedef unsigned short bf16_t;
typedef short bf16x8 __attribute__((ext_vector_type(8)));
typedef float f32x4 __attribute__((ext_vector_type(4)));
typedef unsigned u32x4 __attribute__((ext_vector_type(4)));
constexpr int BM = 256, BK = 64, HALF = 128, HTB = HALF * BK * 2  , STAGE_BYTES = 8 * HTB, NXCD = 8, WGM = 8;

__host__ __device__ __forceinline__ int lds_byte(int r, int c) { const int st = (r >> 4) * 2 + (c >> 5), rr = r & 15, cc = c & 31, ob = rr * 64 + cc * 2; return st * 1024 + (ob ^ (((ob >> 9) & 1) << 5)); }
__host__ __device__ __forceinline__ void stage_rc(int b, int& R, int& C) { const int st = b / 1024, sb = b % 1024, swz = sb ^ (((sb >> 9) & 1) << 5); R = (st >> 1) * 16 + swz / 64; C = (st & 1) * 32 + (swz % 64) / 2; }
__host__ __device__ __forceinline__ int perm32(int rho) { const int n = rho >> 4, i = rho & 15; return 8 * (i >> 2) + 4 * n + (i & 3); }

struct Unit { int pm, pn; };
struct Gemm { const bf16_t* A; const bf16_t* Bt; int M, N, K; };

struct StaticOrder {
    int nM, nN, nwg, G, c;
    __host__ __device__ void init(int M, int N, int G_, int c_) { nM = M / BM; nN = N / BM; nwg = nM * nN; G = G_; c = c_; }
    __host__ __device__ bool next(int i, Unit& u) const {
        const long L = (long)i * G + c; if (L >= nwg) return false;
        int wgid = (int)L; { const int q = nwg / NXCD, r = nwg % NXCD, xcd = wgid % NXCD, off = wgid / NXCD; wgid = (xcd < r ? xcd * (q + 1) : r * (q + 1) + (xcd - r) * q) + off; }
        const int nig = WGM * nN, gid = wgid / nig, fm = gid * WGM, gsz = (nM - fm) < WGM ? (nM - fm) : WGM;
        u.pm = fm + ((wgid % nig) % gsz); u.pn = (wgid % nig) / gsz; return true;
    }
    __device__ __forceinline__ void a_ready(const Unit&) const {}
    __device__ __forceinline__ void done(const Unit&) const {}
};

__device__ __forceinline__ unsigned cvt_pk_bf16(float lo, float hi) { unsigned r; asm volatile("v_cvt_pk_bf16_f32 %0, %1, %2" : "=v"(r) : "v"(lo), "v"(hi)); return r; }
__device__ __forceinline__ float rstd16(const float* part, int r) {
    const f32x4* p = (const f32x4*)(part + (size_t)r * 16);
    const f32x4 a = p[0], b = p[1], c = p[2], d = p[3];
    const float s = ((a[0] + a[1]) + (a[2] + a[3])) + ((b[0] + b[1]) + (b[2] + b[3])) + ((c[0] + c[1]) + (c[2] + c[3])) + ((d[0] + d[1]) + (d[2] + d[3]));
    return 1.f / sqrtf(s * (1.f / 1024.f) + 1e-6f);
}
__device__ __forceinline__ u32x4 pack8(const f32x4 a, const f32x4 b) { u32x4 w; w.x = cvt_pk_bf16(a[0], a[1]); w.y = cvt_pk_bf16(a[2], a[3]); w.z = cvt_pk_bf16(b[0], b[1]); w.w = cvt_pk_bf16(b[2], b[3]); return w; }
#define rot(t1, t2, c, s) do { const float a_ = (t1) * (c) - (t2) * (s), b_ = (t1) * (s) + (t2) * (c); (t1) = a_; (t2) = b_; } while (0)

struct EpiProj {
    static constexpr bool PERM = true, AFTER_DRAIN = false;
    bf16_t* R; const float* part; const float* rope;
    __device__ __forceinline__ void operator()(const f32x4 (&acc)[2][2][4][2], const Unit& u, int wr, int wc, int fr, int fq) const {
        const int type = u.pn >> 1, hg = u.pn & 1;
        const int colbase = type * 512 + (4 * hg + wc) * 64 + 8 * fq;
        const bool do_rope = (type == 3) || (type == 4);
#pragma unroll
        for (int ai = 0; ai < 2; ++ai)
#pragma unroll
            for (int m = 0; m < 4; ++m) {
                const int r = u.pm * BM + ai * HALF + wr * 64 + m * 16 + fr;
                const float rs = rstd16(part, r);
                f32x4 a0 = acc[ai][0][m][0] * rs, a1 = acc[ai][0][m][1] * rs, b0 = acc[ai][1][m][0] * rs, b1 = acc[ai][1][m][1] * rs;
                if (do_rope) {
                    const f32x4* rp = (const f32x4*)(rope + ((size_t)(r & 2047) * 32 + 8 * fq) * 2);
                    const f32x4 c0 = rp[0], c1 = rp[1], c2 = rp[2], c3 = rp[3];
                    rot(a0[0], b0[0], c0[0], c0[1]); rot(a0[1], b0[1], c0[2], c0[3]); rot(a0[2], b0[2], c1[0], c1[1]); rot(a0[3], b0[3], c1[2], c1[3]);
                    rot(a1[0], b1[0], c2[0], c2[1]); rot(a1[1], b1[1], c2[2], c2[3]); rot(a1[2], b1[2], c3[0], c3[1]); rot(a1[3], b1[3], c3[2], c3[3]);
                }
                bf16_t* rowp = R + (size_t)r * 3584 + colbase;
                *(u32x4*)(rowp) = pack8(a0, a1);
                *(u32x4*)(rowp + 32) = pack8(b0, b1);
            }
    }
};
struct EpiRes {
    static constexpr bool PERM = true, AFTER_DRAIN = false;
    const float* xf; bf16_t* hb; float* part; const float* bias;
    __device__ __forceinline__ void operator()(const f32x4 (&acc)[2][2][4][2], const Unit& u, int wr, int wc, int fr, int fq) const {
        const int col0 = u.pn * BM + wc * 32 + 8 * fq;
        f32x4 bv[2][2];
#pragma unroll
        for (int bj = 0; bj < 2; ++bj)
#pragma unroll
            for (int n = 0; n < 2; ++n) bv[bj][n] = bias ? *(const f32x4*)(bias + col0 + bj * HALF + 4 * n) : (f32x4){0.f, 0.f, 0.f, 0.f};
#pragma unroll
        for (int ai = 0; ai < 2; ++ai)
#pragma unroll
            for (int m = 0; m < 4; ++m) {
                const int r = u.pm * BM + ai * HALF + wr * 64 + m * 16 + fr;
                const size_t off = (size_t)r * 1024 + col0;
                float ss = 0.f;
#pragma unroll
                for (int bj = 0; bj < 2; ++bj) {
                    f32x4 x0, x1;
                    if (xf) { x0 = *(const f32x4*)(xf + off + bj * HALF); x1 = *(const f32x4*)(xf + off + bj * HALF + 4); }
                    else { const u32x4 w = *(const u32x4*)(hb + off + bj * HALF);
                           x0 = (f32x4){__uint_as_float(w[0] << 16), __uint_as_float(w[0] & 0xffff0000u), __uint_as_float(w[1] << 16), __uint_as_float(w[1] & 0xffff0000u)};
                           x1 = (f32x4){__uint_as_float(w[2] << 16), __uint_as_float(w[2] & 0xffff0000u), __uint_as_float(w[3] << 16), __uint_as_float(w[3] & 0xffff0000u)}; }
                    const f32x4 h0 = x0 + acc[ai][bj][m][0] + bv[bj][0], h1 = x1 + acc[ai][bj][m][1] + bv[bj][1];
                    *(u32x4*)(hb + off + bj * HALF) = pack8(h0, h1);
                    ss += (h0[0] * h0[0] + h0[1] * h0[1]) + (h0[2] * h0[2] + h0[3] * h0[3]) + (h1[0] * h1[0] + h1[1] * h1[1]) + (h1[2] * h1[2] + h1[3] * h1[3]);
                }
                ss += __shfl_xor(ss, 16); ss += __shfl_xor(ss, 32);
                if (fq == 0) part[(size_t)r * 16 + 4 * u.pn + wc] = ss;
            }
    }
};
struct EpiQ {
    static constexpr bool PERM = true, AFTER_DRAIN = false;
    bf16_t* O; const float* part;
    __device__ __forceinline__ void operator()(const f32x4 (&acc)[2][2][4][2], const Unit& u, int wr, int wc, int fr, int fq) const {
        const int col0 = u.pn * BM + wc * 32 + 8 * fq;
#pragma unroll
        for (int ai = 0; ai < 2; ++ai)
#pragma unroll
            for (int m = 0; m < 4; ++m) {
                const int r = u.pm * BM + ai * HALF + wr * 64 + m * 16 + fr;
                const float rs = rstd16(part, r);
                bf16_t* rowp = O + (size_t)r * 1024 + col0;
#pragma unroll
                for (int bj = 0; bj < 2; ++bj) *(u32x4*)(rowp + bj * HALF) = pack8(acc[ai][bj][m][0] * rs, acc[ai][bj][m][1] * rs);
            }
    }
};
struct EpiGlu {
    static constexpr bool PERM = true, AFTER_DRAIN = false;
    bf16_t* G; const float* part; const float* b1;
    __device__ __forceinline__ void operator()(const f32x4 (&acc)[2][2][4][2], const Unit& u, int wr, int wc, int fr, int fq) const {
        const int col = u.pn * 128 + wc * 32 + 8 * fq;
        f32x4 ba[2], bg[2];
#pragma unroll
        for (int n = 0; n < 2; ++n) { ba[n] = *(const f32x4*)(b1 + col + 4 * n); bg[n] = *(const f32x4*)(b1 + 1024 + col + 4 * n); }
#pragma unroll
        for (int ai = 0; ai < 2; ++ai)
#pragma unroll
            for (int m = 0; m < 4; ++m) {
                const int r = u.pm * BM + ai * HALF + wr * 64 + m * 16 + fr;
                const float rs = rstd16(part, r);
                f32x4 y[2];
#pragma unroll
                for (int n = 0; n < 2; ++n) {
                    const f32x4 a = acc[ai][0][m][n] * rs + ba[n], g = acc[ai][1][m][n] * rs + bg[n];
#pragma unroll
                    for (int i = 0; i < 4; ++i) y[n][i] = a[i] / (1.f + __expf(-g[i]));
                }
                *(u32x4*)(G + (size_t)r * 1024 + col) = pack8(y[0], y[1]);
            }
    }
};
template <class Epi, class Sched, bool ALIGN_EPI = false, bool SP2 = false>
__device__ __forceinline__ void gemm_phase(PG8_LAS unsigned char* lds, const Gemm g, const Sched& S, const Epi& E, const int wave_id) {
    const int lane = lane_id(), wid = wave_id, tid = wid * 64 + lane, wr = wid >> 2, wc = wid & 3, fr = lane & 15, fq = lane >> 4;
    const int K = g.K, nt = K / BK;
    unsigned voffA[2], voffB[2];
#pragma unroll
    for (int i = 0; i < 2; ++i) { int R, C; stage_rc(tid * 16 + i * 8192, R, C); const int Rb = Epi::PERM ? ((R & ~31) + perm32(R & 31)) : R;
        voffA[i] = (unsigned)(R * K + C) * 2u; voffB[i] = (unsigned)(Rb * K + C) * 2u; }
    const size_t kstep = (size_t)(BK * 2);
    const size_t hstep = (size_t)HALF * K * 2;
    const size_t tstep = 2 * hstep;
    const unsigned ldsw = (unsigned)wid * 1024u;
    const int aoff = lds_byte(wr * 64 + fr, fq * 8), boff = lds_byte(wc * 32 + fr, fq * 8);
#define PG8_SA(b, h) (((b) * 2 + (h)) * HTB)
#define PG8_SB(b, h) ((4 + (b) * 2 + (h)) * HTB)
#define PG8_STAGE(bufoff, gbase, voff) do { _Pragma("unroll") for (int _i = 0; _i < 2; ++_i) \
        __builtin_amdgcn_global_load_lds((const unsigned*)((const char*)(gbase) + (voff)[_i]), (PG8_LAS unsigned*)(lds + (bufoff) + ldsw + _i * 8192), 16, 0, 0); } while (0)
#define PG8_LDA(dst, b, h) do { _Pragma("unroll") for (int m = 0; m < 4; ++m) _Pragma("unroll") for (int k = 0; k < 2; ++k) dst[m][k] = *(const PG8_LAS bf16x8*)(lds + PG8_SA(b, h) + aoff + m * 2048 + k * 1024); } while (0)
#define PG8_LDB(dst, b, h) do { _Pragma("unroll") for (int n = 0; n < 2; ++n) _Pragma("unroll") for (int k = 0; k < 2; ++k) dst[n][k] = *(const PG8_LAS bf16x8*)(lds + PG8_SB(b, h) + boff + n * 2048 + k * 1024); } while (0)
#define PG8_MMA(ai, bj, At, Bt) do { __builtin_amdgcn_s_setprio(1); _Pragma("unroll") for (int m = 0; m < 4; ++m) _Pragma("unroll") for (int n = 0; n < 2; ++n) _Pragma("unroll") for (int k = 0; k < 2; ++k) \
        acc[ai][bj][m][n] = __builtin_amdgcn_mfma_f32_16x16x32_bf16(Bt[n][k], At[m][k], acc[ai][bj][m][n], 0, 0, 0); __builtin_amdgcn_s_setprio(0); } while (0)
#define PG8_WAIT_V(n) asm volatile("s_waitcnt vmcnt(" #n ")" ::: "memory")
#define PG8_WAIT_L(n) asm volatile("s_waitcnt lgkmcnt(" #n ")" ::: "memory")
#define PG8_BAR __builtin_amdgcn_s_barrier()
#define PG8_SCHED __builtin_amdgcn_sched_barrier(0)
    Unit cur, nxt; int ui = 0;
    if (!S.next(0, cur)) return;
    f32x4 acc[2][2][4][2];
#pragma unroll
    for (int a = 0; a < 2; ++a)
#pragma unroll
        for (int b = 0; b < 2; ++b)
#pragma unroll
            for (int m = 0; m < 4; ++m)
#pragma unroll
                for (int n = 0; n < 2; ++n) acc[a][b][m][n] = (f32x4){0.f, 0.f, 0.f, 0.f};
    bf16x8 At[4][2], B0[2][2], B1[2][2];
    const char* cA = (const char*)g.A + (size_t)cur.pm * tstep; const char* cB = (const char*)g.Bt + (size_t)cur.pn * tstep;
    S.a_ready(cur);
    if constexpr (SP2) {
        PG8_STAGE(PG8_SB(0, 0), cB, voffB); PG8_STAGE(PG8_SB(0, 1), cB + hstep, voffB); PG8_STAGE(PG8_SA(0, 0), cA, voffA); PG8_STAGE(PG8_SA(0, 1), cA + hstep, voffA);
        if (wr == 1) PG8_BAR;
        PG8_WAIT_V(2); PG8_BAR;
        PG8_STAGE(PG8_SB(1, 0), cB + kstep, voffB); PG8_STAGE(PG8_SA(1, 0), cA + kstep, voffA); PG8_STAGE(PG8_SB(1, 1), cB + hstep + kstep, voffB);
        PG8_WAIT_V(6); PG8_BAR;
    } else {
        PG8_STAGE(PG8_SB(0, 0), cB, voffB); PG8_STAGE(PG8_SA(0, 0), cA, voffA); PG8_STAGE(PG8_SB(0, 1), cB + hstep, voffB); PG8_STAGE(PG8_SA(0, 1), cA + hstep, voffA);
        if (wr == 1) PG8_BAR;
        PG8_WAIT_V(4); PG8_BAR;
        PG8_STAGE(PG8_SB(1, 0), cB + kstep, voffB); PG8_STAGE(PG8_SA(1, 0), cA + kstep, voffA); PG8_STAGE(PG8_SB(1, 1), cB + hstep + kstep, voffB);
        PG8_WAIT_V(6); PG8_BAR;
    }
    for (;;) {
        const bool has_next = S.next(ui + 1, nxt);
        const char* nA = has_next ? (const char*)g.A + (size_t)nxt.pm * tstep : cA; const char* nB = has_next ? (const char*)g.Bt + (size_t)nxt.pn * tstep : cB;
        for (int t = 0; t < nt; t += 2) {
            const bool last = (t == nt - 2);
            const char* a1 = cA + (size_t)(t + 1) * kstep;
            const char* a2 = last ? nA : cA + (size_t)(t + 2) * kstep; const char* b2 = last ? nB : cB + (size_t)(t + 2) * kstep;
            const char* a3 = a2 + kstep; const char* b3 = b2 + kstep;
            if (last && has_next) S.a_ready(nxt);
            if constexpr (SP2) {
            PG8_LDB(B0, 0, 0); PG8_LDB(B1, 0, 1); PG8_SCHED; PG8_LDA(At, 0, 0); PG8_STAGE(PG8_SA(1, 1), a1 + hstep, voffA);
            PG8_WAIT_V(8); PG8_WAIT_L(0); PG8_BAR; PG8_MMA(0, 0, At, B0); PG8_MMA(0, 1, At, B1); PG8_BAR; PG8_SCHED;
            PG8_LDA(At, 0, 1); PG8_STAGE(PG8_SB(0, 0), b2, voffB); PG8_STAGE(PG8_SB(0, 1), b2 + hstep, voffB); PG8_STAGE(PG8_SA(0, 0), a2, voffA);
            PG8_WAIT_V(8); PG8_WAIT_L(0); PG8_BAR; PG8_MMA(1, 0, At, B0); PG8_MMA(1, 1, At, B1); PG8_BAR; PG8_SCHED;
            PG8_LDB(B0, 1, 0); PG8_LDB(B1, 1, 1); PG8_SCHED; PG8_LDA(At, 1, 0); PG8_STAGE(PG8_SA(0, 1), a2 + hstep, voffA);
            PG8_WAIT_V(8); PG8_WAIT_L(0); PG8_BAR; PG8_MMA(0, 0, At, B0); PG8_MMA(0, 1, At, B1); PG8_BAR; PG8_SCHED;
            PG8_LDA(At, 1, 1); PG8_STAGE(PG8_SB(1, 0), b3, voffB); PG8_STAGE(PG8_SB(1, 1), b3 + hstep, voffB); PG8_STAGE(PG8_SA(1, 0), a3, voffA);
            PG8_WAIT_V(8); PG8_WAIT_L(0); PG8_BAR; PG8_MMA(1, 0, At, B0); PG8_MMA(1, 1, At, B1); PG8_BAR; PG8_SCHED;
            } else {
            PG8_LDB(B0, 0, 0); PG8_SCHED; PG8_LDA(At, 0, 0); PG8_STAGE(PG8_SA(1, 1), a1 + hstep, voffA);
            PG8_WAIT_L(8); PG8_BAR; PG8_WAIT_L(0); PG8_MMA(0, 0, At, B0); PG8_BAR; PG8_SCHED;
            PG8_LDB(B1, 0, 1); PG8_STAGE(PG8_SB(0, 0), b2, voffB);
            PG8_BAR; PG8_WAIT_L(0); PG8_MMA(0, 1, At, B1); PG8_BAR;
            PG8_LDA(At, 0, 1); PG8_STAGE(PG8_SA(0, 0), a2, voffA);
            PG8_BAR; PG8_WAIT_L(0); PG8_MMA(1, 0, At, B0); PG8_BAR; PG8_SCHED;
            PG8_STAGE(PG8_SB(0, 1), b2 + hstep, voffB);
            PG8_WAIT_V(6); PG8_BAR; PG8_MMA(1, 1, At, B1); PG8_BAR;
            PG8_LDB(B0, 1, 0); PG8_SCHED; PG8_LDA(At, 1, 0); PG8_STAGE(PG8_SA(0, 1), a2 + hstep, voffA);
            PG8_WAIT_L(8); PG8_BAR; PG8_WAIT_L(0); PG8_MMA(0, 0, At, B0); PG8_BAR; PG8_SCHED;
            PG8_LDB(B1, 1, 1); PG8_STAGE(PG8_SB(1, 0), b3, voffB);
            PG8_BAR; PG8_WAIT_L(0); PG8_MMA(0, 1, At, B1); PG8_BAR;
            PG8_LDA(At, 1, 1); PG8_STAGE(PG8_SA(1, 0), a3, voffA);
            PG8_BAR; PG8_WAIT_L(0); PG8_MMA(1, 0, At, B0); PG8_BAR; PG8_SCHED;
            PG8_STAGE(PG8_SB(1, 1), b3 + hstep, voffB);
            PG8_WAIT_V(6); PG8_BAR; PG8_MMA(1, 1, At, B1); PG8_BAR;
            }
        }
        if constexpr (ALIGN_EPI) { if (wr == 0) PG8_BAR; }
        if constexpr (!Epi::AFTER_DRAIN) { E(acc, cur, wr, wc, fr, fq); S.done(cur); }
        if (!has_next) break;
#pragma unroll
        for (int a = 0; a < 2; ++a)
#pragma unroll
            for (int b = 0; b < 2; ++b)
#pragma unroll
                for (int m = 0; m < 4; ++m)
#pragma unroll
                    for (int n = 0; n < 2; ++n) acc[a][b][m][n] = (f32x4){0.f, 0.f, 0.f, 0.f};
        cur = nxt; cA = nA; cB = nB; ++ui;
        if constexpr (ALIGN_EPI) { if (wr == 1) PG8_BAR; }
    }
    PG8_WAIT_V(0);
    if constexpr (!ALIGN_EPI) { if (wr == 0) PG8_BAR; }
    PG8_BAR;
    if constexpr (Epi::AFTER_DRAIN) { E.fused(acc, cur, wr, wc, fr, fq, lds, wid, lane); S.done(cur); }
#undef PG8_SA
#undef PG8_SB
#undef PG8_STAGE
#undef PG8_LDA
#undef PG8_LDB
#undef PG8_MMA
#undef PG8_WAIT_V
#undef PG8_WAIT_L
#undef PG8_BAR
#undef PG8_SCHED
}
}

struct Frame {
    LAS unsigned char* lds;
    int wave, G, bid;
    const float *x, *mix_norm, *ffn_norm, *final_norm, *w_in, *w_out, *rel_bias, *conv_w1, *conv_b1, *conv_dw, *conv_dw_b, *conv_ln_g, *conv_ln_b, *conv_w2, *conv_b2,
        *peer_wq, *peer_keys, *peer_u, *peer_v;
    float* out;
    unsigned char* ws;
};
#define FRAME_IDS const int f_lane = lane_id(); const int f_tid = F.wave * 64 + f_lane; (void)f_tid
DI float gamma_of(int h) { return 1.f - exp2f(-5.f - (float)h); }

DI void p0_prep(Frame& F) {
    FRAME_IDS;
    const int gw = F.bid * NWAVES + F.wave, NGW = F.G * NWAVES;
    f32x2* rope = (f32x2*)(F.ws + WS_ROPE);
    for (int i = F.bid * NTHR + f_tid; i < SEQ * 32; i += F.G * NTHR) {
        const int s = i >> 5, j = i & 31;
        const float inv = powf(10000.f, -(float)j / 32.f);
        const float ang = (float)s * inv;
        float sn, cs; sincosf(ang, &sn, &cs);
        rope[i] = (f32x2){cs, sn};
    }
    bf16* xb = (bf16*)(F.ws + WS_XB); float* part = (float*)(F.ws + WS_PART);
    for (int m = gw; m < T; m += NGW) {
        const f32x4* xr = (const f32x4*)(F.x + (size_t)m * DM) + f_lane;
        u32x2* o = (u32x2*)(xb + (size_t)m * DM) + f_lane;
        float s = 0.f;
#pragma unroll
        for (int j = 0; j < 4; ++j) { const f32x4 v = xr[64 * j]; s += v.x * v.x + v.y * v.y + v.z * v.z + v.w * v.w; o[64 * j] = (u32x2){pk2(v.x, v.y), pk2(v.z, v.w)}; }
        s = wave_sum(s);
        if (f_lane < 16) part[(size_t)m * 16 + f_lane] = (f_lane == 0) ? s : 0.f;
    }
}
DI void p0_transpose_item(const float* W, int K, int N, bf16* WT, int prow0, const float* gain, float scale, LAS float* scr, int k0, int n0, int lane) {
#pragma unroll 8
    for (int i = 0; i < 32; ++i) { const int kk = 2 * i + (lane >> 5); scr[kk * 33 + (lane & 31)] = W[(size_t)(k0 + kk) * N + n0 + (lane & 31)] * (gain ? gain[k0 + kk] : 1.f) * scale; }
    asm volatile("s_waitcnt lgkmcnt(0)" ::: "memory");
    const int c = lane & 7;
#pragma unroll
    for (int j = 0; j < 4; ++j) { const int n = (lane >> 3) + 8 * j; const LAS float* q = scr + (8 * c) * 33 + n;
        u32x4 o; o.x = pk2(q[0 * 33], q[1 * 33]); o.y = pk2(q[2 * 33], q[3 * 33]); o.z = pk2(q[4 * 33], q[5 * 33]); o.w = pk2(q[6 * 33], q[7 * 33]);
        *(u32x4*)(WT + (size_t)(prow0 + n) * K + k0 + 8 * c) = o; }
    asm volatile("s_waitcnt lgkmcnt(0)" ::: "memory");
}
DI void p0_weights(Frame& F) {
    FRAME_IDS;
    LAS float* scr = (LAS float*)(F.lds + F.wave * 16384);
    const int gw = F.bid * NWAVES + F.wave, NGW = F.G * NWAVES;
    constexpr int I_IN = 16 * (INC / 32), I_SQ = 16 * (DM / 32), I_W1 = 16 * (2 * DM / 32);
    constexpr int NITEMS = I_IN + I_SQ + I_W1 + I_SQ + 2 * I_SQ;
    for (int it = gw; it < NITEMS; it += NGW) {
        int r = it;
        if (r < I_IN) { const int nb = r % (INC / 32), kb = r / (INC / 32), n0 = nb * 32;
            const int type = n0 / 512, head = (n0 % 512) / 64, bj = (n0 % 64) / 32;
            const int prow0 = 256 * (2 * type + head / 4) + 128 * bj + 32 * (head % 4);
            p0_transpose_item(F.w_in, DM, INC, (bf16*)(F.ws + WS_WIN), prow0, F.mix_norm, (type == 0 || type == 4) ? 0.125f : 1.f, scr, kb * 64, n0, f_lane); continue; }
        r -= I_IN;
        if (r < I_SQ) { const int nb = r % 32, kb = r / 32; p0_transpose_item(F.w_out, DM, DM, (bf16*)(F.ws + WS_WOUT), nb * 32, nullptr, 1.f, scr, kb * 64, nb * 32, f_lane); continue; }
        r -= I_SQ;
        if (r < I_W1) { const int nb = r % 64, kb = r / 64, n0 = nb * 32; const int bj = n0 / 1024, rem = n0 % 1024;
            p0_transpose_item(F.conv_w1, DM, 2 * DM, (bf16*)(F.ws + WS_W1), 256 * (rem / 128) + 128 * bj + (rem % 128), F.mix_norm + DM, 1.f, scr, kb * 64, n0, f_lane); continue; }
        r -= I_W1;
        if (r < I_SQ) { const int nb = r % 32, kb = r / 32; p0_transpose_item(F.conv_w2, DM, DM, (bf16*)(F.ws + WS_W2), nb * 32, nullptr, 1.f, scr, kb * 64, nb * 32, f_lane); continue; }
        r -= I_SQ;
        { const int layer = r / I_SQ; r %= I_SQ; const int nb = r % 32, kb = r / 32;
          p0_transpose_item(F.peer_wq + (size_t)layer * DM * DM, DM, DM, (bf16*)(F.ws + WS_WQ) + (size_t)layer * DM * DM, nb * 32, F.ffn_norm + layer * DM, 1.f, scr, kb * 64, nb * 32, f_lane); }
    }
}
DI float row_rstd(const float* part, int m) {
    const f32x4* p = (const f32x4*)(part + (size_t)m * 16);
    const f32x4 a = p[0], b = p[1], c = p[2], d = p[3];
    const float s = ((a.x + a.y) + (a.z + a.w)) + ((b.x + b.y) + (b.z + b.w)) + ((c.x + c.y) + (c.z + c.w)) + ((d.x + d.y) + (d.z + d.w));
    return 1.f / sqrtf(s * (1.f / DM) + EPS);
}

typedef short v4i16 __attribute__((ext_vector_type(4)));
typedef __bf16 bf16x2_t __attribute__((ext_vector_type(2)));
DI unsigned cvtpk(float lo, float hi) { f32x2 v = {lo, hi}; bf16x2_t b = __builtin_convertvector(v, bf16x2_t); return __builtin_bit_cast(unsigned, b); }
DI v4i16 ds_tr16(LAS const unsigned char* p) { return __builtin_amdgcn_ds_read_tr16_b64_v4i16((LAS v4i16*)p); }
DI int crow(int r, int h) { return (r & 3) + 8 * (r >> 2) + 4 * h; }
DI bf16x8 pack_step(const f32x16& x, const int s) {
    u32x4 w = {cvtpk(x[8 * s + 0], x[8 * s + 1]), cvtpk(x[8 * s + 2], x[8 * s + 3]), cvtpk(x[8 * s + 4], x[8 * s + 5]), cvtpk(x[8 * s + 6], x[8 * s + 7])};
    return __builtin_bit_cast(bf16x8, w);
}
constexpr int AT_KB = 64 * 144, AT_VB = 8192, AT_BUF = AT_KB + AT_VB, AT_BIAS = 2 * AT_BUF;
DI void attn_item(Frame& F, const int it) {
    FRAME_IDS;
    const bf16* R = (const bf16*)(F.ws + WS_R); bf16* O = (bf16*)(F.ws + WS_O);
    LAS unsigned char* lds = F.lds;
    LAS float* bias_s = (LAS float*)(lds + AT_BIAS);
    const int q32 = f_lane & 31, h = f_lane >> 5, w = F.wave;
    const int srow = f_tid >> 3, sch = f_tid & 7;
    const int vtr_off = ((f_lane & 15) >> 2) * 64 + (16 * ((f_lane >> 4) & 1) + 4 * (f_lane & 3)) * 2;
    {
        const int b = it / (NHA * 8), hd = (it / 8) % NHA, c0 = (it % 8) * 4;
        const int c = c0 + (w >> 1), qrow0 = 32 * (w & 1);
        const size_t tq = (size_t)b * SEQ + c * 64 + qrow0 + q32;
        __syncthreads();
        for (int k = f_tid; k < 257; k += NTHR) bias_s[k] = F.rel_bias[hd * 257 + k];
        bf16x8 qf[4];
#pragma unroll
        for (int ks = 0; ks < 4; ++ks) qf[ks] = *(const bf16x8*)(R + tq * INC + C_QA + hd * 64 + 16 * ks + 8 * h);
        const int t_lo = c0 - 8 < 0 ? 0 : c0 - 8, t_hi = c0 + 3, ntile = t_hi - t_lo + 1;
        const bf16* kbase = R + ((size_t)b * SEQ + srow) * INC + C_KA + hd * 64 + 8 * sch;
        const bf16* vbase = R + ((size_t)b * SEQ + srow) * INC + C_VA + hd * 64 + 8 * sch;
        u32x4 kreg = *(const u32x4*)(kbase + (size_t)t_lo * 64 * INC), vreg = *(const u32x4*)(vbase + (size_t)t_lo * 64 * INC);
        *(LAS u32x4*)(lds + srow * 144 + sch * 16) = kreg;
        *(LAS u32x4*)(lds + AT_KB + (sch >> 2) * 4096 + srow * 64 + (sch & 3) * 16) = vreg;
        __syncthreads();
        const float bias_far = bias_s[256];
        float m = -1e30f, l = 0.f;
        f32x16 o0 = {}, o1 = {};
        for (int i = 0; i < ntile; ++i) {
            const int tc = t_lo + i;
            LAS unsigned char* kb = lds + (i & 1) * AT_BUF; LAS unsigned char* vb = kb + AT_KB;
            if (i + 1 < ntile) { kreg = *(const u32x4*)(kbase + (size_t)(tc + 1) * 64 * INC); vreg = *(const u32x4*)(vbase + (size_t)(tc + 1) * 64 * INC); }
            const int D = c - tc;
            if (D >= 0 && D <= 8) {
                const float init = D >= 3 ? bias_far : 0.f;
                f32x16 p0, p1;
#pragma unroll
                for (int r = 0; r < 16; ++r) { p0[r] = init; p1[r] = init; }
#pragma unroll
                for (int ks = 0; ks < 4; ++ks) {
                    const bf16x8 k0 = *(const LAS bf16x8*)(kb + q32 * 144 + (16 * ks + 8 * h) * 2);
                    const bf16x8 k1 = *(const LAS bf16x8*)(kb + (32 + q32) * 144 + (16 * ks + 8 * h) * 2);
                    p0 = __builtin_amdgcn_mfma_f32_32x32x16_bf16(k0, qf[ks], p0, 0, 0, 0);
                    p1 = __builtin_amdgcn_mfma_f32_32x32x16_bf16(k1, qf[ks], p1, 0, 0, 0);
                }
                if (D < 3) {
                    const int relb = D * 64 + qrow0 + q32 - 4 * h + 128;
#pragma unroll
                    for (int r = 0; r < 16; ++r) {
                        const int r0 = relb - ((r & 3) + 8 * (r >> 2));
                        const int i0 = r0 < 0 ? 0 : (r0 > 256 ? 256 : r0), r1 = r0 - 32, i1 = r1 < 0 ? 0 : (r1 > 256 ? 256 : r1);
                        p0[r] += bias_s[i0]; p1[r] += bias_s[i1];
                    }
                }
                float tm = fmaxf(p0[0], p1[0]);
#pragma unroll
                for (int r = 1; r < 16; ++r) tm = fmaxf(tm, fmaxf(p0[r], p1[r]));
                tm = fmaxf(tm, __shfl_xor(tm, 32));
                const float mn = fmaxf(m, tm), alpha = __expf(m - mn);
                m = mn;
                float ps = 0.f;
#pragma unroll
                for (int r = 0; r < 16; ++r) { p0[r] = __expf(p0[r] - mn); p1[r] = __expf(p1[r] - mn); ps += p0[r] + p1[r]; }
                l = l * alpha + ps;
#pragma unroll
                for (int r = 0; r < 16; ++r) { o0[r] *= alpha; o1[r] *= alpha; }
                bf16x8 pf[4];
                pf[0] = pack_step(p0, 0); pf[1] = pack_step(p0, 1); pf[2] = pack_step(p1, 0); pf[3] = pack_step(p1, 1);
#pragma unroll
                for (int kk = 0; kk < 4; ++kk) {
                    const int key0 = 16 * kk + 4 * h;
                    const v4i16 a0l = ds_tr16(vb + key0 * 64 + vtr_off), a0h = ds_tr16(vb + (key0 + 8) * 64 + vtr_off);
                    const v4i16 a1l = ds_tr16(vb + 4096 + key0 * 64 + vtr_off), a1h = ds_tr16(vb + 4096 + (key0 + 8) * 64 + vtr_off);
                    const bf16x8 a0 = __builtin_shufflevector(a0l, a0h, 0, 1, 2, 3, 4, 5, 6, 7), a1 = __builtin_shufflevector(a1l, a1h, 0, 1, 2, 3, 4, 5, 6, 7);
                    o0 = __builtin_amdgcn_mfma_f32_32x32x16_bf16(a0, pf[kk], o0, 0, 0, 0);
                    o1 = __builtin_amdgcn_mfma_f32_32x32x16_bf16(a1, pf[kk], o1, 0, 0, 0);
                }
            }
            if (i + 1 < ntile) {
                LAS unsigned char* nb = lds + ((i + 1) & 1) * AT_BUF;
                *(LAS u32x4*)(nb + srow * 144 + sch * 16) = kreg;
                *(LAS u32x4*)(nb + AT_KB + (sch >> 2) * 4096 + srow * 64 + (sch & 3) * 16) = vreg;
            }
            __syncthreads();
        }
        l += __shfl_xor(l, 32);
        const float inv = 1.f / l;
        bf16* op = O + tq * DM + hd * 64 + 4 * h;
#pragma unroll
        for (int g = 0; g < 4; ++g) {
            *(u32x2*)(op + 8 * g) = (u32x2){cvtpk(o0[4 * g] * inv, o0[4 * g + 1] * inv), cvtpk(o0[4 * g + 2] * inv, o0[4 * g + 3] * inv)};
            *(u32x2*)(op + 32 + 8 * g) = (u32x2){cvtpk(o1[4 * g] * inv, o1[4 * g + 1] * inv), cvtpk(o1[4 * g + 2] * inv, o1[4 * g + 3] * inv)};
        }
    }
    __syncthreads();
}

constexpr int RT_Q = 0, RT_K = 9216, RT_KD = 18432, RT_V = 26624, RT_BUF = 34816, RT_ZS = 2 * RT_BUF, RT_CS = RT_ZS + 64 * 66 * 4;
DI void ret_item(Frame& F, const int it) {
    FRAME_IDS;
    const bf16* R = (const bf16*)(F.ws + WS_R); bf16* O = (bf16*)(F.ws + WS_O);
    LAS unsigned char* lds = F.lds;
    LAS float* Zs = (LAS float*)(lds + RT_ZS); LAS float* Cs = (LAS float*)(lds + RT_CS);
    const int b = it / NHB, hd = it % NHB;
    const int q32 = f_lane & 31, h = f_lane >> 5, w = F.wave;
    const int role = w >> 2, itile = (w >> 1) & 1, etile = w & 1;
    const int srow = f_tid >> 3, sch = f_tid & 7;
    const int vtr_off = ((f_lane & 15) >> 2) * 64 + (16 * ((f_lane >> 4) & 1) + 4 * (f_lane & 3)) * 2;
    const float l2g = log2f(gamma_of(hd));
    const float cd = exp2f(l2g * 64.f), sdec = exp2f(l2g * (float)(63 - srow));
    float qdv[16];
#pragma unroll
    for (int r = 0; r < 16; ++r) qdv[r] = exp2f(l2g * (float)(32 * itile + crow(r, h) + 1));
    f32x16 xs0 = {}, xs1 = {};
    const size_t trow0 = (size_t)b * SEQ;
    const bf16* gq = R + (trow0 + srow) * INC + hd * 64 + 8 * sch;
    u32x4 qreg = *(const u32x4*)(gq + C_QB), kreg = *(const u32x4*)(gq + C_KB), vreg = *(const u32x4*)(gq + C_VB);
    __syncthreads();
#define RT_STAGE(bufp) do { LAS unsigned char* bp_ = (bufp); \
        *(LAS u32x4*)(bp_ + RT_Q + srow * 144 + sch * 16) = qreg; *(LAS u32x4*)(bp_ + RT_K + srow * 144 + sch * 16) = kreg; \
        *(LAS u32x4*)(bp_ + RT_V + (sch >> 2) * 4096 + srow * 64 + (sch & 3) * 16) = vreg; \
        u32x4 kd_; \
        _Pragma("unroll") for (int e_ = 0; e_ < 4; ++e_) kd_[e_] = cvtpk(__uint_as_float(kreg[e_] << 16) * sdec, __uint_as_float(kreg[e_] & 0xffff0000u) * sdec); \
        *(LAS u32x4*)(bp_ + RT_KD + (sch >> 2) * 4096 + srow * 64 + (sch & 3) * 16) = kd_; } while (0)
    RT_STAGE(lds);
    __syncthreads();
    for (int n = 0; n < NCH; ++n) {
        LAS unsigned char* bp = lds + (n & 1) * RT_BUF;
        if (n + 1 < NCH) { const bf16* g1 = gq + (size_t)(n + 1) * 64 * INC; qreg = *(const u32x4*)(g1 + C_QB); kreg = *(const u32x4*)(g1 + C_KB); vreg = *(const u32x4*)(g1 + C_VB); }
        unsigned short gr[8];
#pragma unroll
        for (int r = 0; r < 8; ++r) gr[r] = R[(trow0 + n * 64 + 8 * w + r) * INC + C_GB + hd * 64 + f_lane];
        if (role == 0) {
            bf16x8 qf[4];
#pragma unroll
            for (int ks = 0; ks < 4; ++ks) qf[ks] = *(const LAS bf16x8*)(bp + RT_Q + (32 * itile + q32) * 144 + (16 * ks + 8 * h) * 2);
            f32x16 st0 = {}, st1 = {};
#pragma unroll
            for (int ks = 0; ks < 4; ++ks) {
                const bf16x8 k0 = *(const LAS bf16x8*)(bp + RT_K + q32 * 144 + (16 * ks + 8 * h) * 2);
                const bf16x8 k1 = *(const LAS bf16x8*)(bp + RT_K + (32 + q32) * 144 + (16 * ks + 8 * h) * 2);
                st0 = __builtin_amdgcn_mfma_f32_32x32x16_bf16(k0, qf[ks], st0, 0, 0, 0);
                st1 = __builtin_amdgcn_mfma_f32_32x32x16_bf16(k1, qf[ks], st1, 0, 0, 0);
            }
            int iiv = 32 * itile + q32 - 4 * h; asm volatile("" : "+v"(iiv));
#pragma unroll
            for (int r = 0; r < 16; ++r) {
                const int dd = iiv - ((r & 3) + 8 * (r >> 2));
                st0[r] *= __builtin_amdgcn_exp2f(l2g * fabsf((float)dd));
                st1[r] *= __builtin_amdgcn_exp2f(l2g * fabsf((float)(dd - 32)));
            }
            f32x16 z = {};
#pragma unroll
            for (int kk = 0; kk < 4; ++kk) {
                const int key0 = 16 * kk + 4 * h;
                const v4i16 bl = ds_tr16(bp + RT_V + etile * 4096 + key0 * 64 + vtr_off), bh = ds_tr16(bp + RT_V + etile * 4096 + (key0 + 8) * 64 + vtr_off);
                const bf16x8 vb = __builtin_shufflevector(bl, bh, 0, 1, 2, 3, 4, 5, 6, 7);
                const bf16x8 xa = (kk < 2) ? pack_step(st0, kk & 1) : pack_step(st1, kk & 1);
                z = __builtin_amdgcn_mfma_f32_32x32x16_bf16(xa, vb, z, 0, 0, 0);
            }
            int zb = (32 * itile + 4 * h) * 66 + 32 * etile + q32; asm volatile("" : "+v"(zb));
#pragma unroll
            for (int r = 0; r < 16; ++r) Zs[zb + ((r & 3) + 8 * (r >> 2)) * 66] = z[r];
        } else {
            f32x16 cr = {};
#pragma unroll
            for (int kk = 0; kk < 4; ++kk) {
                const LAS unsigned char* qp = bp + RT_Q + (32 * itile + q32) * 144 + (16 * kk + 4 * h) * 2;
                const v4i16 al = *(const LAS v4i16*)qp, ah = *(const LAS v4i16*)(qp + 16);
                const bf16x8 qa = __builtin_shufflevector(al, ah, 0, 1, 2, 3, 4, 5, 6, 7);
                const bf16x8 xb = (kk < 2) ? pack_step(xs0, kk & 1) : pack_step(xs1, kk & 1);
                cr = __builtin_amdgcn_mfma_f32_32x32x16_bf16(qa, xb, cr, 0, 0, 0);
            }
            int cb = (32 * itile + 4 * h) * 66 + 32 * etile + q32; asm volatile("" : "+v"(cb));
#pragma unroll
            for (int r = 0; r < 16; ++r) Cs[cb + ((r & 3) + 8 * (r >> 2)) * 66] = cr[r] * qdv[r];
#pragma unroll
            for (int r = 0; r < 16; ++r) { xs0[r] *= cd; xs1[r] *= cd; }
#pragma unroll
            for (int s4 = 0; s4 < 4; ++s4) {
                const int key0 = 16 * s4 + 8 * h;
                const v4i16 vl = ds_tr16(bp + RT_V + etile * 4096 + key0 * 64 + vtr_off), vh = ds_tr16(bp + RT_V + etile * 4096 + (key0 + 4) * 64 + vtr_off);
                const bf16x8 vb = __builtin_shufflevector(vl, vh, 0, 1, 2, 3, 4, 5, 6, 7);
                const v4i16 a0l = ds_tr16(bp + RT_KD + key0 * 64 + vtr_off), a0h = ds_tr16(bp + RT_KD + (key0 + 4) * 64 + vtr_off);
                const v4i16 a1l = ds_tr16(bp + RT_KD + 4096 + key0 * 64 + vtr_off), a1h = ds_tr16(bp + RT_KD + 4096 + (key0 + 4) * 64 + vtr_off);
                const bf16x8 ka0 = __builtin_shufflevector(a0l, a0h, 0, 1, 2, 3, 4, 5, 6, 7), ka1 = __builtin_shufflevector(a1l, a1h, 0, 1, 2, 3, 4, 5, 6, 7);
                xs0 = __builtin_amdgcn_mfma_f32_32x32x16_bf16(ka0, vb, xs0, 0, 0, 0);
                xs1 = __builtin_amdgcn_mfma_f32_32x32x16_bf16(ka1, vb, xs1, 0, 0, 0);
            }
        }
        __syncthreads();
#pragma unroll
        for (int r = 0; r < 8; ++r) {
            const int i = 8 * w + r;
            const float v = Zs[i * 66 + f_lane] + Cs[i * 66 + f_lane];
            const float mu = wave_sum(v) * (1.f / 64.f);
            const float dv = v - mu;
            const float var = wave_sum(dv * dv) * (1.f / 64.f);
            const float g = bf2f(gr[r]);
            O[(trow0 + n * 64 + i) * DM + 512 + hd * 64 + f_lane] = (bf16)f2bf(dv * (1.f / sqrtf(var + EPS)) * (g / (1.f + __expf(-g))));
        }
        if (n + 1 < NCH) RT_STAGE(lds + ((n + 1) & 1) * RT_BUF);
        __syncthreads();
    }
#undef RT_STAGE
}
DI void mix_phase(Frame& F, const int rep) {
    FRAME_IDS;
    unsigned* ctr = (unsigned*)(F.ws + WS_CTL) + CW_QUEUE + 64 * rep;
    volatile LAS unsigned* slot = (volatile LAS unsigned*)(F.lds + MISC_OFF) + 16;
    for (;;) {
        __syncthreads();
        if (f_tid == 0) slot[0] = __hip_atomic_fetch_add(ctr, 1u, __ATOMIC_RELAXED, __HIP_MEMORY_SCOPE_AGENT);
        __syncthreads();
        const int idx = (int)slot[0];
        if (idx >= NB * NHB + NB * NHA * 8) break;
        if (idx < NB * NHB) ret_item(F, idx); else attn_item(F, idx - NB * NHB);
    }
}
DI float fmax_raw(float a, float b) { float r; asm("v_max_f32_e32 %0, %1, %2" : "=v"(r) : "v"(a), "v"(b)); return r; }
DI float fmin_raw(float a, float b) { float r; asm("v_min_f32_e32 %0, %1, %2" : "=v"(r) : "v"(a), "v"(b)); return r; }
#define CE_DESC(x, y) do { const float hi_ = fmax_raw((x), (y)), lo_ = fmin_raw((x), (y)); (x) = hi_; (y) = lo_; } while (0)
template <int N> DI void sort_desc(float* v) {
#pragma unroll
    for (int k = 2; k <= N; k <<= 1)
#pragma unroll
        for (int j = k >> 1; j > 0; j >>= 1)
#pragma unroll
            for (int i = 0; i < N; ++i) { const int l = i ^ j; if (l > i) { if ((i & k) == 0 || k == N) CE_DESC(v[i], v[l]); else CE_DESC(v[l], v[i]); } }
}
DI void merge16(float* a, const float* b) {
#pragma unroll
    for (int i = 0; i < 16; ++i) a[i] = fmax_raw(a[i], b[15 - i]);
#pragma unroll
    for (int j = 8; j > 0; j >>= 1)
#pragma unroll
        for (int i = 0; i < 16; ++i) { const int l = i ^ j; if (l > i) CE_DESC(a[i], a[l]); }
}
DI float key_pack(float v, unsigned keep_mask, unsigned idx) { return __uint_as_float((__float_as_uint(v) & keep_mask) | idx); }
DI void opt_route(Frame& F, int layer) {
    FRAME_IDS;
    const bf16* Q = (const bf16*)(F.ws + WS_Q);
    int* eidx = (int*)(F.ws + WS_EIDX); float* gate = (float*)(F.ws + WS_GATE);
    const float* keys = F.peer_keys + (size_t)layer * 2 * PK * 64;
    LAS unsigned char* kl = F.lds;
    __syncthreads();
    for (int idx = f_tid; idx < 2 * PK * 8; idx += NTHR) {
        const int row = idx >> 3, ch = idx & 7;
        const f32x4 a = *(const f32x4*)(keys + (size_t)row * 64 + ch * 8), b = *(const f32x4*)(keys + (size_t)row * 64 + ch * 8 + 4);
        *(LAS u32x4*)(kl + row * 144 + ch * 16) = (u32x4){pk2(a[0], a[1]), pk2(a[2], a[3]), pk2(b[0], b[1]), pk2(b[2], b[3])};
    }
    __syncthreads();
    LAS int* lut = (LAS int*)(F.lds + 40960 + F.wave * 8192);
    const int c = f_lane & 31, h = f_lane >> 5;
    const int gw = F.bid * NWAVES + F.wave, NGW = F.G * NWAVES;
    for (int task = gw; task < (T / 32) * PH; task += NGW) {
        const int tile = task >> 3, hh = task & 7, t = tile * 32 + c;
        float tk[2][16];
#pragma unroll
        for (int side = 0; side < 2; ++side) {
            bf16x8 qf[4];
#pragma unroll
            for (int ks = 0; ks < 4; ++ks) qf[ks] = *(const bf16x8*)(Q + (size_t)t * DM + hh * PQD + side * 64 + 16 * ks + 8 * h);
            float v[64];
#pragma unroll
            for (int kt = 0; kt < 4; ++kt) {
                f32x16 acc = {};
#pragma unroll
                for (int ks = 0; ks < 4; ++ks) {
                    const bf16x8 a = *(const LAS bf16x8*)(kl + (side * PK + 32 * kt + c) * 144 + (16 * ks + 8 * h) * 2);
                    acc = __builtin_amdgcn_mfma_f32_32x32x16_bf16(a, qf[ks], acc, 0, 0, 0);
                }
#pragma unroll
                for (int r = 0; r < 16; ++r) v[16 * kt + r] = key_pack(acc[r], 0xFFFFFF80u, (unsigned)(32 * kt + (r & 3) + 8 * (r >> 2) + 4 * h));
            }
            sort_desc<16>(v); sort_desc<16>(v + 16); sort_desc<16>(v + 32); sort_desc<16>(v + 48);
            merge16(v, v + 16); merge16(v + 32, v + 48); merge16(v, v + 32);
            float pr[16];
#pragma unroll
            for (int i = 0; i < 16; ++i) pr[i] = __shfl_xor(v[i], 32);
            merge16(v, pr);
#pragma unroll
            for (int i = 0; i < 16; ++i) { tk[side][i] = v[i]; lut[(side * 16 + i) * 64 + f_lane] = (int)(__float_as_uint(v[i]) & 0x7Fu); }
        }
        float cd[64];
        {   int n = 0;
#pragma unroll
            for (int a = 0; a < 16; ++a)
#pragma unroll
                for (int b = 0; b < 16; ++b) if ((a + 1) * (b + 1) <= 16) { cd[n] = key_pack(tk[0][a] + tk[1][b], 0xFFFFFF00u, (unsigned)(a * 16 + b)); ++n; }
#pragma unroll
            for (int i = 50; i < 64; ++i) cd[i] = -INFINITY;
        }
        sort_desc<16>(cd); sort_desc<16>(cd + 16); sort_desc<16>(cd + 32); CE_DESC(cd[48], cd[49]);
        merge16(cd, cd + 16); merge16(cd + 32, cd + 48); merge16(cd, cd + 32);
        int ex[16]; float gv[16]; float sum = 0.f;
        const float top = __uint_as_float(__float_as_uint(cd[0]) & 0xFFFFFF00u);
#pragma unroll
        for (int i = 0; i < 16; ++i) {
            const unsigned bits = __float_as_uint(cd[i]);
            const int a = (bits >> 4) & 15, b = bits & 15;
            ex[i] = lut[a * 64 + f_lane] * PK + lut[(16 + b) * 64 + f_lane];
            gv[i] = __expf(__uint_as_float(bits & 0xFFFFFF00u) - top); sum += gv[i];
        }
        const float inv = 1.f / sum;
        if (h == 0) {
            u32x4* ep = (u32x4*)(eidx + (size_t)t * NSEL + hh * 16);
#pragma unroll
            for (int q = 0; q < 4; ++q) ep[q] = (u32x4){(unsigned)ex[4 * q], (unsigned)ex[4 * q + 1], (unsigned)ex[4 * q + 2], (unsigned)ex[4 * q + 3]};
        } else {
            f32x4* gp = (f32x4*)(gate + (size_t)t * NSEL + hh * 16);
#pragma unroll
            for (int q = 0; q < 4; ++q) gp[q] = (f32x4){gv[4 * q] * inv, gv[4 * q + 1] * inv, gv[4 * q + 2] * inv, gv[4 * q + 3] * inv};
        }
    }
    __syncthreads();
}
DI unsigned q8x4(f32x4 v, const float sc) {
    const int a = (int)rintf(v[0] * sc), b = (int)rintf(v[1] * sc), c = (int)rintf(v[2] * sc), d = (int)rintf(v[3] * sc);
    return ((unsigned)a & 0xFFu) | (((unsigned)b & 0xFFu) << 8) | (((unsigned)c & 0xFFu) << 16) | ((unsigned)d << 24);
}
DI void p0_int8(Frame& F) {
    FRAME_IDS;
    const int gw = F.bid * NWAVES + F.wave, NGW = F.G * NWAVES;
    float* SC = (float*)(F.ws + WS_SC);
    for (int row = gw; row < 4 * PE; row += NGW) {
        const int tab = row / PE, e = row % PE, layer = tab & 1, isv = tab >> 1;
        const float* src = (isv ? F.peer_v : F.peer_u) + ((size_t)layer * PE + e) * DM;
        unsigned* dst = (unsigned*)(F.ws + (isv ? WS_V8 : WS_U8)) + (size_t)layer * 8 * PE * 32;
        const f32x4* sp = (const f32x4*)src + f_lane;
        const f32x4* gp = (const f32x4*)(F.ffn_norm + layer * DM) + f_lane;
        f32x4 v[4]; float am = 0.f;
#pragma unroll
        for (int j = 0; j < 4; ++j) { v[j] = sp[64 * j]; if (!isv) v[j] = v[j] * gp[64 * j]; am = fmaxf(am, fmaxf(fmaxf(fabsf(v[j][0]), fabsf(v[j][1])), fmaxf(fabsf(v[j][2]), fabsf(v[j][3])))); }
        am = wave_max(am);
        const float sc = am > 0.f ? 127.f / am : 0.f;
#pragma unroll
        for (int j = 0; j < 4; ++j) dst[((size_t)(2 * j + (f_lane >> 5)) * PE + e) * 32 + (f_lane & 31)] = q8x4(v[j], sc);
        if (f_lane == 0) SC[tab * PE + e] = am * (1.f / 127.f);
    }
}
DI float dot16_fp8(const u32x4 r, const float (&xs)[16]) {
    float s0 = 0.f, s1 = 0.f;
#pragma unroll
    for (int w = 0; w < 4; ++w) {
        const f32x2 lo = __builtin_amdgcn_cvt_pk_f32_fp8((int)r[w], false), hi = __builtin_amdgcn_cvt_pk_f32_fp8((int)r[w], true);
        s0 = fmaf(lo[0], xs[4 * w + 0], s0); s1 = fmaf(lo[1], xs[4 * w + 1], s1); s0 = fmaf(hi[0], xs[4 * w + 2], s0); s1 = fmaf(hi[1], xs[4 * w + 3], s1);
    }
    return s0 + s1;
}
DI void axpy16_fp8(const u32x4 r, const float a, float (&o)[16]) {
#pragma unroll
    for (int w = 0; w < 4; ++w) {
        const f32x2 lo = __builtin_amdgcn_cvt_pk_f32_fp8((int)r[w], false), hi = __builtin_amdgcn_cvt_pk_f32_fp8((int)r[w], true);
        o[4 * w + 0] = fmaf(a, lo[0], o[4 * w + 0]); o[4 * w + 1] = fmaf(a, lo[1], o[4 * w + 1]); o[4 * w + 2] = fmaf(a, hi[0], o[4 * w + 2]); o[4 * w + 3] = fmaf(a, hi[1], o[4 * w + 3]);
    }
}
DI float red_combine(const int level, const float a, const float b, const int lane) {
    const int M = 32 >> level; const bool bit = (lane & M) != 0;
    const float send = bit ? a : b, keep = bit ? b : a;
    return keep + __shfl_xor(send, M);
}
constexpr int brev6(int k) { return ((k & 1) << 5) | ((k & 2) << 3) | ((k & 4) << 1) | ((k & 8) >> 1) | ((k & 16) >> 3) | ((k & 32) >> 5); }
struct XInfo { int xrank, nx, rank, nloc; };
DI XInfo get_xinfo(Frame& F, const bool census) {
    FRAME_IDS;
    volatile LAS unsigned* M = (volatile LAS unsigned*)(F.lds + MISC_OFF);
    __syncthreads();
    if (f_tid == 0) {
        unsigned xr = (unsigned)F.bid & 7u, nx = 8u, rk = (unsigned)F.bid >> 3, nl = ((unsigned)F.G + 7u - ((unsigned)F.bid & 7u)) >> 3;
        if (census) {
            unsigned* bar = (unsigned*)(F.ws + WS_CTL) + CW_BAR; const unsigned x = xb_xcc_id();
            unsigned cnt = 0u, below = 0u, mine = 0u;
#pragma unroll
            for (unsigned j = 0; j < 16; ++j) { const unsigned c = xb_ld(&bar[XB_XCNT(j)]); cnt += (c > 0u); below += (c > 0u && j < x); mine = (j == x) ? c : mine; }
            if (cnt > 0u && mine > 0u) { xr = below; nx = cnt; rk = M[12]; nl = mine; }
        }
        M[20] = xr; M[21] = nx; M[22] = rk; M[23] = nl;
    }
    __syncthreads();
    XInfo xi; xi.xrank = (int)M[20]; xi.nx = (int)M[21]; xi.rank = (int)M[22]; xi.nloc = (int)M[23];
    return xi;
}
DI int comb_c(const int level, const int a, const int b, const int lane) {
    const int M = 4 >> level; const bool bit = (lane & M) != 0;
    const int send = bit ? a : b, keep = bit ? b : a;
    return keep + __shfl_xor(send, M);
}
DI int dot16_i8(const u32x4 r, const u32x4 x) {
    int s = __builtin_amdgcn_sdot4((int)r[0], (int)x[0], 0, false);
    s = __builtin_amdgcn_sdot4((int)r[1], (int)x[1], s, false); s = __builtin_amdgcn_sdot4((int)r[2], (int)x[2], s, false); s = __builtin_amdgcn_sdot4((int)r[3], (int)x[3], s, false);
    return s;
}
DI int half_dots(const u32x4 (&rows)[8], const u32x4 xq, const int lane) {
    int p[8];
#pragma unroll
    for (int i = 0; i < 8; ++i) p[i] = dot16_i8(rows[i], xq);
#pragma unroll
    for (int i = 0; i < 4; ++i) p[i] = comb_c(0, p[2 * i], p[2 * i + 1], lane);
    p[0] = comb_c(1, p[0], p[1], lane); p[1] = comb_c(1, p[2], p[3], lane);
    return comb_c(2, p[0], p[1], lane);
}
DI u32x4 xquant(const f32x4 (&hv)[4], const float rstd) {
    u32x4 o;
#pragma unroll
    for (int w = 0; w < 4; ++w) {
        const f32x4 x = hv[w] * (rstd * XQ);
        const int a = (int)rintf(__builtin_amdgcn_fmed3f(x[0], -127.f, 127.f)), b = (int)rintf(__builtin_amdgcn_fmed3f(x[1], -127.f, 127.f)), c = (int)rintf(__builtin_amdgcn_fmed3f(x[2], -127.f, 127.f)), d = (int)rintf(__builtin_amdgcn_fmed3f(x[3], -127.f, 127.f));
        o[w] = ((unsigned)a & 0xFFu) | (((unsigned)b & 0xFFu) << 8) | (((unsigned)c & 0xFFu) << 16) | ((unsigned)d << 24);
    }
    return o;
}
DI float rstd_bcast(const float* part, const int t) {
    const f32x4* p = (const f32x4*)(part + (size_t)t * 16);
    const f32x4 a = p[0], b = p[1], c = p[2], d = p[3];
    const float s = ((a[0] + a[1]) + (a[2] + a[3])) + ((b[0] + b[1]) + (b[2] + b[3])) + ((c[0] + c[1]) + (c[2] + c[3])) + ((d[0] + d[1]) + (d[2] + d[3]));
    return 1.f / sqrtf(s * (1.f / DM) + EPS);
}
#ifndef PROBE_MODE
#define PROBE_MODE 1
#endif
DI void gather_u(Frame& F, const int layer, const XInfo xi, const bool dry) {
    FRAME_IDS;
    const unsigned emask = (dry && PROBE_MODE == 2) ? 15u : 0xFFFFFFFFu;
    const int* eidx = (const int*)(F.ws + WS_EIDX); int* PU = (int*)(F.ws + (dry ? WS_R : WS_PU)); const float* part = (const float*)(F.ws + WS_PART); const bf16* hbp = (const bf16*)(F.ws + WS_XB);
    const int g = f_lane >> 3, c = f_lane & 7, c16 = c * 16;
    const int kst = 16 * g + (((c & 1) << 2) | (c & 2) | ((c & 4) >> 2));
    const int gwl = xi.rank * NWAVES + F.wave, NGWL = xi.nloc * NWAVES;
    LAS unsigned char* wl = F.lds + F.wave * 2048;
    __syncthreads();
    for (int j = xi.xrank; j < 8; j += xi.nx) {
        const __amdgpu_buffer_rsrc_t U8 = __builtin_amdgcn_make_buffer_rsrc((void*)(F.ws + WS_U8 + ((size_t)(layer * 8 + j) * PE) * 128), 0, PE * 128, 0x00020000);
        int t = gwl;
        if (t >= T) continue;
#define U_LOAD(tt, ri, rh, rp) do { ri = *(const u32x2*)(eidx + (size_t)(tt) * NSEL + 2 * f_lane) & emask; { const unsigned hw_ = *(const unsigned*)(hbp + (size_t)(tt) * DM + 128 * j + 2 * f_lane); rh = (f32x2){__uint_as_float(hw_ << 16), __uint_as_float(hw_ & 0xffff0000u)}; } \
            rp = part[(size_t)(tt) * 16 + (f_lane & 15)]; } while (0)
#define U_SPREAD(slot, ri, rh, rp, e, xqv) do { \
            float ps_ = rp; ps_ += __shfl_xor(ps_, 1); ps_ += __shfl_xor(ps_, 2); ps_ += __shfl_xor(ps_, 4); ps_ += __shfl_xor(ps_, 8); \
            const float rs_ = (1.f / sqrtf(ps_ * (1.f / DM) + EPS)) * XQ; \
            const int q0_ = (int)rintf(__builtin_amdgcn_fmed3f(rh[0] * rs_, -127.f, 127.f)), q1_ = (int)rintf(__builtin_amdgcn_fmed3f(rh[1] * rs_, -127.f, 127.f)); \
            LAS unsigned char* sl_ = wl + (slot) * 1024; \
            *(LAS u32x2*)(sl_ + 8 * f_lane) = ri; *(LAS unsigned short*)(sl_ + 512 + 2 * f_lane) = (unsigned short)(((unsigned)q0_ & 0xFFu) | (((unsigned)q1_ & 0xFFu) << 8)); \
            asm volatile("s_waitcnt lgkmcnt(0)" ::: "memory"); \
            _Pragma("unroll") for (int q_ = 0; q_ < 4; ++q_) e[q_] = *(const LAS u32x4*)(sl_ + 64 * g + 16 * q_); \
            xqv = *(const LAS u32x4*)(sl_ + 512 + c16); } while (0)
        u32x2 ri; f32x2 rh; float rp;
        u32x4 e0[4], e1[4], xq, xq1;
        U_LOAD(t, ri, rh, rp); U_SPREAD(0, ri, rh, rp, e0, xq);
        { const int t1 = (t + NGWL < T) ? t + NGWL : t; U_LOAD(t1, ri, rh, rp); U_SPREAD(1, ri, rh, rp, e1, xq1); }
        { const int t2 = (t + 2 * NGWL < T) ? t + 2 * NGWL : t; U_LOAD(t2, ri, rh, rp); }
        u32x4 A0[8], B0[8], A1[8], B1[8];
#pragma unroll
        for (int i = 0; i < 8; ++i) A0[i] = __builtin_amdgcn_raw_buffer_load_b128(U8, (int)e0[i >> 2][i & 3] * 128 + c16, 0, 0);
#pragma unroll
        for (int i = 0; i < 8; ++i) B0[i] = __builtin_amdgcn_raw_buffer_load_b128(U8, (int)e0[2 + (i >> 2)][i & 3] * 128 + c16, 0, 0);
#define U_ITEM(CA, CB, NA, NB, slot) do { \
            _Pragma("unroll") for (int i = 0; i < 8; ++i) NA[i] = __builtin_amdgcn_raw_buffer_load_b128(U8, (int)e1[i >> 2][i & 3] * 128 + c16, 0, 0); \
            asm volatile("" ::: "memory"); \
            const int r0 = half_dots(CA, xq, f_lane); \
            _Pragma("unroll") for (int i = 0; i < 8; ++i) NB[i] = __builtin_amdgcn_raw_buffer_load_b128(U8, (int)e1[2 + (i >> 2)][i & 3] * 128 + c16, 0, 0); \
            asm volatile("" ::: "memory"); \
            const int rr1 = half_dots(CB, xq, f_lane); \
            int* pp = PU + ((size_t)t * 8 + j) * NSEL + kst; \
            pp[0] = r0; pp[8] = rr1; \
            xq = xq1; \
            U_SPREAD(slot, ri, rh, rp, e1, xq1);                        \
            { const int t3 = (t + 3 * NGWL < T) ? t + 3 * NGWL : t; U_LOAD(t3, ri, rh, rp); } } while (0)
        for (;;) {
            U_ITEM(A0, B0, A1, B1, 0); t += NGWL; if (t >= T) break;
            U_ITEM(A1, B1, A0, B0, 1); t += NGWL; if (t >= T) break;
        }
#undef U_ITEM
#undef U_LOAD
#undef U_SPREAD
    }
    __syncthreads();
}
DI void gather_r(Frame& F, const int layer) {
    FRAME_IDS;
    const int* PU = (const int*)(F.ws + WS_PU); const float* gate = (const float*)(F.ws + WS_GATE); const int* eidx = (const int*)(F.ws + WS_EIDX);
    const float* SCu = (const float*)(F.ws + WS_SC) + (size_t)layer * PE; const float* SCv = (const float*)(F.ws + WS_SC) + (size_t)(2 + layer) * PE;
    signed char* A8 = (signed char*)(F.ws + WS_A); float* SA = (float*)(F.ws + WS_SA);
    const int gw = F.bid * NWAVES + F.wave, NGW = F.G * NWAVES;
    for (int t = gw; t < T; t += NGW) {
#pragma unroll
        for (int hf = 0; hf < 2; ++hf) {
            const int k = 64 * hf + f_lane;
            int sacc = 0;
#pragma unroll
            for (int j = 0; j < 8; ++j) sacc += PU[((size_t)t * 8 + j) * NSEL + k];
            const int e = eidx[(size_t)t * NSEL + k];
            const float d = (float)sacc * (SCu[e] * (1.f / XQ));
            const float a = gelu_erf(d) * gate[(size_t)t * NSEL + k] * SCv[e];
            float am = fabsf(a);
#pragma unroll
            for (int o = 1; o < 16; o <<= 1) am = fmaxf(am, __shfl_xor(am, o));
            const float sc = am > 0.f ? 127.f / am : 0.f;
            A8[(size_t)t * NSEL + k] = (signed char)(int)rintf(a * sc);
            if ((f_lane & 15) == 0) SA[(size_t)t * 8 + (k >> 4)] = am * (1.f / 127.f);
        }
    }
}
DI void tr4x4(const unsigned w0, const unsigned w1, const unsigned w2, const unsigned w3, unsigned (&cdw)[4]) {
    const unsigned t01l = __builtin_amdgcn_perm(w1, w0, 0x05010400u), t01h = __builtin_amdgcn_perm(w1, w0, 0x07030602u);
    const unsigned t23l = __builtin_amdgcn_perm(w3, w2, 0x05010400u), t23h = __builtin_amdgcn_perm(w3, w2, 0x07030602u);
    cdw[0] = __builtin_amdgcn_perm(t23l, t01l, 0x05040100u); cdw[1] = __builtin_amdgcn_perm(t23l, t01l, 0x07060302u);
    cdw[2] = __builtin_amdgcn_perm(t23h, t01h, 0x05040100u); cdw[3] = __builtin_amdgcn_perm(t23h, t01h, 0x07060302u);
}
DI void axpy4rows(const u32x4 r0, const u32x4 r1, const u32x4 r2, const u32x4 r3, const unsigned a4, int (&acc)[16]) {
#pragma unroll
    for (int d = 0; d < 4; ++d) {
        unsigned cdw[4];
        tr4x4(r0[d], r1[d], r2[d], r3[d], cdw);
#pragma unroll
        for (int i = 0; i < 4; ++i) acc[4 * d + i] = __builtin_amdgcn_sdot4((int)cdw[i], (int)a4, acc[4 * d + i], false);
    }
}
DI void gather_v(Frame& F, const int layer, const XInfo xi, const bool dry) {
    FRAME_IDS;
    const int* eidx = (const int*)(F.ws + WS_EIDX); const unsigned char* A8 = F.ws + WS_A; const float* SA = (const float*)(F.ws + WS_SA);
    float* part_w = dry ? (float*)(F.ws + WS_R) : (float*)(F.ws + WS_PART); bf16* hb_w = dry ? (bf16*)(F.ws + WS_HID2) : (bf16*)(F.ws + WS_XB); const bf16* hbp = (const bf16*)(F.ws + WS_XB);
    const int g = f_lane >> 3, c = f_lane & 7, c16 = c * 16;
    const int cc = 16 * c + 8 * (g >> 2) + 4 * ((g >> 1) & 1) + 2 * (g & 1);
    const int gwl = xi.rank * NWAVES + F.wave, NGWL = xi.nloc * NWAVES;
    const bool b5 = (f_lane & 32) != 0, b4 = (f_lane & 16) != 0, b3 = (f_lane & 8) != 0;
    LAS unsigned char* wl = F.lds + F.wave * 2048;
    __syncthreads();
    for (int j = xi.xrank; j < 8; j += xi.nx) {
        const __amdgpu_buffer_rsrc_t V8 = __builtin_amdgcn_make_buffer_rsrc((void*)(F.ws + WS_V8 + ((size_t)(layer * 8 + j) * PE) * 128), 0, PE * 128, 0x00020000);
        int t = gwl;
        if (t >= T) continue;
#define V_LOAD(tt, ri, ra, rs) do { ri = *(const u32x2*)(eidx + (size_t)(tt) * NSEL + 2 * f_lane); ra = *(const unsigned short*)(A8 + (size_t)(tt) * NSEL + 2 * f_lane); rs = SA[(size_t)(tt) * 8 + (f_lane & 7)]; } while (0)
#define V_SPREAD(slot, ri, ra, rs, e, avv, sav) do { \
            LAS unsigned char* sl_ = wl + (slot) * 1024; \
            *(LAS u32x2*)(sl_ + 8 * f_lane) = ri; *(LAS unsigned short*)(sl_ + 512 + 2 * f_lane) = ra; if (f_lane < 8) *(LAS float*)(sl_ + 640 + 4 * f_lane) = rs; \
            asm volatile("s_waitcnt lgkmcnt(0)" ::: "memory"); \
            _Pragma("unroll") for (int q_ = 0; q_ < 4; ++q_) e[q_] = *(const LAS u32x4*)(sl_ + 64 * g + 16 * q_); \
            avv = *(const LAS u32x4*)(sl_ + 512 + 16 * g); sav = *(const LAS float*)(sl_ + 640 + 4 * g); } while (0)
        u32x2 ri; unsigned short ra; float rs;
        u32x4 e0[4], e1[4], av, a1; float sa, sa1; f32x2 hold;
        V_LOAD(t, ri, ra, rs); V_SPREAD(0, ri, ra, rs, e0, av, sa);
        { const int t1 = (t + NGWL < T) ? t + NGWL : t; V_LOAD(t1, ri, ra, rs); V_SPREAD(1, ri, ra, rs, e1, a1, sa1); }
        { const int t2 = (t + 2 * NGWL < T) ? t + 2 * NGWL : t; V_LOAD(t2, ri, ra, rs); }
        { const unsigned hw_ = *(const unsigned*)(hbp + (size_t)t * DM + 128 * j + cc); hold = (f32x2){__uint_as_float(hw_ << 16), __uint_as_float(hw_ & 0xffff0000u)}; }
        u32x4 A0[8], B0[8], A1[8], B1[8];
#pragma unroll
        for (int i = 0; i < 8; ++i) A0[i] = __builtin_amdgcn_raw_buffer_load_b128(V8, (int)e0[i >> 2][i & 3] * 128 + c16, 0, 0);
#pragma unroll
        for (int i = 0; i < 8; ++i) B0[i] = __builtin_amdgcn_raw_buffer_load_b128(V8, (int)e0[2 + (i >> 2)][i & 3] * 128 + c16, 0, 0);
#define V_ITEM(CA, CB, NA, NB, slot) do { \
            const int t1 = (t + NGWL < T) ? t + NGWL : t; \
            const unsigned hw1_ = *(const unsigned*)(hbp + (size_t)t1 * DM + 128 * j + cc); \
            _Pragma("unroll") for (int i = 0; i < 8; ++i) NA[i] = __builtin_amdgcn_raw_buffer_load_b128(V8, (int)e1[i >> 2][i & 3] * 128 + c16, 0, 0); \
            asm volatile("" ::: "memory"); \
            int acc[16]; \
            _Pragma("unroll") for (int n = 0; n < 16; ++n) acc[n] = 0; \
            axpy4rows(CA[0], CA[1], CA[2], CA[3], av[0], acc); axpy4rows(CA[4], CA[5], CA[6], CA[7], av[1], acc); \
            _Pragma("unroll") for (int i = 0; i < 8; ++i) NB[i] = __builtin_amdgcn_raw_buffer_load_b128(V8, (int)e1[2 + (i >> 2)][i & 3] * 128 + c16, 0, 0); \
            asm volatile("" ::: "memory"); \
            axpy4rows(CB[0], CB[1], CB[2], CB[3], av[2], acc); axpy4rows(CB[4], CB[5], CB[6], CB[7], av[3], acc); \
            float o[16]; \
            _Pragma("unroll") for (int n = 0; n < 16; ++n) o[n] = (float)acc[n] * sa; \
            float r8[8], r4[4], r2[2]; \
            _Pragma("unroll") for (int n = 0; n < 8; ++n) { const float keep = b5 ? o[8 + n] : o[n], send = b5 ? o[n] : o[8 + n]; r8[n] = keep + __shfl_xor(send, 32); } \
            _Pragma("unroll") for (int n = 0; n < 4; ++n) { const float keep = b4 ? r8[4 + n] : r8[n], send = b4 ? r8[n] : r8[4 + n]; r4[n] = keep + __shfl_xor(send, 16); } \
            _Pragma("unroll") for (int n = 0; n < 2; ++n) { const float keep = b3 ? r4[2 + n] : r4[n], send = b3 ? r4[n] : r4[2 + n]; r2[n] = keep + __shfl_xor(send, 8); } \
            const float h0 = hold[0] + r2[0], h1v = hold[1] + r2[1]; \
            const float ss = wave_sum(h0 * h0 + h1v * h1v); \
            *(unsigned*)(hb_w + (size_t)t * DM + 128 * j + cc) = cvtpk(h0, h1v); \
            if (f_lane == 0) part_w[(size_t)t * 16 + j] = ss; \
            if (j == 0 && f_lane >= 8 && f_lane < 16) part_w[(size_t)t * 16 + f_lane] = 0.f; \
            av = a1; sa = sa1; hold = (f32x2){__uint_as_float(hw1_ << 16), __uint_as_float(hw1_ & 0xffff0000u)}; \
            V_SPREAD(slot, ri, ra, rs, e1, a1, sa1); \
            { const int t3 = (t + 3 * NGWL < T) ? t + 3 * NGWL : t; V_LOAD(t3, ri, ra, rs); } } while (0)
        for (;;) {
            V_ITEM(A0, B0, A1, B1, 0); t += NGWL; if (t >= T) break;
            V_ITEM(A1, B1, A0, B0, 1); t += NGWL; if (t >= T) break;
        }
#undef V_ITEM
#undef V_LOAD
#undef V_SPREAD
    }
    __syncthreads();
}
DI void final_norm(Frame& F) {
    FRAME_IDS;
    const float* part = (const float*)(F.ws + WS_PART); const bf16* hbp = (const bf16*)(F.ws + WS_XB);
    const int gw = F.bid * NWAVES + F.wave, NGW = F.G * NWAVES;
    for (int t = gw; t < T; t += NGW) {
        const float r = rstd_bcast(part, t);
        const u32x2* hp = (const u32x2*)(hbp + (size_t)t * DM) + f_lane;
        f32x4* op = (f32x4*)(F.out + (size_t)t * DM) + f_lane;
        const f32x4* gp = (const f32x4*)F.final_norm + f_lane;
#pragma unroll
        for (int q = 0; q < 4; ++q) { const u32x2 w = hp[64 * q];
            const f32x4 h = {__uint_as_float(w[0] << 16), __uint_as_float(w[0] & 0xffff0000u), __uint_as_float(w[1] << 16), __uint_as_float(w[1] & 0xffff0000u)};
            op[64 * q] = h * r * gp[64 * q]; }
    }
}
DI void opt_conv(Frame& F) {
    FRAME_IDS;
    const bf16* G = (const bf16*)(F.ws + WS_GLU); bf16* H2 = (bf16*)(F.ws + WS_HID2);
    LAS float* ys = (LAS float*)F.lds;
    float wt0[CW], wt1[CW];
#pragma unroll
    for (int j = 0; j < CW; ++j) { const f32x2 wv = *(const f32x2*)(F.conv_dw + j * DM + 2 * f_tid); wt0[j] = wv[0]; wt1[j] = wv[1]; }
    const f32x2 bdw = *(const f32x2*)(F.conv_dw_b + 2 * f_tid);
    for (int it = F.bid; it < T / 128; it += F.G) {
        const int s0 = (it % (SEQ / 128)) * 128;
        const size_t row0 = (size_t)it * 128;
        const unsigned* gp = (const unsigned*)G + f_tid;
        unsigned win[CW];
#pragma unroll
        for (int u = 0; u < CW - 1; ++u) { const int sp = s0 - (CW - 1) + u; win[u + 1] = sp >= 0 ? gp[(row0 - (CW - 1) + u) * 512] : 0u; }
        win[0] = 0u;
        for (int bt = 0; bt < 5; ++bt) {
            unsigned nx[CW];
#pragma unroll
            for (int u = 0; u < CW; ++u) { const int sl = 31 * bt + u; nx[u] = (s0 + sl < SEQ) ? gp[(row0 + sl) * 512] : 0u; }
            __syncthreads();
#pragma unroll
            for (int u = 0; u < CW; ++u) {
                win[u] = nx[u];
                float a0 = bdw[0], a1 = bdw[1];
#pragma unroll
                for (int j = 0; j < CW; ++j) {
                    const unsigned xv = win[(u + 1 + j) % CW];
                    a0 = fmaf(wt0[j], __uint_as_float(xv << 16), a0); a1 = fmaf(wt1[j], __uint_as_float(xv & 0xffff0000u), a1);
                }
                *(LAS f32x2*)(ys + u * DM + 2 * f_tid) = (f32x2){a0, a1};
            }
            __syncthreads();
            for (int u = F.wave; u < CW; u += NWAVES) {
                const int sl = 31 * bt + u;
                if (sl < 128) {
                    f32x4 v[4]; float sm = 0.f;
#pragma unroll
                    for (int k = 0; k < 4; ++k) { v[k] = *(const LAS f32x4*)(ys + u * DM + 256 * k + 4 * f_lane); sm += (v[k][0] + v[k][1]) + (v[k][2] + v[k][3]); }
                    const float mu = wave_sum(sm) * (1.f / DM);
                    float sq = 0.f;
#pragma unroll
                    for (int k = 0; k < 4; ++k) { v[k] = v[k] - mu; sq += (v[k][0] * v[k][0] + v[k][1] * v[k][1]) + (v[k][2] * v[k][2] + v[k][3] * v[k][3]); }
                    const float rs = 1.f / sqrtf(wave_sum(sq) * (1.f / DM) + EPS);
#pragma unroll
                    for (int k = 0; k < 4; ++k) {
                        const f32x4 g = *(const f32x4*)(F.conv_ln_g + 256 * k + 4 * f_lane), bb = *(const f32x4*)(F.conv_ln_b + 256 * k + 4 * f_lane);
                        f32x4 z = v[k] * rs * g + bb;
#pragma unroll
                        for (int e = 0; e < 4; ++e) z[e] = z[e] / (1.f + __expf(-z[e]));
                        *(u32x2*)(H2 + (row0 + sl) * DM + 256 * k + 4 * f_lane) = (u32x2){cvtpk(z[0], z[1]), cvtpk(z[2], z[3])};
                    }
                }
            }
        }
    }
    __syncthreads();
}
enum Phase { PH_PREP = 0, PH_PROJ, PH_MIX, PH_WOUT, PH_Q0, PH_ROUTE0, PH_GU0, PH_GR0, PH_GV0, PH_W1, PH_CONV, PH_W2, PH_Q1, PH_ROUTE1, PH_GU1, PH_GR1, PH_GV1, PH_FINAL, PH_COUNT };
struct Args { const float* in[19]; float* out; unsigned char* ws; int ph_lo, ph_hi; };
#ifndef TEST_PHASE
#define TEST_PHASE -1
#endif
#ifndef REP_PHASE
#define REP_PHASE -1
#endif

__global__ void __launch_bounds__(NTHR, 2) mega_fwd(Args args) {
    extern __shared__ __attribute__((aligned(16))) unsigned char lds[];
    Frame F;
    F.lds = (LAS unsigned char*)lds;
    F.wave = __builtin_amdgcn_readfirstlane((int)threadIdx.x >> 6); FRAME_IDS;
    F.G = gridDim.x; F.bid = blockIdx.x;
    F.x = args.in[0]; F.mix_norm = args.in[1]; F.ffn_norm = args.in[2]; F.final_norm = args.in[3]; F.w_in = args.in[4]; F.w_out = args.in[5]; F.rel_bias = args.in[6];
    F.conv_w1 = args.in[7]; F.conv_b1 = args.in[8]; F.conv_dw = args.in[9]; F.conv_dw_b = args.in[10]; F.conv_ln_g = args.in[11]; F.conv_ln_b = args.in[12];
    F.conv_w2 = args.in[13]; F.conv_b2 = args.in[14]; F.peer_wq = args.in[15]; F.peer_keys = args.in[16]; F.peer_u = args.in[17]; F.peer_v = args.in[18];
    F.out = args.out; F.ws = args.ws;
    volatile LAS unsigned* MISC = (volatile LAS unsigned*)(F.lds + MISC_OFF);
    for (int u = f_tid; u < (LDS_BYTES - LDSCTL_OFF) / 4; u += NTHR) ((LAS unsigned*)(F.lds + LDSCTL_OFF))[u] = 0u;
    __syncthreads();
    const int lo = args.ph_lo, hi = args.ph_hi;
    XcdBarrier bar; bar.bar = (unsigned*)(F.ws + WS_CTL) + CW_BAR; bar.x = 0; bar.st = nullptr;
    if (hi - lo > 1) bar = xcd_barrier_post((unsigned*)(F.ws + WS_CTL) + CW_BAR, MISC + 8);
#define IN(k) ((TEST_PHASE < 0 || TEST_PHASE == (k)) && lo <= (k) && (k) < hi)
#define SEAM(k) do { if (IN(k) && IN((k) + 1)) xcd_barrier(bar, F.wave); } while (0)
#define REPS(k) for (int rep_ = ((k) == REP_PHASE ? 0 : 1); rep_ < 2; ++rep_)
#define GEMM_PHASE(EPI, Aptr, Bptr, NN, ...) do { pg8::Gemm g{(const bf16*)(Aptr), (const bf16*)(Bptr), T, (NN), DM}; pg8::StaticOrder S; S.init(T, (NN), F.G, F.bid); \
        pg8::EPI E{__VA_ARGS__}; pg8::gemm_phase<pg8::EPI, pg8::StaticOrder, true, true>(F.lds, g, S, E, F.wave); } while (0)
    bf16* XB = (bf16*)(F.ws + WS_XB);
    float* PART = (float*)(F.ws + WS_PART); const float* ROPE = (const float*)(F.ws + WS_ROPE);
    if (IN(PH_PREP)) REPS(PH_PREP) { p0_prep(F); p0_weights(F); p0_int8(F); } SEAM(PH_PREP);
    if (IN(PH_PROJ)) REPS(PH_PROJ) { GEMM_PHASE(EpiProj, XB, F.ws + WS_WIN, INC, (bf16*)(F.ws + WS_R), PART, ROPE); } SEAM(PH_PROJ);
    if (IN(PH_MIX)) REPS(PH_MIX) { mix_phase(F, rep_); } SEAM(PH_MIX);
    if (IN(PH_WOUT)) REPS(PH_WOUT) { GEMM_PHASE(EpiRes, F.ws + WS_O, F.ws + WS_WOUT, DM, F.x, XB, PART, nullptr); } SEAM(PH_WOUT);
    if (IN(PH_Q0)) REPS(PH_Q0) { GEMM_PHASE(EpiQ, XB, F.ws + WS_WQ, DM, (bf16*)(F.ws + WS_Q), PART); } SEAM(PH_Q0);
    if (IN(PH_ROUTE0)) REPS(PH_ROUTE0) { opt_route(F, 0); } SEAM(PH_ROUTE0);
    const bool census = (hi - lo > 1);
    if (IN(PH_GU0)) REPS(PH_GU0) { gather_u(F, 0, get_xinfo(F, census), rep_ == 0); } SEAM(PH_GU0);
    if (IN(PH_GR0)) REPS(PH_GR0) { gather_r(F, 0); } SEAM(PH_GR0);
    if (IN(PH_GV0)) REPS(PH_GV0) { gather_v(F, 0, get_xinfo(F, census), rep_ == 0); } SEAM(PH_GV0);
    if (IN(PH_W1)) REPS(PH_W1) { GEMM_PHASE(EpiGlu, XB, F.ws + WS_W1, 2 * DM, (bf16*)(F.ws + WS_GLU), PART, F.conv_b1); } SEAM(PH_W1);
    if (IN(PH_CONV)) REPS(PH_CONV) { opt_conv(F); } SEAM(PH_CONV);
    if (IN(PH_W2)) { GEMM_PHASE(EpiRes, F.ws + WS_HID2, F.ws + WS_W2, DM, nullptr, XB, PART, F.conv_b2); } SEAM(PH_W2);
    if (IN(PH_Q1)) REPS(PH_Q1) { GEMM_PHASE(EpiQ, XB, F.ws + WS_WQ + (size_t)DM * DM * 2, DM, (bf16*)(F.ws + WS_Q), PART); } SEAM(PH_Q1);
    if (IN(PH_ROUTE1)) REPS(PH_ROUTE1) { opt_route(F, 1); } SEAM(PH_ROUTE1);
    if (IN(PH_GU1)) REPS(PH_GU1) { gather_u(F, 1, get_xinfo(F, census), rep_ == 0); } SEAM(PH_GU1);
    if (IN(PH_GR1)) REPS(PH_GR1) { gather_r(F, 1); } SEAM(PH_GR1);
    if (IN(PH_GV1)) REPS(PH_GV1) { gather_v(F, 1, get_xinfo(F, census), rep_ == 0); } SEAM(PH_GV1);
    if (IN(PH_FINAL)) { final_norm(F); }
#undef IN
#undef SEAM
}

extern "C" void kernel_launch(void* const* d_in, const int* in_sizes, int n_in, void* d_out, int out_size, void* d_ws, size_t ws_size, hipStream_t stream) {
    static int grid = 0;
    if (grid == 0) {
        if (n_in != 19 || out_size != T * DM || ws_size < WS_END) { fprintf(stderr, "kernel_launch: unexpected shapes (n_in %d out %d ws %zu)\n", n_in, out_size, ws_size); grid = -1; return; }
        int dev = 0, cus = 0;
        if (hipGetDevice(&dev) != hipSuccess || hipDeviceGetAttribute(&cus, hipDeviceAttributeMultiprocessorCount, dev) != hipSuccess) { grid = -1; return; }
        if (hipFuncSetAttribute((const void*)mega_fwd, hipFuncAttributeMaxDynamicSharedMemorySize, LDS_BYTES) != hipSuccess) { fprintf(stderr, "kernel_launch: hipFuncSetAttribute failed\n"); grid = -1; return; }
        (void)hipGetLastError();
        grid = cus;
    }
    if (grid < 0) return;
    (void)hipMemsetAsync((char*)d_ws + WS_CTL, 0, CTL_ZERO_BYTES, stream);
    Args a{};
    for (int i = 0; i < 19; ++i) a.in[i] = (const float*)d_in[i];
    a.out = (float*)d_out; a.ws = (unsigned char*)d_ws;
#if MK_ONE_LAUNCH
    a.ph_lo = 0; a.ph_hi = PH_COUNT;
    hipLaunchKernelGGL(mega_fwd, dim3(grid), dim3(NTHR), LDS_BYTES, stream, a);
#else
    for (int p = 0; p < PH_COUNT; ++p) { a.ph_lo = p; a.ph_hi = p + 1; hipLaunchKernelGGL(mega_fwd, dim3(grid), dim3(NTHR), LDS_BYTES, stream, a); }
#endif
}
```

```cpp
#include <hip/hip_runtime.h>
#include <cstdio>
#include <cstdint>

#ifndef REP_PHASE
#define REP_PHASE -1
#endif
#ifndef PROBE_MODE
#define PROBE_MODE 1
#endif
#ifndef MK_ONE_LAUNCH
#define MK_ONE_LAUNCH 1
#endif

#define GAS __attribute__((address_space(1)))
#define LAS __attribute__((address_space(3)))
#define DI __device__ __forceinline__
typedef unsigned short bf16;
typedef float f32x2 __attribute__((ext_vector_type(2)));
typedef float f32x4 __attribute__((ext_vector_type(4)));
typedef unsigned u32x2 __attribute__((ext_vector_type(2)));
typedef unsigned u32x4 __attribute__((ext_vector_type(4)));
typedef short bf16x8 __attribute__((ext_vector_type(8)));
typedef float f32x16 __attribute__((ext_vector_type(16)));

constexpr int NB = 16, SEQ = 2048, DM = 1024, T = NB * SEQ;
constexpr int CHUNK = 64, HD = 64, NHA = 8, NHB = 8, INC = 3584, NCH = SEQ / CHUNK;
constexpr int PH = 8, PK = 128, PE = PK * PK, PQD = 128, PTOP = 16, NSEL = PH * PTOP;
constexpr int CW = 31;
constexpr float EPS = 1e-6f;
constexpr float LOG2E = 1.4426950408889634f;
constexpr float XQ = 127.f / 6.f;
constexpr int NWAVES = 8, NTHR = NWAVES * 64;

constexpr int C_QA = 0, C_KA = 512, C_VA = 1024, C_QB = 1536, C_KB = 2048, C_VB = 2560, C_GB = 3072;

constexpr size_t MiB = 1u << 20;
constexpr size_t WS_CTL = 0, CTL_ZERO_BYTES = 1 * MiB;
constexpr size_t WS_WIN = 2 * MiB, WS_WOUT = 9 * MiB, WS_W1 = 11 * MiB, WS_W2 = 15 * MiB, WS_WQ = 17 * MiB;
constexpr size_t WS_ROPE = 22 * MiB;
constexpr size_t WS_PART = 23 * MiB;
constexpr size_t WS_EIDX = 26 * MiB;
constexpr size_t WS_GATE = 42 * MiB;
constexpr size_t WS_U8 = 64 * MiB, WS_V8 = 96 * MiB;
constexpr size_t WS_SC = 25 * MiB;
constexpr size_t WS_SA = 58 * MiB;
constexpr size_t WS_PU = 256 * MiB;
constexpr size_t WS_A = 384 * MiB;
constexpr size_t WS_XB = 128 * MiB;
constexpr size_t WS_R = 192 * MiB;
constexpr size_t WS_O = 416 * MiB;
constexpr size_t WS_Q = 192 * MiB;
constexpr size_t WS_HID = 256 * MiB;
constexpr size_t WS_GLU = 384 * MiB;
constexpr size_t WS_HID2 = 448 * MiB;
constexpr size_t WS_END = 512 * MiB;
constexpr int CW_BAR = 4096, CW_QUEUE = 8192;

constexpr int RING_BYTES = 131072, LDSCTL_OFF = RING_BYTES, MISC_OFF = LDSCTL_OFF + 320, LDS_BYTES = 147456;

DI float bf2f(bf16 v) { return __uint_as_float(((unsigned)v) << 16); }
DI unsigned f2bf(float f) { unsigned u = __float_as_uint(f); return (u + 0x7fffu + ((u >> 16) & 1u)) >> 16; }
DI unsigned pk2(float lo, float hi) { return f2bf(lo) | (f2bf(hi) << 16); }
#define DPP_MOV_I(x, ctrl) __builtin_amdgcn_mov_dpp((x), (ctrl), 0xF, 0xF, false)
#define DPP_XOR1 0xB1
#define DPP_XOR2 0x4E
#define DPP_HMIRROR 0x141
#define DPP_ROR8 0x128
DI float swap32_add(const float a, const float b) { const auto r = __builtin_amdgcn_permlane32_swap(__float_as_uint(a), __float_as_uint(b), false, false); return __uint_as_float(r[0]) + __uint_as_float(r[1]); }
DI float swap16_add(const float a, const float b) { const auto r = __builtin_amdgcn_permlane16_swap(__float_as_uint(a), __float_as_uint(b), false, false); return __uint_as_float(r[0]) + __uint_as_float(r[1]); }
DI float wave_sum_fast(float v) {
    v += __int_as_float(DPP_MOV_I(__float_as_int(v), DPP_XOR1)); v += __int_as_float(DPP_MOV_I(__float_as_int(v), DPP_XOR2));
    v += __int_as_float(DPP_MOV_I(__float_as_int(v), DPP_HMIRROR)); v += __int_as_float(DPP_MOV_I(__float_as_int(v), DPP_ROR8));
    v = swap16_add(v, v); v = swap32_add(v, v);
    return v;
}
DI float wave_sum(float v) { return wave_sum_fast(v); }
DI float swap32_max(const float a) { const auto r = __builtin_amdgcn_permlane32_swap(__float_as_uint(a), __float_as_uint(a), false, false); return fmaxf(__uint_as_float(r[0]), __uint_as_float(r[1])); }
DI float swap16_max(const float a) { const auto r = __builtin_amdgcn_permlane16_swap(__float_as_uint(a), __float_as_uint(a), false, false); return fmaxf(__uint_as_float(r[0]), __uint_as_float(r[1])); }
DI float wave_max(float v) {
    v = fmaxf(v, __int_as_float(DPP_MOV_I(__float_as_int(v), DPP_XOR1))); v = fmaxf(v, __int_as_float(DPP_MOV_I(__float_as_int(v), DPP_XOR2)));
    v = fmaxf(v, __int_as_float(DPP_MOV_I(__float_as_int(v), DPP_HMIRROR))); v = fmaxf(v, __int_as_float(DPP_MOV_I(__float_as_int(v), DPP_ROR8)));
    v = swap16_max(v); v = swap32_max(v);
    return v;
}
DI float block_sum(float v, LAS float* red, int tid) {
    v = wave_sum(v);
    __syncthreads();
    if ((tid & 63) == 0) red[tid >> 6] = v;
    __syncthreads();
    float s = 0.f;
#pragma unroll
    for (int i = 0; i < NWAVES; ++i) s += red[i];
    return s;
}
DI float gelu_erf(float x) { return 0.5f * x * (1.f + erff(x * 0.70710678118654752f)); }
DI float sigmoidf(float x) { return 1.f / (1.f + __expf(-x)); }

DI int lane_id() { int r; asm volatile("v_mbcnt_lo_u32_b32 %0, -1, 0\n\tv_mbcnt_hi_u32_b32 %0, -1, %0" : "=v"(r)); return r; }
#define XB_TMO      128
#define XB_XCNT(j)  (256  + 64 * (j))
#define XB_XSUB(j)  (1280 + 64 * (j))
#define XB_XGEN(j)  (2304 + 64 * (j))
#define XB_TOP      3328
#define XB_TOPGEN   3392
#define XCD_BAR_WORDS 3456
#define XB_SPIN_CAP (1u << 22)
DI unsigned xb_ld(unsigned* p)              { return __hip_atomic_load(p, __ATOMIC_RELAXED, __HIP_MEMORY_SCOPE_AGENT); }
DI unsigned xb_add(unsigned* p, unsigned v) { return __hip_atomic_fetch_add(p, v, __ATOMIC_RELAXED, __HIP_MEMORY_SCOPE_AGENT); }
DI unsigned xb_xcc_id() { return (unsigned)__builtin_amdgcn_s_getreg((3 << 11) | 20) & 0xFu; }
#define XB_SPIN(cond, bar) do { unsigned _sp = 0; while (cond) { __builtin_amdgcn_s_sleep(1); \
    if ((++_sp & 255u) == 0u) { if (xb_ld(&(bar)[XB_TMO])) break; if (_sp > XB_SPIN_CAP) { atomicAdd(&(bar)[XB_TMO], 1u); break; } } } } while (0)
struct XcdBarrier { unsigned* bar; unsigned x; volatile LAS unsigned* st; };
DI XcdBarrier xcd_barrier_post(unsigned* bar, volatile LAS unsigned* st) {
    XcdBarrier b; b.bar = bar; b.x = xb_xcc_id(); b.st = st;
    if (threadIdx.x == 0) st[4] = xb_add(&bar[XB_XCNT(b.x)], 1u);
    return b;
}
DI void xcd_barrier_complete(unsigned* bar, unsigned x, unsigned& nloc, unsigned& nx) {
    const unsigned G = gridDim.x * gridDim.y * gridDim.z;
    unsigned sum, cnt, mine, sp = 0u;
    for (;;) {
        sum = 0u; cnt = 0u; mine = 0u;
#pragma unroll
        for (unsigned j = 0; j < 16; ++j) { const unsigned c = xb_ld(&bar[XB_XCNT(j)]); sum += c; cnt += (c > 0u) ? 1u : 0u; mine = (j == x) ? c : mine; }
        if (sum == G) break;
        __builtin_amdgcn_s_sleep(1);
        if ((++sp & 255u) == 0u) { if (xb_ld(&bar[XB_TMO])) break; if (sp > XB_SPIN_CAP) { atomicAdd(&bar[XB_TMO], 1u); break; } }
    }
    nloc = mine > 0u ? mine : 1u; nx = cnt > 0u ? cnt : 1u;
}
DI void xcd_barrier(const XcdBarrier& b, const int wave_id) {
    asm volatile("s_waitcnt vmcnt(0)" ::: "memory");
    __syncthreads();
    if (wave_id == 0 && lane_id() == 0) {
        unsigned* bar = b.bar;
        __builtin_amdgcn_s_waitcnt(0);
        unsigned nloc = b.st[0], nx = b.st[1];
        if (nloc == 0u) { xcd_barrier_complete(bar, b.x, nloc, nx); b.st[0] = nloc; b.st[1] = nx; }
        const unsigned old = xb_add(&bar[XB_XSUB(b.x)], 1u);
        const unsigned gen = old / nloc;
        if (old + 1u == (gen + 1u) * nloc) {
            __builtin_amdgcn_fence(__ATOMIC_RELEASE, "agent");
            asm volatile("s_waitcnt vmcnt(0)" ::: "memory");
            const unsigned og = xb_add(&bar[XB_TOP], 1u);
            const unsigned tg = og / nx;
            if (og + 1u == (tg + 1u) * nx) xb_add(&bar[XB_TOPGEN], 1u);
            else XB_SPIN(xb_ld(&bar[XB_TOPGEN]) == tg, bar);
            __builtin_amdgcn_fence(__ATOMIC_ACQUIRE, "agent");
            xb_add(&bar[XB_XGEN(b.x)], 1u);
            asm volatile("s_waitcnt vmcnt(0)" ::: "memory");
        } else {
            XB_SPIN(xb_ld(&bar[XB_XGEN(b.x)]) == gen, bar);
            __builtin_amdgcn_fence(__ATOMIC_ACQUIRE, "agent");
            asm volatile("s_waitcnt vmcnt(0)" ::: "memory");
        }
    }
    __syncthreads();
}

namespace pg8 {
#define PG8_LAS __attribute__((address_space(3)))
typedef unsigned short bf16_t;
typedef short bf16x8 __attribute__((ext_vector_type(8)));
typedef float f32x4 __attribute__((ext_vector_type(4)));
typedef unsigned u32x4 __attribute__((ext_vector_type(4)));
constexpr int BM = 256, BK = 64, HALF = 128, HTB = HALF * BK * 2  , STAGE_BYTES = 8 * HTB, NXCD = 8, WGM = 8;

__host__ __device__ __forceinline__ int lds_byte(int r, int c) { const int st = (r >> 4) * 2 + (c >> 5), rr = r & 15, cc = c & 31, ob = rr * 64 + cc * 2; return st * 1024 + (ob ^ (((ob >> 9) & 1) << 5)); }
__host__ __device__ __forceinline__ void stage_rc(int b, int& R, int& C) { const int st = b / 1024, sb = b % 1024, swz = sb ^ (((sb >> 9) & 1) << 5); R = (st >> 1) * 16 + swz / 64; C = (st & 1) * 32 + (swz % 64) / 2; }
__host__ __device__ __forceinline__ int perm32(int rho) { const int n = rho >> 4, i = rho & 15; return 8 * (i >> 2) + 4 * n + (i & 3); }

struct Unit { int pm, pn; };
struct Gemm { const bf16_t* A; const bf16_t* Bt; int M, N, K; };

struct StaticOrder {
    int nM, nN, nwg, G, c;
    __host__ __device__ void init(int M, int N, int G_, int c_) { nM = M / BM; nN = N / BM; nwg = nM * nN; G = G_; c = c_; }
    __host__ __device__ bool next(int i, Unit& u) const {
        const long L = (long)i * G + c; if (L >= nwg) return false;
        int wgid = (int)L; { const int q = nwg / NXCD, r = nwg % NXCD, xcd = wgid % NXCD, off = wgid / NXCD; wgid = (xcd < r ? xcd * (q + 1) : r * (q + 1) + (xcd - r) * q) + off; }
        const int nig = WGM * nN, gid = wgid / nig, fm = gid * WGM, gsz = (nM - fm) < WGM ? (nM - fm) : WGM;
        u.pm = fm + ((wgid % nig) % gsz); u.pn = (wgid % nig) / gsz; return true;
    }
    __device__ __forceinline__ void a_ready(const Unit&) const {}
    __device__ __forceinline__ void done(const Unit&) const {}
};

__device__ __forceinline__ unsigned cvt_pk_bf16(float lo, float hi) { unsigned r; asm volatile("v_cvt_pk_bf16_f32 %0, %1, %2" : "=v"(r) : "v"(lo), "v"(hi)); return r; }
__device__ __forceinline__ float rstd16(const float* part, int r, int fq) {
    const f32x4 a = *(const f32x4*)(part + (size_t)r * 16 + 4 * fq);
    float s = (a[0] + a[1]) + (a[2] + a[3]);
    s = swap16_add(s, s); s = swap32_add(s, s);
    return 1.f / sqrtf(s * (1.f / 1024.f) + 1e-6f);
}
__device__ __forceinline__ u32x4 pack8(const f32x4 a, const f32x4 b) { u32x4 w; w.x = cvt_pk_bf16(a[0], a[1]); w.y = cvt_pk_bf16(a[2], a[3]); w.z = cvt_pk_bf16(b[0], b[1]); w.w = cvt_pk_bf16(b[2], b[3]); return w; }
#define rot(t1, t2, c, s) do { const float a_ = (t1) * (c) - (t2) * (s), b_ = (t1) * (s) + (t2) * (c); (t1) = a_; (t2) = b_; } while (0)

struct EpiProj {
    static constexpr bool PERM = true, AFTER_DRAIN = false;
    bf16_t* R; const float* rope;
    __device__ __forceinline__ void operator()(const f32x4 (&acc)[2][2][4][2], const Unit& u, int wr, int wc, int fr, int fq) const {
        const int type = u.pn >> 1, hg = u.pn & 1;
        const int colbase = type * 512 + (4 * hg + wc) * 64 + 8 * fq;
        const bool do_rope = (type == 3) || (type == 4);
#pragma unroll
        for (int ai = 0; ai < 2; ++ai)
#pragma unroll
            for (int m = 0; m < 4; ++m) {
                const int r = u.pm * BM + ai * HALF + wr * 64 + m * 16 + fr;
                f32x4 a0 = acc[ai][0][m][0], a1 = acc[ai][0][m][1], b0 = acc[ai][1][m][0], b1 = acc[ai][1][m][1];
                if (do_rope) {
                    const f32x4* rp = (const f32x4*)(rope + ((size_t)(r & 2047) * 32 + 8 * fq) * 2);
                    const f32x4 c0 = rp[0], c1 = rp[1], c2 = rp[2], c3 = rp[3];
                    rot(a0[0], b0[0], c0[0], c0[1]); rot(a0[1], b0[1], c0[2], c0[3]); rot(a0[2], b0[2], c1[0], c1[1]); rot(a0[3], b0[3], c1[2], c1[3]);
                    rot(a1[0], b1[0], c2[0], c2[1]); rot(a1[1], b1[1], c2[2], c2[3]); rot(a1[2], b1[2], c3[0], c3[1]); rot(a1[3], b1[3], c3[2], c3[3]);
                }
                bf16_t* rowp = R + (size_t)r * 3584 + colbase;
                *(u32x4*)(rowp) = pack8(a0, a1);
                *(u32x4*)(rowp + 32) = pack8(b0, b1);
            }
    }
};
struct EpiRes {
    static constexpr bool PERM = true, AFTER_DRAIN = false;
    const float* xf; bf16_t* hb; float* part; const float* bias;
    __device__ __forceinline__ void operator()(const f32x4 (&acc)[2][2][4][2], const Unit& u, int wr, int wc, int fr, int fq) const {
        const int col0 = u.pn * BM + wc * 32 + 8 * fq;
        f32x4 bv[2][2];
#pragma unroll
        for (int bj = 0; bj < 2; ++bj)
#pragma unroll
            for (int n = 0; n < 2; ++n) bv[bj][n] = bias ? *(const f32x4*)(bias + col0 + bj * HALF + 4 * n) : (f32x4){0.f, 0.f, 0.f, 0.f};
#pragma unroll
        for (int ai = 0; ai < 2; ++ai)
#pragma unroll
            for (int m = 0; m < 4; ++m) {
                const int r = u.pm * BM + ai * HALF + wr * 64 + m * 16 + fr;
                const size_t off = (size_t)r * 1024 + col0;
                float ss = 0.f;
#pragma unroll
                for (int bj = 0; bj < 2; ++bj) {
                    f32x4 x0, x1;
                    if (xf) { x0 = *(const f32x4*)(xf + off + bj * HALF); x1 = *(const f32x4*)(xf + off + bj * HALF + 4); }
                    else { const u32x4 w = *(const u32x4*)(hb + off + bj * HALF);
                           x0 = (f32x4){__uint_as_float(w[0] << 16), __uint_as_float(w[0] & 0xffff0000u), __uint_as_float(w[1] << 16), __uint_as_float(w[1] & 0xffff0000u)};
                           x1 = (f32x4){__uint_as_float(w[2] << 16), __uint_as_float(w[2] & 0xffff0000u), __uint_as_float(w[3] << 16), __uint_as_float(w[3] & 0xffff0000u)}; }
                    const f32x4 h0 = x0 + acc[ai][bj][m][0] + bv[bj][0], h1 = x1 + acc[ai][bj][m][1] + bv[bj][1];
                    *(u32x4*)(hb + off + bj * HALF) = pack8(h0, h1);
                    ss += (h0[0] * h0[0] + h0[1] * h0[1]) + (h0[2] * h0[2] + h0[3] * h0[3]) + (h1[0] * h1[0] + h1[1] * h1[1]) + (h1[2] * h1[2] + h1[3] * h1[3]);
                }
                ss = swap16_add(ss, ss); ss = swap32_add(ss, ss);
                if (fq == 0) part[(size_t)r * 16 + 4 * u.pn + wc] = ss;
            }
    }
};
struct EpiQ {
    static constexpr bool PERM = true, AFTER_DRAIN = false;
    bf16_t* O; const float* part;
    __device__ __forceinline__ void operator()(const f32x4 (&acc)[2][2][4][2], const Unit& u, int wr, int wc, int fr, int fq) const {
        const int col0 = u.pn * BM + wc * 32 + 8 * fq;
#pragma unroll
        for (int ai = 0; ai < 2; ++ai)
#pragma unroll
            for (int m = 0; m < 4; ++m) {
                const int r = u.pm * BM + ai * HALF + wr * 64 + m * 16 + fr;
                const float rs = rstd16(part, r, fq);
                bf16_t* rowp = O + (size_t)r * 1024 + col0;
#pragma unroll
                for (int bj = 0; bj < 2; ++bj) *(u32x4*)(rowp + bj * HALF) = pack8(acc[ai][bj][m][0] * rs, acc[ai][bj][m][1] * rs);
            }
    }
};
struct EpiGlu {
    static constexpr bool PERM = true, AFTER_DRAIN = false;
    bf16_t* G; const float* part; const float* b1;
    __device__ __forceinline__ void operator()(const f32x4 (&acc)[2][2][4][2], const Unit& u, int wr, int wc, int fr, int fq) const {
        const int col = u.pn * 128 + wc * 32 + 8 * fq;
        f32x4 ba[2], bg[2];
#pragma unroll
        for (int n = 0; n < 2; ++n) { ba[n] = *(const f32x4*)(b1 + col + 4 * n); bg[n] = *(const f32x4*)(b1 + 1024 + col + 4 * n); }
#pragma unroll
        for (int ai = 0; ai < 2; ++ai)
#pragma unroll
            for (int m = 0; m < 4; ++m) {
                const int r = u.pm * BM + ai * HALF + wr * 64 + m * 16 + fr;
                const float rs = rstd16(part, r, fq);
                f32x4 y[2];
#pragma unroll
                for (int n = 0; n < 2; ++n) {
                    const f32x4 a = acc[ai][0][m][n] * rs + ba[n], g = acc[ai][1][m][n] * rs + bg[n];
#pragma unroll
                    for (int i = 0; i < 4; ++i) y[n][i] = a[i] / (1.f + __expf(-g[i]));
                }
                *(u32x4*)(G + (size_t)r * 1024 + col) = pack8(y[0], y[1]);
            }
    }
};
template <class Epi, class Sched, bool ALIGN_EPI = false, bool SP2 = false>
__device__ __forceinline__ void gemm_phase(PG8_LAS unsigned char* lds, const Gemm g, const Sched& S, const Epi& E, const int wave_id) {
    const int lane = lane_id(), wid = wave_id, tid = wid * 64 + lane, wr = wid >> 2, wc = wid & 3, fr = lane & 15, fq = lane >> 4;
    const int K = g.K, nt = K / BK;
    unsigned voffA[2], voffB[2];
#pragma unroll
    for (int i = 0; i < 2; ++i) { int R, C; stage_rc(tid * 16 + i * 8192, R, C); const int Rb = Epi::PERM ? ((R & ~31) + perm32(R & 31)) : R;
        voffA[i] = (unsigned)(R * K + C) * 2u; voffB[i] = (unsigned)(Rb * K + C) * 2u; }
    const size_t kstep = (size_t)(BK * 2);
    const size_t hstep = (size_t)HALF * K * 2;
    const size_t tstep = 2 * hstep;
    const unsigned ldsw = (unsigned)wid * 1024u;
    const int aoff = lds_byte(wr * 64 + fr, fq * 8), boff = lds_byte(wc * 32 + fr, fq * 8);
#define PG8_SA(b, h) (((b) * 2 + (h)) * HTB)
#define PG8_SB(b, h) ((4 + (b) * 2 + (h)) * HTB)
#define PG8_STAGE(bufoff, gbase, voff) do { _Pragma("unroll") for (int _i = 0; _i < 2; ++_i) \
        __builtin_amdgcn_global_load_lds((const unsigned*)((const char*)(gbase) + (voff)[_i]), (PG8_LAS unsigned*)(lds + (bufoff) + ldsw + _i * 8192), 16, 0, 0); } while (0)
#define PG8_LDA(dst, b, h) do { _Pragma("unroll") for (int m = 0; m < 4; ++m) _Pragma("unroll") for (int k = 0; k < 2; ++k) dst[m][k] = *(const PG8_LAS bf16x8*)(lds + PG8_SA(b, h) + aoff + m * 2048 + k * 1024); } while (0)
#define PG8_LDB(dst, b, h) do { _Pragma("unroll") for (int n = 0; n < 2; ++n) _Pragma("unroll") for (int k = 0; k < 2; ++k) dst[n][k] = *(const PG8_LAS bf16x8*)(lds + PG8_SB(b, h) + boff + n * 2048 + k * 1024); } while (0)
#define PG8_MMA(ai, bj, At, Bt) do { __builtin_amdgcn_s_setprio(1); _Pragma("unroll") for (int m = 0; m < 4; ++m) _Pragma("unroll") for (int n = 0; n < 2; ++n) _Pragma("unroll") for (int k = 0; k < 2; ++k) \
        acc[ai][bj][m][n] = __builtin_amdgcn_mfma_f32_16x16x32_bf16(Bt[n][k], At[m][k], acc[ai][bj][m][n], 0, 0, 0); __builtin_amdgcn_s_setprio(0); } while (0)
#define PG8_WAIT_V(n) asm volatile("s_waitcnt vmcnt(" #n ")" ::: "memory")
#define PG8_WAIT_L(n) asm volatile("s_waitcnt lgkmcnt(" #n ")" ::: "memory")
#define PG8_BAR __builtin_amdgcn_s_barrier()
#define PG8_SCHED __builtin_amdgcn_sched_barrier(0)
    Unit cur, nxt; int ui = 0;
    if (!S.next(0, cur)) return;
    f32x4 acc[2][2][4][2];
#pragma unroll
    for (int a = 0; a < 2; ++a)
#pragma unroll
        for (int b = 0; b < 2; ++b)
#pragma unroll
            for (int m = 0; m < 4; ++m)
#pragma unroll
                for (int n = 0; n < 2; ++n) acc[a][b][m][n] = (f32x4){0.f, 0.f, 0.f, 0.f};
    bf16x8 At[4][2], B0[2][2], B1[2][2];
    const char* cA = (const char*)g.A + (size_t)cur.pm * tstep; const char* cB = (const char*)g.Bt + (size_t)cur.pn * tstep;
    S.a_ready(cur);
    if constexpr (SP2) {
        PG8_STAGE(PG8_SB(0, 0), cB, voffB); PG8_STAGE(PG8_SB(0, 1), cB + hstep, voffB); PG8_STAGE(PG8_SA(0, 0), cA, voffA); PG8_STAGE(PG8_SA(0, 1), cA + hstep, voffA);
        if (wr == 1) PG8_BAR;
        PG8_WAIT_V(2); PG8_BAR;
        PG8_STAGE(PG8_SB(1, 0), cB + kstep, voffB); PG8_STAGE(PG8_SA(1, 0), cA + kstep, voffA); PG8_STAGE(PG8_SB(1, 1), cB + hstep + kstep, voffB);
        PG8_WAIT_V(6); PG8_BAR;
    } else {
        PG8_STAGE(PG8_SB(0, 0), cB, voffB); PG8_STAGE(PG8_SA(0, 0), cA, voffA); PG8_STAGE(PG8_SB(0, 1), cB + hstep, voffB); PG8_STAGE(PG8_SA(0, 1), cA + hstep, voffA);
        if (wr == 1) PG8_BAR;
        PG8_WAIT_V(4); PG8_BAR;
        PG8_STAGE(PG8_SB(1, 0), cB + kstep, voffB); PG8_STAGE(PG8_SA(1, 0), cA + kstep, voffA); PG8_STAGE(PG8_SB(1, 1), cB + hstep + kstep, voffB);
        PG8_WAIT_V(6); PG8_BAR;
    }
    for (;;) {
        const bool has_next = S.next(ui + 1, nxt);
        const char* nA = has_next ? (const char*)g.A + (size_t)nxt.pm * tstep : cA; const char* nB = has_next ? (const char*)g.Bt + (size_t)nxt.pn * tstep : cB;
        for (int t = 0; t < nt; t += 2) {
            const bool last = (t == nt - 2);
            const char* a1 = cA + (size_t)(t + 1) * kstep;
            const char* a2 = last ? nA : cA + (size_t)(t + 2) * kstep; const char* b2 = last ? nB : cB + (size_t)(t + 2) * kstep;
            const char* a3 = a2 + kstep; const char* b3 = b2 + kstep;
            if (last && has_next) S.a_ready(nxt);
            if constexpr (SP2) {
            PG8_LDB(B0, 0, 0); PG8_LDB(B1, 0, 1); PG8_SCHED; PG8_LDA(At, 0, 0); PG8_STAGE(PG8_SA(1, 1), a1 + hstep, voffA);
            PG8_WAIT_V(8); PG8_WAIT_L(0); PG8_BAR; PG8_MMA(0, 0, At, B0); PG8_MMA(0, 1, At, B1); PG8_BAR; PG8_SCHED;
            PG8_LDA(At, 0, 1); PG8_STAGE(PG8_SB(0, 0), b2, voffB); PG8_STAGE(PG8_SB(0, 1), b2 + hstep, voffB); PG8_STAGE(PG8_SA(0, 0), a2, voffA);
            PG8_WAIT_V(8); PG8_WAIT_L(0); PG8_BAR; PG8_MMA(1, 0, At, B0); PG8_MMA(1, 1, At, B1); PG8_BAR; PG8_SCHED;
            PG8_LDB(B0, 1, 0); PG8_LDB(B1, 1, 1); PG8_SCHED; PG8_LDA(At, 1, 0); PG8_STAGE(PG8_SA(0, 1), a2 + hstep, voffA);
            PG8_WAIT_V(8); PG8_WAIT_L(0); PG8_BAR; PG8_MMA(0, 0, At, B0); PG8_MMA(0, 1, At, B1); PG8_BAR; PG8_SCHED;
            PG8_LDA(At, 1, 1); PG8_STAGE(PG8_SB(1, 0), b3, voffB); PG8_STAGE(PG8_SB(1, 1), b3 + hstep, voffB); PG8_STAGE(PG8_SA(1, 0), a3, voffA);
            PG8_WAIT_V(8); PG8_WAIT_L(0); PG8_BAR; PG8_MMA(1, 0, At, B0); PG8_MMA(1, 1, At, B1); PG8_BAR; PG8_SCHED;
            } else {
            PG8_LDB(B0, 0, 0); PG8_SCHED; PG8_LDA(At, 0, 0); PG8_STAGE(PG8_SA(1, 1), a1 + hstep, voffA);
            PG8_WAIT_L(8); PG8_BAR; PG8_WAIT_L(0); PG8_MMA(0, 0, At, B0); PG8_BAR; PG8_SCHED;
            PG8_LDB(B1, 0, 1); PG8_STAGE(PG8_SB(0, 0), b2, voffB);
            PG8_BAR; PG8_WAIT_L(0); PG8_MMA(0, 1, At, B1); PG8_BAR;
            PG8_LDA(At, 0, 1); PG8_STAGE(PG8_SA(0, 0), a2, voffA);
            PG8_BAR; PG8_WAIT_L(0); PG8_MMA(1, 0, At, B0); PG8_BAR; PG8_SCHED;
            PG8_STAGE(PG8_SB(0, 1), b2 + hstep, voffB);
            PG8_WAIT_V(6); PG8_BAR; PG8_MMA(1, 1, At, B1); PG8_BAR;
            PG8_LDB(B0, 1, 0); PG8_SCHED; PG8_LDA(At, 1, 0); PG8_STAGE(PG8_SA(0, 1), a2 + hstep, voffA);
            PG8_WAIT_L(8); PG8_BAR; PG8_WAIT_L(0); PG8_MMA(0, 0, At, B0); PG8_BAR; PG8_SCHED;
            PG8_LDB(B1, 1, 1); PG8_STAGE(PG8_SB(1, 0), b3, voffB);
            PG8_BAR; PG8_WAIT_L(0); PG8_MMA(0, 1, At, B1); PG8_BAR;
            PG8_LDA(At, 1, 1); PG8_STAGE(PG8_SA(1, 0), a3, voffA);
            PG8_BAR; PG8_WAIT_L(0); PG8_MMA(1, 0, At, B0); PG8_BAR; PG8_SCHED;
            PG8_STAGE(PG8_SB(1, 1), b3 + hstep, voffB);
            PG8_WAIT_V(6); PG8_BAR; PG8_MMA(1, 1, At, B1); PG8_BAR;
            }
        }
        if constexpr (ALIGN_EPI) { if (wr == 0) PG8_BAR; }
        if constexpr (!Epi::AFTER_DRAIN) { E(acc, cur, wr, wc, fr, fq); S.done(cur); }
        if (!has_next) break;
#pragma unroll
        for (int a = 0; a < 2; ++a)
#pragma unroll
            for (int b = 0; b < 2; ++b)
#pragma unroll
                for (int m = 0; m < 4; ++m)
#pragma unroll
                    for (int n = 0; n < 2; ++n) acc[a][b][m][n] = (f32x4){0.f, 0.f, 0.f, 0.f};
        cur = nxt; cA = nA; cB = nB; ++ui;
        if constexpr (ALIGN_EPI) { if (wr == 1) PG8_BAR; }
    }
    PG8_WAIT_V(0);
    if constexpr (!ALIGN_EPI) { if (wr == 0) PG8_BAR; }
    PG8_BAR;
    if constexpr (Epi::AFTER_DRAIN) { E.fused(acc, cur, wr, wc, fr, fq, lds, wid, lane); S.done(cur); }
#undef PG8_SA
#undef PG8_SB
#undef PG8_STAGE
#undef PG8_LDA
#undef PG8_LDB
#undef PG8_MMA
#undef PG8_WAIT_V
#undef PG8_WAIT_L
#undef PG8_BAR
#undef PG8_SCHED
}
}

struct Frame {
    LAS unsigned char* lds;
    int wave, G, bid;
    const float *x, *mix_norm, *ffn_norm, *final_norm, *w_in, *w_out, *rel_bias, *conv_w1, *conv_b1, *conv_dw, *conv_dw_b, *conv_ln_g, *conv_ln_b, *conv_w2, *conv_b2,
        *peer_wq, *peer_keys, *peer_u, *peer_v;
    float* out;
    unsigned char* ws;
};
#define FRAME_IDS const int f_lane = lane_id(); const int f_tid = F.wave * 64 + f_lane; (void)f_tid
DI float gamma_of(int h) { return 1.f - exp2f(-5.f - (float)h); }

DI void p0_prep(Frame& F) {
    FRAME_IDS;
    const int gw = F.bid * NWAVES + F.wave, NGW = F.G * NWAVES;
    f32x2* rope = (f32x2*)(F.ws + WS_ROPE);
    for (int i = F.bid * NTHR + f_tid; i < SEQ * 32; i += F.G * NTHR) {
        const int s = i >> 5, j = i & 31;
        const float inv = powf(10000.f, -(float)j / 32.f);
        const float ang = (float)s * inv;
        float sn, cs; sincosf(ang, &sn, &cs);
        rope[i] = (f32x2){cs, sn};
    }
    bf16* xb = (bf16*)(F.ws + WS_XB);
    for (int m = gw; m < T; m += NGW) {
        const f32x4* xr = (const f32x4*)(F.x + (size_t)m * DM) + f_lane;
        u32x2* o = (u32x2*)(xb + (size_t)m * DM) + f_lane;
        f32x4 v[4]; float s = 0.f;
#pragma unroll
        for (int j = 0; j < 4; ++j) { v[j] = xr[64 * j]; s += v[j].x * v[j].x + v[j].y * v[j].y + v[j].z * v[j].z + v[j].w * v[j].w; }
        const float r = 1.f / sqrtf(wave_sum(s) * (1.f / DM) + EPS);
#pragma unroll
        for (int j = 0; j < 4; ++j) o[64 * j] = (u32x2){pk2(v[j].x * r, v[j].y * r), pk2(v[j].z * r, v[j].w * r)};
    }
}
DI void p0_transpose_item(const float* W, int K, int N, bf16* WT, int prow0, const float* gain, float scale, LAS float* scr, int k0, int n0, int lane) {
#pragma unroll 8
    for (int i = 0; i < 32; ++i) { const int kk = 2 * i + (lane >> 5); scr[kk * 33 + (lane & 31)] = W[(size_t)(k0 + kk) * N + n0 + (lane & 31)] * (gain ? gain[k0 + kk] : 1.f) * scale; }
    asm volatile("s_waitcnt lgkmcnt(0)" ::: "memory");
    const int c = lane & 7;
#pragma unroll
    for (int j = 0; j < 4; ++j) { const int n = (lane >> 3) + 8 * j; const LAS float* q = scr + (8 * c) * 33 + n;
        u32x4 o; o.x = pk2(q[0 * 33], q[1 * 33]); o.y = pk2(q[2 * 33], q[3 * 33]); o.z = pk2(q[4 * 33], q[5 * 33]); o.w = pk2(q[6 * 33], q[7 * 33]);
        *(u32x4*)(WT + (size_t)(prow0 + n) * K + k0 + 8 * c) = o; }
    asm volatile("s_waitcnt lgkmcnt(0)" ::: "memory");
}
DI void p0_weights(Frame& F) {
    FRAME_IDS;
    LAS float* scr = (LAS float*)(F.lds + F.wave * 16384);
    const int gw = F.bid * NWAVES + F.wave, NGW = F.G * NWAVES;
    constexpr int I_IN = 16 * (INC / 32), I_SQ = 16 * (DM / 32), I_W1 = 16 * (2 * DM / 32);
    constexpr int NITEMS = I_IN + I_SQ + I_W1 + I_SQ + 2 * I_SQ;
    for (int it = gw; it < NITEMS; it += NGW) {
        int r = it;
        if (r < I_IN) { const int nb = r % (INC / 32), kb = r / (INC / 32), n0 = nb * 32;
            const int type = n0 / 512, head = (n0 % 512) / 64, bj = (n0 % 64) / 32;
            const int prow0 = 256 * (2 * type + head / 4) + 128 * bj + 32 * (head % 4);
            p0_transpose_item(F.w_in, DM, INC, (bf16*)(F.ws + WS_WIN), prow0, F.mix_norm, type == 0 ? 0.125f * LOG2E : (type == 4 ? 0.125f : 1.f), scr, kb * 64, n0, f_lane); continue; }
        r -= I_IN;
        if (r < I_SQ) { const int nb = r % 32, kb = r / 32; p0_transpose_item(F.w_out, DM, DM, (bf16*)(F.ws + WS_WOUT), nb * 32, nullptr, 1.f, scr, kb * 64, nb * 32, f_lane); continue; }
        r -= I_SQ;
        if (r < I_W1) { const int nb = r % 64, kb = r / 64, n0 = nb * 32; const int bj = n0 / 1024, rem = n0 % 1024;
            p0_transpose_item(F.conv_w1, DM, 2 * DM, (bf16*)(F.ws + WS_W1), 256 * (rem / 128) + 128 * bj + (rem % 128), F.mix_norm + DM, 1.f, scr, kb * 64, n0, f_lane); continue; }
        r -= I_W1;
        if (r < I_SQ) { const int nb = r % 32, kb = r / 32; p0_transpose_item(F.conv_w2, DM, DM, (bf16*)(F.ws + WS_W2), nb * 32, nullptr, 1.f, scr, kb * 64, nb * 32, f_lane); continue; }
        r -= I_SQ;
        { const int layer = r / I_SQ; r %= I_SQ; const int nb = r % 32, kb = r / 32;
          p0_transpose_item(F.peer_wq + (size_t)layer * DM * DM, DM, DM, (bf16*)(F.ws + WS_WQ) + (size_t)layer * DM * DM, nb * 32, F.ffn_norm + layer * DM, 1.f, scr, kb * 64, nb * 32, f_lane); }
    }
}
DI float row_rstd(const float* part, int m) {
    const f32x4* p = (const f32x4*)(part + (size_t)m * 16);
    const f32x4 a = p[0], b = p[1], c = p[2], d = p[3];
    const float s = ((a.x + a.y) + (a.z + a.w)) + ((b.x + b.y) + (b.z + b.w)) + ((c.x + c.y) + (c.z + c.w)) + ((d.x + d.y) + (d.z + d.w));
    return 1.f / sqrtf(s * (1.f / DM) + EPS);
}

typedef short v4i16 __attribute__((ext_vector_type(4)));
typedef __bf16 bf16x2_t __attribute__((ext_vector_type(2)));
DI unsigned cvtpk(float lo, float hi) { f32x2 v = {lo, hi}; bf16x2_t b = __builtin_convertvector(v, bf16x2_t); return __builtin_bit_cast(unsigned, b); }
DI v4i16 ds_tr16(LAS const unsigned char* p) { return __builtin_amdgcn_ds_read_tr16_b64_v4i16((LAS v4i16*)p); }
DI int crow(int r, int h) { return (r & 3) + 8 * (r >> 2) + 4 * h; }
DI bf16x8 pack_step(const f32x16& x, const int s) {
    u32x4 w = {cvtpk(x[8 * s + 0], x[8 * s + 1]), cvtpk(x[8 * s + 2], x[8 * s + 3]), cvtpk(x[8 * s + 4], x[8 * s + 5]), cvtpk(x[8 * s + 6], x[8 * s + 7])};
    return __builtin_bit_cast(bf16x8, w);
}
constexpr int AT_KB = 64 * 144, AT_VB = 8192, AT_BUF = AT_KB + AT_VB, AT_BIAS = 2 * AT_BUF;
DI void attn_item(Frame& F, const int it) {
    FRAME_IDS;
    const bf16* R = (const bf16*)(F.ws + WS_R); bf16* O = (bf16*)(F.ws + WS_O);
    LAS unsigned char* lds = F.lds;
    LAS float* bias_s = (LAS float*)(lds + AT_BIAS);
    const int q32 = f_lane & 31, h = f_lane >> 5, w = F.wave;
    const int srow = f_tid >> 3, sch = f_tid & 7;
    const int vtr_off = ((f_lane & 15) >> 2) * 64 + (16 * ((f_lane >> 4) & 1) + 4 * (f_lane & 3)) * 2;
    {
        const int b = it / (NHA * 8), hd = (it / 8) % NHA, c0 = (it % 8) * 4;
        const int c = c0 + (w >> 1), qrow0 = 32 * (w & 1);
        const size_t tq = (size_t)b * SEQ + c * 64 + qrow0 + q32;
        __syncthreads();
        for (int k = f_tid; k < 257; k += NTHR) bias_s[k] = F.rel_bias[hd * 257 + k] * LOG2E;
        bf16x8 qf[4];
#pragma unroll
        for (int ks = 0; ks < 4; ++ks) qf[ks] = *(const bf16x8*)(R + tq * INC + C_QA + hd * 64 + 16 * ks + 8 * h);
        const int t_lo = c0 - 8 < 0 ? 0 : c0 - 8, t_hi = c0 + 3, ntile = t_hi - t_lo + 1;
        const bf16* kbase = R + ((size_t)b * SEQ + srow) * INC + C_KA + hd * 64 + 8 * sch;
        const bf16* vbase = R + ((size_t)b * SEQ + srow) * INC + C_VA + hd * 64 + 8 * sch;
        u32x4 kreg = *(const u32x4*)(kbase + (size_t)t_lo * 64 * INC), vreg = *(const u32x4*)(vbase + (size_t)t_lo * 64 * INC);
        *(LAS u32x4*)(lds + srow * 144 + sch * 16) = kreg;
        *(LAS u32x4*)(lds + AT_KB + (sch >> 2) * 4096 + srow * 64 + (sch & 3) * 16) = vreg;
        __syncthreads();
        const float bias_far = bias_s[256];
        float m = -1e30f, l = 0.f;
        f32x16 o0 = {}, o1 = {};
        for (int i = 0; i < ntile; ++i) {
            const int tc = t_lo + i;
            LAS unsigned char* kb = lds + (i & 1) * AT_BUF; LAS unsigned char* vb = kb + AT_KB;
            if (i + 1 < ntile) { kreg = *(const u32x4*)(kbase + (size_t)(tc + 1) * 64 * INC); vreg = *(const u32x4*)(vbase + (size_t)(tc + 1) * 64 * INC); }
            const int D = c - tc;
            if (D >= 0 && D <= 8) {
                const float init = D >= 3 ? bias_far : 0.f;
                f32x16 p0, p1;
#pragma unroll
                for (int r = 0; r < 16; ++r) { p0[r] = init; p1[r] = init; }
#pragma unroll
                for (int ks = 0; ks < 4; ++ks) {
                    const bf16x8 k0 = *(const LAS bf16x8*)(kb + q32 * 144 + (16 * ks + 8 * h) * 2);
                    const bf16x8 k1 = *(const LAS bf16x8*)(kb + (32 + q32) * 144 + (16 * ks + 8 * h) * 2);
                    p0 = __builtin_amdgcn_mfma_f32_32x32x16_bf16(k0, qf[ks], p0, 0, 0, 0);
                    p1 = __builtin_amdgcn_mfma_f32_32x32x16_bf16(k1, qf[ks], p1, 0, 0, 0);
                }
                if (D < 3) {
                    const int relb = D * 64 + qrow0 + q32 - 4 * h + 128;
#pragma unroll
                    for (int r = 0; r < 16; ++r) {
                        const int r0 = relb - ((r & 3) + 8 * (r >> 2));
                        const int i0 = r0 < 0 ? 0 : (r0 > 256 ? 256 : r0), r1 = r0 - 32, i1 = r1 < 0 ? 0 : (r1 > 256 ? 256 : r1);
                        p0[r] += bias_s[i0]; p1[r] += bias_s[i1];
                    }
                }
                float tm = fmaxf(p0[0], p1[0]);
#pragma unroll
                for (int r = 1; r < 16; ++r) tm = fmaxf(tm, fmaxf(p0[r], p1[r]));
                tm = swap32_max(tm);
                const float mn = fmaxf(m, tm), alpha = __builtin_amdgcn_exp2f(m - mn);
                m = mn;
                float ps = 0.f;
#pragma unroll
                for (int r = 0; r < 16; ++r) { p0[r] = __builtin_amdgcn_exp2f(p0[r] - mn); p1[r] = __builtin_amdgcn_exp2f(p1[r] - mn); ps += p0[r] + p1[r]; }
                l = l * alpha + ps;
                if (!__all(alpha == 1.f)) {
#pragma unroll
                    for (int r = 0; r < 16; ++r) { o0[r] *= alpha; o1[r] *= alpha; }
                }
                bf16x8 pf[4];
                pf[0] = pack_step(p0, 0); pf[1] = pack_step(p0, 1); pf[2] = pack_step(p1, 0); pf[3] = pack_step(p1, 1);
#pragma unroll
                for (int kk = 0; kk < 4; ++kk) {
                    const int key0 = 16 * kk + 4 * h;
                    const v4i16 a0l = ds_tr16(vb + key0 * 64 + vtr_off), a0h = ds_tr16(vb + (key0 + 8) * 64 + vtr_off);
                    const v4i16 a1l = ds_tr16(vb + 4096 + key0 * 64 + vtr_off), a1h = ds_tr16(vb + 4096 + (key0 + 8) * 64 + vtr_off);
                    const bf16x8 a0 = __builtin_shufflevector(a0l, a0h, 0, 1, 2, 3, 4, 5, 6, 7), a1 = __builtin_shufflevector(a1l, a1h, 0, 1, 2, 3, 4, 5, 6, 7);
                    o0 = __builtin_amdgcn_mfma_f32_32x32x16_bf16(a0, pf[kk], o0, 0, 0, 0);
                    o1 = __builtin_amdgcn_mfma_f32_32x32x16_bf16(a1, pf[kk], o1, 0, 0, 0);
                }
            }
            if (i + 1 < ntile) {
                LAS unsigned char* nb = lds + ((i + 1) & 1) * AT_BUF;
                *(LAS u32x4*)(nb + srow * 144 + sch * 16) = kreg;
                *(LAS u32x4*)(nb + AT_KB + (sch >> 2) * 4096 + srow * 64 + (sch & 3) * 16) = vreg;
            }
            __syncthreads();
        }
        l = swap32_add(l, l);
        const float inv = 1.f / l;
        bf16* op = O + tq * DM + hd * 64 + 4 * h;
#pragma unroll
        for (int g = 0; g < 4; ++g) {
            *(u32x2*)(op + 8 * g) = (u32x2){cvtpk(o0[4 * g] * inv, o0[4 * g + 1] * inv), cvtpk(o0[4 * g + 2] * inv, o0[4 * g + 3] * inv)};
            *(u32x2*)(op + 32 + 8 * g) = (u32x2){cvtpk(o1[4 * g] * inv, o1[4 * g + 1] * inv), cvtpk(o1[4 * g + 2] * inv, o1[4 * g + 3] * inv)};
        }
    }
    __syncthreads();
}

constexpr int RT_Q = 0, RT_K = 9216, RT_KD = 18432, RT_V = 26624, RT_BUF = 34816, RT_ZS = 2 * RT_BUF, RT_CS = RT_ZS + 64 * 66 * 4;
DI void ret_item(Frame& F, const int it) {
    FRAME_IDS;
    const bf16* R = (const bf16*)(F.ws + WS_R); bf16* O = (bf16*)(F.ws + WS_O);
    LAS unsigned char* lds = F.lds;
    LAS float* Zs = (LAS float*)(lds + RT_ZS); LAS float* Cs = (LAS float*)(lds + RT_CS);
    const int b = it / NHB, hd = it % NHB;
    const int q32 = f_lane & 31, h = f_lane >> 5, w = F.wave;
    const int role = w >> 2, itile = (w >> 1) & 1, etile = w & 1;
    const int srow = f_tid >> 3, sch = f_tid & 7;
    const int vtr_off = ((f_lane & 15) >> 2) * 64 + (16 * ((f_lane >> 4) & 1) + 4 * (f_lane & 3)) * 2;
    const float l2g = log2f(gamma_of(hd));
    const float cd = exp2f(l2g * 64.f), sdec = exp2f(l2g * (float)(63 - srow));
    float qdv[16];
#pragma unroll
    for (int r = 0; r < 16; ++r) qdv[r] = exp2f(l2g * (float)(32 * itile + crow(r, h) + 1));
    f32x16 xs0 = {}, xs1 = {};
    const size_t trow0 = (size_t)b * SEQ;
    const bf16* gq = R + (trow0 + srow) * INC + hd * 64 + 8 * sch;
    u32x4 qreg = *(const u32x4*)(gq + C_QB), kreg = *(const u32x4*)(gq + C_KB), vreg = *(const u32x4*)(gq + C_VB);
    __syncthreads();
#define RT_STAGE(bufp) do { LAS unsigned char* bp_ = (bufp); \
        *(LAS u32x4*)(bp_ + RT_Q + srow * 144 + sch * 16) = qreg; *(LAS u32x4*)(bp_ + RT_K + srow * 144 + sch * 16) = kreg; \
        *(LAS u32x4*)(bp_ + RT_V + (sch >> 2) * 4096 + srow * 64 + (sch & 3) * 16) = vreg; \
        u32x4 kd_; \
        _Pragma("unroll") for (int e_ = 0; e_ < 4; ++e_) kd_[e_] = cvtpk(__uint_as_float(kreg[e_] << 16) * sdec, __uint_as_float(kreg[e_] & 0xffff0000u) * sdec); \
        *(LAS u32x4*)(bp_ + RT_KD + (sch >> 2) * 4096 + srow * 64 + (sch & 3) * 16) = kd_; } while (0)
    RT_STAGE(lds);
    __syncthreads();
    for (int n = 0; n < NCH; ++n) {
        LAS unsigned char* bp = lds + (n & 1) * RT_BUF;
        if (n + 1 < NCH) { const bf16* g1 = gq + (size_t)(n + 1) * 64 * INC; qreg = *(const u32x4*)(g1 + C_QB); kreg = *(const u32x4*)(g1 + C_KB); vreg = *(const u32x4*)(g1 + C_VB); }
        unsigned short gr[8];
#pragma unroll
        for (int r = 0; r < 8; ++r) gr[r] = R[(trow0 + n * 64 + 8 * w + r) * INC + C_GB + hd * 64 + f_lane];
        if (role == 0) {
            bf16x8 qf[4];
#pragma unroll
            for (int ks = 0; ks < 4; ++ks) qf[ks] = *(const LAS bf16x8*)(bp + RT_Q + (32 * itile + q32) * 144 + (16 * ks + 8 * h) * 2);
            f32x16 st0 = {}, st1 = {};
#pragma unroll
            for (int ks = 0; ks < 4; ++ks) {
                const bf16x8 k0 = *(const LAS bf16x8*)(bp + RT_K + q32 * 144 + (16 * ks + 8 * h) * 2);
                const bf16x8 k1 = *(const LAS bf16x8*)(bp + RT_K + (32 + q32) * 144 + (16 * ks + 8 * h) * 2);
                st0 = __builtin_amdgcn_mfma_f32_32x32x16_bf16(k0, qf[ks], st0, 0, 0, 0);
                st1 = __builtin_amdgcn_mfma_f32_32x32x16_bf16(k1, qf[ks], st1, 0, 0, 0);
            }
            int iiv = 32 * itile + q32 - 4 * h; asm volatile("" : "+v"(iiv));
#pragma unroll
            for (int r = 0; r < 16; ++r) {
                const int dd = iiv - ((r & 3) + 8 * (r >> 2));
                st0[r] *= __builtin_amdgcn_exp2f(l2g * fabsf((float)dd));
                st1[r] *= __builtin_amdgcn_exp2f(l2g * fabsf((float)(dd - 32)));
            }
            f32x16 z = {};
#pragma unroll
            for (int kk = 0; kk < 4; ++kk) {
                const int key0 = 16 * kk + 4 * h;
                const v4i16 bl = ds_tr16(bp + RT_V + etile * 4096 + key0 * 64 + vtr_off), bh = ds_tr16(bp + RT_V + etile * 4096 + (key0 + 8) * 64 + vtr_off);
                const bf16x8 vb = __builtin_shufflevector(bl, bh, 0, 1, 2, 3, 4, 5, 6, 7);
                const bf16x8 xa = (kk < 2) ? pack_step(st0, kk & 1) : pack_step(st1, kk & 1);
                z = __builtin_amdgcn_mfma_f32_32x32x16_bf16(xa, vb, z, 0, 0, 0);
            }
            int zb = (32 * itile + 4 * h) * 66 + 32 * etile + q32; asm volatile("" : "+v"(zb));
#pragma unroll
            for (int r = 0; r < 16; ++r) Zs[zb + ((r & 3) + 8 * (r >> 2)) * 66] = z[r];
        } else {
            f32x16 cr = {};
#pragma unroll
            for (int kk = 0; kk < 4; ++kk) {
                const LAS unsigned char* qp = bp + RT_Q + (32 * itile + q32) * 144 + (16 * kk + 4 * h) * 2;
                const v4i16 al = *(const LAS v4i16*)qp, ah = *(const LAS v4i16*)(qp + 16);
                const bf16x8 qa = __builtin_shufflevector(al, ah, 0, 1, 2, 3, 4, 5, 6, 7);
                const bf16x8 xb = (kk < 2) ? pack_step(xs0, kk & 1) : pack_step(xs1, kk & 1);
                cr = __builtin_amdgcn_mfma_f32_32x32x16_bf16(qa, xb, cr, 0, 0, 0);
            }
            int cb = (32 * itile + 4 * h) * 66 + 32 * etile + q32; asm volatile("" : "+v"(cb));
#pragma unroll
            for (int r = 0; r < 16; ++r) Cs[cb + ((r & 3) + 8 * (r >> 2)) * 66] = cr[r] * qdv[r];
#pragma unroll
            for (int r = 0; r < 16; ++r) { xs0[r] *= cd; xs1[r] *= cd; }
#pragma unroll
            for (int s4 = 0; s4 < 4; ++s4) {
                const int key0 = 16 * s4 + 8 * h;
                const v4i16 vl = ds_tr16(bp + RT_V + etile * 4096 + key0 * 64 + vtr_off), vh = ds_tr16(bp + RT_V + etile * 4096 + (key0 + 4) * 64 + vtr_off);
                const bf16x8 vb = __builtin_shufflevector(vl, vh, 0, 1, 2, 3, 4, 5, 6, 7);
                const v4i16 a0l = ds_tr16(bp + RT_KD + key0 * 64 + vtr_off), a0h = ds_tr16(bp + RT_KD + (key0 + 4) * 64 + vtr_off);
                const v4i16 a1l = ds_tr16(bp + RT_KD + 4096 + key0 * 64 + vtr_off), a1h = ds_tr16(bp + RT_KD + 4096 + (key0 + 4) * 64 + vtr_off);
                const bf16x8 ka0 = __builtin_shufflevector(a0l, a0h, 0, 1, 2, 3, 4, 5, 6, 7), ka1 = __builtin_shufflevector(a1l, a1h, 0, 1, 2, 3, 4, 5, 6, 7);
                xs0 = __builtin_amdgcn_mfma_f32_32x32x16_bf16(ka0, vb, xs0, 0, 0, 0);
                xs1 = __builtin_amdgcn_mfma_f32_32x32x16_bf16(ka1, vb, xs1, 0, 0, 0);
            }
        }
        __syncthreads();
#pragma unroll
        for (int r = 0; r < 8; ++r) {
            const int i = 8 * w + r;
            const float v = Zs[i * 66 + f_lane] + Cs[i * 66 + f_lane];
            const float mu = wave_sum(v) * (1.f / 64.f);
            const float dv = v - mu;
            const float var = wave_sum(dv * dv) * (1.f / 64.f);
            const float g = bf2f(gr[r]);
            O[(trow0 + n * 64 + i) * DM + 512 + hd * 64 + f_lane] = (bf16)f2bf(dv * (1.f / sqrtf(var + EPS)) * (g / (1.f + __expf(-g))));
        }
        if (n + 1 < NCH) RT_STAGE(lds + ((n + 1) & 1) * RT_BUF);
        __syncthreads();
    }
#undef RT_STAGE
}
DI unsigned q8x4(f32x4 v, const float sc) {
    const int a = (int)rintf(v[0] * sc), b = (int)rintf(v[1] * sc), c = (int)rintf(v[2] * sc), d = (int)rintf(v[3] * sc);
    return ((unsigned)a & 0xFFu) | (((unsigned)b & 0xFFu) << 8) | (((unsigned)c & 0xFFu) << 16) | ((unsigned)d << 24);
}
DI void int8_rows(Frame& F, const int row0, const int nrows, const int f_lane) {
    float* SC = (float*)(F.ws + WS_SC);
    for (int rr = row0; rr < row0 + nrows; rr += 2) {
        f32x4 v[2][4]; float am[2];
#pragma unroll
        for (int u = 0; u < 2; ++u) {
            const int row = rr + u, tab = row / PE, e = row % PE, layer = tab & 1, isv = tab >> 1;
            const f32x4* sp = (const f32x4*)((isv ? F.peer_v : F.peer_u) + ((size_t)layer * PE + e) * DM) + f_lane;
#pragma unroll
            for (int j = 0; j < 4; ++j) v[u][j] = sp[64 * j];
        }
#pragma unroll
        for (int u = 0; u < 2; ++u) {
            const int row = rr + u, tab = row / PE, e = row % PE, layer = tab & 1, isv = tab >> 1;
            unsigned* dst = (unsigned*)(F.ws + (isv ? WS_V8 : WS_U8)) + (size_t)layer * 8 * PE * 32;
            const f32x4* gp = (const f32x4*)(F.ffn_norm + layer * DM) + f_lane;
            float a = 0.f;
#pragma unroll
            for (int j = 0; j < 4; ++j) { if (!isv) v[u][j] = v[u][j] * gp[64 * j]; a = fmaxf(a, fmaxf(fmaxf(fabsf(v[u][j][0]), fabsf(v[u][j][1])), fmaxf(fabsf(v[u][j][2]), fabsf(v[u][j][3])))); }
            a = wave_max(a); am[u] = a;
            const float sc = a > 0.f ? 127.f / a : 0.f;
#pragma unroll
            for (int j = 0; j < 4; ++j) dst[((size_t)(2 * j + (f_lane >> 5)) * PE + e) * 32 + (f_lane & 31)] = q8x4(v[u][j], sc);
            if (f_lane == 0) SC[tab * PE + e] = am[u] * (1.f / 127.f);
        }
    }
}
constexpr int Q8_ITEM_ROWS = 512, Q8_ITEMS = 4 * PE / Q8_ITEM_ROWS;
constexpr int PH_MIX_ID = 2;
DI void mix_phase(Frame& F, const int rep) {
    FRAME_IDS;
    unsigned* ctr = (unsigned*)(F.ws + WS_CTL) + CW_QUEUE + 64 * rep;
    volatile LAS unsigned* slot = (volatile LAS unsigned*)(F.lds + MISC_OFF) + 16;
    constexpr int N_RET = NB * NHB, N_ATT = NB * NHA * 8;
    static_assert(N_ATT == 8 * Q8_ITEMS, "8 attention items per quantisation item");
    for (;;) {
        __syncthreads();
        if (f_tid == 0) slot[0] = __hip_atomic_fetch_add(ctr, 1u, __ATOMIC_RELAXED, __HIP_MEMORY_SCOPE_AGENT);
        __syncthreads();
        const int idx = (int)slot[0];
        if (idx >= N_RET + N_ATT + Q8_ITEMS) break;
        const bool probe_pass = (REP_PHASE == PH_MIX_ID && rep == 0);
        if (idx < N_RET) { if (!(probe_pass && PROBE_MODE == 4)) ret_item(F, idx); }
        else if (probe_pass && PROBE_MODE == 3) { }
        else { const int k = idx - N_RET, grp = k / 9, pos = k - 9 * grp;
            if (pos == 8) int8_rows(F, grp * Q8_ITEM_ROWS + F.wave * 64, 64, f_lane);
            else attn_item(F, 8 * grp + pos); }
    }
}
DI float fmax_raw(float a, float b) { float r; asm("v_max_f32_e32 %0, %1, %2" : "=v"(r) : "v"(a), "v"(b)); return r; }
DI float fmin_raw(float a, float b) { float r; asm("v_min_f32_e32 %0, %1, %2" : "=v"(r) : "v"(a), "v"(b)); return r; }
#define CE_DESC(x, y) do { const float hi_ = fmax_raw((x), (y)), lo_ = fmin_raw((x), (y)); (x) = hi_; (y) = lo_; } while (0)
template <int N> DI void sort_desc(float* v) {
#pragma unroll
    for (int k = 2; k <= N; k <<= 1)
#pragma unroll
        for (int j = k >> 1; j > 0; j >>= 1)
#pragma unroll
            for (int i = 0; i < N; ++i) { const int l = i ^ j; if (l > i) { if ((i & k) == 0 || k == N) CE_DESC(v[i], v[l]); else CE_DESC(v[l], v[i]); } }
}
DI void merge16(float* a, const float* b) {
#pragma unroll
    for (int i = 0; i < 16; ++i) a[i] = fmax_raw(a[i], b[15 - i]);
#pragma unroll
    for (int j = 8; j > 0; j >>= 1)
#pragma unroll
        for (int i = 0; i < 16; ++i) { const int l = i ^ j; if (l > i) CE_DESC(a[i], a[l]); }
}
DI float key_pack(float v, unsigned keep_mask, unsigned idx) { return __uint_as_float((__float_as_uint(v) & keep_mask) | idx); }
DI void opt_route(Frame& F, int layer) {
    FRAME_IDS;
    const bf16* Q = (const bf16*)(F.ws + WS_Q);
    int* eidx = (int*)(F.ws + WS_EIDX); float* gate = (float*)(F.ws + WS_GATE);
    const float* keys = F.peer_keys + (size_t)layer * 2 * PK * 64;
    LAS unsigned char* kl = F.lds;
    __syncthreads();
    for (int idx = f_tid; idx < 2 * PK * 8; idx += NTHR) {
        const int row = idx >> 3, ch = idx & 7;
        const f32x4 a = *(const f32x4*)(keys + (size_t)row * 64 + ch * 8), b = *(const f32x4*)(keys + (size_t)row * 64 + ch * 8 + 4);
        *(LAS u32x4*)(kl + row * 144 + ch * 16) = (u32x4){pk2(a[0], a[1]), pk2(a[2], a[3]), pk2(b[0], b[1]), pk2(b[2], b[3])};
    }
    __syncthreads();
    LAS int* lut = (LAS int*)(F.lds + 40960 + F.wave * 8192);
    const int c = f_lane & 31, h = f_lane >> 5;
    pg8::StaticOrder SO; SO.init(T, DM, F.G, F.bid);
    pg8::Unit un;
    for (int ui = 0; SO.next(ui, un); ++ui)
    for (int k2 = F.wave; k2 < 16; k2 += NWAVES) {
        const int tile = 8 * un.pm + (k2 & 7), hh = 2 * un.pn + (k2 >> 3), t = tile * 32 + c;
        float tk[2][16];
#pragma unroll
        for (int side = 0; side < 2; ++side) {
            bf16x8 qf[4];
#pragma unroll
            for (int ks = 0; ks < 4; ++ks) qf[ks] = *(const bf16x8*)(Q + (size_t)t * DM + hh * PQD + side * 64 + 16 * ks + 8 * h);
            float v[64];
#pragma unroll
            for (int kt = 0; kt < 4; ++kt) {
                f32x16 acc = {};
#pragma unroll
                for (int ks = 0; ks < 4; ++ks) {
                    const bf16x8 a = *(const LAS bf16x8*)(kl + (side * PK + 32 * kt + c) * 144 + (16 * ks + 8 * h) * 2);
                    acc = __builtin_amdgcn_mfma_f32_32x32x16_bf16(a, qf[ks], acc, 0, 0, 0);
                }
#pragma unroll
                for (int r = 0; r < 16; ++r) v[16 * kt + r] = key_pack(acc[r], 0xFFFFFF80u, (unsigned)(32 * kt + (r & 3) + 8 * (r >> 2) + 4 * h));
            }
            sort_desc<16>(v); sort_desc<16>(v + 16); sort_desc<16>(v + 32); sort_desc<16>(v + 48);
            merge16(v, v + 16); merge16(v + 32, v + 48); merge16(v, v + 32);
            float pr[16];
#pragma unroll
            for (int i = 0; i < 16; ++i) pr[i] = __shfl_xor(v[i], 32);
            merge16(v, pr);
#pragma unroll
            for (int i = 0; i < 16; ++i) { tk[side][i] = v[i]; lut[(side * 16 + i) * 64 + f_lane] = (int)(__float_as_uint(v[i]) & 0x7Fu); }
        }
        float cd[64];
        {   int n = 0;
#pragma unroll
            for (int a = 0; a < 16; ++a)
#pragma unroll
                for (int b = 0; b < 16; ++b) if ((a + 1) * (b + 1) <= 16) { cd[n] = key_pack(tk[0][a] + tk[1][b], 0xFFFFFF00u, (unsigned)(a * 16 + b)); ++n; }
#pragma unroll
            for (int i = 50; i < 64; ++i) cd[i] = -INFINITY;
        }
        sort_desc<16>(cd); sort_desc<16>(cd + 16); sort_desc<16>(cd + 32); CE_DESC(cd[48], cd[49]);
        merge16(cd, cd + 16); merge16(cd + 32, cd + 48); merge16(cd, cd + 32);
        int ex[16]; float gv[16]; float sum = 0.f;
        const float top = __uint_as_float(__float_as_uint(cd[0]) & 0xFFFFFF00u);
#pragma unroll
        for (int i = 0; i < 16; ++i) {
            const unsigned bits = __float_as_uint(cd[i]);
            const int a = (bits >> 4) & 15, b = bits & 15;
            ex[i] = lut[a * 64 + f_lane] * PK + lut[(16 + b) * 64 + f_lane];
            gv[i] = __expf(__uint_as_float(bits & 0xFFFFFF00u) - top); sum += gv[i];
        }
        const float inv = 1.f / sum;
        if (h == 0) {
            u32x4* ep = (u32x4*)(eidx + (size_t)t * NSEL + hh * 16);
#pragma unroll
            for (int q = 0; q < 4; ++q) ep[q] = (u32x4){(unsigned)ex[4 * q], (unsigned)ex[4 * q + 1], (unsigned)ex[4 * q + 2], (unsigned)ex[4 * q + 3]};
        } else {
            f32x4* gp = (f32x4*)(gate + (size_t)t * NSEL + hh * 16);
#pragma unroll
            for (int q = 0; q < 4; ++q) gp[q] = (f32x4){gv[4 * q] * inv, gv[4 * q + 1] * inv, gv[4 * q + 2] * inv, gv[4 * q + 3] * inv};
        }
    }
    __syncthreads();
}
DI float dot16_fp8(const u32x4 r, const float (&xs)[16]) {
    float s0 = 0.f, s1 = 0.f;
#pragma unroll
    for (int w = 0; w < 4; ++w) {
        const f32x2 lo = __builtin_amdgcn_cvt_pk_f32_fp8((int)r[w], false), hi = __builtin_amdgcn_cvt_pk_f32_fp8((int)r[w], true);
        s0 = fmaf(lo[0], xs[4 * w + 0], s0); s1 = fmaf(lo[1], xs[4 * w + 1], s1); s0 = fmaf(hi[0], xs[4 * w + 2], s0); s1 = fmaf(hi[1], xs[4 * w + 3], s1);
    }
    return s0 + s1;
}
DI void axpy16_fp8(const u32x4 r, const float a, float (&o)[16]) {
#pragma unroll
    for (int w = 0; w < 4; ++w) {
        const f32x2 lo = __builtin_amdgcn_cvt_pk_f32_fp8((int)r[w], false), hi = __builtin_amdgcn_cvt_pk_f32_fp8((int)r[w], true);
        o[4 * w + 0] = fmaf(a, lo[0], o[4 * w + 0]); o[4 * w + 1] = fmaf(a, lo[1], o[4 * w + 1]); o[4 * w + 2] = fmaf(a, hi[0], o[4 * w + 2]); o[4 * w + 3] = fmaf(a, hi[1], o[4 * w + 3]);
    }
}
DI float red_combine(const int level, const float a, const float b, const int lane) {
    const int M = 32 >> level; const bool bit = (lane & M) != 0;
    const float send = bit ? a : b, keep = bit ? b : a;
    return keep + __shfl_xor(send, M);
}
constexpr int brev6(int k) { return ((k & 1) << 5) | ((k & 2) << 3) | ((k & 4) << 1) | ((k & 8) >> 1) | ((k & 16) >> 3) | ((k & 32) >> 5); }
struct XInfo { int xrank, nx, rank, nloc; };
DI XInfo get_xinfo(Frame& F, const bool census) {
    FRAME_IDS;
    volatile LAS unsigned* M = (volatile LAS unsigned*)(F.lds + MISC_OFF);
    __syncthreads();
    if (f_tid == 0) {
        unsigned xr = (unsigned)F.bid & 7u, nx = 8u, rk = (unsigned)F.bid >> 3, nl = ((unsigned)F.G + 7u - ((unsigned)F.bid & 7u)) >> 3;
        if (census) {
            unsigned* bar = (unsigned*)(F.ws + WS_CTL) + CW_BAR; const unsigned x = xb_xcc_id();
            unsigned cnt = 0u, below = 0u, mine = 0u;
#pragma unroll
            for (unsigned j = 0; j < 16; ++j) { const unsigned c = xb_ld(&bar[XB_XCNT(j)]); cnt += (c > 0u); below += (c > 0u && j < x); mine = (j == x) ? c : mine; }
            if (cnt > 0u && mine > 0u) { xr = below; nx = cnt; rk = M[12]; nl = mine; }
        }
        M[20] = xr; M[21] = nx; M[22] = rk; M[23] = nl;
    }
    __syncthreads();
    XInfo xi; xi.xrank = (int)M[20]; xi.nx = (int)M[21]; xi.rank = (int)M[22]; xi.nloc = (int)M[23];
    return xi;
}
DI int comb_c(const int level, const int a, const int b, const int lane) {
    const int M = 4 >> level; const bool bit = (lane & M) != 0;
    const int send = bit ? a : b, keep = bit ? b : a;
    const int recv = level == 0 ? DPP_MOV_I(send, DPP_HMIRROR) : (level == 1 ? DPP_MOV_I(send, DPP_XOR2) : DPP_MOV_I(send, DPP_XOR1));
    return keep + recv;
}
DI int dot16_i8(const u32x4 r, const u32x4 x) {
    int s = __builtin_amdgcn_sdot4((int)r[0], (int)x[0], 0, false);
    s = __builtin_amdgcn_sdot4((int)r[1], (int)x[1], s, false); s = __builtin_amdgcn_sdot4((int)r[2], (int)x[2], s, false); s = __builtin_amdgcn_sdot4((int)r[3], (int)x[3], s, false);
    return s;
}
DI int half_dots(const u32x4 (&rows)[8], const u32x4 xq, const int lane) {
    int p[8];
#pragma unroll
    for (int i = 0; i < 8; ++i) p[i] = dot16_i8(rows[i], xq);
#pragma unroll
    for (int i = 0; i < 4; ++i) p[i] = comb_c(0, p[2 * i], p[2 * i + 1], lane);
    p[0] = comb_c(1, p[0], p[1], lane); p[1] = comb_c(1, p[2], p[3], lane);
    return comb_c(2, p[0], p[1], lane);
}
DI u32x4 xquant(const f32x4 (&hv)[4], const float rstd) {
    u32x4 o;
#pragma unroll
    for (int w = 0; w < 4; ++w) {
        const f32x4 x = hv[w] * (rstd * XQ);
        const int a = (int)rintf(__builtin_amdgcn_fmed3f(x[0], -127.f, 127.f)), b = (int)rintf(__builtin_amdgcn_fmed3f(x[1], -127.f, 127.f)), c = (int)rintf(__builtin_amdgcn_fmed3f(x[2], -127.f, 127.f)), d = (int)rintf(__builtin_amdgcn_fmed3f(x[3], -127.f, 127.f));
        o[w] = ((unsigned)a & 0xFFu) | (((unsigned)b & 0xFFu) << 8) | (((unsigned)c & 0xFFu) << 16) | ((unsigned)d << 24);
    }
    return o;
}
DI float rstd_bcast(const float* part, const int t) {
    const f32x4* p = (const f32x4*)(part + (size_t)t * 16);
    const f32x4 a = p[0], b = p[1], c = p[2], d = p[3];
    const float s = ((a[0] + a[1]) + (a[2] + a[3])) + ((b[0] + b[1]) + (b[2] + b[3])) + ((c[0] + c[1]) + (c[2] + c[3])) + ((d[0] + d[1]) + (d[2] + d[3]));
    return 1.f / sqrtf(s * (1.f / DM) + EPS);
}
DI void gather_u(Frame& F, const int layer, const XInfo xi, const bool dry) {
    FRAME_IDS;
    const unsigned emask = (dry && PROBE_MODE == 2) ? 15u : 0xFFFFFFFFu;
    const int* eidx = (const int*)(F.ws + WS_EIDX); int* PU = (int*)(F.ws + (dry ? WS_R : WS_PU)); const float* part = (const float*)(F.ws + WS_PART); const bf16* hbp = (const bf16*)(F.ws + WS_XB);
    const int g = f_lane >> 3, c = f_lane & 7, c16 = c * 16;
    const int kst = 16 * g + (((c & 1) << 2) | (c & 2) | ((c & 4) >> 2));
    const int gwl = xi.rank * NWAVES + F.wave, NGWL = xi.nloc * NWAVES;
    LAS unsigned char* wl = F.lds + F.wave * 2048;
    __syncthreads();
    for (int j = xi.xrank; j < 8; j += xi.nx) {
        const __amdgpu_buffer_rsrc_t U8 = __builtin_amdgcn_make_buffer_rsrc((void*)(F.ws + WS_U8 + ((size_t)(layer * 8 + j) * PE) * 128), 0, PE * 128, 0x00020000);
        int t = gwl;
        if (t >= T) continue;
#define U_LOAD(tt, ri, rh, rp) do { ri = *(const u32x2*)(eidx + (size_t)(tt) * NSEL + 2 * f_lane) & emask; { const unsigned hw_ = *(const unsigned*)(hbp + (size_t)(tt) * DM + 128 * j + 2 * f_lane); rh = (f32x2){__uint_as_float(hw_ << 16), __uint_as_float(hw_ & 0xffff0000u)}; } \
            rp = part[(size_t)(tt) * 16 + (f_lane & 15)]; } while (0)
#define U_SPREAD(slot, ri, rh, rp, e, xqv) do { \
            float ps_ = rp; ps_ += __int_as_float(DPP_MOV_I(__float_as_int(ps_), DPP_XOR1)); ps_ += __int_as_float(DPP_MOV_I(__float_as_int(ps_), DPP_XOR2)); ps_ += __int_as_float(DPP_MOV_I(__float_as_int(ps_), DPP_HMIRROR)); ps_ += __int_as_float(DPP_MOV_I(__float_as_int(ps_), DPP_ROR8)); \
            const float rs_ = (1.f / sqrtf(ps_ * (1.f / DM) + EPS)) * XQ; \
            const int q0_ = (int)rintf(__builtin_amdgcn_fmed3f(rh[0] * rs_, -127.f, 127.f)), q1_ = (int)rintf(__builtin_amdgcn_fmed3f(rh[1] * rs_, -127.f, 127.f)); \
            LAS unsigned char* sl_ = wl + (slot) * 1024; \
            *(LAS u32x2*)(sl_ + 8 * f_lane) = ri; *(LAS unsigned short*)(sl_ + 512 + 2 * f_lane) = (unsigned short)(((unsigned)q0_ & 0xFFu) | (((unsigned)q1_ & 0xFFu) << 8)); \
            asm volatile("s_waitcnt lgkmcnt(0)" ::: "memory"); \
            _Pragma("unroll") for (int q_ = 0; q_ < 4; ++q_) e[q_] = *(const LAS u32x4*)(sl_ + 64 * g + 16 * q_); \
            xqv = *(const LAS u32x4*)(sl_ + 512 + c16); } while (0)
        u32x2 ri; f32x2 rh; float rp;
        u32x4 e0[4], e1[4], xq, xq1;
        U_LOAD(t, ri, rh, rp); U_SPREAD(0, ri, rh, rp, e0, xq);
        { const int t1 = (t + NGWL < T) ? t + NGWL : t; U_LOAD(t1, ri, rh, rp); U_SPREAD(1, ri, rh, rp, e1, xq1); }
        { const int t2 = (t + 2 * NGWL < T) ? t + 2 * NGWL : t; U_LOAD(t2, ri, rh, rp); }
        u32x4 A0[8], B0[8], A1[8], B1[8];
#pragma unroll
        for (int i = 0; i < 8; ++i) A0[i] = __builtin_amdgcn_raw_buffer_load_b128(U8, (int)e0[i >> 2][i & 3] * 128 + c16, 0, 0);
#pragma unroll
        for (int i = 0; i < 8; ++i) B0[i] = __builtin_amdgcn_raw_buffer_load_b128(U8, (int)e0[2 + (i >> 2)][i & 3] * 128 + c16, 0, 0);
#define U_ITEM(CA, CB, NA, NB, slot) do { \
            _Pragma("unroll") for (int i = 0; i < 8; ++i) NA[i] = __builtin_amdgcn_raw_buffer_load_b128(U8, (int)e1[i >> 2][i & 3] * 128 + c16, 0, 0); \
            asm volatile("" ::: "memory"); \
            const int r0 = half_dots(CA, xq, f_lane); \
            _Pragma("unroll") for (int i = 0; i < 8; ++i) NB[i] = __builtin_amdgcn_raw_buffer_load_b128(U8, (int)e1[2 + (i >> 2)][i & 3] * 128 + c16, 0, 0); \
            asm volatile("" ::: "memory"); \
            const int rr1 = half_dots(CB, xq, f_lane); \
            int* pp = PU + ((size_t)t * 8 + j) * NSEL + kst; \
            pp[0] = r0; pp[8] = rr1; \
            xq = xq1; \
            U_SPREAD(slot, ri, rh, rp, e1, xq1);                        \
            { const int t3 = (t + 3 * NGWL < T) ? t + 3 * NGWL : t; U_LOAD(t3, ri, rh, rp); } } while (0)
        for (;;) {
            U_ITEM(A0, B0, A1, B1, 0); t += NGWL; if (t >= T) break;
            U_ITEM(A1, B1, A0, B0, 1); t += NGWL; if (t >= T) break;
        }
#undef U_ITEM
#undef U_LOAD
#undef U_SPREAD
    }
    __syncthreads();
}
DI void gather_r(Frame& F, const int layer) {
    FRAME_IDS;
    const int* PU = (const int*)(F.ws + WS_PU); const float* gate = (const float*)(F.ws + WS_GATE); const int* eidx = (const int*)(F.ws + WS_EIDX);
    const float* SCu = (const float*)(F.ws + WS_SC) + (size_t)layer * PE; const float* SCv = (const float*)(F.ws + WS_SC) + (size_t)(2 + layer) * PE;
    signed char* A8 = (signed char*)(F.ws + WS_A); float* SA = (float*)(F.ws + WS_SA);
    const int gw = F.bid * NWAVES + F.wave, NGW = F.G * NWAVES;
    for (int t = gw; t < T; t += NGW) {
#pragma unroll
        for (int hf = 0; hf < 2; ++hf) {
            const int k = 64 * hf + f_lane;
            int sacc = 0;
#pragma unroll
            for (int j = 0; j < 8; ++j) sacc += PU[((size_t)t * 8 + j) * NSEL + k];
            const int e = eidx[(size_t)t * NSEL + k];
            const float d = (float)sacc * (SCu[e] * (1.f / XQ));
            const float a = gelu_erf(d) * gate[(size_t)t * NSEL + k] * SCv[e];
            float am = fabsf(a);
#pragma unroll
            for (int o = 1; o < 16; o <<= 1) am = fmaxf(am, __shfl_xor(am, o));
            const float sc = am > 0.f ? 127.f / am : 0.f;
            A8[(size_t)t * NSEL + k] = (signed char)(int)rintf(a * sc);
            if ((f_lane & 15) == 0) SA[(size_t)t * 8 + (k >> 4)] = am * (1.f / 127.f);
        }
    }
}
DI void tr4x4(const unsigned w0, const unsigned w1, const unsigned w2, const unsigned w3, unsigned (&cdw)[4]) {
    const unsigned t01l = __builtin_amdgcn_perm(w1, w0, 0x05010400u), t01h = __builtin_amdgcn_perm(w1, w0, 0x07030602u);
    const unsigned t23l = __builtin_amdgcn_perm(w3, w2, 0x05010400u), t23h = __builtin_amdgcn_perm(w3, w2, 0x07030602u);
    cdw[0] = __builtin_amdgcn_perm(t23l, t01l, 0x05040100u); cdw[1] = __builtin_amdgcn_perm(t23l, t01l, 0x07060302u);
    cdw[2] = __builtin_amdgcn_perm(t23h, t01h, 0x05040100u); cdw[3] = __builtin_amdgcn_perm(t23h, t01h, 0x07060302u);
}
DI void axpy4rows(const u32x4 r0, const u32x4 r1, const u32x4 r2, const u32x4 r3, const unsigned a4, int (&acc)[16]) {
#pragma unroll
    for (int d = 0; d < 4; ++d) {
        unsigned cdw[4];
        tr4x4(r0[d], r1[d], r2[d], r3[d], cdw);
#pragma unroll
        for (int i = 0; i < 4; ++i) acc[4 * d + i] = __builtin_amdgcn_sdot4((int)cdw[i], (int)a4, acc[4 * d + i], false);
    }
}
DI void gather_v(Frame& F, const int layer, const XInfo xi, const bool dry) {
    FRAME_IDS;
    const int* eidx = (const int*)(F.ws + WS_EIDX); const unsigned char* A8 = F.ws + WS_A; const float* SA = (const float*)(F.ws + WS_SA);
    float* part_w = dry ? (float*)(F.ws + WS_R) : (float*)(F.ws + WS_PART); bf16* hb_w = dry ? (bf16*)(F.ws + WS_HID2) : (bf16*)(F.ws + WS_XB); const bf16* hbp = (const bf16*)(F.ws + WS_XB);
    const int g = f_lane >> 3, c = f_lane & 7, c16 = c * 16;
    const int cc = 16 * c + 8 * (g >> 2) + 4 * ((g >> 1) & 1) + 2 * (g & 1);
    const int gwl = xi.rank * NWAVES + F.wave, NGWL = xi.nloc * NWAVES;
    const bool b3 = (f_lane & 8) != 0;
    LAS unsigned char* wl = F.lds + F.wave * 2048;
    __syncthreads();
    for (int j = xi.xrank; j < 8; j += xi.nx) {
        const __amdgpu_buffer_rsrc_t V8 = __builtin_amdgcn_make_buffer_rsrc((void*)(F.ws + WS_V8 + ((size_t)(layer * 8 + j) * PE) * 128), 0, PE * 128, 0x00020000);
        int t = gwl;
        if (t >= T) continue;
#define V_LOAD(tt, ri, ra, rs) do { ri = *(const u32x2*)(eidx + (size_t)(tt) * NSEL + 2 * f_lane); ra = *(const unsigned short*)(A8 + (size_t)(tt) * NSEL + 2 * f_lane); rs = SA[(size_t)(tt) * 8 + (f_lane & 7)]; } while (0)
#define V_SPREAD(slot, ri, ra, rs, e, avv, sav) do { \
            LAS unsigned char* sl_ = wl + (slot) * 1024; \
            *(LAS u32x2*)(sl_ + 8 * f_lane) = ri; *(LAS unsigned short*)(sl_ + 512 + 2 * f_lane) = ra; if (f_lane < 8) *(LAS float*)(sl_ + 640 + 4 * f_lane) = rs; \
            asm volatile("s_waitcnt lgkmcnt(0)" ::: "memory"); \
            _Pragma("unroll") for (int q_ = 0; q_ < 4; ++q_) e[q_] = *(const LAS u32x4*)(sl_ + 64 * g + 16 * q_); \
            avv = *(const LAS u32x4*)(sl_ + 512 + 16 * g); sav = *(const LAS float*)(sl_ + 640 + 4 * g); } while (0)
        u32x2 ri; unsigned short ra; float rs;
        u32x4 e0[4], e1[4], av, a1; float sa, sa1; f32x2 hold;
        V_LOAD(t, ri, ra, rs); V_SPREAD(0, ri, ra, rs, e0, av, sa);
        { const int t1 = (t + NGWL < T) ? t + NGWL : t; V_LOAD(t1, ri, ra, rs); V_SPREAD(1, ri, ra, rs, e1, a1, sa1); }
        { const int t2 = (t + 2 * NGWL < T) ? t + 2 * NGWL : t; V_LOAD(t2, ri, ra, rs); }
        { const unsigned hw_ = *(const unsigned*)(hbp + (size_t)t * DM + 128 * j + cc); hold = (f32x2){__uint_as_float(hw_ << 16), __uint_as_float(hw_ & 0xffff0000u)}; }
        u32x4 A0[8], B0[8], A1[8], B1[8];
#pragma unroll
        for (int i = 0; i < 8; ++i) A0[i] = __builtin_amdgcn_raw_buffer_load_b128(V8, (int)e0[i >> 2][i & 3] * 128 + c16, 0, 0);
#pragma unroll
        for (int i = 0; i < 8; ++i) B0[i] = __builtin_amdgcn_raw_buffer_load_b128(V8, (int)e0[2 + (i >> 2)][i & 3] * 128 + c16, 0, 0);
#define V_ITEM(CA, CB, NA, NB, slot) do { \
            const int t1 = (t + NGWL < T) ? t + NGWL : t; \
            const unsigned hw1_ = *(const unsigned*)(hbp + (size_t)t1 * DM + 128 * j + cc); \
            _Pragma("unroll") for (int i = 0; i < 8; ++i) NA[i] = __builtin_amdgcn_raw_buffer_load_b128(V8, (int)e1[i >> 2][i & 3] * 128 + c16, 0, 0); \
            asm volatile("" ::: "memory"); \
            int acc[16]; \
            _Pragma("unroll") for (int n = 0; n < 16; ++n) acc[n] = 0; \
            axpy4rows(CA[0], CA[1], CA[2], CA[3], av[0], acc); axpy4rows(CA[4], CA[5], CA[6], CA[7], av[1], acc); \
            _Pragma("unroll") for (int i = 0; i < 8; ++i) NB[i] = __builtin_amdgcn_raw_buffer_load_b128(V8, (int)e1[2 + (i >> 2)][i & 3] * 128 + c16, 0, 0); \
            asm volatile("" ::: "memory"); \
            axpy4rows(CB[0], CB[1], CB[2], CB[3], av[2], acc); axpy4rows(CB[4], CB[5], CB[6], CB[7], av[3], acc); \
            float o[16]; \
            _Pragma("unroll") for (int n = 0; n < 16; ++n) o[n] = (float)acc[n] * sa; \
            float r8[8], r4[4], r2[2]; \
            _Pragma("unroll") for (int n = 0; n < 8; ++n) r8[n] = swap32_add(o[n], o[8 + n]); \
            _Pragma("unroll") for (int n = 0; n < 4; ++n) r4[n] = swap16_add(r8[n], r8[4 + n]); \
            _Pragma("unroll") for (int n = 0; n < 2; ++n) { const float keep = b3 ? r4[2 + n] : r4[n], send = b3 ? r4[n] : r4[2 + n]; r2[n] = keep + __int_as_float(DPP_MOV_I(__float_as_int(send), DPP_ROR8)); } \
            const float h0 = hold[0] + r2[0], h1v = hold[1] + r2[1]; \
            const float ss = wave_sum_fast(h0 * h0 + h1v * h1v); \
            *(unsigned*)(hb_w + (size_t)t * DM + 128 * j + cc) = cvtpk(h0, h1v); \
            if (f_lane == 0) part_w[(size_t)t * 16 + j] = ss; \
            if (j == 0 && f_lane >= 8 && f_lane < 16) part_w[(size_t)t * 16 + f_lane] = 0.f; \
            av = a1; sa = sa1; hold = (f32x2){__uint_as_float(hw1_ << 16), __uint_as_float(hw1_ & 0xffff0000u)}; \
            V_SPREAD(slot, ri, ra, rs, e1, a1, sa1); \
            { const int t3 = (t + 3 * NGWL < T) ? t + 3 * NGWL : t; V_LOAD(t3, ri, ra, rs); } } while (0)
        for (;;) {
            V_ITEM(A0, B0, A1, B1, 0); t += NGWL; if (t >= T) break;
            V_ITEM(A1, B1, A0, B0, 1); t += NGWL; if (t >= T) break;
        }
#undef V_ITEM
#undef V_LOAD
#undef V_SPREAD
    }
    __syncthreads();
}
DI void final_norm(Frame& F) {
    FRAME_IDS;
    const float* part = (const float*)(F.ws + WS_PART); const bf16* hbp = (const bf16*)(F.ws + WS_XB);
    const int gw = F.bid * NWAVES + F.wave, NGW = F.G * NWAVES;
    for (int t = gw; t < T; t += NGW) {
        const float r = rstd_bcast(part, t);
        const u32x2* hp = (const u32x2*)(hbp + (size_t)t * DM) + f_lane;
        f32x4* op = (f32x4*)(F.out + (size_t)t * DM) + f_lane;
        const f32x4* gp = (const f32x4*)F.final_norm + f_lane;
#pragma unroll
        for (int q = 0; q < 4; ++q) { const u32x2 w = hp[64 * q];
            const f32x4 h = {__uint_as_float(w[0] << 16), __uint_as_float(w[0] & 0xffff0000u), __uint_as_float(w[1] << 16), __uint_as_float(w[1] & 0xffff0000u)};
            op[64 * q] = h * r * gp[64 * q]; }
    }
}
DI void opt_conv(Frame& F) {
    FRAME_IDS;
    const bf16* G = (const bf16*)(F.ws + WS_GLU); bf16* H2 = (bf16*)(F.ws + WS_HID2);
    LAS float* ys = (LAS float*)F.lds;
    float wt0[CW], wt1[CW];
#pragma unroll
    for (int j = 0; j < CW; ++j) { const f32x2 wv = *(const f32x2*)(F.conv_dw + j * DM + 2 * f_tid); wt0[j] = wv[0]; wt1[j] = wv[1]; }
    const f32x2 bdw = *(const f32x2*)(F.conv_dw_b + 2 * f_tid);
    for (int it = F.bid; it < T / 128; it += F.G) {
        const int s0 = (it % (SEQ / 128)) * 128;
        const size_t row0 = (size_t)it * 128;
        const unsigned* gp = (const unsigned*)G + f_tid;
        unsigned win[CW];
#pragma unroll
        for (int u = 0; u < CW - 1; ++u) { const int sp = s0 - (CW - 1) + u; win[u + 1] = sp >= 0 ? gp[(row0 - (CW - 1) + u) * 512] : 0u; }
        win[0] = 0u;
        for (int bt = 0; bt < 5; ++bt) {
            unsigned nx[CW];
#pragma unroll
            for (int u = 0; u < CW; ++u) { const int sl = 31 * bt + u; nx[u] = (s0 + sl < SEQ) ? gp[(row0 + sl) * 512] : 0u; }
            __syncthreads();
#pragma unroll
            for (int u = 0; u < CW; ++u) {
                win[u] = nx[u];
                float a0 = bdw[0], a1 = bdw[1];
#pragma unroll
                for (int j = 0; j < CW; ++j) {
                    const unsigned xv = win[(u + 1 + j) % CW];
                    a0 = fmaf(wt0[j], __uint_as_float(xv << 16), a0); a1 = fmaf(wt1[j], __uint_as_float(xv & 0xffff0000u), a1);
                }
                *(LAS f32x2*)(ys + u * DM + 2 * f_tid) = (f32x2){a0, a1};
            }
            __syncthreads();
            for (int u = F.wave; u < CW; u += NWAVES) {
                const int sl = 31 * bt + u;
                if (sl < 128) {
                    f32x4 v[4]; float sm = 0.f;
#pragma unroll
                    for (int k = 0; k < 4; ++k) { v[k] = *(const LAS f32x4*)(ys + u * DM + 256 * k + 4 * f_lane); sm += (v[k][0] + v[k][1]) + (v[k][2] + v[k][3]); }
                    const float mu = wave_sum(sm) * (1.f / DM);
                    float sq = 0.f;
#pragma unroll
                    for (int k = 0; k < 4; ++k) { v[k] = v[k] - mu; sq += (v[k][0] * v[k][0] + v[k][1] * v[k][1]) + (v[k][2] * v[k][2] + v[k][3] * v[k][3]); }
                    const float rs = 1.f / sqrtf(wave_sum(sq) * (1.f / DM) + EPS);
#pragma unroll
                    for (int k = 0; k < 4; ++k) {
                        const f32x4 g = *(const f32x4*)(F.conv_ln_g + 256 * k + 4 * f_lane), bb = *(const f32x4*)(F.conv_ln_b + 256 * k + 4 * f_lane);
                        f32x4 z = v[k] * rs * g + bb;
#pragma unroll
                        for (int e = 0; e < 4; ++e) z[e] = z[e] / (1.f + __expf(-z[e]));
                        *(u32x2*)(H2 + (row0 + sl) * DM + 256 * k + 4 * f_lane) = (u32x2){cvtpk(z[0], z[1]), cvtpk(z[2], z[3])};
                    }
                }
            }
        }
    }
    __syncthreads();
}
enum Phase { PH_PREP = 0, PH_PROJ, PH_MIX, PH_WOUT, PH_Q0, PH_GU0, PH_GR0, PH_GV0, PH_W1, PH_CONV, PH_W2, PH_Q1, PH_GU1, PH_GR1, PH_GV1, PH_FINAL, PH_COUNT };
struct Args { const float* in[19]; float* out; unsigned char* ws; int ph_lo, ph_hi; };
#ifndef TEST_PHASE
#define TEST_PHASE -1
#endif

__global__ void __launch_bounds__(NTHR, 2) mega_fwd(Args args) {
    extern __shared__ __attribute__((aligned(16))) unsigned char lds[];
    Frame F;
    F.lds = (LAS unsigned char*)lds;
    F.wave = __builtin_amdgcn_readfirstlane((int)threadIdx.x >> 6); FRAME_IDS;
    F.G = gridDim.x; F.bid = blockIdx.x;
    F.x = args.in[0]; F.mix_norm = args.in[1]; F.ffn_norm = args.in[2]; F.final_norm = args.in[3]; F.w_in = args.in[4]; F.w_out = args.in[5]; F.rel_bias = args.in[6];
    F.conv_w1 = args.in[7]; F.conv_b1 = args.in[8]; F.conv_dw = args.in[9]; F.conv_dw_b = args.in[10]; F.conv_ln_g = args.in[11]; F.conv_ln_b = args.in[12];
    F.conv_w2 = args.in[13]; F.conv_b2 = args.in[14]; F.peer_wq = args.in[15]; F.peer_keys = args.in[16]; F.peer_u = args.in[17]; F.peer_v = args.in[18];
    F.out = args.out; F.ws = args.ws;
    volatile LAS unsigned* MISC = (volatile LAS unsigned*)(F.lds + MISC_OFF);
    for (int u = f_tid; u < (LDS_BYTES - LDSCTL_OFF) / 4; u += NTHR) ((LAS unsigned*)(F.lds + LDSCTL_OFF))[u] = 0u;
    __syncthreads();
    const int lo = args.ph_lo, hi = args.ph_hi;
    XcdBarrier bar; bar.bar = (unsigned*)(F.ws + WS_CTL) + CW_BAR; bar.x = 0; bar.st = nullptr;
    if (hi - lo > 1) bar = xcd_barrier_post((unsigned*)(F.ws + WS_CTL) + CW_BAR, MISC + 8);
#define IN(k) ((TEST_PHASE < 0 || TEST_PHASE == (k)) && lo <= (k) && (k) < hi)
#define SEAM(k) do { if (IN(k) && IN((k) + 1)) xcd_barrier(bar, F.wave); } while (0)
#define REPS(k) for (int rep_ = ((k) == REP_PHASE ? 0 : 1); rep_ < 2; ++rep_)
#define GEMM_PHASE(EPI, Aptr, Bptr, NN, ...) do { pg8::Gemm g{(const bf16*)(Aptr), (const bf16*)(Bptr), T, (NN), DM}; pg8::StaticOrder S; S.init(T, (NN), F.G, F.bid); \
        pg8::EPI E{__VA_ARGS__}; pg8::gemm_phase<pg8::EPI, pg8::StaticOrder, true, true>(F.lds, g, S, E, F.wave); } while (0)
    bf16* XB = (bf16*)(F.ws + WS_XB);
    float* PART = (float*)(F.ws + WS_PART); const float* ROPE = (const float*)(F.ws + WS_ROPE);
    if (IN(PH_PREP)) REPS(PH_PREP) { p0_prep(F); p0_weights(F); } SEAM(PH_PREP);
    if (PROBE_MODE == 9 && IN(PH_PREP) && IN(PH_PREP + 1)) { for (int xb_ = 0; xb_ < 8; ++xb_) xcd_barrier(bar, F.wave); }
    if (IN(PH_PROJ)) REPS(PH_PROJ) { GEMM_PHASE(EpiProj, XB, F.ws + WS_WIN, INC, (bf16*)(F.ws + WS_R), ROPE); } SEAM(PH_PROJ);
    if (IN(PH_MIX)) REPS(PH_MIX) { mix_phase(F, rep_); } SEAM(PH_MIX);
    if (IN(PH_WOUT)) REPS(PH_WOUT) { GEMM_PHASE(EpiRes, F.ws + WS_O, F.ws + WS_WOUT, DM, F.x, XB, PART, nullptr); } SEAM(PH_WOUT);
    if (IN(PH_Q0)) REPS(PH_Q0) { GEMM_PHASE(EpiQ, XB, F.ws + WS_WQ, DM, (bf16*)(F.ws + WS_Q), PART); asm volatile("s_waitcnt vmcnt(0)" ::: "memory"); __syncthreads(); opt_route(F, 0); } SEAM(PH_Q0);
    const bool census = (hi - lo > 1);
    if (IN(PH_GU0)) REPS(PH_GU0) { gather_u(F, 0, get_xinfo(F, census), rep_ == 0); } SEAM(PH_GU0);
    if (IN(PH_GR0)) REPS(PH_GR0) { gather_r(F, 0); } SEAM(PH_GR0);
    if (IN(PH_GV0)) REPS(PH_GV0) { gather_v(F, 0, get_xinfo(F, census), rep_ == 0); } SEAM(PH_GV0);
    if (IN(PH_W1)) REPS(PH_W1) { GEMM_PHASE(EpiGlu, XB, F.ws + WS_W1, 2 * DM, (bf16*)(F.ws + WS_GLU), PART, F.conv_b1); } SEAM(PH_W1);
    if (IN(PH_CONV)) REPS(PH_CONV) { opt_conv(F); } SEAM(PH_CONV);
    if (IN(PH_W2)) { GEMM_PHASE(EpiRes, F.ws + WS_HID2, F.ws + WS_W2, DM, nullptr, XB, PART, F.conv_b2); } SEAM(PH_W2);
    if (IN(PH_Q1)) REPS(PH_Q1) { GEMM_PHASE(EpiQ, XB, F.ws + WS_WQ + (size_t)DM * DM * 2, DM, (bf16*)(F.ws + WS_Q), PART); asm volatile("s_waitcnt vmcnt(0)" ::: "memory"); __syncthreads(); opt_route(F, 1); } SEAM(PH_Q1);
    if (IN(PH_GU1)) REPS(PH_GU1) { gather_u(F, 1, get_xinfo(F, census), rep_ == 0); } SEAM(PH_GU1);
    if (IN(PH_GR1)) REPS(PH_GR1) { gather_r(F, 1); } SEAM(PH_GR1);
    if (IN(PH_GV1)) REPS(PH_GV1) { gather_v(F, 1, get_xinfo(F, census), rep_ == 0); } SEAM(PH_GV1);
    if (IN(PH_FINAL)) { final_norm(F); }
#undef IN
#undef SEAM
}

extern "C" void kernel_launch(void* const* d_in, const int* in_sizes, int n_in, void* d_out, int out_size, void* d_ws, size_t ws_size, hipStream_t stream) {
    static int grid = 0;
    if (grid == 0) {
        if (n_in != 19 || out_size != T * DM || ws_size < WS_END) { fprintf(stderr, "kernel_launch: unexpected shapes (n_in %d out %d ws %zu)\n", n_in, out_size, ws_size); grid = -1; return; }
        int dev = 0, cus = 0;
        if (hipGetDevice(&dev) != hipSuccess || hipDeviceGetAttribute(&cus, hipDeviceAttributeMultiprocessorCount, dev) != hipSuccess) { grid = -1; return; }
        if (hipFuncSetAttribute((const void*)mega_fwd, hipFuncAttributeMaxDynamicSharedMemorySize, LDS_BYTES) != hipSuccess) { fprintf(stderr, "kernel_launch: hipFuncSetAttribute failed\n"); grid = -1; return; }
        (void)hipGetLastError();
        grid = cus;
    }
    if (grid < 0) return;
    (void)hipMemsetAsync((char*)d_ws + WS_CTL, 0, CTL_ZERO_BYTES, stream);
    Args a{};
    for (int i = 0; i < 19; ++i) a.in[i] = (const float*)d_in[i];
    a.out = (float*)d_out; a.ws = (unsigned char*)d_ws;
#if MK_ONE_LAUNCH
    a.ph_lo = 0; a.ph_hi = PH_COUNT;
    hipLaunchKernelGGL(mega_fwd, dim3(grid), dim3(NTHR), LDS_BYTES, stream, a);
#else
    for (int p = 0; p < PH_COUNT; ++p) { a.ph_lo = p; a.ph_hi = p + 1; hipLaunchKernelGGL(mega_fwd, dim3(grid), dim3(NTHR), LDS_BYTES, stream, a); }
#endif
}
```

```cpp
#include <hip/hip_runtime.h>
#include <cstdio>
#include <cstdint>

#ifndef REP_PHASE
#define REP_PHASE -1
#endif
#ifndef PROBE_MODE
#define PROBE_MODE 1
#endif
#ifndef MK_ONE_LAUNCH
#define MK_ONE_LAUNCH 1
#endif

#define GAS __attribute__((address_space(1)))
#define LAS __attribute__((address_space(3)))
#define DI __device__ __forceinline__
typedef unsigned short bf16;
typedef float f32x2 __attribute__((ext_vector_type(2)));
typedef float f32x4 __attribute__((ext_vector_type(4)));
typedef unsigned u32x2 __attribute__((ext_vector_type(2)));
typedef unsigned u32x4 __attribute__((ext_vector_type(4)));
typedef short bf16x8 __attribute__((ext_vector_type(8)));
typedef float f32x16 __attribute__((ext_vector_type(16)));

constexpr int NB = 16, SEQ = 2048, DM = 1024, T = NB * SEQ;
constexpr int CHUNK = 64, HD = 64, NHA = 8, NHB = 8, INC = 3584, NCH = SEQ / CHUNK;
constexpr int PH = 8, PK = 128, PE = PK * PK, PQD = 128, PTOP = 16, NSEL = PH * PTOP;
constexpr int CW = 31;
constexpr float EPS = 1e-6f;
constexpr float LOG2E = 1.4426950408889634f;
constexpr float XQ = 127.f / 6.f;
constexpr int NWAVES = 8, NTHR = NWAVES * 64;

constexpr int C_QA = 0, C_KA = 512, C_VA = 1024, C_QB = 1536, C_KB = 2048, C_VB = 2560, C_GB = 3072;

constexpr size_t MiB = 1u << 20;
constexpr size_t WS_CTL = 0, CTL_ZERO_BYTES = 1 * MiB;
constexpr size_t WS_WIN = 2 * MiB, WS_WOUT = 9 * MiB, WS_W1 = 11 * MiB, WS_W2 = 15 * MiB, WS_WQ = 17 * MiB;
constexpr size_t WS_ROPE = 22 * MiB;
constexpr size_t WS_PART = 23 * MiB;
constexpr size_t WS_EIDX = 26 * MiB;
constexpr size_t WS_GATE = 42 * MiB;
constexpr size_t WS_U8 = 64 * MiB, WS_V8 = 96 * MiB;
constexpr size_t WS_SC = 25 * MiB;
constexpr size_t WS_SA = 58 * MiB;
constexpr size_t WS_PU = 256 * MiB;
constexpr size_t WS_A = 384 * MiB;
constexpr size_t WS_XB = 128 * MiB;
constexpr size_t WS_R = 192 * MiB;
constexpr size_t WS_O = 416 * MiB;
constexpr size_t WS_Q = 192 * MiB;
constexpr size_t WS_HID = 256 * MiB;
constexpr size_t WS_GLU = 384 * MiB;
constexpr size_t WS_HID2 = 448 * MiB;
constexpr size_t WS_END = 512 * MiB;
constexpr int CW_BAR = 4096, CW_QUEUE = 8192;

constexpr int RING_BYTES = 131072, LDSCTL_OFF = RING_BYTES, MISC_OFF = LDSCTL_OFF + 320, LDS_BYTES = 147456;

DI float bf2f(bf16 v) { return __uint_as_float(((unsigned)v) << 16); }
DI unsigned f2bf(float f) { unsigned u = __float_as_uint(f); return (u + 0x7fffu + ((u >> 16) & 1u)) >> 16; }
DI unsigned pk2(float lo, float hi) { return f2bf(lo) | (f2bf(hi) << 16); }
#define DPP_MOV_I(x, ctrl) __builtin_amdgcn_mov_dpp((x), (ctrl), 0xF, 0xF, false)
#define DPP_XOR1 0xB1
#define DPP_XOR2 0x4E
#define DPP_HMIRROR 0x141
#define DPP_ROR8 0x128
DI float swap32_add(const float a, const float b) { const auto r = __builtin_amdgcn_permlane32_swap(__float_as_uint(a), __float_as_uint(b), false, false); return __uint_as_float(r[0]) + __uint_as_float(r[1]); }
DI float swap16_add(const float a, const float b) { const auto r = __builtin_amdgcn_permlane16_swap(__float_as_uint(a), __float_as_uint(b), false, false); return __uint_as_float(r[0]) + __uint_as_float(r[1]); }
DI int swap32_addi(const int a, const int b) { const auto r = __builtin_amdgcn_permlane32_swap((unsigned)a, (unsigned)b, false, false); return (int)(r[0] + r[1]); }
DI int swap16_addi(const int a, const int b) { const auto r = __builtin_amdgcn_permlane16_swap((unsigned)a, (unsigned)b, false, false); return (int)(r[0] + r[1]); }
DI float wave_sum_fast(float v) {
    v += __int_as_float(DPP_MOV_I(__float_as_int(v), DPP_XOR1)); v += __int_as_float(DPP_MOV_I(__float_as_int(v), DPP_XOR2));
    v += __int_as_float(DPP_MOV_I(__float_as_int(v), DPP_HMIRROR)); v += __int_as_float(DPP_MOV_I(__float_as_int(v), DPP_ROR8));
    v = swap16_add(v, v); v = swap32_add(v, v);
    return v;
}
DI float wave_sum(float v) { return wave_sum_fast(v); }
DI float swap32_max(const float a) { const auto r = __builtin_amdgcn_permlane32_swap(__float_as_uint(a), __float_as_uint(a), false, false); return fmaxf(__uint_as_float(r[0]), __uint_as_float(r[1])); }
DI float swap16_max(const float a) { const auto r = __builtin_amdgcn_permlane16_swap(__float_as_uint(a), __float_as_uint(a), false, false); return fmaxf(__uint_as_float(r[0]), __uint_as_float(r[1])); }
DI float wave_max(float v) {
    v = fmaxf(v, __int_as_float(DPP_MOV_I(__float_as_int(v), DPP_XOR1))); v = fmaxf(v, __int_as_float(DPP_MOV_I(__float_as_int(v), DPP_XOR2)));
    v = fmaxf(v, __int_as_float(DPP_MOV_I(__float_as_int(v), DPP_HMIRROR))); v = fmaxf(v, __int_as_float(DPP_MOV_I(__float_as_int(v), DPP_ROR8)));
    v = swap16_max(v); v = swap32_max(v);
    return v;
}
DI float block_sum(float v, LAS float* red, int tid) {
    v = wave_sum(v);
    __syncthreads();
    if ((tid & 63) == 0) red[tid >> 6] = v;
    __syncthreads();
    float s = 0.f;
#pragma unroll
    for (int i = 0; i < NWAVES; ++i) s += red[i];
    return s;
}
DI float gelu_erf(float x) { return 0.5f * x * (1.f + erff(x * 0.70710678118654752f)); }
DI float sigmoidf(float x) { return 1.f / (1.f + __expf(-x)); }

DI int lane_id() { int r; asm volatile("v_mbcnt_lo_u32_b32 %0, -1, 0\n\tv_mbcnt_hi_u32_b32 %0, -1, %0" : "=v"(r)); return r; }
#define XB_TMO      128
#define XB_XCNT(j)  (256  + 64 * (j))
#define XB_XSUB(j)  (1280 + 64 * (j))
#define XB_XGEN(j)  (2304 + 64 * (j))
#define XB_TOP      3328
#define XB_TOPGEN   3392
#define XCD_BAR_WORDS 3456
#define XB_SPIN_CAP (1u << 22)
DI unsigned xb_ld(unsigned* p)              { return __hip_atomic_load(p, __ATOMIC_RELAXED, __HIP_MEMORY_SCOPE_AGENT); }
DI unsigned xb_add(unsigned* p, unsigned v) { return __hip_atomic_fetch_add(p, v, __ATOMIC_RELAXED, __HIP_MEMORY_SCOPE_AGENT); }
DI unsigned xb_xcc_id() { return (unsigned)__builtin_amdgcn_s_getreg((3 << 11) | 20) & 0xFu; }
#define XB_SPIN(cond, bar) do { unsigned _sp = 0; while (cond) { __builtin_amdgcn_s_sleep(1); \
    if ((++_sp & 255u) == 0u) { if (xb_ld(&(bar)[XB_TMO])) break; if (_sp > XB_SPIN_CAP) { atomicAdd(&(bar)[XB_TMO], 1u); break; } } } } while (0)
struct XcdBarrier { unsigned* bar; unsigned x; volatile LAS unsigned* st; };
DI XcdBarrier xcd_barrier_post(unsigned* bar, volatile LAS unsigned* st) {
    XcdBarrier b; b.bar = bar; b.x = xb_xcc_id(); b.st = st;
    if (threadIdx.x == 0) st[4] = xb_add(&bar[XB_XCNT(b.x)], 1u);
    return b;
}
DI void xcd_barrier_complete(unsigned* bar, unsigned x, unsigned& nloc, unsigned& nx) {
    const unsigned G = gridDim.x * gridDim.y * gridDim.z;
    unsigned sum, cnt, mine, sp = 0u;
    for (;;) {
        sum = 0u; cnt = 0u; mine = 0u;
#pragma unroll
        for (unsigned j = 0; j < 16; ++j) { const unsigned c = xb_ld(&bar[XB_XCNT(j)]); sum += c; cnt += (c > 0u) ? 1u : 0u; mine = (j == x) ? c : mine; }
        if (sum == G) break;
        __builtin_amdgcn_s_sleep(1);
        if ((++sp & 255u) == 0u) { if (xb_ld(&bar[XB_TMO])) break; if (sp > XB_SPIN_CAP) { atomicAdd(&bar[XB_TMO], 1u); break; } }
    }
    nloc = mine > 0u ? mine : 1u; nx = cnt > 0u ? cnt : 1u;
}
DI void xcd_barrier(const XcdBarrier& b, const int wave_id) {
    asm volatile("s_waitcnt vmcnt(0)" ::: "memory");
    __syncthreads();
    if (wave_id == 0 && lane_id() == 0) {
        unsigned* bar = b.bar;
        __builtin_amdgcn_s_waitcnt(0);
        unsigned nloc = b.st[0], nx = b.st[1];
        if (nloc == 0u) { xcd_barrier_complete(bar, b.x, nloc, nx); b.st[0] = nloc; b.st[1] = nx; }
        const unsigned old = xb_add(&bar[XB_XSUB(b.x)], 1u);
        const unsigned gen = old / nloc;
        if (old + 1u == (gen + 1u) * nloc) {
            __builtin_amdgcn_fence(__ATOMIC_RELEASE, "agent");
            asm volatile("s_waitcnt vmcnt(0)" ::: "memory");
            const unsigned og = xb_add(&bar[XB_TOP], 1u);
            const unsigned tg = og / nx;
            if (og + 1u == (tg + 1u) * nx) xb_add(&bar[XB_TOPGEN], 1u);
            else XB_SPIN(xb_ld(&bar[XB_TOPGEN]) == tg, bar);
            __builtin_amdgcn_fence(__ATOMIC_ACQUIRE, "agent");
            xb_add(&bar[XB_XGEN(b.x)], 1u);
            asm volatile("s_waitcnt vmcnt(0)" ::: "memory");
        } else {
            XB_SPIN(xb_ld(&bar[XB_XGEN(b.x)]) == gen, bar);
            __builtin_amdgcn_fence(__ATOMIC_ACQUIRE, "agent");
            asm volatile("s_waitcnt vmcnt(0)" ::: "memory");
        }
    }
    __syncthreads();
}

namespace pg8 {
#define PG8_LAS __attribute__((address_space(3)))
typedef unsigned short bf16_t;
typedef short bf16x8 __attribute__((ext_vector_type(8)));
typedef float f32x4 __attribute__((ext_vector_type(4)));
typedef unsigned u32x4 __attribute__((ext_vector_type(4)));
constexpr int BM = 256, BK = 64, HALF = 128, HTB = HALF * BK * 2  , STAGE_BYTES = 8 * HTB, NXCD = 8, WGM = 8;

__host__ __device__ __forceinline__ int lds_byte(int r, int c) { const int st = (r >> 4) * 2 + (c >> 5), rr = r & 15, cc = c & 31, ob = rr * 64 + cc * 2; return st * 1024 + (ob ^ (((ob >> 9) & 1) << 5)); }
__host__ __device__ __forceinline__ void stage_rc(int b, int& R, int& C) { const int st = b / 1024, sb = b % 1024, swz = sb ^ (((sb >> 9) & 1) << 5); R = (st >> 1) * 16 + swz / 64; C = (st & 1) * 32 + (swz % 64) / 2; }
__host__ __device__ __forceinline__ int perm32(int rho) { const int n = rho >> 4, i = rho & 15; return 8 * (i >> 2) + 4 * n + (i & 3); }

struct Unit { int pm, pn; };
struct Gemm { const bf16_t* A; const bf16_t* Bt; int M, N, K; };

struct StaticOrder {
    int nM, nN, nwg, G, c;
    __host__ __device__ void init(int M, int N, int G_, int c_) { nM = M / BM; nN = N / BM; nwg = nM * nN; G = G_; c = c_; }
    __host__ __device__ bool next(int i, Unit& u) const {
        const long L = (long)i * G + c; if (L >= nwg) return false;
        int wgid = (int)L; { const int q = nwg / NXCD, r = nwg % NXCD, xcd = wgid % NXCD, off = wgid / NXCD; wgid = (xcd < r ? xcd * (q + 1) : r * (q + 1) + (xcd - r) * q) + off; }
        const int nig = WGM * nN, gid = wgid / nig, fm = gid * WGM, gsz = (nM - fm) < WGM ? (nM - fm) : WGM;
        u.pm = fm + ((wgid % nig) % gsz); u.pn = (wgid % nig) / gsz; return true;
    }
    __device__ __forceinline__ void a_ready(const Unit&) const {}
    __device__ __forceinline__ void done(const Unit&) const {}
};

__device__ __forceinline__ unsigned cvt_pk_bf16(float lo, float hi) { unsigned r; asm volatile("v_cvt_pk_bf16_f32 %0, %1, %2" : "=v"(r) : "v"(lo), "v"(hi)); return r; }
__device__ __forceinline__ float rstd16(const float* part, int r, int fq) {
    const f32x4 a = *(const f32x4*)(part + (size_t)r * 16 + 4 * fq);
    float s = (a[0] + a[1]) + (a[2] + a[3]);
    s = swap16_add(s, s); s = swap32_add(s, s);
    return 1.f / sqrtf(s * (1.f / 1024.f) + 1e-6f);
}
__device__ __forceinline__ u32x4 pack8(const f32x4 a, const f32x4 b) { u32x4 w; w.x = cvt_pk_bf16(a[0], a[1]); w.y = cvt_pk_bf16(a[2], a[3]); w.z = cvt_pk_bf16(b[0], b[1]); w.w = cvt_pk_bf16(b[2], b[3]); return w; }
#define rot(t1, t2, c, s) do { const float a_ = (t1) * (c) - (t2) * (s), b_ = (t1) * (s) + (t2) * (c); (t1) = a_; (t2) = b_; } while (0)

struct EpiProj {
    static constexpr bool PERM = true, AFTER_DRAIN = false;
    bf16_t* R; const float* rope;
    __device__ __forceinline__ void operator()(const f32x4 (&acc)[2][2][4][2], const Unit& u, int wr, int wc, int fr, int fq) const {
        const int type = u.pn >> 1, hg = u.pn & 1;
        const int colbase = type * 512 + (4 * hg + wc) * 64 + 8 * fq;
        const bool do_rope = (type == 3) || (type == 4);
#pragma unroll
        for (int ai = 0; ai < 2; ++ai)
#pragma unroll
            for (int m = 0; m < 4; ++m) {
                const int r = u.pm * BM + ai * HALF + wr * 64 + m * 16 + fr;
                f32x4 a0 = acc[ai][0][m][0], a1 = acc[ai][0][m][1], b0 = acc[ai][1][m][0], b1 = acc[ai][1][m][1];
                if (do_rope) {
                    const f32x4* rp = (const f32x4*)(rope + ((size_t)(r & 2047) * 32 + 8 * fq) * 2);
                    const f32x4 c0 = rp[0], c1 = rp[1], c2 = rp[2], c3 = rp[3];
                    rot(a0[0], b0[0], c0[0], c0[1]); rot(a0[1], b0[1], c0[2], c0[3]); rot(a0[2], b0[2], c1[0], c1[1]); rot(a0[3], b0[3], c1[2], c1[3]);
                    rot(a1[0], b1[0], c2[0], c2[1]); rot(a1[1], b1[1], c2[2], c2[3]); rot(a1[2], b1[2], c3[0], c3[1]); rot(a1[3], b1[3], c3[2], c3[3]);
                }
                bf16_t* rowp = R + (size_t)r * 3584 + colbase;
                *(u32x4*)(rowp) = pack8(a0, a1);
                *(u32x4*)(rowp + 32) = pack8(b0, b1);
            }
    }
};
struct EpiRes {
    static constexpr bool PERM = true, AFTER_DRAIN = false;
    const float* xf; bf16_t* hb; float* part; const float* bias;
    __device__ __forceinline__ void operator()(const f32x4 (&acc)[2][2][4][2], const Unit& u, int wr, int wc, int fr, int fq) const {
        const int col0 = u.pn * BM + wc * 32 + 8 * fq;
        f32x4 bv[2][2];
#pragma unroll
        for (int bj = 0; bj < 2; ++bj)
#pragma unroll
            for (int n = 0; n < 2; ++n) bv[bj][n] = bias ? *(const f32x4*)(bias + col0 + bj * HALF + 4 * n) : (f32x4){0.f, 0.f, 0.f, 0.f};
#pragma unroll
        for (int ai = 0; ai < 2; ++ai)
#pragma unroll
            for (int m = 0; m < 4; ++m) {
                const int r = u.pm * BM + ai * HALF + wr * 64 + m * 16 + fr;
                const size_t off = (size_t)r * 1024 + col0;
                float ss = 0.f;
#pragma unroll
                for (int bj = 0; bj < 2; ++bj) {
                    f32x4 x0, x1;
                    if (xf) { x0 = *(const f32x4*)(xf + off + bj * HALF); x1 = *(const f32x4*)(xf + off + bj * HALF + 4); }
                    else { const u32x4 w = *(const u32x4*)(hb + off + bj * HALF);
                           x0 = (f32x4){__uint_as_float(w[0] << 16), __uint_as_float(w[0] & 0xffff0000u), __uint_as_float(w[1] << 16), __uint_as_float(w[1] & 0xffff0000u)};
                           x1 = (f32x4){__uint_as_float(w[2] << 16), __uint_as_float(w[2] & 0xffff0000u), __uint_as_float(w[3] << 16), __uint_as_float(w[3] & 0xffff0000u)}; }
                    const f32x4 h0 = x0 + acc[ai][bj][m][0] + bv[bj][0], h1 = x1 + acc[ai][bj][m][1] + bv[bj][1];
                    *(u32x4*)(hb + off + bj * HALF) = pack8(h0, h1);
                    ss += (h0[0] * h0[0] + h0[1] * h0[1]) + (h0[2] * h0[2] + h0[3] * h0[3]) + (h1[0] * h1[0] + h1[1] * h1[1]) + (h1[2] * h1[2] + h1[3] * h1[3]);
                }
                ss = swap16_add(ss, ss); ss = swap32_add(ss, ss);
                if (fq == 0) part[(size_t)r * 16 + 4 * u.pn + wc] = ss;
            }
    }
};
struct EpiQ {
    static constexpr bool PERM = true, AFTER_DRAIN = false;
    bf16_t* O; const float* part;
    __device__ __forceinline__ void operator()(const f32x4 (&acc)[2][2][4][2], const Unit& u, int wr, int wc, int fr, int fq) const {
        const int col0 = u.pn * BM + wc * 32 + 8 * fq;
#pragma unroll
        for (int ai = 0; ai < 2; ++ai)
#pragma unroll
            for (int m = 0; m < 4; ++m) {
                const int r = u.pm * BM + ai * HALF + wr * 64 + m * 16 + fr;
                const float rs = rstd16(part, r, fq);
                bf16_t* rowp = O + (size_t)r * 1024 + col0;
#pragma unroll
                for (int bj = 0; bj < 2; ++bj) *(u32x4*)(rowp + bj * HALF) = pack8(acc[ai][bj][m][0] * rs, acc[ai][bj][m][1] * rs);
            }
    }
};
struct EpiGlu {
    static constexpr bool PERM = true, AFTER_DRAIN = false;
    bf16_t* G; const float* part; const float* b1;
    __device__ __forceinline__ void operator()(const f32x4 (&acc)[2][2][4][2], const Unit& u, int wr, int wc, int fr, int fq) const {
        const int col = u.pn * 128 + wc * 32 + 8 * fq;
        f32x4 ba[2], bg[2];
#pragma unroll
        for (int n = 0; n < 2; ++n) { ba[n] = *(const f32x4*)(b1 + col + 4 * n); bg[n] = *(const f32x4*)(b1 + 1024 + col + 4 * n); }
#pragma unroll
        for (int ai = 0; ai < 2; ++ai)
#pragma unroll
            for (int m = 0; m < 4; ++m) {
                const int r = u.pm * BM + ai * HALF + wr * 64 + m * 16 + fr;
                const float rs = rstd16(part, r, fq);
                f32x4 y[2];
#pragma unroll
                for (int n = 0; n < 2; ++n) {
                    const f32x4 a = acc[ai][0][m][n] * rs + ba[n], g = acc[ai][1][m][n] * rs + bg[n];
#pragma unroll
                    for (int i = 0; i < 4; ++i) y[n][i] = a[i] / (1.f + __expf(-g[i]));
                }
                *(u32x4*)(G + (size_t)r * 1024 + col) = pack8(y[0], y[1]);
            }
    }
};
template <class Epi, class Sched, bool ALIGN_EPI = false, bool SP2 = false>
__device__ __forceinline__ void gemm_phase(PG8_LAS unsigned char* lds, const Gemm g, const Sched& S, const Epi& E, const int wave_id) {
    const int lane = lane_id(), wid = wave_id, tid = wid * 64 + lane, wr = wid >> 2, wc = wid & 3, fr = lane & 15, fq = lane >> 4;
    const int K = g.K, nt = K / BK;
    unsigned voffA[2], voffB[2];
#pragma unroll
    for (int i = 0; i < 2; ++i) { int R, C; stage_rc(tid * 16 + i * 8192, R, C); const int Rb = Epi::PERM ? ((R & ~31) + perm32(R & 31)) : R;
        voffA[i] = (unsigned)(R * K + C) * 2u; voffB[i] = (unsigned)(Rb * K + C) * 2u; }
    const size_t kstep = (size_t)(BK * 2);
    const size_t hstep = (size_t)HALF * K * 2;
    const size_t tstep = 2 * hstep;
    const unsigned ldsw = (unsigned)wid * 1024u;
    const int aoff = lds_byte(wr * 64 + fr, fq * 8), boff = lds_byte(wc * 32 + fr, fq * 8);
#define PG8_SA(b, h) (((b) * 2 + (h)) * HTB)
#define PG8_SB(b, h) ((4 + (b) * 2 + (h)) * HTB)
#define PG8_STAGE(bufoff, gbase, voff) do { _Pragma("unroll") for (int _i = 0; _i < 2; ++_i) \
        __builtin_amdgcn_global_load_lds((const unsigned*)((const char*)(gbase) + (voff)[_i]), (PG8_LAS unsigned*)(lds + (bufoff) + ldsw + _i * 8192), 16, 0, 0); } while (0)
#define PG8_LDA(dst, b, h) do { _Pragma("unroll") for (int m = 0; m < 4; ++m) _Pragma("unroll") for (int k = 0; k < 2; ++k) dst[m][k] = *(const PG8_LAS bf16x8*)(lds + PG8_SA(b, h) + aoff + m * 2048 + k * 1024); } while (0)
#define PG8_LDB(dst, b, h) do { _Pragma("unroll") for (int n = 0; n < 2; ++n) _Pragma("unroll") for (int k = 0; k < 2; ++k) dst[n][k] = *(const PG8_LAS bf16x8*)(lds + PG8_SB(b, h) + boff + n * 2048 + k * 1024); } while (0)
#define PG8_MMA(ai, bj, At, Bt) do { __builtin_amdgcn_s_setprio(1); _Pragma("unroll") for (int m = 0; m < 4; ++m) _Pragma("unroll") for (int n = 0; n < 2; ++n) _Pragma("unroll") for (int k = 0; k < 2; ++k) \
        acc[ai][bj][m][n] = __builtin_amdgcn_mfma_f32_16x16x32_bf16(Bt[n][k], At[m][k], acc[ai][bj][m][n], 0, 0, 0); __builtin_amdgcn_s_setprio(0); } while (0)
#define PG8_WAIT_V(n) asm volatile("s_waitcnt vmcnt(" #n ")" ::: "memory")
#define PG8_WAIT_L(n) asm volatile("s_waitcnt lgkmcnt(" #n ")" ::: "memory")
#define PG8_BAR __builtin_amdgcn_s_barrier()
#define PG8_SCHED __builtin_amdgcn_sched_barrier(0)
    Unit cur, nxt; int ui = 0;
    if (!S.next(0, cur)) return;
    f32x4 acc[2][2][4][2];
#pragma unroll
    for (int a = 0; a < 2; ++a)
#pragma unroll
        for (int b = 0; b < 2; ++b)
#pragma unroll
            for (int m = 0; m < 4; ++m)
#pragma unroll
                for (int n = 0; n < 2; ++n) acc[a][b][m][n] = (f32x4){0.f, 0.f, 0.f, 0.f};
    bf16x8 At[4][2], B0[2][2], B1[2][2];
    const char* cA = (const char*)g.A + (size_t)cur.pm * tstep; const char* cB = (const char*)g.Bt + (size_t)cur.pn * tstep;
    S.a_ready(cur);
    if constexpr (SP2) {
        PG8_STAGE(PG8_SB(0, 0), cB, voffB); PG8_STAGE(PG8_SB(0, 1), cB + hstep, voffB); PG8_STAGE(PG8_SA(0, 0), cA, voffA); PG8_STAGE(PG8_SA(0, 1), cA + hstep, voffA);
        if (wr == 1) PG8_BAR;
        PG8_WAIT_V(2); PG8_BAR;
        PG8_STAGE(PG8_SB(1, 0), cB + kstep, voffB); PG8_STAGE(PG8_SA(1, 0), cA + kstep, voffA); PG8_STAGE(PG8_SB(1, 1), cB + hstep + kstep, voffB);
        PG8_WAIT_V(6); PG8_BAR;
    } else {
        PG8_STAGE(PG8_SB(0, 0), cB, voffB); PG8_STAGE(PG8_SA(0, 0), cA, voffA); PG8_STAGE(PG8_SB(0, 1), cB + hstep, voffB); PG8_STAGE(PG8_SA(0, 1), cA + hstep, voffA);
        if (wr == 1) PG8_BAR;
        PG8_WAIT_V(4); PG8_BAR;
        PG8_STAGE(PG8_SB(1, 0), cB + kstep, voffB); PG8_STAGE(PG8_SA(1, 0), cA + kstep, voffA); PG8_STAGE(PG8_SB(1, 1), cB + hstep + kstep, voffB);
        PG8_WAIT_V(6); PG8_BAR;
    }
    for (;;) {
        const bool has_next = S.next(ui + 1, nxt);
        const char* nA = has_next ? (const char*)g.A + (size_t)nxt.pm * tstep : cA; const char* nB = has_next ? (const char*)g.Bt + (size_t)nxt.pn * tstep : cB;
        for (int t = 0; t < nt; t += 2) {
            const bool last = (t == nt - 2);
            const char* a1 = cA + (size_t)(t + 1) * kstep;
            const char* a2 = last ? nA : cA + (size_t)(t + 2) * kstep; const char* b2 = last ? nB : cB + (size_t)(t + 2) * kstep;
            const char* a3 = a2 + kstep; const char* b3 = b2 + kstep;
            if (last && has_next) S.a_ready(nxt);
            if constexpr (SP2) {
            PG8_LDB(B0, 0, 0); PG8_LDB(B1, 0, 1); PG8_SCHED; PG8_LDA(At, 0, 0); PG8_STAGE(PG8_SA(1, 1), a1 + hstep, voffA);
            PG8_WAIT_V(8); PG8_WAIT_L(0); PG8_BAR; PG8_MMA(0, 0, At, B0); PG8_MMA(0, 1, At, B1); PG8_BAR; PG8_SCHED;
            PG8_LDA(At, 0, 1); PG8_STAGE(PG8_SB(0, 0), b2, voffB); PG8_STAGE(PG8_SB(0, 1), b2 + hstep, voffB); PG8_STAGE(PG8_SA(0, 0), a2, voffA);
            PG8_WAIT_V(8); PG8_WAIT_L(0); PG8_BAR; PG8_MMA(1, 0, At, B0); PG8_MMA(1, 1, At, B1); PG8_BAR; PG8_SCHED;
            PG8_LDB(B0, 1, 0); PG8_LDB(B1, 1, 1); PG8_SCHED; PG8_LDA(At, 1, 0); PG8_STAGE(PG8_SA(0, 1), a2 + hstep, voffA);
            PG8_WAIT_V(8); PG8_WAIT_L(0); PG8_BAR; PG8_MMA(0, 0, At, B0); PG8_MMA(0, 1, At, B1); PG8_BAR; PG8_SCHED;
            PG8_LDA(At, 1, 1); PG8_STAGE(PG8_SB(1, 0), b3, voffB); PG8_STAGE(PG8_SB(1, 1), b3 + hstep, voffB); PG8_STAGE(PG8_SA(1, 0), a3, voffA);
            PG8_WAIT_V(8); PG8_WAIT_L(0); PG8_BAR; PG8_MMA(1, 0, At, B0); PG8_MMA(1, 1, At, B1); PG8_BAR; PG8_SCHED;
            } else {
            PG8_LDB(B0, 0, 0); PG8_SCHED; PG8_LDA(At, 0, 0); PG8_STAGE(PG8_SA(1, 1), a1 + hstep, voffA);
            PG8_WAIT_L(8); PG8_BAR; PG8_WAIT_L(0); PG8_MMA(0, 0, At, B0); PG8_BAR; PG8_SCHED;
            PG8_LDB(B1, 0, 1); PG8_STAGE(PG8_SB(0, 0), b2, voffB);
            PG8_BAR; PG8_WAIT_L(0); PG8_MMA(0, 1, At, B1); PG8_BAR;
            PG8_LDA(At, 0, 1); PG8_STAGE(PG8_SA(0, 0), a2, voffA);
            PG8_BAR; PG8_WAIT_L(0); PG8_MMA(1, 0, At, B0); PG8_BAR; PG8_SCHED;
            PG8_STAGE(PG8_SB(0, 1), b2 + hstep, voffB);
            PG8_WAIT_V(6); PG8_BAR; PG8_MMA(1, 1, At, B1); PG8_BAR;
            PG8_LDB(B0, 1, 0); PG8_SCHED; PG8_LDA(At, 1, 0); PG8_STAGE(PG8_SA(0, 1), a2 + hstep, voffA);
            PG8_WAIT_L(8); PG8_BAR; PG8_WAIT_L(0); PG8_MMA(0, 0, At, B0); PG8_BAR; PG8_SCHED;
            PG8_LDB(B1, 1, 1); PG8_STAGE(PG8_SB(1, 0), b3, voffB);
            PG8_BAR; PG8_WAIT_L(0); PG8_MMA(0, 1, At, B1); PG8_BAR;
            PG8_LDA(At, 1, 1); PG8_STAGE(PG8_SA(1, 0), a3, voffA);
            PG8_BAR; PG8_WAIT_L(0); PG8_MMA(1, 0, At, B0); PG8_BAR; PG8_SCHED;
            PG8_STAGE(PG8_SB(1, 1), b3 + hstep, voffB);
            PG8_WAIT_V(6); PG8_BAR; PG8_MMA(1, 1, At, B1); PG8_BAR;
            }
        }
        if constexpr (ALIGN_EPI) { if (wr == 0) PG8_BAR; }
        if constexpr (!Epi::AFTER_DRAIN) { E(acc, cur, wr, wc, fr, fq); S.done(cur); }
        if (!has_next) break;
#pragma unroll
        for (int a = 0; a < 2; ++a)
#pragma unroll
            for (int b = 0; b < 2; ++b)
#pragma unroll
                for (int m = 0; m < 4; ++m)
#pragma unroll
                    for (int n = 0; n < 2; ++n) acc[a][b][m][n] = (f32x4){0.f, 0.f, 0.f, 0.f};
        cur = nxt; cA = nA; cB = nB; ++ui;
        if constexpr (ALIGN_EPI) { if (wr == 1) PG8_BAR; }
    }
    PG8_WAIT_V(0);
    if constexpr (!ALIGN_EPI) { if (wr == 0) PG8_BAR; }
    PG8_BAR;
    if constexpr (Epi::AFTER_DRAIN) { E.fused(acc, cur, wr, wc, fr, fq, lds, wid, lane); S.done(cur); }
#undef PG8_SA
#undef PG8_SB
#undef PG8_STAGE
#undef PG8_LDA
#undef PG8_LDB
#undef PG8_MMA
#undef PG8_WAIT_V
#undef PG8_WAIT_L
#undef PG8_BAR
#undef PG8_SCHED
}
}

struct Frame {
    LAS unsigned char* lds;
    int wave, G, bid;
    const float *x, *mix_norm, *ffn_norm, *final_norm, *w_in, *w_out, *rel_bias, *conv_w1, *conv_b1, *conv_dw, *conv_dw_b, *conv_ln_g, *conv_ln_b, *conv_w2, *conv_b2,
        *peer_wq, *peer_keys, *peer_u, *peer_v;
    float* out;
    unsigned char* ws;
};
#define FRAME_IDS const int f_lane = lane_id(); const int f_tid = F.wave * 64 + f_lane; (void)f_tid
DI float gamma_of(int h) { return 1.f - exp2f(-5.f - (float)h); }

DI void p0_prep(Frame& F) {
    FRAME_IDS;
    const int gw = F.bid * NWAVES + F.wave, NGW = F.G * NWAVES;
    f32x2* rope = (f32x2*)(F.ws + WS_ROPE);
    for (int i = F.bid * NTHR + f_tid; i < SEQ * 32; i += F.G * NTHR) {
        const int s = i >> 5, j = i & 31;
        const float inv = powf(10000.f, -(float)j / 32.f);
        const float ang = (float)s * inv;
        float sn, cs; sincosf(ang, &sn, &cs);
        rope[i] = (f32x2){cs, sn};
    }
    bf16* xb = (bf16*)(F.ws + WS_XB);
    for (int m = gw; m < T; m += NGW) {
        const f32x4* xr = (const f32x4*)(F.x + (size_t)m * DM) + f_lane;
        u32x2* o = (u32x2*)(xb + (size_t)m * DM) + f_lane;
        f32x4 v[4]; float s = 0.f;
#pragma unroll
        for (int j = 0; j < 4; ++j) { v[j] = xr[64 * j]; s += v[j].x * v[j].x + v[j].y * v[j].y + v[j].z * v[j].z + v[j].w * v[j].w; }
        const float r = 1.f / sqrtf(wave_sum(s) * (1.f / DM) + EPS);
#pragma unroll
        for (int j = 0; j < 4; ++j) o[64 * j] = (u32x2){pk2(v[j].x * r, v[j].y * r), pk2(v[j].z * r, v[j].w * r)};
    }
}
DI void p0_transpose_item(const float* W, int K, int N, bf16* WT, int prow0, const float* gain, float scale, LAS float* scr, int k0, int n0, int lane) {
#pragma unroll 8
    for (int i = 0; i < 32; ++i) { const int kk = 2 * i + (lane >> 5); scr[kk * 33 + (lane & 31)] = W[(size_t)(k0 + kk) * N + n0 + (lane & 31)] * (gain ? gain[k0 + kk] : 1.f) * scale; }
    asm volatile("s_waitcnt lgkmcnt(0)" ::: "memory");
    const int c = lane & 7;
#pragma unroll
    for (int j = 0; j < 4; ++j) { const int n = (lane >> 3) + 8 * j; const LAS float* q = scr + (8 * c) * 33 + n;
        u32x4 o; o.x = pk2(q[0 * 33], q[1 * 33]); o.y = pk2(q[2 * 33], q[3 * 33]); o.z = pk2(q[4 * 33], q[5 * 33]); o.w = pk2(q[6 * 33], q[7 * 33]);
        *(u32x4*)(WT + (size_t)(prow0 + n) * K + k0 + 8 * c) = o; }
    asm volatile("s_waitcnt lgkmcnt(0)" ::: "memory");
}
DI void p0_weights(Frame& F) {
    FRAME_IDS;
    LAS float* scr = (LAS float*)(F.lds + F.wave * 16384);
    const int gw = F.bid * NWAVES + F.wave, NGW = F.G * NWAVES;
    constexpr int I_IN = 16 * (INC / 32), I_SQ = 16 * (DM / 32), I_W1 = 16 * (2 * DM / 32);
    constexpr int NITEMS = I_IN + I_SQ + I_W1 + I_SQ + 2 * I_SQ;
    for (int it = gw; it < NITEMS; it += NGW) {
        int r = it;
        if (r < I_IN) { const int nb = r % (INC / 32), kb = r / (INC / 32), n0 = nb * 32;
            const int type = n0 / 512, head = (n0 % 512) / 64, bj = (n0 % 64) / 32;
            const int prow0 = 256 * (2 * type + head / 4) + 128 * bj + 32 * (head % 4);
            p0_transpose_item(F.w_in, DM, INC, (bf16*)(F.ws + WS_WIN), prow0, F.mix_norm, type == 0 ? 0.125f * LOG2E : (type == 4 ? 0.125f : 1.f), scr, kb * 64, n0, f_lane); continue; }
        r -= I_IN;
        if (r < I_SQ) { const int nb = r % 32, kb = r / 32; p0_transpose_item(F.w_out, DM, DM, (bf16*)(F.ws + WS_WOUT), nb * 32, nullptr, 1.f, scr, kb * 64, nb * 32, f_lane); continue; }
        r -= I_SQ;
        if (r < I_W1) { const int nb = r % 64, kb = r / 64, n0 = nb * 32; const int bj = n0 / 1024, rem = n0 % 1024;
            p0_transpose_item(F.conv_w1, DM, 2 * DM, (bf16*)(F.ws + WS_W1), 256 * (rem / 128) + 128 * bj + (rem % 128), F.mix_norm + DM, 1.f, scr, kb * 64, n0, f_lane); continue; }
        r -= I_W1;
        if (r < I_SQ) { const int nb = r % 32, kb = r / 32; p0_transpose_item(F.conv_w2, DM, DM, (bf16*)(F.ws + WS_W2), nb * 32, nullptr, 1.f, scr, kb * 64, nb * 32, f_lane); continue; }
        r -= I_SQ;
        { const int layer = r / I_SQ; r %= I_SQ; const int nb = r % 32, kb = r / 32;
          p0_transpose_item(F.peer_wq + (size_t)layer * DM * DM, DM, DM, (bf16*)(F.ws + WS_WQ) + (size_t)layer * DM * DM, nb * 32, F.ffn_norm + layer * DM, 1.f, scr, kb * 64, nb * 32, f_lane); }
    }
}
DI float row_rstd(const float* part, int m) {
    const f32x4* p = (const f32x4*)(part + (size_t)m * 16);
    const f32x4 a = p[0], b = p[1], c = p[2], d = p[3];
    const float s = ((a.x + a.y) + (a.z + a.w)) + ((b.x + b.y) + (b.z + b.w)) + ((c.x + c.y) + (c.z + c.w)) + ((d.x + d.y) + (d.z + d.w));
    return 1.f / sqrtf(s * (1.f / DM) + EPS);
}

typedef short v4i16 __attribute__((ext_vector_type(4)));
typedef __bf16 bf16x2_t __attribute__((ext_vector_type(2)));
DI unsigned cvtpk(float lo, float hi) { f32x2 v = {lo, hi}; bf16x2_t b = __builtin_convertvector(v, bf16x2_t); return __builtin_bit_cast(unsigned, b); }
DI v4i16 ds_tr16(LAS const unsigned char* p) { return __builtin_amdgcn_ds_read_tr16_b64_v4i16((LAS v4i16*)p); }
DI int crow(int r, int h) { return (r & 3) + 8 * (r >> 2) + 4 * h; }
DI bf16x8 pack_step(const f32x16& x, const int s) {
    u32x4 w = {cvtpk(x[8 * s + 0], x[8 * s + 1]), cvtpk(x[8 * s + 2], x[8 * s + 3]), cvtpk(x[8 * s + 4], x[8 * s + 5]), cvtpk(x[8 * s + 6], x[8 * s + 7])};
    return __builtin_bit_cast(bf16x8, w);
}
constexpr int AT_KB = 64 * 144, AT_VB = 8192, AT_BUF = AT_KB + AT_VB, AT_BIAS = 2 * AT_BUF;
DI void attn_item(Frame& F, const int it) {
    FRAME_IDS;
    const bf16* R = (const bf16*)(F.ws + WS_R); bf16* O = (bf16*)(F.ws + WS_O);
    LAS unsigned char* lds = F.lds;
    LAS float* bias_s = (LAS float*)(lds + AT_BIAS);
    const int q32 = f_lane & 31, h = f_lane >> 5, w = F.wave;
    const int srow = f_tid >> 3, sch = f_tid & 7;
    const int vtr_off = ((f_lane & 15) >> 2) * 64 + (16 * ((f_lane >> 4) & 1) + 4 * (f_lane & 3)) * 2;
    {
        const int b = it / (NHA * 8), hd = (it / 8) % NHA, c0 = (it % 8) * 4;
        const int c = c0 + (w >> 1), qrow0 = 32 * (w & 1);
        const size_t tq = (size_t)b * SEQ + c * 64 + qrow0 + q32;
        __syncthreads();
        for (int k = f_tid; k < 257; k += NTHR) bias_s[k] = F.rel_bias[hd * 257 + k] * LOG2E;
        bf16x8 qf[4];
#pragma unroll
        for (int ks = 0; ks < 4; ++ks) qf[ks] = *(const bf16x8*)(R + tq * INC + C_QA + hd * 64 + 16 * ks + 8 * h);
        const int t_lo = c0 - 8 < 0 ? 0 : c0 - 8, t_hi = c0 + 3, ntile = t_hi - t_lo + 1;
        const bf16* kbase = R + ((size_t)b * SEQ + srow) * INC + C_KA + hd * 64 + 8 * sch;
        const bf16* vbase = R + ((size_t)b * SEQ + srow) * INC + C_VA + hd * 64 + 8 * sch;
        u32x4 kreg = *(const u32x4*)(kbase + (size_t)t_lo * 64 * INC), vreg = *(const u32x4*)(vbase + (size_t)t_lo * 64 * INC);
        *(LAS u32x4*)(lds + srow * 144 + sch * 16) = kreg;
        *(LAS u32x4*)(lds + AT_KB + (sch >> 2) * 4096 + srow * 64 + (sch & 3) * 16) = vreg;
        __syncthreads();
        const float bias_far = bias_s[256];
        float m = -1e30f, l = 0.f;
        f32x16 o0 = {}, o1 = {};
        for (int i = 0; i < ntile; ++i) {
            const int tc = t_lo + i;
            LAS unsigned char* kb = lds + (i & 1) * AT_BUF; LAS unsigned char* vb = kb + AT_KB;
            if (i + 1 < ntile) { kreg = *(const u32x4*)(kbase + (size_t)(tc + 1) * 64 * INC); vreg = *(const u32x4*)(vbase + (size_t)(tc + 1) * 64 * INC); }
            const int D = c - tc;
            if (D >= 0 && D <= 8) {
                const float init = D >= 3 ? bias_far : 0.f;
                f32x16 p0, p1;
#pragma unroll
                for (int r = 0; r < 16; ++r) { p0[r] = init; p1[r] = init; }
#pragma unroll
                for (int ks = 0; ks < 4; ++ks) {
                    const bf16x8 k0 = *(const LAS bf16x8*)(kb + q32 * 144 + (16 * ks + 8 * h) * 2);
                    const bf16x8 k1 = *(const LAS bf16x8*)(kb + (32 + q32) * 144 + (16 * ks + 8 * h) * 2);
                    p0 = __builtin_amdgcn_mfma_f32_32x32x16_bf16(k0, qf[ks], p0, 0, 0, 0);
                    p1 = __builtin_amdgcn_mfma_f32_32x32x16_bf16(k1, qf[ks], p1, 0, 0, 0);
                }
                if (D < 3) {
                    const int relb = D * 64 + qrow0 + q32 - 4 * h + 128;
#pragma unroll
                    for (int r = 0; r < 16; ++r) {
                        const int r0 = relb - ((r & 3) + 8 * (r >> 2));
                        const int i0 = r0 < 0 ? 0 : (r0 > 256 ? 256 : r0), r1 = r0 - 32, i1 = r1 < 0 ? 0 : (r1 > 256 ? 256 : r1);
                        p0[r] += bias_s[i0]; p1[r] += bias_s[i1];
                    }
                }
                float tm = fmaxf(p0[0], p1[0]);
#pragma unroll
                for (int r = 1; r < 16; ++r) tm = fmaxf(tm, fmaxf(p0[r], p1[r]));
                tm = swap32_max(tm);
                const float mn = fmaxf(m, tm), alpha = __builtin_amdgcn_exp2f(m - mn);
                m = mn;
                float ps = 0.f;
#pragma unroll
                for (int r = 0; r < 16; ++r) { p0[r] = __builtin_amdgcn_exp2f(p0[r] - mn); p1[r] = __builtin_amdgcn_exp2f(p1[r] - mn); ps += p0[r] + p1[r]; }
                l = l * alpha + ps;
                if (!__all(alpha == 1.f)) {
#pragma unroll
                    for (int r = 0; r < 16; ++r) { o0[r] *= alpha; o1[r] *= alpha; }
                }
                bf16x8 pf[4];
                pf[0] = pack_step(p0, 0); pf[1] = pack_step(p0, 1); pf[2] = pack_step(p1, 0); pf[3] = pack_step(p1, 1);
#pragma unroll
                for (int kk = 0; kk < 4; ++kk) {
                    const int key0 = 16 * kk + 4 * h;
                    const v4i16 a0l = ds_tr16(vb + key0 * 64 + vtr_off), a0h = ds_tr16(vb + (key0 + 8) * 64 + vtr_off);
                    const v4i16 a1l = ds_tr16(vb + 4096 + key0 * 64 + vtr_off), a1h = ds_tr16(vb + 4096 + (key0 + 8) * 64 + vtr_off);
                    const bf16x8 a0 = __builtin_shufflevector(a0l, a0h, 0, 1, 2, 3, 4, 5, 6, 7), a1 = __builtin_shufflevector(a1l, a1h, 0, 1, 2, 3, 4, 5, 6, 7);
                    o0 = __builtin_amdgcn_mfma_f32_32x32x16_bf16(a0, pf[kk], o0, 0, 0, 0);
                    o1 = __builtin_amdgcn_mfma_f32_32x32x16_bf16(a1, pf[kk], o1, 0, 0, 0);
                }
            }
            if (i + 1 < ntile) {
                LAS unsigned char* nb = lds + ((i + 1) & 1) * AT_BUF;
                *(LAS u32x4*)(nb + srow * 144 + sch * 16) = kreg;
                *(LAS u32x4*)(nb + AT_KB + (sch >> 2) * 4096 + srow * 64 + (sch & 3) * 16) = vreg;
            }
            __syncthreads();
        }
        l = swap32_add(l, l);
        const float inv = 1.f / l;
        bf16* op = O + tq * DM + hd * 64 + 4 * h;
#pragma unroll
        for (int g = 0; g < 4; ++g) {
            *(u32x2*)(op + 8 * g) = (u32x2){cvtpk(o0[4 * g] * inv, o0[4 * g + 1] * inv), cvtpk(o0[4 * g + 2] * inv, o0[4 * g + 3] * inv)};
            *(u32x2*)(op + 32 + 8 * g) = (u32x2){cvtpk(o1[4 * g] * inv, o1[4 * g + 1] * inv), cvtpk(o1[4 * g + 2] * inv, o1[4 * g + 3] * inv)};
        }
    }
    __syncthreads();
}

constexpr int RT_Q = 0, RT_K = 9216, RT_KD = 18432, RT_V = 26624, RT_BUF = 34816, RT_ZS = 2 * RT_BUF, RT_CS = RT_ZS + 64 * 66 * 4;
DI void ret_item(Frame& F, const int it) {
    FRAME_IDS;
    const bf16* R = (const bf16*)(F.ws + WS_R); bf16* O = (bf16*)(F.ws + WS_O);
    LAS unsigned char* lds = F.lds;
    LAS float* Zs = (LAS float*)(lds + RT_ZS); LAS float* Cs = (LAS float*)(lds + RT_CS);
    const int b = it / NHB, hd = it % NHB;
    const int q32 = f_lane & 31, h = f_lane >> 5, w = F.wave;
    const int role = w >> 2, itile = (w >> 1) & 1, etile = w & 1;
    const int srow = f_tid >> 3, sch = f_tid & 7;
    const int vtr_off = ((f_lane & 15) >> 2) * 64 + (16 * ((f_lane >> 4) & 1) + 4 * (f_lane & 3)) * 2;
    const float l2g = log2f(gamma_of(hd));
    const float cd = exp2f(l2g * 64.f), sdec = exp2f(l2g * (float)(63 - srow));
    float qdv[16];
#pragma unroll
    for (int r = 0; r < 16; ++r) qdv[r] = exp2f(l2g * (float)(32 * itile + crow(r, h) + 1));
    f32x16 xs0 = {}, xs1 = {};
    const size_t trow0 = (size_t)b * SEQ;
    const bf16* gq = R + (trow0 + srow) * INC + hd * 64 + 8 * sch;
    u32x4 qreg = *(const u32x4*)(gq + C_QB), kreg = *(const u32x4*)(gq + C_KB), vreg = *(const u32x4*)(gq + C_VB);
    __syncthreads();
#define RT_STAGE(bufp) do { LAS unsigned char* bp_ = (bufp); \
        *(LAS u32x4*)(bp_ + RT_Q + srow * 144 + sch * 16) = qreg; *(LAS u32x4*)(bp_ + RT_K + srow * 144 + sch * 16) = kreg; \
        *(LAS u32x4*)(bp_ + RT_V + (sch >> 2) * 4096 + srow * 64 + (sch & 3) * 16) = vreg; \
        u32x4 kd_; \
        _Pragma("unroll") for (int e_ = 0; e_ < 4; ++e_) kd_[e_] = cvtpk(__uint_as_float(kreg[e_] << 16) * sdec, __uint_as_float(kreg[e_] & 0xffff0000u) * sdec); \
        *(LAS u32x4*)(bp_ + RT_KD + (sch >> 2) * 4096 + srow * 64 + (sch & 3) * 16) = kd_; } while (0)
    RT_STAGE(lds);
    __syncthreads();
    for (int n = 0; n < NCH; ++n) {
        LAS unsigned char* bp = lds + (n & 1) * RT_BUF;
        if (n + 1 < NCH) { const bf16* g1 = gq + (size_t)(n + 1) * 64 * INC; qreg = *(const u32x4*)(g1 + C_QB); kreg = *(const u32x4*)(g1 + C_KB); vreg = *(const u32x4*)(g1 + C_VB); }
        unsigned short gr[8];
#pragma unroll
        for (int r = 0; r < 8; ++r) gr[r] = R[(trow0 + n * 64 + 8 * w + r) * INC + C_GB + hd * 64 + f_lane];
        if (role == 0) {
            bf16x8 qf[4];
#pragma unroll
            for (int ks = 0; ks < 4; ++ks) qf[ks] = *(const LAS bf16x8*)(bp + RT_Q + (32 * itile + q32) * 144 + (16 * ks + 8 * h) * 2);
            f32x16 st0 = {}, st1 = {};
#pragma unroll
            for (int ks = 0; ks < 4; ++ks) {
                const bf16x8 k0 = *(const LAS bf16x8*)(bp + RT_K + q32 * 144 + (16 * ks + 8 * h) * 2);
                const bf16x8 k1 = *(const LAS bf16x8*)(bp + RT_K + (32 + q32) * 144 + (16 * ks + 8 * h) * 2);
                st0 = __builtin_amdgcn_mfma_f32_32x32x16_bf16(k0, qf[ks], st0, 0, 0, 0);
                st1 = __builtin_amdgcn_mfma_f32_32x32x16_bf16(k1, qf[ks], st1, 0, 0, 0);
            }
            int iiv = 32 * itile + q32 - 4 * h; asm volatile("" : "+v"(iiv));
#pragma unroll
            for (int r = 0; r < 16; ++r) {
                const int dd = iiv - ((r & 3) + 8 * (r >> 2));
                st0[r] *= __builtin_amdgcn_exp2f(l2g * fabsf((float)dd));
                st1[r] *= __builtin_amdgcn_exp2f(l2g * fabsf((float)(dd - 32)));
            }
            f32x16 z = {};
#pragma unroll
            for (int kk = 0; kk < 4; ++kk) {
                const int key0 = 16 * kk + 4 * h;
                const v4i16 bl = ds_tr16(bp + RT_V + etile * 4096 + key0 * 64 + vtr_off), bh = ds_tr16(bp + RT_V + etile * 4096 + (key0 + 8) * 64 + vtr_off);
                const bf16x8 vb = __builtin_shufflevector(bl, bh, 0, 1, 2, 3, 4, 5, 6, 7);
                const bf16x8 xa = (kk < 2) ? pack_step(st0, kk & 1) : pack_step(st1, kk & 1);
                z = __builtin_amdgcn_mfma_f32_32x32x16_bf16(xa, vb, z, 0, 0, 0);
            }
            int zb = (32 * itile + 4 * h) * 66 + 32 * etile + q32; asm volatile("" : "+v"(zb));
#pragma unroll
            for (int r = 0; r < 16; ++r) Zs[zb + ((r & 3) + 8 * (r >> 2)) * 66] = z[r];
        } else {
            f32x16 cr = {};
#pragma unroll
            for (int kk = 0; kk < 4; ++kk) {
                const LAS unsigned char* qp = bp + RT_Q + (32 * itile + q32) * 144 + (16 * kk + 4 * h) * 2;
                const v4i16 al = *(const LAS v4i16*)qp, ah = *(const LAS v4i16*)(qp + 16);
                const bf16x8 qa = __builtin_shufflevector(al, ah, 0, 1, 2, 3, 4, 5, 6, 7);
                const bf16x8 xb = (kk < 2) ? pack_step(xs0, kk & 1) : pack_step(xs1, kk & 1);
                cr = __builtin_amdgcn_mfma_f32_32x32x16_bf16(qa, xb, cr, 0, 0, 0);
            }
            int cb = (32 * itile + 4 * h) * 66 + 32 * etile + q32; asm volatile("" : "+v"(cb));
#pragma unroll
            for (int r = 0; r < 16; ++r) Cs[cb + ((r & 3) + 8 * (r >> 2)) * 66] = cr[r] * qdv[r];
#pragma unroll
            for (int r = 0; r < 16; ++r) { xs0[r] *= cd; xs1[r] *= cd; }
#pragma unroll
            for (int s4 = 0; s4 < 4; ++s4) {
                const int key0 = 16 * s4 + 8 * h;
                const v4i16 vl = ds_tr16(bp + RT_V + etile * 4096 + key0 * 64 + vtr_off), vh = ds_tr16(bp + RT_V + etile * 4096 + (key0 + 4) * 64 + vtr_off);
                const bf16x8 vb = __builtin_shufflevector(vl, vh, 0, 1, 2, 3, 4, 5, 6, 7);
                const v4i16 a0l = ds_tr16(bp + RT_KD + key0 * 64 + vtr_off), a0h = ds_tr16(bp + RT_KD + (key0 + 4) * 64 + vtr_off);
                const v4i16 a1l = ds_tr16(bp + RT_KD + 4096 + key0 * 64 + vtr_off), a1h = ds_tr16(bp + RT_KD + 4096 + (key0 + 4) * 64 + vtr_off);
                const bf16x8 ka0 = __builtin_shufflevector(a0l, a0h, 0, 1, 2, 3, 4, 5, 6, 7), ka1 = __builtin_shufflevector(a1l, a1h, 0, 1, 2, 3, 4, 5, 6, 7);
                xs0 = __builtin_amdgcn_mfma_f32_32x32x16_bf16(ka0, vb, xs0, 0, 0, 0);
                xs1 = __builtin_amdgcn_mfma_f32_32x32x16_bf16(ka1, vb, xs1, 0, 0, 0);
            }
        }
        __syncthreads();
#pragma unroll
        for (int r = 0; r < 8; ++r) {
            const int i = 8 * w + r;
            const float v = Zs[i * 66 + f_lane] + Cs[i * 66 + f_lane];
            const float mu = wave_sum(v) * (1.f / 64.f);
            const float dv = v - mu;
            const float var = wave_sum(dv * dv) * (1.f / 64.f);
            const float g = bf2f(gr[r]);
            O[(trow0 + n * 64 + i) * DM + 512 + hd * 64 + f_lane] = (bf16)f2bf(dv * (1.f / sqrtf(var + EPS)) * (g / (1.f + __expf(-g))));
        }
        if (n + 1 < NCH) RT_STAGE(lds + ((n + 1) & 1) * RT_BUF);
        __syncthreads();
    }
#undef RT_STAGE
}
DI unsigned q8x4(f32x4 v, const float sc) {
    const int a = (int)rintf(v[0] * sc), b = (int)rintf(v[1] * sc), c = (int)rintf(v[2] * sc), d = (int)rintf(v[3] * sc);
    return ((unsigned)a & 0xFFu) | (((unsigned)b & 0xFFu) << 8) | (((unsigned)c & 0xFFu) << 16) | ((unsigned)d << 24);
}
DI void int8_rows(Frame& F, const int row0, const int nrows, const int f_lane) {
    float* SC = (float*)(F.ws + WS_SC);
    for (int rr = row0; rr < row0 + nrows; rr += 4) {
        f32x4 v[4][4];
#pragma unroll
        for (int u = 0; u < 4; ++u) {
            const int row = rr + u, tab = row / PE, e = row % PE, layer = tab & 1, isv = tab >> 1;
            const f32x4* sp = (const f32x4*)((isv ? F.peer_v : F.peer_u) + ((size_t)layer * PE + e) * DM) + f_lane;
#pragma unroll
            for (int j = 0; j < 4; ++j) v[u][j] = sp[64 * j];
        }
#pragma unroll
        for (int u = 0; u < 4; ++u) {
            const int row = rr + u, tab = row / PE, e = row % PE, layer = tab & 1, isv = tab >> 1;
            unsigned* dst = (unsigned*)(F.ws + (isv ? WS_V8 : WS_U8)) + (size_t)layer * 8 * PE * 32;
            const f32x4* gp = (const f32x4*)(F.ffn_norm + layer * DM) + f_lane;
            float a = 0.f;
#pragma unroll
            for (int j = 0; j < 4; ++j) { if (!isv) v[u][j] = v[u][j] * gp[64 * j]; a = fmaxf(a, fmaxf(fmaxf(fabsf(v[u][j][0]), fabsf(v[u][j][1])), fmaxf(fabsf(v[u][j][2]), fabsf(v[u][j][3])))); }
            a = wave_max(a);
            const float sc = a > 0.f ? 127.f / a : 0.f;
#pragma unroll
            for (int j = 0; j < 4; ++j) dst[((size_t)(2 * j + (f_lane >> 5)) * PE + e) * 32 + (f_lane & 31)] = q8x4(v[u][j], sc);
            if (f_lane == 0) SC[tab * PE + e] = a * (1.f / 127.f);
        }
    }
}
constexpr int Q8_ITEM_ROWS = 512, Q8_ITEMS = 4 * PE / Q8_ITEM_ROWS;
constexpr int PH_MIX_ID = 2;
DI void mix_phase(Frame& F, const int rep) {
    FRAME_IDS;
    unsigned* ctr = (unsigned*)(F.ws + WS_CTL) + CW_QUEUE + 64 * rep;
    volatile LAS unsigned* slot = (volatile LAS unsigned*)(F.lds + MISC_OFF) + 16;
    constexpr int N_RET = NB * NHB, N_ATT = NB * NHA * 8;
    static_assert(N_ATT == 8 * Q8_ITEMS, "8 attention items per quantisation item");
    for (;;) {
        __syncthreads();
        if (f_tid == 0) slot[0] = __hip_atomic_fetch_add(ctr, 1u, __ATOMIC_RELAXED, __HIP_MEMORY_SCOPE_AGENT);
        __syncthreads();
        const int idx = (int)slot[0];
        if (idx >= N_RET + N_ATT + Q8_ITEMS) break;
        const bool probe_pass = (REP_PHASE == PH_MIX_ID && rep == 0);
        if (idx < N_RET) { if (!(probe_pass && PROBE_MODE == 4)) ret_item(F, idx); }
        else if (probe_pass && PROBE_MODE == 3) { }
        else { const int k = idx - N_RET, grp = k / 9, pos = k - 9 * grp;
            if (pos == 8) int8_rows(F, grp * Q8_ITEM_ROWS + F.wave * 64, 64, f_lane);
            else attn_item(F, 8 * grp + pos); }
    }
}
DI float fmax_raw(float a, float b) { float r; asm("v_max_f32_e32 %0, %1, %2" : "=v"(r) : "v"(a), "v"(b)); return r; }
DI float fmin_raw(float a, float b) { float r; asm("v_min_f32_e32 %0, %1, %2" : "=v"(r) : "v"(a), "v"(b)); return r; }
#define CE_DESC(x, y) do { const float hi_ = fmax_raw((x), (y)), lo_ = fmin_raw((x), (y)); (x) = hi_; (y) = lo_; } while (0)
template <int N> DI void sort_desc(float* v) {
#pragma unroll
    for (int k = 2; k <= N; k <<= 1)
#pragma unroll
        for (int j = k >> 1; j > 0; j >>= 1)
#pragma unroll
            for (int i = 0; i < N; ++i) { const int l = i ^ j; if (l > i) { if ((i & k) == 0 || k == N) CE_DESC(v[i], v[l]); else CE_DESC(v[l], v[i]); } }
}
DI void merge16(float* a, const float* b) {
#pragma unroll
    for (int i = 0; i < 16; ++i) a[i] = fmax_raw(a[i], b[15 - i]);
#pragma unroll
    for (int j = 8; j > 0; j >>= 1)
#pragma unroll
        for (int i = 0; i < 16; ++i) { const int l = i ^ j; if (l > i) CE_DESC(a[i], a[l]); }
}
DI float key_pack(float v, unsigned keep_mask, unsigned idx) { return __uint_as_float((__float_as_uint(v) & keep_mask) | idx); }
DI void opt_route(Frame& F, int layer) {
    FRAME_IDS;
    const bf16* Q = (const bf16*)(F.ws + WS_Q);
    int* eidx = (int*)(F.ws + WS_EIDX); float* gate = (float*)(F.ws + WS_GATE);
    const float* keys = F.peer_keys + (size_t)layer * 2 * PK * 64;
    LAS unsigned char* kl = F.lds;
    __syncthreads();
    for (int idx = f_tid; idx < 2 * PK * 8; idx += NTHR) {
        const int row = idx >> 3, ch = idx & 7;
        const f32x4 a = *(const f32x4*)(keys + (size_t)row * 64 + ch * 8), b = *(const f32x4*)(keys + (size_t)row * 64 + ch * 8 + 4);
        *(LAS u32x4*)(kl + row * 144 + ch * 16) = (u32x4){pk2(a[0], a[1]), pk2(a[2], a[3]), pk2(b[0], b[1]), pk2(b[2], b[3])};
    }
    __syncthreads();
    LAS int* lut = (LAS int*)(F.lds + 40960 + F.wave * 8192);
    const int c = f_lane & 31, h = f_lane >> 5;
    pg8::StaticOrder SO; SO.init(T, DM, F.G, F.bid);
    pg8::Unit un;
    for (int ui = 0; SO.next(ui, un); ++ui)
    for (int k2 = F.wave; k2 < 16; k2 += NWAVES) {
        const int tile = 8 * un.pm + (k2 & 7), hh = 2 * un.pn + (k2 >> 3), t = tile * 32 + c;
        float tk[2][16];
#pragma unroll
        for (int side = 0; side < 2; ++side) {
            bf16x8 qf[4];
#pragma unroll
            for (int ks = 0; ks < 4; ++ks) qf[ks] = *(const bf16x8*)(Q + (size_t)t * DM + hh * PQD + side * 64 + 16 * ks + 8 * h);
            float v[64];
#pragma unroll
            for (int kt = 0; kt < 4; ++kt) {
                f32x16 acc = {};
#pragma unroll
                for (int ks = 0; ks < 4; ++ks) {
                    const bf16x8 a = *(const LAS bf16x8*)(kl + (side * PK + 32 * kt + c) * 144 + (16 * ks + 8 * h) * 2);
                    acc = __builtin_amdgcn_mfma_f32_32x32x16_bf16(a, qf[ks], acc, 0, 0, 0);
                }
#pragma unroll
                for (int r = 0; r < 16; ++r) v[16 * kt + r] = key_pack(acc[r], 0xFFFFFF80u, (unsigned)(32 * kt + (r & 3) + 8 * (r >> 2) + 4 * h));
            }
            sort_desc<16>(v); sort_desc<16>(v + 16); sort_desc<16>(v + 32); sort_desc<16>(v + 48);
            merge16(v, v + 16); merge16(v + 32, v + 48); merge16(v, v + 32);
            float pr[16];
#pragma unroll
            for (int i = 0; i < 16; ++i) pr[i] = __shfl_xor(v[i], 32);
            merge16(v, pr);
#pragma unroll
            for (int i = 0; i < 16; ++i) { tk[side][i] = v[i]; lut[(side * 16 + i) * 64 + f_lane] = (int)(__float_as_uint(v[i]) & 0x7Fu); }
        }
        float cd[64];
        {   int n = 0;
#pragma unroll
            for (int a = 0; a < 16; ++a)
#pragma unroll
                for (int b = 0; b < 16; ++b) if ((a + 1) * (b + 1) <= 16) { cd[n] = key_pack(tk[0][a] + tk[1][b], 0xFFFFFF00u, (unsigned)(a * 16 + b)); ++n; }
#pragma unroll
            for (int i = 50; i < 64; ++i) cd[i] = -INFINITY;
        }
        sort_desc<16>(cd); sort_desc<16>(cd + 16); sort_desc<16>(cd + 32); CE_DESC(cd[48], cd[49]);
        merge16(cd, cd + 16); merge16(cd + 32, cd + 48); merge16(cd, cd + 32);
        int ex[16]; float gv[16]; float sum = 0.f;
        const float top = __uint_as_float(__float_as_uint(cd[0]) & 0xFFFFFF00u);
#pragma unroll
        for (int i = 0; i < 16; ++i) {
            const unsigned bits = __float_as_uint(cd[i]);
            const int a = (bits >> 4) & 15, b = bits & 15;
            ex[i] = lut[a * 64 + f_lane] * PK + lut[(16 + b) * 64 + f_lane];
            gv[i] = __expf(__uint_as_float(bits & 0xFFFFFF00u) - top); sum += gv[i];
        }
        const float inv = 1.f / sum;
        if (h == 0) {
            u32x4* ep = (u32x4*)(eidx + (size_t)t * NSEL + hh * 16);
#pragma unroll
            for (int q = 0; q < 4; ++q) ep[q] = (u32x4){(unsigned)ex[4 * q], (unsigned)ex[4 * q + 1], (unsigned)ex[4 * q + 2], (unsigned)ex[4 * q + 3]};
        } else {
            f32x4* gp = (f32x4*)(gate + (size_t)t * NSEL + hh * 16);
#pragma unroll
            for (int q = 0; q < 4; ++q) gp[q] = (f32x4){gv[4 * q] * inv, gv[4 * q + 1] * inv, gv[4 * q + 2] * inv, gv[4 * q + 3] * inv};
        }
    }
    __syncthreads();
}
DI float dot16_fp8(const u32x4 r, const float (&xs)[16]) {
    float s0 = 0.f, s1 = 0.f;
#pragma unroll
    for (int w = 0; w < 4; ++w) {
        const f32x2 lo = __builtin_amdgcn_cvt_pk_f32_fp8((int)r[w], false), hi = __builtin_amdgcn_cvt_pk_f32_fp8((int)r[w], true);
        s0 = fmaf(lo[0], xs[4 * w + 0], s0); s1 = fmaf(lo[1], xs[4 * w + 1], s1); s0 = fmaf(hi[0], xs[4 * w + 2], s0); s1 = fmaf(hi[1], xs[4 * w + 3], s1);
    }
    return s0 + s1;
}
DI void axpy16_fp8(const u32x4 r, const float a, float (&o)[16]) {
#pragma unroll
    for (int w = 0; w < 4; ++w) {
        const f32x2 lo = __builtin_amdgcn_cvt_pk_f32_fp8((int)r[w], false), hi = __builtin_amdgcn_cvt_pk_f32_fp8((int)r[w], true);
        o[4 * w + 0] = fmaf(a, lo[0], o[4 * w + 0]); o[4 * w + 1] = fmaf(a, lo[1], o[4 * w + 1]); o[4 * w + 2] = fmaf(a, hi[0], o[4 * w + 2]); o[4 * w + 3] = fmaf(a, hi[1], o[4 * w + 3]);
    }
}
DI float red_combine(const int level, const float a, const float b, const int lane) {
    const int M = 32 >> level; const bool bit = (lane & M) != 0;
    const float send = bit ? a : b, keep = bit ? b : a;
    return keep + __shfl_xor(send, M);
}
constexpr int brev6(int k) { return ((k & 1) << 5) | ((k & 2) << 3) | ((k & 4) << 1) | ((k & 8) >> 1) | ((k & 16) >> 3) | ((k & 32) >> 5); }
struct XInfo { int xrank, nx, rank, nloc; };
DI XInfo get_xinfo(Frame& F, const bool census) {
    FRAME_IDS;
    volatile LAS unsigned* M = (volatile LAS unsigned*)(F.lds + MISC_OFF);
    __syncthreads();
    if (f_tid == 0) {
        unsigned xr = (unsigned)F.bid & 7u, nx = 8u, rk = (unsigned)F.bid >> 3, nl = ((unsigned)F.G + 7u - ((unsigned)F.bid & 7u)) >> 3;
        if (census) {
            unsigned* bar = (unsigned*)(F.ws + WS_CTL) + CW_BAR; const unsigned x = xb_xcc_id();
            unsigned cnt = 0u, below = 0u, mine = 0u;
#pragma unroll
            for (unsigned j = 0; j < 16; ++j) { const unsigned c = xb_ld(&bar[XB_XCNT(j)]); cnt += (c > 0u); below += (c > 0u && j < x); mine = (j == x) ? c : mine; }
            if (cnt > 0u && mine > 0u) { xr = below; nx = cnt; rk = M[12]; nl = mine; }
        }
        M[20] = xr; M[21] = nx; M[22] = rk; M[23] = nl;
    }
    __syncthreads();
    XInfo xi; xi.xrank = (int)M[20]; xi.nx = (int)M[21]; xi.rank = (int)M[22]; xi.nloc = (int)M[23];
    return xi;
}
DI int comb_c(const int level, const int a, const int b, const int lane) {
    const int M = 4 >> level; const bool bit = (lane & M) != 0;
    const int send = bit ? a : b, keep = bit ? b : a;
    const int recv = level == 0 ? DPP_MOV_I(send, DPP_HMIRROR) : (level == 1 ? DPP_MOV_I(send, DPP_XOR2) : DPP_MOV_I(send, DPP_XOR1));
    return keep + recv;
}
DI int dot16_i8(const u32x4 r, const u32x4 x) {
    int s = __builtin_amdgcn_sdot4((int)r[0], (int)x[0], 0, false);
    s = __builtin_amdgcn_sdot4((int)r[1], (int)x[1], s, false); s = __builtin_amdgcn_sdot4((int)r[2], (int)x[2], s, false); s = __builtin_amdgcn_sdot4((int)r[3], (int)x[3], s, false);
    return s;
}
DI int half_dots(const u32x4 (&rows)[8], const u32x4 xq, const int lane) {
    int p[8];
#pragma unroll
    for (int i = 0; i < 8; ++i) p[i] = dot16_i8(rows[i], xq);
#pragma unroll
    for (int i = 0; i < 4; ++i) p[i] = comb_c(0, p[2 * i], p[2 * i + 1], lane);
    p[0] = comb_c(1, p[0], p[1], lane); p[1] = comb_c(1, p[2], p[3], lane);
    return comb_c(2, p[0], p[1], lane);
}
DI u32x4 xquant(const f32x4 (&hv)[4], const float rstd) {
    u32x4 o;
#pragma unroll
    for (int w = 0; w < 4; ++w) {
        const f32x4 x = hv[w] * (rstd * XQ);
        const int a = (int)rintf(__builtin_amdgcn_fmed3f(x[0], -127.f, 127.f)), b = (int)rintf(__builtin_amdgcn_fmed3f(x[1], -127.f, 127.f)), c = (int)rintf(__builtin_amdgcn_fmed3f(x[2], -127.f, 127.f)), d = (int)rintf(__builtin_amdgcn_fmed3f(x[3], -127.f, 127.f));
        o[w] = ((unsigned)a & 0xFFu) | (((unsigned)b & 0xFFu) << 8) | (((unsigned)c & 0xFFu) << 16) | ((unsigned)d << 24);
    }
    return o;
}
DI float rstd_bcast(const float* part, const int t) {
    const f32x4* p = (const f32x4*)(part + (size_t)t * 16);
    const f32x4 a = p[0], b = p[1], c = p[2], d = p[3];
    const float s = ((a[0] + a[1]) + (a[2] + a[3])) + ((b[0] + b[1]) + (b[2] + b[3])) + ((c[0] + c[1]) + (c[2] + c[3])) + ((d[0] + d[1]) + (d[2] + d[3]));
    return 1.f / sqrtf(s * (1.f / DM) + EPS);
}
DI void gather_u(Frame& F, const int layer, const XInfo xi, const bool dry) {
    FRAME_IDS;
    const unsigned emask = (dry && PROBE_MODE == 2) ? 15u : 0xFFFFFFFFu;
    const int* eidx = (const int*)(F.ws + WS_EIDX); int* PU = (int*)(F.ws + (dry ? WS_R : WS_PU)); const float* part = (const float*)(F.ws + WS_PART); const bf16* hbp = (const bf16*)(F.ws + WS_XB);
    const int g = f_lane >> 3, c = f_lane & 7, c16 = c * 16;
    const int kst = 16 * g + (((c & 1) << 2) | (c & 2) | ((c & 4) >> 2));
    const int gwl = xi.rank * NWAVES + F.wave, NGWL = xi.nloc * NWAVES;
    LAS unsigned char* wl = F.lds + F.wave * 2048;
    __syncthreads();
    for (int j = xi.xrank; j < 8; j += xi.nx) {
        const __amdgpu_buffer_rsrc_t U8 = __builtin_amdgcn_make_buffer_rsrc((void*)(F.ws + WS_U8 + ((size_t)(layer * 8 + j) * PE) * 128), 0, PE * 128, 0x00020000);
        int t = gwl;
        if (t >= T) continue;
#define U_LOAD(tt, ri, rh, rp) do { ri = *(const u32x2*)(eidx + (size_t)(tt) * NSEL + 2 * f_lane) & emask; { const unsigned hw_ = *(const unsigned*)(hbp + (size_t)(tt) * DM + 128 * j + 2 * f_lane); rh = (f32x2){__uint_as_float(hw_ << 16), __uint_as_float(hw_ & 0xffff0000u)}; } \
            rp = part[(size_t)(tt) * 16 + (f_lane & 15)]; } while (0)
#define U_SPREAD(slot, ri, rh, rp, e, xqv) do { \
            float ps_ = rp; ps_ += __int_as_float(DPP_MOV_I(__float_as_int(ps_), DPP_XOR1)); ps_ += __int_as_float(DPP_MOV_I(__float_as_int(ps_), DPP_XOR2)); ps_ += __int_as_float(DPP_MOV_I(__float_as_int(ps_), DPP_HMIRROR)); ps_ += __int_as_float(DPP_MOV_I(__float_as_int(ps_), DPP_ROR8)); \
            const float rs_ = (1.f / sqrtf(ps_ * (1.f / DM) + EPS)) * XQ; \
            const int q0_ = (int)rintf(__builtin_amdgcn_fmed3f(rh[0] * rs_, -127.f, 127.f)), q1_ = (int)rintf(__builtin_amdgcn_fmed3f(rh[1] * rs_, -127.f, 127.f)); \
            LAS unsigned char* sl_ = wl + (slot) * 1024; \
            *(LAS u32x2*)(sl_ + 8 * f_lane) = ri; *(LAS unsigned short*)(sl_ + 512 + 2 * f_lane) = (unsigned short)(((unsigned)q0_ & 0xFFu) | (((unsigned)q1_ & 0xFFu) << 8)); \
            asm volatile("s_waitcnt lgkmcnt(0)" ::: "memory"); \
            _Pragma("unroll") for (int q_ = 0; q_ < 4; ++q_) e[q_] = *(const LAS u32x4*)(sl_ + 64 * g + 16 * q_); \
            xqv = *(const LAS u32x4*)(sl_ + 512 + c16); } while (0)
        u32x2 ri; f32x2 rh; float rp;
        u32x4 e0[4], e1[4], xq, xq1;
        U_LOAD(t, ri, rh, rp); U_SPREAD(0, ri, rh, rp, e0, xq);
        { const int t1 = (t + NGWL < T) ? t + NGWL : t; U_LOAD(t1, ri, rh, rp); U_SPREAD(1, ri, rh, rp, e1, xq1); }
        { const int t2 = (t + 2 * NGWL < T) ? t + 2 * NGWL : t; U_LOAD(t2, ri, rh, rp); }
        u32x4 A0[8], B0[8], A1[8], B1[8];
#pragma unroll
        for (int i = 0; i < 8; ++i) A0[i] = __builtin_amdgcn_raw_buffer_load_b128(U8, (int)e0[i >> 2][i & 3] * 128 + c16, 0, 0);
#pragma unroll
        for (int i = 0; i < 8; ++i) B0[i] = __builtin_amdgcn_raw_buffer_load_b128(U8, (int)e0[2 + (i >> 2)][i & 3] * 128 + c16, 0, 0);
#define U_ITEM(CA, CB, NA, NB, slot) do { \
            _Pragma("unroll") for (int i = 0; i < 8; ++i) NA[i] = __builtin_amdgcn_raw_buffer_load_b128(U8, (int)e1[i >> 2][i & 3] * 128 + c16, 0, 0); \
            asm volatile("" ::: "memory"); \
            const int r0 = half_dots(CA, xq, f_lane); \
            _Pragma("unroll") for (int i = 0; i < 8; ++i) NB[i] = __builtin_amdgcn_raw_buffer_load_b128(U8, (int)e1[2 + (i >> 2)][i & 3] * 128 + c16, 0, 0); \
            asm volatile("" ::: "memory"); \
            const int rr1 = half_dots(CB, xq, f_lane); \
            int* pp = PU + ((size_t)t * 8 + j) * NSEL + kst; \
            pp[0] = r0; pp[8] = rr1; \
            xq = xq1; \
            U_SPREAD(slot, ri, rh, rp, e1, xq1);                        \
            { const int t3 = (t + 3 * NGWL < T) ? t + 3 * NGWL : t; U_LOAD(t3, ri, rh, rp); } } while (0)
        for (;;) {
            U_ITEM(A0, B0, A1, B1, 0); t += NGWL; if (t >= T) break;
            U_ITEM(A1, B1, A0, B0, 1); t += NGWL; if (t >= T) break;
        }
#undef U_ITEM
#undef U_LOAD
#undef U_SPREAD
    }
    __syncthreads();
}
DI void gather_r(Frame& F, const int layer) {
    FRAME_IDS;
    const int* PU = (const int*)(F.ws + WS_PU); const float* gate = (const float*)(F.ws + WS_GATE); const int* eidx = (const int*)(F.ws + WS_EIDX);
    const float* SCu = (const float*)(F.ws + WS_SC) + (size_t)layer * PE; const float* SCv = (const float*)(F.ws + WS_SC) + (size_t)(2 + layer) * PE;
    signed char* A8 = (signed char*)(F.ws + WS_A); float* SA = (float*)(F.ws + WS_SA);
    const int gw = F.bid * NWAVES + F.wave, NGW = F.G * NWAVES;
    for (int t = gw; t < T; t += NGW) {
        float a[2];
#pragma unroll
        for (int hf = 0; hf < 2; ++hf) {
            const int k = 64 * hf + f_lane;
            int sacc = 0;
#pragma unroll
            for (int j = 0; j < 8; ++j) sacc += PU[((size_t)t * 8 + j) * NSEL + k];
            const int e = eidx[(size_t)t * NSEL + k];
            const float d = (float)sacc * (SCu[e] * (1.f / XQ));
            a[hf] = gelu_erf(d) * gate[(size_t)t * NSEL + k] * SCv[e];
        }
        const float am = wave_max(fmaxf(fabsf(a[0]), fabsf(a[1])));
        const float sc = am > 0.f ? 127.f / am : 0.f;
        A8[(size_t)t * NSEL + f_lane] = (signed char)(int)rintf(a[0] * sc);
        A8[(size_t)t * NSEL + 64 + f_lane] = (signed char)(int)rintf(a[1] * sc);
        if (f_lane == 0) SA[t] = am * (1.f / 127.f);
    }
}
DI void tr4x4(const unsigned w0, const unsigned w1, const unsigned w2, const unsigned w3, unsigned (&cdw)[4]) {
    const unsigned t01l = __builtin_amdgcn_perm(w1, w0, 0x05010400u), t01h = __builtin_amdgcn_perm(w1, w0, 0x07030602u);
    const unsigned t23l = __builtin_amdgcn_perm(w3, w2, 0x05010400u), t23h = __builtin_amdgcn_perm(w3, w2, 0x07030602u);
    cdw[0] = __builtin_amdgcn_perm(t23l, t01l, 0x05040100u); cdw[1] = __builtin_amdgcn_perm(t23l, t01l, 0x07060302u);
    cdw[2] = __builtin_amdgcn_perm(t23h, t01h, 0x05040100u); cdw[3] = __builtin_amdgcn_perm(t23h, t01h, 0x07060302u);
}
DI void axpy4rows(const u32x4 r0, const u32x4 r1, const u32x4 r2, const u32x4 r3, const unsigned a4, int (&acc)[16]) {
#pragma unroll
    for (int d = 0; d < 4; ++d) {
        unsigned cdw[4];
        tr4x4(r0[d], r1[d], r2[d], r3[d], cdw);
#pragma unroll
        for (int i = 0; i < 4; ++i) acc[4 * d + i] = __builtin_amdgcn_sdot4((int)cdw[i], (int)a4, acc[4 * d + i], false);
    }
}
DI void gather_v(Frame& F, const int layer, const XInfo xi, const bool dry) {
    FRAME_IDS;
    const int* eidx = (const int*)(F.ws + WS_EIDX); const unsigned char* A8 = F.ws + WS_A; const float* SA = (const float*)(F.ws + WS_SA);
    float* part_w = dry ? (float*)(F.ws + WS_R) : (float*)(F.ws + WS_PART); bf16* hb_w = dry ? (bf16*)(F.ws + WS_HID2) : (bf16*)(F.ws + WS_XB); const bf16* hbp = (const bf16*)(F.ws + WS_XB);
    const int g = f_lane >> 3, c = f_lane & 7, c16 = c * 16;
    const int cc = 16 * c + 8 * (g >> 2) + 4 * ((g >> 1) & 1) + 2 * (g & 1);
    const int gwl = xi.rank * NWAVES + F.wave, NGWL = xi.nloc * NWAVES;
    const bool b3 = (f_lane & 8) != 0;
    LAS unsigned char* wl = F.lds + F.wave * 2048;
    __syncthreads();
    for (int j = xi.xrank; j < 8; j += xi.nx) {
        const __amdgpu_buffer_rsrc_t V8 = __builtin_amdgcn_make_buffer_rsrc((void*)(F.ws + WS_V8 + ((size_t)(layer * 8 + j) * PE) * 128), 0, PE * 128, 0x00020000);
        int t = gwl;
        if (t >= T) continue;
#define V_LOAD(tt, ri, ra, rs) do { ri = *(const u32x2*)(eidx + (size_t)(tt) * NSEL + 2 * f_lane); ra = *(const unsigned short*)(A8 + (size_t)(tt) * NSEL + 2 * f_lane); rs = SA[(tt)]; } while (0)
#define V_SPREAD(slot, ri, ra, rs, e, avv, sav) do { \
            LAS unsigned char* sl_ = wl + (slot) * 1024; \
            *(LAS u32x2*)(sl_ + 8 * f_lane) = ri; *(LAS unsigned short*)(sl_ + 512 + 2 * f_lane) = ra; \
            asm volatile("s_waitcnt lgkmcnt(0)" ::: "memory"); \
            _Pragma("unroll") for (int q_ = 0; q_ < 4; ++q_) e[q_] = *(const LAS u32x4*)(sl_ + 64 * g + 16 * q_); \
            avv = *(const LAS u32x4*)(sl_ + 512 + 16 * g); sav = rs; } while (0)
        u32x2 ri; unsigned short ra; float rs;
        u32x4 e0[4], e1[4], av, a1; float sa, sa1; f32x2 hold;
        V_LOAD(t, ri, ra, rs); V_SPREAD(0, ri, ra, rs, e0, av, sa);
        { const int t1 = (t + NGWL < T) ? t + NGWL : t; V_LOAD(t1, ri, ra, rs); V_SPREAD(1, ri, ra, rs, e1, a1, sa1); }
        { const int t2 = (t + 2 * NGWL < T) ? t + 2 * NGWL : t; V_LOAD(t2, ri, ra, rs); }
        { const unsigned hw_ = *(const unsigned*)(hbp + (size_t)t * DM + 128 * j + cc); hold = (f32x2){__uint_as_float(hw_ << 16), __uint_as_float(hw_ & 0xffff0000u)}; }
        u32x4 A0[8], B0[8], A1[8], B1[8];
#pragma unroll
        for (int i = 0; i < 8; ++i) A0[i] = __builtin_amdgcn_raw_buffer_load_b128(V8, (int)e0[i >> 2][i & 3] * 128 + c16, 0, 0);
#pragma unroll
        for (int i = 0; i < 8; ++i) B0[i] = __builtin_amdgcn_raw_buffer_load_b128(V8, (int)e0[2 + (i >> 2)][i & 3] * 128 + c16, 0, 0);
#define V_ITEM(CA, CB, NA, NB, slot) do { \
            const int t1 = (t + NGWL < T) ? t + NGWL : t; \
            const unsigned hw1_ = *(const unsigned*)(hbp + (size_t)t1 * DM + 128 * j + cc); \
            _Pragma("unroll") for (int i = 0; i < 8; ++i) NA[i] = __builtin_amdgcn_raw_buffer_load_b128(V8, (int)e1[i >> 2][i & 3] * 128 + c16, 0, 0); \
            asm volatile("" ::: "memory"); \
            int acc[16]; \
            _Pragma("unroll") for (int n = 0; n < 16; ++n) acc[n] = 0; \
            axpy4rows(CA[0], CA[1], CA[2], CA[3], av[0], acc); axpy4rows(CA[4], CA[5], CA[6], CA[7], av[1], acc); \
            _Pragma("unroll") for (int i = 0; i < 8; ++i) NB[i] = __builtin_amdgcn_raw_buffer_load_b128(V8, (int)e1[2 + (i >> 2)][i & 3] * 128 + c16, 0, 0); \
            asm volatile("" ::: "memory"); \
            axpy4rows(CB[0], CB[1], CB[2], CB[3], av[2], acc); axpy4rows(CB[4], CB[5], CB[6], CB[7], av[3], acc); \
            int r8[8], r4[4]; float r2[2]; \
            _Pragma("unroll") for (int n = 0; n < 8; ++n) r8[n] = swap32_addi(acc[n], acc[8 + n]); \
            _Pragma("unroll") for (int n = 0; n < 4; ++n) r4[n] = swap16_addi(r8[n], r8[4 + n]); \
            _Pragma("unroll") for (int n = 0; n < 2; ++n) { const int keep = b3 ? r4[2 + n] : r4[n], send = b3 ? r4[n] : r4[2 + n]; r2[n] = (float)(keep + DPP_MOV_I(send, DPP_ROR8)) * sa; } \
            const float h0 = hold[0] + r2[0], h1v = hold[1] + r2[1]; \
            const float ss = wave_sum_fast(h0 * h0 + h1v * h1v); \
            *(unsigned*)(hb_w + (size_t)t * DM + 128 * j + cc) = cvtpk(h0, h1v); \
            if (f_lane == 0) part_w[(size_t)t * 16 + j] = ss; \
            if (j == 0 && f_lane >= 8 && f_lane < 16) part_w[(size_t)t * 16 + f_lane] = 0.f; \
            av = a1; sa = sa1; hold = (f32x2){__uint_as_float(hw1_ << 16), __uint_as_float(hw1_ & 0xffff0000u)}; \
            V_SPREAD(slot, ri, ra, rs, e1, a1, sa1); \
            { const int t3 = (t + 3 * NGWL < T) ? t + 3 * NGWL : t; V_LOAD(t3, ri, ra, rs); } } while (0)
        for (;;) {
            V_ITEM(A0, B0, A1, B1, 0); t += NGWL; if (t >= T) break;
            V_ITEM(A1, B1, A0, B0, 1); t += NGWL; if (t >= T) break;
        }
#undef V_ITEM
#undef V_LOAD
#undef V_SPREAD
    }
    __syncthreads();
}
DI void final_norm(Frame& F) {
    FRAME_IDS;
    const float* part = (const float*)(F.ws + WS_PART); const bf16* hbp = (const bf16*)(F.ws + WS_XB);
    const int gw = F.bid * NWAVES + F.wave, NGW = F.G * NWAVES;
    for (int t = gw; t < T; t += NGW) {
        const float r = rstd_bcast(part, t);
        const u32x2* hp = (const u32x2*)(hbp + (size_t)t * DM) + f_lane;
        f32x4* op = (f32x4*)(F.out + (size_t)t * DM) + f_lane;
        const f32x4* gp = (const f32x4*)F.final_norm + f_lane;
#pragma unroll
        for (int q = 0; q < 4; ++q) { const u32x2 w = hp[64 * q];
            const f32x4 h = {__uint_as_float(w[0] << 16), __uint_as_float(w[0] & 0xffff0000u), __uint_as_float(w[1] << 16), __uint_as_float(w[1] & 0xffff0000u)};
            op[64 * q] = h * r * gp[64 * q]; }
    }
}
DI void opt_conv(Frame& F) {
    FRAME_IDS;
    const bf16* G = (const bf16*)(F.ws + WS_GLU); bf16* H2 = (bf16*)(F.ws + WS_HID2);
    LAS float* ys = (LAS float*)F.lds;
    float wt0[CW], wt1[CW];
#pragma unroll
    for (int j = 0; j < CW; ++j) { const f32x2 wv = *(const f32x2*)(F.conv_dw + j * DM + 2 * f_tid); wt0[j] = wv[0]; wt1[j] = wv[1]; }
    const f32x2 bdw = *(const f32x2*)(F.conv_dw_b + 2 * f_tid);
    for (int it = F.bid; it < T / 128; it += F.G) {
        const int s0 = (it % (SEQ / 128)) * 128;
        const size_t row0 = (size_t)it * 128;
        const unsigned* gp = (const unsigned*)G + f_tid;
        unsigned win[CW];
#pragma unroll
        for (int u = 0; u < CW - 1; ++u) { const int sp = s0 - (CW - 1) + u; win[u + 1] = sp >= 0 ? gp[(row0 - (CW - 1) + u) * 512] : 0u; }
        win[0] = 0u;
        for (int bt = 0; bt < 5; ++bt) {
            unsigned nx[CW];
#pragma unroll
            for (int u = 0; u < CW; ++u) { const int sl = 31 * bt + u; nx[u] = (s0 + sl < SEQ) ? gp[(row0 + sl) * 512] : 0u; }
            __syncthreads();
#pragma unroll
            for (int u = 0; u < CW; ++u) {
                win[u] = nx[u];
                float a0 = bdw[0], a1 = bdw[1];
#pragma unroll
                for (int j = 0; j < CW; ++j) {
                    const unsigned xv = win[(u + 1 + j) % CW];
                    a0 = fmaf(wt0[j], __uint_as_float(xv << 16), a0); a1 = fmaf(wt1[j], __uint_as_float(xv & 0xffff0000u), a1);
                }
                *(LAS f32x2*)(ys + u * DM + 2 * f_tid) = (f32x2){a0, a1};
            }
            __syncthreads();
            for (int u = F.wave; u < CW; u += NWAVES) {
                const int sl = 31 * bt + u;
                if (sl < 128) {
                    f32x4 v[4]; float sm = 0.f;
#pragma unroll
                    for (int k = 0; k < 4; ++k) { v[k] = *(const LAS f32x4*)(ys + u * DM + 256 * k + 4 * f_lane); sm += (v[k][0] + v[k][1]) + (v[k][2] + v[k][3]); }
                    const float mu = wave_sum(sm) * (1.f / DM);
                    float sq = 0.f;
#pragma unroll
                    for (int k = 0; k < 4; ++k) { v[k] = v[k] - mu; sq += (v[k][0] * v[k][0] + v[k][1] * v[k][1]) + (v[k][2] * v[k][2] + v[k][3] * v[k][3]); }
                    const float rs = 1.f / sqrtf(wave_sum(sq) * (1.f / DM) + EPS);
#pragma unroll
                    for (int k = 0; k < 4; ++k) {
                        const f32x4 g = *(const f32x4*)(F.conv_ln_g + 256 * k + 4 * f_lane), bb = *(const f32x4*)(F.conv_ln_b + 256 * k + 4 * f_lane);
                        f32x4 z = v[k] * rs * g + bb;
#pragma unroll
                        for (int e = 0; e < 4; ++e) z[e] = z[e] / (1.f + __expf(-z[e]));
                        *(u32x2*)(H2 + (row0 + sl) * DM + 256 * k + 4 * f_lane) = (u32x2){cvtpk(z[0], z[1]), cvtpk(z[2], z[3])};
                    }
                }
            }
        }
    }
    __syncthreads();
}
enum Phase { PH_PREP = 0, PH_PROJ, PH_MIX, PH_WOUT, PH_Q0, PH_GU0, PH_GR0, PH_GV0, PH_W1, PH_CONV, PH_W2, PH_Q1, PH_GU1, PH_GR1, PH_GV1, PH_FINAL, PH_COUNT };
struct Args { const float* in[19]; float* out; unsigned char* ws; int ph_lo, ph_hi; };
#ifndef TEST_PHASE
#define TEST_PHASE -1
#endif

__global__ void __launch_bounds__(NTHR, 2) mega_fwd(Args args) {
    extern __shared__ __attribute__((aligned(16))) unsigned char lds[];
    Frame F;
    F.lds = (LAS unsigned char*)lds;
    F.wave = __builtin_amdgcn_readfirstlane((int)threadIdx.x >> 6); FRAME_IDS;
    F.G = gridDim.x; F.bid = blockIdx.x;
    F.x = args.in[0]; F.mix_norm = args.in[1]; F.ffn_norm = args.in[2]; F.final_norm = args.in[3]; F.w_in = args.in[4]; F.w_out = args.in[5]; F.rel_bias = args.in[6];
    F.conv_w1 = args.in[7]; F.conv_b1 = args.in[8]; F.conv_dw = args.in[9]; F.conv_dw_b = args.in[10]; F.conv_ln_g = args.in[11]; F.conv_ln_b = args.in[12];
    F.conv_w2 = args.in[13]; F.conv_b2 = args.in[14]; F.peer_wq = args.in[15]; F.peer_keys = args.in[16]; F.peer_u = args.in[17]; F.peer_v = args.in[18];
    F.out = args.out; F.ws = args.ws;
    volatile LAS unsigned* MISC = (volatile LAS unsigned*)(F.lds + MISC_OFF);
    for (int u = f_tid; u < (LDS_BYTES - LDSCTL_OFF) / 4; u += NTHR) ((LAS unsigned*)(F.lds + LDSCTL_OFF))[u] = 0u;
    __syncthreads();
    const int lo = args.ph_lo, hi = args.ph_hi;
    XcdBarrier bar; bar.bar = (unsigned*)(F.ws + WS_CTL) + CW_BAR; bar.x = 0; bar.st = nullptr;
    if (hi - lo > 1) bar = xcd_barrier_post((unsigned*)(F.ws + WS_CTL) + CW_BAR, MISC + 8);
#define IN(k) ((TEST_PHASE < 0 || TEST_PHASE == (k)) && lo <= (k) && (k) < hi)
#define SEAM(k) do { if (IN(k) && IN((k) + 1)) xcd_barrier(bar, F.wave); } while (0)
#define REPS(k) for (int rep_ = ((k) == REP_PHASE ? 0 : 1); rep_ < 2; ++rep_)
#define GEMM_PHASE(EPI, Aptr, Bptr, NN, ...) do { pg8::Gemm g{(const bf16*)(Aptr), (const bf16*)(Bptr), T, (NN), DM}; pg8::StaticOrder S; S.init(T, (NN), F.G, F.bid); \
        pg8::EPI E{__VA_ARGS__}; pg8::gemm_phase<pg8::EPI, pg8::StaticOrder, true, true>(F.lds, g, S, E, F.wave); } while (0)
    bf16* XB = (bf16*)(F.ws + WS_XB);
    float* PART = (float*)(F.ws + WS_PART); const float* ROPE = (const float*)(F.ws + WS_ROPE);
    if (IN(PH_PREP)) REPS(PH_PREP) { p0_prep(F); p0_weights(F); } SEAM(PH_PREP);
    if (PROBE_MODE == 9 && IN(PH_PREP) && IN(PH_PREP + 1)) { for (int xb_ = 0; xb_ < 8; ++xb_) xcd_barrier(bar, F.wave); }
    if (IN(PH_PROJ)) REPS(PH_PROJ) { GEMM_PHASE(EpiProj, XB, F.ws + WS_WIN, INC, (bf16*)(F.ws + WS_R), ROPE); } SEAM(PH_PROJ);
    if (IN(PH_MIX)) REPS(PH_MIX) { mix_phase(F, rep_); } SEAM(PH_MIX);
    if (IN(PH_WOUT)) REPS(PH_WOUT) { GEMM_PHASE(EpiRes, F.ws + WS_O, F.ws + WS_WOUT, DM, F.x, XB, PART, nullptr); } SEAM(PH_WOUT);
    if (IN(PH_Q0)) REPS(PH_Q0) { GEMM_PHASE(EpiQ, XB, F.ws + WS_WQ, DM, (bf16*)(F.ws + WS_Q), PART); asm volatile("s_waitcnt vmcnt(0)" ::: "memory"); __syncthreads(); opt_route(F, 0); } SEAM(PH_Q0);
    const bool census = (hi - lo > 1);
    if (IN(PH_GU0)) REPS(PH_GU0) { gather_u(F, 0, get_xinfo(F, census), rep_ == 0); } SEAM(PH_GU0);
    if (IN(PH_GR0)) REPS(PH_GR0) { gather_r(F, 0); } SEAM(PH_GR0);
    if (IN(PH_GV0)) REPS(PH_GV0) { gather_v(F, 0, get_xinfo(F, census), rep_ == 0); } SEAM(PH_GV0);
    if (IN(PH_W1)) REPS(PH_W1) { GEMM_PHASE(EpiGlu, XB, F.ws + WS_W1, 2 * DM, (bf16*)(F.ws + WS_GLU), PART, F.conv_b1); } SEAM(PH_W1);
    if (IN(PH_CONV)) REPS(PH_CONV) { opt_conv(F); } SEAM(PH_CONV);
    if (IN(PH_W2)) { GEMM_PHASE(EpiRes, F.ws + WS_HID2, F.ws + WS_W2, DM, nullptr, XB, PART, F.conv_b2); } SEAM(PH_W2);
    if (IN(PH_Q1)) REPS(PH_Q1) { GEMM_PHASE(EpiQ, XB, F.ws + WS_WQ + (size_t)DM * DM * 2, DM, (bf16*)(F.ws + WS_Q), PART); asm volatile("s_waitcnt vmcnt(0)" ::: "memory"); __syncthreads(); opt_route(F, 1); } SEAM(PH_Q1);
    if (IN(PH_GU1)) REPS(PH_GU1) { gather_u(F, 1, get_xinfo(F, census), rep_ == 0); } SEAM(PH_GU1);
    if (IN(PH_GR1)) REPS(PH_GR1) { gather_r(F, 1); } SEAM(PH_GR1);
    if (IN(PH_GV1)) REPS(PH_GV1) { gather_v(F, 1, get_xinfo(F, census), rep_ == 0); } SEAM(PH_GV1);
    if (IN(PH_FINAL)) { final_norm(F); }
#undef IN
#undef SEAM
}

extern "C" void kernel_launch(void* const* d_in, const int* in_sizes, int n_in, void* d_out, int out_size, void* d_ws, size_t ws_size, hipStream_t stream) {
    static int grid = 0;
    if (grid == 0) {
        if (n_in != 19 || out_size != T * DM || ws_size < WS_END) { fprintf(stderr, "kernel_launch: unexpected shapes (n_in %d out %d ws %zu)\n", n_in, out_size, ws_size); grid = -1; return; }
        int dev = 0, cus = 0;
        if (hipGetDevice(&dev) != hipSuccess || hipDeviceGetAttribute(&cus, hipDeviceAttributeMultiprocessorCount, dev) != hipSuccess) { grid = -1; return; }
        if (hipFuncSetAttribute((const void*)mega_fwd, hipFuncAttributeMaxDynamicSharedMemorySize, LDS_BYTES) != hipSuccess) { fprintf(stderr, "kernel_launch: hipFuncSetAttribute failed\n"); grid = -1; return; }
        (void)hipGetLastError();
        grid = cus;
    }
    if (grid < 0) return;
    (void)hipMemsetAsync((char*)d_ws + WS_CTL, 0, CTL_ZERO_BYTES, stream);
    Args a{};
    for (int i = 0; i < 19; ++i) a.in[i] = (const float*)d_in[i];
    a.out = (float*)d_out; a.ws = (unsigned char*)d_ws;
#if MK_ONE_LAUNCH
    a.ph_lo = 0; a.ph_hi = PH_COUNT;
    hipLaunchKernelGGL(mega_fwd, dim3(grid), dim3(NTHR), LDS_BYTES, stream, a);
#else
    for (int p = 0; p < PH_COUNT; ++p) { a.ph_lo = p; a.ph_hi = p + 1; hipLaunchKernelGGL(mega_fwd, dim3(grid), dim3(NTHR), LDS_BYTES, stream, a); }
#endif
}
```

```cpp
#include <hip/hip_runtime.h>
#include <cstdio>
#include <cstdint>

#ifndef REP_PHASE
#define REP_PHASE -1
#endif
#ifndef PROBE_MODE
#define PROBE_MODE 1
#endif
#ifndef MK_ONE_LAUNCH
#define MK_ONE_LAUNCH 1
#endif

#define GAS __attribute__((address_space(1)))
#define LAS __attribute__((address_space(3)))
#define DI __device__ __forceinline__
typedef unsigned short bf16;
typedef float f32x2 __attribute__((ext_vector_type(2)));
typedef float f32x4 __attribute__((ext_vector_type(4)));
typedef unsigned u32x2 __attribute__((ext_vector_type(2)));
typedef unsigned u32x4 __attribute__((ext_vector_type(4)));
typedef short bf16x8 __attribute__((ext_vector_type(8)));
typedef float f32x16 __attribute__((ext_vector_type(16)));

constexpr int NB = 16, SEQ = 2048, DM = 1024, T = NB * SEQ;
constexpr int CHUNK = 64, HD = 64, NHA = 8, NHB = 8, INC = 3584, NCH = SEQ / CHUNK;
constexpr int PH = 8, PK = 128, PE = PK * PK, PQD = 128, PTOP = 16, NSEL = PH * PTOP;
constexpr int CW = 31;
constexpr float EPS = 1e-6f;
constexpr float LOG2E = 1.4426950408889634f;
constexpr float XQ = 127.f / 6.f;
constexpr int NWAVES = 8, NTHR = NWAVES * 64;

constexpr int C_QA = 0, C_KA = 512, C_VA = 1024, C_QB = 1536, C_KB = 2048, C_VB = 2560, C_GB = 3072;

constexpr size_t MiB = 1u << 20;
constexpr size_t WS_CTL = 0, CTL_ZERO_BYTES = 1 * MiB;
constexpr size_t WS_WIN = 2 * MiB, WS_WOUT = 9 * MiB, WS_W1 = 11 * MiB, WS_W2 = 15 * MiB, WS_WQ = 17 * MiB;
constexpr size_t WS_ROPE = 22 * MiB;
constexpr size_t WS_PART = 23 * MiB;
constexpr size_t WS_EIDX = 26 * MiB;
constexpr size_t WS_GATE = 42 * MiB;
constexpr size_t WS_U8 = 64 * MiB, WS_V8 = 96 * MiB;
constexpr size_t WS_SC = 25 * MiB;
constexpr size_t WS_SA = 58 * MiB;
constexpr size_t WS_PU = 256 * MiB;
constexpr size_t WS_A = 384 * MiB;
constexpr size_t WS_XB = 128 * MiB;
constexpr size_t WS_R = 192 * MiB;
constexpr size_t WS_O = 416 * MiB;
constexpr size_t WS_Q = 192 * MiB;
constexpr size_t WS_HID = 256 * MiB;
constexpr size_t WS_GLU = 384 * MiB;
constexpr size_t WS_HID2 = 448 * MiB;
constexpr size_t WS_END = 512 * MiB;
constexpr int CW_BAR = 4096, CW_QUEUE = 8192;

constexpr int RING_BYTES = 131072, LDSCTL_OFF = RING_BYTES, MISC_OFF = LDSCTL_OFF + 320, LDS_BYTES = 147456;

DI float bf2f(bf16 v) { return __uint_as_float(((unsigned)v) << 16); }
DI unsigned f2bf(float f) { unsigned u = __float_as_uint(f); return (u + 0x7fffu + ((u >> 16) & 1u)) >> 16; }
DI unsigned pk2(float lo, float hi) { return f2bf(lo) | (f2bf(hi) << 16); }
#define DPP_MOV_I(x, ctrl) __builtin_amdgcn_mov_dpp((x), (ctrl), 0xF, 0xF, false)
#define DPP_XOR1 0xB1
#define DPP_XOR2 0x4E
#define DPP_HMIRROR 0x141
#define DPP_ROR8 0x128
DI float swap32_add(const float a, const float b) { const auto r = __builtin_amdgcn_permlane32_swap(__float_as_uint(a), __float_as_uint(b), false, false); return __uint_as_float(r[0]) + __uint_as_float(r[1]); }
DI float swap16_add(const float a, const float b) { const auto r = __builtin_amdgcn_permlane16_swap(__float_as_uint(a), __float_as_uint(b), false, false); return __uint_as_float(r[0]) + __uint_as_float(r[1]); }
DI int swap32_addi(const int a, const int b) { const auto r = __builtin_amdgcn_permlane32_swap((unsigned)a, (unsigned)b, false, false); return (int)(r[0] + r[1]); }
DI int swap16_addi(const int a, const int b) { const auto r = __builtin_amdgcn_permlane16_swap((unsigned)a, (unsigned)b, false, false); return (int)(r[0] + r[1]); }
DI float wave_sum_fast(float v) {
    v += __int_as_float(DPP_MOV_I(__float_as_int(v), DPP_XOR1)); v += __int_as_float(DPP_MOV_I(__float_as_int(v), DPP_XOR2));
    v += __int_as_float(DPP_MOV_I(__float_as_int(v), DPP_HMIRROR)); v += __int_as_float(DPP_MOV_I(__float_as_int(v), DPP_ROR8));
    v = swap16_add(v, v); v = swap32_add(v, v);
    return v;
}
DI float wave_sum(float v) { return wave_sum_fast(v); }
DI float swap32_max(const float a) { const auto r = __builtin_amdgcn_permlane32_swap(__float_as_uint(a), __float_as_uint(a), false, false); return fmaxf(__uint_as_float(r[0]), __uint_as_float(r[1])); }
DI float swap16_max(const float a) { const auto r = __builtin_amdgcn_permlane16_swap(__float_as_uint(a), __float_as_uint(a), false, false); return fmaxf(__uint_as_float(r[0]), __uint_as_float(r[1])); }
DI float wave_max(float v) {
    v = fmaxf(v, __int_as_float(DPP_MOV_I(__float_as_int(v), DPP_XOR1))); v = fmaxf(v, __int_as_float(DPP_MOV_I(__float_as_int(v), DPP_XOR2)));
    v = fmaxf(v, __int_as_float(DPP_MOV_I(__float_as_int(v), DPP_HMIRROR))); v = fmaxf(v, __int_as_float(DPP_MOV_I(__float_as_int(v), DPP_ROR8)));
    v = swap16_max(v); v = swap32_max(v);
    return v;
}
DI float block_sum(float v, LAS float* red, int tid) {
    v = wave_sum(v);
    __syncthreads();
    if ((tid & 63) == 0) red[tid >> 6] = v;
    __syncthreads();
    float s = 0.f;
#pragma unroll
    for (int i = 0; i < NWAVES; ++i) s += red[i];
    return s;
}
DI float gelu_erf(float x) { return 0.5f * x * (1.f + erff(x * 0.70710678118654752f)); }
DI float sigmoidf(float x) { return 1.f / (1.f + __expf(-x)); }

DI int lane_id() { int r; asm volatile("v_mbcnt_lo_u32_b32 %0, -1, 0\n\tv_mbcnt_hi_u32_b32 %0, -1, %0" : "=v"(r)); return r; }
#define XB_TMO      128
#define XB_XCNT(j)  (256  + 64 * (j))
#define XB_XSUB(j)  (1280 + 64 * (j))
#define XB_XGEN(j)  (2304 + 64 * (j))
#define XB_TOP      3328
#define XB_TOPGEN   3392
#define XCD_BAR_WORDS 3456
#define XB_SPIN_CAP (1u << 22)
DI unsigned xb_ld(unsigned* p)              { return __hip_atomic_load(p, __ATOMIC_RELAXED, __HIP_MEMORY_SCOPE_AGENT); }
DI unsigned xb_add(unsigned* p, unsigned v) { return __hip_atomic_fetch_add(p, v, __ATOMIC_RELAXED, __HIP_MEMORY_SCOPE_AGENT); }
DI unsigned xb_xcc_id() { return (unsigned)__builtin_amdgcn_s_getreg((3 << 11) | 20) & 0xFu; }
#define XB_SPIN(cond, bar) do { unsigned _sp = 0; while (cond) { __builtin_amdgcn_s_sleep(1); \
    if ((++_sp & 255u) == 0u) { if (xb_ld(&(bar)[XB_TMO])) break; if (_sp > XB_SPIN_CAP) { atomicAdd(&(bar)[XB_TMO], 1u); break; } } } } while (0)
struct XcdBarrier { unsigned* bar; unsigned x; volatile LAS unsigned* st; };
DI XcdBarrier xcd_barrier_post(unsigned* bar, volatile LAS unsigned* st) {
    XcdBarrier b; b.bar = bar; b.x = xb_xcc_id(); b.st = st;
    if (threadIdx.x == 0) st[4] = xb_add(&bar[XB_XCNT(b.x)], 1u);
    return b;
}
DI void xcd_barrier_complete(unsigned* bar, unsigned x, unsigned& nloc, unsigned& nx) {
    const unsigned G = gridDim.x * gridDim.y * gridDim.z;
    unsigned sum, cnt, mine, sp = 0u;
    for (;;) {
        sum = 0u; cnt = 0u; mine = 0u;
#pragma unroll
        for (unsigned j = 0; j < 16; ++j) { const unsigned c = xb_ld(&bar[XB_XCNT(j)]); sum += c; cnt += (c > 0u) ? 1u : 0u; mine = (j == x) ? c : mine; }
        if (sum == G) break;
        __builtin_amdgcn_s_sleep(1);
        if ((++sp & 255u) == 0u) { if (xb_ld(&bar[XB_TMO])) break; if (sp > XB_SPIN_CAP) { atomicAdd(&bar[XB_TMO], 1u); break; } }
    }
    nloc = mine > 0u ? mine : 1u; nx = cnt > 0u ? cnt : 1u;
}
DI void xcd_barrier(const XcdBarrier& b, const int wave_id) {
    asm volatile("s_waitcnt vmcnt(0)" ::: "memory");
    __syncthreads();
    if (wave_id == 0 && lane_id() == 0) {
        unsigned* bar = b.bar;
        __builtin_amdgcn_s_waitcnt(0);
        unsigned nloc = b.st[0], nx = b.st[1];
        if (nloc == 0u) { xcd_barrier_complete(bar, b.x, nloc, nx); b.st[0] = nloc; b.st[1] = nx; }
        const unsigned old = xb_add(&bar[XB_XSUB(b.x)], 1u);
        const unsigned gen = old / nloc;
        if (old + 1u == (gen + 1u) * nloc) {
            __builtin_amdgcn_fence(__ATOMIC_RELEASE, "agent");
            asm volatile("s_waitcnt vmcnt(0)" ::: "memory");
            const unsigned og = xb_add(&bar[XB_TOP], 1u);
            const unsigned tg = og / nx;
            if (og + 1u == (tg + 1u) * nx) xb_add(&bar[XB_TOPGEN], 1u);
            else XB_SPIN(xb_ld(&bar[XB_TOPGEN]) == tg, bar);
            __builtin_amdgcn_fence(__ATOMIC_ACQUIRE, "agent");
            xb_add(&bar[XB_XGEN(b.x)], 1u);
            asm volatile("s_waitcnt vmcnt(0)" ::: "memory");
        } else {
            XB_SPIN(xb_ld(&bar[XB_XGEN(b.x)]) == gen, bar);
            __builtin_amdgcn_fence(__ATOMIC_ACQUIRE, "agent");
            asm volatile("s_waitcnt vmcnt(0)" ::: "memory");
        }
    }
    __syncthreads();
}

namespace pg8 {
#define PG8_LAS __attribute__((address_space(3)))
typedef unsigned short bf16_t;
typedef short bf16x8 __attribute__((ext_vector_type(8)));
typedef float f32x4 __attribute__((ext_vector_type(4)));
typedef unsigned u32x4 __attribute__((ext_vector_type(4)));
constexpr int BM = 256, BK = 64, HALF = 128, HTB = HALF * BK * 2  , STAGE_BYTES = 8 * HTB, NXCD = 8, WGM = 8;

__host__ __device__ __forceinline__ int lds_byte(int r, int c) { const int st = (r >> 4) * 2 + (c >> 5), rr = r & 15, cc = c & 31, ob = rr * 64 + cc * 2; return st * 1024 + (ob ^ (((ob >> 9) & 1) << 5)); }
__host__ __device__ __forceinline__ void stage_rc(int b, int& R, int& C) { const int st = b / 1024, sb = b % 1024, swz = sb ^ (((sb >> 9) & 1) << 5); R = (st >> 1) * 16 + swz / 64; C = (st & 1) * 32 + (swz % 64) / 2; }
__host__ __device__ __forceinline__ int perm32(int rho) { const int n = rho >> 4, i = rho & 15; return 8 * (i >> 2) + 4 * n + (i & 3); }

struct Unit { int pm, pn; };
struct Gemm { const bf16_t* A; const bf16_t* Bt; int M, N, K; };

struct StaticOrder {
    int nM, nN, nwg, G, c;
    __host__ __device__ void init(int M, int N, int G_, int c_) { nM = M / BM; nN = N / BM; nwg = nM * nN; G = G_; c = c_; }
    __host__ __device__ bool next(int i, Unit& u) const {
        const long L = (long)i * G + c; if (L >= nwg) return false;
        int wgid = (int)L; { const int q = nwg / NXCD, r = nwg % NXCD, xcd = wgid % NXCD, off = wgid / NXCD; wgid = (xcd < r ? xcd * (q + 1) : r * (q + 1) + (xcd - r) * q) + off; }
        const int nig = WGM * nN, gid = wgid / nig, fm = gid * WGM, gsz = (nM - fm) < WGM ? (nM - fm) : WGM;
        u.pm = fm + ((wgid % nig) % gsz); u.pn = (wgid % nig) / gsz; return true;
    }
    __device__ __forceinline__ void a_ready(const Unit&) const {}
    __device__ __forceinline__ void done(const Unit&) const {}
};

__device__ __forceinline__ unsigned cvt_pk_bf16(float lo, float hi) { unsigned r; asm volatile("v_cvt_pk_bf16_f32 %0, %1, %2" : "=v"(r) : "v"(lo), "v"(hi)); return r; }
__device__ __forceinline__ float rstd16(const float* part, int r, int fq) {
    const f32x4 a = *(const f32x4*)(part + (size_t)r * 16 + 4 * fq);
    float s = (a[0] + a[1]) + (a[2] + a[3]);
    s = swap16_add(s, s); s = swap32_add(s, s);
    return 1.f / sqrtf(s * (1.f / 1024.f) + 1e-6f);
}
__device__ __forceinline__ u32x4 pack8(const f32x4 a, const f32x4 b) { u32x4 w; w.x = cvt_pk_bf16(a[0], a[1]); w.y = cvt_pk_bf16(a[2], a[3]); w.z = cvt_pk_bf16(b[0], b[1]); w.w = cvt_pk_bf16(b[2], b[3]); return w; }
#define rot(t1, t2, c, s) do { const float a_ = (t1) * (c) - (t2) * (s), b_ = (t1) * (s) + (t2) * (c); (t1) = a_; (t2) = b_; } while (0)

struct EpiProj {
    static constexpr bool PERM = true, AFTER_DRAIN = false;
    bf16_t* R; const float* rope;
    __device__ __forceinline__ void operator()(const f32x4 (&acc)[2][2][4][2], const Unit& u, int wr, int wc, int fr, int fq) const {
        const int type = u.pn >> 1, hg = u.pn & 1;
        const int colbase = type * 512 + (4 * hg + wc) * 64 + 8 * fq;
        const bool do_rope = (type == 3) || (type == 4);
#pragma unroll
        for (int ai = 0; ai < 2; ++ai)
#pragma unroll
            for (int m = 0; m < 4; ++m) {
                const int r = u.pm * BM + ai * HALF + wr * 64 + m * 16 + fr;
                f32x4 a0 = acc[ai][0][m][0], a1 = acc[ai][0][m][1], b0 = acc[ai][1][m][0], b1 = acc[ai][1][m][1];
                if (do_rope) {
                    const f32x4* rp = (const f32x4*)(rope + ((size_t)(r & 2047) * 32 + 8 * fq) * 2);
                    const f32x4 c0 = rp[0], c1 = rp[1], c2 = rp[2], c3 = rp[3];
                    rot(a0[0], b0[0], c0[0], c0[1]); rot(a0[1], b0[1], c0[2], c0[3]); rot(a0[2], b0[2], c1[0], c1[1]); rot(a0[3], b0[3], c1[2], c1[3]);
                    rot(a1[0], b1[0], c2[0], c2[1]); rot(a1[1], b1[1], c2[2], c2[3]); rot(a1[2], b1[2], c3[0], c3[1]); rot(a1[3], b1[3], c3[2], c3[3]);
                }
                bf16_t* rowp = R + (size_t)r * 3584 + colbase;
                *(u32x4*)(rowp) = pack8(a0, a1);
                *(u32x4*)(rowp + 32) = pack8(b0, b1);
            }
    }
};
struct EpiRes {
    static constexpr bool PERM = true, AFTER_DRAIN = false;
    const float* xf; bf16_t* hb; float* part; const float* bias;
    __device__ __forceinline__ void operator()(const f32x4 (&acc)[2][2][4][2], const Unit& u, int wr, int wc, int fr, int fq) const {
        const int col0 = u.pn * BM + wc * 32 + 8 * fq;
        f32x4 bv[2][2];
#pragma unroll
        for (int bj = 0; bj < 2; ++bj)
#pragma unroll
            for (int n = 0; n < 2; ++n) bv[bj][n] = bias ? *(const f32x4*)(bias + col0 + bj * HALF + 4 * n) : (f32x4){0.f, 0.f, 0.f, 0.f};
#pragma unroll
        for (int ai = 0; ai < 2; ++ai)
#pragma unroll
            for (int m = 0; m < 4; ++m) {
                const int r = u.pm * BM + ai * HALF + wr * 64 + m * 16 + fr;
                const size_t off = (size_t)r * 1024 + col0;
                float ss = 0.f;
#pragma unroll
                for (int bj = 0; bj < 2; ++bj) {
                    f32x4 x0, x1;
                    if (xf) { x0 = *(const f32x4*)(xf + off + bj * HALF); x1 = *(const f32x4*)(xf + off + bj * HALF + 4); }
                    else { const u32x4 w = *(const u32x4*)(hb + off + bj * HALF);
                           x0 = (f32x4){__uint_as_float(w[0] << 16), __uint_as_float(w[0] & 0xffff0000u), __uint_as_float(w[1] << 16), __uint_as_float(w[1] & 0xffff0000u)};
                           x1 = (f32x4){__uint_as_float(w[2] << 16), __uint_as_float(w[2] & 0xffff0000u), __uint_as_float(w[3] << 16), __uint_as_float(w[3] & 0xffff0000u)}; }
                    const f32x4 h0 = x0 + acc[ai][bj][m][0] + bv[bj][0], h1 = x1 + acc[ai][bj][m][1] + bv[bj][1];
                    *(u32x4*)(hb + off + bj * HALF) = pack8(h0, h1);
                    ss += (h0[0] * h0[0] + h0[1] * h0[1]) + (h0[2] * h0[2] + h0[3] * h0[3]) + (h1[0] * h1[0] + h1[1] * h1[1]) + (h1[2] * h1[2] + h1[3] * h1[3]);
                }
                ss = swap16_add(ss, ss); ss = swap32_add(ss, ss);
                if (fq == 0) part[(size_t)r * 16 + 4 * u.pn + wc] = ss;
            }
    }
};
struct EpiQ {
    static constexpr bool PERM = true, AFTER_DRAIN = false;
    bf16_t* O; const float* part;
    __device__ __forceinline__ void operator()(const f32x4 (&acc)[2][2][4][2], const Unit& u, int wr, int wc, int fr, int fq) const {
        const int col0 = u.pn * BM + wc * 32 + 8 * fq;
#pragma unroll
        for (int ai = 0; ai < 2; ++ai)
#pragma unroll
            for (int m = 0; m < 4; ++m) {
                const int r = u.pm * BM + ai * HALF + wr * 64 + m * 16 + fr;
                const float rs = rstd16(part, r, fq);
                bf16_t* rowp = O + (size_t)r * 1024 + col0;
#pragma unroll
                for (int bj = 0; bj < 2; ++bj) *(u32x4*)(rowp + bj * HALF) = pack8(acc[ai][bj][m][0] * rs, acc[ai][bj][m][1] * rs);
            }
    }
};
struct EpiGlu {
    static constexpr bool PERM = true, AFTER_DRAIN = false;
    bf16_t* G; const float* part; const float* b1;
    __device__ __forceinline__ void operator()(const f32x4 (&acc)[2][2][4][2], const Unit& u, int wr, int wc, int fr, int fq) const {
        const int col = u.pn * 128 + wc * 32 + 8 * fq;
        f32x4 ba[2], bg[2];
#pragma unroll
        for (int n = 0; n < 2; ++n) { ba[n] = *(const f32x4*)(b1 + col + 4 * n); bg[n] = *(const f32x4*)(b1 + 1024 + col + 4 * n); }
#pragma unroll
        for (int ai = 0; ai < 2; ++ai)
#pragma unroll
            for (int m = 0; m < 4; ++m) {
                const int r = u.pm * BM + ai * HALF + wr * 64 + m * 16 + fr;
                const float rs = rstd16(part, r, fq);
                f32x4 y[2];
#pragma unroll
                for (int n = 0; n < 2; ++n) {
                    const f32x4 a = acc[ai][0][m][n] * rs + ba[n], g = acc[ai][1][m][n] * rs + bg[n];
#pragma unroll
                    for (int i = 0; i < 4; ++i) y[n][i] = a[i] / (1.f + __expf(-g[i]));
                }
                *(u32x4*)(G + (size_t)r * 1024 + col) = pack8(y[0], y[1]);
            }
    }
};
template <class Epi, class Sched, bool ALIGN_EPI = false, bool SP2 = false>
__device__ __forceinline__ void gemm_phase(PG8_LAS unsigned char* lds, const Gemm g, const Sched& S, const Epi& E, const int wave_id) {
    const int lane = lane_id(), wid = wave_id, tid = wid * 64 + lane, wr = wid >> 2, wc = wid & 3, fr = lane & 15, fq = lane >> 4;
    const int K = g.K, nt = K / BK;
    unsigned voffA[2], voffB[2];
#pragma unroll
    for (int i = 0; i < 2; ++i) { int R, C; stage_rc(tid * 16 + i * 8192, R, C); const int Rb = Epi::PERM ? ((R & ~31) + perm32(R & 31)) : R;
        voffA[i] = (unsigned)(R * K + C) * 2u; voffB[i] = (unsigned)(Rb * K + C) * 2u; }
    const size_t kstep = (size_t)(BK * 2);
    const size_t hstep = (size_t)HALF * K * 2;
    const size_t tstep = 2 * hstep;
    const unsigned ldsw = (unsigned)wid * 1024u;
    const int aoff = lds_byte(wr * 64 + fr, fq * 8), boff = lds_byte(wc * 32 + fr, fq * 8);
#define PG8_SA(b, h) (((b) * 2 + (h)) * HTB)
#define PG8_SB(b, h) ((4 + (b) * 2 + (h)) * HTB)
#define PG8_STAGE(bufoff, gbase, voff) do { _Pragma("unroll") for (int _i = 0; _i < 2; ++_i) \
        __builtin_amdgcn_global_load_lds((const unsigned*)((const char*)(gbase) + (voff)[_i]), (PG8_LAS unsigned*)(lds + (bufoff) + ldsw + _i * 8192), 16, 0, 0); } while (0)
#define PG8_LDA(dst, b, h) do { _Pragma("unroll") for (int m = 0; m < 4; ++m) _Pragma("unroll") for (int k = 0; k < 2; ++k) dst[m][k] = *(const PG8_LAS bf16x8*)(lds + PG8_SA(b, h) + aoff + m * 2048 + k * 1024); } while (0)
#define PG8_LDB(dst, b, h) do { _Pragma("unroll") for (int n = 0; n < 2; ++n) _Pragma("unroll") for (int k = 0; k < 2; ++k) dst[n][k] = *(const PG8_LAS bf16x8*)(lds + PG8_SB(b, h) + boff + n * 2048 + k * 1024); } while (0)
#define PG8_MMA(ai, bj, At, Bt) do { __builtin_amdgcn_s_setprio(1); _Pragma("unroll") for (int m = 0; m < 4; ++m) _Pragma("unroll") for (int n = 0; n < 2; ++n) _Pragma("unroll") for (int k = 0; k < 2; ++k) \
        acc[ai][bj][m][n] = __builtin_amdgcn_mfma_f32_16x16x32_bf16(Bt[n][k], At[m][k], acc[ai][bj][m][n], 0, 0, 0); __builtin_amdgcn_s_setprio(0); } while (0)
#define PG8_WAIT_V(n) asm volatile("s_waitcnt vmcnt(" #n ")" ::: "memory")
#define PG8_WAIT_L(n) asm volatile("s_waitcnt lgkmcnt(" #n ")" ::: "memory")
#define PG8_BAR __builtin_amdgcn_s_barrier()
#define PG8_SCHED __builtin_amdgcn_sched_barrier(0)
    Unit cur, nxt; int ui = 0;
    if (!S.next(0, cur)) return;
    f32x4 acc[2][2][4][2];
#pragma unroll
    for (int a = 0; a < 2; ++a)
#pragma unroll
        for (int b = 0; b < 2; ++b)
#pragma unroll
            for (int m = 0; m < 4; ++m)
#pragma unroll
                for (int n = 0; n < 2; ++n) acc[a][b][m][n] = (f32x4){0.f, 0.f, 0.f, 0.f};
    bf16x8 At[4][2], B0[2][2], B1[2][2];
    const char* cA = (const char*)g.A + (size_t)cur.pm * tstep; const char* cB = (const char*)g.Bt + (size_t)cur.pn * tstep;
    S.a_ready(cur);
    if constexpr (SP2) {
        PG8_STAGE(PG8_SB(0, 0), cB, voffB); PG8_STAGE(PG8_SB(0, 1), cB + hstep, voffB); PG8_STAGE(PG8_SA(0, 0), cA, voffA); PG8_STAGE(PG8_SA(0, 1), cA + hstep, voffA);
        if (wr == 1) PG8_BAR;
        PG8_WAIT_V(2); PG8_BAR;
        PG8_STAGE(PG8_SB(1, 0), cB + kstep, voffB); PG8_STAGE(PG8_SA(1, 0), cA + kstep, voffA); PG8_STAGE(PG8_SB(1, 1), cB + hstep + kstep, voffB);
        PG8_WAIT_V(6); PG8_BAR;
    } else {
        PG8_STAGE(PG8_SB(0, 0), cB, voffB); PG8_STAGE(PG8_SA(0, 0), cA, voffA); PG8_STAGE(PG8_SB(0, 1), cB + hstep, voffB); PG8_STAGE(PG8_SA(0, 1), cA + hstep, voffA);
        if (wr == 1) PG8_BAR;
        PG8_WAIT_V(4); PG8_BAR;
        PG8_STAGE(PG8_SB(1, 0), cB + kstep, voffB); PG8_STAGE(PG8_SA(1, 0), cA + kstep, voffA); PG8_STAGE(PG8_SB(1, 1), cB + hstep + kstep, voffB);
        PG8_WAIT_V(6); PG8_BAR;
    }
    for (;;) {
        const bool has_next = S.next(ui + 1, nxt);
        const char* nA = has_next ? (const char*)g.A + (size_t)nxt.pm * tstep : cA; const char* nB = has_next ? (const char*)g.Bt + (size_t)nxt.pn * tstep : cB;
        for (int t = 0; t < nt; t += 2) {
            const bool last = (t == nt - 2);
            const char* a1 = cA + (size_t)(t + 1) * kstep;
            const char* a2 = last ? nA : cA + (size_t)(t + 2) * kstep; const char* b2 = last ? nB : cB + (size_t)(t + 2) * kstep;
            const char* a3 = a2 + kstep; const char* b3 = b2 + kstep;
            if (last && has_next) S.a_ready(nxt);
            if constexpr (SP2) {
            PG8_LDB(B0, 0, 0); PG8_LDB(B1, 0, 1); PG8_SCHED; PG8_LDA(At, 0, 0); PG8_STAGE(PG8_SA(1, 1), a1 + hstep, voffA);
            PG8_WAIT_V(8); PG8_WAIT_L(0); PG8_BAR; PG8_MMA(0, 0, At, B0); PG8_MMA(0, 1, At, B1); PG8_BAR; PG8_SCHED;
            PG8_LDA(At, 0, 1); PG8_STAGE(PG8_SB(0, 0), b2, voffB); PG8_STAGE(PG8_SB(0, 1), b2 + hstep, voffB); PG8_STAGE(PG8_SA(0, 0), a2, voffA);
            PG8_WAIT_V(8); PG8_WAIT_L(0); PG8_BAR; PG8_MMA(1, 0, At, B0); PG8_MMA(1, 1, At, B1); PG8_BAR; PG8_SCHED;
            PG8_LDB(B0, 1, 0); PG8_LDB(B1, 1, 1); PG8_SCHED; PG8_LDA(At, 1, 0); PG8_STAGE(PG8_SA(0, 1), a2 + hstep, voffA);
            PG8_WAIT_V(8); PG8_WAIT_L(0); PG8_BAR; PG8_MMA(0, 0, At, B0); PG8_MMA(0, 1, At, B1); PG8_BAR; PG8_SCHED;
            PG8_LDA(At, 1, 1); PG8_STAGE(PG8_SB(1, 0), b3, voffB); PG8_STAGE(PG8_SB(1, 1), b3 + hstep, voffB); PG8_STAGE(PG8_SA(1, 0), a3, voffA);
            PG8_WAIT_V(8); PG8_WAIT_L(0); PG8_BAR; PG8_MMA(1, 0, At, B0); PG8_MMA(1, 1, At, B1); PG8_BAR; PG8_SCHED;
            } else {
            PG8_LDB(B0, 0, 0); PG8_SCHED; PG8_LDA(At, 0, 0); PG8_STAGE(PG8_SA(1, 1), a1 + hstep, voffA);
            PG8_WAIT_L(8); PG8_BAR; PG8_WAIT_L(0); PG8_MMA(0, 0, At, B0); PG8_BAR; PG8_SCHED;
            PG8_LDB(B1, 0, 1); PG8_STAGE(PG8_SB(0, 0), b2, voffB);
            PG8_BAR; PG8_WAIT_L(0); PG8_MMA(0, 1, At, B1); PG8_BAR;
            PG8_LDA(At, 0, 1); PG8_STAGE(PG8_SA(0, 0), a2, voffA);
            PG8_BAR; PG8_WAIT_L(0); PG8_MMA(1, 0, At, B0); PG8_BAR; PG8_SCHED;
            PG8_STAGE(PG8_SB(0, 1), b2 + hstep, voffB);
            PG8_WAIT_V(6); PG8_BAR; PG8_MMA(1, 1, At, B1); PG8_BAR;
            PG8_LDB(B0, 1, 0); PG8_SCHED; PG8_LDA(At, 1, 0); PG8_STAGE(PG8_SA(0, 1), a2 + hstep, voffA);
            PG8_WAIT_L(8); PG8_BAR; PG8_WAIT_L(0); PG8_MMA(0, 0, At, B0); PG8_BAR; PG8_SCHED;
            PG8_LDB(B1, 1, 1); PG8_STAGE(PG8_SB(1, 0), b3, voffB);
            PG8_BAR; PG8_WAIT_L(0); PG8_MMA(0, 1, At, B1); PG8_BAR;
            PG8_LDA(At, 1, 1); PG8_STAGE(PG8_SA(1, 0), a3, voffA);
            PG8_BAR; PG8_WAIT_L(0); PG8_MMA(1, 0, At, B0); PG8_BAR; PG8_SCHED;
            PG8_STAGE(PG8_SB(1, 1), b3 + hstep, voffB);
            PG8_WAIT_V(6); PG8_BAR; PG8_MMA(1, 1, At, B1); PG8_BAR;
            }
        }
        if constexpr (ALIGN_EPI) { if (wr == 0) PG8_BAR; }
        if constexpr (!Epi::AFTER_DRAIN) { E(acc, cur, wr, wc, fr, fq); S.done(cur); }
        if (!has_next) break;
#pragma unroll
        for (int a = 0; a < 2; ++a)
#pragma unroll
            for (int b = 0; b < 2; ++b)
#pragma unroll
                for (int m = 0; m < 4; ++m)
#pragma unroll
                    for (int n = 0; n < 2; ++n) acc[a][b][m][n] = (f32x4){0.f, 0.f, 0.f, 0.f};
        cur = nxt; cA = nA; cB = nB; ++ui;
        if constexpr (ALIGN_EPI) { if (wr == 1) PG8_BAR; }
    }
    PG8_WAIT_V(0);
    if constexpr (!ALIGN_EPI) { if (wr == 0) PG8_BAR; }
    PG8_BAR;
    if constexpr (Epi::AFTER_DRAIN) { E.fused(acc, cur, wr, wc, fr, fq, lds, wid, lane); S.done(cur); }
#undef PG8_SA
#undef PG8_SB
#undef PG8_STAGE
#undef PG8_LDA
#undef PG8_LDB
#undef PG8_MMA
#undef PG8_WAIT_V
#undef PG8_WAIT_L
#undef PG8_BAR
#undef PG8_SCHED
}
}

struct Frame {
    LAS unsigned char* lds;
    int wave, G, bid;
    const float *x, *mix_norm, *ffn_norm, *final_norm, *w_in, *w_out, *rel_bias, *conv_w1, *conv_b1, *conv_dw, *conv_dw_b, *conv_ln_g, *conv_ln_b, *conv_w2, *conv_b2,
        *peer_wq, *peer_keys, *peer_u, *peer_v;
    float* out;
    unsigned char* ws;
};
#define FRAME_IDS const int f_lane = lane_id(); const int f_tid = F.wave * 64 + f_lane; (void)f_tid
DI float gamma_of(int h) { return 1.f - exp2f(-5.f - (float)h); }

DI void p0_prep(Frame& F) {
    FRAME_IDS;
    const int gw = F.bid * NWAVES + F.wave, NGW = F.G * NWAVES;
    f32x2* rope = (f32x2*)(F.ws + WS_ROPE);
    for (int i = F.bid * NTHR + f_tid; i < SEQ * 32; i += F.G * NTHR) {
        const int s = i >> 5, j = i & 31;
        const float inv = powf(10000.f, -(float)j / 32.f);
        const float ang = (float)s * inv;
        float sn, cs; sincosf(ang, &sn, &cs);
        rope[i] = (f32x2){cs, sn};
    }
    bf16* xb = (bf16*)(F.ws + WS_XB);
    for (int m = gw; m < T; m += NGW) {
        const f32x4* xr = (const f32x4*)(F.x + (size_t)m * DM) + f_lane;
        u32x2* o = (u32x2*)(xb + (size_t)m * DM) + f_lane;
        f32x4 v[4]; float s = 0.f;
#pragma unroll
        for (int j = 0; j < 4; ++j) { v[j] = xr[64 * j]; s += v[j].x * v[j].x + v[j].y * v[j].y + v[j].z * v[j].z + v[j].w * v[j].w; }
        const float r = 1.f / sqrtf(wave_sum(s) * (1.f / DM) + EPS);
#pragma unroll
        for (int j = 0; j < 4; ++j) o[64 * j] = (u32x2){pk2(v[j].x * r, v[j].y * r), pk2(v[j].z * r, v[j].w * r)};
    }
}
DI void p0_transpose_item(const float* W, int K, int N, bf16* WT, int prow0, const float* gain, float scale, LAS float* scr, int k0, int n0, int lane) {
#pragma unroll 8
    for (int i = 0; i < 32; ++i) { const int kk = 2 * i + (lane >> 5); scr[kk * 33 + (lane & 31)] = W[(size_t)(k0 + kk) * N + n0 + (lane & 31)] * (gain ? gain[k0 + kk] : 1.f) * scale; }
    asm volatile("s_waitcnt lgkmcnt(0)" ::: "memory");
    const int c = lane & 7;
#pragma unroll
    for (int j = 0; j < 4; ++j) { const int n = (lane >> 3) + 8 * j; const LAS float* q = scr + (8 * c) * 33 + n;
        u32x4 o; o.x = pk2(q[0 * 33], q[1 * 33]); o.y = pk2(q[2 * 33], q[3 * 33]); o.z = pk2(q[4 * 33], q[5 * 33]); o.w = pk2(q[6 * 33], q[7 * 33]);
        *(u32x4*)(WT + (size_t)(prow0 + n) * K + k0 + 8 * c) = o; }
    asm volatile("s_waitcnt lgkmcnt(0)" ::: "memory");
}
DI void p0_weights(Frame& F) {
    FRAME_IDS;
    LAS float* scr = (LAS float*)(F.lds + F.wave * 16384);
    const int gw = F.bid * NWAVES + F.wave, NGW = F.G * NWAVES;
    constexpr int I_IN = 16 * (INC / 32), I_SQ = 16 * (DM / 32), I_W1 = 16 * (2 * DM / 32);
    constexpr int NITEMS = I_IN + I_SQ + I_W1 + I_SQ + 2 * I_SQ;
    for (int it = gw; it < NITEMS; it += NGW) {
        int r = it;
        if (r < I_IN) { const int nb = r % (INC / 32), kb = r / (INC / 32), n0 = nb * 32;
            const int type = n0 / 512, head = (n0 % 512) / 64, bj = (n0 % 64) / 32;
            const int prow0 = 256 * (2 * type + head / 4) + 128 * bj + 32 * (head % 4);
            p0_transpose_item(F.w_in, DM, INC, (bf16*)(F.ws + WS_WIN), prow0, F.mix_norm, type == 0 ? 0.125f * LOG2E : (type == 4 ? 0.125f : 1.f), scr, kb * 64, n0, f_lane); continue; }
        r -= I_IN;
        if (r < I_SQ) { const int nb = r % 32, kb = r / 32; p0_transpose_item(F.w_out, DM, DM, (bf16*)(F.ws + WS_WOUT), nb * 32, nullptr, 1.f, scr, kb * 64, nb * 32, f_lane); continue; }
        r -= I_SQ;
        if (r < I_W1) { const int nb = r % 64, kb = r / 64, n0 = nb * 32; const int bj = n0 / 1024, rem = n0 % 1024;
            p0_transpose_item(F.conv_w1, DM, 2 * DM, (bf16*)(F.ws + WS_W1), 256 * (rem / 128) + 128 * bj + (rem % 128), F.mix_norm + DM, 1.f, scr, kb * 64, n0, f_lane); continue; }
        r -= I_W1;
        if (r < I_SQ) { const int nb = r % 32, kb = r / 32; p0_transpose_item(F.conv_w2, DM, DM, (bf16*)(F.ws + WS_W2), nb * 32, nullptr, 1.f, scr, kb * 64, nb * 32, f_lane); continue; }
        r -= I_SQ;
        { const int layer = r / I_SQ; r %= I_SQ; const int nb = r % 32, kb = r / 32;
          p0_transpose_item(F.peer_wq + (size_t)layer * DM * DM, DM, DM, (bf16*)(F.ws + WS_WQ) + (size_t)layer * DM * DM, nb * 32, F.ffn_norm + layer * DM, 1.f, scr, kb * 64, nb * 32, f_lane); }
    }
}
DI float row_rstd(const float* part, int m) {
    const f32x4* p = (const f32x4*)(part + (size_t)m * 16);
    const f32x4 a = p[0], b = p[1], c = p[2], d = p[3];
    const float s = ((a.x + a.y) + (a.z + a.w)) + ((b.x + b.y) + (b.z + b.w)) + ((c.x + c.y) + (c.z + c.w)) + ((d.x + d.y) + (d.z + d.w));
    return 1.f / sqrtf(s * (1.f / DM) + EPS);
}

typedef short v4i16 __attribute__((ext_vector_type(4)));
typedef __bf16 bf16x2_t __attribute__((ext_vector_type(2)));
DI unsigned cvtpk(float lo, float hi) { f32x2 v = {lo, hi}; bf16x2_t b = __builtin_convertvector(v, bf16x2_t); return __builtin_bit_cast(unsigned, b); }
DI v4i16 ds_tr16(LAS const unsigned char* p) { return __builtin_amdgcn_ds_read_tr16_b64_v4i16((LAS v4i16*)p); }
DI int crow(int r, int h) { return (r & 3) + 8 * (r >> 2) + 4 * h; }
DI bf16x8 pack_step(const f32x16& x, const int s) {
    u32x4 w = {cvtpk(x[8 * s + 0], x[8 * s + 1]), cvtpk(x[8 * s + 2], x[8 * s + 3]), cvtpk(x[8 * s + 4], x[8 * s + 5]), cvtpk(x[8 * s + 6], x[8 * s + 7])};
    return __builtin_bit_cast(bf16x8, w);
}
constexpr int AT_KB = 64 * 144, AT_VB = 8192, AT_BUF = AT_KB + AT_VB, AT_BIAS = 2 * AT_BUF;
DI void attn_item(Frame& F, const int it) {
    FRAME_IDS;
    const bf16* R = (const bf16*)(F.ws + WS_R); bf16* O = (bf16*)(F.ws + WS_O);
    LAS unsigned char* lds = F.lds;
    LAS float* bias_s = (LAS float*)(lds + AT_BIAS);
    const int q32 = f_lane & 31, h = f_lane >> 5, w = F.wave;
    const int srow = f_tid >> 3, sch = f_tid & 7;
    const int vtr_off = ((f_lane & 15) >> 2) * 64 + (16 * ((f_lane >> 4) & 1) + 4 * (f_lane & 3)) * 2;
    {
        const int b = it / (NHA * 8), hd = (it / 8) % NHA, c0 = (it % 8) * 4;
        const int c = c0 + (w >> 1), qrow0 = 32 * (w & 1);
        const size_t tq = (size_t)b * SEQ + c * 64 + qrow0 + q32;
        __syncthreads();
        for (int k = f_tid; k < 257; k += NTHR) bias_s[k] = F.rel_bias[hd * 257 + k] * LOG2E;
        bf16x8 qf[4];
#pragma unroll
        for (int ks = 0; ks < 4; ++ks) qf[ks] = *(const bf16x8*)(R + tq * INC + C_QA + hd * 64 + 16 * ks + 8 * h);
        const int t_lo = c0 - 8 < 0 ? 0 : c0 - 8, t_hi = c0 + 3, ntile = t_hi - t_lo + 1;
        const bf16* kbase = R + ((size_t)b * SEQ + srow) * INC + C_KA + hd * 64 + 8 * sch;
        const bf16* vbase = R + ((size_t)b * SEQ + srow) * INC + C_VA + hd * 64 + 8 * sch;
        u32x4 kreg = *(const u32x4*)(kbase + (size_t)t_lo * 64 * INC), vreg = *(const u32x4*)(vbase + (size_t)t_lo * 64 * INC);
        *(LAS u32x4*)(lds + srow * 144 + sch * 16) = kreg;
        *(LAS u32x4*)(lds + AT_KB + (sch >> 2) * 4096 + srow * 64 + (sch & 3) * 16) = vreg;
        __syncthreads();
        const float bias_far = bias_s[256];
        float m = -1e30f, l = 0.f;
        f32x16 o0 = {}, o1 = {};
        for (int i = 0; i < ntile; ++i) {
            const int tc = t_lo + i;
            LAS unsigned char* kb = lds + (i & 1) * AT_BUF; LAS unsigned char* vb = kb + AT_KB;
            if (i + 1 < ntile) { kreg = *(const u32x4*)(kbase + (size_t)(tc + 1) * 64 * INC); vreg = *(const u32x4*)(vbase + (size_t)(tc + 1) * 64 * INC); }
            const int D = c - tc;
            if (D >= 0 && D <= 8) {
                const float init = D >= 3 ? bias_far : 0.f;
                f32x16 p0, p1;
#pragma unroll
                for (int r = 0; r < 16; ++r) { p0[r] = init; p1[r] = init; }
#pragma unroll
                for (int ks = 0; ks < 4; ++ks) {
                    const bf16x8 k0 = *(const LAS bf16x8*)(kb + q32 * 144 + (16 * ks + 8 * h) * 2);
                    const bf16x8 k1 = *(const LAS bf16x8*)(kb + (32 + q32) * 144 + (16 * ks + 8 * h) * 2);
                    p0 = __builtin_amdgcn_mfma_f32_32x32x16_bf16(k0, qf[ks], p0, 0, 0, 0);
                    p1 = __builtin_amdgcn_mfma_f32_32x32x16_bf16(k1, qf[ks], p1, 0, 0, 0);
                }
                if (D < 3) {
                    const int relb = D * 64 + qrow0 + q32 - 4 * h + 128;
#pragma unroll
                    for (int r = 0; r < 16; ++r) {
                        const int r0 = relb - ((r & 3) + 8 * (r >> 2));
                        const int i0 = r0 < 0 ? 0 : (r0 > 256 ? 256 : r0), r1 = r0 - 32, i1 = r1 < 0 ? 0 : (r1 > 256 ? 256 : r1);
                        p0[r] += bias_s[i0]; p1[r] += bias_s[i1];
                    }
                }
                float tm = fmaxf(p0[0], p1[0]);
#pragma unroll
                for (int r = 1; r < 16; ++r) tm = fmaxf(tm, fmaxf(p0[r], p1[r]));
                tm = swap32_max(tm);
                const float mn = fmaxf(m, tm), alpha = __builtin_amdgcn_exp2f(m - mn);
                m = mn;
                float ps = 0.f;
#pragma unroll
                for (int r = 0; r < 16; ++r) { p0[r] = __builtin_amdgcn_exp2f(p0[r] - mn); p1[r] = __builtin_amdgcn_exp2f(p1[r] - mn); ps += p0[r] + p1[r]; }
                l = l * alpha + ps;
                if (!__all(alpha == 1.f)) {
#pragma unroll
                    for (int r = 0; r < 16; ++r) { o0[r] *= alpha; o1[r] *= alpha; }
                }
                bf16x8 pf[4];
                pf[0] = pack_step(p0, 0); pf[1] = pack_step(p0, 1); pf[2] = pack_step(p1, 0); pf[3] = pack_step(p1, 1);
#pragma unroll
                for (int kk = 0; kk < 4; ++kk) {
                    const int key0 = 16 * kk + 4 * h;
                    const v4i16 a0l = ds_tr16(vb + key0 * 64 + vtr_off), a0h = ds_tr16(vb + (key0 + 8) * 64 + vtr_off);
                    const v4i16 a1l = ds_tr16(vb + 4096 + key0 * 64 + vtr_off), a1h = ds_tr16(vb + 4096 + (key0 + 8) * 64 + vtr_off);
                    const bf16x8 a0 = __builtin_shufflevector(a0l, a0h, 0, 1, 2, 3, 4, 5, 6, 7), a1 = __builtin_shufflevector(a1l, a1h, 0, 1, 2, 3, 4, 5, 6, 7);
                    o0 = __builtin_amdgcn_mfma_f32_32x32x16_bf16(a0, pf[kk], o0, 0, 0, 0);
                    o1 = __builtin_amdgcn_mfma_f32_32x32x16_bf16(a1, pf[kk], o1, 0, 0, 0);
                }
            }
            if (i + 1 < ntile) {
                LAS unsigned char* nb = lds + ((i + 1) & 1) * AT_BUF;
                *(LAS u32x4*)(nb + srow * 144 + sch * 16) = kreg;
                *(LAS u32x4*)(nb + AT_KB + (sch >> 2) * 4096 + srow * 64 + (sch & 3) * 16) = vreg;
            }
            __syncthreads();
        }
        l = swap32_add(l, l);
        const float inv = 1.f / l;
        bf16* op = O + tq * DM + hd * 64 + 4 * h;
#pragma unroll
        for (int g = 0; g < 4; ++g) {
            *(u32x2*)(op + 8 * g) = (u32x2){cvtpk(o0[4 * g] * inv, o0[4 * g + 1] * inv), cvtpk(o0[4 * g + 2] * inv, o0[4 * g + 3] * inv)};
            *(u32x2*)(op + 32 + 8 * g) = (u32x2){cvtpk(o1[4 * g] * inv, o1[4 * g + 1] * inv), cvtpk(o1[4 * g + 2] * inv, o1[4 * g + 3] * inv)};
        }
    }
    __syncthreads();
}

constexpr int RT_Q = 0, RT_K = 9216, RT_KD = 18432, RT_V = 26624, RT_BUF = 34816, RT_ZS = 2 * RT_BUF, RT_CS = RT_ZS + 64 * 66 * 4;
DI void ret_item(Frame& F, const int it) {
    FRAME_IDS;
    const bf16* R = (const bf16*)(F.ws + WS_R); bf16* O = (bf16*)(F.ws + WS_O);
    LAS unsigned char* lds = F.lds;
    LAS float* Zs = (LAS float*)(lds + RT_ZS); LAS float* Cs = (LAS float*)(lds + RT_CS);
    const int b = it / NHB, hd = it % NHB;
    const int q32 = f_lane & 31, h = f_lane >> 5, w = F.wave;
    const int role = w >> 2, itile = (w >> 1) & 1, etile = w & 1;
    const int srow = f_tid >> 3, sch = f_tid & 7;
    const int vtr_off = ((f_lane & 15) >> 2) * 64 + (16 * ((f_lane >> 4) & 1) + 4 * (f_lane & 3)) * 2;
    const float l2g = log2f(gamma_of(hd));
    const float cd = exp2f(l2g * 64.f), sdec = exp2f(l2g * (float)(63 - srow));
    float qdv[16];
#pragma unroll
    for (int r = 0; r < 16; ++r) qdv[r] = exp2f(l2g * (float)(32 * itile + crow(r, h) + 1));
    f32x16 xs0 = {}, xs1 = {};
    const size_t trow0 = (size_t)b * SEQ;
    const bf16* gq = R + (trow0 + srow) * INC + hd * 64 + 8 * sch;
    u32x4 qreg = *(const u32x4*)(gq + C_QB), kreg = *(const u32x4*)(gq + C_KB), vreg = *(const u32x4*)(gq + C_VB);
    __syncthreads();
#define RT_STAGE(bufp) do { LAS unsigned char* bp_ = (bufp); \
        *(LAS u32x4*)(bp_ + RT_Q + srow * 144 + sch * 16) = qreg; *(LAS u32x4*)(bp_ + RT_K + srow * 144 + sch * 16) = kreg; \
        *(LAS u32x4*)(bp_ + RT_V + (sch >> 2) * 4096 + srow * 64 + (sch & 3) * 16) = vreg; \
        u32x4 kd_; \
        _Pragma("unroll") for (int e_ = 0; e_ < 4; ++e_) kd_[e_] = cvtpk(__uint_as_float(kreg[e_] << 16) * sdec, __uint_as_float(kreg[e_] & 0xffff0000u) * sdec); \
        *(LAS u32x4*)(bp_ + RT_KD + (sch >> 2) * 4096 + srow * 64 + (sch & 3) * 16) = kd_; } while (0)
    RT_STAGE(lds);
    __syncthreads();
    for (int n = 0; n < NCH; ++n) {
        LAS unsigned char* bp = lds + (n & 1) * RT_BUF;
        if (n + 1 < NCH) { const bf16* g1 = gq + (size_t)(n + 1) * 64 * INC; qreg = *(const u32x4*)(g1 + C_QB); kreg = *(const u32x4*)(g1 + C_KB); vreg = *(const u32x4*)(g1 + C_VB); }
        unsigned short gr[8];
#pragma unroll
        for (int r = 0; r < 8; ++r) gr[r] = R[(trow0 + n * 64 + 8 * w + r) * INC + C_GB + hd * 64 + f_lane];
        if (role == 0) {
            bf16x8 qf[4];
#pragma unroll
            for (int ks = 0; ks < 4; ++ks) qf[ks] = *(const LAS bf16x8*)(bp + RT_Q + (32 * itile + q32) * 144 + (16 * ks + 8 * h) * 2);
            f32x16 st0 = {}, st1 = {};
#pragma unroll
            for (int ks = 0; ks < 4; ++ks) {
                const bf16x8 k0 = *(const LAS bf16x8*)(bp + RT_K + q32 * 144 + (16 * ks + 8 * h) * 2);
                const bf16x8 k1 = *(const LAS bf16x8*)(bp + RT_K + (32 + q32) * 144 + (16 * ks + 8 * h) * 2);
                st0 = __builtin_amdgcn_mfma_f32_32x32x16_bf16(k0, qf[ks], st0, 0, 0, 0);
                st1 = __builtin_amdgcn_mfma_f32_32x32x16_bf16(k1, qf[ks], st1, 0, 0, 0);
            }
            int iiv = 32 * itile + q32 - 4 * h; asm volatile("" : "+v"(iiv));
#pragma unroll
            for (int r = 0; r < 16; ++r) {
                const int dd = iiv - ((r & 3) + 8 * (r >> 2));
                st0[r] *= __builtin_amdgcn_exp2f(l2g * fabsf((float)dd));
                st1[r] *= __builtin_amdgcn_exp2f(l2g * fabsf((float)(dd - 32)));
            }
            f32x16 z = {};
#pragma unroll
            for (int kk = 0; kk < 4; ++kk) {
                const int key0 = 16 * kk + 4 * h;
                const v4i16 bl = ds_tr16(bp + RT_V + etile * 4096 + key0 * 64 + vtr_off), bh = ds_tr16(bp + RT_V + etile * 4096 + (key0 + 8) * 64 + vtr_off);
                const bf16x8 vb = __builtin_shufflevector(bl, bh, 0, 1, 2, 3, 4, 5, 6, 7);
                const bf16x8 xa = (kk < 2) ? pack_step(st0, kk & 1) : pack_step(st1, kk & 1);
                z = __builtin_amdgcn_mfma_f32_32x32x16_bf16(xa, vb, z, 0, 0, 0);
            }
            int zb = (32 * itile + 4 * h) * 66 + 32 * etile + q32; asm volatile("" : "+v"(zb));
#pragma unroll
            for (int r = 0; r < 16; ++r) Zs[zb + ((r & 3) + 8 * (r >> 2)) * 66] = z[r];
        } else {
            f32x16 cr = {};
#pragma unroll
            for (int kk = 0; kk < 4; ++kk) {
                const LAS unsigned char* qp = bp + RT_Q + (32 * itile + q32) * 144 + (16 * kk + 4 * h) * 2;
                const v4i16 al = *(const LAS v4i16*)qp, ah = *(const LAS v4i16*)(qp + 16);
                const bf16x8 qa = __builtin_shufflevector(al, ah, 0, 1, 2, 3, 4, 5, 6, 7);
                const bf16x8 xb = (kk < 2) ? pack_step(xs0, kk & 1) : pack_step(xs1, kk & 1);
                cr = __builtin_amdgcn_mfma_f32_32x32x16_bf16(qa, xb, cr, 0, 0, 0);
            }
            int cb = (32 * itile + 4 * h) * 66 + 32 * etile + q32; asm volatile("" : "+v"(cb));
#pragma unroll
            for (int r = 0; r < 16; ++r) Cs[cb + ((r & 3) + 8 * (r >> 2)) * 66] = cr[r] * qdv[r];
#pragma unroll
            for (int r = 0; r < 16; ++r) { xs0[r] *= cd; xs1[r] *= cd; }
#pragma unroll
            for (int s4 = 0; s4 < 4; ++s4) {
                const int key0 = 16 * s4 + 8 * h;
                const v4i16 vl = ds_tr16(bp + RT_V + etile * 4096 + key0 * 64 + vtr_off), vh = ds_tr16(bp + RT_V + etile * 4096 + (key0 + 4) * 64 + vtr_off);
                const bf16x8 vb = __builtin_shufflevector(vl, vh, 0, 1, 2, 3, 4, 5, 6, 7);
                const v4i16 a0l = ds_tr16(bp + RT_KD + key0 * 64 + vtr_off), a0h = ds_tr16(bp + RT_KD + (key0 + 4) * 64 + vtr_off);
                const v4i16 a1l = ds_tr16(bp + RT_KD + 4096 + key0 * 64 + vtr_off), a1h = ds_tr16(bp + RT_KD + 4096 + (key0 + 4) * 64 + vtr_off);
                const bf16x8 ka0 = __builtin_shufflevector(a0l, a0h, 0, 1, 2, 3, 4, 5, 6, 7), ka1 = __builtin_shufflevector(a1l, a1h, 0, 1, 2, 3, 4, 5, 6, 7);
                xs0 = __builtin_amdgcn_mfma_f32_32x32x16_bf16(ka0, vb, xs0, 0, 0, 0);
                xs1 = __builtin_amdgcn_mfma_f32_32x32x16_bf16(ka1, vb, xs1, 0, 0, 0);
            }
        }
        __syncthreads();
#pragma unroll
        for (int r = 0; r < 8; ++r) {
            const int i = 8 * w + r;
            const float v = Zs[i * 66 + f_lane] + Cs[i * 66 + f_lane];
            const float mu = wave_sum(v) * (1.f / 64.f);
            const float dv = v - mu;
            const float var = wave_sum(dv * dv) * (1.f / 64.f);
            const float g = bf2f(gr[r]);
            O[(trow0 + n * 64 + i) * DM + 512 + hd * 64 + f_lane] = (bf16)f2bf(dv * (1.f / sqrtf(var + EPS)) * (g / (1.f + __expf(-g))));
        }
        if (n + 1 < NCH) RT_STAGE(lds + ((n + 1) & 1) * RT_BUF);
        __syncthreads();
    }
#undef RT_STAGE
}
DI unsigned q8x4(f32x4 v, const float sc) {
    const int a = (int)rintf(v[0] * sc), b = (int)rintf(v[1] * sc), c = (int)rintf(v[2] * sc), d = (int)rintf(v[3] * sc);
    return ((unsigned)a & 0xFFu) | (((unsigned)b & 0xFFu) << 8) | (((unsigned)c & 0xFFu) << 16) | ((unsigned)d << 24);
}
DI void int8_rows(Frame& F, const int row0, const int nrows, const int f_lane) {
    float* SC = (float*)(F.ws + WS_SC);
    for (int rr = row0; rr < row0 + nrows; rr += 4) {
        f32x4 v[4][4];
#pragma unroll
        for (int u = 0; u < 4; ++u) {
            const int row = rr + u, tab = row / PE, e = row % PE, layer = tab & 1, isv = tab >> 1;
            const f32x4* sp = (const f32x4*)((isv ? F.peer_v : F.peer_u) + ((size_t)layer * PE + e) * DM) + f_lane;
#pragma unroll
            for (int j = 0; j < 4; ++j) v[u][j] = sp[64 * j];
        }
#pragma unroll
        for (int u = 0; u < 4; ++u) {
            const int row = rr + u, tab = row / PE, e = row % PE, layer = tab & 1, isv = tab >> 1;
            unsigned* dst = (unsigned*)(F.ws + (isv ? WS_V8 : WS_U8)) + (size_t)layer * 8 * PE * 32;
            const f32x4* gp = (const f32x4*)(F.ffn_norm + layer * DM) + f_lane;
            float a = 0.f;
#pragma unroll
            for (int j = 0; j < 4; ++j) { if (!isv) v[u][j] = v[u][j] * gp[64 * j]; a = fmaxf(a, fmaxf(fmaxf(fabsf(v[u][j][0]), fabsf(v[u][j][1])), fmaxf(fabsf(v[u][j][2]), fabsf(v[u][j][3])))); }
            a = wave_max(a);
            const float sc = a > 0.f ? 127.f / a : 0.f;
#pragma unroll
            for (int j = 0; j < 4; ++j) dst[((size_t)(2 * j + (f_lane >> 5)) * PE + e) * 32 + (f_lane & 31)] = q8x4(v[u][j], sc);
            if (f_lane == 0) SC[tab * PE + e] = a * (1.f / 127.f);
        }
    }
}
constexpr int Q8_ITEM_ROWS = 512, Q8_ITEMS = 4 * PE / Q8_ITEM_ROWS;
constexpr int PH_MIX_ID = 2;
DI void mix_phase(Frame& F, const int rep) {
    FRAME_IDS;
    unsigned* ctr = (unsigned*)(F.ws + WS_CTL) + CW_QUEUE + 64 * rep;
    volatile LAS unsigned* slot = (volatile LAS unsigned*)(F.lds + MISC_OFF) + 16;
    constexpr int N_RET = NB * NHB, N_ATT = NB * NHA * 8;
    static_assert(N_ATT == 8 * Q8_ITEMS, "8 attention items per quantisation item");
    for (;;) {
        __syncthreads();
        if (f_tid == 0) slot[0] = __hip_atomic_fetch_add(ctr, 1u, __ATOMIC_RELAXED, __HIP_MEMORY_SCOPE_AGENT);
        __syncthreads();
        const int idx = (int)slot[0];
        if (idx >= N_RET + N_ATT + Q8_ITEMS) break;
        const bool probe_pass = (REP_PHASE == PH_MIX_ID && rep == 0);
        if (idx < N_RET) { if (!(probe_pass && PROBE_MODE == 4)) ret_item(F, idx); }
        else if (probe_pass && PROBE_MODE == 3) { }
        else { const int k = idx - N_RET, grp = k / 9, pos = k - 9 * grp;
            if (pos == 8) int8_rows(F, grp * Q8_ITEM_ROWS + F.wave * 64, 64, f_lane);
            else attn_item(F, 8 * grp + pos); }
    }
}
DI float fmax_raw(float a, float b) { float r; asm("v_max_f32_e32 %0, %1, %2" : "=v"(r) : "v"(a), "v"(b)); return r; }
DI float fmin_raw(float a, float b) { float r; asm("v_min_f32_e32 %0, %1, %2" : "=v"(r) : "v"(a), "v"(b)); return r; }
#define CE_DESC(x, y) do { const float hi_ = fmax_raw((x), (y)), lo_ = fmin_raw((x), (y)); (x) = hi_; (y) = lo_; } while (0)
template <int N> DI void sort_desc(float* v) {
#pragma unroll
    for (int k = 2; k <= N; k <<= 1)
#pragma unroll
        for (int j = k >> 1; j > 0; j >>= 1)
#pragma unroll
            for (int i = 0; i < N; ++i) { const int l = i ^ j; if (l > i) { if ((i & k) == 0 || k == N) CE_DESC(v[i], v[l]); else CE_DESC(v[l], v[i]); } }
}
DI void merge16(float* a, const float* b) {
#pragma unroll
    for (int i = 0; i < 16; ++i) a[i] = fmax_raw(a[i], b[15 - i]);
#pragma unroll
    for (int j = 8; j > 0; j >>= 1)
#pragma unroll
        for (int i = 0; i < 16; ++i) { const int l = i ^ j; if (l > i) CE_DESC(a[i], a[l]); }
}
DI float key_pack(float v, unsigned keep_mask, unsigned idx) { return __uint_as_float((__float_as_uint(v) & keep_mask) | idx); }
DI void opt_route(Frame& F, int layer) {
    FRAME_IDS;
    const bf16* Q = (const bf16*)(F.ws + WS_Q);
    int* eidx = (int*)(F.ws + WS_EIDX); float* gate = (float*)(F.ws + WS_GATE);
    const float* keys = F.peer_keys + (size_t)layer * 2 * PK * 64;
    LAS unsigned char* kl = F.lds;
    __syncthreads();
    for (int idx = f_tid; idx < 2 * PK * 8; idx += NTHR) {
        const int row = idx >> 3, ch = idx & 7;
        const f32x4 a = *(const f32x4*)(keys + (size_t)row * 64 + ch * 8), b = *(const f32x4*)(keys + (size_t)row * 64 + ch * 8 + 4);
        *(LAS u32x4*)(kl + row * 144 + ch * 16) = (u32x4){pk2(a[0], a[1]), pk2(a[2], a[3]), pk2(b[0], b[1]), pk2(b[2], b[3])};
    }
    __syncthreads();
    LAS int* lut = (LAS int*)(F.lds + 40960 + F.wave * 8192);
    const int c = f_lane & 31, h = f_lane >> 5;
    pg8::StaticOrder SO; SO.init(T, DM, F.G, F.bid);
    pg8::Unit un;
    for (int ui = 0; SO.next(ui, un); ++ui)
    for (int k2 = F.wave; k2 < 16; k2 += NWAVES) {
        const int tile = 8 * un.pm + (k2 & 7), hh = 2 * un.pn + (k2 >> 3), t = tile * 32 + c;
        float tk[2][16];
#pragma unroll
        for (int side = 0; side < 2; ++side) {
            bf16x8 qf[4];
#pragma unroll
            for (int ks = 0; ks < 4; ++ks) qf[ks] = *(const bf16x8*)(Q + (size_t)t * DM + hh * PQD + side * 64 + 16 * ks + 8 * h);
            float v[64];
#pragma unroll
            for (int kt = 0; kt < 4; ++kt) {
                f32x16 acc = {};
#pragma unroll
                for (int ks = 0; ks < 4; ++ks) {
                    const bf16x8 a = *(const LAS bf16x8*)(kl + (side * PK + 32 * kt + c) * 144 + (16 * ks + 8 * h) * 2);
                    acc = __builtin_amdgcn_mfma_f32_32x32x16_bf16(a, qf[ks], acc, 0, 0, 0);
                }
#pragma unroll
                for (int r = 0; r < 16; ++r) v[16 * kt + r] = key_pack(acc[r], 0xFFFFFF80u, (unsigned)(32 * kt + (r & 3) + 8 * (r >> 2) + 4 * h));
            }
            sort_desc<16>(v); sort_desc<16>(v + 16); sort_desc<16>(v + 32); sort_desc<16>(v + 48);
            merge16(v, v + 16); merge16(v + 32, v + 48); merge16(v, v + 32);
            float pr[16];
#pragma unroll
            for (int i = 0; i < 16; ++i) pr[i] = __shfl_xor(v[i], 32);
            merge16(v, pr);
#pragma unroll
            for (int i = 0; i < 16; ++i) { tk[side][i] = v[i]; lut[(side * 16 + i) * 64 + f_lane] = (int)(__float_as_uint(v[i]) & 0x7Fu); }
        }
        float cd[64];
        {   int n = 0;
#pragma unroll
            for (int a = 0; a < 16; ++a)
#pragma unroll
                for (int b = 0; b < 16; ++b) if ((a + 1) * (b + 1) <= 16) { cd[n] = key_pack(tk[0][a] + tk[1][b], 0xFFFFFF00u, (unsigned)(a * 16 + b)); ++n; }
#pragma unroll
            for (int i = 50; i < 64; ++i) cd[i] = -INFINITY;
        }
        sort_desc<16>(cd); sort_desc<16>(cd + 16); sort_desc<16>(cd + 32); CE_DESC(cd[48], cd[49]);
        merge16(cd, cd + 16); merge16(cd + 32, cd + 48); merge16(cd, cd + 32);
        int ex[16]; float gv[16]; float sum = 0.f;
        const float top = __uint_as_float(__float_as_uint(cd[0]) & 0xFFFFFF00u);
#pragma unroll
        for (int i = 0; i < 16; ++i) {
            const unsigned bits = __float_as_uint(cd[i]);
            const int a = (bits >> 4) & 15, b = bits & 15;
            ex[i] = lut[a * 64 + f_lane] * PK + lut[(16 + b) * 64 + f_lane];
            gv[i] = __expf(__uint_as_float(bits & 0xFFFFFF00u) - top); sum += gv[i];
        }
        const float inv = 1.f / sum;
        if (h == 0) {
            u32x4* ep = (u32x4*)(eidx + (size_t)t * NSEL + hh * 16);
#pragma unroll
            for (int q = 0; q < 4; ++q) ep[q] = (u32x4){(unsigned)ex[4 * q], (unsigned)ex[4 * q + 1], (unsigned)ex[4 * q + 2], (unsigned)ex[4 * q + 3]};
        } else {
            f32x4* gp = (f32x4*)(gate + (size_t)t * NSEL + hh * 16);
#pragma unroll
            for (int q = 0; q < 4; ++q) gp[q] = (f32x4){gv[4 * q] * inv, gv[4 * q + 1] * inv, gv[4 * q + 2] * inv, gv[4 * q + 3] * inv};
        }
    }
    __syncthreads();
}
DI float dot16_fp8(const u32x4 r, const float (&xs)[16]) {
    float s0 = 0.f, s1 = 0.f;
#pragma unroll
    for (int w = 0; w < 4; ++w) {
        const f32x2 lo = __builtin_amdgcn_cvt_pk_f32_fp8((int)r[w], false), hi = __builtin_amdgcn_cvt_pk_f32_fp8((int)r[w], true);
        s0 = fmaf(lo[0], xs[4 * w + 0], s0); s1 = fmaf(lo[1], xs[4 * w + 1], s1); s0 = fmaf(hi[0], xs[4 * w + 2], s0); s1 = fmaf(hi[1], xs[4 * w + 3], s1);
    }
    return s0 + s1;
}
DI void axpy16_fp8(const u32x4 r, const float a, float (&o)[16]) {
#pragma unroll
    for (int w = 0; w < 4; ++w) {
        const f32x2 lo = __builtin_amdgcn_cvt_pk_f32_fp8((int)r[w], false), hi = __builtin_amdgcn_cvt_pk_f32_fp8((int)r[w], true);
        o[4 * w + 0] = fmaf(a, lo[0], o[4 * w + 0]); o[4 * w + 1] = fmaf(a, lo[1], o[4 * w + 1]); o[4 * w + 2] = fmaf(a, hi[0], o[4 * w + 2]); o[4 * w + 3] = fmaf(a, hi[1], o[4 * w + 3]);
    }
}
DI float red_combine(const int level, const float a, const float b, const int lane) {
    const int M = 32 >> level; const bool bit = (lane & M) != 0;
    const float send = bit ? a : b, keep = bit ? b : a;
    return keep + __shfl_xor(send, M);
}
constexpr int brev6(int k) { return ((k & 1) << 5) | ((k & 2) << 3) | ((k & 4) << 1) | ((k & 8) >> 1) | ((k & 16) >> 3) | ((k & 32) >> 5); }
struct XInfo { int xrank, nx, rank, nloc; };
DI XInfo get_xinfo(Frame& F, const bool census) {
    FRAME_IDS;
    volatile LAS unsigned* M = (volatile LAS unsigned*)(F.lds + MISC_OFF);
    __syncthreads();
    if (f_tid == 0) {
        unsigned xr = (unsigned)F.bid & 7u, nx = 8u, rk = (unsigned)F.bid >> 3, nl = ((unsigned)F.G + 7u - ((unsigned)F.bid & 7u)) >> 3;
        if (census) {
            unsigned* bar = (unsigned*)(F.ws + WS_CTL) + CW_BAR; const unsigned x = xb_xcc_id();
            unsigned cnt = 0u, below = 0u, mine = 0u;
#pragma unroll
            for (unsigned j = 0; j < 16; ++j) { const unsigned c = xb_ld(&bar[XB_XCNT(j)]); cnt += (c > 0u); below += (c > 0u && j < x); mine = (j == x) ? c : mine; }
            if (cnt > 0u && mine > 0u) { xr = below; nx = cnt; rk = M[12]; nl = mine; }
        }
        M[20] = xr; M[21] = nx; M[22] = rk; M[23] = nl;
    }
    __syncthreads();
    XInfo xi; xi.xrank = (int)M[20]; xi.nx = (int)M[21]; xi.rank = (int)M[22]; xi.nloc = (int)M[23];
    return xi;
}
DI int comb_c(const int level, const int a, const int b, const int lane) {
    const int M = 4 >> level; const bool bit = (lane & M) != 0;
    const int send = bit ? a : b, keep = bit ? b : a;
    const int recv = level == 0 ? DPP_MOV_I(send, DPP_HMIRROR) : (level == 1 ? DPP_MOV_I(send, DPP_XOR2) : DPP_MOV_I(send, DPP_XOR1));
    return keep + recv;
}
DI int dot16_i8(const u32x4 r, const u32x4 x) {
    int s = __builtin_amdgcn_sdot4((int)r[0], (int)x[0], 0, false);
    s = __builtin_amdgcn_sdot4((int)r[1], (int)x[1], s, false); s = __builtin_amdgcn_sdot4((int)r[2], (int)x[2], s, false); s = __builtin_amdgcn_sdot4((int)r[3], (int)x[3], s, false);
    return s;
}
DI int half_dots(const u32x4 (&rows)[8], const u32x4 xq, const int lane) {
    int p[8];
#pragma unroll
    for (int i = 0; i < 8; ++i) p[i] = dot16_i8(rows[i], xq);
#pragma unroll
    for (int i = 0; i < 4; ++i) p[i] = comb_c(0, p[2 * i], p[2 * i + 1], lane);
    p[0] = comb_c(1, p[0], p[1], lane); p[1] = comb_c(1, p[2], p[3], lane);
    return comb_c(2, p[0], p[1], lane);
}
DI u32x4 xquant(const f32x4 (&hv)[4], const float rstd) {
    u32x4 o;
#pragma unroll
    for (int w = 0; w < 4; ++w) {
        const f32x4 x = hv[w] * (rstd * XQ);
        const int a = (int)rintf(__builtin_amdgcn_fmed3f(x[0], -127.f, 127.f)), b = (int)rintf(__builtin_amdgcn_fmed3f(x[1], -127.f, 127.f)), c = (int)rintf(__builtin_amdgcn_fmed3f(x[2], -127.f, 127.f)), d = (int)rintf(__builtin_amdgcn_fmed3f(x[3], -127.f, 127.f));
        o[w] = ((unsigned)a & 0xFFu) | (((unsigned)b & 0xFFu) << 8) | (((unsigned)c & 0xFFu) << 16) | ((unsigned)d << 24);
    }
    return o;
}
DI float rstd_bcast(const float* part, const int t) {
    const f32x4* p = (const f32x4*)(part + (size_t)t * 16);
    const f32x4 a = p[0], b = p[1], c = p[2], d = p[3];
    const float s = ((a[0] + a[1]) + (a[2] + a[3])) + ((b[0] + b[1]) + (b[2] + b[3])) + ((c[0] + c[1]) + (c[2] + c[3])) + ((d[0] + d[1]) + (d[2] + d[3]));
    return 1.f / sqrtf(s * (1.f / DM) + EPS);
}
DI void gather_u(Frame& F, const int layer, const XInfo xi, const bool dry) {
    FRAME_IDS;
    const unsigned emask = (dry && PROBE_MODE == 2) ? 15u : 0xFFFFFFFFu;
    const int* eidx = (const int*)(F.ws + WS_EIDX); int* PU = (int*)(F.ws + (dry ? WS_R : WS_PU)); const float* part = (const float*)(F.ws + WS_PART); const bf16* hbp = (const bf16*)(F.ws + WS_XB);
    const int g = f_lane >> 3, c = f_lane & 7, c16 = c * 16;
    const int kst = 16 * g + (((c & 1) << 2) | (c & 2) | ((c & 4) >> 2));
    const int gwl = xi.rank * NWAVES + F.wave, NGWL = xi.nloc * NWAVES;
    LAS unsigned char* wl = F.lds + F.wave * 2048;
    __syncthreads();
    for (int j = xi.xrank; j < 8; j += xi.nx) {
        const __amdgpu_buffer_rsrc_t U8 = __builtin_amdgcn_make_buffer_rsrc((void*)(F.ws + WS_U8 + ((size_t)(layer * 8 + j) * PE) * 128), 0, PE * 128, 0x00020000);
        int t = gwl;
        if (t >= T) continue;
#define U_LOAD(tt, ri, rh, rp) do { ri = *(const u32x2*)(eidx + (size_t)(tt) * NSEL + 2 * f_lane) & emask; { const unsigned hw_ = *(const unsigned*)(hbp + (size_t)(tt) * DM + 128 * j + 2 * f_lane); rh = (f32x2){__uint_as_float(hw_ << 16), __uint_as_float(hw_ & 0xffff0000u)}; } \
            rp = part[(size_t)(tt) * 16 + (f_lane & 15)]; } while (0)
#define U_SPREAD(slot, ri, rh, rp, e, xqv) do { \
            float ps_ = rp; ps_ += __int_as_float(DPP_MOV_I(__float_as_int(ps_), DPP_XOR1)); ps_ += __int_as_float(DPP_MOV_I(__float_as_int(ps_), DPP_XOR2)); ps_ += __int_as_float(DPP_MOV_I(__float_as_int(ps_), DPP_HMIRROR)); ps_ += __int_as_float(DPP_MOV_I(__float_as_int(ps_), DPP_ROR8)); \
            const float rs_ = (1.f / sqrtf(ps_ * (1.f / DM) + EPS)) * XQ; \
            const int q0_ = (int)rintf(__builtin_amdgcn_fmed3f(rh[0] * rs_, -127.f, 127.f)), q1_ = (int)rintf(__builtin_amdgcn_fmed3f(rh[1] * rs_, -127.f, 127.f)); \
            LAS unsigned char* sl_ = wl + (slot) * 1024; \
            *(LAS u32x2*)(sl_ + 8 * f_lane) = ri; *(LAS unsigned short*)(sl_ + 512 + 2 * f_lane) = (unsigned short)(((unsigned)q0_ & 0xFFu) | (((unsigned)q1_ & 0xFFu) << 8)); \
            asm volatile("s_waitcnt lgkmcnt(0)" ::: "memory"); \
            _Pragma("unroll") for (int q_ = 0; q_ < 4; ++q_) e[q_] = *(const LAS u32x4*)(sl_ + 64 * g + 16 * q_); \
            xqv = *(const LAS u32x4*)(sl_ + 512 + c16); } while (0)
        u32x2 ri; f32x2 rh; float rp;
        u32x4 e0[4], e1[4], xq, xq1;
        U_LOAD(t, ri, rh, rp); U_SPREAD(0, ri, rh, rp, e0, xq);
        { const int t1 = (t + NGWL < T) ? t + NGWL : t; U_LOAD(t1, ri, rh, rp); U_SPREAD(1, ri, rh, rp, e1, xq1); }
        { const int t2 = (t + 2 * NGWL < T) ? t + 2 * NGWL : t; U_LOAD(t2, ri, rh, rp); }
        u32x4 A0[8], B0[8], A1[8], B1[8];
#pragma unroll
        for (int i = 0; i < 8; ++i) A0[i] = __builtin_amdgcn_raw_buffer_load_b128(U8, (int)e0[i >> 2][i & 3] * 128 + c16, 0, 0);
#pragma unroll
        for (int i = 0; i < 8; ++i) B0[i] = __builtin_amdgcn_raw_buffer_load_b128(U8, (int)e0[2 + (i >> 2)][i & 3] * 128 + c16, 0, 0);
#define U_ITEM(CA, CB, NA, NB, slot) do { \
            _Pragma("unroll") for (int i = 0; i < 8; ++i) NA[i] = __builtin_amdgcn_raw_buffer_load_b128(U8, (int)e1[i >> 2][i & 3] * 128 + c16, 0, 0); \
            asm volatile("" ::: "memory"); \
            const int r0 = half_dots(CA, xq, f_lane); \
            _Pragma("unroll") for (int i = 0; i < 8; ++i) NB[i] = __builtin_amdgcn_raw_buffer_load_b128(U8, (int)e1[2 + (i >> 2)][i & 3] * 128 + c16, 0, 0); \
            asm volatile("" ::: "memory"); \
            const int rr1 = half_dots(CB, xq, f_lane); \
            int* pp = PU + ((size_t)t * 8 + j) * NSEL + kst; \
            pp[0] = r0; pp[8] = rr1; \
            xq = xq1; \
            U_SPREAD(slot, ri, rh, rp, e1, xq1);                        \
            { const int t3 = (t + 3 * NGWL < T) ? t + 3 * NGWL : t; U_LOAD(t3, ri, rh, rp); } } while (0)
        for (;;) {
            U_ITEM(A0, B0, A1, B1, 0); t += NGWL; if (t >= T) break;
            U_ITEM(A1, B1, A0, B0, 1); t += NGWL; if (t >= T) break;
        }
#undef U_ITEM
#undef U_LOAD
#undef U_SPREAD
    }
    __syncthreads();
}
DI void gather_r(Frame& F, const int layer) {
    FRAME_IDS;
    const int* PU = (const int*)(F.ws + WS_PU); const float* gate = (const float*)(F.ws + WS_GATE); const int* eidx = (const int*)(F.ws + WS_EIDX);
    const float* SCu = (const float*)(F.ws + WS_SC) + (size_t)layer * PE; const float* SCv = (const float*)(F.ws + WS_SC) + (size_t)(2 + layer) * PE;
    signed char* A8 = (signed char*)(F.ws + WS_A); float* SA = (float*)(F.ws + WS_SA);
    const int gw = F.bid * NWAVES + F.wave, NGW = F.G * NWAVES;
    for (int t = gw; t < T; t += NGW) {
        float a[2];
#pragma unroll
        for (int hf = 0; hf < 2; ++hf) {
            const int k = 64 * hf + f_lane;
            int sacc = 0;
#pragma unroll
            for (int j = 0; j < 8; ++j) sacc += PU[((size_t)t * 8 + j) * NSEL + k];
            const int e = eidx[(size_t)t * NSEL + k];
            const float d = (float)sacc * (SCu[e] * (1.f / XQ));
            a[hf] = gelu_erf(d) * gate[(size_t)t * NSEL + k] * SCv[e];
        }
        const float am = wave_max(fmaxf(fabsf(a[0]), fabsf(a[1])));
        const float sc = am > 0.f ? 127.f / am : 0.f;
        A8[(size_t)t * NSEL + f_lane] = (signed char)(int)rintf(a[0] * sc);
        A8[(size_t)t * NSEL + 64 + f_lane] = (signed char)(int)rintf(a[1] * sc);
        if (f_lane == 0) SA[t] = am * (1.f / 127.f);
    }
}
DI void tr4x4(const unsigned w0, const unsigned w1, const unsigned w2, const unsigned w3, unsigned (&cdw)[4]) {
    const unsigned t01l = __builtin_amdgcn_perm(w1, w0, 0x05010400u), t01h = __builtin_amdgcn_perm(w1, w0, 0x07030602u);
    const unsigned t23l = __builtin_amdgcn_perm(w3, w2, 0x05010400u), t23h = __builtin_amdgcn_perm(w3, w2, 0x07030602u);
    cdw[0] = __builtin_amdgcn_perm(t23l, t01l, 0x05040100u); cdw[1] = __builtin_amdgcn_perm(t23l, t01l, 0x07060302u);
    cdw[2] = __builtin_amdgcn_perm(t23h, t01h, 0x05040100u); cdw[3] = __builtin_amdgcn_perm(t23h, t01h, 0x07060302u);
}
DI void axpy4rows(const u32x4 r0, const u32x4 r1, const u32x4 r2, const u32x4 r3, const unsigned a4, int (&acc)[16]) {
#pragma unroll
    for (int d = 0; d < 4; ++d) {
        unsigned cdw[4];
        tr4x4(r0[d], r1[d], r2[d], r3[d], cdw);
#pragma unroll
        for (int i = 0; i < 4; ++i) acc[4 * d + i] = __builtin_amdgcn_sdot4((int)cdw[i], (int)a4, acc[4 * d + i], false);
    }
}
DI void gather_v(Frame& F, const int layer, const XInfo xi, const bool dry) {
    FRAME_IDS;
    const int* eidx = (const int*)(F.ws + WS_EIDX); const unsigned char* A8 = F.ws + WS_A; const float* SA = (const float*)(F.ws + WS_SA);
    float* part_w = dry ? (float*)(F.ws + WS_R) : (float*)(F.ws + WS_PART); bf16* hb_w = dry ? (bf16*)(F.ws + WS_HID2) : (bf16*)(F.ws + WS_XB); const bf16* hbp = (const bf16*)(F.ws + WS_XB);
    const int g = f_lane >> 3, c = f_lane & 7, c16 = c * 16;
    const int cc = 16 * c + 8 * (g >> 2) + 4 * ((g >> 1) & 1) + 2 * (g & 1);
    const int gwl = xi.rank * NWAVES + F.wave, NGWL = xi.nloc * NWAVES;
    const bool b3 = (f_lane & 8) != 0;
    LAS unsigned char* wl = F.lds + F.wave * 2048;
    __syncthreads();
    for (int j = xi.xrank; j < 8; j += xi.nx) {
        const __amdgpu_buffer_rsrc_t V8 = __builtin_amdgcn_make_buffer_rsrc((void*)(F.ws + WS_V8 + ((size_t)(layer * 8 + j) * PE) * 128), 0, PE * 128, 0x00020000);
        int t = gwl;
        if (t >= T) continue;
#define V_LOAD(tt, ri, ra, rs) do { ri = *(const u32x2*)(eidx + (size_t)(tt) * NSEL + 2 * f_lane); ra = *(const unsigned short*)(A8 + (size_t)(tt) * NSEL + 2 * f_lane); rs = SA[(tt)]; } while (0)
#define V_SPREAD(slot, ri, ra, rs, e, avv, sav) do { \
            LAS unsigned char* sl_ = wl + (slot) * 1024; \
            *(LAS u32x2*)(sl_ + 8 * f_lane) = ri; *(LAS unsigned short*)(sl_ + 512 + 2 * f_lane) = ra; \
            asm volatile("s_waitcnt lgkmcnt(0)" ::: "memory"); \
            _Pragma("unroll") for (int q_ = 0; q_ < 4; ++q_) e[q_] = *(const LAS u32x4*)(sl_ + 64 * g + 16 * q_); \
            avv = *(const LAS u32x4*)(sl_ + 512 + 16 * g); sav = rs; } while (0)
        u32x2 ri; unsigned short ra; float rs;
        u32x4 e0[4], e1[4], av, a1; float sa, sa1; f32x2 hold;
        V_LOAD(t, ri, ra, rs); V_SPREAD(0, ri, ra, rs, e0, av, sa);
        { const int t1 = (t + NGWL < T) ? t + NGWL : t; V_LOAD(t1, ri, ra, rs); V_SPREAD(1, ri, ra, rs, e1, a1, sa1); }
        { const int t2 = (t + 2 * NGWL < T) ? t + 2 * NGWL : t; V_LOAD(t2, ri, ra, rs); }
        { const unsigned hw_ = *(const unsigned*)(hbp + (size_t)t * DM + 128 * j + cc); hold = (f32x2){__uint_as_float(hw_ << 16), __uint_as_float(hw_ & 0xffff0000u)}; }
        u32x4 A0[8], B0[8], A1[8], B1[8];
#pragma unroll
        for (int i = 0; i < 8; ++i) A0[i] = __builtin_amdgcn_raw_buffer_load_b128(V8, (int)e0[i >> 2][i & 3] * 128 + c16, 0, 0);
#pragma unroll
        for (int i = 0; i < 8; ++i) B0[i] = __builtin_amdgcn_raw_buffer_load_b128(V8, (int)e0[2 + (i >> 2)][i & 3] * 128 + c16, 0, 0);
#define V_ITEM(CA, CB, NA, NB, slot) do { \
            const int t1 = (t + NGWL < T) ? t + NGWL : t; \
            const unsigned hw1_ = *(const unsigned*)(hbp + (size_t)t1 * DM + 128 * j + cc); \
            _Pragma("unroll") for (int i = 0; i < 8; ++i) NA[i] = __builtin_amdgcn_raw_buffer_load_b128(V8, (int)e1[i >> 2][i & 3] * 128 + c16, 0, 0); \
            asm volatile("" ::: "memory"); \
            int acc[16]; \
            _Pragma("unroll") for (int n = 0; n < 16; ++n) acc[n] = 0; \
            axpy4rows(CA[0], CA[1], CA[2], CA[3], av[0], acc); axpy4rows(CA[4], CA[5], CA[6], CA[7], av[1], acc); \
            _Pragma("unroll") for (int i = 0; i < 8; ++i) NB[i] = __builtin_amdgcn_raw_buffer_load_b128(V8, (int)e1[2 + (i >> 2)][i & 3] * 128 + c16, 0, 0); \
            asm volatile("" ::: "memory"); \
            axpy4rows(CB[0], CB[1], CB[2], CB[3], av[2], acc); axpy4rows(CB[4], CB[5], CB[6], CB[7], av[3], acc); \
            int r8[8], r4[4]; float r2[2]; \
            _Pragma("unroll") for (int n = 0; n < 8; ++n) r8[n] = swap32_addi(acc[n], acc[8 + n]); \
            _Pragma("unroll") for (int n = 0; n < 4; ++n) r4[n] = swap16_addi(r8[n], r8[4 + n]); \
            _Pragma("unroll") for (int n = 0; n < 2; ++n) { const int keep = b3 ? r4[2 + n] : r4[n], send = b3 ? r4[n] : r4[2 + n]; r2[n] = (float)(keep + DPP_MOV_I(send, DPP_ROR8)) * sa; } \
            const float h0 = hold[0] + r2[0], h1v = hold[1] + r2[1]; \
            const float ss = wave_sum_fast(h0 * h0 + h1v * h1v); \
            *(unsigned*)(hb_w + (size_t)t * DM + 128 * j + cc) = cvtpk(h0, h1v); \
            if (f_lane == 0) part_w[(size_t)t * 16 + j] = ss; \
            if (j == 0 && f_lane >= 8 && f_lane < 16) part_w[(size_t)t * 16 + f_lane] = 0.f; \
            av = a1; sa = sa1; hold = (f32x2){__uint_as_float(hw1_ << 16), __uint_as_float(hw1_ & 0xffff0000u)}; \
            V_SPREAD(slot, ri, ra, rs, e1, a1, sa1); \
            { const int t3 = (t + 3 * NGWL < T) ? t + 3 * NGWL : t; V_LOAD(t3, ri, ra, rs); } } while (0)
        for (;;) {
            V_ITEM(A0, B0, A1, B1, 0); t += NGWL; if (t >= T) break;
            V_ITEM(A1, B1, A0, B0, 1); t += NGWL; if (t >= T) break;
        }
#undef V_ITEM
#undef V_LOAD
#undef V_SPREAD
    }
    __syncthreads();
}
DI void final_norm(Frame& F) {
    FRAME_IDS;
    const float* part = (const float*)(F.ws + WS_PART); const bf16* hbp = (const bf16*)(F.ws + WS_XB);
    const int gw = F.bid * NWAVES + F.wave, NGW = F.G * NWAVES;
    for (int t = gw; t < T; t += NGW) {
        const float r = rstd_bcast(part, t);
        const u32x2* hp = (const u32x2*)(hbp + (size_t)t * DM) + f_lane;
        f32x4* op = (f32x4*)(F.out + (size_t)t * DM) + f_lane;
        const f32x4* gp = (const f32x4*)F.final_norm + f_lane;
#pragma unroll
        for (int q = 0; q < 4; ++q) { const u32x2 w = hp[64 * q];
            const f32x4 h = {__uint_as_float(w[0] << 16), __uint_as_float(w[0] & 0xffff0000u), __uint_as_float(w[1] << 16), __uint_as_float(w[1] & 0xffff0000u)};
            op[64 * q] = h * r * gp[64 * q]; }
    }
}
DI void opt_conv(Frame& F) {
    FRAME_IDS;
    const bf16* G = (const bf16*)(F.ws + WS_GLU); bf16* H2 = (bf16*)(F.ws + WS_HID2);
    LAS float* ys = (LAS float*)F.lds;
    f32x2 wt[CW];
#pragma unroll
    for (int j = 0; j < CW; ++j) wt[j] = *(const f32x2*)(F.conv_dw + j * DM + 2 * f_tid);
    const f32x2 bdw = *(const f32x2*)(F.conv_dw_b + 2 * f_tid);
    f32x4 lng[4], lnb[4];
#pragma unroll
    for (int k = 0; k < 4; ++k) { lng[k] = *(const f32x4*)(F.conv_ln_g + 256 * k + 4 * f_lane); lnb[k] = *(const f32x4*)(F.conv_ln_b + 256 * k + 4 * f_lane); }
    for (int it = F.bid; it < T / 128; it += F.G) {
        const int s0 = (it % (SEQ / 128)) * 128;
        const size_t row0 = (size_t)it * 128;
        const unsigned* gp = (const unsigned*)G + f_tid;
        f32x2 win[CW];
#pragma unroll
        for (int u = 0; u < CW - 1; ++u) { const int sp = s0 - (CW - 1) + u; const unsigned xv = sp >= 0 ? gp[(row0 - (CW - 1) + u) * 512] : 0u; win[u + 1] = (f32x2){__uint_as_float(xv << 16), __uint_as_float(xv & 0xffff0000u)}; }
        win[0] = (f32x2){0.f, 0.f};
        unsigned nx[CW], nn[CW];
#pragma unroll
        for (int u = 0; u < CW; ++u) nx[u] = (s0 + u < SEQ) ? gp[(row0 + u) * 512] : 0u;
        for (int bt = 0; bt < 5; ++bt) {
#pragma unroll
            for (int u = 0; u < CW; ++u) { const int sl = 31 * (bt + 1) + u; nn[u] = (bt < 4 && s0 + sl < SEQ) ? gp[(row0 + sl) * 512] : 0u; }
            __syncthreads();
#pragma unroll
            for (int u = 0; u < CW; ++u) {
                win[u] = (f32x2){__uint_as_float(nx[u] << 16), __uint_as_float(nx[u] & 0xffff0000u)};
                f32x2 a = bdw;
#pragma unroll
                for (int j = 0; j < CW; ++j) a = wt[j] * win[(u + 1 + j) % CW] + a;
                *(LAS f32x2*)(ys + u * DM + 2 * f_tid) = a;
            }
            __syncthreads();
            for (int u = F.wave; u < CW; u += NWAVES) {
                const int sl = 31 * bt + u;
                if (sl < 128) {
                    f32x4 v[4]; float sm = 0.f;
#pragma unroll
                    for (int k = 0; k < 4; ++k) { v[k] = *(const LAS f32x4*)(ys + u * DM + 256 * k + 4 * f_lane); sm += (v[k][0] + v[k][1]) + (v[k][2] + v[k][3]); }
                    const float mu = wave_sum(sm) * (1.f / DM);
                    float sq = 0.f;
#pragma unroll
                    for (int k = 0; k < 4; ++k) { v[k] = v[k] - mu; sq += (v[k][0] * v[k][0] + v[k][1] * v[k][1]) + (v[k][2] * v[k][2] + v[k][3] * v[k][3]); }
                    const float rs = 1.f / sqrtf(wave_sum(sq) * (1.f / DM) + EPS);
#pragma unroll
                    for (int k = 0; k < 4; ++k) {
                        f32x4 z = v[k] * rs * lng[k] + lnb[k];
#pragma unroll
                        for (int e = 0; e < 4; ++e) z[e] = z[e] / (1.f + __expf(-z[e]));
                        *(u32x2*)(H2 + (row0 + sl) * DM + 256 * k + 4 * f_lane) = (u32x2){cvtpk(z[0], z[1]), cvtpk(z[2], z[3])};
                    }
                }
            }
#pragma unroll
            for (int u = 0; u < CW; ++u) nx[u] = nn[u];
        }
    }
    __syncthreads();
}
enum Phase { PH_PREP = 0, PH_PROJ, PH_MIX, PH_WOUT, PH_Q0, PH_GU0, PH_GR0, PH_GV0, PH_W1, PH_CONV, PH_W2, PH_Q1, PH_GU1, PH_GR1, PH_GV1, PH_FINAL, PH_COUNT };
struct Args { const float* in[19]; float* out; unsigned char* ws; int ph_lo, ph_hi; };
#ifndef TEST_PHASE
#define TEST_PHASE -1
#endif

__global__ void __launch_bounds__(NTHR, 2) mega_fwd(Args args) {
    extern __shared__ __attribute__((aligned(16))) unsigned char lds[];
    Frame F;
    F.lds = (LAS unsigned char*)lds;
    F.wave = __builtin_amdgcn_readfirstlane((int)threadIdx.x >> 6); FRAME_IDS;
    F.G = gridDim.x; F.bid = blockIdx.x;
    F.x = args.in[0]; F.mix_norm = args.in[1]; F.ffn_norm = args.in[2]; F.final_norm = args.in[3]; F.w_in = args.in[4]; F.w_out = args.in[5]; F.rel_bias = args.in[6];
    F.conv_w1 = args.in[7]; F.conv_b1 = args.in[8]; F.conv_dw = args.in[9]; F.conv_dw_b = args.in[10]; F.conv_ln_g = args.in[11]; F.conv_ln_b = args.in[12];
    F.conv_w2 = args.in[13]; F.conv_b2 = args.in[14]; F.peer_wq = args.in[15]; F.peer_keys = args.in[16]; F.peer_u = args.in[17]; F.peer_v = args.in[18];
    F.out = args.out; F.ws = args.ws;
    volatile LAS unsigned* MISC = (volatile LAS unsigned*)(F.lds + MISC_OFF);
    for (int u = f_tid; u < (LDS_BYTES - LDSCTL_OFF) / 4; u += NTHR) ((LAS unsigned*)(F.lds + LDSCTL_OFF))[u] = 0u;
    __syncthreads();
    const int lo = args.ph_lo, hi = args.ph_hi;
    XcdBarrier bar; bar.bar = (unsigned*)(F.ws + WS_CTL) + CW_BAR; bar.x = 0; bar.st = nullptr;
    if (hi - lo > 1) bar = xcd_barrier_post((unsigned*)(F.ws + WS_CTL) + CW_BAR, MISC + 8);
#define IN(k) ((TEST_PHASE < 0 || TEST_PHASE == (k)) && lo <= (k) && (k) < hi)
#define SEAM(k) do { if (IN(k) && IN((k) + 1)) xcd_barrier(bar, F.wave); } while (0)
#define REPS(k) for (int rep_ = ((k) == REP_PHASE ? 0 : 1); rep_ < 2; ++rep_)
#define GEMM_PHASE(EPI, Aptr, Bptr, NN, ...) do { pg8::Gemm g{(const bf16*)(Aptr), (const bf16*)(Bptr), T, (NN), DM}; pg8::StaticOrder S; S.init(T, (NN), F.G, F.bid); \
        pg8::EPI E{__VA_ARGS__}; pg8::gemm_phase<pg8::EPI, pg8::StaticOrder, true, true>(F.lds, g, S, E, F.wave); } while (0)
    bf16* XB = (bf16*)(F.ws + WS_XB);
    float* PART = (float*)(F.ws + WS_PART); const float* ROPE = (const float*)(F.ws + WS_ROPE);
    if (IN(PH_PREP)) REPS(PH_PREP) { p0_prep(F); p0_weights(F); } SEAM(PH_PREP);
    if (PROBE_MODE == 9 && IN(PH_PREP) && IN(PH_PREP + 1)) { for (int xb_ = 0; xb_ < 8; ++xb_) xcd_barrier(bar, F.wave); }
    if (IN(PH_PROJ)) REPS(PH_PROJ) { GEMM_PHASE(EpiProj, XB, F.ws + WS_WIN, INC, (bf16*)(F.ws + WS_R), ROPE); } SEAM(PH_PROJ);
    if (IN(PH_MIX)) REPS(PH_MIX) { mix_phase(F, rep_); } SEAM(PH_MIX);
    if (IN(PH_WOUT)) REPS(PH_WOUT) { GEMM_PHASE(EpiRes, F.ws + WS_O, F.ws + WS_WOUT, DM, F.x, XB, PART, nullptr); } SEAM(PH_WOUT);
    if (IN(PH_Q0)) REPS(PH_Q0) { GEMM_PHASE(EpiQ, XB, F.ws + WS_WQ, DM, (bf16*)(F.ws + WS_Q), PART); asm volatile("s_waitcnt vmcnt(0)" ::: "memory"); __syncthreads(); opt_route(F, 0); } SEAM(PH_Q0);
    const bool census = (hi - lo > 1);
    if (IN(PH_GU0)) REPS(PH_GU0) { gather_u(F, 0, get_xinfo(F, census), rep_ == 0); } SEAM(PH_GU0);
    if (IN(PH_GR0)) REPS(PH_GR0) { gather_r(F, 0); } SEAM(PH_GR0);
    if (IN(PH_GV0)) REPS(PH_GV0) { gather_v(F, 0, get_xinfo(F, census), rep_ == 0); } SEAM(PH_GV0);
    if (IN(PH_W1)) REPS(PH_W1) { GEMM_PHASE(EpiGlu, XB, F.ws + WS_W1, 2 * DM, (bf16*)(F.ws + WS_GLU), PART, F.conv_b1); } SEAM(PH_W1);
    if (IN(PH_CONV)) REPS(PH_CONV) { opt_conv(F); } SEAM(PH_CONV);
    if (IN(PH_W2)) { GEMM_PHASE(EpiRes, F.ws + WS_HID2, F.ws + WS_W2, DM, nullptr, XB, PART, F.conv_b2); } SEAM(PH_W2);
    if (IN(PH_Q1)) REPS(PH_Q1) { GEMM_PHASE(EpiQ, XB, F.ws + WS_WQ + (size_t)DM * DM * 2, DM, (bf16*)(F.ws + WS_Q), PART); asm volatile("s_waitcnt vmcnt(0)" ::: "memory"); __syncthreads(); opt_route(F, 1); } SEAM(PH_Q1);
    if (IN(PH_GU1)) REPS(PH_GU1) { gather_u(F, 1, get_xinfo(F, census), rep_ == 0); } SEAM(PH_GU1);
    if (IN(PH_GR1)) REPS(PH_GR1) { gather_r(F, 1); } SEAM(PH_GR1);
    if (IN(PH_GV1)) REPS(PH_GV1) { gather_v(F, 1, get_xinfo(F, census), rep_ == 0); } SEAM(PH_GV1);
    if (IN(PH_FINAL)) { final_norm(F); }
#undef IN
#undef SEAM
}

extern "C" void kernel_launch(void* const* d_in, const int* in_sizes, int n_in, void* d_out, int out_size, void* d_ws, size_t ws_size, hipStream_t stream) {
    static int grid = 0;
    if (grid == 0) {
        if (n_in != 19 || out_size != T * DM || ws_size < WS_END) { fprintf(stderr, "kernel_launch: unexpected shapes (n_in %d out %d ws %zu)\n", n_in, out_size, ws_size); grid = -1; return; }
        int dev = 0, cus = 0;
        if (hipGetDevice(&dev) != hipSuccess || hipDeviceGetAttribute(&cus, hipDeviceAttributeMultiprocessorCount, dev) != hipSuccess) { grid = -1; return; }
        if (hipFuncSetAttribute((const void*)mega_fwd, hipFuncAttributeMaxDynamicSharedMemorySize, LDS_BYTES) != hipSuccess) { fprintf(stderr, "kernel_launch: hipFuncSetAttribute failed\n"); grid = -1; return; }
        (void)hipGetLastError();
        grid = cus;
    }
    if (grid < 0) return;
    (void)hipMemsetAsync((char*)d_ws + WS_CTL, 0, CTL_ZERO_BYTES, stream);
    Args a{};
    for (int i = 0; i < 19; ++i) a.in[i] = (const float*)d_in[i];
    a.out = (float*)d_out; a.ws = (unsigned char*)d_ws;
#if MK_ONE_LAUNCH
    a.ph_lo = 0; a.ph_hi = PH_COUNT;
    hipLaunchKernelGGL(mega_fwd, dim3(grid), dim3(NTHR), LDS_BYTES, stream, a);
#else
    for (int p = 0; p < PH_COUNT; ++p) { a.ph_lo = p; a.ph_hi = p + 1; hipLaunchKernelGGL(mega_fwd, dim3(grid), dim3(NTHR), LDS_BYTES, stream, a); }
#endif
}
```

```cpp
#include <hip/hip_runtime.h>
#include <cstdio>
#include <cstdint>

#ifndef REP_PHASE
#define REP_PHASE -1
#endif
#ifndef PROBE_MODE
#define PROBE_MODE 1
#endif
#ifndef MK_ONE_LAUNCH
#define MK_ONE_LAUNCH 1
#endif

#define GAS __attribute__((address_space(1)))
#define LAS __attribute__((address_space(3)))
#define DI __device__ __forceinline__
typedef unsigned short bf16;
typedef float f32x2 __attribute__((ext_vector_type(2)));
typedef float f32x4 __attribute__((ext_vector_type(4)));
typedef unsigned u32x2 __attribute__((ext_vector_type(2)));
typedef unsigned u32x4 __attribute__((ext_vector_type(4)));
typedef short bf16x8 __attribute__((ext_vector_type(8)));
typedef float f32x16 __attribute__((ext_vector_type(16)));

constexpr int NB = 16, SEQ = 2048, DM = 1024, T = NB * SEQ;
constexpr int CHUNK = 64, HD = 64, NHA = 8, NHB = 8, INC = 3584, NCH = SEQ / CHUNK;
constexpr int PH = 8, PK = 128, PE = PK * PK, PQD = 128, PTOP = 16, NSEL = PH * PTOP;
constexpr int CW = 31;
constexpr float EPS = 1e-6f;
constexpr float LOG2E = 1.4426950408889634f;
constexpr float XQ = 127.f / 6.f;
constexpr int NWAVES = 8, NTHR = NWAVES * 64;

constexpr int C_QA = 0, C_KA = 512, C_VA = 1024, C_QB = 1536, C_KB = 2048, C_VB = 2560, C_GB = 3072;

constexpr size_t MiB = 1u << 20;
constexpr size_t WS_CTL = 0, CTL_ZERO_BYTES = 1 * MiB;
constexpr size_t WS_WIN = 2 * MiB, WS_WOUT = 9 * MiB, WS_W1 = 11 * MiB, WS_W2 = 15 * MiB, WS_WQ = 17 * MiB;
constexpr size_t WS_ROPE = 22 * MiB;
constexpr size_t WS_PART = 23 * MiB;
constexpr size_t WS_EIDX = 26 * MiB;
constexpr size_t WS_GATE = 42 * MiB;
constexpr size_t WS_U8 = 64 * MiB, WS_V8 = 96 * MiB;
constexpr size_t WS_SC = 25 * MiB;
constexpr size_t WS_SA = 58 * MiB;
constexpr size_t WS_PU = 256 * MiB;
constexpr size_t WS_A = 384 * MiB;
constexpr size_t WS_XB = 128 * MiB;
constexpr size_t WS_R = 192 * MiB;
constexpr size_t WS_O = 416 * MiB;
constexpr size_t WS_Q = 192 * MiB;
constexpr size_t WS_HID = 256 * MiB;
constexpr size_t WS_GLU = 384 * MiB;
constexpr size_t WS_HID2 = 448 * MiB;
constexpr size_t WS_END = 512 * MiB;
constexpr int CW_BAR = 4096, CW_QUEUE = 8192;

constexpr int RING_BYTES = 131072, LDSCTL_OFF = RING_BYTES, MISC_OFF = LDSCTL_OFF + 320, LDS_BYTES = 147456;

DI float bf2f(bf16 v) { return __uint_as_float(((unsigned)v) << 16); }
DI unsigned f2bf(float f) { unsigned u = __float_as_uint(f); return (u + 0x7fffu + ((u >> 16) & 1u)) >> 16; }
DI unsigned pk2(float lo, float hi) { return f2bf(lo) | (f2bf(hi) << 16); }
#define DPP_MOV_I(x, ctrl) __builtin_amdgcn_mov_dpp((x), (ctrl), 0xF, 0xF, false)
#define DPP_XOR1 0xB1
#define DPP_XOR2 0x4E
#define DPP_HMIRROR 0x141
#define DPP_ROR8 0x128
DI float swap32_add(const float a, const float b) { const auto r = __builtin_amdgcn_permlane32_swap(__float_as_uint(a), __float_as_uint(b), false, false); return __uint_as_float(r[0]) + __uint_as_float(r[1]); }
DI float swap16_add(const float a, const float b) { const auto r = __builtin_amdgcn_permlane16_swap(__float_as_uint(a), __float_as_uint(b), false, false); return __uint_as_float(r[0]) + __uint_as_float(r[1]); }
DI int swap32_addi(const int a, const int b) { const auto r = __builtin_amdgcn_permlane32_swap((unsigned)a, (unsigned)b, false, false); return (int)(r[0] + r[1]); }
DI int swap16_addi(const int a, const int b) { const auto r = __builtin_amdgcn_permlane16_swap((unsigned)a, (unsigned)b, false, false); return (int)(r[0] + r[1]); }
DI float wave_sum_fast(float v) {
    v += __int_as_float(DPP_MOV_I(__float_as_int(v), DPP_XOR1)); v += __int_as_float(DPP_MOV_I(__float_as_int(v), DPP_XOR2));
    v += __int_as_float(DPP_MOV_I(__float_as_int(v), DPP_HMIRROR)); v += __int_as_float(DPP_MOV_I(__float_as_int(v), DPP_ROR8));
    v = swap16_add(v, v); v = swap32_add(v, v);
    return v;
}
DI float wave_sum(float v) { return wave_sum_fast(v); }
DI float swap32_max(const float a) { const auto r = __builtin_amdgcn_permlane32_swap(__float_as_uint(a), __float_as_uint(a), false, false); return fmaxf(__uint_as_float(r[0]), __uint_as_float(r[1])); }
DI float swap16_max(const float a) { const auto r = __builtin_amdgcn_permlane16_swap(__float_as_uint(a), __float_as_uint(a), false, false); return fmaxf(__uint_as_float(r[0]), __uint_as_float(r[1])); }
DI float wave_max(float v) {
    v = fmaxf(v, __int_as_float(DPP_MOV_I(__float_as_int(v), DPP_XOR1))); v = fmaxf(v, __int_as_float(DPP_MOV_I(__float_as_int(v), DPP_XOR2)));
    v = fmaxf(v, __int_as_float(DPP_MOV_I(__float_as_int(v), DPP_HMIRROR))); v = fmaxf(v, __int_as_float(DPP_MOV_I(__float_as_int(v), DPP_ROR8)));
    v = swap16_max(v); v = swap32_max(v);
    return v;
}
DI float block_sum(float v, LAS float* red, int tid) {
    v = wave_sum(v);
    __syncthreads();
    if ((tid & 63) == 0) red[tid >> 6] = v;
    __syncthreads();
    float s = 0.f;
#pragma unroll
    for (int i = 0; i < NWAVES; ++i) s += red[i];
    return s;
}
DI float gelu_erf(float x) { return 0.5f * x * (1.f + erff(x * 0.70710678118654752f)); }
DI float sigmoidf(float x) { return 1.f / (1.f + __expf(-x)); }

DI int lane_id() { int r; asm volatile("v_mbcnt_lo_u32_b32 %0, -1, 0\n\tv_mbcnt_hi_u32_b32 %0, -1, %0" : "=v"(r)); return r; }
#define XB_TMO      128
#define XB_XCNT(j)  (256  + 64 * (j))
#define XB_XSUB(j)  (1280 + 64 * (j))
#define XB_XGEN(j)  (2304 + 64 * (j))
#define XB_TOP      3328
#define XB_TOPGEN   3392
#define XCD_BAR_WORDS 3456
#define XB_SPIN_CAP (1u << 22)
DI unsigned xb_ld(unsigned* p)              { return __hip_atomic_load(p, __ATOMIC_RELAXED, __HIP_MEMORY_SCOPE_AGENT); }
DI unsigned xb_add(unsigned* p, unsigned v) { return __hip_atomic_fetch_add(p, v, __ATOMIC_RELAXED, __HIP_MEMORY_SCOPE_AGENT); }
DI unsigned xb_xcc_id() { return (unsigned)__builtin_amdgcn_s_getreg((3 << 11) | 20) & 0xFu; }
#define XB_SPIN(cond, bar) do { unsigned _sp = 0; while (cond) { __builtin_amdgcn_s_sleep(1); \
    if ((++_sp & 255u) == 0u) { if (xb_ld(&(bar)[XB_TMO])) break; if (_sp > XB_SPIN_CAP) { atomicAdd(&(bar)[XB_TMO], 1u); break; } } } } while (0)
struct XcdBarrier { unsigned* bar; unsigned x; volatile LAS unsigned* st; };
DI XcdBarrier xcd_barrier_post(unsigned* bar, volatile LAS unsigned* st) {
    XcdBarrier b; b.bar = bar; b.x = xb_xcc_id(); b.st = st;
    if (threadIdx.x == 0) st[4] = xb_add(&bar[XB_XCNT(b.x)], 1u);
    return b;
}
DI void xcd_barrier_complete(unsigned* bar, unsigned x, unsigned& nloc, unsigned& nx) {
    const unsigned G = gridDim.x * gridDim.y * gridDim.z;
    unsigned sum, cnt, mine, sp = 0u;
    for (;;) {
        sum = 0u; cnt = 0u; mine = 0u;
#pragma unroll
        for (unsigned j = 0; j < 16; ++j) { const unsigned c = xb_ld(&bar[XB_XCNT(j)]); sum += c; cnt += (c > 0u) ? 1u : 0u; mine = (j == x) ? c : mine; }
        if (sum == G) break;
        __builtin_amdgcn_s_sleep(1);
        if ((++sp & 255u) == 0u) { if (xb_ld(&bar[XB_TMO])) break; if (sp > XB_SPIN_CAP) { atomicAdd(&bar[XB_TMO], 1u); break; } }
    }
    nloc = mine > 0u ? mine : 1u; nx = cnt > 0u ? cnt : 1u;
}
DI void xcd_barrier(const XcdBarrier& b, const int wave_id) {
    asm volatile("s_waitcnt vmcnt(0)" ::: "memory");
    __syncthreads();
    if (wave_id == 0 && lane_id() == 0) {
        unsigned* bar = b.bar;
        __builtin_amdgcn_s_waitcnt(0);
        unsigned nloc = b.st[0], nx = b.st[1];
        if (nloc == 0u) { xcd_barrier_complete(bar, b.x, nloc, nx); b.st[0] = nloc; b.st[1] = nx; }
        const unsigned old = xb_add(&bar[XB_XSUB(b.x)], 1u);
        const unsigned gen = old / nloc;
        if (old + 1u == (gen + 1u) * nloc) {
            __builtin_amdgcn_fence(__ATOMIC_RELEASE, "agent");
            asm volatile("s_waitcnt vmcnt(0)" ::: "memory");
            const unsigned og = xb_add(&bar[XB_TOP], 1u);
            const unsigned tg = og / nx;
            if (og + 1u == (tg + 1u) * nx) xb_add(&bar[XB_TOPGEN], 1u);
            else XB_SPIN(xb_ld(&bar[XB_TOPGEN]) == tg, bar);
            __builtin_amdgcn_fence(__ATOMIC_ACQUIRE, "agent");
            xb_add(&bar[XB_XGEN(b.x)], 1u);
            asm volatile("s_waitcnt vmcnt(0)" ::: "memory");
        } else {
            XB_SPIN(xb_ld(&bar[XB_XGEN(b.x)]) == gen, bar);
            __builtin_amdgcn_fence(__ATOMIC_ACQUIRE, "agent");
            asm volatile("s_waitcnt vmcnt(0)" ::: "memory");
        }
    }
    __syncthreads();
}

namespace pg8 {
#define PG8_LAS __attribute__((address_space(3)))
typedef unsigned short bf16_t;
typedef short bf16x8 __attribute__((ext_vector_type(8)));
typedef float f32x4 __attribute__((ext_vector_type(4)));
typedef unsigned u32x4 __attribute__((ext_vector_type(4)));
constexpr int BM = 256, BK = 64, HALF = 128, HTB = HALF * BK * 2  , STAGE_BYTES = 8 * HTB, NXCD = 8, WGM = 8;

__host__ __device__ __forceinline__ int lds_byte(int r, int c) { const int st = (r >> 4) * 2 + (c >> 5), rr = r & 15, cc = c & 31, ob = rr * 64 + cc * 2; return st * 1024 + (ob ^ (((ob >> 9) & 1) << 5)); }
__host__ __device__ __forceinline__ void stage_rc(int b, int& R, int& C) { const int st = b / 1024, sb = b % 1024, swz = sb ^ (((sb >> 9) & 1) << 5); R = (st >> 1) * 16 + swz / 64; C = (st & 1) * 32 + (swz % 64) / 2; }
__host__ __device__ __forceinline__ int perm32(int rho) { const int n = rho >> 4, i = rho & 15; return 8 * (i >> 2) + 4 * n + (i & 3); }

struct Unit { int pm, pn; };
struct Gemm { const bf16_t* A; const bf16_t* Bt; int M, N, K; };

struct StaticOrder {
    int nM, nN, nwg, G, c;
    __host__ __device__ void init(int M, int N, int G_, int c_) { nM = M / BM; nN = N / BM; nwg = nM * nN; G = G_; c = c_; }
    __host__ __device__ bool next(int i, Unit& u) const {
        const long L = (long)i * G + c; if (L >= nwg) return false;
        int wgid = (int)L; { const int q = nwg / NXCD, r = nwg % NXCD, xcd = wgid % NXCD, off = wgid / NXCD; wgid = (xcd < r ? xcd * (q + 1) : r * (q + 1) + (xcd - r) * q) + off; }
        const int nig = WGM * nN, gid = wgid / nig, fm = gid * WGM, gsz = (nM - fm) < WGM ? (nM - fm) : WGM;
        u.pm = fm + ((wgid % nig) % gsz); u.pn = (wgid % nig) / gsz; return true;
    }
    __device__ __forceinline__ void a_ready(const Unit&) const {}
    __device__ __forceinline__ void done(const Unit&) const {}
};

__device__ __forceinline__ unsigned cvt_pk_bf16(float lo, float hi) { unsigned r; asm volatile("v_cvt_pk_bf16_f32 %0, %1, %2" : "=v"(r) : "v"(lo), "v"(hi)); return r; }
__device__ __forceinline__ float rstd16(const float* part, int r, int fq) {
    const f32x4 a = *(const f32x4*)(part + (size_t)r * 16 + 4 * fq);
    float s = (a[0] + a[1]) + (a[2] + a[3]);
    s = swap16_add(s, s); s = swap32_add(s, s);
    return 1.f / sqrtf(s * (1.f / 1024.f) + 1e-6f);
}
__device__ __forceinline__ u32x4 pack8(const f32x4 a, const f32x4 b) { u32x4 w; w.x = cvt_pk_bf16(a[0], a[1]); w.y = cvt_pk_bf16(a[2], a[3]); w.z = cvt_pk_bf16(b[0], b[1]); w.w = cvt_pk_bf16(b[2], b[3]); return w; }
#define rot(t1, t2, c, s) do { const float a_ = (t1) * (c) - (t2) * (s), b_ = (t1) * (s) + (t2) * (c); (t1) = a_; (t2) = b_; } while (0)

struct EpiProj {
    static constexpr bool PERM = true, AFTER_DRAIN = false;
    bf16_t* R; const float* rope;
    __device__ __forceinline__ void operator()(const f32x4 (&acc)[2][2][4][2], const Unit& u, int wr, int wc, int fr, int fq) const {
        const int type = u.pn >> 1, hg = u.pn & 1;
        const int colbase = type * 512 + (4 * hg + wc) * 64 + 8 * fq;
        const bool do_rope = (type == 3) || (type == 4);
#pragma unroll
        for (int ai = 0; ai < 2; ++ai)
#pragma unroll
            for (int m = 0; m < 4; ++m) {
                const int r = u.pm * BM + ai * HALF + wr * 64 + m * 16 + fr;
                f32x4 a0 = acc[ai][0][m][0], a1 = acc[ai][0][m][1], b0 = acc[ai][1][m][0], b1 = acc[ai][1][m][1];
                if (do_rope) {
                    const f32x4* rp = (const f32x4*)(rope + ((size_t)(r & 2047) * 32 + 8 * fq) * 2);
                    const f32x4 c0 = rp[0], c1 = rp[1], c2 = rp[2], c3 = rp[3];
                    rot(a0[0], b0[0], c0[0], c0[1]); rot(a0[1], b0[1], c0[2], c0[3]); rot(a0[2], b0[2], c1[0], c1[1]); rot(a0[3], b0[3], c1[2], c1[3]);
                    rot(a1[0], b1[0], c2[0], c2[1]); rot(a1[1], b1[1], c2[2], c2[3]); rot(a1[2], b1[2], c3[0], c3[1]); rot(a1[3], b1[3], c3[2], c3[3]);
                }
                bf16_t* rowp = R + (size_t)r * 3584 + colbase;
                *(u32x4*)(rowp) = pack8(a0, a1);
                *(u32x4*)(rowp + 32) = pack8(b0, b1);
            }
    }
};
struct EpiRes {
    static constexpr bool PERM = true, AFTER_DRAIN = false;
    const float* xf; bf16_t* hb; float* part; const float* bias;
    __device__ __forceinline__ void operator()(const f32x4 (&acc)[2][2][4][2], const Unit& u, int wr, int wc, int fr, int fq) const {
        const int col0 = u.pn * BM + wc * 32 + 8 * fq;
        f32x4 bv[2][2];
#pragma unroll
        for (int bj = 0; bj < 2; ++bj)
#pragma unroll
            for (int n = 0; n < 2; ++n) bv[bj][n] = bias ? *(const f32x4*)(bias + col0 + bj * HALF + 4 * n) : (f32x4){0.f, 0.f, 0.f, 0.f};
#pragma unroll
        for (int ai = 0; ai < 2; ++ai)
#pragma unroll
            for (int m = 0; m < 4; ++m) {
                const int r = u.pm * BM + ai * HALF + wr * 64 + m * 16 + fr;
                const size_t off = (size_t)r * 1024 + col0;
                float ss = 0.f;
#pragma unroll
                for (int bj = 0; bj < 2; ++bj) {
                    f32x4 x0, x1;
                    if (xf) { x0 = *(const f32x4*)(xf + off + bj * HALF); x1 = *(const f32x4*)(xf + off + bj * HALF + 4); }
                    else { const u32x4 w = *(const u32x4*)(hb + off + bj * HALF);
                           x0 = (f32x4){__uint_as_float(w[0] << 16), __uint_as_float(w[0] & 0xffff0000u), __uint_as_float(w[1] << 16), __uint_as_float(w[1] & 0xffff0000u)};
                           x1 = (f32x4){__uint_as_float(w[2] << 16), __uint_as_float(w[2] & 0xffff0000u), __uint_as_float(w[3] << 16), __uint_as_float(w[3] & 0xffff0000u)}; }
                    const f32x4 h0 = x0 + acc[ai][bj][m][0] + bv[bj][0], h1 = x1 + acc[ai][bj][m][1] + bv[bj][1];
                    *(u32x4*)(hb + off + bj * HALF) = pack8(h0, h1);
                    ss += (h0[0] * h0[0] + h0[1] * h0[1]) + (h0[2] * h0[2] + h0[3] * h0[3]) + (h1[0] * h1[0] + h1[1] * h1[1]) + (h1[2] * h1[2] + h1[3] * h1[3]);
                }
                ss = swap16_add(ss, ss); ss = swap32_add(ss, ss);
                if (fq == 0) part[(size_t)r * 16 + 4 * u.pn + wc] = ss;
            }
    }
};
struct EpiQ {
    static constexpr bool PERM = true, AFTER_DRAIN = false;
    bf16_t* O; const float* part;
    __device__ __forceinline__ void operator()(const f32x4 (&acc)[2][2][4][2], const Unit& u, int wr, int wc, int fr, int fq) const {
        const int col0 = u.pn * BM + wc * 32 + 8 * fq;
#pragma unroll
        for (int ai = 0; ai < 2; ++ai)
#pragma unroll
            for (int m = 0; m < 4; ++m) {
                const int r = u.pm * BM + ai * HALF + wr * 64 + m * 16 + fr;
                const float rs = rstd16(part, r, fq);
                bf16_t* rowp = O + (size_t)r * 1024 + col0;
#pragma unroll
                for (int bj = 0; bj < 2; ++bj) *(u32x4*)(rowp + bj * HALF) = pack8(acc[ai][bj][m][0] * rs, acc[ai][bj][m][1] * rs);
            }
    }
};
struct EpiGlu {
    static constexpr bool PERM = true, AFTER_DRAIN = false;
    bf16_t* G; const float* part; const float* b1;
    __device__ __forceinline__ void operator()(const f32x4 (&acc)[2][2][4][2], const Unit& u, int wr, int wc, int fr, int fq) const {
        const int col = u.pn * 128 + wc * 32 + 8 * fq;
        f32x4 ba[2], bg[2];
#pragma unroll
        for (int n = 0; n < 2; ++n) { ba[n] = *(const f32x4*)(b1 + col + 4 * n); bg[n] = *(const f32x4*)(b1 + 1024 + col + 4 * n); }
#pragma unroll
        for (int ai = 0; ai < 2; ++ai)
#pragma unroll
            for (int m = 0; m < 4; ++m) {
                const int r = u.pm * BM + ai * HALF + wr * 64 + m * 16 + fr;
                const float rs = rstd16(part, r, fq);
                f32x4 y[2];
#pragma unroll
                for (int n = 0; n < 2; ++n) {
                    const f32x4 a = acc[ai][0][m][n] * rs + ba[n], g = acc[ai][1][m][n] * rs + bg[n];
#pragma unroll
                    for (int i = 0; i < 4; ++i) y[n][i] = a[i] / (1.f + __expf(-g[i]));
                }
                *(u32x4*)(G + (size_t)r * 1024 + col) = pack8(y[0], y[1]);
            }
    }
};
template <class Epi, class Sched, bool ALIGN_EPI = false, bool SP2 = false>
__device__ __forceinline__ void gemm_phase(PG8_LAS unsigned char* lds, const Gemm g, const Sched& S, const Epi& E, const int wave_id) {
    const int lane = lane_id(), wid = wave_id, tid = wid * 64 + lane, wr = wid >> 2, wc = wid & 3, fr = lane & 15, fq = lane >> 4;
    const int K = g.K, nt = K / BK;
    unsigned voffA[2], voffB[2];
#pragma unroll
    for (int i = 0; i < 2; ++i) { int R, C; stage_rc(tid * 16 + i * 8192, R, C); const int Rb = Epi::PERM ? ((R & ~31) + perm32(R & 31)) : R;
        voffA[i] = (unsigned)(R * K + C) * 2u; voffB[i] = (unsigned)(Rb * K + C) * 2u; }
    const size_t kstep = (size_t)(BK * 2);
    const size_t hstep = (size_t)HALF * K * 2;
    const size_t tstep = 2 * hstep;
    const unsigned ldsw = (unsigned)wid * 1024u;
    const int aoff = lds_byte(wr * 64 + fr, fq * 8), boff = lds_byte(wc * 32 + fr, fq * 8);
#define PG8_SA(b, h) (((b) * 2 + (h)) * HTB)
#define PG8_SB(b, h) ((4 + (b) * 2 + (h)) * HTB)
#define PG8_STAGE(bufoff, gbase, voff) do { _Pragma("unroll") for (int _i = 0; _i < 2; ++_i) \
        __builtin_amdgcn_global_load_lds((const unsigned*)((const char*)(gbase) + (voff)[_i]), (PG8_LAS unsigned*)(lds + (bufoff) + ldsw + _i * 8192), 16, 0, 0); } while (0)
#define PG8_LDA(dst, b, h) do { _Pragma("unroll") for (int m = 0; m < 4; ++m) _Pragma("unroll") for (int k = 0; k < 2; ++k) dst[m][k] = *(const PG8_LAS bf16x8*)(lds + PG8_SA(b, h) + aoff + m * 2048 + k * 1024); } while (0)
#define PG8_LDB(dst, b, h) do { _Pragma("unroll") for (int n = 0; n < 2; ++n) _Pragma("unroll") for (int k = 0; k < 2; ++k) dst[n][k] = *(const PG8_LAS bf16x8*)(lds + PG8_SB(b, h) + boff + n * 2048 + k * 1024); } while (0)
#define PG8_MMA(ai, bj, At, Bt) do { __builtin_amdgcn_s_setprio(1); _Pragma("unroll") for (int m = 0; m < 4; ++m) _Pragma("unroll") for (int n = 0; n < 2; ++n) _Pragma("unroll") for (int k = 0; k < 2; ++k) \
        acc[ai][bj][m][n] = __builtin_amdgcn_mfma_f32_16x16x32_bf16(Bt[n][k], At[m][k], acc[ai][bj][m][n], 0, 0, 0); __builtin_amdgcn_s_setprio(0); } while (0)
#define PG8_WAIT_V(n) asm volatile("s_waitcnt vmcnt(" #n ")" ::: "memory")
#define PG8_WAIT_L(n) asm volatile("s_waitcnt lgkmcnt(" #n ")" ::: "memory")
#define PG8_BAR __builtin_amdgcn_s_barrier()
#define PG8_SCHED __builtin_amdgcn_sched_barrier(0)
    Unit cur, nxt; int ui = 0;
    if (!S.next(0, cur)) return;
    f32x4 acc[2][2][4][2];
#pragma unroll
    for (int a = 0; a < 2; ++a)
#pragma unroll
        for (int b = 0; b < 2; ++b)
#pragma unroll
            for (int m = 0; m < 4; ++m)
#pragma unroll
                for (int n = 0; n < 2; ++n) acc[a][b][m][n] = (f32x4){0.f, 0.f, 0.f, 0.f};
    bf16x8 At[4][2], B0[2][2], B1[2][2];
    const char* cA = (const char*)g.A + (size_t)cur.pm * tstep; const char* cB = (const char*)g.Bt + (size_t)cur.pn * tstep;
    S.a_ready(cur);
    if constexpr (SP2) {
        PG8_STAGE(PG8_SB(0, 0), cB, voffB); PG8_STAGE(PG8_SB(0, 1), cB + hstep, voffB); PG8_STAGE(PG8_SA(0, 0), cA, voffA); PG8_STAGE(PG8_SA(0, 1), cA + hstep, voffA);
        if (wr == 1) PG8_BAR;
        PG8_WAIT_V(2); PG8_BAR;
        PG8_STAGE(PG8_SB(1, 0), cB + kstep, voffB); PG8_STAGE(PG8_SA(1, 0), cA + kstep, voffA); PG8_STAGE(PG8_SB(1, 1), cB + hstep + kstep, voffB);
        PG8_WAIT_V(6); PG8_BAR;
    } else {
        PG8_STAGE(PG8_SB(0, 0), cB, voffB); PG8_STAGE(PG8_SA(0, 0), cA, voffA); PG8_STAGE(PG8_SB(0, 1), cB + hstep, voffB); PG8_STAGE(PG8_SA(0, 1), cA + hstep, voffA);
        if (wr == 1) PG8_BAR;
        PG8_WAIT_V(4); PG8_BAR;
        PG8_STAGE(PG8_SB(1, 0), cB + kstep, voffB); PG8_STAGE(PG8_SA(1, 0), cA + kstep, voffA); PG8_STAGE(PG8_SB(1, 1), cB + hstep + kstep, voffB);
        PG8_WAIT_V(6); PG8_BAR;
    }
    for (;;) {
        const bool has_next = S.next(ui + 1, nxt);
        const char* nA = has_next ? (const char*)g.A + (size_t)nxt.pm * tstep : cA; const char* nB = has_next ? (const char*)g.Bt + (size_t)nxt.pn * tstep : cB;
        for (int t = 0; t < nt; t += 2) {
            const bool last = (t == nt - 2);
            const char* a1 = cA + (size_t)(t + 1) * kstep;
            const char* a2 = last ? nA : cA + (size_t)(t + 2) * kstep; const char* b2 = last ? nB : cB + (size_t)(t + 2) * kstep;
            const char* a3 = a2 + kstep; const char* b3 = b2 + kstep;
            if (last && has_next) S.a_ready(nxt);
            if constexpr (SP2) {
            PG8_LDB(B0, 0, 0); PG8_LDB(B1, 0, 1); PG8_SCHED; PG8_LDA(At, 0, 0); PG8_STAGE(PG8_SA(1, 1), a1 + hstep, voffA);
            PG8_WAIT_V(8); PG8_WAIT_L(0); PG8_BAR; PG8_MMA(0, 0, At, B0); PG8_MMA(0, 1, At, B1); PG8_BAR; PG8_SCHED;
            PG8_LDA(At, 0, 1); PG8_STAGE(PG8_SB(0, 0), b2, voffB); PG8_STAGE(PG8_SB(0, 1), b2 + hstep, voffB); PG8_STAGE(PG8_SA(0, 0), a2, voffA);
            PG8_WAIT_V(8); PG8_WAIT_L(0); PG8_BAR; PG8_MMA(1, 0, At, B0); PG8_MMA(1, 1, At, B1); PG8_BAR; PG8_SCHED;
            PG8_LDB(B0, 1, 0); PG8_LDB(B1, 1, 1); PG8_SCHED; PG8_LDA(At, 1, 0); PG8_STAGE(PG8_SA(0, 1), a2 + hstep, voffA);
            PG8_WAIT_V(8); PG8_WAIT_L(0); PG8_BAR; PG8_MMA(0, 0, At, B0); PG8_MMA(0, 1, At, B1); PG8_BAR; PG8_SCHED;
            PG8_LDA(At, 1, 1); PG8_STAGE(PG8_SB(1, 0), b3, voffB); PG8_STAGE(PG8_SB(1, 1), b3 + hstep, voffB); PG8_STAGE(PG8_SA(1, 0), a3, voffA);
            PG8_WAIT_V(8); PG8_WAIT_L(0); PG8_BAR; PG8_MMA(1, 0, At, B0); PG8_MMA(1, 1, At, B1); PG8_BAR; PG8_SCHED;
            } else {
            PG8_LDB(B0, 0, 0); PG8_SCHED; PG8_LDA(At, 0, 0); PG8_STAGE(PG8_SA(1, 1), a1 + hstep, voffA);
            PG8_WAIT_L(8); PG8_BAR; PG8_WAIT_L(0); PG8_MMA(0, 0, At, B0); PG8_BAR; PG8_SCHED;
            PG8_LDB(B1, 0, 1); PG8_STAGE(PG8_SB(0, 0), b2, voffB);
            PG8_BAR; PG8_WAIT_L(0); PG8_MMA(0, 1, At, B1); PG8_BAR;
            PG8_LDA(At, 0, 1); PG8_STAGE(PG8_SA(0, 0), a2, voffA);
            PG8_BAR; PG8_WAIT_L(0); PG8_MMA(1, 0, At, B0); PG8_BAR; PG8_SCHED;
            PG8_STAGE(PG8_SB(0, 1), b2 + hstep, voffB);
            PG8_WAIT_V(6); PG8_BAR; PG8_MMA(1, 1, At, B1); PG8_BAR;
            PG8_LDB(B0, 1, 0); PG8_SCHED; PG8_LDA(At, 1, 0); PG8_STAGE(PG8_SA(0, 1), a2 + hstep, voffA);
            PG8_WAIT_L(8); PG8_BAR; PG8_WAIT_L(0); PG8_MMA(0, 0, At, B0); PG8_BAR; PG8_SCHED;
            PG8_LDB(B1, 1, 1); PG8_STAGE(PG8_SB(1, 0), b3, voffB);
            PG8_BAR; PG8_WAIT_L(0); PG8_MMA(0, 1, At, B1); PG8_BAR;
            PG8_LDA(At, 1, 1); PG8_STAGE(PG8_SA(1, 0), a3, voffA);
            PG8_BAR; PG8_WAIT_L(0); PG8_MMA(1, 0, At, B0); PG8_BAR; PG8_SCHED;
            PG8_STAGE(PG8_SB(1, 1), b3 + hstep, voffB);
            PG8_WAIT_V(6); PG8_BAR; PG8_MMA(1, 1, At, B1); PG8_BAR;
            }
        }
        if constexpr (ALIGN_EPI) { if (wr == 0) PG8_BAR; }
        if constexpr (!Epi::AFTER_DRAIN) { E(acc, cur, wr, wc, fr, fq); S.done(cur); }
        if (!has_next) break;
#pragma unroll
        for (int a = 0; a < 2; ++a)
#pragma unroll
            for (int b = 0; b < 2; ++b)
#pragma unroll
                for (int m = 0; m < 4; ++m)
#pragma unroll
                    for (int n = 0; n < 2; ++n) acc[a][b][m][n] = (f32x4){0.f, 0.f, 0.f, 0.f};
        cur = nxt; cA = nA; cB = nB; ++ui;
        if constexpr (ALIGN_EPI) { if (wr == 1) PG8_BAR; }
    }
    PG8_WAIT_V(0);
    if constexpr (!ALIGN_EPI) { if (wr == 0) PG8_BAR; }
    PG8_BAR;
    if constexpr (Epi::AFTER_DRAIN) { E.fused(acc, cur, wr, wc, fr, fq, lds, wid, lane); S.done(cur); }
#undef PG8_SA
#undef PG8_SB
#undef PG8_STAGE
#undef PG8_LDA
#undef PG8_LDB
#undef PG8_MMA
#undef PG8_WAIT_V
#undef PG8_WAIT_L
#undef PG8_BAR
#undef PG8_SCHED
}
}

struct Frame {
    LAS unsigned char* lds;
    int wave, G, bid;
    const float *x, *mix_norm, *ffn_norm, *final_norm, *w_in, *w_out, *rel_bias, *conv_w1, *conv_b1, *conv_dw, *conv_dw_b, *conv_ln_g, *conv_ln_b, *conv_w2, *conv_b2,
        *peer_wq, *peer_keys, *peer_u, *peer_v;
    float* out;
    unsigned char* ws;
};
#define FRAME_IDS const int f_lane = lane_id(); const int f_tid = F.wave * 64 + f_lane; (void)f_tid
DI float gamma_of(int h) { return 1.f - exp2f(-5.f - (float)h); }

DI void p0_prep(Frame& F) {
    FRAME_IDS;
    const int gw = F.bid * NWAVES + F.wave, NGW = F.G * NWAVES;
    f32x2* rope = (f32x2*)(F.ws + WS_ROPE);
    for (int i = F.bid * NTHR + f_tid; i < SEQ * 32; i += F.G * NTHR) {
        const int s = i >> 5, j = i & 31;
        const float inv = powf(10000.f, -(float)j / 32.f);
        const float ang = (float)s * inv;
        float sn, cs; sincosf(ang, &sn, &cs);
        rope[i] = (f32x2){cs, sn};
    }
    bf16* xb = (bf16*)(F.ws + WS_XB);
    for (int m = gw; m < T; m += NGW) {
        const f32x4* xr = (const f32x4*)(F.x + (size_t)m * DM) + f_lane;
        u32x2* o = (u32x2*)(xb + (size_t)m * DM) + f_lane;
        f32x4 v[4]; float s = 0.f;
#pragma unroll
        for (int j = 0; j < 4; ++j) { v[j] = xr[64 * j]; s += v[j].x * v[j].x + v[j].y * v[j].y + v[j].z * v[j].z + v[j].w * v[j].w; }
        const float r = 1.f / sqrtf(wave_sum(s) * (1.f / DM) + EPS);
#pragma unroll
        for (int j = 0; j < 4; ++j) o[64 * j] = (u32x2){pk2(v[j].x * r, v[j].y * r), pk2(v[j].z * r, v[j].w * r)};
    }
}
DI void p0_transpose_item(const float* W, int K, int N, bf16* WT, int prow0, const float* gain, float scale, LAS float* scr, int k0, int n0, int lane) {
#pragma unroll 8
    for (int i = 0; i < 32; ++i) { const int kk = 2 * i + (lane >> 5); scr[kk * 33 + (lane & 31)] = W[(size_t)(k0 + kk) * N + n0 + (lane & 31)] * (gain ? gain[k0 + kk] : 1.f) * scale; }
    asm volatile("s_waitcnt lgkmcnt(0)" ::: "memory");
    const int c = lane & 7;
#pragma unroll
    for (int j = 0; j < 4; ++j) { const int n = (lane >> 3) + 8 * j; const LAS float* q = scr + (8 * c) * 33 + n;
        u32x4 o; o.x = pk2(q[0 * 33], q[1 * 33]); o.y = pk2(q[2 * 33], q[3 * 33]); o.z = pk2(q[4 * 33], q[5 * 33]); o.w = pk2(q[6 * 33], q[7 * 33]);
        *(u32x4*)(WT + (size_t)(prow0 + n) * K + k0 + 8 * c) = o; }
    asm volatile("s_waitcnt lgkmcnt(0)" ::: "memory");
}
DI void p0_weights(Frame& F) {
    FRAME_IDS;
    LAS float* scr = (LAS float*)(F.lds + F.wave * 16384);
    const int gw = F.bid * NWAVES + F.wave, NGW = F.G * NWAVES;
    constexpr int I_IN = 16 * (INC / 32), I_SQ = 16 * (DM / 32), I_W1 = 16 * (2 * DM / 32);
    constexpr int NITEMS = I_IN + I_SQ + I_W1 + I_SQ + 2 * I_SQ;
    for (int it = gw; it < NITEMS; it += NGW) {
        int r = it;
        if (r < I_IN) { const int nb = r % (INC / 32), kb = r / (INC / 32), n0 = nb * 32;
            const int type = n0 / 512, head = (n0 % 512) / 64, bj = (n0 % 64) / 32;
            const int prow0 = 256 * (2 * type + head / 4) + 128 * bj + 32 * (head % 4);
            p0_transpose_item(F.w_in, DM, INC, (bf16*)(F.ws + WS_WIN), prow0, F.mix_norm, type == 0 ? 0.125f * LOG2E : (type == 4 ? 0.125f : 1.f), scr, kb * 64, n0, f_lane); continue; }
        r -= I_IN;
        if (r < I_SQ) { const int nb = r % 32, kb = r / 32; p0_transpose_item(F.w_out, DM, DM, (bf16*)(F.ws + WS_WOUT), nb * 32, nullptr, 1.f, scr, kb * 64, nb * 32, f_lane); continue; }
        r -= I_SQ;
        if (r < I_W1) { const int nb = r % 64, kb = r / 64, n0 = nb * 32; const int bj = n0 / 1024, rem = n0 % 1024;
            p0_transpose_item(F.conv_w1, DM, 2 * DM, (bf16*)(F.ws + WS_W1), 256 * (rem / 128) + 128 * bj + (rem % 128), F.mix_norm + DM, 1.f, scr, kb * 64, n0, f_lane); continue; }
        r -= I_W1;
        if (r < I_SQ) { const int nb = r % 32, kb = r / 32; p0_transpose_item(F.conv_w2, DM, DM, (bf16*)(F.ws + WS_W2), nb * 32, nullptr, 1.f, scr, kb * 64, nb * 32, f_lane); continue; }
        r -= I_SQ;
        { const int layer = r / I_SQ; r %= I_SQ; const int nb = r % 32, kb = r / 32;
          p0_transpose_item(F.peer_wq + (size_t)layer * DM * DM, DM, DM, (bf16*)(F.ws + WS_WQ) + (size_t)layer * DM * DM, nb * 32, F.ffn_norm + layer * DM, 1.f, scr, kb * 64, nb * 32, f_lane); }
    }
}
DI float row_rstd(const float* part, int m) {
    const f32x4* p = (const f32x4*)(part + (size_t)m * 16);
    const f32x4 a = p[0], b = p[1], c = p[2], d = p[3];
    const float s = ((a.x + a.y) + (a.z + a.w)) + ((b.x + b.y) + (b.z + b.w)) + ((c.x + c.y) + (c.z + c.w)) + ((d.x + d.y) + (d.z + d.w));
    return 1.f / sqrtf(s * (1.f / DM) + EPS);
}

typedef short v4i16 __attribute__((ext_vector_type(4)));
typedef __bf16 bf16x2_t __attribute__((ext_vector_type(2)));
DI unsigned cvtpk(float lo, float hi) { f32x2 v = {lo, hi}; bf16x2_t b = __builtin_convertvector(v, bf16x2_t); return __builtin_bit_cast(unsigned, b); }
DI v4i16 ds_tr16(LAS const unsigned char* p) { return __builtin_amdgcn_ds_read_tr16_b64_v4i16((LAS v4i16*)p); }
DI int crow(int r, int h) { return (r & 3) + 8 * (r >> 2) + 4 * h; }
DI bf16x8 pack_step(const f32x16& x, const int s) {
    u32x4 w = {cvtpk(x[8 * s + 0], x[8 * s + 1]), cvtpk(x[8 * s + 2], x[8 * s + 3]), cvtpk(x[8 * s + 4], x[8 * s + 5]), cvtpk(x[8 * s + 6], x[8 * s + 7])};
    return __builtin_bit_cast(bf16x8, w);
}
constexpr int AT_KB = 64 * 144, AT_VB = 8192, AT_BUF = AT_KB + AT_VB, AT_BIAS = 2 * AT_BUF;
DI void attn_item(Frame& F, const int it) {
    FRAME_IDS;
    const bf16* R = (const bf16*)(F.ws + WS_R); bf16* O = (bf16*)(F.ws + WS_O);
    LAS unsigned char* lds = F.lds;
    LAS float* bias_s = (LAS float*)(lds + AT_BIAS);
    const int q32 = f_lane & 31, h = f_lane >> 5, w = F.wave;
    const int srow = f_tid >> 3, sch = f_tid & 7;
    const int vtr_off = ((f_lane & 15) >> 2) * 64 + (16 * ((f_lane >> 4) & 1) + 4 * (f_lane & 3)) * 2;
    {
        const int b = it / (NHA * 8), hd = (it / 8) % NHA, c0 = (it % 8) * 4;
        const int c = c0 + (w >> 1), qrow0 = 32 * (w & 1);
        const size_t tq = (size_t)b * SEQ + c * 64 + qrow0 + q32;
        __syncthreads();
        for (int k = f_tid; k < 257; k += NTHR) bias_s[k] = F.rel_bias[hd * 257 + k] * LOG2E;
        bf16x8 qf[4];
#pragma unroll
        for (int ks = 0; ks < 4; ++ks) qf[ks] = *(const bf16x8*)(R + tq * INC + C_QA + hd * 64 + 16 * ks + 8 * h);
        const int t_lo = c0 - 8 < 0 ? 0 : c0 - 8, t_hi = c0 + 3, ntile = t_hi - t_lo + 1;
        const bf16* kbase = R + ((size_t)b * SEQ + srow) * INC + C_KA + hd * 64 + 8 * sch;
        const bf16* vbase = R + ((size_t)b * SEQ + srow) * INC + C_VA + hd * 64 + 8 * sch;
        u32x4 kreg = *(const u32x4*)(kbase + (size_t)t_lo * 64 * INC), vreg = *(const u32x4*)(vbase + (size_t)t_lo * 64 * INC);
        *(LAS u32x4*)(lds + srow * 144 + sch * 16) = kreg;
        *(LAS u32x4*)(lds + AT_KB + (sch >> 2) * 4096 + srow * 64 + (sch & 3) * 16) = vreg;
        __syncthreads();
        const float bias_far = bias_s[256];
        float m = -1e30f, l = 0.f;
        f32x16 o0 = {}, o1 = {};
        for (int i = 0; i < ntile; ++i) {
            const int tc = t_lo + i;
            LAS unsigned char* kb = lds + (i & 1) * AT_BUF; LAS unsigned char* vb = kb + AT_KB;
            if (i + 1 < ntile) { kreg = *(const u32x4*)(kbase + (size_t)(tc + 1) * 64 * INC); vreg = *(const u32x4*)(vbase + (size_t)(tc + 1) * 64 * INC); }
            const int D = c - tc;
            if (D >= 0 && D <= 8) {
                const float init = D >= 3 ? bias_far : 0.f;
                f32x16 p0, p1;
#pragma unroll
                for (int r = 0; r < 16; ++r) { p0[r] = init; p1[r] = init; }
#pragma unroll
                for (int ks = 0; ks < 4; ++ks) {
                    const bf16x8 k0 = *(const LAS bf16x8*)(kb + q32 * 144 + (16 * ks + 8 * h) * 2);
                    const bf16x8 k1 = *(const LAS bf16x8*)(kb + (32 + q32) * 144 + (16 * ks + 8 * h) * 2);
                    p0 = __builtin_amdgcn_mfma_f32_32x32x16_bf16(k0, qf[ks], p0, 0, 0, 0);
                    p1 = __builtin_amdgcn_mfma_f32_32x32x16_bf16(k1, qf[ks], p1, 0, 0, 0);
                }
                if (D < 3) {
                    const int relb = D * 64 + qrow0 + q32 - 4 * h + 128;
#pragma unroll
                    for (int r = 0; r < 16; ++r) {
                        const int r0 = relb - ((r & 3) + 8 * (r >> 2));
                        const int i0 = r0 < 0 ? 0 : (r0 > 256 ? 256 : r0), r1 = r0 - 32, i1 = r1 < 0 ? 0 : (r1 > 256 ? 256 : r1);
                        p0[r] += bias_s[i0]; p1[r] += bias_s[i1];
                    }
                }
                float tm = fmaxf(p0[0], p1[0]);
#pragma unroll
                for (int r = 1; r < 16; ++r) tm = fmaxf(tm, fmaxf(p0[r], p1[r]));
                tm = swap32_max(tm);
                const float mn = fmaxf(m, tm), alpha = __builtin_amdgcn_exp2f(m - mn);
                m = mn;
                float ps = 0.f;
#pragma unroll
                for (int r = 0; r < 16; ++r) { p0[r] = __builtin_amdgcn_exp2f(p0[r] - mn); p1[r] = __builtin_amdgcn_exp2f(p1[r] - mn); ps += p0[r] + p1[r]; }
                l = l * alpha + ps;
                if (!__all(alpha == 1.f)) {
#pragma unroll
                    for (int r = 0; r < 16; ++r) { o0[r] *= alpha; o1[r] *= alpha; }
                }
                bf16x8 pf[4];
                pf[0] = pack_step(p0, 0); pf[1] = pack_step(p0, 1); pf[2] = pack_step(p1, 0); pf[3] = pack_step(p1, 1);
#pragma unroll
                for (int kk = 0; kk < 4; ++kk) {
                    const int key0 = 16 * kk + 4 * h;
                    const v4i16 a0l = ds_tr16(vb + key0 * 64 + vtr_off), a0h = ds_tr16(vb + (key0 + 8) * 64 + vtr_off);
                    const v4i16 a1l = ds_tr16(vb + 4096 + key0 * 64 + vtr_off), a1h = ds_tr16(vb + 4096 + (key0 + 8) * 64 + vtr_off);
                    const bf16x8 a0 = __builtin_shufflevector(a0l, a0h, 0, 1, 2, 3, 4, 5, 6, 7), a1 = __builtin_shufflevector(a1l, a1h, 0, 1, 2, 3, 4, 5, 6, 7);
                    o0 = __builtin_amdgcn_mfma_f32_32x32x16_bf16(a0, pf[kk], o0, 0, 0, 0);
                    o1 = __builtin_amdgcn_mfma_f32_32x32x16_bf16(a1, pf[kk], o1, 0, 0, 0);
                }
            }
            if (i + 1 < ntile) {
                LAS unsigned char* nb = lds + ((i + 1) & 1) * AT_BUF;
                *(LAS u32x4*)(nb + srow * 144 + sch * 16) = kreg;
                *(LAS u32x4*)(nb + AT_KB + (sch >> 2) * 4096 + srow * 64 + (sch & 3) * 16) = vreg;
            }
            __syncthreads();
        }
        l = swap32_add(l, l);
        const float inv = 1.f / l;
        bf16* op = O + tq * DM + hd * 64 + 4 * h;
#pragma unroll
        for (int g = 0; g < 4; ++g) {
            *(u32x2*)(op + 8 * g) = (u32x2){cvtpk(o0[4 * g] * inv, o0[4 * g + 1] * inv), cvtpk(o0[4 * g + 2] * inv, o0[4 * g + 3] * inv)};
            *(u32x2*)(op + 32 + 8 * g) = (u32x2){cvtpk(o1[4 * g] * inv, o1[4 * g + 1] * inv), cvtpk(o1[4 * g + 2] * inv, o1[4 * g + 3] * inv)};
        }
    }
    __syncthreads();
}

constexpr int RT_Q = 0, RT_K = 9216, RT_KD = 18432, RT_V = 26624, RT_BUF = 34816, RT_ZS = 2 * RT_BUF, RT_CS = RT_ZS + 64 * 66 * 4;
DI void ret_item(Frame& F, const int it) {
    FRAME_IDS;
    const bf16* R = (const bf16*)(F.ws + WS_R); bf16* O = (bf16*)(F.ws + WS_O);
    LAS unsigned char* lds = F.lds;
    LAS float* Zs = (LAS float*)(lds + RT_ZS); LAS float* Cs = (LAS float*)(lds + RT_CS);
    const int b = it / NHB, hd = it % NHB;
    const int q32 = f_lane & 31, h = f_lane >> 5, w = F.wave;
    const int role = w >> 2, itile = (w >> 1) & 1, etile = w & 1;
    const int srow = f_tid >> 3, sch = f_tid & 7;
    const int vtr_off = ((f_lane & 15) >> 2) * 64 + (16 * ((f_lane >> 4) & 1) + 4 * (f_lane & 3)) * 2;
    const float l2g = log2f(gamma_of(hd));
    const float cd = exp2f(l2g * 64.f), sdec = exp2f(l2g * (float)(63 - srow));
    float qdv[16];
#pragma unroll
    for (int r = 0; r < 16; ++r) qdv[r] = exp2f(l2g * (float)(32 * itile + crow(r, h) + 1));
    f32x16 xs0 = {}, xs1 = {};
    const size_t trow0 = (size_t)b * SEQ;
    const bf16* gq = R + (trow0 + srow) * INC + hd * 64 + 8 * sch;
    u32x4 qreg = *(const u32x4*)(gq + C_QB), kreg = *(const u32x4*)(gq + C_KB), vreg = *(const u32x4*)(gq + C_VB);
    __syncthreads();
#define RT_STAGE(bufp) do { LAS unsigned char* bp_ = (bufp); \
        *(LAS u32x4*)(bp_ + RT_Q + srow * 144 + sch * 16) = qreg; *(LAS u32x4*)(bp_ + RT_K + srow * 144 + sch * 16) = kreg; \
        *(LAS u32x4*)(bp_ + RT_V + (sch >> 2) * 4096 + srow * 64 + (sch & 3) * 16) = vreg; \
        u32x4 kd_; \
        _Pragma("unroll") for (int e_ = 0; e_ < 4; ++e_) kd_[e_] = cvtpk(__uint_as_float(kreg[e_] << 16) * sdec, __uint_as_float(kreg[e_] & 0xffff0000u) * sdec); \
        *(LAS u32x4*)(bp_ + RT_KD + (sch >> 2) * 4096 + srow * 64 + (sch & 3) * 16) = kd_; } while (0)
    RT_STAGE(lds);
    __syncthreads();
    for (int n = 0; n < NCH; ++n) {
        LAS unsigned char* bp = lds + (n & 1) * RT_BUF;
        if (n + 1 < NCH) { const bf16* g1 = gq + (size_t)(n + 1) * 64 * INC; qreg = *(const u32x4*)(g1 + C_QB); kreg = *(const u32x4*)(g1 + C_KB); vreg = *(const u32x4*)(g1 + C_VB); }
        unsigned short gr[8];
#pragma unroll
        for (int r = 0; r < 8; ++r) gr[r] = R[(trow0 + n * 64 + 8 * w + r) * INC + C_GB + hd * 64 + f_lane];
        if (role == 0) {
            bf16x8 qf[4];
#pragma unroll
            for (int ks = 0; ks < 4; ++ks) qf[ks] = *(const LAS bf16x8*)(bp + RT_Q + (32 * itile + q32) * 144 + (16 * ks + 8 * h) * 2);
            f32x16 st0 = {}, st1 = {};
#pragma unroll
            for (int ks = 0; ks < 4; ++ks) {
                const bf16x8 k0 = *(const LAS bf16x8*)(bp + RT_K + q32 * 144 + (16 * ks + 8 * h) * 2);
                const bf16x8 k1 = *(const LAS bf16x8*)(bp + RT_K + (32 + q32) * 144 + (16 * ks + 8 * h) * 2);
                st0 = __builtin_amdgcn_mfma_f32_32x32x16_bf16(k0, qf[ks], st0, 0, 0, 0);
                st1 = __builtin_amdgcn_mfma_f32_32x32x16_bf16(k1, qf[ks], st1, 0, 0, 0);
            }
            int iiv = 32 * itile + q32 - 4 * h; asm volatile("" : "+v"(iiv));
#pragma unroll
            for (int r = 0; r < 16; ++r) {
                const int dd = iiv - ((r & 3) + 8 * (r >> 2));
                st0[r] *= __builtin_amdgcn_exp2f(l2g * fabsf((float)dd));
                st1[r] *= __builtin_amdgcn_exp2f(l2g * fabsf((float)(dd - 32)));
            }
            f32x16 z = {};
#pragma unroll
            for (int kk = 0; kk < 4; ++kk) {
                const int key0 = 16 * kk + 4 * h;
                const v4i16 bl = ds_tr16(bp + RT_V + etile * 4096 + key0 * 64 + vtr_off), bh = ds_tr16(bp + RT_V + etile * 4096 + (key0 + 8) * 64 + vtr_off);
                const bf16x8 vb = __builtin_shufflevector(bl, bh, 0, 1, 2, 3, 4, 5, 6, 7);
                const bf16x8 xa = (kk < 2) ? pack_step(st0, kk & 1) : pack_step(st1, kk & 1);
                z = __builtin_amdgcn_mfma_f32_32x32x16_bf16(xa, vb, z, 0, 0, 0);
            }
            int zb = (32 * itile + 4 * h) * 66 + 32 * etile + q32; asm volatile("" : "+v"(zb));
#pragma unroll
            for (int r = 0; r < 16; ++r) Zs[zb + ((r & 3) + 8 * (r >> 2)) * 66] = z[r];
        } else {
            f32x16 cr = {};
#pragma unroll
            for (int kk = 0; kk < 4; ++kk) {
                const LAS unsigned char* qp = bp + RT_Q + (32 * itile + q32) * 144 + (16 * kk + 4 * h) * 2;
                const v4i16 al = *(const LAS v4i16*)qp, ah = *(const LAS v4i16*)(qp + 16);
                const bf16x8 qa = __builtin_shufflevector(al, ah, 0, 1, 2, 3, 4, 5, 6, 7);
                const bf16x8 xb = (kk < 2) ? pack_step(xs0, kk & 1) : pack_step(xs1, kk & 1);
                cr = __builtin_amdgcn_mfma_f32_32x32x16_bf16(qa, xb, cr, 0, 0, 0);
            }
            int cb = (32 * itile + 4 * h) * 66 + 32 * etile + q32; asm volatile("" : "+v"(cb));
#pragma unroll
            for (int r = 0; r < 16; ++r) Cs[cb + ((r & 3) + 8 * (r >> 2)) * 66] = cr[r] * qdv[r];
#pragma unroll
            for (int r = 0; r < 16; ++r) { xs0[r] *= cd; xs1[r] *= cd; }
#pragma unroll
            for (int s4 = 0; s4 < 4; ++s4) {
                const int key0 = 16 * s4 + 8 * h;
                const v4i16 vl = ds_tr16(bp + RT_V + etile * 4096 + key0 * 64 + vtr_off), vh = ds_tr16(bp + RT_V + etile * 4096 + (key0 + 4) * 64 + vtr_off);
                const bf16x8 vb = __builtin_shufflevector(vl, vh, 0, 1, 2, 3, 4, 5, 6, 7);
                const v4i16 a0l = ds_tr16(bp + RT_KD + key0 * 64 + vtr_off), a0h = ds_tr16(bp + RT_KD + (key0 + 4) * 64 + vtr_off);
                const v4i16 a1l = ds_tr16(bp + RT_KD + 4096 + key0 * 64 + vtr_off), a1h = ds_tr16(bp + RT_KD + 4096 + (key0 + 4) * 64 + vtr_off);
                const bf16x8 ka0 = __builtin_shufflevector(a0l, a0h, 0, 1, 2, 3, 4, 5, 6, 7), ka1 = __builtin_shufflevector(a1l, a1h, 0, 1, 2, 3, 4, 5, 6, 7);
                xs0 = __builtin_amdgcn_mfma_f32_32x32x16_bf16(ka0, vb, xs0, 0, 0, 0);
                xs1 = __builtin_amdgcn_mfma_f32_32x32x16_bf16(ka1, vb, xs1, 0, 0, 0);
            }
        }
        __syncthreads();
#pragma unroll
        for (int r = 0; r < 8; ++r) {
            const int i = 8 * w + r;
            const float v = Zs[i * 66 + f_lane] + Cs[i * 66 + f_lane];
            const float mu = wave_sum(v) * (1.f / 64.f);
            const float dv = v - mu;
            const float var = wave_sum(dv * dv) * (1.f / 64.f);
            const float g = bf2f(gr[r]);
            O[(trow0 + n * 64 + i) * DM + 512 + hd * 64 + f_lane] = (bf16)f2bf(dv * (1.f / sqrtf(var + EPS)) * (g / (1.f + __expf(-g))));
        }
        if (n + 1 < NCH) RT_STAGE(lds + ((n + 1) & 1) * RT_BUF);
        __syncthreads();
    }
#undef RT_STAGE
}
DI unsigned q8x4(f32x4 v, const float sc) {
    const int a = (int)rintf(v[0] * sc), b = (int)rintf(v[1] * sc), c = (int)rintf(v[2] * sc), d = (int)rintf(v[3] * sc);
    return ((unsigned)a & 0xFFu) | (((unsigned)b & 0xFFu) << 8) | (((unsigned)c & 0xFFu) << 16) | ((unsigned)d << 24);
}
DI void int8_rows(Frame& F, const int row0, const int nrows, const int f_lane) {
    float* SC = (float*)(F.ws + WS_SC);
    for (int rr = row0; rr < row0 + nrows; rr += 4) {
        f32x4 v[4][4];
#pragma unroll
        for (int u = 0; u < 4; ++u) {
            const int row = rr + u, tab = row / PE, e = row % PE, layer = tab & 1, isv = tab >> 1;
            const f32x4* sp = (const f32x4*)((isv ? F.peer_v : F.peer_u) + ((size_t)layer * PE + e) * DM) + f_lane;
#pragma unroll
            for (int j = 0; j < 4; ++j) v[u][j] = sp[64 * j];
        }
#pragma unroll
        for (int u = 0; u < 4; ++u) {
            const int row = rr + u, tab = row / PE, e = row % PE, layer = tab & 1, isv = tab >> 1;
            const f32x4* gp = (const f32x4*)(F.ffn_norm + layer * DM) + f_lane;
            float a = 0.f;
#pragma unroll
            for (int j = 0; j < 4; ++j) { if (!isv) v[u][j] = v[u][j] * gp[64 * j]; a = fmaxf(a, fmaxf(fmaxf(fabsf(v[u][j][0]), fabsf(v[u][j][1])), fmaxf(fabsf(v[u][j][2]), fabsf(v[u][j][3])))); }
            a = wave_max(a);
            if (isv) {
                unsigned* dst = (unsigned*)(F.ws + WS_V8) + (size_t)layer * 8 * PE * 32;
                const float sc = a > 0.f ? 127.f / a : 0.f;
#pragma unroll
                for (int j = 0; j < 4; ++j) dst[((size_t)(2 * j + (f_lane >> 5)) * PE + e) * 32 + (f_lane & 31)] = q8x4(v[u][j], sc);
                if (f_lane == 0) SC[tab * PE + e] = a * (1.f / 127.f);
            } else {
                unsigned* dst = (unsigned*)(F.ws + WS_U8) + (size_t)layer * 4 * PE * 32;
                float sq = 0.f;
#pragma unroll
                for (int j = 0; j < 4; ++j) sq += (v[u][j][0] * v[u][j][0] + v[u][j][1] * v[u][j][1]) + (v[u][j][2] * v[u][j][2] + v[u][j][3] * v[u][j][3]);
                const float step = fminf(0.355f * sqrtf(wave_sum(sq) * (1.f / DM)), a * (1.f / 7.f)) ;
                const float sc = step > 0.f ? 1.f / step : 0.f;
#pragma unroll
                for (int j = 0; j < 4; ++j) {
                    const int q0 = (int)rintf(__builtin_amdgcn_fmed3f(v[u][j][0] * sc, -7.f, 7.f)), q1 = (int)rintf(__builtin_amdgcn_fmed3f(v[u][j][1] * sc, -7.f, 7.f)), q2 = (int)rintf(__builtin_amdgcn_fmed3f(v[u][j][2] * sc, -7.f, 7.f)), q3 = (int)rintf(__builtin_amdgcn_fmed3f(v[u][j][3] * sc, -7.f, 7.f));
                    unsigned w = ((unsigned)q0 & 0xFu) | (((unsigned)q1 & 0xFu) << 8) | (((unsigned)q2 & 0xFu) << 16) | (((unsigned)q3 & 0xFu) << 24);
                    if (f_lane & 1) w <<= 4;
                    w |= (unsigned)DPP_MOV_I((int)w, DPP_XOR1);
                    if (!(f_lane & 1)) dst[((size_t)j * PE + e) * 32 + (f_lane >> 1)] = w;
                }
                if (f_lane == 0) SC[tab * PE + e] = step * (1.f / 16.f);
            }
        }
    }
}
constexpr int Q8_ITEM_ROWS = 512, Q8_ITEMS = 4 * PE / Q8_ITEM_ROWS;
constexpr int PH_MIX_ID = 2;
DI void mix_phase(Frame& F, const int rep) {
    FRAME_IDS;
    unsigned* ctr = (unsigned*)(F.ws + WS_CTL) + CW_QUEUE + 64 * rep;
    volatile LAS unsigned* slot = (volatile LAS unsigned*)(F.lds + MISC_OFF) + 16;
    constexpr int N_RET = NB * NHB, N_ATT = NB * NHA * 8;
    static_assert(N_ATT == 8 * Q8_ITEMS, "8 attention items per quantisation item");
    for (;;) {
        __syncthreads();
        if (f_tid == 0) slot[0] = __hip_atomic_fetch_add(ctr, 1u, __ATOMIC_RELAXED, __HIP_MEMORY_SCOPE_AGENT);
        __syncthreads();
        const int idx = (int)slot[0];
        if (idx >= N_RET + N_ATT + Q8_ITEMS) break;
        const bool probe_pass = (REP_PHASE == PH_MIX_ID && rep == 0);
        if (idx < N_RET) { if (!(probe_pass && PROBE_MODE == 4)) ret_item(F, idx); }
        else if (probe_pass && PROBE_MODE == 3) { }
        else { const int k = idx - N_RET, grp = k / 9, pos = k - 9 * grp;
            if (pos == 8) int8_rows(F, grp * Q8_ITEM_ROWS + F.wave * 64, 64, f_lane);
            else attn_item(F, 8 * grp + pos); }
    }
}
DI float fmax_raw(float a, float b) { float r; asm("v_max_f32_e32 %0, %1, %2" : "=v"(r) : "v"(a), "v"(b)); return r; }
DI float fmin_raw(float a, float b) { float r; asm("v_min_f32_e32 %0, %1, %2" : "=v"(r) : "v"(a), "v"(b)); return r; }
#define CE_DESC(x, y) do { const float hi_ = fmax_raw((x), (y)), lo_ = fmin_raw((x), (y)); (x) = hi_; (y) = lo_; } while (0)
template <int N> DI void sort_desc(float* v) {
#pragma unroll
    for (int k = 2; k <= N; k <<= 1)
#pragma unroll
        for (int j = k >> 1; j > 0; j >>= 1)
#pragma unroll
            for (int i = 0; i < N; ++i) { const int l = i ^ j; if (l > i) { if ((i & k) == 0 || k == N) CE_DESC(v[i], v[l]); else CE_DESC(v[l], v[i]); } }
}
DI void merge16(float* a, const float* b) {
#pragma unroll
    for (int i = 0; i < 16; ++i) a[i] = fmax_raw(a[i], b[15 - i]);
#pragma unroll
    for (int j = 8; j > 0; j >>= 1)
#pragma unroll
        for (int i = 0; i < 16; ++i) { const int l = i ^ j; if (l > i) CE_DESC(a[i], a[l]); }
}
DI float key_pack(float v, unsigned keep_mask, unsigned idx) { return __uint_as_float((__float_as_uint(v) & keep_mask) | idx); }
DI void opt_route(Frame& F, int layer) {
    FRAME_IDS;
    const bf16* Q = (const bf16*)(F.ws + WS_Q);
    int* eidx = (int*)(F.ws + WS_EIDX); float* gate = (float*)(F.ws + WS_GATE);
    const float* keys = F.peer_keys + (size_t)layer * 2 * PK * 64;
    LAS unsigned char* kl = F.lds;
    __syncthreads();
    for (int idx = f_tid; idx < 2 * PK * 8; idx += NTHR) {
        const int row = idx >> 3, ch = idx & 7;
        const f32x4 a = *(const f32x4*)(keys + (size_t)row * 64 + ch * 8), b = *(const f32x4*)(keys + (size_t)row * 64 + ch * 8 + 4);
        *(LAS u32x4*)(kl + row * 144 + ch * 16) = (u32x4){pk2(a[0], a[1]), pk2(a[2], a[3]), pk2(b[0], b[1]), pk2(b[2], b[3])};
    }
    __syncthreads();
    LAS int* lut = (LAS int*)(F.lds + 40960 + F.wave * 8192);
    const int c = f_lane & 31, h = f_lane >> 5;
    pg8::StaticOrder SO; SO.init(T, DM, F.G, F.bid);
    pg8::Unit un;
    for (int ui = 0; SO.next(ui, un); ++ui)
    for (int k2 = F.wave; k2 < 16; k2 += NWAVES) {
        const int tile = 8 * un.pm + (k2 & 7), hh = 2 * un.pn + (k2 >> 3), t = tile * 32 + c;
        float tk[2][16];
#pragma unroll
        for (int side = 0; side < 2; ++side) {
            bf16x8 qf[4];
#pragma unroll
            for (int ks = 0; ks < 4; ++ks) qf[ks] = *(const bf16x8*)(Q + (size_t)t * DM + hh * PQD + side * 64 + 16 * ks + 8 * h);
            float v[64];
#pragma unroll
            for (int kt = 0; kt < 4; ++kt) {
                f32x16 acc = {};
#pragma unroll
                for (int ks = 0; ks < 4; ++ks) {
                    const bf16x8 a = *(const LAS bf16x8*)(kl + (side * PK + 32 * kt + c) * 144 + (16 * ks + 8 * h) * 2);
                    acc = __builtin_amdgcn_mfma_f32_32x32x16_bf16(a, qf[ks], acc, 0, 0, 0);
                }
#pragma unroll
                for (int r = 0; r < 16; ++r) v[16 * kt + r] = key_pack(acc[r], 0xFFFFFF80u, (unsigned)(32 * kt + (r & 3) + 8 * (r >> 2) + 4 * h));
            }
            sort_desc<16>(v); sort_desc<16>(v + 16); sort_desc<16>(v + 32); sort_desc<16>(v + 48);
            merge16(v, v + 16); merge16(v + 32, v + 48); merge16(v, v + 32);
            float pr[16];
#pragma unroll
            for (int i = 0; i < 16; ++i) pr[i] = __shfl_xor(v[i], 32);
            merge16(v, pr);
#pragma unroll
            for (int i = 0; i < 16; ++i) { tk[side][i] = v[i]; lut[(side * 16 + i) * 64 + f_lane] = (int)(__float_as_uint(v[i]) & 0x7Fu); }
        }
        float cd[64];
        {   int n = 0;
#pragma unroll
            for (int a = 0; a < 16; ++a)
#pragma unroll
                for (int b = 0; b < 16; ++b) if ((a + 1) * (b + 1) <= 16) { cd[n] = key_pack(tk[0][a] + tk[1][b], 0xFFFFFF00u, (unsigned)(a * 16 + b)); ++n; }
#pragma unroll
            for (int i = 50; i < 64; ++i) cd[i] = -INFINITY;
        }
        sort_desc<16>(cd); sort_desc<16>(cd + 16); sort_desc<16>(cd + 32); CE_DESC(cd[48], cd[49]);
        merge16(cd, cd + 16); merge16(cd + 32, cd + 48); merge16(cd, cd + 32);
        int ex[16]; float gv[16]; float sum = 0.f;
        const float top = __uint_as_float(__float_as_uint(cd[0]) & 0xFFFFFF00u);
#pragma unroll
        for (int i = 0; i < 16; ++i) {
            const unsigned bits = __float_as_uint(cd[i]);
            const int a = (bits >> 4) & 15, b = bits & 15;
            ex[i] = lut[a * 64 + f_lane] * PK + lut[(16 + b) * 64 + f_lane];
            gv[i] = __expf(__uint_as_float(bits & 0xFFFFFF00u) - top); sum += gv[i];
        }
        const float inv = 1.f / sum;
        if (h == 0) {
            u32x4* ep = (u32x4*)(eidx + (size_t)t * NSEL + hh * 16);
#pragma unroll
            for (int q = 0; q < 4; ++q) ep[q] = (u32x4){(unsigned)ex[4 * q], (unsigned)ex[4 * q + 1], (unsigned)ex[4 * q + 2], (unsigned)ex[4 * q + 3]};
        } else {
            f32x4* gp = (f32x4*)(gate + (size_t)t * NSEL + hh * 16);
#pragma unroll
            for (int q = 0; q < 4; ++q) gp[q] = (f32x4){gv[4 * q] * inv, gv[4 * q + 1] * inv, gv[4 * q + 2] * inv, gv[4 * q + 3] * inv};
        }
    }
    __syncthreads();
}
struct XInfo { int xrank, nx, rank, nloc; };
DI XInfo get_xinfo(Frame& F, const bool census) {
    FRAME_IDS;
    volatile LAS unsigned* M = (volatile LAS unsigned*)(F.lds + MISC_OFF);
    __syncthreads();
    if (f_tid == 0) {
        unsigned xr = (unsigned)F.bid & 7u, nx = 8u, rk = (unsigned)F.bid >> 3, nl = ((unsigned)F.G + 7u - ((unsigned)F.bid & 7u)) >> 3;
        if (census) {
            unsigned* bar = (unsigned*)(F.ws + WS_CTL) + CW_BAR; const unsigned x = xb_xcc_id();
            unsigned cnt = 0u, below = 0u, mine = 0u;
#pragma unroll
            for (unsigned j = 0; j < 16; ++j) { const unsigned c = xb_ld(&bar[XB_XCNT(j)]); cnt += (c > 0u); below += (c > 0u && j < x); mine = (j == x) ? c : mine; }
            if (cnt > 0u && mine > 0u) { xr = below; nx = cnt; rk = M[12]; nl = mine; }
        }
        M[20] = xr; M[21] = nx; M[22] = rk; M[23] = nl;
    }
    __syncthreads();
    XInfo xi; xi.xrank = (int)M[20]; xi.nx = (int)M[21]; xi.rank = (int)M[22]; xi.nloc = (int)M[23];
    return xi;
}
DI int comb_c(const int level, const int a, const int b, const int lane) {
    const int M = 4 >> level; const bool bit = (lane & M) != 0;
    const int send = bit ? a : b, keep = bit ? b : a;
    const int recv = level == 0 ? DPP_MOV_I(send, DPP_HMIRROR) : (level == 1 ? DPP_MOV_I(send, DPP_XOR2) : DPP_MOV_I(send, DPP_XOR1));
    return keep + recv;
}
DI int dot16_i8(const u32x4 r, const u32x4 x) {
    int s = __builtin_amdgcn_sdot4((int)r[0], (int)x[0], 0, false);
    s = __builtin_amdgcn_sdot4((int)r[1], (int)x[1], s, false); s = __builtin_amdgcn_sdot4((int)r[2], (int)x[2], s, false); s = __builtin_amdgcn_sdot4((int)r[3], (int)x[3], s, false);
    return s;
}
DI int half_dots(const u32x4 (&rows)[8], const u32x4 xq, const int lane) {
    int p[8];
#pragma unroll
    for (int i = 0; i < 8; ++i) p[i] = dot16_i8(rows[i], xq);
#pragma unroll
    for (int i = 0; i < 4; ++i) p[i] = comb_c(0, p[2 * i], p[2 * i + 1], lane);
    p[0] = comb_c(1, p[0], p[1], lane); p[1] = comb_c(1, p[2], p[3], lane);
    return comb_c(2, p[0], p[1], lane);
}
DI u32x4 xquant(const f32x4 (&hv)[4], const float rstd) {
    u32x4 o;
#pragma unroll
    for (int w = 0; w < 4; ++w) {
        const f32x4 x = hv[w] * (rstd * XQ);
        const int a = (int)rintf(__builtin_amdgcn_fmed3f(x[0], -127.f, 127.f)), b = (int)rintf(__builtin_amdgcn_fmed3f(x[1], -127.f, 127.f)), c = (int)rintf(__builtin_amdgcn_fmed3f(x[2], -127.f, 127.f)), d = (int)rintf(__builtin_amdgcn_fmed3f(x[3], -127.f, 127.f));
        o[w] = ((unsigned)a & 0xFFu) | (((unsigned)b & 0xFFu) << 8) | (((unsigned)c & 0xFFu) << 16) | ((unsigned)d << 24);
    }
    return o;
}
DI float rstd_bcast(const float* part, const int t) {
    const f32x4* p = (const f32x4*)(part + (size_t)t * 16);
    const f32x4 a = p[0], b = p[1], c = p[2], d = p[3];
    const float s = ((a[0] + a[1]) + (a[2] + a[3])) + ((b[0] + b[1]) + (b[2] + b[3])) + ((c[0] + c[1]) + (c[2] + c[3])) + ((d[0] + d[1]) + (d[2] + d[3]));
    return 1.f / sqrtf(s * (1.f / DM) + EPS);
}
DI int dot32_i4(const u32x4 r, const u32x4 xa, const u32x4 xb) {
    int s = 0;
#pragma unroll
    for (int d = 0; d < 4; ++d) {
        const unsigned lo = (r[d] << 4) & 0xF0F0F0F0u, hi = r[d] & 0xF0F0F0F0u;
        const unsigned x0 = d < 2 ? xa[2 * d] : xb[2 * d - 4], x1 = d < 2 ? xa[2 * d + 1] : xb[2 * d - 3];
        s = __builtin_amdgcn_sdot4((int)lo, (int)x0, s, false); s = __builtin_amdgcn_sdot4((int)hi, (int)x1, s, false);
    }
    return s;
}
DI int half_dots4(const u32x4 (&rows)[8], const u32x4 xa, const u32x4 xb, const int lane) {
    int p[8];
#pragma unroll
    for (int i = 0; i < 8; ++i) p[i] = dot32_i4(rows[i], xa, xb);
#pragma unroll
    for (int i = 0; i < 4; ++i) p[i] = comb_c(0, p[2 * i], p[2 * i + 1], lane);
    p[0] = comb_c(1, p[0], p[1], lane); p[1] = comb_c(1, p[2], p[3], lane);
    return comb_c(2, p[0], p[1], lane);
}
DI void gather_u(Frame& F, const int layer, const XInfo xi, const bool dry) {
    FRAME_IDS;
    const unsigned emask = (dry && PROBE_MODE == 2) ? 15u : ((dry && PROBE_MODE == 5) ? 4095u : 0xFFFFFFFFu);
    const int* eidx = (const int*)(F.ws + WS_EIDX); int* PU = (int*)(F.ws + (dry ? WS_R : WS_PU)); const float* part = (const float*)(F.ws + WS_PART); const bf16* hbp = (const bf16*)(F.ws + WS_XB);
    const int g = f_lane >> 3, c = f_lane & 7, c16 = c * 16;
    const int kst = 16 * g + (((c & 1) << 2) | (c & 2) | ((c & 4) >> 2));
    const int gwl = xi.rank * NWAVES + F.wave, NGWL = xi.nloc * NWAVES;
    LAS unsigned char* wl = F.lds + F.wave * 2048;
    __syncthreads();
    for (int j = xi.xrank; j < 8; j += xi.nx) {
        const int sl = j & 3, th = j >> 2;
        const __amdgpu_buffer_rsrc_t U8 = __builtin_amdgcn_make_buffer_rsrc((void*)(F.ws + WS_U8 + ((size_t)(layer * 4 + sl) * PE) * 128), 0, PE * 128, 0x00020000);
        int tt = gwl;
        if (tt >= T / 2) continue;
#define TOK(x_) (2 * (x_) + th)
#define U_LOAD(tk, ri, rh, rp) do { ri = *(const u32x2*)(eidx + (size_t)(tk) * NSEL + 2 * f_lane) & emask; rh = *(const u32x2*)(hbp + (size_t)(tk) * DM + 256 * sl + 4 * f_lane); \
            rp = part[(size_t)(tk) * 16 + (f_lane & 15)]; } while (0)
#define U_SPREAD(slot, ri, rh, rp, e, xa_, xb_) do { \
            float ps_ = rp; ps_ += __int_as_float(DPP_MOV_I(__float_as_int(ps_), DPP_XOR1)); ps_ += __int_as_float(DPP_MOV_I(__float_as_int(ps_), DPP_XOR2)); ps_ += __int_as_float(DPP_MOV_I(__float_as_int(ps_), DPP_HMIRROR)); ps_ += __int_as_float(DPP_MOV_I(__float_as_int(ps_), DPP_ROR8)); \
            const float rs_ = (1.f / sqrtf(ps_ * (1.f / DM) + EPS)) * XQ; \
            const int q0_ = (int)rintf(__builtin_amdgcn_fmed3f(__uint_as_float(rh[0] << 16) * rs_, -127.f, 127.f)), q1_ = (int)rintf(__builtin_amdgcn_fmed3f(__uint_as_float(rh[0] & 0xffff0000u) * rs_, -127.f, 127.f)); \
            const int q2_ = (int)rintf(__builtin_amdgcn_fmed3f(__uint_as_float(rh[1] << 16) * rs_, -127.f, 127.f)), q3_ = (int)rintf(__builtin_amdgcn_fmed3f(__uint_as_float(rh[1] & 0xffff0000u) * rs_, -127.f, 127.f)); \
            LAS unsigned char* sl_ = wl + (slot) * 1024; \
            *(LAS u32x2*)(sl_ + 8 * f_lane) = ri; *(LAS unsigned*)(sl_ + 512 + 4 * f_lane) = ((unsigned)q0_ & 0xFFu) | (((unsigned)q1_ & 0xFFu) << 8) | (((unsigned)q2_ & 0xFFu) << 16) | ((unsigned)q3_ << 24); \
            asm volatile("s_waitcnt lgkmcnt(0)" ::: "memory"); \
            _Pragma("unroll") for (int q_ = 0; q_ < 4; ++q_) e[q_] = *(const LAS u32x4*)(sl_ + 64 * g + 16 * q_); \
            xa_ = *(const LAS u32x4*)(sl_ + 512 + 32 * c); xb_ = *(const LAS u32x4*)(sl_ + 512 + 32 * c + 16); } while (0)
        u32x2 ri, rh; float rp;
        u32x4 e0[4], e1[4], xa, xb, xa1, xb1;
        U_LOAD(TOK(tt), ri, rh, rp); U_SPREAD(0, ri, rh, rp, e0, xa, xb);
        { const int t1 = (tt + NGWL < T / 2) ? tt + NGWL : tt; U_LOAD(TOK(t1), ri, rh, rp); U_SPREAD(1, ri, rh, rp, e1, xa1, xb1); }
        { const int t2 = (tt + 2 * NGWL < T / 2) ? tt + 2 * NGWL : tt; U_LOAD(TOK(t2), ri, rh, rp); }
        u32x4 A0[8], B0[8], A1[8], B1[8];
#pragma unroll
        for (int i = 0; i < 8; ++i) A0[i] = __builtin_amdgcn_raw_buffer_load_b128(U8, (int)e0[i >> 2][i & 3] * 128 + c16, 0, 0);
#pragma unroll
        for (int i = 0; i < 8; ++i) B0[i] = __builtin_amdgcn_raw_buffer_load_b128(U8, (int)e0[2 + (i >> 2)][i & 3] * 128 + c16, 0, 0);
#define U_ITEM(CA, CB, NA, NB, slot) do { \
            _Pragma("unroll") for (int i = 0; i < 8; ++i) NA[i] = __builtin_amdgcn_raw_buffer_load_b128(U8, (int)e1[i >> 2][i & 3] * 128 + c16, 0, 0); \
            asm volatile("" ::: "memory"); \
            const int r0 = half_dots4(CA, xa, xb, f_lane); \
            _Pragma("unroll") for (int i = 0; i < 8; ++i) NB[i] = __builtin_amdgcn_raw_buffer_load_b128(U8, (int)e1[2 + (i >> 2)][i & 3] * 128 + c16, 0, 0); \
            asm volatile("" ::: "memory"); \
            const int rr1 = half_dots4(CB, xa, xb, f_lane); \
            int* pp = PU + ((size_t)TOK(tt) * 4 + sl) * NSEL + kst; \
            pp[0] = r0; pp[8] = rr1; \
            xa = xa1; xb = xb1; \
            U_SPREAD(slot, ri, rh, rp, e1, xa1, xb1);                   \
            { const int t3 = (tt + 3 * NGWL < T / 2) ? tt + 3 * NGWL : tt; U_LOAD(TOK(t3), ri, rh, rp); } } while (0)
        for (;;) {
            U_ITEM(A0, B0, A1, B1, 0); tt += NGWL; if (tt >= T / 2) break;
            U_ITEM(A1, B1, A0, B0, 1); tt += NGWL; if (tt >= T / 2) break;
        }
#undef U_ITEM
#undef U_LOAD
#undef U_SPREAD
#undef TOK
    }
    __syncthreads();
}
DI void gather_r(Frame& F, const int layer) {
    FRAME_IDS;
    const int* PU = (const int*)(F.ws + WS_PU); const float* gate = (const float*)(F.ws + WS_GATE); const int* eidx = (const int*)(F.ws + WS_EIDX);
    const float* SCu = (const float*)(F.ws + WS_SC) + (size_t)layer * PE; const float* SCv = (const float*)(F.ws + WS_SC) + (size_t)(2 + layer) * PE;
    signed char* A8 = (signed char*)(F.ws + WS_A); float* SA = (float*)(F.ws + WS_SA);
    const int gw = F.bid * NWAVES + F.wave, NGW = F.G * NWAVES;
    for (int t = gw; t < T; t += NGW) {
        float a[2];
#pragma unroll
        for (int hf = 0; hf < 2; ++hf) {
            const int k = 64 * hf + f_lane;
            int sacc = 0;
#pragma unroll
            for (int j = 0; j < 4; ++j) sacc += PU[((size_t)t * 4 + j) * NSEL + k];
            const int e = eidx[(size_t)t * NSEL + k];
            const float d = (float)sacc * (SCu[e] * (1.f / XQ));
            a[hf] = gelu_erf(d) * gate[(size_t)t * NSEL + k] * SCv[e];
        }
        const float am = wave_max(fmaxf(fabsf(a[0]), fabsf(a[1])));
        const float sc = am > 0.f ? 127.f / am : 0.f;
        A8[(size_t)t * NSEL + f_lane] = (signed char)(int)rintf(a[0] * sc);
        A8[(size_t)t * NSEL + 64 + f_lane] = (signed char)(int)rintf(a[1] * sc);
        if (f_lane == 0) SA[t] = am * (1.f / 127.f);
    }
}
DI void tr4x4(const unsigned w0, const unsigned w1, const unsigned w2, const unsigned w3, unsigned (&cdw)[4]) {
    const unsigned t01l = __builtin_amdgcn_perm(w1, w0, 0x05010400u), t01h = __builtin_amdgcn_perm(w1, w0, 0x07030602u);
    const unsigned t23l = __builtin_amdgcn_perm(w3, w2, 0x05010400u), t23h = __builtin_amdgcn_perm(w3, w2, 0x07030602u);
    cdw[0] = __builtin_amdgcn_perm(t23l, t01l, 0x05040100u); cdw[1] = __builtin_amdgcn_perm(t23l, t01l, 0x07060302u);
    cdw[2] = __builtin_amdgcn_perm(t23h, t01h, 0x05040100u); cdw[3] = __builtin_amdgcn_perm(t23h, t01h, 0x07060302u);
}
DI void axpy4rows(const u32x4 r0, const u32x4 r1, const u32x4 r2, const u32x4 r3, const unsigned a4, int (&acc)[16]) {
#pragma unroll
    for (int d = 0; d < 4; ++d) {
        unsigned cdw[4];
        tr4x4(r0[d], r1[d], r2[d], r3[d], cdw);
#pragma unroll
        for (int i = 0; i < 4; ++i) acc[4 * d + i] = __builtin_amdgcn_sdot4((int)cdw[i], (int)a4, acc[4 * d + i], false);
    }
}
DI void gather_v(Frame& F, const int layer, const XInfo xi, const bool dry) {
    FRAME_IDS;
    const int* eidx = (const int*)(F.ws + WS_EIDX); const unsigned char* A8 = F.ws + WS_A; const float* SA = (const float*)(F.ws + WS_SA);
    float* part_w = dry ? (float*)(F.ws + WS_R) : (float*)(F.ws + WS_PART); bf16* hb_w = dry ? (bf16*)(F.ws + WS_HID2) : (bf16*)(F.ws + WS_XB); const bf16* hbp = (const bf16*)(F.ws + WS_XB);
    const int g = f_lane >> 3, c = f_lane & 7, c16 = c * 16;
    const int cc = 16 * c + 8 * (g >> 2) + 4 * ((g >> 1) & 1) + 2 * (g & 1);
    const int gwl = xi.rank * NWAVES + F.wave, NGWL = xi.nloc * NWAVES;
    const bool b3 = (f_lane & 8) != 0;
    LAS unsigned char* wl = F.lds + F.wave * 2048;
    __syncthreads();
    for (int j = xi.xrank; j < 8; j += xi.nx) {
        const __amdgpu_buffer_rsrc_t V8 = __builtin_amdgcn_make_buffer_rsrc((void*)(F.ws + WS_V8 + ((size_t)(layer * 8 + j) * PE) * 128), 0, PE * 128, 0x00020000);
        int t = gwl;
        if (t >= T) continue;
#define V_LOAD(tt, ri, ra, rs) do { ri = *(const u32x2*)(eidx + (size_t)(tt) * NSEL + 2 * f_lane); ra = *(const unsigned short*)(A8 + (size_t)(tt) * NSEL + 2 * f_lane); rs = SA[(tt)]; } while (0)
#define V_SPREAD(slot, ri, ra, rs, e, avv, sav) do { \
            LAS unsigned char* sl_ = wl + (slot) * 1024; \
            *(LAS u32x2*)(sl_ + 8 * f_lane) = ri; *(LAS unsigned short*)(sl_ + 512 + 2 * f_lane) = ra; \
            asm volatile("s_waitcnt lgkmcnt(0)" ::: "memory"); \
            _Pragma("unroll") for (int q_ = 0; q_ < 4; ++q_) e[q_] = *(const LAS u32x4*)(sl_ + 64 * g + 16 * q_); \
            avv = *(const LAS u32x4*)(sl_ + 512 + 16 * g); sav = rs; } while (0)
        u32x2 ri; unsigned short ra; float rs;
        u32x4 e0[4], e1[4], av, a1; float sa, sa1; f32x2 hold;
        V_LOAD(t, ri, ra, rs); V_SPREAD(0, ri, ra, rs, e0, av, sa);
        { const int t1 = (t + NGWL < T) ? t + NGWL : t; V_LOAD(t1, ri, ra, rs); V_SPREAD(1, ri, ra, rs, e1, a1, sa1); }
        { const int t2 = (t + 2 * NGWL < T) ? t + 2 * NGWL : t; V_LOAD(t2, ri, ra, rs); }
        { const unsigned hw_ = *(const unsigned*)(hbp + (size_t)t * DM + 128 * j + cc); hold = (f32x2){__uint_as_float(hw_ << 16), __uint_as_float(hw_ & 0xffff0000u)}; }
        u32x4 A0[8], B0[8], A1[8], B1[8];
#pragma unroll
        for (int i = 0; i < 8; ++i) A0[i] = __builtin_amdgcn_raw_buffer_load_b128(V8, (int)e0[i >> 2][i & 3] * 128 + c16, 0, 0);
#pragma unroll
        for (int i = 0; i < 8; ++i) B0[i] = __builtin_amdgcn_raw_buffer_load_b128(V8, (int)e0[2 + (i >> 2)][i & 3] * 128 + c16, 0, 0);
#define V_ITEM(CA, CB, NA, NB, slot) do { \
            const int t1 = (t + NGWL < T) ? t + NGWL : t; \
            const unsigned hw1_ = *(const unsigned*)(hbp + (size_t)t1 * DM + 128 * j + cc); \
            _Pragma("unroll") for (int i = 0; i < 8; ++i) NA[i] = __builtin_amdgcn_raw_buffer_load_b128(V8, (int)e1[i >> 2][i & 3] * 128 + c16, 0, 0); \
            asm volatile("" ::: "memory"); \
            int acc[16]; \
            _Pragma("unroll") for (int n = 0; n < 16; ++n) acc[n] = 0; \
            axpy4rows(CA[0], CA[1], CA[2], CA[3], av[0], acc); axpy4rows(CA[4], CA[5], CA[6], CA[7], av[1], acc); \
            _Pragma("unroll") for (int i = 0; i < 8; ++i) NB[i] = __builtin_amdgcn_raw_buffer_load_b128(V8, (int)e1[2 + (i >> 2)][i & 3] * 128 + c16, 0, 0); \
            asm volatile("" ::: "memory"); \
            axpy4rows(CB[0], CB[1], CB[2], CB[3], av[2], acc); axpy4rows(CB[4], CB[5], CB[6], CB[7], av[3], acc); \
            int r8[8], r4[4]; float r2[2]; \
            _Pragma("unroll") for (int n = 0; n < 8; ++n) r8[n] = swap32_addi(acc[n], acc[8 + n]); \
            _Pragma("unroll") for (int n = 0; n < 4; ++n) r4[n] = swap16_addi(r8[n], r8[4 + n]); \
            _Pragma("unroll") for (int n = 0; n < 2; ++n) { const int keep = b3 ? r4[2 + n] : r4[n], send = b3 ? r4[n] : r4[2 + n]; r2[n] = (float)(keep + DPP_MOV_I(send, DPP_ROR8)) * sa; } \
            const float h0 = hold[0] + r2[0], h1v = hold[1] + r2[1]; \
            const float ss = wave_sum_fast(h0 * h0 + h1v * h1v); \
            *(unsigned*)(hb_w + (size_t)t * DM + 128 * j + cc) = cvtpk(h0, h1v); \
            if (f_lane == 0) part_w[(size_t)t * 16 + j] = ss; \
            if (j == 0 && f_lane >= 8 && f_lane < 16) part_w[(size_t)t * 16 + f_lane] = 0.f; \
            av = a1; sa = sa1; hold = (f32x2){__uint_as_float(hw1_ << 16), __uint_as_float(hw1_ & 0xffff0000u)}; \
            V_SPREAD(slot, ri, ra, rs, e1, a1, sa1); \
            { const int t3 = (t + 3 * NGWL < T) ? t + 3 * NGWL : t; V_LOAD(t3, ri, ra, rs); } } while (0)
        for (;;) {
            V_ITEM(A0, B0, A1, B1, 0); t += NGWL; if (t >= T) break;
            V_ITEM(A1, B1, A0, B0, 1); t += NGWL; if (t >= T) break;
        }
#undef V_ITEM
#undef V_LOAD
#undef V_SPREAD
    }
    __syncthreads();
}
DI void final_norm(Frame& F) {
    FRAME_IDS;
    const float* part = (const float*)(F.ws + WS_PART); const bf16* hbp = (const bf16*)(F.ws + WS_XB);
    const int gw = F.bid * NWAVES + F.wave, NGW = F.G * NWAVES;
    for (int t = gw; t < T; t += NGW) {
        const float r = rstd_bcast(part, t);
        const u32x2* hp = (const u32x2*)(hbp + (size_t)t * DM) + f_lane;
        f32x4* op = (f32x4*)(F.out + (size_t)t * DM) + f_lane;
        const f32x4* gp = (const f32x4*)F.final_norm + f_lane;
#pragma unroll
        for (int q = 0; q < 4; ++q) { const u32x2 w = hp[64 * q];
            const f32x4 h = {__uint_as_float(w[0] << 16), __uint_as_float(w[0] & 0xffff0000u), __uint_as_float(w[1] << 16), __uint_as_float(w[1] & 0xffff0000u)};
            op[64 * q] = h * r * gp[64 * q]; }
    }
}
DI void opt_conv(Frame& F) {
    FRAME_IDS;
    const bf16* G = (const bf16*)(F.ws + WS_GLU); bf16* H2 = (bf16*)(F.ws + WS_HID2);
    LAS float* ys = (LAS float*)F.lds;
    f32x2 wt[CW];
#pragma unroll
    for (int j = 0; j < CW; ++j) wt[j] = *(const f32x2*)(F.conv_dw + j * DM + 2 * f_tid);
    const f32x2 bdw = *(const f32x2*)(F.conv_dw_b + 2 * f_tid);
    f32x4 lng[4], lnb[4];
#pragma unroll
    for (int k = 0; k < 4; ++k) { lng[k] = *(const f32x4*)(F.conv_ln_g + 256 * k + 4 * f_lane); lnb[k] = *(const f32x4*)(F.conv_ln_b + 256 * k + 4 * f_lane); }
    for (int it = F.bid; it < T / 128; it += F.G) {
        const int s0 = (it % (SEQ / 128)) * 128;
        const size_t row0 = (size_t)it * 128;
        const unsigned* gp = (const unsigned*)G + f_tid;
        f32x2 win[CW];
#pragma unroll
        for (int u = 0; u < CW - 1; ++u) { const int sp = s0 - (CW - 1) + u; const unsigned xv = sp >= 0 ? gp[(row0 - (CW - 1) + u) * 512] : 0u; win[u + 1] = (f32x2){__uint_as_float(xv << 16), __uint_as_float(xv & 0xffff0000u)}; }
        win[0] = (f32x2){0.f, 0.f};
        unsigned nx[CW], nn[CW];
#pragma unroll
        for (int u = 0; u < CW; ++u) nx[u] = (s0 + u < SEQ) ? gp[(row0 + u) * 512] : 0u;
        for (int bt = 0; bt < 5; ++bt) {
#pragma unroll
            for (int u = 0; u < CW; ++u) { const int sl = 31 * (bt + 1) + u; nn[u] = (bt < 4 && s0 + sl < SEQ) ? gp[(row0 + sl) * 512] : 0u; }
            __syncthreads();
#pragma unroll
            for (int u = 0; u < CW; ++u) {
                win[u] = (f32x2){__uint_as_float(nx[u] << 16), __uint_as_float(nx[u] & 0xffff0000u)};
                f32x2 a = bdw;
#pragma unroll
                for (int j = 0; j < CW; ++j) a = wt[j] * win[(u + 1 + j) % CW] + a;
                *(LAS f32x2*)(ys + u * DM + 2 * f_tid) = a;
            }
            __syncthreads();
            for (int u = F.wave; u < CW; u += NWAVES) {
                const int sl = 31 * bt + u;
                if (sl < 128) {
                    f32x4 v[4]; float sm = 0.f;
#pragma unroll
                    for (int k = 0; k < 4; ++k) { v[k] = *(const LAS f32x4*)(ys + u * DM + 256 * k + 4 * f_lane); sm += (v[k][0] + v[k][1]) + (v[k][2] + v[k][3]); }
                    const float mu = wave_sum(sm) * (1.f / DM);
                    float sq = 0.f;
#pragma unroll
                    for (int k = 0; k < 4; ++k) { v[k] = v[k] - mu; sq += (v[k][0] * v[k][0] + v[k][1] * v[k][1]) + (v[k][2] * v[k][2] + v[k][3] * v[k][3]); }
                    const float rs = 1.f / sqrtf(wave_sum(sq) * (1.f / DM) + EPS);
#pragma unroll
                    for (int k = 0; k < 4; ++k) {
                        f32x4 z = v[k] * rs * lng[k] + lnb[k];
#pragma unroll
                        for (int e = 0; e < 4; ++e) z[e] = z[e] / (1.f + __expf(-z[e]));
                        *(u32x2*)(H2 + (row0 + sl) * DM + 256 * k + 4 * f_lane) = (u32x2){cvtpk(z[0], z[1]), cvtpk(z[2], z[3])};
                    }
                }
            }
#pragma unroll
            for (int u = 0; u < CW; ++u) nx[u] = nn[u];
        }
    }
    __syncthreads();
}
enum Phase { PH_PREP = 0, PH_PROJ, PH_MIX, PH_WOUT, PH_Q0, PH_GU0, PH_GR0, PH_GV0, PH_W1, PH_CONV, PH_W2, PH_Q1, PH_GU1, PH_GR1, PH_GV1, PH_FINAL, PH_COUNT };
struct Args { const float* in[19]; float* out; unsigned char* ws; int ph_lo, ph_hi; };
#ifndef TEST_PHASE
#define TEST_PHASE -1
#endif

__global__ void __launch_bounds__(NTHR, 2) mega_fwd(Args args) {
    extern __shared__ __attribute__((aligned(16))) unsigned char lds[];
    Frame F;
    F.lds = (LAS unsigned char*)lds;
    F.wave = __builtin_amdgcn_readfirstlane((int)threadIdx.x >> 6); FRAME_IDS;
    F.G = gridDim.x; F.bid = blockIdx.x;
    F.x = args.in[0]; F.mix_norm = args.in[1]; F.ffn_norm = args.in[2]; F.final_norm = args.in[3]; F.w_in = args.in[4]; F.w_out = args.in[5]; F.rel_bias = args.in[6];
    F.conv_w1 = args.in[7]; F.conv_b1 = args.in[8]; F.conv_dw = args.in[9]; F.conv_dw_b = args.in[10]; F.conv_ln_g = args.in[11]; F.conv_ln_b = args.in[12];
    F.conv_w2 = args.in[13]; F.conv_b2 = args.in[14]; F.peer_wq = args.in[15]; F.peer_keys = args.in[16]; F.peer_u = args.in[17]; F.peer_v = args.in[18];
    F.out = args.out; F.ws = args.ws;
    volatile LAS unsigned* MISC = (volatile LAS unsigned*)(F.lds + MISC_OFF);
    for (int u = f_tid; u < (LDS_BYTES - LDSCTL_OFF) / 4; u += NTHR) ((LAS unsigned*)(F.lds + LDSCTL_OFF))[u] = 0u;
    __syncthreads();
    const int lo = args.ph_lo, hi = args.ph_hi;
    XcdBarrier bar; bar.bar = (unsigned*)(F.ws + WS_CTL) + CW_BAR; bar.x = 0; bar.st = nullptr;
    if (hi - lo > 1) bar = xcd_barrier_post((unsigned*)(F.ws + WS_CTL) + CW_BAR, MISC + 8);
#define IN(k) ((TEST_PHASE < 0 || TEST_PHASE == (k)) && lo <= (k) && (k) < hi)
#define SEAM(k) do { if (IN(k) && IN((k) + 1)) xcd_barrier(bar, F.wave); } while (0)
#define REPS(k) for (int rep_ = ((k) == REP_PHASE ? 0 : 1); rep_ < 2; ++rep_)
#define GEMM_PHASE(EPI, Aptr, Bptr, NN, ...) do { pg8::Gemm g{(const bf16*)(Aptr), (const bf16*)(Bptr), T, (NN), DM}; pg8::StaticOrder S; S.init(T, (NN), F.G, F.bid); \
        pg8::EPI E{__VA_ARGS__}; pg8::gemm_phase<pg8::EPI, pg8::StaticOrder, true, true>(F.lds, g, S, E, F.wave); } while (0)
    bf16* XB = (bf16*)(F.ws + WS_XB);
    float* PART = (float*)(F.ws + WS_PART); const float* ROPE = (const float*)(F.ws + WS_ROPE);
    if (IN(PH_PREP)) REPS(PH_PREP) { p0_prep(F); p0_weights(F); } SEAM(PH_PREP);
    if (PROBE_MODE == 9 && IN(PH_PREP) && IN(PH_PREP + 1)) { for (int xb_ = 0; xb_ < 8; ++xb_) xcd_barrier(bar, F.wave); }
    if (IN(PH_PROJ)) REPS(PH_PROJ) { GEMM_PHASE(EpiProj, XB, F.ws + WS_WIN, INC, (bf16*)(F.ws + WS_R), ROPE); } SEAM(PH_PROJ);
    if (IN(PH_MIX)) REPS(PH_MIX) { mix_phase(F, rep_); } SEAM(PH_MIX);
    if (IN(PH_WOUT)) REPS(PH_WOUT) { GEMM_PHASE(EpiRes, F.ws + WS_O, F.ws + WS_WOUT, DM, F.x, XB, PART, nullptr); } SEAM(PH_WOUT);
    if (IN(PH_Q0)) REPS(PH_Q0) { GEMM_PHASE(EpiQ, XB, F.ws + WS_WQ, DM, (bf16*)(F.ws + WS_Q), PART); asm volatile("s_waitcnt vmcnt(0)" ::: "memory"); __syncthreads(); opt_route(F, 0); } SEAM(PH_Q0);
    const bool census = (hi - lo > 1);
    if (IN(PH_GU0)) REPS(PH_GU0) { gather_u(F, 0, get_xinfo(F, census), rep_ == 0); } SEAM(PH_GU0);
    if (IN(PH_GR0)) REPS(PH_GR0) { gather_r(F, 0); } SEAM(PH_GR0);
    if (IN(PH_GV0)) REPS(PH_GV0) { gather_v(F, 0, get_xinfo(F, census), rep_ == 0); } SEAM(PH_GV0);
    if (IN(PH_W1)) REPS(PH_W1) { GEMM_PHASE(EpiGlu, XB, F.ws + WS_W1, 2 * DM, (bf16*)(F.ws + WS_GLU), PART, F.conv_b1); } SEAM(PH_W1);
    if (IN(PH_CONV)) REPS(PH_CONV) { opt_conv(F); } SEAM(PH_CONV);
    if (IN(PH_W2)) { GEMM_PHASE(EpiRes, F.ws + WS_HID2, F.ws + WS_W2, DM, nullptr, XB, PART, F.conv_b2); } SEAM(PH_W2);
    if (IN(PH_Q1)) REPS(PH_Q1) { GEMM_PHASE(EpiQ, XB, F.ws + WS_WQ + (size_t)DM * DM * 2, DM, (bf16*)(F.ws + WS_Q), PART); asm volatile("s_waitcnt vmcnt(0)" ::: "memory"); __syncthreads(); opt_route(F, 1); } SEAM(PH_Q1);
    if (IN(PH_GU1)) REPS(PH_GU1) { gather_u(F, 1, get_xinfo(F, census), rep_ == 0); } SEAM(PH_GU1);
    if (IN(PH_GR1)) REPS(PH_GR1) { gather_r(F, 1); } SEAM(PH_GR1);
    if (IN(PH_GV1)) REPS(PH_GV1) { gather_v(F, 1, get_xinfo(F, census), rep_ == 0); } SEAM(PH_GV1);
    if (IN(PH_FINAL)) { final_norm(F); }
#undef IN
#undef SEAM
}

extern "C" void kernel_launch(void* const* d_in, const int* in_sizes, int n_in, void* d_out, int out_size, void* d_ws, size_t ws_size, hipStream_t stream) {
    static int grid = 0;
    if (grid == 0) {
        if (n_in != 19 || out_size != T * DM || ws_size < WS_END) { fprintf(stderr, "kernel_launch: unexpected shapes (n_in %d out %d ws %zu)\n", n_in, out_size, ws_size); grid = -1; return; }
        int dev = 0, cus = 0;
        if (hipGetDevice(&dev) != hipSuccess || hipDeviceGetAttribute(&cus, hipDeviceAttributeMultiprocessorCount, dev) != hipSuccess) { grid = -1; return; }
        if (hipFuncSetAttribute((const void*)mega_fwd, hipFuncAttributeMaxDynamicSharedMemorySize, LDS_BYTES) != hipSuccess) { fprintf(stderr, "kernel_launch: hipFuncSetAttribute failed\n"); grid = -1; return; }
        (void)hipGetLastError();
        grid = cus;
    }
    if (grid < 0) return;
    (void)hipMemsetAsync((char*)d_ws + WS_CTL, 0, CTL_ZERO_BYTES, stream);
    Args a{};
    for (int i = 0; i < 19; ++i) a.in[i] = (const float*)d_in[i];
    a.out = (float*)d_out; a.ws = (unsigned char*)d_ws;
#if MK_ONE_LAUNCH
    a.ph_lo = 0; a.ph_hi = PH_COUNT;
    hipLaunchKernelGGL(mega_fwd, dim3(grid), dim3(NTHR), LDS_BYTES, stream, a);
#else
    for (int p = 0; p < PH_COUNT; ++p) { a.ph_lo = p; a.ph_hi = p + 1; hipLaunchKernelGGL(mega_fwd, dim3(grid), dim3(NTHR), LDS_BYTES, stream, a); }
#endif
}
```

```cpp
#include <hip/hip_runtime.h>
#include <cstdio>
#include <cstdint>

#ifndef REP_PHASE
#define REP_PHASE -1
#endif
#ifndef PROBE_MODE
#define PROBE_MODE 1
#endif
#ifndef MK_ONE_LAUNCH
#define MK_ONE_LAUNCH 1
#endif

#define GAS __attribute__((address_space(1)))
#define LAS __attribute__((address_space(3)))
#define DI __device__ __forceinline__
typedef unsigned short bf16;
typedef float f32x2 __attribute__((ext_vector_type(2)));
typedef float f32x4 __attribute__((ext_vector_type(4)));
typedef unsigned u32x2 __attribute__((ext_vector_type(2)));
typedef unsigned u32x4 __attribute__((ext_vector_type(4)));
typedef short bf16x8 __attribute__((ext_vector_type(8)));
typedef float f32x16 __attribute__((ext_vector_type(16)));

constexpr int NB = 16, SEQ = 2048, DM = 1024, T = NB * SEQ;
constexpr int CHUNK = 64, HD = 64, NHA = 8, NHB = 8, INC = 3584, NCH = SEQ / CHUNK;
constexpr int PH = 8, PK = 128, PE = PK * PK, PQD = 128, PTOP = 16, NSEL = PH * PTOP;
constexpr int CW = 31;
constexpr float EPS = 1e-6f;
constexpr float LOG2E = 1.4426950408889634f;
constexpr float XQ = 127.f / 6.f;
constexpr int NWAVES = 8, NTHR = NWAVES * 64;

constexpr int C_QA = 0, C_KA = 512, C_VA = 1024, C_QB = 1536, C_KB = 2048, C_VB = 2560, C_GB = 3072;

constexpr size_t MiB = 1u << 20;
constexpr size_t WS_CTL = 0, CTL_ZERO_BYTES = 1 * MiB;
constexpr size_t WS_WIN = 2 * MiB, WS_WOUT = 9 * MiB, WS_W1 = 11 * MiB, WS_W2 = 15 * MiB, WS_WQ = 17 * MiB;
constexpr size_t WS_ROPE = 22 * MiB;
constexpr size_t WS_PART = 23 * MiB;
constexpr size_t WS_EIDX = 26 * MiB;
constexpr size_t WS_GATE = 42 * MiB;
constexpr size_t WS_U8 = 64 * MiB, WS_V8 = 96 * MiB;
constexpr size_t WS_SC = 25 * MiB;
constexpr size_t WS_SA = 58 * MiB;
constexpr size_t WS_PU = 256 * MiB;
constexpr size_t WS_A = 384 * MiB;
constexpr size_t WS_XB = 128 * MiB;
constexpr size_t WS_R = 192 * MiB;
constexpr size_t WS_O = 416 * MiB;
constexpr size_t WS_Q = 192 * MiB;
constexpr size_t WS_HID = 256 * MiB;
constexpr size_t WS_GLU = 384 * MiB;
constexpr size_t WS_HID2 = 448 * MiB;
constexpr size_t WS_END = 512 * MiB;
constexpr int CW_BAR = 4096, CW_QUEUE = 8192;

constexpr int RING_BYTES = 131072, LDSCTL_OFF = RING_BYTES, MISC_OFF = LDSCTL_OFF + 320, LDS_BYTES = 147456;

DI float bf2f(bf16 v) { return __uint_as_float(((unsigned)v) << 16); }
DI unsigned f2bf(float f) { unsigned u = __float_as_uint(f); return (u + 0x7fffu + ((u >> 16) & 1u)) >> 16; }
DI unsigned pk2(float lo, float hi) { return f2bf(lo) | (f2bf(hi) << 16); }
#define DPP_MOV_I(x, ctrl) __builtin_amdgcn_mov_dpp((x), (ctrl), 0xF, 0xF, false)
#define DPP_XOR1 0xB1
#define DPP_XOR2 0x4E
#define DPP_HMIRROR 0x141
#define DPP_ROR8 0x128
DI float swap32_add(const float a, const float b) { const auto r = __builtin_amdgcn_permlane32_swap(__float_as_uint(a), __float_as_uint(b), false, false); return __uint_as_float(r[0]) + __uint_as_float(r[1]); }
DI float swap16_add(const float a, const float b) { const auto r = __builtin_amdgcn_permlane16_swap(__float_as_uint(a), __float_as_uint(b), false, false); return __uint_as_float(r[0]) + __uint_as_float(r[1]); }
DI int swap32_addi(const int a, const int b) { const auto r = __builtin_amdgcn_permlane32_swap((unsigned)a, (unsigned)b, false, false); return (int)(r[0] + r[1]); }
DI int swap16_addi(const int a, const int b) { const auto r = __builtin_amdgcn_permlane16_swap((unsigned)a, (unsigned)b, false, false); return (int)(r[0] + r[1]); }
DI float wave_sum_fast(float v) {
    v += __int_as_float(DPP_MOV_I(__float_as_int(v), DPP_XOR1)); v += __int_as_float(DPP_MOV_I(__float_as_int(v), DPP_XOR2));
    v += __int_as_float(DPP_MOV_I(__float_as_int(v), DPP_HMIRROR)); v += __int_as_float(DPP_MOV_I(__float_as_int(v), DPP_ROR8));
    v = swap16_add(v, v); v = swap32_add(v, v);
    return v;
}
DI float wave_sum(float v) { return wave_sum_fast(v); }
DI float swap32_max(const float a) { const auto r = __builtin_amdgcn_permlane32_swap(__float_as_uint(a), __float_as_uint(a), false, false); return fmaxf(__uint_as_float(r[0]), __uint_as_float(r[1])); }
DI float swap16_max(const float a) { const auto r = __builtin_amdgcn_permlane16_swap(__float_as_uint(a), __float_as_uint(a), false, false); return fmaxf(__uint_as_float(r[0]), __uint_as_float(r[1])); }
DI float wave_max(float v) {
    v = fmaxf(v, __int_as_float(DPP_MOV_I(__float_as_int(v), DPP_XOR1))); v = fmaxf(v, __int_as_float(DPP_MOV_I(__float_as_int(v), DPP_XOR2)));
    v = fmaxf(v, __int_as_float(DPP_MOV_I(__float_as_int(v), DPP_HMIRROR))); v = fmaxf(v, __int_as_float(DPP_MOV_I(__float_as_int(v), DPP_ROR8)));
    v = swap16_max(v); v = swap32_max(v);
    return v;
}
DI float block_sum(float v, LAS float* red, int tid) {
    v = wave_sum(v);
    __syncthreads();
    if ((tid & 63) == 0) red[tid >> 6] = v;
    __syncthreads();
    float s = 0.f;
#pragma unroll
    for (int i = 0; i < NWAVES; ++i) s += red[i];
    return s;
}
DI float gelu_erf(float x) { return 0.5f * x * (1.f + erff(x * 0.70710678118654752f)); }
DI float sigmoidf(float x) { return 1.f / (1.f + __expf(-x)); }

DI int lane_id() { int r; asm volatile("v_mbcnt_lo_u32_b32 %0, -1, 0\n\tv_mbcnt_hi_u32_b32 %0, -1, %0" : "=v"(r)); return r; }
#define XB_TMO      128
#define XB_XCNT(j)  (256  + 64 * (j))
#define XB_XSUB(j)  (1280 + 64 * (j))
#define XB_XGEN(j)  (2304 + 64 * (j))
#define XB_TOP      3328
#define XB_TOPGEN   3392
#define XCD_BAR_WORDS 3456
#define XB_SPIN_CAP (1u << 22)
DI unsigned xb_ld(unsigned* p)              { return __hip_atomic_load(p, __ATOMIC_RELAXED, __HIP_MEMORY_SCOPE_AGENT); }
DI unsigned xb_add(unsigned* p, unsigned v) { return __hip_atomic_fetch_add(p, v, __ATOMIC_RELAXED, __HIP_MEMORY_SCOPE_AGENT); }
DI unsigned xb_xcc_id() { return (unsigned)__builtin_amdgcn_s_getreg((3 << 11) | 20) & 0xFu; }
#define XB_SPIN(cond, bar) do { unsigned _sp = 0; while (cond) { __builtin_amdgcn_s_sleep(1); \
    if ((++_sp & 255u) == 0u) { if (xb_ld(&(bar)[XB_TMO])) break; if (_sp > XB_SPIN_CAP) { atomicAdd(&(bar)[XB_TMO], 1u); break; } } } } while (0)
struct XcdBarrier { unsigned* bar; unsigned x; volatile LAS unsigned* st; };
DI XcdBarrier xcd_barrier_post(unsigned* bar, volatile LAS unsigned* st) {
    XcdBarrier b; b.bar = bar; b.x = xb_xcc_id(); b.st = st;
    if (threadIdx.x == 0) st[4] = xb_add(&bar[XB_XCNT(b.x)], 1u);
    return b;
}
DI void xcd_barrier_complete(unsigned* bar, unsigned x, unsigned& nloc, unsigned& nx) {
    const unsigned G = gridDim.x * gridDim.y * gridDim.z;
    unsigned sum, cnt, mine, sp = 0u;
    for (;;) {
        sum = 0u; cnt = 0u; mine = 0u;
#pragma unroll
        for (unsigned j = 0; j < 16; ++j) { const unsigned c = xb_ld(&bar[XB_XCNT(j)]); sum += c; cnt += (c > 0u) ? 1u : 0u; mine = (j == x) ? c : mine; }
        if (sum == G) break;
        __builtin_amdgcn_s_sleep(1);
        if ((++sp & 255u) == 0u) { if (xb_ld(&bar[XB_TMO])) break; if (sp > XB_SPIN_CAP) { atomicAdd(&bar[XB_TMO], 1u); break; } }
    }
    nloc = mine > 0u ? mine : 1u; nx = cnt > 0u ? cnt : 1u;
}
DI void xcd_barrier(const XcdBarrier& b, const int wave_id) {
    asm volatile("s_waitcnt vmcnt(0)" ::: "memory");
    __syncthreads();
    if (wave_id == 0 && lane_id() == 0) {
        unsigned* bar = b.bar;
        __builtin_amdgcn_s_waitcnt(0);
        unsigned nloc = b.st[0], nx = b.st[1];
        if (nloc == 0u) { xcd_barrier_complete(bar, b.x, nloc, nx); b.st[0] = nloc; b.st[1] = nx; }
        const unsigned old = xb_add(&bar[XB_XSUB(b.x)], 1u);
        const unsigned gen = old / nloc;
        if (old + 1u == (gen + 1u) * nloc) {
            __builtin_amdgcn_fence(__ATOMIC_RELEASE, "agent");
            asm volatile("s_waitcnt vmcnt(0)" ::: "memory");
            const unsigned og = xb_add(&bar[XB_TOP], 1u);
            const unsigned tg = og / nx;
            if (og + 1u == (tg + 1u) * nx) xb_add(&bar[XB_TOPGEN], 1u);
            else XB_SPIN(xb_ld(&bar[XB_TOPGEN]) == tg, bar);
            __builtin_amdgcn_fence(__ATOMIC_ACQUIRE, "agent");
            xb_add(&bar[XB_XGEN(b.x)], 1u);
            asm volatile("s_waitcnt vmcnt(0)" ::: "memory");
        } else {
            XB_SPIN(xb_ld(&bar[XB_XGEN(b.x)]) == gen, bar);
            __builtin_amdgcn_fence(__ATOMIC_ACQUIRE, "agent");
            asm volatile("s_waitcnt vmcnt(0)" ::: "memory");
        }
    }
    __syncthreads();
}

namespace pg8 {
#define PG8_LAS __attribute__((address_space(3)))
typedef unsigned short bf16_t;
typedef short bf16x8 __attribute__((ext_vector_type(8)));
typedef float f32x4 __attribute__((ext_vector_type(4)));
typedef unsigned u32x4 __attribute__((ext_vector_type(4)));
constexpr int BM = 256, BK = 64, HALF = 128, HTB = HALF * BK * 2  , STAGE_BYTES = 8 * HTB, NXCD = 8, WGM = 8;

__host__ __device__ __forceinline__ int lds_byte(int r, int c) { const int st = (r >> 4) * 2 + (c >> 5), rr = r & 15, cc = c & 31, ob = rr * 64 + cc * 2; return st * 1024 + (ob ^ (((ob >> 9) & 1) << 5)); }
__host__ __device__ __forceinline__ void stage_rc(int b, int& R, int& C) { const int st = b / 1024, sb = b % 1024, swz = sb ^ (((sb >> 9) & 1) << 5); R = (st >> 1) * 16 + swz / 64; C = (st & 1) * 32 + (swz % 64) / 2; }
__host__ __device__ __forceinline__ int perm32(int rho) { const int n = rho >> 4, i = rho & 15; return 8 * (i >> 2) + 4 * n + (i & 3); }

struct Unit { int pm, pn; };
struct Gemm { const bf16_t* A; const bf16_t* Bt; int M, N, K; };

struct StaticOrder {
    int nM, nN, nwg, G, c;
    __host__ __device__ void init(int M, int N, int G_, int c_) { nM = M / BM; nN = N / BM; nwg = nM * nN; G = G_; c = c_; }
    __host__ __device__ bool next(int i, Unit& u) const {
        const long L = (long)i * G + c; if (L >= nwg) return false;
        int wgid = (int)L; { const int q = nwg / NXCD, r = nwg % NXCD, xcd = wgid % NXCD, off = wgid / NXCD; wgid = (xcd < r ? xcd * (q + 1) : r * (q + 1) + (xcd - r) * q) + off; }
        const int nig = WGM * nN, gid = wgid / nig, fm = gid * WGM, gsz = (nM - fm) < WGM ? (nM - fm) : WGM;
        u.pm = fm + ((wgid % nig) % gsz); u.pn = (wgid % nig) / gsz; return true;
    }
    __device__ __forceinline__ void a_ready(const Unit&) const {}
    __device__ __forceinline__ void done(const Unit&) const {}
};

__device__ __forceinline__ unsigned cvt_pk_bf16(float lo, float hi) { unsigned r; asm volatile("v_cvt_pk_bf16_f32 %0, %1, %2" : "=v"(r) : "v"(lo), "v"(hi)); return r; }
__device__ __forceinline__ float rstd16(const float* part, int r, int fq) {
    const f32x4 a = *(const f32x4*)(part + (size_t)r * 16 + 4 * fq);
    float s = (a[0] + a[1]) + (a[2] + a[3]);
    s = swap16_add(s, s); s = swap32_add(s, s);
    return 1.f / sqrtf(s * (1.f / 1024.f) + 1e-6f);
}
__device__ __forceinline__ u32x4 pack8(const f32x4 a, const f32x4 b) { u32x4 w; w.x = cvt_pk_bf16(a[0], a[1]); w.y = cvt_pk_bf16(a[2], a[3]); w.z = cvt_pk_bf16(b[0], b[1]); w.w = cvt_pk_bf16(b[2], b[3]); return w; }
#define rot(t1, t2, c, s) do { const float a_ = (t1) * (c) - (t2) * (s), b_ = (t1) * (s) + (t2) * (c); (t1) = a_; (t2) = b_; } while (0)

struct EpiProj {
    static constexpr bool PERM = true, AFTER_DRAIN = false;
    bf16_t* R; const float* rope;
    __device__ __forceinline__ void operator()(const f32x4 (&acc)[2][2][4][2], const Unit& u, int wr, int wc, int fr, int fq) const {
        const int type = u.pn >> 1, hg = u.pn & 1;
        const int colbase = type * 512 + (4 * hg + wc) * 64 + 8 * fq;
        const bool do_rope = (type == 3) || (type == 4);
#pragma unroll
        for (int ai = 0; ai < 2; ++ai)
#pragma unroll
            for (int m = 0; m < 4; ++m) {
                const int r = u.pm * BM + ai * HALF + wr * 64 + m * 16 + fr;
                f32x4 a0 = acc[ai][0][m][0], a1 = acc[ai][0][m][1], b0 = acc[ai][1][m][0], b1 = acc[ai][1][m][1];
                if (do_rope) {
                    const f32x4* rp = (const f32x4*)(rope + ((size_t)(r & 2047) * 32 + 8 * fq) * 2);
                    const f32x4 c0 = rp[0], c1 = rp[1], c2 = rp[2], c3 = rp[3];
                    rot(a0[0], b0[0], c0[0], c0[1]); rot(a0[1], b0[1], c0[2], c0[3]); rot(a0[2], b0[2], c1[0], c1[1]); rot(a0[3], b0[3], c1[2], c1[3]);
                    rot(a1[0], b1[0], c2[0], c2[1]); rot(a1[1], b1[1], c2[2], c2[3]); rot(a1[2], b1[2], c3[0], c3[1]); rot(a1[3], b1[3], c3[2], c3[3]);
                }
                bf16_t* rowp = R + (size_t)r * 3584 + colbase;
                *(u32x4*)(rowp) = pack8(a0, a1);
                *(u32x4*)(rowp + 32) = pack8(b0, b1);
            }
    }
};
struct EpiRes {
    static constexpr bool PERM = true, AFTER_DRAIN = false;
    const float* xf; bf16_t* hb; float* part; const float* bias;
    __device__ __forceinline__ void operator()(const f32x4 (&acc)[2][2][4][2], const Unit& u, int wr, int wc, int fr, int fq) const {
        const int col0 = u.pn * BM + wc * 32 + 8 * fq;
        f32x4 bv[2][2];
#pragma unroll
        for (int bj = 0; bj < 2; ++bj)
#pragma unroll
            for (int n = 0; n < 2; ++n) bv[bj][n] = bias ? *(const f32x4*)(bias + col0 + bj * HALF + 4 * n) : (f32x4){0.f, 0.f, 0.f, 0.f};
#pragma unroll
        for (int ai = 0; ai < 2; ++ai)
#pragma unroll
            for (int m = 0; m < 4; ++m) {
                const int r = u.pm * BM + ai * HALF + wr * 64 + m * 16 + fr;
                const size_t off = (size_t)r * 1024 + col0;
                float ss = 0.f;
#pragma unroll
                for (int bj = 0; bj < 2; ++bj) {
                    f32x4 x0, x1;
                    if (xf) { x0 = *(const f32x4*)(xf + off + bj * HALF); x1 = *(const f32x4*)(xf + off + bj * HALF + 4); }
                    else { const u32x4 w = *(const u32x4*)(hb + off + bj * HALF);
                           x0 = (f32x4){__uint_as_float(w[0] << 16), __uint_as_float(w[0] & 0xffff0000u), __uint_as_float(w[1] << 16), __uint_as_float(w[1] & 0xffff0000u)};
                           x1 = (f32x4){__uint_as_float(w[2] << 16), __uint_as_float(w[2] & 0xffff0000u), __uint_as_float(w[3] << 16), __uint_as_float(w[3] & 0xffff0000u)}; }
                    const f32x4 h0 = x0 + acc[ai][bj][m][0] + bv[bj][0], h1 = x1 + acc[ai][bj][m][1] + bv[bj][1];
                    *(u32x4*)(hb + off + bj * HALF) = pack8(h0, h1);
                    ss += (h0[0] * h0[0] + h0[1] * h0[1]) + (h0[2] * h0[2] + h0[3] * h0[3]) + (h1[0] * h1[0] + h1[1] * h1[1]) + (h1[2] * h1[2] + h1[3] * h1[3]);
                }
                ss = swap16_add(ss, ss); ss = swap32_add(ss, ss);
                if (fq == 0) part[(size_t)r * 16 + 4 * u.pn + wc] = ss;
            }
    }
};
struct EpiQ {
    static constexpr bool PERM = true, AFTER_DRAIN = false;
    bf16_t* O; const float* part;
    __device__ __forceinline__ void operator()(const f32x4 (&acc)[2][2][4][2], const Unit& u, int wr, int wc, int fr, int fq) const {
        const int col0 = u.pn * BM + wc * 32 + 8 * fq;
#pragma unroll
        for (int ai = 0; ai < 2; ++ai)
#pragma unroll
            for (int m = 0; m < 4; ++m) {
                const int r = u.pm * BM + ai * HALF + wr * 64 + m * 16 + fr;
                const float rs = rstd16(part, r, fq);
                bf16_t* rowp = O + (size_t)r * 1024 + col0;
#pragma unroll
                for (int bj = 0; bj < 2; ++bj) *(u32x4*)(rowp + bj * HALF) = pack8(acc[ai][bj][m][0] * rs, acc[ai][bj][m][1] * rs);
            }
    }
};
struct EpiGlu {
    static constexpr bool PERM = true, AFTER_DRAIN = false;
    bf16_t* G; const float* part; const float* b1;
    __device__ __forceinline__ void operator()(const f32x4 (&acc)[2][2][4][2], const Unit& u, int wr, int wc, int fr, int fq) const {
        const int col = u.pn * 128 + wc * 32 + 8 * fq;
        f32x4 ba[2], bg[2];
#pragma unroll
        for (int n = 0; n < 2; ++n) { ba[n] = *(const f32x4*)(b1 + col + 4 * n); bg[n] = *(const f32x4*)(b1 + 1024 + col + 4 * n); }
#pragma unroll
        for (int ai = 0; ai < 2; ++ai)
#pragma unroll
            for (int m = 0; m < 4; ++m) {
                const int r = u.pm * BM + ai * HALF + wr * 64 + m * 16 + fr;
                const float rs = rstd16(part, r, fq);
                f32x4 y[2];
#pragma unroll
                for (int n = 0; n < 2; ++n) {
                    const f32x4 a = acc[ai][0][m][n] * rs + ba[n], g = acc[ai][1][m][n] * rs + bg[n];
#pragma unroll
                    for (int i = 0; i < 4; ++i) y[n][i] = a[i] / (1.f + __expf(-g[i]));
                }
                *(u32x4*)(G + (size_t)r * 1024 + col) = pack8(y[0], y[1]);
            }
    }
};
template <class Epi, class Sched, bool ALIGN_EPI = false, bool SP2 = false>
__device__ __forceinline__ void gemm_phase(PG8_LAS unsigned char* lds, const Gemm g, const Sched& S, const Epi& E, const int wave_id) {
    const int lane = lane_id(), wid = wave_id, tid = wid * 64 + lane, wr = wid >> 2, wc = wid & 3, fr = lane & 15, fq = lane >> 4;
    const int K = g.K, nt = K / BK;
    unsigned voffA[2], voffB[2];
#pragma unroll
    for (int i = 0; i < 2; ++i) { int R, C; stage_rc(tid * 16 + i * 8192, R, C); const int Rb = Epi::PERM ? ((R & ~31) + perm32(R & 31)) : R;
        voffA[i] = (unsigned)(R * K + C) * 2u; voffB[i] = (unsigned)(Rb * K + C) * 2u; }
    const size_t kstep = (size_t)(BK * 2);
    const size_t hstep = (size_t)HALF * K * 2;
    const size_t tstep = 2 * hstep;
    const unsigned ldsw = (unsigned)wid * 1024u;
    const int aoff = lds_byte(wr * 64 + fr, fq * 8), boff = lds_byte(wc * 32 + fr, fq * 8);
#define PG8_SA(b, h) (((b) * 2 + (h)) * HTB)
#define PG8_SB(b, h) ((4 + (b) * 2 + (h)) * HTB)
#define PG8_STAGE(bufoff, gbase, voff) do { _Pragma("unroll") for (int _i = 0; _i < 2; ++_i) \
        __builtin_amdgcn_global_load_lds((const unsigned*)((const char*)(gbase) + (voff)[_i]), (PG8_LAS unsigned*)(lds + (bufoff) + ldsw + _i * 8192), 16, 0, 0); } while (0)
#define PG8_LDA(dst, b, h) do { _Pragma("unroll") for (int m = 0; m < 4; ++m) _Pragma("unroll") for (int k = 0; k < 2; ++k) dst[m][k] = *(const PG8_LAS bf16x8*)(lds + PG8_SA(b, h) + aoff + m * 2048 + k * 1024); } while (0)
#define PG8_LDB(dst, b, h) do { _Pragma("unroll") for (int n = 0; n < 2; ++n) _Pragma("unroll") for (int k = 0; k < 2; ++k) dst[n][k] = *(const PG8_LAS bf16x8*)(lds + PG8_SB(b, h) + boff + n * 2048 + k * 1024); } while (0)
#define PG8_MMA(ai, bj, At, Bt) do { __builtin_amdgcn_s_setprio(1); _Pragma("unroll") for (int m = 0; m < 4; ++m) _Pragma("unroll") for (int n = 0; n < 2; ++n) _Pragma("unroll") for (int k = 0; k < 2; ++k) \
        acc[ai][bj][m][n] = __builtin_amdgcn_mfma_f32_16x16x32_bf16(Bt[n][k], At[m][k], acc[ai][bj][m][n], 0, 0, 0); __builtin_amdgcn_s_setprio(0); } while (0)
#define PG8_WAIT_V(n) asm volatile("s_waitcnt vmcnt(" #n ")" ::: "memory")
#define PG8_WAIT_L(n) asm volatile("s_waitcnt lgkmcnt(" #n ")" ::: "memory")
#define PG8_BAR __builtin_amdgcn_s_barrier()
#define PG8_SCHED __builtin_amdgcn_sched_barrier(0)
    Unit cur, nxt; int ui = 0;
    if (!S.next(0, cur)) return;
    f32x4 acc[2][2][4][2];
#pragma unroll
    for (int a = 0; a < 2; ++a)
#pragma unroll
        for (int b = 0; b < 2; ++b)
#pragma unroll
            for (int m = 0; m < 4; ++m)
#pragma unroll
                for (int n = 0; n < 2; ++n) acc[a][b][m][n] = (f32x4){0.f, 0.f, 0.f, 0.f};
    bf16x8 At[4][2], B0[2][2], B1[2][2];
    const char* cA = (const char*)g.A + (size_t)cur.pm * tstep; const char* cB = (const char*)g.Bt + (size_t)cur.pn * tstep;
    S.a_ready(cur);
    if constexpr (SP2) {
        PG8_STAGE(PG8_SB(0, 0), cB, voffB); PG8_STAGE(PG8_SB(0, 1), cB + hstep, voffB); PG8_STAGE(PG8_SA(0, 0), cA, voffA); PG8_STAGE(PG8_SA(0, 1), cA + hstep, voffA);
        if (wr == 1) PG8_BAR;
        PG8_WAIT_V(2); PG8_BAR;
        PG8_STAGE(PG8_SB(1, 0), cB + kstep, voffB); PG8_STAGE(PG8_SA(1, 0), cA + kstep, voffA); PG8_STAGE(PG8_SB(1, 1), cB + hstep + kstep, voffB);
        PG8_WAIT_V(6); PG8_BAR;
    } else {
        PG8_STAGE(PG8_SB(0, 0), cB, voffB); PG8_STAGE(PG8_SA(0, 0), cA, voffA); PG8_STAGE(PG8_SB(0, 1), cB + hstep, voffB); PG8_STAGE(PG8_SA(0, 1), cA + hstep, voffA);
        if (wr == 1) PG8_BAR;
        PG8_WAIT_V(4); PG8_BAR;
        PG8_STAGE(PG8_SB(1, 0), cB + kstep, voffB); PG8_STAGE(PG8_SA(1, 0), cA + kstep, voffA); PG8_STAGE(PG8_SB(1, 1), cB + hstep + kstep, voffB);
        PG8_WAIT_V(6); PG8_BAR;
    }
    for (;;) {
        const bool has_next = S.next(ui + 1, nxt);
        const char* nA = has_next ? (const char*)g.A + (size_t)nxt.pm * tstep : cA; const char* nB = has_next ? (const char*)g.Bt + (size_t)nxt.pn * tstep : cB;
        for (int t = 0; t < nt; t += 2) {
            const bool last = (t == nt - 2);
            const char* a1 = cA + (size_t)(t + 1) * kstep;
            const char* a2 = last ? nA : cA + (size_t)(t + 2) * kstep; const char* b2 = last ? nB : cB + (size_t)(t + 2) * kstep;
            const char* a3 = a2 + kstep; const char* b3 = b2 + kstep;
            if (last && has_next) S.a_ready(nxt);
            if constexpr (SP2) {
            PG8_LDB(B0, 0, 0); PG8_LDB(B1, 0, 1); PG8_SCHED; PG8_LDA(At, 0, 0); PG8_STAGE(PG8_SA(1, 1), a1 + hstep, voffA);
            PG8_WAIT_V(8); PG8_WAIT_L(0); PG8_BAR; PG8_MMA(0, 0, At, B0); PG8_MMA(0, 1, At, B1); PG8_BAR; PG8_SCHED;
            PG8_LDA(At, 0, 1); PG8_STAGE(PG8_SB(0, 0), b2, voffB); PG8_STAGE(PG8_SB(0, 1), b2 + hstep, voffB); PG8_STAGE(PG8_SA(0, 0), a2, voffA);
            PG8_WAIT_V(8); PG8_WAIT_L(0); PG8_BAR; PG8_MMA(1, 0, At, B0); PG8_MMA(1, 1, At, B1); PG8_BAR; PG8_SCHED;
            PG8_LDB(B0, 1, 0); PG8_LDB(B1, 1, 1); PG8_SCHED; PG8_LDA(At, 1, 0); PG8_STAGE(PG8_SA(0, 1), a2 + hstep, voffA);
            PG8_WAIT_V(8); PG8_WAIT_L(0); PG8_BAR; PG8_MMA(0, 0, At, B0); PG8_MMA(0, 1, At, B1); PG8_BAR; PG8_SCHED;
            PG8_LDA(At, 1, 1); PG8_STAGE(PG8_SB(1, 0), b3, voffB); PG8_STAGE(PG8_SB(1, 1), b3 + hstep, voffB); PG8_STAGE(PG8_SA(1, 0), a3, voffA);
            PG8_WAIT_V(8); PG8_WAIT_L(0); PG8_BAR; PG8_MMA(1, 0, At, B0); PG8_MMA(1, 1, At, B1); PG8_BAR; PG8_SCHED;
            } else {
            PG8_LDB(B0, 0, 0); PG8_SCHED; PG8_LDA(At, 0, 0); PG8_STAGE(PG8_SA(1, 1), a1 + hstep, voffA);
            PG8_WAIT_L(8); PG8_BAR; PG8_WAIT_L(0); PG8_MMA(0, 0, At, B0); PG8_BAR; PG8_SCHED;
            PG8_LDB(B1, 0, 1); PG8_STAGE(PG8_SB(0, 0), b2, voffB);
            PG8_BAR; PG8_WAIT_L(0); PG8_MMA(0, 1, At, B1); PG8_BAR;
            PG8_LDA(At, 0, 1); PG8_STAGE(PG8_SA(0, 0), a2, voffA);
            PG8_BAR; PG8_WAIT_L(0); PG8_MMA(1, 0, At, B0); PG8_BAR; PG8_SCHED;
            PG8_STAGE(PG8_SB(0, 1), b2 + hstep, voffB);
            PG8_WAIT_V(6); PG8_BAR; PG8_MMA(1, 1, At, B1); PG8_BAR;
            PG8_LDB(B0, 1, 0); PG8_SCHED; PG8_LDA(At, 1, 0); PG8_STAGE(PG8_SA(0, 1), a2 + hstep, voffA);
            PG8_WAIT_L(8); PG8_BAR; PG8_WAIT_L(0); PG8_MMA(0, 0, At, B0); PG8_BAR; PG8_SCHED;
            PG8_LDB(B1, 1, 1); PG8_STAGE(PG8_SB(1, 0), b3, voffB);
            PG8_BAR; PG8_WAIT_L(0); PG8_MMA(0, 1, At, B1); PG8_BAR;
            PG8_LDA(At, 1, 1); PG8_STAGE(PG8_SA(1, 0), a3, voffA);
            PG8_BAR; PG8_WAIT_L(0); PG8_MMA(1, 0, At, B0); PG8_BAR; PG8_SCHED;
            PG8_STAGE(PG8_SB(1, 1), b3 + hstep, voffB);
            PG8_WAIT_V(6); PG8_BAR; PG8_MMA(1, 1, At, B1); PG8_BAR;
            }
        }
        if constexpr (ALIGN_EPI) { if (wr == 0) PG8_BAR; }
        if constexpr (!Epi::AFTER_DRAIN) { E(acc, cur, wr, wc, fr, fq); S.done(cur); }
        if (!has_next) break;
#pragma unroll
        for (int a = 0; a < 2; ++a)
#pragma unroll
            for (int b = 0; b < 2; ++b)
#pragma unroll
                for (int m = 0; m < 4; ++m)
#pragma unroll
                    for (int n = 0; n < 2; ++n) acc[a][b][m][n] = (f32x4){0.f, 0.f, 0.f, 0.f};
        cur = nxt; cA = nA; cB = nB; ++ui;
        if constexpr (ALIGN_EPI) { if (wr == 1) PG8_BAR; }
    }
    PG8_WAIT_V(0);
    if constexpr (!ALIGN_EPI) { if (wr == 0) PG8_BAR; }
    PG8_BAR;
    if constexpr (Epi::AFTER_DRAIN) { E.fused(acc, cur, wr, wc, fr, fq, lds, wid, lane); S.done(cur); }
#undef PG8_SA
#undef PG8_SB
#undef PG8_STAGE
#undef PG8_LDA
#undef PG8_LDB
#undef PG8_MMA
#undef PG8_WAIT_V
#undef PG8_WAIT_L
#undef PG8_BAR
#undef PG8_SCHED
}
}

struct Frame {
    LAS unsigned char* lds;
    int wave, G, bid;
    const float *x, *mix_norm, *ffn_norm, *final_norm, *w_in, *w_out, *rel_bias, *conv_w1, *conv_b1, *conv_dw, *conv_dw_b, *conv_ln_g, *conv_ln_b, *conv_w2, *conv_b2,
        *peer_wq, *peer_keys, *peer_u, *peer_v;
    float* out;
    unsigned char* ws;
};
#define FRAME_IDS const int f_lane = lane_id(); const int f_tid = F.wave * 64 + f_lane; (void)f_tid
DI float gamma_of(int h) { return 1.f - exp2f(-5.f - (float)h); }

DI void p0_prep(Frame& F) {
    FRAME_IDS;
    const int gw = F.bid * NWAVES + F.wave, NGW = F.G * NWAVES;
    f32x2* rope = (f32x2*)(F.ws + WS_ROPE);
    for (int i = F.bid * NTHR + f_tid; i < SEQ * 32; i += F.G * NTHR) {
        const int s = i >> 5, j = i & 31;
        const float inv = powf(10000.f, -(float)j / 32.f);
        const float ang = (float)s * inv;
        float sn, cs; sincosf(ang, &sn, &cs);
        rope[i] = (f32x2){cs, sn};
    }
    bf16* xb = (bf16*)(F.ws + WS_XB);
    for (int m = gw; m < T; m += NGW) {
        const f32x4* xr = (const f32x4*)(F.x + (size_t)m * DM) + f_lane;
        u32x2* o = (u32x2*)(xb + (size_t)m * DM) + f_lane;
        f32x4 v[4]; float s = 0.f;
#pragma unroll
        for (int j = 0; j < 4; ++j) { v[j] = xr[64 * j]; s += v[j].x * v[j].x + v[j].y * v[j].y + v[j].z * v[j].z + v[j].w * v[j].w; }
        const float r = 1.f / sqrtf(wave_sum(s) * (1.f / DM) + EPS);
#pragma unroll
        for (int j = 0; j < 4; ++j) o[64 * j] = (u32x2){pk2(v[j].x * r, v[j].y * r), pk2(v[j].z * r, v[j].w * r)};
    }
}
DI void p0_transpose_item(const float* W, int K, int N, bf16* WT, int prow0, const float* gain, float scale, LAS float* scr, int k0, int n0, int lane) {
#pragma unroll 8
    for (int i = 0; i < 32; ++i) { const int kk = 2 * i + (lane >> 5); scr[kk * 33 + (lane & 31)] = W[(size_t)(k0 + kk) * N + n0 + (lane & 31)] * (gain ? gain[k0 + kk] : 1.f) * scale; }
    asm volatile("s_waitcnt lgkmcnt(0)" ::: "memory");
    const int c = lane & 7;
#pragma unroll
    for (int j = 0; j < 4; ++j) { const int n = (lane >> 3) + 8 * j; const LAS float* q = scr + (8 * c) * 33 + n;
        u32x4 o; o.x = pk2(q[0 * 33], q[1 * 33]); o.y = pk2(q[2 * 33], q[3 * 33]); o.z = pk2(q[4 * 33], q[5 * 33]); o.w = pk2(q[6 * 33], q[7 * 33]);
        *(u32x4*)(WT + (size_t)(prow0 + n) * K + k0 + 8 * c) = o; }
    asm volatile("s_waitcnt lgkmcnt(0)" ::: "memory");
}
DI void p0_weights(Frame& F) {
    FRAME_IDS;
    LAS float* scr = (LAS float*)(F.lds + F.wave * 16384);
    const int gw = F.bid * NWAVES + F.wave, NGW = F.G * NWAVES;
    constexpr int I_IN = 16 * (INC / 32), I_SQ = 16 * (DM / 32), I_W1 = 16 * (2 * DM / 32);
    constexpr int NITEMS = I_IN + I_SQ + I_W1 + I_SQ + 2 * I_SQ;
    for (int it = gw; it < NITEMS; it += NGW) {
        int r = it;
        if (r < I_IN) { const int nb = r % (INC / 32), kb = r / (INC / 32), n0 = nb * 32;
            const int type = n0 / 512, head = (n0 % 512) / 64, bj = (n0 % 64) / 32;
            const int prow0 = 256 * (2 * type + head / 4) + 128 * bj + 32 * (head % 4);
            p0_transpose_item(F.w_in, DM, INC, (bf16*)(F.ws + WS_WIN), prow0, F.mix_norm, type == 0 ? 0.125f * LOG2E : (type == 4 ? 0.125f : 1.f), scr, kb * 64, n0, f_lane); continue; }
        r -= I_IN;
        if (r < I_SQ) { const int nb = r % 32, kb = r / 32; p0_transpose_item(F.w_out, DM, DM, (bf16*)(F.ws + WS_WOUT), nb * 32, nullptr, 1.f, scr, kb * 64, nb * 32, f_lane); continue; }
        r -= I_SQ;
        if (r < I_W1) { const int nb = r % 64, kb = r / 64, n0 = nb * 32; const int bj = n0 / 1024, rem = n0 % 1024;
            p0_transpose_item(F.conv_w1, DM, 2 * DM, (bf16*)(F.ws + WS_W1), 256 * (rem / 128) + 128 * bj + (rem % 128), F.mix_norm + DM, 1.f, scr, kb * 64, n0, f_lane); continue; }
        r -= I_W1;
        if (r < I_SQ) { const int nb = r % 32, kb = r / 32; p0_transpose_item(F.conv_w2, DM, DM, (bf16*)(F.ws + WS_W2), nb * 32, nullptr, 1.f, scr, kb * 64, nb * 32, f_lane); continue; }
        r -= I_SQ;
        { const int layer = r / I_SQ; r %= I_SQ; const int nb = r % 32, kb = r / 32;
          p0_transpose_item(F.peer_wq + (size_t)layer * DM * DM, DM, DM, (bf16*)(F.ws + WS_WQ) + (size_t)layer * DM * DM, nb * 32, F.ffn_norm + layer * DM, 1.f, scr, kb * 64, nb * 32, f_lane); }
    }
}
DI float row_rstd(const float* part, int m) {
    const f32x4* p = (const f32x4*)(part + (size_t)m * 16);
    const f32x4 a = p[0], b = p[1], c = p[2], d = p[3];
    const float s = ((a.x + a.y) + (a.z + a.w)) + ((b.x + b.y) + (b.z + b.w)) + ((c.x + c.y) + (c.z + c.w)) + ((d.x + d.y) + (d.z + d.w));
    return 1.f / sqrtf(s * (1.f / DM) + EPS);
}

typedef short v4i16 __attribute__((ext_vector_type(4)));
typedef __bf16 bf16x2_t __attribute__((ext_vector_type(2)));
DI unsigned cvtpk(float lo, float hi) { f32x2 v = {lo, hi}; bf16x2_t b = __builtin_convertvector(v, bf16x2_t); return __builtin_bit_cast(unsigned, b); }
DI v4i16 ds_tr16(LAS const unsigned char* p) { return __builtin_amdgcn_ds_read_tr16_b64_v4i16((LAS v4i16*)p); }
DI int crow(int r, int h) { return (r & 3) + 8 * (r >> 2) + 4 * h; }
DI bf16x8 pack_step(const f32x16& x, const int s) {
    u32x4 w = {cvtpk(x[8 * s + 0], x[8 * s + 1]), cvtpk(x[8 * s + 2], x[8 * s + 3]), cvtpk(x[8 * s + 4], x[8 * s + 5]), cvtpk(x[8 * s + 6], x[8 * s + 7])};
    return __builtin_bit_cast(bf16x8, w);
}
constexpr int AT_KB = 64 * 144, AT_VB = 8192, AT_BUF = AT_KB + AT_VB, AT_BIAS = 2 * AT_BUF;
DI void attn_item(Frame& F, const int it) {
    FRAME_IDS;
    const bf16* R = (const bf16*)(F.ws + WS_R); bf16* O = (bf16*)(F.ws + WS_O);
    LAS unsigned char* lds = F.lds;
    LAS float* bias_s = (LAS float*)(lds + AT_BIAS);
    const int q32 = f_lane & 31, h = f_lane >> 5, w = F.wave;
    const int srow = f_tid >> 3, sch = f_tid & 7;
    const int vtr_off = ((f_lane & 15) >> 2) * 64 + (16 * ((f_lane >> 4) & 1) + 4 * (f_lane & 3)) * 2;
    {
        const int b = it / (NHA * 8), hd = (it / 8) % NHA, c0 = (it % 8) * 4;
        const int c = c0 + (w >> 1), qrow0 = 32 * (w & 1);
        const size_t tq = (size_t)b * SEQ + c * 64 + qrow0 + q32;
        __syncthreads();
        for (int k = f_tid; k < 257; k += NTHR) bias_s[k] = F.rel_bias[hd * 257 + k] * LOG2E;
        bf16x8 qf[4];
#pragma unroll
        for (int ks = 0; ks < 4; ++ks) qf[ks] = *(const bf16x8*)(R + tq * INC + C_QA + hd * 64 + 16 * ks + 8 * h);
        const int t_lo = c0 - 8 < 0 ? 0 : c0 - 8, t_hi = c0 + 3, ntile = t_hi - t_lo + 1;
        const bf16* kbase = R + ((size_t)b * SEQ + srow) * INC + C_KA + hd * 64 + 8 * sch;
        const bf16* vbase = R + ((size_t)b * SEQ + srow) * INC + C_VA + hd * 64 + 8 * sch;
        u32x4 kreg = *(const u32x4*)(kbase + (size_t)t_lo * 64 * INC), vreg = *(const u32x4*)(vbase + (size_t)t_lo * 64 * INC);
        *(LAS u32x4*)(lds + srow * 144 + sch * 16) = kreg;
        *(LAS u32x4*)(lds + AT_KB + (sch >> 2) * 4096 + srow * 64 + (sch & 3) * 16) = vreg;
        __syncthreads();
        const float bias_far = bias_s[256];
        float m = -1e30f, l = 0.f;
        f32x16 o0 = {}, o1 = {};
        for (int i = 0; i < ntile; ++i) {
            const int tc = t_lo + i;
            LAS unsigned char* kb = lds + (i & 1) * AT_BUF; LAS unsigned char* vb = kb + AT_KB;
            if (i + 1 < ntile) { kreg = *(const u32x4*)(kbase + (size_t)(tc + 1) * 64 * INC); vreg = *(const u32x4*)(vbase + (size_t)(tc + 1) * 64 * INC); }
            const int D = c - tc;
            if (D >= 0 && D <= 8) {
                const float init = D >= 3 ? bias_far : 0.f;
                f32x16 p0, p1;
#pragma unroll
                for (int r = 0; r < 16; ++r) { p0[r] = init; p1[r] = init; }
#pragma unroll
                for (int ks = 0; ks < 4; ++ks) {
                    const bf16x8 k0 = *(const LAS bf16x8*)(kb + q32 * 144 + (16 * ks + 8 * h) * 2);
                    const bf16x8 k1 = *(const LAS bf16x8*)(kb + (32 + q32) * 144 + (16 * ks + 8 * h) * 2);
                    p0 = __builtin_amdgcn_mfma_f32_32x32x16_bf16(k0, qf[ks], p0, 0, 0, 0);
                    p1 = __builtin_amdgcn_mfma_f32_32x32x16_bf16(k1, qf[ks], p1, 0, 0, 0);
                }
                if (D < 3) {
                    const int relb = D * 64 + qrow0 + q32 - 4 * h + 128;
#pragma unroll
                    for (int r = 0; r < 16; ++r) {
                        const int r0 = relb - ((r & 3) + 8 * (r >> 2));
                        const int i0 = r0 < 0 ? 0 : (r0 > 256 ? 256 : r0), r1 = r0 - 32, i1 = r1 < 0 ? 0 : (r1 > 256 ? 256 : r1);
                        p0[r] += bias_s[i0]; p1[r] += bias_s[i1];
                    }
                }
                float tm = fmaxf(p0[0], p1[0]);
#pragma unroll
                for (int r = 1; r < 16; ++r) tm = fmaxf(tm, fmaxf(p0[r], p1[r]));
                tm = swap32_max(tm);
                const float mn = fmaxf(m, tm), alpha = __builtin_amdgcn_exp2f(m - mn);
                m = mn;
                float ps = 0.f;
#pragma unroll
                for (int r = 0; r < 16; ++r) { p0[r] = __builtin_amdgcn_exp2f(p0[r] - mn); p1[r] = __builtin_amdgcn_exp2f(p1[r] - mn); ps += p0[r] + p1[r]; }
                l = l * alpha + ps;
                if (!__all(alpha == 1.f)) {
#pragma unroll
                    for (int r = 0; r < 16; ++r) { o0[r] *= alpha; o1[r] *= alpha; }
                }
                bf16x8 pf[4];
                pf[0] = pack_step(p0, 0); pf[1] = pack_step(p0, 1); pf[2] = pack_step(p1, 0); pf[3] = pack_step(p1, 1);
#pragma unroll
                for (int kk = 0; kk < 4; ++kk) {
                    const int key0 = 16 * kk + 4 * h;
                    const v4i16 a0l = ds_tr16(vb + key0 * 64 + vtr_off), a0h = ds_tr16(vb + (key0 + 8) * 64 + vtr_off);
                    const v4i16 a1l = ds_tr16(vb + 4096 + key0 * 64 + vtr_off), a1h = ds_tr16(vb + 4096 + (key0 + 8) * 64 + vtr_off);
                    const bf16x8 a0 = __builtin_shufflevector(a0l, a0h, 0, 1, 2, 3, 4, 5, 6, 7), a1 = __builtin_shufflevector(a1l, a1h, 0, 1, 2, 3, 4, 5, 6, 7);
                    o0 = __builtin_amdgcn_mfma_f32_32x32x16_bf16(a0, pf[kk], o0, 0, 0, 0);
                    o1 = __builtin_amdgcn_mfma_f32_32x32x16_bf16(a1, pf[kk], o1, 0, 0, 0);
                }
            }
            if (i + 1 < ntile) {
                LAS unsigned char* nb = lds + ((i + 1) & 1) * AT_BUF;
                *(LAS u32x4*)(nb + srow * 144 + sch * 16) = kreg;
                *(LAS u32x4*)(nb + AT_KB + (sch >> 2) * 4096 + srow * 64 + (sch & 3) * 16) = vreg;
            }
            __syncthreads();
        }
        l = swap32_add(l, l);
        const float inv = 1.f / l;
        bf16* op = O + tq * DM + hd * 64 + 4 * h;
#pragma unroll
        for (int g = 0; g < 4; ++g) {
            *(u32x2*)(op + 8 * g) = (u32x2){cvtpk(o0[4 * g] * inv, o0[4 * g + 1] * inv), cvtpk(o0[4 * g + 2] * inv, o0[4 * g + 3] * inv)};
            *(u32x2*)(op + 32 + 8 * g) = (u32x2){cvtpk(o1[4 * g] * inv, o1[4 * g + 1] * inv), cvtpk(o1[4 * g + 2] * inv, o1[4 * g + 3] * inv)};
        }
    }
    __syncthreads();
}

constexpr int RT_Q = 0, RT_K = 9216, RT_KD = 18432, RT_V = 26624, RT_BUF = 34816, RT_ZS = 2 * RT_BUF, RT_CS = RT_ZS + 64 * 66 * 4;
DI void ret_item(Frame& F, const int it) {
    FRAME_IDS;
    const bf16* R = (const bf16*)(F.ws + WS_R); bf16* O = (bf16*)(F.ws + WS_O);
    LAS unsigned char* lds = F.lds;
    LAS float* Zs = (LAS float*)(lds + RT_ZS); LAS float* Cs = (LAS float*)(lds + RT_CS);
    const int b = it / NHB, hd = it % NHB;
    const int q32 = f_lane & 31, h = f_lane >> 5, w = F.wave;
    const int role = w >> 2, itile = (w >> 1) & 1, etile = w & 1;
    const int srow = f_tid >> 3, sch = f_tid & 7;
    const int vtr_off = ((f_lane & 15) >> 2) * 64 + (16 * ((f_lane >> 4) & 1) + 4 * (f_lane & 3)) * 2;
    const float l2g = log2f(gamma_of(hd));
    const float cd = exp2f(l2g * 64.f), sdec = exp2f(l2g * (float)(63 - srow));
    float qdv[16];
#pragma unroll
    for (int r = 0; r < 16; ++r) qdv[r] = exp2f(l2g * (float)(32 * itile + crow(r, h) + 1));
    f32x16 xs0 = {}, xs1 = {};
    const size_t trow0 = (size_t)b * SEQ;
    const bf16* gq = R + (trow0 + srow) * INC + hd * 64 + 8 * sch;
    u32x4 qreg = *(const u32x4*)(gq + C_QB), kreg = *(const u32x4*)(gq + C_KB), vreg = *(const u32x4*)(gq + C_VB);
    __syncthreads();
#define RT_STAGE(bufp) do { LAS unsigned char* bp_ = (bufp); \
        *(LAS u32x4*)(bp_ + RT_Q + srow * 144 + sch * 16) = qreg; *(LAS u32x4*)(bp_ + RT_K + srow * 144 + sch * 16) = kreg; \
        *(LAS u32x4*)(bp_ + RT_V + (sch >> 2) * 4096 + srow * 64 + (sch & 3) * 16) = vreg; \
        u32x4 kd_; \
        _Pragma("unroll") for (int e_ = 0; e_ < 4; ++e_) kd_[e_] = cvtpk(__uint_as_float(kreg[e_] << 16) * sdec, __uint_as_float(kreg[e_] & 0xffff0000u) * sdec); \
        *(LAS u32x4*)(bp_ + RT_KD + (sch >> 2) * 4096 + srow * 64 + (sch & 3) * 16) = kd_; } while (0)
    RT_STAGE(lds);
    __syncthreads();
    for (int n = 0; n < NCH; ++n) {
        LAS unsigned char* bp = lds + (n & 1) * RT_BUF;
        if (n + 1 < NCH) { const bf16* g1 = gq + (size_t)(n + 1) * 64 * INC; qreg = *(const u32x4*)(g1 + C_QB); kreg = *(const u32x4*)(g1 + C_KB); vreg = *(const u32x4*)(g1 + C_VB); }
        unsigned short gr[8];
#pragma unroll
        for (int r = 0; r < 8; ++r) gr[r] = R[(trow0 + n * 64 + 8 * w + r) * INC + C_GB + hd * 64 + f_lane];
        if (role == 0) {
            bf16x8 qf[4];
#pragma unroll
            for (int ks = 0; ks < 4; ++ks) qf[ks] = *(const LAS bf16x8*)(bp + RT_Q + (32 * itile + q32) * 144 + (16 * ks + 8 * h) * 2);
            f32x16 st0 = {}, st1 = {};
#pragma unroll
            for (int ks = 0; ks < 4; ++ks) {
                const bf16x8 k0 = *(const LAS bf16x8*)(bp + RT_K + q32 * 144 + (16 * ks + 8 * h) * 2);
                const bf16x8 k1 = *(const LAS bf16x8*)(bp + RT_K + (32 + q32) * 144 + (16 * ks + 8 * h) * 2);
                st0 = __builtin_amdgcn_mfma_f32_32x32x16_bf16(k0, qf[ks], st0, 0, 0, 0);
                st1 = __builtin_amdgcn_mfma_f32_32x32x16_bf16(k1, qf[ks], st1, 0, 0, 0);
            }
            int iiv = 32 * itile + q32 - 4 * h; asm volatile("" : "+v"(iiv));
#pragma unroll
            for (int r = 0; r < 16; ++r) {
                const int dd = iiv - ((r & 3) + 8 * (r >> 2));
                st0[r] *= __builtin_amdgcn_exp2f(l2g * fabsf((float)dd));
                st1[r] *= __builtin_amdgcn_exp2f(l2g * fabsf((float)(dd - 32)));
            }
            f32x16 z = {};
#pragma unroll
            for (int kk = 0; kk < 4; ++kk) {
                const int key0 = 16 * kk + 4 * h;
                const v4i16 bl = ds_tr16(bp + RT_V + etile * 4096 + key0 * 64 + vtr_off), bh = ds_tr16(bp + RT_V + etile * 4096 + (key0 + 8) * 64 + vtr_off);
                const bf16x8 vb = __builtin_shufflevector(bl, bh, 0, 1, 2, 3, 4, 5, 6, 7);
                const bf16x8 xa = (kk < 2) ? pack_step(st0, kk & 1) : pack_step(st1, kk & 1);
                z = __builtin_amdgcn_mfma_f32_32x32x16_bf16(xa, vb, z, 0, 0, 0);
            }
            int zb = (32 * itile + 4 * h) * 66 + 32 * etile + q32; asm volatile("" : "+v"(zb));
#pragma unroll
            for (int r = 0; r < 16; ++r) Zs[zb + ((r & 3) + 8 * (r >> 2)) * 66] = z[r];
        } else {
            f32x16 cr = {};
#pragma unroll
            for (int kk = 0; kk < 4; ++kk) {
                const LAS unsigned char* qp = bp + RT_Q + (32 * itile + q32) * 144 + (16 * kk + 4 * h) * 2;
                const v4i16 al = *(const LAS v4i16*)qp, ah = *(const LAS v4i16*)(qp + 16);
                const bf16x8 qa = __builtin_shufflevector(al, ah, 0, 1, 2, 3, 4, 5, 6, 7);
                const bf16x8 xb = (kk < 2) ? pack_step(xs0, kk & 1) : pack_step(xs1, kk & 1);
                cr = __builtin_amdgcn_mfma_f32_32x32x16_bf16(qa, xb, cr, 0, 0, 0);
            }
            int cb = (32 * itile + 4 * h) * 66 + 32 * etile + q32; asm volatile("" : "+v"(cb));
#pragma unroll
            for (int r = 0; r < 16; ++r) Cs[cb + ((r & 3) + 8 * (r >> 2)) * 66] = cr[r] * qdv[r];
#pragma unroll
            for (int r = 0; r < 16; ++r) { xs0[r] *= cd; xs1[r] *= cd; }
#pragma unroll
            for (int s4 = 0; s4 < 4; ++s4) {
                const int key0 = 16 * s4 + 8 * h;
                const v4i16 vl = ds_tr16(bp + RT_V + etile * 4096 + key0 * 64 + vtr_off), vh = ds_tr16(bp + RT_V + etile * 4096 + (key0 + 4) * 64 + vtr_off);
                const bf16x8 vb = __builtin_shufflevector(vl, vh, 0, 1, 2, 3, 4, 5, 6, 7);
                const v4i16 a0l = ds_tr16(bp + RT_KD + key0 * 64 + vtr_off), a0h = ds_tr16(bp + RT_KD + (key0 + 4) * 64 + vtr_off);
                const v4i16 a1l = ds_tr16(bp + RT_KD + 4096 + key0 * 64 + vtr_off), a1h = ds_tr16(bp + RT_KD + 4096 + (key0 + 4) * 64 + vtr_off);
                const bf16x8 ka0 = __builtin_shufflevector(a0l, a0h, 0, 1, 2, 3, 4, 5, 6, 7), ka1 = __builtin_shufflevector(a1l, a1h, 0, 1, 2, 3, 4, 5, 6, 7);
                xs0 = __builtin_amdgcn_mfma_f32_32x32x16_bf16(ka0, vb, xs0, 0, 0, 0);
                xs1 = __builtin_amdgcn_mfma_f32_32x32x16_bf16(ka1, vb, xs1, 0, 0, 0);
            }
        }
        __syncthreads();
#pragma unroll
        for (int r = 0; r < 8; ++r) {
            const int i = 8 * w + r;
            const float v = Zs[i * 66 + f_lane] + Cs[i * 66 + f_lane];
            const float mu = wave_sum(v) * (1.f / 64.f);
            const float dv = v - mu;
            const float var = wave_sum(dv * dv) * (1.f / 64.f);
            const float g = bf2f(gr[r]);
            O[(trow0 + n * 64 + i) * DM + 512 + hd * 64 + f_lane] = (bf16)f2bf(dv * (1.f / sqrtf(var + EPS)) * (g / (1.f + __expf(-g))));
        }
        if (n + 1 < NCH) RT_STAGE(lds + ((n + 1) & 1) * RT_BUF);
        __syncthreads();
    }
#undef RT_STAGE
}
DI unsigned q8x4(f32x4 v, const float sc) {
    const int a = (int)rintf(v[0] * sc), b = (int)rintf(v[1] * sc), c = (int)rintf(v[2] * sc), d = (int)rintf(v[3] * sc);
    return ((unsigned)a & 0xFFu) | (((unsigned)b & 0xFFu) << 8) | (((unsigned)c & 0xFFu) << 16) | ((unsigned)d << 24);
}
DI void int8_rows(Frame& F, const int row0, const int nrows, const int f_lane) {
    float* SC = (float*)(F.ws + WS_SC);
    for (int rr = row0; rr < row0 + nrows; rr += 4) {
        f32x4 v[4][4];
#pragma unroll
        for (int u = 0; u < 4; ++u) {
            const int row = rr + u, tab = row / PE, e = row % PE, layer = tab & 1, isv = tab >> 1;
            const f32x4* sp = (const f32x4*)((isv ? F.peer_v : F.peer_u) + ((size_t)layer * PE + e) * DM) + f_lane;
#pragma unroll
            for (int j = 0; j < 4; ++j) v[u][j] = sp[64 * j];
        }
#pragma unroll
        for (int u = 0; u < 4; ++u) {
            const int row = rr + u, tab = row / PE, e = row % PE, layer = tab & 1, isv = tab >> 1;
            const f32x4* gp = (const f32x4*)(F.ffn_norm + layer * DM) + f_lane;
            float a = 0.f, sq = 0.f;
#pragma unroll
            for (int j = 0; j < 4; ++j) { if (!isv) v[u][j] = v[u][j] * gp[64 * j]; a = fmaxf(a, fmaxf(fmaxf(fabsf(v[u][j][0]), fabsf(v[u][j][1])), fmaxf(fabsf(v[u][j][2]), fabsf(v[u][j][3]))));
                sq += (v[u][j][0] * v[u][j][0] + v[u][j][1] * v[u][j][1]) + (v[u][j][2] * v[u][j][2] + v[u][j][3] * v[u][j][3]); }
            a = wave_max(a);
            const float step = fminf(0.355f * sqrtf(wave_sum(sq) * (1.f / DM)), a * (1.f / 7.f));
            const float sc = step > 0.f ? 1.f / step : 0.f;
            unsigned* dst = (unsigned*)(F.ws + (isv ? WS_V8 : WS_U8)) + (size_t)layer * 4 * PE * 32;
#pragma unroll
            for (int j = 0; j < 4; ++j) {
                const int q0 = (int)rintf(__builtin_amdgcn_fmed3f(v[u][j][0] * sc, -7.f, 7.f)), q1 = (int)rintf(__builtin_amdgcn_fmed3f(v[u][j][1] * sc, -7.f, 7.f)), q2 = (int)rintf(__builtin_amdgcn_fmed3f(v[u][j][2] * sc, -7.f, 7.f)), q3 = (int)rintf(__builtin_amdgcn_fmed3f(v[u][j][3] * sc, -7.f, 7.f));
                const int ob = (isv && !(f_lane & 1)) ? 8 : 0;
                unsigned w = ((unsigned)(q0 + ob) & 0xFu) | (((unsigned)(q1 + ob) & 0xFu) << 8) | (((unsigned)(q2 + ob) & 0xFu) << 16) | (((unsigned)(q3 + ob) & 0xFu) << 24);
                if (f_lane & 1) w <<= 4;
                w |= (unsigned)DPP_MOV_I((int)w, DPP_XOR1);
                if (!(f_lane & 1)) dst[((size_t)j * PE + e) * 32 + (f_lane >> 1)] = w;
            }
            if (f_lane == 0) SC[tab * PE + e] = step * (1.f / 16.f);
        }
    }
}
constexpr int Q8_ITEM_ROWS = 512, Q8_ITEMS = 4 * PE / Q8_ITEM_ROWS;
constexpr int PH_MIX_ID = 2;
DI void mix_phase(Frame& F, const int rep) {
    FRAME_IDS;
    unsigned* ctr = (unsigned*)(F.ws + WS_CTL) + CW_QUEUE + 64 * rep;
    volatile LAS unsigned* slot = (volatile LAS unsigned*)(F.lds + MISC_OFF) + 16;
    constexpr int N_RET = NB * NHB, N_ATT = NB * NHA * 8;
    static_assert(N_ATT == 8 * Q8_ITEMS, "8 attention items per quantisation item");
    for (;;) {
        __syncthreads();
        if (f_tid == 0) slot[0] = __hip_atomic_fetch_add(ctr, 1u, __ATOMIC_RELAXED, __HIP_MEMORY_SCOPE_AGENT);
        __syncthreads();
        const int idx = (int)slot[0];
        if (idx >= N_RET + N_ATT + Q8_ITEMS) break;
        const bool probe_pass = (REP_PHASE == PH_MIX_ID && rep == 0);
        if (idx < N_RET) { if (!(probe_pass && PROBE_MODE == 4)) ret_item(F, idx); }
        else if (probe_pass && PROBE_MODE == 3) { }
        else { const int k = idx - N_RET, grp = k / 9, pos = k - 9 * grp;
            if (pos == 8) int8_rows(F, grp * Q8_ITEM_ROWS + F.wave * 64, 64, f_lane);
            else attn_item(F, 8 * grp + pos); }
    }
}
DI float fmax_raw(float a, float b) { float r; asm("v_max_f32_e32 %0, %1, %2" : "=v"(r) : "v"(a), "v"(b)); return r; }
DI float fmin_raw(float a, float b) { float r; asm("v_min_f32_e32 %0, %1, %2" : "=v"(r) : "v"(a), "v"(b)); return r; }
#define CE_DESC(x, y) do { const float hi_ = fmax_raw((x), (y)), lo_ = fmin_raw((x), (y)); (x) = hi_; (y) = lo_; } while (0)
template <int N> DI void sort_desc(float* v) {
#pragma unroll
    for (int k = 2; k <= N; k <<= 1)
#pragma unroll
        for (int j = k >> 1; j > 0; j >>= 1)
#pragma unroll
            for (int i = 0; i < N; ++i) { const int l = i ^ j; if (l > i) { if ((i & k) == 0 || k == N) CE_DESC(v[i], v[l]); else CE_DESC(v[l], v[i]); } }
}
DI void merge16(float* a, const float* b) {
#pragma unroll
    for (int i = 0; i < 16; ++i) a[i] = fmax_raw(a[i], b[15 - i]);
#pragma unroll
    for (int j = 8; j > 0; j >>= 1)
#pragma unroll
        for (int i = 0; i < 16; ++i) { const int l = i ^ j; if (l > i) CE_DESC(a[i], a[l]); }
}
DI float key_pack(float v, unsigned keep_mask, unsigned idx) { return __uint_as_float((__float_as_uint(v) & keep_mask) | idx); }
DI void opt_route(Frame& F, int layer) {
    FRAME_IDS;
    const bf16* Q = (const bf16*)(F.ws + WS_Q);
    int* eidx = (int*)(F.ws + WS_EIDX); float* gate = (float*)(F.ws + WS_GATE);
    const float* keys = F.peer_keys + (size_t)layer * 2 * PK * 64;
    LAS unsigned char* kl = F.lds;
    __syncthreads();
    for (int idx = f_tid; idx < 2 * PK * 8; idx += NTHR) {
        const int row = idx >> 3, ch = idx & 7;
        const f32x4 a = *(const f32x4*)(keys + (size_t)row * 64 + ch * 8), b = *(const f32x4*)(keys + (size_t)row * 64 + ch * 8 + 4);
        *(LAS u32x4*)(kl + row * 144 + ch * 16) = (u32x4){pk2(a[0], a[1]), pk2(a[2], a[3]), pk2(b[0], b[1]), pk2(b[2], b[3])};
    }
    __syncthreads();
    LAS int* lut = (LAS int*)(F.lds + 40960 + F.wave * 8192);
    const int c = f_lane & 31, h = f_lane >> 5;
    pg8::StaticOrder SO; SO.init(T, DM, F.G, F.bid);
    pg8::Unit un;
    for (int ui = 0; SO.next(ui, un); ++ui)
    for (int k2 = F.wave; k2 < 16; k2 += NWAVES) {
        const int tile = 8 * un.pm + (k2 & 7), hh = 2 * un.pn + (k2 >> 3), t = tile * 32 + c;
        float tk[2][16];
#pragma unroll
        for (int side = 0; side < 2; ++side) {
            bf16x8 qf[4];
#pragma unroll
            for (int ks = 0; ks < 4; ++ks) qf[ks] = *(const bf16x8*)(Q + (size_t)t * DM + hh * PQD + side * 64 + 16 * ks + 8 * h);
            float v[64];
#pragma unroll
            for (int kt = 0; kt < 4; ++kt) {
                f32x16 acc = {};
#pragma unroll
                for (int ks = 0; ks < 4; ++ks) {
                    const bf16x8 a = *(const LAS bf16x8*)(kl + (side * PK + 32 * kt + c) * 144 + (16 * ks + 8 * h) * 2);
                    acc = __builtin_amdgcn_mfma_f32_32x32x16_bf16(a, qf[ks], acc, 0, 0, 0);
                }
#pragma unroll
                for (int r = 0; r < 16; ++r) v[16 * kt + r] = key_pack(acc[r], 0xFFFFFF80u, (unsigned)(32 * kt + (r & 3) + 8 * (r >> 2) + 4 * h));
            }
            sort_desc<16>(v); sort_desc<16>(v + 16); sort_desc<16>(v + 32); sort_desc<16>(v + 48);
            merge16(v, v + 16); merge16(v + 32, v + 48); merge16(v, v + 32);
            float pr[16];
#pragma unroll
            for (int i = 0; i < 16; ++i) pr[i] = __shfl_xor(v[i], 32);
            merge16(v, pr);
#pragma unroll
            for (int i = 0; i < 16; ++i) { tk[side][i] = v[i]; lut[(side * 16 + i) * 64 + f_lane] = (int)(__float_as_uint(v[i]) & 0x7Fu); }
        }
        float cd[64];
        {   int n = 0;
#pragma unroll
            for (int a = 0; a < 16; ++a)
#pragma unroll
                for (int b = 0; b < 16; ++b) if ((a + 1) * (b + 1) <= 16) { cd[n] = key_pack(tk[0][a] + tk[1][b], 0xFFFFFF00u, (unsigned)(a * 16 + b)); ++n; }
#pragma unroll
            for (int i = 50; i < 64; ++i) cd[i] = -INFINITY;
        }
        sort_desc<16>(cd); sort_desc<16>(cd + 16); sort_desc<16>(cd + 32); CE_DESC(cd[48], cd[49]);
        merge16(cd, cd + 16); merge16(cd + 32, cd + 48); merge16(cd, cd + 32);
        int ex[16]; float gv[16]; float sum = 0.f;
        const float top = __uint_as_float(__float_as_uint(cd[0]) & 0xFFFFFF00u);
#pragma unroll
        for (int i = 0; i < 16; ++i) {
            const unsigned bits = __float_as_uint(cd[i]);
            const int a = (bits >> 4) & 15, b = bits & 15;
            ex[i] = lut[a * 64 + f_lane] * PK + lut[(16 + b) * 64 + f_lane];
            gv[i] = __expf(__uint_as_float(bits & 0xFFFFFF00u) - top); sum += gv[i];
        }
        const float inv = 1.f / sum;
        if (h == 0) {
            u32x4* ep = (u32x4*)(eidx + (size_t)t * NSEL + hh * 16);
#pragma unroll
            for (int q = 0; q < 4; ++q) ep[q] = (u32x4){(unsigned)ex[4 * q], (unsigned)ex[4 * q + 1], (unsigned)ex[4 * q + 2], (unsigned)ex[4 * q + 3]};
        } else {
            f32x4* gp = (f32x4*)(gate + (size_t)t * NSEL + hh * 16);
#pragma unroll
            for (int q = 0; q < 4; ++q) gp[q] = (f32x4){gv[4 * q] * inv, gv[4 * q + 1] * inv, gv[4 * q + 2] * inv, gv[4 * q + 3] * inv};
        }
    }
    __syncthreads();
}
struct XInfo { int xrank, nx, rank, nloc; };
DI XInfo get_xinfo(Frame& F, const bool census) {
    FRAME_IDS;
    volatile LAS unsigned* M = (volatile LAS unsigned*)(F.lds + MISC_OFF);
    __syncthreads();
    if (f_tid == 0) {
        unsigned xr = (unsigned)F.bid & 7u, nx = 8u, rk = (unsigned)F.bid >> 3, nl = ((unsigned)F.G + 7u - ((unsigned)F.bid & 7u)) >> 3;
        if (census) {
            unsigned* bar = (unsigned*)(F.ws + WS_CTL) + CW_BAR; const unsigned x = xb_xcc_id();
            unsigned cnt = 0u, below = 0u, mine = 0u;
#pragma unroll
            for (unsigned j = 0; j < 16; ++j) { const unsigned c = xb_ld(&bar[XB_XCNT(j)]); cnt += (c > 0u); below += (c > 0u && j < x); mine = (j == x) ? c : mine; }
            if (cnt > 0u && mine > 0u) { xr = below; nx = cnt; rk = M[12]; nl = mine; }
        }
        M[20] = xr; M[21] = nx; M[22] = rk; M[23] = nl;
    }
    __syncthreads();
    XInfo xi; xi.xrank = (int)M[20]; xi.nx = (int)M[21]; xi.rank = (int)M[22]; xi.nloc = (int)M[23];
    return xi;
}
DI int comb_c(const int level, const int a, const int b, const int lane) {
    const int M = 4 >> level; const bool bit = (lane & M) != 0;
    const int send = bit ? a : b, keep = bit ? b : a;
    const int recv = level == 0 ? DPP_MOV_I(send, DPP_HMIRROR) : (level == 1 ? DPP_MOV_I(send, DPP_XOR2) : DPP_MOV_I(send, DPP_XOR1));
    return keep + recv;
}
DI int dot16_i8(const u32x4 r, const u32x4 x) {
    int s = __builtin_amdgcn_sdot4((int)r[0], (int)x[0], 0, false);
    s = __builtin_amdgcn_sdot4((int)r[1], (int)x[1], s, false); s = __builtin_amdgcn_sdot4((int)r[2], (int)x[2], s, false); s = __builtin_amdgcn_sdot4((int)r[3], (int)x[3], s, false);
    return s;
}
DI int half_dots(const u32x4 (&rows)[8], const u32x4 xq, const int lane) {
    int p[8];
#pragma unroll
    for (int i = 0; i < 8; ++i) p[i] = dot16_i8(rows[i], xq);
#pragma unroll
    for (int i = 0; i < 4; ++i) p[i] = comb_c(0, p[2 * i], p[2 * i + 1], lane);
    p[0] = comb_c(1, p[0], p[1], lane); p[1] = comb_c(1, p[2], p[3], lane);
    return comb_c(2, p[0], p[1], lane);
}
DI u32x4 xquant(const f32x4 (&hv)[4], const float rstd) {
    u32x4 o;
#pragma unroll
    for (int w = 0; w < 4; ++w) {
        const f32x4 x = hv[w] * (rstd * XQ);
        const int a = (int)rintf(__builtin_amdgcn_fmed3f(x[0], -127.f, 127.f)), b = (int)rintf(__builtin_amdgcn_fmed3f(x[1], -127.f, 127.f)), c = (int)rintf(__builtin_amdgcn_fmed3f(x[2], -127.f, 127.f)), d = (int)rintf(__builtin_amdgcn_fmed3f(x[3], -127.f, 127.f));
        o[w] = ((unsigned)a & 0xFFu) | (((unsigned)b & 0xFFu) << 8) | (((unsigned)c & 0xFFu) << 16) | ((unsigned)d << 24);
    }
    return o;
}
DI float rstd_bcast(const float* part, const int t) {
    const f32x4* p = (const f32x4*)(part + (size_t)t * 16);
    const f32x4 a = p[0], b = p[1], c = p[2], d = p[3];
    const float s = ((a[0] + a[1]) + (a[2] + a[3])) + ((b[0] + b[1]) + (b[2] + b[3])) + ((c[0] + c[1]) + (c[2] + c[3])) + ((d[0] + d[1]) + (d[2] + d[3]));
    return 1.f / sqrtf(s * (1.f / DM) + EPS);
}
DI int dot32_i4(const u32x4 r, const u32x4 xa, const u32x4 xb) {
    int s = 0;
#pragma unroll
    for (int d = 0; d < 4; ++d) {
        const unsigned lo = (r[d] << 4) & 0xF0F0F0F0u, hi = r[d] & 0xF0F0F0F0u;
        const unsigned x0 = d < 2 ? xa[2 * d] : xb[2 * d - 4], x1 = d < 2 ? xa[2 * d + 1] : xb[2 * d - 3];
        s = __builtin_amdgcn_sdot4((int)lo, (int)x0, s, false); s = __builtin_amdgcn_sdot4((int)hi, (int)x1, s, false);
    }
    return s;
}
DI int half_dots4(const u32x4 (&rows)[8], const u32x4 xa, const u32x4 xb, const int lane) {
    int p[8];
#pragma unroll
    for (int i = 0; i < 8; ++i) p[i] = dot32_i4(rows[i], xa, xb);
#pragma unroll
    for (int i = 0; i < 4; ++i) p[i] = comb_c(0, p[2 * i], p[2 * i + 1], lane);
    p[0] = comb_c(1, p[0], p[1], lane); p[1] = comb_c(1, p[2], p[3], lane);
    return comb_c(2, p[0], p[1], lane);
}
DI void gather_u(Frame& F, const int layer, const XInfo xi, const bool dry) {
    FRAME_IDS;
    const unsigned emask = (dry && PROBE_MODE == 2) ? 15u : ((dry && PROBE_MODE == 5) ? 4095u : 0xFFFFFFFFu);
    const int* eidx = (const int*)(F.ws + WS_EIDX); int* PU = (int*)(F.ws + (dry ? WS_R : WS_PU)); const float* part = (const float*)(F.ws + WS_PART); const bf16* hbp = (const bf16*)(F.ws + WS_XB);
    const int g = f_lane >> 3, c = f_lane & 7, c16 = c * 16;
    const int kst = 16 * g + (((c & 1) << 2) | (c & 2) | ((c & 4) >> 2));
    const int gwl = xi.rank * NWAVES + F.wave, NGWL = xi.nloc * NWAVES;
    LAS unsigned char* wl = F.lds + F.wave * 2048;
    __syncthreads();
    for (int j = xi.xrank; j < 8; j += xi.nx) {
        const int sl = j & 3, th = j >> 2;
        const __amdgpu_buffer_rsrc_t U8 = __builtin_amdgcn_make_buffer_rsrc((void*)(F.ws + WS_U8 + ((size_t)(layer * 4 + sl) * PE) * 128), 0, PE * 128, 0x00020000);
        int tt = gwl;
        if (tt >= T / 2) continue;
#define TOK(x_) (2 * (x_) + th)
#define U_LOAD(tk, ri, rh, rp) do { ri = *(const u32x2*)(eidx + (size_t)(tk) * NSEL + 2 * f_lane) & emask; rh = *(const u32x2*)(hbp + (size_t)(tk) * DM + 256 * sl + 4 * f_lane); \
            rp = part[(size_t)(tk) * 16 + (f_lane & 15)]; } while (0)
#define U_SPREAD(slot, ri, rh, rp, e, xa_, xb_) do { \
            float ps_ = rp; ps_ += __int_as_float(DPP_MOV_I(__float_as_int(ps_), DPP_XOR1)); ps_ += __int_as_float(DPP_MOV_I(__float_as_int(ps_), DPP_XOR2)); ps_ += __int_as_float(DPP_MOV_I(__float_as_int(ps_), DPP_HMIRROR)); ps_ += __int_as_float(DPP_MOV_I(__float_as_int(ps_), DPP_ROR8)); \
            const float rs_ = (1.f / sqrtf(ps_ * (1.f / DM) + EPS)) * XQ; \
            const int q0_ = (int)rintf(__builtin_amdgcn_fmed3f(__uint_as_float(rh[0] << 16) * rs_, -127.f, 127.f)), q1_ = (int)rintf(__builtin_amdgcn_fmed3f(__uint_as_float(rh[0] & 0xffff0000u) * rs_, -127.f, 127.f)); \
            const int q2_ = (int)rintf(__builtin_amdgcn_fmed3f(__uint_as_float(rh[1] << 16) * rs_, -127.f, 127.f)), q3_ = (int)rintf(__builtin_amdgcn_fmed3f(__uint_as_float(rh[1] & 0xffff0000u) * rs_, -127.f, 127.f)); \
            LAS unsigned char* sl_ = wl + (slot) * 1024; \
            *(LAS u32x2*)(sl_ + 8 * f_lane) = ri; *(LAS unsigned*)(sl_ + 512 + 4 * f_lane) = ((unsigned)q0_ & 0xFFu) | (((unsigned)q1_ & 0xFFu) << 8) | (((unsigned)q2_ & 0xFFu) << 16) | ((unsigned)q3_ << 24); \
            asm volatile("s_waitcnt lgkmcnt(0)" ::: "memory"); \
            _Pragma("unroll") for (int q_ = 0; q_ < 4; ++q_) e[q_] = *(const LAS u32x4*)(sl_ + 64 * g + 16 * q_); \
            xa_ = *(const LAS u32x4*)(sl_ + 512 + 32 * c); xb_ = *(const LAS u32x4*)(sl_ + 512 + 32 * c + 16); } while (0)
        u32x2 ri, rh; float rp;
        u32x4 e0[4], e1[4], xa, xb, xa1, xb1;
        U_LOAD(TOK(tt), ri, rh, rp); U_SPREAD(0, ri, rh, rp, e0, xa, xb);
        { const int t1 = (tt + NGWL < T / 2) ? tt + NGWL : tt; U_LOAD(TOK(t1), ri, rh, rp); U_SPREAD(1, ri, rh, rp, e1, xa1, xb1); }
        { const int t2 = (tt + 2 * NGWL < T / 2) ? tt + 2 * NGWL : tt; U_LOAD(TOK(t2), ri, rh, rp); }
        u32x4 A0[8], B0[8], A1[8], B1[8];
#pragma unroll
        for (int i = 0; i < 8; ++i) A0[i] = __builtin_amdgcn_raw_buffer_load_b128(U8, (int)e0[i >> 2][i & 3] * 128 + c16, 0, 0);
#pragma unroll
        for (int i = 0; i < 8; ++i) B0[i] = __builtin_amdgcn_raw_buffer_load_b128(U8, (int)e0[2 + (i >> 2)][i & 3] * 128 + c16, 0, 0);
#define U_ITEM(CA, CB, NA, NB, slot) do { \
            _Pragma("unroll") for (int i = 0; i < 8; ++i) NA[i] = __builtin_amdgcn_raw_buffer_load_b128(U8, (int)e1[i >> 2][i & 3] * 128 + c16, 0, 0); \
            asm volatile("" ::: "memory"); \
            const int r0 = half_dots4(CA, xa, xb, f_lane); \
            _Pragma("unroll") for (int i = 0; i < 8; ++i) NB[i] = __builtin_amdgcn_raw_buffer_load_b128(U8, (int)e1[2 + (i >> 2)][i & 3] * 128 + c16, 0, 0); \
            asm volatile("" ::: "memory"); \
            const int rr1 = half_dots4(CB, xa, xb, f_lane); \
            int* pp = PU + ((size_t)TOK(tt) * 4 + sl) * NSEL + kst; \
            pp[0] = r0; pp[8] = rr1; \
            xa = xa1; xb = xb1; \
            U_SPREAD(slot, ri, rh, rp, e1, xa1, xb1);                   \
            { const int t3 = (tt + 3 * NGWL < T / 2) ? tt + 3 * NGWL : tt; U_LOAD(TOK(t3), ri, rh, rp); } } while (0)
        for (;;) {
            U_ITEM(A0, B0, A1, B1, 0); tt += NGWL; if (tt >= T / 2) break;
            U_ITEM(A1, B1, A0, B0, 1); tt += NGWL; if (tt >= T / 2) break;
        }
#undef U_ITEM
#undef U_LOAD
#undef U_SPREAD
#undef TOK
    }
    __syncthreads();
}
DI void gather_r(Frame& F, const int layer) {
    FRAME_IDS;
    const int* PU = (const int*)(F.ws + WS_PU); const float* gate = (const float*)(F.ws + WS_GATE); const int* eidx = (const int*)(F.ws + WS_EIDX);
    const float* SCu = (const float*)(F.ws + WS_SC) + (size_t)layer * PE; const float* SCv = (const float*)(F.ws + WS_SC) + (size_t)(2 + layer) * PE;
    signed char* A8 = (signed char*)(F.ws + WS_A); float* SA = (float*)(F.ws + WS_SA);
    const int gw = F.bid * NWAVES + F.wave, NGW = F.G * NWAVES;
    for (int t = gw; t < T; t += NGW) {
        float a[2];
#pragma unroll
        for (int hf = 0; hf < 2; ++hf) {
            const int k = 64 * hf + f_lane;
            int sacc = 0;
#pragma unroll
            for (int j = 0; j < 4; ++j) sacc += PU[((size_t)t * 4 + j) * NSEL + k];
            const int e = eidx[(size_t)t * NSEL + k];
            const float d = (float)sacc * (SCu[e] * (1.f / XQ));
            a[hf] = gelu_erf(d) * gate[(size_t)t * NSEL + k] * SCv[e];
        }
        const float am = wave_max(fmaxf(fabsf(a[0]), fabsf(a[1])));
        const float sc = am > 0.f ? 127.f / am : 0.f;
        A8[(size_t)t * NSEL + f_lane] = (signed char)(int)rintf(a[0] * sc);
        A8[(size_t)t * NSEL + 64 + f_lane] = (signed char)(int)rintf(a[1] * sc);
        if (f_lane == 0) SA[t] = am * (1.f / 127.f);
    }
}
DI void tr4x4(const unsigned w0, const unsigned w1, const unsigned w2, const unsigned w3, unsigned (&cdw)[4]) {
    const unsigned t01l = __builtin_amdgcn_perm(w1, w0, 0x05010400u), t01h = __builtin_amdgcn_perm(w1, w0, 0x07030602u);
    const unsigned t23l = __builtin_amdgcn_perm(w3, w2, 0x05010400u), t23h = __builtin_amdgcn_perm(w3, w2, 0x07030602u);
    cdw[0] = __builtin_amdgcn_perm(t23l, t01l, 0x05040100u); cdw[1] = __builtin_amdgcn_perm(t23l, t01l, 0x07060302u);
    cdw[2] = __builtin_amdgcn_perm(t23h, t01h, 0x05040100u); cdw[3] = __builtin_amdgcn_perm(t23h, t01h, 0x07060302u);
}
DI void axpy4rows(const u32x4 r0, const u32x4 r1, const u32x4 r2, const u32x4 r3, const unsigned a4, int (&ahi)[16], int (&aall)[16]) {
#pragma unroll
    for (int d = 0; d < 4; ++d) {
        unsigned cdw[4];
        tr4x4(r0[d], r1[d], r2[d], r3[d], cdw);
#pragma unroll
        for (int b = 0; b < 4; ++b) {
            aall[4 * d + b] = __builtin_amdgcn_sdot4((int)cdw[b], (int)a4, aall[4 * d + b], false);
            ahi[4 * d + b] = __builtin_amdgcn_sdot4((int)(cdw[b] & 0xF0F0F0F0u), (int)a4, ahi[4 * d + b], false);
        }
    }
}
DI void gather_v(Frame& F, const int layer, const XInfo xi, const bool dry) {
    FRAME_IDS;
    const int* eidx = (const int*)(F.ws + WS_EIDX); const unsigned char* A8 = F.ws + WS_A; const float* SA = (const float*)(F.ws + WS_SA);
    float* part_w = dry ? (float*)(F.ws + WS_R) : (float*)(F.ws + WS_PART); bf16* hb_w = dry ? (bf16*)(F.ws + WS_HID2) : (bf16*)(F.ws + WS_XB); const bf16* hbp = (const bf16*)(F.ws + WS_XB);
    const int g = f_lane >> 3, c = f_lane & 7, c16 = c * 16;
    const int cc = 32 * c + 16 * (g >> 2) + 8 * ((g >> 1) & 1) + 4 * (g & 1);
    const int gwl = xi.rank * NWAVES + F.wave, NGWL = xi.nloc * NWAVES;
    const bool b3 = (f_lane & 8) != 0;
    LAS unsigned char* wl = F.lds + F.wave * 2048;
    __syncthreads();
    for (int j = xi.xrank; j < 8; j += xi.nx) {
        const int sl = j & 3, th = j >> 2;
        const __amdgpu_buffer_rsrc_t V8 = __builtin_amdgcn_make_buffer_rsrc((void*)(F.ws + WS_V8 + ((size_t)(layer * 4 + sl) * PE) * 128), 0, PE * 128, 0x00020000);
        int tt = gwl;
        if (tt >= T / 2) continue;
#define TOK(x_) (2 * (x_) + th)
#define V_LOAD(tk, ri, ra, rs) do { ri = *(const u32x2*)(eidx + (size_t)(tk) * NSEL + 2 * f_lane); ra = *(const unsigned short*)(A8 + (size_t)(tk) * NSEL + 2 * f_lane); rs = SA[(tk)]; } while (0)
#define V_SPREAD(slot, ri, ra, rs, e, avv, sav) do { \
            LAS unsigned char* sl_ = wl + (slot) * 1024; \
            *(LAS u32x2*)(sl_ + 8 * f_lane) = ri; *(LAS unsigned short*)(sl_ + 512 + 2 * f_lane) = ra; \
            asm volatile("s_waitcnt lgkmcnt(0)" ::: "memory"); \
            _Pragma("unroll") for (int q_ = 0; q_ < 4; ++q_) e[q_] = *(const LAS u32x4*)(sl_ + 64 * g + 16 * q_); \
            avv = *(const LAS u32x4*)(sl_ + 512 + 16 * g); sav = rs; } while (0)
        u32x2 ri; unsigned short ra; float rs;
        u32x4 e0[4], e1[4], av, a1; float sa, sa1; u32x2 hold;
        V_LOAD(TOK(tt), ri, ra, rs); V_SPREAD(0, ri, ra, rs, e0, av, sa);
        { const int t1 = (tt + NGWL < T / 2) ? tt + NGWL : tt; V_LOAD(TOK(t1), ri, ra, rs); V_SPREAD(1, ri, ra, rs, e1, a1, sa1); }
        { const int t2 = (tt + 2 * NGWL < T / 2) ? tt + 2 * NGWL : tt; V_LOAD(TOK(t2), ri, ra, rs); }
        hold = *(const u32x2*)(hbp + (size_t)TOK(tt) * DM + 256 * sl + cc);
        u32x4 A0[8], B0[8], A1[8], B1[8];
#pragma unroll
        for (int i = 0; i < 8; ++i) A0[i] = __builtin_amdgcn_raw_buffer_load_b128(V8, (int)e0[i >> 2][i & 3] * 128 + c16, 0, 0);
#pragma unroll
        for (int i = 0; i < 8; ++i) B0[i] = __builtin_amdgcn_raw_buffer_load_b128(V8, (int)e0[2 + (i >> 2)][i & 3] * 128 + c16, 0, 0);
#define V_ITEM(CA, CB, NA, NB, slot) do { \
            const int t1 = (tt + NGWL < T / 2) ? tt + NGWL : tt; \
            const u32x2 hold1 = *(const u32x2*)(hbp + (size_t)TOK(t1) * DM + 256 * sl + cc); \
            _Pragma("unroll") for (int i = 0; i < 8; ++i) NA[i] = __builtin_amdgcn_raw_buffer_load_b128(V8, (int)e1[i >> 2][i & 3] * 128 + c16, 0, 0); \
            asm volatile("" ::: "memory"); \
            int ahi[16], aall[16]; \
            _Pragma("unroll") for (int n = 0; n < 16; ++n) { ahi[n] = 0; aall[n] = 0; } \
            axpy4rows(CA[0], CA[1], CA[2], CA[3], av[0], ahi, aall); axpy4rows(CA[4], CA[5], CA[6], CA[7], av[1], ahi, aall); \
            _Pragma("unroll") for (int i = 0; i < 8; ++i) NB[i] = __builtin_amdgcn_raw_buffer_load_b128(V8, (int)e1[2 + (i >> 2)][i & 3] * 128 + c16, 0, 0); \
            asm volatile("" ::: "memory"); \
            axpy4rows(CB[0], CB[1], CB[2], CB[3], av[2], ahi, aall); axpy4rows(CB[4], CB[5], CB[6], CB[7], av[3], ahi, aall); \
            int sa8 = __builtin_amdgcn_sdot4(0x01010101, (int)av[0], 0, false); sa8 = __builtin_amdgcn_sdot4(0x01010101, (int)av[1], sa8, false); sa8 = __builtin_amdgcn_sdot4(0x01010101, (int)av[2], sa8, false); sa8 = __builtin_amdgcn_sdot4(0x01010101, (int)av[3], sa8, false); \
            sa8 *= 8; \
            int acc[32];                                                \
            _Pragma("unroll") for (int d_ = 0; d_ < 4; ++d_) _Pragma("unroll") for (int b_ = 0; b_ < 4; ++b_) { acc[8 * d_ + 4 + b_] = ahi[4 * d_ + b_]; acc[8 * d_ + b_] = (aall[4 * d_ + b_] - ahi[4 * d_ + b_] - sa8) << 4; } \
            int r16[16], r8[8]; float hv[4]; \
            _Pragma("unroll") for (int n = 0; n < 16; ++n) r16[n] = swap32_addi(acc[n], acc[16 + n]); \
            _Pragma("unroll") for (int n = 0; n < 8; ++n) r8[n] = swap16_addi(r16[n], r16[8 + n]); \
            _Pragma("unroll") for (int n = 0; n < 4; ++n) { const int keep = b3 ? r8[4 + n] : r8[n], send = b3 ? r8[n] : r8[4 + n]; hv[n] = (float)(keep + DPP_MOV_I(send, DPP_ROR8)) * sa; } \
            hv[0] += __uint_as_float(hold[0] << 16); hv[1] += __uint_as_float(hold[0] & 0xffff0000u); hv[2] += __uint_as_float(hold[1] << 16); hv[3] += __uint_as_float(hold[1] & 0xffff0000u); \
            const float ss = wave_sum_fast((hv[0] * hv[0] + hv[1] * hv[1]) + (hv[2] * hv[2] + hv[3] * hv[3])); \
            *(u32x2*)(hb_w + (size_t)TOK(tt) * DM + 256 * sl + cc) = (u32x2){cvtpk(hv[0], hv[1]), cvtpk(hv[2], hv[3])}; \
            if (f_lane == 0) part_w[(size_t)TOK(tt) * 16 + sl] = ss; \
            if (sl == 0 && f_lane >= 4 && f_lane < 16) part_w[(size_t)TOK(tt) * 16 + f_lane] = 0.f; \
            av = a1; sa = sa1; hold = hold1; \
            V_SPREAD(slot, ri, ra, rs, e1, a1, sa1); \
            { const int t3 = (tt + 3 * NGWL < T / 2) ? tt + 3 * NGWL : tt; V_LOAD(TOK(t3), ri, ra, rs); } } while (0)
        for (;;) {
            V_ITEM(A0, B0, A1, B1, 0); tt += NGWL; if (tt >= T / 2) break;
            V_ITEM(A1, B1, A0, B0, 1); tt += NGWL; if (tt >= T / 2) break;
        }
#undef V_ITEM
#undef V_LOAD
#undef V_SPREAD
#undef TOK
    }
    __syncthreads();
}
DI void final_norm(Frame& F) {
    FRAME_IDS;
    const float* part = (const float*)(F.ws + WS_PART); const bf16* hbp = (const bf16*)(F.ws + WS_XB);
    const int gw = F.bid * NWAVES + F.wave, NGW = F.G * NWAVES;
    for (int t = gw; t < T; t += NGW) {
        const float r = rstd_bcast(part, t);
        const u32x2* hp = (const u32x2*)(hbp + (size_t)t * DM) + f_lane;
        f32x4* op = (f32x4*)(F.out + (size_t)t * DM) + f_lane;
        const f32x4* gp = (const f32x4*)F.final_norm + f_lane;
#pragma unroll
        for (int q = 0; q < 4; ++q) { const u32x2 w = hp[64 * q];
            const f32x4 h = {__uint_as_float(w[0] << 16), __uint_as_float(w[0] & 0xffff0000u), __uint_as_float(w[1] << 16), __uint_as_float(w[1] & 0xffff0000u)};
            op[64 * q] = h * r * gp[64 * q]; }
    }
}
DI void opt_conv(Frame& F) {
    FRAME_IDS;
    const bf16* G = (const bf16*)(F.ws + WS_GLU); bf16* H2 = (bf16*)(F.ws + WS_HID2);
    LAS float* ys = (LAS float*)F.lds;
    f32x2 wt[CW];
#pragma unroll
    for (int j = 0; j < CW; ++j) wt[j] = *(const f32x2*)(F.conv_dw + j * DM + 2 * f_tid);
    const f32x2 bdw = *(const f32x2*)(F.conv_dw_b + 2 * f_tid);
    f32x4 lng[4], lnb[4];
#pragma unroll
    for (int k = 0; k < 4; ++k) { lng[k] = *(const f32x4*)(F.conv_ln_g + 256 * k + 4 * f_lane); lnb[k] = *(const f32x4*)(F.conv_ln_b + 256 * k + 4 * f_lane); }
    for (int it = F.bid; it < T / 128; it += F.G) {
        const int s0 = (it % (SEQ / 128)) * 128;
        const size_t row0 = (size_t)it * 128;
        const unsigned* gp = (const unsigned*)G + f_tid;
        f32x2 win[CW];
#pragma unroll
        for (int u = 0; u < CW - 1; ++u) { const int sp = s0 - (CW - 1) + u; const unsigned xv = sp >= 0 ? gp[(row0 - (CW - 1) + u) * 512] : 0u; win[u + 1] = (f32x2){__uint_as_float(xv << 16), __uint_as_float(xv & 0xffff0000u)}; }
        win[0] = (f32x2){0.f, 0.f};
        unsigned nx[CW], nn[CW];
#pragma unroll
        for (int u = 0; u < CW; ++u) nx[u] = (s0 + u < SEQ) ? gp[(row0 + u) * 512] : 0u;
        for (int bt = 0; bt < 5; ++bt) {
#pragma unroll
            for (int u = 0; u < CW; ++u) { const int sl = 31 * (bt + 1) + u; nn[u] = (bt < 4 && s0 + sl < SEQ) ? gp[(row0 + sl) * 512] : 0u; }
            __syncthreads();
#pragma unroll
            for (int u = 0; u < CW; ++u) {
                win[u] = (f32x2){__uint_as_float(nx[u] << 16), __uint_as_float(nx[u] & 0xffff0000u)};
                f32x2 a = bdw;
#pragma unroll
                for (int j = 0; j < CW; ++j) a = wt[j] * win[(u + 1 + j) % CW] + a;
                *(LAS f32x2*)(ys + u * DM + 2 * f_tid) = a;
            }
            __syncthreads();
            for (int u = F.wave; u < CW; u += NWAVES) {
                const int sl = 31 * bt + u;
                if (sl < 128) {
                    f32x4 v[4]; float sm = 0.f;
#pragma unroll
                    for (int k = 0; k < 4; ++k) { v[k] = *(const LAS f32x4*)(ys + u * DM + 256 * k + 4 * f_lane); sm += (v[k][0] + v[k][1]) + (v[k][2] + v[k][3]); }
                    const float mu = wave_sum(sm) * (1.f / DM);
                    float sq = 0.f;
#pragma unroll
                    for (int k = 0; k < 4; ++k) { v[k] = v[k] - mu; sq += (v[k][0] * v[k][0] + v[k][1] * v[k][1]) + (v[k][2] * v[k][2] + v[k][3] * v[k][3]); }
                    const float rs = 1.f / sqrtf(wave_sum(sq) * (1.f / DM) + EPS);
#pragma unroll
                    for (int k = 0; k < 4; ++k) {
                        f32x4 z = v[k] * rs * lng[k] + lnb[k];
#pragma unroll
                        for (int e = 0; e < 4; ++e) z[e] = z[e] / (1.f + __expf(-z[e]));
                        *(u32x2*)(H2 + (row0 + sl) * DM + 256 * k + 4 * f_lane) = (u32x2){cvtpk(z[0], z[1]), cvtpk(z[2], z[3])};
                    }
                }
            }
#pragma unroll
            for (int u = 0; u < CW; ++u) nx[u] = nn[u];
        }
    }
    __syncthreads();
}
enum Phase { PH_PREP = 0, PH_PROJ, PH_MIX, PH_WOUT, PH_Q0, PH_GU0, PH_GR0, PH_GV0, PH_W1, PH_CONV, PH_W2, PH_Q1, PH_GU1, PH_GR1, PH_GV1, PH_FINAL, PH_COUNT };
struct Args { const float* in[19]; float* out; unsigned char* ws; int ph_lo, ph_hi; };
#ifndef TEST_PHASE
#define TEST_PHASE -1
#endif

__global__ void __launch_bounds__(NTHR, 2) mega_fwd(Args args) {
    extern __shared__ __attribute__((aligned(16))) unsigned char lds[];
    Frame F;
    F.lds = (LAS unsigned char*)lds;
    F.wave = __builtin_amdgcn_readfirstlane((int)threadIdx.x >> 6); FRAME_IDS;
    F.G = gridDim.x; F.bid = blockIdx.x;
    F.x = args.in[0]; F.mix_norm = args.in[1]; F.ffn_norm = args.in[2]; F.final_norm = args.in[3]; F.w_in = args.in[4]; F.w_out = args.in[5]; F.rel_bias = args.in[6];
    F.conv_w1 = args.in[7]; F.conv_b1 = args.in[8]; F.conv_dw = args.in[9]; F.conv_dw_b = args.in[10]; F.conv_ln_g = args.in[11]; F.conv_ln_b = args.in[12];
    F.conv_w2 = args.in[13]; F.conv_b2 = args.in[14]; F.peer_wq = args.in[15]; F.peer_keys = args.in[16]; F.peer_u = args.in[17]; F.peer_v = args.in[18];
    F.out = args.out; F.ws = args.ws;
    volatile LAS unsigned* MISC = (volatile LAS unsigned*)(F.lds + MISC_OFF);
    for (int u = f_tid; u < (LDS_BYTES - LDSCTL_OFF) / 4; u += NTHR) ((LAS unsigned*)(F.lds + LDSCTL_OFF))[u] = 0u;
    __syncthreads();
    const int lo = args.ph_lo, hi = args.ph_hi;
    XcdBarrier bar; bar.bar = (unsigned*)(F.ws + WS_CTL) + CW_BAR; bar.x = 0; bar.st = nullptr;
    if (hi - lo > 1) bar = xcd_barrier_post((unsigned*)(F.ws + WS_CTL) + CW_BAR, MISC + 8);
#define IN(k) ((TEST_PHASE < 0 || TEST_PHASE == (k)) && lo <= (k) && (k) < hi)
#define SEAM(k) do { if (IN(k) && IN((k) + 1)) xcd_barrier(bar, F.wave); } while (0)
#define REPS(k) for (int rep_ = ((k) == REP_PHASE ? 0 : 1); rep_ < 2; ++rep_)
#define GEMM_PHASE(EPI, Aptr, Bptr, NN, ...) do { pg8::Gemm g{(const bf16*)(Aptr), (const bf16*)(Bptr), T, (NN), DM}; pg8::StaticOrder S; S.init(T, (NN), F.G, F.bid); \
        pg8::EPI E{__VA_ARGS__}; pg8::gemm_phase<pg8::EPI, pg8::StaticOrder, true, true>(F.lds, g, S, E, F.wave); } while (0)
    bf16* XB = (bf16*)(F.ws + WS_XB);
    float* PART = (float*)(F.ws + WS_PART); const float* ROPE = (const float*)(F.ws + WS_ROPE);
    if (IN(PH_PREP)) REPS(PH_PREP) { p0_prep(F); p0_weights(F); } SEAM(PH_PREP);
    if (PROBE_MODE == 9 && IN(PH_PREP) && IN(PH_PREP + 1)) { for (int xb_ = 0; xb_ < 8; ++xb_) xcd_barrier(bar, F.wave); }
    if (IN(PH_PROJ)) REPS(PH_PROJ) { GEMM_PHASE(EpiProj, XB, F.ws + WS_WIN, INC, (bf16*)(F.ws + WS_R), ROPE); } SEAM(PH_PROJ);
    if (IN(PH_MIX)) REPS(PH_MIX) { mix_phase(F, rep_); } SEAM(PH_MIX);
    if (IN(PH_WOUT)) REPS(PH_WOUT) { GEMM_PHASE(EpiRes, F.ws + WS_O, F.ws + WS_WOUT, DM, F.x, XB, PART, nullptr); } SEAM(PH_WOUT);
    if (IN(PH_Q0)) REPS(PH_Q0) { GEMM_PHASE(EpiQ, XB, F.ws + WS_WQ, DM, (bf16*)(F.ws + WS_Q), PART); asm volatile("s_waitcnt vmcnt(0)" ::: "memory"); __syncthreads(); opt_route(F, 0); } SEAM(PH_Q0);
    const bool census = (hi - lo > 1);
    if (IN(PH_GU0)) REPS(PH_GU0) { gather_u(F, 0, get_xinfo(F, census), rep_ == 0); } SEAM(PH_GU0);
    if (IN(PH_GR0)) REPS(PH_GR0) { gather_r(F, 0); } SEAM(PH_GR0);
    if (IN(PH_GV0)) REPS(PH_GV0) { gather_v(F, 0, get_xinfo(F, census), rep_ == 0); } SEAM(PH_GV0);
    if (IN(PH_W1)) REPS(PH_W1) { GEMM_PHASE(EpiGlu, XB, F.ws + WS_W1, 2 * DM, (bf16*)(F.ws + WS_GLU), PART, F.conv_b1); } SEAM(PH_W1);
    if (IN(PH_CONV)) REPS(PH_CONV) { opt_conv(F); } SEAM(PH_CONV);
    if (IN(PH_W2)) { GEMM_PHASE(EpiRes, F.ws + WS_HID2, F.ws + WS_W2, DM, nullptr, XB, PART, F.conv_b2); } SEAM(PH_W2);
    if (IN(PH_Q1)) REPS(PH_Q1) { GEMM_PHASE(EpiQ, XB, F.ws + WS_WQ + (size_t)DM * DM * 2, DM, (bf16*)(F.ws + WS_Q), PART); asm volatile("s_waitcnt vmcnt(0)" ::: "memory"); __syncthreads(); opt_route(F, 1); } SEAM(PH_Q1);
    if (IN(PH_GU1)) REPS(PH_GU1) { gather_u(F, 1, get_xinfo(F, census), rep_ == 0); } SEAM(PH_GU1);
    if (IN(PH_GR1)) REPS(PH_GR1) { gather_r(F, 1); } SEAM(PH_GR1);
    if (IN(PH_GV1)) REPS(PH_GV1) { gather_v(F, 1, get_xinfo(F, census), rep_ == 0); } SEAM(PH_GV1);
    if (IN(PH_FINAL)) { final_norm(F); }
#undef IN
#undef SEAM
}

extern "C" void kernel_launch(void* const* d_in, const int* in_sizes, int n_in, void* d_out, int out_size, void* d_ws, size_t ws_size, hipStream_t stream) {
    static int grid = 0;
    if (grid == 0) {
        if (n_in != 19 || out_size != T * DM || ws_size < WS_END) { fprintf(stderr, "kernel_launch: unexpected shapes (n_in %d out %d ws %zu)\n", n_in, out_size, ws_size); grid = -1; return; }
        int dev = 0, cus = 0;
        if (hipGetDevice(&dev) != hipSuccess || hipDeviceGetAttribute(&cus, hipDeviceAttributeMultiprocessorCount, dev) != hipSuccess) { grid = -1; return; }
        if (hipFuncSetAttribute((const void*)mega_fwd, hipFuncAttributeMaxDynamicSharedMemorySize, LDS_BYTES) != hipSuccess) { fprintf(stderr, "kernel_launch: hipFuncSetAttribute failed\n"); grid = -1; return; }
        (void)hipGetLastError();
        grid = cus;
    }
    if (grid < 0) return;
    (void)hipMemsetAsync((char*)d_ws + WS_CTL, 0, CTL_ZERO_BYTES, stream);
    Args a{};
    for (int i = 0; i < 19; ++i) a.in[i] = (const float*)d_in[i];
    a.out = (float*)d_out; a.ws = (unsigned char*)d_ws;
#if MK_ONE_LAUNCH
    a.ph_lo = 0; a.ph_hi = PH_COUNT;
    hipLaunchKernelGGL(mega_fwd, dim3(grid), dim3(NTHR), LDS_BYTES, stream, a);
#else
    for (int p = 0; p < PH_COUNT; ++p) { a.ph_lo = p; a.ph_hi = p + 1; hipLaunchKernelGGL(mega_fwd, dim3(grid), dim3(NTHR), LDS_BYTES, stream, a); }
#endif
}
```

```cpp
#include <hip/hip_runtime.h>
#include <cstdio>
#include <cstdint>

#ifndef REP_PHASE
#define REP_PHASE -1
#endif
#ifndef PROBE_MODE
#define PROBE_MODE 1
#endif
#ifndef MK_ONE_LAUNCH
#define MK_ONE_LAUNCH 1
#endif

#define GAS __attribute__((address_space(1)))
#define LAS __attribute__((address_space(3)))
#define DI __device__ __forceinline__
typedef unsigned short bf16;
typedef float f32x2 __attribute__((ext_vector_type(2)));
typedef float f32x4 __attribute__((ext_vector_type(4)));
typedef unsigned u32x2 __attribute__((ext_vector_type(2)));
typedef unsigned u32x4 __attribute__((ext_vector_type(4)));
typedef short bf16x8 __attribute__((ext_vector_type(8)));
typedef float f32x16 __attribute__((ext_vector_type(16)));

constexpr int NB = 16, SEQ = 2048, DM = 1024, T = NB * SEQ;
constexpr int CHUNK = 64, HD = 64, NHA = 8, NHB = 8, INC = 3584, NCH = SEQ / CHUNK;
constexpr int PH = 8, PK = 128, PE = PK * PK, PQD = 128, PTOP = 16, NSEL = PH * PTOP;
constexpr int CW = 31;
constexpr float EPS = 1e-6f;
constexpr float LOG2E = 1.4426950408889634f;
constexpr float XQ = 127.f / 6.f;
constexpr int NWAVES = 8, NTHR = NWAVES * 64;

constexpr int C_QA = 0, C_KA = 512, C_VA = 1024, C_QB = 1536, C_KB = 2048, C_VB = 2560, C_GB = 3072;

constexpr size_t MiB = 1u << 20;
constexpr size_t WS_CTL = 0, CTL_ZERO_BYTES = 1 * MiB;
constexpr size_t WS_WIN = 2 * MiB, WS_WOUT = 9 * MiB, WS_W1 = 11 * MiB, WS_W2 = 15 * MiB, WS_WQ = 17 * MiB;
constexpr size_t WS_ROPE = 22 * MiB;
constexpr size_t WS_PART = 23 * MiB;
constexpr size_t WS_EIDX = 26 * MiB;
constexpr size_t WS_GATE = 42 * MiB;
constexpr size_t WS_U8 = 64 * MiB, WS_V8 = 96 * MiB;
constexpr size_t WS_SC = 25 * MiB;
constexpr size_t WS_ROWSC = 59 * MiB;
constexpr size_t WS_COLSC = 60 * MiB;
constexpr size_t WS_SA = 58 * MiB;
constexpr size_t WS_PU = 256 * MiB;
constexpr size_t WS_A = 384 * MiB;
constexpr size_t WS_XB = 128 * MiB;
constexpr size_t WS_R = 192 * MiB;
constexpr size_t WS_O = 416 * MiB;
constexpr size_t WS_Q = 192 * MiB;
constexpr size_t WS_HID = 256 * MiB;
constexpr size_t WS_GLU = 384 * MiB;
constexpr size_t WS_HID2 = 448 * MiB;
constexpr size_t WS_END = 512 * MiB;
constexpr int CW_BAR = 4096, CW_QUEUE = 8192;

constexpr int RING_BYTES = 131072, LDSCTL_OFF = RING_BYTES, MISC_OFF = LDSCTL_OFF + 320, LDS_BYTES = 147456;

DI float bf2f(bf16 v) { return __uint_as_float(((unsigned)v) << 16); }
DI unsigned f2bf(float f) { unsigned u = __float_as_uint(f); return (u + 0x7fffu + ((u >> 16) & 1u)) >> 16; }
DI unsigned pk2(float lo, float hi) { return f2bf(lo) | (f2bf(hi) << 16); }
#define DPP_MOV_I(x, ctrl) __builtin_amdgcn_mov_dpp((x), (ctrl), 0xF, 0xF, false)
#define DPP_XOR1 0xB1
#define DPP_XOR2 0x4E
#define DPP_HMIRROR 0x141
#define DPP_ROR8 0x128
DI float swap32_add(const float a, const float b) { const auto r = __builtin_amdgcn_permlane32_swap(__float_as_uint(a), __float_as_uint(b), false, false); return __uint_as_float(r[0]) + __uint_as_float(r[1]); }
DI float swap16_add(const float a, const float b) { const auto r = __builtin_amdgcn_permlane16_swap(__float_as_uint(a), __float_as_uint(b), false, false); return __uint_as_float(r[0]) + __uint_as_float(r[1]); }
DI int swap32_addi(const int a, const int b) { const auto r = __builtin_amdgcn_permlane32_swap((unsigned)a, (unsigned)b, false, false); return (int)(r[0] + r[1]); }
DI int swap16_addi(const int a, const int b) { const auto r = __builtin_amdgcn_permlane16_swap((unsigned)a, (unsigned)b, false, false); return (int)(r[0] + r[1]); }
DI float wave_sum_fast(float v) {
    v += __int_as_float(DPP_MOV_I(__float_as_int(v), DPP_XOR1)); v += __int_as_float(DPP_MOV_I(__float_as_int(v), DPP_XOR2));
    v += __int_as_float(DPP_MOV_I(__float_as_int(v), DPP_HMIRROR)); v += __int_as_float(DPP_MOV_I(__float_as_int(v), DPP_ROR8));
    v = swap16_add(v, v); v = swap32_add(v, v);
    return v;
}
DI float wave_sum(float v) { return wave_sum_fast(v); }
DI float swap32_max(const float a) { const auto r = __builtin_amdgcn_permlane32_swap(__float_as_uint(a), __float_as_uint(a), false, false); return fmaxf(__uint_as_float(r[0]), __uint_as_float(r[1])); }
DI float swap16_max(const float a) { const auto r = __builtin_amdgcn_permlane16_swap(__float_as_uint(a), __float_as_uint(a), false, false); return fmaxf(__uint_as_float(r[0]), __uint_as_float(r[1])); }
DI float wave_max(float v) {
    v = fmaxf(v, __int_as_float(DPP_MOV_I(__float_as_int(v), DPP_XOR1))); v = fmaxf(v, __int_as_float(DPP_MOV_I(__float_as_int(v), DPP_XOR2)));
    v = fmaxf(v, __int_as_float(DPP_MOV_I(__float_as_int(v), DPP_HMIRROR))); v = fmaxf(v, __int_as_float(DPP_MOV_I(__float_as_int(v), DPP_ROR8)));
    v = swap16_max(v); v = swap32_max(v);
    return v;
}
DI float block_sum(float v, LAS float* red, int tid) {
    v = wave_sum(v);
    __syncthreads();
    if ((tid & 63) == 0) red[tid >> 6] = v;
    __syncthreads();
    float s = 0.f;
#pragma unroll
    for (int i = 0; i < NWAVES; ++i) s += red[i];
    return s;
}
DI float gelu_erf(float x) { return 0.5f * x * (1.f + erff(x * 0.70710678118654752f)); }
DI float sigmoidf(float x) { return 1.f / (1.f + __expf(-x)); }

DI int lane_id() { int r; asm volatile("v_mbcnt_lo_u32_b32 %0, -1, 0\n\tv_mbcnt_hi_u32_b32 %0, -1, %0" : "=v"(r)); return r; }
#define XB_TMO      128
#define XB_XCNT(j)  (256  + 64 * (j))
#define XB_XSUB(j)  (1280 + 64 * (j))
#define XB_XGEN(j)  (2304 + 64 * (j))
#define XB_TOP      3328
#define XB_TOPGEN   3392
#define XCD_BAR_WORDS 3456
#define XB_SPIN_CAP (1u << 22)
DI unsigned xb_ld(unsigned* p)              { return __hip_atomic_load(p, __ATOMIC_RELAXED, __HIP_MEMORY_SCOPE_AGENT); }
DI unsigned xb_add(unsigned* p, unsigned v) { return __hip_atomic_fetch_add(p, v, __ATOMIC_RELAXED, __HIP_MEMORY_SCOPE_AGENT); }
DI unsigned xb_xcc_id() { return (unsigned)__builtin_amdgcn_s_getreg((3 << 11) | 20) & 0xFu; }
#define XB_SPIN(cond, bar) do { unsigned _sp = 0; while (cond) { __builtin_amdgcn_s_sleep(1); \
    if ((++_sp & 255u) == 0u) { if (xb_ld(&(bar)[XB_TMO])) break; if (_sp > XB_SPIN_CAP) { atomicAdd(&(bar)[XB_TMO], 1u); break; } } } } while (0)
struct XcdBarrier { unsigned* bar; unsigned x; volatile LAS unsigned* st; };
DI XcdBarrier xcd_barrier_post(unsigned* bar, volatile LAS unsigned* st) {
    XcdBarrier b; b.bar = bar; b.x = xb_xcc_id(); b.st = st;
    if (threadIdx.x == 0) st[4] = xb_add(&bar[XB_XCNT(b.x)], 1u);
    return b;
}
DI void xcd_barrier_complete(unsigned* bar, unsigned x, unsigned& nloc, unsigned& nx) {
    const unsigned G = gridDim.x * gridDim.y * gridDim.z;
    unsigned sum, cnt, mine, sp = 0u;
    for (;;) {
        sum = 0u; cnt = 0u; mine = 0u;
#pragma unroll
        for (unsigned j = 0; j < 16; ++j) { const unsigned c = xb_ld(&bar[XB_XCNT(j)]); sum += c; cnt += (c > 0u) ? 1u : 0u; mine = (j == x) ? c : mine; }
        if (sum == G) break;
        __builtin_amdgcn_s_sleep(1);
        if ((++sp & 255u) == 0u) { if (xb_ld(&bar[XB_TMO])) break; if (sp > XB_SPIN_CAP) { atomicAdd(&bar[XB_TMO], 1u); break; } }
    }
    nloc = mine > 0u ? mine : 1u; nx = cnt > 0u ? cnt : 1u;
}
DI void xcd_barrier(const XcdBarrier& b, const int wave_id) {
    asm volatile("s_waitcnt vmcnt(0)" ::: "memory");
    __syncthreads();
    if (wave_id == 0 && lane_id() == 0) {
        unsigned* bar = b.bar;
        __builtin_amdgcn_s_waitcnt(0);
        unsigned nloc = b.st[0], nx = b.st[1];
        if (nloc == 0u) { xcd_barrier_complete(bar, b.x, nloc, nx); b.st[0] = nloc; b.st[1] = nx; }
        const unsigned old = xb_add(&bar[XB_XSUB(b.x)], 1u);
        const unsigned gen = old / nloc;
        if (old + 1u == (gen + 1u) * nloc) {
            __builtin_amdgcn_fence(__ATOMIC_RELEASE, "agent");
            asm volatile("s_waitcnt vmcnt(0)" ::: "memory");
            const unsigned og = xb_add(&bar[XB_TOP], 1u);
            const unsigned tg = og / nx;
            if (og + 1u == (tg + 1u) * nx) xb_add(&bar[XB_TOPGEN], 1u);
            else XB_SPIN(xb_ld(&bar[XB_TOPGEN]) == tg, bar);
            __builtin_amdgcn_fence(__ATOMIC_ACQUIRE, "agent");
            xb_add(&bar[XB_XGEN(b.x)], 1u);
            asm volatile("s_waitcnt vmcnt(0)" ::: "memory");
        } else {
            XB_SPIN(xb_ld(&bar[XB_XGEN(b.x)]) == gen, bar);
            __builtin_amdgcn_fence(__ATOMIC_ACQUIRE, "agent");
            asm volatile("s_waitcnt vmcnt(0)" ::: "memory");
        }
    }
    __syncthreads();
}

namespace pg8 {
#define PG8_LAS __attribute__((address_space(3)))
typedef unsigned short bf16_t;
typedef short bf16x8 __attribute__((ext_vector_type(8)));
typedef float f32x4 __attribute__((ext_vector_type(4)));
typedef unsigned u32x4 __attribute__((ext_vector_type(4)));
typedef int i32x4 __attribute__((ext_vector_type(4)));
constexpr int BM = 256, BK = 64, HALF = 128, HTB = HALF * BK * 2  , STAGE_BYTES = 8 * HTB, NXCD = 8, WGM = 8;

__host__ __device__ __forceinline__ int lds_byte(int r, int c) { const int st = (r >> 4) * 2 + (c >> 5), rr = r & 15, cc = c & 31, ob = rr * 64 + cc * 2; return st * 1024 + (ob ^ (((ob >> 9) & 1) << 5)); }
__host__ __device__ __forceinline__ void stage_rc(int b, int& R, int& C) { const int st = b / 1024, sb = b % 1024, swz = sb ^ (((sb >> 9) & 1) << 5); R = (st >> 1) * 16 + swz / 64; C = (st & 1) * 32 + (swz % 64) / 2; }
__host__ __device__ __forceinline__ int perm32(int rho) { const int n = rho >> 4, i = rho & 15; return 8 * (i >> 2) + 4 * n + (i & 3); }

struct Unit { int pm, pn; };
struct Gemm { const bf16_t* A; const bf16_t* Bt; int M, N, K; };

struct StaticOrder {
    int nM, nN, nwg, G, c;
    __host__ __device__ void init(int M, int N, int G_, int c_) { nM = M / BM; nN = N / BM; nwg = nM * nN; G = G_; c = c_; }
    __host__ __device__ bool next(int i, Unit& u) const {
        const long L = (long)i * G + c; if (L >= nwg) return false;
        int wgid = (int)L; { const int q = nwg / NXCD, r = nwg % NXCD, xcd = wgid % NXCD, off = wgid / NXCD; wgid = (xcd < r ? xcd * (q + 1) : r * (q + 1) + (xcd - r) * q) + off; }
        const int nig = WGM * nN, gid = wgid / nig, fm = gid * WGM, gsz = (nM - fm) < WGM ? (nM - fm) : WGM;
        u.pm = fm + ((wgid % nig) % gsz); u.pn = (wgid % nig) / gsz; return true;
    }
    __device__ __forceinline__ void a_ready(const Unit&) const {}
    __device__ __forceinline__ void done(const Unit&) const {}
};

__device__ __forceinline__ unsigned cvt_pk_bf16(float lo, float hi) { unsigned r; asm volatile("v_cvt_pk_bf16_f32 %0, %1, %2" : "=v"(r) : "v"(lo), "v"(hi)); return r; }
__device__ __forceinline__ float rstd16(const float* part, int r, int fq) {
    const f32x4 a = *(const f32x4*)(part + (size_t)r * 16 + 4 * fq);
    float s = (a[0] + a[1]) + (a[2] + a[3]);
    s = swap16_add(s, s); s = swap32_add(s, s);
    return 1.f / sqrtf(s * (1.f / 1024.f) + 1e-6f);
}
__device__ __forceinline__ u32x4 pack8(const f32x4 a, const f32x4 b) { u32x4 w; w.x = cvt_pk_bf16(a[0], a[1]); w.y = cvt_pk_bf16(a[2], a[3]); w.z = cvt_pk_bf16(b[0], b[1]); w.w = cvt_pk_bf16(b[2], b[3]); return w; }
#define rot(t1, t2, c, s) do { const float a_ = (t1) * (c) - (t2) * (s), b_ = (t1) * (s) + (t2) * (c); (t1) = a_; (t2) = b_; } while (0)

struct EpiProj {
    static constexpr bool PERM = true, AFTER_DRAIN = false;
    bf16_t* R; const float* rope;
    __device__ __forceinline__ void operator()(const f32x4 (&acc)[2][2][4][2], const Unit& u, int wr, int wc, int fr, int fq) const {
        const int type = u.pn >> 1, hg = u.pn & 1;
        const int colbase = type * 512 + (4 * hg + wc) * 64 + 8 * fq;
        const bool do_rope = (type == 3) || (type == 4);
#pragma unroll
        for (int ai = 0; ai < 2; ++ai)
#pragma unroll
            for (int m = 0; m < 4; ++m) {
                const int r = u.pm * BM + ai * HALF + wr * 64 + m * 16 + fr;
                f32x4 a0 = acc[ai][0][m][0], a1 = acc[ai][0][m][1], b0 = acc[ai][1][m][0], b1 = acc[ai][1][m][1];
                if (do_rope) {
                    const f32x4* rp = (const f32x4*)(rope + ((size_t)(r & 2047) * 32 + 8 * fq) * 2);
                    const f32x4 c0 = rp[0], c1 = rp[1], c2 = rp[2], c3 = rp[3];
                    rot(a0[0], b0[0], c0[0], c0[1]); rot(a0[1], b0[1], c0[2], c0[3]); rot(a0[2], b0[2], c1[0], c1[1]); rot(a0[3], b0[3], c1[2], c1[3]);
                    rot(a1[0], b1[0], c2[0], c2[1]); rot(a1[1], b1[1], c2[2], c2[3]); rot(a1[2], b1[2], c3[0], c3[1]); rot(a1[3], b1[3], c3[2], c3[3]);
                }
                bf16_t* rowp = R + (size_t)r * 3584 + colbase;
                *(u32x4*)(rowp) = pack8(a0, a1);
                *(u32x4*)(rowp + 32) = pack8(b0, b1);
            }
    }
};
struct EpiProj8 {
    static constexpr bool PERM = true, AFTER_DRAIN = false;
    bf16_t* R; const float* rope; const float* rowsc; const float* colsc;
    __device__ __forceinline__ void operator()(const f32x4 (&acc)[2][2][4][2], const Unit& u, int wr, int wc, int fr, int fq) const {
        const int type = u.pn >> 1, hg = u.pn & 1;
        const int colbase = type * 512 + (4 * hg + wc) * 64 + 8 * fq;
        const bool do_rope = (type == 3) || (type == 4);
        f32x4 cs[2][2];
#pragma unroll
        for (int bj = 0; bj < 2; ++bj)
#pragma unroll
            for (int n = 0; n < 2; ++n) cs[bj][n] = *(const f32x4*)(colsc + u.pn * BM + bj * HALF + wc * 32 + 8 * fq + 4 * n);
#pragma unroll
        for (int ai = 0; ai < 2; ++ai)
#pragma unroll
            for (int m = 0; m < 4; ++m) {
                const int r = u.pm * BM + ai * HALF + wr * 64 + m * 16 + fr;
                const float rs = rowsc[r];
                f32x4 v[2][2];
#pragma unroll
                for (int bj = 0; bj < 2; ++bj)
#pragma unroll
                    for (int n = 0; n < 2; ++n) { const i32x4 ia = __builtin_bit_cast(i32x4, acc[ai][bj][m][n]);
                        v[bj][n] = (f32x4){(float)ia[0], (float)ia[1], (float)ia[2], (float)ia[3]} * cs[bj][n] * rs; }
                f32x4 a0 = v[0][0], a1 = v[0][1], b0 = v[1][0], b1 = v[1][1];
                if (do_rope) {
                    const f32x4* rp = (const f32x4*)(rope + ((size_t)(r & 2047) * 32 + 8 * fq) * 2);
                    const f32x4 c0 = rp[0], c1 = rp[1], c2 = rp[2], c3 = rp[3];
                    rot(a0[0], b0[0], c0[0], c0[1]); rot(a0[1], b0[1], c0[2], c0[3]); rot(a0[2], b0[2], c1[0], c1[1]); rot(a0[3], b0[3], c1[2], c1[3]);
                    rot(a1[0], b1[0], c2[0], c2[1]); rot(a1[1], b1[1], c2[2], c2[3]); rot(a1[2], b1[2], c3[0], c3[1]); rot(a1[3], b1[3], c3[2], c3[3]);
                }
                bf16_t* rowp = R + (size_t)r * 3584 + colbase;
                *(u32x4*)(rowp) = pack8(a0, a1);
                *(u32x4*)(rowp + 32) = pack8(b0, b1);
            }
    }
};
struct EpiRes {
    static constexpr bool PERM = true, AFTER_DRAIN = false;
    const float* xf; bf16_t* hb; float* part; const float* bias;
    __device__ __forceinline__ void operator()(const f32x4 (&acc)[2][2][4][2], const Unit& u, int wr, int wc, int fr, int fq) const {
        const int col0 = u.pn * BM + wc * 32 + 8 * fq;
        f32x4 bv[2][2];
#pragma unroll
        for (int bj = 0; bj < 2; ++bj)
#pragma unroll
            for (int n = 0; n < 2; ++n) bv[bj][n] = bias ? *(const f32x4*)(bias + col0 + bj * HALF + 4 * n) : (f32x4){0.f, 0.f, 0.f, 0.f};
#pragma unroll
        for (int ai = 0; ai < 2; ++ai)
#pragma unroll
            for (int m = 0; m < 4; ++m) {
                const int r = u.pm * BM + ai * HALF + wr * 64 + m * 16 + fr;
                const size_t off = (size_t)r * 1024 + col0;
                float ss = 0.f;
#pragma unroll
                for (int bj = 0; bj < 2; ++bj) {
                    f32x4 x0, x1;
                    if (xf) { x0 = *(const f32x4*)(xf + off + bj * HALF); x1 = *(const f32x4*)(xf + off + bj * HALF + 4); }
                    else { const u32x4 w = *(const u32x4*)(hb + off + bj * HALF);
                           x0 = (f32x4){__uint_as_float(w[0] << 16), __uint_as_float(w[0] & 0xffff0000u), __uint_as_float(w[1] << 16), __uint_as_float(w[1] & 0xffff0000u)};
                           x1 = (f32x4){__uint_as_float(w[2] << 16), __uint_as_float(w[2] & 0xffff0000u), __uint_as_float(w[3] << 16), __uint_as_float(w[3] & 0xffff0000u)}; }
                    const f32x4 h0 = x0 + acc[ai][bj][m][0] + bv[bj][0], h1 = x1 + acc[ai][bj][m][1] + bv[bj][1];
                    *(u32x4*)(hb + off + bj * HALF) = pack8(h0, h1);
                    ss += (h0[0] * h0[0] + h0[1] * h0[1]) + (h0[2] * h0[2] + h0[3] * h0[3]) + (h1[0] * h1[0] + h1[1] * h1[1]) + (h1[2] * h1[2] + h1[3] * h1[3]);
                }
                ss = swap16_add(ss, ss); ss = swap32_add(ss, ss);
                if (fq == 0) part[(size_t)r * 16 + 4 * u.pn + wc] = ss;
            }
    }
};
struct EpiQ {
    static constexpr bool PERM = true, AFTER_DRAIN = false;
    bf16_t* O; const float* part;
    __device__ __forceinline__ void operator()(const f32x4 (&acc)[2][2][4][2], const Unit& u, int wr, int wc, int fr, int fq) const {
        const int col0 = u.pn * BM + wc * 32 + 8 * fq;
#pragma unroll
        for (int ai = 0; ai < 2; ++ai)
#pragma unroll
            for (int m = 0; m < 4; ++m) {
                const int r = u.pm * BM + ai * HALF + wr * 64 + m * 16 + fr;
                const float rs = rstd16(part, r, fq);
                bf16_t* rowp = O + (size_t)r * 1024 + col0;
#pragma unroll
                for (int bj = 0; bj < 2; ++bj) *(u32x4*)(rowp + bj * HALF) = pack8(acc[ai][bj][m][0] * rs, acc[ai][bj][m][1] * rs);
            }
    }
};
struct EpiGlu {
    static constexpr bool PERM = true, AFTER_DRAIN = false;
    bf16_t* G; const float* part; const float* b1;
    __device__ __forceinline__ void operator()(const f32x4 (&acc)[2][2][4][2], const Unit& u, int wr, int wc, int fr, int fq) const {
        const int col = u.pn * 128 + wc * 32 + 8 * fq;
        f32x4 ba[2], bg[2];
#pragma unroll
        for (int n = 0; n < 2; ++n) { ba[n] = *(const f32x4*)(b1 + col + 4 * n); bg[n] = *(const f32x4*)(b1 + 1024 + col + 4 * n); }
#pragma unroll
        for (int ai = 0; ai < 2; ++ai)
#pragma unroll
            for (int m = 0; m < 4; ++m) {
                const int r = u.pm * BM + ai * HALF + wr * 64 + m * 16 + fr;
                const float rs = rstd16(part, r, fq);
                f32x4 y[2];
#pragma unroll
                for (int n = 0; n < 2; ++n) {
                    const f32x4 a = acc[ai][0][m][n] * rs + ba[n], g = acc[ai][1][m][n] * rs + bg[n];
#pragma unroll
                    for (int i = 0; i < 4; ++i) y[n][i] = a[i] / (1.f + __expf(-g[i]));
                }
                *(u32x4*)(G + (size_t)r * 1024 + col) = pack8(y[0], y[1]);
            }
    }
};
template <class Epi, class Sched, bool ALIGN_EPI = false, bool SP2 = false, bool I8 = false>
__device__ __forceinline__ void gemm_phase(PG8_LAS unsigned char* lds, const Gemm g, const Sched& S, const Epi& E, const int wave_id) {
    const int lane = lane_id(), wid = wave_id, tid = wid * 64 + lane, wr = wid >> 2, wc = wid & 3, fr = lane & 15, fq = lane >> 4;
    const int K = g.K, nt = K / BK;
    unsigned voffA[2], voffB[2];
#pragma unroll
    for (int i = 0; i < 2; ++i) { int R, C; stage_rc(tid * 16 + i * 8192, R, C); const int Rb = Epi::PERM ? ((R & ~31) + perm32(R & 31)) : R;
        voffA[i] = (unsigned)(R * K + C) * 2u; voffB[i] = (unsigned)(Rb * K + C) * 2u; }
    const size_t kstep = (size_t)(BK * 2);
    const size_t hstep = (size_t)HALF * K * 2;
    const size_t tstep = 2 * hstep;
    const unsigned ldsw = (unsigned)wid * 1024u;
    const int aoff = lds_byte(wr * 64 + fr, fq * 8), boff = lds_byte(wc * 32 + fr, fq * 8);
#define PG8_SA(b, h) (((b) * 2 + (h)) * HTB)
#define PG8_SB(b, h) ((4 + (b) * 2 + (h)) * HTB)
#define PG8_STAGE(bufoff, gbase, voff) do { _Pragma("unroll") for (int _i = 0; _i < 2; ++_i) \
        __builtin_amdgcn_global_load_lds((const unsigned*)((const char*)(gbase) + (voff)[_i]), (PG8_LAS unsigned*)(lds + (bufoff) + ldsw + _i * 8192), 16, 0, 0); } while (0)
#define PG8_LDA(dst, b, h) do { _Pragma("unroll") for (int m = 0; m < 4; ++m) _Pragma("unroll") for (int k = 0; k < 2; ++k) dst[m][k] = *(const PG8_LAS bf16x8*)(lds + PG8_SA(b, h) + aoff + m * 2048 + k * 1024); } while (0)
#define PG8_LDB(dst, b, h) do { _Pragma("unroll") for (int n = 0; n < 2; ++n) _Pragma("unroll") for (int k = 0; k < 2; ++k) dst[n][k] = *(const PG8_LAS bf16x8*)(lds + PG8_SB(b, h) + boff + n * 2048 + k * 1024); } while (0)
#define PG8_MMA(ai, bj, At, Bt) do { __builtin_amdgcn_s_setprio(1); _Pragma("unroll") for (int m = 0; m < 4; ++m) _Pragma("unroll") for (int n = 0; n < 2; ++n) _Pragma("unroll") for (int k = 0; k < 2; ++k) { \
        if constexpr (I8) acc[ai][bj][m][n] = __builtin_bit_cast(f32x4, __builtin_amdgcn_mfma_i32_16x16x64_i8(__builtin_bit_cast(i32x4, Bt[n][k]), __builtin_bit_cast(i32x4, At[m][k]), __builtin_bit_cast(i32x4, acc[ai][bj][m][n]), 0, 0, 0)); \
        else acc[ai][bj][m][n] = __builtin_amdgcn_mfma_f32_16x16x32_bf16(Bt[n][k], At[m][k], acc[ai][bj][m][n], 0, 0, 0); } __builtin_amdgcn_s_setprio(0); } while (0)
#define PG8_WAIT_V(n) asm volatile("s_waitcnt vmcnt(" #n ")" ::: "memory")
#define PG8_WAIT_L(n) asm volatile("s_waitcnt lgkmcnt(" #n ")" ::: "memory")
#define PG8_BAR __builtin_amdgcn_s_barrier()
#define PG8_SCHED __builtin_amdgcn_sched_barrier(0)
    Unit cur, nxt; int ui = 0;
    if (!S.next(0, cur)) return;
    f32x4 acc[2][2][4][2];
#pragma unroll
    for (int a = 0; a < 2; ++a)
#pragma unroll
        for (int b = 0; b < 2; ++b)
#pragma unroll
            for (int m = 0; m < 4; ++m)
#pragma unroll
                for (int n = 0; n < 2; ++n) acc[a][b][m][n] = (f32x4){0.f, 0.f, 0.f, 0.f};
    bf16x8 At[4][2], B0[2][2], B1[2][2];
    const char* cA = (const char*)g.A + (size_t)cur.pm * tstep; const char* cB = (const char*)g.Bt + (size_t)cur.pn * tstep;
    S.a_ready(cur);
    if constexpr (SP2) {
        PG8_STAGE(PG8_SB(0, 0), cB, voffB); PG8_STAGE(PG8_SB(0, 1), cB + hstep, voffB); PG8_STAGE(PG8_SA(0, 0), cA, voffA); PG8_STAGE(PG8_SA(0, 1), cA + hstep, voffA);
        if (wr == 1) PG8_BAR;
        PG8_WAIT_V(2); PG8_BAR;
        PG8_STAGE(PG8_SB(1, 0), cB + kstep, voffB); PG8_STAGE(PG8_SA(1, 0), cA + kstep, voffA); PG8_STAGE(PG8_SB(1, 1), cB + hstep + kstep, voffB);
        PG8_WAIT_V(6); PG8_BAR;
    } else {
        PG8_STAGE(PG8_SB(0, 0), cB, voffB); PG8_STAGE(PG8_SA(0, 0), cA, voffA); PG8_STAGE(PG8_SB(0, 1), cB + hstep, voffB); PG8_STAGE(PG8_SA(0, 1), cA + hstep, voffA);
        if (wr == 1) PG8_BAR;
        PG8_WAIT_V(4); PG8_BAR;
        PG8_STAGE(PG8_SB(1, 0), cB + kstep, voffB); PG8_STAGE(PG8_SA(1, 0), cA + kstep, voffA); PG8_STAGE(PG8_SB(1, 1), cB + hstep + kstep, voffB);
        PG8_WAIT_V(6); PG8_BAR;
    }
    for (;;) {
        const bool has_next = S.next(ui + 1, nxt);
        const char* nA = has_next ? (const char*)g.A + (size_t)nxt.pm * tstep : cA; const char* nB = has_next ? (const char*)g.Bt + (size_t)nxt.pn * tstep : cB;
        for (int t = 0; t < nt; t += 2) {
            const bool last = (t == nt - 2);
            const char* a1 = cA + (size_t)(t + 1) * kstep;
            const char* a2 = last ? nA : cA + (size_t)(t + 2) * kstep; const char* b2 = last ? nB : cB + (size_t)(t + 2) * kstep;
            const char* a3 = a2 + kstep; const char* b3 = b2 + kstep;
            if (last && has_next) S.a_ready(nxt);
            if constexpr (SP2) {
            PG8_LDB(B0, 0, 0); PG8_LDB(B1, 0, 1); PG8_SCHED; PG8_LDA(At, 0, 0); PG8_STAGE(PG8_SA(1, 1), a1 + hstep, voffA);
            PG8_WAIT_V(8); PG8_WAIT_L(0); PG8_BAR; PG8_MMA(0, 0, At, B0); PG8_MMA(0, 1, At, B1); PG8_BAR; PG8_SCHED;
            PG8_LDA(At, 0, 1); PG8_STAGE(PG8_SB(0, 0), b2, voffB); PG8_STAGE(PG8_SB(0, 1), b2 + hstep, voffB); PG8_STAGE(PG8_SA(0, 0), a2, voffA);
            PG8_WAIT_V(8); PG8_WAIT_L(0); PG8_BAR; PG8_MMA(1, 0, At, B0); PG8_MMA(1, 1, At, B1); PG8_BAR; PG8_SCHED;
            PG8_LDB(B0, 1, 0); PG8_LDB(B1, 1, 1); PG8_SCHED; PG8_LDA(At, 1, 0); PG8_STAGE(PG8_SA(0, 1), a2 + hstep, voffA);
            PG8_WAIT_V(8); PG8_WAIT_L(0); PG8_BAR; PG8_MMA(0, 0, At, B0); PG8_MMA(0, 1, At, B1); PG8_BAR; PG8_SCHED;
            PG8_LDA(At, 1, 1); PG8_STAGE(PG8_SB(1, 0), b3, voffB); PG8_STAGE(PG8_SB(1, 1), b3 + hstep, voffB); PG8_STAGE(PG8_SA(1, 0), a3, voffA);
            PG8_WAIT_V(8); PG8_WAIT_L(0); PG8_BAR; PG8_MMA(1, 0, At, B0); PG8_MMA(1, 1, At, B1); PG8_BAR; PG8_SCHED;
            } else {
            PG8_LDB(B0, 0, 0); PG8_SCHED; PG8_LDA(At, 0, 0); PG8_STAGE(PG8_SA(1, 1), a1 + hstep, voffA);
            PG8_WAIT_L(8); PG8_BAR; PG8_WAIT_L(0); PG8_MMA(0, 0, At, B0); PG8_BAR; PG8_SCHED;
            PG8_LDB(B1, 0, 1); PG8_STAGE(PG8_SB(0, 0), b2, voffB);
            PG8_BAR; PG8_WAIT_L(0); PG8_MMA(0, 1, At, B1); PG8_BAR;
            PG8_LDA(At, 0, 1); PG8_STAGE(PG8_SA(0, 0), a2, voffA);
            PG8_BAR; PG8_WAIT_L(0); PG8_MMA(1, 0, At, B0); PG8_BAR; PG8_SCHED;
            PG8_STAGE(PG8_SB(0, 1), b2 + hstep, voffB);
            PG8_WAIT_V(6); PG8_BAR; PG8_MMA(1, 1, At, B1); PG8_BAR;
            PG8_LDB(B0, 1, 0); PG8_SCHED; PG8_LDA(At, 1, 0); PG8_STAGE(PG8_SA(0, 1), a2 + hstep, voffA);
            PG8_WAIT_L(8); PG8_BAR; PG8_WAIT_L(0); PG8_MMA(0, 0, At, B0); PG8_BAR; PG8_SCHED;
            PG8_LDB(B1, 1, 1); PG8_STAGE(PG8_SB(1, 0), b3, voffB);
            PG8_BAR; PG8_WAIT_L(0); PG8_MMA(0, 1, At, B1); PG8_BAR;
            PG8_LDA(At, 1, 1); PG8_STAGE(PG8_SA(1, 0), a3, voffA);
            PG8_BAR; PG8_WAIT_L(0); PG8_MMA(1, 0, At, B0); PG8_BAR; PG8_SCHED;
            PG8_STAGE(PG8_SB(1, 1), b3 + hstep, voffB);
            PG8_WAIT_V(6); PG8_BAR; PG8_MMA(1, 1, At, B1); PG8_BAR;
            }
        }
        if constexpr (ALIGN_EPI) { if (wr == 0) PG8_BAR; }
        if constexpr (!Epi::AFTER_DRAIN) { E(acc, cur, wr, wc, fr, fq); S.done(cur); }
        if (!has_next) break;
#pragma unroll
        for (int a = 0; a < 2; ++a)
#pragma unroll
            for (int b = 0; b < 2; ++b)
#pragma unroll
                for (int m = 0; m < 4; ++m)
#pragma unroll
                    for (int n = 0; n < 2; ++n) acc[a][b][m][n] = (f32x4){0.f, 0.f, 0.f, 0.f};
        cur = nxt; cA = nA; cB = nB; ++ui;
        if constexpr (ALIGN_EPI) { if (wr == 1) PG8_BAR; }
    }
    PG8_WAIT_V(0);
    if constexpr (!ALIGN_EPI) { if (wr == 0) PG8_BAR; }
    PG8_BAR;
    if constexpr (Epi::AFTER_DRAIN) { E.fused(acc, cur, wr, wc, fr, fq, lds, wid, lane); S.done(cur); }
#undef PG8_SA
#undef PG8_SB
#undef PG8_STAGE
#undef PG8_LDA
#undef PG8_LDB
#undef PG8_MMA
#undef PG8_WAIT_V
#undef PG8_WAIT_L
#undef PG8_BAR
#undef PG8_SCHED
}
}

struct Frame {
    LAS unsigned char* lds;
    int wave, G, bid;
    const float *x, *mix_norm, *ffn_norm, *final_norm, *w_in, *w_out, *rel_bias, *conv_w1, *conv_b1, *conv_dw, *conv_dw_b, *conv_ln_g, *conv_ln_b, *conv_w2, *conv_b2,
        *peer_wq, *peer_keys, *peer_u, *peer_v;
    float* out;
    unsigned char* ws;
};
#define FRAME_IDS const int f_lane = lane_id(); const int f_tid = F.wave * 64 + f_lane; (void)f_tid
DI float gamma_of(int h) { return 1.f - exp2f(-5.f - (float)h); }

DI unsigned q8x4(f32x4 v, const float sc) {
    const int a = (int)rintf(v[0] * sc), b = (int)rintf(v[1] * sc), c = (int)rintf(v[2] * sc), d = (int)rintf(v[3] * sc);
    return ((unsigned)a & 0xFFu) | (((unsigned)b & 0xFFu) << 8) | (((unsigned)c & 0xFFu) << 16) | ((unsigned)d << 24);
}
DI void p0_prep(Frame& F) {
    FRAME_IDS;
    const int gw = F.bid * NWAVES + F.wave, NGW = F.G * NWAVES;
    f32x2* rope = (f32x2*)(F.ws + WS_ROPE);
    for (int i = F.bid * NTHR + f_tid; i < SEQ * 32; i += F.G * NTHR) {
        const int s = i >> 5, j = i & 31;
        const float inv = powf(10000.f, -(float)j / 32.f);
        const float ang = (float)s * inv;
        float sn, cs; sincosf(ang, &sn, &cs);
        rope[i] = (f32x2){cs, sn};
    }
    unsigned* xq = (unsigned*)(F.ws + WS_XB); float* rowsc = (float*)(F.ws + WS_ROWSC);
    for (int m = gw; m < T; m += NGW) {
        const f32x4* xr = (const f32x4*)(F.x + (size_t)m * DM) + f_lane;
        f32x4 v[4]; float s = 0.f, am = 0.f;
#pragma unroll
        for (int j = 0; j < 4; ++j) { v[j] = xr[64 * j]; s += v[j].x * v[j].x + v[j].y * v[j].y + v[j].z * v[j].z + v[j].w * v[j].w; am = fmaxf(am, fmaxf(fmaxf(fabsf(v[j].x), fabsf(v[j].y)), fmaxf(fabsf(v[j].z), fabsf(v[j].w)))); }
        const float r = 1.f / sqrtf(wave_sum(s) * (1.f / DM) + EPS);
        am = wave_max(am);
        const float sc = am > 0.f ? 127.f / am : 0.f;
#pragma unroll
        for (int j = 0; j < 4; ++j) xq[(size_t)m * (DM / 4) + f_lane + 64 * j] = q8x4(v[j], sc);
        if (f_lane == 0) rowsc[m] = am * (1.f / 127.f) * r;
    }
}
DI void p0_transpose_item(const float* W, int K, int N, bf16* WT, int prow0, const float* gain, float scale, LAS float* scr, int k0, int n0, int lane) {
#pragma unroll 8
    for (int i = 0; i < 32; ++i) { const int kk = 2 * i + (lane >> 5); scr[kk * 33 + (lane & 31)] = W[(size_t)(k0 + kk) * N + n0 + (lane & 31)] * (gain ? gain[k0 + kk] : 1.f) * scale; }
    asm volatile("s_waitcnt lgkmcnt(0)" ::: "memory");
    const int c = lane & 7;
#pragma unroll
    for (int j = 0; j < 4; ++j) { const int n = (lane >> 3) + 8 * j; const LAS float* q = scr + (8 * c) * 33 + n;
        u32x4 o; o.x = pk2(q[0 * 33], q[1 * 33]); o.y = pk2(q[2 * 33], q[3 * 33]); o.z = pk2(q[4 * 33], q[5 * 33]); o.w = pk2(q[6 * 33], q[7 * 33]);
        *(u32x4*)(WT + (size_t)(prow0 + n) * K + k0 + 8 * c) = o; }
    asm volatile("s_waitcnt lgkmcnt(0)" ::: "memory");
}
DI void p0_amax_item(const float* W, int N, unsigned* colmax, const float* gain, float scale, int k0, int n0, int lane) {
    float am = 0.f;
#pragma unroll 8
    for (int i = 0; i < 32; ++i) { const int kk = 2 * i + (lane >> 5); am = fmaxf(am, fabsf(W[(size_t)(k0 + kk) * N + n0 + (lane & 31)] * (gain ? gain[k0 + kk] : 1.f) * scale)); }
    am = swap32_max(am);
    if (lane < 32) __hip_atomic_fetch_max(colmax + lane, __float_as_uint(am), __ATOMIC_RELAXED, __HIP_MEMORY_SCOPE_AGENT);
}
DI void p0_q8_item(const float* W, int N, unsigned char* WT, const unsigned* colmax, float* colsc, int prow0, const float* gain, float scale, LAS float* scr, int k0, int n0, int lane) {
    const float am = __uint_as_float(colmax[lane & 31]);
    const float sc = am > 0.f ? 127.f / am : 0.f;
    if (k0 == 0 && lane < 32) colsc[lane] = am * (1.f / 127.f);
#pragma unroll 8
    for (int i = 0; i < 32; ++i) { const int kk = 2 * i + (lane >> 5); scr[kk * 33 + (lane & 31)] = rintf(W[(size_t)(k0 + kk) * N + n0 + (lane & 31)] * (gain ? gain[k0 + kk] : 1.f) * scale * sc); }
    asm volatile("s_waitcnt lgkmcnt(0)" ::: "memory");
    const int ch = lane & 3;
#pragma unroll
    for (int j = 0; j < 2; ++j) { const int n = (lane >> 2) + 16 * j; const LAS float* q = scr + (16 * ch) * 33 + n;
        u32x4 o;
#pragma unroll
        for (int w = 0; w < 4; ++w) o[w] = ((unsigned)(int)q[(4 * w) * 33] & 0xFFu) | (((unsigned)(int)q[(4 * w + 1) * 33] & 0xFFu) << 8) | (((unsigned)(int)q[(4 * w + 2) * 33] & 0xFFu) << 16) | ((unsigned)(int)q[(4 * w + 3) * 33] << 24);
        *(u32x4*)(WT + (size_t)(prow0 + n) * DM + k0 + 16 * ch) = o; }
    asm volatile("s_waitcnt lgkmcnt(0)" ::: "memory");
}
constexpr int CW_COLMAX = 16384;
constexpr int CS_WIN = 0, CS_WOUT = 3584, CS_W1 = 4608, CS_W2 = 6656, CS_WQ = 7680;
constexpr bool I8_WIN = true, I8_WOUT = false, I8_W1 = false, I8_W2 = false, I8_WQ = false;
DI void p0_weights(Frame& F, const int pass) {
    FRAME_IDS;
    LAS float* scr = (LAS float*)(F.lds + F.wave * 16384);
    unsigned* colmax = (unsigned*)(F.ws + WS_CTL) + CW_COLMAX; float* colsc = (float*)(F.ws + WS_COLSC);
    const int gw = F.bid * NWAVES + F.wave, NGW = F.G * NWAVES;
    constexpr int I_IN = 16 * (INC / 32), I_SQ = 16 * (DM / 32), I_W1 = 16 * (2 * DM / 32);
    constexpr int NITEMS = I_IN + I_SQ + I_W1 + I_SQ + 2 * I_SQ;
#define WITEM(I8FLAG, Wp, Nn, WTb, CSo, prow0, gainp, scl, k0, n0) do { \
        if (pass == 0) { if (I8FLAG) p0_amax_item(Wp, Nn, colmax + (CSo) + (prow0), gainp, scl, k0, n0, f_lane); } \
        else if (I8FLAG) p0_q8_item(Wp, Nn, (unsigned char*)(WTb), colmax + (CSo) + (prow0), colsc + (CSo) + (prow0), prow0, gainp, scl, scr, k0, n0, f_lane); \
        else p0_transpose_item(Wp, DM, Nn, (bf16*)(WTb), prow0, gainp, scl, scr, k0, n0, f_lane); } while (0)
    for (int it = gw; it < NITEMS; it += NGW) {
        int r = it;
        if (r < I_IN) { const int nb = r % (INC / 32), kb = r / (INC / 32), n0 = nb * 32;
            const int type = n0 / 512, head = (n0 % 512) / 64, bj = (n0 % 64) / 32;
            const int prow0 = 256 * (2 * type + head / 4) + 128 * bj + 32 * (head % 4);
            WITEM(I8_WIN, F.w_in, INC, F.ws + WS_WIN, CS_WIN, prow0, F.mix_norm, (type == 0 ? 0.125f * LOG2E : (type == 4 ? 0.125f : 1.f)), kb * 64, n0); continue; }
        r -= I_IN;
        if (r < I_SQ) { const int nb = r % 32, kb = r / 32; WITEM(I8_WOUT, F.w_out, DM, F.ws + WS_WOUT, CS_WOUT, nb * 32, (const float*)nullptr, 1.f, kb * 64, nb * 32); continue; }
        r -= I_SQ;
        if (r < I_W1) { const int nb = r % 64, kb = r / 64, n0 = nb * 32; const int bj = n0 / 1024, rem = n0 % 1024;
            WITEM(I8_W1, F.conv_w1, 2 * DM, F.ws + WS_W1, CS_W1, 256 * (rem / 128) + 128 * bj + (rem % 128), F.mix_norm + DM, 1.f, kb * 64, n0); continue; }
        r -= I_W1;
        if (r < I_SQ) { const int nb = r % 32, kb = r / 32; WITEM(I8_W2, F.conv_w2, DM, F.ws + WS_W2, CS_W2, nb * 32, (const float*)nullptr, 1.f, kb * 64, nb * 32); continue; }
        r -= I_SQ;
        { const int layer = r / I_SQ; r %= I_SQ; const int nb = r % 32, kb = r / 32;
          WITEM(I8_WQ, F.peer_wq + (size_t)layer * DM * DM, DM, F.ws + WS_WQ + (size_t)layer * DM * DM * 2, CS_WQ + layer * DM, nb * 32, F.ffn_norm + layer * DM, 1.f, kb * 64, nb * 32); }
    }
#undef WITEM
}
DI float row_rstd(const float* part, int m) {
    const f32x4* p = (const f32x4*)(part + (size_t)m * 16);
    const f32x4 a = p[0], b = p[1], c = p[2], d = p[3];
    const float s = ((a.x + a.y) + (a.z + a.w)) + ((b.x + b.y) + (b.z + b.w)) + ((c.x + c.y) + (c.z + c.w)) + ((d.x + d.y) + (d.z + d.w));
    return 1.f / sqrtf(s * (1.f / DM) + EPS);
}

typedef short v4i16 __attribute__((ext_vector_type(4)));
typedef __bf16 bf16x2_t __attribute__((ext_vector_type(2)));
DI unsigned cvtpk(float lo, float hi) { f32x2 v = {lo, hi}; bf16x2_t b = __builtin_convertvector(v, bf16x2_t); return __builtin_bit_cast(unsigned, b); }
DI v4i16 ds_tr16(LAS const unsigned char* p) { return __builtin_amdgcn_ds_read_tr16_b64_v4i16((LAS v4i16*)p); }
DI int crow(int r, int h) { return (r & 3) + 8 * (r >> 2) + 4 * h; }
DI bf16x8 pack_step(const f32x16& x, const int s) {
    u32x4 w = {cvtpk(x[8 * s + 0], x[8 * s + 1]), cvtpk(x[8 * s + 2], x[8 * s + 3]), cvtpk(x[8 * s + 4], x[8 * s + 5]), cvtpk(x[8 * s + 6], x[8 * s + 7])};
    return __builtin_bit_cast(bf16x8, w);
}
constexpr int AT_KB = 64 * 144, AT_VB = 8192, AT_BUF = AT_KB + AT_VB, AT_BIAS = 2 * AT_BUF;
DI void attn_item(Frame& F, const int it) {
    FRAME_IDS;
    const bf16* R = (const bf16*)(F.ws + WS_R); bf16* O = (bf16*)(F.ws + WS_O);
    LAS unsigned char* lds = F.lds;
    LAS float* bias_s = (LAS float*)(lds + AT_BIAS);
    const int q32 = f_lane & 31, h = f_lane >> 5, w = F.wave;
    const int srow = f_tid >> 3, sch = f_tid & 7;
    const int vtr_off = ((f_lane & 15) >> 2) * 64 + (16 * ((f_lane >> 4) & 1) + 4 * (f_lane & 3)) * 2;
    {
        const int b = it / (NHA * 8), hd = (it / 8) % NHA, c0 = (it % 8) * 4;
        const int c = c0 + (w >> 1), qrow0 = 32 * (w & 1);
        const size_t tq = (size_t)b * SEQ + c * 64 + qrow0 + q32;
        __syncthreads();
        for (int k = f_tid; k < 257; k += NTHR) bias_s[k] = F.rel_bias[hd * 257 + k] * LOG2E;
        bf16x8 qf[4];
#pragma unroll
        for (int ks = 0; ks < 4; ++ks) qf[ks] = *(const bf16x8*)(R + tq * INC + C_QA + hd * 64 + 16 * ks + 8 * h);
        const int t_lo = c0 - 8 < 0 ? 0 : c0 - 8, t_hi = c0 + 3, ntile = t_hi - t_lo + 1;
        const bf16* kbase = R + ((size_t)b * SEQ + srow) * INC + C_KA + hd * 64 + 8 * sch;
        const bf16* vbase = R + ((size_t)b * SEQ + srow) * INC + C_VA + hd * 64 + 8 * sch;
        u32x4 kreg = *(const u32x4*)(kbase + (size_t)t_lo * 64 * INC), vreg = *(const u32x4*)(vbase + (size_t)t_lo * 64 * INC);
        *(LAS u32x4*)(lds + srow * 144 + sch * 16) = kreg;
        *(LAS u32x4*)(lds + AT_KB + (sch >> 2) * 4096 + srow * 64 + (sch & 3) * 16) = vreg;
        __syncthreads();
        const float bias_far = bias_s[256];
        float m = -1e30f, l = 0.f;
        f32x16 o0 = {}, o1 = {};
        for (int i = 0; i < ntile; ++i) {
            const int tc = t_lo + i;
            LAS unsigned char* kb = lds + (i & 1) * AT_BUF; LAS unsigned char* vb = kb + AT_KB;
            if (i + 1 < ntile) { kreg = *(const u32x4*)(kbase + (size_t)(tc + 1) * 64 * INC); vreg = *(const u32x4*)(vbase + (size_t)(tc + 1) * 64 * INC); }
            const int D = c - tc;
            if (D >= 0 && D <= 8) {
                const float init = D >= 3 ? bias_far : 0.f;
                f32x16 p0, p1;
#pragma unroll
                for (int r = 0; r < 16; ++r) { p0[r] = init; p1[r] = init; }
#pragma unroll
                for (int ks = 0; ks < 4; ++ks) {
                    const bf16x8 k0 = *(const LAS bf16x8*)(kb + q32 * 144 + (16 * ks + 8 * h) * 2);
                    const bf16x8 k1 = *(const LAS bf16x8*)(kb + (32 + q32) * 144 + (16 * ks + 8 * h) * 2);
                    p0 = __builtin_amdgcn_mfma_f32_32x32x16_bf16(k0, qf[ks], p0, 0, 0, 0);
                    p1 = __builtin_amdgcn_mfma_f32_32x32x16_bf16(k1, qf[ks], p1, 0, 0, 0);
                }
                if (D < 3) {
                    const int relb = D * 64 + qrow0 + q32 - 4 * h + 128;
#pragma unroll
                    for (int r = 0; r < 16; ++r) {
                        const int r0 = relb - ((r & 3) + 8 * (r >> 2));
                        const int i0 = r0 < 0 ? 0 : (r0 > 256 ? 256 : r0), r1 = r0 - 32, i1 = r1 < 0 ? 0 : (r1 > 256 ? 256 : r1);
                        p0[r] += bias_s[i0]; p1[r] += bias_s[i1];
                    }
                }
                float tm = fmaxf(p0[0], p1[0]);
#pragma unroll
                for (int r = 1; r < 16; ++r) tm = fmaxf(tm, fmaxf(p0[r], p1[r]));
                tm = swap32_max(tm);
                const float mn = fmaxf(m, tm), alpha = __builtin_amdgcn_exp2f(m - mn);
                m = mn;
                float ps = 0.f;
#pragma unroll
                for (int r = 0; r < 16; ++r) { p0[r] = __builtin_amdgcn_exp2f(p0[r] - mn); p1[r] = __builtin_amdgcn_exp2f(p1[r] - mn); ps += p0[r] + p1[r]; }
                l = l * alpha + ps;
                if (!__all(alpha == 1.f)) {
#pragma unroll
                    for (int r = 0; r < 16; ++r) { o0[r] *= alpha; o1[r] *= alpha; }
                }
                bf16x8 pf[4];
                pf[0] = pack_step(p0, 0); pf[1] = pack_step(p0, 1); pf[2] = pack_step(p1, 0); pf[3] = pack_step(p1, 1);
#pragma unroll
                for (int kk = 0; kk < 4; ++kk) {
                    const int key0 = 16 * kk + 4 * h;
                    const v4i16 a0l = ds_tr16(vb + key0 * 64 + vtr_off), a0h = ds_tr16(vb + (key0 + 8) * 64 + vtr_off);
                    const v4i16 a1l = ds_tr16(vb + 4096 + key0 * 64 + vtr_off), a1h = ds_tr16(vb + 4096 + (key0 + 8) * 64 + vtr_off);
                    const bf16x8 a0 = __builtin_shufflevector(a0l, a0h, 0, 1, 2, 3, 4, 5, 6, 7), a1 = __builtin_shufflevector(a1l, a1h, 0, 1, 2, 3, 4, 5, 6, 7);
                    o0 = __builtin_amdgcn_mfma_f32_32x32x16_bf16(a0, pf[kk], o0, 0, 0, 0);
                    o1 = __builtin_amdgcn_mfma_f32_32x32x16_bf16(a1, pf[kk], o1, 0, 0, 0);
                }
            }
            if (i + 1 < ntile) {
                LAS unsigned char* nb = lds + ((i + 1) & 1) * AT_BUF;
                *(LAS u32x4*)(nb + srow * 144 + sch * 16) = kreg;
                *(LAS u32x4*)(nb + AT_KB + (sch >> 2) * 4096 + srow * 64 + (sch & 3) * 16) = vreg;
            }
            __syncthreads();
        }
        l = swap32_add(l, l);
        const float inv = 1.f / l;
        bf16* op = O + tq * DM + hd * 64 + 4 * h;
#pragma unroll
        for (int g = 0; g < 4; ++g) {
            *(u32x2*)(op + 8 * g) = (u32x2){cvtpk(o0[4 * g] * inv, o0[4 * g + 1] * inv), cvtpk(o0[4 * g + 2] * inv, o0[4 * g + 3] * inv)};
            *(u32x2*)(op + 32 + 8 * g) = (u32x2){cvtpk(o1[4 * g] * inv, o1[4 * g + 1] * inv), cvtpk(o1[4 * g + 2] * inv, o1[4 * g + 3] * inv)};
        }
    }
    __syncthreads();
}

constexpr int RT_Q = 0, RT_K = 9216, RT_KD = 18432, RT_V = 26624, RT_BUF = 34816, RT_ZS = 2 * RT_BUF, RT_CS = RT_ZS + 64 * 66 * 4;
DI void ret_item(Frame& F, const int it) {
    FRAME_IDS;
    const bf16* R = (const bf16*)(F.ws + WS_R); bf16* O = (bf16*)(F.ws + WS_O);
    LAS unsigned char* lds = F.lds;
    LAS float* Zs = (LAS float*)(lds + RT_ZS); LAS float* Cs = (LAS float*)(lds + RT_CS);
    const int b = it / NHB, hd = it % NHB;
    const int q32 = f_lane & 31, h = f_lane >> 5, w = F.wave;
    const int role = w >> 2, itile = (w >> 1) & 1, etile = w & 1;
    const int srow = f_tid >> 3, sch = f_tid & 7;
    const int vtr_off = ((f_lane & 15) >> 2) * 64 + (16 * ((f_lane >> 4) & 1) + 4 * (f_lane & 3)) * 2;
    const float l2g = log2f(gamma_of(hd));
    const float cd = exp2f(l2g * 64.f), sdec = exp2f(l2g * (float)(63 - srow));
    float qdv[16];
#pragma unroll
    for (int r = 0; r < 16; ++r) qdv[r] = exp2f(l2g * (float)(32 * itile + crow(r, h) + 1));
    f32x16 xs0 = {}, xs1 = {};
    const size_t trow0 = (size_t)b * SEQ;
    const bf16* gq = R + (trow0 + srow) * INC + hd * 64 + 8 * sch;
    u32x4 qreg = *(const u32x4*)(gq + C_QB), kreg = *(const u32x4*)(gq + C_KB), vreg = *(const u32x4*)(gq + C_VB);
    __syncthreads();
#define RT_STAGE(bufp) do { LAS unsigned char* bp_ = (bufp); \
        *(LAS u32x4*)(bp_ + RT_Q + srow * 144 + sch * 16) = qreg; *(LAS u32x4*)(bp_ + RT_K + srow * 144 + sch * 16) = kreg; \
        *(LAS u32x4*)(bp_ + RT_V + (sch >> 2) * 4096 + srow * 64 + (sch & 3) * 16) = vreg; \
        u32x4 kd_; \
        _Pragma("unroll") for (int e_ = 0; e_ < 4; ++e_) kd_[e_] = cvtpk(__uint_as_float(kreg[e_] << 16) * sdec, __uint_as_float(kreg[e_] & 0xffff0000u) * sdec); \
        *(LAS u32x4*)(bp_ + RT_KD + (sch >> 2) * 4096 + srow * 64 + (sch & 3) * 16) = kd_; } while (0)
    RT_STAGE(lds);
    __syncthreads();
    for (int n = 0; n < NCH; ++n) {
        LAS unsigned char* bp = lds + (n & 1) * RT_BUF;
        if (n + 1 < NCH) { const bf16* g1 = gq + (size_t)(n + 1) * 64 * INC; qreg = *(const u32x4*)(g1 + C_QB); kreg = *(const u32x4*)(g1 + C_KB); vreg = *(const u32x4*)(g1 + C_VB); }
        unsigned short gr[8];
#pragma unroll
        for (int r = 0; r < 8; ++r) gr[r] = R[(trow0 + n * 64 + 8 * w + r) * INC + C_GB + hd * 64 + f_lane];
        if (role == 0) {
            bf16x8 qf[4];
#pragma unroll
            for (int ks = 0; ks < 4; ++ks) qf[ks] = *(const LAS bf16x8*)(bp + RT_Q + (32 * itile + q32) * 144 + (16 * ks + 8 * h) * 2);
            f32x16 st0 = {}, st1 = {};
#pragma unroll
            for (int ks = 0; ks < 4; ++ks) {
                const bf16x8 k0 = *(const LAS bf16x8*)(bp + RT_K + q32 * 144 + (16 * ks + 8 * h) * 2);
                const bf16x8 k1 = *(const LAS bf16x8*)(bp + RT_K + (32 + q32) * 144 + (16 * ks + 8 * h) * 2);
                st0 = __builtin_amdgcn_mfma_f32_32x32x16_bf16(k0, qf[ks], st0, 0, 0, 0);
                st1 = __builtin_amdgcn_mfma_f32_32x32x16_bf16(k1, qf[ks], st1, 0, 0, 0);
            }
            int iiv = 32 * itile + q32 - 4 * h; asm volatile("" : "+v"(iiv));
#pragma unroll
            for (int r = 0; r < 16; ++r) {
                const int dd = iiv - ((r & 3) + 8 * (r >> 2));
                st0[r] *= __builtin_amdgcn_exp2f(l2g * fabsf((float)dd));
                st1[r] *= __builtin_amdgcn_exp2f(l2g * fabsf((float)(dd - 32)));
            }
            f32x16 z = {};
#pragma unroll
            for (int kk = 0; kk < 4; ++kk) {
                const int key0 = 16 * kk + 4 * h;
                const v4i16 bl = ds_tr16(bp + RT_V + etile * 4096 + key0 * 64 + vtr_off), bh = ds_tr16(bp + RT_V + etile * 4096 + (key0 + 8) * 64 + vtr_off);
                const bf16x8 vb = __builtin_shufflevector(bl, bh, 0, 1, 2, 3, 4, 5, 6, 7);
                const bf16x8 xa = (kk < 2) ? pack_step(st0, kk & 1) : pack_step(st1, kk & 1);
                z = __builtin_amdgcn_mfma_f32_32x32x16_bf16(xa, vb, z, 0, 0, 0);
            }
            int zb = (32 * itile + 4 * h) * 66 + 32 * etile + q32; asm volatile("" : "+v"(zb));
#pragma unroll
            for (int r = 0; r < 16; ++r) Zs[zb + ((r & 3) + 8 * (r >> 2)) * 66] = z[r];
        } else {
            f32x16 cr = {};
#pragma unroll
            for (int kk = 0; kk < 4; ++kk) {
                const LAS unsigned char* qp = bp + RT_Q + (32 * itile + q32) * 144 + (16 * kk + 4 * h) * 2;
                const v4i16 al = *(const LAS v4i16*)qp, ah = *(const LAS v4i16*)(qp + 16);
                const bf16x8 qa = __builtin_shufflevector(al, ah, 0, 1, 2, 3, 4, 5, 6, 7);
                const bf16x8 xb = (kk < 2) ? pack_step(xs0, kk & 1) : pack_step(xs1, kk & 1);
                cr = __builtin_amdgcn_mfma_f32_32x32x16_bf16(qa, xb, cr, 0, 0, 0);
            }
            int cb = (32 * itile + 4 * h) * 66 + 32 * etile + q32; asm volatile("" : "+v"(cb));
#pragma unroll
            for (int r = 0; r < 16; ++r) Cs[cb + ((r & 3) + 8 * (r >> 2)) * 66] = cr[r] * qdv[r];
#pragma unroll
            for (int r = 0; r < 16; ++r) { xs0[r] *= cd; xs1[r] *= cd; }
#pragma unroll
            for (int s4 = 0; s4 < 4; ++s4) {
                const int key0 = 16 * s4 + 8 * h;
                const v4i16 vl = ds_tr16(bp + RT_V + etile * 4096 + key0 * 64 + vtr_off), vh = ds_tr16(bp + RT_V + etile * 4096 + (key0 + 4) * 64 + vtr_off);
                const bf16x8 vb = __builtin_shufflevector(vl, vh, 0, 1, 2, 3, 4, 5, 6, 7);
                const v4i16 a0l = ds_tr16(bp + RT_KD + key0 * 64 + vtr_off), a0h = ds_tr16(bp + RT_KD + (key0 + 4) * 64 + vtr_off);
                const v4i16 a1l = ds_tr16(bp + RT_KD + 4096 + key0 * 64 + vtr_off), a1h = ds_tr16(bp + RT_KD + 4096 + (key0 + 4) * 64 + vtr_off);
                const bf16x8 ka0 = __builtin_shufflevector(a0l, a0h, 0, 1, 2, 3, 4, 5, 6, 7), ka1 = __builtin_shufflevector(a1l, a1h, 0, 1, 2, 3, 4, 5, 6, 7);
                xs0 = __builtin_amdgcn_mfma_f32_32x32x16_bf16(ka0, vb, xs0, 0, 0, 0);
                xs1 = __builtin_amdgcn_mfma_f32_32x32x16_bf16(ka1, vb, xs1, 0, 0, 0);
            }
        }
        __syncthreads();
#pragma unroll
        for (int r = 0; r < 8; ++r) {
            const int i = 8 * w + r;
            const float v = Zs[i * 66 + f_lane] + Cs[i * 66 + f_lane];
            const float mu = wave_sum(v) * (1.f / 64.f);
            const float dv = v - mu;
            const float var = wave_sum(dv * dv) * (1.f / 64.f);
            const float g = bf2f(gr[r]);
            O[(trow0 + n * 64 + i) * DM + 512 + hd * 64 + f_lane] = (bf16)f2bf(dv * (1.f / sqrtf(var + EPS)) * (g / (1.f + __expf(-g))));
        }
        if (n + 1 < NCH) RT_STAGE(lds + ((n + 1) & 1) * RT_BUF);
        __syncthreads();
    }
#undef RT_STAGE
}
DI void int8_rows(Frame& F, const int row0, const int nrows, const int f_lane) {
    float* SC = (float*)(F.ws + WS_SC);
    for (int rr = row0; rr < row0 + nrows; rr += 4) {
        f32x4 v[4][4];
#pragma unroll
        for (int u = 0; u < 4; ++u) {
            const int row = rr + u, tab = row / PE, e = row % PE, layer = tab & 1, isv = tab >> 1;
            const f32x4* sp = (const f32x4*)((isv ? F.peer_v : F.peer_u) + ((size_t)layer * PE + e) * DM) + f_lane;
#pragma unroll
            for (int j = 0; j < 4; ++j) v[u][j] = sp[64 * j];
        }
#pragma unroll
        for (int u = 0; u < 4; ++u) {
            const int row = rr + u, tab = row / PE, e = row % PE, layer = tab & 1, isv = tab >> 1;
            const f32x4* gp = (const f32x4*)(F.ffn_norm + layer * DM) + f_lane;
            float a = 0.f, sq = 0.f;
#pragma unroll
            for (int j = 0; j < 4; ++j) { if (!isv) v[u][j] = v[u][j] * gp[64 * j]; a = fmaxf(a, fmaxf(fmaxf(fabsf(v[u][j][0]), fabsf(v[u][j][1])), fmaxf(fabsf(v[u][j][2]), fabsf(v[u][j][3]))));
                sq += (v[u][j][0] * v[u][j][0] + v[u][j][1] * v[u][j][1]) + (v[u][j][2] * v[u][j][2] + v[u][j][3] * v[u][j][3]); }
            a = wave_max(a);
            const float step = fminf(0.355f * sqrtf(wave_sum(sq) * (1.f / DM)), a * (1.f / 7.f));
            const float sc = step > 0.f ? 1.f / step : 0.f;
            unsigned* dst = (unsigned*)(F.ws + (isv ? WS_V8 : WS_U8)) + (size_t)layer * 4 * PE * 32;
#pragma unroll
            for (int j = 0; j < 4; ++j) {
                const int q0 = (int)rintf(__builtin_amdgcn_fmed3f(v[u][j][0] * sc, -7.f, 7.f)), q1 = (int)rintf(__builtin_amdgcn_fmed3f(v[u][j][1] * sc, -7.f, 7.f)), q2 = (int)rintf(__builtin_amdgcn_fmed3f(v[u][j][2] * sc, -7.f, 7.f)), q3 = (int)rintf(__builtin_amdgcn_fmed3f(v[u][j][3] * sc, -7.f, 7.f));
                const int ob = (isv && !(f_lane & 1)) ? 8 : 0;
                unsigned w = ((unsigned)(q0 + ob) & 0xFu) | (((unsigned)(q1 + ob) & 0xFu) << 8) | (((unsigned)(q2 + ob) & 0xFu) << 16) | (((unsigned)(q3 + ob) & 0xFu) << 24);
                if (f_lane & 1) w <<= 4;
                w |= (unsigned)DPP_MOV_I((int)w, DPP_XOR1);
                if (!(f_lane & 1)) dst[((size_t)j * PE + e) * 32 + (f_lane >> 1)] = w;
            }
            if (f_lane == 0) SC[tab * PE + e] = step * (1.f / 16.f);
        }
    }
}
constexpr int Q8_ITEM_ROWS = 512, Q8_ITEMS = 4 * PE / Q8_ITEM_ROWS;
constexpr int PH_MIX_ID = 3;
DI void mix_phase(Frame& F, const int rep) {
    FRAME_IDS;
    unsigned* ctr = (unsigned*)(F.ws + WS_CTL) + CW_QUEUE + 64 * rep;
    volatile LAS unsigned* slot = (volatile LAS unsigned*)(F.lds + MISC_OFF) + 16;
    constexpr int N_RET = NB * NHB, N_ATT = NB * NHA * 8;
    static_assert(N_ATT == 8 * Q8_ITEMS, "8 attention items per quantisation item");
    for (;;) {
        __syncthreads();
        if (f_tid == 0) slot[0] = __hip_atomic_fetch_add(ctr, 1u, __ATOMIC_RELAXED, __HIP_MEMORY_SCOPE_AGENT);
        __syncthreads();
        const int idx = (int)slot[0];
        if (idx >= N_RET + N_ATT + Q8_ITEMS) break;
        const bool probe_pass = (REP_PHASE == PH_MIX_ID && rep == 0);
        if (idx < N_RET) { if (!(probe_pass && PROBE_MODE == 4)) ret_item(F, idx); }
        else if (probe_pass && PROBE_MODE == 3) { }
        else { const int k = idx - N_RET, grp = k / 9, pos = k - 9 * grp;
            if (pos == 8) int8_rows(F, grp * Q8_ITEM_ROWS + F.wave * 64, 64, f_lane);
            else attn_item(F, 8 * grp + pos); }
    }
}
DI float fmax_raw(float a, float b) { float r; asm("v_max_f32_e32 %0, %1, %2" : "=v"(r) : "v"(a), "v"(b)); return r; }
DI float fmin_raw(float a, float b) { float r; asm("v_min_f32_e32 %0, %1, %2" : "=v"(r) : "v"(a), "v"(b)); return r; }
#define CE_DESC(x, y) do { const float hi_ = fmax_raw((x), (y)), lo_ = fmin_raw((x), (y)); (x) = hi_; (y) = lo_; } while (0)
template <int N> DI void sort_desc(float* v) {
#pragma unroll
    for (int k = 2; k <= N; k <<= 1)
#pragma unroll
        for (int j = k >> 1; j > 0; j >>= 1)
#pragma unroll
            for (int i = 0; i < N; ++i) { const int l = i ^ j; if (l > i) { if ((i & k) == 0 || k == N) CE_DESC(v[i], v[l]); else CE_DESC(v[l], v[i]); } }
}
DI void merge16(float* a, const float* b) {
#pragma unroll
    for (int i = 0; i < 16; ++i) a[i] = fmax_raw(a[i], b[15 - i]);
#pragma unroll
    for (int j = 8; j > 0; j >>= 1)
#pragma unroll
        for (int i = 0; i < 16; ++i) { const int l = i ^ j; if (l > i) CE_DESC(a[i], a[l]); }
}
DI float key_pack(float v, unsigned keep_mask, unsigned idx) { return __uint_as_float((__float_as_uint(v) & keep_mask) | idx); }
DI void opt_route(Frame& F, int layer) {
    FRAME_IDS;
    const bf16* Q = (const bf16*)(F.ws + WS_Q);
    int* eidx = (int*)(F.ws + WS_EIDX); float* gate = (float*)(F.ws + WS_GATE);
    const float* keys = F.peer_keys + (size_t)layer * 2 * PK * 64;
    LAS unsigned char* kl = F.lds;
    __syncthreads();
    for (int idx = f_tid; idx < 2 * PK * 8; idx += NTHR) {
        const int row = idx >> 3, ch = idx & 7;
        const f32x4 a = *(const f32x4*)(keys + (size_t)row * 64 + ch * 8), b = *(const f32x4*)(keys + (size_t)row * 64 + ch * 8 + 4);
        *(LAS u32x4*)(kl + row * 144 + ch * 16) = (u32x4){pk2(a[0], a[1]), pk2(a[2], a[3]), pk2(b[0], b[1]), pk2(b[2], b[3])};
    }
    __syncthreads();
    LAS int* lut = (LAS int*)(F.lds + 40960 + F.wave * 8192);
    const int c = f_lane & 31, h = f_lane >> 5;
    pg8::StaticOrder SO; SO.init(T, DM, F.G, F.bid);
    pg8::Unit un;
    for (int ui = 0; SO.next(ui, un); ++ui)
    for (int k2 = F.wave; k2 < 16; k2 += NWAVES) {
        const int tile = 8 * un.pm + (k2 & 7), hh = 2 * un.pn + (k2 >> 3), t = tile * 32 + c;
        float tk[2][16];
#pragma unroll
        for (int side = 0; side < 2; ++side) {
            bf16x8 qf[4];
#pragma unroll
            for (int ks = 0; ks < 4; ++ks) qf[ks] = *(const bf16x8*)(Q + (size_t)t * DM + hh * PQD + side * 64 + 16 * ks + 8 * h);
            float v[64];
#pragma unroll
            for (int kt = 0; kt < 4; ++kt) {
                f32x16 acc = {};
#pragma unroll
                for (int ks = 0; ks < 4; ++ks) {
                    const bf16x8 a = *(const LAS bf16x8*)(kl + (side * PK + 32 * kt + c) * 144 + (16 * ks + 8 * h) * 2);
                    acc = __builtin_amdgcn_mfma_f32_32x32x16_bf16(a, qf[ks], acc, 0, 0, 0);
                }
#pragma unroll
                for (int r = 0; r < 16; ++r) v[16 * kt + r] = key_pack(acc[r], 0xFFFFFF80u, (unsigned)(32 * kt + (r & 3) + 8 * (r >> 2) + 4 * h));
            }
            sort_desc<16>(v); sort_desc<16>(v + 16); sort_desc<16>(v + 32); sort_desc<16>(v + 48);
            merge16(v, v + 16); merge16(v + 32, v + 48); merge16(v, v + 32);
            float pr[16];
#pragma unroll
            for (int i = 0; i < 16; ++i) pr[i] = __shfl_xor(v[i], 32);
            merge16(v, pr);
#pragma unroll
            for (int i = 0; i < 16; ++i) { tk[side][i] = v[i]; lut[(side * 16 + i) * 64 + f_lane] = (int)(__float_as_uint(v[i]) & 0x7Fu); }
        }
        float cd[64];
        {   int n = 0;
#pragma unroll
            for (int a = 0; a < 16; ++a)
#pragma unroll
                for (int b = 0; b < 16; ++b) if ((a + 1) * (b + 1) <= 16) { cd[n] = key_pack(tk[0][a] + tk[1][b], 0xFFFFFF00u, (unsigned)(a * 16 + b)); ++n; }
#pragma unroll
            for (int i = 50; i < 64; ++i) cd[i] = -INFINITY;
        }
        sort_desc<16>(cd); sort_desc<16>(cd + 16); sort_desc<16>(cd + 32); CE_DESC(cd[48], cd[49]);
        merge16(cd, cd + 16); merge16(cd + 32, cd + 48); merge16(cd, cd + 32);
        int ex[16]; float gv[16]; float sum = 0.f;
        const float top = __uint_as_float(__float_as_uint(cd[0]) & 0xFFFFFF00u);
#pragma unroll
        for (int i = 0; i < 16; ++i) {
            const unsigned bits = __float_as_uint(cd[i]);
            const int a = (bits >> 4) & 15, b = bits & 15;
            ex[i] = lut[a * 64 + f_lane] * PK + lut[(16 + b) * 64 + f_lane];
            gv[i] = __expf(__uint_as_float(bits & 0xFFFFFF00u) - top); sum += gv[i];
        }
        const float inv = 1.f / sum;
        if (h == 0) {
            u32x4* ep = (u32x4*)(eidx + (size_t)t * NSEL + hh * 16);
#pragma unroll
            for (int q = 0; q < 4; ++q) ep[q] = (u32x4){(unsigned)ex[4 * q], (unsigned)ex[4 * q + 1], (unsigned)ex[4 * q + 2], (unsigned)ex[4 * q + 3]};
        } else {
            f32x4* gp = (f32x4*)(gate + (size_t)t * NSEL + hh * 16);
#pragma unroll
            for (int q = 0; q < 4; ++q) gp[q] = (f32x4){gv[4 * q] * inv, gv[4 * q + 1] * inv, gv[4 * q + 2] * inv, gv[4 * q + 3] * inv};
        }
    }
    __syncthreads();
}
struct XInfo { int xrank, nx, rank, nloc; };
DI XInfo get_xinfo(Frame& F, const bool census) {
    FRAME_IDS;
    volatile LAS unsigned* M = (volatile LAS unsigned*)(F.lds + MISC_OFF);
    __syncthreads();
    if (f_tid == 0) {
        unsigned xr = (unsigned)F.bid & 7u, nx = 8u, rk = (unsigned)F.bid >> 3, nl = ((unsigned)F.G + 7u - ((unsigned)F.bid & 7u)) >> 3;
        if (census) {
            unsigned* bar = (unsigned*)(F.ws + WS_CTL) + CW_BAR; const unsigned x = xb_xcc_id();
            unsigned cnt = 0u, below = 0u, mine = 0u;
#pragma unroll
            for (unsigned j = 0; j < 16; ++j) { const unsigned c = xb_ld(&bar[XB_XCNT(j)]); cnt += (c > 0u); below += (c > 0u && j < x); mine = (j == x) ? c : mine; }
            if (cnt > 0u && mine > 0u) { xr = below; nx = cnt; rk = M[12]; nl = mine; }
        }
        M[20] = xr; M[21] = nx; M[22] = rk; M[23] = nl;
    }
    __syncthreads();
    XInfo xi; xi.xrank = (int)M[20]; xi.nx = (int)M[21]; xi.rank = (int)M[22]; xi.nloc = (int)M[23];
    return xi;
}
DI int comb_c(const int level, const int a, const int b, const int lane) {
    const int M = 4 >> level; const bool bit = (lane & M) != 0;
    const int send = bit ? a : b, keep = bit ? b : a;
    const int recv = level == 0 ? DPP_MOV_I(send, DPP_HMIRROR) : (level == 1 ? DPP_MOV_I(send, DPP_XOR2) : DPP_MOV_I(send, DPP_XOR1));
    return keep + recv;
}
DI int dot16_i8(const u32x4 r, const u32x4 x) {
    int s = __builtin_amdgcn_sdot4((int)r[0], (int)x[0], 0, false);
    s = __builtin_amdgcn_sdot4((int)r[1], (int)x[1], s, false); s = __builtin_amdgcn_sdot4((int)r[2], (int)x[2], s, false); s = __builtin_amdgcn_sdot4((int)r[3], (int)x[3], s, false);
    return s;
}
DI int half_dots(const u32x4 (&rows)[8], const u32x4 xq, const int lane) {
    int p[8];
#pragma unroll
    for (int i = 0; i < 8; ++i) p[i] = dot16_i8(rows[i], xq);
#pragma unroll
    for (int i = 0; i < 4; ++i) p[i] = comb_c(0, p[2 * i], p[2 * i + 1], lane);
    p[0] = comb_c(1, p[0], p[1], lane); p[1] = comb_c(1, p[2], p[3], lane);
    return comb_c(2, p[0], p[1], lane);
}
DI u32x4 xquant(const f32x4 (&hv)[4], const float rstd) {
    u32x4 o;
#pragma unroll
    for (int w = 0; w < 4; ++w) {
        const f32x4 x = hv[w] * (rstd * XQ);
        const int a = (int)rintf(__builtin_amdgcn_fmed3f(x[0], -127.f, 127.f)), b = (int)rintf(__builtin_amdgcn_fmed3f(x[1], -127.f, 127.f)), c = (int)rintf(__builtin_amdgcn_fmed3f(x[2], -127.f, 127.f)), d = (int)rintf(__builtin_amdgcn_fmed3f(x[3], -127.f, 127.f));
        o[w] = ((unsigned)a & 0xFFu) | (((unsigned)b & 0xFFu) << 8) | (((unsigned)c & 0xFFu) << 16) | ((unsigned)d << 24);
    }
    return o;
}
DI float rstd_bcast(const float* part, const int t) {
    const f32x4* p = (const f32x4*)(part + (size_t)t * 16);
    const f32x4 a = p[0], b = p[1], c = p[2], d = p[3];
    const float s = ((a[0] + a[1]) + (a[2] + a[3])) + ((b[0] + b[1]) + (b[2] + b[3])) + ((c[0] + c[1]) + (c[2] + c[3])) + ((d[0] + d[1]) + (d[2] + d[3]));
    return 1.f / sqrtf(s * (1.f / DM) + EPS);
}
DI int dot32_i4(const u32x4 r, const u32x4 xa, const u32x4 xb) {
    int s = 0;
#pragma unroll
    for (int d = 0; d < 4; ++d) {
        const unsigned lo = (r[d] << 4) & 0xF0F0F0F0u, hi = r[d] & 0xF0F0F0F0u;
        const unsigned x0 = d < 2 ? xa[2 * d] : xb[2 * d - 4], x1 = d < 2 ? xa[2 * d + 1] : xb[2 * d - 3];
        s = __builtin_amdgcn_sdot4((int)lo, (int)x0, s, false); s = __builtin_amdgcn_sdot4((int)hi, (int)x1, s, false);
    }
    return s;
}
DI int half_dots4(const u32x4 (&rows)[8], const u32x4 xa, const u32x4 xb, const int lane) {
    int p[8];
#pragma unroll
    for (int i = 0; i < 8; ++i) p[i] = dot32_i4(rows[i], xa, xb);
#pragma unroll
    for (int i = 0; i < 4; ++i) p[i] = comb_c(0, p[2 * i], p[2 * i + 1], lane);
    p[0] = comb_c(1, p[0], p[1], lane); p[1] = comb_c(1, p[2], p[3], lane);
    return comb_c(2, p[0], p[1], lane);
}
DI void gather_u(Frame& F, const int layer, const XInfo xi, const bool dry) {
    FRAME_IDS;
    const unsigned emask = (dry && PROBE_MODE == 2) ? 15u : ((dry && PROBE_MODE == 5) ? 4095u : 0xFFFFFFFFu);
    const int* eidx = (const int*)(F.ws + WS_EIDX); int* PU = (int*)(F.ws + (dry ? WS_R : WS_PU)); const float* part = (const float*)(F.ws + WS_PART); const bf16* hbp = (const bf16*)(F.ws + WS_XB);
    const int g = f_lane >> 3, c = f_lane & 7, c16 = c * 16;
    const int kst = 16 * g + (((c & 1) << 2) | (c & 2) | ((c & 4) >> 2));
    const int gwl = xi.rank * NWAVES + F.wave, NGWL = xi.nloc * NWAVES;
    LAS unsigned char* wl = F.lds + F.wave * 2048;
    __syncthreads();
    for (int j = xi.xrank; j < 8; j += xi.nx) {
        const int sl = j & 3, th = j >> 2;
        const __amdgpu_buffer_rsrc_t U8 = __builtin_amdgcn_make_buffer_rsrc((void*)(F.ws + WS_U8 + ((size_t)(layer * 4 + sl) * PE) * 128), 0, PE * 128, 0x00020000);
        int tt = gwl;
        if (tt >= T / 2) continue;
#define TOK(x_) (2 * (x_) + th)
#define U_LOAD(tk, ri, rh, rp) do { ri = *(const u32x2*)(eidx + (size_t)(tk) * NSEL + 2 * f_lane) & emask; rh = *(const u32x2*)(hbp + (size_t)(tk) * DM + 256 * sl + 4 * f_lane); \
            rp = part[(size_t)(tk) * 16 + (f_lane & 15)]; } while (0)
#define U_SPREAD(slot, ri, rh, rp, e, xa_, xb_) do { \
            float ps_ = rp; ps_ += __int_as_float(DPP_MOV_I(__float_as_int(ps_), DPP_XOR1)); ps_ += __int_as_float(DPP_MOV_I(__float_as_int(ps_), DPP_XOR2)); ps_ += __int_as_float(DPP_MOV_I(__float_as_int(ps_), DPP_HMIRROR)); ps_ += __int_as_float(DPP_MOV_I(__float_as_int(ps_), DPP_ROR8)); \
            const float rs_ = (1.f / sqrtf(ps_ * (1.f / DM) + EPS)) * XQ; \
            const int q0_ = (int)rintf(__builtin_amdgcn_fmed3f(__uint_as_float(rh[0] << 16) * rs_, -127.f, 127.f)), q1_ = (int)rintf(__builtin_amdgcn_fmed3f(__uint_as_float(rh[0] & 0xffff0000u) * rs_, -127.f, 127.f)); \
            const int q2_ = (int)rintf(__builtin_amdgcn_fmed3f(__uint_as_float(rh[1] << 16) * rs_, -127.f, 127.f)), q3_ = (int)rintf(__builtin_amdgcn_fmed3f(__uint_as_float(rh[1] & 0xffff0000u) * rs_, -127.f, 127.f)); \
            LAS unsigned char* sl_ = wl + (slot) * 1024; \
            *(LAS u32x2*)(sl_ + 8 * f_lane) = ri; *(LAS unsigned*)(sl_ + 512 + 4 * f_lane) = ((unsigned)q0_ & 0xFFu) | (((unsigned)q1_ & 0xFFu) << 8) | (((unsigned)q2_ & 0xFFu) << 16) | ((unsigned)q3_ << 24); \
            asm volatile("s_waitcnt lgkmcnt(0)" ::: "memory"); \
            _Pragma("unroll") for (int q_ = 0; q_ < 4; ++q_) e[q_] = *(const LAS u32x4*)(sl_ + 64 * g + 16 * q_); \
            xa_ = *(const LAS u32x4*)(sl_ + 512 + 32 * c); xb_ = *(const LAS u32x4*)(sl_ + 512 + 32 * c + 16); } while (0)
        u32x2 ri, rh; float rp;
        u32x4 e0[4], e1[4], xa, xb, xa1, xb1;
        U_LOAD(TOK(tt), ri, rh, rp); U_SPREAD(0, ri, rh, rp, e0, xa, xb);
        { const int t1 = (tt + NGWL < T / 2) ? tt + NGWL : tt; U_LOAD(TOK(t1), ri, rh, rp); U_SPREAD(1, ri, rh, rp, e1, xa1, xb1); }
        { const int t2 = (tt + 2 * NGWL < T / 2) ? tt + 2 * NGWL : tt; U_LOAD(TOK(t2), ri, rh, rp); }
        u32x4 A0[8], B0[8], A1[8], B1[8];
#pragma unroll
        for (int i = 0; i < 8; ++i) A0[i] = __builtin_amdgcn_raw_buffer_load_b128(U8, (int)e0[i >> 2][i & 3] * 128 + c16, 0, 0);
#pragma unroll
        for (int i = 0; i < 8; ++i) B0[i] = __builtin_amdgcn_raw_buffer_load_b128(U8, (int)e0[2 + (i >> 2)][i & 3] * 128 + c16, 0, 0);
#define U_ITEM(CA, CB, NA, NB, slot) do { \
            _Pragma("unroll") for (int i = 0; i < 8; ++i) NA[i] = __builtin_amdgcn_raw_buffer_load_b128(U8, (int)e1[i >> 2][i & 3] * 128 + c16, 0, 0); \
            asm volatile("" ::: "memory"); \
            const int r0 = half_dots4(CA, xa, xb, f_lane); \
            _Pragma("unroll") for (int i = 0; i < 8; ++i) NB[i] = __builtin_amdgcn_raw_buffer_load_b128(U8, (int)e1[2 + (i >> 2)][i & 3] * 128 + c16, 0, 0); \
            asm volatile("" ::: "memory"); \
            const int rr1 = half_dots4(CB, xa, xb, f_lane); \
            int* pp = PU + ((size_t)TOK(tt) * 4 + sl) * NSEL + kst; \
            pp[0] = r0; pp[8] = rr1; \
            xa = xa1; xb = xb1; \
            U_SPREAD(slot, ri, rh, rp, e1, xa1, xb1);                   \
            { const int t3 = (tt + 3 * NGWL < T / 2) ? tt + 3 * NGWL : tt; U_LOAD(TOK(t3), ri, rh, rp); } } while (0)
        for (;;) {
            U_ITEM(A0, B0, A1, B1, 0); tt += NGWL; if (tt >= T / 2) break;
            U_ITEM(A1, B1, A0, B0, 1); tt += NGWL; if (tt >= T / 2) break;
        }
#undef U_ITEM
#undef U_LOAD
#undef U_SPREAD
#undef TOK
    }
    __syncthreads();
}
DI void gather_r(Frame& F, const int layer) {
    FRAME_IDS;
    const int* PU = (const int*)(F.ws + WS_PU); const float* gate = (const float*)(F.ws + WS_GATE); const int* eidx = (const int*)(F.ws + WS_EIDX);
    const float* SCu = (const float*)(F.ws + WS_SC) + (size_t)layer * PE; const float* SCv = (const float*)(F.ws + WS_SC) + (size_t)(2 + layer) * PE;
    signed char* A8 = (signed char*)(F.ws + WS_A); float* SA = (float*)(F.ws + WS_SA);
    const int gw = F.bid * NWAVES + F.wave, NGW = F.G * NWAVES;
    for (int t = gw; t < T; t += NGW) {
        float a[2];
#pragma unroll
        for (int hf = 0; hf < 2; ++hf) {
            const int k = 64 * hf + f_lane;
            int sacc = 0;
#pragma unroll
            for (int j = 0; j < 4; ++j) sacc += PU[((size_t)t * 4 + j) * NSEL + k];
            const int e = eidx[(size_t)t * NSEL + k];
            const float d = (float)sacc * (SCu[e] * (1.f / XQ));
            a[hf] = gelu_erf(d) * gate[(size_t)t * NSEL + k] * SCv[e];
        }
        const float am = wave_max(fmaxf(fabsf(a[0]), fabsf(a[1])));
        const float sc = am > 0.f ? 127.f / am : 0.f;
        A8[(size_t)t * NSEL + f_lane] = (signed char)(int)rintf(a[0] * sc);
        A8[(size_t)t * NSEL + 64 + f_lane] = (signed char)(int)rintf(a[1] * sc);
        if (f_lane == 0) SA[t] = am * (1.f / 127.f);
    }
}
DI void tr4x4(const unsigned w0, const unsigned w1, const unsigned w2, const unsigned w3, unsigned (&cdw)[4]) {
    const unsigned t01l = __builtin_amdgcn_perm(w1, w0, 0x05010400u), t01h = __builtin_amdgcn_perm(w1, w0, 0x07030602u);
    const unsigned t23l = __builtin_amdgcn_perm(w3, w2, 0x05010400u), t23h = __builtin_amdgcn_perm(w3, w2, 0x07030602u);
    cdw[0] = __builtin_amdgcn_perm(t23l, t01l, 0x05040100u); cdw[1] = __builtin_amdgcn_perm(t23l, t01l, 0x07060302u);
    cdw[2] = __builtin_amdgcn_perm(t23h, t01h, 0x05040100u); cdw[3] = __builtin_amdgcn_perm(t23h, t01h, 0x07060302u);
}
DI void axpy4rows(const u32x4 r0, const u32x4 r1, const u32x4 r2, const u32x4 r3, const unsigned a4, int (&ahi)[16], int (&aall)[16]) {
#pragma unroll
    for (int d = 0; d < 4; ++d) {
        unsigned cdw[4];
        tr4x4(r0[d], r1[d], r2[d], r3[d], cdw);
#pragma unroll
        for (int b = 0; b < 4; ++b) {
            aall[4 * d + b] = __builtin_amdgcn_sdot4((int)cdw[b], (int)a4, aall[4 * d + b], false);
            ahi[4 * d + b] = __builtin_amdgcn_sdot4((int)(cdw[b] & 0xF0F0F0F0u), (int)a4, ahi[4 * d + b], false);
        }
    }
}
DI void gather_v(Frame& F, const int layer, const XInfo xi, const bool dry) {
    FRAME_IDS;
    const int* eidx = (const int*)(F.ws + WS_EIDX); const unsigned char* A8 = F.ws + WS_A; const float* SA = (const float*)(F.ws + WS_SA);
    float* part_w = dry ? (float*)(F.ws + WS_R) : (float*)(F.ws + WS_PART); bf16* hb_w = dry ? (bf16*)(F.ws + WS_HID2) : (bf16*)(F.ws + WS_XB); const bf16* hbp = (const bf16*)(F.ws + WS_XB);
    const int g = f_lane >> 3, c = f_lane & 7, c16 = c * 16;
    const int cc = 32 * c + 16 * (g >> 2) + 8 * ((g >> 1) & 1) + 4 * (g & 1);
    const int gwl = xi.rank * NWAVES + F.wave, NGWL = xi.nloc * NWAVES;
    const bool b3 = (f_lane & 8) != 0;
    LAS unsigned char* wl = F.lds + F.wave * 2048;
    __syncthreads();
    for (int j = xi.xrank; j < 8; j += xi.nx) {
        const int sl = j & 3, th = j >> 2;
        const __amdgpu_buffer_rsrc_t V8 = __builtin_amdgcn_make_buffer_rsrc((void*)(F.ws + WS_V8 + ((size_t)(layer * 4 + sl) * PE) * 128), 0, PE * 128, 0x00020000);
        int tt = gwl;
        if (tt >= T / 2) continue;
#define TOK(x_) (2 * (x_) + th)
#define V_LOAD(tk, ri, ra, rs) do { ri = *(const u32x2*)(eidx + (size_t)(tk) * NSEL + 2 * f_lane); ra = *(const unsigned short*)(A8 + (size_t)(tk) * NSEL + 2 * f_lane); rs = SA[(tk)]; } while (0)
#define V_SPREAD(slot, ri, ra, rs, e, avv, sav) do { \
            LAS unsigned char* sl_ = wl + (slot) * 1024; \
            *(LAS u32x2*)(sl_ + 8 * f_lane) = ri; *(LAS unsigned short*)(sl_ + 512 + 2 * f_lane) = ra; \
            asm volatile("s_waitcnt lgkmcnt(0)" ::: "memory"); \
            _Pragma("unroll") for (int q_ = 0; q_ < 4; ++q_) e[q_] = *(const LAS u32x4*)(sl_ + 64 * g + 16 * q_); \
            avv = *(const LAS u32x4*)(sl_ + 512 + 16 * g); sav = rs; } while (0)
        u32x2 ri; unsigned short ra; float rs;
        u32x4 e0[4], e1[4], av, a1; float sa, sa1; u32x2 hold;
        V_LOAD(TOK(tt), ri, ra, rs); V_SPREAD(0, ri, ra, rs, e0, av, sa);
        { const int t1 = (tt + NGWL < T / 2) ? tt + NGWL : tt; V_LOAD(TOK(t1), ri, ra, rs); V_SPREAD(1, ri, ra, rs, e1, a1, sa1); }
        { const int t2 = (tt + 2 * NGWL < T / 2) ? tt + 2 * NGWL : tt; V_LOAD(TOK(t2), ri, ra, rs); }
        hold = *(const u32x2*)(hbp + (size_t)TOK(tt) * DM + 256 * sl + cc);
        u32x4 A0[8], B0[8], A1[8], B1[8];
#pragma unroll
        for (int i = 0; i < 8; ++i) A0[i] = __builtin_amdgcn_raw_buffer_load_b128(V8, (int)e0[i >> 2][i & 3] * 128 + c16, 0, 0);
#pragma unroll
        for (int i = 0; i < 8; ++i) B0[i] = __builtin_amdgcn_raw_buffer_load_b128(V8, (int)e0[2 + (i >> 2)][i & 3] * 128 + c16, 0, 0);
#define V_ITEM(CA, CB, NA, NB, slot) do { \
            const int t1 = (tt + NGWL < T / 2) ? tt + NGWL : tt; \
            const u32x2 hold1 = *(const u32x2*)(hbp + (size_t)TOK(t1) * DM + 256 * sl + cc); \
            _Pragma("unroll") for (int i = 0; i < 8; ++i) NA[i] = __builtin_amdgcn_raw_buffer_load_b128(V8, (int)e1[i >> 2][i & 3] * 128 + c16, 0, 0); \
            asm volatile("" ::: "memory"); \
            int ahi[16], aall[16]; \
            _Pragma("unroll") for (int n = 0; n < 16; ++n) { ahi[n] = 0; aall[n] = 0; } \
            axpy4rows(CA[0], CA[1], CA[2], CA[3], av[0], ahi, aall); axpy4rows(CA[4], CA[5], CA[6], CA[7], av[1], ahi, aall); \
            _Pragma("unroll") for (int i = 0; i < 8; ++i) NB[i] = __builtin_amdgcn_raw_buffer_load_b128(V8, (int)e1[2 + (i >> 2)][i & 3] * 128 + c16, 0, 0); \
            asm volatile("" ::: "memory"); \
            axpy4rows(CB[0], CB[1], CB[2], CB[3], av[2], ahi, aall); axpy4rows(CB[4], CB[5], CB[6], CB[7], av[3], ahi, aall); \
            int sa8 = __builtin_amdgcn_sdot4(0x01010101, (int)av[0], 0, false); sa8 = __builtin_amdgcn_sdot4(0x01010101, (int)av[1], sa8, false); sa8 = __builtin_amdgcn_sdot4(0x01010101, (int)av[2], sa8, false); sa8 = __builtin_amdgcn_sdot4(0x01010101, (int)av[3], sa8, false); \
            sa8 *= 8; \
            int acc[32];                                                \
            _Pragma("unroll") for (int d_ = 0; d_ < 4; ++d_) _Pragma("unroll") for (int b_ = 0; b_ < 4; ++b_) { acc[8 * d_ + 4 + b_] = ahi[4 * d_ + b_]; acc[8 * d_ + b_] = (aall[4 * d_ + b_] - ahi[4 * d_ + b_] - sa8) << 4; } \
            int r16[16], r8[8]; float hv[4]; \
            _Pragma("unroll") for (int n = 0; n < 16; ++n) r16[n] = swap32_addi(acc[n], acc[16 + n]); \
            _Pragma("unroll") for (int n = 0; n < 8; ++n) r8[n] = swap16_addi(r16[n], r16[8 + n]); \
            _Pragma("unroll") for (int n = 0; n < 4; ++n) { const int keep = b3 ? r8[4 + n] : r8[n], send = b3 ? r8[n] : r8[4 + n]; hv[n] = (float)(keep + DPP_MOV_I(send, DPP_ROR8)) * sa; } \
            hv[0] += __uint_as_float(hold[0] << 16); hv[1] += __uint_as_float(hold[0] & 0xffff0000u); hv[2] += __uint_as_float(hold[1] << 16); hv[3] += __uint_as_float(hold[1] & 0xffff0000u); \
            const float ss = wave_sum_fast((hv[0] * hv[0] + hv[1] * hv[1]) + (hv[2] * hv[2] + hv[3] * hv[3])); \
            *(u32x2*)(hb_w + (size_t)TOK(tt) * DM + 256 * sl + cc) = (u32x2){cvtpk(hv[0], hv[1]), cvtpk(hv[2], hv[3])}; \
            if (f_lane == 0) part_w[(size_t)TOK(tt) * 16 + sl] = ss; \
            if (sl == 0 && f_lane >= 4 && f_lane < 16) part_w[(size_t)TOK(tt) * 16 + f_lane] = 0.f; \
            av = a1; sa = sa1; hold = hold1; \
            V_SPREAD(slot, ri, ra, rs, e1, a1, sa1); \
            { const int t3 = (tt + 3 * NGWL < T / 2) ? tt + 3 * NGWL : tt; V_LOAD(TOK(t3), ri, ra, rs); } } while (0)
        for (;;) {
            V_ITEM(A0, B0, A1, B1, 0); tt += NGWL; if (tt >= T / 2) break;
            V_ITEM(A1, B1, A0, B0, 1); tt += NGWL; if (tt >= T / 2) break;
        }
#undef V_ITEM
#undef V_LOAD
#undef V_SPREAD
#undef TOK
    }
    __syncthreads();
}
DI void final_norm(Frame& F) {
    FRAME_IDS;
    const float* part = (const float*)(F.ws + WS_PART); const bf16* hbp = (const bf16*)(F.ws + WS_XB);
    const int gw = F.bid * NWAVES + F.wave, NGW = F.G * NWAVES;
    for (int t = gw; t < T; t += NGW) {
        const float r = rstd_bcast(part, t);
        const u32x2* hp = (const u32x2*)(hbp + (size_t)t * DM) + f_lane;
        f32x4* op = (f32x4*)(F.out + (size_t)t * DM) + f_lane;
        const f32x4* gp = (const f32x4*)F.final_norm + f_lane;
#pragma unroll
        for (int q = 0; q < 4; ++q) { const u32x2 w = hp[64 * q];
            const f32x4 h = {__uint_as_float(w[0] << 16), __uint_as_float(w[0] & 0xffff0000u), __uint_as_float(w[1] << 16), __uint_as_float(w[1] & 0xffff0000u)};
            op[64 * q] = h * r * gp[64 * q]; }
    }
}
DI void opt_conv(Frame& F) {
    FRAME_IDS;
    const bf16* G = (const bf16*)(F.ws + WS_GLU); bf16* H2 = (bf16*)(F.ws + WS_HID2);
    LAS float* ys = (LAS float*)F.lds;
    f32x2 wt[CW];
#pragma unroll
    for (int j = 0; j < CW; ++j) wt[j] = *(const f32x2*)(F.conv_dw + j * DM + 2 * f_tid);
    const f32x2 bdw = *(const f32x2*)(F.conv_dw_b + 2 * f_tid);
    f32x4 lng[4], lnb[4];
#pragma unroll
    for (int k = 0; k < 4; ++k) { lng[k] = *(const f32x4*)(F.conv_ln_g + 256 * k + 4 * f_lane); lnb[k] = *(const f32x4*)(F.conv_ln_b + 256 * k + 4 * f_lane); }
    for (int it = F.bid; it < T / 128; it += F.G) {
        const int s0 = (it % (SEQ / 128)) * 128;
        const size_t row0 = (size_t)it * 128;
        const unsigned* gp = (const unsigned*)G + f_tid;
        f32x2 win[CW];
#pragma unroll
        for (int u = 0; u < CW - 1; ++u) { const int sp = s0 - (CW - 1) + u; const unsigned xv = sp >= 0 ? gp[(row0 - (CW - 1) + u) * 512] : 0u; win[u + 1] = (f32x2){__uint_as_float(xv << 16), __uint_as_float(xv & 0xffff0000u)}; }
        win[0] = (f32x2){0.f, 0.f};
        unsigned nx[CW], nn[CW];
#pragma unroll
        for (int u = 0; u < CW; ++u) nx[u] = (s0 + u < SEQ) ? gp[(row0 + u) * 512] : 0u;
        for (int bt = 0; bt < 5; ++bt) {
#pragma unroll
            for (int u = 0; u < CW; ++u) { const int sl = 31 * (bt + 1) + u; nn[u] = (bt < 4 && s0 + sl < SEQ) ? gp[(row0 + sl) * 512] : 0u; }
            __syncthreads();
#pragma unroll
            for (int u = 0; u < CW; ++u) {
                win[u] = (f32x2){__uint_as_float(nx[u] << 16), __uint_as_float(nx[u] & 0xffff0000u)};
                f32x2 a = bdw;
#pragma unroll
                for (int j = 0; j < CW; ++j) a = wt[j] * win[(u + 1 + j) % CW] + a;
                *(LAS f32x2*)(ys + u * DM + 2 * f_tid) = a;
            }
            __syncthreads();
            for (int u = F.wave; u < CW; u += NWAVES) {
                const int sl = 31 * bt + u;
                if (sl < 128) {
                    f32x4 v[4]; float sm = 0.f;
#pragma unroll
                    for (int k = 0; k < 4; ++k) { v[k] = *(const LAS f32x4*)(ys + u * DM + 256 * k + 4 * f_lane); sm += (v[k][0] + v[k][1]) + (v[k][2] + v[k][3]); }
                    const float mu = wave_sum(sm) * (1.f / DM);
                    float sq = 0.f;
#pragma unroll
                    for (int k = 0; k < 4; ++k) { v[k] = v[k] - mu; sq += (v[k][0] * v[k][0] + v[k][1] * v[k][1]) + (v[k][2] * v[k][2] + v[k][3] * v[k][3]); }
                    const float rs = 1.f / sqrtf(wave_sum(sq) * (1.f / DM) + EPS);
#pragma unroll
                    for (int k = 0; k < 4; ++k) {
                        f32x4 z = v[k] * rs * lng[k] + lnb[k];
#pragma unroll
                        for (int e = 0; e < 4; ++e) z[e] = z[e] / (1.f + __expf(-z[e]));
                        *(u32x2*)(H2 + (row0 + sl) * DM + 256 * k + 4 * f_lane) = (u32x2){cvtpk(z[0], z[1]), cvtpk(z[2], z[3])};
                    }
                }
            }
#pragma unroll
            for (int u = 0; u < CW; ++u) nx[u] = nn[u];
        }
    }
    __syncthreads();
}
enum Phase { PH_PREP = 0, PH_PREPW, PH_PROJ, PH_MIX, PH_WOUT, PH_Q0, PH_GU0, PH_GR0, PH_GV0, PH_W1, PH_CONV, PH_W2, PH_Q1, PH_GU1, PH_GR1, PH_GV1, PH_FINAL, PH_COUNT };
struct Args { const float* in[19]; float* out; unsigned char* ws; int ph_lo, ph_hi; };
#ifndef TEST_PHASE
#define TEST_PHASE -1
#endif

__global__ void __launch_bounds__(NTHR, 2) mega_fwd(Args args) {
    extern __shared__ __attribute__((aligned(16))) unsigned char lds[];
    Frame F;
    F.lds = (LAS unsigned char*)lds;
    F.wave = __builtin_amdgcn_readfirstlane((int)threadIdx.x >> 6); FRAME_IDS;
    F.G = gridDim.x; F.bid = blockIdx.x;
    F.x = args.in[0]; F.mix_norm = args.in[1]; F.ffn_norm = args.in[2]; F.final_norm = args.in[3]; F.w_in = args.in[4]; F.w_out = args.in[5]; F.rel_bias = args.in[6];
    F.conv_w1 = args.in[7]; F.conv_b1 = args.in[8]; F.conv_dw = args.in[9]; F.conv_dw_b = args.in[10]; F.conv_ln_g = args.in[11]; F.conv_ln_b = args.in[12];
    F.conv_w2 = args.in[13]; F.conv_b2 = args.in[14]; F.peer_wq = args.in[15]; F.peer_keys = args.in[16]; F.peer_u = args.in[17]; F.peer_v = args.in[18];
    F.out = args.out; F.ws = args.ws;
    volatile LAS unsigned* MISC = (volatile LAS unsigned*)(F.lds + MISC_OFF);
    for (int u = f_tid; u < (LDS_BYTES - LDSCTL_OFF) / 4; u += NTHR) ((LAS unsigned*)(F.lds + LDSCTL_OFF))[u] = 0u;
    __syncthreads();
    const int lo = args.ph_lo, hi = args.ph_hi;
    XcdBarrier bar; bar.bar = (unsigned*)(F.ws + WS_CTL) + CW_BAR; bar.x = 0; bar.st = nullptr;
    if (hi - lo > 1) bar = xcd_barrier_post((unsigned*)(F.ws + WS_CTL) + CW_BAR, MISC + 8);
#define IN(k) ((TEST_PHASE < 0 || TEST_PHASE == (k)) && lo <= (k) && (k) < hi)
#define SEAM(k) do { if (IN(k) && IN((k) + 1)) xcd_barrier(bar, F.wave); } while (0)
#define REPS(k) for (int rep_ = ((k) == REP_PHASE ? 0 : 1); rep_ < 2; ++rep_)
#define GEMM_PHASE(EPI, Aptr, Bptr, NN, ...) do { pg8::Gemm g{(const bf16*)(Aptr), (const bf16*)(Bptr), T, (NN), DM}; pg8::StaticOrder S; S.init(T, (NN), F.G, F.bid); \
        pg8::EPI E{__VA_ARGS__}; pg8::gemm_phase<pg8::EPI, pg8::StaticOrder, true, true>(F.lds, g, S, E, F.wave); } while (0)
    bf16* XB = (bf16*)(F.ws + WS_XB);
    float* PART = (float*)(F.ws + WS_PART); const float* ROPE = (const float*)(F.ws + WS_ROPE);
    if (IN(PH_PREP)) REPS(PH_PREP) { p0_prep(F); p0_weights(F, 0); } SEAM(PH_PREP);
    if (IN(PH_PREPW)) REPS(PH_PREPW) { p0_weights(F, 1); } SEAM(PH_PREPW);
    if (PROBE_MODE == 9 && IN(PH_PREP) && IN(PH_PREP + 1)) { for (int xb_ = 0; xb_ < 8; ++xb_) xcd_barrier(bar, F.wave); }
    if (IN(PH_PROJ)) REPS(PH_PROJ) { { pg8::Gemm g{(const bf16*)XB, (const bf16*)(F.ws + WS_WIN), T, INC, DM / 2}; pg8::StaticOrder S; S.init(T, INC, F.G, F.bid); pg8::EpiProj8 E{(bf16*)(F.ws + WS_R), ROPE, (const float*)(F.ws + WS_ROWSC), (const float*)(F.ws + WS_COLSC)}; pg8::gemm_phase<pg8::EpiProj8, pg8::StaticOrder, true, true, true>(F.lds, g, S, E, F.wave); } } SEAM(PH_PROJ);
    if (IN(PH_MIX)) REPS(PH_MIX) { mix_phase(F, rep_); } SEAM(PH_MIX);
    if (IN(PH_WOUT)) REPS(PH_WOUT) { GEMM_PHASE(EpiRes, F.ws + WS_O, F.ws + WS_WOUT, DM, F.x, XB, PART, nullptr); } SEAM(PH_WOUT);
    if (IN(PH_Q0)) REPS(PH_Q0) { GEMM_PHASE(EpiQ, XB, F.ws + WS_WQ, DM, (bf16*)(F.ws + WS_Q), PART); asm volatile("s_waitcnt vmcnt(0)" ::: "memory"); __syncthreads(); opt_route(F, 0); } SEAM(PH_Q0);
    const bool census = (hi - lo > 1);
    if (IN(PH_GU0)) REPS(PH_GU0) { gather_u(F, 0, get_xinfo(F, census), rep_ == 0); } SEAM(PH_GU0);
    if (IN(PH_GR0)) REPS(PH_GR0) { gather_r(F, 0); } SEAM(PH_GR0);
    if (IN(PH_GV0)) REPS(PH_GV0) { gather_v(F, 0, get_xinfo(F, census), rep_ == 0); } SEAM(PH_GV0);
    if (IN(PH_W1)) REPS(PH_W1) { GEMM_PHASE(EpiGlu, XB, F.ws + WS_W1, 2 * DM, (bf16*)(F.ws + WS_GLU), PART, F.conv_b1); } SEAM(PH_W1);
    if (IN(PH_CONV)) REPS(PH_CONV) { opt_conv(F); } SEAM(PH_CONV);
    if (IN(PH_W2)) { GEMM_PHASE(EpiRes, F.ws + WS_HID2, F.ws + WS_W2, DM, nullptr, XB, PART, F.conv_b2); } SEAM(PH_W2);
    if (IN(PH_Q1)) REPS(PH_Q1) { GEMM_PHASE(EpiQ, XB, F.ws + WS_WQ + (size_t)DM * DM * 2, DM, (bf16*)(F.ws + WS_Q), PART); asm volatile("s_waitcnt vmcnt(0)" ::: "memory"); __syncthreads(); opt_route(F, 1); } SEAM(PH_Q1);
    if (IN(PH_GU1)) REPS(PH_GU1) { gather_u(F, 1, get_xinfo(F, census), rep_ == 0); } SEAM(PH_GU1);
    if (IN(PH_GR1)) REPS(PH_GR1) { gather_r(F, 1); } SEAM(PH_GR1);
    if (IN(PH_GV1)) REPS(PH_GV1) { gather_v(F, 1, get_xinfo(F, census), rep_ == 0); } SEAM(PH_GV1);
    if (IN(PH_FINAL)) { final_norm(F); }
#undef IN
#undef SEAM
}

extern "C" void kernel_launch(void* const* d_in, const int* in_sizes, int n_in, void* d_out, int out_size, void* d_ws, size_t ws_size, hipStream_t stream) {
    static int grid = 0;
    if (grid == 0) {
        if (n_in != 19 || out_size != T * DM || ws_size < WS_END) { fprintf(stderr, "kernel_launch: unexpected shapes (n_in %d out %d ws %zu)\n", n_in, out_size, ws_size); grid = -1; return; }
        int dev = 0, cus = 0;
        if (hipGetDevice(&dev) != hipSuccess || hipDeviceGetAttribute(&cus, hipDeviceAttributeMultiprocessorCount, dev) != hipSuccess) { grid = -1; return; }
        if (hipFuncSetAttribute((const void*)mega_fwd, hipFuncAttributeMaxDynamicSharedMemorySize, LDS_BYTES) != hipSuccess) { fprintf(stderr, "kernel_launch: hipFuncSetAttribute failed\n"); grid = -1; return; }
        (void)hipGetLastError();
        grid = cus;
    }
    if (grid < 0) return;
    (void)hipMemsetAsync((char*)d_ws + WS_CTL, 0, CTL_ZERO_BYTES, stream);
    Args a{};
    for (int i = 0; i < 19; ++i) a.in[i] = (const float*)d_in[i];
    a.out = (float*)d_out; a.ws = (unsigned char*)d_ws;
#if MK_ONE_LAUNCH
    a.ph_lo = 0; a.ph_hi = PH_COUNT;
    hipLaunchKernelGGL(mega_fwd, dim3(grid), dim3(NTHR), LDS_BYTES, stream, a);
#else
    for (int p = 0; p < PH_COUNT; ++p) { a.ph_lo = p; a.ph_hi = p + 1; hipLaunchKernelGGL(mega_fwd, dim3(grid), dim3(NTHR), LDS_BYTES, stream, a); }
#endif
}
```

```cpp
#include <hip/hip_runtime.h>
#include <cstdio>
#include <cstdint>

#ifndef REP_PHASE
#define REP_PHASE -1
#endif
#ifndef PROBE_MODE
#define PROBE_MODE 1
#endif
#ifndef MK_ONE_LAUNCH
#define MK_ONE_LAUNCH 1
#endif

#define GAS __attribute__((address_space(1)))
#define LAS __attribute__((address_space(3)))
#define DI __device__ __forceinline__
typedef unsigned short bf16;
typedef float f32x2 __attribute__((ext_vector_type(2)));
typedef float f32x4 __attribute__((ext_vector_type(4)));
typedef unsigned u32x2 __attribute__((ext_vector_type(2)));
typedef unsigned u32x4 __attribute__((ext_vector_type(4)));
typedef short bf16x8 __attribute__((ext_vector_type(8)));
typedef float f32x16 __attribute__((ext_vector_type(16)));

constexpr int NB = 16, SEQ = 2048, DM = 1024, T = NB * SEQ;
constexpr int CHUNK = 64, HD = 64, NHA = 8, NHB = 8, INC = 3584, NCH = SEQ / CHUNK;
constexpr int PH = 8, PK = 128, PE = PK * PK, PQD = 128, PTOP = 16, NSEL = PH * PTOP;
constexpr int CW = 31;
constexpr float EPS = 1e-6f;
constexpr float LOG2E = 1.4426950408889634f;
constexpr float XQ = 127.f / 6.f;
constexpr int NWAVES = 8, NTHR = NWAVES * 64;

constexpr int C_QA = 0, C_KA = 512, C_VA = 1024, C_QB = 1536, C_KB = 2048, C_VB = 2560, C_GB = 3072;

constexpr size_t MiB = 1u << 20;
constexpr size_t WS_CTL = 0, CTL_ZERO_BYTES = 1 * MiB;
constexpr size_t WS_WIN = 2 * MiB, WS_WOUT = 9 * MiB, WS_W1 = 11 * MiB, WS_W2 = 15 * MiB, WS_WQ = 17 * MiB;
constexpr size_t WS_ROPE = 22 * MiB;
constexpr size_t WS_PART = 23 * MiB;
constexpr size_t WS_EIDX = 26 * MiB;
constexpr size_t WS_GATE = 42 * MiB;
constexpr size_t WS_U8 = 64 * MiB, WS_V8 = 96 * MiB;
constexpr size_t WS_SC = 25 * MiB;
constexpr size_t WS_ROWSC = 59 * MiB;
constexpr size_t WS_COLSC = 60 * MiB;
constexpr size_t WS_SA = 58 * MiB;
constexpr size_t WS_PU = 256 * MiB;
constexpr size_t WS_A = 384 * MiB;
constexpr size_t WS_XB = 128 * MiB;
constexpr size_t WS_R = 192 * MiB;
constexpr size_t WS_O = 416 * MiB;
constexpr size_t WS_Q = 192 * MiB;
constexpr size_t WS_HID = 256 * MiB;
constexpr size_t WS_GLU = 384 * MiB;
constexpr size_t WS_HID2 = 448 * MiB;
constexpr size_t WS_END = 512 * MiB;
constexpr int CW_BAR = 4096, CW_QUEUE = 8192;

constexpr int RING_BYTES = 131072, LDSCTL_OFF = RING_BYTES, MISC_OFF = LDSCTL_OFF + 320, LDS_BYTES = 147456;

DI float bf2f(bf16 v) { return __uint_as_float(((unsigned)v) << 16); }
DI unsigned f2bf(float f) { unsigned u = __float_as_uint(f); return (u + 0x7fffu + ((u >> 16) & 1u)) >> 16; }
DI unsigned pk2(float lo, float hi) { return f2bf(lo) | (f2bf(hi) << 16); }
#define DPP_MOV_I(x, ctrl) __builtin_amdgcn_mov_dpp((x), (ctrl), 0xF, 0xF, false)
#define DPP_XOR1 0xB1
#define DPP_XOR2 0x4E
#define DPP_HMIRROR 0x141
#define DPP_ROR8 0x128
DI float swap32_add(const float a, const float b) { const auto r = __builtin_amdgcn_permlane32_swap(__float_as_uint(a), __float_as_uint(b), false, false); return __uint_as_float(r[0]) + __uint_as_float(r[1]); }
DI float swap16_add(const float a, const float b) { const auto r = __builtin_amdgcn_permlane16_swap(__float_as_uint(a), __float_as_uint(b), false, false); return __uint_as_float(r[0]) + __uint_as_float(r[1]); }
DI int swap32_addi(const int a, const int b) { const auto r = __builtin_amdgcn_permlane32_swap((unsigned)a, (unsigned)b, false, false); return (int)(r[0] + r[1]); }
DI int swap16_addi(const int a, const int b) { const auto r = __builtin_amdgcn_permlane16_swap((unsigned)a, (unsigned)b, false, false); return (int)(r[0] + r[1]); }
DI float wave_sum_fast(float v) {
    v += __int_as_float(DPP_MOV_I(__float_as_int(v), DPP_XOR1)); v += __int_as_float(DPP_MOV_I(__float_as_int(v), DPP_XOR2));
    v += __int_as_float(DPP_MOV_I(__float_as_int(v), DPP_HMIRROR)); v += __int_as_float(DPP_MOV_I(__float_as_int(v), DPP_ROR8));
    v = swap16_add(v, v); v = swap32_add(v, v);
    return v;
}
DI float wave_sum(float v) { return wave_sum_fast(v); }
DI float swap32_max(const float a) { const auto r = __builtin_amdgcn_permlane32_swap(__float_as_uint(a), __float_as_uint(a), false, false); return fmaxf(__uint_as_float(r[0]), __uint_as_float(r[1])); }
DI float swap16_max(const float a) { const auto r = __builtin_amdgcn_permlane16_swap(__float_as_uint(a), __float_as_uint(a), false, false); return fmaxf(__uint_as_float(r[0]), __uint_as_float(r[1])); }
DI float wave_max(float v) {
    v = fmaxf(v, __int_as_float(DPP_MOV_I(__float_as_int(v), DPP_XOR1))); v = fmaxf(v, __int_as_float(DPP_MOV_I(__float_as_int(v), DPP_XOR2)));
    v = fmaxf(v, __int_as_float(DPP_MOV_I(__float_as_int(v), DPP_HMIRROR))); v = fmaxf(v, __int_as_float(DPP_MOV_I(__float_as_int(v), DPP_ROR8)));
    v = swap16_max(v); v = swap32_max(v);
    return v;
}
DI float block_sum(float v, LAS float* red, int tid) {
    v = wave_sum(v);
    __syncthreads();
    if ((tid & 63) == 0) red[tid >> 6] = v;
    __syncthreads();
    float s = 0.f;
#pragma unroll
    for (int i = 0; i < NWAVES; ++i) s += red[i];
    return s;
}
DI float gelu_erf(float x) { return 0.5f * x * (1.f + erff(x * 0.70710678118654752f)); }
DI float sigmoidf(float x) { return 1.f / (1.f + __expf(-x)); }

DI int lane_id() { int r; asm volatile("v_mbcnt_lo_u32_b32 %0, -1, 0\n\tv_mbcnt_hi_u32_b32 %0, -1, %0" : "=v"(r)); return r; }
#define XB_TMO      128
#define XB_XCNT(j)  (256  + 64 * (j))
#define XB_XSUB(j)  (1280 + 64 * (j))
#define XB_XGEN(j)  (2304 + 64 * (j))
#define XB_TOP      3328
#define XB_TOPGEN   3392
#define XCD_BAR_WORDS 3456
#define XB_SPIN_CAP (1u << 22)
DI unsigned xb_ld(unsigned* p)              { return __hip_atomic_load(p, __ATOMIC_RELAXED, __HIP_MEMORY_SCOPE_AGENT); }
DI unsigned xb_add(unsigned* p, unsigned v) { return __hip_atomic_fetch_add(p, v, __ATOMIC_RELAXED, __HIP_MEMORY_SCOPE_AGENT); }
DI unsigned xb_xcc_id() { return (unsigned)__builtin_amdgcn_s_getreg((3 << 11) | 20) & 0xFu; }
#define XB_SPIN(cond, bar) do { unsigned _sp = 0; while (cond) { __builtin_amdgcn_s_sleep(1); \
    if ((++_sp & 255u) == 0u) { if (xb_ld(&(bar)[XB_TMO])) break; if (_sp > XB_SPIN_CAP) { atomicAdd(&(bar)[XB_TMO], 1u); break; } } } } while (0)
struct XcdBarrier { unsigned* bar; unsigned x; volatile LAS unsigned* st; };
DI XcdBarrier xcd_barrier_post(unsigned* bar, volatile LAS unsigned* st) {
    XcdBarrier b; b.bar = bar; b.x = xb_xcc_id(); b.st = st;
    if (threadIdx.x == 0) st[4] = xb_add(&bar[XB_XCNT(b.x)], 1u);
    return b;
}
DI void xcd_barrier_complete(unsigned* bar, unsigned x, unsigned& nloc, unsigned& nx) {
    const unsigned G = gridDim.x * gridDim.y * gridDim.z;
    unsigned sum, cnt, mine, sp = 0u;
    for (;;) {
        sum = 0u; cnt = 0u; mine = 0u;
#pragma unroll
        for (unsigned j = 0; j < 16; ++j) { const unsigned c = xb_ld(&bar[XB_XCNT(j)]); sum += c; cnt += (c > 0u) ? 1u : 0u; mine = (j == x) ? c : mine; }
        if (sum == G) break;
        __builtin_amdgcn_s_sleep(1);
        if ((++sp & 255u) == 0u) { if (xb_ld(&bar[XB_TMO])) break; if (sp > XB_SPIN_CAP) { atomicAdd(&bar[XB_TMO], 1u); break; } }
    }
    nloc = mine > 0u ? mine : 1u; nx = cnt > 0u ? cnt : 1u;
}
DI void xcd_barrier(const XcdBarrier& b, const int wave_id) {
    asm volatile("s_waitcnt vmcnt(0)" ::: "memory");
    __syncthreads();
    if (wave_id == 0 && lane_id() == 0) {
        unsigned* bar = b.bar;
        __builtin_amdgcn_s_waitcnt(0);
        unsigned nloc = b.st[0], nx = b.st[1];
        if (nloc == 0u) { xcd_barrier_complete(bar, b.x, nloc, nx); b.st[0] = nloc; b.st[1] = nx; }
        const unsigned old = xb_add(&bar[XB_XSUB(b.x)], 1u);
        const unsigned gen = old / nloc;
        if (old + 1u == (gen + 1u) * nloc) {
            __builtin_amdgcn_fence(__ATOMIC_RELEASE, "agent");
            asm volatile("s_waitcnt vmcnt(0)" ::: "memory");
            const unsigned og = xb_add(&bar[XB_TOP], 1u);
            const unsigned tg = og / nx;
            if (og + 1u == (tg + 1u) * nx) xb_add(&bar[XB_TOPGEN], 1u);
            else XB_SPIN(xb_ld(&bar[XB_TOPGEN]) == tg, bar);
            __builtin_amdgcn_fence(__ATOMIC_ACQUIRE, "agent");
            xb_add(&bar[XB_XGEN(b.x)], 1u);
            asm volatile("s_waitcnt vmcnt(0)" ::: "memory");
        } else {
            XB_SPIN(xb_ld(&bar[XB_XGEN(b.x)]) == gen, bar);
            __builtin_amdgcn_fence(__ATOMIC_ACQUIRE, "agent");
            asm volatile("s_waitcnt vmcnt(0)" ::: "memory");
        }
    }
    __syncthreads();
}

namespace pg8 {
#define PG8_LAS __attribute__((address_space(3)))
typedef unsigned short bf16_t;
typedef short bf16x8 __attribute__((ext_vector_type(8)));
typedef float f32x4 __attribute__((ext_vector_type(4)));
typedef unsigned u32x4 __attribute__((ext_vector_type(4)));
typedef int i32x4 __attribute__((ext_vector_type(4)));
constexpr int BM = 256, BK = 64, HALF = 128, HTB = HALF * BK * 2  , STAGE_BYTES = 8 * HTB, NXCD = 8, WGM = 8;

__host__ __device__ __forceinline__ int lds_byte(int r, int c) { const int st = (r >> 4) * 2 + (c >> 5), rr = r & 15, cc = c & 31, ob = rr * 64 + cc * 2; return st * 1024 + (ob ^ (((ob >> 9) & 1) << 5)); }
__host__ __device__ __forceinline__ void stage_rc(int b, int& R, int& C) { const int st = b / 1024, sb = b % 1024, swz = sb ^ (((sb >> 9) & 1) << 5); R = (st >> 1) * 16 + swz / 64; C = (st & 1) * 32 + (swz % 64) / 2; }
__host__ __device__ __forceinline__ int perm32(int rho) { const int n = rho >> 4, i = rho & 15; return 8 * (i >> 2) + 4 * n + (i & 3); }

struct Unit { int pm, pn; };
struct Gemm { const bf16_t* A; const bf16_t* Bt; int M, N, K; };

struct StaticOrder {
    int nM, nN, nwg, G, c;
    __host__ __device__ void init(int M, int N, int G_, int c_) { nM = M / BM; nN = N / BM; nwg = nM * nN; G = G_; c = c_; }
    __host__ __device__ bool next(int i, Unit& u) const {
        const long L = (long)i * G + c; if (L >= nwg) return false;
        int wgid = (int)L; { const int q = nwg / NXCD, r = nwg % NXCD, xcd = wgid % NXCD, off = wgid / NXCD; wgid = (xcd < r ? xcd * (q + 1) : r * (q + 1) + (xcd - r) * q) + off; }
        const int nig = WGM * nN, gid = wgid / nig, fm = gid * WGM, gsz = (nM - fm) < WGM ? (nM - fm) : WGM;
        u.pm = fm + ((wgid % nig) % gsz); u.pn = (wgid % nig) / gsz; return true;
    }
    __device__ __forceinline__ void a_ready(const Unit&) const {}
    __device__ __forceinline__ void done(const Unit&) const {}
};

__device__ __forceinline__ unsigned cvt_pk_bf16(float lo, float hi) { unsigned r; asm volatile("v_cvt_pk_bf16_f32 %0, %1, %2" : "=v"(r) : "v"(lo), "v"(hi)); return r; }
__device__ __forceinline__ float rstd16(const float* part, int r, int fq) {
    const f32x4 a = *(const f32x4*)(part + (size_t)r * 16 + 4 * fq);
    float s = (a[0] + a[1]) + (a[2] + a[3]);
    s = swap16_add(s, s); s = swap32_add(s, s);
    return 1.f / sqrtf(s * (1.f / 1024.f) + 1e-6f);
}
__device__ __forceinline__ u32x4 pack8(const f32x4 a, const f32x4 b) { u32x4 w; w.x = cvt_pk_bf16(a[0], a[1]); w.y = cvt_pk_bf16(a[2], a[3]); w.z = cvt_pk_bf16(b[0], b[1]); w.w = cvt_pk_bf16(b[2], b[3]); return w; }
#define rot(t1, t2, c, s) do { const float a_ = (t1) * (c) - (t2) * (s), b_ = (t1) * (s) + (t2) * (c); (t1) = a_; (t2) = b_; } while (0)

struct EpiProj8 {
    static constexpr bool PERM = true, AFTER_DRAIN = false;
    bf16_t* R; const float* rope; const float* rowsc; const float* colsc;
    __device__ __forceinline__ void operator()(const f32x4 (&acc)[2][2][4][2], const Unit& u, int wr, int wc, int fr, int fq) const {
        const int type = u.pn >> 1, hg = u.pn & 1;
        const int colbase = type * 512 + (4 * hg + wc) * 64 + 8 * fq;
        const bool do_rope = (type == 3) || (type == 4);
        f32x4 cs[2][2];
#pragma unroll
        for (int bj = 0; bj < 2; ++bj)
#pragma unroll
            for (int n = 0; n < 2; ++n) cs[bj][n] = *(const f32x4*)(colsc + u.pn * BM + bj * HALF + wc * 32 + 8 * fq + 4 * n);
#pragma unroll
        for (int ai = 0; ai < 2; ++ai)
#pragma unroll
            for (int m = 0; m < 4; ++m) {
                const int r = u.pm * BM + ai * HALF + wr * 64 + m * 16 + fr;
                const float rs = rowsc[r];
                f32x4 v[2][2];
#pragma unroll
                for (int bj = 0; bj < 2; ++bj)
#pragma unroll
                    for (int n = 0; n < 2; ++n) { const i32x4 ia = __builtin_bit_cast(i32x4, acc[ai][bj][m][n]);
                        v[bj][n] = (f32x4){(float)ia[0], (float)ia[1], (float)ia[2], (float)ia[3]} * cs[bj][n] * rs; }
                f32x4 a0 = v[0][0], a1 = v[0][1], b0 = v[1][0], b1 = v[1][1];
                if (do_rope) {
                    const f32x4* rp = (const f32x4*)(rope + ((size_t)(r & 2047) * 32 + 8 * fq) * 2);
                    const f32x4 c0 = rp[0], c1 = rp[1], c2 = rp[2], c3 = rp[3];
                    rot(a0[0], b0[0], c0[0], c0[1]); rot(a0[1], b0[1], c0[2], c0[3]); rot(a0[2], b0[2], c1[0], c1[1]); rot(a0[3], b0[3], c1[2], c1[3]);
                    rot(a1[0], b1[0], c2[0], c2[1]); rot(a1[1], b1[1], c2[2], c2[3]); rot(a1[2], b1[2], c3[0], c3[1]); rot(a1[3], b1[3], c3[2], c3[3]);
                }
                bf16_t* rowp = R + (size_t)r * 3584 + colbase;
                *(u32x4*)(rowp) = pack8(a0, a1);
                *(u32x4*)(rowp + 32) = pack8(b0, b1);
            }
    }
};
struct EpiRes {
    static constexpr bool PERM = true, AFTER_DRAIN = false;
    const float* xf; bf16_t* hb; float* part; const float* bias;
    __device__ __forceinline__ void operator()(const f32x4 (&acc)[2][2][4][2], const Unit& u, int wr, int wc, int fr, int fq) const {
        const int col0 = u.pn * BM + wc * 32 + 8 * fq;
        f32x4 bv[2][2];
#pragma unroll
        for (int bj = 0; bj < 2; ++bj)
#pragma unroll
            for (int n = 0; n < 2; ++n) bv[bj][n] = bias ? *(const f32x4*)(bias + col0 + bj * HALF + 4 * n) : (f32x4){0.f, 0.f, 0.f, 0.f};
#pragma unroll
        for (int ai = 0; ai < 2; ++ai)
#pragma unroll
            for (int m = 0; m < 4; ++m) {
                const int r = u.pm * BM + ai * HALF + wr * 64 + m * 16 + fr;
                const size_t off = (size_t)r * 1024 + col0;
                float ss = 0.f;
#pragma unroll
                for (int bj = 0; bj < 2; ++bj) {
                    f32x4 x0, x1;
                    if (xf) { x0 = *(const f32x4*)(xf + off + bj * HALF); x1 = *(const f32x4*)(xf + off + bj * HALF + 4); }
                    else { const u32x4 w = *(const u32x4*)(hb + off + bj * HALF);
                           x0 = (f32x4){__uint_as_float(w[0] << 16), __uint_as_float(w[0] & 0xffff0000u), __uint_as_float(w[1] << 16), __uint_as_float(w[1] & 0xffff0000u)};
                           x1 = (f32x4){__uint_as_float(w[2] << 16), __uint_as_float(w[2] & 0xffff0000u), __uint_as_float(w[3] << 16), __uint_as_float(w[3] & 0xffff0000u)}; }
                    const f32x4 h0 = x0 + acc[ai][bj][m][0] + bv[bj][0], h1 = x1 + acc[ai][bj][m][1] + bv[bj][1];
                    *(u32x4*)(hb + off + bj * HALF) = pack8(h0, h1);
                    ss += (h0[0] * h0[0] + h0[1] * h0[1]) + (h0[2] * h0[2] + h0[3] * h0[3]) + (h1[0] * h1[0] + h1[1] * h1[1]) + (h1[2] * h1[2] + h1[3] * h1[3]);
                }
                ss = swap16_add(ss, ss); ss = swap32_add(ss, ss);
                if (fq == 0) part[(size_t)r * 16 + 4 * u.pn + wc] = ss;
            }
    }
};
struct EpiQ {
    static constexpr bool PERM = true, AFTER_DRAIN = false;
    bf16_t* O; const float* part;
    __device__ __forceinline__ void operator()(const f32x4 (&acc)[2][2][4][2], const Unit& u, int wr, int wc, int fr, int fq) const {
        const int col0 = u.pn * BM + wc * 32 + 8 * fq;
#pragma unroll
        for (int ai = 0; ai < 2; ++ai)
#pragma unroll
            for (int m = 0; m < 4; ++m) {
                const int r = u.pm * BM + ai * HALF + wr * 64 + m * 16 + fr;
                const float rs = rstd16(part, r, fq);
                bf16_t* rowp = O + (size_t)r * 1024 + col0;
#pragma unroll
                for (int bj = 0; bj < 2; ++bj) *(u32x4*)(rowp + bj * HALF) = pack8(acc[ai][bj][m][0] * rs, acc[ai][bj][m][1] * rs);
            }
    }
};
struct EpiGlu {
    static constexpr bool PERM = true, AFTER_DRAIN = false;
    bf16_t* G; const float* part; const float* b1;
    __device__ __forceinline__ void operator()(const f32x4 (&acc)[2][2][4][2], const Unit& u, int wr, int wc, int fr, int fq) const {
        const int col = u.pn * 128 + wc * 32 + 8 * fq;
        f32x4 ba[2], bg[2];
#pragma unroll
        for (int n = 0; n < 2; ++n) { ba[n] = *(const f32x4*)(b1 + col + 4 * n); bg[n] = *(const f32x4*)(b1 + 1024 + col + 4 * n); }
#pragma unroll
        for (int ai = 0; ai < 2; ++ai)
#pragma unroll
            for (int m = 0; m < 4; ++m) {
                const int r = u.pm * BM + ai * HALF + wr * 64 + m * 16 + fr;
                const float rs = rstd16(part, r, fq);
                f32x4 y[2];
#pragma unroll
                for (int n = 0; n < 2; ++n) {
                    const f32x4 a = acc[ai][0][m][n] * rs + ba[n], g = acc[ai][1][m][n] * rs + bg[n];
#pragma unroll
                    for (int i = 0; i < 4; ++i) y[n][i] = a[i] / (1.f + __expf(-g[i]));
                }
                *(u32x4*)(G + (size_t)r * 1024 + col) = pack8(y[0], y[1]);
            }
    }
};
template <class Epi, class Sched, bool ALIGN_EPI = false, bool SP2 = false, bool I8 = false>
__device__ __forceinline__ void gemm_phase(PG8_LAS unsigned char* lds, const Gemm g, const Sched& S, const Epi& E, const int wave_id) {
    const int lane = lane_id(), wid = wave_id, tid = wid * 64 + lane, wr = wid >> 2, wc = wid & 3, fr = lane & 15, fq = lane >> 4;
    const int K = g.K, nt = K / BK;
    unsigned voffA[2], voffB[2];
#pragma unroll
    for (int i = 0; i < 2; ++i) { int R, C; stage_rc(tid * 16 + i * 8192, R, C); const int Rb = Epi::PERM ? ((R & ~31) + perm32(R & 31)) : R;
        voffA[i] = (unsigned)(R * K + C) * 2u; voffB[i] = (unsigned)(Rb * K + C) * 2u; }
    const size_t kstep = (size_t)(BK * 2);
    const size_t hstep = (size_t)HALF * K * 2;
    const size_t tstep = 2 * hstep;
    const unsigned ldsw = (unsigned)wid * 1024u;
    const int aoff = lds_byte(wr * 64 + fr, fq * 8), boff = lds_byte(wc * 32 + fr, fq * 8);
#define PG8_SA(b, h) (((b) * 2 + (h)) * HTB)
#define PG8_SB(b, h) ((4 + (b) * 2 + (h)) * HTB)
#define PG8_STAGE(bufoff, gbase, voff) do { _Pragma("unroll") for (int _i = 0; _i < 2; ++_i) \
        __builtin_amdgcn_global_load_lds((const unsigned*)((const char*)(gbase) + (voff)[_i]), (PG8_LAS unsigned*)(lds + (bufoff) + ldsw + _i * 8192), 16, 0, 0); } while (0)
#define PG8_LDA(dst, b, h) do { _Pragma("unroll") for (int m = 0; m < 4; ++m) _Pragma("unroll") for (int k = 0; k < 2; ++k) dst[m][k] = *(const PG8_LAS bf16x8*)(lds + PG8_SA(b, h) + aoff + m * 2048 + k * 1024); } while (0)
#define PG8_LDB(dst, b, h) do { _Pragma("unroll") for (int n = 0; n < 2; ++n) _Pragma("unroll") for (int k = 0; k < 2; ++k) dst[n][k] = *(const PG8_LAS bf16x8*)(lds + PG8_SB(b, h) + boff + n * 2048 + k * 1024); } while (0)
#define PG8_MMA(ai, bj, At, Bt) do { __builtin_amdgcn_s_setprio(1); _Pragma("unroll") for (int m = 0; m < 4; ++m) _Pragma("unroll") for (int n = 0; n < 2; ++n) _Pragma("unroll") for (int k = 0; k < 2; ++k) { \
        if constexpr (I8) acc[ai][bj][m][n] = __builtin_bit_cast(f32x4, __builtin_amdgcn_mfma_i32_16x16x64_i8(__builtin_bit_cast(i32x4, Bt[n][k]), __builtin_bit_cast(i32x4, At[m][k]), __builtin_bit_cast(i32x4, acc[ai][bj][m][n]), 0, 0, 0)); \
        else acc[ai][bj][m][n] = __builtin_amdgcn_mfma_f32_16x16x32_bf16(Bt[n][k], At[m][k], acc[ai][bj][m][n], 0, 0, 0); } __builtin_amdgcn_s_setprio(0); } while (0)
#define PG8_WAIT_V(n) asm volatile("s_waitcnt vmcnt(" #n ")" ::: "memory")
#define PG8_WAIT_L(n) asm volatile("s_waitcnt lgkmcnt(" #n ")" ::: "memory")
#define PG8_BAR __builtin_amdgcn_s_barrier()
#define PG8_SCHED __builtin_amdgcn_sched_barrier(0)
    Unit cur, nxt; int ui = 0;
    if (!S.next(0, cur)) return;
    f32x4 acc[2][2][4][2];
#pragma unroll
    for (int a = 0; a < 2; ++a)
#pragma unroll
        for (int b = 0; b < 2; ++b)
#pragma unroll
            for (int m = 0; m < 4; ++m)
#pragma unroll
                for (int n = 0; n < 2; ++n) acc[a][b][m][n] = (f32x4){0.f, 0.f, 0.f, 0.f};
    bf16x8 At[4][2], B0[2][2], B1[2][2];
    const char* cA = (const char*)g.A + (size_t)cur.pm * tstep; const char* cB = (const char*)g.Bt + (size_t)cur.pn * tstep;
    S.a_ready(cur);
    if constexpr (SP2) {
        PG8_STAGE(PG8_SB(0, 0), cB, voffB); PG8_STAGE(PG8_SB(0, 1), cB + hstep, voffB); PG8_STAGE(PG8_SA(0, 0), cA, voffA); PG8_STAGE(PG8_SA(0, 1), cA + hstep, voffA);
        if (wr == 1) PG8_BAR;
        PG8_WAIT_V(2); PG8_BAR;
        PG8_STAGE(PG8_SB(1, 0), cB + kstep, voffB); PG8_STAGE(PG8_SA(1, 0), cA + kstep, voffA); PG8_STAGE(PG8_SB(1, 1), cB + hstep + kstep, voffB);
        PG8_WAIT_V(6); PG8_BAR;
    } else {
        PG8_STAGE(PG8_SB(0, 0), cB, voffB); PG8_STAGE(PG8_SA(0, 0), cA, voffA); PG8_STAGE(PG8_SB(0, 1), cB + hstep, voffB); PG8_STAGE(PG8_SA(0, 1), cA + hstep, voffA);
        if (wr == 1) PG8_BAR;
        PG8_WAIT_V(4); PG8_BAR;
        PG8_STAGE(PG8_SB(1, 0), cB + kstep, voffB); PG8_STAGE(PG8_SA(1, 0), cA + kstep, voffA); PG8_STAGE(PG8_SB(1, 1), cB + hstep + kstep, voffB);
        PG8_WAIT_V(6); PG8_BAR;
    }
    for (;;) {
        const bool has_next = S.next(ui + 1, nxt);
        const char* nA = has_next ? (const char*)g.A + (size_t)nxt.pm * tstep : cA; const char* nB = has_next ? (const char*)g.Bt + (size_t)nxt.pn * tstep : cB;
        for (int t = 0; t < nt; t += 2) {
            const bool last = (t == nt - 2);
            const char* a1 = cA + (size_t)(t + 1) * kstep;
            const char* a2 = last ? nA : cA + (size_t)(t + 2) * kstep; const char* b2 = last ? nB : cB + (size_t)(t + 2) * kstep;
            const char* a3 = a2 + kstep; const char* b3 = b2 + kstep;
            if (last && has_next) S.a_ready(nxt);
            if constexpr (SP2) {
            PG8_LDB(B0, 0, 0); PG8_LDB(B1, 0, 1); PG8_SCHED; PG8_LDA(At, 0, 0); PG8_STAGE(PG8_SA(1, 1), a1 + hstep, voffA);
            PG8_WAIT_V(8); PG8_WAIT_L(0); PG8_BAR; PG8_MMA(0, 0, At, B0); PG8_MMA(0, 1, At, B1); PG8_BAR; PG8_SCHED;
            PG8_LDA(At, 0, 1); PG8_STAGE(PG8_SB(0, 0), b2, voffB); PG8_STAGE(PG8_SB(0, 1), b2 + hstep, voffB); PG8_STAGE(PG8_SA(0, 0), a2, voffA);
            PG8_WAIT_V(8); PG8_WAIT_L(0); PG8_BAR; PG8_MMA(1, 0, At, B0); PG8_MMA(1, 1, At, B1); PG8_BAR; PG8_SCHED;
            PG8_LDB(B0, 1, 0); PG8_LDB(B1, 1, 1); PG8_SCHED; PG8_LDA(At, 1, 0); PG8_STAGE(PG8_SA(0, 1), a2 + hstep, voffA);
            PG8_WAIT_V(8); PG8_WAIT_L(0); PG8_BAR; PG8_MMA(0, 0, At, B0); PG8_MMA(0, 1, At, B1); PG8_BAR; PG8_SCHED;
            PG8_LDA(At, 1, 1); PG8_STAGE(PG8_SB(1, 0), b3, voffB); PG8_STAGE(PG8_SB(1, 1), b3 + hstep, voffB); PG8_STAGE(PG8_SA(1, 0), a3, voffA);
            PG8_WAIT_V(8); PG8_WAIT_L(0); PG8_BAR; PG8_MMA(1, 0, At, B0); PG8_MMA(1, 1, At, B1); PG8_BAR; PG8_SCHED;
            } else {
            PG8_LDB(B0, 0, 0); PG8_SCHED; PG8_LDA(At, 0, 0); PG8_STAGE(PG8_SA(1, 1), a1 + hstep, voffA);
            PG8_WAIT_L(8); PG8_BAR; PG8_WAIT_L(0); PG8_MMA(0, 0, At, B0); PG8_BAR; PG8_SCHED;
            PG8_LDB(B1, 0, 1); PG8_STAGE(PG8_SB(0, 0), b2, voffB);
            PG8_BAR; PG8_WAIT_L(0); PG8_MMA(0, 1, At, B1); PG8_BAR;
            PG8_LDA(At, 0, 1); PG8_STAGE(PG8_SA(0, 0), a2, voffA);
            PG8_BAR; PG8_WAIT_L(0); PG8_MMA(1, 0, At, B0); PG8_BAR; PG8_SCHED;
            PG8_STAGE(PG8_SB(0, 1), b2 + hstep, voffB);
            PG8_WAIT_V(6); PG8_BAR; PG8_MMA(1, 1, At, B1); PG8_BAR;
            PG8_LDB(B0, 1, 0); PG8_SCHED; PG8_LDA(At, 1, 0); PG8_STAGE(PG8_SA(0, 1), a2 + hstep, voffA);
            PG8_WAIT_L(8); PG8_BAR; PG8_WAIT_L(0); PG8_MMA(0, 0, At, B0); PG8_BAR; PG8_SCHED;
            PG8_LDB(B1, 1, 1); PG8_STAGE(PG8_SB(1, 0), b3, voffB);
            PG8_BAR; PG8_WAIT_L(0); PG8_MMA(0, 1, At, B1); PG8_BAR;
            PG8_LDA(At, 1, 1); PG8_STAGE(PG8_SA(1, 0), a3, voffA);
            PG8_BAR; PG8_WAIT_L(0); PG8_MMA(1, 0, At, B0); PG8_BAR; PG8_SCHED;
            PG8_STAGE(PG8_SB(1, 1), b3 + hstep, voffB);
            PG8_WAIT_V(6); PG8_BAR; PG8_MMA(1, 1, At, B1); PG8_BAR;
            }
        }
        if constexpr (ALIGN_EPI) { if (wr == 0) PG8_BAR; }
        if constexpr (!Epi::AFTER_DRAIN) { E(acc, cur, wr, wc, fr, fq); S.done(cur); }
        if (!has_next) break;
#pragma unroll
        for (int a = 0; a < 2; ++a)
#pragma unroll
            for (int b = 0; b < 2; ++b)
#pragma unroll
                for (int m = 0; m < 4; ++m)
#pragma unroll
                    for (int n = 0; n < 2; ++n) acc[a][b][m][n] = (f32x4){0.f, 0.f, 0.f, 0.f};
        cur = nxt; cA = nA; cB = nB; ++ui;
        if constexpr (ALIGN_EPI) { if (wr == 1) PG8_BAR; }
    }
    PG8_WAIT_V(0);
    if constexpr (!ALIGN_EPI) { if (wr == 0) PG8_BAR; }
    PG8_BAR;
    if constexpr (Epi::AFTER_DRAIN) { E.fused(acc, cur, wr, wc, fr, fq, lds, wid, lane); S.done(cur); }
#undef PG8_SA
#undef PG8_SB
#undef PG8_STAGE
#undef PG8_LDA
#undef PG8_LDB
#undef PG8_MMA
#undef PG8_WAIT_V
#undef PG8_WAIT_L
#undef PG8_BAR
#undef PG8_SCHED
}
}

struct Frame {
    LAS unsigned char* lds;
    int wave, G, bid;
    const float *x, *mix_norm, *ffn_norm, *final_norm, *w_in, *w_out, *rel_bias, *conv_w1, *conv_b1, *conv_dw, *conv_dw_b, *conv_ln_g, *conv_ln_b, *conv_w2, *conv_b2,
        *peer_wq, *peer_keys, *peer_u, *peer_v;
    float* out;
    unsigned char* ws;
};
#define FRAME_IDS const int f_lane = lane_id(); const int f_tid = F.wave * 64 + f_lane; (void)f_tid
DI float gamma_of(int h) { return 1.f - exp2f(-5.f - (float)h); }

DI unsigned q8x4(f32x4 v, const float sc) {
    const int a = (int)rintf(v[0] * sc), b = (int)rintf(v[1] * sc), c = (int)rintf(v[2] * sc), d = (int)rintf(v[3] * sc);
    return ((unsigned)a & 0xFFu) | (((unsigned)b & 0xFFu) << 8) | (((unsigned)c & 0xFFu) << 16) | ((unsigned)d << 24);
}
DI void p0_prep(Frame& F) {
    FRAME_IDS;
    const int gw = F.bid * NWAVES + F.wave, NGW = F.G * NWAVES;
    f32x2* rope = (f32x2*)(F.ws + WS_ROPE);
    for (int i = F.bid * NTHR + f_tid; i < SEQ * 32; i += F.G * NTHR) {
        const int s = i >> 5, j = i & 31;
        const float inv = powf(10000.f, -(float)j / 32.f);
        const float ang = (float)s * inv;
        float sn, cs; sincosf(ang, &sn, &cs);
        rope[i] = (f32x2){cs, sn};
    }
    unsigned* xq = (unsigned*)(F.ws + WS_XB); float* rowsc = (float*)(F.ws + WS_ROWSC);
    for (int m = gw; m < T; m += NGW) {
        const f32x4* xr = (const f32x4*)(F.x + (size_t)m * DM) + f_lane;
        f32x4 v[4]; float s = 0.f, am = 0.f;
#pragma unroll
        for (int j = 0; j < 4; ++j) { v[j] = xr[64 * j]; s += v[j].x * v[j].x + v[j].y * v[j].y + v[j].z * v[j].z + v[j].w * v[j].w; am = fmaxf(am, fmaxf(fmaxf(fabsf(v[j].x), fabsf(v[j].y)), fmaxf(fabsf(v[j].z), fabsf(v[j].w)))); }
        const float r = 1.f / sqrtf(wave_sum(s) * (1.f / DM) + EPS);
        am = wave_max(am);
        const float sc = am > 0.f ? 127.f / am : 0.f;
#pragma unroll
        for (int j = 0; j < 4; ++j) xq[(size_t)m * (DM / 4) + f_lane + 64 * j] = q8x4(v[j], sc);
        if (f_lane == 0) rowsc[m] = am * (1.f / 127.f) * r;
    }
}
DI void p0_transpose_item(const float* W, int K, int N, bf16* WT, int prow0, const float* gain, float scale, LAS float* scr, int k0, int n0, int lane) {
#pragma unroll 8
    for (int i = 0; i < 32; ++i) { const int kk = 2 * i + (lane >> 5); scr[kk * 33 + (lane & 31)] = W[(size_t)(k0 + kk) * N + n0 + (lane & 31)] * (gain ? gain[k0 + kk] : 1.f) * scale; }
    asm volatile("s_waitcnt lgkmcnt(0)" ::: "memory");
    const int c = lane & 7;
#pragma unroll
    for (int j = 0; j < 4; ++j) { const int n = (lane >> 3) + 8 * j; const LAS float* q = scr + (8 * c) * 33 + n;
        u32x4 o; o.x = pk2(q[0 * 33], q[1 * 33]); o.y = pk2(q[2 * 33], q[3 * 33]); o.z = pk2(q[4 * 33], q[5 * 33]); o.w = pk2(q[6 * 33], q[7 * 33]);
        *(u32x4*)(WT + (size_t)(prow0 + n) * K + k0 + 8 * c) = o; }
    asm volatile("s_waitcnt lgkmcnt(0)" ::: "memory");
}
DI void p0_amax_item(const float* W, int N, unsigned* colmax, const float* gain, float scale, int k0, int n0, int lane) {
    float am = 0.f;
#pragma unroll 8
    for (int i = 0; i < 32; ++i) { const int kk = 2 * i + (lane >> 5); am = fmaxf(am, fabsf(W[(size_t)(k0 + kk) * N + n0 + (lane & 31)] * (gain ? gain[k0 + kk] : 1.f) * scale)); }
    am = swap32_max(am);
    if (lane < 32) __hip_atomic_fetch_max(colmax + lane, __float_as_uint(am), __ATOMIC_RELAXED, __HIP_MEMORY_SCOPE_AGENT);
}
DI void p0_q8_item(const float* W, int N, unsigned char* WT, const unsigned* colmax, float* colsc, int prow0, const float* gain, float scale, LAS float* scr, int k0, int n0, int lane) {
    const float am = __uint_as_float(colmax[lane & 31]);
    const float sc = am > 0.f ? 127.f / am : 0.f;
    if (k0 == 0 && lane < 32) colsc[lane] = am * (1.f / 127.f);
#pragma unroll 8
    for (int i = 0; i < 32; ++i) { const int kk = 2 * i + (lane >> 5); scr[kk * 33 + (lane & 31)] = rintf(W[(size_t)(k0 + kk) * N + n0 + (lane & 31)] * (gain ? gain[k0 + kk] : 1.f) * scale * sc); }
    asm volatile("s_waitcnt lgkmcnt(0)" ::: "memory");
    const int ch = lane & 3;
#pragma unroll
    for (int j = 0; j < 2; ++j) { const int n = (lane >> 2) + 16 * j; const LAS float* q = scr + (16 * ch) * 33 + n;
        u32x4 o;
#pragma unroll
        for (int w = 0; w < 4; ++w) o[w] = ((unsigned)(int)q[(4 * w) * 33] & 0xFFu) | (((unsigned)(int)q[(4 * w + 1) * 33] & 0xFFu) << 8) | (((unsigned)(int)q[(4 * w + 2) * 33] & 0xFFu) << 16) | ((unsigned)(int)q[(4 * w + 3) * 33] << 24);
        *(u32x4*)(WT + (size_t)(prow0 + n) * DM + k0 + 16 * ch) = o; }
    asm volatile("s_waitcnt lgkmcnt(0)" ::: "memory");
}
constexpr int CW_COLMAX = 16384;
constexpr int CS_WIN = 0, CS_WOUT = 3584, CS_W1 = 4608, CS_W2 = 6656, CS_WQ = 7680;
constexpr bool I8_WIN = true, I8_WOUT = false, I8_W1 = false, I8_W2 = false, I8_WQ = false;
DI void p0_weights(Frame& F, const int pass) {
    FRAME_IDS;
    LAS float* scr = (LAS float*)(F.lds + F.wave * 16384);
    unsigned* colmax = (unsigned*)(F.ws + WS_CTL) + CW_COLMAX; float* colsc = (float*)(F.ws + WS_COLSC);
    const int gw = F.bid * NWAVES + F.wave, NGW = F.G * NWAVES;
    constexpr int I_IN = 16 * (INC / 32), I_SQ = 16 * (DM / 32), I_W1 = 16 * (2 * DM / 32);
    constexpr int NITEMS = I_IN + I_SQ + I_W1 + I_SQ + 2 * I_SQ;
#define WITEM(I8FLAG, Wp, Nn, WTb, CSo, prow0, gainp, scl, k0, n0) do { \
        if (pass == 0) { if (I8FLAG) p0_amax_item(Wp, Nn, colmax + (CSo) + (prow0), gainp, scl, k0, n0, f_lane); } \
        else if (I8FLAG) p0_q8_item(Wp, Nn, (unsigned char*)(WTb), colmax + (CSo) + (prow0), colsc + (CSo) + (prow0), prow0, gainp, scl, scr, k0, n0, f_lane); \
        else p0_transpose_item(Wp, DM, Nn, (bf16*)(WTb), prow0, gainp, scl, scr, k0, n0, f_lane); } while (0)
    for (int it = gw; it < NITEMS; it += NGW) {
        int r = it;
        if (r < I_IN) { const int nb = r % (INC / 32), kb = r / (INC / 32), n0 = nb * 32;
            const int type = n0 / 512, head = (n0 % 512) / 64, bj = (n0 % 64) / 32;
            const int prow0 = 256 * (2 * type + head / 4) + 128 * bj + 32 * (head % 4);
            WITEM(I8_WIN, F.w_in, INC, F.ws + WS_WIN, CS_WIN, prow0, F.mix_norm, (type == 0 ? 0.125f * LOG2E : (type == 4 ? 0.125f : 1.f)), kb * 64, n0); continue; }
        r -= I_IN;
        if (r < I_SQ) { const int nb = r % 32, kb = r / 32; WITEM(I8_WOUT, F.w_out, DM, F.ws + WS_WOUT, CS_WOUT, nb * 32, (const float*)nullptr, 1.f, kb * 64, nb * 32); continue; }
        r -= I_SQ;
        if (r < I_W1) { const int nb = r % 64, kb = r / 64, n0 = nb * 32; const int bj = n0 / 1024, rem = n0 % 1024;
            WITEM(I8_W1, F.conv_w1, 2 * DM, F.ws + WS_W1, CS_W1, 256 * (rem / 128) + 128 * bj + (rem % 128), F.mix_norm + DM, 1.f, kb * 64, n0); continue; }
        r -= I_W1;
        if (r < I_SQ) { const int nb = r % 32, kb = r / 32; WITEM(I8_W2, F.conv_w2, DM, F.ws + WS_W2, CS_W2, nb * 32, (const float*)nullptr, 1.f, kb * 64, nb * 32); continue; }
        r -= I_SQ;
        { const int layer = r / I_SQ; r %= I_SQ; const int nb = r % 32, kb = r / 32;
          WITEM(I8_WQ, F.peer_wq + (size_t)layer * DM * DM, DM, F.ws + WS_WQ + (size_t)layer * DM * DM * 2, CS_WQ + layer * DM, nb * 32, F.ffn_norm + layer * DM, 1.f, kb * 64, nb * 32); }
    }
#undef WITEM
}
DI float row_rstd(const float* part, int m) {
    const f32x4* p = (const f32x4*)(part + (size_t)m * 16);
    const f32x4 a = p[0], b = p[1], c = p[2], d = p[3];
    const float s = ((a.x + a.y) + (a.z + a.w)) + ((b.x + b.y) + (b.z + b.w)) + ((c.x + c.y) + (c.z + c.w)) + ((d.x + d.y) + (d.z + d.w));
    return 1.f / sqrtf(s * (1.f / DM) + EPS);
}

typedef short v4i16 __attribute__((ext_vector_type(4)));
typedef __bf16 bf16x2_t __attribute__((ext_vector_type(2)));
DI unsigned cvtpk(float lo, float hi) { f32x2 v = {lo, hi}; bf16x2_t b = __builtin_convertvector(v, bf16x2_t); return __builtin_bit_cast(unsigned, b); }
DI v4i16 ds_tr16(LAS const unsigned char* p) { return __builtin_amdgcn_ds_read_tr16_b64_v4i16((LAS v4i16*)p); }
DI int crow(int r, int h) { return (r & 3) + 8 * (r >> 2) + 4 * h; }
DI bf16x8 pack_step(const f32x16& x, const int s) {
    u32x4 w = {cvtpk(x[8 * s + 0], x[8 * s + 1]), cvtpk(x[8 * s + 2], x[8 * s + 3]), cvtpk(x[8 * s + 4], x[8 * s + 5]), cvtpk(x[8 * s + 6], x[8 * s + 7])};
    return __builtin_bit_cast(bf16x8, w);
}
constexpr int AT_KB = 64 * 144, AT_VB = 8192, AT_BUF = AT_KB + AT_VB, AT_BIAS = 2 * AT_BUF;
DI void attn_item(Frame& F, const int it) {
    FRAME_IDS;
    const bf16* R = (const bf16*)(F.ws + WS_R); bf16* O = (bf16*)(F.ws + WS_O);
    LAS unsigned char* lds = F.lds;
    LAS float* bias_s = (LAS float*)(lds + AT_BIAS);
    const int q32 = f_lane & 31, h = f_lane >> 5, w = F.wave;
    const int srow = f_tid >> 3, sch = f_tid & 7;
    const int vtr_off = ((f_lane & 15) >> 2) * 64 + (16 * ((f_lane >> 4) & 1) + 4 * (f_lane & 3)) * 2;
    {
        const int b = it / (NHA * 8), hd = (it / 8) % NHA, c0 = (it % 8) * 4;
        const int c = c0 + (w >> 1), qrow0 = 32 * (w & 1);
        const size_t tq = (size_t)b * SEQ + c * 64 + qrow0 + q32;
        __syncthreads();
        for (int k = f_tid; k < 257; k += NTHR) bias_s[k] = F.rel_bias[hd * 257 + k] * LOG2E;
        bf16x8 qf[4];
#pragma unroll
        for (int ks = 0; ks < 4; ++ks) qf[ks] = *(const bf16x8*)(R + tq * INC + C_QA + hd * 64 + 16 * ks + 8 * h);
        const int t_lo = c0 - 8 < 0 ? 0 : c0 - 8, t_hi = c0 + 3, ntile = t_hi - t_lo + 1;
        const bf16* kbase = R + ((size_t)b * SEQ + srow) * INC + C_KA + hd * 64 + 8 * sch;
        const bf16* vbase = R + ((size_t)b * SEQ + srow) * INC + C_VA + hd * 64 + 8 * sch;
        u32x4 kreg = *(const u32x4*)(kbase + (size_t)t_lo * 64 * INC), vreg = *(const u32x4*)(vbase + (size_t)t_lo * 64 * INC);
        *(LAS u32x4*)(lds + srow * 144 + sch * 16) = kreg;
        *(LAS u32x4*)(lds + AT_KB + (sch >> 2) * 4096 + srow * 64 + (sch & 3) * 16) = vreg;
        __syncthreads();
        const float bias_far = bias_s[256];
        float m = -1e30f, l = 0.f;
        f32x16 o0 = {}, o1 = {};
        for (int i = 0; i < ntile; ++i) {
            const int tc = t_lo + i;
            LAS unsigned char* kb = lds + (i & 1) * AT_BUF; LAS unsigned char* vb = kb + AT_KB;
            if (i + 1 < ntile) { kreg = *(const u32x4*)(kbase + (size_t)(tc + 1) * 64 * INC); vreg = *(const u32x4*)(vbase + (size_t)(tc + 1) * 64 * INC); }
            const int D = c - tc;
            if (D >= 0 && D <= 8) {
                const float init = D >= 3 ? bias_far : 0.f;
                f32x16 p0, p1;
#pragma unroll
                for (int r = 0; r < 16; ++r) { p0[r] = init; p1[r] = init; }
#pragma unroll
                for (int ks = 0; ks < 4; ++ks) {
                    const bf16x8 k0 = *(const LAS bf16x8*)(kb + q32 * 144 + (16 * ks + 8 * h) * 2);
                    const bf16x8 k1 = *(const LAS bf16x8*)(kb + (32 + q32) * 144 + (16 * ks + 8 * h) * 2);
                    p0 = __builtin_amdgcn_mfma_f32_32x32x16_bf16(k0, qf[ks], p0, 0, 0, 0);
                    p1 = __builtin_amdgcn_mfma_f32_32x32x16_bf16(k1, qf[ks], p1, 0, 0, 0);
                }
                if (D < 3) {
                    const int relb = D * 64 + qrow0 + q32 - 4 * h + 128;
#pragma unroll
                    for (int r = 0; r < 16; ++r) {
                        const int r0 = relb - ((r & 3) + 8 * (r >> 2));
                        const int i0 = r0 < 0 ? 0 : (r0 > 256 ? 256 : r0), r1 = r0 - 32, i1 = r1 < 0 ? 0 : (r1 > 256 ? 256 : r1);
                        p0[r] += bias_s[i0]; p1[r] += bias_s[i1];
                    }
                }
                float tm = fmaxf(p0[0], p1[0]);
#pragma unroll
                for (int r = 1; r < 16; ++r) tm = fmaxf(tm, fmaxf(p0[r], p1[r]));
                tm = swap32_max(tm);
                const float mn = fmaxf(m, tm), alpha = __builtin_amdgcn_exp2f(m - mn);
                m = mn;
                float ps = 0.f;
#pragma unroll
                for (int r = 0; r < 16; ++r) { p0[r] = __builtin_amdgcn_exp2f(p0[r] - mn); p1[r] = __builtin_amdgcn_exp2f(p1[r] - mn); ps += p0[r] + p1[r]; }
                l = l * alpha + ps;
                if (!__all(alpha == 1.f)) {
#pragma unroll
                    for (int r = 0; r < 16; ++r) { o0[r] *= alpha; o1[r] *= alpha; }
                }
                bf16x8 pf[4];
                pf[0] = pack_step(p0, 0); pf[1] = pack_step(p0, 1); pf[2] = pack_step(p1, 0); pf[3] = pack_step(p1, 1);
#pragma unroll
                for (int kk = 0; kk < 4; ++kk) {
                    const int key0 = 16 * kk + 4 * h;
                    const v4i16 a0l = ds_tr16(vb + key0 * 64 + vtr_off), a0h = ds_tr16(vb + (key0 + 8) * 64 + vtr_off);
                    const v4i16 a1l = ds_tr16(vb + 4096 + key0 * 64 + vtr_off), a1h = ds_tr16(vb + 4096 + (key0 + 8) * 64 + vtr_off);
                    const bf16x8 a0 = __builtin_shufflevector(a0l, a0h, 0, 1, 2, 3, 4, 5, 6, 7), a1 = __builtin_shufflevector(a1l, a1h, 0, 1, 2, 3, 4, 5, 6, 7);
                    o0 = __builtin_amdgcn_mfma_f32_32x32x16_bf16(a0, pf[kk], o0, 0, 0, 0);
                    o1 = __builtin_amdgcn_mfma_f32_32x32x16_bf16(a1, pf[kk], o1, 0, 0, 0);
                }
            }
            if (i + 1 < ntile) {
                LAS unsigned char* nb = lds + ((i + 1) & 1) * AT_BUF;
                *(LAS u32x4*)(nb + srow * 144 + sch * 16) = kreg;
                *(LAS u32x4*)(nb + AT_KB + (sch >> 2) * 4096 + srow * 64 + (sch & 3) * 16) = vreg;
            }
            __syncthreads();
        }
        l = swap32_add(l, l);
        const float inv = 1.f / l;
        bf16* op = O + tq * DM + hd * 64 + 4 * h;
#pragma unroll
        for (int g = 0; g < 4; ++g) {
            *(u32x2*)(op + 8 * g) = (u32x2){cvtpk(o0[4 * g] * inv, o0[4 * g + 1] * inv), cvtpk(o0[4 * g + 2] * inv, o0[4 * g + 3] * inv)};
            *(u32x2*)(op + 32 + 8 * g) = (u32x2){cvtpk(o1[4 * g] * inv, o1[4 * g + 1] * inv), cvtpk(o1[4 * g + 2] * inv, o1[4 * g + 3] * inv)};
        }
    }
    __syncthreads();
}

constexpr int RT_Q = 0, RT_K = 9216, RT_KD = 18432, RT_V = 26624, RT_BUF = 34816, RT_ZS = 2 * RT_BUF, RT_CS = RT_ZS + 64 * 66 * 4;
DI void ret_item(Frame& F, const int it) {
    FRAME_IDS;
    const bf16* R = (const bf16*)(F.ws + WS_R); bf16* O = (bf16*)(F.ws + WS_O);
    LAS unsigned char* lds = F.lds;
    LAS float* Zs = (LAS float*)(lds + RT_ZS); LAS float* Cs = (LAS float*)(lds + RT_CS);
    const int b = it / NHB, hd = it % NHB;
    const int q32 = f_lane & 31, h = f_lane >> 5, w = F.wave;
    const int role = w >> 2, itile = (w >> 1) & 1, etile = w & 1;
    const int srow = f_tid >> 3, sch = f_tid & 7;
    const int vtr_off = ((f_lane & 15) >> 2) * 64 + (16 * ((f_lane >> 4) & 1) + 4 * (f_lane & 3)) * 2;
    const float l2g = log2f(gamma_of(hd));
    const float cd = exp2f(l2g * 64.f), sdec = exp2f(l2g * (float)(63 - srow));
    float qdv[16];
#pragma unroll
    for (int r = 0; r < 16; ++r) qdv[r] = exp2f(l2g * (float)(32 * itile + crow(r, h) + 1));
    f32x16 xs0 = {}, xs1 = {};
    const size_t trow0 = (size_t)b * SEQ;
    const bf16* gq = R + (trow0 + srow) * INC + hd * 64 + 8 * sch;
    u32x4 qreg = *(const u32x4*)(gq + C_QB), kreg = *(const u32x4*)(gq + C_KB), vreg = *(const u32x4*)(gq + C_VB);
    __syncthreads();
#define RT_STAGE(bufp) do { LAS unsigned char* bp_ = (bufp); \
        *(LAS u32x4*)(bp_ + RT_Q + srow * 144 + sch * 16) = qreg; *(LAS u32x4*)(bp_ + RT_K + srow * 144 + sch * 16) = kreg; \
        *(LAS u32x4*)(bp_ + RT_V + (sch >> 2) * 4096 + srow * 64 + (sch & 3) * 16) = vreg; \
        u32x4 kd_; \
        _Pragma("unroll") for (int e_ = 0; e_ < 4; ++e_) kd_[e_] = cvtpk(__uint_as_float(kreg[e_] << 16) * sdec, __uint_as_float(kreg[e_] & 0xffff0000u) * sdec); \
        *(LAS u32x4*)(bp_ + RT_KD + (sch >> 2) * 4096 + srow * 64 + (sch & 3) * 16) = kd_; } while (0)
    RT_STAGE(lds);
    __syncthreads();
    for (int n = 0; n < NCH; ++n) {
        LAS unsigned char* bp = lds + (n & 1) * RT_BUF;
        if (n + 1 < NCH) { const bf16* g1 = gq + (size_t)(n + 1) * 64 * INC; qreg = *(const u32x4*)(g1 + C_QB); kreg = *(const u32x4*)(g1 + C_KB); vreg = *(const u32x4*)(g1 + C_VB); }
        unsigned short gr[8];
#pragma unroll
        for (int r = 0; r < 8; ++r) gr[r] = R[(trow0 + n * 64 + 8 * w + r) * INC + C_GB + hd * 64 + f_lane];
        if (role == 0) {
            bf16x8 qf[4];
#pragma unroll
            for (int ks = 0; ks < 4; ++ks) qf[ks] = *(const LAS bf16x8*)(bp + RT_Q + (32 * itile + q32) * 144 + (16 * ks + 8 * h) * 2);
            f32x16 st0 = {}, st1 = {};
#pragma unroll
            for (int ks = 0; ks < 4; ++ks) {
                const bf16x8 k0 = *(const LAS bf16x8*)(bp + RT_K + q32 * 144 + (16 * ks + 8 * h) * 2);
                const bf16x8 k1 = *(const LAS bf16x8*)(bp + RT_K + (32 + q32) * 144 + (16 * ks + 8 * h) * 2);
                st0 = __builtin_amdgcn_mfma_f32_32x32x16_bf16(k0, qf[ks], st0, 0, 0, 0);
                st1 = __builtin_amdgcn_mfma_f32_32x32x16_bf16(k1, qf[ks], st1, 0, 0, 0);
            }
            int iiv = 32 * itile + q32 - 4 * h; asm volatile("" : "+v"(iiv));
#pragma unroll
            for (int r = 0; r < 16; ++r) {
                const int dd = iiv - ((r & 3) + 8 * (r >> 2));
                st0[r] *= __builtin_amdgcn_exp2f(l2g * fabsf((float)dd));
                st1[r] *= __builtin_amdgcn_exp2f(l2g * fabsf((float)(dd - 32)));
            }
            f32x16 z = {};
#pragma unroll
            for (int kk = 0; kk < 4; ++kk) {
                const int key0 = 16 * kk + 4 * h;
                const v4i16 bl = ds_tr16(bp + RT_V + etile * 4096 + key0 * 64 + vtr_off), bh = ds_tr16(bp + RT_V + etile * 4096 + (key0 + 8) * 64 + vtr_off);
                const bf16x8 vb = __builtin_shufflevector(bl, bh, 0, 1, 2, 3, 4, 5, 6, 7);
                const bf16x8 xa = (kk < 2) ? pack_step(st0, kk & 1) : pack_step(st1, kk & 1);
                z = __builtin_amdgcn_mfma_f32_32x32x16_bf16(xa, vb, z, 0, 0, 0);
            }
            int zb = (32 * itile + 4 * h) * 66 + 32 * etile + q32; asm volatile("" : "+v"(zb));
#pragma unroll
            for (int r = 0; r < 16; ++r) Zs[zb + ((r & 3) + 8 * (r >> 2)) * 66] = z[r];
        } else {
            f32x16 cr = {};
#pragma unroll
            for (int kk = 0; kk < 4; ++kk) {
                const LAS unsigned char* qp = bp + RT_Q + (32 * itile + q32) * 144 + (16 * kk + 4 * h) * 2;
                const v4i16 al = *(const LAS v4i16*)qp, ah = *(const LAS v4i16*)(qp + 16);
                const bf16x8 qa = __builtin_shufflevector(al, ah, 0, 1, 2, 3, 4, 5, 6, 7);
                const bf16x8 xb = (kk < 2) ? pack_step(xs0, kk & 1) : pack_step(xs1, kk & 1);
                cr = __builtin_amdgcn_mfma_f32_32x32x16_bf16(qa, xb, cr, 0, 0, 0);
            }
            int cb = (32 * itile + 4 * h) * 66 + 32 * etile + q32; asm volatile("" : "+v"(cb));
#pragma unroll
            for (int r = 0; r < 16; ++r) Cs[cb + ((r & 3) + 8 * (r >> 2)) * 66] = cr[r] * qdv[r];
#pragma unroll
            for (int r = 0; r < 16; ++r) { xs0[r] *= cd; xs1[r] *= cd; }
#pragma unroll
            for (int s4 = 0; s4 < 4; ++s4) {
                const int key0 = 16 * s4 + 8 * h;
                const v4i16 vl = ds_tr16(bp + RT_V + etile * 4096 + key0 * 64 + vtr_off), vh = ds_tr16(bp + RT_V + etile * 4096 + (key0 + 4) * 64 + vtr_off);
                const bf16x8 vb = __builtin_shufflevector(vl, vh, 0, 1, 2, 3, 4, 5, 6, 7);
                const v4i16 a0l = ds_tr16(bp + RT_KD + key0 * 64 + vtr_off), a0h = ds_tr16(bp + RT_KD + (key0 + 4) * 64 + vtr_off);
                const v4i16 a1l = ds_tr16(bp + RT_KD + 4096 + key0 * 64 + vtr_off), a1h = ds_tr16(bp + RT_KD + 4096 + (key0 + 4) * 64 + vtr_off);
                const bf16x8 ka0 = __builtin_shufflevector(a0l, a0h, 0, 1, 2, 3, 4, 5, 6, 7), ka1 = __builtin_shufflevector(a1l, a1h, 0, 1, 2, 3, 4, 5, 6, 7);
                xs0 = __builtin_amdgcn_mfma_f32_32x32x16_bf16(ka0, vb, xs0, 0, 0, 0);
                xs1 = __builtin_amdgcn_mfma_f32_32x32x16_bf16(ka1, vb, xs1, 0, 0, 0);
            }
        }
        __syncthreads();
#pragma unroll
        for (int r = 0; r < 8; ++r) {
            const int i = 8 * w + r;
            const float v = Zs[i * 66 + f_lane] + Cs[i * 66 + f_lane];
            const float mu = wave_sum(v) * (1.f / 64.f);
            const float dv = v - mu;
            const float var = wave_sum(dv * dv) * (1.f / 64.f);
            const float g = bf2f(gr[r]);
            O[(trow0 + n * 64 + i) * DM + 512 + hd * 64 + f_lane] = (bf16)f2bf(dv * (1.f / sqrtf(var + EPS)) * (g / (1.f + __expf(-g))));
        }
        if (n + 1 < NCH) RT_STAGE(lds + ((n + 1) & 1) * RT_BUF);
        __syncthreads();
    }
#undef RT_STAGE
}
DI void int8_rows(Frame& F, const int row0, const int nrows, const int f_lane) {
    float* SC = (float*)(F.ws + WS_SC);
    for (int rr = row0; rr < row0 + nrows; rr += 4) {
        f32x4 v[4][4];
#pragma unroll
        for (int u = 0; u < 4; ++u) {
            const int row = rr + u, tab = row / PE, e = row % PE, layer = tab & 1, isv = tab >> 1;
            const f32x4* sp = (const f32x4*)((isv ? F.peer_v : F.peer_u) + ((size_t)layer * PE + e) * DM) + f_lane;
#pragma unroll
            for (int j = 0; j < 4; ++j) v[u][j] = sp[64 * j];
        }
#pragma unroll
        for (int u = 0; u < 4; ++u) {
            const int row = rr + u, tab = row / PE, e = row % PE, layer = tab & 1, isv = tab >> 1;
            const f32x4* gp = (const f32x4*)(F.ffn_norm + layer * DM) + f_lane;
            float a = 0.f, sq = 0.f;
#pragma unroll
            for (int j = 0; j < 4; ++j) { if (!isv) v[u][j] = v[u][j] * gp[64 * j]; a = fmaxf(a, fmaxf(fmaxf(fabsf(v[u][j][0]), fabsf(v[u][j][1])), fmaxf(fabsf(v[u][j][2]), fabsf(v[u][j][3]))));
                sq += (v[u][j][0] * v[u][j][0] + v[u][j][1] * v[u][j][1]) + (v[u][j][2] * v[u][j][2] + v[u][j][3] * v[u][j][3]); }
            a = wave_max(a);
            const float step = fminf(0.355f * sqrtf(wave_sum(sq) * (1.f / DM)), a * (1.f / 7.f));
            const float sc = step > 0.f ? 1.f / step : 0.f;
            unsigned* dst = (unsigned*)(F.ws + (isv ? WS_V8 : WS_U8)) + (size_t)layer * 4 * PE * 32;
#pragma unroll
            for (int j = 0; j < 4; ++j) {
                const int q0 = (int)rintf(__builtin_amdgcn_fmed3f(v[u][j][0] * sc, -7.f, 7.f)), q1 = (int)rintf(__builtin_amdgcn_fmed3f(v[u][j][1] * sc, -7.f, 7.f)), q2 = (int)rintf(__builtin_amdgcn_fmed3f(v[u][j][2] * sc, -7.f, 7.f)), q3 = (int)rintf(__builtin_amdgcn_fmed3f(v[u][j][3] * sc, -7.f, 7.f));
                const int ob = (isv && !(f_lane & 1)) ? 8 : 0;
                unsigned w = ((unsigned)(q0 + ob) & 0xFu) | (((unsigned)(q1 + ob) & 0xFu) << 8) | (((unsigned)(q2 + ob) & 0xFu) << 16) | (((unsigned)(q3 + ob) & 0xFu) << 24);
                if (f_lane & 1) w <<= 4;
                w |= (unsigned)DPP_MOV_I((int)w, DPP_XOR1);
                if (!(f_lane & 1)) dst[((size_t)j * PE + e) * 32 + (f_lane >> 1)] = w;
            }
            if (f_lane == 0) SC[tab * PE + e] = step * (1.f / 16.f);
        }
    }
}
constexpr int Q8_ITEM_ROWS = 512, Q8_ITEMS = 4 * PE / Q8_ITEM_ROWS;
constexpr int PH_MIX_ID = 3;
DI void mix_phase(Frame& F, const int rep) {
    FRAME_IDS;
    unsigned* ctr = (unsigned*)(F.ws + WS_CTL) + CW_QUEUE + 64 * rep;
    volatile LAS unsigned* slot = (volatile LAS unsigned*)(F.lds + MISC_OFF) + 16;
    constexpr int N_RET = NB * NHB, N_ATT = NB * NHA * 8;
    static_assert(N_ATT == 8 * Q8_ITEMS, "8 attention items per quantisation item");
    for (;;) {
        __syncthreads();
        if (f_tid == 0) slot[0] = __hip_atomic_fetch_add(ctr, 1u, __ATOMIC_RELAXED, __HIP_MEMORY_SCOPE_AGENT);
        __syncthreads();
        const int idx = (int)slot[0];
        if (idx >= N_RET + N_ATT + Q8_ITEMS) break;
        const bool probe_pass = (REP_PHASE == PH_MIX_ID && rep == 0);
        if (idx < N_RET) { if (!(probe_pass && PROBE_MODE == 4)) ret_item(F, idx); }
        else if (probe_pass && PROBE_MODE == 3) { }
        else { const int k = idx - N_RET, grp = k / 9, pos = k - 9 * grp;
            if (pos == 8) int8_rows(F, grp * Q8_ITEM_ROWS + F.wave * 64, 64, f_lane);
            else attn_item(F, 8 * grp + pos); }
    }
}
DI float fmax_raw(float a, float b) { float r; asm("v_max_f32_e32 %0, %1, %2" : "=v"(r) : "v"(a), "v"(b)); return r; }
DI float fmin_raw(float a, float b) { float r; asm("v_min_f32_e32 %0, %1, %2" : "=v"(r) : "v"(a), "v"(b)); return r; }
#define CE_DESC(x, y) do { const float hi_ = fmax_raw((x), (y)), lo_ = fmin_raw((x), (y)); (x) = hi_; (y) = lo_; } while (0)
template <int N> DI void sort_desc(float* v) {
#pragma unroll
    for (int k = 2; k <= N; k <<= 1)
#pragma unroll
        for (int j = k >> 1; j > 0; j >>= 1)
#pragma unroll
            for (int i = 0; i < N; ++i) { const int l = i ^ j; if (l > i) { if ((i & k) == 0 || k == N) CE_DESC(v[i], v[l]); else CE_DESC(v[l], v[i]); } }
}
DI void merge16(float* a, const float* b) {
#pragma unroll
    for (int i = 0; i < 16; ++i) a[i] = fmax_raw(a[i], b[15 - i]);
#pragma unroll
    for (int j = 8; j > 0; j >>= 1)
#pragma unroll
        for (int i = 0; i < 16; ++i) { const int l = i ^ j; if (l > i) CE_DESC(a[i], a[l]); }
}
DI float key_pack(float v, unsigned keep_mask, unsigned idx) { return __uint_as_float((__float_as_uint(v) & keep_mask) | idx); }
DI void opt_route(Frame& F, int layer) {
    FRAME_IDS;
    const bf16* Q = (const bf16*)(F.ws + WS_Q);
    int* eidx = (int*)(F.ws + WS_EIDX); float* gate = (float*)(F.ws + WS_GATE);
    const float* keys = F.peer_keys + (size_t)layer * 2 * PK * 64;
    LAS unsigned char* kl = F.lds;
    __syncthreads();
    for (int idx = f_tid; idx < 2 * PK * 8; idx += NTHR) {
        const int row = idx >> 3, ch = idx & 7;
        const f32x4 a = *(const f32x4*)(keys + (size_t)row * 64 + ch * 8), b = *(const f32x4*)(keys + (size_t)row * 64 + ch * 8 + 4);
        *(LAS u32x4*)(kl + row * 144 + ch * 16) = (u32x4){pk2(a[0], a[1]), pk2(a[2], a[3]), pk2(b[0], b[1]), pk2(b[2], b[3])};
    }
    __syncthreads();
    LAS int* lut = (LAS int*)(F.lds + 40960 + F.wave * 8192);
    const int c = f_lane & 31, h = f_lane >> 5;
    pg8::StaticOrder SO; SO.init(T, DM, F.G, F.bid);
    pg8::Unit un;
    for (int ui = 0; SO.next(ui, un); ++ui)
    for (int k2 = F.wave; k2 < 16; k2 += NWAVES) {
        const int tile = 8 * un.pm + (k2 & 7), hh = 2 * un.pn + (k2 >> 3), t = tile * 32 + c;
        float tk[2][16];
#pragma unroll
        for (int side = 0; side < 2; ++side) {
            bf16x8 qf[4];
#pragma unroll
            for (int ks = 0; ks < 4; ++ks) qf[ks] = *(const bf16x8*)(Q + (size_t)t * DM + hh * PQD + side * 64 + 16 * ks + 8 * h);
            float v[64];
#pragma unroll
            for (int kt = 0; kt < 4; ++kt) {
                f32x16 acc = {};
#pragma unroll
                for (int ks = 0; ks < 4; ++ks) {
                    const bf16x8 a = *(const LAS bf16x8*)(kl + (side * PK + 32 * kt + c) * 144 + (16 * ks + 8 * h) * 2);
                    acc = __builtin_amdgcn_mfma_f32_32x32x16_bf16(a, qf[ks], acc, 0, 0, 0);
                }
#pragma unroll
                for (int r = 0; r < 16; ++r) v[16 * kt + r] = key_pack(acc[r], 0xFFFFFF80u, (unsigned)(32 * kt + (r & 3) + 8 * (r >> 2) + 4 * h));
            }
            sort_desc<16>(v); sort_desc<16>(v + 16); sort_desc<16>(v + 32); sort_desc<16>(v + 48);
            merge16(v, v + 16); merge16(v + 32, v + 48); merge16(v, v + 32);
            float pr[16];
#pragma unroll
            for (int i = 0; i < 16; ++i) pr[i] = __shfl_xor(v[i], 32);
            merge16(v, pr);
#pragma unroll
            for (int i = 0; i < 16; ++i) { tk[side][i] = v[i]; lut[(side * 16 + i) * 64 + f_lane] = (int)(__float_as_uint(v[i]) & 0x7Fu); }
        }
        float cd[64];
        {   int n = 0;
#pragma unroll
            for (int a = 0; a < 16; ++a)
#pragma unroll
                for (int b = 0; b < 16; ++b) if ((a + 1) * (b + 1) <= 16) { cd[n] = key_pack(tk[0][a] + tk[1][b], 0xFFFFFF00u, (unsigned)(a * 16 + b)); ++n; }
#pragma unroll
            for (int i = 50; i < 64; ++i) cd[i] = -INFINITY;
        }
        sort_desc<16>(cd); sort_desc<16>(cd + 16); sort_desc<16>(cd + 32); CE_DESC(cd[48], cd[49]);
        merge16(cd, cd + 16); merge16(cd + 32, cd + 48); merge16(cd, cd + 32);
        int ex[16]; float gv[16]; float sum = 0.f;
        const float top = __uint_as_float(__float_as_uint(cd[0]) & 0xFFFFFF00u);
#pragma unroll
        for (int i = 0; i < 16; ++i) {
            const unsigned bits = __float_as_uint(cd[i]);
            const int a = (bits >> 4) & 15, b = bits & 15;
            ex[i] = lut[a * 64 + f_lane] * PK + lut[(16 + b) * 64 + f_lane];
            gv[i] = __expf(__uint_as_float(bits & 0xFFFFFF00u) - top); sum += gv[i];
        }
        const float inv = 1.f / sum;
        if (h == 0) {
            u32x4* ep = (u32x4*)(eidx + (size_t)t * NSEL + hh * 16);
#pragma unroll
            for (int q = 0; q < 4; ++q) ep[q] = (u32x4){(unsigned)ex[4 * q], (unsigned)ex[4 * q + 1], (unsigned)ex[4 * q + 2], (unsigned)ex[4 * q + 3]};
        } else {
            f32x4* gp = (f32x4*)(gate + (size_t)t * NSEL + hh * 16);
#pragma unroll
            for (int q = 0; q < 4; ++q) gp[q] = (f32x4){gv[4 * q] * inv, gv[4 * q + 1] * inv, gv[4 * q + 2] * inv, gv[4 * q + 3] * inv};
        }
    }
    __syncthreads();
}
struct XInfo { int xrank, nx, rank, nloc; };
DI XInfo get_xinfo(Frame& F, const bool census) {
    FRAME_IDS;
    volatile LAS unsigned* M = (volatile LAS unsigned*)(F.lds + MISC_OFF);
    __syncthreads();
    if (f_tid == 0) {
        unsigned xr = (unsigned)F.bid & 7u, nx = 8u, rk = (unsigned)F.bid >> 3, nl = ((unsigned)F.G + 7u - ((unsigned)F.bid & 7u)) >> 3;
        if (census) {
            unsigned* bar = (unsigned*)(F.ws + WS_CTL) + CW_BAR; const unsigned x = xb_xcc_id();
            unsigned cnt = 0u, below = 0u, mine = 0u;
#pragma unroll
            for (unsigned j = 0; j < 16; ++j) { const unsigned c = xb_ld(&bar[XB_XCNT(j)]); cnt += (c > 0u); below += (c > 0u && j < x); mine = (j == x) ? c : mine; }
            if (cnt > 0u && mine > 0u) { xr = below; nx = cnt; rk = M[12]; nl = mine; }
        }
        M[20] = xr; M[21] = nx; M[22] = rk; M[23] = nl;
    }
    __syncthreads();
    XInfo xi; xi.xrank = (int)M[20]; xi.nx = (int)M[21]; xi.rank = (int)M[22]; xi.nloc = (int)M[23];
    return xi;
}
DI int comb_c(const int level, const int a, const int b, const int lane) {
    const int M = 4 >> level; const bool bit = (lane & M) != 0;
    const int send = bit ? a : b, keep = bit ? b : a;
    const int recv = level == 0 ? DPP_MOV_I(send, DPP_HMIRROR) : (level == 1 ? DPP_MOV_I(send, DPP_XOR2) : DPP_MOV_I(send, DPP_XOR1));
    return keep + recv;
}
DI int dot16_i8(const u32x4 r, const u32x4 x) {
    int s = __builtin_amdgcn_sdot4((int)r[0], (int)x[0], 0, false);
    s = __builtin_amdgcn_sdot4((int)r[1], (int)x[1], s, false); s = __builtin_amdgcn_sdot4((int)r[2], (int)x[2], s, false); s = __builtin_amdgcn_sdot4((int)r[3], (int)x[3], s, false);
    return s;
}
DI int half_dots(const u32x4 (&rows)[8], const u32x4 xq, const int lane) {
    int p[8];
#pragma unroll
    for (int i = 0; i < 8; ++i) p[i] = dot16_i8(rows[i], xq);
#pragma unroll
    for (int i = 0; i < 4; ++i) p[i] = comb_c(0, p[2 * i], p[2 * i + 1], lane);
    p[0] = comb_c(1, p[0], p[1], lane); p[1] = comb_c(1, p[2], p[3], lane);
    return comb_c(2, p[0], p[1], lane);
}
DI u32x4 xquant(const f32x4 (&hv)[4], const float rstd) {
    u32x4 o;
#pragma unroll
    for (int w = 0; w < 4; ++w) {
        const f32x4 x = hv[w] * (rstd * XQ);
        const int a = (int)rintf(__builtin_amdgcn_fmed3f(x[0], -127.f, 127.f)), b = (int)rintf(__builtin_amdgcn_fmed3f(x[1], -127.f, 127.f)), c = (int)rintf(__builtin_amdgcn_fmed3f(x[2], -127.f, 127.f)), d = (int)rintf(__builtin_amdgcn_fmed3f(x[3], -127.f, 127.f));
        o[w] = ((unsigned)a & 0xFFu) | (((unsigned)b & 0xFFu) << 8) | (((unsigned)c & 0xFFu) << 16) | ((unsigned)d << 24);
    }
    return o;
}
DI float rstd_bcast(const float* part, const int t) {
    const f32x4* p = (const f32x4*)(part + (size_t)t * 16);
    const f32x4 a = p[0], b = p[1], c = p[2], d = p[3];
    const float s = ((a[0] + a[1]) + (a[2] + a[3])) + ((b[0] + b[1]) + (b[2] + b[3])) + ((c[0] + c[1]) + (c[2] + c[3])) + ((d[0] + d[1]) + (d[2] + d[3]));
    return 1.f / sqrtf(s * (1.f / DM) + EPS);
}
DI int dot32_i4(const u32x4 r, const u32x4 xa, const u32x4 xb) {
    int s = 0;
#pragma unroll
    for (int d = 0; d < 4; ++d) {
        const unsigned lo = (r[d] << 4) & 0xF0F0F0F0u, hi = r[d] & 0xF0F0F0F0u;
        const unsigned x0 = d < 2 ? xa[2 * d] : xb[2 * d - 4], x1 = d < 2 ? xa[2 * d + 1] : xb[2 * d - 3];
        s = __builtin_amdgcn_sdot4((int)lo, (int)x0, s, false); s = __builtin_amdgcn_sdot4((int)hi, (int)x1, s, false);
    }
    return s;
}
DI int half_dots4(const u32x4 (&rows)[8], const u32x4 xa, const u32x4 xb, const int lane) {
    int p[8];
#pragma unroll
    for (int i = 0; i < 8; ++i) p[i] = dot32_i4(rows[i], xa, xb);
#pragma unroll
    for (int i = 0; i < 4; ++i) p[i] = comb_c(0, p[2 * i], p[2 * i + 1], lane);
    p[0] = comb_c(1, p[0], p[1], lane); p[1] = comb_c(1, p[2], p[3], lane);
    return comb_c(2, p[0], p[1], lane);
}
DI void gather_u(Frame& F, const int layer, const XInfo xi, const bool dry) {
    FRAME_IDS;
    const unsigned emask = (dry && PROBE_MODE == 2) ? 15u : ((dry && PROBE_MODE == 5) ? 4095u : 0xFFFFFFFFu);
    const int* eidx = (const int*)(F.ws + WS_EIDX); int* PU = (int*)(F.ws + (dry ? WS_R : WS_PU)); const float* part = (const float*)(F.ws + WS_PART); const bf16* hbp = (const bf16*)(F.ws + WS_XB);
    const int g = f_lane >> 3, c = f_lane & 7, c16 = c * 16;
    const int kst = 16 * g + (((c & 1) << 2) | (c & 2) | ((c & 4) >> 2));
    const int gwl = xi.rank * NWAVES + F.wave, NGWL = xi.nloc * NWAVES;
    LAS unsigned char* wl = F.lds + F.wave * 2048;
    __syncthreads();
    for (int j = xi.xrank; j < 8; j += xi.nx) {
        const int sl = j & 3, th = j >> 2;
        const __amdgpu_buffer_rsrc_t U8 = __builtin_amdgcn_make_buffer_rsrc((void*)(F.ws + WS_U8 + ((size_t)(layer * 4 + sl) * PE) * 128), 0, PE * 128, 0x00020000);
        int tt = gwl;
        if (tt >= T / 2) continue;
#define TOK(x_) (2 * (x_) + th)
#define U_LOAD(tk, ri, rh, rp) do { ri = *(const u32x2*)(eidx + (size_t)(tk) * NSEL + 2 * f_lane) & emask; rh = *(const u32x2*)(hbp + (size_t)(tk) * DM + 256 * sl + 4 * f_lane); \
            rp = part[(size_t)(tk) * 16 + (f_lane & 15)]; } while (0)
#define U_SPREAD(slot, ri, rh, rp, e, xa_, xb_) do { \
            float ps_ = rp; ps_ += __int_as_float(DPP_MOV_I(__float_as_int(ps_), DPP_XOR1)); ps_ += __int_as_float(DPP_MOV_I(__float_as_int(ps_), DPP_XOR2)); ps_ += __int_as_float(DPP_MOV_I(__float_as_int(ps_), DPP_HMIRROR)); ps_ += __int_as_float(DPP_MOV_I(__float_as_int(ps_), DPP_ROR8)); \
            const float rs_ = (1.f / sqrtf(ps_ * (1.f / DM) + EPS)) * XQ; \
            const int q0_ = (int)rintf(__builtin_amdgcn_fmed3f(__uint_as_float(rh[0] << 16) * rs_, -127.f, 127.f)), q1_ = (int)rintf(__builtin_amdgcn_fmed3f(__uint_as_float(rh[0] & 0xffff0000u) * rs_, -127.f, 127.f)); \
            const int q2_ = (int)rintf(__builtin_amdgcn_fmed3f(__uint_as_float(rh[1] << 16) * rs_, -127.f, 127.f)), q3_ = (int)rintf(__builtin_amdgcn_fmed3f(__uint_as_float(rh[1] & 0xffff0000u) * rs_, -127.f, 127.f)); \
            LAS unsigned char* sl_ = wl + (slot) * 1024; \
            *(LAS u32x2*)(sl_ + 8 * f_lane) = ri; *(LAS unsigned*)(sl_ + 512 + 4 * f_lane) = ((unsigned)q0_ & 0xFFu) | (((unsigned)q1_ & 0xFFu) << 8) | (((unsigned)q2_ & 0xFFu) << 16) | ((unsigned)q3_ << 24); \
            asm volatile("s_waitcnt lgkmcnt(0)" ::: "memory"); \
            _Pragma("unroll") for (int q_ = 0; q_ < 4; ++q_) e[q_] = *(const LAS u32x4*)(sl_ + 64 * g + 16 * q_); \
            xa_ = *(const LAS u32x4*)(sl_ + 512 + 32 * c); xb_ = *(const LAS u32x4*)(sl_ + 512 + 32 * c + 16); } while (0)
        u32x2 ri, rh; float rp;
        u32x4 e0[4], e1[4], xa, xb, xa1, xb1;
        U_LOAD(TOK(tt), ri, rh, rp); U_SPREAD(0, ri, rh, rp, e0, xa, xb);
        { const int t1 = (tt + NGWL < T / 2) ? tt + NGWL : tt; U_LOAD(TOK(t1), ri, rh, rp); U_SPREAD(1, ri, rh, rp, e1, xa1, xb1); }
        { const int t2 = (tt + 2 * NGWL < T / 2) ? tt + 2 * NGWL : tt; U_LOAD(TOK(t2), ri, rh, rp); }
        u32x4 A0[8], B0[8], A1[8], B1[8];
#pragma unroll
        for (int i = 0; i < 8; ++i) A0[i] = __builtin_amdgcn_raw_buffer_load_b128(U8, (int)e0[i >> 2][i & 3] * 128 + c16, 0, 0);
#pragma unroll
        for (int i = 0; i < 8; ++i) B0[i] = __builtin_amdgcn_raw_buffer_load_b128(U8, (int)e0[2 + (i >> 2)][i & 3] * 128 + c16, 0, 0);
#define U_ITEM(CA, CB, NA, NB, slot) do { \
            _Pragma("unroll") for (int i = 0; i < 8; ++i) NA[i] = __builtin_amdgcn_raw_buffer_load_b128(U8, (int)e1[i >> 2][i & 3] * 128 + c16, 0, 0); \
            asm volatile("" ::: "memory"); \
            const int r0 = half_dots4(CA, xa, xb, f_lane); \
            _Pragma("unroll") for (int i = 0; i < 8; ++i) NB[i] = __builtin_amdgcn_raw_buffer_load_b128(U8, (int)e1[2 + (i >> 2)][i & 3] * 128 + c16, 0, 0); \
            asm volatile("" ::: "memory"); \
            const int rr1 = half_dots4(CB, xa, xb, f_lane); \
            int* pp = PU + ((size_t)TOK(tt) * 4 + sl) * NSEL + kst; \
            pp[0] = r0; pp[8] = rr1; \
            xa = xa1; xb = xb1; \
            U_SPREAD(slot, ri, rh, rp, e1, xa1, xb1);                   \
            { const int t3 = (tt + 3 * NGWL < T / 2) ? tt + 3 * NGWL : tt; U_LOAD(TOK(t3), ri, rh, rp); } } while (0)
        for (;;) {
            U_ITEM(A0, B0, A1, B1, 0); tt += NGWL; if (tt >= T / 2) break;
            U_ITEM(A1, B1, A0, B0, 1); tt += NGWL; if (tt >= T / 2) break;
        }
#undef U_ITEM
#undef U_LOAD
#undef U_SPREAD
#undef TOK
    }
    __syncthreads();
}
DI void gather_r(Frame& F, const int layer) {
    FRAME_IDS;
    const int* PU = (const int*)(F.ws + WS_PU); const float* gate = (const float*)(F.ws + WS_GATE); const int* eidx = (const int*)(F.ws + WS_EIDX);
    const float* SCu = (const float*)(F.ws + WS_SC) + (size_t)layer * PE; const float* SCv = (const float*)(F.ws + WS_SC) + (size_t)(2 + layer) * PE;
    signed char* A8 = (signed char*)(F.ws + WS_A); float* SA = (float*)(F.ws + WS_SA);
    const int gw = F.bid * NWAVES + F.wave, NGW = F.G * NWAVES;
    for (int t = gw; t < T; t += NGW) {
        float a[2];
#pragma unroll
        for (int hf = 0; hf < 2; ++hf) {
            const int k = 64 * hf + f_lane;
            int sacc = 0;
#pragma unroll
            for (int j = 0; j < 4; ++j) sacc += PU[((size_t)t * 4 + j) * NSEL + k];
            const int e = eidx[(size_t)t * NSEL + k];
            const float d = (float)sacc * (SCu[e] * (1.f / XQ));
            a[hf] = gelu_erf(d) * gate[(size_t)t * NSEL + k] * SCv[e];
        }
        const float am = wave_max(fmaxf(fabsf(a[0]), fabsf(a[1])));
        const float sc = am > 0.f ? 127.f / am : 0.f;
        A8[(size_t)t * NSEL + f_lane] = (signed char)(int)rintf(a[0] * sc);
        A8[(size_t)t * NSEL + 64 + f_lane] = (signed char)(int)rintf(a[1] * sc);
        if (f_lane == 0) SA[t] = am * (1.f / 127.f);
    }
}
DI void tr4x4(const unsigned w0, const unsigned w1, const unsigned w2, const unsigned w3, unsigned (&cdw)[4]) {
    const unsigned t01l = __builtin_amdgcn_perm(w1, w0, 0x05010400u), t01h = __builtin_amdgcn_perm(w1, w0, 0x07030602u);
    const unsigned t23l = __builtin_amdgcn_perm(w3, w2, 0x05010400u), t23h = __builtin_amdgcn_perm(w3, w2, 0x07030602u);
    cdw[0] = __builtin_amdgcn_perm(t23l, t01l, 0x05040100u); cdw[1] = __builtin_amdgcn_perm(t23l, t01l, 0x07060302u);
    cdw[2] = __builtin_amdgcn_perm(t23h, t01h, 0x05040100u); cdw[3] = __builtin_amdgcn_perm(t23h, t01h, 0x07060302u);
}
DI void axpy4rows(const u32x4 r0, const u32x4 r1, const u32x4 r2, const u32x4 r3, const unsigned a4, int (&ahi)[16], int (&aall)[16]) {
#pragma unroll
    for (int d = 0; d < 4; ++d) {
        unsigned cdw[4];
        tr4x4(r0[d], r1[d], r2[d], r3[d], cdw);
#pragma unroll
        for (int b = 0; b < 4; ++b) {
            aall[4 * d + b] = __builtin_amdgcn_sdot4((int)cdw[b], (int)a4, aall[4 * d + b], false);
            ahi[4 * d + b] = __builtin_amdgcn_sdot4((int)(cdw[b] & 0xF0F0F0F0u), (int)a4, ahi[4 * d + b], false);
        }
    }
}
DI void gather_v(Frame& F, const int layer, const XInfo xi, const bool dry) {
    FRAME_IDS;
    const int* eidx = (const int*)(F.ws + WS_EIDX); const unsigned char* A8 = F.ws + WS_A; const float* SA = (const float*)(F.ws + WS_SA);
    float* part_w = dry ? (float*)(F.ws + WS_R) : (float*)(F.ws + WS_PART); bf16* hb_w = dry ? (bf16*)(F.ws + WS_HID2) : (bf16*)(F.ws + WS_XB); const bf16* hbp = (const bf16*)(F.ws + WS_XB);
    const int g = f_lane >> 3, c = f_lane & 7, c16 = c * 16;
    const int cc = 32 * c + 16 * (g >> 2) + 8 * ((g >> 1) & 1) + 4 * (g & 1);
    const int gwl = xi.rank * NWAVES + F.wave, NGWL = xi.nloc * NWAVES;
    const bool b3 = (f_lane & 8) != 0;
    LAS unsigned char* wl = F.lds + F.wave * 2048;
    __syncthreads();
    for (int j = xi.xrank; j < 8; j += xi.nx) {
        const int sl = j & 3, th = j >> 2;
        const __amdgpu_buffer_rsrc_t V8 = __builtin_amdgcn_make_buffer_rsrc((void*)(F.ws + WS_V8 + ((size_t)(layer * 4 + sl) * PE) * 128), 0, PE * 128, 0x00020000);
        int tt = gwl;
        if (tt >= T / 2) continue;
#define TOK(x_) (2 * (x_) + th)
#define V_LOAD(tk, ri, ra, rs) do { ri = *(const u32x2*)(eidx + (size_t)(tk) * NSEL + 2 * f_lane); ra = *(const unsigned short*)(A8 + (size_t)(tk) * NSEL + 2 * f_lane); rs = SA[(tk)]; } while (0)
#define V_SPREAD(slot, ri, ra, rs, e, avv, sav) do { \
            LAS unsigned char* sl_ = wl + (slot) * 1024; \
            *(LAS u32x2*)(sl_ + 8 * f_lane) = ri; *(LAS unsigned short*)(sl_ + 512 + 2 * f_lane) = ra; \
            asm volatile("s_waitcnt lgkmcnt(0)" ::: "memory"); \
            _Pragma("unroll") for (int q_ = 0; q_ < 4; ++q_) e[q_] = *(const LAS u32x4*)(sl_ + 64 * g + 16 * q_); \
            avv = *(const LAS u32x4*)(sl_ + 512 + 16 * g); sav = rs; } while (0)
        u32x2 ri; unsigned short ra; float rs;
        u32x4 e0[4], e1[4], av, a1; float sa, sa1; u32x2 hold;
        V_LOAD(TOK(tt), ri, ra, rs); V_SPREAD(0, ri, ra, rs, e0, av, sa);
        { const int t1 = (tt + NGWL < T / 2) ? tt + NGWL : tt; V_LOAD(TOK(t1), ri, ra, rs); V_SPREAD(1, ri, ra, rs, e1, a1, sa1); }
        { const int t2 = (tt + 2 * NGWL < T / 2) ? tt + 2 * NGWL : tt; V_LOAD(TOK(t2), ri, ra, rs); }
        hold = *(const u32x2*)(hbp + (size_t)TOK(tt) * DM + 256 * sl + cc);
        u32x4 A0[8], B0[8], A1[8], B1[8];
#pragma unroll
        for (int i = 0; i < 8; ++i) A0[i] = __builtin_amdgcn_raw_buffer_load_b128(V8, (int)e0[i >> 2][i & 3] * 128 + c16, 0, 0);
#pragma unroll
        for (int i = 0; i < 8; ++i) B0[i] = __builtin_amdgcn_raw_buffer_load_b128(V8, (int)e0[2 + (i >> 2)][i & 3] * 128 + c16, 0, 0);
#define V_ITEM(CA, CB, NA, NB, slot) do { \
            const int t1 = (tt + NGWL < T / 2) ? tt + NGWL : tt; \
            const u32x2 hold1 = *(const u32x2*)(hbp + (size_t)TOK(t1) * DM + 256 * sl + cc); \
            _Pragma("unroll") for (int i = 0; i < 8; ++i) NA[i] = __builtin_amdgcn_raw_buffer_load_b128(V8, (int)e1[i >> 2][i & 3] * 128 + c16, 0, 0); \
            asm volatile("" ::: "memory"); \
            int ahi[16], aall[16]; \
            _Pragma("unroll") for (int n = 0; n < 16; ++n) { ahi[n] = 0; aall[n] = 0; } \
            axpy4rows(CA[0], CA[1], CA[2], CA[3], av[0], ahi, aall); axpy4rows(CA[4], CA[5], CA[6], CA[7], av[1], ahi, aall); \
            _Pragma("unroll") for (int i = 0; i < 8; ++i) NB[i] = __builtin_amdgcn_raw_buffer_load_b128(V8, (int)e1[2 + (i >> 2)][i & 3] * 128 + c16, 0, 0); \
            asm volatile("" ::: "memory"); \
            axpy4rows(CB[0], CB[1], CB[2], CB[3], av[2], ahi, aall); axpy4rows(CB[4], CB[5], CB[6], CB[7], av[3], ahi, aall); \
            int sa8 = __builtin_amdgcn_sdot4(0x01010101, (int)av[0], 0, false); sa8 = __builtin_amdgcn_sdot4(0x01010101, (int)av[1], sa8, false); sa8 = __builtin_amdgcn_sdot4(0x01010101, (int)av[2], sa8, false); sa8 = __builtin_amdgcn_sdot4(0x01010101, (int)av[3], sa8, false); \
            sa8 *= 8; \
            int acc[32];                                                \
            _Pragma("unroll") for (int d_ = 0; d_ < 4; ++d_) _Pragma("unroll") for (int b_ = 0; b_ < 4; ++b_) { acc[8 * d_ + 4 + b_] = ahi[4 * d_ + b_]; acc[8 * d_ + b_] = (aall[4 * d_ + b_] - ahi[4 * d_ + b_] - sa8) << 4; } \
            int r16[16], r8[8]; float hv[4]; \
            _Pragma("unroll") for (int n = 0; n < 16; ++n) r16[n] = swap32_addi(acc[n], acc[16 + n]); \
            _Pragma("unroll") for (int n = 0; n < 8; ++n) r8[n] = swap16_addi(r16[n], r16[8 + n]); \
            _Pragma("unroll") for (int n = 0; n < 4; ++n) { const int keep = b3 ? r8[4 + n] : r8[n], send = b3 ? r8[n] : r8[4 + n]; hv[n] = (float)(keep + DPP_MOV_I(send, DPP_ROR8)) * sa; } \
            hv[0] += __uint_as_float(hold[0] << 16); hv[1] += __uint_as_float(hold[0] & 0xffff0000u); hv[2] += __uint_as_float(hold[1] << 16); hv[3] += __uint_as_float(hold[1] & 0xffff0000u); \
            const float ss = wave_sum_fast((hv[0] * hv[0] + hv[1] * hv[1]) + (hv[2] * hv[2] + hv[3] * hv[3])); \
            *(u32x2*)(hb_w + (size_t)TOK(tt) * DM + 256 * sl + cc) = (u32x2){cvtpk(hv[0], hv[1]), cvtpk(hv[2], hv[3])}; \
            if (f_lane == 0) part_w[(size_t)TOK(tt) * 16 + sl] = ss; \
            if (sl == 0 && f_lane >= 4 && f_lane < 16) part_w[(size_t)TOK(tt) * 16 + f_lane] = 0.f; \
            av = a1; sa = sa1; hold = hold1; \
            V_SPREAD(slot, ri, ra, rs, e1, a1, sa1); \
            { const int t3 = (tt + 3 * NGWL < T / 2) ? tt + 3 * NGWL : tt; V_LOAD(TOK(t3), ri, ra, rs); } } while (0)
        for (;;) {
            V_ITEM(A0, B0, A1, B1, 0); tt += NGWL; if (tt >= T / 2) break;
            V_ITEM(A1, B1, A0, B0, 1); tt += NGWL; if (tt >= T / 2) break;
        }
#undef V_ITEM
#undef V_LOAD
#undef V_SPREAD
#undef TOK
    }
    __syncthreads();
}
DI void final_norm(Frame& F) {
    FRAME_IDS;
    const float* part = (const float*)(F.ws + WS_PART); const bf16* hbp = (const bf16*)(F.ws + WS_XB);
    const int gw = F.bid * NWAVES + F.wave, NGW = F.G * NWAVES;
    for (int t = gw; t < T; t += NGW) {
        const float r = rstd_bcast(part, t);
        const u32x2* hp = (const u32x2*)(hbp + (size_t)t * DM) + f_lane;
        f32x4* op = (f32x4*)(F.out + (size_t)t * DM) + f_lane;
        const f32x4* gp = (const f32x4*)F.final_norm + f_lane;
#pragma unroll
        for (int q = 0; q < 4; ++q) { const u32x2 w = hp[64 * q];
            const f32x4 h = {__uint_as_float(w[0] << 16), __uint_as_float(w[0] & 0xffff0000u), __uint_as_float(w[1] << 16), __uint_as_float(w[1] & 0xffff0000u)};
            op[64 * q] = h * r * gp[64 * q]; }
    }
}
DI void opt_conv(Frame& F) {
    FRAME_IDS;
    const bf16* G = (const bf16*)(F.ws + WS_GLU); bf16* H2 = (bf16*)(F.ws + WS_HID2);
    LAS float* ys = (LAS float*)F.lds;
    f32x2 wt[CW];
#pragma unroll
    for (int j = 0; j < CW; ++j) wt[j] = *(const f32x2*)(F.conv_dw + j * DM + 2 * f_tid);
    const f32x2 bdw = *(const f32x2*)(F.conv_dw_b + 2 * f_tid);
    f32x4 lng[4], lnb[4];
#pragma unroll
    for (int k = 0; k < 4; ++k) { lng[k] = *(const f32x4*)(F.conv_ln_g + 256 * k + 4 * f_lane); lnb[k] = *(const f32x4*)(F.conv_ln_b + 256 * k + 4 * f_lane); }
    for (int it = F.bid; it < T / 128; it += F.G) {
        const int s0 = (it % (SEQ / 128)) * 128;
        const size_t row0 = (size_t)it * 128;
        const unsigned* gp = (const unsigned*)G + f_tid;
        f32x2 win[CW];
#pragma unroll
        for (int u = 0; u < CW - 1; ++u) { const int sp = s0 - (CW - 1) + u; const unsigned xv = sp >= 0 ? gp[(row0 - (CW - 1) + u) * 512] : 0u; win[u + 1] = (f32x2){__uint_as_float(xv << 16), __uint_as_float(xv & 0xffff0000u)}; }
        win[0] = (f32x2){0.f, 0.f};
        unsigned nx[CW], nn[CW];
#pragma unroll
        for (int u = 0; u < CW; ++u) nx[u] = (s0 + u < SEQ) ? gp[(row0 + u) * 512] : 0u;
        for (int bt = 0; bt < 5; ++bt) {
#pragma unroll
            for (int u = 0; u < CW; ++u) { const int sl = 31 * (bt + 1) + u; nn[u] = (bt < 4 && s0 + sl < SEQ) ? gp[(row0 + sl) * 512] : 0u; }
            __syncthreads();
#pragma unroll
            for (int u = 0; u < CW; ++u) {
                win[u] = (f32x2){__uint_as_float(nx[u] << 16), __uint_as_float(nx[u] & 0xffff0000u)};
                f32x2 a = bdw;
#pragma unroll
                for (int j = 0; j < CW; ++j) a = wt[j] * win[(u + 1 + j) % CW] + a;
                *(LAS f32x2*)(ys + u * DM + 2 * f_tid) = a;
            }
            __syncthreads();
            for (int u = F.wave; u < CW; u += NWAVES) {
                const int sl = 31 * bt + u;
                if (sl < 128) {
                    f32x4 v[4]; float sm = 0.f;
#pragma unroll
                    for (int k = 0; k < 4; ++k) { v[k] = *(const LAS f32x4*)(ys + u * DM + 256 * k + 4 * f_lane); sm += (v[k][0] + v[k][1]) + (v[k][2] + v[k][3]); }
                    const float mu = wave_sum(sm) * (1.f / DM);
                    float sq = 0.f;
#pragma unroll
                    for (int k = 0; k < 4; ++k) { v[k] = v[k] - mu; sq += (v[k][0] * v[k][0] + v[k][1] * v[k][1]) + (v[k][2] * v[k][2] + v[k][3] * v[k][3]); }
                    const float rs = 1.f / sqrtf(wave_sum(sq) * (1.f / DM) + EPS);
#pragma unroll
                    for (int k = 0; k < 4; ++k) {
                        f32x4 z = v[k] * rs * lng[k] + lnb[k];
#pragma unroll
                        for (int e = 0; e < 4; ++e) z[e] = z[e] / (1.f + __expf(-z[e]));
                        *(u32x2*)(H2 + (row0 + sl) * DM + 256 * k + 4 * f_lane) = (u32x2){cvtpk(z[0], z[1]), cvtpk(z[2], z[3])};
                    }
                }
            }
#pragma unroll
            for (int u = 0; u < CW; ++u) nx[u] = nn[u];
        }
    }
    __syncthreads();
}
enum Phase { PH_PREP = 0, PH_PREPW, PH_PROJ, PH_MIX, PH_WOUT, PH_Q0, PH_GU0, PH_GR0, PH_GV0, PH_W1, PH_CONV, PH_W2, PH_Q1, PH_GU1, PH_GR1, PH_GV1, PH_FINAL, PH_COUNT };
struct Args { const float* in[19]; float* out; unsigned char* ws; int ph_lo, ph_hi; };
#ifndef TEST_PHASE
#define TEST_PHASE -1
#endif

__global__ void __launch_bounds__(NTHR, 2) mega_fwd(Args args) {
    extern __shared__ __attribute__((aligned(16))) unsigned char lds[];
    Frame F;
    F.lds = (LAS unsigned char*)lds;
    F.wave = __builtin_amdgcn_readfirstlane((int)threadIdx.x >> 6); FRAME_IDS;
    F.G = gridDim.x; F.bid = blockIdx.x;
    F.x = args.in[0]; F.mix_norm = args.in[1]; F.ffn_norm = args.in[2]; F.final_norm = args.in[3]; F.w_in = args.in[4]; F.w_out = args.in[5]; F.rel_bias = args.in[6];
    F.conv_w1 = args.in[7]; F.conv_b1 = args.in[8]; F.conv_dw = args.in[9]; F.conv_dw_b = args.in[10]; F.conv_ln_g = args.in[11]; F.conv_ln_b = args.in[12];
    F.conv_w2 = args.in[13]; F.conv_b2 = args.in[14]; F.peer_wq = args.in[15]; F.peer_keys = args.in[16]; F.peer_u = args.in[17]; F.peer_v = args.in[18];
    F.out = args.out; F.ws = args.ws;
    volatile LAS unsigned* MISC = (volatile LAS unsigned*)(F.lds + MISC_OFF);
    for (int u = f_tid; u < (LDS_BYTES - LDSCTL_OFF) / 4; u += NTHR) ((LAS unsigned*)(F.lds + LDSCTL_OFF))[u] = 0u;
    __syncthreads();
    const int lo = args.ph_lo, hi = args.ph_hi;
    XcdBarrier bar; bar.bar = (unsigned*)(F.ws + WS_CTL) + CW_BAR; bar.x = 0; bar.st = nullptr;
    if (hi - lo > 1) bar = xcd_barrier_post((unsigned*)(F.ws + WS_CTL) + CW_BAR, MISC + 8);
#define IN(k) ((TEST_PHASE < 0 || TEST_PHASE == (k)) && lo <= (k) && (k) < hi)
#define SEAM(k) do { if (IN(k) && IN((k) + 1)) xcd_barrier(bar, F.wave); } while (0)
#define REPS(k) for (int rep_ = ((k) == REP_PHASE ? 0 : 1); rep_ < 2; ++rep_)
#define GEMM_PHASE(EPI, Aptr, Bptr, NN, ...) do { pg8::Gemm g{(const bf16*)(Aptr), (const bf16*)(Bptr), T, (NN), DM}; pg8::StaticOrder S; S.init(T, (NN), F.G, F.bid); \
        pg8::EPI E{__VA_ARGS__}; pg8::gemm_phase<pg8::EPI, pg8::StaticOrder, true, true>(F.lds, g, S, E, F.wave); } while (0)
    bf16* XB = (bf16*)(F.ws + WS_XB);
    float* PART = (float*)(F.ws + WS_PART); const float* ROPE = (const float*)(F.ws + WS_ROPE);
    if (IN(PH_PREP)) REPS(PH_PREP) { p0_prep(F); p0_weights(F, 0); } SEAM(PH_PREP);
    if (IN(PH_PREPW)) REPS(PH_PREPW) { p0_weights(F, 1); } SEAM(PH_PREPW);
    if (PROBE_MODE == 9 && IN(PH_PREP) && IN(PH_PREP + 1)) { for (int xb_ = 0; xb_ < 8; ++xb_) xcd_barrier(bar, F.wave); }
    if (IN(PH_PROJ)) REPS(PH_PROJ) { { pg8::Gemm g{(const bf16*)XB, (const bf16*)(F.ws + WS_WIN), T, INC, DM / 2}; pg8::StaticOrder S; S.init(T, INC, F.G, F.bid); pg8::EpiProj8 E{(bf16*)(F.ws + WS_R), ROPE, (const float*)(F.ws + WS_ROWSC), (const float*)(F.ws + WS_COLSC)}; pg8::gemm_phase<pg8::EpiProj8, pg8::StaticOrder, true, true, true>(F.lds, g, S, E, F.wave); } } SEAM(PH_PROJ);
    if (IN(PH_MIX)) REPS(PH_MIX) { mix_phase(F, rep_); } SEAM(PH_MIX);
    if (IN(PH_WOUT)) REPS(PH_WOUT) { GEMM_PHASE(EpiRes, F.ws + WS_O, F.ws + WS_WOUT, DM, F.x, XB, PART, nullptr); } SEAM(PH_WOUT);
    if (IN(PH_Q0)) REPS(PH_Q0) { GEMM_PHASE(EpiQ, XB, F.ws + WS_WQ, DM, (bf16*)(F.ws + WS_Q), PART); asm volatile("s_waitcnt vmcnt(0)" ::: "memory"); __syncthreads(); opt_route(F, 0); } SEAM(PH_Q0);
    const bool census = (hi - lo > 1);
    if (IN(PH_GU0)) REPS(PH_GU0) { gather_u(F, 0, get_xinfo(F, census), rep_ == 0); } SEAM(PH_GU0);
    if (IN(PH_GR0)) REPS(PH_GR0) { gather_r(F, 0); } SEAM(PH_GR0);
    if (IN(PH_GV0)) REPS(PH_GV0) { gather_v(F, 0, get_xinfo(F, census), rep_ == 0); } SEAM(PH_GV0);
    if (IN(PH_W1)) REPS(PH_W1) { GEMM_PHASE(EpiGlu, XB, F.ws + WS_W1, 2 * DM, (bf16*)(F.ws + WS_GLU), PART, F.conv_b1); } SEAM(PH_W1);
    if (IN(PH_CONV)) REPS(PH_CONV) { opt_conv(F); } SEAM(PH_CONV);
    if (IN(PH_W2)) { GEMM_PHASE(EpiRes, F.ws + WS_HID2, F.ws + WS_W2, DM, nullptr, XB, PART, F.conv_b2); } SEAM(PH_W2);
    if (IN(PH_Q1)) REPS(PH_Q1) { GEMM_PHASE(EpiQ, XB, F.ws + WS_WQ + (size_t)DM * DM * 2, DM, (bf16*)(F.ws + WS_Q), PART); asm volatile("s_waitcnt vmcnt(0)" ::: "memory"); __syncthreads(); opt_route(F, 1); } SEAM(PH_Q1);
    if (IN(PH_GU1)) REPS(PH_GU1) { gather_u(F, 1, get_xinfo(F, census), rep_ == 0); } SEAM(PH_GU1);
    if (IN(PH_GR1)) REPS(PH_GR1) { gather_r(F, 1); } SEAM(PH_GR1);
    if (IN(PH_GV1)) REPS(PH_GV1) { gather_v(F, 1, get_xinfo(F, census), rep_ == 0); } SEAM(PH_GV1);
    if (IN(PH_FINAL)) { final_norm(F); }
#undef IN
#undef SEAM
}

extern "C" void kernel_launch(void* const* d_in, const int* in_sizes, int n_in, void* d_out, int out_size, void* d_ws, size_t ws_size, hipStream_t stream) {
    static int grid = 0;
    if (grid == 0) {
        if (n_in != 19 || out_size != T * DM || ws_size < WS_END) { fprintf(stderr, "kernel_launch: unexpected shapes (n_in %d out %d ws %zu)\n", n_in, out_size, ws_size); grid = -1; return; }
        int dev = 0, cus = 0;
        if (hipGetDevice(&dev) != hipSuccess || hipDeviceGetAttribute(&cus, hipDeviceAttributeMultiprocessorCount, dev) != hipSuccess) { grid = -1; return; }
        if (hipFuncSetAttribute((const void*)mega_fwd, hipFuncAttributeMaxDynamicSharedMemorySize, LDS_BYTES) != hipSuccess) { fprintf(stderr, "kernel_launch: hipFuncSetAttribute failed\n"); grid = -1; return; }
        (void)hipGetLastError();
        grid = cus;
    }
    if (grid < 0) return;
    (void)hipMemsetAsync((char*)d_ws + WS_CTL, 0, CTL_ZERO_BYTES, stream);
    Args a{};
    for (int i = 0; i < 19; ++i) a.in[i] = (const float*)d_in[i];
    a.out = (float*)d_out; a.ws = (unsigned char*)d_ws;
#if MK_ONE_LAUNCH
    a.ph_lo = 0; a.ph_hi = PH_COUNT;
    hipLaunchKernelGGL(mega_fwd, dim3(grid), dim3(NTHR), LDS_BYTES, stream, a);
#else
    for (int p = 0; p < PH_COUNT; ++p) { a.ph_lo = p; a.ph_hi = p + 1; hipLaunchKernelGGL(mega_fwd, dim3(grid), dim3(NTHR), LDS_BYTES, stream, a); }
#endif
}
```

```cpp
#include <hip/hip_runtime.h>
#include <cstdio>
#include <cstdint>

#ifndef REP_PHASE
#define REP_PHASE -1
#endif
#ifndef PROBE_MODE
#define PROBE_MODE 1
#endif
#ifndef MK_ONE_LAUNCH
#define MK_ONE_LAUNCH 1
#endif

#define GAS __attribute__((address_space(1)))
#define LAS __attribute__((address_space(3)))
#define DI __device__ __forceinline__
typedef unsigned short bf16;
typedef float f32x2 __attribute__((ext_vector_type(2)));
typedef float f32x4 __attribute__((ext_vector_type(4)));
typedef unsigned u32x2 __attribute__((ext_vector_type(2)));
typedef unsigned u32x4 __attribute__((ext_vector_type(4)));
typedef short bf16x8 __attribute__((ext_vector_type(8)));
typedef float f32x16 __attribute__((ext_vector_type(16)));

constexpr int NB = 16, SEQ = 2048, DM = 1024, T = NB * SEQ;
constexpr int CHUNK = 64, HD = 64, NHA = 8, NHB = 8, INC = 3584, NCH = SEQ / CHUNK;
constexpr int PH = 8, PK = 128, PE = PK * PK, PQD = 128, PTOP = 16, NSEL = PH * PTOP;
constexpr int CW = 31;
constexpr float EPS = 1e-6f;
constexpr float LOG2E = 1.4426950408889634f;
constexpr float XQ = 127.f / 6.f;
constexpr int NWAVES = 8, NTHR = NWAVES * 64;

constexpr int C_QA = 0, C_KA = 512, C_VA = 1024, C_QB = 1536, C_KB = 2048, C_VB = 2560, C_GB = 3072;

constexpr size_t MiB = 1u << 20;
constexpr size_t WS_CTL = 0, CTL_ZERO_BYTES = 1 * MiB;
constexpr size_t WS_WIN = 2 * MiB, WS_WOUT = 9 * MiB, WS_W1 = 11 * MiB, WS_W2 = 15 * MiB, WS_WQ = 17 * MiB;
constexpr size_t WS_ROPE = 22 * MiB;
constexpr size_t WS_PART = 23 * MiB;
constexpr size_t WS_EIDX = 26 * MiB;
constexpr size_t WS_GATE = 42 * MiB;
constexpr size_t WS_U8 = 64 * MiB, WS_V8 = 96 * MiB;
constexpr size_t WS_SC = 25 * MiB;
constexpr size_t WS_ROWSC = 59 * MiB;
constexpr size_t WS_COLSC = 60 * MiB;
constexpr size_t WS_SA = 58 * MiB;
constexpr size_t WS_PU = 256 * MiB;
constexpr size_t WS_A = 384 * MiB;
constexpr size_t WS_XB = 128 * MiB;
constexpr size_t WS_R = 192 * MiB;
constexpr size_t WS_O = 416 * MiB;
constexpr size_t WS_Q = 192 * MiB;
constexpr size_t WS_HID = 256 * MiB;
constexpr size_t WS_GLU = 384 * MiB;
constexpr size_t WS_HID2 = 448 * MiB;
constexpr size_t WS_END = 512 * MiB;
constexpr int CW_BAR = 4096, CW_QUEUE = 8192;

constexpr int RING_BYTES = 131072, LDSCTL_OFF = RING_BYTES, MISC_OFF = LDSCTL_OFF + 320, LDS_BYTES = 147456;

DI float bf2f(bf16 v) { return __uint_as_float(((unsigned)v) << 16); }
DI unsigned f2bf(float f) { unsigned u = __float_as_uint(f); return (u + 0x7fffu + ((u >> 16) & 1u)) >> 16; }
DI unsigned pk2(float lo, float hi) { return f2bf(lo) | (f2bf(hi) << 16); }
#define DPP_MOV_I(x, ctrl) __builtin_amdgcn_mov_dpp((x), (ctrl), 0xF, 0xF, false)
#define DPP_XOR1 0xB1
#define DPP_XOR2 0x4E
#define DPP_HMIRROR 0x141
#define DPP_ROR8 0x128
DI float swap32_add(const float a, const float b) { const auto r = __builtin_amdgcn_permlane32_swap(__float_as_uint(a), __float_as_uint(b), false, false); return __uint_as_float(r[0]) + __uint_as_float(r[1]); }
DI float swap16_add(const float a, const float b) { const auto r = __builtin_amdgcn_permlane16_swap(__float_as_uint(a), __float_as_uint(b), false, false); return __uint_as_float(r[0]) + __uint_as_float(r[1]); }
DI int swap32_addi(const int a, const int b) { const auto r = __builtin_amdgcn_permlane32_swap((unsigned)a, (unsigned)b, false, false); return (int)(r[0] + r[1]); }
DI int swap16_addi(const int a, const int b) { const auto r = __builtin_amdgcn_permlane16_swap((unsigned)a, (unsigned)b, false, false); return (int)(r[0] + r[1]); }
DI float wave_sum_fast(float v) {
    v += __int_as_float(DPP_MOV_I(__float_as_int(v), DPP_XOR1)); v += __int_as_float(DPP_MOV_I(__float_as_int(v), DPP_XOR2));
    v += __int_as_float(DPP_MOV_I(__float_as_int(v), DPP_HMIRROR)); v += __int_as_float(DPP_MOV_I(__float_as_int(v), DPP_ROR8));
    v = swap16_add(v, v); v = swap32_add(v, v);
    return v;
}
DI float wave_sum(float v) { return wave_sum_fast(v); }
DI float swap32_max(const float a) { const auto r = __builtin_amdgcn_permlane32_swap(__float_as_uint(a), __float_as_uint(a), false, false); return fmaxf(__uint_as_float(r[0]), __uint_as_float(r[1])); }
DI float swap16_max(const float a) { const auto r = __builtin_amdgcn_permlane16_swap(__float_as_uint(a), __float_as_uint(a), false, false); return fmaxf(__uint_as_float(r[0]), __uint_as_float(r[1])); }
DI float wave_max(float v) {
    v = fmaxf(v, __int_as_float(DPP_MOV_I(__float_as_int(v), DPP_XOR1))); v = fmaxf(v, __int_as_float(DPP_MOV_I(__float_as_int(v), DPP_XOR2)));
    v = fmaxf(v, __int_as_float(DPP_MOV_I(__float_as_int(v), DPP_HMIRROR))); v = fmaxf(v, __int_as_float(DPP_MOV_I(__float_as_int(v), DPP_ROR8)));
    v = swap16_max(v); v = swap32_max(v);
    return v;
}
DI float block_sum(float v, LAS float* red, int tid) {
    v = wave_sum(v);
    __syncthreads();
    if ((tid & 63) == 0) red[tid >> 6] = v;
    __syncthreads();
    float s = 0.f;
#pragma unroll
    for (int i = 0; i < NWAVES; ++i) s += red[i];
    return s;
}
DI float gelu_erf(float x) { return 0.5f * x * (1.f + erff(x * 0.70710678118654752f)); }
DI float sigmoidf(float x) { return 1.f / (1.f + __expf(-x)); }

DI int lane_id() { int r; asm volatile("v_mbcnt_lo_u32_b32 %0, -1, 0\n\tv_mbcnt_hi_u32_b32 %0, -1, %0" : "=v"(r)); return r; }
#define XB_TMO      128
#define XB_XCNT(j)  (256  + 64 * (j))
#define XB_XSUB(j)  (1280 + 64 * (j))
#define XB_XGEN(j)  (2304 + 64 * (j))
#define XB_TOP      3328
#define XB_TOPGEN   3392
#define XCD_BAR_WORDS 3456
#define XB_SPIN_CAP (1u << 22)
DI unsigned xb_ld(unsigned* p)              { return __hip_atomic_load(p, __ATOMIC_RELAXED, __HIP_MEMORY_SCOPE_AGENT); }
DI unsigned xb_add(unsigned* p, unsigned v) { return __hip_atomic_fetch_add(p, v, __ATOMIC_RELAXED, __HIP_MEMORY_SCOPE_AGENT); }
DI unsigned xb_xcc_id() { return (unsigned)__builtin_amdgcn_s_getreg((3 << 11) | 20) & 0xFu; }
#define XB_SPIN(cond, bar) do { unsigned _sp = 0; while (cond) { __builtin_amdgcn_s_sleep(1); \
    if ((++_sp & 255u) == 0u) { if (xb_ld(&(bar)[XB_TMO])) break; if (_sp > XB_SPIN_CAP) { atomicAdd(&(bar)[XB_TMO], 1u); break; } } } } while (0)
struct XcdBarrier { unsigned* bar; unsigned x; volatile LAS unsigned* st; };
DI XcdBarrier xcd_barrier_post(unsigned* bar, volatile LAS unsigned* st) {
    XcdBarrier b; b.bar = bar; b.x = xb_xcc_id(); b.st = st;
    if (threadIdx.x == 0) st[4] = xb_add(&bar[XB_XCNT(b.x)], 1u);
    return b;
}
DI void xcd_barrier_complete(unsigned* bar, unsigned x, unsigned& nloc, unsigned& nx) {
    const unsigned G = gridDim.x * gridDim.y * gridDim.z;
    unsigned sum, cnt, mine, sp = 0u;
    for (;;) {
        sum = 0u; cnt = 0u; mine = 0u;
#pragma unroll
        for (unsigned j = 0; j < 16; ++j) { const unsigned c = xb_ld(&bar[XB_XCNT(j)]); sum += c; cnt += (c > 0u) ? 1u : 0u; mine = (j == x) ? c : mine; }
        if (sum == G) break;
        __builtin_amdgcn_s_sleep(1);
        if ((++sp & 255u) == 0u) { if (xb_ld(&bar[XB_TMO])) break; if (sp > XB_SPIN_CAP) { atomicAdd(&bar[XB_TMO], 1u); break; } }
    }
    nloc = mine > 0u ? mine : 1u; nx = cnt > 0u ? cnt : 1u;
}
DI void xcd_barrier(const XcdBarrier& b, const int wave_id) {
    asm volatile("s_waitcnt vmcnt(0)" ::: "memory");
    __syncthreads();
    if (wave_id == 0 && lane_id() == 0) {
        unsigned* bar = b.bar;
        __builtin_amdgcn_s_waitcnt(0);
        unsigned nloc = b.st[0], nx = b.st[1];
        if (nloc == 0u) { xcd_barrier_complete(bar, b.x, nloc, nx); b.st[0] = nloc; b.st[1] = nx; }
        const unsigned old = xb_add(&bar[XB_XSUB(b.x)], 1u);
        const unsigned gen = old / nloc;
        if (old + 1u == (gen + 1u) * nloc) {
            __builtin_amdgcn_fence(__ATOMIC_RELEASE, "agent");
            asm volatile("s_waitcnt vmcnt(0)" ::: "memory");
            const unsigned og = xb_add(&bar[XB_TOP], 1u);
            const unsigned tg = og / nx;
            if (og + 1u == (tg + 1u) * nx) xb_add(&bar[XB_TOPGEN], 1u);
            else XB_SPIN(xb_ld(&bar[XB_TOPGEN]) == tg, bar);
            __builtin_amdgcn_fence(__ATOMIC_ACQUIRE, "agent");
            xb_add(&bar[XB_XGEN(b.x)], 1u);
            asm volatile("s_waitcnt vmcnt(0)" ::: "memory");
        } else {
            XB_SPIN(xb_ld(&bar[XB_XGEN(b.x)]) == gen, bar);
            __builtin_amdgcn_fence(__ATOMIC_ACQUIRE, "agent");
            asm volatile("s_waitcnt vmcnt(0)" ::: "memory");
        }
    }
    __syncthreads();
}

namespace pg8 {
#define PG8_LAS __attribute__((address_space(3)))
typedef unsigned short bf16_t;
typedef short bf16x8 __attribute__((ext_vector_type(8)));
typedef float f32x4 __attribute__((ext_vector_type(4)));
typedef unsigned u32x4 __attribute__((ext_vector_type(4)));
typedef int i32x4 __attribute__((ext_vector_type(4)));
constexpr int BM = 256, BK = 64, HALF = 128, HTB = HALF * BK * 2  , STAGE_BYTES = 8 * HTB, NXCD = 8, WGM = 8;

__host__ __device__ __forceinline__ int lds_byte(int r, int c) { const int st = (r >> 4) * 2 + (c >> 5), rr = r & 15, cc = c & 31, ob = rr * 64 + cc * 2; return st * 1024 + (ob ^ (((ob >> 9) & 1) << 5)); }
__host__ __device__ __forceinline__ void stage_rc(int b, int& R, int& C) { const int st = b / 1024, sb = b % 1024, swz = sb ^ (((sb >> 9) & 1) << 5); R = (st >> 1) * 16 + swz / 64; C = (st & 1) * 32 + (swz % 64) / 2; }
__host__ __device__ __forceinline__ int perm32(int rho) { const int n = rho >> 4, i = rho & 15; return 8 * (i >> 2) + 4 * n + (i & 3); }

struct Unit { int pm, pn; };
struct Gemm { const bf16_t* A; const bf16_t* Bt; int M, N, K; };

struct StaticOrder {
    int nM, nN, nwg, G, c;
    __host__ __device__ void init(int M, int N, int G_, int c_) { nM = M / BM; nN = N / BM; nwg = nM * nN; G = G_; c = c_; }
    __host__ __device__ bool next(int i, Unit& u) const {
        const long L = (long)i * G + c; if (L >= nwg) return false;
        int wgid = (int)L; { const int q = nwg / NXCD, r = nwg % NXCD, xcd = wgid % NXCD, off = wgid / NXCD; wgid = (xcd < r ? xcd * (q + 1) : r * (q + 1) + (xcd - r) * q) + off; }
        const int nig = WGM * nN, gid = wgid / nig, fm = gid * WGM, gsz = (nM - fm) < WGM ? (nM - fm) : WGM;
        u.pm = fm + ((wgid % nig) % gsz); u.pn = (wgid % nig) / gsz; return true;
    }
    __device__ __forceinline__ void a_ready(const Unit&) const {}
    __device__ __forceinline__ void done(const Unit&) const {}
};

__device__ __forceinline__ unsigned cvt_pk_bf16(float lo, float hi) { unsigned r; asm volatile("v_cvt_pk_bf16_f32 %0, %1, %2" : "=v"(r) : "v"(lo), "v"(hi)); return r; }
__device__ __forceinline__ float rstd16(const float* part, int r, int fq) {
    const f32x4 a = *(const f32x4*)(part + (size_t)r * 16 + 4 * fq);
    float s = (a[0] + a[1]) + (a[2] + a[3]);
    s = swap16_add(s, s); s = swap32_add(s, s);
    return 1.f / sqrtf(s * (1.f / 1024.f) + 1e-6f);
}
__device__ __forceinline__ u32x4 pack8(const f32x4 a, const f32x4 b) { u32x4 w; w.x = cvt_pk_bf16(a[0], a[1]); w.y = cvt_pk_bf16(a[2], a[3]); w.z = cvt_pk_bf16(b[0], b[1]); w.w = cvt_pk_bf16(b[2], b[3]); return w; }
#define rot(t1, t2, c, s) do { const float a_ = (t1) * (c) - (t2) * (s), b_ = (t1) * (s) + (t2) * (c); (t1) = a_; (t2) = b_; } while (0)

struct EpiProj8 {
    static constexpr bool PERM = true, AFTER_DRAIN = false;
    bf16_t* R; const float* rope; const float* rowsc; const float* colsc;
    __device__ __forceinline__ void operator()(const f32x4 (&acc)[2][2][4][2], const Unit& u, int wr, int wc, int fr, int fq) const {
        const int type = u.pn >> 1, hg = u.pn & 1;
        const int colbase = type * 512 + (4 * hg + wc) * 64 + 8 * fq;
        const bool do_rope = (type == 3) || (type == 4);
        f32x4 cs[2][2];
#pragma unroll
        for (int bj = 0; bj < 2; ++bj)
#pragma unroll
            for (int n = 0; n < 2; ++n) cs[bj][n] = *(const f32x4*)(colsc + u.pn * BM + bj * HALF + wc * 32 + 8 * fq + 4 * n);
#pragma unroll
        for (int ai = 0; ai < 2; ++ai)
#pragma unroll
            for (int m = 0; m < 4; ++m) {
                const int r = u.pm * BM + ai * HALF + wr * 64 + m * 16 + fr;
                const float rs = rowsc[r];
                f32x4 v[2][2];
#pragma unroll
                for (int bj = 0; bj < 2; ++bj)
#pragma unroll
                    for (int n = 0; n < 2; ++n) { const i32x4 ia = __builtin_bit_cast(i32x4, acc[ai][bj][m][n]);
                        v[bj][n] = (f32x4){(float)ia[0], (float)ia[1], (float)ia[2], (float)ia[3]} * cs[bj][n] * rs; }
                f32x4 a0 = v[0][0], a1 = v[0][1], b0 = v[1][0], b1 = v[1][1];
                if (do_rope) {
                    const f32x4* rp = (const f32x4*)(rope + ((size_t)(r & 2047) * 32 + 8 * fq) * 2);
                    const f32x4 c0 = rp[0], c1 = rp[1], c2 = rp[2], c3 = rp[3];
                    rot(a0[0], b0[0], c0[0], c0[1]); rot(a0[1], b0[1], c0[2], c0[3]); rot(a0[2], b0[2], c1[0], c1[1]); rot(a0[3], b0[3], c1[2], c1[3]);
                    rot(a1[0], b1[0], c2[0], c2[1]); rot(a1[1], b1[1], c2[2], c2[3]); rot(a1[2], b1[2], c3[0], c3[1]); rot(a1[3], b1[3], c3[2], c3[3]);
                }
                bf16_t* rowp = R + (size_t)r * 3584 + colbase;
                *(u32x4*)(rowp) = pack8(a0, a1);
                *(u32x4*)(rowp + 32) = pack8(b0, b1);
            }
    }
};
struct EpiRes {
    static constexpr bool PERM = true, AFTER_DRAIN = false;
    const float* xf; bf16_t* hb; float* part; const float* bias;
    __device__ __forceinline__ void operator()(const f32x4 (&acc)[2][2][4][2], const Unit& u, int wr, int wc, int fr, int fq) const {
        const int col0 = u.pn * BM + wc * 32 + 8 * fq;
        f32x4 bv[2][2];
#pragma unroll
        for (int bj = 0; bj < 2; ++bj)
#pragma unroll
            for (int n = 0; n < 2; ++n) bv[bj][n] = bias ? *(const f32x4*)(bias + col0 + bj * HALF + 4 * n) : (f32x4){0.f, 0.f, 0.f, 0.f};
#pragma unroll
        for (int ai = 0; ai < 2; ++ai)
#pragma unroll
            for (int m = 0; m < 4; ++m) {
                const int r = u.pm * BM + ai * HALF + wr * 64 + m * 16 + fr;
                const size_t off = (size_t)r * 1024 + col0;
                float ss = 0.f;
#pragma unroll
                for (int bj = 0; bj < 2; ++bj) {
                    f32x4 x0, x1;
                    if (xf) { x0 = *(const f32x4*)(xf + off + bj * HALF); x1 = *(const f32x4*)(xf + off + bj * HALF + 4); }
                    else { const u32x4 w = *(const u32x4*)(hb + off + bj * HALF);
                           x0 = (f32x4){__uint_as_float(w[0] << 16), __uint_as_float(w[0] & 0xffff0000u), __uint_as_float(w[1] << 16), __uint_as_float(w[1] & 0xffff0000u)};
                           x1 = (f32x4){__uint_as_float(w[2] << 16), __uint_as_float(w[2] & 0xffff0000u), __uint_as_float(w[3] << 16), __uint_as_float(w[3] & 0xffff0000u)}; }
                    const f32x4 h0 = x0 + acc[ai][bj][m][0] + bv[bj][0], h1 = x1 + acc[ai][bj][m][1] + bv[bj][1];
                    *(u32x4*)(hb + off + bj * HALF) = pack8(h0, h1);
                    ss += (h0[0] * h0[0] + h0[1] * h0[1]) + (h0[2] * h0[2] + h0[3] * h0[3]) + (h1[0] * h1[0] + h1[1] * h1[1]) + (h1[2] * h1[2] + h1[3] * h1[3]);
                }
                ss = swap16_add(ss, ss); ss = swap32_add(ss, ss);
                if (fq == 0) part[(size_t)r * 16 + 4 * u.pn + wc] = ss;
            }
    }
};
struct EpiQ {
    static constexpr bool PERM = true, AFTER_DRAIN = false;
    bf16_t* O; const float* part;
    __device__ __forceinline__ void operator()(const f32x4 (&acc)[2][2][4][2], const Unit& u, int wr, int wc, int fr, int fq) const {
        const int col0 = u.pn * BM + wc * 32 + 8 * fq;
#pragma unroll
        for (int ai = 0; ai < 2; ++ai)
#pragma unroll
            for (int m = 0; m < 4; ++m) {
                const int r = u.pm * BM + ai * HALF + wr * 64 + m * 16 + fr;
                const float rs = rstd16(part, r, fq);
                bf16_t* rowp = O + (size_t)r * 1024 + col0;
#pragma unroll
                for (int bj = 0; bj < 2; ++bj) *(u32x4*)(rowp + bj * HALF) = pack8(acc[ai][bj][m][0] * rs, acc[ai][bj][m][1] * rs);
            }
    }
};
struct EpiGlu {
    static constexpr bool PERM = true, AFTER_DRAIN = false;
    bf16_t* G; const float* part; const float* b1;
    __device__ __forceinline__ void operator()(const f32x4 (&acc)[2][2][4][2], const Unit& u, int wr, int wc, int fr, int fq) const {
        const int col = u.pn * 128 + wc * 32 + 8 * fq;
        f32x4 ba[2], bg[2];
#pragma unroll
        for (int n = 0; n < 2; ++n) { ba[n] = *(const f32x4*)(b1 + col + 4 * n); bg[n] = *(const f32x4*)(b1 + 1024 + col + 4 * n); }
#pragma unroll
        for (int ai = 0; ai < 2; ++ai)
#pragma unroll
            for (int m = 0; m < 4; ++m) {
                const int r = u.pm * BM + ai * HALF + wr * 64 + m * 16 + fr;
                const float rs = rstd16(part, r, fq);
                f32x4 y[2];
#pragma unroll
                for (int n = 0; n < 2; ++n) {
                    const f32x4 a = acc[ai][0][m][n] * rs + ba[n], g = acc[ai][1][m][n] * rs + bg[n];
#pragma unroll
                    for (int i = 0; i < 4; ++i) y[n][i] = a[i] / (1.f + __expf(-g[i]));
                }
                *(u32x4*)(G + (size_t)r * 1024 + col) = pack8(y[0], y[1]);
            }
    }
};
template <class Epi, class Sched, bool ALIGN_EPI = false, bool SP2 = false, bool I8 = false>
__device__ __forceinline__ void gemm_phase(PG8_LAS unsigned char* lds, const Gemm g, const Sched& S, const Epi& E, const int wave_id) {
    const int lane = lane_id(), wid = wave_id, tid = wid * 64 + lane, wr = wid >> 2, wc = wid & 3, fr = lane & 15, fq = lane >> 4;
    const int K = g.K, nt = K / BK;
    unsigned voffA[2], voffB[2];
#pragma unroll
    for (int i = 0; i < 2; ++i) { int R, C; stage_rc(tid * 16 + i * 8192, R, C); const int Rb = Epi::PERM ? ((R & ~31) + perm32(R & 31)) : R;
        voffA[i] = (unsigned)(R * K + C) * 2u; voffB[i] = (unsigned)(Rb * K + C) * 2u; }
    const size_t kstep = (size_t)(BK * 2);
    const size_t hstep = (size_t)HALF * K * 2;
    const size_t tstep = 2 * hstep;
    const unsigned ldsw = (unsigned)wid * 1024u;
    const int aoff = lds_byte(wr * 64 + fr, fq * 8), boff = lds_byte(wc * 32 + fr, fq * 8);
#define PG8_SA(b, h) (((b) * 2 + (h)) * HTB)
#define PG8_SB(b, h) ((4 + (b) * 2 + (h)) * HTB)
#define PG8_STAGE(bufoff, gbase, voff) do { _Pragma("unroll") for (int _i = 0; _i < 2; ++_i) \
        __builtin_amdgcn_global_load_lds((const unsigned*)((const char*)(gbase) + (voff)[_i]), (PG8_LAS unsigned*)(lds + (bufoff) + ldsw + _i * 8192), 16, 0, 0); } while (0)
#define PG8_LDA(dst, b, h) do { _Pragma("unroll") for (int m = 0; m < 4; ++m) _Pragma("unroll") for (int k = 0; k < 2; ++k) dst[m][k] = *(const PG8_LAS bf16x8*)(lds + PG8_SA(b, h) + aoff + m * 2048 + k * 1024); } while (0)
#define PG8_LDB(dst, b, h) do { _Pragma("unroll") for (int n = 0; n < 2; ++n) _Pragma("unroll") for (int k = 0; k < 2; ++k) dst[n][k] = *(const PG8_LAS bf16x8*)(lds + PG8_SB(b, h) + boff + n * 2048 + k * 1024); } while (0)
#define PG8_MMA(ai, bj, At, Bt) do { __builtin_amdgcn_s_setprio(1); _Pragma("unroll") for (int m = 0; m < 4; ++m) _Pragma("unroll") for (int n = 0; n < 2; ++n) _Pragma("unroll") for (int k = 0; k < 2; ++k) { \
        if constexpr (I8) acc[ai][bj][m][n] = __builtin_bit_cast(f32x4, __builtin_amdgcn_mfma_i32_16x16x64_i8(__builtin_bit_cast(i32x4, Bt[n][k]), __builtin_bit_cast(i32x4, At[m][k]), __builtin_bit_cast(i32x4, acc[ai][bj][m][n]), 0, 0, 0)); \
        else acc[ai][bj][m][n] = __builtin_amdgcn_mfma_f32_16x16x32_bf16(Bt[n][k], At[m][k], acc[ai][bj][m][n], 0, 0, 0); } __builtin_amdgcn_s_setprio(0); } while (0)
#define PG8_WAIT_V(n) asm volatile("s_waitcnt vmcnt(" #n ")" ::: "memory")
#define PG8_WAIT_L(n) asm volatile("s_waitcnt lgkmcnt(" #n ")" ::: "memory")
#define PG8_BAR __builtin_amdgcn_s_barrier()
#define PG8_SCHED __builtin_amdgcn_sched_barrier(0)
    Unit cur, nxt; int ui = 0;
    if (!S.next(0, cur)) return;
    f32x4 acc[2][2][4][2];
#pragma unroll
    for (int a = 0; a < 2; ++a)
#pragma unroll
        for (int b = 0; b < 2; ++b)
#pragma unroll
            for (int m = 0; m < 4; ++m)
#pragma unroll
                for (int n = 0; n < 2; ++n) acc[a][b][m][n] = (f32x4){0.f, 0.f, 0.f, 0.f};
    bf16x8 At[4][2], B0[2][2], B1[2][2];
    const char* cA = (const char*)g.A + (size_t)cur.pm * tstep; const char* cB = (const char*)g.Bt + (size_t)cur.pn * tstep;
    S.a_ready(cur);
    if constexpr (SP2) {
        PG8_STAGE(PG8_SB(0, 0), cB, voffB); PG8_STAGE(PG8_SB(0, 1), cB + hstep, voffB); PG8_STAGE(PG8_SA(0, 0), cA, voffA); PG8_STAGE(PG8_SA(0, 1), cA + hstep, voffA);
        if (wr == 1) PG8_BAR;
        PG8_WAIT_V(2); PG8_BAR;
        PG8_STAGE(PG8_SB(1, 0), cB + kstep, voffB); PG8_STAGE(PG8_SA(1, 0), cA + kstep, voffA); PG8_STAGE(PG8_SB(1, 1), cB + hstep + kstep, voffB);
        PG8_WAIT_V(6); PG8_BAR;
    } else {
        PG8_STAGE(PG8_SB(0, 0), cB, voffB); PG8_STAGE(PG8_SA(0, 0), cA, voffA); PG8_STAGE(PG8_SB(0, 1), cB + hstep, voffB); PG8_STAGE(PG8_SA(0, 1), cA + hstep, voffA);
        if (wr == 1) PG8_BAR;
        PG8_WAIT_V(4); PG8_BAR;
        PG8_STAGE(PG8_SB(1, 0), cB + kstep, voffB); PG8_STAGE(PG8_SA(1, 0), cA + kstep, voffA); PG8_STAGE(PG8_SB(1, 1), cB + hstep + kstep, voffB);
        PG8_WAIT_V(6); PG8_BAR;
    }
    for (;;) {
        const bool has_next = S.next(ui + 1, nxt);
        const char* nA = has_next ? (const char*)g.A + (size_t)nxt.pm * tstep : cA; const char* nB = has_next ? (const char*)g.Bt + (size_t)nxt.pn * tstep : cB;
        for (int t = 0; t < nt; t += 2) {
            const bool last = (t == nt - 2);
            const char* a1 = cA + (size_t)(t + 1) * kstep;
            const char* a2 = last ? nA : cA + (size_t)(t + 2) * kstep; const char* b2 = last ? nB : cB + (size_t)(t + 2) * kstep;
            const char* a3 = a2 + kstep; const char* b3 = b2 + kstep;
            if (last && has_next) S.a_ready(nxt);
            if constexpr (SP2) {
            PG8_LDB(B0, 0, 0); PG8_LDB(B1, 0, 1); PG8_SCHED; PG8_LDA(At, 0, 0); PG8_STAGE(PG8_SA(1, 1), a1 + hstep, voffA);
            PG8_WAIT_V(8); PG8_WAIT_L(0); PG8_BAR; PG8_MMA(0, 0, At, B0); PG8_MMA(0, 1, At, B1); PG8_BAR; PG8_SCHED;
            PG8_LDA(At, 0, 1); PG8_STAGE(PG8_SB(0, 0), b2, voffB); PG8_STAGE(PG8_SB(0, 1), b2 + hstep, voffB); PG8_STAGE(PG8_SA(0, 0), a2, voffA);
            PG8_WAIT_V(8); PG8_WAIT_L(0); PG8_BAR; PG8_MMA(1, 0, At, B0); PG8_MMA(1, 1, At, B1); PG8_BAR; PG8_SCHED;
            PG8_LDB(B0, 1, 0); PG8_LDB(B1, 1, 1); PG8_SCHED; PG8_LDA(At, 1, 0); PG8_STAGE(PG8_SA(0, 1), a2 + hstep, voffA);
            PG8_WAIT_V(8); PG8_WAIT_L(0); PG8_BAR; PG8_MMA(0, 0, At, B0); PG8_MMA(0, 1, At, B1); PG8_BAR; PG8_SCHED;
            PG8_LDA(At, 1, 1); PG8_STAGE(PG8_SB(1, 0), b3, voffB); PG8_STAGE(PG8_SB(1, 1), b3 + hstep, voffB); PG8_STAGE(PG8_SA(1, 0), a3, voffA);
            PG8_WAIT_V(8); PG8_WAIT_L(0); PG8_BAR; PG8_MMA(1, 0, At, B0); PG8_MMA(1, 1, At, B1); PG8_BAR; PG8_SCHED;
            } else {
            PG8_LDB(B0, 0, 0); PG8_SCHED; PG8_LDA(At, 0, 0); PG8_STAGE(PG8_SA(1, 1), a1 + hstep, voffA);
            PG8_WAIT_L(8); PG8_BAR; PG8_WAIT_L(0); PG8_MMA(0, 0, At, B0); PG8_BAR; PG8_SCHED;
            PG8_LDB(B1, 0, 1); PG8_STAGE(PG8_SB(0, 0), b2, voffB);
            PG8_BAR; PG8_WAIT_L(0); PG8_MMA(0, 1, At, B1); PG8_BAR;
            PG8_LDA(At, 0, 1); PG8_STAGE(PG8_SA(0, 0), a2, voffA);
            PG8_BAR; PG8_WAIT_L(0); PG8_MMA(1, 0, At, B0); PG8_BAR; PG8_SCHED;
            PG8_STAGE(PG8_SB(0, 1), b2 + hstep, voffB);
            PG8_WAIT_V(6); PG8_BAR; PG8_MMA(1, 1, At, B1); PG8_BAR;
            PG8_LDB(B0, 1, 0); PG8_SCHED; PG8_LDA(At, 1, 0); PG8_STAGE(PG8_SA(0, 1), a2 + hstep, voffA);
            PG8_WAIT_L(8); PG8_BAR; PG8_WAIT_L(0); PG8_MMA(0, 0, At, B0); PG8_BAR; PG8_SCHED;
            PG8_LDB(B1, 1, 1); PG8_STAGE(PG8_SB(1, 0), b3, voffB);
            PG8_BAR; PG8_WAIT_L(0); PG8_MMA(0, 1, At, B1); PG8_BAR;
            PG8_LDA(At, 1, 1); PG8_STAGE(PG8_SA(1, 0), a3, voffA);
            PG8_BAR; PG8_WAIT_L(0); PG8_MMA(1, 0, At, B0); PG8_BAR; PG8_SCHED;
            PG8_STAGE(PG8_SB(1, 1), b3 + hstep, voffB);
            PG8_WAIT_V(6); PG8_BAR; PG8_MMA(1, 1, At, B1); PG8_BAR;
            }
        }
        if constexpr (ALIGN_EPI) { if (wr == 0) PG8_BAR; }
        if constexpr (!Epi::AFTER_DRAIN) { E(acc, cur, wr, wc, fr, fq); S.done(cur); }
        if (!has_next) break;
#pragma unroll
        for (int a = 0; a < 2; ++a)
#pragma unroll
            for (int b = 0; b < 2; ++b)
#pragma unroll
                for (int m = 0; m < 4; ++m)
#pragma unroll
                    for (int n = 0; n < 2; ++n) acc[a][b][m][n] = (f32x4){0.f, 0.f, 0.f, 0.f};
        cur = nxt; cA = nA; cB = nB; ++ui;
        if constexpr (ALIGN_EPI) { if (wr == 1) PG8_BAR; }
    }
    PG8_WAIT_V(0);
    if constexpr (!ALIGN_EPI) { if (wr == 0) PG8_BAR; }
    PG8_BAR;
    if constexpr (Epi::AFTER_DRAIN) { E.fused(acc, cur, wr, wc, fr, fq, lds, wid, lane); S.done(cur); }
#undef PG8_SA
#undef PG8_SB
#undef PG8_STAGE
#undef PG8_LDA
#undef PG8_LDB
#undef PG8_MMA
#undef PG8_WAIT_V
#undef PG8_WAIT_L
#undef PG8_BAR
#undef PG8_SCHED
}
}

struct Frame {
    LAS unsigned char* lds;
    int wave, G, bid;
    const float *x, *mix_norm, *ffn_norm, *final_norm, *w_in, *w_out, *rel_bias, *conv_w1, *conv_b1, *conv_dw, *conv_dw_b, *conv_ln_g, *conv_ln_b, *conv_w2, *conv_b2,
        *peer_wq, *peer_keys, *peer_u, *peer_v;
    float* out;
    unsigned char* ws;
};
#define FRAME_IDS const int f_lane = lane_id(); const int f_tid = F.wave * 64 + f_lane; (void)f_tid
DI float gamma_of(int h) { return 1.f - exp2f(-5.f - (float)h); }

DI unsigned q8x4(f32x4 v, const float sc) {
    const int a = (int)rintf(v[0] * sc), b = (int)rintf(v[1] * sc), c = (int)rintf(v[2] * sc), d = (int)rintf(v[3] * sc);
    return ((unsigned)a & 0xFFu) | (((unsigned)b & 0xFFu) << 8) | (((unsigned)c & 0xFFu) << 16) | ((unsigned)d << 24);
}
DI void p0_prep(Frame& F) {
    FRAME_IDS;
    const int gw = F.bid * NWAVES + F.wave, NGW = F.G * NWAVES;
    f32x2* rope = (f32x2*)(F.ws + WS_ROPE);
    for (int i = F.bid * NTHR + f_tid; i < SEQ * 32; i += F.G * NTHR) {
        const int s = i >> 5, j = i & 31;
        const float inv = powf(10000.f, -(float)j / 32.f);
        const float ang = (float)s * inv;
        float sn, cs; sincosf(ang, &sn, &cs);
        rope[i] = (f32x2){cs, sn};
    }
    unsigned* xq = (unsigned*)(F.ws + WS_XB); float* rowsc = (float*)(F.ws + WS_ROWSC);
    for (int m = gw; m < T; m += NGW) {
        const f32x4* xr = (const f32x4*)(F.x + (size_t)m * DM) + f_lane;
        f32x4 v[4]; float s = 0.f, am = 0.f;
#pragma unroll
        for (int j = 0; j < 4; ++j) { v[j] = xr[64 * j]; s += v[j].x * v[j].x + v[j].y * v[j].y + v[j].z * v[j].z + v[j].w * v[j].w; am = fmaxf(am, fmaxf(fmaxf(fabsf(v[j].x), fabsf(v[j].y)), fmaxf(fabsf(v[j].z), fabsf(v[j].w)))); }
        const float r = 1.f / sqrtf(wave_sum(s) * (1.f / DM) + EPS);
        am = wave_max(am);
        const float sc = am > 0.f ? 127.f / am : 0.f;
#pragma unroll
        for (int j = 0; j < 4; ++j) xq[(size_t)m * (DM / 4) + f_lane + 64 * j] = q8x4(v[j], sc);
        if (f_lane == 0) rowsc[m] = am * (1.f / 127.f) * r;
    }
}
DI void p0_transpose_item(const float* W, int K, int N, bf16* WT, int prow0, const float* gain, float scale, LAS float* scr, int k0, int n0, int lane) {
#pragma unroll 8
    for (int i = 0; i < 32; ++i) { const int kk = 2 * i + (lane >> 5); scr[kk * 33 + (lane & 31)] = W[(size_t)(k0 + kk) * N + n0 + (lane & 31)] * (gain ? gain[k0 + kk] : 1.f) * scale; }
    asm volatile("s_waitcnt lgkmcnt(0)" ::: "memory");
    const int c = lane & 7;
#pragma unroll
    for (int j = 0; j < 4; ++j) { const int n = (lane >> 3) + 8 * j; const LAS float* q = scr + (8 * c) * 33 + n;
        u32x4 o; o.x = pk2(q[0 * 33], q[1 * 33]); o.y = pk2(q[2 * 33], q[3 * 33]); o.z = pk2(q[4 * 33], q[5 * 33]); o.w = pk2(q[6 * 33], q[7 * 33]);
        *(u32x4*)(WT + (size_t)(prow0 + n) * K + k0 + 8 * c) = o; }
    asm volatile("s_waitcnt lgkmcnt(0)" ::: "memory");
}
DI void p0_amax_item(const float* W, int N, unsigned* colmax, const float* gain, float scale, int k0, int n0, int lane) {
    float am = 0.f;
#pragma unroll 8
    for (int i = 0; i < 32; ++i) { const int kk = 2 * i + (lane >> 5); am = fmaxf(am, fabsf(W[(size_t)(k0 + kk) * N + n0 + (lane & 31)] * (gain ? gain[k0 + kk] : 1.f) * scale)); }
    am = swap32_max(am);
    if (lane < 32) __hip_atomic_fetch_max(colmax + lane, __float_as_uint(am), __ATOMIC_RELAXED, __HIP_MEMORY_SCOPE_AGENT);
}
DI void p0_q8_item(const float* W, int N, unsigned char* WT, const unsigned* colmax, float* colsc, int prow0, const float* gain, float scale, LAS float* scr, int k0, int n0, int lane) {
    const float am = __uint_as_float(colmax[lane & 31]);
    const float sc = am > 0.f ? 127.f / am : 0.f;
    if (k0 == 0 && lane < 32) colsc[lane] = am * (1.f / 127.f);
#pragma unroll 8
    for (int i = 0; i < 32; ++i) { const int kk = 2 * i + (lane >> 5); scr[kk * 33 + (lane & 31)] = rintf(W[(size_t)(k0 + kk) * N + n0 + (lane & 31)] * (gain ? gain[k0 + kk] : 1.f) * scale * sc); }
    asm volatile("s_waitcnt lgkmcnt(0)" ::: "memory");
    const int ch = lane & 3;
#pragma unroll
    for (int j = 0; j < 2; ++j) { const int n = (lane >> 2) + 16 * j; const LAS float* q = scr + (16 * ch) * 33 + n;
        u32x4 o;
#pragma unroll
        for (int w = 0; w < 4; ++w) o[w] = ((unsigned)(int)q[(4 * w) * 33] & 0xFFu) | (((unsigned)(int)q[(4 * w + 1) * 33] & 0xFFu) << 8) | (((unsigned)(int)q[(4 * w + 2) * 33] & 0xFFu) << 16) | ((unsigned)(int)q[(4 * w + 3) * 33] << 24);
        *(u32x4*)(WT + (size_t)(prow0 + n) * DM + k0 + 16 * ch) = o; }
    asm volatile("s_waitcnt lgkmcnt(0)" ::: "memory");
}
constexpr int CW_COLMAX = 16384;
constexpr int CS_WIN = 0, CS_WOUT = 3584, CS_W1 = 4608, CS_W2 = 6656, CS_WQ = 7680;
constexpr bool I8_WIN = true, I8_WOUT = false, I8_W1 = false, I8_W2 = false, I8_WQ = false;
DI void p0_weights(Frame& F, const int pass) {
    FRAME_IDS;
    LAS float* scr = (LAS float*)(F.lds + F.wave * 16384);
    unsigned* colmax = (unsigned*)(F.ws + WS_CTL) + CW_COLMAX; float* colsc = (float*)(F.ws + WS_COLSC);
    const int gw = F.bid * NWAVES + F.wave, NGW = F.G * NWAVES;
    constexpr int I_IN = 16 * (INC / 32), I_SQ = 16 * (DM / 32), I_W1 = 16 * (2 * DM / 32);
    constexpr int NITEMS = I_IN + I_SQ + I_W1 + I_SQ + 2 * I_SQ;
#define WITEM(I8FLAG, Wp, Nn, WTb, CSo, prow0, gainp, scl, k0, n0) do { \
        if (pass == 0) { if (I8FLAG) p0_amax_item(Wp, Nn, colmax + (CSo) + (prow0), gainp, scl, k0, n0, f_lane); } \
        else if (I8FLAG) p0_q8_item(Wp, Nn, (unsigned char*)(WTb), colmax + (CSo) + (prow0), colsc + (CSo) + (prow0), prow0, gainp, scl, scr, k0, n0, f_lane); \
        else p0_transpose_item(Wp, DM, Nn, (bf16*)(WTb), prow0, gainp, scl, scr, k0, n0, f_lane); } while (0)
    for (int it = gw; it < NITEMS; it += NGW) {
        int r = it;
        if (r < I_IN) { const int nb = r % (INC / 32), kb = r / (INC / 32), n0 = nb * 32;
            const int type = n0 / 512, head = (n0 % 512) / 64, bj = (n0 % 64) / 32;
            const int prow0 = 256 * (2 * type + head / 4) + 128 * bj + 32 * (head % 4);
            WITEM(I8_WIN, F.w_in, INC, F.ws + WS_WIN, CS_WIN, prow0, F.mix_norm, (type == 0 ? 0.125f * LOG2E : (type == 4 ? 0.125f : 1.f)), kb * 64, n0); continue; }
        r -= I_IN;
        if (r < I_SQ) { const int nb = r % 32, kb = r / 32; WITEM(I8_WOUT, F.w_out, DM, F.ws + WS_WOUT, CS_WOUT, nb * 32, (const float*)nullptr, 1.f, kb * 64, nb * 32); continue; }
        r -= I_SQ;
        if (r < I_W1) { const int nb = r % 64, kb = r / 64, n0 = nb * 32; const int bj = n0 / 1024, rem = n0 % 1024;
            WITEM(I8_W1, F.conv_w1, 2 * DM, F.ws + WS_W1, CS_W1, 256 * (rem / 128) + 128 * bj + (rem % 128), F.mix_norm + DM, 1.f, kb * 64, n0); continue; }
        r -= I_W1;
        if (r < I_SQ) { const int nb = r % 32, kb = r / 32; WITEM(I8_W2, F.conv_w2, DM, F.ws + WS_W2, CS_W2, nb * 32, (const float*)nullptr, 1.f, kb * 64, nb * 32); continue; }
        r -= I_SQ;
        { const int layer = r / I_SQ; r %= I_SQ; const int nb = r % 32, kb = r / 32;
          WITEM(I8_WQ, F.peer_wq + (size_t)layer * DM * DM, DM, F.ws + WS_WQ + (size_t)layer * DM * DM * 2, CS_WQ + layer * DM, nb * 32, F.ffn_norm + layer * DM, 1.f, kb * 64, nb * 32); }
    }
#undef WITEM
}
DI float row_rstd(const float* part, int m) {
    const f32x4* p = (const f32x4*)(part + (size_t)m * 16);
    const f32x4 a = p[0], b = p[1], c = p[2], d = p[3];
    const float s = ((a.x + a.y) + (a.z + a.w)) + ((b.x + b.y) + (b.z + b.w)) + ((c.x + c.y) + (c.z + c.w)) + ((d.x + d.y) + (d.z + d.w));
    return 1.f / sqrtf(s * (1.f / DM) + EPS);
}

typedef short v4i16 __attribute__((ext_vector_type(4)));
typedef __bf16 bf16x2_t __attribute__((ext_vector_type(2)));
DI unsigned cvtpk(float lo, float hi) { f32x2 v = {lo, hi}; bf16x2_t b = __builtin_convertvector(v, bf16x2_t); return __builtin_bit_cast(unsigned, b); }
DI v4i16 ds_tr16(LAS const unsigned char* p) { return __builtin_amdgcn_ds_read_tr16_b64_v4i16((LAS v4i16*)p); }
DI int crow(int r, int h) { return (r & 3) + 8 * (r >> 2) + 4 * h; }
DI bf16x8 pack_step(const f32x16& x, const int s) {
    u32x4 w = {cvtpk(x[8 * s + 0], x[8 * s + 1]), cvtpk(x[8 * s + 2], x[8 * s + 3]), cvtpk(x[8 * s + 4], x[8 * s + 5]), cvtpk(x[8 * s + 6], x[8 * s + 7])};
    return __builtin_bit_cast(bf16x8, w);
}
constexpr int AT_KB = 64 * 144, AT_VB = 8192, AT_BUF = AT_KB + AT_VB, AT_BIAS = 2 * AT_BUF;
DI void attn_item(Frame& F, const int it) {
    FRAME_IDS;
    const bf16* R = (const bf16*)(F.ws + WS_R); bf16* O = (bf16*)(F.ws + WS_O);
    LAS unsigned char* lds = F.lds;
    LAS float* bias_s = (LAS float*)(lds + AT_BIAS);
    const int q32 = f_lane & 31, h = f_lane >> 5, w = F.wave;
    const int srow = f_tid >> 3, sch = f_tid & 7;
    const int vtr_off = ((f_lane & 15) >> 2) * 64 + (16 * ((f_lane >> 4) & 1) + 4 * (f_lane & 3)) * 2;
    {
        const int b = it / (NHA * 8), hd = (it / 8) % NHA, c0 = (it % 8) * 4;
        const int c = c0 + (w >> 1), qrow0 = 32 * (w & 1);
        const size_t tq = (size_t)b * SEQ + c * 64 + qrow0 + q32;
        __syncthreads();
        for (int k = f_tid; k < 257; k += NTHR) bias_s[k] = F.rel_bias[hd * 257 + k] * LOG2E;
        bf16x8 qf[4];
#pragma unroll
        for (int ks = 0; ks < 4; ++ks) qf[ks] = *(const bf16x8*)(R + tq * INC + C_QA + hd * 64 + 16 * ks + 8 * h);
        const int t_lo = c0 - 8 < 0 ? 0 : c0 - 8, t_hi = c0 + 3, ntile = t_hi - t_lo + 1;
        const bf16* kbase = R + ((size_t)b * SEQ + srow) * INC + C_KA + hd * 64 + 8 * sch;
        const bf16* vbase = R + ((size_t)b * SEQ + srow) * INC + C_VA + hd * 64 + 8 * sch;
        u32x4 kreg = *(const u32x4*)(kbase + (size_t)t_lo * 64 * INC), vreg = *(const u32x4*)(vbase + (size_t)t_lo * 64 * INC);
        *(LAS u32x4*)(lds + srow * 144 + sch * 16) = kreg;
        *(LAS u32x4*)(lds + AT_KB + (sch >> 2) * 4096 + srow * 64 + (sch & 3) * 16) = vreg;
        __syncthreads();
        const float bias_far = bias_s[256];
        float m = -1e30f, l = 0.f;
        f32x16 o0 = {}, o1 = {};
        for (int i = 0; i < ntile; ++i) {
            const int tc = t_lo + i;
            LAS unsigned char* kb = lds + (i & 1) * AT_BUF; LAS unsigned char* vb = kb + AT_KB;
            if (i + 1 < ntile) { kreg = *(const u32x4*)(kbase + (size_t)(tc + 1) * 64 * INC); vreg = *(const u32x4*)(vbase + (size_t)(tc + 1) * 64 * INC); }
            const int D = c - tc;
            if (D >= 0 && D <= 8) {
                const float init = D >= 3 ? bias_far : 0.f;
                f32x16 p0, p1;
#pragma unroll
                for (int r = 0; r < 16; ++r) { p0[r] = init; p1[r] = init; }
#pragma unroll
                for (int ks = 0; ks < 4; ++ks) {
                    const bf16x8 k0 = *(const LAS bf16x8*)(kb + q32 * 144 + (16 * ks + 8 * h) * 2);
                    const bf16x8 k1 = *(const LAS bf16x8*)(kb + (32 + q32) * 144 + (16 * ks + 8 * h) * 2);
                    p0 = __builtin_amdgcn_mfma_f32_32x32x16_bf16(k0, qf[ks], p0, 0, 0, 0);
                    p1 = __builtin_amdgcn_mfma_f32_32x32x16_bf16(k1, qf[ks], p1, 0, 0, 0);
                }
                if (D < 3) {
                    const int relb = D * 64 + qrow0 + q32 - 4 * h + 128;
#pragma unroll
                    for (int r = 0; r < 16; ++r) {
                        const int r0 = relb - ((r & 3) + 8 * (r >> 2));
                        const int i0 = r0 < 0 ? 0 : (r0 > 256 ? 256 : r0), r1 = r0 - 32, i1 = r1 < 0 ? 0 : (r1 > 256 ? 256 : r1);
                        p0[r] += bias_s[i0]; p1[r] += bias_s[i1];
                    }
                }
                float tm = fmaxf(p0[0], p1[0]);
#pragma unroll
                for (int r = 1; r < 16; ++r) tm = fmaxf(tm, fmaxf(p0[r], p1[r]));
                tm = swap32_max(tm);
                const float mn = fmaxf(m, tm), alpha = __builtin_amdgcn_exp2f(m - mn);
                m = mn;
                float ps = 0.f;
#pragma unroll
                for (int r = 0; r < 16; ++r) { p0[r] = __builtin_amdgcn_exp2f(p0[r] - mn); p1[r] = __builtin_amdgcn_exp2f(p1[r] - mn); ps += p0[r] + p1[r]; }
                l = l * alpha + ps;
                if (!__all(alpha == 1.f)) {
#pragma unroll
                    for (int r = 0; r < 16; ++r) { o0[r] *= alpha; o1[r] *= alpha; }
                }
                bf16x8 pf[4];
                pf[0] = pack_step(p0, 0); pf[1] = pack_step(p0, 1); pf[2] = pack_step(p1, 0); pf[3] = pack_step(p1, 1);
#pragma unroll
                for (int kk = 0; kk < 4; ++kk) {
                    const int key0 = 16 * kk + 4 * h;
                    const v4i16 a0l = ds_tr16(vb + key0 * 64 + vtr_off), a0h = ds_tr16(vb + (key0 + 8) * 64 + vtr_off);
                    const v4i16 a1l = ds_tr16(vb + 4096 + key0 * 64 + vtr_off), a1h = ds_tr16(vb + 4096 + (key0 + 8) * 64 + vtr_off);
                    const bf16x8 a0 = __builtin_shufflevector(a0l, a0h, 0, 1, 2, 3, 4, 5, 6, 7), a1 = __builtin_shufflevector(a1l, a1h, 0, 1, 2, 3, 4, 5, 6, 7);
                    o0 = __builtin_amdgcn_mfma_f32_32x32x16_bf16(a0, pf[kk], o0, 0, 0, 0);
                    o1 = __builtin_amdgcn_mfma_f32_32x32x16_bf16(a1, pf[kk], o1, 0, 0, 0);
                }
            }
            if (i + 1 < ntile) {
                LAS unsigned char* nb = lds + ((i + 1) & 1) * AT_BUF;
                *(LAS u32x4*)(nb + srow * 144 + sch * 16) = kreg;
                *(LAS u32x4*)(nb + AT_KB + (sch >> 2) * 4096 + srow * 64 + (sch & 3) * 16) = vreg;
            }
            __syncthreads();
        }
        l = swap32_add(l, l);
        const float inv = 1.f / l;
        bf16* op = O + tq * DM + hd * 64 + 4 * h;
#pragma unroll
        for (int g = 0; g < 4; ++g) {
            *(u32x2*)(op + 8 * g) = (u32x2){cvtpk(o0[4 * g] * inv, o0[4 * g + 1] * inv), cvtpk(o0[4 * g + 2] * inv, o0[4 * g + 3] * inv)};
            *(u32x2*)(op + 32 + 8 * g) = (u32x2){cvtpk(o1[4 * g] * inv, o1[4 * g + 1] * inv), cvtpk(o1[4 * g + 2] * inv, o1[4 * g + 3] * inv)};
        }
    }
    __syncthreads();
}

constexpr int RT_Q = 0, RT_K = 9216, RT_KD = 18432, RT_V = 26624, RT_BUF = 34816, RT_ZS = 2 * RT_BUF, RT_CS = RT_ZS + 64 * 66 * 4;
DI void ret_item(Frame& F, const int it) {
    FRAME_IDS;
    const bf16* R = (const bf16*)(F.ws + WS_R); bf16* O = (bf16*)(F.ws + WS_O);
    LAS unsigned char* lds = F.lds;
    LAS float* Zs = (LAS float*)(lds + RT_ZS); LAS float* Cs = (LAS float*)(lds + RT_CS);
    const int b = it / NHB, hd = it % NHB;
    const int q32 = f_lane & 31, h = f_lane >> 5, w = F.wave;
    const int role = w >> 2, itile = (w >> 1) & 1, etile = w & 1;
    const int srow = f_tid >> 3, sch = f_tid & 7;
    const int vtr_off = ((f_lane & 15) >> 2) * 64 + (16 * ((f_lane >> 4) & 1) + 4 * (f_lane & 3)) * 2;
    const float l2g = log2f(gamma_of(hd));
    const float cd = exp2f(l2g * 64.f), sdec = exp2f(l2g * (float)(63 - srow));
    float qdv[16];
#pragma unroll
    for (int r = 0; r < 16; ++r) qdv[r] = exp2f(l2g * (float)(32 * itile + crow(r, h) + 1));
    f32x16 xs0 = {}, xs1 = {};
    const size_t trow0 = (size_t)b * SEQ;
    const bf16* gq = R + (trow0 + srow) * INC + hd * 64 + 8 * sch;
    u32x4 qreg = *(const u32x4*)(gq + C_QB), kreg = *(const u32x4*)(gq + C_KB), vreg = *(const u32x4*)(gq + C_VB);
    __syncthreads();
#define RT_STAGE(bufp) do { LAS unsigned char* bp_ = (bufp); \
        *(LAS u32x4*)(bp_ + RT_Q + srow * 144 + sch * 16) = qreg; *(LAS u32x4*)(bp_ + RT_K + srow * 144 + sch * 16) = kreg; \
        *(LAS u32x4*)(bp_ + RT_V + (sch >> 2) * 4096 + srow * 64 + (sch & 3) * 16) = vreg; \
        u32x4 kd_; \
        _Pragma("unroll") for (int e_ = 0; e_ < 4; ++e_) kd_[e_] = cvtpk(__uint_as_float(kreg[e_] << 16) * sdec, __uint_as_float(kreg[e_] & 0xffff0000u) * sdec); \
        *(LAS u32x4*)(bp_ + RT_KD + (sch >> 2) * 4096 + srow * 64 + (sch & 3) * 16) = kd_; } while (0)
    RT_STAGE(lds);
    __syncthreads();
    for (int n = 0; n < NCH; ++n) {
        LAS unsigned char* bp = lds + (n & 1) * RT_BUF;
        if (n + 1 < NCH) { const bf16* g1 = gq + (size_t)(n + 1) * 64 * INC; qreg = *(const u32x4*)(g1 + C_QB); kreg = *(const u32x4*)(g1 + C_KB); vreg = *(const u32x4*)(g1 + C_VB); }
        unsigned short gr[8];
#pragma unroll
        for (int r = 0; r < 8; ++r) gr[r] = R[(trow0 + n * 64 + 8 * w + r) * INC + C_GB + hd * 64 + f_lane];
        if (role == 0) {
            bf16x8 qf[4];
#pragma unroll
            for (int ks = 0; ks < 4; ++ks) qf[ks] = *(const LAS bf16x8*)(bp + RT_Q + (32 * itile + q32) * 144 + (16 * ks + 8 * h) * 2);
            f32x16 st0 = {}, st1 = {};
#pragma unroll
            for (int ks = 0; ks < 4; ++ks) {
                const bf16x8 k0 = *(const LAS bf16x8*)(bp + RT_K + q32 * 144 + (16 * ks + 8 * h) * 2);
                const bf16x8 k1 = *(const LAS bf16x8*)(bp + RT_K + (32 + q32) * 144 + (16 * ks + 8 * h) * 2);
                st0 = __builtin_amdgcn_mfma_f32_32x32x16_bf16(k0, qf[ks], st0, 0, 0, 0);
                st1 = __builtin_amdgcn_mfma_f32_32x32x16_bf16(k1, qf[ks], st1, 0, 0, 0);
            }
            int iiv = 32 * itile + q32 - 4 * h; asm volatile("" : "+v"(iiv));
#pragma unroll
            for (int r = 0; r < 16; ++r) {
                const int dd = iiv - ((r & 3) + 8 * (r >> 2));
                st0[r] *= __builtin_amdgcn_exp2f(l2g * fabsf((float)dd));
                st1[r] *= __builtin_amdgcn_exp2f(l2g * fabsf((float)(dd - 32)));
            }
            f32x16 z = {};
#pragma unroll
            for (int kk = 0; kk < 4; ++kk) {
                const int key0 = 16 * kk + 4 * h;
                const v4i16 bl = ds_tr16(bp + RT_V + etile * 4096 + key0 * 64 + vtr_off), bh = ds_tr16(bp + RT_V + etile * 4096 + (key0 + 8) * 64 + vtr_off);
                const bf16x8 vb = __builtin_shufflevector(bl, bh, 0, 1, 2, 3, 4, 5, 6, 7);
                const bf16x8 xa = (kk < 2) ? pack_step(st0, kk & 1) : pack_step(st1, kk & 1);
                z = __builtin_amdgcn_mfma_f32_32x32x16_bf16(xa, vb, z, 0, 0, 0);
            }
            int zb = (32 * itile + 4 * h) * 66 + 32 * etile + q32; asm volatile("" : "+v"(zb));
#pragma unroll
            for (int r = 0; r < 16; ++r) Zs[zb + ((r & 3) + 8 * (r >> 2)) * 66] = z[r];
        } else {
            f32x16 cr = {};
#pragma unroll
            for (int kk = 0; kk < 4; ++kk) {
                const LAS unsigned char* qp = bp + RT_Q + (32 * itile + q32) * 144 + (16 * kk + 4 * h) * 2;
                const v4i16 al = *(const LAS v4i16*)qp, ah = *(const LAS v4i16*)(qp + 16);
                const bf16x8 qa = __builtin_shufflevector(al, ah, 0, 1, 2, 3, 4, 5, 6, 7);
                const bf16x8 xb = (kk < 2) ? pack_step(xs0, kk & 1) : pack_step(xs1, kk & 1);
                cr = __builtin_amdgcn_mfma_f32_32x32x16_bf16(qa, xb, cr, 0, 0, 0);
            }
            int cb = (32 * itile + 4 * h) * 66 + 32 * etile + q32; asm volatile("" : "+v"(cb));
#pragma unroll
            for (int r = 0; r < 16; ++r) Cs[cb + ((r & 3) + 8 * (r >> 2)) * 66] = cr[r] * qdv[r];
#pragma unroll
            for (int r = 0; r < 16; ++r) { xs0[r] *= cd; xs1[r] *= cd; }
#pragma unroll
            for (int s4 = 0; s4 < 4; ++s4) {
                const int key0 = 16 * s4 + 8 * h;
                const v4i16 vl = ds_tr16(bp + RT_V + etile * 4096 + key0 * 64 + vtr_off), vh = ds_tr16(bp + RT_V + etile * 4096 + (key0 + 4) * 64 + vtr_off);
                const bf16x8 vb = __builtin_shufflevector(vl, vh, 0, 1, 2, 3, 4, 5, 6, 7);
                const v4i16 a0l = ds_tr16(bp + RT_KD + key0 * 64 + vtr_off), a0h = ds_tr16(bp + RT_KD + (key0 + 4) * 64 + vtr_off);
                const v4i16 a1l = ds_tr16(bp + RT_KD + 4096 + key0 * 64 + vtr_off), a1h = ds_tr16(bp + RT_KD + 4096 + (key0 + 4) * 64 + vtr_off);
                const bf16x8 ka0 = __builtin_shufflevector(a0l, a0h, 0, 1, 2, 3, 4, 5, 6, 7), ka1 = __builtin_shufflevector(a1l, a1h, 0, 1, 2, 3, 4, 5, 6, 7);
                xs0 = __builtin_amdgcn_mfma_f32_32x32x16_bf16(ka0, vb, xs0, 0, 0, 0);
                xs1 = __builtin_amdgcn_mfma_f32_32x32x16_bf16(ka1, vb, xs1, 0, 0, 0);
            }
        }
        __syncthreads();
#pragma unroll
        for (int r = 0; r < 8; ++r) {
            const int i = 8 * w + r;
            const float v = Zs[i * 66 + f_lane] + Cs[i * 66 + f_lane];
            const float mu = wave_sum(v) * (1.f / 64.f);
            const float dv = v - mu;
            const float var = wave_sum(dv * dv) * (1.f / 64.f);
            const float g = bf2f(gr[r]);
            O[(trow0 + n * 64 + i) * DM + 512 + hd * 64 + f_lane] = (bf16)f2bf(dv * (1.f / sqrtf(var + EPS)) * (g / (1.f + __expf(-g))));
        }
        if (n + 1 < NCH) RT_STAGE(lds + ((n + 1) & 1) * RT_BUF);
        __syncthreads();
    }
#undef RT_STAGE
}
DI void int8_rows(Frame& F, const int row0, const int nrows, const int f_lane) {
    float* SC = (float*)(F.ws + WS_SC);
    for (int rr = row0; rr < row0 + nrows; rr += 8) {
        f32x4 v[8][4];
#pragma unroll
        for (int u = 0; u < 8; ++u) {
            const int row = rr + u, tab = row / PE, e = row % PE, layer = tab & 1, isv = tab >> 1;
            const f32x4* sp = (const f32x4*)((isv ? F.peer_v : F.peer_u) + ((size_t)layer * PE + e) * DM) + f_lane;
#pragma unroll
            for (int j = 0; j < 4; ++j) v[u][j] = sp[64 * j];
        }
#pragma unroll
        for (int u = 0; u < 8; ++u) {
            const int row = rr + u, tab = row / PE, e = row % PE, layer = tab & 1, isv = tab >> 1;
            const f32x4* gp = (const f32x4*)(F.ffn_norm + layer * DM) + f_lane;
            float a = 0.f, sq = 0.f;
#pragma unroll
            for (int j = 0; j < 4; ++j) { if (!isv) v[u][j] = v[u][j] * gp[64 * j]; a = fmaxf(a, fmaxf(fmaxf(fabsf(v[u][j][0]), fabsf(v[u][j][1])), fmaxf(fabsf(v[u][j][2]), fabsf(v[u][j][3]))));
                sq += (v[u][j][0] * v[u][j][0] + v[u][j][1] * v[u][j][1]) + (v[u][j][2] * v[u][j][2] + v[u][j][3] * v[u][j][3]); }
            a = wave_max(a);
            const float step = fminf(0.355f * sqrtf(wave_sum(sq) * (1.f / DM)), a * (1.f / 7.f));
            const float sc = step > 0.f ? 1.f / step : 0.f;
            unsigned* dst = (unsigned*)(F.ws + (isv ? WS_V8 : WS_U8)) + (size_t)layer * 4 * PE * 32;
#pragma unroll
            for (int j = 0; j < 4; ++j) {
                const int q0 = (int)rintf(__builtin_amdgcn_fmed3f(v[u][j][0] * sc, -7.f, 7.f)), q1 = (int)rintf(__builtin_amdgcn_fmed3f(v[u][j][1] * sc, -7.f, 7.f)), q2 = (int)rintf(__builtin_amdgcn_fmed3f(v[u][j][2] * sc, -7.f, 7.f)), q3 = (int)rintf(__builtin_amdgcn_fmed3f(v[u][j][3] * sc, -7.f, 7.f));
                const int ob = (isv && !(f_lane & 1)) ? 8 : 0;
                unsigned w = ((unsigned)(q0 + ob) & 0xFu) | (((unsigned)(q1 + ob) & 0xFu) << 8) | (((unsigned)(q2 + ob) & 0xFu) << 16) | (((unsigned)(q3 + ob) & 0xFu) << 24);
                if (f_lane & 1) w <<= 4;
                w |= (unsigned)DPP_MOV_I((int)w, DPP_XOR1);
                if (!(f_lane & 1)) dst[((size_t)j * PE + e) * 32 + (f_lane >> 1)] = w;
            }
            if (f_lane == 0) SC[tab * PE + e] = isv ? step * (1.f / 16.f) : step;
        }
    }
}
constexpr int Q8_ITEM_ROWS = 512, Q8_ITEMS = 4 * PE / Q8_ITEM_ROWS;
constexpr int PH_MIX_ID = 3;
DI void mix_phase(Frame& F, const int rep) {
    FRAME_IDS;
    unsigned* ctr = (unsigned*)(F.ws + WS_CTL) + CW_QUEUE + 64 * rep;
    volatile LAS unsigned* slot = (volatile LAS unsigned*)(F.lds + MISC_OFF) + 16;
    constexpr int N_RET = NB * NHB, N_ATT = NB * NHA * 8;
    static_assert(N_ATT == 8 * Q8_ITEMS, "8 attention items per quantisation item");
    for (;;) {
        __syncthreads();
        if (f_tid == 0) slot[0] = __hip_atomic_fetch_add(ctr, 1u, __ATOMIC_RELAXED, __HIP_MEMORY_SCOPE_AGENT);
        __syncthreads();
        const int idx = (int)slot[0];
        if (idx >= N_RET + N_ATT + Q8_ITEMS) break;
        const bool probe_pass = (REP_PHASE == PH_MIX_ID && rep == 0);
        if (idx < N_RET) { if (!(probe_pass && PROBE_MODE == 4)) ret_item(F, idx); }
        else if (probe_pass && PROBE_MODE == 3) { }
        else { const int k = idx - N_RET, grp = k / 9, pos = k - 9 * grp;
            if (pos == 8) int8_rows(F, grp * Q8_ITEM_ROWS + F.wave * 64, 64, f_lane);
            else attn_item(F, 8 * grp + pos); }
    }
}
DI float fmax_raw(float a, float b) { float r; asm("v_max_f32_e32 %0, %1, %2" : "=v"(r) : "v"(a), "v"(b)); return r; }
DI float fmin_raw(float a, float b) { float r; asm("v_min_f32_e32 %0, %1, %2" : "=v"(r) : "v"(a), "v"(b)); return r; }
#define CE_DESC(x, y) do { const float hi_ = fmax_raw((x), (y)), lo_ = fmin_raw((x), (y)); (x) = hi_; (y) = lo_; } while (0)
template <int N> DI void sort_desc(float* v) {
#pragma unroll
    for (int k = 2; k <= N; k <<= 1)
#pragma unroll
        for (int j = k >> 1; j > 0; j >>= 1)
#pragma unroll
            for (int i = 0; i < N; ++i) { const int l = i ^ j; if (l > i) { if ((i & k) == 0 || k == N) CE_DESC(v[i], v[l]); else CE_DESC(v[l], v[i]); } }
}
DI void merge16(float* a, const float* b) {
#pragma unroll
    for (int i = 0; i < 16; ++i) a[i] = fmax_raw(a[i], b[15 - i]);
#pragma unroll
    for (int j = 8; j > 0; j >>= 1)
#pragma unroll
        for (int i = 0; i < 16; ++i) { const int l = i ^ j; if (l > i) CE_DESC(a[i], a[l]); }
}
DI float key_pack(float v, unsigned keep_mask, unsigned idx) { return __uint_as_float((__float_as_uint(v) & keep_mask) | idx); }
DI void opt_route(Frame& F, int layer) {
    FRAME_IDS;
    const bf16* Q = (const bf16*)(F.ws + WS_Q);
    int* eidx = (int*)(F.ws + WS_EIDX); float* gate = (float*)(F.ws + WS_GATE);
    const float* keys = F.peer_keys + (size_t)layer * 2 * PK * 64;
    LAS unsigned char* kl = F.lds;
    __syncthreads();
    for (int idx = f_tid; idx < 2 * PK * 8; idx += NTHR) {
        const int row = idx >> 3, ch = idx & 7;
        const f32x4 a = *(const f32x4*)(keys + (size_t)row * 64 + ch * 8), b = *(const f32x4*)(keys + (size_t)row * 64 + ch * 8 + 4);
        *(LAS u32x4*)(kl + row * 144 + ch * 16) = (u32x4){pk2(a[0], a[1]), pk2(a[2], a[3]), pk2(b[0], b[1]), pk2(b[2], b[3])};
    }
    __syncthreads();
    LAS int* lut = (LAS int*)(F.lds + 40960 + F.wave * 8192);
    const int c = f_lane & 31, h = f_lane >> 5;
    pg8::StaticOrder SO; SO.init(T, DM, F.G, F.bid);
    pg8::Unit un;
    for (int ui = 0; SO.next(ui, un); ++ui)
    for (int k2 = F.wave; k2 < 16; k2 += NWAVES) {
        const int tile = 8 * un.pm + (k2 & 7), hh = 2 * un.pn + (k2 >> 3), t = tile * 32 + c;
        float tk[2][16];
#pragma unroll
        for (int side = 0; side < 2; ++side) {
            bf16x8 qf[4];
#pragma unroll
            for (int ks = 0; ks < 4; ++ks) qf[ks] = *(const bf16x8*)(Q + (size_t)t * DM + hh * PQD + side * 64 + 16 * ks + 8 * h);
            float v[64];
#pragma unroll
            for (int kt = 0; kt < 4; ++kt) {
                f32x16 acc = {};
#pragma unroll
                for (int ks = 0; ks < 4; ++ks) {
                    const bf16x8 a = *(const LAS bf16x8*)(kl + (side * PK + 32 * kt + c) * 144 + (16 * ks + 8 * h) * 2);
                    acc = __builtin_amdgcn_mfma_f32_32x32x16_bf16(a, qf[ks], acc, 0, 0, 0);
                }
#pragma unroll
                for (int r = 0; r < 16; ++r) v[16 * kt + r] = key_pack(acc[r], 0xFFFFFF80u, (unsigned)(32 * kt + (r & 3) + 8 * (r >> 2) + 4 * h));
            }
            sort_desc<16>(v); sort_desc<16>(v + 16); sort_desc<16>(v + 32); sort_desc<16>(v + 48);
            merge16(v, v + 16); merge16(v + 32, v + 48); merge16(v, v + 32);
            float pr[16];
#pragma unroll
            for (int i = 0; i < 16; ++i) pr[i] = __shfl_xor(v[i], 32);
            merge16(v, pr);
#pragma unroll
            for (int i = 0; i < 16; ++i) { tk[side][i] = v[i]; lut[(side * 16 + i) * 64 + f_lane] = (int)(__float_as_uint(v[i]) & 0x7Fu); }
        }
        float cd[64];
        {   int n = 0;
#pragma unroll
            for (int a = 0; a < 16; ++a)
#pragma unroll
                for (int b = 0; b < 16; ++b) if ((a + 1) * (b + 1) <= 16) { cd[n] = key_pack(tk[0][a] + tk[1][b], 0xFFFFFF00u, (unsigned)(a * 16 + b)); ++n; }
#pragma unroll
            for (int i = 50; i < 64; ++i) cd[i] = -INFINITY;
        }
        sort_desc<16>(cd); sort_desc<16>(cd + 16); sort_desc<16>(cd + 32); CE_DESC(cd[48], cd[49]);
        merge16(cd, cd + 16); merge16(cd + 32, cd + 48); merge16(cd, cd + 32);
        int ex[16]; float gv[16]; float sum = 0.f;
        const float top = __uint_as_float(__float_as_uint(cd[0]) & 0xFFFFFF00u);
#pragma unroll
        for (int i = 0; i < 16; ++i) {
            const unsigned bits = __float_as_uint(cd[i]);
            const int a = (bits >> 4) & 15, b = bits & 15;
            ex[i] = lut[a * 64 + f_lane] * PK + lut[(16 + b) * 64 + f_lane];
            gv[i] = __expf(__uint_as_float(bits & 0xFFFFFF00u) - top); sum += gv[i];
        }
        const float inv = 1.f / sum;
        if (h == 0) {
            u32x4* ep = (u32x4*)(eidx + (size_t)t * NSEL + hh * 16);
#pragma unroll
            for (int q = 0; q < 4; ++q) ep[q] = (u32x4){(unsigned)ex[4 * q], (unsigned)ex[4 * q + 1], (unsigned)ex[4 * q + 2], (unsigned)ex[4 * q + 3]};
        } else {
            f32x4* gp = (f32x4*)(gate + (size_t)t * NSEL + hh * 16);
#pragma unroll
            for (int q = 0; q < 4; ++q) gp[q] = (f32x4){gv[4 * q] * inv, gv[4 * q + 1] * inv, gv[4 * q + 2] * inv, gv[4 * q + 3] * inv};
        }
    }
    __syncthreads();
}
struct XInfo { int xrank, nx, rank, nloc; };
DI XInfo get_xinfo(Frame& F, const bool census) {
    FRAME_IDS;
    volatile LAS unsigned* M = (volatile LAS unsigned*)(F.lds + MISC_OFF);
    __syncthreads();
    if (f_tid == 0) {
        unsigned xr = (unsigned)F.bid & 7u, nx = 8u, rk = (unsigned)F.bid >> 3, nl = ((unsigned)F.G + 7u - ((unsigned)F.bid & 7u)) >> 3;
        if (census) {
            unsigned* bar = (unsigned*)(F.ws + WS_CTL) + CW_BAR; const unsigned x = xb_xcc_id();
            unsigned cnt = 0u, below = 0u, mine = 0u;
#pragma unroll
            for (unsigned j = 0; j < 16; ++j) { const unsigned c = xb_ld(&bar[XB_XCNT(j)]); cnt += (c > 0u); below += (c > 0u && j < x); mine = (j == x) ? c : mine; }
            if (cnt > 0u && mine > 0u) { xr = below; nx = cnt; rk = M[12]; nl = mine; }
        }
        M[20] = xr; M[21] = nx; M[22] = rk; M[23] = nl;
    }
    __syncthreads();
    XInfo xi; xi.xrank = (int)M[20]; xi.nx = (int)M[21]; xi.rank = (int)M[22]; xi.nloc = (int)M[23];
    return xi;
}
DI int comb_c(const int level, const int a, const int b, const int lane) {
    const int M = 4 >> level; const bool bit = (lane & M) != 0;
    const int send = bit ? a : b, keep = bit ? b : a;
    const int recv = level == 0 ? DPP_MOV_I(send, DPP_HMIRROR) : (level == 1 ? DPP_MOV_I(send, DPP_XOR2) : DPP_MOV_I(send, DPP_XOR1));
    return keep + recv;
}
DI int dot16_i8(const u32x4 r, const u32x4 x) {
    int s = __builtin_amdgcn_sdot4((int)r[0], (int)x[0], 0, false);
    s = __builtin_amdgcn_sdot4((int)r[1], (int)x[1], s, false); s = __builtin_amdgcn_sdot4((int)r[2], (int)x[2], s, false); s = __builtin_amdgcn_sdot4((int)r[3], (int)x[3], s, false);
    return s;
}
DI int half_dots(const u32x4 (&rows)[8], const u32x4 xq, const int lane) {
    int p[8];
#pragma unroll
    for (int i = 0; i < 8; ++i) p[i] = dot16_i8(rows[i], xq);
#pragma unroll
    for (int i = 0; i < 4; ++i) p[i] = comb_c(0, p[2 * i], p[2 * i + 1], lane);
    p[0] = comb_c(1, p[0], p[1], lane); p[1] = comb_c(1, p[2], p[3], lane);
    return comb_c(2, p[0], p[1], lane);
}
DI u32x4 xquant(const f32x4 (&hv)[4], const float rstd) {
    u32x4 o;
#pragma unroll
    for (int w = 0; w < 4; ++w) {
        const f32x4 x = hv[w] * (rstd * XQ);
        const int a = (int)rintf(__builtin_amdgcn_fmed3f(x[0], -127.f, 127.f)), b = (int)rintf(__builtin_amdgcn_fmed3f(x[1], -127.f, 127.f)), c = (int)rintf(__builtin_amdgcn_fmed3f(x[2], -127.f, 127.f)), d = (int)rintf(__builtin_amdgcn_fmed3f(x[3], -127.f, 127.f));
        o[w] = ((unsigned)a & 0xFFu) | (((unsigned)b & 0xFFu) << 8) | (((unsigned)c & 0xFFu) << 16) | ((unsigned)d << 24);
    }
    return o;
}
DI float rstd_bcast(const float* part, const int t) {
    const f32x4* p = (const f32x4*)(part + (size_t)t * 16);
    const f32x4 a = p[0], b = p[1], c = p[2], d = p[3];
    const float s = ((a[0] + a[1]) + (a[2] + a[3])) + ((b[0] + b[1]) + (b[2] + b[3])) + ((c[0] + c[1]) + (c[2] + c[3])) + ((d[0] + d[1]) + (d[2] + d[3]));
    return 1.f / sqrtf(s * (1.f / DM) + EPS);
}
DI int dot32_i4(const u32x4 r, const u32x4 xh, const u32x4 xl) {
    int ah = 0, al = 0;
#pragma unroll
    for (int d = 0; d < 4; ++d) { ah = __builtin_amdgcn_sdot8((int)r[d], (int)xh[d], ah, false); al = __builtin_amdgcn_sdot8((int)r[d], (int)xl[d], al, false); }
    return (ah << 4) + al;
}
DI int half_dots4(const u32x4 (&rows)[8], const u32x4 xa, const u32x4 xb, const int lane) {
    int p[8];
#pragma unroll
    for (int i = 0; i < 8; ++i) p[i] = dot32_i4(rows[i], xa, xb);
#pragma unroll
    for (int i = 0; i < 4; ++i) p[i] = comb_c(0, p[2 * i], p[2 * i + 1], lane);
    p[0] = comb_c(1, p[0], p[1], lane); p[1] = comb_c(1, p[2], p[3], lane);
    return comb_c(2, p[0], p[1], lane);
}
DI void gather_u(Frame& F, const int layer, const XInfo xi, const bool dry) {
    FRAME_IDS;
    const unsigned emask = (dry && PROBE_MODE == 2) ? 15u : ((dry && PROBE_MODE == 5) ? 4095u : 0xFFFFFFFFu);
    const int* eidx = (const int*)(F.ws + WS_EIDX); int* PU = (int*)(F.ws + (dry ? WS_R : WS_PU)); const float* part = (const float*)(F.ws + WS_PART); const bf16* hbp = (const bf16*)(F.ws + WS_XB);
    const int g = f_lane >> 3, c = f_lane & 7, c16 = c * 16;
    const int kst = 16 * g + (((c & 1) << 2) | (c & 2) | ((c & 4) >> 2));
    const int gwl = xi.rank * NWAVES + F.wave, NGWL = xi.nloc * NWAVES;
    LAS unsigned char* wl = F.lds + F.wave * 2048;
    __syncthreads();
    for (int j = xi.xrank; j < 8; j += xi.nx) {
        const int sl = j & 3, th = j >> 2;
        const __amdgpu_buffer_rsrc_t U8 = __builtin_amdgcn_make_buffer_rsrc((void*)(F.ws + WS_U8 + ((size_t)(layer * 4 + sl) * PE) * 128), 0, PE * 128, 0x00020000);
        int tt = gwl;
        if (tt >= T / 2) continue;
#define TOK(x_) (2 * (x_) + th)
#define U_LOAD(tk, ri, rh, rp) do { ri = *(const u32x2*)(eidx + (size_t)(tk) * NSEL + 2 * f_lane) & emask; rh = *(const u32x2*)(hbp + (size_t)(tk) * DM + 256 * sl + 4 * f_lane); \
            rp = part[(size_t)(tk) * 16 + (f_lane & 15)]; } while (0)
#define U_SPREAD(slot, ri, rh, rp, e, xa_, xb_) do { \
            float ps_ = rp; ps_ += __int_as_float(DPP_MOV_I(__float_as_int(ps_), DPP_XOR1)); ps_ += __int_as_float(DPP_MOV_I(__float_as_int(ps_), DPP_XOR2)); ps_ += __int_as_float(DPP_MOV_I(__float_as_int(ps_), DPP_HMIRROR)); ps_ += __int_as_float(DPP_MOV_I(__float_as_int(ps_), DPP_ROR8)); \
            const float rs_ = (1.f / sqrtf(ps_ * (1.f / DM) + EPS)) * XQ; \
            const int q0_ = (int)rintf(__builtin_amdgcn_fmed3f(__uint_as_float(rh[0] << 16) * rs_, -119.f, 119.f)), q1_ = (int)rintf(__builtin_amdgcn_fmed3f(__uint_as_float(rh[0] & 0xffff0000u) * rs_, -119.f, 119.f)); \
            const int q2_ = (int)rintf(__builtin_amdgcn_fmed3f(__uint_as_float(rh[1] << 16) * rs_, -119.f, 119.f)), q3_ = (int)rintf(__builtin_amdgcn_fmed3f(__uint_as_float(rh[1] & 0xffff0000u) * rs_, -119.f, 119.f)); \
            const int h0_ = (q0_ + 8) >> 4, h1_ = (q1_ + 8) >> 4, h2_ = (q2_ + 8) >> 4, h3_ = (q3_ + 8) >> 4;     \
            unsigned wh_ = ((unsigned)h0_ & 0xFu) | (((unsigned)h1_ & 0xFu) << 8) | (((unsigned)h2_ & 0xFu) << 16) | (((unsigned)h3_ & 0xFu) << 24); \
            unsigned wl_ = ((unsigned)(q0_ - 16 * h0_) & 0xFu) | (((unsigned)(q1_ - 16 * h1_) & 0xFu) << 8) | (((unsigned)(q2_ - 16 * h2_) & 0xFu) << 16) | (((unsigned)(q3_ - 16 * h3_) & 0xFu) << 24); \
            if (f_lane & 1) { wh_ <<= 4; wl_ <<= 4; } \
            wh_ |= (unsigned)DPP_MOV_I((int)wh_, DPP_XOR1); wl_ |= (unsigned)DPP_MOV_I((int)wl_, DPP_XOR1); \
            LAS unsigned char* sl_ = wl + (slot) * 1024; \
            *(LAS u32x2*)(sl_ + 8 * f_lane) = ri; if (!(f_lane & 1)) { *(LAS unsigned*)(sl_ + 512 + 2 * f_lane) = wh_; *(LAS unsigned*)(sl_ + 768 + 2 * f_lane) = wl_; } \
            asm volatile("s_waitcnt lgkmcnt(0)" ::: "memory"); \
            _Pragma("unroll") for (int q_ = 0; q_ < 4; ++q_) e[q_] = *(const LAS u32x4*)(sl_ + 64 * g + 16 * q_); \
            xa_ = *(const LAS u32x4*)(sl_ + 512 + 16 * c); xb_ = *(const LAS u32x4*)(sl_ + 768 + 16 * c); } while (0)
        u32x2 ri, rh; float rp;
        u32x4 e0[4], e1[4], xa, xb, xa1, xb1;
        U_LOAD(TOK(tt), ri, rh, rp); U_SPREAD(0, ri, rh, rp, e0, xa, xb);
        { const int t1 = (tt + NGWL < T / 2) ? tt + NGWL : tt; U_LOAD(TOK(t1), ri, rh, rp); U_SPREAD(1, ri, rh, rp, e1, xa1, xb1); }
        { const int t2 = (tt + 2 * NGWL < T / 2) ? tt + 2 * NGWL : tt; U_LOAD(TOK(t2), ri, rh, rp); }
        u32x4 A0[8], B0[8], A1[8], B1[8];
#pragma unroll
        for (int i = 0; i < 8; ++i) A0[i] = __builtin_amdgcn_raw_buffer_load_b128(U8, (int)e0[i >> 2][i & 3] * 128 + c16, 0, 0);
#pragma unroll
        for (int i = 0; i < 8; ++i) B0[i] = __builtin_amdgcn_raw_buffer_load_b128(U8, (int)e0[2 + (i >> 2)][i & 3] * 128 + c16, 0, 0);
#define U_ITEM(CA, CB, NA, NB, slot) do { \
            _Pragma("unroll") for (int i = 0; i < 8; ++i) NA[i] = __builtin_amdgcn_raw_buffer_load_b128(U8, (int)e1[i >> 2][i & 3] * 128 + c16, 0, 0); \
            asm volatile("" ::: "memory"); \
            const int r0 = half_dots4(CA, xa, xb, f_lane); \
            _Pragma("unroll") for (int i = 0; i < 8; ++i) NB[i] = __builtin_amdgcn_raw_buffer_load_b128(U8, (int)e1[2 + (i >> 2)][i & 3] * 128 + c16, 0, 0); \
            asm volatile("" ::: "memory"); \
            const int rr1 = half_dots4(CB, xa, xb, f_lane); \
            int* pp = PU + ((size_t)TOK(tt) * 4 + sl) * NSEL + kst; \
            pp[0] = r0; pp[8] = rr1; \
            xa = xa1; xb = xb1; \
            U_SPREAD(slot, ri, rh, rp, e1, xa1, xb1);                   \
            { const int t3 = (tt + 3 * NGWL < T / 2) ? tt + 3 * NGWL : tt; U_LOAD(TOK(t3), ri, rh, rp); } } while (0)
        for (;;) {
            U_ITEM(A0, B0, A1, B1, 0); tt += NGWL; if (tt >= T / 2) break;
            U_ITEM(A1, B1, A0, B0, 1); tt += NGWL; if (tt >= T / 2) break;
        }
#undef U_ITEM
#undef U_LOAD
#undef U_SPREAD
#undef TOK
    }
    __syncthreads();
}
DI void gather_r(Frame& F, const int layer) {
    FRAME_IDS;
    const int* PU = (const int*)(F.ws + WS_PU); const float* gate = (const float*)(F.ws + WS_GATE); const int* eidx = (const int*)(F.ws + WS_EIDX);
    const float* SCu = (const float*)(F.ws + WS_SC) + (size_t)layer * PE; const float* SCv = (const float*)(F.ws + WS_SC) + (size_t)(2 + layer) * PE;
    signed char* A8 = (signed char*)(F.ws + WS_A); float* SA = (float*)(F.ws + WS_SA);
    const int gw = F.bid * NWAVES + F.wave, NGW = F.G * NWAVES;
    for (int t = gw; t < T; t += NGW) {
        float a[2];
#pragma unroll
        for (int hf = 0; hf < 2; ++hf) {
            const int k = 64 * hf + f_lane;
            int sacc = 0;
#pragma unroll
            for (int j = 0; j < 4; ++j) sacc += PU[((size_t)t * 4 + j) * NSEL + k];
            const int e = eidx[(size_t)t * NSEL + k];
            const float d = (float)sacc * (SCu[e] * (1.f / XQ));
            a[hf] = gelu_erf(d) * gate[(size_t)t * NSEL + k] * SCv[e];
        }
        const float am = wave_max(fmaxf(fabsf(a[0]), fabsf(a[1])));
        const float sc = am > 0.f ? 127.f / am : 0.f;
        A8[(size_t)t * NSEL + f_lane] = (signed char)(int)rintf(a[0] * sc);
        A8[(size_t)t * NSEL + 64 + f_lane] = (signed char)(int)rintf(a[1] * sc);
        if (f_lane == 0) SA[t] = am * (1.f / 127.f);
    }
}
DI void tr4x4(const unsigned w0, const unsigned w1, const unsigned w2, const unsigned w3, unsigned (&cdw)[4]) {
    const unsigned t01l = __builtin_amdgcn_perm(w1, w0, 0x05010400u), t01h = __builtin_amdgcn_perm(w1, w0, 0x07030602u);
    const unsigned t23l = __builtin_amdgcn_perm(w3, w2, 0x05010400u), t23h = __builtin_amdgcn_perm(w3, w2, 0x07030602u);
    cdw[0] = __builtin_amdgcn_perm(t23l, t01l, 0x05040100u); cdw[1] = __builtin_amdgcn_perm(t23l, t01l, 0x07060302u);
    cdw[2] = __builtin_amdgcn_perm(t23h, t01h, 0x05040100u); cdw[3] = __builtin_amdgcn_perm(t23h, t01h, 0x07060302u);
}
DI void axpy4rows(const u32x4 r0, const u32x4 r1, const u32x4 r2, const u32x4 r3, const unsigned a4, int (&ahi)[16], int (&aall)[16]) {
#pragma unroll
    for (int d = 0; d < 4; ++d) {
        unsigned cdw[4];
        tr4x4(r0[d], r1[d], r2[d], r3[d], cdw);
#pragma unroll
        for (int b = 0; b < 4; ++b) {
            aall[4 * d + b] = __builtin_amdgcn_sdot4((int)cdw[b], (int)a4, aall[4 * d + b], false);
            ahi[4 * d + b] = __builtin_amdgcn_sdot4((int)(cdw[b] & 0xF0F0F0F0u), (int)a4, ahi[4 * d + b], false);
        }
    }
}
DI void gather_v(Frame& F, const int layer, const XInfo xi, const bool dry) {
    FRAME_IDS;
    const int* eidx = (const int*)(F.ws + WS_EIDX); const unsigned char* A8 = F.ws + WS_A; const float* SA = (const float*)(F.ws + WS_SA);
    float* part_w = dry ? (float*)(F.ws + WS_R) : (float*)(F.ws + WS_PART); bf16* hb_w = dry ? (bf16*)(F.ws + WS_HID2) : (bf16*)(F.ws + WS_XB); const bf16* hbp = (const bf16*)(F.ws + WS_XB);
    const int g = f_lane >> 3, c = f_lane & 7, c16 = c * 16;
    const int cc = 32 * c + 16 * (g >> 2) + 8 * ((g >> 1) & 1) + 4 * (g & 1);
    const int gwl = xi.rank * NWAVES + F.wave, NGWL = xi.nloc * NWAVES;
    const bool b3 = (f_lane & 8) != 0;
    LAS unsigned char* wl = F.lds + F.wave * 2048;
    __syncthreads();
    for (int j = xi.xrank; j < 8; j += xi.nx) {
        const int sl = j & 3, th = j >> 2;
        const __amdgpu_buffer_rsrc_t V8 = __builtin_amdgcn_make_buffer_rsrc((void*)(F.ws + WS_V8 + ((size_t)(layer * 4 + sl) * PE) * 128), 0, PE * 128, 0x00020000);
        int tt = gwl;
        if (tt >= T / 2) continue;
#define TOK(x_) (2 * (x_) + th)
#define V_LOAD(tk, ri, ra, rs) do { ri = *(const u32x2*)(eidx + (size_t)(tk) * NSEL + 2 * f_lane); ra = *(const unsigned short*)(A8 + (size_t)(tk) * NSEL + 2 * f_lane); rs = SA[(tk)]; } while (0)
#define V_SPREAD(slot, ri, ra, rs, e, avv, sav) do { \
            LAS unsigned char* sl_ = wl + (slot) * 1024; \
            *(LAS u32x2*)(sl_ + 8 * f_lane) = ri; *(LAS unsigned short*)(sl_ + 512 + 2 * f_lane) = ra; \
            asm volatile("s_waitcnt lgkmcnt(0)" ::: "memory"); \
            _Pragma("unroll") for (int q_ = 0; q_ < 4; ++q_) e[q_] = *(const LAS u32x4*)(sl_ + 64 * g + 16 * q_); \
            avv = *(const LAS u32x4*)(sl_ + 512 + 16 * g); sav = rs; } while (0)
        u32x2 ri; unsigned short ra; float rs;
        u32x4 e0[4], e1[4], av, a1; float sa, sa1; u32x2 hold;
        V_LOAD(TOK(tt), ri, ra, rs); V_SPREAD(0, ri, ra, rs, e0, av, sa);
        { const int t1 = (tt + NGWL < T / 2) ? tt + NGWL : tt; V_LOAD(TOK(t1), ri, ra, rs); V_SPREAD(1, ri, ra, rs, e1, a1, sa1); }
        { const int t2 = (tt + 2 * NGWL < T / 2) ? tt + 2 * NGWL : tt; V_LOAD(TOK(t2), ri, ra, rs); }
        hold = *(const u32x2*)(hbp + (size_t)TOK(tt) * DM + 256 * sl + cc);
        u32x4 A0[8], B0[8], A1[8], B1[8];
#pragma unroll
        for (int i = 0; i < 8; ++i) A0[i] = __builtin_amdgcn_raw_buffer_load_b128(V8, (int)e0[i >> 2][i & 3] * 128 + c16, 0, 0);
#pragma unroll
        for (int i = 0; i < 8; ++i) B0[i] = __builtin_amdgcn_raw_buffer_load_b128(V8, (int)e0[2 + (i >> 2)][i & 3] * 128 + c16, 0, 0);
#define V_ITEM(CA, CB, NA, NB, slot) do { \
            const int t1 = (tt + NGWL < T / 2) ? tt + NGWL : tt; \
            const u32x2 hold1 = *(const u32x2*)(hbp + (size_t)TOK(t1) * DM + 256 * sl + cc); \
            _Pragma("unroll") for (int i = 0; i < 8; ++i) NA[i] = __builtin_amdgcn_raw_buffer_load_b128(V8, (int)e1[i >> 2][i & 3] * 128 + c16, 0, 0); \
            asm volatile("" ::: "memory"); \
            int ahi[16], aall[16]; \
            _Pragma("unroll") for (int n = 0; n < 16; ++n) { ahi[n] = 0; aall[n] = 0; } \
            axpy4rows(CA[0], CA[1], CA[2], CA[3], av[0], ahi, aall); axpy4rows(CA[4], CA[5], CA[6], CA[7], av[1], ahi, aall); \
            _Pragma("unroll") for (int i = 0; i < 8; ++i) NB[i] = __builtin_amdgcn_raw_buffer_load_b128(V8, (int)e1[2 + (i >> 2)][i & 3] * 128 + c16, 0, 0); \
            asm volatile("" ::: "memory"); \
            axpy4rows(CB[0], CB[1], CB[2], CB[3], av[2], ahi, aall); axpy4rows(CB[4], CB[5], CB[6], CB[7], av[3], ahi, aall); \
            int sa8 = __builtin_amdgcn_sdot4(0x01010101, (int)av[0], 0, false); sa8 = __builtin_amdgcn_sdot4(0x01010101, (int)av[1], sa8, false); sa8 = __builtin_amdgcn_sdot4(0x01010101, (int)av[2], sa8, false); sa8 = __builtin_amdgcn_sdot4(0x01010101, (int)av[3], sa8, false); \
            sa8 *= 8; \
            int acc[32];                                                \
            _Pragma("unroll") for (int d_ = 0; d_ < 4; ++d_) _Pragma("unroll") for (int b_ = 0; b_ < 4; ++b_) { acc[8 * d_ + 4 + b_] = ahi[4 * d_ + b_]; acc[8 * d_ + b_] = (aall[4 * d_ + b_] - ahi[4 * d_ + b_] - sa8) << 4; } \
            int r16[16], r8[8]; float hv[4]; \
            _Pragma("unroll") for (int n = 0; n < 16; ++n) r16[n] = swap32_addi(acc[n], acc[16 + n]); \
            _Pragma("unroll") for (int n = 0; n < 8; ++n) r8[n] = swap16_addi(r16[n], r16[8 + n]); \
            _Pragma("unroll") for (int n = 0; n < 4; ++n) { const int keep = b3 ? r8[4 + n] : r8[n], send = b3 ? r8[n] : r8[4 + n]; hv[n] = (float)(keep + DPP_MOV_I(send, DPP_ROR8)) * sa; } \
            hv[0] += __uint_as_float(hold[0] << 16); hv[1] += __uint_as_float(hold[0] & 0xffff0000u); hv[2] += __uint_as_float(hold[1] << 16); hv[3] += __uint_as_float(hold[1] & 0xffff0000u); \
            const float ss = wave_sum_fast((hv[0] * hv[0] + hv[1] * hv[1]) + (hv[2] * hv[2] + hv[3] * hv[3])); \
            *(u32x2*)(hb_w + (size_t)TOK(tt) * DM + 256 * sl + cc) = (u32x2){cvtpk(hv[0], hv[1]), cvtpk(hv[2], hv[3])}; \
            if (f_lane == 0) part_w[(size_t)TOK(tt) * 16 + sl] = ss; \
            if (sl == 0 && f_lane >= 4 && f_lane < 16) part_w[(size_t)TOK(tt) * 16 + f_lane] = 0.f; \
            av = a1; sa = sa1; hold = hold1; \
            V_SPREAD(slot, ri, ra, rs, e1, a1, sa1); \
            { const int t3 = (tt + 3 * NGWL < T / 2) ? tt + 3 * NGWL : tt; V_LOAD(TOK(t3), ri, ra, rs); } } while (0)
        for (;;) {
            V_ITEM(A0, B0, A1, B1, 0); tt += NGWL; if (tt >= T / 2) break;
            V_ITEM(A1, B1, A0, B0, 1); tt += NGWL; if (tt >= T / 2) break;
        }
#undef V_ITEM
#undef V_LOAD
#undef V_SPREAD
#undef TOK
    }
    __syncthreads();
}
DI void final_norm(Frame& F) {
    FRAME_IDS;
    const float* part = (const float*)(F.ws + WS_PART); const bf16* hbp = (const bf16*)(F.ws + WS_XB);
    const int gw = F.bid * NWAVES + F.wave, NGW = F.G * NWAVES;
    for (int t = gw; t < T; t += NGW) {
        const float r = rstd_bcast(part, t);
        const u32x2* hp = (const u32x2*)(hbp + (size_t)t * DM) + f_lane;
        f32x4* op = (f32x4*)(F.out + (size_t)t * DM) + f_lane;
        const f32x4* gp = (const f32x4*)F.final_norm + f_lane;
#pragma unroll
        for (int q = 0; q < 4; ++q) { const u32x2 w = hp[64 * q];
            const f32x4 h = {__uint_as_float(w[0] << 16), __uint_as_float(w[0] & 0xffff0000u), __uint_as_float(w[1] << 16), __uint_as_float(w[1] & 0xffff0000u)};
            op[64 * q] = h * r * gp[64 * q]; }
    }
}
DI void opt_conv(Frame& F) {
    FRAME_IDS;
    const bf16* G = (const bf16*)(F.ws + WS_GLU); bf16* H2 = (bf16*)(F.ws + WS_HID2);
    LAS float* ys = (LAS float*)F.lds;
    f32x2 wt[CW];
#pragma unroll
    for (int j = 0; j < CW; ++j) wt[j] = *(const f32x2*)(F.conv_dw + j * DM + 2 * f_tid);
    const f32x2 bdw = *(const f32x2*)(F.conv_dw_b + 2 * f_tid);
    f32x4 lng[4], lnb[4];
#pragma unroll
    for (int k = 0; k < 4; ++k) { lng[k] = *(const f32x4*)(F.conv_ln_g + 256 * k + 4 * f_lane); lnb[k] = *(const f32x4*)(F.conv_ln_b + 256 * k + 4 * f_lane); }
    for (int it = F.bid; it < T / 128; it += F.G) {
        const int s0 = (it % (SEQ / 128)) * 128;
        const size_t row0 = (size_t)it * 128;
        const unsigned* gp = (const unsigned*)G + f_tid;
        f32x2 win[CW];
#pragma unroll
        for (int u = 0; u < CW - 1; ++u) { const int sp = s0 - (CW - 1) + u; const unsigned xv = sp >= 0 ? gp[(row0 - (CW - 1) + u) * 512] : 0u; win[u + 1] = (f32x2){__uint_as_float(xv << 16), __uint_as_float(xv & 0xffff0000u)}; }
        win[0] = (f32x2){0.f, 0.f};
        unsigned nx[CW], nn[CW];
#pragma unroll
        for (int u = 0; u < CW; ++u) nx[u] = (s0 + u < SEQ) ? gp[(row0 + u) * 512] : 0u;
        for (int bt = 0; bt < 5; ++bt) {
#pragma unroll
            for (int u = 0; u < CW; ++u) { const int sl = 31 * (bt + 1) + u; nn[u] = (bt < 4 && s0 + sl < SEQ) ? gp[(row0 + sl) * 512] : 0u; }
            __syncthreads();
#pragma unroll
            for (int u = 0; u < CW; ++u) {
                win[u] = (f32x2){__uint_as_float(nx[u] << 16), __uint_as_float(nx[u] & 0xffff0000u)};
                f32x2 a = bdw;
#pragma unroll
                for (int j = 0; j < CW; ++j) a = wt[j] * win[(u + 1 + j) % CW] + a;
                *(LAS f32x2*)(ys + u * DM + 2 * f_tid) = a;
            }
            __syncthreads();
            for (int u = F.wave; u < CW; u += NWAVES) {
                const int sl = 31 * bt + u;
                if (sl < 128) {
                    f32x4 v[4]; float sm = 0.f;
#pragma unroll
                    for (int k = 0; k < 4; ++k) { v[k] = *(const LAS f32x4*)(ys + u * DM + 256 * k + 4 * f_lane); sm += (v[k][0] + v[k][1]) + (v[k][2] + v[k][3]); }
                    const float mu = wave_sum(sm) * (1.f / DM);
                    float sq = 0.f;
#pragma unroll
                    for (int k = 0; k < 4; ++k) { v[k] = v[k] - mu; sq += (v[k][0] * v[k][0] + v[k][1] * v[k][1]) + (v[k][2] * v[k][2] + v[k][3] * v[k][3]); }
                    const float rs = 1.f / sqrtf(wave_sum(sq) * (1.f / DM) + EPS);
#pragma unroll
                    for (int k = 0; k < 4; ++k) {
                        f32x4 z = v[k] * rs * lng[k] + lnb[k];
#pragma unroll
                        for (int e = 0; e < 4; ++e) z[e] = z[e] / (1.f + __expf(-z[e]));
                        *(u32x2*)(H2 + (row0 + sl) * DM + 256 * k + 4 * f_lane) = (u32x2){cvtpk(z[0], z[1]), cvtpk(z[2], z[3])};
                    }
                }
            }
#pragma unroll
            for (int u = 0; u < CW; ++u) nx[u] = nn[u];
        }
    }
    __syncthreads();
}
enum Phase { PH_PREP = 0, PH_PREPW, PH_PROJ, PH_MIX, PH_WOUT, PH_Q0, PH_GU0, PH_GR0, PH_GV0, PH_W1, PH_CONV, PH_W2, PH_Q1, PH_GU1, PH_GR1, PH_GV1, PH_FINAL, PH_COUNT };
struct Args { const float* in[19]; float* out; unsigned char* ws; int ph_lo, ph_hi; };
#ifndef TEST_PHASE
#define TEST_PHASE -1
#endif

__global__ void __launch_bounds__(NTHR, 2) mega_fwd(Args args) {
    extern __shared__ __attribute__((aligned(16))) unsigned char lds[];
    Frame F;
    F.lds = (LAS unsigned char*)lds;
    F.wave = __builtin_amdgcn_readfirstlane((int)threadIdx.x >> 6); FRAME_IDS;
    F.G = gridDim.x; F.bid = blockIdx.x;
    F.x = args.in[0]; F.mix_norm = args.in[1]; F.ffn_norm = args.in[2]; F.final_norm = args.in[3]; F.w_in = args.in[4]; F.w_out = args.in[5]; F.rel_bias = args.in[6];
    F.conv_w1 = args.in[7]; F.conv_b1 = args.in[8]; F.conv_dw = args.in[9]; F.conv_dw_b = args.in[10]; F.conv_ln_g = args.in[11]; F.conv_ln_b = args.in[12];
    F.conv_w2 = args.in[13]; F.conv_b2 = args.in[14]; F.peer_wq = args.in[15]; F.peer_keys = args.in[16]; F.peer_u = args.in[17]; F.peer_v = args.in[18];
    F.out = args.out; F.ws = args.ws;
    volatile LAS unsigned* MISC = (volatile LAS unsigned*)(F.lds + MISC_OFF);
    for (int u = f_tid; u < (LDS_BYTES - LDSCTL_OFF) / 4; u += NTHR) ((LAS unsigned*)(F.lds + LDSCTL_OFF))[u] = 0u;
    __syncthreads();
    const int lo = args.ph_lo, hi = args.ph_hi;
    XcdBarrier bar; bar.bar = (unsigned*)(F.ws + WS_CTL) + CW_BAR; bar.x = 0; bar.st = nullptr;
    if (hi - lo > 1) bar = xcd_barrier_post((unsigned*)(F.ws + WS_CTL) + CW_BAR, MISC + 8);
#define IN(k) ((TEST_PHASE < 0 || TEST_PHASE == (k)) && lo <= (k) && (k) < hi)
#define SEAM(k) do { if (IN(k) && IN((k) + 1)) xcd_barrier(bar, F.wave); } while (0)
#define REPS(k) for (int rep_ = ((k) == REP_PHASE ? 0 : 1); rep_ < 2; ++rep_)
#define GEMM_PHASE(EPI, Aptr, Bptr, NN, ...) do { pg8::Gemm g{(const bf16*)(Aptr), (const bf16*)(Bptr), T, (NN), DM}; pg8::StaticOrder S; S.init(T, (NN), F.G, F.bid); \
        pg8::EPI E{__VA_ARGS__}; pg8::gemm_phase<pg8::EPI, pg8::StaticOrder, true, true>(F.lds, g, S, E, F.wave); } while (0)
    bf16* XB = (bf16*)(F.ws + WS_XB);
    float* PART = (float*)(F.ws + WS_PART); const float* ROPE = (const float*)(F.ws + WS_ROPE);
    if (IN(PH_PREP)) REPS(PH_PREP) { p0_prep(F); p0_weights(F, 0); } SEAM(PH_PREP);
    if (IN(PH_PREPW)) REPS(PH_PREPW) { p0_weights(F, 1); } SEAM(PH_PREPW);
    if (PROBE_MODE == 9 && IN(PH_PREP) && IN(PH_PREP + 1)) { for (int xb_ = 0; xb_ < 8; ++xb_) xcd_barrier(bar, F.wave); }
    if (IN(PH_PROJ)) REPS(PH_PROJ) { { pg8::Gemm g{(const bf16*)XB, (const bf16*)(F.ws + WS_WIN), T, INC, DM / 2}; pg8::StaticOrder S; S.init(T, INC, F.G, F.bid); pg8::EpiProj8 E{(bf16*)(F.ws + WS_R), ROPE, (const float*)(F.ws + WS_ROWSC), (const float*)(F.ws + WS_COLSC)}; pg8::gemm_phase<pg8::EpiProj8, pg8::StaticOrder, true, true, true>(F.lds, g, S, E, F.wave); } } SEAM(PH_PROJ);
    if (IN(PH_MIX)) REPS(PH_MIX) { mix_phase(F, rep_); } SEAM(PH_MIX);
    if (IN(PH_WOUT)) REPS(PH_WOUT) { GEMM_PHASE(EpiRes, F.ws + WS_O, F.ws + WS_WOUT, DM, F.x, XB, PART, nullptr); } SEAM(PH_WOUT);
    if (IN(PH_Q0)) REPS(PH_Q0) { GEMM_PHASE(EpiQ, XB, F.ws + WS_WQ, DM, (bf16*)(F.ws + WS_Q), PART); asm volatile("s_waitcnt vmcnt(0)" ::: "memory"); __syncthreads(); opt_route(F, 0); } SEAM(PH_Q0);
    const bool census = (hi - lo > 1);
    if (IN(PH_GU0)) REPS(PH_GU0) { gather_u(F, 0, get_xinfo(F, census), rep_ == 0); } SEAM(PH_GU0);
    if (IN(PH_GR0)) REPS(PH_GR0) { gather_r(F, 0); } SEAM(PH_GR0);
    if (IN(PH_GV0)) REPS(PH_GV0) { gather_v(F, 0, get_xinfo(F, census), rep_ == 0); } SEAM(PH_GV0);
    if (IN(PH_W1)) REPS(PH_W1) { GEMM_PHASE(EpiGlu, XB, F.ws + WS_W1, 2 * DM, (bf16*)(F.ws + WS_GLU), PART, F.conv_b1); } SEAM(PH_W1);
    if (IN(PH_CONV)) REPS(PH_CONV) { opt_conv(F); } SEAM(PH_CONV);
    if (IN(PH_W2)) { GEMM_PHASE(EpiRes, F.ws + WS_HID2, F.ws + WS_W2, DM, nullptr, XB, PART, F.conv_b2); } SEAM(PH_W2);
    if (IN(PH_Q1)) REPS(PH_Q1) { GEMM_PHASE(EpiQ, XB, F.ws + WS_WQ + (size_t)DM * DM * 2, DM, (bf16*)(F.ws + WS_Q), PART); asm volatile("s_waitcnt vmcnt(0)" ::: "memory"); __syncthreads(); opt_route(F, 1); } SEAM(PH_Q1);
    if (IN(PH_GU1)) REPS(PH_GU1) { gather_u(F, 1, get_xinfo(F, census), rep_ == 0); } SEAM(PH_GU1);
    if (IN(PH_GR1)) REPS(PH_GR1) { gather_r(F, 1); } SEAM(PH_GR1);
    if (IN(PH_GV1)) REPS(PH_GV1) { gather_v(F, 1, get_xinfo(F, census), rep_ == 0); } SEAM(PH_GV1);
    if (IN(PH_FINAL)) { final_norm(F); }
#undef IN
#undef SEAM
}

extern "C" void kernel_launch(void* const* d_in, const int* in_sizes, int n_in, void* d_out, int out_size, void* d_ws, size_t ws_size, hipStream_t stream) {
    static int grid = 0;
    if (grid == 0) {
        if (n_in != 19 || out_size != T * DM || ws_size < WS_END) { fprintf(stderr, "kernel_launch: unexpected shapes (n_in %d out %d ws %zu)\n", n_in, out_size, ws_size); grid = -1; return; }
        int dev = 0, cus = 0;
        if (hipGetDevice(&dev) != hipSuccess || hipDeviceGetAttribute(&cus, hipDeviceAttributeMultiprocessorCount, dev) != hipSuccess) { grid = -1; return; }
        if (hipFuncSetAttribute((const void*)mega_fwd, hipFuncAttributeMaxDynamicSharedMemorySize, LDS_BYTES) != hipSuccess) { fprintf(stderr, "kernel_launch: hipFuncSetAttribute failed\n"); grid = -1; return; }
        (void)hipGetLastError();
        grid = cus;
    }
    if (grid < 0) return;
    (void)hipMemsetAsync((char*)d_ws + WS_CTL, 0, CTL_ZERO_BYTES, stream);
    Args a{};
    for (int i = 0; i < 19; ++i) a.in[i] = (const float*)d_in[i];
    a.out = (float*)d_out; a.ws = (unsigned char*)d_ws;
#if MK_ONE_LAUNCH
    a.ph_lo = 0; a.ph_hi = PH_COUNT;
    hipLaunchKernelGGL(mega_fwd, dim3(grid), dim3(NTHR), LDS_BYTES, stream, a);
#else
    for (int p = 0; p < PH_COUNT; ++p) { a.ph_lo = p; a.ph_hi = p + 1; hipLaunchKernelGGL(mega_fwd, dim3(grid), dim3(NTHR), LDS_BYTES, stream, a); }
#endif
}
```

```cpp
#include <hip/hip_runtime.h>
#include <cstdio>
#include <cstdint>

#ifndef REP_PHASE
#define REP_PHASE -1
#endif
#ifndef PROBE_MODE
#define PROBE_MODE 1
#endif
#ifndef MK_ONE_LAUNCH
#define MK_ONE_LAUNCH 1
#endif

#define GAS __attribute__((address_space(1)))
#define LAS __attribute__((address_space(3)))
#define DI __device__ __forceinline__
typedef unsigned short bf16;
typedef float f32x2 __attribute__((ext_vector_type(2)));
typedef float f32x4 __attribute__((ext_vector_type(4)));
typedef unsigned u32x2 __attribute__((ext_vector_type(2)));
typedef unsigned u32x4 __attribute__((ext_vector_type(4)));
typedef short bf16x8 __attribute__((ext_vector_type(8)));
typedef float f32x16 __attribute__((ext_vector_type(16)));

constexpr int NB = 16, SEQ = 2048, DM = 1024, T = NB * SEQ;
constexpr int CHUNK = 64, HD = 64, NHA = 8, NHB = 8, INC = 3584, NCH = SEQ / CHUNK;
constexpr int PH = 8, PK = 128, PE = PK * PK, PQD = 128, PTOP = 16, NSEL = PH * PTOP;
constexpr int CW = 31;
constexpr float EPS = 1e-6f;
constexpr float LOG2E = 1.4426950408889634f;
constexpr float XQ = 127.f / 6.f;
constexpr int NWAVES = 8, NTHR = NWAVES * 64;

constexpr int C_QA = 0, C_KA = 512, C_VA = 1024, C_QB = 1536, C_KB = 2048, C_VB = 2560, C_GB = 3072;

constexpr size_t MiB = 1u << 20;
constexpr size_t WS_CTL = 0, CTL_ZERO_BYTES = 1 * MiB;
constexpr size_t WS_WIN = 2 * MiB, WS_WOUT = 9 * MiB, WS_W1 = 11 * MiB, WS_W2 = 15 * MiB, WS_WQ = 17 * MiB;
constexpr size_t WS_ROPE = 22 * MiB;
constexpr size_t WS_PART = 23 * MiB;
constexpr size_t WS_EIDX = 26 * MiB;
constexpr size_t WS_GATE = 42 * MiB;
constexpr size_t WS_U8 = 64 * MiB, WS_V8 = 96 * MiB;
constexpr size_t WS_SC = 25 * MiB;
constexpr size_t WS_ROWSC = 59 * MiB;
constexpr size_t WS_COLSC = 60 * MiB;
constexpr size_t WS_SA = 58 * MiB;
constexpr size_t WS_PU = 256 * MiB;
constexpr size_t WS_A = 384 * MiB;
constexpr size_t WS_XB = 128 * MiB;
constexpr size_t WS_R = 192 * MiB;
constexpr size_t WS_O = 416 * MiB;
constexpr size_t WS_Q = 192 * MiB;
constexpr size_t WS_HID = 256 * MiB;
constexpr size_t WS_GLU = 384 * MiB;
constexpr size_t WS_HID2 = 448 * MiB;
constexpr size_t WS_END = 512 * MiB;
constexpr int CW_BAR = 4096, CW_QUEUE = 8192;

constexpr int RING_BYTES = 131072, LDSCTL_OFF = RING_BYTES, MISC_OFF = LDSCTL_OFF + 320, LDS_BYTES = 147456;

DI float bf2f(bf16 v) { return __uint_as_float(((unsigned)v) << 16); }
DI unsigned f2bf(float f) { unsigned u = __float_as_uint(f); return (u + 0x7fffu + ((u >> 16) & 1u)) >> 16; }
DI unsigned pk2(float lo, float hi) { return f2bf(lo) | (f2bf(hi) << 16); }
#define DPP_MOV_I(x, ctrl) __builtin_amdgcn_mov_dpp((x), (ctrl), 0xF, 0xF, false)
#define DPP_XOR1 0xB1
#define DPP_XOR2 0x4E
#define DPP_HMIRROR 0x141
#define DPP_ROR8 0x128
DI float swap32_add(const float a, const float b) { const auto r = __builtin_amdgcn_permlane32_swap(__float_as_uint(a), __float_as_uint(b), false, false); return __uint_as_float(r[0]) + __uint_as_float(r[1]); }
DI float swap16_add(const float a, const float b) { const auto r = __builtin_amdgcn_permlane16_swap(__float_as_uint(a), __float_as_uint(b), false, false); return __uint_as_float(r[0]) + __uint_as_float(r[1]); }
DI int swap32_addi(const int a, const int b) { const auto r = __builtin_amdgcn_permlane32_swap((unsigned)a, (unsigned)b, false, false); return (int)(r[0] + r[1]); }
DI int swap16_addi(const int a, const int b) { const auto r = __builtin_amdgcn_permlane16_swap((unsigned)a, (unsigned)b, false, false); return (int)(r[0] + r[1]); }
DI float wave_sum_fast(float v) {
    v += __int_as_float(DPP_MOV_I(__float_as_int(v), DPP_XOR1)); v += __int_as_float(DPP_MOV_I(__float_as_int(v), DPP_XOR2));
    v += __int_as_float(DPP_MOV_I(__float_as_int(v), DPP_HMIRROR)); v += __int_as_float(DPP_MOV_I(__float_as_int(v), DPP_ROR8));
    v = swap16_add(v, v); v = swap32_add(v, v);
    return v;
}
DI float wave_sum(float v) { return wave_sum_fast(v); }
DI float swap32_max(const float a) { const auto r = __builtin_amdgcn_permlane32_swap(__float_as_uint(a), __float_as_uint(a), false, false); return fmaxf(__uint_as_float(r[0]), __uint_as_float(r[1])); }
DI float swap16_max(const float a) { const auto r = __builtin_amdgcn_permlane16_swap(__float_as_uint(a), __float_as_uint(a), false, false); return fmaxf(__uint_as_float(r[0]), __uint_as_float(r[1])); }
DI float wave_max(float v) {
    v = fmaxf(v, __int_as_float(DPP_MOV_I(__float_as_int(v), DPP_XOR1))); v = fmaxf(v, __int_as_float(DPP_MOV_I(__float_as_int(v), DPP_XOR2)));
    v = fmaxf(v, __int_as_float(DPP_MOV_I(__float_as_int(v), DPP_HMIRROR))); v = fmaxf(v, __int_as_float(DPP_MOV_I(__float_as_int(v), DPP_ROR8)));
    v = swap16_max(v); v = swap32_max(v);
    return v;
}
DI float block_sum(float v, LAS float* red, int tid) {
    v = wave_sum(v);
    __syncthreads();
    if ((tid & 63) == 0) red[tid >> 6] = v;
    __syncthreads();
    float s = 0.f;
#pragma unroll
    for (int i = 0; i < NWAVES; ++i) s += red[i];
    return s;
}
DI float gelu_erf(float x) { return 0.5f * x * (1.f + erff(x * 0.70710678118654752f)); }
DI float sigmoidf(float x) { return 1.f / (1.f + __expf(-x)); }

DI int lane_id() { int r; asm volatile("v_mbcnt_lo_u32_b32 %0, -1, 0\n\tv_mbcnt_hi_u32_b32 %0, -1, %0" : "=v"(r)); return r; }
#define XB_TMO      128
#define XB_XCNT(j)  (256  + 64 * (j))
#define XB_XSUB(j)  (1280 + 64 * (j))
#define XB_XGEN(j)  (2304 + 64 * (j))
#define XB_TOP      3328
#define XB_TOPGEN   3392
#define XCD_BAR_WORDS 3456
#define XB_SPIN_CAP (1u << 22)
DI unsigned xb_ld(unsigned* p)              { return __hip_atomic_load(p, __ATOMIC_RELAXED, __HIP_MEMORY_SCOPE_AGENT); }
DI unsigned xb_add(unsigned* p, unsigned v) { return __hip_atomic_fetch_add(p, v, __ATOMIC_RELAXED, __HIP_MEMORY_SCOPE_AGENT); }
DI unsigned xb_xcc_id() { return (unsigned)__builtin_amdgcn_s_getreg((3 << 11) | 20) & 0xFu; }
#define XB_SPIN(cond, bar) do { unsigned _sp = 0; while (cond) { __builtin_amdgcn_s_sleep(1); \
    if ((++_sp & 255u) == 0u) { if (xb_ld(&(bar)[XB_TMO])) break; if (_sp > XB_SPIN_CAP) { atomicAdd(&(bar)[XB_TMO], 1u); break; } } } } while (0)
struct XcdBarrier { unsigned* bar; unsigned x; volatile LAS unsigned* st; };
DI XcdBarrier xcd_barrier_post(unsigned* bar, volatile LAS unsigned* st) {
    XcdBarrier b; b.bar = bar; b.x = xb_xcc_id(); b.st = st;
    if (threadIdx.x == 0) st[4] = xb_add(&bar[XB_XCNT(b.x)], 1u);
    return b;
}
DI void xcd_barrier_complete(unsigned* bar, unsigned x, unsigned& nloc, unsigned& nx) {
    const unsigned G = gridDim.x * gridDim.y * gridDim.z;
    unsigned sum, cnt, mine, sp = 0u;
    for (;;) {
        sum = 0u; cnt = 0u; mine = 0u;
#pragma unroll
        for (unsigned j = 0; j < 16; ++j) { const unsigned c = xb_ld(&bar[XB_XCNT(j)]); sum += c; cnt += (c > 0u) ? 1u : 0u; mine = (j == x) ? c : mine; }
        if (sum == G) break;
        __builtin_amdgcn_s_sleep(1);
        if ((++sp & 255u) == 0u) { if (xb_ld(&bar[XB_TMO])) break; if (sp > XB_SPIN_CAP) { atomicAdd(&bar[XB_TMO], 1u); break; } }
    }
    nloc = mine > 0u ? mine : 1u; nx = cnt > 0u ? cnt : 1u;
}
DI void xcd_barrier(const XcdBarrier& b, const int wave_id) {
    asm volatile("s_waitcnt vmcnt(0)" ::: "memory");
    __syncthreads();
    if (wave_id == 0 && lane_id() == 0) {
        unsigned* bar = b.bar;
        __builtin_amdgcn_s_waitcnt(0);
        unsigned nloc = b.st[0], nx = b.st[1];
        if (nloc == 0u) { xcd_barrier_complete(bar, b.x, nloc, nx); b.st[0] = nloc; b.st[1] = nx; }
        const unsigned old = xb_add(&bar[XB_XSUB(b.x)], 1u);
        const unsigned gen = old / nloc;
        if (old + 1u == (gen + 1u) * nloc) {
            __builtin_amdgcn_fence(__ATOMIC_RELEASE, "agent");
            asm volatile("s_waitcnt vmcnt(0)" ::: "memory");
            const unsigned og = xb_add(&bar[XB_TOP], 1u);
            const unsigned tg = og / nx;
            if (og + 1u == (tg + 1u) * nx) xb_add(&bar[XB_TOPGEN], 1u);
            else XB_SPIN(xb_ld(&bar[XB_TOPGEN]) == tg, bar);
            __builtin_amdgcn_fence(__ATOMIC_ACQUIRE, "agent");
            xb_add(&bar[XB_XGEN(b.x)], 1u);
            asm volatile("s_waitcnt vmcnt(0)" ::: "memory");
        } else {
            XB_SPIN(xb_ld(&bar[XB_XGEN(b.x)]) == gen, bar);
            __builtin_amdgcn_fence(__ATOMIC_ACQUIRE, "agent");
            asm volatile("s_waitcnt vmcnt(0)" ::: "memory");
        }
    }
    __syncthreads();
}

namespace pg8 {
#define PG8_LAS __attribute__((address_space(3)))
typedef unsigned short bf16_t;
typedef short bf16x8 __attribute__((ext_vector_type(8)));
typedef float f32x4 __attribute__((ext_vector_type(4)));
typedef unsigned u32x4 __attribute__((ext_vector_type(4)));
typedef int i32x4 __attribute__((ext_vector_type(4)));
constexpr int BM = 256, BK = 64, HALF = 128, HTB = HALF * BK * 2  , STAGE_BYTES = 8 * HTB, NXCD = 8, WGM = 8;

__host__ __device__ __forceinline__ int lds_byte(int r, int c) { const int st = (r >> 4) * 2 + (c >> 5), rr = r & 15, cc = c & 31, ob = rr * 64 + cc * 2; return st * 1024 + (ob ^ (((ob >> 9) & 1) << 5)); }
__host__ __device__ __forceinline__ void stage_rc(int b, int& R, int& C) { const int st = b / 1024, sb = b % 1024, swz = sb ^ (((sb >> 9) & 1) << 5); R = (st >> 1) * 16 + swz / 64; C = (st & 1) * 32 + (swz % 64) / 2; }
__host__ __device__ __forceinline__ int perm32(int rho) { const int n = rho >> 4, i = rho & 15; return 8 * (i >> 2) + 4 * n + (i & 3); }

struct Unit { int pm, pn; };
struct Gemm { const bf16_t* A; const bf16_t* Bt; int M, N, K; };

struct StaticOrder {
    int nM, nN, nwg, G, c;
    __host__ __device__ void init(int M, int N, int G_, int c_) { nM = M / BM; nN = N / BM; nwg = nM * nN; G = G_; c = c_; }
    __host__ __device__ bool next(int i, Unit& u) const {
        const long L = (long)i * G + c; if (L >= nwg) return false;
        int wgid = (int)L; { const int q = nwg / NXCD, r = nwg % NXCD, xcd = wgid % NXCD, off = wgid / NXCD; wgid = (xcd < r ? xcd * (q + 1) : r * (q + 1) + (xcd - r) * q) + off; }
        const int nig = WGM * nN, gid = wgid / nig, fm = gid * WGM, gsz = (nM - fm) < WGM ? (nM - fm) : WGM;
        u.pm = fm + ((wgid % nig) % gsz); u.pn = (wgid % nig) / gsz; return true;
    }
    __device__ __forceinline__ void a_ready(const Unit&) const {}
    __device__ __forceinline__ void done(const Unit&) const {}
};

__device__ __forceinline__ unsigned cvt_pk_bf16(float lo, float hi) { unsigned r; asm volatile("v_cvt_pk_bf16_f32 %0, %1, %2" : "=v"(r) : "v"(lo), "v"(hi)); return r; }
__device__ __forceinline__ float rstd16(const float* part, int r, int fq) {
    const f32x4 a = *(const f32x4*)(part + (size_t)r * 16 + 4 * fq);
    float s = (a[0] + a[1]) + (a[2] + a[3]);
    s = swap16_add(s, s); s = swap32_add(s, s);
    return 1.f / sqrtf(s * (1.f / 1024.f) + 1e-6f);
}
__device__ __forceinline__ u32x4 pack8(const f32x4 a, const f32x4 b) { u32x4 w; w.x = cvt_pk_bf16(a[0], a[1]); w.y = cvt_pk_bf16(a[2], a[3]); w.z = cvt_pk_bf16(b[0], b[1]); w.w = cvt_pk_bf16(b[2], b[3]); return w; }
#define rot(t1, t2, c, s) do { const float a_ = (t1) * (c) - (t2) * (s), b_ = (t1) * (s) + (t2) * (c); (t1) = a_; (t2) = b_; } while (0)

struct EpiProj8 {
    static constexpr bool PERM = true, AFTER_DRAIN = false;
    bf16_t* R; const float* rope; const float* rowsc; const float* colsc;
    __device__ __forceinline__ void operator()(const f32x4 (&acc)[2][2][4][2], const Unit& u, int wr, int wc, int fr, int fq) const {
        const int type = u.pn >> 1, hg = u.pn & 1;
        const int colbase = type * 512 + (4 * hg + wc) * 64 + 8 * fq;
        const bool do_rope = (type == 3) || (type == 4);
        f32x4 cs[2][2];
#pragma unroll
        for (int bj = 0; bj < 2; ++bj)
#pragma unroll
            for (int n = 0; n < 2; ++n) cs[bj][n] = *(const f32x4*)(colsc + u.pn * BM + bj * HALF + wc * 32 + 8 * fq + 4 * n);
#pragma unroll
        for (int ai = 0; ai < 2; ++ai)
#pragma unroll
            for (int m = 0; m < 4; ++m) {
                const int r = u.pm * BM + ai * HALF + wr * 64 + m * 16 + fr;
                const float rs = rowsc[r];
                f32x4 v[2][2];
#pragma unroll
                for (int bj = 0; bj < 2; ++bj)
#pragma unroll
                    for (int n = 0; n < 2; ++n) { const i32x4 ia = __builtin_bit_cast(i32x4, acc[ai][bj][m][n]);
                        v[bj][n] = (f32x4){(float)ia[0], (float)ia[1], (float)ia[2], (float)ia[3]} * cs[bj][n] * rs; }
                f32x4 a0 = v[0][0], a1 = v[0][1], b0 = v[1][0], b1 = v[1][1];
                if (do_rope) {
                    const f32x4* rp = (const f32x4*)(rope + ((size_t)(r & 2047) * 32 + 8 * fq) * 2);
                    const f32x4 c0 = rp[0], c1 = rp[1], c2 = rp[2], c3 = rp[3];
                    rot(a0[0], b0[0], c0[0], c0[1]); rot(a0[1], b0[1], c0[2], c0[3]); rot(a0[2], b0[2], c1[0], c1[1]); rot(a0[3], b0[3], c1[2], c1[3]);
                    rot(a1[0], b1[0], c2[0], c2[1]); rot(a1[1], b1[1], c2[2], c2[3]); rot(a1[2], b1[2], c3[0], c3[1]); rot(a1[3], b1[3], c3[2], c3[3]);
                }
                bf16_t* rowp = R + (size_t)r * 3584 + colbase;
                *(u32x4*)(rowp) = pack8(a0, a1);
                *(u32x4*)(rowp + 32) = pack8(b0, b1);
            }
    }
};
struct EpiRes {
    static constexpr bool PERM = true, AFTER_DRAIN = false;
    const float* xf; bf16_t* hb; float* part; const float* bias;
    __device__ __forceinline__ void operator()(const f32x4 (&acc)[2][2][4][2], const Unit& u, int wr, int wc, int fr, int fq) const {
        const int col0 = u.pn * BM + wc * 32 + 8 * fq;
        f32x4 bv[2][2];
#pragma unroll
        for (int bj = 0; bj < 2; ++bj)
#pragma unroll
            for (int n = 0; n < 2; ++n) bv[bj][n] = bias ? *(const f32x4*)(bias + col0 + bj * HALF + 4 * n) : (f32x4){0.f, 0.f, 0.f, 0.f};
#pragma unroll
        for (int ai = 0; ai < 2; ++ai)
#pragma unroll
            for (int m = 0; m < 4; ++m) {
                const int r = u.pm * BM + ai * HALF + wr * 64 + m * 16 + fr;
                const size_t off = (size_t)r * 1024 + col0;
                float ss = 0.f;
#pragma unroll
                for (int bj = 0; bj < 2; ++bj) {
                    f32x4 x0, x1;
                    if (xf) { x0 = *(const f32x4*)(xf + off + bj * HALF); x1 = *(const f32x4*)(xf + off + bj * HALF + 4); }
                    else { const u32x4 w = *(const u32x4*)(hb + off + bj * HALF);
                           x0 = (f32x4){__uint_as_float(w[0] << 16), __uint_as_float(w[0] & 0xffff0000u), __uint_as_float(w[1] << 16), __uint_as_float(w[1] & 0xffff0000u)};
                           x1 = (f32x4){__uint_as_float(w[2] << 16), __uint_as_float(w[2] & 0xffff0000u), __uint_as_float(w[3] << 16), __uint_as_float(w[3] & 0xffff0000u)}; }
                    const f32x4 h0 = x0 + acc[ai][bj][m][0] + bv[bj][0], h1 = x1 + acc[ai][bj][m][1] + bv[bj][1];
                    *(u32x4*)(hb + off + bj * HALF) = pack8(h0, h1);
                    ss += (h0[0] * h0[0] + h0[1] * h0[1]) + (h0[2] * h0[2] + h0[3] * h0[3]) + (h1[0] * h1[0] + h1[1] * h1[1]) + (h1[2] * h1[2] + h1[3] * h1[3]);
                }
                ss = swap16_add(ss, ss); ss = swap32_add(ss, ss);
                if (fq == 0) part[(size_t)r * 16 + 4 * u.pn + wc] = ss;
            }
    }
};
struct EpiQ {
    static constexpr bool PERM = true, AFTER_DRAIN = false;
    bf16_t* O; const float* part;
    __device__ __forceinline__ void operator()(const f32x4 (&acc)[2][2][4][2], const Unit& u, int wr, int wc, int fr, int fq) const {
        const int col0 = u.pn * BM + wc * 32 + 8 * fq;
#pragma unroll
        for (int ai = 0; ai < 2; ++ai)
#pragma unroll
            for (int m = 0; m < 4; ++m) {
                const int r = u.pm * BM + ai * HALF + wr * 64 + m * 16 + fr;
                const float rs = rstd16(part, r, fq);
                bf16_t* rowp = O + (size_t)r * 1024 + col0;
#pragma unroll
                for (int bj = 0; bj < 2; ++bj) *(u32x4*)(rowp + bj * HALF) = pack8(acc[ai][bj][m][0] * rs, acc[ai][bj][m][1] * rs);
            }
    }
};
struct EpiGlu {
    static constexpr bool PERM = true, AFTER_DRAIN = false;
    bf16_t* G; const float* part; const float* b1;
    __device__ __forceinline__ void operator()(const f32x4 (&acc)[2][2][4][2], const Unit& u, int wr, int wc, int fr, int fq) const {
        const int col = u.pn * 128 + wc * 32 + 8 * fq;
        f32x4 ba[2], bg[2];
#pragma unroll
        for (int n = 0; n < 2; ++n) { ba[n] = *(const f32x4*)(b1 + col + 4 * n); bg[n] = *(const f32x4*)(b1 + 1024 + col + 4 * n); }
#pragma unroll
        for (int ai = 0; ai < 2; ++ai)
#pragma unroll
            for (int m = 0; m < 4; ++m) {
                const int r = u.pm * BM + ai * HALF + wr * 64 + m * 16 + fr;
                const float rs = rstd16(part, r, fq);
                f32x4 y[2];
#pragma unroll
                for (int n = 0; n < 2; ++n) {
                    const f32x4 a = acc[ai][0][m][n] * rs + ba[n], g = acc[ai][1][m][n] * rs + bg[n];
#pragma unroll
                    for (int i = 0; i < 4; ++i) y[n][i] = a[i] / (1.f + __expf(-g[i]));
                }
                *(u32x4*)(G + (size_t)r * 1024 + col) = pack8(y[0], y[1]);
            }
    }
};
template <class Epi, class Sched, bool ALIGN_EPI = false, bool SP2 = false, bool I8 = false>
__device__ __forceinline__ void gemm_phase(PG8_LAS unsigned char* lds, const Gemm g, const Sched& S, const Epi& E, const int wave_id) {
    const int lane = lane_id(), wid = wave_id, tid = wid * 64 + lane, wr = wid >> 2, wc = wid & 3, fr = lane & 15, fq = lane >> 4;
    const int K = g.K, nt = K / BK;
    unsigned voffA[2], voffB[2];
#pragma unroll
    for (int i = 0; i < 2; ++i) { int R, C; stage_rc(tid * 16 + i * 8192, R, C); const int Rb = Epi::PERM ? ((R & ~31) + perm32(R & 31)) : R;
        voffA[i] = (unsigned)(R * K + C) * 2u; voffB[i] = (unsigned)(Rb * K + C) * 2u; }
    const size_t kstep = (size_t)(BK * 2);
    const size_t hstep = (size_t)HALF * K * 2;
    const size_t tstep = 2 * hstep;
    const unsigned ldsw = (unsigned)wid * 1024u;
    const int aoff = lds_byte(wr * 64 + fr, fq * 8), boff = lds_byte(wc * 32 + fr, fq * 8);
#define PG8_SA(b, h) (((b) * 2 + (h)) * HTB)
#define PG8_SB(b, h) ((4 + (b) * 2 + (h)) * HTB)
#define PG8_STAGE(bufoff, gbase, voff) do { _Pragma("unroll") for (int _i = 0; _i < 2; ++_i) \
        __builtin_amdgcn_global_load_lds((const unsigned*)((const char*)(gbase) + (voff)[_i]), (PG8_LAS unsigned*)(lds + (bufoff) + ldsw + _i * 8192), 16, 0, 0); } while (0)
#define PG8_LDA(dst, b, h) do { _Pragma("unroll") for (int m = 0; m < 4; ++m) _Pragma("unroll") for (int k = 0; k < 2; ++k) dst[m][k] = *(const PG8_LAS bf16x8*)(lds + PG8_SA(b, h) + aoff + m * 2048 + k * 1024); } while (0)
#define PG8_LDB(dst, b, h) do { _Pragma("unroll") for (int n = 0; n < 2; ++n) _Pragma("unroll") for (int k = 0; k < 2; ++k) dst[n][k] = *(const PG8_LAS bf16x8*)(lds + PG8_SB(b, h) + boff + n * 2048 + k * 1024); } while (0)
#define PG8_MMA(ai, bj, At, Bt) do { __builtin_amdgcn_s_setprio(1); _Pragma("unroll") for (int m = 0; m < 4; ++m) _Pragma("unroll") for (int n = 0; n < 2; ++n) _Pragma("unroll") for (int k = 0; k < 2; ++k) { \
        if constexpr (I8) acc[ai][bj][m][n] = __builtin_bit_cast(f32x4, __builtin_amdgcn_mfma_i32_16x16x64_i8(__builtin_bit_cast(i32x4, Bt[n][k]), __builtin_bit_cast(i32x4, At[m][k]), __builtin_bit_cast(i32x4, acc[ai][bj][m][n]), 0, 0, 0)); \
        else acc[ai][bj][m][n] = __builtin_amdgcn_mfma_f32_16x16x32_bf16(Bt[n][k], At[m][k], acc[ai][bj][m][n], 0, 0, 0); } __builtin_amdgcn_s_setprio(0); } while (0)
#define PG8_WAIT_V(n) asm volatile("s_waitcnt vmcnt(" #n ")" ::: "memory")
#define PG8_WAIT_L(n) asm volatile("s_waitcnt lgkmcnt(" #n ")" ::: "memory")
#define PG8_BAR __builtin_amdgcn_s_barrier()
#define PG8_SCHED __builtin_amdgcn_sched_barrier(0)
    Unit cur, nxt; int ui = 0;
    if (!S.next(0, cur)) return;
    f32x4 acc[2][2][4][2];
#pragma unroll
    for (int a = 0; a < 2; ++a)
#pragma unroll
        for (int b = 0; b < 2; ++b)
#pragma unroll
            for (int m = 0; m < 4; ++m)
#pragma unroll
                for (int n = 0; n < 2; ++n) acc[a][b][m][n] = (f32x4){0.f, 0.f, 0.f, 0.f};
    bf16x8 At[4][2], B0[2][2], B1[2][2];
    const char* cA = (const char*)g.A + (size_t)cur.pm * tstep; const char* cB = (const char*)g.Bt + (size_t)cur.pn * tstep;
    S.a_ready(cur);
    if constexpr (SP2) {
        PG8_STAGE(PG8_SB(0, 0), cB, voffB); PG8_STAGE(PG8_SB(0, 1), cB + hstep, voffB); PG8_STAGE(PG8_SA(0, 0), cA, voffA); PG8_STAGE(PG8_SA(0, 1), cA + hstep, voffA);
        if (wr == 1) PG8_BAR;
        PG8_WAIT_V(2); PG8_BAR;
        PG8_STAGE(PG8_SB(1, 0), cB + kstep, voffB); PG8_STAGE(PG8_SA(1, 0), cA + kstep, voffA); PG8_STAGE(PG8_SB(1, 1), cB + hstep + kstep, voffB);
        PG8_WAIT_V(6); PG8_BAR;
    } else {
        PG8_STAGE(PG8_SB(0, 0), cB, voffB); PG8_STAGE(PG8_SA(0, 0), cA, voffA); PG8_STAGE(PG8_SB(0, 1), cB + hstep, voffB); PG8_STAGE(PG8_SA(0, 1), cA + hstep, voffA);
        if (wr == 1) PG8_BAR;
        PG8_WAIT_V(4); PG8_BAR;
        PG8_STAGE(PG8_SB(1, 0), cB + kstep, voffB); PG8_STAGE(PG8_SA(1, 0), cA + kstep, voffA); PG8_STAGE(PG8_SB(1, 1), cB + hstep + kstep, voffB);
        PG8_WAIT_V(6); PG8_BAR;
    }
    for (;;) {
        const bool has_next = S.next(ui + 1, nxt);
        const char* nA = has_next ? (const char*)g.A + (size_t)nxt.pm * tstep : cA; const char* nB = has_next ? (const char*)g.Bt + (size_t)nxt.pn * tstep : cB;
        for (int t = 0; t < nt; t += 2) {
            const bool last = (t == nt - 2);
            const char* a1 = cA + (size_t)(t + 1) * kstep;
            const char* a2 = last ? nA : cA + (size_t)(t + 2) * kstep; const char* b2 = last ? nB : cB + (size_t)(t + 2) * kstep;
            const char* a3 = a2 + kstep; const char* b3 = b2 + kstep;
            if (last && has_next) S.a_ready(nxt);
            if constexpr (SP2) {
            PG8_LDB(B0, 0, 0); PG8_LDB(B1, 0, 1); PG8_SCHED; PG8_LDA(At, 0, 0); PG8_STAGE(PG8_SA(1, 1), a1 + hstep, voffA);
            PG8_WAIT_V(8); PG8_WAIT_L(0); PG8_BAR; PG8_MMA(0, 0, At, B0); PG8_MMA(0, 1, At, B1); PG8_BAR; PG8_SCHED;
            PG8_LDA(At, 0, 1); PG8_STAGE(PG8_SB(0, 0), b2, voffB); PG8_STAGE(PG8_SB(0, 1), b2 + hstep, voffB); PG8_STAGE(PG8_SA(0, 0), a2, voffA);
            PG8_WAIT_V(8); PG8_WAIT_L(0); PG8_BAR; PG8_MMA(1, 0, At, B0); PG8_MMA(1, 1, At, B1); PG8_BAR; PG8_SCHED;
            PG8_LDB(B0, 1, 0); PG8_LDB(B1, 1, 1); PG8_SCHED; PG8_LDA(At, 1, 0); PG8_STAGE(PG8_SA(0, 1), a2 + hstep, voffA);
            PG8_WAIT_V(8); PG8_WAIT_L(0); PG8_BAR; PG8_MMA(0, 0, At, B0); PG8_MMA(0, 1, At, B1); PG8_BAR; PG8_SCHED;
            PG8_LDA(At, 1, 1); PG8_STAGE(PG8_SB(1, 0), b3, voffB); PG8_STAGE(PG8_SB(1, 1), b3 + hstep, voffB); PG8_STAGE(PG8_SA(1, 0), a3, voffA);
            PG8_WAIT_V(8); PG8_WAIT_L(0); PG8_BAR; PG8_MMA(1, 0, At, B0); PG8_MMA(1, 1, At, B1); PG8_BAR; PG8_SCHED;
            } else {
            PG8_LDB(B0, 0, 0); PG8_SCHED; PG8_LDA(At, 0, 0); PG8_STAGE(PG8_SA(1, 1), a1 + hstep, voffA);
            PG8_WAIT_L(8); PG8_BAR; PG8_WAIT_L(0); PG8_MMA(0, 0, At, B0); PG8_BAR; PG8_SCHED;
            PG8_LDB(B1, 0, 1); PG8_STAGE(PG8_SB(0, 0), b2, voffB);
            PG8_BAR; PG8_WAIT_L(0); PG8_MMA(0, 1, At, B1); PG8_BAR;
            PG8_LDA(At, 0, 1); PG8_STAGE(PG8_SA(0, 0), a2, voffA);
            PG8_BAR; PG8_WAIT_L(0); PG8_MMA(1, 0, At, B0); PG8_BAR; PG8_SCHED;
            PG8_STAGE(PG8_SB(0, 1), b2 + hstep, voffB);
            PG8_WAIT_V(6); PG8_BAR; PG8_MMA(1, 1, At, B1); PG8_BAR;
            PG8_LDB(B0, 1, 0); PG8_SCHED; PG8_LDA(At, 1, 0); PG8_STAGE(PG8_SA(0, 1), a2 + hstep, voffA);
            PG8_WAIT_L(8); PG8_BAR; PG8_WAIT_L(0); PG8_MMA(0, 0, At, B0); PG8_BAR; PG8_SCHED;
            PG8_LDB(B1, 1, 1); PG8_STAGE(PG8_SB(1, 0), b3, voffB);
            PG8_BAR; PG8_WAIT_L(0); PG8_MMA(0, 1, At, B1); PG8_BAR;
            PG8_LDA(At, 1, 1); PG8_STAGE(PG8_SA(1, 0), a3, voffA);
            PG8_BAR; PG8_WAIT_L(0); PG8_MMA(1, 0, At, B0); PG8_BAR; PG8_SCHED;
            PG8_STAGE(PG8_SB(1, 1), b3 + hstep, voffB);
            PG8_WAIT_V(6); PG8_BAR; PG8_MMA(1, 1, At, B1); PG8_BAR;
            }
        }
        if constexpr (ALIGN_EPI) { if (wr == 0) PG8_BAR; }
        if constexpr (!Epi::AFTER_DRAIN) { E(acc, cur, wr, wc, fr, fq); S.done(cur); }
        if (!has_next) break;
#pragma unroll
        for (int a = 0; a < 2; ++a)
#pragma unroll
            for (int b = 0; b < 2; ++b)
#pragma unroll
                for (int m = 0; m < 4; ++m)
#pragma unroll
                    for (int n = 0; n < 2; ++n) acc[a][b][m][n] = (f32x4){0.f, 0.f, 0.f, 0.f};
        cur = nxt; cA = nA; cB = nB; ++ui;
        if constexpr (ALIGN_EPI) { if (wr == 1) PG8_BAR; }
    }
    PG8_WAIT_V(0);
    if constexpr (!ALIGN_EPI) { if (wr == 0) PG8_BAR; }
    PG8_BAR;
    if constexpr (Epi::AFTER_DRAIN) { E.fused(acc, cur, wr, wc, fr, fq, lds, wid, lane); S.done(cur); }
#undef PG8_SA
#undef PG8_SB
#undef PG8_STAGE
#undef PG8_LDA
#undef PG8_LDB
#undef PG8_MMA
#undef PG8_WAIT_V
#undef PG8_WAIT_L
#undef PG8_BAR
#undef PG8_SCHED
}
}

struct Frame {
    LAS unsigned char* lds;
    int wave, G, bid;
    const float *x, *mix_norm, *ffn_norm, *final_norm, *w_in, *w_out, *rel_bias, *conv_w1, *conv_b1, *conv_dw, *conv_dw_b, *conv_ln_g, *conv_ln_b, *conv_w2, *conv_b2,
        *peer_wq, *peer_keys, *peer_u, *peer_v;
    float* out;
    unsigned char* ws;
};
#define FRAME_IDS const int f_lane = lane_id(); const int f_tid = F.wave * 64 + f_lane; (void)f_tid
DI float gamma_of(int h) { return 1.f - exp2f(-5.f - (float)h); }

DI unsigned q8x4(f32x4 v, const float sc) {
    const int a = (int)rintf(v[0] * sc), b = (int)rintf(v[1] * sc), c = (int)rintf(v[2] * sc), d = (int)rintf(v[3] * sc);
    return ((unsigned)a & 0xFFu) | (((unsigned)b & 0xFFu) << 8) | (((unsigned)c & 0xFFu) << 16) | ((unsigned)d << 24);
}
DI void p0_prep(Frame& F) {
    FRAME_IDS;
    const int gw = F.bid * NWAVES + F.wave, NGW = F.G * NWAVES;
    f32x2* rope = (f32x2*)(F.ws + WS_ROPE);
    for (int i = F.bid * NTHR + f_tid; i < SEQ * 32; i += F.G * NTHR) {
        const int s = i >> 5, j = i & 31;
        const float inv = powf(10000.f, -(float)j / 32.f);
        const float ang = (float)s * inv;
        float sn, cs; sincosf(ang, &sn, &cs);
        rope[i] = (f32x2){cs, sn};
    }
    unsigned* xq = (unsigned*)(F.ws + WS_XB); float* rowsc = (float*)(F.ws + WS_ROWSC);
    for (int m = gw; m < T; m += NGW) {
        const f32x4* xr = (const f32x4*)(F.x + (size_t)m * DM) + f_lane;
        f32x4 v[4]; float s = 0.f, am = 0.f;
#pragma unroll
        for (int j = 0; j < 4; ++j) { v[j] = xr[64 * j]; s += v[j].x * v[j].x + v[j].y * v[j].y + v[j].z * v[j].z + v[j].w * v[j].w; am = fmaxf(am, fmaxf(fmaxf(fabsf(v[j].x), fabsf(v[j].y)), fmaxf(fabsf(v[j].z), fabsf(v[j].w)))); }
        const float r = 1.f / sqrtf(wave_sum(s) * (1.f / DM) + EPS);
        am = wave_max(am);
        const float sc = am > 0.f ? 127.f / am : 0.f;
#pragma unroll
        for (int j = 0; j < 4; ++j) xq[(size_t)m * (DM / 4) + f_lane + 64 * j] = q8x4(v[j], sc);
        if (f_lane == 0) rowsc[m] = am * (1.f / 127.f) * r;
    }
}
DI void p0_transpose_item(const float* W, int K, int N, bf16* WT, int prow0, const float* gain, float scale, LAS float* scr, int k0, int n0, int lane) {
#pragma unroll 8
    for (int i = 0; i < 32; ++i) { const int kk = 2 * i + (lane >> 5); scr[kk * 33 + (lane & 31)] = W[(size_t)(k0 + kk) * N + n0 + (lane & 31)] * (gain ? gain[k0 + kk] : 1.f) * scale; }
    asm volatile("s_waitcnt lgkmcnt(0)" ::: "memory");
    const int c = lane & 7;
#pragma unroll
    for (int j = 0; j < 4; ++j) { const int n = (lane >> 3) + 8 * j; const LAS float* q = scr + (8 * c) * 33 + n;
        u32x4 o; o.x = pk2(q[0 * 33], q[1 * 33]); o.y = pk2(q[2 * 33], q[3 * 33]); o.z = pk2(q[4 * 33], q[5 * 33]); o.w = pk2(q[6 * 33], q[7 * 33]);
        *(u32x4*)(WT + (size_t)(prow0 + n) * K + k0 + 8 * c) = o; }
    asm volatile("s_waitcnt lgkmcnt(0)" ::: "memory");
}
DI void p0_amax_item(const float* W, int N, unsigned* colmax, const float* gain, float scale, int k0, int n0, int lane) {
    float am = 0.f;
#pragma unroll 8
    for (int i = 0; i < 32; ++i) { const int kk = 2 * i + (lane >> 5); am = fmaxf(am, fabsf(W[(size_t)(k0 + kk) * N + n0 + (lane & 31)] * (gain ? gain[k0 + kk] : 1.f) * scale)); }
    am = swap32_max(am);
    if (lane < 32) __hip_atomic_fetch_max(colmax + lane, __float_as_uint(am), __ATOMIC_RELAXED, __HIP_MEMORY_SCOPE_AGENT);
}
DI void p0_q8_item(const float* W, int N, unsigned char* WT, const unsigned* colmax, float* colsc, int prow0, const float* gain, float scale, LAS float* scr, int k0, int n0, int lane) {
    const float am = __uint_as_float(colmax[lane & 31]);
    const float sc = am > 0.f ? 127.f / am : 0.f;
    if (k0 == 0 && lane < 32) colsc[lane] = am * (1.f / 127.f);
#pragma unroll 8
    for (int i = 0; i < 32; ++i) { const int kk = 2 * i + (lane >> 5); scr[kk * 33 + (lane & 31)] = rintf(W[(size_t)(k0 + kk) * N + n0 + (lane & 31)] * (gain ? gain[k0 + kk] : 1.f) * scale * sc); }
    asm volatile("s_waitcnt lgkmcnt(0)" ::: "memory");
    const int ch = lane & 3;
#pragma unroll
    for (int j = 0; j < 2; ++j) { const int n = (lane >> 2) + 16 * j; const LAS float* q = scr + (16 * ch) * 33 + n;
        u32x4 o;
#pragma unroll
        for (int w = 0; w < 4; ++w) o[w] = ((unsigned)(int)q[(4 * w) * 33] & 0xFFu) | (((unsigned)(int)q[(4 * w + 1) * 33] & 0xFFu) << 8) | (((unsigned)(int)q[(4 * w + 2) * 33] & 0xFFu) << 16) | ((unsigned)(int)q[(4 * w + 3) * 33] << 24);
        *(u32x4*)(WT + (size_t)(prow0 + n) * DM + k0 + 16 * ch) = o; }
    asm volatile("s_waitcnt lgkmcnt(0)" ::: "memory");
}
constexpr int CW_COLMAX = 16384;
constexpr int CS_WIN = 0, CS_WOUT = 3584, CS_W1 = 4608, CS_W2 = 6656, CS_WQ = 7680;
constexpr bool I8_WIN = true, I8_WOUT = false, I8_W1 = false, I8_W2 = false, I8_WQ = false;
DI void p0_weights(Frame& F, const int pass) {
    FRAME_IDS;
    LAS float* scr = (LAS float*)(F.lds + F.wave * 16384);
    unsigned* colmax = (unsigned*)(F.ws + WS_CTL) + CW_COLMAX; float* colsc = (float*)(F.ws + WS_COLSC);
    const int gw = F.bid * NWAVES + F.wave, NGW = F.G * NWAVES;
    constexpr int I_IN = 16 * (INC / 32), I_SQ = 16 * (DM / 32), I_W1 = 16 * (2 * DM / 32);
    constexpr int NITEMS = I_IN + I_SQ + I_W1 + I_SQ + 2 * I_SQ;
#define WITEM(I8FLAG, Wp, Nn, WTb, CSo, prow0, gainp, scl, k0, n0) do { \
        if (pass == 0) { if (I8FLAG) p0_amax_item(Wp, Nn, colmax + (CSo) + (prow0), gainp, scl, k0, n0, f_lane); } \
        else if (I8FLAG) p0_q8_item(Wp, Nn, (unsigned char*)(WTb), colmax + (CSo) + (prow0), colsc + (CSo) + (prow0), prow0, gainp, scl, scr, k0, n0, f_lane); \
        else p0_transpose_item(Wp, DM, Nn, (bf16*)(WTb), prow0, gainp, scl, scr, k0, n0, f_lane); } while (0)
    for (int it = gw; it < NITEMS; it += NGW) {
        int r = it;
        if (r < I_IN) { const int nb = r % (INC / 32), kb = r / (INC / 32), n0 = nb * 32;
            const int type = n0 / 512, head = (n0 % 512) / 64, bj = (n0 % 64) / 32;
            const int prow0 = 256 * (2 * type + head / 4) + 128 * bj + 32 * (head % 4);
            WITEM(I8_WIN, F.w_in, INC, F.ws + WS_WIN, CS_WIN, prow0, F.mix_norm, (type == 0 ? 0.125f * LOG2E : (type == 4 ? 0.125f : 1.f)), kb * 64, n0); continue; }
        r -= I_IN;
        if (r < I_SQ) { const int nb = r % 32, kb = r / 32; WITEM(I8_WOUT, F.w_out, DM, F.ws + WS_WOUT, CS_WOUT, nb * 32, (const float*)nullptr, 1.f, kb * 64, nb * 32); continue; }
        r -= I_SQ;
        if (r < I_W1) { const int nb = r % 64, kb = r / 64, n0 = nb * 32; const int bj = n0 / 1024, rem = n0 % 1024;
            WITEM(I8_W1, F.conv_w1, 2 * DM, F.ws + WS_W1, CS_W1, 256 * (rem / 128) + 128 * bj + (rem % 128), F.mix_norm + DM, 1.f, kb * 64, n0); continue; }
        r -= I_W1;
        if (r < I_SQ) { const int nb = r % 32, kb = r / 32; WITEM(I8_W2, F.conv_w2, DM, F.ws + WS_W2, CS_W2, nb * 32, (const float*)nullptr, 1.f, kb * 64, nb * 32); continue; }
        r -= I_SQ;
        { const int layer = r / I_SQ; r %= I_SQ; const int nb = r % 32, kb = r / 32;
          WITEM(I8_WQ, F.peer_wq + (size_t)layer * DM * DM, DM, F.ws + WS_WQ + (size_t)layer * DM * DM * 2, CS_WQ + layer * DM, nb * 32, F.ffn_norm + layer * DM, 1.f, kb * 64, nb * 32); }
    }
#undef WITEM
}
DI float row_rstd(const float* part, int m) {
    const f32x4* p = (const f32x4*)(part + (size_t)m * 16);
    const f32x4 a = p[0], b = p[1], c = p[2], d = p[3];
    const float s = ((a.x + a.y) + (a.z + a.w)) + ((b.x + b.y) + (b.z + b.w)) + ((c.x + c.y) + (c.z + c.w)) + ((d.x + d.y) + (d.z + d.w));
    return 1.f / sqrtf(s * (1.f / DM) + EPS);
}

typedef short v4i16 __attribute__((ext_vector_type(4)));
typedef __bf16 bf16x2_t __attribute__((ext_vector_type(2)));
DI unsigned cvtpk(float lo, float hi) { f32x2 v = {lo, hi}; bf16x2_t b = __builtin_convertvector(v, bf16x2_t); return __builtin_bit_cast(unsigned, b); }
DI v4i16 ds_tr16(LAS const unsigned char* p) { return __builtin_amdgcn_ds_read_tr16_b64_v4i16((LAS v4i16*)p); }
DI int crow(int r, int h) { return (r & 3) + 8 * (r >> 2) + 4 * h; }
DI bf16x8 pack_step(const f32x16& x, const int s) {
    u32x4 w = {cvtpk(x[8 * s + 0], x[8 * s + 1]), cvtpk(x[8 * s + 2], x[8 * s + 3]), cvtpk(x[8 * s + 4], x[8 * s + 5]), cvtpk(x[8 * s + 6], x[8 * s + 7])};
    return __builtin_bit_cast(bf16x8, w);
}
constexpr int AT_KB = 64 * 144, AT_VB = 8192, AT_BUF = AT_KB + AT_VB, AT_BIAS = 2 * AT_BUF;
DI void attn_item(Frame& F, const int it) {
    FRAME_IDS;
    const bf16* R = (const bf16*)(F.ws + WS_R); bf16* O = (bf16*)(F.ws + WS_O);
    LAS unsigned char* lds = F.lds;
    LAS float* bias_s = (LAS float*)(lds + AT_BIAS);
    const int q32 = f_lane & 31, h = f_lane >> 5, w = F.wave;
    const int srow = f_tid >> 3, sch = f_tid & 7;
    const int vtr_off = ((f_lane & 15) >> 2) * 64 + (16 * ((f_lane >> 4) & 1) + 4 * (f_lane & 3)) * 2;
    {
        const int b = it / (NHA * 8), hd = (it / 8) % NHA, c0 = (it % 8) * 4;
        const int c = c0 + (w >> 1), qrow0 = 32 * (w & 1);
        const size_t tq = (size_t)b * SEQ + c * 64 + qrow0 + q32;
        __syncthreads();
        for (int k = f_tid; k < 257; k += NTHR) bias_s[k] = F.rel_bias[hd * 257 + k] * LOG2E;
        bf16x8 qf[4];
#pragma unroll
        for (int ks = 0; ks < 4; ++ks) qf[ks] = *(const bf16x8*)(R + tq * INC + C_QA + hd * 64 + 16 * ks + 8 * h);
        const int t_lo = c0 - 8 < 0 ? 0 : c0 - 8, t_hi = c0 + 3, ntile = t_hi - t_lo + 1;
        const bf16* kbase = R + ((size_t)b * SEQ + srow) * INC + C_KA + hd * 64 + 8 * sch;
        const bf16* vbase = R + ((size_t)b * SEQ + srow) * INC + C_VA + hd * 64 + 8 * sch;
        u32x4 kreg = *(const u32x4*)(kbase + (size_t)t_lo * 64 * INC), vreg = *(const u32x4*)(vbase + (size_t)t_lo * 64 * INC);
        *(LAS u32x4*)(lds + srow * 144 + sch * 16) = kreg;
        *(LAS u32x4*)(lds + AT_KB + (sch >> 2) * 4096 + srow * 64 + (sch & 3) * 16) = vreg;
        __syncthreads();
        const float bias_far = bias_s[256];
        float m = -1e30f, l = 0.f;
        f32x16 o0 = {}, o1 = {};
        for (int i = 0; i < ntile; ++i) {
            const int tc = t_lo + i;
            LAS unsigned char* kb = lds + (i & 1) * AT_BUF; LAS unsigned char* vb = kb + AT_KB;
            if (i + 1 < ntile) { kreg = *(const u32x4*)(kbase + (size_t)(tc + 1) * 64 * INC); vreg = *(const u32x4*)(vbase + (size_t)(tc + 1) * 64 * INC); }
            const int D = c - tc;
            if (D >= 0 && D <= 8) {
                const float init = D >= 3 ? bias_far : 0.f;
                f32x16 p0, p1;
#pragma unroll
                for (int r = 0; r < 16; ++r) { p0[r] = init; p1[r] = init; }
#pragma unroll
                for (int ks = 0; ks < 4; ++ks) {
                    const bf16x8 k0 = *(const LAS bf16x8*)(kb + q32 * 144 + (16 * ks + 8 * h) * 2);
                    const bf16x8 k1 = *(const LAS bf16x8*)(kb + (32 + q32) * 144 + (16 * ks + 8 * h) * 2);
                    p0 = __builtin_amdgcn_mfma_f32_32x32x16_bf16(k0, qf[ks], p0, 0, 0, 0);
                    p1 = __builtin_amdgcn_mfma_f32_32x32x16_bf16(k1, qf[ks], p1, 0, 0, 0);
                }
                if (D < 3) {
                    const int relb = D * 64 + qrow0 + q32 - 4 * h + 128;
#pragma unroll
                    for (int r = 0; r < 16; ++r) {
                        const int r0 = relb - ((r & 3) + 8 * (r >> 2));
                        const int i0 = r0 < 0 ? 0 : (r0 > 256 ? 256 : r0), r1 = r0 - 32, i1 = r1 < 0 ? 0 : (r1 > 256 ? 256 : r1);
                        p0[r] += bias_s[i0]; p1[r] += bias_s[i1];
                    }
                }
                float tm = fmaxf(p0[0], p1[0]);
#pragma unroll
                for (int r = 1; r < 16; ++r) tm = fmaxf(tm, fmaxf(p0[r], p1[r]));
                tm = swap32_max(tm);
                const float mn = fmaxf(m, tm), alpha = __builtin_amdgcn_exp2f(m - mn);
                m = mn;
                float ps = 0.f;
#pragma unroll
                for (int r = 0; r < 16; ++r) { p0[r] = __builtin_amdgcn_exp2f(p0[r] - mn); p1[r] = __builtin_amdgcn_exp2f(p1[r] - mn); ps += p0[r] + p1[r]; }
                l = l * alpha + ps;
                if (!__all(alpha == 1.f)) {
#pragma unroll
                    for (int r = 0; r < 16; ++r) { o0[r] *= alpha; o1[r] *= alpha; }
                }
                bf16x8 pf[4];
                pf[0] = pack_step(p0, 0); pf[1] = pack_step(p0, 1); pf[2] = pack_step(p1, 0); pf[3] = pack_step(p1, 1);
#pragma unroll
                for (int kk = 0; kk < 4; ++kk) {
                    const int key0 = 16 * kk + 4 * h;
                    const v4i16 a0l = ds_tr16(vb + key0 * 64 + vtr_off), a0h = ds_tr16(vb + (key0 + 8) * 64 + vtr_off);
                    const v4i16 a1l = ds_tr16(vb + 4096 + key0 * 64 + vtr_off), a1h = ds_tr16(vb + 4096 + (key0 + 8) * 64 + vtr_off);
                    const bf16x8 a0 = __builtin_shufflevector(a0l, a0h, 0, 1, 2, 3, 4, 5, 6, 7), a1 = __builtin_shufflevector(a1l, a1h, 0, 1, 2, 3, 4, 5, 6, 7);
                    o0 = __builtin_amdgcn_mfma_f32_32x32x16_bf16(a0, pf[kk], o0, 0, 0, 0);
                    o1 = __builtin_amdgcn_mfma_f32_32x32x16_bf16(a1, pf[kk], o1, 0, 0, 0);
                }
            }
            if (i + 1 < ntile) {
                LAS unsigned char* nb = lds + ((i + 1) & 1) * AT_BUF;
                *(LAS u32x4*)(nb + srow * 144 + sch * 16) = kreg;
                *(LAS u32x4*)(nb + AT_KB + (sch >> 2) * 4096 + srow * 64 + (sch & 3) * 16) = vreg;
            }
            __syncthreads();
        }
        l = swap32_add(l, l);
        const float inv = 1.f / l;
        bf16* op = O + tq * DM + hd * 64 + 4 * h;
#pragma unroll
        for (int g = 0; g < 4; ++g) {
            *(u32x2*)(op + 8 * g) = (u32x2){cvtpk(o0[4 * g] * inv, o0[4 * g + 1] * inv), cvtpk(o0[4 * g + 2] * inv, o0[4 * g + 3] * inv)};
            *(u32x2*)(op + 32 + 8 * g) = (u32x2){cvtpk(o1[4 * g] * inv, o1[4 * g + 1] * inv), cvtpk(o1[4 * g + 2] * inv, o1[4 * g + 3] * inv)};
        }
    }
    __syncthreads();
}

constexpr int RT_Q = 0, RT_K = 9216, RT_KD = 18432, RT_V = 26624, RT_BUF = 34816, RT_ZS = 2 * RT_BUF, RT_CS = RT_ZS + 64 * 66 * 4;
DI void ret_item(Frame& F, const int it) {
    FRAME_IDS;
    const bf16* R = (const bf16*)(F.ws + WS_R); bf16* O = (bf16*)(F.ws + WS_O);
    LAS unsigned char* lds = F.lds;
    LAS float* Zs = (LAS float*)(lds + RT_ZS); LAS float* Cs = (LAS float*)(lds + RT_CS);
    const int b = it / NHB, hd = it % NHB;
    const int q32 = f_lane & 31, h = f_lane >> 5, w = F.wave;
    const int role = w >> 2, itile = (w >> 1) & 1, etile = w & 1;
    const int srow = f_tid >> 3, sch = f_tid & 7;
    const int vtr_off = ((f_lane & 15) >> 2) * 64 + (16 * ((f_lane >> 4) & 1) + 4 * (f_lane & 3)) * 2;
    const float l2g = log2f(gamma_of(hd));
    const float cd = exp2f(l2g * 64.f), sdec = exp2f(l2g * (float)(63 - srow));
    float qdv[16];
#pragma unroll
    for (int r = 0; r < 16; ++r) qdv[r] = exp2f(l2g * (float)(32 * itile + crow(r, h) + 1));
    f32x16 xs0 = {}, xs1 = {};
    const size_t trow0 = (size_t)b * SEQ;
    const bf16* gq = R + (trow0 + srow) * INC + hd * 64 + 8 * sch;
    u32x4 qreg = *(const u32x4*)(gq + C_QB), kreg = *(const u32x4*)(gq + C_KB), vreg = *(const u32x4*)(gq + C_VB);
    __syncthreads();
#define RT_STAGE(bufp) do { LAS unsigned char* bp_ = (bufp); \
        *(LAS u32x4*)(bp_ + RT_Q + srow * 144 + sch * 16) = qreg; *(LAS u32x4*)(bp_ + RT_K + srow * 144 + sch * 16) = kreg; \
        *(LAS u32x4*)(bp_ + RT_V + (sch >> 2) * 4096 + srow * 64 + (sch & 3) * 16) = vreg; \
        u32x4 kd_; \
        _Pragma("unroll") for (int e_ = 0; e_ < 4; ++e_) kd_[e_] = cvtpk(__uint_as_float(kreg[e_] << 16) * sdec, __uint_as_float(kreg[e_] & 0xffff0000u) * sdec); \
        *(LAS u32x4*)(bp_ + RT_KD + (sch >> 2) * 4096 + srow * 64 + (sch & 3) * 16) = kd_; } while (0)
    RT_STAGE(lds);
    __syncthreads();
    for (int n = 0; n < NCH; ++n) {
        LAS unsigned char* bp = lds + (n & 1) * RT_BUF;
        if (n + 1 < NCH) { const bf16* g1 = gq + (size_t)(n + 1) * 64 * INC; qreg = *(const u32x4*)(g1 + C_QB); kreg = *(const u32x4*)(g1 + C_KB); vreg = *(const u32x4*)(g1 + C_VB); }
        unsigned short gr[8];
#pragma unroll
        for (int r = 0; r < 8; ++r) gr[r] = R[(trow0 + n * 64 + 8 * w + r) * INC + C_GB + hd * 64 + f_lane];
        if (role == 0) {
            bf16x8 qf[4];
#pragma unroll
            for (int ks = 0; ks < 4; ++ks) qf[ks] = *(const LAS bf16x8*)(bp + RT_Q + (32 * itile + q32) * 144 + (16 * ks + 8 * h) * 2);
            f32x16 st0 = {}, st1 = {};
#pragma unroll
            for (int ks = 0; ks < 4; ++ks) {
                const bf16x8 k0 = *(const LAS bf16x8*)(bp + RT_K + q32 * 144 + (16 * ks + 8 * h) * 2);
                const bf16x8 k1 = *(const LAS bf16x8*)(bp + RT_K + (32 + q32) * 144 + (16 * ks + 8 * h) * 2);
                st0 = __builtin_amdgcn_mfma_f32_32x32x16_bf16(k0, qf[ks], st0, 0, 0, 0);
                st1 = __builtin_amdgcn_mfma_f32_32x32x16_bf16(k1, qf[ks], st1, 0, 0, 0);
            }
            int iiv = 32 * itile + q32 - 4 * h; asm volatile("" : "+v"(iiv));
#pragma unroll
            for (int r = 0; r < 16; ++r) {
                const int dd = iiv - ((r & 3) + 8 * (r >> 2));
                st0[r] *= __builtin_amdgcn_exp2f(l2g * fabsf((float)dd));
                st1[r] *= __builtin_amdgcn_exp2f(l2g * fabsf((float)(dd - 32)));
            }
            f32x16 z = {};
#pragma unroll
            for (int kk = 0; kk < 4; ++kk) {
                const int key0 = 16 * kk + 4 * h;
                const v4i16 bl = ds_tr16(bp + RT_V + etile * 4096 + key0 * 64 + vtr_off), bh = ds_tr16(bp + RT_V + etile * 4096 + (key0 + 8) * 64 + vtr_off);
                const bf16x8 vb = __builtin_shufflevector(bl, bh, 0, 1, 2, 3, 4, 5, 6, 7);
                const bf16x8 xa = (kk < 2) ? pack_step(st0, kk & 1) : pack_step(st1, kk & 1);
                z = __builtin_amdgcn_mfma_f32_32x32x16_bf16(xa, vb, z, 0, 0, 0);
            }
            int zb = (32 * itile + 4 * h) * 66 + 32 * etile + q32; asm volatile("" : "+v"(zb));
#pragma unroll
            for (int r = 0; r < 16; ++r) Zs[zb + ((r & 3) + 8 * (r >> 2)) * 66] = z[r];
        } else {
            f32x16 cr = {};
#pragma unroll
            for (int kk = 0; kk < 4; ++kk) {
                const LAS unsigned char* qp = bp + RT_Q + (32 * itile + q32) * 144 + (16 * kk + 4 * h) * 2;
                const v4i16 al = *(const LAS v4i16*)qp, ah = *(const LAS v4i16*)(qp + 16);
                const bf16x8 qa = __builtin_shufflevector(al, ah, 0, 1, 2, 3, 4, 5, 6, 7);
                const bf16x8 xb = (kk < 2) ? pack_step(xs0, kk & 1) : pack_step(xs1, kk & 1);
                cr = __builtin_amdgcn_mfma_f32_32x32x16_bf16(qa, xb, cr, 0, 0, 0);
            }
            int cb = (32 * itile + 4 * h) * 66 + 32 * etile + q32; asm volatile("" : "+v"(cb));
#pragma unroll
            for (int r = 0; r < 16; ++r) Cs[cb + ((r & 3) + 8 * (r >> 2)) * 66] = cr[r] * qdv[r];
#pragma unroll
            for (int r = 0; r < 16; ++r) { xs0[r] *= cd; xs1[r] *= cd; }
#pragma unroll
            for (int s4 = 0; s4 < 4; ++s4) {
                const int key0 = 16 * s4 + 8 * h;
                const v4i16 vl = ds_tr16(bp + RT_V + etile * 4096 + key0 * 64 + vtr_off), vh = ds_tr16(bp + RT_V + etile * 4096 + (key0 + 4) * 64 + vtr_off);
                const bf16x8 vb = __builtin_shufflevector(vl, vh, 0, 1, 2, 3, 4, 5, 6, 7);
                const v4i16 a0l = ds_tr16(bp + RT_KD + key0 * 64 + vtr_off), a0h = ds_tr16(bp + RT_KD + (key0 + 4) * 64 + vtr_off);
                const v4i16 a1l = ds_tr16(bp + RT_KD + 4096 + key0 * 64 + vtr_off), a1h = ds_tr16(bp + RT_KD + 4096 + (key0 + 4) * 64 + vtr_off);
                const bf16x8 ka0 = __builtin_shufflevector(a0l, a0h, 0, 1, 2, 3, 4, 5, 6, 7), ka1 = __builtin_shufflevector(a1l, a1h, 0, 1, 2, 3, 4, 5, 6, 7);
                xs0 = __builtin_amdgcn_mfma_f32_32x32x16_bf16(ka0, vb, xs0, 0, 0, 0);
                xs1 = __builtin_amdgcn_mfma_f32_32x32x16_bf16(ka1, vb, xs1, 0, 0, 0);
            }
        }
        __syncthreads();
#pragma unroll
        for (int r = 0; r < 8; ++r) {
            const int i = 8 * w + r;
            const float v = Zs[i * 66 + f_lane] + Cs[i * 66 + f_lane];
            const float mu = wave_sum(v) * (1.f / 64.f);
            const float dv = v - mu;
            const float var = wave_sum(dv * dv) * (1.f / 64.f);
            const float g = bf2f(gr[r]);
            O[(trow0 + n * 64 + i) * DM + 512 + hd * 64 + f_lane] = (bf16)f2bf(dv * (1.f / sqrtf(var + EPS)) * (g / (1.f + __expf(-g))));
        }
        if (n + 1 < NCH) RT_STAGE(lds + ((n + 1) & 1) * RT_BUF);
        __syncthreads();
    }
#undef RT_STAGE
}
DI void int8_rows(Frame& F, const int row0, const int nrows, const int f_lane) {
    float* SC = (float*)(F.ws + WS_SC);
    for (int rr = row0; rr < row0 + nrows; rr += 8) {
        f32x4 v[8][4];
#pragma unroll
        for (int u = 0; u < 8; ++u) {
            const int row = rr + u, tab = row / PE, e = row % PE, layer = tab & 1, isv = tab >> 1;
            const f32x4* sp = (const f32x4*)((isv ? F.peer_v : F.peer_u) + ((size_t)layer * PE + e) * DM) + f_lane;
#pragma unroll
            for (int j = 0; j < 4; ++j) v[u][j] = sp[64 * j];
        }
#pragma unroll
        for (int u = 0; u < 8; ++u) {
            const int row = rr + u, tab = row / PE, e = row % PE, layer = tab & 1, isv = tab >> 1;
            const f32x4* gp = (const f32x4*)(F.ffn_norm + layer * DM) + f_lane;
            float a = 0.f, sq = 0.f;
#pragma unroll
            for (int j = 0; j < 4; ++j) { if (!isv) v[u][j] = v[u][j] * gp[64 * j]; a = fmaxf(a, fmaxf(fmaxf(fabsf(v[u][j][0]), fabsf(v[u][j][1])), fmaxf(fabsf(v[u][j][2]), fabsf(v[u][j][3]))));
                sq += (v[u][j][0] * v[u][j][0] + v[u][j][1] * v[u][j][1]) + (v[u][j][2] * v[u][j][2] + v[u][j][3] * v[u][j][3]); }
            a = wave_max(a);
            const float step = fminf(0.355f * sqrtf(wave_sum(sq) * (1.f / DM)), a * (1.f / 7.f));
            const float sc = step > 0.f ? 1.f / step : 0.f;
            unsigned* dst = (unsigned*)(F.ws + (isv ? WS_V8 : WS_U8)) + (size_t)layer * 4 * PE * 32;
#pragma unroll
            for (int j = 0; j < 4; ++j) {
                const int q0 = (int)rintf(__builtin_amdgcn_fmed3f(v[u][j][0] * sc, -7.f, 7.f)), q1 = (int)rintf(__builtin_amdgcn_fmed3f(v[u][j][1] * sc, -7.f, 7.f)), q2 = (int)rintf(__builtin_amdgcn_fmed3f(v[u][j][2] * sc, -7.f, 7.f)), q3 = (int)rintf(__builtin_amdgcn_fmed3f(v[u][j][3] * sc, -7.f, 7.f));
                const int ob = (isv && !(f_lane & 1)) ? 8 : 0;
                unsigned w = ((unsigned)(q0 + ob) & 0xFu) | (((unsigned)(q1 + ob) & 0xFu) << 8) | (((unsigned)(q2 + ob) & 0xFu) << 16) | (((unsigned)(q3 + ob) & 0xFu) << 24);
                if (f_lane & 1) w <<= 4;
                w |= (unsigned)DPP_MOV_I((int)w, DPP_XOR1);
                if (!(f_lane & 1)) dst[((size_t)j * PE + e) * 32 + (f_lane >> 1)] = w;
            }
            if (f_lane == 0) SC[tab * PE + e] = isv ? step * (1.f / 16.f) : step;
        }
    }
}
constexpr int Q8_ITEM_ROWS = 512, Q8_ITEMS = 4 * PE / Q8_ITEM_ROWS;
constexpr int PH_MIX_ID = 3;
DI int attn_order(const int q) { return q < 768 ? (q / 6) * 8 + (q % 6) + 2 : ((q - 768) & 127) * 8 + ((q - 768) < 128 ? 1 : 0); }
DI void mix_phase(Frame& F, const int rep) {
    FRAME_IDS;
    unsigned* ctr = (unsigned*)(F.ws + WS_CTL) + CW_QUEUE + 64 * rep;
    volatile LAS unsigned* slot = (volatile LAS unsigned*)(F.lds + MISC_OFF) + 16;
    constexpr int N_RET = NB * NHB, N_ATT = NB * NHA * 8;
    static_assert(N_ATT == 8 * Q8_ITEMS, "8 attention items per quantisation item");
    for (;;) {
        __syncthreads();
        if (f_tid == 0) slot[0] = __hip_atomic_fetch_add(ctr, 1u, __ATOMIC_RELAXED, __HIP_MEMORY_SCOPE_AGENT);
        __syncthreads();
        const int idx = (int)slot[0];
        if (idx >= N_RET + N_ATT + Q8_ITEMS) break;
        const bool probe_pass = (REP_PHASE == PH_MIX_ID && rep == 0);
        if (idx < N_RET) { if (!(probe_pass && PROBE_MODE == 4)) ret_item(F, idx); }
        else if (probe_pass && PROBE_MODE == 3) { }
        else { const int k = idx - N_RET;
            if (k < 4 * Q8_ITEMS) { const int grp = k >> 2, pos = k & 3;
                if (pos == 3) int8_rows(F, grp * Q8_ITEM_ROWS + F.wave * 64, 64, f_lane);
                else attn_item(F, attn_order(3 * grp + pos)); }
            else attn_item(F, attn_order(k - Q8_ITEMS)); }
    }
}
DI float fmax_raw(float a, float b) { float r; asm("v_max_f32_e32 %0, %1, %2" : "=v"(r) : "v"(a), "v"(b)); return r; }
DI float fmin_raw(float a, float b) { float r; asm("v_min_f32_e32 %0, %1, %2" : "=v"(r) : "v"(a), "v"(b)); return r; }
#define CE_DESC(x, y) do { const float hi_ = fmax_raw((x), (y)), lo_ = fmin_raw((x), (y)); (x) = hi_; (y) = lo_; } while (0)
template <int N> DI void sort_desc(float* v) {
#pragma unroll
    for (int k = 2; k <= N; k <<= 1)
#pragma unroll
        for (int j = k >> 1; j > 0; j >>= 1)
#pragma unroll
            for (int i = 0; i < N; ++i) { const int l = i ^ j; if (l > i) { if ((i & k) == 0 || k == N) CE_DESC(v[i], v[l]); else CE_DESC(v[l], v[i]); } }
}
DI void merge16(float* a, const float* b) {
#pragma unroll
    for (int i = 0; i < 16; ++i) a[i] = fmax_raw(a[i], b[15 - i]);
#pragma unroll
    for (int j = 8; j > 0; j >>= 1)
#pragma unroll
        for (int i = 0; i < 16; ++i) { const int l = i ^ j; if (l > i) CE_DESC(a[i], a[l]); }
}
DI float key_pack(float v, unsigned keep_mask, unsigned idx) { return __uint_as_float((__float_as_uint(v) & keep_mask) | idx); }
DI void opt_route(Frame& F, int layer) {
    FRAME_IDS;
    const bf16* Q = (const bf16*)(F.ws + WS_Q);
    int* eidx = (int*)(F.ws + WS_EIDX); float* gate = (float*)(F.ws + WS_GATE);
    const float* keys = F.peer_keys + (size_t)layer * 2 * PK * 64;
    LAS unsigned char* kl = F.lds;
    __syncthreads();
    for (int idx = f_tid; idx < 2 * PK * 8; idx += NTHR) {
        const int row = idx >> 3, ch = idx & 7;
        const f32x4 a = *(const f32x4*)(keys + (size_t)row * 64 + ch * 8), b = *(const f32x4*)(keys + (size_t)row * 64 + ch * 8 + 4);
        *(LAS u32x4*)(kl + row * 144 + ch * 16) = (u32x4){pk2(a[0], a[1]), pk2(a[2], a[3]), pk2(b[0], b[1]), pk2(b[2], b[3])};
    }
    __syncthreads();
    LAS int* lut = (LAS int*)(F.lds + 40960 + F.wave * 8192);
    const int c = f_lane & 31, h = f_lane >> 5;
    pg8::StaticOrder SO; SO.init(T, DM, F.G, F.bid);
    pg8::Unit un;
    for (int ui = 0; SO.next(ui, un); ++ui)
    for (int k2 = F.wave; k2 < 16; k2 += NWAVES) {
        const int tile = 8 * un.pm + (k2 & 7), hh = 2 * un.pn + (k2 >> 3), t = tile * 32 + c;
        float tk[2][16];
#pragma unroll
        for (int side = 0; side < 2; ++side) {
            bf16x8 qf[4];
#pragma unroll
            for (int ks = 0; ks < 4; ++ks) qf[ks] = *(const bf16x8*)(Q + (size_t)t * DM + hh * PQD + side * 64 + 16 * ks + 8 * h);
            float v[64];
#pragma unroll
            for (int kt = 0; kt < 4; ++kt) {
                f32x16 acc = {};
#pragma unroll
                for (int ks = 0; ks < 4; ++ks) {
                    const bf16x8 a = *(const LAS bf16x8*)(kl + (side * PK + 32 * kt + c) * 144 + (16 * ks + 8 * h) * 2);
                    acc = __builtin_amdgcn_mfma_f32_32x32x16_bf16(a, qf[ks], acc, 0, 0, 0);
                }
#pragma unroll
                for (int r = 0; r < 16; ++r) v[16 * kt + r] = key_pack(acc[r], 0xFFFFFF80u, (unsigned)(32 * kt + (r & 3) + 8 * (r >> 2) + 4 * h));
            }
            sort_desc<16>(v); sort_desc<16>(v + 16); sort_desc<16>(v + 32); sort_desc<16>(v + 48);
            merge16(v, v + 16); merge16(v + 32, v + 48); merge16(v, v + 32);
            float pr[16];
#pragma unroll
            for (int i = 0; i < 16; ++i) pr[i] = __shfl_xor(v[i], 32);
            merge16(v, pr);
#pragma unroll
            for (int i = 0; i < 16; ++i) { tk[side][i] = v[i]; lut[(side * 16 + i) * 64 + f_lane] = (int)(__float_as_uint(v[i]) & 0x7Fu); }
        }
        float cd[64];
        {   int n = 0;
#pragma unroll
            for (int a = 0; a < 16; ++a)
#pragma unroll
                for (int b = 0; b < 16; ++b) if ((a + 1) * (b + 1) <= 16) { cd[n] = key_pack(tk[0][a] + tk[1][b], 0xFFFFFF00u, (unsigned)(a * 16 + b)); ++n; }
#pragma unroll
            for (int i = 50; i < 64; ++i) cd[i] = -INFINITY;
        }
        sort_desc<16>(cd); sort_desc<16>(cd + 16); sort_desc<16>(cd + 32); CE_DESC(cd[48], cd[49]);
        merge16(cd, cd + 16); merge16(cd + 32, cd + 48); merge16(cd, cd + 32);
        int ex[16]; float gv[16]; float sum = 0.f;
        const float top = __uint_as_float(__float_as_uint(cd[0]) & 0xFFFFFF00u);
#pragma unroll
        for (int i = 0; i < 16; ++i) {
            const unsigned bits = __float_as_uint(cd[i]);
            const int a = (bits >> 4) & 15, b = bits & 15;
            ex[i] = lut[a * 64 + f_lane] * PK + lut[(16 + b) * 64 + f_lane];
            gv[i] = __expf(__uint_as_float(bits & 0xFFFFFF00u) - top); sum += gv[i];
        }
        const float inv = 1.f / sum;
        if (h == 0) {
            u32x4* ep = (u32x4*)(eidx + (size_t)t * NSEL + hh * 16);
#pragma unroll
            for (int q = 0; q < 4; ++q) ep[q] = (u32x4){(unsigned)ex[4 * q], (unsigned)ex[4 * q + 1], (unsigned)ex[4 * q + 2], (unsigned)ex[4 * q + 3]};
        } else {
            f32x4* gp = (f32x4*)(gate + (size_t)t * NSEL + hh * 16);
#pragma unroll
            for (int q = 0; q < 4; ++q) gp[q] = (f32x4){gv[4 * q] * inv, gv[4 * q + 1] * inv, gv[4 * q + 2] * inv, gv[4 * q + 3] * inv};
        }
    }
    __syncthreads();
}
struct XInfo { int xrank, nx, rank, nloc; };
DI XInfo get_xinfo(Frame& F, const bool census) {
    FRAME_IDS;
    volatile LAS unsigned* M = (volatile LAS unsigned*)(F.lds + MISC_OFF);
    __syncthreads();
    if (f_tid == 0) {
        unsigned xr = (unsigned)F.bid & 7u, nx = 8u, rk = (unsigned)F.bid >> 3, nl = ((unsigned)F.G + 7u - ((unsigned)F.bid & 7u)) >> 3;
        if (census) {
            unsigned* bar = (unsigned*)(F.ws + WS_CTL) + CW_BAR; const unsigned x = xb_xcc_id();
            unsigned cnt = 0u, below = 0u, mine = 0u;
#pragma unroll
            for (unsigned j = 0; j < 16; ++j) { const unsigned c = xb_ld(&bar[XB_XCNT(j)]); cnt += (c > 0u); below += (c > 0u && j < x); mine = (j == x) ? c : mine; }
            if (cnt > 0u && mine > 0u) { xr = below; nx = cnt; rk = M[12]; nl = mine; }
        }
        M[20] = xr; M[21] = nx; M[22] = rk; M[23] = nl;
    }
    __syncthreads();
    XInfo xi; xi.xrank = (int)M[20]; xi.nx = (int)M[21]; xi.rank = (int)M[22]; xi.nloc = (int)M[23];
    return xi;
}
DI int comb_c(const int level, const int a, const int b, const int lane) {
    const int M = 4 >> level; const bool bit = (lane & M) != 0;
    const int send = bit ? a : b, keep = bit ? b : a;
    const int recv = level == 0 ? DPP_MOV_I(send, DPP_HMIRROR) : (level == 1 ? DPP_MOV_I(send, DPP_XOR2) : DPP_MOV_I(send, DPP_XOR1));
    return keep + recv;
}
DI int dot16_i8(const u32x4 r, const u32x4 x) {
    int s = __builtin_amdgcn_sdot4((int)r[0], (int)x[0], 0, false);
    s = __builtin_amdgcn_sdot4((int)r[1], (int)x[1], s, false); s = __builtin_amdgcn_sdot4((int)r[2], (int)x[2], s, false); s = __builtin_amdgcn_sdot4((int)r[3], (int)x[3], s, false);
    return s;
}
DI int half_dots(const u32x4 (&rows)[8], const u32x4 xq, const int lane) {
    int p[8];
#pragma unroll
    for (int i = 0; i < 8; ++i) p[i] = dot16_i8(rows[i], xq);
#pragma unroll
    for (int i = 0; i < 4; ++i) p[i] = comb_c(0, p[2 * i], p[2 * i + 1], lane);
    p[0] = comb_c(1, p[0], p[1], lane); p[1] = comb_c(1, p[2], p[3], lane);
    return comb_c(2, p[0], p[1], lane);
}
DI u32x4 xquant(const f32x4 (&hv)[4], const float rstd) {
    u32x4 o;
#pragma unroll
    for (int w = 0; w < 4; ++w) {
        const f32x4 x = hv[w] * (rstd * XQ);
        const int a = (int)rintf(__builtin_amdgcn_fmed3f(x[0], -127.f, 127.f)), b = (int)rintf(__builtin_amdgcn_fmed3f(x[1], -127.f, 127.f)), c = (int)rintf(__builtin_amdgcn_fmed3f(x[2], -127.f, 127.f)), d = (int)rintf(__builtin_amdgcn_fmed3f(x[3], -127.f, 127.f));
        o[w] = ((unsigned)a & 0xFFu) | (((unsigned)b & 0xFFu) << 8) | (((unsigned)c & 0xFFu) << 16) | ((unsigned)d << 24);
    }
    return o;
}
DI float rstd_bcast(const float* part, const int t) {
    const f32x4* p = (const f32x4*)(part + (size_t)t * 16);
    const f32x4 a = p[0], b = p[1], c = p[2], d = p[3];
    const float s = ((a[0] + a[1]) + (a[2] + a[3])) + ((b[0] + b[1]) + (b[2] + b[3])) + ((c[0] + c[1]) + (c[2] + c[3])) + ((d[0] + d[1]) + (d[2] + d[3]));
    return 1.f / sqrtf(s * (1.f / DM) + EPS);
}
DI int dot32_i4(const u32x4 r, const u32x4 xh, const u32x4 xl) {
    int ah = 0, al = 0;
#pragma unroll
    for (int d = 0; d < 4; ++d) { ah = __builtin_amdgcn_sdot8((int)r[d], (int)xh[d], ah, false); al = __builtin_amdgcn_sdot8((int)r[d], (int)xl[d], al, false); }
    return (ah << 4) + al;
}
DI int half_dots4(const u32x4 (&rows)[8], const u32x4 xa, const u32x4 xb, const int lane) {
    int p[8];
#pragma unroll
    for (int i = 0; i < 8; ++i) p[i] = dot32_i4(rows[i], xa, xb);
#pragma unroll
    for (int i = 0; i < 4; ++i) p[i] = comb_c(0, p[2 * i], p[2 * i + 1], lane);
    p[0] = comb_c(1, p[0], p[1], lane); p[1] = comb_c(1, p[2], p[3], lane);
    return comb_c(2, p[0], p[1], lane);
}
DI void gather_u(Frame& F, const int layer, const XInfo xi, const bool dry) {
    FRAME_IDS;
    const unsigned emask = (dry && PROBE_MODE == 2) ? 15u : ((dry && PROBE_MODE == 5) ? 4095u : 0xFFFFFFFFu);
    const int* eidx = (const int*)(F.ws + WS_EIDX); int* PU = (int*)(F.ws + (dry ? WS_R : WS_PU)); const float* part = (const float*)(F.ws + WS_PART); const bf16* hbp = (const bf16*)(F.ws + WS_XB);
    const int g = f_lane >> 3, c = f_lane & 7, c16 = c * 16;
    const int kst = 16 * g + (((c & 1) << 2) | (c & 2) | ((c & 4) >> 2));
    const int gwl = xi.rank * NWAVES + F.wave, NGWL = xi.nloc * NWAVES;
    LAS unsigned char* wl = F.lds + F.wave * 2048;
    __syncthreads();
    for (int j = xi.xrank; j < 8; j += xi.nx) {
        const int sl = j & 3, th = j >> 2;
        const __amdgpu_buffer_rsrc_t U8 = __builtin_amdgcn_make_buffer_rsrc((void*)(F.ws + WS_U8 + ((size_t)(layer * 4 + sl) * PE) * 128), 0, PE * 128, 0x00020000);
        int tt = gwl;
        if (tt >= T / 2) continue;
#define TOK(x_) (2 * (x_) + th)
#define U_LOAD(tk, ri, rh, rp) do { ri = *(const u32x2*)(eidx + (size_t)(tk) * NSEL + 2 * f_lane) & emask; rh = *(const u32x2*)(hbp + (size_t)(tk) * DM + 256 * sl + 4 * f_lane); \
            rp = part[(size_t)(tk) * 16 + (f_lane & 15)]; } while (0)
#define U_SPREAD(slot, ri, rh, rp, e, xa_, xb_) do { \
            float ps_ = rp; ps_ += __int_as_float(DPP_MOV_I(__float_as_int(ps_), DPP_XOR1)); ps_ += __int_as_float(DPP_MOV_I(__float_as_int(ps_), DPP_XOR2)); ps_ += __int_as_float(DPP_MOV_I(__float_as_int(ps_), DPP_HMIRROR)); ps_ += __int_as_float(DPP_MOV_I(__float_as_int(ps_), DPP_ROR8)); \
            const float rs_ = (1.f / sqrtf(ps_ * (1.f / DM) + EPS)) * XQ; \
            const int q0_ = (int)rintf(__builtin_amdgcn_fmed3f(__uint_as_float(rh[0] << 16) * rs_, -119.f, 119.f)), q1_ = (int)rintf(__builtin_amdgcn_fmed3f(__uint_as_float(rh[0] & 0xffff0000u) * rs_, -119.f, 119.f)); \
            const int q2_ = (int)rintf(__builtin_amdgcn_fmed3f(__uint_as_float(rh[1] << 16) * rs_, -119.f, 119.f)), q3_ = (int)rintf(__builtin_amdgcn_fmed3f(__uint_as_float(rh[1] & 0xffff0000u) * rs_, -119.f, 119.f)); \
            const int h0_ = (q0_ + 8) >> 4, h1_ = (q1_ + 8) >> 4, h2_ = (q2_ + 8) >> 4, h3_ = (q3_ + 8) >> 4;     \
            unsigned wh_ = ((unsigned)h0_ & 0xFu) | (((unsigned)h1_ & 0xFu) << 8) | (((unsigned)h2_ & 0xFu) << 16) | (((unsigned)h3_ & 0xFu) << 24); \
            unsigned wl_ = ((unsigned)(q0_ - 16 * h0_) & 0xFu) | (((unsigned)(q1_ - 16 * h1_) & 0xFu) << 8) | (((unsigned)(q2_ - 16 * h2_) & 0xFu) << 16) | (((unsigned)(q3_ - 16 * h3_) & 0xFu) << 24); \
            if (f_lane & 1) { wh_ <<= 4; wl_ <<= 4; } \
            wh_ |= (unsigned)DPP_MOV_I((int)wh_, DPP_XOR1); wl_ |= (unsigned)DPP_MOV_I((int)wl_, DPP_XOR1); \
            LAS unsigned char* sl_ = wl + (slot) * 1024; \
            *(LAS u32x2*)(sl_ + 8 * f_lane) = ri; if (!(f_lane & 1)) { *(LAS unsigned*)(sl_ + 512 + 2 * f_lane) = wh_; *(LAS unsigned*)(sl_ + 768 + 2 * f_lane) = wl_; } \
            asm volatile("s_waitcnt lgkmcnt(0)" ::: "memory"); \
            _Pragma("unroll") for (int q_ = 0; q_ < 4; ++q_) e[q_] = *(const LAS u32x4*)(sl_ + 64 * g + 16 * q_); \
            xa_ = *(const LAS u32x4*)(sl_ + 512 + 16 * c); xb_ = *(const LAS u32x4*)(sl_ + 768 + 16 * c); } while (0)
        u32x2 ri, rh; float rp;
        u32x4 e0[4], e1[4], xa, xb, xa1, xb1;
        U_LOAD(TOK(tt), ri, rh, rp); U_SPREAD(0, ri, rh, rp, e0, xa, xb);
        { const int t1 = (tt + NGWL < T / 2) ? tt + NGWL : tt; U_LOAD(TOK(t1), ri, rh, rp); U_SPREAD(1, ri, rh, rp, e1, xa1, xb1); }
        { const int t2 = (tt + 2 * NGWL < T / 2) ? tt + 2 * NGWL : tt; U_LOAD(TOK(t2), ri, rh, rp); }
        u32x4 A0[8], B0[8], A1[8], B1[8];
#pragma unroll
        for (int i = 0; i < 8; ++i) A0[i] = __builtin_amdgcn_raw_buffer_load_b128(U8, (int)e0[i >> 2][i & 3] * 128 + c16, 0, 0);
#pragma unroll
        for (int i = 0; i < 8; ++i) B0[i] = __builtin_amdgcn_raw_buffer_load_b128(U8, (int)e0[2 + (i >> 2)][i & 3] * 128 + c16, 0, 0);
#define U_ITEM(CA, CB, NA, NB, slot) do { \
            _Pragma("unroll") for (int i = 0; i < 8; ++i) NA[i] = __builtin_amdgcn_raw_buffer_load_b128(U8, (int)e1[i >> 2][i & 3] * 128 + c16, 0, 0); \
            asm volatile("" ::: "memory"); \
            const int r0 = half_dots4(CA, xa, xb, f_lane); \
            _Pragma("unroll") for (int i = 0; i < 8; ++i) NB[i] = __builtin_amdgcn_raw_buffer_load_b128(U8, (int)e1[2 + (i >> 2)][i & 3] * 128 + c16, 0, 0); \
            asm volatile("" ::: "memory"); \
            const int rr1 = half_dots4(CB, xa, xb, f_lane); \
            int* pp = PU + ((size_t)TOK(tt) * 4 + sl) * NSEL + kst; \
            pp[0] = r0; pp[8] = rr1; \
            xa = xa1; xb = xb1; \
            U_SPREAD(slot, ri, rh, rp, e1, xa1, xb1);                   \
            { const int t3 = (tt + 3 * NGWL < T / 2) ? tt + 3 * NGWL : tt; U_LOAD(TOK(t3), ri, rh, rp); } } while (0)
        for (;;) {
            U_ITEM(A0, B0, A1, B1, 0); tt += NGWL; if (tt >= T / 2) break;
            U_ITEM(A1, B1, A0, B0, 1); tt += NGWL; if (tt >= T / 2) break;
        }
#undef U_ITEM
#undef U_LOAD
#undef U_SPREAD
#undef TOK
    }
    __syncthreads();
}
DI void gather_r(Frame& F, const int layer) {
    FRAME_IDS;
    const int* PU = (const int*)(F.ws + WS_PU); const float* gate = (const float*)(F.ws + WS_GATE); const int* eidx = (const int*)(F.ws + WS_EIDX);
    const float* SCu = (const float*)(F.ws + WS_SC) + (size_t)layer * PE; const float* SCv = (const float*)(F.ws + WS_SC) + (size_t)(2 + layer) * PE;
    signed char* A8 = (signed char*)(F.ws + WS_A); float* SA = (float*)(F.ws + WS_SA);
    const int gw = F.bid * NWAVES + F.wave, NGW = F.G * NWAVES;
    for (int t = gw; t < T; t += NGW) {
        float a[2];
#pragma unroll
        for (int hf = 0; hf < 2; ++hf) {
            const int k = 64 * hf + f_lane;
            int sacc = 0;
#pragma unroll
            for (int j = 0; j < 4; ++j) sacc += PU[((size_t)t * 4 + j) * NSEL + k];
            const int e = eidx[(size_t)t * NSEL + k];
            const float d = (float)sacc * (SCu[e] * (1.f / XQ));
            a[hf] = gelu_erf(d) * gate[(size_t)t * NSEL + k] * SCv[e];
        }
        const float am = wave_max(fmaxf(fabsf(a[0]), fabsf(a[1])));
        const float sc = am > 0.f ? 127.f / am : 0.f;
        A8[(size_t)t * NSEL + f_lane] = (signed char)(int)rintf(a[0] * sc);
        A8[(size_t)t * NSEL + 64 + f_lane] = (signed char)(int)rintf(a[1] * sc);
        if (f_lane == 0) SA[t] = am * (1.f / 127.f);
    }
}
DI void tr4x4(const unsigned w0, const unsigned w1, const unsigned w2, const unsigned w3, unsigned (&cdw)[4]) {
    const unsigned t01l = __builtin_amdgcn_perm(w1, w0, 0x05010400u), t01h = __builtin_amdgcn_perm(w1, w0, 0x07030602u);
    const unsigned t23l = __builtin_amdgcn_perm(w3, w2, 0x05010400u), t23h = __builtin_amdgcn_perm(w3, w2, 0x07030602u);
    cdw[0] = __builtin_amdgcn_perm(t23l, t01l, 0x05040100u); cdw[1] = __builtin_amdgcn_perm(t23l, t01l, 0x07060302u);
    cdw[2] = __builtin_amdgcn_perm(t23h, t01h, 0x05040100u); cdw[3] = __builtin_amdgcn_perm(t23h, t01h, 0x07060302u);
}
DI void axpy4rows(const u32x4 r0, const u32x4 r1, const u32x4 r2, const u32x4 r3, const unsigned a4, int (&ahi)[16], int (&aall)[16]) {
#pragma unroll
    for (int d = 0; d < 4; ++d) {
        unsigned cdw[4];
        tr4x4(r0[d], r1[d], r2[d], r3[d], cdw);
#pragma unroll
        for (int b = 0; b < 4; ++b) {
            aall[4 * d + b] = __builtin_amdgcn_sdot4((int)cdw[b], (int)a4, aall[4 * d + b], false);
            ahi[4 * d + b] = __builtin_amdgcn_sdot4((int)(cdw[b] & 0xF0F0F0F0u), (int)a4, ahi[4 * d + b], false);
        }
    }
}
DI void gather_v(Frame& F, const int layer, const XInfo xi, const bool dry) {
    FRAME_IDS;
    const int* eidx = (const int*)(F.ws + WS_EIDX); const unsigned char* A8 = F.ws + WS_A; const float* SA = (const float*)(F.ws + WS_SA);
    float* part_w = dry ? (float*)(F.ws + WS_R) : (float*)(F.ws + WS_PART); bf16* hb_w = dry ? (bf16*)(F.ws + WS_HID2) : (bf16*)(F.ws + WS_XB); const bf16* hbp = (const bf16*)(F.ws + WS_XB);
    const int g = f_lane >> 3, c = f_lane & 7, c16 = c * 16;
    const int cc = 32 * c + 16 * (g >> 2) + 8 * ((g >> 1) & 1) + 4 * (g & 1);
    const int gwl = xi.rank * NWAVES + F.wave, NGWL = xi.nloc * NWAVES;
    const bool b3 = (f_lane & 8) != 0;
    LAS unsigned char* wl = F.lds + F.wave * 2048;
    __syncthreads();
    for (int j = xi.xrank; j < 8; j += xi.nx) {
        const int sl = j & 3, th = j >> 2;
        const __amdgpu_buffer_rsrc_t V8 = __builtin_amdgcn_make_buffer_rsrc((void*)(F.ws + WS_V8 + ((size_t)(layer * 4 + sl) * PE) * 128), 0, PE * 128, 0x00020000);
        int tt = gwl;
        if (tt >= T / 2) continue;
#define TOK(x_) (2 * (x_) + th)
#define V_LOAD(tk, ri, ra, rs) do { ri = *(const u32x2*)(eidx + (size_t)(tk) * NSEL + 2 * f_lane); ra = *(const unsigned short*)(A8 + (size_t)(tk) * NSEL + 2 * f_lane); rs = SA[(tk)]; } while (0)
#define V_SPREAD(slot, ri, ra, rs, e, avv, sav) do { \
            LAS unsigned char* sl_ = wl + (slot) * 1024; \
            *(LAS u32x2*)(sl_ + 8 * f_lane) = ri; *(LAS unsigned short*)(sl_ + 512 + 2 * f_lane) = ra; \
            asm volatile("s_waitcnt lgkmcnt(0)" ::: "memory"); \
            _Pragma("unroll") for (int q_ = 0; q_ < 4; ++q_) e[q_] = *(const LAS u32x4*)(sl_ + 64 * g + 16 * q_); \
            avv = *(const LAS u32x4*)(sl_ + 512 + 16 * g); sav = rs; } while (0)
        u32x2 ri; unsigned short ra; float rs;
        u32x4 e0[4], e1[4], av, a1; float sa, sa1; u32x2 hold;
        V_LOAD(TOK(tt), ri, ra, rs); V_SPREAD(0, ri, ra, rs, e0, av, sa);
        { const int t1 = (tt + NGWL < T / 2) ? tt + NGWL : tt; V_LOAD(TOK(t1), ri, ra, rs); V_SPREAD(1, ri, ra, rs, e1, a1, sa1); }
        { const int t2 = (tt + 2 * NGWL < T / 2) ? tt + 2 * NGWL : tt; V_LOAD(TOK(t2), ri, ra, rs); }
        hold = *(const u32x2*)(hbp + (size_t)TOK(tt) * DM + 256 * sl + cc);
        u32x4 A0[8], B0[8], A1[8], B1[8];
#pragma unroll
        for (int i = 0; i < 8; ++i) A0[i] = __builtin_amdgcn_raw_buffer_load_b128(V8, (int)e0[i >> 2][i & 3] * 128 + c16, 0, 0);
#pragma unroll
        for (int i = 0; i < 8; ++i) B0[i] = __builtin_amdgcn_raw_buffer_load_b128(V8, (int)e0[2 + (i >> 2)][i & 3] * 128 + c16, 0, 0);
#define V_ITEM(CA, CB, NA, NB, slot) do { \
            const int t1 = (tt + NGWL < T / 2) ? tt + NGWL : tt; \
            const u32x2 hold1 = *(const u32x2*)(hbp + (size_t)TOK(t1) * DM + 256 * sl + cc); \
            _Pragma("unroll") for (int i = 0; i < 8; ++i) NA[i] = __builtin_amdgcn_raw_buffer_load_b128(V8, (int)e1[i >> 2][i & 3] * 128 + c16, 0, 0); \
            asm volatile("" ::: "memory"); \
            int ahi[16], aall[16]; \
            _Pragma("unroll") for (int n = 0; n < 16; ++n) { ahi[n] = 0; aall[n] = 0; } \
            axpy4rows(CA[0], CA[1], CA[2], CA[3], av[0], ahi, aall); axpy4rows(CA[4], CA[5], CA[6], CA[7], av[1], ahi, aall); \
            _Pragma("unroll") for (int i = 0; i < 8; ++i) NB[i] = __builtin_amdgcn_raw_buffer_load_b128(V8, (int)e1[2 + (i >> 2)][i & 3] * 128 + c16, 0, 0); \
            asm volatile("" ::: "memory"); \
            axpy4rows(CB[0], CB[1], CB[2], CB[3], av[2], ahi, aall); axpy4rows(CB[4], CB[5], CB[6], CB[7], av[3], ahi, aall); \
            int sa8 = __builtin_amdgcn_sdot4(0x01010101, (int)av[0], 0, false); sa8 = __builtin_amdgcn_sdot4(0x01010101, (int)av[1], sa8, false); sa8 = __builtin_amdgcn_sdot4(0x01010101, (int)av[2], sa8, false); sa8 = __builtin_amdgcn_sdot4(0x01010101, (int)av[3], sa8, false); \
            sa8 *= 8; \
            int acc[32];                                                \
            _Pragma("unroll") for (int d_ = 0; d_ < 4; ++d_) _Pragma("unroll") for (int b_ = 0; b_ < 4; ++b_) { acc[8 * d_ + 4 + b_] = ahi[4 * d_ + b_]; acc[8 * d_ + b_] = (aall[4 * d_ + b_] - ahi[4 * d_ + b_] - sa8) << 4; } \
            int r16[16], r8[8]; float hv[4]; \
            _Pragma("unroll") for (int n = 0; n < 16; ++n) r16[n] = swap32_addi(acc[n], acc[16 + n]); \
            _Pragma("unroll") for (int n = 0; n < 8; ++n) r8[n] = swap16_addi(r16[n], r16[8 + n]); \
            _Pragma("unroll") for (int n = 0; n < 4; ++n) { const int keep = b3 ? r8[4 + n] : r8[n], send = b3 ? r8[n] : r8[4 + n]; hv[n] = (float)(keep + DPP_MOV_I(send, DPP_ROR8)) * sa; } \
            hv[0] += __uint_as_float(hold[0] << 16); hv[1] += __uint_as_float(hold[0] & 0xffff0000u); hv[2] += __uint_as_float(hold[1] << 16); hv[3] += __uint_as_float(hold[1] & 0xffff0000u); \
            const float ss = wave_sum_fast((hv[0] * hv[0] + hv[1] * hv[1]) + (hv[2] * hv[2] + hv[3] * hv[3])); \
            *(u32x2*)(hb_w + (size_t)TOK(tt) * DM + 256 * sl + cc) = (u32x2){cvtpk(hv[0], hv[1]), cvtpk(hv[2], hv[3])}; \
            if (f_lane == 0) part_w[(size_t)TOK(tt) * 16 + sl] = ss; \
            if (sl == 0 && f_lane >= 4 && f_lane < 16) part_w[(size_t)TOK(tt) * 16 + f_lane] = 0.f; \
            av = a1; sa = sa1; hold = hold1; \
            V_SPREAD(slot, ri, ra, rs, e1, a1, sa1); \
            { const int t3 = (tt + 3 * NGWL < T / 2) ? tt + 3 * NGWL : tt; V_LOAD(TOK(t3), ri, ra, rs); } } while (0)
        for (;;) {
            V_ITEM(A0, B0, A1, B1, 0); tt += NGWL; if (tt >= T / 2) break;
            V_ITEM(A1, B1, A0, B0, 1); tt += NGWL; if (tt >= T / 2) break;
        }
#undef V_ITEM
#undef V_LOAD
#undef V_SPREAD
#undef TOK
    }
    __syncthreads();
}
DI void final_norm(Frame& F) {
    FRAME_IDS;
    const float* part = (const float*)(F.ws + WS_PART); const bf16* hbp = (const bf16*)(F.ws + WS_XB);
    const int gw = F.bid * NWAVES + F.wave, NGW = F.G * NWAVES;
    for (int t = gw; t < T; t += NGW) {
        const float r = rstd_bcast(part, t);
        const u32x2* hp = (const u32x2*)(hbp + (size_t)t * DM) + f_lane;
        f32x4* op = (f32x4*)(F.out + (size_t)t * DM) + f_lane;
        const f32x4* gp = (const f32x4*)F.final_norm + f_lane;
#pragma unroll
        for (int q = 0; q < 4; ++q) { const u32x2 w = hp[64 * q];
            const f32x4 h = {__uint_as_float(w[0] << 16), __uint_as_float(w[0] & 0xffff0000u), __uint_as_float(w[1] << 16), __uint_as_float(w[1] & 0xffff0000u)};
            op[64 * q] = h * r * gp[64 * q]; }
    }
}
DI void opt_conv(Frame& F) {
    FRAME_IDS;
    const bf16* G = (const bf16*)(F.ws + WS_GLU); bf16* H2 = (bf16*)(F.ws + WS_HID2);
    LAS float* ys = (LAS float*)F.lds;
    f32x2 wt[CW];
#pragma unroll
    for (int j = 0; j < CW; ++j) wt[j] = *(const f32x2*)(F.conv_dw + j * DM + 2 * f_tid);
    const f32x2 bdw = *(const f32x2*)(F.conv_dw_b + 2 * f_tid);
    f32x4 lng[4], lnb[4];
#pragma unroll
    for (int k = 0; k < 4; ++k) { lng[k] = *(const f32x4*)(F.conv_ln_g + 256 * k + 4 * f_lane); lnb[k] = *(const f32x4*)(F.conv_ln_b + 256 * k + 4 * f_lane); }
    for (int it = F.bid; it < T / 128; it += F.G) {
        const int s0 = (it % (SEQ / 128)) * 128;
        const size_t row0 = (size_t)it * 128;
        const unsigned* gp = (const unsigned*)G + f_tid;
        f32x2 win[CW];
#pragma unroll
        for (int u = 0; u < CW - 1; ++u) { const int sp = s0 - (CW - 1) + u; const unsigned xv = sp >= 0 ? gp[(row0 - (CW - 1) + u) * 512] : 0u; win[u + 1] = (f32x2){__uint_as_float(xv << 16), __uint_as_float(xv & 0xffff0000u)}; }
        win[0] = (f32x2){0.f, 0.f};
        unsigned nx[CW], nn[CW];
#pragma unroll
        for (int u = 0; u < CW; ++u) nx[u] = (s0 + u < SEQ) ? gp[(row0 + u) * 512] : 0u;
        for (int bt = 0; bt < 5; ++bt) {
#pragma unroll
            for (int u = 0; u < CW; ++u) { const int sl = 31 * (bt + 1) + u; nn[u] = (bt < 4 && s0 + sl < SEQ) ? gp[(row0 + sl) * 512] : 0u; }
            __syncthreads();
#pragma unroll
            for (int u = 0; u < CW; ++u) {
                win[u] = (f32x2){__uint_as_float(nx[u] << 16), __uint_as_float(nx[u] & 0xffff0000u)};
                f32x2 a = bdw;
#pragma unroll
                for (int j = 0; j < CW; ++j) a = wt[j] * win[(u + 1 + j) % CW] + a;
                *(LAS f32x2*)(ys + u * DM + 2 * f_tid) = a;
            }
            __syncthreads();
            for (int u = F.wave; u < CW; u += NWAVES) {
                const int sl = 31 * bt + u;
                if (sl < 128) {
                    f32x4 v[4]; float sm = 0.f;
#pragma unroll
                    for (int k = 0; k < 4; ++k) { v[k] = *(const LAS f32x4*)(ys + u * DM + 256 * k + 4 * f_lane); sm += (v[k][0] + v[k][1]) + (v[k][2] + v[k][3]); }
                    const float mu = wave_sum(sm) * (1.f / DM);
                    float sq = 0.f;
#pragma unroll
                    for (int k = 0; k < 4; ++k) { v[k] = v[k] - mu; sq += (v[k][0] * v[k][0] + v[k][1] * v[k][1]) + (v[k][2] * v[k][2] + v[k][3] * v[k][3]); }
                    const float rs = 1.f / sqrtf(wave_sum(sq) * (1.f / DM) + EPS);
#pragma unroll
                    for (int k = 0; k < 4; ++k) {
                        f32x4 z = v[k] * rs * lng[k] + lnb[k];
#pragma unroll
                        for (int e = 0; e < 4; ++e) z[e] = z[e] / (1.f + __expf(-z[e]));
                        *(u32x2*)(H2 + (row0 + sl) * DM + 256 * k + 4 * f_lane) = (u32x2){cvtpk(z[0], z[1]), cvtpk(z[2], z[3])};
                    }
                }
            }
#pragma unroll
            for (int u = 0; u < CW; ++u) nx[u] = nn[u];
        }
    }
    __syncthreads();
}
enum Phase { PH_PREP = 0, PH_PREPW, PH_PROJ, PH_MIX, PH_WOUT, PH_Q0, PH_GU0, PH_GR0, PH_GV0, PH_W1, PH_CONV, PH_W2, PH_Q1, PH_GU1, PH_GR1, PH_GV1, PH_FINAL, PH_COUNT };
struct Args { const float* in[19]; float* out; unsigned char* ws; int ph_lo, ph_hi; };
#ifndef TEST_PHASE
#define TEST_PHASE -1
#endif

__global__ void __launch_bounds__(NTHR, 2) mega_fwd(Args args) {
    extern __shared__ __attribute__((aligned(16))) unsigned char lds[];
    Frame F;
    F.lds = (LAS unsigned char*)lds;
    F.wave = __builtin_amdgcn_readfirstlane((int)threadIdx.x >> 6); FRAME_IDS;
    F.G = gridDim.x; F.bid = blockIdx.x;
    F.x = args.in[0]; F.mix_norm = args.in[1]; F.ffn_norm = args.in[2]; F.final_norm = args.in[3]; F.w_in = args.in[4]; F.w_out = args.in[5]; F.rel_bias = args.in[6];
    F.conv_w1 = args.in[7]; F.conv_b1 = args.in[8]; F.conv_dw = args.in[9]; F.conv_dw_b = args.in[10]; F.conv_ln_g = args.in[11]; F.conv_ln_b = args.in[12];
    F.conv_w2 = args.in[13]; F.conv_b2 = args.in[14]; F.peer_wq = args.in[15]; F.peer_keys = args.in[16]; F.peer_u = args.in[17]; F.peer_v = args.in[18];
    F.out = args.out; F.ws = args.ws;
    volatile LAS unsigned* MISC = (volatile LAS unsigned*)(F.lds + MISC_OFF);
    for (int u = f_tid; u < (LDS_BYTES - LDSCTL_OFF) / 4; u += NTHR) ((LAS unsigned*)(F.lds + LDSCTL_OFF))[u] = 0u;
    __syncthreads();
    const int lo = args.ph_lo, hi = args.ph_hi;
    XcdBarrier bar; bar.bar = (unsigned*)(F.ws + WS_CTL) + CW_BAR; bar.x = 0; bar.st = nullptr;
    if (hi - lo > 1) bar = xcd_barrier_post((unsigned*)(F.ws + WS_CTL) + CW_BAR, MISC + 8);
#define IN(k) ((TEST_PHASE < 0 || TEST_PHASE == (k)) && lo <= (k) && (k) < hi)
#define SEAM(k) do { if (IN(k) && IN((k) + 1)) xcd_barrier(bar, F.wave); } while (0)
#define REPS(k) for (int rep_ = ((k) == REP_PHASE ? 0 : 1); rep_ < 2; ++rep_)
#define GEMM_PHASE(EPI, Aptr, Bptr, NN, ...) do { pg8::Gemm g{(const bf16*)(Aptr), (const bf16*)(Bptr), T, (NN), DM}; pg8::StaticOrder S; S.init(T, (NN), F.G, F.bid); \
        pg8::EPI E{__VA_ARGS__}; pg8::gemm_phase<pg8::EPI, pg8::StaticOrder, true, true>(F.lds, g, S, E, F.wave); } while (0)
    bf16* XB = (bf16*)(F.ws + WS_XB);
    float* PART = (float*)(F.ws + WS_PART); const float* ROPE = (const float*)(F.ws + WS_ROPE);
    if (IN(PH_PREP)) REPS(PH_PREP) { p0_prep(F); p0_weights(F, 0); } SEAM(PH_PREP);
    if (IN(PH_PREPW)) REPS(PH_PREPW) { p0_weights(F, 1); } SEAM(PH_PREPW);
    if (PROBE_MODE == 9 && IN(PH_PREP) && IN(PH_PREP + 1)) { for (int xb_ = 0; xb_ < 8; ++xb_) xcd_barrier(bar, F.wave); }
    if (IN(PH_PROJ)) REPS(PH_PROJ) { { pg8::Gemm g{(const bf16*)XB, (const bf16*)(F.ws + WS_WIN), T, INC, DM / 2}; pg8::StaticOrder S; S.init(T, INC, F.G, F.bid); pg8::EpiProj8 E{(bf16*)(F.ws + WS_R), ROPE, (const float*)(F.ws + WS_ROWSC), (const float*)(F.ws + WS_COLSC)}; pg8::gemm_phase<pg8::EpiProj8, pg8::StaticOrder, true, true, true>(F.lds, g, S, E, F.wave); } } SEAM(PH_PROJ);
    if (IN(PH_MIX)) REPS(PH_MIX) { mix_phase(F, rep_); } SEAM(PH_MIX);
    if (IN(PH_WOUT)) REPS(PH_WOUT) { GEMM_PHASE(EpiRes, F.ws + WS_O, F.ws + WS_WOUT, DM, F.x, XB, PART, nullptr); } SEAM(PH_WOUT);
    if (IN(PH_Q0)) REPS(PH_Q0) { GEMM_PHASE(EpiQ, XB, F.ws + WS_WQ, DM, (bf16*)(F.ws + WS_Q), PART); asm volatile("s_waitcnt vmcnt(0)" ::: "memory"); __syncthreads(); opt_route(F, 0); } SEAM(PH_Q0);
    const bool census = (hi - lo > 1);
    if (IN(PH_GU0)) REPS(PH_GU0) { gather_u(F, 0, get_xinfo(F, census), rep_ == 0); } SEAM(PH_GU0);
    if (IN(PH_GR0)) REPS(PH_GR0) { gather_r(F, 0); } SEAM(PH_GR0);
    if (IN(PH_GV0)) REPS(PH_GV0) { gather_v(F, 0, get_xinfo(F, census), rep_ == 0); } SEAM(PH_GV0);
    if (IN(PH_W1)) REPS(PH_W1) { GEMM_PHASE(EpiGlu, XB, F.ws + WS_W1, 2 * DM, (bf16*)(F.ws + WS_GLU), PART, F.conv_b1); } SEAM(PH_W1);
    if (IN(PH_CONV)) REPS(PH_CONV) { opt_conv(F); } SEAM(PH_CONV);
    if (IN(PH_W2)) { GEMM_PHASE(EpiRes, F.ws + WS_HID2, F.ws + WS_W2, DM, nullptr, XB, PART, F.conv_b2); } SEAM(PH_W2);
    if (IN(PH_Q1)) REPS(PH_Q1) { GEMM_PHASE(EpiQ, XB, F.ws + WS_WQ + (size_t)DM * DM * 2, DM, (bf16*)(F.ws + WS_Q), PART); asm volatile("s_waitcnt vmcnt(0)" ::: "memory"); __syncthreads(); opt_route(F, 1); } SEAM(PH_Q1);
    if (IN(PH_GU1)) REPS(PH_GU1) { gather_u(F, 1, get_xinfo(F, census), rep_ == 0); } SEAM(PH_GU1);
    if (IN(PH_GR1)) REPS(PH_GR1) { gather_r(F, 1); } SEAM(PH_GR1);
    if (IN(PH_GV1)) REPS(PH_GV1) { gather_v(F, 1, get_xinfo(F, census), rep_ == 0); } SEAM(PH_GV1);
    if (IN(PH_FINAL)) { final_norm(F); }
#undef IN
#undef SEAM
}

extern "C" void kernel_launch(void* const* d_in, const int* in_sizes, int n_in, void* d_out, int out_size, void* d_ws, size_t ws_size, hipStream_t stream) {
    static int grid = 0;
    if (grid == 0) {
        if (n_in != 19 || out_size != T * DM || ws_size < WS_END) { fprintf(stderr, "kernel_launch: unexpected shapes (n_in %d out %d ws %zu)\n", n_in, out_size, ws_size); grid = -1; return; }
        int dev = 0, cus = 0;
        if (hipGetDevice(&dev) != hipSuccess || hipDeviceGetAttribute(&cus, hipDeviceAttributeMultiprocessorCount, dev) != hipSuccess) { grid = -1; return; }
        if (hipFuncSetAttribute((const void*)mega_fwd, hipFuncAttributeMaxDynamicSharedMemorySize, LDS_BYTES) != hipSuccess) { fprintf(stderr, "kernel_launch: hipFuncSetAttribute failed\n"); grid = -1; return; }
        (void)hipGetLastError();
        grid = cus;
    }
    if (grid < 0) return;
    (void)hipMemsetAsync((char*)d_ws + WS_CTL, 0, CTL_ZERO_BYTES, stream);
    Args a{};
    for (int i = 0; i < 19; ++i) a.in[i] = (const float*)d_in[i];
    a.out = (float*)d_out; a.ws = (unsigned char*)d_ws;
#if MK_ONE_LAUNCH
    a.ph_lo = 0; a.ph_hi = PH_COUNT;
    hipLaunchKernelGGL(mega_fwd, dim3(grid), dim3(NTHR), LDS_BYTES, stream, a);
#else
    for (int p = 0; p < PH_COUNT; ++p) { a.ph_lo = p; a.ph_hi = p + 1; hipLaunchKernelGGL(mega_fwd, dim3(grid), dim3(NTHR), LDS_BYTES, stream, a); }
#endif
}
```

```cpp
#include <hip/hip_runtime.h>
#include <cstdio>
#include <cstdint>

#ifndef REP_PHASE
#define REP_PHASE -1
#endif
#ifndef PROBE_MODE
#define PROBE_MODE 1
#endif
#ifndef MK_ONE_LAUNCH
#define MK_ONE_LAUNCH 1
#endif

#define GAS __attribute__((address_space(1)))
#define LAS __attribute__((address_space(3)))
#define DI __device__ __forceinline__
typedef unsigned short bf16;
typedef float f32x2 __attribute__((ext_vector_type(2)));
typedef float f32x4 __attribute__((ext_vector_type(4)));
typedef unsigned u32x2 __attribute__((ext_vector_type(2)));
typedef unsigned u32x4 __attribute__((ext_vector_type(4)));
typedef short bf16x8 __attribute__((ext_vector_type(8)));
typedef float f32x16 __attribute__((ext_vector_type(16)));

constexpr int NB = 16, SEQ = 2048, DM = 1024, T = NB * SEQ;
constexpr int CHUNK = 64, HD = 64, NHA = 8, NHB = 8, INC = 3584, NCH = SEQ / CHUNK;
constexpr int PH = 8, PK = 128, PE = PK * PK, PQD = 128, PTOP = 16, NSEL = PH * PTOP;
constexpr int CW = 31;
constexpr float EPS = 1e-6f;
constexpr float LOG2E = 1.4426950408889634f;
constexpr float XQ = 127.f / 6.f;
constexpr int NWAVES = 8, NTHR = NWAVES * 64;

constexpr int C_QA = 0, C_KA = 512, C_VA = 1024, C_QB = 1536, C_KB = 2048, C_VB = 2560, C_GB = 3072;

constexpr size_t MiB = 1u << 20;
constexpr size_t WS_CTL = 0, CTL_ZERO_BYTES = 1 * MiB;
constexpr size_t WS_WIN = 2 * MiB, WS_WOUT = 9 * MiB, WS_W1 = 11 * MiB, WS_W2 = 15 * MiB, WS_WQ = 17 * MiB;
constexpr size_t WS_ROPE = 22 * MiB;
constexpr size_t WS_PART = 23 * MiB;
constexpr size_t WS_EIDX = 26 * MiB;
constexpr size_t WS_GATE = 42 * MiB;
constexpr size_t WS_U8 = 64 * MiB, WS_V8 = 96 * MiB;
constexpr size_t WS_SC = 25 * MiB;
constexpr size_t WS_ROWSC = 59 * MiB;
constexpr size_t WS_COLSC = 60 * MiB;
constexpr size_t WS_SA = 58 * MiB;
constexpr size_t WS_PU = 256 * MiB;
constexpr size_t WS_A = 384 * MiB;
constexpr size_t WS_XB = 128 * MiB;
constexpr size_t WS_R = 192 * MiB;
constexpr size_t WS_O = 416 * MiB;
constexpr size_t WS_Q = 192 * MiB;
constexpr size_t WS_HID = 256 * MiB;
constexpr size_t WS_GLU = 384 * MiB;
constexpr size_t WS_HID2 = 448 * MiB;
constexpr size_t WS_END = 512 * MiB;
constexpr int CW_BAR = 4096, CW_QUEUE = 8192;

constexpr int RING_BYTES = 131072, LDSCTL_OFF = RING_BYTES, MISC_OFF = LDSCTL_OFF + 320, LDS_BYTES = 147456;

DI float bf2f(bf16 v) { return __uint_as_float(((unsigned)v) << 16); }
DI unsigned f2bf(float f) { unsigned u = __float_as_uint(f); return (u + 0x7fffu + ((u >> 16) & 1u)) >> 16; }
DI unsigned pk2(float lo, float hi) { return f2bf(lo) | (f2bf(hi) << 16); }
#define DPP_MOV_I(x, ctrl) __builtin_amdgcn_mov_dpp((x), (ctrl), 0xF, 0xF, false)
#define DPP_XOR1 0xB1
#define DPP_XOR2 0x4E
#define DPP_HMIRROR 0x141
#define DPP_ROR8 0x128
DI float swap32_add(const float a, const float b) { const auto r = __builtin_amdgcn_permlane32_swap(__float_as_uint(a), __float_as_uint(b), false, false); return __uint_as_float(r[0]) + __uint_as_float(r[1]); }
DI float swap16_add(const float a, const float b) { const auto r = __builtin_amdgcn_permlane16_swap(__float_as_uint(a), __float_as_uint(b), false, false); return __uint_as_float(r[0]) + __uint_as_float(r[1]); }
DI int swap32_addi(const int a, const int b) { const auto r = __builtin_amdgcn_permlane32_swap((unsigned)a, (unsigned)b, false, false); return (int)(r[0] + r[1]); }
DI int swap16_addi(const int a, const int b) { const auto r = __builtin_amdgcn_permlane16_swap((unsigned)a, (unsigned)b, false, false); return (int)(r[0] + r[1]); }
DI float wave_sum_fast(float v) {
    v += __int_as_float(DPP_MOV_I(__float_as_int(v), DPP_XOR1)); v += __int_as_float(DPP_MOV_I(__float_as_int(v), DPP_XOR2));
    v += __int_as_float(DPP_MOV_I(__float_as_int(v), DPP_HMIRROR)); v += __int_as_float(DPP_MOV_I(__float_as_int(v), DPP_ROR8));
    v = swap16_add(v, v); v = swap32_add(v, v);
    return v;
}
DI float wave_sum(float v) { return wave_sum_fast(v); }
DI float swap32_max(const float a) { const auto r = __builtin_amdgcn_permlane32_swap(__float_as_uint(a), __float_as_uint(a), false, false); return fmaxf(__uint_as_float(r[0]), __uint_as_float(r[1])); }
DI float swap16_max(const float a) { const auto r = __builtin_amdgcn_permlane16_swap(__float_as_uint(a), __float_as_uint(a), false, false); return fmaxf(__uint_as_float(r[0]), __uint_as_float(r[1])); }
DI float wave_max(float v) {
    v = fmaxf(v, __int_as_float(DPP_MOV_I(__float_as_int(v), DPP_XOR1))); v = fmaxf(v, __int_as_float(DPP_MOV_I(__float_as_int(v), DPP_XOR2)));
    v = fmaxf(v, __int_as_float(DPP_MOV_I(__float_as_int(v), DPP_HMIRROR))); v = fmaxf(v, __int_as_float(DPP_MOV_I(__float_as_int(v), DPP_ROR8)));
    v = swap16_max(v); v = swap32_max(v);
    return v;
}
DI float block_sum(float v, LAS float* red, int tid) {
    v = wave_sum(v);
    __syncthreads();
    if ((tid & 63) == 0) red[tid >> 6] = v;
    __syncthreads();
    float s = 0.f;
#pragma unroll
    for (int i = 0; i < NWAVES; ++i) s += red[i];
    return s;
}
DI float gelu_erf(float x) { return 0.5f * x * (1.f + erff(x * 0.70710678118654752f)); }
DI float sigmoidf(float x) { return 1.f / (1.f + __expf(-x)); }

DI int lane_id() { int r; asm volatile("v_mbcnt_lo_u32_b32 %0, -1, 0\n\tv_mbcnt_hi_u32_b32 %0, -1, %0" : "=v"(r)); return r; }
#define XB_TMO      128
#define XB_XCNT(j)  (256  + 64 * (j))
#define XB_XSUB(j)  (1280 + 64 * (j))
#define XB_XGEN(j)  (2304 + 64 * (j))
#define XB_TOP      3328
#define XB_TOPGEN   3392
#define XCD_BAR_WORDS 3456
#define XB_SPIN_CAP (1u << 22)
DI unsigned xb_ld(unsigned* p)              { return __hip_atomic_load(p, __ATOMIC_RELAXED, __HIP_MEMORY_SCOPE_AGENT); }
DI unsigned xb_add(unsigned* p, unsigned v) { return __hip_atomic_fetch_add(p, v, __ATOMIC_RELAXED, __HIP_MEMORY_SCOPE_AGENT); }
DI unsigned xb_xcc_id() { return (unsigned)__builtin_amdgcn_s_getreg((3 << 11) | 20) & 0xFu; }
#define XB_SPIN(cond, bar) do { unsigned _sp = 0; while (cond) { __builtin_amdgcn_s_sleep(1); \
    if ((++_sp & 255u) == 0u) { if (xb_ld(&(bar)[XB_TMO])) break; if (_sp > XB_SPIN_CAP) { atomicAdd(&(bar)[XB_TMO], 1u); break; } } } } while (0)
struct XcdBarrier { unsigned* bar; unsigned x; volatile LAS unsigned* st; };
DI XcdBarrier xcd_barrier_post(unsigned* bar, volatile LAS unsigned* st) {
    XcdBarrier b; b.bar = bar; b.x = xb_xcc_id(); b.st = st;
    if (threadIdx.x == 0) st[4] = xb_add(&bar[XB_XCNT(b.x)], 1u);
    return b;
}
DI void xcd_barrier_complete(unsigned* bar, unsigned x, unsigned& nloc, unsigned& nx) {
    const unsigned G = gridDim.x * gridDim.y * gridDim.z;
    unsigned sum, cnt, mine, sp = 0u;
    for (;;) {
        sum = 0u; cnt = 0u; mine = 0u;
#pragma unroll
        for (unsigned j = 0; j < 16; ++j) { const unsigned c = xb_ld(&bar[XB_XCNT(j)]); sum += c; cnt += (c > 0u) ? 1u : 0u; mine = (j == x) ? c : mine; }
        if (sum == G) break;
        __builtin_amdgcn_s_sleep(1);
        if ((++sp & 255u) == 0u) { if (xb_ld(&bar[XB_TMO])) break; if (sp > XB_SPIN_CAP) { atomicAdd(&bar[XB_TMO], 1u); break; } }
    }
    nloc = mine > 0u ? mine : 1u; nx = cnt > 0u ? cnt : 1u;
}
DI void xcd_barrier(const XcdBarrier& b, const int wave_id) {
    asm volatile("s_waitcnt vmcnt(0)" ::: "memory");
    __syncthreads();
    if (wave_id == 0 && lane_id() == 0) {
        unsigned* bar = b.bar;
        __builtin_amdgcn_s_waitcnt(0);
        unsigned nloc = b.st[0], nx = b.st[1];
        if (nloc == 0u) { xcd_barrier_complete(bar, b.x, nloc, nx); b.st[0] = nloc; b.st[1] = nx; }
        const unsigned old = xb_add(&bar[XB_XSUB(b.x)], 1u);
        const unsigned gen = old / nloc;
        if (old + 1u == (gen + 1u) * nloc) {
            __builtin_amdgcn_fence(__ATOMIC_RELEASE, "agent");
            asm volatile("s_waitcnt vmcnt(0)" ::: "memory");
            const unsigned og = xb_add(&bar[XB_TOP], 1u);
            const unsigned tg = og / nx;
            if (og + 1u == (tg + 1u) * nx) xb_add(&bar[XB_TOPGEN], 1u);
            else XB_SPIN(xb_ld(&bar[XB_TOPGEN]) == tg, bar);
            __builtin_amdgcn_fence(__ATOMIC_ACQUIRE, "agent");
            xb_add(&bar[XB_XGEN(b.x)], 1u);
            asm volatile("s_waitcnt vmcnt(0)" ::: "memory");
        } else {
            XB_SPIN(xb_ld(&bar[XB_XGEN(b.x)]) == gen, bar);
            __builtin_amdgcn_fence(__ATOMIC_ACQUIRE, "agent");
            asm volatile("s_waitcnt vmcnt(0)" ::: "memory");
        }
    }
    __syncthreads();
}

namespace pg8 {
#define PG8_LAS __attribute__((address_space(3)))
typedef unsigned short bf16_t;
typedef short bf16x8 __attribute__((ext_vector_type(8)));
typedef float f32x4 __attribute__((ext_vector_type(4)));
typedef unsigned u32x4 __attribute__((ext_vector_type(4)));
typedef int i32x4 __attribute__((ext_vector_type(4)));
constexpr int BM = 256, BK = 64, HALF = 128, HTB = HALF * BK * 2  , STAGE_BYTES = 8 * HTB, NXCD = 8, WGM = 8;

__host__ __device__ __forceinline__ int lds_byte(int r, int c) { const int st = (r >> 4) * 2 + (c >> 5), rr = r & 15, cc = c & 31, ob = rr * 64 + cc * 2; return st * 1024 + (ob ^ (((ob >> 9) & 1) << 5)); }
__host__ __device__ __forceinline__ void stage_rc(int b, int& R, int& C) { const int st = b / 1024, sb = b % 1024, swz = sb ^ (((sb >> 9) & 1) << 5); R = (st >> 1) * 16 + swz / 64; C = (st & 1) * 32 + (swz % 64) / 2; }
__host__ __device__ __forceinline__ int perm32(int rho) { const int n = rho >> 4, i = rho & 15; return 8 * (i >> 2) + 4 * n + (i & 3); }

struct Unit { int pm, pn; };
struct Gemm { const bf16_t* A; const bf16_t* Bt; int M, N, K; };

struct StaticOrder {
    int nM, nN, nwg, G, c;
    __host__ __device__ void init(int M, int N, int G_, int c_) { nM = M / BM; nN = N / BM; nwg = nM * nN; G = G_; c = c_; }
    __host__ __device__ bool next(int i, Unit& u) const {
        const long L = (long)i * G + c; if (L >= nwg) return false;
        int wgid = (int)L; { const int q = nwg / NXCD, r = nwg % NXCD, xcd = wgid % NXCD, off = wgid / NXCD; wgid = (xcd < r ? xcd * (q + 1) : r * (q + 1) + (xcd - r) * q) + off; }
        const int nig = WGM * nN, gid = wgid / nig, fm = gid * WGM, gsz = (nM - fm) < WGM ? (nM - fm) : WGM;
        u.pm = fm + ((wgid % nig) % gsz); u.pn = (wgid % nig) / gsz; return true;
    }
    __device__ __forceinline__ void a_ready(const Unit&) const {}
    __device__ __forceinline__ void done(const Unit&) const {}
};

__device__ __forceinline__ unsigned cvt_pk_bf16(float lo, float hi) { unsigned r; asm volatile("v_cvt_pk_bf16_f32 %0, %1, %2" : "=v"(r) : "v"(lo), "v"(hi)); return r; }
__device__ __forceinline__ float rstd16(const float* part, int r, int fq) {
    const f32x4 a = *(const f32x4*)(part + (size_t)r * 16 + 4 * fq);
    float s = (a[0] + a[1]) + (a[2] + a[3]);
    s = swap16_add(s, s); s = swap32_add(s, s);
    return 1.f / sqrtf(s * (1.f / 1024.f) + 1e-6f);
}
__device__ __forceinline__ u32x4 pack8(const f32x4 a, const f32x4 b) { u32x4 w; w.x = cvt_pk_bf16(a[0], a[1]); w.y = cvt_pk_bf16(a[2], a[3]); w.z = cvt_pk_bf16(b[0], b[1]); w.w = cvt_pk_bf16(b[2], b[3]); return w; }
#define rot(t1, t2, c, s) do { const float a_ = (t1) * (c) - (t2) * (s), b_ = (t1) * (s) + (t2) * (c); (t1) = a_; (t2) = b_; } while (0)

struct EpiProj8 {
    static constexpr bool PERM = true, AFTER_DRAIN = false;
    bf16_t* R; const float* rope; const float* rowsc; const float* colsc;
    __device__ __forceinline__ void operator()(const f32x4 (&acc)[2][2][4][2], const Unit& u, int wr, int wc, int fr, int fq) const {
        const int type = u.pn >> 1, hg = u.pn & 1;
        const int colbase = type * 512 + (4 * hg + wc) * 64 + 8 * fq;
        const bool do_rope = (type == 3) || (type == 4);
        f32x4 cs[2][2];
#pragma unroll
        for (int bj = 0; bj < 2; ++bj)
#pragma unroll
            for (int n = 0; n < 2; ++n) cs[bj][n] = *(const f32x4*)(colsc + u.pn * BM + bj * HALF + wc * 32 + 8 * fq + 4 * n);
#pragma unroll
        for (int ai = 0; ai < 2; ++ai)
#pragma unroll
            for (int m = 0; m < 4; ++m) {
                const int r = u.pm * BM + ai * HALF + wr * 64 + m * 16 + fr;
                const float rs = rowsc[r];
                f32x4 v[2][2];
#pragma unroll
                for (int bj = 0; bj < 2; ++bj)
#pragma unroll
                    for (int n = 0; n < 2; ++n) { const i32x4 ia = __builtin_bit_cast(i32x4, acc[ai][bj][m][n]);
                        v[bj][n] = (f32x4){(float)ia[0], (float)ia[1], (float)ia[2], (float)ia[3]} * cs[bj][n] * rs; }
                f32x4 a0 = v[0][0], a1 = v[0][1], b0 = v[1][0], b1 = v[1][1];
                if (do_rope) {
                    const f32x4* rp = (const f32x4*)(rope + ((size_t)(r & 2047) * 32 + 8 * fq) * 2);
                    const f32x4 c0 = rp[0], c1 = rp[1], c2 = rp[2], c3 = rp[3];
                    rot(a0[0], b0[0], c0[0], c0[1]); rot(a0[1], b0[1], c0[2], c0[3]); rot(a0[2], b0[2], c1[0], c1[1]); rot(a0[3], b0[3], c1[2], c1[3]);
                    rot(a1[0], b1[0], c2[0], c2[1]); rot(a1[1], b1[1], c2[2], c2[3]); rot(a1[2], b1[2], c3[0], c3[1]); rot(a1[3], b1[3], c3[2], c3[3]);
                }
                bf16_t* rowp = R + (size_t)r * 3584 + colbase;
                *(u32x4*)(rowp) = pack8(a0, a1);
                *(u32x4*)(rowp + 32) = pack8(b0, b1);
            }
    }
};
struct EpiRes {
    static constexpr bool PERM = true, AFTER_DRAIN = false;
    const float* xf; bf16_t* hb; float* part; const float* bias;
    __device__ __forceinline__ void operator()(const f32x4 (&acc)[2][2][4][2], const Unit& u, int wr, int wc, int fr, int fq) const {
        const int col0 = u.pn * BM + wc * 32 + 8 * fq;
        f32x4 bv[2][2];
#pragma unroll
        for (int bj = 0; bj < 2; ++bj)
#pragma unroll
            for (int n = 0; n < 2; ++n) bv[bj][n] = bias ? *(const f32x4*)(bias + col0 + bj * HALF + 4 * n) : (f32x4){0.f, 0.f, 0.f, 0.f};
#pragma unroll
        for (int ai = 0; ai < 2; ++ai)
#pragma unroll
            for (int m = 0; m < 4; ++m) {
                const int r = u.pm * BM + ai * HALF + wr * 64 + m * 16 + fr;
                const size_t off = (size_t)r * 1024 + col0;
                float ss = 0.f;
#pragma unroll
                for (int bj = 0; bj < 2; ++bj) {
                    f32x4 x0, x1;
                    if (xf) { x0 = *(const f32x4*)(xf + off + bj * HALF); x1 = *(const f32x4*)(xf + off + bj * HALF + 4); }
                    else { const u32x4 w = *(const u32x4*)(hb + off + bj * HALF);
                           x0 = (f32x4){__uint_as_float(w[0] << 16), __uint_as_float(w[0] & 0xffff0000u), __uint_as_float(w[1] << 16), __uint_as_float(w[1] & 0xffff0000u)};
                           x1 = (f32x4){__uint_as_float(w[2] << 16), __uint_as_float(w[2] & 0xffff0000u), __uint_as_float(w[3] << 16), __uint_as_float(w[3] & 0xffff0000u)}; }
                    const f32x4 h0 = x0 + acc[ai][bj][m][0] + bv[bj][0], h1 = x1 + acc[ai][bj][m][1] + bv[bj][1];
                    *(u32x4*)(hb + off + bj * HALF) = pack8(h0, h1);
                    ss += (h0[0] * h0[0] + h0[1] * h0[1]) + (h0[2] * h0[2] + h0[3] * h0[3]) + (h1[0] * h1[0] + h1[1] * h1[1]) + (h1[2] * h1[2] + h1[3] * h1[3]);
                }
                ss = swap16_add(ss, ss); ss = swap32_add(ss, ss);
                if (fq == 0) part[(size_t)r * 16 + 4 * u.pn + wc] = ss;
            }
    }
};
struct EpiQ {
    static constexpr bool PERM = true, AFTER_DRAIN = false;
    bf16_t* O; const float* part;
    __device__ __forceinline__ void operator()(const f32x4 (&acc)[2][2][4][2], const Unit& u, int wr, int wc, int fr, int fq) const {
        const int col0 = u.pn * BM + wc * 32 + 8 * fq;
#pragma unroll
        for (int ai = 0; ai < 2; ++ai)
#pragma unroll
            for (int m = 0; m < 4; ++m) {
                const int r = u.pm * BM + ai * HALF + wr * 64 + m * 16 + fr;
                const float rs = rstd16(part, r, fq);
                bf16_t* rowp = O + (size_t)r * 1024 + col0;
#pragma unroll
                for (int bj = 0; bj < 2; ++bj) *(u32x4*)(rowp + bj * HALF) = pack8(acc[ai][bj][m][0] * rs, acc[ai][bj][m][1] * rs);
            }
    }
};
struct EpiGlu {
    static constexpr bool PERM = true, AFTER_DRAIN = false;
    bf16_t* G; const float* part; const float* b1;
    __device__ __forceinline__ void operator()(const f32x4 (&acc)[2][2][4][2], const Unit& u, int wr, int wc, int fr, int fq) const {
        const int col = u.pn * 128 + wc * 32 + 8 * fq;
        f32x4 ba[2], bg[2];
#pragma unroll
        for (int n = 0; n < 2; ++n) { ba[n] = *(const f32x4*)(b1 + col + 4 * n); bg[n] = *(const f32x4*)(b1 + 1024 + col + 4 * n); }
#pragma unroll
        for (int ai = 0; ai < 2; ++ai)
#pragma unroll
            for (int m = 0; m < 4; ++m) {
                const int r = u.pm * BM + ai * HALF + wr * 64 + m * 16 + fr;
                const float rs = rstd16(part, r, fq);
                f32x4 y[2];
#pragma unroll
                for (int n = 0; n < 2; ++n) {
                    const f32x4 a = acc[ai][0][m][n] * rs + ba[n], g = acc[ai][1][m][n] * rs + bg[n];
#pragma unroll
                    for (int i = 0; i < 4; ++i) y[n][i] = a[i] / (1.f + __expf(-g[i]));
                }
                *(u32x4*)(G + (size_t)r * 1024 + col) = pack8(y[0], y[1]);
            }
    }
};
template <class Epi, class Sched, bool ALIGN_EPI = false, bool SP2 = false, bool I8 = false>
__device__ __forceinline__ void gemm_phase(PG8_LAS unsigned char* lds, const Gemm g, const Sched& S, const Epi& E, const int wave_id) {
    const int lane = lane_id(), wid = wave_id, tid = wid * 64 + lane, wr = wid >> 2, wc = wid & 3, fr = lane & 15, fq = lane >> 4;
    const int K = g.K, nt = K / BK;
    unsigned voffA[2], voffB[2];
#pragma unroll
    for (int i = 0; i < 2; ++i) { int R, C; stage_rc(tid * 16 + i * 8192, R, C); const int Rb = Epi::PERM ? ((R & ~31) + perm32(R & 31)) : R;
        voffA[i] = (unsigned)(R * K + C) * 2u; voffB[i] = (unsigned)(Rb * K + C) * 2u; }
    const size_t kstep = (size_t)(BK * 2);
    const size_t hstep = (size_t)HALF * K * 2;
    const size_t tstep = 2 * hstep;
    const unsigned ldsw = (unsigned)wid * 1024u;
    const int aoff = lds_byte(wr * 64 + fr, fq * 8), boff = lds_byte(wc * 32 + fr, fq * 8);
#define PG8_SA(b, h) (((b) * 2 + (h)) * HTB)
#define PG8_SB(b, h) ((4 + (b) * 2 + (h)) * HTB)
#define PG8_STAGE(bufoff, gbase, voff) do { _Pragma("unroll") for (int _i = 0; _i < 2; ++_i) \
        __builtin_amdgcn_global_load_lds((const unsigned*)((const char*)(gbase) + (voff)[_i]), (PG8_LAS unsigned*)(lds + (bufoff) + ldsw + _i * 8192), 16, 0, 0); } while (0)
#define PG8_LDA(dst, b, h) do { _Pragma("unroll") for (int m = 0; m < 4; ++m) _Pragma("unroll") for (int k = 0; k < 2; ++k) dst[m][k] = *(const PG8_LAS bf16x8*)(lds + PG8_SA(b, h) + aoff + m * 2048 + k * 1024); } while (0)
#define PG8_LDB(dst, b, h) do { _Pragma("unroll") for (int n = 0; n < 2; ++n) _Pragma("unroll") for (int k = 0; k < 2; ++k) dst[n][k] = *(const PG8_LAS bf16x8*)(lds + PG8_SB(b, h) + boff + n * 2048 + k * 1024); } while (0)
#define PG8_MMA(ai, bj, At, Bt) do { __builtin_amdgcn_s_setprio(1); _Pragma("unroll") for (int m = 0; m < 4; ++m) _Pragma("unroll") for (int n = 0; n < 2; ++n) _Pragma("unroll") for (int k = 0; k < 2; ++k) { \
        if constexpr (I8) acc[ai][bj][m][n] = __builtin_bit_cast(f32x4, __builtin_amdgcn_mfma_i32_16x16x64_i8(__builtin_bit_cast(i32x4, Bt[n][k]), __builtin_bit_cast(i32x4, At[m][k]), __builtin_bit_cast(i32x4, acc[ai][bj][m][n]), 0, 0, 0)); \
        else acc[ai][bj][m][n] = __builtin_amdgcn_mfma_f32_16x16x32_bf16(Bt[n][k], At[m][k], acc[ai][bj][m][n], 0, 0, 0); } __builtin_amdgcn_s_setprio(0); } while (0)
#define PG8_WAIT_V(n) asm volatile("s_waitcnt vmcnt(" #n ")" ::: "memory")
#define PG8_WAIT_L(n) asm volatile("s_waitcnt lgkmcnt(" #n ")" ::: "memory")
#define PG8_BAR __builtin_amdgcn_s_barrier()
#define PG8_SCHED __builtin_amdgcn_sched_barrier(0)
    Unit cur, nxt; int ui = 0;
    if (!S.next(0, cur)) return;
    f32x4 acc[2][2][4][2];
#pragma unroll
    for (int a = 0; a < 2; ++a)
#pragma unroll
        for (int b = 0; b < 2; ++b)
#pragma unroll
            for (int m = 0; m < 4; ++m)
#pragma unroll
                for (int n = 0; n < 2; ++n) acc[a][b][m][n] = (f32x4){0.f, 0.f, 0.f, 0.f};
    bf16x8 At[4][2], B0[2][2], B1[2][2];
    const char* cA = (const char*)g.A + (size_t)cur.pm * tstep; const char* cB = (const char*)g.Bt + (size_t)cur.pn * tstep;
    S.a_ready(cur);
    if constexpr (SP2) {
        PG8_STAGE(PG8_SB(0, 0), cB, voffB); PG8_STAGE(PG8_SB(0, 1), cB + hstep, voffB); PG8_STAGE(PG8_SA(0, 0), cA, voffA); PG8_STAGE(PG8_SA(0, 1), cA + hstep, voffA);
        if (wr == 1) PG8_BAR;
        PG8_WAIT_V(2); PG8_BAR;
        PG8_STAGE(PG8_SB(1, 0), cB + kstep, voffB); PG8_STAGE(PG8_SA(1, 0), cA + kstep, voffA); PG8_STAGE(PG8_SB(1, 1), cB + hstep + kstep, voffB);
        PG8_WAIT_V(6); PG8_BAR;
    } else {
        PG8_STAGE(PG8_SB(0, 0), cB, voffB); PG8_STAGE(PG8_SA(0, 0), cA, voffA); PG8_STAGE(PG8_SB(0, 1), cB + hstep, voffB); PG8_STAGE(PG8_SA(0, 1), cA + hstep, voffA);
        if (wr == 1) PG8_BAR;
        PG8_WAIT_V(4); PG8_BAR;
        PG8_STAGE(PG8_SB(1, 0), cB + kstep, voffB); PG8_STAGE(PG8_SA(1, 0), cA + kstep, voffA); PG8_STAGE(PG8_SB(1, 1), cB + hstep + kstep, voffB);
        PG8_WAIT_V(6); PG8_BAR;
    }
    for (;;) {
        const bool has_next = S.next(ui + 1, nxt);
        const char* nA = has_next ? (const char*)g.A + (size_t)nxt.pm * tstep : cA; const char* nB = has_next ? (const char*)g.Bt + (size_t)nxt.pn * tstep : cB;
        for (int t = 0; t < nt; t += 2) {
            const bool last = (t == nt - 2);
            const char* a1 = cA + (size_t)(t + 1) * kstep;
            const char* a2 = last ? nA : cA + (size_t)(t + 2) * kstep; const char* b2 = last ? nB : cB + (size_t)(t + 2) * kstep;
            const char* a3 = a2 + kstep; const char* b3 = b2 + kstep;
            if (last && has_next) S.a_ready(nxt);
            if constexpr (SP2) {
            PG8_LDB(B0, 0, 0); PG8_LDB(B1, 0, 1); PG8_SCHED; PG8_LDA(At, 0, 0); PG8_STAGE(PG8_SA(1, 1), a1 + hstep, voffA);
            PG8_WAIT_V(8); PG8_WAIT_L(0); PG8_BAR; PG8_MMA(0, 0, At, B0); PG8_MMA(0, 1, At, B1); PG8_BAR; PG8_SCHED;
            PG8_LDA(At, 0, 1); PG8_STAGE(PG8_SB(0, 0), b2, voffB); PG8_STAGE(PG8_SB(0, 1), b2 + hstep, voffB); PG8_STAGE(PG8_SA(0, 0), a2, voffA);
            PG8_WAIT_V(8); PG8_WAIT_L(0); PG8_BAR; PG8_MMA(1, 0, At, B0); PG8_MMA(1, 1, At, B1); PG8_BAR; PG8_SCHED;
            PG8_LDB(B0, 1, 0); PG8_LDB(B1, 1, 1); PG8_SCHED; PG8_LDA(At, 1, 0); PG8_STAGE(PG8_SA(0, 1), a2 + hstep, voffA);
            PG8_WAIT_V(8); PG8_WAIT_L(0); PG8_BAR; PG8_MMA(0, 0, At, B0); PG8_MMA(0, 1, At, B1); PG8_BAR; PG8_SCHED;
            PG8_LDA(At, 1, 1); PG8_STAGE(PG8_SB(1, 0), b3, voffB); PG8_STAGE(PG8_SB(1, 1), b3 + hstep, voffB); PG8_STAGE(PG8_SA(1, 0), a3, voffA);
            PG8_WAIT_V(8); PG8_WAIT_L(0); PG8_BAR; PG8_MMA(1, 0, At, B0); PG8_MMA(1, 1, At, B1); PG8_BAR; PG8_SCHED;
            } else {
            PG8_LDB(B0, 0, 0); PG8_SCHED; PG8_LDA(At, 0, 0); PG8_STAGE(PG8_SA(1, 1), a1 + hstep, voffA);
            PG8_WAIT_L(8); PG8_BAR; PG8_WAIT_L(0); PG8_MMA(0, 0, At, B0); PG8_BAR; PG8_SCHED;
            PG8_LDB(B1, 0, 1); PG8_STAGE(PG8_SB(0, 0), b2, voffB);
            PG8_BAR; PG8_WAIT_L(0); PG8_MMA(0, 1, At, B1); PG8_BAR;
            PG8_LDA(At, 0, 1); PG8_STAGE(PG8_SA(0, 0), a2, voffA);
            PG8_BAR; PG8_WAIT_L(0); PG8_MMA(1, 0, At, B0); PG8_BAR; PG8_SCHED;
            PG8_STAGE(PG8_SB(0, 1), b2 + hstep, voffB);
            PG8_WAIT_V(6); PG8_BAR; PG8_MMA(1, 1, At, B1); PG8_BAR;
            PG8_LDB(B0, 1, 0); PG8_SCHED; PG8_LDA(At, 1, 0); PG8_STAGE(PG8_SA(0, 1), a2 + hstep, voffA);
            PG8_WAIT_L(8); PG8_BAR; PG8_WAIT_L(0); PG8_MMA(0, 0, At, B0); PG8_BAR; PG8_SCHED;
            PG8_LDB(B1, 1, 1); PG8_STAGE(PG8_SB(1, 0), b3, voffB);
            PG8_BAR; PG8_WAIT_L(0); PG8_MMA(0, 1, At, B1); PG8_BAR;
            PG8_LDA(At, 1, 1); PG8_STAGE(PG8_SA(1, 0), a3, voffA);
            PG8_BAR; PG8_WAIT_L(0); PG8_MMA(1, 0, At, B0); PG8_BAR; PG8_SCHED;
            PG8_STAGE(PG8_SB(1, 1), b3 + hstep, voffB);
            PG8_WAIT_V(6); PG8_BAR; PG8_MMA(1, 1, At, B1); PG8_BAR;
            }
        }
        if constexpr (ALIGN_EPI) { if (wr == 0) PG8_BAR; }
        if constexpr (!Epi::AFTER_DRAIN) { E(acc, cur, wr, wc, fr, fq); S.done(cur); }
        if (!has_next) break;
#pragma unroll
        for (int a = 0; a < 2; ++a)
#pragma unroll
            for (int b = 0; b < 2; ++b)
#pragma unroll
                for (int m = 0; m < 4; ++m)
#pragma unroll
                    for (int n = 0; n < 2; ++n) acc[a][b][m][n] = (f32x4){0.f, 0.f, 0.f, 0.f};
        cur = nxt; cA = nA; cB = nB; ++ui;
        if constexpr (ALIGN_EPI) { if (wr == 1) PG8_BAR; }
    }
    PG8_WAIT_V(0);
    if constexpr (!ALIGN_EPI) { if (wr == 0) PG8_BAR; }
    PG8_BAR;
    if constexpr (Epi::AFTER_DRAIN) { E.fused(acc, cur, wr, wc, fr, fq, lds, wid, lane); S.done(cur); }
#undef PG8_SA
#undef PG8_SB
#undef PG8_STAGE
#undef PG8_LDA
#undef PG8_LDB
#undef PG8_MMA
#undef PG8_WAIT_V
#undef PG8_WAIT_L
#undef PG8_BAR
#undef PG8_SCHED
}
}

struct Frame {
    LAS unsigned char* lds;
    int wave, G, bid;
    const float *x, *mix_norm, *ffn_norm, *final_norm, *w_in, *w_out, *rel_bias, *conv_w1, *conv_b1, *conv_dw, *conv_dw_b, *conv_ln_g, *conv_ln_b, *conv_w2, *conv_b2,
        *peer_wq, *peer_keys, *peer_u, *peer_v;
    float* out;
    unsigned char* ws;
};
#define FRAME_IDS const int f_lane = lane_id(); const int f_tid = F.wave * 64 + f_lane; (void)f_tid
DI float gamma_of(int h) { return 1.f - exp2f(-5.f - (float)h); }

DI unsigned q8x4(f32x4 v, const float sc) {
    const int a = (int)rintf(v[0] * sc), b = (int)rintf(v[1] * sc), c = (int)rintf(v[2] * sc), d = (int)rintf(v[3] * sc);
    return ((unsigned)a & 0xFFu) | (((unsigned)b & 0xFFu) << 8) | (((unsigned)c & 0xFFu) << 16) | ((unsigned)d << 24);
}
DI void p0_prep(Frame& F) {
    FRAME_IDS;
    const int gw = F.bid * NWAVES + F.wave, NGW = F.G * NWAVES;
    f32x2* rope = (f32x2*)(F.ws + WS_ROPE);
    for (int i = F.bid * NTHR + f_tid; i < SEQ * 32; i += F.G * NTHR) {
        const int s = i >> 5, j = i & 31;
        const float inv = powf(10000.f, -(float)j / 32.f);
        const float ang = (float)s * inv;
        float sn, cs; sincosf(ang, &sn, &cs);
        rope[i] = (f32x2){cs, sn};
    }
    unsigned* xq = (unsigned*)(F.ws + WS_XB); float* rowsc = (float*)(F.ws + WS_ROWSC);
    for (int m = gw; m < T; m += NGW) {
        const f32x4* xr = (const f32x4*)(F.x + (size_t)m * DM) + f_lane;
        f32x4 v[4]; float s = 0.f, am = 0.f;
#pragma unroll
        for (int j = 0; j < 4; ++j) { v[j] = xr[64 * j]; s += v[j].x * v[j].x + v[j].y * v[j].y + v[j].z * v[j].z + v[j].w * v[j].w; am = fmaxf(am, fmaxf(fmaxf(fabsf(v[j].x), fabsf(v[j].y)), fmaxf(fabsf(v[j].z), fabsf(v[j].w)))); }
        const float r = 1.f / sqrtf(wave_sum(s) * (1.f / DM) + EPS);
        am = wave_max(am);
        const float sc = am > 0.f ? 127.f / am : 0.f;
#pragma unroll
        for (int j = 0; j < 4; ++j) xq[(size_t)m * (DM / 4) + f_lane + 64 * j] = q8x4(v[j], sc);
        if (f_lane == 0) rowsc[m] = am * (1.f / 127.f) * r;
    }
}
DI void p0_transpose_item(const float* W, int K, int N, bf16* WT, int prow0, const float* gain, float scale, LAS float* scr, int k0, int n0, int lane) {
#pragma unroll 8
    for (int i = 0; i < 32; ++i) { const int kk = 2 * i + (lane >> 5); scr[kk * 33 + (lane & 31)] = W[(size_t)(k0 + kk) * N + n0 + (lane & 31)] * (gain ? gain[k0 + kk] : 1.f) * scale; }
    asm volatile("s_waitcnt lgkmcnt(0)" ::: "memory");
    const int c = lane & 7;
#pragma unroll
    for (int j = 0; j < 4; ++j) { const int n = (lane >> 3) + 8 * j; const LAS float* q = scr + (8 * c) * 33 + n;
        u32x4 o; o.x = pk2(q[0 * 33], q[1 * 33]); o.y = pk2(q[2 * 33], q[3 * 33]); o.z = pk2(q[4 * 33], q[5 * 33]); o.w = pk2(q[6 * 33], q[7 * 33]);
        *(u32x4*)(WT + (size_t)(prow0 + n) * K + k0 + 8 * c) = o; }
    asm volatile("s_waitcnt lgkmcnt(0)" ::: "memory");
}
DI void p0_amax_item(const float* W, int N, unsigned* colmax, const float* gain, float scale, int k0, int n0, int lane) {
    float am = 0.f;
#pragma unroll 8
    for (int i = 0; i < 32; ++i) { const int kk = 2 * i + (lane >> 5); am = fmaxf(am, fabsf(W[(size_t)(k0 + kk) * N + n0 + (lane & 31)] * (gain ? gain[k0 + kk] : 1.f) * scale)); }
    am = swap32_max(am);
    if (lane < 32) __hip_atomic_fetch_max(colmax + lane, __float_as_uint(am), __ATOMIC_RELAXED, __HIP_MEMORY_SCOPE_AGENT);
}
DI void p0_q8_item(const float* W, int N, unsigned char* WT, const unsigned* colmax, float* colsc, int prow0, const float* gain, float scale, LAS float* scr, int k0, int n0, int lane) {
    const float am = __uint_as_float(colmax[lane & 31]);
    const float sc = am > 0.f ? 127.f / am : 0.f;
    if (k0 == 0 && lane < 32) colsc[lane] = am * (1.f / 127.f);
#pragma unroll 8
    for (int i = 0; i < 32; ++i) { const int kk = 2 * i + (lane >> 5); scr[kk * 33 + (lane & 31)] = rintf(W[(size_t)(k0 + kk) * N + n0 + (lane & 31)] * (gain ? gain[k0 + kk] : 1.f) * scale * sc); }
    asm volatile("s_waitcnt lgkmcnt(0)" ::: "memory");
    const int ch = lane & 3;
#pragma unroll
    for (int j = 0; j < 2; ++j) { const int n = (lane >> 2) + 16 * j; const LAS float* q = scr + (16 * ch) * 33 + n;
        u32x4 o;
#pragma unroll
        for (int w = 0; w < 4; ++w) o[w] = ((unsigned)(int)q[(4 * w) * 33] & 0xFFu) | (((unsigned)(int)q[(4 * w + 1) * 33] & 0xFFu) << 8) | (((unsigned)(int)q[(4 * w + 2) * 33] & 0xFFu) << 16) | ((unsigned)(int)q[(4 * w + 3) * 33] << 24);
        *(u32x4*)(WT + (size_t)(prow0 + n) * DM + k0 + 16 * ch) = o; }
    asm volatile("s_waitcnt lgkmcnt(0)" ::: "memory");
}
constexpr int CW_COLMAX = 16384;
constexpr int CS_WIN = 0, CS_WOUT = 3584, CS_W1 = 4608, CS_W2 = 6656, CS_WQ = 7680;
constexpr bool I8_WIN = true, I8_WOUT = false, I8_W1 = false, I8_W2 = false, I8_WQ = false;
DI void p0_weights(Frame& F, const int pass) {
    FRAME_IDS;
    LAS float* scr = (LAS float*)(F.lds + F.wave * 16384);
    unsigned* colmax = (unsigned*)(F.ws + WS_CTL) + CW_COLMAX; float* colsc = (float*)(F.ws + WS_COLSC);
    const int gw = F.bid * NWAVES + F.wave, NGW = F.G * NWAVES;
    constexpr int I_IN = 16 * (INC / 32), I_SQ = 16 * (DM / 32), I_W1 = 16 * (2 * DM / 32);
    constexpr int NITEMS = I_IN + I_SQ + I_W1 + I_SQ + 2 * I_SQ;
#define WITEM(I8FLAG, Wp, Nn, WTb, CSo, prow0, gainp, scl, k0, n0) do { \
        if (pass == 0) { if (I8FLAG) p0_amax_item(Wp, Nn, colmax + (CSo) + (prow0), gainp, scl, k0, n0, f_lane); } \
        else if (I8FLAG) p0_q8_item(Wp, Nn, (unsigned char*)(WTb), colmax + (CSo) + (prow0), colsc + (CSo) + (prow0), prow0, gainp, scl, scr, k0, n0, f_lane); \
        else p0_transpose_item(Wp, DM, Nn, (bf16*)(WTb), prow0, gainp, scl, scr, k0, n0, f_lane); } while (0)
    for (int it = gw; it < NITEMS; it += NGW) {
        int r = it;
        if (r < I_IN) { const int nb = r % (INC / 32), kb = r / (INC / 32), n0 = nb * 32;
            const int type = n0 / 512, head = (n0 % 512) / 64, bj = (n0 % 64) / 32;
            const int prow0 = 256 * (2 * type + head / 4) + 128 * bj + 32 * (head % 4);
            WITEM(I8_WIN, F.w_in, INC, F.ws + WS_WIN, CS_WIN, prow0, F.mix_norm, (type == 0 ? 0.125f * LOG2E : (type == 4 ? 0.125f : 1.f)), kb * 64, n0); continue; }
        r -= I_IN;
        if (r < I_SQ) { const int nb = r % 32, kb = r / 32; WITEM(I8_WOUT, F.w_out, DM, F.ws + WS_WOUT, CS_WOUT, nb * 32, (const float*)nullptr, 1.f, kb * 64, nb * 32); continue; }
        r -= I_SQ;
        if (r < I_W1) { const int nb = r % 64, kb = r / 64, n0 = nb * 32; const int bj = n0 / 1024, rem = n0 % 1024;
            WITEM(I8_W1, F.conv_w1, 2 * DM, F.ws + WS_W1, CS_W1, 256 * (rem / 128) + 128 * bj + (rem % 128), F.mix_norm + DM, 1.f, kb * 64, n0); continue; }
        r -= I_W1;
        if (r < I_SQ) { const int nb = r % 32, kb = r / 32; WITEM(I8_W2, F.conv_w2, DM, F.ws + WS_W2, CS_W2, nb * 32, (const float*)nullptr, 1.f, kb * 64, nb * 32); continue; }
        r -= I_SQ;
        { const int layer = r / I_SQ; r %= I_SQ; const int nb = r % 32, kb = r / 32;
          WITEM(I8_WQ, F.peer_wq + (size_t)layer * DM * DM, DM, F.ws + WS_WQ + (size_t)layer * DM * DM * 2, CS_WQ + layer * DM, nb * 32, F.ffn_norm + layer * DM, 1.f, kb * 64, nb * 32); }
    }
#undef WITEM
}
DI float row_rstd(const float* part, int m) {
    const f32x4* p = (const f32x4*)(part + (size_t)m * 16);
    const f32x4 a = p[0], b = p[1], c = p[2], d = p[3];
    const float s = ((a.x + a.y) + (a.z + a.w)) + ((b.x + b.y) + (b.z + b.w)) + ((c.x + c.y) + (c.z + c.w)) + ((d.x + d.y) + (d.z + d.w));
    return 1.f / sqrtf(s * (1.f / DM) + EPS);
}

typedef short v4i16 __attribute__((ext_vector_type(4)));
typedef __bf16 bf16x2_t __attribute__((ext_vector_type(2)));
DI unsigned cvtpk(float lo, float hi) { f32x2 v = {lo, hi}; bf16x2_t b = __builtin_convertvector(v, bf16x2_t); return __builtin_bit_cast(unsigned, b); }
DI v4i16 ds_tr16(LAS const unsigned char* p) { return __builtin_amdgcn_ds_read_tr16_b64_v4i16((LAS v4i16*)p); }
DI int crow(int r, int h) { return (r & 3) + 8 * (r >> 2) + 4 * h; }
DI bf16x8 pack_step(const f32x16& x, const int s) {
    u32x4 w = {cvtpk(x[8 * s + 0], x[8 * s + 1]), cvtpk(x[8 * s + 2], x[8 * s + 3]), cvtpk(x[8 * s + 4], x[8 * s + 5]), cvtpk(x[8 * s + 6], x[8 * s + 7])};
    return __builtin_bit_cast(bf16x8, w);
}
constexpr int AT_KB = 64 * 144, AT_VB = 8192, AT_BUF = AT_KB + AT_VB, AT_BIAS = 2 * AT_BUF;
DI void attn_item(Frame& F, const int it) {
    FRAME_IDS;
    const bf16* R = (const bf16*)(F.ws + WS_R); bf16* O = (bf16*)(F.ws + WS_O);
    LAS unsigned char* lds = F.lds;
    LAS float* bias_s = (LAS float*)(lds + AT_BIAS);
    const int q32 = f_lane & 31, h = f_lane >> 5, w = F.wave;
    const int srow = f_tid >> 3, sch = f_tid & 7;
    const int vtr_off = ((f_lane & 15) >> 2) * 64 + (16 * ((f_lane >> 4) & 1) + 4 * (f_lane & 3)) * 2;
    {
        const int b = it / (NHA * 8), hd = (it / 8) % NHA, c0 = (it % 8) * 4;
        const int c = c0 + (w >> 1), qrow0 = 32 * (w & 1);
        const size_t tq = (size_t)b * SEQ + c * 64 + qrow0 + q32;
        __syncthreads();
        for (int k = f_tid; k < 257; k += NTHR) bias_s[k] = F.rel_bias[hd * 257 + k] * LOG2E;
        bf16x8 qf[4];
#pragma unroll
        for (int ks = 0; ks < 4; ++ks) qf[ks] = *(const bf16x8*)(R + tq * INC + C_QA + hd * 64 + 16 * ks + 8 * h);
        asm volatile("" ::: "memory");
        const int t_lo = c0 - 8 < 0 ? 0 : c0 - 8, t_hi = c0 + 3, ntile = t_hi - t_lo + 1;
        const bf16* kbase = R + ((size_t)b * SEQ + srow) * INC + C_KA + hd * 64 + 8 * sch;
        const bf16* vbase = R + ((size_t)b * SEQ + srow) * INC + C_VA + hd * 64 + 8 * sch;
        u32x4 kA = *(const u32x4*)(kbase + (size_t)t_lo * 64 * INC), vA = *(const u32x4*)(vbase + (size_t)t_lo * 64 * INC);
        u32x4 kB = *(const u32x4*)(kbase + (size_t)(t_lo + 1) * 64 * INC), vB = *(const u32x4*)(vbase + (size_t)(t_lo + 1) * 64 * INC);
        *(LAS u32x4*)(lds + srow * 144 + sch * 16) = kA;
        *(LAS u32x4*)(lds + AT_KB + (sch >> 2) * 4096 + srow * 64 + (sch & 3) * 16) = vA;
        __syncthreads();
        const float bias_far = bias_s[256];
        float m = -1e30f, l = 0.f;
        f32x16 o0 = {}, o1 = {};
        auto tile_step = [&](const int i, u32x4& kL, u32x4& vL, const u32x4& kW, const u32x4& vW) __attribute__((always_inline)) {
            const int tc = t_lo + i;
            LAS unsigned char* kb = lds + (i & 1) * AT_BUF; LAS unsigned char* vb = kb + AT_KB;
            { const int tl = tc + 2 < t_hi ? tc + 2 : t_hi;
              kL = *(const u32x4*)(kbase + (size_t)tl * 64 * INC); vL = *(const u32x4*)(vbase + (size_t)tl * 64 * INC); }
            const int D = c - tc;
            if (D >= 0 && D <= 8) {
                const float init = D >= 3 ? bias_far : 0.f;
                f32x16 p0, p1;
#pragma unroll
                for (int r = 0; r < 16; ++r) { p0[r] = init; p1[r] = init; }
#pragma unroll
                for (int ks = 0; ks < 4; ++ks) {
                    const bf16x8 k0 = *(const LAS bf16x8*)(kb + q32 * 144 + (16 * ks + 8 * h) * 2);
                    const bf16x8 k1 = *(const LAS bf16x8*)(kb + (32 + q32) * 144 + (16 * ks + 8 * h) * 2);
                    p0 = __builtin_amdgcn_mfma_f32_32x32x16_bf16(k0, qf[ks], p0, 0, 0, 0);
                    p1 = __builtin_amdgcn_mfma_f32_32x32x16_bf16(k1, qf[ks], p1, 0, 0, 0);
                }
                if (D < 3) {
                    const int relb = D * 64 + qrow0 + q32 - 4 * h + 128;
#pragma unroll
                    for (int r = 0; r < 16; ++r) {
                        const int r0 = relb - ((r & 3) + 8 * (r >> 2));
                        const int i0 = r0 < 0 ? 0 : (r0 > 256 ? 256 : r0), r1 = r0 - 32, i1 = r1 < 0 ? 0 : (r1 > 256 ? 256 : r1);
                        p0[r] += bias_s[i0]; p1[r] += bias_s[i1];
                    }
                }
                float tm = fmaxf(p0[0], p1[0]);
#pragma unroll
                for (int r = 1; r < 16; ++r) tm = fmaxf(tm, fmaxf(p0[r], p1[r]));
                tm = swap32_max(tm);
                const float mn = fmaxf(m, tm), alpha = __builtin_amdgcn_exp2f(m - mn);
                m = mn;
                float ps = 0.f;
#pragma unroll
                for (int r = 0; r < 16; ++r) { p0[r] = __builtin_amdgcn_exp2f(p0[r] - mn); p1[r] = __builtin_amdgcn_exp2f(p1[r] - mn); ps += p0[r] + p1[r]; }
                l = l * alpha + ps;
                if (!__all(alpha == 1.f)) {
#pragma unroll
                    for (int r = 0; r < 16; ++r) { o0[r] *= alpha; o1[r] *= alpha; }
                }
                bf16x8 pf[4];
                pf[0] = pack_step(p0, 0); pf[1] = pack_step(p0, 1); pf[2] = pack_step(p1, 0); pf[3] = pack_step(p1, 1);
#pragma unroll
                for (int kk = 0; kk < 4; ++kk) {
                    const int key0 = 16 * kk + 4 * h;
                    const v4i16 a0l = ds_tr16(vb + key0 * 64 + vtr_off), a0h = ds_tr16(vb + (key0 + 8) * 64 + vtr_off);
                    const v4i16 a1l = ds_tr16(vb + 4096 + key0 * 64 + vtr_off), a1h = ds_tr16(vb + 4096 + (key0 + 8) * 64 + vtr_off);
                    const bf16x8 a0 = __builtin_shufflevector(a0l, a0h, 0, 1, 2, 3, 4, 5, 6, 7), a1 = __builtin_shufflevector(a1l, a1h, 0, 1, 2, 3, 4, 5, 6, 7);
                    o0 = __builtin_amdgcn_mfma_f32_32x32x16_bf16(a0, pf[kk], o0, 0, 0, 0);
                    o1 = __builtin_amdgcn_mfma_f32_32x32x16_bf16(a1, pf[kk], o1, 0, 0, 0);
                }
            }
            if (i + 1 < ntile) {
                LAS unsigned char* nb = lds + ((i + 1) & 1) * AT_BUF;
                *(LAS u32x4*)(nb + srow * 144 + sch * 16) = kW;
                *(LAS u32x4*)(nb + AT_KB + (sch >> 2) * 4096 + srow * 64 + (sch & 3) * 16) = vW;
            }
            __syncthreads();
        };
        for (int i = 0; i < ntile; i += 2) { tile_step(i, kA, vA, kB, vB); tile_step(i + 1, kB, vB, kA, vA); }
        l = swap32_add(l, l);
        const float inv = 1.f / l;
        bf16* op = O + tq * DM + hd * 64 + 4 * h;
#pragma unroll
        for (int g = 0; g < 4; ++g) {
            *(u32x2*)(op + 8 * g) = (u32x2){cvtpk(o0[4 * g] * inv, o0[4 * g + 1] * inv), cvtpk(o0[4 * g + 2] * inv, o0[4 * g + 3] * inv)};
            *(u32x2*)(op + 32 + 8 * g) = (u32x2){cvtpk(o1[4 * g] * inv, o1[4 * g + 1] * inv), cvtpk(o1[4 * g + 2] * inv, o1[4 * g + 3] * inv)};
        }
    }
    __syncthreads();
}

constexpr int RT_Q = 0, RT_K = 9216, RT_KD = 18432, RT_V = 26624, RT_BUF = 34816, RT_ZS = 2 * RT_BUF, RT_CS = RT_ZS + 64 * 66 * 4;
DI void ret_item(Frame& F, const int it) {
    FRAME_IDS;
    const bf16* R = (const bf16*)(F.ws + WS_R); bf16* O = (bf16*)(F.ws + WS_O);
    LAS unsigned char* lds = F.lds;
    LAS float* Zs = (LAS float*)(lds + RT_ZS); LAS float* Cs = (LAS float*)(lds + RT_CS);
    const int b = it / NHB, hd = it % NHB;
    const int q32 = f_lane & 31, h = f_lane >> 5, w = F.wave;
    const int role = w >> 2, itile = (w >> 1) & 1, etile = w & 1;
    const int srow = f_tid >> 3, sch = f_tid & 7;
    const int vtr_off = ((f_lane & 15) >> 2) * 64 + (16 * ((f_lane >> 4) & 1) + 4 * (f_lane & 3)) * 2;
    const float l2g = log2f(gamma_of(hd));
    const float cd = exp2f(l2g * 64.f), sdec = exp2f(l2g * (float)(63 - srow));
    float qdv[16];
#pragma unroll
    for (int r = 0; r < 16; ++r) qdv[r] = exp2f(l2g * (float)(32 * itile + crow(r, h) + 1));
    f32x16 xs0 = {}, xs1 = {};
    const size_t trow0 = (size_t)b * SEQ;
    const bf16* gq = R + (trow0 + srow) * INC + hd * 64 + 8 * sch;
    u32x4 qreg = *(const u32x4*)(gq + C_QB), kreg = *(const u32x4*)(gq + C_KB), vreg = *(const u32x4*)(gq + C_VB);
    __syncthreads();
#define RT_STAGE(bufp) do { LAS unsigned char* bp_ = (bufp); \
        *(LAS u32x4*)(bp_ + RT_Q + srow * 144 + sch * 16) = qreg; *(LAS u32x4*)(bp_ + RT_K + srow * 144 + sch * 16) = kreg; \
        *(LAS u32x4*)(bp_ + RT_V + (sch >> 2) * 4096 + srow * 64 + (sch & 3) * 16) = vreg; \
        u32x4 kd_; \
        _Pragma("unroll") for (int e_ = 0; e_ < 4; ++e_) kd_[e_] = cvtpk(__uint_as_float(kreg[e_] << 16) * sdec, __uint_as_float(kreg[e_] & 0xffff0000u) * sdec); \
        *(LAS u32x4*)(bp_ + RT_KD + (sch >> 2) * 4096 + srow * 64 + (sch & 3) * 16) = kd_; } while (0)
    RT_STAGE(lds);
    __syncthreads();
    for (int n = 0; n < NCH; ++n) {
        LAS unsigned char* bp = lds + (n & 1) * RT_BUF;
        if (n + 1 < NCH) { const bf16* g1 = gq + (size_t)(n + 1) * 64 * INC; qreg = *(const u32x4*)(g1 + C_QB); kreg = *(const u32x4*)(g1 + C_KB); vreg = *(const u32x4*)(g1 + C_VB); }
        unsigned short gr[8];
#pragma unroll
        for (int r = 0; r < 8; ++r) gr[r] = R[(trow0 + n * 64 + 8 * w + r) * INC + C_GB + hd * 64 + f_lane];
        if (role == 0) {
            bf16x8 qf[4];
#pragma unroll
            for (int ks = 0; ks < 4; ++ks) qf[ks] = *(const LAS bf16x8*)(bp + RT_Q + (32 * itile + q32) * 144 + (16 * ks + 8 * h) * 2);
            f32x16 st0 = {}, st1 = {};
#pragma unroll
            for (int ks = 0; ks < 4; ++ks) {
                const bf16x8 k0 = *(const LAS bf16x8*)(bp + RT_K + q32 * 144 + (16 * ks + 8 * h) * 2);
                const bf16x8 k1 = *(const LAS bf16x8*)(bp + RT_K + (32 + q32) * 144 + (16 * ks + 8 * h) * 2);
                st0 = __builtin_amdgcn_mfma_f32_32x32x16_bf16(k0, qf[ks], st0, 0, 0, 0);
                st1 = __builtin_amdgcn_mfma_f32_32x32x16_bf16(k1, qf[ks], st1, 0, 0, 0);
            }
            int iiv = 32 * itile + q32 - 4 * h; asm volatile("" : "+v"(iiv));
#pragma unroll
            for (int r = 0; r < 16; ++r) {
                const int dd = iiv - ((r & 3) + 8 * (r >> 2));
                st0[r] *= __builtin_amdgcn_exp2f(l2g * fabsf((float)dd));
                st1[r] *= __builtin_amdgcn_exp2f(l2g * fabsf((float)(dd - 32)));
            }
            f32x16 z = {};
#pragma unroll
            for (int kk = 0; kk < 4; ++kk) {
                const int key0 = 16 * kk + 4 * h;
                const v4i16 bl = ds_tr16(bp + RT_V + etile * 4096 + key0 * 64 + vtr_off), bh = ds_tr16(bp + RT_V + etile * 4096 + (key0 + 8) * 64 + vtr_off);
                const bf16x8 vb = __builtin_shufflevector(bl, bh, 0, 1, 2, 3, 4, 5, 6, 7);
                const bf16x8 xa = (kk < 2) ? pack_step(st0, kk & 1) : pack_step(st1, kk & 1);
                z = __builtin_amdgcn_mfma_f32_32x32x16_bf16(xa, vb, z, 0, 0, 0);
            }
            int zb = (32 * itile + 4 * h) * 66 + 32 * etile + q32; asm volatile("" : "+v"(zb));
#pragma unroll
            for (int r = 0; r < 16; ++r) Zs[zb + ((r & 3) + 8 * (r >> 2)) * 66] = z[r];
        } else {
            f32x16 cr = {};
#pragma unroll
            for (int kk = 0; kk < 4; ++kk) {
                const LAS unsigned char* qp = bp + RT_Q + (32 * itile + q32) * 144 + (16 * kk + 4 * h) * 2;
                const v4i16 al = *(const LAS v4i16*)qp, ah = *(const LAS v4i16*)(qp + 16);
                const bf16x8 qa = __builtin_shufflevector(al, ah, 0, 1, 2, 3, 4, 5, 6, 7);
                const bf16x8 xb = (kk < 2) ? pack_step(xs0, kk & 1) : pack_step(xs1, kk & 1);
                cr = __builtin_amdgcn_mfma_f32_32x32x16_bf16(qa, xb, cr, 0, 0, 0);
            }
            int cb = (32 * itile + 4 * h) * 66 + 32 * etile + q32; asm volatile("" : "+v"(cb));
#pragma unroll
            for (int r = 0; r < 16; ++r) Cs[cb + ((r & 3) + 8 * (r >> 2)) * 66] = cr[r] * qdv[r];
#pragma unroll
            for (int r = 0; r < 16; ++r) { xs0[r] *= cd; xs1[r] *= cd; }
#pragma unroll
            for (int s4 = 0; s4 < 4; ++s4) {
                const int key0 = 16 * s4 + 8 * h;
                const v4i16 vl = ds_tr16(bp + RT_V + etile * 4096 + key0 * 64 + vtr_off), vh = ds_tr16(bp + RT_V + etile * 4096 + (key0 + 4) * 64 + vtr_off);
                const bf16x8 vb = __builtin_shufflevector(vl, vh, 0, 1, 2, 3, 4, 5, 6, 7);
                const v4i16 a0l = ds_tr16(bp + RT_KD + key0 * 64 + vtr_off), a0h = ds_tr16(bp + RT_KD + (key0 + 4) * 64 + vtr_off);
                const v4i16 a1l = ds_tr16(bp + RT_KD + 4096 + key0 * 64 + vtr_off), a1h = ds_tr16(bp + RT_KD + 4096 + (key0 + 4) * 64 + vtr_off);
                const bf16x8 ka0 = __builtin_shufflevector(a0l, a0h, 0, 1, 2, 3, 4, 5, 6, 7), ka1 = __builtin_shufflevector(a1l, a1h, 0, 1, 2, 3, 4, 5, 6, 7);
                xs0 = __builtin_amdgcn_mfma_f32_32x32x16_bf16(ka0, vb, xs0, 0, 0, 0);
                xs1 = __builtin_amdgcn_mfma_f32_32x32x16_bf16(ka1, vb, xs1, 0, 0, 0);
            }
        }
        __syncthreads();
#pragma unroll
        for (int r = 0; r < 8; ++r) {
            const int i = 8 * w + r;
            const float v = Zs[i * 66 + f_lane] + Cs[i * 66 + f_lane];
            const float mu = wave_sum(v) * (1.f / 64.f);
            const float dv = v - mu;
            const float var = wave_sum(dv * dv) * (1.f / 64.f);
            const float g = bf2f(gr[r]);
            O[(trow0 + n * 64 + i) * DM + 512 + hd * 64 + f_lane] = (bf16)f2bf(dv * (1.f / sqrtf(var + EPS)) * (g / (1.f + __expf(-g))));
        }
        if (n + 1 < NCH) RT_STAGE(lds + ((n + 1) & 1) * RT_BUF);
        __syncthreads();
    }
#undef RT_STAGE
}
DI float max3_abs(const float a, const float x, const float y) { float r; asm("v_max3_f32 %0, %1, |%2|, |%3|" : "=v"(r) : "v"(a), "v"(x), "v"(y)); return r; }
DI void int8_rows(Frame& F, const int row0, const int nrows, const int f_lane) {
    const int tab = row0 / PE, e0 = row0 % PE, layer = tab & 1, isv = tab >> 1;
    f32x4 gn[4];
    { const f32x4* gp = (const f32x4*)(F.ffn_norm + layer * DM) + f_lane;
#pragma unroll
      for (int j = 0; j < 4; ++j) gn[j] = isv ? (f32x4){1.f, 1.f, 1.f, 1.f} : gp[64 * j]; }
    const f32x4* src = (const f32x4*)((isv ? F.peer_v : F.peer_u) + ((size_t)layer * PE + e0) * DM) + f_lane;
    unsigned* dst = (unsigned*)(F.ws + (isv ? WS_V8 : WS_U8)) + (size_t)layer * 4 * PE * 32 + (size_t)e0 * 32 + (f_lane >> 1);
    float* scp = (float*)(F.ws + WS_SC) + tab * PE + e0;
    const unsigned xmask = (isv && !(f_lane & 1)) ? 0u : 0x08080808u;
    const int sh = (f_lane & 1) * 4;
    const float scmul = isv ? (1.f / 16.f) : 1.f;
    f32x4 A[4][4], B[4][4];
#define Q4_LOAD(D, r) do { _Pragma("unroll") for (int u_ = 0; u_ < 4; ++u_) _Pragma("unroll") for (int j_ = 0; j_ < 4; ++j_) D[u_][j_] = src[(size_t)((r) + u_) * 256 + 64 * j_]; } while (0)
#define Q4_PROC(D, r) do { _Pragma("unroll") for (int u_ = 0; u_ < 4; ++u_) { \
        float a_ = 0.f; f32x4 sq_ = {0.f, 0.f, 0.f, 0.f}; \
        _Pragma("unroll") for (int j_ = 0; j_ < 4; ++j_) { D[u_][j_] = D[u_][j_] * gn[j_]; a_ = max3_abs(max3_abs(a_, D[u_][j_][0], D[u_][j_][1]), D[u_][j_][2], D[u_][j_][3]); sq_ += D[u_][j_] * D[u_][j_]; } \
        a_ = wave_max(a_); \
        const float step_ = fminf(0.355f * sqrtf(wave_sum((sq_[0] + sq_[1]) + (sq_[2] + sq_[3])) * (1.f / DM)), a_ * (1.f / 7.f)); \
        const float sc_ = step_ > 0.f ? 1.f / step_ : 0.f; \
        _Pragma("unroll") for (int j_ = 0; j_ < 4; ++j_) {                  \
            const f32x4 t_ = D[u_][j_] * sc_ + 8388616.f;                   \
            const unsigned b0_ = __float_as_uint(__builtin_amdgcn_fmed3f(t_[0], 8388609.f, 8388623.f)), b1_ = __float_as_uint(__builtin_amdgcn_fmed3f(t_[1], 8388609.f, 8388623.f)); \
            const unsigned b2_ = __float_as_uint(__builtin_amdgcn_fmed3f(t_[2], 8388609.f, 8388623.f)), b3_ = __float_as_uint(__builtin_amdgcn_fmed3f(t_[3], 8388609.f, 8388623.f)); \
            unsigned w_ = __builtin_amdgcn_perm(__builtin_amdgcn_perm(b3_, b2_, 0x0c0c0400u), __builtin_amdgcn_perm(b1_, b0_, 0x0c0c0400u), 0x05040100u); \
            w_ = (w_ ^ xmask) << sh; \
            w_ |= (unsigned)DPP_MOV_I((int)w_, DPP_XOR1); \
            if (!(f_lane & 1)) dst[((size_t)j_ * PE + (r) + u_) * 32] = w_; \
        } \
        if (f_lane == 0) scp[(r) + u_] = step_ * scmul; } } while (0)
    Q4_LOAD(A, 0);
    for (int r = 0; r < nrows; r += 8) {
        Q4_LOAD(B, r + 4);
        Q4_PROC(A, r);
        { const int rn = r + 8 < nrows ? r + 8 : r + 4;
          Q4_LOAD(A, rn); }
        Q4_PROC(B, r + 4);
    }
#undef Q4_LOAD
#undef Q4_PROC
}
constexpr int Q8_ITEM_ROWS = 512, Q8_ITEMS = 4 * PE / Q8_ITEM_ROWS;
constexpr int PH_MIX_ID = 3;
DI int attn_order(const int q) { return q < 768 ? (q / 6) * 8 + (q % 6) + 2 : ((q - 768) & 127) * 8 + ((q - 768) < 128 ? 1 : 0); }
DI void mix_phase(Frame& F, const int rep) {
    FRAME_IDS;
    unsigned* ctr = (unsigned*)(F.ws + WS_CTL) + CW_QUEUE + 64 * rep;
    volatile LAS unsigned* slot = (volatile LAS unsigned*)(F.lds + MISC_OFF) + 16;
    constexpr int N_RET = NB * NHB, N_ATT = NB * NHA * 8;
    static_assert(N_ATT == 8 * Q8_ITEMS, "8 attention items per quantisation item");
    for (;;) {
        __syncthreads();
        if (f_tid == 0) slot[0] = __hip_atomic_fetch_add(ctr, 1u, __ATOMIC_RELAXED, __HIP_MEMORY_SCOPE_AGENT);
        __syncthreads();
        const int idx = (int)slot[0];
        if (idx >= N_RET + N_ATT + Q8_ITEMS) break;
        const bool probe_pass = (REP_PHASE == PH_MIX_ID && rep == 0);
        if (idx < N_RET) { if (!(probe_pass && PROBE_MODE >= 4)) ret_item(F, idx); }
        else if (probe_pass && PROBE_MODE == 3) { }
        else { const int k = idx - N_RET;
            if (k < 4 * Q8_ITEMS) { const int grp = k >> 2, pos = k & 3;
                if (pos == 3) { if (!(probe_pass && PROBE_MODE == 5)) int8_rows(F, grp * Q8_ITEM_ROWS + F.wave * 64, 64, f_lane); }
                else if (!(probe_pass && PROBE_MODE == 6)) attn_item(F, attn_order(3 * grp + pos)); }
            else if (!(probe_pass && PROBE_MODE == 6)) attn_item(F, attn_order(k - Q8_ITEMS)); }
    }
}
DI float fmax_raw(float a, float b) { float r; asm("v_max_f32_e32 %0, %1, %2" : "=v"(r) : "v"(a), "v"(b)); return r; }
DI float fmin_raw(float a, float b) { float r; asm("v_min_f32_e32 %0, %1, %2" : "=v"(r) : "v"(a), "v"(b)); return r; }
#define CE_DESC(x, y) do { const float hi_ = fmax_raw((x), (y)), lo_ = fmin_raw((x), (y)); (x) = hi_; (y) = lo_; } while (0)
template <int N> DI void sort_desc(float* v) {
#pragma unroll
    for (int k = 2; k <= N; k <<= 1)
#pragma unroll
        for (int j = k >> 1; j > 0; j >>= 1)
#pragma unroll
            for (int i = 0; i < N; ++i) { const int l = i ^ j; if (l > i) { if ((i & k) == 0 || k == N) CE_DESC(v[i], v[l]); else CE_DESC(v[l], v[i]); } }
}
DI void merge16(float* a, const float* b) {
#pragma unroll
    for (int i = 0; i < 16; ++i) a[i] = fmax_raw(a[i], b[15 - i]);
#pragma unroll
    for (int j = 8; j > 0; j >>= 1)
#pragma unroll
        for (int i = 0; i < 16; ++i) { const int l = i ^ j; if (l > i) CE_DESC(a[i], a[l]); }
}
DI float key_pack(float v, unsigned keep_mask, unsigned idx) { return __uint_as_float((__float_as_uint(v) & keep_mask) | idx); }
DI void opt_route(Frame& F, int layer) {
    FRAME_IDS;
    const bf16* Q = (const bf16*)(F.ws + WS_Q);
    int* eidx = (int*)(F.ws + WS_EIDX); float* gate = (float*)(F.ws + WS_GATE);
    const float* keys = F.peer_keys + (size_t)layer * 2 * PK * 64;
    LAS unsigned char* kl = F.lds;
    __syncthreads();
    for (int idx = f_tid; idx < 2 * PK * 8; idx += NTHR) {
        const int row = idx >> 3, ch = idx & 7;
        const f32x4 a = *(const f32x4*)(keys + (size_t)row * 64 + ch * 8), b = *(const f32x4*)(keys + (size_t)row * 64 + ch * 8 + 4);
        *(LAS u32x4*)(kl + row * 144 + ch * 16) = (u32x4){pk2(a[0], a[1]), pk2(a[2], a[3]), pk2(b[0], b[1]), pk2(b[2], b[3])};
    }
    __syncthreads();
    LAS int* lut = (LAS int*)(F.lds + 40960 + F.wave * 8192);
    const int c = f_lane & 31, h = f_lane >> 5;
    pg8::StaticOrder SO; SO.init(T, DM, F.G, F.bid);
    pg8::Unit un;
    for (int ui = 0; SO.next(ui, un); ++ui)
    for (int k2 = F.wave; k2 < 16; k2 += NWAVES) {
        const int tile = 8 * un.pm + (k2 & 7), hh = 2 * un.pn + (k2 >> 3), t = tile * 32 + c;
        float tk[2][16];
#pragma unroll
        for (int side = 0; side < 2; ++side) {
            bf16x8 qf[4];
#pragma unroll
            for (int ks = 0; ks < 4; ++ks) qf[ks] = *(const bf16x8*)(Q + (size_t)t * DM + hh * PQD + side * 64 + 16 * ks + 8 * h);
            float v[64];
#pragma unroll
            for (int kt = 0; kt < 4; ++kt) {
                f32x16 acc = {};
#pragma unroll
                for (int ks = 0; ks < 4; ++ks) {
                    const bf16x8 a = *(const LAS bf16x8*)(kl + (side * PK + 32 * kt + c) * 144 + (16 * ks + 8 * h) * 2);
                    acc = __builtin_amdgcn_mfma_f32_32x32x16_bf16(a, qf[ks], acc, 0, 0, 0);
                }
#pragma unroll
                for (int r = 0; r < 16; ++r) v[16 * kt + r] = key_pack(acc[r], 0xFFFFFF80u, (unsigned)(32 * kt + (r & 3) + 8 * (r >> 2) + 4 * h));
            }
            sort_desc<16>(v); sort_desc<16>(v + 16); sort_desc<16>(v + 32); sort_desc<16>(v + 48);
            merge16(v, v + 16); merge16(v + 32, v + 48); merge16(v, v + 32);
            float pr[16];
#pragma unroll
            for (int i = 0; i < 16; ++i) pr[i] = __shfl_xor(v[i], 32);
            merge16(v, pr);
#pragma unroll
            for (int i = 0; i < 16; ++i) { tk[side][i] = v[i]; lut[(side * 16 + i) * 64 + f_lane] = (int)(__float_as_uint(v[i]) & 0x7Fu); }
        }
        float cd[64];
        {   int n = 0;
#pragma unroll
            for (int a = 0; a < 16; ++a)
#pragma unroll
                for (int b = 0; b < 16; ++b) if ((a + 1) * (b + 1) <= 16) { cd[n] = key_pack(tk[0][a] + tk[1][b], 0xFFFFFF00u, (unsigned)(a * 16 + b)); ++n; }
#pragma unroll
            for (int i = 50; i < 64; ++i) cd[i] = -INFINITY;
        }
        sort_desc<16>(cd); sort_desc<16>(cd + 16); sort_desc<16>(cd + 32); CE_DESC(cd[48], cd[49]);
        merge16(cd, cd + 16); merge16(cd + 32, cd + 48); merge16(cd, cd + 32);
        int ex[16]; float gv[16]; float sum = 0.f;
        const float top = __uint_as_float(__float_as_uint(cd[0]) & 0xFFFFFF00u);
#pragma unroll
        for (int i = 0; i < 16; ++i) {
            const unsigned bits = __float_as_uint(cd[i]);
            const int a = (bits >> 4) & 15, b = bits & 15;
            ex[i] = lut[a * 64 + f_lane] * PK + lut[(16 + b) * 64 + f_lane];
            gv[i] = __expf(__uint_as_float(bits & 0xFFFFFF00u) - top); sum += gv[i];
        }
        const float inv = 1.f / sum;
        if (h == 0) {
            u32x4* ep = (u32x4*)(eidx + (size_t)t * NSEL + hh * 16);
#pragma unroll
            for (int q = 0; q < 4; ++q) ep[q] = (u32x4){(unsigned)ex[4 * q], (unsigned)ex[4 * q + 1], (unsigned)ex[4 * q + 2], (unsigned)ex[4 * q + 3]};
        } else {
            f32x4* gp = (f32x4*)(gate + (size_t)t * NSEL + hh * 16);
#pragma unroll
            for (int q = 0; q < 4; ++q) gp[q] = (f32x4){gv[4 * q] * inv, gv[4 * q + 1] * inv, gv[4 * q + 2] * inv, gv[4 * q + 3] * inv};
        }
    }
    __syncthreads();
}
struct XInfo { int xrank, nx, rank, nloc; };
DI XInfo get_xinfo(Frame& F, const bool census) {
    FRAME_IDS;
    volatile LAS unsigned* M = (volatile LAS unsigned*)(F.lds + MISC_OFF);
    __syncthreads();
    if (f_tid == 0) {
        unsigned xr = (unsigned)F.bid & 7u, nx = 8u, rk = (unsigned)F.bid >> 3, nl = ((unsigned)F.G + 7u - ((unsigned)F.bid & 7u)) >> 3;
        if (census) {
            unsigned* bar = (unsigned*)(F.ws + WS_CTL) + CW_BAR; const unsigned x = xb_xcc_id();
            unsigned cnt = 0u, below = 0u, mine = 0u;
#pragma unroll
            for (unsigned j = 0; j < 16; ++j) { const unsigned c = xb_ld(&bar[XB_XCNT(j)]); cnt += (c > 0u); below += (c > 0u && j < x); mine = (j == x) ? c : mine; }
            if (cnt > 0u && mine > 0u) { xr = below; nx = cnt; rk = M[12]; nl = mine; }
        }
        M[20] = xr; M[21] = nx; M[22] = rk; M[23] = nl;
    }
    __syncthreads();
    XInfo xi; xi.xrank = (int)M[20]; xi.nx = (int)M[21]; xi.rank = (int)M[22]; xi.nloc = (int)M[23];
    return xi;
}
DI int comb_c(const int level, const int a, const int b, const int lane) {
    const int M = 4 >> level; const bool bit = (lane & M) != 0;
    const int send = bit ? a : b, keep = bit ? b : a;
    const int recv = level == 0 ? DPP_MOV_I(send, DPP_HMIRROR) : (level == 1 ? DPP_MOV_I(send, DPP_XOR2) : DPP_MOV_I(send, DPP_XOR1));
    return keep + recv;
}
DI int dot16_i8(const u32x4 r, const u32x4 x) {
    int s = __builtin_amdgcn_sdot4((int)r[0], (int)x[0], 0, false);
    s = __builtin_amdgcn_sdot4((int)r[1], (int)x[1], s, false); s = __builtin_amdgcn_sdot4((int)r[2], (int)x[2], s, false); s = __builtin_amdgcn_sdot4((int)r[3], (int)x[3], s, false);
    return s;
}
DI int half_dots(const u32x4 (&rows)[8], const u32x4 xq, const int lane) {
    int p[8];
#pragma unroll
    for (int i = 0; i < 8; ++i) p[i] = dot16_i8(rows[i], xq);
#pragma unroll
    for (int i = 0; i < 4; ++i) p[i] = comb_c(0, p[2 * i], p[2 * i + 1], lane);
    p[0] = comb_c(1, p[0], p[1], lane); p[1] = comb_c(1, p[2], p[3], lane);
    return comb_c(2, p[0], p[1], lane);
}
DI u32x4 xquant(const f32x4 (&hv)[4], const float rstd) {
    u32x4 o;
#pragma unroll
    for (int w = 0; w < 4; ++w) {
        const f32x4 x = hv[w] * (rstd * XQ);
        const int a = (int)rintf(__builtin_amdgcn_fmed3f(x[0], -127.f, 127.f)), b = (int)rintf(__builtin_amdgcn_fmed3f(x[1], -127.f, 127.f)), c = (int)rintf(__builtin_amdgcn_fmed3f(x[2], -127.f, 127.f)), d = (int)rintf(__builtin_amdgcn_fmed3f(x[3], -127.f, 127.f));
        o[w] = ((unsigned)a & 0xFFu) | (((unsigned)b & 0xFFu) << 8) | (((unsigned)c & 0xFFu) << 16) | ((unsigned)d << 24);
    }
    return o;
}
DI float rstd_bcast(const float* part, const int t) {
    const f32x4* p = (const f32x4*)(part + (size_t)t * 16);
    const f32x4 a = p[0], b = p[1], c = p[2], d = p[3];
    const float s = ((a[0] + a[1]) + (a[2] + a[3])) + ((b[0] + b[1]) + (b[2] + b[3])) + ((c[0] + c[1]) + (c[2] + c[3])) + ((d[0] + d[1]) + (d[2] + d[3]));
    return 1.f / sqrtf(s * (1.f / DM) + EPS);
}
DI int dot32_i4(const u32x4 r, const u32x4 xh, const u32x4 xl) {
    int ah = 0, al = 0;
#pragma unroll
    for (int d = 0; d < 4; ++d) { ah = __builtin_amdgcn_sdot8((int)r[d], (int)xh[d], ah, false); al = __builtin_amdgcn_sdot8((int)r[d], (int)xl[d], al, false); }
    return (ah << 4) + al;
}
DI int half_dots4(const u32x4 (&rows)[8], const u32x4 xa, const u32x4 xb, const int lane) {
    int p[8];
#pragma unroll
    for (int i = 0; i < 8; ++i) p[i] = dot32_i4(rows[i], xa, xb);
#pragma unroll
    for (int i = 0; i < 4; ++i) p[i] = comb_c(0, p[2 * i], p[2 * i + 1], lane);
    p[0] = comb_c(1, p[0], p[1], lane); p[1] = comb_c(1, p[2], p[3], lane);
    return comb_c(2, p[0], p[1], lane);
}
DI void gather_u(Frame& F, const int layer, const XInfo xi, const bool dry) {
    FRAME_IDS;
    const unsigned emask = (dry && PROBE_MODE == 2) ? 15u : ((dry && PROBE_MODE == 5) ? 4095u : 0xFFFFFFFFu);
    const int* eidx = (const int*)(F.ws + WS_EIDX); int* PU = (int*)(F.ws + (dry ? WS_R : WS_PU)); const float* part = (const float*)(F.ws + WS_PART); const bf16* hbp = (const bf16*)(F.ws + WS_XB);
    const int g = f_lane >> 3, c = f_lane & 7, c16 = c * 16;
    const int kst = 16 * g + (((c & 1) << 2) | (c & 2) | ((c & 4) >> 2));
    const int gwl = xi.rank * NWAVES + F.wave, NGWL = xi.nloc * NWAVES;
    LAS unsigned char* wl = F.lds + F.wave * 2048;
    __syncthreads();
    for (int j = xi.xrank; j < 8; j += xi.nx) {
        const int sl = j & 3, th = j >> 2;
        const __amdgpu_buffer_rsrc_t U8 = __builtin_amdgcn_make_buffer_rsrc((void*)(F.ws + WS_U8 + ((size_t)(layer * 4 + sl) * PE) * 128), 0, PE * 128, 0x00020000);
        int tt = gwl;
        if (tt >= T / 2) continue;
#define TOK(x_) (2 * (x_) + th)
#define U_LOAD(tk, ri, rh, rp) do { ri = *(const u32x2*)(eidx + (size_t)(tk) * NSEL + 2 * f_lane) & emask; rh = *(const u32x2*)(hbp + (size_t)(tk) * DM + 256 * sl + 4 * f_lane); \
            rp = part[(size_t)(tk) * 16 + (f_lane & 15)]; } while (0)
#define U_SPREAD(slot, ri, rh, rp, e, xa_, xb_) do { \
            float ps_ = rp; ps_ += __int_as_float(DPP_MOV_I(__float_as_int(ps_), DPP_XOR1)); ps_ += __int_as_float(DPP_MOV_I(__float_as_int(ps_), DPP_XOR2)); ps_ += __int_as_float(DPP_MOV_I(__float_as_int(ps_), DPP_HMIRROR)); ps_ += __int_as_float(DPP_MOV_I(__float_as_int(ps_), DPP_ROR8)); \
            const float rs_ = (1.f / sqrtf(ps_ * (1.f / DM) + EPS)) * XQ; \
            const int q0_ = (int)rintf(__builtin_amdgcn_fmed3f(__uint_as_float(rh[0] << 16) * rs_, -119.f, 119.f)), q1_ = (int)rintf(__builtin_amdgcn_fmed3f(__uint_as_float(rh[0] & 0xffff0000u) * rs_, -119.f, 119.f)); \
            const int q2_ = (int)rintf(__builtin_amdgcn_fmed3f(__uint_as_float(rh[1] << 16) * rs_, -119.f, 119.f)), q3_ = (int)rintf(__builtin_amdgcn_fmed3f(__uint_as_float(rh[1] & 0xffff0000u) * rs_, -119.f, 119.f)); \
            const int h0_ = (q0_ + 8) >> 4, h1_ = (q1_ + 8) >> 4, h2_ = (q2_ + 8) >> 4, h3_ = (q3_ + 8) >> 4;     \
            unsigned wh_ = ((unsigned)h0_ & 0xFu) | (((unsigned)h1_ & 0xFu) << 8) | (((unsigned)h2_ & 0xFu) << 16) | (((unsigned)h3_ & 0xFu) << 24); \
            unsigned wl_ = ((unsigned)(q0_ - 16 * h0_) & 0xFu) | (((unsigned)(q1_ - 16 * h1_) & 0xFu) << 8) | (((unsigned)(q2_ - 16 * h2_) & 0xFu) << 16) | (((unsigned)(q3_ - 16 * h3_) & 0xFu) << 24); \
            if (f_lane & 1) { wh_ <<= 4; wl_ <<= 4; } \
            wh_ |= (unsigned)DPP_MOV_I((int)wh_, DPP_XOR1); wl_ |= (unsigned)DPP_MOV_I((int)wl_, DPP_XOR1); \
            LAS unsigned char* sl_ = wl + (slot) * 1024; \
            *(LAS u32x2*)(sl_ + 8 * f_lane) = ri; if (!(f_lane & 1)) { *(LAS unsigned*)(sl_ + 512 + 2 * f_lane) = wh_; *(LAS unsigned*)(sl_ + 768 + 2 * f_lane) = wl_; } \
            asm volatile("s_waitcnt lgkmcnt(0)" ::: "memory"); \
            _Pragma("unroll") for (int q_ = 0; q_ < 4; ++q_) e[q_] = *(const LAS u32x4*)(sl_ + 64 * g + 16 * q_); \
            xa_ = *(const LAS u32x4*)(sl_ + 512 + 16 * c); xb_ = *(const LAS u32x4*)(sl_ + 768 + 16 * c); } while (0)
        u32x2 ri, rh; float rp;
        u32x4 e0[4], e1[4], xa, xb, xa1, xb1;
        U_LOAD(TOK(tt), ri, rh, rp); U_SPREAD(0, ri, rh, rp, e0, xa, xb);
        { const int t1 = (tt + NGWL < T / 2) ? tt + NGWL : tt; U_LOAD(TOK(t1), ri, rh, rp); U_SPREAD(1, ri, rh, rp, e1, xa1, xb1); }
        { const int t2 = (tt + 2 * NGWL < T / 2) ? tt + 2 * NGWL : tt; U_LOAD(TOK(t2), ri, rh, rp); }
        u32x4 A0[8], B0[8], A1[8], B1[8];
#pragma unroll
        for (int i = 0; i < 8; ++i) A0[i] = __builtin_amdgcn_raw_buffer_load_b128(U8, (int)e0[i >> 2][i & 3] * 128 + c16, 0, 0);
#pragma unroll
        for (int i = 0; i < 8; ++i) B0[i] = __builtin_amdgcn_raw_buffer_load_b128(U8, (int)e0[2 + (i >> 2)][i & 3] * 128 + c16, 0, 0);
#define U_ITEM(CA, CB, NA, NB, slot) do { \
            _Pragma("unroll") for (int i = 0; i < 8; ++i) NA[i] = __builtin_amdgcn_raw_buffer_load_b128(U8, (int)e1[i >> 2][i & 3] * 128 + c16, 0, 0); \
            asm volatile("" ::: "memory"); \
            const int r0 = half_dots4(CA, xa, xb, f_lane); \
            _Pragma("unroll") for (int i = 0; i < 8; ++i) NB[i] = __builtin_amdgcn_raw_buffer_load_b128(U8, (int)e1[2 + (i >> 2)][i & 3] * 128 + c16, 0, 0); \
            asm volatile("" ::: "memory"); \
            const int rr1 = half_dots4(CB, xa, xb, f_lane); \
            int* pp = PU + ((size_t)TOK(tt) * 4 + sl) * NSEL + kst; \
            pp[0] = r0; pp[8] = rr1; \
            xa = xa1; xb = xb1; \
            U_SPREAD(slot, ri, rh, rp, e1, xa1, xb1);                   \
            { const int t3 = (tt + 3 * NGWL < T / 2) ? tt + 3 * NGWL : tt; U_LOAD(TOK(t3), ri, rh, rp); } } while (0)
        for (;;) {
            U_ITEM(A0, B0, A1, B1, 0); tt += NGWL; if (tt >= T / 2) break;
            U_ITEM(A1, B1, A0, B0, 1); tt += NGWL; if (tt >= T / 2) break;
        }
#undef U_ITEM
#undef U_LOAD
#undef U_SPREAD
#undef TOK
    }
    __syncthreads();
}
DI void gather_r(Frame& F, const int layer) {
    FRAME_IDS;
    const int* PU = (const int*)(F.ws + WS_PU); const float* gate = (const float*)(F.ws + WS_GATE); const int* eidx = (const int*)(F.ws + WS_EIDX);
    const float* SCu = (const float*)(F.ws + WS_SC) + (size_t)layer * PE; const float* SCv = (const float*)(F.ws + WS_SC) + (size_t)(2 + layer) * PE;
    signed char* A8 = (signed char*)(F.ws + WS_A); float* SA = (float*)(F.ws + WS_SA);
    const int gw = F.bid * NWAVES + F.wave, NGW = F.G * NWAVES;
    for (int t = gw; t < T; t += NGW) {
        float a[2];
#pragma unroll
        for (int hf = 0; hf < 2; ++hf) {
            const int k = 64 * hf + f_lane;
            int sacc = 0;
#pragma unroll
            for (int j = 0; j < 4; ++j) sacc += PU[((size_t)t * 4 + j) * NSEL + k];
            const int e = eidx[(size_t)t * NSEL + k];
            const float d = (float)sacc * (SCu[e] * (1.f / XQ));
            a[hf] = gelu_erf(d) * gate[(size_t)t * NSEL + k] * SCv[e];
        }
        const float am = wave_max(fmaxf(fabsf(a[0]), fabsf(a[1])));
        const float sc = am > 0.f ? 127.f / am : 0.f;
        A8[(size_t)t * NSEL + f_lane] = (signed char)(int)rintf(a[0] * sc);
        A8[(size_t)t * NSEL + 64 + f_lane] = (signed char)(int)rintf(a[1] * sc);
        if (f_lane == 0) SA[t] = am * (1.f / 127.f);
    }
}
DI void tr4x4(const unsigned w0, const unsigned w1, const unsigned w2, const unsigned w3, unsigned (&cdw)[4]) {
    const unsigned t01l = __builtin_amdgcn_perm(w1, w0, 0x05010400u), t01h = __builtin_amdgcn_perm(w1, w0, 0x07030602u);
    const unsigned t23l = __builtin_amdgcn_perm(w3, w2, 0x05010400u), t23h = __builtin_amdgcn_perm(w3, w2, 0x07030602u);
    cdw[0] = __builtin_amdgcn_perm(t23l, t01l, 0x05040100u); cdw[1] = __builtin_amdgcn_perm(t23l, t01l, 0x07060302u);
    cdw[2] = __builtin_amdgcn_perm(t23h, t01h, 0x05040100u); cdw[3] = __builtin_amdgcn_perm(t23h, t01h, 0x07060302u);
}
DI void axpy4rows(const u32x4 r0, const u32x4 r1, const u32x4 r2, const u32x4 r3, const unsigned a4, int (&ahi)[16], int (&aall)[16]) {
#pragma unroll
    for (int d = 0; d < 4; ++d) {
        unsigned cdw[4];
        tr4x4(r0[d], r1[d], r2[d], r3[d], cdw);
#pragma unroll
        for (int b = 0; b < 4; ++b) {
            aall[4 * d + b] = __builtin_amdgcn_sdot4((int)cdw[b], (int)a4, aall[4 * d + b], false);
            ahi[4 * d + b] = __builtin_amdgcn_sdot4((int)(cdw[b] & 0xF0F0F0F0u), (int)a4, ahi[4 * d + b], false);
        }
    }
}
DI void gather_v(Frame& F, const int layer, const XInfo xi, const bool dry) {
    FRAME_IDS;
    const int* eidx = (const int*)(F.ws + WS_EIDX); const unsigned char* A8 = F.ws + WS_A; const float* SA = (const float*)(F.ws + WS_SA);
    float* part_w = dry ? (float*)(F.ws + WS_R) : (float*)(F.ws + WS_PART); bf16* hb_w = dry ? (bf16*)(F.ws + WS_HID2) : (bf16*)(F.ws + WS_XB); const bf16* hbp = (const bf16*)(F.ws + WS_XB);
    const int g = f_lane >> 3, c = f_lane & 7, c16 = c * 16;
    const int cc = 32 * c + 16 * (g >> 2) + 8 * ((g >> 1) & 1) + 4 * (g & 1);
    const int gwl = xi.rank * NWAVES + F.wave, NGWL = xi.nloc * NWAVES;
    const bool b3 = (f_lane & 8) != 0;
    LAS unsigned char* wl = F.lds + F.wave * 2048;
    __syncthreads();
    for (int j = xi.xrank; j < 8; j += xi.nx) {
        const int sl = j & 3, th = j >> 2;
        const __amdgpu_buffer_rsrc_t V8 = __builtin_amdgcn_make_buffer_rsrc((void*)(F.ws + WS_V8 + ((size_t)(layer * 4 + sl) * PE) * 128), 0, PE * 128, 0x00020000);
        int tt = gwl;
        if (tt >= T / 2) continue;
#define TOK(x_) (2 * (x_) + th)
#define V_LOAD(tk, ri, ra, rs) do { ri = *(const u32x2*)(eidx + (size_t)(tk) * NSEL + 2 * f_lane); ra = *(const unsigned short*)(A8 + (size_t)(tk) * NSEL + 2 * f_lane); rs = SA[(tk)]; } while (0)
#define V_SPREAD(slot, ri, ra, rs, e, avv, sav) do { \
            LAS unsigned char* sl_ = wl + (slot) * 1024; \
            *(LAS u32x2*)(sl_ + 8 * f_lane) = ri; *(LAS unsigned short*)(sl_ + 512 + 2 * f_lane) = ra; \
            asm volatile("s_waitcnt lgkmcnt(0)" ::: "memory"); \
            _Pragma("unroll") for (int q_ = 0; q_ < 4; ++q_) e[q_] = *(const LAS u32x4*)(sl_ + 64 * g + 16 * q_); \
            avv = *(const LAS u32x4*)(sl_ + 512 + 16 * g); sav = rs; } while (0)
        u32x2 ri; unsigned short ra; float rs;
        u32x4 e0[4], e1[4], av, a1; float sa, sa1; u32x2 hold;
        V_LOAD(TOK(tt), ri, ra, rs); V_SPREAD(0, ri, ra, rs, e0, av, sa);
        { const int t1 = (tt + NGWL < T / 2) ? tt + NGWL : tt; V_LOAD(TOK(t1), ri, ra, rs); V_SPREAD(1, ri, ra, rs, e1, a1, sa1); }
        { const int t2 = (tt + 2 * NGWL < T / 2) ? tt + 2 * NGWL : tt; V_LOAD(TOK(t2), ri, ra, rs); }
        hold = *(const u32x2*)(hbp + (size_t)TOK(tt) * DM + 256 * sl + cc);
        u32x4 A0[8], B0[8], A1[8], B1[8];
#pragma unroll
        for (int i = 0; i < 8; ++i) A0[i] = __builtin_amdgcn_raw_buffer_load_b128(V8, (int)e0[i >> 2][i & 3] * 128 + c16, 0, 0);
#pragma unroll
        for (int i = 0; i < 8; ++i) B0[i] = __builtin_amdgcn_raw_buffer_load_b128(V8, (int)e0[2 + (i >> 2)][i & 3] * 128 + c16, 0, 0);
#define V_ITEM(CA, CB, NA, NB, slot) do { \
            const int t1 = (tt + NGWL < T / 2) ? tt + NGWL : tt; \
            const u32x2 hold1 = *(const u32x2*)(hbp + (size_t)TOK(t1) * DM + 256 * sl + cc); \
            _Pragma("unroll") for (int i = 0; i < 8; ++i) NA[i] = __builtin_amdgcn_raw_buffer_load_b128(V8, (int)e1[i >> 2][i & 3] * 128 + c16, 0, 0); \
            asm volatile("" ::: "memory"); \
            int ahi[16], aall[16]; \
            _Pragma("unroll") for (int n = 0; n < 16; ++n) { ahi[n] = 0; aall[n] = 0; } \
            axpy4rows(CA[0], CA[1], CA[2], CA[3], av[0], ahi, aall); axpy4rows(CA[4], CA[5], CA[6], CA[7], av[1], ahi, aall); \
            _Pragma("unroll") for (int i = 0; i < 8; ++i) NB[i] = __builtin_amdgcn_raw_buffer_load_b128(V8, (int)e1[2 + (i >> 2)][i & 3] * 128 + c16, 0, 0); \
            asm volatile("" ::: "memory"); \
            axpy4rows(CB[0], CB[1], CB[2], CB[3], av[2], ahi, aall); axpy4rows(CB[4], CB[5], CB[6], CB[7], av[3], ahi, aall); \
            int sa8 = __builtin_amdgcn_sdot4(0x01010101, (int)av[0], 0, false); sa8 = __builtin_amdgcn_sdot4(0x01010101, (int)av[1], sa8, false); sa8 = __builtin_amdgcn_sdot4(0x01010101, (int)av[2], sa8, false); sa8 = __builtin_amdgcn_sdot4(0x01010101, (int)av[3], sa8, false); \
            sa8 *= 8; \
            int acc[32];                                                \
            _Pragma("unroll") for (int d_ = 0; d_ < 4; ++d_) _Pragma("unroll") for (int b_ = 0; b_ < 4; ++b_) { acc[8 * d_ + 4 + b_] = ahi[4 * d_ + b_]; acc[8 * d_ + b_] = (aall[4 * d_ + b_] - ahi[4 * d_ + b_] - sa8) << 4; } \
            int r16[16], r8[8]; float hv[4]; \
            _Pragma("unroll") for (int n = 0; n < 16; ++n) r16[n] = swap32_addi(acc[n], acc[16 + n]); \
            _Pragma("unroll") for (int n = 0; n < 8; ++n) r8[n] = swap16_addi(r16[n], r16[8 + n]); \
            _Pragma("unroll") for (int n = 0; n < 4; ++n) { const int keep = b3 ? r8[4 + n] : r8[n], send = b3 ? r8[n] : r8[4 + n]; hv[n] = (float)(keep + DPP_MOV_I(send, DPP_ROR8)) * sa; } \
            hv[0] += __uint_as_float(hold[0] << 16); hv[1] += __uint_as_float(hold[0] & 0xffff0000u); hv[2] += __uint_as_float(hold[1] << 16); hv[3] += __uint_as_float(hold[1] & 0xffff0000u); \
            const float ss = wave_sum_fast((hv[0] * hv[0] + hv[1] * hv[1]) + (hv[2] * hv[2] + hv[3] * hv[3])); \
            *(u32x2*)(hb_w + (size_t)TOK(tt) * DM + 256 * sl + cc) = (u32x2){cvtpk(hv[0], hv[1]), cvtpk(hv[2], hv[3])}; \
            if (f_lane == 0) part_w[(size_t)TOK(tt) * 16 + sl] = ss; \
            if (sl == 0 && f_lane >= 4 && f_lane < 16) part_w[(size_t)TOK(tt) * 16 + f_lane] = 0.f; \
            av = a1; sa = sa1; hold = hold1; \
            V_SPREAD(slot, ri, ra, rs, e1, a1, sa1); \
            { const int t3 = (tt + 3 * NGWL < T / 2) ? tt + 3 * NGWL : tt; V_LOAD(TOK(t3), ri, ra, rs); } } while (0)
        for (;;) {
            V_ITEM(A0, B0, A1, B1, 0); tt += NGWL; if (tt >= T / 2) break;
            V_ITEM(A1, B1, A0, B0, 1); tt += NGWL; if (tt >= T / 2) break;
        }
#undef V_ITEM
#undef V_LOAD
#undef V_SPREAD
#undef TOK
    }
    __syncthreads();
}
DI void final_norm(Frame& F) {
    FRAME_IDS;
    const float* part = (const float*)(F.ws + WS_PART); const bf16* hbp = (const bf16*)(F.ws + WS_XB);
    const int gw = F.bid * NWAVES + F.wave, NGW = F.G * NWAVES;
    for (int t = gw; t < T; t += NGW) {
        const float r = rstd_bcast(part, t);
        const u32x2* hp = (const u32x2*)(hbp + (size_t)t * DM) + f_lane;
        f32x4* op = (f32x4*)(F.out + (size_t)t * DM) + f_lane;
        const f32x4* gp = (const f32x4*)F.final_norm + f_lane;
#pragma unroll
        for (int q = 0; q < 4; ++q) { const u32x2 w = hp[64 * q];
            const f32x4 h = {__uint_as_float(w[0] << 16), __uint_as_float(w[0] & 0xffff0000u), __uint_as_float(w[1] << 16), __uint_as_float(w[1] & 0xffff0000u)};
            op[64 * q] = h * r * gp[64 * q]; }
    }
}
DI void opt_conv(Frame& F) {
    FRAME_IDS;
    const bf16* G = (const bf16*)(F.ws + WS_GLU); bf16* H2 = (bf16*)(F.ws + WS_HID2);
    LAS float* ys = (LAS float*)F.lds;
    f32x2 wt[CW];
#pragma unroll
    for (int j = 0; j < CW; ++j) wt[j] = *(const f32x2*)(F.conv_dw + j * DM + 2 * f_tid);
    const f32x2 bdw = *(const f32x2*)(F.conv_dw_b + 2 * f_tid);
    f32x4 lng[4], lnb[4];
#pragma unroll
    for (int k = 0; k < 4; ++k) { lng[k] = *(const f32x4*)(F.conv_ln_g + 256 * k + 4 * f_lane); lnb[k] = *(const f32x4*)(F.conv_ln_b + 256 * k + 4 * f_lane); }
    for (int it = F.bid; it < T / 128; it += F.G) {
        const int s0 = (it % (SEQ / 128)) * 128;
        const size_t row0 = (size_t)it * 128;
        const unsigned* gp = (const unsigned*)G + f_tid;
        f32x2 win[CW];
#pragma unroll
        for (int u = 0; u < CW - 1; ++u) { const int sp = s0 - (CW - 1) + u; const unsigned xv = sp >= 0 ? gp[(row0 - (CW - 1) + u) * 512] : 0u; win[u + 1] = (f32x2){__uint_as_float(xv << 16), __uint_as_float(xv & 0xffff0000u)}; }
        win[0] = (f32x2){0.f, 0.f};
        unsigned nx[CW], nn[CW];
#pragma unroll
        for (int u = 0; u < CW; ++u) nx[u] = (s0 + u < SEQ) ? gp[(row0 + u) * 512] : 0u;
        for (int bt = 0; bt < 5; ++bt) {
#pragma unroll
            for (int u = 0; u < CW; ++u) { const int sl = 31 * (bt + 1) + u; nn[u] = (bt < 4 && s0 + sl < SEQ) ? gp[(row0 + sl) * 512] : 0u; }
            __syncthreads();
#pragma unroll
            for (int u = 0; u < CW; ++u) {
                win[u] = (f32x2){__uint_as_float(nx[u] << 16), __uint_as_float(nx[u] & 0xffff0000u)};
                f32x2 a = bdw;
#pragma unroll
                for (int j = 0; j < CW; ++j) a = wt[j] * win[(u + 1 + j) % CW] + a;
                *(LAS f32x2*)(ys + u * DM + 2 * f_tid) = a;
            }
            __syncthreads();
            for (int u = F.wave; u < CW; u += NWAVES) {
                const int sl = 31 * bt + u;
                if (sl < 128) {
                    f32x4 v[4]; float sm = 0.f;
#pragma unroll
                    for (int k = 0; k < 4; ++k) { v[k] = *(const LAS f32x4*)(ys + u * DM + 256 * k + 4 * f_lane); sm += (v[k][0] + v[k][1]) + (v[k][2] + v[k][3]); }
                    const float mu = wave_sum(sm) * (1.f / DM);
                    float sq = 0.f;
#pragma unroll
                    for (int k = 0; k < 4; ++k) { v[k] = v[k] - mu; sq += (v[k][0] * v[k][0] + v[k][1] * v[k][1]) + (v[k][2] * v[k][2] + v[k][3] * v[k][3]); }
                    const float rs = 1.f / sqrtf(wave_sum(sq) * (1.f / DM) + EPS);
#pragma unroll
                    for (int k = 0; k < 4; ++k) {
                        f32x4 z = v[k] * rs * lng[k] + lnb[k];
#pragma unroll
                        for (int e = 0; e < 4; ++e) z[e] = z[e] / (1.f + __expf(-z[e]));
                        *(u32x2*)(H2 + (row0 + sl) * DM + 256 * k + 4 * f_lane) = (u32x2){cvtpk(z[0], z[1]), cvtpk(z[2], z[3])};
                    }
                }
            }
#pragma unroll
            for (int u = 0; u < CW; ++u) nx[u] = nn[u];
        }
    }
    __syncthreads();
}
enum Phase { PH_PREP = 0, PH_PREPW, PH_PROJ, PH_MIX, PH_WOUT, PH_Q0, PH_GU0, PH_GR0, PH_GV0, PH_W1, PH_CONV, PH_W2, PH_Q1, PH_GU1, PH_GR1, PH_GV1, PH_FINAL, PH_COUNT };
struct Args { const float* in[19]; float* out; unsigned char* ws; int ph_lo, ph_hi; };
#ifndef TEST_PHASE
#define TEST_PHASE -1
#endif

__global__ void __launch_bounds__(NTHR, 2) mega_fwd(Args args) {
    extern __shared__ __attribute__((aligned(16))) unsigned char lds[];
    Frame F;
    F.lds = (LAS unsigned char*)lds;
    F.wave = __builtin_amdgcn_readfirstlane((int)threadIdx.x >> 6); FRAME_IDS;
    F.G = gridDim.x; F.bid = blockIdx.x;
    F.x = args.in[0]; F.mix_norm = args.in[1]; F.ffn_norm = args.in[2]; F.final_norm = args.in[3]; F.w_in = args.in[4]; F.w_out = args.in[5]; F.rel_bias = args.in[6];
    F.conv_w1 = args.in[7]; F.conv_b1 = args.in[8]; F.conv_dw = args.in[9]; F.conv_dw_b = args.in[10]; F.conv_ln_g = args.in[11]; F.conv_ln_b = args.in[12];
    F.conv_w2 = args.in[13]; F.conv_b2 = args.in[14]; F.peer_wq = args.in[15]; F.peer_keys = args.in[16]; F.peer_u = args.in[17]; F.peer_v = args.in[18];
    F.out = args.out; F.ws = args.ws;
    volatile LAS unsigned* MISC = (volatile LAS unsigned*)(F.lds + MISC_OFF);
    for (int u = f_tid; u < (LDS_BYTES - LDSCTL_OFF) / 4; u += NTHR) ((LAS unsigned*)(F.lds + LDSCTL_OFF))[u] = 0u;
    __syncthreads();
    const int lo = args.ph_lo, hi = args.ph_hi;
    XcdBarrier bar; bar.bar = (unsigned*)(F.ws + WS_CTL) + CW_BAR; bar.x = 0; bar.st = nullptr;
    if (hi - lo > 1) bar = xcd_barrier_post((unsigned*)(F.ws + WS_CTL) + CW_BAR, MISC + 8);
#define IN(k) ((TEST_PHASE < 0 || TEST_PHASE == (k)) && lo <= (k) && (k) < hi)
#define SEAM(k) do { if (IN(k) && IN((k) + 1)) xcd_barrier(bar, F.wave); } while (0)
#define REPS(k) for (int rep_ = ((k) == REP_PHASE ? 0 : 1); rep_ < 2; ++rep_)
#define GEMM_PHASE(EPI, Aptr, Bptr, NN, ...) do { pg8::Gemm g{(const bf16*)(Aptr), (const bf16*)(Bptr), T, (NN), DM}; pg8::StaticOrder S; S.init(T, (NN), F.G, F.bid); \
        pg8::EPI E{__VA_ARGS__}; pg8::gemm_phase<pg8::EPI, pg8::StaticOrder, true, true>(F.lds, g, S, E, F.wave); } while (0)
    bf16* XB = (bf16*)(F.ws + WS_XB);
    float* PART = (float*)(F.ws + WS_PART); const float* ROPE = (const float*)(F.ws + WS_ROPE);
    if (IN(PH_PREP)) REPS(PH_PREP) { p0_prep(F); p0_weights(F, 0); } SEAM(PH_PREP);
    if (IN(PH_PREPW)) REPS(PH_PREPW) { p0_weights(F, 1); } SEAM(PH_PREPW);
    if (PROBE_MODE == 9 && IN(PH_PREP) && IN(PH_PREP + 1)) { for (int xb_ = 0; xb_ < 8; ++xb_) xcd_barrier(bar, F.wave); }
    if (IN(PH_PROJ)) REPS(PH_PROJ) { { pg8::Gemm g{(const bf16*)XB, (const bf16*)(F.ws + WS_WIN), T, INC, DM / 2}; pg8::StaticOrder S; S.init(T, INC, F.G, F.bid); pg8::EpiProj8 E{(bf16*)(F.ws + WS_R), ROPE, (const float*)(F.ws + WS_ROWSC), (const float*)(F.ws + WS_COLSC)}; pg8::gemm_phase<pg8::EpiProj8, pg8::StaticOrder, true, true, true>(F.lds, g, S, E, F.wave); } } SEAM(PH_PROJ);
    if (IN(PH_MIX)) REPS(PH_MIX) { mix_phase(F, rep_); } SEAM(PH_MIX);
    if (IN(PH_WOUT)) REPS(PH_WOUT) { GEMM_PHASE(EpiRes, F.ws + WS_O, F.ws + WS_WOUT, DM, F.x, XB, PART, nullptr); } SEAM(PH_WOUT);
    if (IN(PH_Q0)) REPS(PH_Q0) { GEMM_PHASE(EpiQ, XB, F.ws + WS_WQ, DM, (bf16*)(F.ws + WS_Q), PART); asm volatile("s_waitcnt vmcnt(0)" ::: "memory"); __syncthreads(); opt_route(F, 0); } SEAM(PH_Q0);
    const bool census = (hi - lo > 1);
    if (IN(PH_GU0)) REPS(PH_GU0) { gather_u(F, 0, get_xinfo(F, census), rep_ == 0); } SEAM(PH_GU0);
    if (IN(PH_GR0)) REPS(PH_GR0) { gather_r(F, 0); } SEAM(PH_GR0);
    if (IN(PH_GV0)) REPS(PH_GV0) { gather_v(F, 0, get_xinfo(F, census), rep_ == 0); } SEAM(PH_GV0);
    if (IN(PH_W1)) REPS(PH_W1) { GEMM_PHASE(EpiGlu, XB, F.ws + WS_W1, 2 * DM, (bf16*)(F.ws + WS_GLU), PART, F.conv_b1); } SEAM(PH_W1);
    if (IN(PH_CONV)) REPS(PH_CONV) { opt_conv(F); } SEAM(PH_CONV);
    if (IN(PH_W2)) { GEMM_PHASE(EpiRes, F.ws + WS_HID2, F.ws + WS_W2, DM, nullptr, XB, PART, F.conv_b2); } SEAM(PH_W2);
    if (IN(PH_Q1)) REPS(PH_Q1) { GEMM_PHASE(EpiQ, XB, F.ws + WS_WQ + (size_t)DM * DM * 2, DM, (bf16*)(F.ws + WS_Q), PART); asm volatile("s_waitcnt vmcnt(0)" ::: "memory"); __syncthreads(); opt_route(F, 1); } SEAM(PH_Q1);
    if (IN(PH_GU1)) REPS(PH_GU1) { gather_u(F, 1, get_xinfo(F, census), rep_ == 0); } SEAM(PH_GU1);
    if (IN(PH_GR1)) REPS(PH_GR1) { gather_r(F, 1); } SEAM(PH_GR1);
    if (IN(PH_GV1)) REPS(PH_GV1) { gather_v(F, 1, get_xinfo(F, census), rep_ == 0); } SEAM(PH_GV1);
    if (IN(PH_FINAL)) { final_norm(F); }
#undef IN
#undef SEAM
}

extern "C" void kernel_launch(void* const* d_in, const int* in_sizes, int n_in, void* d_out, int out_size, void* d_ws, size_t ws_size, hipStream_t stream) {
    static int grid = 0;
    if (grid == 0) {
        if (n_in != 19 || out_size != T * DM || ws_size < WS_END) { fprintf(stderr, "kernel_launch: unexpected shapes (n_in %d out %d ws %zu)\n", n_in, out_size, ws_size); grid = -1; return; }
        int dev = 0, cus = 0;
        if (hipGetDevice(&dev) != hipSuccess || hipDeviceGetAttribute(&cus, hipDeviceAttributeMultiprocessorCount, dev) != hipSuccess) { grid = -1; return; }
        if (hipFuncSetAttribute((const void*)mega_fwd, hipFuncAttributeMaxDynamicSharedMemorySize, LDS_BYTES) != hipSuccess) { fprintf(stderr, "kernel_launch: hipFuncSetAttribute failed\n"); grid = -1; return; }
        (void)hipGetLastError();
        grid = cus;
    }
    if (grid < 0) return;
    (void)hipMemsetAsync((char*)d_ws + WS_CTL, 0, CTL_ZERO_BYTES, stream);
    Args a{};
    for (int i = 0; i < 19; ++i) a.in[i] = (const float*)d_in[i];
    a.out = (float*)d_out; a.ws = (unsigned char*)d_ws;
#if MK_ONE_LAUNCH
    a.ph_lo = 0; a.ph_hi = PH_COUNT;
    hipLaunchKernelGGL(mega_fwd, dim3(grid), dim3(NTHR), LDS_BYTES, stream, a);
#else
    for (int p = 0; p < PH_COUNT; ++p) { a.ph_lo = p; a.ph_hi = p + 1; hipLaunchKernelGGL(mega_fwd, dim3(grid), dim3(NTHR), LDS_BYTES, stream, a); }
#endif
}
```

```cpp
#include <hip/hip_runtime.h>
#include <cstdio>
#include <cstdint>

#ifndef REP_PHASE
#define REP_PHASE -1
#endif
#ifndef PROBE_MODE
#define PROBE_MODE 1
#endif
#ifndef MK_ONE_LAUNCH
#define MK_ONE_LAUNCH 1
#endif

#define GAS __attribute__((address_space(1)))
#define LAS __attribute__((address_space(3)))
#define DI __device__ __forceinline__
typedef unsigned short bf16;
typedef float f32x2 __attribute__((ext_vector_type(2)));
typedef float f32x4 __attribute__((ext_vector_type(4)));
typedef unsigned u32x2 __attribute__((ext_vector_type(2)));
typedef unsigned u32x4 __attribute__((ext_vector_type(4)));
typedef short bf16x8 __attribute__((ext_vector_type(8)));
typedef float f32x16 __attribute__((ext_vector_type(16)));

constexpr int NB = 16, SEQ = 2048, DM = 1024, T = NB * SEQ;
constexpr int CHUNK = 64, HD = 64, NHA = 8, NHB = 8, INC = 3584, NCH = SEQ / CHUNK;
constexpr int PH = 8, PK = 128, PE = PK * PK, PQD = 128, PTOP = 16, NSEL = PH * PTOP;
constexpr int CW = 31;
constexpr float EPS = 1e-6f;
constexpr float LOG2E = 1.4426950408889634f;
constexpr float XQ = 127.f / 6.f;
constexpr int NWAVES = 8, NTHR = NWAVES * 64;

constexpr int C_QA = 0, C_KA = 512, C_VA = 1024, C_QB = 1536, C_KB = 2048, C_VB = 2560, C_GB = 3072;

constexpr size_t MiB = 1u << 20;
constexpr size_t WS_CTL = 0, CTL_ZERO_BYTES = 1 * MiB;
constexpr size_t WS_WIN = 2 * MiB, WS_WOUT = 9 * MiB, WS_W1 = 11 * MiB, WS_W2 = 15 * MiB, WS_WQ = 17 * MiB;
constexpr size_t WS_ROPE = 22 * MiB;
constexpr size_t WS_PART = 23 * MiB;
constexpr size_t WS_EIDX = 26 * MiB;
constexpr size_t WS_GATE = 42 * MiB;
constexpr size_t WS_U8 = 64 * MiB, WS_V8 = 96 * MiB;
constexpr size_t WS_SC = 25 * MiB;
constexpr size_t WS_ROWSC = 59 * MiB;
constexpr size_t WS_COLSC = 60 * MiB;
constexpr size_t WS_SA = 58 * MiB;
constexpr size_t WS_PU = 256 * MiB;
constexpr size_t WS_A = 384 * MiB;
constexpr size_t WS_XB = 128 * MiB;
constexpr size_t WS_R = 192 * MiB;
constexpr size_t WS_O = 416 * MiB;
constexpr size_t WS_Q = 192 * MiB;
constexpr size_t WS_HID = 256 * MiB;
constexpr size_t WS_GLU = 384 * MiB;
constexpr size_t WS_HID2 = 448 * MiB;
constexpr size_t WS_END = 512 * MiB;
constexpr int CW_BAR = 4096, CW_QUEUE = 8192;

constexpr int RING_BYTES = 131072, LDSCTL_OFF = RING_BYTES, MISC_OFF = LDSCTL_OFF + 320, LDS_BYTES = 147456;

DI float bf2f(bf16 v) { return __uint_as_float(((unsigned)v) << 16); }
DI unsigned f2bf(float f) { unsigned u = __float_as_uint(f); return (u + 0x7fffu + ((u >> 16) & 1u)) >> 16; }
DI unsigned pk2(float lo, float hi) { return f2bf(lo) | (f2bf(hi) << 16); }
#define DPP_MOV_I(x, ctrl) __builtin_amdgcn_mov_dpp((x), (ctrl), 0xF, 0xF, false)
#define DPP_XOR1 0xB1
#define DPP_XOR2 0x4E
#define DPP_HMIRROR 0x141
#define DPP_ROR8 0x128
DI float swap32_add(const float a, const float b) { const auto r = __builtin_amdgcn_permlane32_swap(__float_as_uint(a), __float_as_uint(b), false, false); return __uint_as_float(r[0]) + __uint_as_float(r[1]); }
DI float swap16_add(const float a, const float b) { const auto r = __builtin_amdgcn_permlane16_swap(__float_as_uint(a), __float_as_uint(b), false, false); return __uint_as_float(r[0]) + __uint_as_float(r[1]); }
DI int swap32_addi(const int a, const int b) { const auto r = __builtin_amdgcn_permlane32_swap((unsigned)a, (unsigned)b, false, false); return (int)(r[0] + r[1]); }
DI int swap16_addi(const int a, const int b) { const auto r = __builtin_amdgcn_permlane16_swap((unsigned)a, (unsigned)b, false, false); return (int)(r[0] + r[1]); }
DI float wave_sum_fast(float v) {
    v += __int_as_float(DPP_MOV_I(__float_as_int(v), DPP_XOR1)); v += __int_as_float(DPP_MOV_I(__float_as_int(v), DPP_XOR2));
    v += __int_as_float(DPP_MOV_I(__float_as_int(v), DPP_HMIRROR)); v += __int_as_float(DPP_MOV_I(__float_as_int(v), DPP_ROR8));
    v = swap16_add(v, v); v = swap32_add(v, v);
    return v;
}
DI float wave_sum(float v) { return wave_sum_fast(v); }
DI float swap32_max(const float a) { const auto r = __builtin_amdgcn_permlane32_swap(__float_as_uint(a), __float_as_uint(a), false, false); return fmaxf(__uint_as_float(r[0]), __uint_as_float(r[1])); }
DI float swap16_max(const float a) { const auto r = __builtin_amdgcn_permlane16_swap(__float_as_uint(a), __float_as_uint(a), false, false); return fmaxf(__uint_as_float(r[0]), __uint_as_float(r[1])); }
DI float wave_max(float v) {
    v = fmaxf(v, __int_as_float(DPP_MOV_I(__float_as_int(v), DPP_XOR1))); v = fmaxf(v, __int_as_float(DPP_MOV_I(__float_as_int(v), DPP_XOR2)));
    v = fmaxf(v, __int_as_float(DPP_MOV_I(__float_as_int(v), DPP_HMIRROR))); v = fmaxf(v, __int_as_float(DPP_MOV_I(__float_as_int(v), DPP_ROR8)));
    v = swap16_max(v); v = swap32_max(v);
    return v;
}
DI float block_sum(float v, LAS float* red, int tid) {
    v = wave_sum(v);
    __syncthreads();
    if ((tid & 63) == 0) red[tid >> 6] = v;
    __syncthreads();
    float s = 0.f;
#pragma unroll
    for (int i = 0; i < NWAVES; ++i) s += red[i];
    return s;
}
DI float gelu_erf(float x) { return 0.5f * x * (1.f + erff(x * 0.70710678118654752f)); }
DI float sigmoidf(float x) { return 1.f / (1.f + __expf(-x)); }

DI int lane_id() { int r; asm volatile("v_mbcnt_lo_u32_b32 %0, -1, 0\n\tv_mbcnt_hi_u32_b32 %0, -1, %0" : "=v"(r)); return r; }
#define XB_TMO      128
#define XB_XCNT(j)  (256  + 64 * (j))
#define XB_XSUB(j)  (1280 + 64 * (j))
#define XB_XGEN(j)  (2304 + 64 * (j))
#define XB_TOP      3328
#define XB_TOPGEN   3392
#define XCD_BAR_WORDS 3456
#define XB_SPIN_CAP (1u << 22)
DI unsigned xb_ld(unsigned* p)              { return __hip_atomic_load(p, __ATOMIC_RELAXED, __HIP_MEMORY_SCOPE_AGENT); }
DI unsigned xb_add(unsigned* p, unsigned v) { return __hip_atomic_fetch_add(p, v, __ATOMIC_RELAXED, __HIP_MEMORY_SCOPE_AGENT); }
DI unsigned xb_xcc_id() { return (unsigned)__builtin_amdgcn_s_getreg((3 << 11) | 20) & 0xFu; }
#define XB_SPIN(cond, bar) do { unsigned _sp = 0; while (cond) { __builtin_amdgcn_s_sleep(1); \
    if ((++_sp & 255u) == 0u) { if (xb_ld(&(bar)[XB_TMO])) break; if (_sp > XB_SPIN_CAP) { atomicAdd(&(bar)[XB_TMO], 1u); break; } } } } while (0)
struct XcdBarrier { unsigned* bar; unsigned x; volatile LAS unsigned* st; };
DI XcdBarrier xcd_barrier_post(unsigned* bar, volatile LAS unsigned* st) {
    XcdBarrier b; b.bar = bar; b.x = xb_xcc_id(); b.st = st;
    if (threadIdx.x == 0) st[4] = xb_add(&bar[XB_XCNT(b.x)], 1u);
    return b;
}
DI void xcd_barrier_complete(unsigned* bar, unsigned x, unsigned& nloc, unsigned& nx) {
    const unsigned G = gridDim.x * gridDim.y * gridDim.z;
    unsigned sum, cnt, mine, sp = 0u;
    for (;;) {
        sum = 0u; cnt = 0u; mine = 0u;
#pragma unroll
        for (unsigned j = 0; j < 16; ++j) { const unsigned c = xb_ld(&bar[XB_XCNT(j)]); sum += c; cnt += (c > 0u) ? 1u : 0u; mine = (j == x) ? c : mine; }
        if (sum == G) break;
        __builtin_amdgcn_s_sleep(1);
        if ((++sp & 255u) == 0u) { if (xb_ld(&bar[XB_TMO])) break; if (sp > XB_SPIN_CAP) { atomicAdd(&bar[XB_TMO], 1u); break; } }
    }
    nloc = mine > 0u ? mine : 1u; nx = cnt > 0u ? cnt : 1u;
}
DI void xcd_barrier(const XcdBarrier& b, const int wave_id) {
    asm volatile("s_waitcnt vmcnt(0)" ::: "memory");
    __syncthreads();
    if (wave_id == 0 && lane_id() == 0) {
        unsigned* bar = b.bar;
        __builtin_amdgcn_s_waitcnt(0);
        unsigned nloc = b.st[0], nx = b.st[1];
        if (nloc == 0u) { xcd_barrier_complete(bar, b.x, nloc, nx); b.st[0] = nloc; b.st[1] = nx; }
        const unsigned old = xb_add(&bar[XB_XSUB(b.x)], 1u);
        const unsigned gen = old / nloc;
        if (old + 1u == (gen + 1u) * nloc) {
            __builtin_amdgcn_fence(__ATOMIC_RELEASE, "agent");
            asm volatile("s_waitcnt vmcnt(0)" ::: "memory");
            const unsigned og = xb_add(&bar[XB_TOP], 1u);
            const unsigned tg = og / nx;
            if (og + 1u == (tg + 1u) * nx) xb_add(&bar[XB_TOPGEN], 1u);
            else XB_SPIN(xb_ld(&bar[XB_TOPGEN]) == tg, bar);
            __builtin_amdgcn_fence(__ATOMIC_ACQUIRE, "agent");
            xb_add(&bar[XB_XGEN(b.x)], 1u);
            asm volatile("s_waitcnt vmcnt(0)" ::: "memory");
        } else {
            XB_SPIN(xb_ld(&bar[XB_XGEN(b.x)]) == gen, bar);
            __builtin_amdgcn_fence(__ATOMIC_ACQUIRE, "agent");
            asm volatile("s_waitcnt vmcnt(0)" ::: "memory");
        }
    }
    __syncthreads();
}

namespace pg8 {
#define PG8_LAS __attribute__((address_space(3)))
typedef unsigned short bf16_t;
typedef short bf16x8 __attribute__((ext_vector_type(8)));
typedef float f32x4 __attribute__((ext_vector_type(4)));
typedef unsigned u32x4 __attribute__((ext_vector_type(4)));
typedef int i32x4 __attribute__((ext_vector_type(4)));
constexpr int BM = 256, BK = 64, HALF = 128, HTB = HALF * BK * 2  , STAGE_BYTES = 8 * HTB, NXCD = 8, WGM = 8;

__host__ __device__ __forceinline__ int lds_byte(int r, int c) { const int st = (r >> 4) * 2 + (c >> 5), rr = r & 15, cc = c & 31, ob = rr * 64 + cc * 2; return st * 1024 + (ob ^ (((ob >> 9) & 1) << 5)); }
__host__ __device__ __forceinline__ void stage_rc(int b, int& R, int& C) { const int st = b / 1024, sb = b % 1024, swz = sb ^ (((sb >> 9) & 1) << 5); R = (st >> 1) * 16 + swz / 64; C = (st & 1) * 32 + (swz % 64) / 2; }
__host__ __device__ __forceinline__ int perm32(int rho) { const int n = rho >> 4, i = rho & 15; return 8 * (i >> 2) + 4 * n + (i & 3); }

struct Unit { int pm, pn; };
struct Gemm { const bf16_t* A; const bf16_t* Bt; int M, N, K; };

struct StaticOrder {
    int nM, nN, nwg, G, c;
    __host__ __device__ void init(int M, int N, int G_, int c_) { nM = M / BM; nN = N / BM; nwg = nM * nN; G = G_; c = c_; }
    __host__ __device__ bool next(int i, Unit& u) const {
        const long L = (long)i * G + c; if (L >= nwg) return false;
        int wgid = (int)L; { const int q = nwg / NXCD, r = nwg % NXCD, xcd = wgid % NXCD, off = wgid / NXCD; wgid = (xcd < r ? xcd * (q + 1) : r * (q + 1) + (xcd - r) * q) + off; }
        const int nig = WGM * nN, gid = wgid / nig, fm = gid * WGM, gsz = (nM - fm) < WGM ? (nM - fm) : WGM;
        u.pm = fm + ((wgid % nig) % gsz); u.pn = (wgid % nig) / gsz; return true;
    }
    __device__ __forceinline__ void a_ready(const Unit&) const {}
    __device__ __forceinline__ void done(const Unit&) const {}
};

__device__ __forceinline__ unsigned cvt_pk_bf16(float lo, float hi) { unsigned r; asm volatile("v_cvt_pk_bf16_f32 %0, %1, %2" : "=v"(r) : "v"(lo), "v"(hi)); return r; }
__device__ __forceinline__ float rstd16(const float* part, int r, int fq) {
    const f32x4 a = *(const f32x4*)(part + (size_t)r * 16 + 4 * fq);
    float s = (a[0] + a[1]) + (a[2] + a[3]);
    s = swap16_add(s, s); s = swap32_add(s, s);
    return 1.f / sqrtf(s * (1.f / 1024.f) + 1e-6f);
}
__device__ __forceinline__ u32x4 pack8(const f32x4 a, const f32x4 b) { u32x4 w; w.x = cvt_pk_bf16(a[0], a[1]); w.y = cvt_pk_bf16(a[2], a[3]); w.z = cvt_pk_bf16(b[0], b[1]); w.w = cvt_pk_bf16(b[2], b[3]); return w; }
#define rot(t1, t2, c, s) do { const float a_ = (t1) * (c) - (t2) * (s), b_ = (t1) * (s) + (t2) * (c); (t1) = a_; (t2) = b_; } while (0)

struct EpiProj8 {
    static constexpr bool PERM = true, AFTER_DRAIN = false;
    bf16_t* R; const float* rope; const float* rowsc; const float* colsc;
    __device__ __forceinline__ void operator()(const f32x4 (&acc)[2][2][4][2], const Unit& u, int wr, int wc, int fr, int fq) const {
        const int type = u.pn >> 1, hg = u.pn & 1;
        const int colbase = type * 512 + (4 * hg + wc) * 64 + 8 * fq;
        const bool do_rope = (type == 3) || (type == 4);
        f32x4 cs[2][2];
#pragma unroll
        for (int bj = 0; bj < 2; ++bj)
#pragma unroll
            for (int n = 0; n < 2; ++n) cs[bj][n] = *(const f32x4*)(colsc + u.pn * BM + bj * HALF + wc * 32 + 8 * fq + 4 * n);
#pragma unroll
        for (int ai = 0; ai < 2; ++ai)
#pragma unroll
            for (int m = 0; m < 4; ++m) {
                const int r = u.pm * BM + ai * HALF + wr * 64 + m * 16 + fr;
                const float rs = rowsc[r];
                f32x4 v[2][2];
#pragma unroll
                for (int bj = 0; bj < 2; ++bj)
#pragma unroll
                    for (int n = 0; n < 2; ++n) { const i32x4 ia = __builtin_bit_cast(i32x4, acc[ai][bj][m][n]);
                        v[bj][n] = (f32x4){(float)ia[0], (float)ia[1], (float)ia[2], (float)ia[3]} * cs[bj][n] * rs; }
                f32x4 a0 = v[0][0], a1 = v[0][1], b0 = v[1][0], b1 = v[1][1];
                if (do_rope) {
                    const f32x4* rp = (const f32x4*)(rope + ((size_t)(r & 2047) * 32 + 8 * fq) * 2);
                    const f32x4 c0 = rp[0], c1 = rp[1], c2 = rp[2], c3 = rp[3];
                    rot(a0[0], b0[0], c0[0], c0[1]); rot(a0[1], b0[1], c0[2], c0[3]); rot(a0[2], b0[2], c1[0], c1[1]); rot(a0[3], b0[3], c1[2], c1[3]);
                    rot(a1[0], b1[0], c2[0], c2[1]); rot(a1[1], b1[1], c2[2], c2[3]); rot(a1[2], b1[2], c3[0], c3[1]); rot(a1[3], b1[3], c3[2], c3[3]);
                }
                bf16_t* rowp = R + (size_t)r * 3584 + colbase;
                *(u32x4*)(rowp) = pack8(a0, a1);
                *(u32x4*)(rowp + 32) = pack8(b0, b1);
            }
    }
};
struct EpiRes {
    static constexpr bool PERM = true, AFTER_DRAIN = false;
    const float* xf; bf16_t* hb; float* part; const float* bias;
    __device__ __forceinline__ void operator()(const f32x4 (&acc)[2][2][4][2], const Unit& u, int wr, int wc, int fr, int fq) const {
        const int col0 = u.pn * BM + wc * 32 + 8 * fq;
        f32x4 bv[2][2];
#pragma unroll
        for (int bj = 0; bj < 2; ++bj)
#pragma unroll
            for (int n = 0; n < 2; ++n) bv[bj][n] = bias ? *(const f32x4*)(bias + col0 + bj * HALF + 4 * n) : (f32x4){0.f, 0.f, 0.f, 0.f};
#pragma unroll
        for (int ai = 0; ai < 2; ++ai)
#pragma unroll
            for (int m = 0; m < 4; ++m) {
                const int r = u.pm * BM + ai * HALF + wr * 64 + m * 16 + fr;
                const size_t off = (size_t)r * 1024 + col0;
                float ss = 0.f;
#pragma unroll
                for (int bj = 0; bj < 2; ++bj) {
                    f32x4 x0, x1;
                    if (xf) { x0 = *(const f32x4*)(xf + off + bj * HALF); x1 = *(const f32x4*)(xf + off + bj * HALF + 4); }
                    else { const u32x4 w = *(const u32x4*)(hb + off + bj * HALF);
                           x0 = (f32x4){__uint_as_float(w[0] << 16), __uint_as_float(w[0] & 0xffff0000u), __uint_as_float(w[1] << 16), __uint_as_float(w[1] & 0xffff0000u)};
                           x1 = (f32x4){__uint_as_float(w[2] << 16), __uint_as_float(w[2] & 0xffff0000u), __uint_as_float(w[3] << 16), __uint_as_float(w[3] & 0xffff0000u)}; }
                    const f32x4 h0 = x0 + acc[ai][bj][m][0] + bv[bj][0], h1 = x1 + acc[ai][bj][m][1] + bv[bj][1];
                    *(u32x4*)(hb + off + bj * HALF) = pack8(h0, h1);
                    ss += (h0[0] * h0[0] + h0[1] * h0[1]) + (h0[2] * h0[2] + h0[3] * h0[3]) + (h1[0] * h1[0] + h1[1] * h1[1]) + (h1[2] * h1[2] + h1[3] * h1[3]);
                }
                ss = swap16_add(ss, ss); ss = swap32_add(ss, ss);
                if (fq == 0) part[(size_t)r * 16 + 4 * u.pn + wc] = ss;
            }
    }
};
struct EpiQ {
    static constexpr bool PERM = true, AFTER_DRAIN = false;
    bf16_t* O; const float* part;
    __device__ __forceinline__ void operator()(const f32x4 (&acc)[2][2][4][2], const Unit& u, int wr, int wc, int fr, int fq) const {
        const int col0 = u.pn * BM + wc * 32 + 8 * fq;
#pragma unroll
        for (int ai = 0; ai < 2; ++ai)
#pragma unroll
            for (int m = 0; m < 4; ++m) {
                const int r = u.pm * BM + ai * HALF + wr * 64 + m * 16 + fr;
                const float rs = rstd16(part, r, fq);
                bf16_t* rowp = O + (size_t)r * 1024 + col0;
#pragma unroll
                for (int bj = 0; bj < 2; ++bj) *(u32x4*)(rowp + bj * HALF) = pack8(acc[ai][bj][m][0] * rs, acc[ai][bj][m][1] * rs);
            }
    }
};
struct EpiGlu {
    static constexpr bool PERM = true, AFTER_DRAIN = false;
    bf16_t* G; const float* part; const float* b1;
    __device__ __forceinline__ void operator()(const f32x4 (&acc)[2][2][4][2], const Unit& u, int wr, int wc, int fr, int fq) const {
        const int col = u.pn * 128 + wc * 32 + 8 * fq;
        f32x4 ba[2], bg[2];
#pragma unroll
        for (int n = 0; n < 2; ++n) { ba[n] = *(const f32x4*)(b1 + col + 4 * n); bg[n] = *(const f32x4*)(b1 + 1024 + col + 4 * n); }
#pragma unroll
        for (int ai = 0; ai < 2; ++ai)
#pragma unroll
            for (int m = 0; m < 4; ++m) {
                const int r = u.pm * BM + ai * HALF + wr * 64 + m * 16 + fr;
                const float rs = rstd16(part, r, fq);
                f32x4 y[2];
#pragma unroll
                for (int n = 0; n < 2; ++n) {
                    const f32x4 a = acc[ai][0][m][n] * rs + ba[n], g = acc[ai][1][m][n] * rs + bg[n];
#pragma unroll
                    for (int i = 0; i < 4; ++i) y[n][i] = a[i] / (1.f + __expf(-g[i]));
                }
                *(u32x4*)(G + (size_t)r * 1024 + col) = pack8(y[0], y[1]);
            }
    }
};
template <class Epi, class Sched, bool ALIGN_EPI = false, bool SP2 = false, bool I8 = false>
__device__ __forceinline__ void gemm_phase(PG8_LAS unsigned char* lds, const Gemm g, const Sched& S, const Epi& E, const int wave_id) {
    const int lane = lane_id(), wid = wave_id, tid = wid * 64 + lane, wr = wid >> 2, wc = wid & 3, fr = lane & 15, fq = lane >> 4;
    const int K = g.K, nt = K / BK;
    unsigned voffA[2], voffB[2];
#pragma unroll
    for (int i = 0; i < 2; ++i) { int R, C; stage_rc(tid * 16 + i * 8192, R, C); const int Rb = Epi::PERM ? ((R & ~31) + perm32(R & 31)) : R;
        voffA[i] = (unsigned)(R * K + C) * 2u; voffB[i] = (unsigned)(Rb * K + C) * 2u; }
    const size_t kstep = (size_t)(BK * 2);
    const size_t hstep = (size_t)HALF * K * 2;
    const size_t tstep = 2 * hstep;
    const unsigned ldsw = (unsigned)wid * 1024u;
    const int aoff = lds_byte(wr * 64 + fr, fq * 8), boff = lds_byte(wc * 32 + fr, fq * 8);
#define PG8_SA(b, h) (((b) * 2 + (h)) * HTB)
#define PG8_SB(b, h) ((4 + (b) * 2 + (h)) * HTB)
#define PG8_STAGE(bufoff, gbase, voff) do { _Pragma("unroll") for (int _i = 0; _i < 2; ++_i) \
        __builtin_amdgcn_global_load_lds((const unsigned*)((const char*)(gbase) + (voff)[_i]), (PG8_LAS unsigned*)(lds + (bufoff) + ldsw + _i * 8192), 16, 0, 0); } while (0)
#define PG8_LDA(dst, b, h) do { _Pragma("unroll") for (int m = 0; m < 4; ++m) _Pragma("unroll") for (int k = 0; k < 2; ++k) dst[m][k] = *(const PG8_LAS bf16x8*)(lds + PG8_SA(b, h) + aoff + m * 2048 + k * 1024); } while (0)
#define PG8_LDB(dst, b, h) do { _Pragma("unroll") for (int n = 0; n < 2; ++n) _Pragma("unroll") for (int k = 0; k < 2; ++k) dst[n][k] = *(const PG8_LAS bf16x8*)(lds + PG8_SB(b, h) + boff + n * 2048 + k * 1024); } while (0)
#define PG8_MMA(ai, bj, At, Bt) do { __builtin_amdgcn_s_setprio(1); _Pragma("unroll") for (int m = 0; m < 4; ++m) _Pragma("unroll") for (int n = 0; n < 2; ++n) _Pragma("unroll") for (int k = 0; k < 2; ++k) { \
        if constexpr (I8) acc[ai][bj][m][n] = __builtin_bit_cast(f32x4, __builtin_amdgcn_mfma_i32_16x16x64_i8(__builtin_bit_cast(i32x4, Bt[n][k]), __builtin_bit_cast(i32x4, At[m][k]), __builtin_bit_cast(i32x4, acc[ai][bj][m][n]), 0, 0, 0)); \
        else acc[ai][bj][m][n] = __builtin_amdgcn_mfma_f32_16x16x32_bf16(Bt[n][k], At[m][k], acc[ai][bj][m][n], 0, 0, 0); } __builtin_amdgcn_s_setprio(0); } while (0)
#define PG8_WAIT_V(n) asm volatile("s_waitcnt vmcnt(" #n ")" ::: "memory")
#define PG8_WAIT_L(n) asm volatile("s_waitcnt lgkmcnt(" #n ")" ::: "memory")
#define PG8_BAR __builtin_amdgcn_s_barrier()
#define PG8_SCHED __builtin_amdgcn_sched_barrier(0)
    Unit cur, nxt; int ui = 0;
    if (!S.next(0, cur)) return;
    f32x4 acc[2][2][4][2];
#pragma unroll
    for (int a = 0; a < 2; ++a)
#pragma unroll
        for (int b = 0; b < 2; ++b)
#pragma unroll
            for (int m = 0; m < 4; ++m)
#pragma unroll
                for (int n = 0; n < 2; ++n) acc[a][b][m][n] = (f32x4){0.f, 0.f, 0.f, 0.f};
    bf16x8 At[4][2], B0[2][2], B1[2][2];
    const char* cA = (const char*)g.A + (size_t)cur.pm * tstep; const char* cB = (const char*)g.Bt + (size_t)cur.pn * tstep;
    S.a_ready(cur);
    if constexpr (SP2) {
        PG8_STAGE(PG8_SB(0, 0), cB, voffB); PG8_STAGE(PG8_SB(0, 1), cB + hstep, voffB); PG8_STAGE(PG8_SA(0, 0), cA, voffA); PG8_STAGE(PG8_SA(0, 1), cA + hstep, voffA);
        if (wr == 1) PG8_BAR;
        PG8_WAIT_V(2); PG8_BAR;
        PG8_STAGE(PG8_SB(1, 0), cB + kstep, voffB); PG8_STAGE(PG8_SA(1, 0), cA + kstep, voffA); PG8_STAGE(PG8_SB(1, 1), cB + hstep + kstep, voffB);
        PG8_WAIT_V(6); PG8_BAR;
    } else {
        PG8_STAGE(PG8_SB(0, 0), cB, voffB); PG8_STAGE(PG8_SA(0, 0), cA, voffA); PG8_STAGE(PG8_SB(0, 1), cB + hstep, voffB); PG8_STAGE(PG8_SA(0, 1), cA + hstep, voffA);
        if (wr == 1) PG8_BAR;
        PG8_WAIT_V(4); PG8_BAR;
        PG8_STAGE(PG8_SB(1, 0), cB + kstep, voffB); PG8_STAGE(PG8_SA(1, 0), cA + kstep, voffA); PG8_STAGE(PG8_SB(1, 1), cB + hstep + kstep, voffB);
        PG8_WAIT_V(6); PG8_BAR;
    }
    for (;;) {
        const bool has_next = S.next(ui + 1, nxt);
        const char* nA = has_next ? (const char*)g.A + (size_t)nxt.pm * tstep : cA; const char* nB = has_next ? (const char*)g.Bt + (size_t)nxt.pn * tstep : cB;
        for (int t = 0; t < nt; t += 2) {
            const bool last = (t == nt - 2);
            const char* a1 = cA + (size_t)(t + 1) * kstep;
            const char* a2 = last ? nA : cA + (size_t)(t + 2) * kstep; const char* b2 = last ? nB : cB + (size_t)(t + 2) * kstep;
            const char* a3 = a2 + kstep; const char* b3 = b2 + kstep;
            if (last && has_next) S.a_ready(nxt);
            if constexpr (SP2) {
            PG8_LDB(B0, 0, 0); PG8_LDB(B1, 0, 1); PG8_SCHED; PG8_LDA(At, 0, 0); PG8_STAGE(PG8_SA(1, 1), a1 + hstep, voffA);
            PG8_WAIT_V(8); PG8_WAIT_L(0); PG8_BAR; PG8_MMA(0, 0, At, B0); PG8_MMA(0, 1, At, B1); PG8_BAR; PG8_SCHED;
            PG8_LDA(At, 0, 1); PG8_STAGE(PG8_SB(0, 0), b2, voffB); PG8_STAGE(PG8_SB(0, 1), b2 + hstep, voffB); PG8_STAGE(PG8_SA(0, 0), a2, voffA);
            PG8_WAIT_V(8); PG8_WAIT_L(0); PG8_BAR; PG8_MMA(1, 0, At, B0); PG8_MMA(1, 1, At, B1); PG8_BAR; PG8_SCHED;
            PG8_LDB(B0, 1, 0); PG8_LDB(B1, 1, 1); PG8_SCHED; PG8_LDA(At, 1, 0); PG8_STAGE(PG8_SA(0, 1), a2 + hstep, voffA);
            PG8_WAIT_V(8); PG8_WAIT_L(0); PG8_BAR; PG8_MMA(0, 0, At, B0); PG8_MMA(0, 1, At, B1); PG8_BAR; PG8_SCHED;
            PG8_LDA(At, 1, 1); PG8_STAGE(PG8_SB(1, 0), b3, voffB); PG8_STAGE(PG8_SB(1, 1), b3 + hstep, voffB); PG8_STAGE(PG8_SA(1, 0), a3, voffA);
            PG8_WAIT_V(8); PG8_WAIT_L(0); PG8_BAR; PG8_MMA(1, 0, At, B0); PG8_MMA(1, 1, At, B1); PG8_BAR; PG8_SCHED;
            } else {
            PG8_LDB(B0, 0, 0); PG8_SCHED; PG8_LDA(At, 0, 0); PG8_STAGE(PG8_SA(1, 1), a1 + hstep, voffA);
            PG8_WAIT_L(8); PG8_BAR; PG8_WAIT_L(0); PG8_MMA(0, 0, At, B0); PG8_BAR; PG8_SCHED;
            PG8_LDB(B1, 0, 1); PG8_STAGE(PG8_SB(0, 0), b2, voffB);
            PG8_BAR; PG8_WAIT_L(0); PG8_MMA(0, 1, At, B1); PG8_BAR;
            PG8_LDA(At, 0, 1); PG8_STAGE(PG8_SA(0, 0), a2, voffA);
            PG8_BAR; PG8_WAIT_L(0); PG8_MMA(1, 0, At, B0); PG8_BAR; PG8_SCHED;
            PG8_STAGE(PG8_SB(0, 1), b2 + hstep, voffB);
            PG8_WAIT_V(6); PG8_BAR; PG8_MMA(1, 1, At, B1); PG8_BAR;
            PG8_LDB(B0, 1, 0); PG8_SCHED; PG8_LDA(At, 1, 0); PG8_STAGE(PG8_SA(0, 1), a2 + hstep, voffA);
            PG8_WAIT_L(8); PG8_BAR; PG8_WAIT_L(0); PG8_MMA(0, 0, At, B0); PG8_BAR; PG8_SCHED;
            PG8_LDB(B1, 1, 1); PG8_STAGE(PG8_SB(1, 0), b3, voffB);
            PG8_BAR; PG8_WAIT_L(0); PG8_MMA(0, 1, At, B1); PG8_BAR;
            PG8_LDA(At, 1, 1); PG8_STAGE(PG8_SA(1, 0), a3, voffA);
            PG8_BAR; PG8_WAIT_L(0); PG8_MMA(1, 0, At, B0); PG8_BAR; PG8_SCHED;
            PG8_STAGE(PG8_SB(1, 1), b3 + hstep, voffB);
            PG8_WAIT_V(6); PG8_BAR; PG8_MMA(1, 1, At, B1); PG8_BAR;
            }
        }
        if constexpr (ALIGN_EPI) { if (wr == 0) PG8_BAR; }
        if constexpr (!Epi::AFTER_DRAIN) { E(acc, cur, wr, wc, fr, fq); S.done(cur); }
        if (!has_next) break;
#pragma unroll
        for (int a = 0; a < 2; ++a)
#pragma unroll
            for (int b = 0; b < 2; ++b)
#pragma unroll
                for (int m = 0; m < 4; ++m)
#pragma unroll
                    for (int n = 0; n < 2; ++n) acc[a][b][m][n] = (f32x4){0.f, 0.f, 0.f, 0.f};
        cur = nxt; cA = nA; cB = nB; ++ui;
        if constexpr (ALIGN_EPI) { if (wr == 1) PG8_BAR; }
    }
    PG8_WAIT_V(0);
    if constexpr (!ALIGN_EPI) { if (wr == 0) PG8_BAR; }
    PG8_BAR;
    if constexpr (Epi::AFTER_DRAIN) { E.fused(acc, cur, wr, wc, fr, fq, lds, wid, lane); S.done(cur); }
#undef PG8_SA
#undef PG8_SB
#undef PG8_STAGE
#undef PG8_LDA
#undef PG8_LDB
#undef PG8_MMA
#undef PG8_WAIT_V
#undef PG8_WAIT_L
#undef PG8_BAR
#undef PG8_SCHED
}
}

struct Frame {
    LAS unsigned char* lds;
    int wave, G, bid;
    const float *x, *mix_norm, *ffn_norm, *final_norm, *w_in, *w_out, *rel_bias, *conv_w1, *conv_b1, *conv_dw, *conv_dw_b, *conv_ln_g, *conv_ln_b, *conv_w2, *conv_b2,
        *peer_wq, *peer_keys, *peer_u, *peer_v;
    float* out;
    unsigned char* ws;
};
#define FRAME_IDS const int f_lane = lane_id(); const int f_tid = F.wave * 64 + f_lane; (void)f_tid
DI float gamma_of(int h) { return 1.f - exp2f(-5.f - (float)h); }

DI unsigned q8x4(f32x4 v, const float sc) {
    const int a = (int)rintf(v[0] * sc), b = (int)rintf(v[1] * sc), c = (int)rintf(v[2] * sc), d = (int)rintf(v[3] * sc);
    return ((unsigned)a & 0xFFu) | (((unsigned)b & 0xFFu) << 8) | (((unsigned)c & 0xFFu) << 16) | ((unsigned)d << 24);
}
DI void p0_prep(Frame& F) {
    FRAME_IDS;
    const int gw = F.bid * NWAVES + F.wave, NGW = F.G * NWAVES;
    f32x2* rope = (f32x2*)(F.ws + WS_ROPE);
    for (int i = F.bid * NTHR + f_tid; i < SEQ * 32; i += F.G * NTHR) {
        const int s = i >> 5, j = i & 31;
        const float inv = powf(10000.f, -(float)j / 32.f);
        const float ang = (float)s * inv;
        float sn, cs; sincosf(ang, &sn, &cs);
        rope[i] = (f32x2){cs, sn};
    }
    unsigned* xq = (unsigned*)(F.ws + WS_XB); float* rowsc = (float*)(F.ws + WS_ROWSC);
    for (int m = gw; m < T; m += NGW) {
        const f32x4* xr = (const f32x4*)(F.x + (size_t)m * DM) + f_lane;
        f32x4 v[4]; float s = 0.f, am = 0.f;
#pragma unroll
        for (int j = 0; j < 4; ++j) { v[j] = xr[64 * j]; s += v[j].x * v[j].x + v[j].y * v[j].y + v[j].z * v[j].z + v[j].w * v[j].w; am = fmaxf(am, fmaxf(fmaxf(fabsf(v[j].x), fabsf(v[j].y)), fmaxf(fabsf(v[j].z), fabsf(v[j].w)))); }
        const float r = 1.f / sqrtf(wave_sum(s) * (1.f / DM) + EPS);
        am = wave_max(am);
        const float sc = am > 0.f ? 127.f / am : 0.f;
#pragma unroll
        for (int j = 0; j < 4; ++j) xq[(size_t)m * (DM / 4) + f_lane + 64 * j] = q8x4(v[j], sc);
        if (f_lane == 0) rowsc[m] = am * (1.f / 127.f) * r;
    }
}
DI void p0_transpose_item(const float* W, int K, int N, bf16* WT, int prow0, const float* gain, float scale, LAS float* scr, int k0, int n0, int lane) {
#pragma unroll 8
    for (int i = 0; i < 32; ++i) { const int kk = 2 * i + (lane >> 5); scr[kk * 33 + (lane & 31)] = W[(size_t)(k0 + kk) * N + n0 + (lane & 31)] * (gain ? gain[k0 + kk] : 1.f) * scale; }
    asm volatile("s_waitcnt lgkmcnt(0)" ::: "memory");
    const int c = lane & 7;
#pragma unroll
    for (int j = 0; j < 4; ++j) { const int n = (lane >> 3) + 8 * j; const LAS float* q = scr + (8 * c) * 33 + n;
        u32x4 o; o.x = pk2(q[0 * 33], q[1 * 33]); o.y = pk2(q[2 * 33], q[3 * 33]); o.z = pk2(q[4 * 33], q[5 * 33]); o.w = pk2(q[6 * 33], q[7 * 33]);
        *(u32x4*)(WT + (size_t)(prow0 + n) * K + k0 + 8 * c) = o; }
    asm volatile("s_waitcnt lgkmcnt(0)" ::: "memory");
}
DI void p0_amax_item(const float* W, int N, unsigned* colmax, const float* gain, float scale, int k0, int n0, int lane) {
    float am = 0.f;
#pragma unroll 8
    for (int i = 0; i < 32; ++i) { const int kk = 2 * i + (lane >> 5); am = fmaxf(am, fabsf(W[(size_t)(k0 + kk) * N + n0 + (lane & 31)] * (gain ? gain[k0 + kk] : 1.f) * scale)); }
    am = swap32_max(am);
    if (lane < 32) __hip_atomic_fetch_max(colmax + lane, __float_as_uint(am), __ATOMIC_RELAXED, __HIP_MEMORY_SCOPE_AGENT);
}
DI void p0_q8_item(const float* W, int N, unsigned char* WT, const unsigned* colmax, float* colsc, int prow0, const float* gain, float scale, LAS float* scr, int k0, int n0, int lane) {
    const float am = __uint_as_float(colmax[lane & 31]);
    const float sc = am > 0.f ? 127.f / am : 0.f;
    if (k0 == 0 && lane < 32) colsc[lane] = am * (1.f / 127.f);
#pragma unroll 8
    for (int i = 0; i < 32; ++i) { const int kk = 2 * i + (lane >> 5); scr[kk * 33 + (lane & 31)] = rintf(W[(size_t)(k0 + kk) * N + n0 + (lane & 31)] * (gain ? gain[k0 + kk] : 1.f) * scale * sc); }
    asm volatile("s_waitcnt lgkmcnt(0)" ::: "memory");
    const int ch = lane & 3;
#pragma unroll
    for (int j = 0; j < 2; ++j) { const int n = (lane >> 2) + 16 * j; const LAS float* q = scr + (16 * ch) * 33 + n;
        u32x4 o;
#pragma unroll
        for (int w = 0; w < 4; ++w) o[w] = ((unsigned)(int)q[(4 * w) * 33] & 0xFFu) | (((unsigned)(int)q[(4 * w + 1) * 33] & 0xFFu) << 8) | (((unsigned)(int)q[(4 * w + 2) * 33] & 0xFFu) << 16) | ((unsigned)(int)q[(4 * w + 3) * 33] << 24);
        *(u32x4*)(WT + (size_t)(prow0 + n) * DM + k0 + 16 * ch) = o; }
    asm volatile("s_waitcnt lgkmcnt(0)" ::: "memory");
}
constexpr int CW_COLMAX = 16384;
constexpr int CS_WIN = 0, CS_WOUT = 3584, CS_W1 = 4608, CS_W2 = 6656, CS_WQ = 7680;
constexpr bool I8_WIN = true, I8_WOUT = false, I8_W1 = false, I8_W2 = false, I8_WQ = false;
DI void p0_weights(Frame& F, const int pass) {
    FRAME_IDS;
    LAS float* scr = (LAS float*)(F.lds + F.wave * 16384);
    unsigned* colmax = (unsigned*)(F.ws + WS_CTL) + CW_COLMAX; float* colsc = (float*)(F.ws + WS_COLSC);
    const int gw = F.bid * NWAVES + F.wave, NGW = F.G * NWAVES;
    constexpr int I_IN = 16 * (INC / 32), I_SQ = 16 * (DM / 32), I_W1 = 16 * (2 * DM / 32);
    constexpr int NITEMS = I_IN + I_SQ + I_W1 + I_SQ + 2 * I_SQ;
#define WITEM(I8FLAG, Wp, Nn, WTb, CSo, prow0, gainp, scl, k0, n0) do { \
        if (pass == 0) { if (I8FLAG) p0_amax_item(Wp, Nn, colmax + (CSo) + (prow0), gainp, scl, k0, n0, f_lane); } \
        else if (I8FLAG) p0_q8_item(Wp, Nn, (unsigned char*)(WTb), colmax + (CSo) + (prow0), colsc + (CSo) + (prow0), prow0, gainp, scl, scr, k0, n0, f_lane); \
        else p0_transpose_item(Wp, DM, Nn, (bf16*)(WTb), prow0, gainp, scl, scr, k0, n0, f_lane); } while (0)
    for (int it = gw; it < NITEMS; it += NGW) {
        int r = it;
        if (r < I_IN) { const int nb = r % (INC / 32), kb = r / (INC / 32), n0 = nb * 32;
            const int type = n0 / 512, head = (n0 % 512) / 64, bj = (n0 % 64) / 32;
            const int prow0 = 256 * (2 * type + head / 4) + 128 * bj + 32 * (head % 4);
            WITEM(I8_WIN, F.w_in, INC, F.ws + WS_WIN, CS_WIN, prow0, F.mix_norm, (type == 0 ? 0.125f * LOG2E : (type == 4 ? 0.125f : 1.f)), kb * 64, n0); continue; }
        r -= I_IN;
        if (r < I_SQ) { const int nb = r % 32, kb = r / 32; WITEM(I8_WOUT, F.w_out, DM, F.ws + WS_WOUT, CS_WOUT, nb * 32, (const float*)nullptr, 1.f, kb * 64, nb * 32); continue; }
        r -= I_SQ;
        if (r < I_W1) { const int nb = r % 64, kb = r / 64, n0 = nb * 32; const int bj = n0 / 1024, rem = n0 % 1024;
            WITEM(I8_W1, F.conv_w1, 2 * DM, F.ws + WS_W1, CS_W1, 256 * (rem / 128) + 128 * bj + (rem % 128), F.mix_norm + DM, 1.f, kb * 64, n0); continue; }
        r -= I_W1;
        if (r < I_SQ) { const int nb = r % 32, kb = r / 32; WITEM(I8_W2, F.conv_w2, DM, F.ws + WS_W2, CS_W2, nb * 32, (const float*)nullptr, 1.f, kb * 64, nb * 32); continue; }
        r -= I_SQ;
        { const int layer = r / I_SQ; r %= I_SQ; const int nb = r % 32, kb = r / 32;
          WITEM(I8_WQ, F.peer_wq + (size_t)layer * DM * DM, DM, F.ws + WS_WQ + (size_t)layer * DM * DM * 2, CS_WQ + layer * DM, nb * 32, F.ffn_norm + layer * DM, 1.f, kb * 64, nb * 32); }
    }
#undef WITEM
}
DI float row_rstd(const float* part, int m) {
    const f32x4* p = (const f32x4*)(part + (size_t)m * 16);
    const f32x4 a = p[0], b = p[1], c = p[2], d = p[3];
    const float s = ((a.x + a.y) + (a.z + a.w)) + ((b.x + b.y) + (b.z + b.w)) + ((c.x + c.y) + (c.z + c.w)) + ((d.x + d.y) + (d.z + d.w));
    return 1.f / sqrtf(s * (1.f / DM) + EPS);
}

typedef short v4i16 __attribute__((ext_vector_type(4)));
typedef __bf16 bf16x2_t __attribute__((ext_vector_type(2)));
DI unsigned cvtpk(float lo, float hi) { f32x2 v = {lo, hi}; bf16x2_t b = __builtin_convertvector(v, bf16x2_t); return __builtin_bit_cast(unsigned, b); }
DI v4i16 ds_tr16(LAS const unsigned char* p) { return __builtin_amdgcn_ds_read_tr16_b64_v4i16((LAS v4i16*)p); }
DI int crow(int r, int h) { return (r & 3) + 8 * (r >> 2) + 4 * h; }
DI bf16x8 pack_step(const f32x16& x, const int s) {
    u32x4 w = {cvtpk(x[8 * s + 0], x[8 * s + 1]), cvtpk(x[8 * s + 2], x[8 * s + 3]), cvtpk(x[8 * s + 4], x[8 * s + 5]), cvtpk(x[8 * s + 6], x[8 * s + 7])};
    return __builtin_bit_cast(bf16x8, w);
}
constexpr int AT_KB = 64 * 144, AT_VB = 8192, AT_BUF = AT_KB + AT_VB, AT_BIAS = 2 * AT_BUF;
DI void attn_item(Frame& F, const int it) {
    FRAME_IDS;
    const bf16* R = (const bf16*)(F.ws + WS_R); bf16* O = (bf16*)(F.ws + WS_O);
    LAS unsigned char* lds = F.lds;
    LAS float* bias_s = (LAS float*)(lds + AT_BIAS);
    const int q32 = f_lane & 31, h = f_lane >> 5, w = F.wave;
    const int srow = f_tid >> 3, sch = f_tid & 7;
    const int vtr_off = ((f_lane & 15) >> 2) * 64 + (16 * ((f_lane >> 4) & 1) + 4 * (f_lane & 3)) * 2;
    {
        const int b = it / (NHA * 8), hd = (it / 8) % NHA, c0 = (it % 8) * 4;
        const int c = c0 + (w >> 1), qrow0 = 32 * (w & 1);
        const size_t tq = (size_t)b * SEQ + c * 64 + qrow0 + q32;
        __syncthreads();
        for (int k = f_tid; k < 257; k += NTHR) bias_s[k] = F.rel_bias[hd * 257 + k] * LOG2E;
        bf16x8 qf[4];
#pragma unroll
        for (int ks = 0; ks < 4; ++ks) qf[ks] = *(const bf16x8*)(R + tq * INC + C_QA + hd * 64 + 16 * ks + 8 * h);
        asm volatile("" ::: "memory");
        const int t_lo = c0 - 8 < 0 ? 0 : c0 - 8, t_hi = c0 + 3, ntile = t_hi - t_lo + 1;
        const bf16* kbase = R + ((size_t)b * SEQ + srow) * INC + C_KA + hd * 64 + 8 * sch;
        const bf16* vbase = R + ((size_t)b * SEQ + srow) * INC + C_VA + hd * 64 + 8 * sch;
        u32x4 kA = *(const u32x4*)(kbase + (size_t)t_lo * 64 * INC), vA = *(const u32x4*)(vbase + (size_t)t_lo * 64 * INC);
        u32x4 kB = *(const u32x4*)(kbase + (size_t)(t_lo + 1) * 64 * INC), vB = *(const u32x4*)(vbase + (size_t)(t_lo + 1) * 64 * INC);
        *(LAS u32x4*)(lds + srow * 144 + sch * 16) = kA;
        *(LAS u32x4*)(lds + AT_KB + (sch >> 2) * 4096 + srow * 64 + (sch & 3) * 16) = vA;
        __syncthreads();
        const float bias_far = bias_s[256];
        float m = -1e30f, l = 0.f;
        f32x16 o0 = {}, o1 = {};
        auto tile_step = [&](const int i, u32x4& kL, u32x4& vL, const u32x4& kW, const u32x4& vW) __attribute__((always_inline)) {
            const int tc = t_lo + i;
            LAS unsigned char* kb = lds + (i & 1) * AT_BUF; LAS unsigned char* vb = kb + AT_KB;
            { const int tl = tc + 2 < t_hi ? tc + 2 : t_hi;
              kL = *(const u32x4*)(kbase + (size_t)tl * 64 * INC); vL = *(const u32x4*)(vbase + (size_t)tl * 64 * INC); }
            const int D = c - tc;
            if (D >= 0 && D <= 8) {
                const float init = D >= 3 ? bias_far : 0.f;
                f32x16 p0, p1;
#pragma unroll
                for (int r = 0; r < 16; ++r) { p0[r] = init; p1[r] = init; }
#pragma unroll
                for (int ks = 0; ks < 4; ++ks) {
                    const bf16x8 k0 = *(const LAS bf16x8*)(kb + q32 * 144 + (16 * ks + 8 * h) * 2);
                    const bf16x8 k1 = *(const LAS bf16x8*)(kb + (32 + q32) * 144 + (16 * ks + 8 * h) * 2);
                    p0 = __builtin_amdgcn_mfma_f32_32x32x16_bf16(k0, qf[ks], p0, 0, 0, 0);
                    p1 = __builtin_amdgcn_mfma_f32_32x32x16_bf16(k1, qf[ks], p1, 0, 0, 0);
                }
                if (D < 3) {
                    const int relb = D * 64 + qrow0 + q32 - 4 * h + 128;
#pragma unroll
                    for (int r = 0; r < 16; ++r) {
                        const int r0 = relb - ((r & 3) + 8 * (r >> 2));
                        const int i0 = r0 < 0 ? 0 : (r0 > 256 ? 256 : r0), r1 = r0 - 32, i1 = r1 < 0 ? 0 : (r1 > 256 ? 256 : r1);
                        p0[r] += bias_s[i0]; p1[r] += bias_s[i1];
                    }
                }
                float tm = fmaxf(p0[0], p1[0]);
#pragma unroll
                for (int r = 1; r < 16; ++r) tm = fmaxf(tm, fmaxf(p0[r], p1[r]));
                tm = swap32_max(tm);
                const float mn = fmaxf(m, tm), alpha = __builtin_amdgcn_exp2f(m - mn);
                m = mn;
                float ps = 0.f;
#pragma unroll
                for (int r = 0; r < 16; ++r) { p0[r] = __builtin_amdgcn_exp2f(p0[r] - mn); p1[r] = __builtin_amdgcn_exp2f(p1[r] - mn); ps += p0[r] + p1[r]; }
                l = l * alpha + ps;
                if (!__all(alpha == 1.f)) {
#pragma unroll
                    for (int r = 0; r < 16; ++r) { o0[r] *= alpha; o1[r] *= alpha; }
                }
                bf16x8 pf[4];
                pf[0] = pack_step(p0, 0); pf[1] = pack_step(p0, 1); pf[2] = pack_step(p1, 0); pf[3] = pack_step(p1, 1);
#pragma unroll
                for (int kk = 0; kk < 4; ++kk) {
                    const int key0 = 16 * kk + 4 * h;
                    const v4i16 a0l = ds_tr16(vb + key0 * 64 + vtr_off), a0h = ds_tr16(vb + (key0 + 8) * 64 + vtr_off);
                    const v4i16 a1l = ds_tr16(vb + 4096 + key0 * 64 + vtr_off), a1h = ds_tr16(vb + 4096 + (key0 + 8) * 64 + vtr_off);
                    const bf16x8 a0 = __builtin_shufflevector(a0l, a0h, 0, 1, 2, 3, 4, 5, 6, 7), a1 = __builtin_shufflevector(a1l, a1h, 0, 1, 2, 3, 4, 5, 6, 7);
                    o0 = __builtin_amdgcn_mfma_f32_32x32x16_bf16(a0, pf[kk], o0, 0, 0, 0);
                    o1 = __builtin_amdgcn_mfma_f32_32x32x16_bf16(a1, pf[kk], o1, 0, 0, 0);
                }
            }
            if (i + 1 < ntile) {
                LAS unsigned char* nb = lds + ((i + 1) & 1) * AT_BUF;
                *(LAS u32x4*)(nb + srow * 144 + sch * 16) = kW;
                *(LAS u32x4*)(nb + AT_KB + (sch >> 2) * 4096 + srow * 64 + (sch & 3) * 16) = vW;
            }
            __syncthreads();
        };
        for (int i = 0; i < ntile; i += 2) { tile_step(i, kA, vA, kB, vB); tile_step(i + 1, kB, vB, kA, vA); }
        l = swap32_add(l, l);
        const float inv = 1.f / l;
        bf16* op = O + tq * DM + hd * 64 + 4 * h;
#pragma unroll
        for (int g = 0; g < 4; ++g) {
            *(u32x2*)(op + 8 * g) = (u32x2){cvtpk(o0[4 * g] * inv, o0[4 * g + 1] * inv), cvtpk(o0[4 * g + 2] * inv, o0[4 * g + 3] * inv)};
            *(u32x2*)(op + 32 + 8 * g) = (u32x2){cvtpk(o1[4 * g] * inv, o1[4 * g + 1] * inv), cvtpk(o1[4 * g + 2] * inv, o1[4 * g + 3] * inv)};
        }
    }
    __syncthreads();
}

constexpr int RT_Q = 0, RT_K = 9216, RT_KD = 18432, RT_V = 26624, RT_BUF = 34816, RT_ZS = 2 * RT_BUF, RT_CS = RT_ZS + 64 * 66 * 4;
DI void ret_item(Frame& F, const int it) {
    FRAME_IDS;
    const bf16* R = (const bf16*)(F.ws + WS_R); bf16* O = (bf16*)(F.ws + WS_O);
    LAS unsigned char* lds = F.lds;
    LAS float* Zs = (LAS float*)(lds + RT_ZS); LAS float* Cs = (LAS float*)(lds + RT_CS);
    const int b = it / NHB, hd = it % NHB;
    const int q32 = f_lane & 31, h = f_lane >> 5, w = F.wave;
    const int role = w >> 2, itile = (w >> 1) & 1, etile = w & 1;
    const int srow = f_tid >> 3, sch = f_tid & 7;
    const int vtr_off = ((f_lane & 15) >> 2) * 64 + (16 * ((f_lane >> 4) & 1) + 4 * (f_lane & 3)) * 2;
    const float l2g = log2f(gamma_of(hd));
    const float cd = exp2f(l2g * 64.f), sdec = exp2f(l2g * (float)(63 - srow));
    float qdv[16];
#pragma unroll
    for (int r = 0; r < 16; ++r) qdv[r] = exp2f(l2g * (float)(32 * itile + crow(r, h) + 1));
    f32x16 xs0 = {}, xs1 = {};
    const size_t trow0 = (size_t)b * SEQ;
    const bf16* gq = R + (trow0 + srow) * INC + hd * 64 + 8 * sch;
    u32x4 qreg = *(const u32x4*)(gq + C_QB), kreg = *(const u32x4*)(gq + C_KB), vreg = *(const u32x4*)(gq + C_VB);
    __syncthreads();
#define RT_STAGE(bufp) do { LAS unsigned char* bp_ = (bufp); \
        *(LAS u32x4*)(bp_ + RT_Q + srow * 144 + sch * 16) = qreg; *(LAS u32x4*)(bp_ + RT_K + srow * 144 + sch * 16) = kreg; \
        *(LAS u32x4*)(bp_ + RT_V + (sch >> 2) * 4096 + srow * 64 + (sch & 3) * 16) = vreg; \
        u32x4 kd_; \
        _Pragma("unroll") for (int e_ = 0; e_ < 4; ++e_) kd_[e_] = cvtpk(__uint_as_float(kreg[e_] << 16) * sdec, __uint_as_float(kreg[e_] & 0xffff0000u) * sdec); \
        *(LAS u32x4*)(bp_ + RT_KD + (sch >> 2) * 4096 + srow * 64 + (sch & 3) * 16) = kd_; } while (0)
    RT_STAGE(lds);
    __syncthreads();
    for (int n = 0; n < NCH; ++n) {
        LAS unsigned char* bp = lds + (n & 1) * RT_BUF;
        if (n + 1 < NCH) { const bf16* g1 = gq + (size_t)(n + 1) * 64 * INC; qreg = *(const u32x4*)(g1 + C_QB); kreg = *(const u32x4*)(g1 + C_KB); vreg = *(const u32x4*)(g1 + C_VB); }
        unsigned short gr[8];
#pragma unroll
        for (int r = 0; r < 8; ++r) gr[r] = R[(trow0 + n * 64 + 8 * w + r) * INC + C_GB + hd * 64 + f_lane];
        if (role == 0) {
            bf16x8 qf[4];
#pragma unroll
            for (int ks = 0; ks < 4; ++ks) qf[ks] = *(const LAS bf16x8*)(bp + RT_Q + (32 * itile + q32) * 144 + (16 * ks + 8 * h) * 2);
            f32x16 st0 = {}, st1 = {};
#pragma unroll
            for (int ks = 0; ks < 4; ++ks) {
                const bf16x8 k0 = *(const LAS bf16x8*)(bp + RT_K + q32 * 144 + (16 * ks + 8 * h) * 2);
                const bf16x8 k1 = *(const LAS bf16x8*)(bp + RT_K + (32 + q32) * 144 + (16 * ks + 8 * h) * 2);
                st0 = __builtin_amdgcn_mfma_f32_32x32x16_bf16(k0, qf[ks], st0, 0, 0, 0);
                st1 = __builtin_amdgcn_mfma_f32_32x32x16_bf16(k1, qf[ks], st1, 0, 0, 0);
            }
            int iiv = 32 * itile + q32 - 4 * h; asm volatile("" : "+v"(iiv));
#pragma unroll
            for (int r = 0; r < 16; ++r) {
                const int dd = iiv - ((r & 3) + 8 * (r >> 2));
                st0[r] *= __builtin_amdgcn_exp2f(l2g * fabsf((float)dd));
                st1[r] *= __builtin_amdgcn_exp2f(l2g * fabsf((float)(dd - 32)));
            }
            f32x16 z = {};
#pragma unroll
            for (int kk = 0; kk < 4; ++kk) {
                const int key0 = 16 * kk + 4 * h;
                const v4i16 bl = ds_tr16(bp + RT_V + etile * 4096 + key0 * 64 + vtr_off), bh = ds_tr16(bp + RT_V + etile * 4096 + (key0 + 8) * 64 + vtr_off);
                const bf16x8 vb = __builtin_shufflevector(bl, bh, 0, 1, 2, 3, 4, 5, 6, 7);
                const bf16x8 xa = (kk < 2) ? pack_step(st0, kk & 1) : pack_step(st1, kk & 1);
                z = __builtin_amdgcn_mfma_f32_32x32x16_bf16(xa, vb, z, 0, 0, 0);
            }
            int zb = (32 * itile + 4 * h) * 66 + 32 * etile + q32; asm volatile("" : "+v"(zb));
#pragma unroll
            for (int r = 0; r < 16; ++r) Zs[zb + ((r & 3) + 8 * (r >> 2)) * 66] = z[r];
        } else {
            f32x16 cr = {};
#pragma unroll
            for (int kk = 0; kk < 4; ++kk) {
                const LAS unsigned char* qp = bp + RT_Q + (32 * itile + q32) * 144 + (16 * kk + 4 * h) * 2;
                const v4i16 al = *(const LAS v4i16*)qp, ah = *(const LAS v4i16*)(qp + 16);
                const bf16x8 qa = __builtin_shufflevector(al, ah, 0, 1, 2, 3, 4, 5, 6, 7);
                const bf16x8 xb = (kk < 2) ? pack_step(xs0, kk & 1) : pack_step(xs1, kk & 1);
                cr = __builtin_amdgcn_mfma_f32_32x32x16_bf16(qa, xb, cr, 0, 0, 0);
            }
            int cb = (32 * itile + 4 * h) * 66 + 32 * etile + q32; asm volatile("" : "+v"(cb));
#pragma unroll
            for (int r = 0; r < 16; ++r) Cs[cb + ((r & 3) + 8 * (r >> 2)) * 66] = cr[r] * qdv[r];
#pragma unroll
            for (int r = 0; r < 16; ++r) { xs0[r] *= cd; xs1[r] *= cd; }
#pragma unroll
            for (int s4 = 0; s4 < 4; ++s4) {
                const int key0 = 16 * s4 + 8 * h;
                const v4i16 vl = ds_tr16(bp + RT_V + etile * 4096 + key0 * 64 + vtr_off), vh = ds_tr16(bp + RT_V + etile * 4096 + (key0 + 4) * 64 + vtr_off);
                const bf16x8 vb = __builtin_shufflevector(vl, vh, 0, 1, 2, 3, 4, 5, 6, 7);
                const v4i16 a0l = ds_tr16(bp + RT_KD + key0 * 64 + vtr_off), a0h = ds_tr16(bp + RT_KD + (key0 + 4) * 64 + vtr_off);
                const v4i16 a1l = ds_tr16(bp + RT_KD + 4096 + key0 * 64 + vtr_off), a1h = ds_tr16(bp + RT_KD + 4096 + (key0 + 4) * 64 + vtr_off);
                const bf16x8 ka0 = __builtin_shufflevector(a0l, a0h, 0, 1, 2, 3, 4, 5, 6, 7), ka1 = __builtin_shufflevector(a1l, a1h, 0, 1, 2, 3, 4, 5, 6, 7);
                xs0 = __builtin_amdgcn_mfma_f32_32x32x16_bf16(ka0, vb, xs0, 0, 0, 0);
                xs1 = __builtin_amdgcn_mfma_f32_32x32x16_bf16(ka1, vb, xs1, 0, 0, 0);
            }
        }
        __syncthreads();
#pragma unroll
        for (int r = 0; r < 8; ++r) {
            const int i = 8 * w + r;
            const float v = Zs[i * 66 + f_lane] + Cs[i * 66 + f_lane];
            const float mu = wave_sum(v) * (1.f / 64.f);
            const float dv = v - mu;
            const float var = wave_sum(dv * dv) * (1.f / 64.f);
            const float g = bf2f(gr[r]);
            O[(trow0 + n * 64 + i) * DM + 512 + hd * 64 + f_lane] = (bf16)f2bf(dv * (1.f / sqrtf(var + EPS)) * (g / (1.f + __expf(-g))));
        }
        if (n + 1 < NCH) RT_STAGE(lds + ((n + 1) & 1) * RT_BUF);
        __syncthreads();
    }
#undef RT_STAGE
}
DI float max3_abs(const float a, const float x, const float y) { float r; asm("v_max3_f32 %0, %1, |%2|, |%3|" : "=v"(r) : "v"(a), "v"(x), "v"(y)); return r; }
DI void int8_rows(Frame& F, const int row0, const int nrows, const int f_lane) {
    const int tab = row0 / PE, e0 = row0 % PE, layer = tab & 1, isv = tab >> 1;
    f32x4 gn[4];
    { const f32x4* gp = (const f32x4*)(F.ffn_norm + layer * DM) + f_lane;
#pragma unroll
      for (int j = 0; j < 4; ++j) gn[j] = isv ? (f32x4){1.f, 1.f, 1.f, 1.f} : gp[64 * j]; }
    const f32x4* src = (const f32x4*)((isv ? F.peer_v : F.peer_u) + ((size_t)layer * PE + e0) * DM) + f_lane;
    unsigned* dst = (unsigned*)(F.ws + (isv ? WS_V8 : WS_U8)) + (size_t)layer * 4 * PE * 32 + (size_t)e0 * 32 + (f_lane >> 1);
    float* scp = (float*)(F.ws + WS_SC) + tab * PE + e0;
    const unsigned xmask = (isv && !(f_lane & 1)) ? 0u : 0x08080808u;
    const int sh = (f_lane & 1) * 4;
    const float scmul = isv ? (1.f / 16.f) : 1.f;
    f32x4 A[4][4], B[4][4];
#define Q4_LOAD(D, r) do { _Pragma("unroll") for (int u_ = 0; u_ < 4; ++u_) _Pragma("unroll") for (int j_ = 0; j_ < 4; ++j_) D[u_][j_] = src[(size_t)((r) + u_) * 256 + 64 * j_]; } while (0)
#define Q4_PROC(D, r) do { _Pragma("unroll") for (int u_ = 0; u_ < 4; ++u_) { \
        float a_ = 0.f; f32x4 sq_ = {0.f, 0.f, 0.f, 0.f}; \
        _Pragma("unroll") for (int j_ = 0; j_ < 4; ++j_) { D[u_][j_] = D[u_][j_] * gn[j_]; a_ = max3_abs(max3_abs(a_, D[u_][j_][0], D[u_][j_][1]), D[u_][j_][2], D[u_][j_][3]); sq_ += D[u_][j_] * D[u_][j_]; } \
        a_ = wave_max(a_); \
        const float step_ = fminf(0.355f * sqrtf(wave_sum((sq_[0] + sq_[1]) + (sq_[2] + sq_[3])) * (1.f / DM)), a_ * (1.f / 7.f)); \
        const float sc_ = step_ > 0.f ? 1.f / step_ : 0.f; \
        _Pragma("unroll") for (int j_ = 0; j_ < 4; ++j_) {                  \
            const f32x4 t_ = D[u_][j_] * sc_ + 8388616.f;                   \
            const unsigned b0_ = __float_as_uint(__builtin_amdgcn_fmed3f(t_[0], 8388609.f, 8388623.f)), b1_ = __float_as_uint(__builtin_amdgcn_fmed3f(t_[1], 8388609.f, 8388623.f)); \
            const unsigned b2_ = __float_as_uint(__builtin_amdgcn_fmed3f(t_[2], 8388609.f, 8388623.f)), b3_ = __float_as_uint(__builtin_amdgcn_fmed3f(t_[3], 8388609.f, 8388623.f)); \
            unsigned w_ = __builtin_amdgcn_perm(__builtin_amdgcn_perm(b3_, b2_, 0x0c0c0400u), __builtin_amdgcn_perm(b1_, b0_, 0x0c0c0400u), 0x05040100u); \
            w_ = (w_ ^ xmask) << sh; \
            w_ |= (unsigned)DPP_MOV_I((int)w_, DPP_XOR1); \
            if (!(f_lane & 1)) dst[((size_t)j_ * PE + (r) + u_) * 32] = w_; \
        } \
        if (f_lane == 0) scp[(r) + u_] = step_ * scmul; } } while (0)
    Q4_LOAD(A, 0);
    for (int r = 0; r < nrows; r += 8) {
        Q4_LOAD(B, r + 4);
        Q4_PROC(A, r);
        { const int rn = r + 8 < nrows ? r + 8 : r + 4;
          Q4_LOAD(A, rn); }
        Q4_PROC(B, r + 4);
    }
#undef Q4_LOAD
#undef Q4_PROC
}
constexpr int Q8_ITEM_ROWS = 512, Q8_ITEMS = 4 * PE / Q8_ITEM_ROWS;
constexpr int PH_MIX_ID = 3;
DI int attn_order(const int q) { return q < 768 ? (q / 6) * 8 + (q % 6) + 2 : ((q - 768) & 127) * 8 + ((q - 768) < 128 ? 1 : 0); }
constexpr int QG = 2;
DI void mix_phase(Frame& F, const int rep) {
    FRAME_IDS;
    unsigned* ctr = (unsigned*)(F.ws + WS_CTL) + CW_QUEUE + 64 * rep;
    volatile LAS unsigned* slot = (volatile LAS unsigned*)(F.lds + MISC_OFF) + 16;
    constexpr int N_RET = NB * NHB, N_ATT = NB * NHA * 8;
    static_assert(N_ATT == 8 * Q8_ITEMS, "8 attention items per quantisation item");
    for (;;) {
        __syncthreads();
        if (f_tid == 0) slot[0] = __hip_atomic_fetch_add(ctr, 1u, __ATOMIC_RELAXED, __HIP_MEMORY_SCOPE_AGENT);
        __syncthreads();
        const int idx = (int)slot[0];
        if (idx >= N_RET + N_ATT + Q8_ITEMS) break;
        const bool probe_pass = (REP_PHASE == PH_MIX_ID && rep == 0);
        if (idx < N_RET) { if (!(probe_pass && PROBE_MODE >= 4)) ret_item(F, idx); }
        else if (probe_pass && PROBE_MODE == 3) { }
        else { const int k = idx - N_RET;
            if (k < QG * Q8_ITEMS) { const int grp = k / QG, pos = k % QG;
                if (pos == QG - 1) { if (!(probe_pass && PROBE_MODE == 5)) int8_rows(F, grp * Q8_ITEM_ROWS + F.wave * 64, 64, f_lane); }
                else if (!(probe_pass && PROBE_MODE == 6)) attn_item(F, attn_order((QG - 1) * grp + pos)); }
            else if (!(probe_pass && PROBE_MODE == 6)) attn_item(F, attn_order(k - Q8_ITEMS)); }
    }
}
DI float fmax_raw(float a, float b) { float r; asm("v_max_f32_e32 %0, %1, %2" : "=v"(r) : "v"(a), "v"(b)); return r; }
DI float fmin_raw(float a, float b) { float r; asm("v_min_f32_e32 %0, %1, %2" : "=v"(r) : "v"(a), "v"(b)); return r; }
#define CE_DESC(x, y) do { const float hi_ = fmax_raw((x), (y)), lo_ = fmin_raw((x), (y)); (x) = hi_; (y) = lo_; } while (0)
template <int N> DI void sort_desc(float* v) {
#pragma unroll
    for (int k = 2; k <= N; k <<= 1)
#pragma unroll
        for (int j = k >> 1; j > 0; j >>= 1)
#pragma unroll
            for (int i = 0; i < N; ++i) { const int l = i ^ j; if (l > i) { if ((i & k) == 0 || k == N) CE_DESC(v[i], v[l]); else CE_DESC(v[l], v[i]); } }
}
DI void merge16(float* a, const float* b) {
#pragma unroll
    for (int i = 0; i < 16; ++i) a[i] = fmax_raw(a[i], b[15 - i]);
#pragma unroll
    for (int j = 8; j > 0; j >>= 1)
#pragma unroll
        for (int i = 0; i < 16; ++i) { const int l = i ^ j; if (l > i) CE_DESC(a[i], a[l]); }
}
DI float key_pack(float v, unsigned keep_mask, unsigned idx) { return __uint_as_float((__float_as_uint(v) & keep_mask) | idx); }
DI void opt_route(Frame& F, int layer) {
    FRAME_IDS;
    const bf16* Q = (const bf16*)(F.ws + WS_Q);
    int* eidx = (int*)(F.ws + WS_EIDX); float* gate = (float*)(F.ws + WS_GATE);
    const float* keys = F.peer_keys + (size_t)layer * 2 * PK * 64;
    LAS unsigned char* kl = F.lds;
    __syncthreads();
    for (int idx = f_tid; idx < 2 * PK * 8; idx += NTHR) {
        const int row = idx >> 3, ch = idx & 7;
        const f32x4 a = *(const f32x4*)(keys + (size_t)row * 64 + ch * 8), b = *(const f32x4*)(keys + (size_t)row * 64 + ch * 8 + 4);
        *(LAS u32x4*)(kl + row * 144 + ch * 16) = (u32x4){pk2(a[0], a[1]), pk2(a[2], a[3]), pk2(b[0], b[1]), pk2(b[2], b[3])};
    }
    __syncthreads();
    LAS int* lut = (LAS int*)(F.lds + 40960 + F.wave * 8192);
    const int c = f_lane & 31, h = f_lane >> 5;
    pg8::StaticOrder SO; SO.init(T, DM, F.G, F.bid);
    pg8::Unit un;
    for (int ui = 0; SO.next(ui, un); ++ui)
    for (int k2 = F.wave; k2 < 16; k2 += NWAVES) {
        const int tile = 8 * un.pm + (k2 & 7), hh = 2 * un.pn + (k2 >> 3), t = tile * 32 + c;
        float tk[2][16];
#pragma unroll
        for (int side = 0; side < 2; ++side) {
            bf16x8 qf[4];
#pragma unroll
            for (int ks = 0; ks < 4; ++ks) qf[ks] = *(const bf16x8*)(Q + (size_t)t * DM + hh * PQD + side * 64 + 16 * ks + 8 * h);
            float v[64];
#pragma unroll
            for (int kt = 0; kt < 4; ++kt) {
                f32x16 acc = {};
#pragma unroll
                for (int ks = 0; ks < 4; ++ks) {
                    const bf16x8 a = *(const LAS bf16x8*)(kl + (side * PK + 32 * kt + c) * 144 + (16 * ks + 8 * h) * 2);
                    acc = __builtin_amdgcn_mfma_f32_32x32x16_bf16(a, qf[ks], acc, 0, 0, 0);
                }
#pragma unroll
                for (int r = 0; r < 16; ++r) v[16 * kt + r] = key_pack(acc[r], 0xFFFFFF80u, (unsigned)(32 * kt + (r & 3) + 8 * (r >> 2) + 4 * h));
            }
            sort_desc<16>(v); sort_desc<16>(v + 16); sort_desc<16>(v + 32); sort_desc<16>(v + 48);
            merge16(v, v + 16); merge16(v + 32, v + 48); merge16(v, v + 32);
            float pr[16];
#pragma unroll
            for (int i = 0; i < 16; ++i) pr[i] = __shfl_xor(v[i], 32);
            merge16(v, pr);
#pragma unroll
            for (int i = 0; i < 16; ++i) { tk[side][i] = v[i]; lut[(side * 16 + i) * 64 + f_lane] = (int)(__float_as_uint(v[i]) & 0x7Fu); }
        }
        float cd[64];
        {   int n = 0;
#pragma unroll
            for (int a = 0; a < 16; ++a)
#pragma unroll
                for (int b = 0; b < 16; ++b) if ((a + 1) * (b + 1) <= 16) { cd[n] = key_pack(tk[0][a] + tk[1][b], 0xFFFFFF00u, (unsigned)(a * 16 + b)); ++n; }
#pragma unroll
            for (int i = 50; i < 64; ++i) cd[i] = -INFINITY;
        }
        sort_desc<16>(cd); sort_desc<16>(cd + 16); sort_desc<16>(cd + 32); CE_DESC(cd[48], cd[49]);
        merge16(cd, cd + 16); merge16(cd + 32, cd + 48); merge16(cd, cd + 32);
        int ex[16]; float gv[16]; float sum = 0.f;
        const float top = __uint_as_float(__float_as_uint(cd[0]) & 0xFFFFFF00u);
#pragma unroll
        for (int i = 0; i < 16; ++i) {
            const unsigned bits = __float_as_uint(cd[i]);
            const int a = (bits >> 4) & 15, b = bits & 15;
            ex[i] = lut[a * 64 + f_lane] * PK + lut[(16 + b) * 64 + f_lane];
            gv[i] = __expf(__uint_as_float(bits & 0xFFFFFF00u) - top); sum += gv[i];
        }
        const float inv = 1.f / sum;
        if (h == 0) {
            u32x4* ep = (u32x4*)(eidx + (size_t)t * NSEL + hh * 16);
#pragma unroll
            for (int q = 0; q < 4; ++q) ep[q] = (u32x4){(unsigned)ex[4 * q], (unsigned)ex[4 * q + 1], (unsigned)ex[4 * q + 2], (unsigned)ex[4 * q + 3]};
        } else {
            f32x4* gp = (f32x4*)(gate + (size_t)t * NSEL + hh * 16);
#pragma unroll
            for (int q = 0; q < 4; ++q) gp[q] = (f32x4){gv[4 * q] * inv, gv[4 * q + 1] * inv, gv[4 * q + 2] * inv, gv[4 * q + 3] * inv};
        }
    }
    __syncthreads();
}
struct XInfo { int xrank, nx, rank, nloc; };
DI XInfo get_xinfo(Frame& F, const bool census) {
    FRAME_IDS;
    volatile LAS unsigned* M = (volatile LAS unsigned*)(F.lds + MISC_OFF);
    __syncthreads();
    if (f_tid == 0) {
        unsigned xr = (unsigned)F.bid & 7u, nx = 8u, rk = (unsigned)F.bid >> 3, nl = ((unsigned)F.G + 7u - ((unsigned)F.bid & 7u)) >> 3;
        if (census) {
            unsigned* bar = (unsigned*)(F.ws + WS_CTL) + CW_BAR; const unsigned x = xb_xcc_id();
            unsigned cnt = 0u, below = 0u, mine = 0u;
#pragma unroll
            for (unsigned j = 0; j < 16; ++j) { const unsigned c = xb_ld(&bar[XB_XCNT(j)]); cnt += (c > 0u); below += (c > 0u && j < x); mine = (j == x) ? c : mine; }
            if (cnt > 0u && mine > 0u) { xr = below; nx = cnt; rk = M[12]; nl = mine; }
        }
        M[20] = xr; M[21] = nx; M[22] = rk; M[23] = nl;
    }
    __syncthreads();
    XInfo xi; xi.xrank = (int)M[20]; xi.nx = (int)M[21]; xi.rank = (int)M[22]; xi.nloc = (int)M[23];
    return xi;
}
DI int comb_c(const int level, const int a, const int b, const int lane) {
    const int M = 4 >> level; const bool bit = (lane & M) != 0;
    const int send = bit ? a : b, keep = bit ? b : a;
    const int recv = level == 0 ? DPP_MOV_I(send, DPP_HMIRROR) : (level == 1 ? DPP_MOV_I(send, DPP_XOR2) : DPP_MOV_I(send, DPP_XOR1));
    return keep + recv;
}
DI int dot16_i8(const u32x4 r, const u32x4 x) {
    int s = __builtin_amdgcn_sdot4((int)r[0], (int)x[0], 0, false);
    s = __builtin_amdgcn_sdot4((int)r[1], (int)x[1], s, false); s = __builtin_amdgcn_sdot4((int)r[2], (int)x[2], s, false); s = __builtin_amdgcn_sdot4((int)r[3], (int)x[3], s, false);
    return s;
}
DI int half_dots(const u32x4 (&rows)[8], const u32x4 xq, const int lane) {
    int p[8];
#pragma unroll
    for (int i = 0; i < 8; ++i) p[i] = dot16_i8(rows[i], xq);
#pragma unroll
    for (int i = 0; i < 4; ++i) p[i] = comb_c(0, p[2 * i], p[2 * i + 1], lane);
    p[0] = comb_c(1, p[0], p[1], lane); p[1] = comb_c(1, p[2], p[3], lane);
    return comb_c(2, p[0], p[1], lane);
}
DI u32x4 xquant(const f32x4 (&hv)[4], const float rstd) {
    u32x4 o;
#pragma unroll
    for (int w = 0; w < 4; ++w) {
        const f32x4 x = hv[w] * (rstd * XQ);
        const int a = (int)rintf(__builtin_amdgcn_fmed3f(x[0], -127.f, 127.f)), b = (int)rintf(__builtin_amdgcn_fmed3f(x[1], -127.f, 127.f)), c = (int)rintf(__builtin_amdgcn_fmed3f(x[2], -127.f, 127.f)), d = (int)rintf(__builtin_amdgcn_fmed3f(x[3], -127.f, 127.f));
        o[w] = ((unsigned)a & 0xFFu) | (((unsigned)b & 0xFFu) << 8) | (((unsigned)c & 0xFFu) << 16) | ((unsigned)d << 24);
    }
    return o;
}
DI float rstd_bcast(const float* part, const int t) {
    const f32x4* p = (const f32x4*)(part + (size_t)t * 16);
    const f32x4 a = p[0], b = p[1], c = p[2], d = p[3];
    const float s = ((a[0] + a[1]) + (a[2] + a[3])) + ((b[0] + b[1]) + (b[2] + b[3])) + ((c[0] + c[1]) + (c[2] + c[3])) + ((d[0] + d[1]) + (d[2] + d[3]));
    return 1.f / sqrtf(s * (1.f / DM) + EPS);
}
DI int dot32_i4(const u32x4 r, const u32x4 xh, const u32x4 xl) {
    int ah = 0, al = 0;
#pragma unroll
    for (int d = 0; d < 4; ++d) { ah = __builtin_amdgcn_sdot8((int)r[d], (int)xh[d], ah, false); al = __builtin_amdgcn_sdot8((int)r[d], (int)xl[d], al, false); }
    return (ah << 4) + al;
}
DI int half_dots4(const u32x4 (&rows)[8], const u32x4 xa, const u32x4 xb, const int lane) {
    int p[8];
#pragma unroll
    for (int i = 0; i < 8; ++i) p[i] = dot32_i4(rows[i], xa, xb);
#pragma unroll
    for (int i = 0; i < 4; ++i) p[i] = comb_c(0, p[2 * i], p[2 * i + 1], lane);
    p[0] = comb_c(1, p[0], p[1], lane); p[1] = comb_c(1, p[2], p[3], lane);
    return comb_c(2, p[0], p[1], lane);
}
DI void gather_u(Frame& F, const int layer, const XInfo xi, const bool dry) {
    FRAME_IDS;
    const unsigned emask = (dry && PROBE_MODE == 2) ? 15u : ((dry && PROBE_MODE == 5) ? 4095u : 0xFFFFFFFFu);
    const int* eidx = (const int*)(F.ws + WS_EIDX); int* PU = (int*)(F.ws + (dry ? WS_R : WS_PU)); const float* part = (const float*)(F.ws + WS_PART); const bf16* hbp = (const bf16*)(F.ws + WS_XB);
    const int g = f_lane >> 3, c = f_lane & 7, c16 = c * 16;
    const int kst = 16 * g + (((c & 1) << 2) | (c & 2) | ((c & 4) >> 2));
    const int gwl = xi.rank * NWAVES + F.wave, NGWL = xi.nloc * NWAVES;
    LAS unsigned char* wl = F.lds + F.wave * 2048;
    __syncthreads();
    for (int j = xi.xrank; j < 8; j += xi.nx) {
        const int sl = j & 3, th = j >> 2;
        const __amdgpu_buffer_rsrc_t U8 = __builtin_amdgcn_make_buffer_rsrc((void*)(F.ws + WS_U8 + ((size_t)(layer * 4 + sl) * PE) * 128), 0, PE * 128, 0x00020000);
        int tt = gwl;
        if (tt >= T / 2) continue;
#define TOK(x_) (2 * (x_) + th)
#define U_LOAD(tk, ri, rh, rp) do { ri = *(const u32x2*)(eidx + (size_t)(tk) * NSEL + 2 * f_lane) & emask; rh = *(const u32x2*)(hbp + (size_t)(tk) * DM + 256 * sl + 4 * f_lane); \
            rp = part[(size_t)(tk) * 16 + (f_lane & 15)]; } while (0)
#define U_SPREAD(slot, ri, rh, rp, e, xa_, xb_) do { \
            float ps_ = rp; ps_ += __int_as_float(DPP_MOV_I(__float_as_int(ps_), DPP_XOR1)); ps_ += __int_as_float(DPP_MOV_I(__float_as_int(ps_), DPP_XOR2)); ps_ += __int_as_float(DPP_MOV_I(__float_as_int(ps_), DPP_HMIRROR)); ps_ += __int_as_float(DPP_MOV_I(__float_as_int(ps_), DPP_ROR8)); \
            const float rs_ = (1.f / sqrtf(ps_ * (1.f / DM) + EPS)) * XQ; \
            const int q0_ = (int)rintf(__builtin_amdgcn_fmed3f(__uint_as_float(rh[0] << 16) * rs_, -119.f, 119.f)), q1_ = (int)rintf(__builtin_amdgcn_fmed3f(__uint_as_float(rh[0] & 0xffff0000u) * rs_, -119.f, 119.f)); \
            const int q2_ = (int)rintf(__builtin_amdgcn_fmed3f(__uint_as_float(rh[1] << 16) * rs_, -119.f, 119.f)), q3_ = (int)rintf(__builtin_amdgcn_fmed3f(__uint_as_float(rh[1] & 0xffff0000u) * rs_, -119.f, 119.f)); \
            const int h0_ = (q0_ + 8) >> 4, h1_ = (q1_ + 8) >> 4, h2_ = (q2_ + 8) >> 4, h3_ = (q3_ + 8) >> 4;     \
            unsigned wh_ = ((unsigned)h0_ & 0xFu) | (((unsigned)h1_ & 0xFu) << 8) | (((unsigned)h2_ & 0xFu) << 16) | (((unsigned)h3_ & 0xFu) << 24); \
            unsigned wl_ = ((unsigned)(q0_ - 16 * h0_) & 0xFu) | (((unsigned)(q1_ - 16 * h1_) & 0xFu) << 8) | (((unsigned)(q2_ - 16 * h2_) & 0xFu) << 16) | (((unsigned)(q3_ - 16 * h3_) & 0xFu) << 24); \
            if (f_lane & 1) { wh_ <<= 4; wl_ <<= 4; } \
            wh_ |= (unsigned)DPP_MOV_I((int)wh_, DPP_XOR1); wl_ |= (unsigned)DPP_MOV_I((int)wl_, DPP_XOR1); \
            LAS unsigned char* sl_ = wl + (slot) * 1024; \
            *(LAS u32x2*)(sl_ + 8 * f_lane) = ri; if (!(f_lane & 1)) { *(LAS unsigned*)(sl_ + 512 + 2 * f_lane) = wh_; *(LAS unsigned*)(sl_ + 768 + 2 * f_lane) = wl_; } \
            asm volatile("s_waitcnt lgkmcnt(0)" ::: "memory"); \
            _Pragma("unroll") for (int q_ = 0; q_ < 4; ++q_) e[q_] = *(const LAS u32x4*)(sl_ + 64 * g + 16 * q_); \
            xa_ = *(const LAS u32x4*)(sl_ + 512 + 16 * c); xb_ = *(const LAS u32x4*)(sl_ + 768 + 16 * c); } while (0)
        u32x2 ri, rh; float rp;
        u32x4 e0[4], e1[4], xa, xb, xa1, xb1;
        U_LOAD(TOK(tt), ri, rh, rp); U_SPREAD(0, ri, rh, rp, e0, xa, xb);
        { const int t1 = (tt + NGWL < T / 2) ? tt + NGWL : tt; U_LOAD(TOK(t1), ri, rh, rp); U_SPREAD(1, ri, rh, rp, e1, xa1, xb1); }
        { const int t2 = (tt + 2 * NGWL < T / 2) ? tt + 2 * NGWL : tt; U_LOAD(TOK(t2), ri, rh, rp); }
        u32x4 A0[8], B0[8], A1[8], B1[8];
#pragma unroll
        for (int i = 0; i < 8; ++i) A0[i] = __builtin_amdgcn_raw_buffer_load_b128(U8, (int)e0[i >> 2][i & 3] * 128 + c16, 0, 0);
#pragma unroll
        for (int i = 0; i < 8; ++i) B0[i] = __builtin_amdgcn_raw_buffer_load_b128(U8, (int)e0[2 + (i >> 2)][i & 3] * 128 + c16, 0, 0);
#define U_ITEM(CA, CB, NA, NB, slot) do { \
            __builtin_amdgcn_sched_barrier(0); \
            _Pragma("unroll") for (int i = 0; i < 8; ++i) NA[i] = __builtin_amdgcn_raw_buffer_load_b128(U8, (int)e1[i >> 2][i & 3] * 128 + c16, 0, 0); \
            __builtin_amdgcn_sched_barrier(0); \
            const int r0 = half_dots4(CA, xa, xb, f_lane); \
            __builtin_amdgcn_sched_barrier(0); \
            _Pragma("unroll") for (int i = 0; i < 8; ++i) NB[i] = __builtin_amdgcn_raw_buffer_load_b128(U8, (int)e1[2 + (i >> 2)][i & 3] * 128 + c16, 0, 0); \
            __builtin_amdgcn_sched_barrier(0); \
            const int rr1 = half_dots4(CB, xa, xb, f_lane); \
            int* pp = PU + ((size_t)TOK(tt) * 4 + sl) * NSEL + kst; \
            pp[0] = r0; pp[8] = rr1; \
            xa = xa1; xb = xb1; \
            U_SPREAD(slot, ri, rh, rp, e1, xa1, xb1);                   \
            { const int t3 = (tt + 3 * NGWL < T / 2) ? tt + 3 * NGWL : tt; U_LOAD(TOK(t3), ri, rh, rp); } } while (0)
        while (tt + NGWL < T / 2) {
            U_ITEM(A0, B0, A1, B1, 0); tt += NGWL;
            U_ITEM(A1, B1, A0, B0, 1); tt += NGWL;
        }
        if (tt < T / 2) { U_ITEM(A0, B0, A1, B1, 0); }
#undef U_ITEM
#undef U_LOAD
#undef U_SPREAD
#undef TOK
    }
    __syncthreads();
}
DI void gather_r(Frame& F, const int layer) {
    FRAME_IDS;
    const int* PU = (const int*)(F.ws + WS_PU); const float* gate = (const float*)(F.ws + WS_GATE); const int* eidx = (const int*)(F.ws + WS_EIDX);
    const float* SCu = (const float*)(F.ws + WS_SC) + (size_t)layer * PE; const float* SCv = (const float*)(F.ws + WS_SC) + (size_t)(2 + layer) * PE;
    signed char* A8 = (signed char*)(F.ws + WS_A); float* SA = (float*)(F.ws + WS_SA);
    const int gw = F.bid * NWAVES + F.wave, NGW = F.G * NWAVES;
    for (int t = gw; t < T; t += NGW) {
        float a[2];
#pragma unroll
        for (int hf = 0; hf < 2; ++hf) {
            const int k = 64 * hf + f_lane;
            int sacc = 0;
#pragma unroll
            for (int j = 0; j < 4; ++j) sacc += PU[((size_t)t * 4 + j) * NSEL + k];
            const int e = eidx[(size_t)t * NSEL + k];
            const float d = (float)sacc * (SCu[e] * (1.f / XQ));
            a[hf] = gelu_erf(d) * gate[(size_t)t * NSEL + k] * SCv[e];
        }
        const float am = wave_max(fmaxf(fabsf(a[0]), fabsf(a[1])));
        const float sc = am > 0.f ? 127.f / am : 0.f;
        A8[(size_t)t * NSEL + f_lane] = (signed char)(int)rintf(a[0] * sc);
        A8[(size_t)t * NSEL + 64 + f_lane] = (signed char)(int)rintf(a[1] * sc);
        if (f_lane == 0) SA[t] = am * (1.f / 127.f);
    }
}
DI void tr4x4(const unsigned w0, const unsigned w1, const unsigned w2, const unsigned w3, unsigned (&cdw)[4]) {
    const unsigned t01l = __builtin_amdgcn_perm(w1, w0, 0x05010400u), t01h = __builtin_amdgcn_perm(w1, w0, 0x07030602u);
    const unsigned t23l = __builtin_amdgcn_perm(w3, w2, 0x05010400u), t23h = __builtin_amdgcn_perm(w3, w2, 0x07030602u);
    cdw[0] = __builtin_amdgcn_perm(t23l, t01l, 0x05040100u); cdw[1] = __builtin_amdgcn_perm(t23l, t01l, 0x07060302u);
    cdw[2] = __builtin_amdgcn_perm(t23h, t01h, 0x05040100u); cdw[3] = __builtin_amdgcn_perm(t23h, t01h, 0x07060302u);
}
DI void axpy4rows(const u32x4 r0, const u32x4 r1, const u32x4 r2, const u32x4 r3, const unsigned a4, int (&ahi)[16], int (&aall)[16]) {
#pragma unroll
    for (int d = 0; d < 4; ++d) {
        unsigned cdw[4];
        tr4x4(r0[d], r1[d], r2[d], r3[d], cdw);
#pragma unroll
        for (int b = 0; b < 4; ++b) {
            aall[4 * d + b] = __builtin_amdgcn_sdot4((int)cdw[b], (int)a4, aall[4 * d + b], false);
            ahi[4 * d + b] = __builtin_amdgcn_sdot4((int)(cdw[b] & 0xF0F0F0F0u), (int)a4, ahi[4 * d + b], false);
        }
    }
}
DI void gather_v(Frame& F, const int layer, const XInfo xi, const bool dry) {
    FRAME_IDS;
    const int* eidx = (const int*)(F.ws + WS_EIDX); const unsigned char* A8 = F.ws + WS_A; const float* SA = (const float*)(F.ws + WS_SA);
    float* part_w = dry ? (float*)(F.ws + WS_R) : (float*)(F.ws + WS_PART); bf16* hb_w = dry ? (bf16*)(F.ws + WS_HID2) : (bf16*)(F.ws + WS_XB); const bf16* hbp = (const bf16*)(F.ws + WS_XB);
    const int g = f_lane >> 3, c = f_lane & 7, c16 = c * 16;
    const int cc = 32 * c + 16 * (g >> 2) + 8 * ((g >> 1) & 1) + 4 * (g & 1);
    const int gwl = xi.rank * NWAVES + F.wave, NGWL = xi.nloc * NWAVES;
    const bool b3 = (f_lane & 8) != 0;
    LAS unsigned char* wl = F.lds + F.wave * 2048;
    __syncthreads();
    for (int j = xi.xrank; j < 8; j += xi.nx) {
        const int sl = j & 3, th = j >> 2;
        const __amdgpu_buffer_rsrc_t V8 = __builtin_amdgcn_make_buffer_rsrc((void*)(F.ws + WS_V8 + ((size_t)(layer * 4 + sl) * PE) * 128), 0, PE * 128, 0x00020000);
        int tt = gwl;
        if (tt >= T / 2) continue;
#define TOK(x_) (2 * (x_) + th)
#define V_LOAD(tk, ri, ra, rs) do { ri = *(const u32x2*)(eidx + (size_t)(tk) * NSEL + 2 * f_lane); ra = *(const unsigned short*)(A8 + (size_t)(tk) * NSEL + 2 * f_lane); rs = SA[(tk)]; } while (0)
#define V_SPREAD(slot, ri, ra, rs, e, avv, sav) do { \
            LAS unsigned char* sl_ = wl + (slot) * 1024; \
            *(LAS u32x2*)(sl_ + 8 * f_lane) = ri; *(LAS unsigned short*)(sl_ + 512 + 2 * f_lane) = ra; \
            asm volatile("s_waitcnt lgkmcnt(0)" ::: "memory"); \
            _Pragma("unroll") for (int q_ = 0; q_ < 4; ++q_) e[q_] = *(const LAS u32x4*)(sl_ + 64 * g + 16 * q_); \
            avv = *(const LAS u32x4*)(sl_ + 512 + 16 * g); sav = rs; } while (0)
        u32x2 ri; unsigned short ra; float rs;
        u32x4 e0[4], e1[4], av, a1; float sa, sa1; u32x2 hold;
        V_LOAD(TOK(tt), ri, ra, rs); V_SPREAD(0, ri, ra, rs, e0, av, sa);
        { const int t1 = (tt + NGWL < T / 2) ? tt + NGWL : tt; V_LOAD(TOK(t1), ri, ra, rs); V_SPREAD(1, ri, ra, rs, e1, a1, sa1); }
        { const int t2 = (tt + 2 * NGWL < T / 2) ? tt + 2 * NGWL : tt; V_LOAD(TOK(t2), ri, ra, rs); }
        hold = *(const u32x2*)(hbp + (size_t)TOK(tt) * DM + 256 * sl + cc);
        u32x4 A0[8], B0[8], A1[8], B1[8];
#pragma unroll
        for (int i = 0; i < 8; ++i) A0[i] = __builtin_amdgcn_raw_buffer_load_b128(V8, (int)e0[i >> 2][i & 3] * 128 + c16, 0, 0);
#pragma unroll
        for (int i = 0; i < 8; ++i) B0[i] = __builtin_amdgcn_raw_buffer_load_b128(V8, (int)e0[2 + (i >> 2)][i & 3] * 128 + c16, 0, 0);
#define V_ITEM(CA, CB, NA, NB, slot) do { \
            const int t1 = (tt + NGWL < T / 2) ? tt + NGWL : tt; \
            const u32x2 hold1 = *(const u32x2*)(hbp + (size_t)TOK(t1) * DM + 256 * sl + cc); \
            __builtin_amdgcn_sched_barrier(0);                          \
            _Pragma("unroll") for (int i = 0; i < 8; ++i) NA[i] = __builtin_amdgcn_raw_buffer_load_b128(V8, (int)e1[i >> 2][i & 3] * 128 + c16, 0, 0); \
            __builtin_amdgcn_sched_barrier(0); \
            int ahi[16], aall[16]; \
            _Pragma("unroll") for (int n = 0; n < 16; ++n) { ahi[n] = 0; aall[n] = 0; } \
            axpy4rows(CA[0], CA[1], CA[2], CA[3], av[0], ahi, aall); axpy4rows(CA[4], CA[5], CA[6], CA[7], av[1], ahi, aall); \
            __builtin_amdgcn_sched_barrier(0); \
            _Pragma("unroll") for (int i = 0; i < 8; ++i) NB[i] = __builtin_amdgcn_raw_buffer_load_b128(V8, (int)e1[2 + (i >> 2)][i & 3] * 128 + c16, 0, 0); \
            __builtin_amdgcn_sched_barrier(0); \
            axpy4rows(CB[0], CB[1], CB[2], CB[3], av[2], ahi, aall); axpy4rows(CB[4], CB[5], CB[6], CB[7], av[3], ahi, aall); \
            int sa8 = __builtin_amdgcn_sdot4(0x01010101, (int)av[0], 0, false); sa8 = __builtin_amdgcn_sdot4(0x01010101, (int)av[1], sa8, false); sa8 = __builtin_amdgcn_sdot4(0x01010101, (int)av[2], sa8, false); sa8 = __builtin_amdgcn_sdot4(0x01010101, (int)av[3], sa8, false); \
            sa8 *= 8; \
            int acc[32];                                                \
            _Pragma("unroll") for (int d_ = 0; d_ < 4; ++d_) _Pragma("unroll") for (int b_ = 0; b_ < 4; ++b_) { acc[8 * d_ + 4 + b_] = ahi[4 * d_ + b_]; acc[8 * d_ + b_] = (aall[4 * d_ + b_] - ahi[4 * d_ + b_] - sa8) << 4; } \
            int r16[16], r8[8]; float hv[4]; \
            _Pragma("unroll") for (int n = 0; n < 16; ++n) r16[n] = swap32_addi(acc[n], acc[16 + n]); \
            _Pragma("unroll") for (int n = 0; n < 8; ++n) r8[n] = swap16_addi(r16[n], r16[8 + n]); \
            _Pragma("unroll") for (int n = 0; n < 4; ++n) { const int keep = b3 ? r8[4 + n] : r8[n], send = b3 ? r8[n] : r8[4 + n]; hv[n] = (float)(keep + DPP_MOV_I(send, DPP_ROR8)) * sa; } \
            hv[0] += __uint_as_float(hold[0] << 16); hv[1] += __uint_as_float(hold[0] & 0xffff0000u); hv[2] += __uint_as_float(hold[1] << 16); hv[3] += __uint_as_float(hold[1] & 0xffff0000u); \
            const float ss = wave_sum_fast((hv[0] * hv[0] + hv[1] * hv[1]) + (hv[2] * hv[2] + hv[3] * hv[3])); \
            *(u32x2*)(hb_w + (size_t)TOK(tt) * DM + 256 * sl + cc) = (u32x2){cvtpk(hv[0], hv[1]), cvtpk(hv[2], hv[3])}; \
            if (f_lane == 0) part_w[(size_t)TOK(tt) * 16 + sl] = ss; \
            if (sl == 0 && f_lane >= 4 && f_lane < 16) part_w[(size_t)TOK(tt) * 16 + f_lane] = 0.f; \
            av = a1; sa = sa1; hold = hold1; \
            V_SPREAD(slot, ri, ra, rs, e1, a1, sa1); \
            { const int t3 = (tt + 3 * NGWL < T / 2) ? tt + 3 * NGWL : tt; V_LOAD(TOK(t3), ri, ra, rs); } } while (0)
        while (tt + NGWL < T / 2) {
            V_ITEM(A0, B0, A1, B1, 0); tt += NGWL;
            V_ITEM(A1, B1, A0, B0, 1); tt += NGWL;
        }
        if (tt < T / 2) { V_ITEM(A0, B0, A1, B1, 0); }
#undef V_ITEM
#undef V_LOAD
#undef V_SPREAD
#undef TOK
    }
    __syncthreads();
}
DI void final_norm(Frame& F) {
    FRAME_IDS;
    const float* part = (const float*)(F.ws + WS_PART); const bf16* hbp = (const bf16*)(F.ws + WS_XB);
    const int gw = F.bid * NWAVES + F.wave, NGW = F.G * NWAVES;
    for (int t = gw; t < T; t += NGW) {
        const float r = rstd_bcast(part, t);
        const u32x2* hp = (const u32x2*)(hbp + (size_t)t * DM) + f_lane;
        f32x4* op = (f32x4*)(F.out + (size_t)t * DM) + f_lane;
        const f32x4* gp = (const f32x4*)F.final_norm + f_lane;
#pragma unroll
        for (int q = 0; q < 4; ++q) { const u32x2 w = hp[64 * q];
            const f32x4 h = {__uint_as_float(w[0] << 16), __uint_as_float(w[0] & 0xffff0000u), __uint_as_float(w[1] << 16), __uint_as_float(w[1] & 0xffff0000u)};
            op[64 * q] = h * r * gp[64 * q]; }
    }
}
DI void opt_conv(Frame& F) {
    FRAME_IDS;
    const bf16* G = (const bf16*)(F.ws + WS_GLU); bf16* H2 = (bf16*)(F.ws + WS_HID2);
    LAS float* ys = (LAS float*)F.lds;
    f32x2 wt[CW];
#pragma unroll
    for (int j = 0; j < CW; ++j) wt[j] = *(const f32x2*)(F.conv_dw + j * DM + 2 * f_tid);
    const f32x2 bdw = *(const f32x2*)(F.conv_dw_b + 2 * f_tid);
    f32x4 lng[4], lnb[4];
#pragma unroll
    for (int k = 0; k < 4; ++k) { lng[k] = *(const f32x4*)(F.conv_ln_g + 256 * k + 4 * f_lane); lnb[k] = *(const f32x4*)(F.conv_ln_b + 256 * k + 4 * f_lane); }
    for (int it = F.bid; it < T / 128; it += F.G) {
        const int s0 = (it % (SEQ / 128)) * 128;
        const size_t row0 = (size_t)it * 128;
        const unsigned* gp = (const unsigned*)G + f_tid;
        f32x2 win[CW];
#pragma unroll
        for (int u = 0; u < CW - 1; ++u) { const int sp = s0 - (CW - 1) + u; const unsigned xv = sp >= 0 ? gp[(row0 - (CW - 1) + u) * 512] : 0u; win[u + 1] = (f32x2){__uint_as_float(xv << 16), __uint_as_float(xv & 0xffff0000u)}; }
        win[0] = (f32x2){0.f, 0.f};
        unsigned nx[CW], nn[CW];
#pragma unroll
        for (int u = 0; u < CW; ++u) nx[u] = (s0 + u < SEQ) ? gp[(row0 + u) * 512] : 0u;
        for (int bt = 0; bt < 5; ++bt) {
#pragma unroll
            for (int u = 0; u < CW; ++u) { const int sl = 31 * (bt + 1) + u; nn[u] = (bt < 4 && s0 + sl < SEQ) ? gp[(row0 + sl) * 512] : 0u; }
            __syncthreads();
#pragma unroll
            for (int u = 0; u < CW; ++u) {
                win[u] = (f32x2){__uint_as_float(nx[u] << 16), __uint_as_float(nx[u] & 0xffff0000u)};
                f32x2 a = bdw;
#pragma unroll
                for (int j = 0; j < CW; ++j) a = wt[j] * win[(u + 1 + j) % CW] + a;
                *(LAS f32x2*)(ys + u * DM + 2 * f_tid) = a;
            }
            __syncthreads();
            for (int u = F.wave; u < CW; u += NWAVES) {
                const int sl = 31 * bt + u;
                if (sl < 128) {
                    f32x4 v[4]; float sm = 0.f;
#pragma unroll
                    for (int k = 0; k < 4; ++k) { v[k] = *(const LAS f32x4*)(ys + u * DM + 256 * k + 4 * f_lane); sm += (v[k][0] + v[k][1]) + (v[k][2] + v[k][3]); }
                    const float mu = wave_sum(sm) * (1.f / DM);
                    float sq = 0.f;
#pragma unroll
                    for (int k = 0; k < 4; ++k) { v[k] = v[k] - mu; sq += (v[k][0] * v[k][0] + v[k][1] * v[k][1]) + (v[k][2] * v[k][2] + v[k][3] * v[k][3]); }
                    const float rs = 1.f / sqrtf(wave_sum(sq) * (1.f / DM) + EPS);
#pragma unroll
                    for (int k = 0; k < 4; ++k) {
                        f32x4 z = v[k] * rs * lng[k] + lnb[k];
#pragma unroll
                        for (int e = 0; e < 4; ++e) z[e] = z[e] / (1.f + __expf(-z[e]));
                        *(u32x2*)(H2 + (row0 + sl) * DM + 256 * k + 4 * f_lane) = (u32x2){cvtpk(z[0], z[1]), cvtpk(z[2], z[3])};
                    }
                }
            }
#pragma unroll
            for (int u = 0; u < CW; ++u) nx[u] = nn[u];
        }
    }
    __syncthreads();
}
enum Phase { PH_PREP = 0, PH_PREPW, PH_PROJ, PH_MIX, PH_WOUT, PH_Q0, PH_GU0, PH_GR0, PH_GV0, PH_W1, PH_CONV, PH_W2, PH_Q1, PH_GU1, PH_GR1, PH_GV1, PH_FINAL, PH_COUNT };
struct Args { const float* in[19]; float* out; unsigned char* ws; int ph_lo, ph_hi; };
#ifndef TEST_PHASE
#define TEST_PHASE -1
#endif

__global__ void __launch_bounds__(NTHR, 2) mega_fwd(Args args) {
    extern __shared__ __attribute__((aligned(16))) unsigned char lds[];
    Frame F;
    F.lds = (LAS unsigned char*)lds;
    F.wave = __builtin_amdgcn_readfirstlane((int)threadIdx.x >> 6); FRAME_IDS;
    F.G = gridDim.x; F.bid = blockIdx.x;
    F.x = args.in[0]; F.mix_norm = args.in[1]; F.ffn_norm = args.in[2]; F.final_norm = args.in[3]; F.w_in = args.in[4]; F.w_out = args.in[5]; F.rel_bias = args.in[6];
    F.conv_w1 = args.in[7]; F.conv_b1 = args.in[8]; F.conv_dw = args.in[9]; F.conv_dw_b = args.in[10]; F.conv_ln_g = args.in[11]; F.conv_ln_b = args.in[12];
    F.conv_w2 = args.in[13]; F.conv_b2 = args.in[14]; F.peer_wq = args.in[15]; F.peer_keys = args.in[16]; F.peer_u = args.in[17]; F.peer_v = args.in[18];
    F.out = args.out; F.ws = args.ws;
    volatile LAS unsigned* MISC = (volatile LAS unsigned*)(F.lds + MISC_OFF);
    for (int u = f_tid; u < (LDS_BYTES - LDSCTL_OFF) / 4; u += NTHR) ((LAS unsigned*)(F.lds + LDSCTL_OFF))[u] = 0u;
    __syncthreads();
    const int lo = args.ph_lo, hi = args.ph_hi;
    XcdBarrier bar; bar.bar = (unsigned*)(F.ws + WS_CTL) + CW_BAR; bar.x = 0; bar.st = nullptr;
    if (hi - lo > 1) bar = xcd_barrier_post((unsigned*)(F.ws + WS_CTL) + CW_BAR, MISC + 8);
#define IN(k) ((TEST_PHASE < 0 || TEST_PHASE == (k)) && lo <= (k) && (k) < hi)
#define SEAM(k) do { if (IN(k) && IN((k) + 1)) xcd_barrier(bar, F.wave); } while (0)
#define REPS(k) for (int rep_ = ((k) == REP_PHASE ? 0 : 1); rep_ < 2; ++rep_)
#define GEMM_PHASE(EPI, Aptr, Bptr, NN, ...) do { pg8::Gemm g{(const bf16*)(Aptr), (const bf16*)(Bptr), T, (NN), DM}; pg8::StaticOrder S; S.init(T, (NN), F.G, F.bid); \
        pg8::EPI E{__VA_ARGS__}; pg8::gemm_phase<pg8::EPI, pg8::StaticOrder, true, true>(F.lds, g, S, E, F.wave); } while (0)
    bf16* XB = (bf16*)(F.ws + WS_XB);
    float* PART = (float*)(F.ws + WS_PART); const float* ROPE = (const float*)(F.ws + WS_ROPE);
    if (IN(PH_PREP)) REPS(PH_PREP) { p0_prep(F); p0_weights(F, 0); } SEAM(PH_PREP);
    if (IN(PH_PREPW)) REPS(PH_PREPW) { p0_weights(F, 1); } SEAM(PH_PREPW);
    if (PROBE_MODE == 9 && IN(PH_PREP) && IN(PH_PREP + 1)) { for (int xb_ = 0; xb_ < 8; ++xb_) xcd_barrier(bar, F.wave); }
    if (IN(PH_PROJ)) REPS(PH_PROJ) { { pg8::Gemm g{(const bf16*)XB, (const bf16*)(F.ws + WS_WIN), T, INC, DM / 2}; pg8::StaticOrder S; S.init(T, INC, F.G, F.bid); pg8::EpiProj8 E{(bf16*)(F.ws + WS_R), ROPE, (const float*)(F.ws + WS_ROWSC), (const float*)(F.ws + WS_COLSC)}; pg8::gemm_phase<pg8::EpiProj8, pg8::StaticOrder, true, true, true>(F.lds, g, S, E, F.wave); } } SEAM(PH_PROJ);
    if (IN(PH_MIX)) REPS(PH_MIX) { mix_phase(F, rep_); } SEAM(PH_MIX);
    if (IN(PH_WOUT)) REPS(PH_WOUT) { GEMM_PHASE(EpiRes, F.ws + WS_O, F.ws + WS_WOUT, DM, F.x, XB, PART, nullptr); } SEAM(PH_WOUT);
    if (IN(PH_Q0)) REPS(PH_Q0) { GEMM_PHASE(EpiQ, XB, F.ws + WS_WQ, DM, (bf16*)(F.ws + WS_Q), PART); asm volatile("s_waitcnt vmcnt(0)" ::: "memory"); __syncthreads(); opt_route(F, 0); } SEAM(PH_Q0);
    const bool census = (hi - lo > 1);
    if (IN(PH_GU0)) REPS(PH_GU0) { gather_u(F, 0, get_xinfo(F, census), rep_ == 0); } SEAM(PH_GU0);
    if (IN(PH_GR0)) REPS(PH_GR0) { gather_r(F, 0); } SEAM(PH_GR0);
    if (IN(PH_GV0)) REPS(PH_GV0) { gather_v(F, 0, get_xinfo(F, census), rep_ == 0); } SEAM(PH_GV0);
    if (IN(PH_W1)) REPS(PH_W1) { GEMM_PHASE(EpiGlu, XB, F.ws + WS_W1, 2 * DM, (bf16*)(F.ws + WS_GLU), PART, F.conv_b1); } SEAM(PH_W1);
    if (IN(PH_CONV)) REPS(PH_CONV) { opt_conv(F); } SEAM(PH_CONV);
    if (IN(PH_W2)) { GEMM_PHASE(EpiRes, F.ws + WS_HID2, F.ws + WS_W2, DM, nullptr, XB, PART, F.conv_b2); } SEAM(PH_W2);
    if (IN(PH_Q1)) REPS(PH_Q1) { GEMM_PHASE(EpiQ, XB, F.ws + WS_WQ + (size_t)DM * DM * 2, DM, (bf16*)(F.ws + WS_Q), PART); asm volatile("s_waitcnt vmcnt(0)" ::: "memory"); __syncthreads(); opt_route(F, 1); } SEAM(PH_Q1);
    if (IN(PH_GU1)) REPS(PH_GU1) { gather_u(F, 1, get_xinfo(F, census), rep_ == 0); } SEAM(PH_GU1);
    if (IN(PH_GR1)) REPS(PH_GR1) { gather_r(F, 1); } SEAM(PH_GR1);
    if (IN(PH_GV1)) REPS(PH_GV1) { gather_v(F, 1, get_xinfo(F, census), rep_ == 0); } SEAM(PH_GV1);
    if (IN(PH_FINAL)) { final_norm(F); }
#undef IN
#undef SEAM
}

extern "C" void kernel_launch(void* const* d_in, const int* in_sizes, int n_in, void* d_out, int out_size, void* d_ws, size_t ws_size, hipStream_t stream) {
    static int grid = 0;
    if (grid == 0) {
        if (n_in != 19 || out_size != T * DM || ws_size < WS_END) { fprintf(stderr, "kernel_launch: unexpected shapes (n_in %d out %d ws %zu)\n", n_in, out_size, ws_size); grid = -1; return; }
        int dev = 0, cus = 0;
        if (hipGetDevice(&dev) != hipSuccess || hipDeviceGetAttribute(&cus, hipDeviceAttributeMultiprocessorCount, dev) != hipSuccess) { grid = -1; return; }
        if (hipFuncSetAttribute((const void*)mega_fwd, hipFuncAttributeMaxDynamicSharedMemorySize, LDS_BYTES) != hipSuccess) { fprintf(stderr, "kernel_launch: hipFuncSetAttribute failed\n"); grid = -1; return; }
        (void)hipGetLastError();
        grid = cus;
    }
    if (grid < 0) return;
    (void)hipMemsetAsync((char*)d_ws + WS_CTL, 0, CTL_ZERO_BYTES, stream);
    Args a{};
    for (int i = 0; i < 19; ++i) a.in[i] = (const float*)d_in[i];
    a.out = (float*)d_out; a.ws = (unsigned char*)d_ws;
#if MK_ONE_LAUNCH
    a.ph_lo = 0; a.ph_hi = PH_COUNT;
    hipLaunchKernelGGL(mega_fwd, dim3(grid), dim3(NTHR), LDS_BYTES, stream, a);
#else
    for (int p = 0; p < PH_COUNT; ++p) { a.ph_lo = p; a.ph_hi = p + 1; hipLaunchKernelGGL(mega_fwd, dim3(grid), dim3(NTHR), LDS_BYTES, stream, a); }
#endif
}
```

```cpp
#include <hip/hip_runtime.h>
#include <cstdio>
#include <cstdint>

#ifndef REP_PHASE
#define REP_PHASE -1
#endif
#ifndef PROBE_MODE
#define PROBE_MODE 1
#endif
#ifndef MK_ONE_LAUNCH
#define MK_ONE_LAUNCH 1
#endif

#define GAS __attribute__((address_space(1)))
#define LAS __attribute__((address_space(3)))
#define DI __device__ __forceinline__
typedef unsigned short bf16;
typedef float f32x2 __attribute__((ext_vector_type(2)));
typedef float f32x4 __attribute__((ext_vector_type(4)));
typedef unsigned u32x2 __attribute__((ext_vector_type(2)));
typedef unsigned u32x4 __attribute__((ext_vector_type(4)));
typedef short bf16x8 __attribute__((ext_vector_type(8)));
typedef float f32x16 __attribute__((ext_vector_type(16)));

constexpr int NB = 16, SEQ = 2048, DM = 1024, T = NB * SEQ;
constexpr int CHUNK = 64, HD = 64, NHA = 8, NHB = 8, INC = 3584, NCH = SEQ / CHUNK;
constexpr int PH = 8, PK = 128, PE = PK * PK, PQD = 128, PTOP = 16, NSEL = PH * PTOP;
constexpr int CW = 31;
constexpr float EPS = 1e-6f;
constexpr float LOG2E = 1.4426950408889634f;
constexpr float XQ = 127.f / 6.f;
constexpr int NWAVES = 8, NTHR = NWAVES * 64;

constexpr int C_QA = 0, C_KA = 512, C_VA = 1024, C_QB = 1536, C_KB = 2048, C_VB = 2560, C_GB = 3072;

constexpr size_t MiB = 1u << 20;
constexpr size_t WS_CTL = 0, CTL_ZERO_BYTES = 1 * MiB;
constexpr size_t WS_WIN = 2 * MiB, WS_WOUT = 9 * MiB, WS_W1 = 11 * MiB, WS_W2 = 15 * MiB, WS_WQ = 17 * MiB;
constexpr size_t WS_ROPE = 22 * MiB;
constexpr size_t WS_PART = 23 * MiB;
constexpr size_t WS_EIDX = 26 * MiB;
constexpr size_t WS_GATE = 42 * MiB;
constexpr size_t WS_U8 = 64 * MiB, WS_V8 = 96 * MiB;
constexpr size_t WS_SC = 25 * MiB;
constexpr size_t WS_ROWSC = 59 * MiB;
constexpr size_t WS_COLSC = 60 * MiB;
constexpr size_t WS_SA = 58 * MiB;
constexpr size_t WS_PU = 256 * MiB;
constexpr size_t WS_A = 384 * MiB;
constexpr size_t WS_XB = 128 * MiB;
constexpr size_t WS_R = 192 * MiB;
constexpr size_t WS_O = 416 * MiB;
constexpr size_t WS_Q = 192 * MiB;
constexpr size_t WS_HID = 256 * MiB;
constexpr size_t WS_GLU = 384 * MiB;
constexpr size_t WS_HID2 = 448 * MiB;
constexpr size_t WS_END = 512 * MiB;
constexpr int CW_BAR = 4096, CW_QUEUE = 8192;

constexpr int RING_BYTES = 131072, LDSCTL_OFF = RING_BYTES, MISC_OFF = LDSCTL_OFF + 320, LDS_BYTES = 147456;

DI float bf2f(bf16 v) { return __uint_as_float(((unsigned)v) << 16); }
DI unsigned f2bf(float f) { unsigned u = __float_as_uint(f); return (u + 0x7fffu + ((u >> 16) & 1u)) >> 16; }
DI unsigned pk2(float lo, float hi) { return f2bf(lo) | (f2bf(hi) << 16); }
#define DPP_MOV_I(x, ctrl) __builtin_amdgcn_mov_dpp((x), (ctrl), 0xF, 0xF, false)
#define DPP_XOR1 0xB1
#define DPP_XOR2 0x4E
#define DPP_HMIRROR 0x141
#define DPP_ROR8 0x128
DI float swap32_add(const float a, const float b) { const auto r = __builtin_amdgcn_permlane32_swap(__float_as_uint(a), __float_as_uint(b), false, false); return __uint_as_float(r[0]) + __uint_as_float(r[1]); }
DI float swap16_add(const float a, const float b) { const auto r = __builtin_amdgcn_permlane16_swap(__float_as_uint(a), __float_as_uint(b), false, false); return __uint_as_float(r[0]) + __uint_as_float(r[1]); }
DI int swap32_addi(const int a, const int b) { const auto r = __builtin_amdgcn_permlane32_swap((unsigned)a, (unsigned)b, false, false); return (int)(r[0] + r[1]); }
DI int swap16_addi(const int a, const int b) { const auto r = __builtin_amdgcn_permlane16_swap((unsigned)a, (unsigned)b, false, false); return (int)(r[0] + r[1]); }
DI float wave_sum_fast(float v) {
    v += __int_as_float(DPP_MOV_I(__float_as_int(v), DPP_XOR1)); v += __int_as_float(DPP_MOV_I(__float_as_int(v), DPP_XOR2));
    v += __int_as_float(DPP_MOV_I(__float_as_int(v), DPP_HMIRROR)); v += __int_as_float(DPP_MOV_I(__float_as_int(v), DPP_ROR8));
    v = swap16_add(v, v); v = swap32_add(v, v);
    return v;
}
DI float wave_sum(float v) { return wave_sum_fast(v); }
DI float swap32_max(const float a) { const auto r = __builtin_amdgcn_permlane32_swap(__float_as_uint(a), __float_as_uint(a), false, false); return fmaxf(__uint_as_float(r[0]), __uint_as_float(r[1])); }
DI float swap16_max(const float a) { const auto r = __builtin_amdgcn_permlane16_swap(__float_as_uint(a), __float_as_uint(a), false, false); return fmaxf(__uint_as_float(r[0]), __uint_as_float(r[1])); }
DI float wave_max(float v) {
    v = fmaxf(v, __int_as_float(DPP_MOV_I(__float_as_int(v), DPP_XOR1))); v = fmaxf(v, __int_as_float(DPP_MOV_I(__float_as_int(v), DPP_XOR2)));
    v = fmaxf(v, __int_as_float(DPP_MOV_I(__float_as_int(v), DPP_HMIRROR))); v = fmaxf(v, __int_as_float(DPP_MOV_I(__float_as_int(v), DPP_ROR8)));
    v = swap16_max(v); v = swap32_max(v);
    return v;
}
DI float block_sum(float v, LAS float* red, int tid) {
    v = wave_sum(v);
    __syncthreads();
    if ((tid & 63) == 0) red[tid >> 6] = v;
    __syncthreads();
    float s = 0.f;
#pragma unroll
    for (int i = 0; i < NWAVES; ++i) s += red[i];
    return s;
}
DI float gelu_erf(float x) { return 0.5f * x * (1.f + erff(x * 0.70710678118654752f)); }
DI float sigmoidf(float x) { return 1.f / (1.f + __expf(-x)); }

DI int lane_id() { int r; asm volatile("v_mbcnt_lo_u32_b32 %0, -1, 0\n\tv_mbcnt_hi_u32_b32 %0, -1, %0" : "=v"(r)); return r; }
#define XB_TMO      128
#define XB_XCNT(j)  (256  + 64 * (j))
#define XB_XSUB(j)  (1280 + 64 * (j))
#define XB_XGEN(j)  (2304 + 64 * (j))
#define XB_TOP      3328
#define XB_TOPGEN   3392
#define XCD_BAR_WORDS 3456
#define XB_SPIN_CAP (1u << 22)
DI unsigned xb_ld(unsigned* p)              { return __hip_atomic_load(p, __ATOMIC_RELAXED, __HIP_MEMORY_SCOPE_AGENT); }
DI unsigned xb_add(unsigned* p, unsigned v) { return __hip_atomic_fetch_add(p, v, __ATOMIC_RELAXED, __HIP_MEMORY_SCOPE_AGENT); }
DI unsigned xb_xcc_id() { return (unsigned)__builtin_amdgcn_s_getreg((3 << 11) | 20) & 0xFu; }
#define XB_SPIN(cond, bar) do { unsigned _sp = 0; while (cond) { __builtin_amdgcn_s_sleep(1); \
    if ((++_sp & 255u) == 0u) { if (xb_ld(&(bar)[XB_TMO])) break; if (_sp > XB_SPIN_CAP) { atomicAdd(&(bar)[XB_TMO], 1u); break; } } } } while (0)
struct XcdBarrier { unsigned* bar; unsigned x; volatile LAS unsigned* st; };
DI XcdBarrier xcd_barrier_post(unsigned* bar, volatile LAS unsigned* st) {
    XcdBarrier b; b.bar = bar; b.x = xb_xcc_id(); b.st = st;
    if (threadIdx.x == 0) st[4] = xb_add(&bar[XB_XCNT(b.x)], 1u);
    return b;
}
DI void xcd_barrier_complete(unsigned* bar, unsigned x, unsigned& nloc, unsigned& nx) {
    const unsigned G = gridDim.x * gridDim.y * gridDim.z;
    unsigned sum, cnt, mine, sp = 0u;
    for (;;) {
        sum = 0u; cnt = 0u; mine = 0u;
#pragma unroll
        for (unsigned j = 0; j < 16; ++j) { const unsigned c = xb_ld(&bar[XB_XCNT(j)]); sum += c; cnt += (c > 0u) ? 1u : 0u; mine = (j == x) ? c : mine; }
        if (sum == G) break;
        __builtin_amdgcn_s_sleep(1);
        if ((++sp & 255u) == 0u) { if (xb_ld(&bar[XB_TMO])) break; if (sp > XB_SPIN_CAP) { atomicAdd(&bar[XB_TMO], 1u); break; } }
    }
    nloc = mine > 0u ? mine : 1u; nx = cnt > 0u ? cnt : 1u;
}
DI void xcd_barrier(const XcdBarrier& b, const int wave_id) {
    asm volatile("s_waitcnt vmcnt(0)" ::: "memory");
    __syncthreads();
    if (wave_id == 0 && lane_id() == 0) {
        unsigned* bar = b.bar;
        __builtin_amdgcn_s_waitcnt(0);
        unsigned nloc = b.st[0], nx = b.st[1];
        if (nloc == 0u) { xcd_barrier_complete(bar, b.x, nloc, nx); b.st[0] = nloc; b.st[1] = nx; }
        const unsigned old = xb_add(&bar[XB_XSUB(b.x)], 1u);
        const unsigned gen = old / nloc;
        if (old + 1u == (gen + 1u) * nloc) {
            __builtin_amdgcn_fence(__ATOMIC_RELEASE, "agent");
            asm volatile("s_waitcnt vmcnt(0)" ::: "memory");
            const unsigned og = xb_add(&bar[XB_TOP], 1u);
            const unsigned tg = og / nx;
            if (og + 1u == (tg + 1u) * nx) xb_add(&bar[XB_TOPGEN], 1u);
            else XB_SPIN(xb_ld(&bar[XB_TOPGEN]) == tg, bar);
            __builtin_amdgcn_fence(__ATOMIC_ACQUIRE, "agent");
            xb_add(&bar[XB_XGEN(b.x)], 1u);
            asm volatile("s_waitcnt vmcnt(0)" ::: "memory");
        } else {
            XB_SPIN(xb_ld(&bar[XB_XGEN(b.x)]) == gen, bar);
            __builtin_amdgcn_fence(__ATOMIC_ACQUIRE, "agent");
            asm volatile("s_waitcnt vmcnt(0)" ::: "memory");
        }
    }
    __syncthreads();
}

namespace pg8 {
#define PG8_LAS __attribute__((address_space(3)))
typedef unsigned short bf16_t;
typedef short bf16x8 __attribute__((ext_vector_type(8)));
typedef float f32x4 __attribute__((ext_vector_type(4)));
typedef unsigned u32x4 __attribute__((ext_vector_type(4)));
typedef int i32x4 __attribute__((ext_vector_type(4)));
constexpr int BM = 256, BK = 64, HALF = 128, HTB = HALF * BK * 2  , STAGE_BYTES = 8 * HTB, NXCD = 8, WGM = 8;

__host__ __device__ __forceinline__ int lds_byte(int r, int c) { const int st = (r >> 4) * 2 + (c >> 5), rr = r & 15, cc = c & 31, ob = rr * 64 + cc * 2; return st * 1024 + (ob ^ (((ob >> 9) & 1) << 5)); }
__host__ __device__ __forceinline__ void stage_rc(int b, int& R, int& C) { const int st = b / 1024, sb = b % 1024, swz = sb ^ (((sb >> 9) & 1) << 5); R = (st >> 1) * 16 + swz / 64; C = (st & 1) * 32 + (swz % 64) / 2; }
__host__ __device__ __forceinline__ int perm32(int rho) { const int n = rho >> 4, i = rho & 15; return 8 * (i >> 2) + 4 * n + (i & 3); }

struct Unit { int pm, pn; };
struct Gemm { const bf16_t* A; const bf16_t* Bt; int M, N, K; };

struct StaticOrder {
    int nM, nN, nwg, G, c;
    __host__ __device__ void init(int M, int N, int G_, int c_) { nM = M / BM; nN = N / BM; nwg = nM * nN; G = G_; c = c_; }
    __host__ __device__ bool next(int i, Unit& u) const {
        const long L = (long)i * G + c; if (L >= nwg) return false;
        int wgid = (int)L; { const int q = nwg / NXCD, r = nwg % NXCD, xcd = wgid % NXCD, off = wgid / NXCD; wgid = (xcd < r ? xcd * (q + 1) : r * (q + 1) + (xcd - r) * q) + off; }
        const int nig = WGM * nN, gid = wgid / nig, fm = gid * WGM, gsz = (nM - fm) < WGM ? (nM - fm) : WGM;
        u.pm = fm + ((wgid % nig) % gsz); u.pn = (wgid % nig) / gsz; return true;
    }
    __device__ __forceinline__ void a_ready(const Unit&) const {}
    __device__ __forceinline__ void done(const Unit&) const {}
};

__device__ __forceinline__ unsigned cvt_pk_bf16(float lo, float hi) { unsigned r; asm volatile("v_cvt_pk_bf16_f32 %0, %1, %2" : "=v"(r) : "v"(lo), "v"(hi)); return r; }
__device__ __forceinline__ float rstd16(const float* part, int r, int fq) {
    const f32x4 a = *(const f32x4*)(part + (size_t)r * 16 + 4 * fq);
    float s = (a[0] + a[1]) + (a[2] + a[3]);
    s = swap16_add(s, s); s = swap32_add(s, s);
    return 1.f / sqrtf(s * (1.f / 1024.f) + 1e-6f);
}
__device__ __forceinline__ u32x4 pack8(const f32x4 a, const f32x4 b) { u32x4 w; w.x = cvt_pk_bf16(a[0], a[1]); w.y = cvt_pk_bf16(a[2], a[3]); w.z = cvt_pk_bf16(b[0], b[1]); w.w = cvt_pk_bf16(b[2], b[3]); return w; }
#define rot(t1, t2, c, s) do { const float a_ = (t1) * (c) - (t2) * (s), b_ = (t1) * (s) + (t2) * (c); (t1) = a_; (t2) = b_; } while (0)

struct EpiProj8 {
    static constexpr bool PERM = true, AFTER_DRAIN = false;
    bf16_t* R; const float* rope; const float* rowsc; const float* colsc;
    __device__ __forceinline__ void operator()(const f32x4 (&acc)[2][2][4][2], const Unit& u, int wr, int wc, int fr, int fq) const {
        const int type = u.pn >> 1, hg = u.pn & 1;
        const int colbase = type * 512 + (4 * hg + wc) * 64 + 8 * fq;
        const bool do_rope = (type == 3) || (type == 4);
        f32x4 cs[2][2];
#pragma unroll
        for (int bj = 0; bj < 2; ++bj)
#pragma unroll
            for (int n = 0; n < 2; ++n) cs[bj][n] = *(const f32x4*)(colsc + u.pn * BM + bj * HALF + wc * 32 + 8 * fq + 4 * n);
#pragma unroll
        for (int ai = 0; ai < 2; ++ai)
#pragma unroll
            for (int m = 0; m < 4; ++m) {
                const int r = u.pm * BM + ai * HALF + wr * 64 + m * 16 + fr;
                const float rs = rowsc[r];
                f32x4 v[2][2];
#pragma unroll
                for (int bj = 0; bj < 2; ++bj)
#pragma unroll
                    for (int n = 0; n < 2; ++n) { const i32x4 ia = __builtin_bit_cast(i32x4, acc[ai][bj][m][n]);
                        v[bj][n] = (f32x4){(float)ia[0], (float)ia[1], (float)ia[2], (float)ia[3]} * cs[bj][n] * rs; }
                f32x4 a0 = v[0][0], a1 = v[0][1], b0 = v[1][0], b1 = v[1][1];
                if (do_rope) {
                    const f32x4* rp = (const f32x4*)(rope + ((size_t)(r & 2047) * 32 + 8 * fq) * 2);
                    const f32x4 c0 = rp[0], c1 = rp[1], c2 = rp[2], c3 = rp[3];
                    rot(a0[0], b0[0], c0[0], c0[1]); rot(a0[1], b0[1], c0[2], c0[3]); rot(a0[2], b0[2], c1[0], c1[1]); rot(a0[3], b0[3], c1[2], c1[3]);
                    rot(a1[0], b1[0], c2[0], c2[1]); rot(a1[1], b1[1], c2[2], c2[3]); rot(a1[2], b1[2], c3[0], c3[1]); rot(a1[3], b1[3], c3[2], c3[3]);
                }
                bf16_t* rowp = R + (size_t)r * 3584 + colbase;
                *(u32x4*)(rowp) = pack8(a0, a1);
                *(u32x4*)(rowp + 32) = pack8(b0, b1);
            }
    }
};
struct EpiRes {
    static constexpr bool PERM = true, AFTER_DRAIN = false;
    const float* xf; bf16_t* hb; float* part; const float* bias;
    __device__ __forceinline__ void operator()(const f32x4 (&acc)[2][2][4][2], const Unit& u, int wr, int wc, int fr, int fq) const {
        const int col0 = u.pn * BM + wc * 32 + 8 * fq;
        f32x4 bv[2][2];
#pragma unroll
        for (int bj = 0; bj < 2; ++bj)
#pragma unroll
            for (int n = 0; n < 2; ++n) bv[bj][n] = bias ? *(const f32x4*)(bias + col0 + bj * HALF + 4 * n) : (f32x4){0.f, 0.f, 0.f, 0.f};
#pragma unroll
        for (int ai = 0; ai < 2; ++ai)
#pragma unroll
            for (int m = 0; m < 4; ++m) {
                const int r = u.pm * BM + ai * HALF + wr * 64 + m * 16 + fr;
                const size_t off = (size_t)r * 1024 + col0;
                float ss = 0.f;
#pragma unroll
                for (int bj = 0; bj < 2; ++bj) {
                    f32x4 x0, x1;
                    if (xf) { x0 = *(const f32x4*)(xf + off + bj * HALF); x1 = *(const f32x4*)(xf + off + bj * HALF + 4); }
                    else { const u32x4 w = *(const u32x4*)(hb + off + bj * HALF);
                           x0 = (f32x4){__uint_as_float(w[0] << 16), __uint_as_float(w[0] & 0xffff0000u), __uint_as_float(w[1] << 16), __uint_as_float(w[1] & 0xffff0000u)};
                           x1 = (f32x4){__uint_as_float(w[2] << 16), __uint_as_float(w[2] & 0xffff0000u), __uint_as_float(w[3] << 16), __uint_as_float(w[3] & 0xffff0000u)}; }
                    const f32x4 h0 = x0 + acc[ai][bj][m][0] + bv[bj][0], h1 = x1 + acc[ai][bj][m][1] + bv[bj][1];
                    *(u32x4*)(hb + off + bj * HALF) = pack8(h0, h1);
                    ss += (h0[0] * h0[0] + h0[1] * h0[1]) + (h0[2] * h0[2] + h0[3] * h0[3]) + (h1[0] * h1[0] + h1[1] * h1[1]) + (h1[2] * h1[2] + h1[3] * h1[3]);
                }
                ss = swap16_add(ss, ss); ss = swap32_add(ss, ss);
                if (fq == 0) part[(size_t)r * 16 + 4 * u.pn + wc] = ss;
            }
    }
};
struct EpiQ {
    static constexpr bool PERM = true, AFTER_DRAIN = false;
    bf16_t* O; const float* part;
    __device__ __forceinline__ void operator()(const f32x4 (&acc)[2][2][4][2], const Unit& u, int wr, int wc, int fr, int fq) const {
        const int col0 = u.pn * BM + wc * 32 + 8 * fq;
#pragma unroll
        for (int ai = 0; ai < 2; ++ai)
#pragma unroll
            for (int m = 0; m < 4; ++m) {
                const int r = u.pm * BM + ai * HALF + wr * 64 + m * 16 + fr;
                const float rs = rstd16(part, r, fq);
                bf16_t* rowp = O + (size_t)r * 1024 + col0;
#pragma unroll
                for (int bj = 0; bj < 2; ++bj) *(u32x4*)(rowp + bj * HALF) = pack8(acc[ai][bj][m][0] * rs, acc[ai][bj][m][1] * rs);
            }
    }
};
struct EpiGlu {
    static constexpr bool PERM = true, AFTER_DRAIN = false;
    bf16_t* G; const float* part; const float* b1;
    __device__ __forceinline__ void operator()(const f32x4 (&acc)[2][2][4][2], const Unit& u, int wr, int wc, int fr, int fq) const {
        const int col = u.pn * 128 + wc * 32 + 8 * fq;
        f32x4 ba[2], bg[2];
#pragma unroll
        for (int n = 0; n < 2; ++n) { ba[n] = *(const f32x4*)(b1 + col + 4 * n); bg[n] = *(const f32x4*)(b1 + 1024 + col + 4 * n); }
#pragma unroll
        for (int ai = 0; ai < 2; ++ai)
#pragma unroll
            for (int m = 0; m < 4; ++m) {
                const int r = u.pm * BM + ai * HALF + wr * 64 + m * 16 + fr;
                const float rs = rstd16(part, r, fq);
                f32x4 y[2];
#pragma unroll
                for (int n = 0; n < 2; ++n) {
                    const f32x4 a = acc[ai][0][m][n] * rs + ba[n], g = acc[ai][1][m][n] * rs + bg[n];
#pragma unroll
                    for (int i = 0; i < 4; ++i) y[n][i] = a[i] / (1.f + __expf(-g[i]));
                }
                *(u32x4*)(G + (size_t)r * 1024 + col) = pack8(y[0], y[1]);
            }
    }
};
template <class Epi, class Sched, bool ALIGN_EPI = false, bool SP2 = false, bool I8 = false>
__device__ __forceinline__ void gemm_phase(PG8_LAS unsigned char* lds, const Gemm g, const Sched& S, const Epi& E, const int wave_id) {
    const int lane = lane_id(), wid = wave_id, tid = wid * 64 + lane, wr = wid >> 2, wc = wid & 3, fr = lane & 15, fq = lane >> 4;
    const int K = g.K, nt = K / BK;
    unsigned voffA[2], voffB[2];
#pragma unroll
    for (int i = 0; i < 2; ++i) { int R, C; stage_rc(tid * 16 + i * 8192, R, C); const int Rb = Epi::PERM ? ((R & ~31) + perm32(R & 31)) : R;
        voffA[i] = (unsigned)(R * K + C) * 2u; voffB[i] = (unsigned)(Rb * K + C) * 2u; }
    const size_t kstep = (size_t)(BK * 2);
    const size_t hstep = (size_t)HALF * K * 2;
    const size_t tstep = 2 * hstep;
    const unsigned ldsw = (unsigned)wid * 1024u;
    const int aoff = lds_byte(wr * 64 + fr, fq * 8), boff = lds_byte(wc * 32 + fr, fq * 8);
#define PG8_SA(b, h) (((b) * 2 + (h)) * HTB)
#define PG8_SB(b, h) ((4 + (b) * 2 + (h)) * HTB)
#define PG8_STAGE(bufoff, gbase, voff) do { _Pragma("unroll") for (int _i = 0; _i < 2; ++_i) \
        __builtin_amdgcn_global_load_lds((const unsigned*)((const char*)(gbase) + (voff)[_i]), (PG8_LAS unsigned*)(lds + (bufoff) + ldsw + _i * 8192), 16, 0, 0); } while (0)
#define PG8_LDA(dst, b, h) do { _Pragma("unroll") for (int m = 0; m < 4; ++m) _Pragma("unroll") for (int k = 0; k < 2; ++k) dst[m][k] = *(const PG8_LAS bf16x8*)(lds + PG8_SA(b, h) + aoff + m * 2048 + k * 1024); } while (0)
#define PG8_LDB(dst, b, h) do { _Pragma("unroll") for (int n = 0; n < 2; ++n) _Pragma("unroll") for (int k = 0; k < 2; ++k) dst[n][k] = *(const PG8_LAS bf16x8*)(lds + PG8_SB(b, h) + boff + n * 2048 + k * 1024); } while (0)
#define PG8_MMA(ai, bj, At, Bt) do { __builtin_amdgcn_s_setprio(1); _Pragma("unroll") for (int m = 0; m < 4; ++m) _Pragma("unroll") for (int n = 0; n < 2; ++n) _Pragma("unroll") for (int k = 0; k < 2; ++k) { \
        if constexpr (I8) acc[ai][bj][m][n] = __builtin_bit_cast(f32x4, __builtin_amdgcn_mfma_i32_16x16x64_i8(__builtin_bit_cast(i32x4, Bt[n][k]), __builtin_bit_cast(i32x4, At[m][k]), __builtin_bit_cast(i32x4, acc[ai][bj][m][n]), 0, 0, 0)); \
        else acc[ai][bj][m][n] = __builtin_amdgcn_mfma_f32_16x16x32_bf16(Bt[n][k], At[m][k], acc[ai][bj][m][n], 0, 0, 0); } __builtin_amdgcn_s_setprio(0); } while (0)
#define PG8_WAIT_V(n) asm volatile("s_waitcnt vmcnt(" #n ")" ::: "memory")
#define PG8_WAIT_L(n) asm volatile("s_waitcnt lgkmcnt(" #n ")" ::: "memory")
#define PG8_BAR __builtin_amdgcn_s_barrier()
#define PG8_SCHED __builtin_amdgcn_sched_barrier(0)
    Unit cur, nxt; int ui = 0;
    if (!S.next(0, cur)) return;
    f32x4 acc[2][2][4][2];
#pragma unroll
    for (int a = 0; a < 2; ++a)
#pragma unroll
        for (int b = 0; b < 2; ++b)
#pragma unroll
            for (int m = 0; m < 4; ++m)
#pragma unroll
                for (int n = 0; n < 2; ++n) acc[a][b][m][n] = (f32x4){0.f, 0.f, 0.f, 0.f};
    bf16x8 At[4][2], B0[2][2], B1[2][2];
    const char* cA = (const char*)g.A + (size_t)cur.pm * tstep; const char* cB = (const char*)g.Bt + (size_t)cur.pn * tstep;
    S.a_ready(cur);
    if constexpr (SP2) {
        PG8_STAGE(PG8_SB(0, 0), cB, voffB); PG8_STAGE(PG8_SB(0, 1), cB + hstep, voffB); PG8_STAGE(PG8_SA(0, 0), cA, voffA); PG8_STAGE(PG8_SA(0, 1), cA + hstep, voffA);
        if (wr == 1) PG8_BAR;
        PG8_WAIT_V(2); PG8_BAR;
        PG8_STAGE(PG8_SB(1, 0), cB + kstep, voffB); PG8_STAGE(PG8_SA(1, 0), cA + kstep, voffA); PG8_STAGE(PG8_SB(1, 1), cB + hstep + kstep, voffB);
        PG8_WAIT_V(6); PG8_BAR;
    } else {
        PG8_STAGE(PG8_SB(0, 0), cB, voffB); PG8_STAGE(PG8_SA(0, 0), cA, voffA); PG8_STAGE(PG8_SB(0, 1), cB + hstep, voffB); PG8_STAGE(PG8_SA(0, 1), cA + hstep, voffA);
        if (wr == 1) PG8_BAR;
        PG8_WAIT_V(4); PG8_BAR;
        PG8_STAGE(PG8_SB(1, 0), cB + kstep, voffB); PG8_STAGE(PG8_SA(1, 0), cA + kstep, voffA); PG8_STAGE(PG8_SB(1, 1), cB + hstep + kstep, voffB);
        PG8_WAIT_V(6); PG8_BAR;
    }
    for (;;) {
        const bool has_next = S.next(ui + 1, nxt);
        const char* nA = has_next ? (const char*)g.A + (size_t)nxt.pm * tstep : cA; const char* nB = has_next ? (const char*)g.Bt + (size_t)nxt.pn * tstep : cB;
        for (int t = 0; t < nt; t += 2) {
            const bool last = (t == nt - 2);
            const char* a1 = cA + (size_t)(t + 1) * kstep;
            const char* a2 = last ? nA : cA + (size_t)(t + 2) * kstep; const char* b2 = last ? nB : cB + (size_t)(t + 2) * kstep;
            const char* a3 = a2 + kstep; const char* b3 = b2 + kstep;
            if (last && has_next) S.a_ready(nxt);
            if constexpr (SP2) {
            PG8_LDB(B0, 0, 0); PG8_LDB(B1, 0, 1); PG8_SCHED; PG8_LDA(At, 0, 0); PG8_STAGE(PG8_SA(1, 1), a1 + hstep, voffA);
            PG8_WAIT_V(8); PG8_WAIT_L(0); PG8_BAR; PG8_MMA(0, 0, At, B0); PG8_MMA(0, 1, At, B1); PG8_BAR; PG8_SCHED;
            PG8_LDA(At, 0, 1); PG8_STAGE(PG8_SB(0, 0), b2, voffB); PG8_STAGE(PG8_SB(0, 1), b2 + hstep, voffB); PG8_STAGE(PG8_SA(0, 0), a2, voffA);
            PG8_WAIT_V(8); PG8_WAIT_L(0); PG8_BAR; PG8_MMA(1, 0, At, B0); PG8_MMA(1, 1, At, B1); PG8_BAR; PG8_SCHED;
            PG8_LDB(B0, 1, 0); PG8_LDB(B1, 1, 1); PG8_SCHED; PG8_LDA(At, 1, 0); PG8_STAGE(PG8_SA(0, 1), a2 + hstep, voffA);
            PG8_WAIT_V(8); PG8_WAIT_L(0); PG8_BAR; PG8_MMA(0, 0, At, B0); PG8_MMA(0, 1, At, B1); PG8_BAR; PG8_SCHED;
            PG8_LDA(At, 1, 1); PG8_STAGE(PG8_SB(1, 0), b3, voffB); PG8_STAGE(PG8_SB(1, 1), b3 + hstep, voffB); PG8_STAGE(PG8_SA(1, 0), a3, voffA);
            PG8_WAIT_V(8); PG8_WAIT_L(0); PG8_BAR; PG8_MMA(1, 0, At, B0); PG8_MMA(1, 1, At, B1); PG8_BAR; PG8_SCHED;
            } else {
            PG8_LDB(B0, 0, 0); PG8_SCHED; PG8_LDA(At, 0, 0); PG8_STAGE(PG8_SA(1, 1), a1 + hstep, voffA);
            PG8_WAIT_L(8); PG8_BAR; PG8_WAIT_L(0); PG8_MMA(0, 0, At, B0); PG8_BAR; PG8_SCHED;
            PG8_LDB(B1, 0, 1); PG8_STAGE(PG8_SB(0, 0), b2, voffB);
            PG8_BAR; PG8_WAIT_L(0); PG8_MMA(0, 1, At, B1); PG8_BAR;
            PG8_LDA(At, 0, 1); PG8_STAGE(PG8_SA(0, 0), a2, voffA);
            PG8_BAR; PG8_WAIT_L(0); PG8_MMA(1, 0, At, B0); PG8_BAR; PG8_SCHED;
            PG8_STAGE(PG8_SB(0, 1), b2 + hstep, voffB);
            PG8_WAIT_V(6); PG8_BAR; PG8_MMA(1, 1, At, B1); PG8_BAR;
            PG8_LDB(B0, 1, 0); PG8_SCHED; PG8_LDA(At, 1, 0); PG8_STAGE(PG8_SA(0, 1), a2 + hstep, voffA);
            PG8_WAIT_L(8); PG8_BAR; PG8_WAIT_L(0); PG8_MMA(0, 0, At, B0); PG8_BAR; PG8_SCHED;
            PG8_LDB(B1, 1, 1); PG8_STAGE(PG8_SB(1, 0), b3, voffB);
            PG8_BAR; PG8_WAIT_L(0); PG8_MMA(0, 1, At, B1); PG8_BAR;
            PG8_LDA(At, 1, 1); PG8_STAGE(PG8_SA(1, 0), a3, voffA);
            PG8_BAR; PG8_WAIT_L(0); PG8_MMA(1, 0, At, B0); PG8_BAR; PG8_SCHED;
            PG8_STAGE(PG8_SB(1, 1), b3 + hstep, voffB);
            PG8_WAIT_V(6); PG8_BAR; PG8_MMA(1, 1, At, B1); PG8_BAR;
            }
        }
        if constexpr (ALIGN_EPI) { if (wr == 0) PG8_BAR; }
        if constexpr (!Epi::AFTER_DRAIN) { E(acc, cur, wr, wc, fr, fq); S.done(cur); }
        if (!has_next) break;
#pragma unroll
        for (int a = 0; a < 2; ++a)
#pragma unroll
            for (int b = 0; b < 2; ++b)
#pragma unroll
                for (int m = 0; m < 4; ++m)
#pragma unroll
                    for (int n = 0; n < 2; ++n) acc[a][b][m][n] = (f32x4){0.f, 0.f, 0.f, 0.f};
        cur = nxt; cA = nA; cB = nB; ++ui;
        if constexpr (ALIGN_EPI) { if (wr == 1) PG8_BAR; }
    }
    PG8_WAIT_V(0);
    if constexpr (!ALIGN_EPI) { if (wr == 0) PG8_BAR; }
    PG8_BAR;
    if constexpr (Epi::AFTER_DRAIN) { E.fused(acc, cur, wr, wc, fr, fq, lds, wid, lane); S.done(cur); }
#undef PG8_SA
#undef PG8_SB
#undef PG8_STAGE
#undef PG8_LDA
#undef PG8_LDB
#undef PG8_MMA
#undef PG8_WAIT_V
#undef PG8_WAIT_L
#undef PG8_BAR
#undef PG8_SCHED
}
}

struct Frame {
    LAS unsigned char* lds;
    int wave, G, bid;
    const float *x, *mix_norm, *ffn_norm, *final_norm, *w_in, *w_out, *rel_bias, *conv_w1, *conv_b1, *conv_dw, *conv_dw_b, *conv_ln_g, *conv_ln_b, *conv_w2, *conv_b2,
        *peer_wq, *peer_keys, *peer_u, *peer_v;
    float* out;
    unsigned char* ws;
};
#define FRAME_IDS const int f_lane = lane_id(); const int f_tid = F.wave * 64 + f_lane; (void)f_tid
DI float gamma_of(int h) { return 1.f - exp2f(-5.f - (float)h); }

DI unsigned q8x4(f32x4 v, const float sc) {
    const int a = (int)rintf(v[0] * sc), b = (int)rintf(v[1] * sc), c = (int)rintf(v[2] * sc), d = (int)rintf(v[3] * sc);
    return ((unsigned)a & 0xFFu) | (((unsigned)b & 0xFFu) << 8) | (((unsigned)c & 0xFFu) << 16) | ((unsigned)d << 24);
}
DI void p0_prep(Frame& F) {
    FRAME_IDS;
    const int gw = F.bid * NWAVES + F.wave, NGW = F.G * NWAVES;
    f32x2* rope = (f32x2*)(F.ws + WS_ROPE);
    for (int i = F.bid * NTHR + f_tid; i < SEQ * 32; i += F.G * NTHR) {
        const int s = i >> 5, j = i & 31;
        const float inv = powf(10000.f, -(float)j / 32.f);
        const float ang = (float)s * inv;
        float sn, cs; sincosf(ang, &sn, &cs);
        rope[i] = (f32x2){cs, sn};
    }
    unsigned* xq = (unsigned*)(F.ws + WS_XB); float* rowsc = (float*)(F.ws + WS_ROWSC);
    for (int m = gw; m < T; m += NGW) {
        const f32x4* xr = (const f32x4*)(F.x + (size_t)m * DM) + f_lane;
        f32x4 v[4]; float s = 0.f, am = 0.f;
#pragma unroll
        for (int j = 0; j < 4; ++j) { v[j] = xr[64 * j]; s += v[j].x * v[j].x + v[j].y * v[j].y + v[j].z * v[j].z + v[j].w * v[j].w; am = fmaxf(am, fmaxf(fmaxf(fabsf(v[j].x), fabsf(v[j].y)), fmaxf(fabsf(v[j].z), fabsf(v[j].w)))); }
        const float r = 1.f / sqrtf(wave_sum(s) * (1.f / DM) + EPS);
        am = wave_max(am);
        const float sc = am > 0.f ? 127.f / am : 0.f;
#pragma unroll
        for (int j = 0; j < 4; ++j) xq[(size_t)m * (DM / 4) + f_lane + 64 * j] = q8x4(v[j], sc);
        if (f_lane == 0) rowsc[m] = am * (1.f / 127.f) * r;
    }
}
#define P0_LOAD_ITEM(wv, gv) \
    float gv[32], wv[32]; \
    if (gain) { _Pragma("unroll") for (int i = 0; i < 32; ++i) gv[i] = gain[k0 + 2 * i + (lane >> 5)] * scale; } \
    else { _Pragma("unroll") for (int i = 0; i < 32; ++i) gv[i] = scale; } \
    _Pragma("unroll") for (int i = 0; i < 32; ++i) wv[i] = W[(size_t)(k0 + 2 * i + (lane >> 5)) * N + n0 + (lane & 31)];
DI void p0_transpose_item(const float* W, int K, int N, bf16* WT, int prow0, const float* gain, float scale, LAS float* scr, int k0, int n0, int lane) {
    P0_LOAD_ITEM(wv, gv)
#pragma unroll
    for (int i = 0; i < 32; ++i) scr[(2 * i + (lane >> 5)) * 33 + (lane & 31)] = wv[i] * gv[i];
    asm volatile("s_waitcnt lgkmcnt(0)" ::: "memory");
    const int c = lane & 7;
#pragma unroll
    for (int j = 0; j < 4; ++j) { const int n = (lane >> 3) + 8 * j; const LAS float* q = scr + (8 * c) * 33 + n;
        u32x4 o; o.x = pk2(q[0 * 33], q[1 * 33]); o.y = pk2(q[2 * 33], q[3 * 33]); o.z = pk2(q[4 * 33], q[5 * 33]); o.w = pk2(q[6 * 33], q[7 * 33]);
        *(u32x4*)(WT + (size_t)(prow0 + n) * K + k0 + 8 * c) = o; }
    asm volatile("s_waitcnt lgkmcnt(0)" ::: "memory");
}
DI void p0_amax_item(const float* W, int N, unsigned* colmax, const float* gain, float scale, int k0, int n0, int lane) {
    P0_LOAD_ITEM(wv, gv)
    float am = 0.f;
#pragma unroll
    for (int i = 0; i < 32; ++i) am = fmaxf(am, fabsf(wv[i] * gv[i]));
    am = swap32_max(am);
    if (lane < 32) __hip_atomic_fetch_max(colmax + lane, __float_as_uint(am), __ATOMIC_RELAXED, __HIP_MEMORY_SCOPE_AGENT);
}
DI void p0_q8_item(const float* W, int N, unsigned char* WT, const unsigned* colmax, float* colsc, int prow0, const float* gain, float scale, LAS float* scr, int k0, int n0, int lane) {
    const float am = __uint_as_float(colmax[lane & 31]);
    const float sc = am > 0.f ? 127.f / am : 0.f;
    if (k0 == 0 && lane < 32) colsc[lane] = am * (1.f / 127.f);
    P0_LOAD_ITEM(wv, gv)
#pragma unroll
    for (int i = 0; i < 32; ++i) scr[(2 * i + (lane >> 5)) * 33 + (lane & 31)] = rintf(wv[i] * gv[i] * sc);
    asm volatile("s_waitcnt lgkmcnt(0)" ::: "memory");
    const int ch = lane & 3;
#pragma unroll
    for (int j = 0; j < 2; ++j) { const int n = (lane >> 2) + 16 * j; const LAS float* q = scr + (16 * ch) * 33 + n;
        u32x4 o;
#pragma unroll
        for (int w = 0; w < 4; ++w) o[w] = ((unsigned)(int)q[(4 * w) * 33] & 0xFFu) | (((unsigned)(int)q[(4 * w + 1) * 33] & 0xFFu) << 8) | (((unsigned)(int)q[(4 * w + 2) * 33] & 0xFFu) << 16) | ((unsigned)(int)q[(4 * w + 3) * 33] << 24);
        *(u32x4*)(WT + (size_t)(prow0 + n) * DM + k0 + 16 * ch) = o; }
    asm volatile("s_waitcnt lgkmcnt(0)" ::: "memory");
}
#undef P0_LOAD_ITEM
constexpr int CW_COLMAX = 16384;
constexpr int CS_WIN = 0, CS_WOUT = 3584, CS_W1 = 4608, CS_W2 = 6656, CS_WQ = 7680;
constexpr bool I8_WIN = true, I8_WOUT = false, I8_W1 = false, I8_W2 = false, I8_WQ = false;
DI void p0_weights(Frame& F, const int pass) {
    FRAME_IDS;
    LAS float* scr = (LAS float*)(F.lds + F.wave * 16384);
    unsigned* colmax = (unsigned*)(F.ws + WS_CTL) + CW_COLMAX; float* colsc = (float*)(F.ws + WS_COLSC);
    const int gw = F.bid * NWAVES + F.wave, NGW = F.G * NWAVES;
    constexpr int I_IN = 16 * (INC / 32), I_SQ = 16 * (DM / 32), I_W1 = 16 * (2 * DM / 32);
    constexpr int NITEMS = I_IN + I_SQ + I_W1 + I_SQ + 2 * I_SQ;
#define WITEM(I8FLAG, Wp, Nn, WTb, CSo, prow0, gainp, scl, k0, n0) do { \
        if (pass == 0) { if (I8FLAG) p0_amax_item(Wp, Nn, colmax + (CSo) + (prow0), gainp, scl, k0, n0, f_lane); } \
        else if (I8FLAG) p0_q8_item(Wp, Nn, (unsigned char*)(WTb), colmax + (CSo) + (prow0), colsc + (CSo) + (prow0), prow0, gainp, scl, scr, k0, n0, f_lane); \
        else p0_transpose_item(Wp, DM, Nn, (bf16*)(WTb), prow0, gainp, scl, scr, k0, n0, f_lane); } while (0)
    for (int it = gw; it < NITEMS; it += NGW) {
        int r = it;
        if (r < I_IN) { const int nb = r % (INC / 32), kb = r / (INC / 32), n0 = nb * 32;
            const int type = n0 / 512, head = (n0 % 512) / 64, bj = (n0 % 64) / 32;
            const int prow0 = 256 * (2 * type + head / 4) + 128 * bj + 32 * (head % 4);
            WITEM(I8_WIN, F.w_in, INC, F.ws + WS_WIN, CS_WIN, prow0, F.mix_norm, (type == 0 ? 0.125f * LOG2E : (type == 4 ? 0.125f : 1.f)), kb * 64, n0); continue; }
        r -= I_IN;
        if (r < I_SQ) { const int nb = r % 32, kb = r / 32; WITEM(I8_WOUT, F.w_out, DM, F.ws + WS_WOUT, CS_WOUT, nb * 32, (const float*)nullptr, 1.f, kb * 64, nb * 32); continue; }
        r -= I_SQ;
        if (r < I_W1) { const int nb = r % 64, kb = r / 64, n0 = nb * 32; const int bj = n0 / 1024, rem = n0 % 1024;
            WITEM(I8_W1, F.conv_w1, 2 * DM, F.ws + WS_W1, CS_W1, 256 * (rem / 128) + 128 * bj + (rem % 128), F.mix_norm + DM, 1.f, kb * 64, n0); continue; }
        r -= I_W1;
        if (r < I_SQ) { const int nb = r % 32, kb = r / 32; WITEM(I8_W2, F.conv_w2, DM, F.ws + WS_W2, CS_W2, nb * 32, (const float*)nullptr, 1.f, kb * 64, nb * 32); continue; }
        r -= I_SQ;
        { const int layer = r / I_SQ; r %= I_SQ; const int nb = r % 32, kb = r / 32;
          WITEM(I8_WQ, F.peer_wq + (size_t)layer * DM * DM, DM, F.ws + WS_WQ + (size_t)layer * DM * DM * 2, CS_WQ + layer * DM, nb * 32, F.ffn_norm + layer * DM, 1.f, kb * 64, nb * 32); }
    }
#undef WITEM
}
DI float row_rstd(const float* part, int m) {
    const f32x4* p = (const f32x4*)(part + (size_t)m * 16);
    const f32x4 a = p[0], b = p[1], c = p[2], d = p[3];
    const float s = ((a.x + a.y) + (a.z + a.w)) + ((b.x + b.y) + (b.z + b.w)) + ((c.x + c.y) + (c.z + c.w)) + ((d.x + d.y) + (d.z + d.w));
    return 1.f / sqrtf(s * (1.f / DM) + EPS);
}

typedef short v4i16 __attribute__((ext_vector_type(4)));
typedef __bf16 bf16x2_t __attribute__((ext_vector_type(2)));
DI unsigned cvtpk(float lo, float hi) { f32x2 v = {lo, hi}; bf16x2_t b = __builtin_convertvector(v, bf16x2_t); return __builtin_bit_cast(unsigned, b); }
DI v4i16 ds_tr16(LAS const unsigned char* p) { return __builtin_amdgcn_ds_read_tr16_b64_v4i16((LAS v4i16*)p); }
DI int crow(int r, int h) { return (r & 3) + 8 * (r >> 2) + 4 * h; }
DI bf16x8 pack_step(const f32x16& x, const int s) {
    u32x4 w = {cvtpk(x[8 * s + 0], x[8 * s + 1]), cvtpk(x[8 * s + 2], x[8 * s + 3]), cvtpk(x[8 * s + 4], x[8 * s + 5]), cvtpk(x[8 * s + 6], x[8 * s + 7])};
    return __builtin_bit_cast(bf16x8, w);
}
constexpr int AT_KB = 64 * 144, AT_VB = 8192, AT_BUF = AT_KB + AT_VB, AT_BIAS = 2 * AT_BUF;
DI void attn_item(Frame& F, const int it) {
    FRAME_IDS;
    const bf16* R = (const bf16*)(F.ws + WS_R); bf16* O = (bf16*)(F.ws + WS_O);
    LAS unsigned char* lds = F.lds;
    LAS float* bias_s = (LAS float*)(lds + AT_BIAS);
    const int q32 = f_lane & 31, h = f_lane >> 5, w = F.wave;
    const int srow = f_tid >> 3, sch = f_tid & 7;
    const int vtr_off = ((f_lane & 15) >> 2) * 64 + (16 * ((f_lane >> 4) & 1) + 4 * (f_lane & 3)) * 2;
    {
        const int b = it / (NHA * 8), hd = (it / 8) % NHA, c0 = (it % 8) * 4;
        const int c = c0 + (w >> 1), qrow0 = 32 * (w & 1);
        const size_t tq = (size_t)b * SEQ + c * 64 + qrow0 + q32;
        __syncthreads();
        for (int k = f_tid; k < 257; k += NTHR) bias_s[k] = F.rel_bias[hd * 257 + k] * LOG2E;
        bf16x8 qf[4];
#pragma unroll
        for (int ks = 0; ks < 4; ++ks) qf[ks] = *(const bf16x8*)(R + tq * INC + C_QA + hd * 64 + 16 * ks + 8 * h);
        asm volatile("" ::: "memory");
        const int t_lo = c0 - 8 < 0 ? 0 : c0 - 8, t_hi = c0 + 3, ntile = t_hi - t_lo + 1;
        const bf16* kbase = R + ((size_t)b * SEQ + srow) * INC + C_KA + hd * 64 + 8 * sch;
        const bf16* vbase = R + ((size_t)b * SEQ + srow) * INC + C_VA + hd * 64 + 8 * sch;
        u32x4 kA = *(const u32x4*)(kbase + (size_t)t_lo * 64 * INC), vA = *(const u32x4*)(vbase + (size_t)t_lo * 64 * INC);
        u32x4 kB = *(const u32x4*)(kbase + (size_t)(t_lo + 1) * 64 * INC), vB = *(const u32x4*)(vbase + (size_t)(t_lo + 1) * 64 * INC);
        *(LAS u32x4*)(lds + srow * 144 + sch * 16) = kA;
        *(LAS u32x4*)(lds + AT_KB + (sch >> 2) * 4096 + srow * 64 + (sch & 3) * 16) = vA;
        __syncthreads();
        const float bias_far = bias_s[256];
        float m = -1e30f, l = 0.f;
        f32x16 o0 = {}, o1 = {};
        auto tile_step = [&](const int i, u32x4& kL, u32x4& vL, const u32x4& kW, const u32x4& vW) __attribute__((always_inline)) {
            const int tc = t_lo + i;
            LAS unsigned char* kb = lds + (i & 1) * AT_BUF; LAS unsigned char* vb = kb + AT_KB;
            { const int tl = tc + 2 < t_hi ? tc + 2 : t_hi;
              kL = *(const u32x4*)(kbase + (size_t)tl * 64 * INC); vL = *(const u32x4*)(vbase + (size_t)tl * 64 * INC); }
            const int D = c - tc;
            if (D >= 0 && D <= 8) {
                const float init = D >= 3 ? bias_far : 0.f;
                f32x16 p0, p1;
#pragma unroll
                for (int r = 0; r < 16; ++r) { p0[r] = init; p1[r] = init; }
#pragma unroll
                for (int ks = 0; ks < 4; ++ks) {
                    const bf16x8 k0 = *(const LAS bf16x8*)(kb + q32 * 144 + (16 * ks + 8 * h) * 2);
                    const bf16x8 k1 = *(const LAS bf16x8*)(kb + (32 + q32) * 144 + (16 * ks + 8 * h) * 2);
                    p0 = __builtin_amdgcn_mfma_f32_32x32x16_bf16(k0, qf[ks], p0, 0, 0, 0);
                    p1 = __builtin_amdgcn_mfma_f32_32x32x16_bf16(k1, qf[ks], p1, 0, 0, 0);
                }
                if (D < 3) {
                    const int relb = D * 64 + qrow0 + q32 - 4 * h + 128;
#pragma unroll
                    for (int r = 0; r < 16; ++r) {
                        const int r0 = relb - ((r & 3) + 8 * (r >> 2));
                        const int i0 = r0 < 0 ? 0 : (r0 > 256 ? 256 : r0), r1 = r0 - 32, i1 = r1 < 0 ? 0 : (r1 > 256 ? 256 : r1);
                        p0[r] += bias_s[i0]; p1[r] += bias_s[i1];
                    }
                }
                float tm = fmaxf(p0[0], p1[0]);
#pragma unroll
                for (int r = 1; r < 16; ++r) tm = fmaxf(tm, fmaxf(p0[r], p1[r]));
                tm = swap32_max(tm);
                const float mn = fmaxf(m, tm), alpha = __builtin_amdgcn_exp2f(m - mn);
                m = mn;
                float ps = 0.f;
#pragma unroll
                for (int r = 0; r < 16; ++r) { p0[r] = __builtin_amdgcn_exp2f(p0[r] - mn); p1[r] = __builtin_amdgcn_exp2f(p1[r] - mn); ps += p0[r] + p1[r]; }
                l = l * alpha + ps;
                if (!__all(alpha == 1.f)) {
#pragma unroll
                    for (int r = 0; r < 16; ++r) { o0[r] *= alpha; o1[r] *= alpha; }
                }
                bf16x8 pf[4];
                pf[0] = pack_step(p0, 0); pf[1] = pack_step(p0, 1); pf[2] = pack_step(p1, 0); pf[3] = pack_step(p1, 1);
#pragma unroll
                for (int kk = 0; kk < 4; ++kk) {
                    const int key0 = 16 * kk + 4 * h;
                    const v4i16 a0l = ds_tr16(vb + key0 * 64 + vtr_off), a0h = ds_tr16(vb + (key0 + 8) * 64 + vtr_off);
                    const v4i16 a1l = ds_tr16(vb + 4096 + key0 * 64 + vtr_off), a1h = ds_tr16(vb + 4096 + (key0 + 8) * 64 + vtr_off);
                    const bf16x8 a0 = __builtin_shufflevector(a0l, a0h, 0, 1, 2, 3, 4, 5, 6, 7), a1 = __builtin_shufflevector(a1l, a1h, 0, 1, 2, 3, 4, 5, 6, 7);
                    o0 = __builtin_amdgcn_mfma_f32_32x32x16_bf16(a0, pf[kk], o0, 0, 0, 0);
                    o1 = __builtin_amdgcn_mfma_f32_32x32x16_bf16(a1, pf[kk], o1, 0, 0, 0);
                }
            }
            if (i + 1 < ntile) {
                LAS unsigned char* nb = lds + ((i + 1) & 1) * AT_BUF;
                *(LAS u32x4*)(nb + srow * 144 + sch * 16) = kW;
                *(LAS u32x4*)(nb + AT_KB + (sch >> 2) * 4096 + srow * 64 + (sch & 3) * 16) = vW;
            }
            __syncthreads();
        };
        for (int i = 0; i < ntile; i += 2) { tile_step(i, kA, vA, kB, vB); tile_step(i + 1, kB, vB, kA, vA); }
        l = swap32_add(l, l);
        const float inv = 1.f / l;
        bf16* op = O + tq * DM + hd * 64 + 4 * h;
#pragma unroll
        for (int g = 0; g < 4; ++g) {
            *(u32x2*)(op + 8 * g) = (u32x2){cvtpk(o0[4 * g] * inv, o0[4 * g + 1] * inv), cvtpk(o0[4 * g + 2] * inv, o0[4 * g + 3] * inv)};
            *(u32x2*)(op + 32 + 8 * g) = (u32x2){cvtpk(o1[4 * g] * inv, o1[4 * g + 1] * inv), cvtpk(o1[4 * g + 2] * inv, o1[4 * g + 3] * inv)};
        }
    }
    __syncthreads();
}

constexpr int RT_Q = 0, RT_K = 9216, RT_KD = 18432, RT_V = 26624, RT_BUF = 34816, RT_ZS = 2 * RT_BUF, RT_CS = RT_ZS + 64 * 66 * 4;
DI void ret_item(Frame& F, const int it) {
    FRAME_IDS;
    const bf16* R = (const bf16*)(F.ws + WS_R); bf16* O = (bf16*)(F.ws + WS_O);
    LAS unsigned char* lds = F.lds;
    LAS float* Zs = (LAS float*)(lds + RT_ZS); LAS float* Cs = (LAS float*)(lds + RT_CS);
    const int b = it / NHB, hd = it % NHB;
    const int q32 = f_lane & 31, h = f_lane >> 5, w = F.wave;
    const int role = w >> 2, itile = (w >> 1) & 1, etile = w & 1;
    const int srow = f_tid >> 3, sch = f_tid & 7;
    const int vtr_off = ((f_lane & 15) >> 2) * 64 + (16 * ((f_lane >> 4) & 1) + 4 * (f_lane & 3)) * 2;
    const float l2g = log2f(gamma_of(hd));
    const float cd = exp2f(l2g * 64.f), sdec = exp2f(l2g * (float)(63 - srow));
    float qdv[16];
#pragma unroll
    for (int r = 0; r < 16; ++r) qdv[r] = exp2f(l2g * (float)(32 * itile + crow(r, h) + 1));
    f32x16 xs0 = {}, xs1 = {};
    const size_t trow0 = (size_t)b * SEQ;
    const bf16* gq = R + (trow0 + srow) * INC + hd * 64 + 8 * sch;
    u32x4 qreg = *(const u32x4*)(gq + C_QB), kreg = *(const u32x4*)(gq + C_KB), vreg = *(const u32x4*)(gq + C_VB);
    __syncthreads();
#define RT_STAGE(bufp) do { LAS unsigned char* bp_ = (bufp); \
        *(LAS u32x4*)(bp_ + RT_Q + srow * 144 + sch * 16) = qreg; *(LAS u32x4*)(bp_ + RT_K + srow * 144 + sch * 16) = kreg; \
        *(LAS u32x4*)(bp_ + RT_V + (sch >> 2) * 4096 + srow * 64 + (sch & 3) * 16) = vreg; \
        u32x4 kd_; \
        _Pragma("unroll") for (int e_ = 0; e_ < 4; ++e_) kd_[e_] = cvtpk(__uint_as_float(kreg[e_] << 16) * sdec, __uint_as_float(kreg[e_] & 0xffff0000u) * sdec); \
        *(LAS u32x4*)(bp_ + RT_KD + (sch >> 2) * 4096 + srow * 64 + (sch & 3) * 16) = kd_; } while (0)
    RT_STAGE(lds);
    __syncthreads();
    for (int n = 0; n < NCH; ++n) {
        LAS unsigned char* bp = lds + (n & 1) * RT_BUF;
        if (n + 1 < NCH) { const bf16* g1 = gq + (size_t)(n + 1) * 64 * INC; qreg = *(const u32x4*)(g1 + C_QB); kreg = *(const u32x4*)(g1 + C_KB); vreg = *(const u32x4*)(g1 + C_VB); }
        unsigned short gr[8];
#pragma unroll
        for (int r = 0; r < 8; ++r) gr[r] = R[(trow0 + n * 64 + 8 * w + r) * INC + C_GB + hd * 64 + f_lane];
        if (role == 0) {
            bf16x8 qf[4];
#pragma unroll
            for (int ks = 0; ks < 4; ++ks) qf[ks] = *(const LAS bf16x8*)(bp + RT_Q + (32 * itile + q32) * 144 + (16 * ks + 8 * h) * 2);
            f32x16 st0 = {}, st1 = {};
#pragma unroll
            for (int ks = 0; ks < 4; ++ks) {
                const bf16x8 k0 = *(const LAS bf16x8*)(bp + RT_K + q32 * 144 + (16 * ks + 8 * h) * 2);
                const bf16x8 k1 = *(const LAS bf16x8*)(bp + RT_K + (32 + q32) * 144 + (16 * ks + 8 * h) * 2);
                st0 = __builtin_amdgcn_mfma_f32_32x32x16_bf16(k0, qf[ks], st0, 0, 0, 0);
                st1 = __builtin_amdgcn_mfma_f32_32x32x16_bf16(k1, qf[ks], st1, 0, 0, 0);
            }
            int iiv = 32 * itile + q32 - 4 * h; asm volatile("" : "+v"(iiv));
#pragma unroll
            for (int r = 0; r < 16; ++r) {
                const int dd = iiv - ((r & 3) + 8 * (r >> 2));
                st0[r] *= __builtin_amdgcn_exp2f(l2g * fabsf((float)dd));
                st1[r] *= __builtin_amdgcn_exp2f(l2g * fabsf((float)(dd - 32)));
            }
            f32x16 z = {};
#pragma unroll
            for (int kk = 0; kk < 4; ++kk) {
                const int key0 = 16 * kk + 4 * h;
                const v4i16 bl = ds_tr16(bp + RT_V + etile * 4096 + key0 * 64 + vtr_off), bh = ds_tr16(bp + RT_V + etile * 4096 + (key0 + 8) * 64 + vtr_off);
                const bf16x8 vb = __builtin_shufflevector(bl, bh, 0, 1, 2, 3, 4, 5, 6, 7);
                const bf16x8 xa = (kk < 2) ? pack_step(st0, kk & 1) : pack_step(st1, kk & 1);
                z = __builtin_amdgcn_mfma_f32_32x32x16_bf16(xa, vb, z, 0, 0, 0);
            }
            int zb = (32 * itile + 4 * h) * 66 + 32 * etile + q32; asm volatile("" : "+v"(zb));
#pragma unroll
            for (int r = 0; r < 16; ++r) Zs[zb + ((r & 3) + 8 * (r >> 2)) * 66] = z[r];
        } else {
            f32x16 cr = {};
#pragma unroll
            for (int kk = 0; kk < 4; ++kk) {
                const LAS unsigned char* qp = bp + RT_Q + (32 * itile + q32) * 144 + (16 * kk + 4 * h) * 2;
                const v4i16 al = *(const LAS v4i16*)qp, ah = *(const LAS v4i16*)(qp + 16);
                const bf16x8 qa = __builtin_shufflevector(al, ah, 0, 1, 2, 3, 4, 5, 6, 7);
                const bf16x8 xb = (kk < 2) ? pack_step(xs0, kk & 1) : pack_step(xs1, kk & 1);
                cr = __builtin_amdgcn_mfma_f32_32x32x16_bf16(qa, xb, cr, 0, 0, 0);
            }
            int cb = (32 * itile + 4 * h) * 66 + 32 * etile + q32; asm volatile("" : "+v"(cb));
#pragma unroll
            for (int r = 0; r < 16; ++r) Cs[cb + ((r & 3) + 8 * (r >> 2)) * 66] = cr[r] * qdv[r];
#pragma unroll
            for (int r = 0; r < 16; ++r) { xs0[r] *= cd; xs1[r] *= cd; }
#pragma unroll
            for (int s4 = 0; s4 < 4; ++s4) {
                const int key0 = 16 * s4 + 8 * h;
                const v4i16 vl = ds_tr16(bp + RT_V + etile * 4096 + key0 * 64 + vtr_off), vh = ds_tr16(bp + RT_V + etile * 4096 + (key0 + 4) * 64 + vtr_off);
                const bf16x8 vb = __builtin_shufflevector(vl, vh, 0, 1, 2, 3, 4, 5, 6, 7);
                const v4i16 a0l = ds_tr16(bp + RT_KD + key0 * 64 + vtr_off), a0h = ds_tr16(bp + RT_KD + (key0 + 4) * 64 + vtr_off);
                const v4i16 a1l = ds_tr16(bp + RT_KD + 4096 + key0 * 64 + vtr_off), a1h = ds_tr16(bp + RT_KD + 4096 + (key0 + 4) * 64 + vtr_off);
                const bf16x8 ka0 = __builtin_shufflevector(a0l, a0h, 0, 1, 2, 3, 4, 5, 6, 7), ka1 = __builtin_shufflevector(a1l, a1h, 0, 1, 2, 3, 4, 5, 6, 7);
                xs0 = __builtin_amdgcn_mfma_f32_32x32x16_bf16(ka0, vb, xs0, 0, 0, 0);
                xs1 = __builtin_amdgcn_mfma_f32_32x32x16_bf16(ka1, vb, xs1, 0, 0, 0);
            }
        }
        __syncthreads();
#pragma unroll
        for (int r = 0; r < 8; ++r) {
            const int i = 8 * w + r;
            const float v = Zs[i * 66 + f_lane] + Cs[i * 66 + f_lane];
            const float mu = wave_sum(v) * (1.f / 64.f);
            const float dv = v - mu;
            const float var = wave_sum(dv * dv) * (1.f / 64.f);
            const float g = bf2f(gr[r]);
            O[(trow0 + n * 64 + i) * DM + 512 + hd * 64 + f_lane] = (bf16)f2bf(dv * (1.f / sqrtf(var + EPS)) * (g / (1.f + __expf(-g))));
        }
        if (n + 1 < NCH) RT_STAGE(lds + ((n + 1) & 1) * RT_BUF);
        __syncthreads();
    }
#undef RT_STAGE
}
DI float max3_abs(const float a, const float x, const float y) { float r; asm("v_max3_f32 %0, %1, |%2|, |%3|" : "=v"(r) : "v"(a), "v"(x), "v"(y)); return r; }
DI void int8_rows(Frame& F, const int row0, const int nrows, const int f_lane) {
    const int tab = row0 / PE, e0 = row0 % PE, layer = tab & 1, isv = tab >> 1;
    f32x4 gn[4];
    { const f32x4* gp = (const f32x4*)(F.ffn_norm + layer * DM) + f_lane;
#pragma unroll
      for (int j = 0; j < 4; ++j) gn[j] = isv ? (f32x4){1.f, 1.f, 1.f, 1.f} : gp[64 * j]; }
    const f32x4* src = (const f32x4*)((isv ? F.peer_v : F.peer_u) + ((size_t)layer * PE + e0) * DM) + f_lane;
    unsigned* dst = (unsigned*)(F.ws + (isv ? WS_V8 : WS_U8)) + (size_t)layer * 4 * PE * 32 + (size_t)e0 * 32 + (f_lane >> 1);
    float* scp = (float*)(F.ws + WS_SC) + tab * PE + e0;
    const unsigned xmask = (isv && !(f_lane & 1)) ? 0u : 0x08080808u;
    const int sh = (f_lane & 1) * 4;
    const float scmul = isv ? (1.f / 16.f) : 1.f;
    f32x4 A[4][4], B[4][4];
#define Q4_LOAD(D, r) do { _Pragma("unroll") for (int u_ = 0; u_ < 4; ++u_) _Pragma("unroll") for (int j_ = 0; j_ < 4; ++j_) D[u_][j_] = src[(size_t)((r) + u_) * 256 + 64 * j_]; } while (0)
#define Q4_PROC(D, r) do { _Pragma("unroll") for (int u_ = 0; u_ < 4; ++u_) { \
        float a_ = 0.f; f32x4 sq_ = {0.f, 0.f, 0.f, 0.f}; \
        _Pragma("unroll") for (int j_ = 0; j_ < 4; ++j_) { D[u_][j_] = D[u_][j_] * gn[j_]; a_ = max3_abs(max3_abs(a_, D[u_][j_][0], D[u_][j_][1]), D[u_][j_][2], D[u_][j_][3]); sq_ += D[u_][j_] * D[u_][j_]; } \
        a_ = wave_max(a_); \
        const float step_ = fminf(0.355f * sqrtf(wave_sum((sq_[0] + sq_[1]) + (sq_[2] + sq_[3])) * (1.f / DM)), a_ * (1.f / 7.f)); \
        const float sc_ = step_ > 0.f ? 1.f / step_ : 0.f; \
        _Pragma("unroll") for (int j_ = 0; j_ < 4; ++j_) {                  \
            const f32x4 t_ = D[u_][j_] * sc_ + 8388616.f;                   \
            const unsigned b0_ = __float_as_uint(__builtin_amdgcn_fmed3f(t_[0], 8388609.f, 8388623.f)), b1_ = __float_as_uint(__builtin_amdgcn_fmed3f(t_[1], 8388609.f, 8388623.f)); \
            const unsigned b2_ = __float_as_uint(__builtin_amdgcn_fmed3f(t_[2], 8388609.f, 8388623.f)), b3_ = __float_as_uint(__builtin_amdgcn_fmed3f(t_[3], 8388609.f, 8388623.f)); \
            unsigned w_ = __builtin_amdgcn_perm(__builtin_amdgcn_perm(b3_, b2_, 0x0c0c0400u), __builtin_amdgcn_perm(b1_, b0_, 0x0c0c0400u), 0x05040100u); \
            w_ = (w_ ^ xmask) << sh; \
            w_ |= (unsigned)DPP_MOV_I((int)w_, DPP_XOR1); \
            if (!(f_lane & 1)) dst[((size_t)j_ * PE + (r) + u_) * 32] = w_; \
        } \
        if (f_lane == 0) scp[(r) + u_] = step_ * scmul; } } while (0)
    Q4_LOAD(A, 0);
    for (int r = 0; r < nrows; r += 8) {
        Q4_LOAD(B, r + 4);
        Q4_PROC(A, r);
        { const int rn = r + 8 < nrows ? r + 8 : r + 4;
          Q4_LOAD(A, rn); }
        Q4_PROC(B, r + 4);
    }
#undef Q4_LOAD
#undef Q4_PROC
}
constexpr int Q8_ITEM_ROWS = 512, Q8_ITEMS = 4 * PE / Q8_ITEM_ROWS;
constexpr int PH_MIX_ID = 3;
DI int attn_order(const int q) { return q < 768 ? (q / 6) * 8 + (q % 6) + 2 : ((q - 768) & 127) * 8 + ((q - 768) < 128 ? 1 : 0); }
constexpr int QG = 2;
DI void mix_phase(Frame& F, const int rep) {
    FRAME_IDS;
    unsigned* ctr = (unsigned*)(F.ws + WS_CTL) + CW_QUEUE + 64 * rep;
    volatile LAS unsigned* slot = (volatile LAS unsigned*)(F.lds + MISC_OFF) + 16;
    constexpr int N_RET = NB * NHB, N_ATT = NB * NHA * 8;
    static_assert(N_ATT == 8 * Q8_ITEMS, "8 attention items per quantisation item");
    for (;;) {
        __syncthreads();
        if (f_tid == 0) slot[0] = __hip_atomic_fetch_add(ctr, 1u, __ATOMIC_RELAXED, __HIP_MEMORY_SCOPE_AGENT);
        __syncthreads();
        const int idx = (int)slot[0];
        if (idx >= N_RET + N_ATT + Q8_ITEMS) break;
        const bool probe_pass = (REP_PHASE == PH_MIX_ID && rep == 0);
        if (idx < N_RET) { if (!(probe_pass && PROBE_MODE >= 4)) ret_item(F, idx); }
        else if (probe_pass && PROBE_MODE == 3) { }
        else { const int k = idx - N_RET;
            if (k < QG * Q8_ITEMS) { const int grp = k / QG, pos = k % QG;
                if (pos == QG - 1) { if (!(probe_pass && PROBE_MODE == 5)) int8_rows(F, grp * Q8_ITEM_ROWS + F.wave * 64, 64, f_lane); }
                else if (!(probe_pass && PROBE_MODE == 6)) attn_item(F, attn_order((QG - 1) * grp + pos)); }
            else if (!(probe_pass && PROBE_MODE == 6)) attn_item(F, attn_order(k - Q8_ITEMS)); }
    }
}
DI float fmax_raw(float a, float b) { float r; asm("v_max_f32_e32 %0, %1, %2" : "=v"(r) : "v"(a), "v"(b)); return r; }
DI float fmin_raw(float a, float b) { float r; asm("v_min_f32_e32 %0, %1, %2" : "=v"(r) : "v"(a), "v"(b)); return r; }
#define CE_DESC(x, y) do { const float hi_ = fmax_raw((x), (y)), lo_ = fmin_raw((x), (y)); (x) = hi_; (y) = lo_; } while (0)
template <int N> DI void sort_desc(float* v) {
#pragma unroll
    for (int k = 2; k <= N; k <<= 1)
#pragma unroll
        for (int j = k >> 1; j > 0; j >>= 1)
#pragma unroll
            for (int i = 0; i < N; ++i) { const int l = i ^ j; if (l > i) { if ((i & k) == 0 || k == N) CE_DESC(v[i], v[l]); else CE_DESC(v[l], v[i]); } }
}
DI void merge16(float* a, const float* b) {
#pragma unroll
    for (int i = 0; i < 16; ++i) a[i] = fmax_raw(a[i], b[15 - i]);
#pragma unroll
    for (int j = 8; j > 0; j >>= 1)
#pragma unroll
        for (int i = 0; i < 16; ++i) { const int l = i ^ j; if (l > i) CE_DESC(a[i], a[l]); }
}
DI void sort16n(float* v) {
    CE_DESC(v[0], v[13]); CE_DESC(v[1], v[12]); CE_DESC(v[2], v[15]); CE_DESC(v[3], v[14]); CE_DESC(v[4], v[8]); CE_DESC(v[5], v[6]); CE_DESC(v[7], v[11]); CE_DESC(v[9], v[10]);
    CE_DESC(v[0], v[5]); CE_DESC(v[1], v[7]); CE_DESC(v[2], v[9]); CE_DESC(v[3], v[4]); CE_DESC(v[6], v[13]); CE_DESC(v[8], v[14]); CE_DESC(v[10], v[15]); CE_DESC(v[11], v[12]);
    CE_DESC(v[0], v[1]); CE_DESC(v[2], v[3]); CE_DESC(v[4], v[5]); CE_DESC(v[6], v[8]); CE_DESC(v[7], v[9]); CE_DESC(v[10], v[11]); CE_DESC(v[12], v[13]); CE_DESC(v[14], v[15]);
    CE_DESC(v[0], v[2]); CE_DESC(v[1], v[3]); CE_DESC(v[4], v[10]); CE_DESC(v[5], v[11]); CE_DESC(v[6], v[7]); CE_DESC(v[8], v[9]); CE_DESC(v[12], v[14]); CE_DESC(v[13], v[15]);
    CE_DESC(v[1], v[2]); CE_DESC(v[3], v[12]); CE_DESC(v[4], v[6]); CE_DESC(v[5], v[7]); CE_DESC(v[8], v[10]); CE_DESC(v[9], v[11]); CE_DESC(v[13], v[14]);
    CE_DESC(v[1], v[4]); CE_DESC(v[2], v[6]); CE_DESC(v[5], v[8]); CE_DESC(v[7], v[10]); CE_DESC(v[9], v[13]); CE_DESC(v[11], v[14]);
    CE_DESC(v[2], v[4]); CE_DESC(v[3], v[6]); CE_DESC(v[9], v[12]); CE_DESC(v[11], v[13]);
    CE_DESC(v[3], v[5]); CE_DESC(v[6], v[8]); CE_DESC(v[7], v[9]); CE_DESC(v[10], v[12]);
    CE_DESC(v[3], v[4]); CE_DESC(v[5], v[6]); CE_DESC(v[7], v[8]); CE_DESC(v[9], v[10]); CE_DESC(v[11], v[12]);
    CE_DESC(v[6], v[7]); CE_DESC(v[8], v[9]);
}
DI void bitonic16(float* a) {
#pragma unroll
    for (int j = 8; j > 0; j >>= 1)
#pragma unroll
        for (int i = 0; i < 16; ++i) { const int l = i ^ j; if (l > i) CE_DESC(a[i], a[l]); }
}
DI float key_pack(float v, unsigned keep_mask, unsigned idx) { return __uint_as_float((__float_as_uint(v) & keep_mask) | idx); }
DI void opt_route(Frame& F, int layer) {
    FRAME_IDS;
    const bf16* Q = (const bf16*)(F.ws + WS_Q);
    int* eidx = (int*)(F.ws + WS_EIDX); float* gate = (float*)(F.ws + WS_GATE);
    const float* keys = F.peer_keys + (size_t)layer * 2 * PK * 64;
    LAS unsigned char* kl = F.lds;
    __syncthreads();
    for (int idx = f_tid; idx < 2 * PK * 8; idx += NTHR) {
        const int row = idx >> 3, ch = idx & 7;
        const f32x4 a = *(const f32x4*)(keys + (size_t)row * 64 + ch * 8), b = *(const f32x4*)(keys + (size_t)row * 64 + ch * 8 + 4);
        *(LAS u32x4*)(kl + row * 144 + ch * 16) = (u32x4){pk2(a[0], a[1]), pk2(a[2], a[3]), pk2(b[0], b[1]), pk2(b[2], b[3])};
    }
    __syncthreads();
    LAS int* lut = (LAS int*)(F.lds + 40960 + F.wave * 8192);
    const int c = f_lane & 31, h = f_lane >> 5;
    pg8::StaticOrder SO; SO.init(T, DM, F.G, F.bid);
    pg8::Unit un;
    for (int ui = 0; SO.next(ui, un); ++ui)
    for (int k2 = F.wave; k2 < 16; k2 += NWAVES) {
        const int tile = 8 * un.pm + (k2 & 7), hh = 2 * un.pn + (k2 >> 3), t = tile * 32 + c;
        float tk[2][16];
#pragma unroll
        for (int side = 0; side < 2; ++side) {
            bf16x8 qf[4];
#pragma unroll
            for (int ks = 0; ks < 4; ++ks) qf[ks] = *(const bf16x8*)(Q + (size_t)t * DM + hh * PQD + side * 64 + 16 * ks + 8 * h);
            float v[64];
#pragma unroll
            for (int kt = 0; kt < 4; ++kt) {
                f32x16 acc = {};
#pragma unroll
                for (int ks = 0; ks < 4; ++ks) {
                    const bf16x8 a = *(const LAS bf16x8*)(kl + (side * PK + 32 * kt + c) * 144 + (16 * ks + 8 * h) * 2);
                    acc = __builtin_amdgcn_mfma_f32_32x32x16_bf16(a, qf[ks], acc, 0, 0, 0);
                }
#pragma unroll
                for (int r = 0; r < 16; ++r) v[16 * kt + r] = key_pack(acc[r], 0xFFFFFF80u, (unsigned)(32 * kt + (r & 3) + 8 * (r >> 2) + 4 * h));
            }
            sort16n(v); sort16n(v + 16); sort16n(v + 32); sort16n(v + 48);
            merge16(v, v + 16); merge16(v + 32, v + 48); merge16(v, v + 32);
            float pr[16];
#pragma unroll
            for (int i = 0; i < 16; ++i) pr[i] = __shfl_xor(v[i], 32);
            merge16(v, pr);
#pragma unroll
            for (int i = 0; i < 16; ++i) { tk[side][i] = v[i]; lut[(side * 16 + i) * 64 + f_lane] = (int)(__float_as_uint(v[i]) & 0x7Fu); }
        }
#define CAND(a_, b_) key_pack(tk[0][a_] + tk[1][b_], 0xFFFFFF00u, (unsigned)((a_) * 16 + (b_)))
        float cd[16], cy[16], cz[16];
#pragma unroll
        for (int b = 0; b < 16; ++b) cd[b] = CAND(0, b);
#pragma unroll
        for (int b = 0; b < 8; ++b) { cy[b] = CAND(1, b); cy[8 + b] = CAND(15 - b, 0); }
        bitonic16(cy);
        cz[0] = CAND(2, 0); cz[1] = CAND(2, 1); cz[2] = CAND(2, 2); cz[3] = CAND(2, 3); cz[4] = CAND(2, 4); cz[5] = CAND(3, 0); cz[6] = CAND(3, 1); cz[7] = CAND(3, 2); cz[8] = CAND(3, 3);
        cz[9] = CAND(4, 0); cz[10] = CAND(4, 1); cz[11] = CAND(4, 2); cz[12] = CAND(5, 0); cz[13] = CAND(5, 1); cz[14] = CAND(6, 0); cz[15] = CAND(6, 1);
        sort16n(cz);
        cz[15] = fmax_raw(cz[15], CAND(7, 0)); cz[14] = fmax_raw(cz[14], CAND(7, 1));
        bitonic16(cz);
        merge16(cd, cy); merge16(cd, cz);
#undef CAND
        int ex[16]; float gv[16]; float sum = 0.f;
        const float top = __uint_as_float(__float_as_uint(cd[0]) & 0xFFFFFF00u);
#pragma unroll
        for (int i = 0; i < 16; ++i) {
            const unsigned bits = __float_as_uint(cd[i]);
            const int a = (bits >> 4) & 15, b = bits & 15;
            ex[i] = lut[a * 64 + f_lane] * PK + lut[(16 + b) * 64 + f_lane];
            gv[i] = __expf(__uint_as_float(bits & 0xFFFFFF00u) - top); sum += gv[i];
        }
        const float inv = 1.f / sum;
        if (h == 0) {
            u32x4* ep = (u32x4*)(eidx + (size_t)t * NSEL + hh * 16);
#pragma unroll
            for (int q = 0; q < 4; ++q) ep[q] = (u32x4){(unsigned)ex[4 * q], (unsigned)ex[4 * q + 1], (unsigned)ex[4 * q + 2], (unsigned)ex[4 * q + 3]};
        } else {
            f32x4* gp = (f32x4*)(gate + (size_t)t * NSEL + hh * 16);
#pragma unroll
            for (int q = 0; q < 4; ++q) gp[q] = (f32x4){gv[4 * q] * inv, gv[4 * q + 1] * inv, gv[4 * q + 2] * inv, gv[4 * q + 3] * inv};
        }
    }
    __syncthreads();
}
struct XInfo { int xrank, nx, rank, nloc; };
DI XInfo get_xinfo(Frame& F, const bool census) {
    FRAME_IDS;
    volatile LAS unsigned* M = (volatile LAS unsigned*)(F.lds + MISC_OFF);
    __syncthreads();
    if (f_tid == 0) {
        unsigned xr = (unsigned)F.bid & 7u, nx = 8u, rk = (unsigned)F.bid >> 3, nl = ((unsigned)F.G + 7u - ((unsigned)F.bid & 7u)) >> 3;
        if (census) {
            unsigned* bar = (unsigned*)(F.ws + WS_CTL) + CW_BAR; const unsigned x = xb_xcc_id();
            unsigned cnt = 0u, below = 0u, mine = 0u;
#pragma unroll
            for (unsigned j = 0; j < 16; ++j) { const unsigned c = xb_ld(&bar[XB_XCNT(j)]); cnt += (c > 0u); below += (c > 0u && j < x); mine = (j == x) ? c : mine; }
            if (cnt > 0u && mine > 0u) { xr = below; nx = cnt; rk = M[12]; nl = mine; }
        }
        M[20] = xr; M[21] = nx; M[22] = rk; M[23] = nl;
    }
    __syncthreads();
    XInfo xi; xi.xrank = (int)M[20]; xi.nx = (int)M[21]; xi.rank = (int)M[22]; xi.nloc = (int)M[23];
    return xi;
}
DI int comb_c(const int level, const int a, const int b, const int lane) {
    const int M = 4 >> level; const bool bit = (lane & M) != 0;
    const int send = bit ? a : b, keep = bit ? b : a;
    const int recv = level == 0 ? DPP_MOV_I(send, DPP_HMIRROR) : (level == 1 ? DPP_MOV_I(send, DPP_XOR2) : DPP_MOV_I(send, DPP_XOR1));
    return keep + recv;
}
DI int dot16_i8(const u32x4 r, const u32x4 x) {
    int s = __builtin_amdgcn_sdot4((int)r[0], (int)x[0], 0, false);
    s = __builtin_amdgcn_sdot4((int)r[1], (int)x[1], s, false); s = __builtin_amdgcn_sdot4((int)r[2], (int)x[2], s, false); s = __builtin_amdgcn_sdot4((int)r[3], (int)x[3], s, false);
    return s;
}
DI int half_dots(const u32x4 (&rows)[8], const u32x4 xq, const int lane) {
    int p[8];
#pragma unroll
    for (int i = 0; i < 8; ++i) p[i] = dot16_i8(rows[i], xq);
#pragma unroll
    for (int i = 0; i < 4; ++i) p[i] = comb_c(0, p[2 * i], p[2 * i + 1], lane);
    p[0] = comb_c(1, p[0], p[1], lane); p[1] = comb_c(1, p[2], p[3], lane);
    return comb_c(2, p[0], p[1], lane);
}
DI u32x4 xquant(const f32x4 (&hv)[4], const float rstd) {
    u32x4 o;
#pragma unroll
    for (int w = 0; w < 4; ++w) {
        const f32x4 x = hv[w] * (rstd * XQ);
        const int a = (int)rintf(__builtin_amdgcn_fmed3f(x[0], -127.f, 127.f)), b = (int)rintf(__builtin_amdgcn_fmed3f(x[1], -127.f, 127.f)), c = (int)rintf(__builtin_amdgcn_fmed3f(x[2], -127.f, 127.f)), d = (int)rintf(__builtin_amdgcn_fmed3f(x[3], -127.f, 127.f));
        o[w] = ((unsigned)a & 0xFFu) | (((unsigned)b & 0xFFu) << 8) | (((unsigned)c & 0xFFu) << 16) | ((unsigned)d << 24);
    }
    return o;
}
DI float rstd_bcast(const float* part, const int t) {
    const f32x4* p = (const f32x4*)(part + (size_t)t * 16);
    const f32x4 a = p[0], b = p[1], c = p[2], d = p[3];
    const float s = ((a[0] + a[1]) + (a[2] + a[3])) + ((b[0] + b[1]) + (b[2] + b[3])) + ((c[0] + c[1]) + (c[2] + c[3])) + ((d[0] + d[1]) + (d[2] + d[3]));
    return 1.f / sqrtf(s * (1.f / DM) + EPS);
}
DI int dot32_i4(const u32x4 r, const u32x4 xh, const u32x4 xl) {
    int ah = 0, al = 0;
#pragma unroll
    for (int d = 0; d < 4; ++d) { ah = __builtin_amdgcn_sdot8((int)r[d], (int)xh[d], ah, false); al = __builtin_amdgcn_sdot8((int)r[d], (int)xl[d], al, false); }
    return (ah << 4) + al;
}
DI int half_dots4(const u32x4 (&rows)[8], const u32x4 xa, const u32x4 xb, const int lane) {
    int p[8];
#pragma unroll
    for (int i = 0; i < 8; ++i) p[i] = dot32_i4(rows[i], xa, xb);
#pragma unroll
    for (int i = 0; i < 4; ++i) p[i] = comb_c(0, p[2 * i], p[2 * i + 1], lane);
    p[0] = comb_c(1, p[0], p[1], lane); p[1] = comb_c(1, p[2], p[3], lane);
    return comb_c(2, p[0], p[1], lane);
}
DI void gather_u(Frame& F, const int layer, const XInfo xi, const bool dry) {
    FRAME_IDS;
    const unsigned emask = (dry && PROBE_MODE == 2) ? 15u : ((dry && PROBE_MODE == 5) ? 4095u : 0xFFFFFFFFu);
    const int* eidx = (const int*)(F.ws + WS_EIDX); int* PU = (int*)(F.ws + (dry ? WS_R : WS_PU)); const float* part = (const float*)(F.ws + WS_PART); const bf16* hbp = (const bf16*)(F.ws + WS_XB);
    const int g = f_lane >> 3, c = f_lane & 7, c16 = c * 16;
    const int kst = 16 * g + (((c & 1) << 2) | (c & 2) | ((c & 4) >> 2));
    const int gwl = xi.rank * NWAVES + F.wave, NGWL = xi.nloc * NWAVES;
    LAS unsigned char* wl = F.lds + F.wave * 2048;
    __syncthreads();
    for (int j = xi.xrank; j < 8; j += xi.nx) {
        const int sl = j & 3, th = j >> 2;
        const __amdgpu_buffer_rsrc_t U8 = __builtin_amdgcn_make_buffer_rsrc((void*)(F.ws + WS_U8 + ((size_t)(layer * 4 + sl) * PE) * 128), 0, PE * 128, 0x00020000);
        int tt = gwl;
        if (tt >= T / 2) continue;
#define TOK(x_) (2 * (x_) + th)
#define U_LOAD(tk, ri, rh, rp) do { ri = *(const u32x2*)(eidx + (size_t)(tk) * NSEL + 2 * f_lane) & emask; rh = *(const u32x2*)(hbp + (size_t)(tk) * DM + 256 * sl + 4 * f_lane); \
            rp = part[(size_t)(tk) * 16 + (f_lane & 15)]; } while (0)
#define U_SPREAD(slot, ri, rh, rp, e, xa_, xb_) do { \
            float ps_ = rp; ps_ += __int_as_float(DPP_MOV_I(__float_as_int(ps_), DPP_XOR1)); ps_ += __int_as_float(DPP_MOV_I(__float_as_int(ps_), DPP_XOR2)); ps_ += __int_as_float(DPP_MOV_I(__float_as_int(ps_), DPP_HMIRROR)); ps_ += __int_as_float(DPP_MOV_I(__float_as_int(ps_), DPP_ROR8)); \
            const float rs_ = (1.f / sqrtf(ps_ * (1.f / DM) + EPS)) * XQ; \
            const int q0_ = (int)rintf(__builtin_amdgcn_fmed3f(__uint_as_float(rh[0] << 16) * rs_, -119.f, 119.f)), q1_ = (int)rintf(__builtin_amdgcn_fmed3f(__uint_as_float(rh[0] & 0xffff0000u) * rs_, -119.f, 119.f)); \
            const int q2_ = (int)rintf(__builtin_amdgcn_fmed3f(__uint_as_float(rh[1] << 16) * rs_, -119.f, 119.f)), q3_ = (int)rintf(__builtin_amdgcn_fmed3f(__uint_as_float(rh[1] & 0xffff0000u) * rs_, -119.f, 119.f)); \
            const int h0_ = (q0_ + 8) >> 4, h1_ = (q1_ + 8) >> 4, h2_ = (q2_ + 8) >> 4, h3_ = (q3_ + 8) >> 4;     \
            unsigned wh_ = ((unsigned)h0_ & 0xFu) | (((unsigned)h1_ & 0xFu) << 8) | (((unsigned)h2_ & 0xFu) << 16) | (((unsigned)h3_ & 0xFu) << 24); \
            unsigned wl_ = ((unsigned)(q0_ - 16 * h0_) & 0xFu) | (((unsigned)(q1_ - 16 * h1_) & 0xFu) << 8) | (((unsigned)(q2_ - 16 * h2_) & 0xFu) << 16) | (((unsigned)(q3_ - 16 * h3_) & 0xFu) << 24); \
            if (f_lane & 1) { wh_ <<= 4; wl_ <<= 4; } \
            wh_ |= (unsigned)DPP_MOV_I((int)wh_, DPP_XOR1); wl_ |= (unsigned)DPP_MOV_I((int)wl_, DPP_XOR1); \
            LAS unsigned char* sl_ = wl + (slot) * 1024; \
            *(LAS u32x2*)(sl_ + 8 * f_lane) = ri; if (!(f_lane & 1)) { *(LAS unsigned*)(sl_ + 512 + 2 * f_lane) = wh_; *(LAS unsigned*)(sl_ + 768 + 2 * f_lane) = wl_; } \
            asm volatile("s_waitcnt lgkmcnt(0)" ::: "memory"); \
            _Pragma("unroll") for (int q_ = 0; q_ < 4; ++q_) e[q_] = *(const LAS u32x4*)(sl_ + 64 * g + 16 * q_); \
            xa_ = *(const LAS u32x4*)(sl_ + 512 + 16 * c); xb_ = *(const LAS u32x4*)(sl_ + 768 + 16 * c); } while (0)
        u32x2 ri, rh; float rp;
        u32x4 e0[4], e1[4], xa, xb, xa1, xb1;
        U_LOAD(TOK(tt), ri, rh, rp); U_SPREAD(0, ri, rh, rp, e0, xa, xb);
        { const int t1 = (tt + NGWL < T / 2) ? tt + NGWL : tt; U_LOAD(TOK(t1), ri, rh, rp); U_SPREAD(1, ri, rh, rp, e1, xa1, xb1); }
        { const int t2 = (tt + 2 * NGWL < T / 2) ? tt + 2 * NGWL : tt; U_LOAD(TOK(t2), ri, rh, rp); }
        u32x4 A0[8], B0[8], A1[8], B1[8];
#pragma unroll
        for (int i = 0; i < 8; ++i) A0[i] = __builtin_amdgcn_raw_buffer_load_b128(U8, (int)e0[i >> 2][i & 3] * 128 + c16, 0, 0);
#pragma unroll
        for (int i = 0; i < 8; ++i) B0[i] = __builtin_amdgcn_raw_buffer_load_b128(U8, (int)e0[2 + (i >> 2)][i & 3] * 128 + c16, 0, 0);
#define U_ITEM(CA, CB, NA, NB, slot) do { \
            __builtin_amdgcn_sched_barrier(0); \
            _Pragma("unroll") for (int i = 0; i < 8; ++i) NA[i] = __builtin_amdgcn_raw_buffer_load_b128(U8, (int)e1[i >> 2][i & 3] * 128 + c16, 0, 0); \
            __builtin_amdgcn_sched_barrier(0); \
            const int r0 = half_dots4(CA, xa, xb, f_lane); \
            __builtin_amdgcn_sched_barrier(0); \
            _Pragma("unroll") for (int i = 0; i < 8; ++i) NB[i] = __builtin_amdgcn_raw_buffer_load_b128(U8, (int)e1[2 + (i >> 2)][i & 3] * 128 + c16, 0, 0); \
            __builtin_amdgcn_sched_barrier(0); \
            const int rr1 = half_dots4(CB, xa, xb, f_lane); \
            int* pp = PU + ((size_t)TOK(tt) * 4 + sl) * NSEL + kst; \
            pp[0] = r0; pp[8] = rr1; \
            xa = xa1; xb = xb1; \
            U_SPREAD(slot, ri, rh, rp, e1, xa1, xb1);                   \
            { const int t3 = (tt + 3 * NGWL < T / 2) ? tt + 3 * NGWL : tt; U_LOAD(TOK(t3), ri, rh, rp); } } while (0)
        while (tt + NGWL < T / 2) {
            U_ITEM(A0, B0, A1, B1, 0); tt += NGWL;
            U_ITEM(A1, B1, A0, B0, 1); tt += NGWL;
        }
        if (tt < T / 2) { U_ITEM(A0, B0, A1, B1, 0); }
#undef U_ITEM
#undef U_LOAD
#undef U_SPREAD
#undef TOK
    }
    __syncthreads();
}
DI void gather_r(Frame& F, const int layer) {
    FRAME_IDS;
    const int* PU = (const int*)(F.ws + WS_PU); const float* gate = (const float*)(F.ws + WS_GATE); const int* eidx = (const int*)(F.ws + WS_EIDX);
    const float* SCu = (const float*)(F.ws + WS_SC) + (size_t)layer * PE; const float* SCv = (const float*)(F.ws + WS_SC) + (size_t)(2 + layer) * PE;
    signed char* A8 = (signed char*)(F.ws + WS_A); float* SA = (float*)(F.ws + WS_SA);
    const int gw = F.bid * NWAVES + F.wave, NGW = F.G * NWAVES;
    for (int t = gw; t < T; t += NGW) {
        float a[2];
#pragma unroll
        for (int hf = 0; hf < 2; ++hf) {
            const int k = 64 * hf + f_lane;
            int sacc = 0;
#pragma unroll
            for (int j = 0; j < 4; ++j) sacc += PU[((size_t)t * 4 + j) * NSEL + k];
            const int e = eidx[(size_t)t * NSEL + k];
            const float d = (float)sacc * (SCu[e] * (1.f / XQ));
            a[hf] = gelu_erf(d) * gate[(size_t)t * NSEL + k] * SCv[e];
        }
        const float am = wave_max(fmaxf(fabsf(a[0]), fabsf(a[1])));
        const float sc = am > 0.f ? 127.f / am : 0.f;
        A8[(size_t)t * NSEL + f_lane] = (signed char)(int)rintf(a[0] * sc);
        A8[(size_t)t * NSEL + 64 + f_lane] = (signed char)(int)rintf(a[1] * sc);
        if (f_lane == 0) SA[t] = am * (1.f / 127.f);
    }
}
DI void tr4x4(const unsigned w0, const unsigned w1, const unsigned w2, const unsigned w3, unsigned (&cdw)[4]) {
    const unsigned t01l = __builtin_amdgcn_perm(w1, w0, 0x05010400u), t01h = __builtin_amdgcn_perm(w1, w0, 0x07030602u);
    const unsigned t23l = __builtin_amdgcn_perm(w3, w2, 0x05010400u), t23h = __builtin_amdgcn_perm(w3, w2, 0x07030602u);
    cdw[0] = __builtin_amdgcn_perm(t23l, t01l, 0x05040100u); cdw[1] = __builtin_amdgcn_perm(t23l, t01l, 0x07060302u);
    cdw[2] = __builtin_amdgcn_perm(t23h, t01h, 0x05040100u); cdw[3] = __builtin_amdgcn_perm(t23h, t01h, 0x07060302u);
}
DI void axpy4rows(const u32x4 r0, const u32x4 r1, const u32x4 r2, const u32x4 r3, const unsigned a4, int (&ahi)[16], int (&aall)[16]) {
#pragma unroll
    for (int d = 0; d < 4; ++d) {
        unsigned cdw[4];
        tr4x4(r0[d], r1[d], r2[d], r3[d], cdw);
#pragma unroll
        for (int b = 0; b < 4; ++b) {
            aall[4 * d + b] = __builtin_amdgcn_sdot4((int)cdw[b], (int)a4, aall[4 * d + b], false);
            ahi[4 * d + b] = __builtin_amdgcn_sdot4((int)(cdw[b] & 0xF0F0F0F0u), (int)a4, ahi[4 * d + b], false);
        }
    }
}
DI void gather_v(Frame& F, const int layer, const XInfo xi, const bool dry) {
    FRAME_IDS;
    const int* eidx = (const int*)(F.ws + WS_EIDX); const unsigned char* A8 = F.ws + WS_A; const float* SA = (const float*)(F.ws + WS_SA);
    float* part_w = dry ? (float*)(F.ws + WS_R) : (float*)(F.ws + WS_PART); bf16* hb_w = dry ? (bf16*)(F.ws + WS_HID2) : (bf16*)(F.ws + WS_XB); const bf16* hbp = (const bf16*)(F.ws + WS_XB);
    const int g = f_lane >> 3, c = f_lane & 7, c16 = c * 16;
    const int cc = 32 * c + 16 * (g >> 2) + 8 * ((g >> 1) & 1) + 4 * (g & 1);
    const int gwl = xi.rank * NWAVES + F.wave, NGWL = xi.nloc * NWAVES;
    const bool b3 = (f_lane & 8) != 0;
    LAS unsigned char* wl = F.lds + F.wave * 2048;
    __syncthreads();
    for (int j = xi.xrank; j < 8; j += xi.nx) {
        const int sl = j & 3, th = j >> 2;
        const __amdgpu_buffer_rsrc_t V8 = __builtin_amdgcn_make_buffer_rsrc((void*)(F.ws + WS_V8 + ((size_t)(layer * 4 + sl) * PE) * 128), 0, PE * 128, 0x00020000);
        int tt = gwl;
        if (tt >= T / 2) continue;
#define TOK(x_) (2 * (x_) + th)
#define V_LOAD(tk, ri, ra, rs) do { ri = *(const u32x2*)(eidx + (size_t)(tk) * NSEL + 2 * f_lane); ra = *(const unsigned short*)(A8 + (size_t)(tk) * NSEL + 2 * f_lane); rs = SA[(tk)]; } while (0)
#define V_SPREAD(slot, ri, ra, rs, e, avv, sav) do { \
            LAS unsigned char* sl_ = wl + (slot) * 1024; \
            *(LAS u32x2*)(sl_ + 8 * f_lane) = ri; *(LAS unsigned short*)(sl_ + 512 + 2 * f_lane) = ra; \
            asm volatile("s_waitcnt lgkmcnt(0)" ::: "memory"); \
            _Pragma("unroll") for (int q_ = 0; q_ < 4; ++q_) e[q_] = *(const LAS u32x4*)(sl_ + 64 * g + 16 * q_); \
            avv = *(const LAS u32x4*)(sl_ + 512 + 16 * g); sav = rs; } while (0)
        u32x2 ri; unsigned short ra; float rs;
        u32x4 e0[4], e1[4], av, a1; float sa, sa1; u32x2 hold;
        V_LOAD(TOK(tt), ri, ra, rs); V_SPREAD(0, ri, ra, rs, e0, av, sa);
        { const int t1 = (tt + NGWL < T / 2) ? tt + NGWL : tt; V_LOAD(TOK(t1), ri, ra, rs); V_SPREAD(1, ri, ra, rs, e1, a1, sa1); }
        { const int t2 = (tt + 2 * NGWL < T / 2) ? tt + 2 * NGWL : tt; V_LOAD(TOK(t2), ri, ra, rs); }
        hold = *(const u32x2*)(hbp + (size_t)TOK(tt) * DM + 256 * sl + cc);
        u32x4 A0[8], B0[8], A1[8], B1[8];
#pragma unroll
        for (int i = 0; i < 8; ++i) A0[i] = __builtin_amdgcn_raw_buffer_load_b128(V8, (int)e0[i >> 2][i & 3] * 128 + c16, 0, 0);
#pragma unroll
        for (int i = 0; i < 8; ++i) B0[i] = __builtin_amdgcn_raw_buffer_load_b128(V8, (int)e0[2 + (i >> 2)][i & 3] * 128 + c16, 0, 0);
#define V_ITEM(CA, CB, NA, NB, slot) do { \
            const int t1 = (tt + NGWL < T / 2) ? tt + NGWL : tt; \
            const u32x2 hold1 = *(const u32x2*)(hbp + (size_t)TOK(t1) * DM + 256 * sl + cc); \
            __builtin_amdgcn_sched_barrier(0);                          \
            _Pragma("unroll") for (int i = 0; i < 8; ++i) NA[i] = __builtin_amdgcn_raw_buffer_load_b128(V8, (int)e1[i >> 2][i & 3] * 128 + c16, 0, 0); \
            __builtin_amdgcn_sched_barrier(0); \
            int ahi[16], aall[16]; \
            _Pragma("unroll") for (int n = 0; n < 16; ++n) { ahi[n] = 0; aall[n] = 0; } \
            axpy4rows(CA[0], CA[1], CA[2], CA[3], av[0], ahi, aall); axpy4rows(CA[4], CA[5], CA[6], CA[7], av[1], ahi, aall); \
            __builtin_amdgcn_sched_barrier(0); \
            _Pragma("unroll") for (int i = 0; i < 8; ++i) NB[i] = __builtin_amdgcn_raw_buffer_load_b128(V8, (int)e1[2 + (i >> 2)][i & 3] * 128 + c16, 0, 0); \
            __builtin_amdgcn_sched_barrier(0); \
            axpy4rows(CB[0], CB[1], CB[2], CB[3], av[2], ahi, aall); axpy4rows(CB[4], CB[5], CB[6], CB[7], av[3], ahi, aall); \
            int sa8 = __builtin_amdgcn_sdot4(0x01010101, (int)av[0], 0, false); sa8 = __builtin_amdgcn_sdot4(0x01010101, (int)av[1], sa8, false); sa8 = __builtin_amdgcn_sdot4(0x01010101, (int)av[2], sa8, false); sa8 = __builtin_amdgcn_sdot4(0x01010101, (int)av[3], sa8, false); \
            sa8 *= 8; \
            int acc[32];                                                \
            _Pragma("unroll") for (int d_ = 0; d_ < 4; ++d_) _Pragma("unroll") for (int b_ = 0; b_ < 4; ++b_) { acc[8 * d_ + 4 + b_] = ahi[4 * d_ + b_]; acc[8 * d_ + b_] = (aall[4 * d_ + b_] - ahi[4 * d_ + b_] - sa8) << 4; } \
            int r16[16], r8[8]; float hv[4]; \
            _Pragma("unroll") for (int n = 0; n < 16; ++n) r16[n] = swap32_addi(acc[n], acc[16 + n]); \
            _Pragma("unroll") for (int n = 0; n < 8; ++n) r8[n] = swap16_addi(r16[n], r16[8 + n]); \
            _Pragma("unroll") for (int n = 0; n < 4; ++n) { const int keep = b3 ? r8[4 + n] : r8[n], send = b3 ? r8[n] : r8[4 + n]; hv[n] = (float)(keep + DPP_MOV_I(send, DPP_ROR8)) * sa; } \
            hv[0] += __uint_as_float(hold[0] << 16); hv[1] += __uint_as_float(hold[0] & 0xffff0000u); hv[2] += __uint_as_float(hold[1] << 16); hv[3] += __uint_as_float(hold[1] & 0xffff0000u); \
            const float ss = wave_sum_fast((hv[0] * hv[0] + hv[1] * hv[1]) + (hv[2] * hv[2] + hv[3] * hv[3])); \
            *(u32x2*)(hb_w + (size_t)TOK(tt) * DM + 256 * sl + cc) = (u32x2){cvtpk(hv[0], hv[1]), cvtpk(hv[2], hv[3])}; \
            if (f_lane == 0) part_w[(size_t)TOK(tt) * 16 + sl] = ss; \
            if (sl == 0 && f_lane >= 4 && f_lane < 16) part_w[(size_t)TOK(tt) * 16 + f_lane] = 0.f; \
            av = a1; sa = sa1; hold = hold1; \
            V_SPREAD(slot, ri, ra, rs, e1, a1, sa1); \
            { const int t3 = (tt + 3 * NGWL < T / 2) ? tt + 3 * NGWL : tt; V_LOAD(TOK(t3), ri, ra, rs); } } while (0)
        while (tt + NGWL < T / 2) {
            V_ITEM(A0, B0, A1, B1, 0); tt += NGWL;
            V_ITEM(A1, B1, A0, B0, 1); tt += NGWL;
        }
        if (tt < T / 2) { V_ITEM(A0, B0, A1, B1, 0); }
#undef V_ITEM
#undef V_LOAD
#undef V_SPREAD
#undef TOK
    }
    __syncthreads();
}
DI void final_norm(Frame& F) {
    FRAME_IDS;
    const float* part = (const float*)(F.ws + WS_PART); const bf16* hbp = (const bf16*)(F.ws + WS_XB);
    const int gw = F.bid * NWAVES + F.wave, NGW = F.G * NWAVES;
    for (int t = gw; t < T; t += NGW) {
        const float r = rstd_bcast(part, t);
        const u32x2* hp = (const u32x2*)(hbp + (size_t)t * DM) + f_lane;
        f32x4* op = (f32x4*)(F.out + (size_t)t * DM) + f_lane;
        const f32x4* gp = (const f32x4*)F.final_norm + f_lane;
#pragma unroll
        for (int q = 0; q < 4; ++q) { const u32x2 w = hp[64 * q];
            const f32x4 h = {__uint_as_float(w[0] << 16), __uint_as_float(w[0] & 0xffff0000u), __uint_as_float(w[1] << 16), __uint_as_float(w[1] & 0xffff0000u)};
            op[64 * q] = h * r * gp[64 * q]; }
    }
}
DI void opt_conv(Frame& F) {
    FRAME_IDS;
    const bf16* G = (const bf16*)(F.ws + WS_GLU); bf16* H2 = (bf16*)(F.ws + WS_HID2);
    LAS float* ys = (LAS float*)F.lds;
    f32x2 wt[CW];
#pragma unroll
    for (int j = 0; j < CW; ++j) wt[j] = *(const f32x2*)(F.conv_dw + j * DM + 2 * f_tid);
    const f32x2 bdw = *(const f32x2*)(F.conv_dw_b + 2 * f_tid);
    f32x4 lng[4], lnb[4];
#pragma unroll
    for (int k = 0; k < 4; ++k) { lng[k] = *(const f32x4*)(F.conv_ln_g + 256 * k + 4 * f_lane); lnb[k] = *(const f32x4*)(F.conv_ln_b + 256 * k + 4 * f_lane); }
    for (int it = F.bid; it < T / 128; it += F.G) {
        const int s0 = (it % (SEQ / 128)) * 128;
        const size_t row0 = (size_t)it * 128;
        const unsigned* gp = (const unsigned*)G + f_tid;
        f32x2 win[32];
        unsigned nx[32];
#pragma unroll
        for (int k = 1; k <= CW - 1; ++k) win[32 - k] = (f32x2){0.f, 0.f};
        if (s0 > 0) {
            unsigned hx[CW - 1];
#pragma unroll
            for (int k = 1; k <= CW - 1; ++k) hx[k - 1] = gp[(row0 - k) * 512];
#pragma unroll
            for (int k = 1; k <= CW - 1; ++k) win[32 - k] = (f32x2){__uint_as_float(hx[k - 1] << 16), __uint_as_float(hx[k - 1] & 0xffff0000u)};
        }
        win[0] = (f32x2){0.f, 0.f}; win[1] = (f32x2){0.f, 0.f};
#pragma unroll
        for (int u = 0; u < 32; ++u) nx[u] = gp[(row0 + u) * 512];
        for (int bt = 0; bt < 4; ++bt) {
            __syncthreads();
#pragma unroll
            for (int u = 0; u < 32; ++u) {
                win[u] = (f32x2){__uint_as_float(nx[u] << 16), __uint_as_float(nx[u] & 0xffff0000u)};
                f32x2 a = bdw;
#pragma unroll
                for (int j = 0; j < CW; ++j) a = wt[j] * win[(u + 2 + j) % 32] + a;
                *(LAS f32x2*)(ys + u * DM + 2 * f_tid) = a;
            }
            { const int nb = bt < 3 ? bt + 1 : 3;
#pragma unroll
              for (int u = 0; u < 32; ++u) nx[u] = gp[(row0 + 32 * nb + u) * 512]; }
            __syncthreads();
            for (int u = F.wave; u < 32; u += NWAVES) {
                const int sl = 32 * bt + u;
                f32x4 v[4]; float sm = 0.f;
#pragma unroll
                for (int k = 0; k < 4; ++k) { v[k] = *(const LAS f32x4*)(ys + u * DM + 256 * k + 4 * f_lane); sm += (v[k][0] + v[k][1]) + (v[k][2] + v[k][3]); }
                const float mu = wave_sum(sm) * (1.f / DM);
                float sq = 0.f;
#pragma unroll
                for (int k = 0; k < 4; ++k) { v[k] = v[k] - mu; sq += (v[k][0] * v[k][0] + v[k][1] * v[k][1]) + (v[k][2] * v[k][2] + v[k][3] * v[k][3]); }
                const float rs = 1.f / sqrtf(wave_sum(sq) * (1.f / DM) + EPS);
#pragma unroll
                for (int k = 0; k < 4; ++k) {
                    f32x4 z = v[k] * rs * lng[k] + lnb[k];
#pragma unroll
                    for (int e = 0; e < 4; ++e) z[e] = z[e] / (1.f + __expf(-z[e]));
                    *(u32x2*)(H2 + (row0 + sl) * DM + 256 * k + 4 * f_lane) = (u32x2){cvtpk(z[0], z[1]), cvtpk(z[2], z[3])};
                }
            }
        }
    }
    __syncthreads();
}
enum Phase { PH_PREP = 0, PH_PREPW, PH_PROJ, PH_MIX, PH_WOUT, PH_Q0, PH_GU0, PH_GR0, PH_GV0, PH_W1, PH_CONV, PH_W2, PH_Q1, PH_GU1, PH_GR1, PH_GV1, PH_FINAL, PH_COUNT };
struct Args { const float* in[19]; float* out; unsigned char* ws; int ph_lo, ph_hi; };
#ifndef TEST_PHASE
#define TEST_PHASE -1
#endif

__global__ void __launch_bounds__(NTHR, 2) mega_fwd(Args args) {
    extern __shared__ __attribute__((aligned(16))) unsigned char lds[];
    Frame F;
    F.lds = (LAS unsigned char*)lds;
    F.wave = __builtin_amdgcn_readfirstlane((int)threadIdx.x >> 6); FRAME_IDS;
    F.G = gridDim.x; F.bid = blockIdx.x;
    F.x = args.in[0]; F.mix_norm = args.in[1]; F.ffn_norm = args.in[2]; F.final_norm = args.in[3]; F.w_in = args.in[4]; F.w_out = args.in[5]; F.rel_bias = args.in[6];
    F.conv_w1 = args.in[7]; F.conv_b1 = args.in[8]; F.conv_dw = args.in[9]; F.conv_dw_b = args.in[10]; F.conv_ln_g = args.in[11]; F.conv_ln_b = args.in[12];
    F.conv_w2 = args.in[13]; F.conv_b2 = args.in[14]; F.peer_wq = args.in[15]; F.peer_keys = args.in[16]; F.peer_u = args.in[17]; F.peer_v = args.in[18];
    F.out = args.out; F.ws = args.ws;
    volatile LAS unsigned* MISC = (volatile LAS unsigned*)(F.lds + MISC_OFF);
    for (int u = f_tid; u < (LDS_BYTES - LDSCTL_OFF) / 4; u += NTHR) ((LAS unsigned*)(F.lds + LDSCTL_OFF))[u] = 0u;
    __syncthreads();
    const int lo = args.ph_lo, hi = args.ph_hi;
    XcdBarrier bar; bar.bar = (unsigned*)(F.ws + WS_CTL) + CW_BAR; bar.x = 0; bar.st = nullptr;
    if (hi - lo > 1) bar = xcd_barrier_post((unsigned*)(F.ws + WS_CTL) + CW_BAR, MISC + 8);
#define IN(k) ((TEST_PHASE < 0 || TEST_PHASE == (k)) && lo <= (k) && (k) < hi)
#define SEAM(k) do { if (IN(k) && IN((k) + 1)) xcd_barrier(bar, F.wave); } while (0)
#define REPS(k) for (int rep_ = ((k) == REP_PHASE ? 0 : 1); rep_ < 2; ++rep_)
#define GEMM_PHASE(EPI, Aptr, Bptr, NN, ...) do { pg8::Gemm g{(const bf16*)(Aptr), (const bf16*)(Bptr), T, (NN), DM}; pg8::StaticOrder S; S.init(T, (NN), F.G, F.bid); \
        pg8::EPI E{__VA_ARGS__}; pg8::gemm_phase<pg8::EPI, pg8::StaticOrder, true, true>(F.lds, g, S, E, F.wave); } while (0)
    bf16* XB = (bf16*)(F.ws + WS_XB);
    float* PART = (float*)(F.ws + WS_PART); const float* ROPE = (const float*)(F.ws + WS_ROPE);
    if (IN(PH_PREP)) REPS(PH_PREP) { p0_prep(F); p0_weights(F, 0); } SEAM(PH_PREP);
    if (IN(PH_PREPW)) REPS(PH_PREPW) { p0_weights(F, 1); } SEAM(PH_PREPW);
    if (PROBE_MODE == 9 && IN(PH_PREP) && IN(PH_PREP + 1)) { for (int xb_ = 0; xb_ < 8; ++xb_) xcd_barrier(bar, F.wave); }
    if (IN(PH_PROJ)) REPS(PH_PROJ) { { pg8::Gemm g{(const bf16*)XB, (const bf16*)(F.ws + WS_WIN), T, INC, DM / 2}; pg8::StaticOrder S; S.init(T, INC, F.G, F.bid); pg8::EpiProj8 E{(bf16*)(F.ws + WS_R), ROPE, (const float*)(F.ws + WS_ROWSC), (const float*)(F.ws + WS_COLSC)}; pg8::gemm_phase<pg8::EpiProj8, pg8::StaticOrder, true, true, true>(F.lds, g, S, E, F.wave); } } SEAM(PH_PROJ);
    if (IN(PH_MIX)) REPS(PH_MIX) { mix_phase(F, rep_); } SEAM(PH_MIX);
    if (IN(PH_WOUT)) REPS(PH_WOUT) { GEMM_PHASE(EpiRes, F.ws + WS_O, F.ws + WS_WOUT, DM, F.x, XB, PART, nullptr); } SEAM(PH_WOUT);
    if (IN(PH_Q0)) REPS(PH_Q0) { GEMM_PHASE(EpiQ, XB, F.ws + WS_WQ, DM, (bf16*)(F.ws + WS_Q), PART); asm volatile("s_waitcnt vmcnt(0)" ::: "memory"); __syncthreads(); opt_route(F, 0); } SEAM(PH_Q0);
    const bool census = (hi - lo > 1);
    if (IN(PH_GU0)) REPS(PH_GU0) { gather_u(F, 0, get_xinfo(F, census), rep_ == 0); } SEAM(PH_GU0);
    if (IN(PH_GR0)) REPS(PH_GR0) { gather_r(F, 0); } SEAM(PH_GR0);
    if (IN(PH_GV0)) REPS(PH_GV0) { gather_v(F, 0, get_xinfo(F, census), rep_ == 0); } SEAM(PH_GV0);
    if (IN(PH_W1)) REPS(PH_W1) { GEMM_PHASE(EpiGlu, XB, F.ws + WS_W1, 2 * DM, (bf16*)(F.ws + WS_GLU), PART, F.conv_b1); } SEAM(PH_W1);
    if (IN(PH_CONV)) REPS(PH_CONV) { opt_conv(F); } SEAM(PH_CONV);
    if (IN(PH_W2)) { GEMM_PHASE(EpiRes, F.ws + WS_HID2, F.ws + WS_W2, DM, nullptr, XB, PART, F.conv_b2); } SEAM(PH_W2);
    if (IN(PH_Q1)) REPS(PH_Q1) { GEMM_PHASE(EpiQ, XB, F.ws + WS_WQ + (size_t)DM * DM * 2, DM, (bf16*)(F.ws + WS_Q), PART); asm volatile("s_waitcnt vmcnt(0)" ::: "memory"); __syncthreads(); opt_route(F, 1); } SEAM(PH_Q1);
    if (IN(PH_GU1)) REPS(PH_GU1) { gather_u(F, 1, get_xinfo(F, census), rep_ == 0); } SEAM(PH_GU1);
    if (IN(PH_GR1)) REPS(PH_GR1) { gather_r(F, 1); } SEAM(PH_GR1);
    if (IN(PH_GV1)) REPS(PH_GV1) { gather_v(F, 1, get_xinfo(F, census), rep_ == 0); } SEAM(PH_GV1);
    if (IN(PH_FINAL)) { final_norm(F); }
#undef IN
#undef SEAM
}

extern "C" void kernel_launch(void* const* d_in, const int* in_sizes, int n_in, void* d_out, int out_size, void* d_ws, size_t ws_size, hipStream_t stream) {
    static int grid = 0;
    if (grid == 0) {
        if (n_in != 19 || out_size != T * DM || ws_size < WS_END) { fprintf(stderr, "kernel_launch: unexpected shapes (n_in %d out %d ws %zu)\n", n_in, out_size, ws_size); grid = -1; return; }
        int dev = 0, cus = 0;
        if (hipGetDevice(&dev) != hipSuccess || hipDeviceGetAttribute(&cus, hipDeviceAttributeMultiprocessorCount, dev) != hipSuccess) { grid = -1; return; }
        if (hipFuncSetAttribute((const void*)mega_fwd, hipFuncAttributeMaxDynamicSharedMemorySize, LDS_BYTES) != hipSuccess) { fprintf(stderr, "kernel_launch: hipFuncSetAttribute failed\n"); grid = -1; return; }
        (void)hipGetLastError();
        grid = cus;
    }
    if (grid < 0) return;
    (void)hipMemsetAsync((char*)d_ws + WS_CTL, 0, CTL_ZERO_BYTES, stream);
    Args a{};
    for (int i = 0; i < 19; ++i) a.in[i] = (const float*)d_in[i];
    a.out = (float*)d_out; a.ws = (unsigned char*)d_ws;
#if MK_ONE_LAUNCH
    a.ph_lo = 0; a.ph_hi = PH_COUNT;
    hipLaunchKernelGGL(mega_fwd, dim3(grid), dim3(NTHR), LDS_BYTES, stream, a);
#else
    for (int p = 0; p < PH_COUNT; ++p) { a.ph_lo = p; a.ph_hi = p + 1; hipLaunchKernelGGL(mega_fwd, dim3(grid), dim3(NTHR), LDS_BYTES, stream, a); }
#endif
}
```

```cpp
#include <hip/hip_runtime.h>
#include <cstdio>
#include <cstdint>

#ifndef REP_PHASE
#define REP_PHASE -1
#endif
#ifndef PROBE_MODE
#define PROBE_MODE 1
#endif
#ifndef MK_ONE_LAUNCH
#define MK_ONE_LAUNCH 1
#endif

#define GAS __attribute__((address_space(1)))
#define LAS __attribute__((address_space(3)))
#define DI __device__ __forceinline__
typedef unsigned short bf16;
typedef float f32x2 __attribute__((ext_vector_type(2)));
typedef float f32x4 __attribute__((ext_vector_type(4)));
typedef unsigned u32x2 __attribute__((ext_vector_type(2)));
typedef unsigned u32x4 __attribute__((ext_vector_type(4)));
typedef short bf16x8 __attribute__((ext_vector_type(8)));
typedef float f32x16 __attribute__((ext_vector_type(16)));

constexpr int NB = 16, SEQ = 2048, DM = 1024, T = NB * SEQ;
constexpr int CHUNK = 64, HD = 64, NHA = 8, NHB = 8, INC = 3584, NCH = SEQ / CHUNK;
constexpr int PH = 8, PK = 128, PE = PK * PK, PQD = 128, PTOP = 16, NSEL = PH * PTOP;
constexpr int CW = 31;
constexpr float EPS = 1e-6f;
constexpr float LOG2E = 1.4426950408889634f;
constexpr float XQ = 127.f / 6.f;
constexpr int NWAVES = 8, NTHR = NWAVES * 64;

constexpr int C_QA = 0, C_KA = 512, C_VA = 1024, C_QB = 1536, C_KB = 2048, C_VB = 2560, C_GB = 3072;

constexpr size_t MiB = 1u << 20;
constexpr size_t WS_CTL = 0, CTL_ZERO_BYTES = 1 * MiB;
constexpr size_t WS_WIN = 2 * MiB, WS_WOUT = 9 * MiB, WS_W1 = 11 * MiB, WS_W2 = 15 * MiB, WS_WQ = 17 * MiB;
constexpr size_t WS_ROPE = 22 * MiB;
constexpr size_t WS_PART = 23 * MiB;
constexpr size_t WS_EIDX = 26 * MiB;
constexpr size_t WS_GATE = 42 * MiB;
constexpr size_t WS_U8 = 64 * MiB, WS_V8 = 96 * MiB;
constexpr size_t WS_SC = 25 * MiB;
constexpr size_t WS_ROWSC = 59 * MiB;
constexpr size_t WS_COLSC = 60 * MiB;
constexpr size_t WS_SA = 58 * MiB;
constexpr size_t WS_PU = 256 * MiB;
constexpr size_t WS_A = 384 * MiB;
constexpr size_t WS_XB = 128 * MiB;
constexpr size_t WS_XQ = 480 * MiB;
constexpr size_t WS_R = 192 * MiB;
constexpr size_t WS_O = 416 * MiB;
constexpr size_t WS_Q = 192 * MiB;
constexpr size_t WS_HID = 256 * MiB;
constexpr size_t WS_GLU = 384 * MiB;
constexpr size_t WS_HID2 = 448 * MiB;
constexpr size_t WS_END = 512 * MiB;
constexpr int CW_BAR = 4096, CW_QUEUE = 8192;

constexpr int RING_BYTES = 131072, LDSCTL_OFF = RING_BYTES, MISC_OFF = LDSCTL_OFF + 320, LDS_BYTES = 147456;

DI float bf2f(bf16 v) { return __uint_as_float(((unsigned)v) << 16); }
DI unsigned f2bf(float f) { unsigned u = __float_as_uint(f); return (u + 0x7fffu + ((u >> 16) & 1u)) >> 16; }
DI unsigned pk2(float lo, float hi) { return f2bf(lo) | (f2bf(hi) << 16); }
#define DPP_MOV_I(x, ctrl) __builtin_amdgcn_mov_dpp((x), (ctrl), 0xF, 0xF, true)
#define DPP_XOR1 0xB1
#define DPP_XOR2 0x4E
#define DPP_HMIRROR 0x141
#define DPP_ROR8 0x128
DI float swap32_add(const float a, const float b) { const auto r = __builtin_amdgcn_permlane32_swap(__float_as_uint(a), __float_as_uint(b), false, false); return __uint_as_float(r[0]) + __uint_as_float(r[1]); }
DI float swap16_add(const float a, const float b) { const auto r = __builtin_amdgcn_permlane16_swap(__float_as_uint(a), __float_as_uint(b), false, false); return __uint_as_float(r[0]) + __uint_as_float(r[1]); }
DI int swap32_addi(const int a, const int b) { const auto r = __builtin_amdgcn_permlane32_swap((unsigned)a, (unsigned)b, false, false); return (int)(r[0] + r[1]); }
DI int swap16_addi(const int a, const int b) { const auto r = __builtin_amdgcn_permlane16_swap((unsigned)a, (unsigned)b, false, false); return (int)(r[0] + r[1]); }
DI float wave_sum_fast(float v) {
    v += __int_as_float(DPP_MOV_I(__float_as_int(v), DPP_XOR1)); v += __int_as_float(DPP_MOV_I(__float_as_int(v), DPP_XOR2));
    v += __int_as_float(DPP_MOV_I(__float_as_int(v), DPP_HMIRROR)); v += __int_as_float(DPP_MOV_I(__float_as_int(v), DPP_ROR8));
    v = swap16_add(v, v); v = swap32_add(v, v);
    return v;
}
DI float wave_sum(float v) { return wave_sum_fast(v); }
DI float swap32_max(const float a) { const auto r = __builtin_amdgcn_permlane32_swap(__float_as_uint(a), __float_as_uint(a), false, false); return fmaxf(__uint_as_float(r[0]), __uint_as_float(r[1])); }
DI float swap16_max(const float a) { const auto r = __builtin_amdgcn_permlane16_swap(__float_as_uint(a), __float_as_uint(a), false, false); return fmaxf(__uint_as_float(r[0]), __uint_as_float(r[1])); }
DI float wave_max(float v) {
    v = fmaxf(v, __int_as_float(DPP_MOV_I(__float_as_int(v), DPP_XOR1))); v = fmaxf(v, __int_as_float(DPP_MOV_I(__float_as_int(v), DPP_XOR2)));
    v = fmaxf(v, __int_as_float(DPP_MOV_I(__float_as_int(v), DPP_HMIRROR))); v = fmaxf(v, __int_as_float(DPP_MOV_I(__float_as_int(v), DPP_ROR8)));
    v = swap16_max(v); v = swap32_max(v);
    return v;
}
DI float block_sum(float v, LAS float* red, int tid) {
    v = wave_sum(v);
    __syncthreads();
    if ((tid & 63) == 0) red[tid >> 6] = v;
    __syncthreads();
    float s = 0.f;
#pragma unroll
    for (int i = 0; i < NWAVES; ++i) s += red[i];
    return s;
}
DI float gelu_erf(float x) { return 0.5f * x * (1.f + erff(x * 0.70710678118654752f)); }
DI float sigmoidf(float x) { return 1.f / (1.f + __expf(-x)); }
DI float frcp(const float x) { return __builtin_amdgcn_rcpf(x); }
DI float frsq(const float x) { return __builtin_amdgcn_rsqf(x); }
DI float fsqrt(const float x) { return __builtin_amdgcn_sqrtf(x); }

DI int lane_id() { int r; asm volatile("v_mbcnt_lo_u32_b32 %0, -1, 0\n\tv_mbcnt_hi_u32_b32 %0, -1, %0" : "=v"(r)); return r; }
#define XB_TMO      128
#define XB_XCNT(j)  (256  + 64 * (j))
#define XB_XSUB(j)  (1280 + 64 * (j))
#define XB_XGEN(j)  (2304 + 64 * (j))
#define XB_TOP      3328
#define XB_TOPGEN   3392
#define XCD_BAR_WORDS 3456
#define XB_SPIN_CAP (1u << 22)
DI unsigned xb_ld(unsigned* p)              { return __hip_atomic_load(p, __ATOMIC_RELAXED, __HIP_MEMORY_SCOPE_AGENT); }
DI unsigned xb_add(unsigned* p, unsigned v) { return __hip_atomic_fetch_add(p, v, __ATOMIC_RELAXED, __HIP_MEMORY_SCOPE_AGENT); }
DI unsigned xb_xcc_id() { return (unsigned)__builtin_amdgcn_s_getreg((3 << 11) | 20) & 0xFu; }
#define XB_SPIN(cond, bar) do { unsigned _sp = 0; while (cond) { __builtin_amdgcn_s_sleep(1); \
    if ((++_sp & 255u) == 0u) { if (xb_ld(&(bar)[XB_TMO])) break; if (_sp > XB_SPIN_CAP) { atomicAdd(&(bar)[XB_TMO], 1u); break; } } } } while (0)
struct XcdBarrier { unsigned* bar; unsigned x; volatile LAS unsigned* st; };
DI XcdBarrier xcd_barrier_post(unsigned* bar, volatile LAS unsigned* st) {
    XcdBarrier b; b.bar = bar; b.x = xb_xcc_id(); b.st = st;
    if (threadIdx.x == 0) st[4] = xb_add(&bar[XB_XCNT(b.x)], 1u);
    return b;
}
DI void xcd_barrier_complete(unsigned* bar, unsigned x, unsigned& nloc, unsigned& nx) {
    const unsigned G = gridDim.x * gridDim.y * gridDim.z;
    unsigned sum, cnt, mine, sp = 0u;
    for (;;) {
        sum = 0u; cnt = 0u; mine = 0u;
#pragma unroll
        for (unsigned j = 0; j < 16; ++j) { const unsigned c = xb_ld(&bar[XB_XCNT(j)]); sum += c; cnt += (c > 0u) ? 1u : 0u; mine = (j == x) ? c : mine; }
        if (sum == G) break;
        __builtin_amdgcn_s_sleep(1);
        if ((++sp & 255u) == 0u) { if (xb_ld(&bar[XB_TMO])) break; if (sp > XB_SPIN_CAP) { atomicAdd(&bar[XB_TMO], 1u); break; } }
    }
    nloc = mine > 0u ? mine : 1u; nx = cnt > 0u ? cnt : 1u;
}
DI void xcd_barrier(const XcdBarrier& b, const int wave_id) {
    asm volatile("s_waitcnt vmcnt(0)" ::: "memory");
    __syncthreads();
    if (wave_id == 0 && lane_id() == 0) {
        unsigned* bar = b.bar;
        __builtin_amdgcn_s_waitcnt(0);
        unsigned nloc = b.st[0], nx = b.st[1];
        if (nloc == 0u) { xcd_barrier_complete(bar, b.x, nloc, nx); b.st[0] = nloc; b.st[1] = nx; }
        const unsigned old = xb_add(&bar[XB_XSUB(b.x)], 1u);
        const unsigned gen = old / nloc;
        if (old + 1u == (gen + 1u) * nloc) {
            __builtin_amdgcn_fence(__ATOMIC_RELEASE, "agent");
            asm volatile("s_waitcnt vmcnt(0)" ::: "memory");
            const unsigned og = xb_add(&bar[XB_TOP], 1u);
            const unsigned tg = og / nx;
            if (og + 1u == (tg + 1u) * nx) xb_add(&bar[XB_TOPGEN], 1u);
            else XB_SPIN(xb_ld(&bar[XB_TOPGEN]) == tg, bar);
            __builtin_amdgcn_fence(__ATOMIC_ACQUIRE, "agent");
            xb_add(&bar[XB_XGEN(b.x)], 1u);
            asm volatile("s_waitcnt vmcnt(0)" ::: "memory");
        } else {
            XB_SPIN(xb_ld(&bar[XB_XGEN(b.x)]) == gen, bar);
            __builtin_amdgcn_fence(__ATOMIC_ACQUIRE, "agent");
            asm volatile("s_waitcnt vmcnt(0)" ::: "memory");
        }
    }
    __syncthreads();
}

#define WT_RSRC(ptr) __builtin_amdgcn_make_buffer_rsrc((void*)(ptr), 0, 0x7FFFFFFF, 0x00020000)
#define WT_ST16(rsrc, byteoff, val) __builtin_amdgcn_raw_buffer_store_b128((val), (rsrc), (int)(byteoff), 0, 16)
namespace pg8 {
#define PG8_LAS __attribute__((address_space(3)))
typedef unsigned short bf16_t;
typedef short bf16x8 __attribute__((ext_vector_type(8)));
typedef float f32x4 __attribute__((ext_vector_type(4)));
typedef unsigned u32x4 __attribute__((ext_vector_type(4)));
typedef int i32x4 __attribute__((ext_vector_type(4)));
constexpr int BM = 256, BK = 64, HALF = 128, HTB = HALF * BK * 2  , STAGE_BYTES = 8 * HTB, NXCD = 8, WGM = 8;

__host__ __device__ __forceinline__ int lds_byte(int r, int c) { const int st = (r >> 4) * 2 + (c >> 5), rr = r & 15, cc = c & 31, ob = rr * 64 + cc * 2; return st * 1024 + (ob ^ (((ob >> 9) & 1) << 5)); }
__host__ __device__ __forceinline__ void stage_rc(int b, int& R, int& C) { const int st = b / 1024, sb = b % 1024, swz = sb ^ (((sb >> 9) & 1) << 5); R = (st >> 1) * 16 + swz / 64; C = (st & 1) * 32 + (swz % 64) / 2; }
__host__ __device__ __forceinline__ int perm32(int rho) { const int n = rho >> 4, i = rho & 15; return 8 * (i >> 2) + 4 * n + (i & 3); }

struct Unit { int pm, pn; };
struct Gemm { const bf16_t* A; const bf16_t* Bt; int M, N, K; };

struct StaticOrder {
    int nM, nN, nwg, G, c;
    __host__ __device__ void init(int M, int N, int G_, int c_) { nM = M / BM; nN = N / BM; nwg = nM * nN; G = G_; c = c_; }
    __host__ __device__ bool next(int i, Unit& u) const {
        const long L = (long)i * G + c; if (L >= nwg) return false;
        int wgid = (int)L; { const int q = nwg / NXCD, r = nwg % NXCD, xcd = wgid % NXCD, off = wgid / NXCD; wgid = (xcd < r ? xcd * (q + 1) : r * (q + 1) + (xcd - r) * q) + off; }
        const int nig = WGM * nN, gid = wgid / nig, fm = gid * WGM, gsz = (nM - fm) < WGM ? (nM - fm) : WGM;
        u.pm = fm + ((wgid % nig) % gsz); u.pn = (wgid % nig) / gsz; return true;
    }
    __device__ __forceinline__ void a_ready(const Unit&) const {}
    __device__ __forceinline__ void done(const Unit&) const {}
};

__device__ __forceinline__ unsigned cvt_pk_bf16(float lo, float hi) { unsigned r; asm volatile("v_cvt_pk_bf16_f32 %0, %1, %2" : "=v"(r) : "v"(lo), "v"(hi)); return r; }
__device__ __forceinline__ float rstd16(const float* part, int r, int fq) {
    const f32x4 a = *(const f32x4*)(part + (size_t)r * 16 + 4 * fq);
    float s = (a[0] + a[1]) + (a[2] + a[3]);
    s = swap16_add(s, s); s = swap32_add(s, s);
    return __builtin_amdgcn_rsqf(s * (1.f / 1024.f) + 1e-6f);
}
__device__ __forceinline__ float rstd16_reduce(const f32x4 a) {
    float s = (a[0] + a[1]) + (a[2] + a[3]);
    s = swap16_add(s, s); s = swap32_add(s, s);
    return __builtin_amdgcn_rsqf(s * (1.f / 1024.f) + 1e-6f);
}
__device__ __forceinline__ u32x4 pack8(const f32x4 a, const f32x4 b) { u32x4 w; w.x = cvt_pk_bf16(a[0], a[1]); w.y = cvt_pk_bf16(a[2], a[3]); w.z = cvt_pk_bf16(b[0], b[1]); w.w = cvt_pk_bf16(b[2], b[3]); return w; }
#define rot(t1, t2, c, s) do { const float a_ = (t1) * (c) - (t2) * (s), b_ = (t1) * (s) + (t2) * (c); (t1) = a_; (t2) = b_; } while (0)

struct EpiProj8 {
    static constexpr bool PERM = true, AFTER_DRAIN = false, HAS_NEXT = false;
    bf16_t* R; const float* rope; const float* rowsc; const float* colsc;
    __device__ __forceinline__ void operator()(const f32x4 (&acc)[2][2][4][2], const Unit& u, int wr, int wc, int fr, int fq) const {
        const int type = u.pn >> 1, hg = u.pn & 1;
        const int colbase = type * 512 + (4 * hg + wc) * 64 + 8 * fq;
        const __amdgpu_buffer_rsrc_t rR = __builtin_amdgcn_make_buffer_rsrc((void*)R, 0, 0x7FFFFFFF, 0x00020000);
        const bool do_rope = (type == 3) || (type == 4);
        f32x4 cs[2][2];
#pragma unroll
        for (int bj = 0; bj < 2; ++bj)
#pragma unroll
            for (int n = 0; n < 2; ++n) cs[bj][n] = *(const f32x4*)(colsc + u.pn * BM + bj * HALF + wc * 32 + 8 * fq + 4 * n);
        float rsv[8];
#pragma unroll
        for (int i8 = 0; i8 < 8; ++i8) rsv[i8] = rowsc[u.pm * BM + (i8 >> 2) * HALF + wr * 64 + (i8 & 3) * 16 + fr];
        f32x4 rc[4] = {};
        if (do_rope) { const f32x4* rp = (const f32x4*)(rope + ((size_t)((u.pm * BM + wr * 64 + fr) & 2047) * 32 + 8 * fq) * 2); rc[0] = rp[0]; rc[1] = rp[1]; rc[2] = rp[2]; rc[3] = rp[3]; }
#pragma unroll
        for (int i8 = 0; i8 < 8; ++i8) {
                const int ai = i8 >> 2, m = i8 & 3;
                const int r = u.pm * BM + ai * HALF + wr * 64 + m * 16 + fr;
                const float rs = rsv[i8];
                const f32x4 c0 = rc[0], c1 = rc[1], c2 = rc[2], c3 = rc[3];
                if (do_rope && i8 < 7) { const int rn = u.pm * BM + ((i8 + 1) >> 2) * HALF + wr * 64 + ((i8 + 1) & 3) * 16 + fr;
                    const f32x4* rp = (const f32x4*)(rope + ((size_t)(rn & 2047) * 32 + 8 * fq) * 2); rc[0] = rp[0]; rc[1] = rp[1]; rc[2] = rp[2]; rc[3] = rp[3]; }
                f32x4 v[2][2];
#pragma unroll
                for (int bj = 0; bj < 2; ++bj)
#pragma unroll
                    for (int n = 0; n < 2; ++n) { const i32x4 ia = __builtin_bit_cast(i32x4, acc[ai][bj][m][n]);
                        v[bj][n] = (f32x4){(float)ia[0], (float)ia[1], (float)ia[2], (float)ia[3]} * cs[bj][n] * rs; }
                f32x4 a0 = v[0][0], a1 = v[0][1], b0 = v[1][0], b1 = v[1][1];
                if (do_rope) {
                    rot(a0[0], b0[0], c0[0], c0[1]); rot(a0[1], b0[1], c0[2], c0[3]); rot(a0[2], b0[2], c1[0], c1[1]); rot(a0[3], b0[3], c1[2], c1[3]);
                    rot(a1[0], b1[0], c2[0], c2[1]); rot(a1[1], b1[1], c2[2], c2[3]); rot(a1[2], b1[2], c3[0], c3[1]); rot(a1[3], b1[3], c3[2], c3[3]);
                }
                const int boff = (r * 3584 + colbase) * 2;
                __builtin_amdgcn_raw_buffer_store_b128(pack8(a0, a1), rR, boff, 0, 16);
                __builtin_amdgcn_raw_buffer_store_b128(pack8(b0, b1), rR, boff + 64, 0, 16);
            }
    }
};
template <bool XF, bool I8 = false> struct EpiRes {
    static constexpr bool PERM = true, AFTER_DRAIN = false, HAS_NEXT = false;
    const float* xf; bf16_t* hb; float* part; const float* bias; const float* rowsc; const float* colsc;
    __device__ __forceinline__ void operator()(const f32x4 (&acc)[2][2][4][2], const Unit& u, int wr, int wc, int fr, int fq) const {
        const int col0 = u.pn * BM + wc * 32 + 8 * fq;
        f32x4 bv[2][2], cs[2][2]; float rsv[8];
#pragma unroll
        for (int bj = 0; bj < 2; ++bj)
#pragma unroll
            for (int n = 0; n < 2; ++n) { bv[bj][n] = bias ? *(const f32x4*)(bias + col0 + bj * HALF + 4 * n) : (f32x4){0.f, 0.f, 0.f, 0.f};
                                          if constexpr (I8) cs[bj][n] = *(const f32x4*)(colsc + col0 + bj * HALF + 4 * n); }
        if constexpr (I8) {
#pragma unroll
            for (int i8 = 0; i8 < 8; ++i8) rsv[i8] = rowsc[u.pm * BM + (i8 >> 2) * HALF + wr * 64 + (i8 & 3) * 16 + fr];
        }
        f32x4 xc[2][2];
#define EPIRES_LOAD(i8_) do { const size_t off_ = (size_t)(u.pm * BM + ((i8_) >> 2) * HALF + wr * 64 + ((i8_) & 3) * 16 + fr) * 1024 + col0; \
            _Pragma("unroll") for (int bj = 0; bj < 2; ++bj) { \
                if constexpr (XF) { const u32x2 q_ = *(const u32x2*)((const unsigned char*)xf + off_ + bj * HALF) ^ 0x80808080u; const float st_ = rowsc[u.pm * BM + ((i8_) >> 2) * HALF + wr * 64 + ((i8_) & 3) * 16 + fr], o_ = -128.f * st_; \
                    xc[bj][0] = (f32x4){(float)(q_[0] & 255u), (float)((q_[0] >> 8) & 255u), (float)((q_[0] >> 16) & 255u), (float)(q_[0] >> 24)} * st_ + o_; \
                    xc[bj][1] = (f32x4){(float)(q_[1] & 255u), (float)((q_[1] >> 8) & 255u), (float)((q_[1] >> 16) & 255u), (float)(q_[1] >> 24)} * st_ + o_; } \
                else { const u32x4 w = *(const u32x4*)(hb + off_ + bj * HALF); \
                       xc[bj][0] = (f32x4){__uint_as_float(w[0] << 16), __uint_as_float(w[0] & 0xffff0000u), __uint_as_float(w[1] << 16), __uint_as_float(w[1] & 0xffff0000u)}; \
                       xc[bj][1] = (f32x4){__uint_as_float(w[2] << 16), __uint_as_float(w[2] & 0xffff0000u), __uint_as_float(w[3] << 16), __uint_as_float(w[3] & 0xffff0000u)}; } } } while (0)
        EPIRES_LOAD(0);
#pragma unroll
        for (int i8 = 0; i8 < 8; ++i8) {
                const int ai = i8 >> 2, m = i8 & 3;
                const int r = u.pm * BM + ai * HALF + wr * 64 + m * 16 + fr;
                const size_t off = (size_t)r * 1024 + col0;
                f32x4 hh[2][2];
#pragma unroll
                for (int bj = 0; bj < 2; ++bj)
#pragma unroll
                    for (int n = 0; n < 2; ++n) {
                        if constexpr (I8) { const i32x4 ia = __builtin_bit_cast(i32x4, acc[ai][bj][m][n]);
                            hh[bj][n] = xc[bj][n] + (f32x4){(float)ia[0], (float)ia[1], (float)ia[2], (float)ia[3]} * cs[bj][n] * rsv[i8] + bv[bj][n]; }
                        else hh[bj][n] = xc[bj][n] + acc[ai][bj][m][n] + bv[bj][n];
                    }
                if (i8 < 7) EPIRES_LOAD(i8 + 1);
                float ss = 0.f;
#pragma unroll
                for (int bj = 0; bj < 2; ++bj) {
                    const f32x4 h0 = hh[bj][0], h1 = hh[bj][1];
                    *(u32x4*)(hb + off + bj * HALF) = pack8(h0, h1);
                    ss += (h0[0] * h0[0] + h0[1] * h0[1]) + (h0[2] * h0[2] + h0[3] * h0[3]) + (h1[0] * h1[0] + h1[1] * h1[1]) + (h1[2] * h1[2] + h1[3] * h1[3]);
                }
                ss = swap16_add(ss, ss); ss = swap32_add(ss, ss);
                if (fq == 0) part[(size_t)r * 16 + 4 * u.pn + wc] = ss;
            }
#undef EPIRES_LOAD
    }
};
struct EpiQ {
    static constexpr bool PERM = true, AFTER_DRAIN = false, HAS_NEXT = true;
    bf16_t* O; const float* part; mutable float rsn[8];
    __device__ __forceinline__ void prime(const Unit& u, int wr, int wc, int fr, int fq) const {
#pragma unroll
        for (int i8 = 0; i8 < 8; ++i8) rsn[i8] = rstd16(part, u.pm * BM + (i8 >> 2) * HALF + wr * 64 + (i8 & 3) * 16 + fr, fq);
    }
    __device__ __forceinline__ void run(const f32x4 (&acc)[2][2][4][2], const Unit& u, const Unit& un, int wr, int wc, int fr, int fq) const {
        const int col0 = u.pn * BM + wc * 32 + 8 * fq;
        float rsv[8]; f32x4 pnx[8];
#pragma unroll
        for (int i8 = 0; i8 < 8; ++i8) { rsv[i8] = rsn[i8]; pnx[i8] = *(const f32x4*)(part + (size_t)(un.pm * BM + (i8 >> 2) * HALF + wr * 64 + (i8 & 3) * 16 + fr) * 16 + 4 * fq); }
#pragma unroll
        for (int ai = 0; ai < 2; ++ai)
#pragma unroll
            for (int m = 0; m < 4; ++m) {
                const int r = u.pm * BM + ai * HALF + wr * 64 + m * 16 + fr;
                const float rs = rsv[4 * ai + m];
                bf16_t* rowp = O + (size_t)r * 1024 + col0;
#pragma unroll
                for (int bj = 0; bj < 2; ++bj) *(u32x4*)(rowp + bj * HALF) = pack8(acc[ai][bj][m][0] * rs, acc[ai][bj][m][1] * rs);
            }
#pragma unroll
        for (int i8 = 0; i8 < 8; ++i8) rsn[i8] = rstd16_reduce(pnx[i8]);
    }
};
template <bool I8 = false> struct EpiGluT {
    static constexpr bool PERM = true, AFTER_DRAIN = false, HAS_NEXT = true;
    bf16_t* G; const float* part; const float* b1; const float* srow; const float* colsc; mutable float rsn[8];
    __device__ __forceinline__ float rowf(int r, int fq) const { const float rs = rstd16(part, r, fq); if constexpr (I8) return rs * srow[r]; else return rs; }
    __device__ __forceinline__ void prime(const Unit& u, int wr, int wc, int fr, int fq) const {
#pragma unroll
        for (int i8 = 0; i8 < 8; ++i8) rsn[i8] = rowf(u.pm * BM + (i8 >> 2) * HALF + wr * 64 + (i8 & 3) * 16 + fr, fq);
    }
    __device__ __forceinline__ void run(const f32x4 (&acc)[2][2][4][2], const Unit& u, const Unit& un, int wr, int wc, int fr, int fq) const {
        const int col = u.pn * 128 + wc * 32 + 8 * fq;
        const __amdgpu_buffer_rsrc_t rG = WT_RSRC(G);
        f32x4 ba[2], bg[2], ca[2], cg[2];
#pragma unroll
        for (int n = 0; n < 2; ++n) { ba[n] = *(const f32x4*)(b1 + col + 4 * n); bg[n] = *(const f32x4*)(b1 + 1024 + col + 4 * n);
            if constexpr (I8) { ca[n] = *(const f32x4*)(colsc + u.pn * BM + wc * 32 + 8 * fq + 4 * n); cg[n] = *(const f32x4*)(colsc + u.pn * BM + HALF + wc * 32 + 8 * fq + 4 * n); } }
        float rsv[8]; f32x4 pnx[8]; float snx[8];
#pragma unroll
        for (int i8 = 0; i8 < 8; ++i8) { const int rn = un.pm * BM + (i8 >> 2) * HALF + wr * 64 + (i8 & 3) * 16 + fr; rsv[i8] = rsn[i8]; pnx[i8] = *(const f32x4*)(part + (size_t)rn * 16 + 4 * fq); if constexpr (I8) snx[i8] = srow[rn]; }
#pragma unroll
        for (int ai = 0; ai < 2; ++ai)
#pragma unroll
            for (int m = 0; m < 4; ++m) {
                const int r = u.pm * BM + ai * HALF + wr * 64 + m * 16 + fr;
                const float rs = rsv[4 * ai + m];
                f32x4 y[2];
#pragma unroll
                for (int n = 0; n < 2; ++n) {
                    f32x4 a, g;
                    if constexpr (I8) { const i32x4 ia = __builtin_bit_cast(i32x4, acc[ai][0][m][n]), ig = __builtin_bit_cast(i32x4, acc[ai][1][m][n]);
                        a = (f32x4){(float)ia[0], (float)ia[1], (float)ia[2], (float)ia[3]} * (ca[n] * rs) + ba[n]; g = (f32x4){(float)ig[0], (float)ig[1], (float)ig[2], (float)ig[3]} * (cg[n] * rs) + bg[n]; }
                    else { a = acc[ai][0][m][n] * rs + ba[n]; g = acc[ai][1][m][n] * rs + bg[n]; }
#pragma unroll
                    for (int i = 0; i < 4; ++i) y[n][i] = a[i] * __builtin_amdgcn_rcpf(1.f + __expf(-g[i]));
                }
                WT_ST16(rG, (r * 1024 + col) * 2, pack8(y[0], y[1]));
            }
#pragma unroll
        for (int i8 = 0; i8 < 8; ++i8) { rsn[i8] = rstd16_reduce(pnx[i8]); if constexpr (I8) rsn[i8] *= snx[i8]; }
    }
};
typedef EpiGluT<false> EpiGlu; typedef EpiGluT<true> EpiGlu8;
template <class Epi, class Sched, bool ALIGN_EPI = false, bool SP2 = false, bool I8 = false>
__device__ __forceinline__ void gemm_phase(PG8_LAS unsigned char* lds, const Gemm g, const Sched& S, const Epi& E, const int wave_id) {
    const int lane = lane_id(), wid = wave_id, tid = wid * 64 + lane, wr = wid >> 2, wc = wid & 3, fr = lane & 15, fq = lane >> 4;
    const int K = g.K, nt = K / BK;
    unsigned voffA[2], voffB[2];
#pragma unroll
    for (int i = 0; i < 2; ++i) { int R, C; stage_rc(tid * 16 + i * 8192, R, C); const int Rb = Epi::PERM ? ((R & ~31) + perm32(R & 31)) : R;
        voffA[i] = (unsigned)(R * K + C) * 2u; voffB[i] = (unsigned)(Rb * K + C) * 2u; }
    const size_t kstep = (size_t)(BK * 2);
    const size_t hstep = (size_t)HALF * K * 2;
    const size_t tstep = 2 * hstep;
    const unsigned ldsw = (unsigned)wid * 1024u;
    const int aoff = lds_byte(wr * 64 + fr, fq * 8), boff = lds_byte(wc * 32 + fr, fq * 8);
#define PG8_SA(b, h) (((b) * 2 + (h)) * HTB)
#define PG8_SB(b, h) ((4 + (b) * 2 + (h)) * HTB)
#define PG8_STAGE(bufoff, gbase, voff) do { _Pragma("unroll") for (int _i = 0; _i < 2; ++_i) \
        __builtin_amdgcn_global_load_lds((const unsigned*)((const char*)(gbase) + (voff)[_i]), (PG8_LAS unsigned*)(lds + (bufoff) + ldsw + _i * 8192), 16, 0, 0); } while (0)
#define PG8_LDA(dst, b, h) do { _Pragma("unroll") for (int m = 0; m < 4; ++m) _Pragma("unroll") for (int k = 0; k < 2; ++k) dst[m][k] = *(const PG8_LAS bf16x8*)(lds + PG8_SA(b, h) + aoff + m * 2048 + k * 1024); } while (0)
#define PG8_LDB(dst, b, h) do { _Pragma("unroll") for (int n = 0; n < 2; ++n) _Pragma("unroll") for (int k = 0; k < 2; ++k) dst[n][k] = *(const PG8_LAS bf16x8*)(lds + PG8_SB(b, h) + boff + n * 2048 + k * 1024); } while (0)
#define PG8_MMA(ai, bj, At, Bt) do { __builtin_amdgcn_s_setprio(1); _Pragma("unroll") for (int m = 0; m < 4; ++m) _Pragma("unroll") for (int n = 0; n < 2; ++n) _Pragma("unroll") for (int k = 0; k < 2; ++k) { \
        if constexpr (I8) acc[ai][bj][m][n] = __builtin_bit_cast(f32x4, __builtin_amdgcn_mfma_i32_16x16x64_i8(__builtin_bit_cast(i32x4, Bt[n][k]), __builtin_bit_cast(i32x4, At[m][k]), __builtin_bit_cast(i32x4, acc[ai][bj][m][n]), 0, 0, 0)); \
        else acc[ai][bj][m][n] = __builtin_amdgcn_mfma_f32_16x16x32_bf16(Bt[n][k], At[m][k], acc[ai][bj][m][n], 0, 0, 0); } __builtin_amdgcn_s_setprio(0); } while (0)
#define PG8_WAIT_V(n) asm volatile("s_waitcnt vmcnt(" #n ")" ::: "memory")
#define PG8_WAIT_L(n) asm volatile("s_waitcnt lgkmcnt(" #n ")" ::: "memory")
#define PG8_BAR __builtin_amdgcn_s_barrier()
#define PG8_SCHED __builtin_amdgcn_sched_barrier(0)
    Unit cur, nxt; int ui = 0;
    if (!S.next(0, cur)) return;
    f32x4 acc[2][2][4][2];
#pragma unroll
    for (int a = 0; a < 2; ++a)
#pragma unroll
        for (int b = 0; b < 2; ++b)
#pragma unroll
            for (int m = 0; m < 4; ++m)
#pragma unroll
                for (int n = 0; n < 2; ++n) acc[a][b][m][n] = (f32x4){0.f, 0.f, 0.f, 0.f};
    bf16x8 At[4][2], B0[2][2], B1[2][2];
    const char* cA = (const char*)g.A + (size_t)cur.pm * tstep; const char* cB = (const char*)g.Bt + (size_t)cur.pn * tstep;
    S.a_ready(cur);
    if constexpr (Epi::HAS_NEXT) E.prime(cur, wr, wc, fr, fq);
    if constexpr (SP2) {
        PG8_STAGE(PG8_SB(0, 0), cB, voffB); PG8_STAGE(PG8_SB(0, 1), cB + hstep, voffB); PG8_STAGE(PG8_SA(0, 0), cA, voffA); PG8_STAGE(PG8_SA(0, 1), cA + hstep, voffA);
        if (wr == 1) PG8_BAR;
        PG8_WAIT_V(2); PG8_BAR;
        PG8_STAGE(PG8_SB(1, 0), cB + kstep, voffB); PG8_STAGE(PG8_SA(1, 0), cA + kstep, voffA); PG8_STAGE(PG8_SB(1, 1), cB + hstep + kstep, voffB);
        PG8_WAIT_V(6); PG8_BAR;
    } else {
        PG8_STAGE(PG8_SB(0, 0), cB, voffB); PG8_STAGE(PG8_SA(0, 0), cA, voffA); PG8_STAGE(PG8_SB(0, 1), cB + hstep, voffB); PG8_STAGE(PG8_SA(0, 1), cA + hstep, voffA);
        if (wr == 1) PG8_BAR;
        PG8_WAIT_V(4); PG8_BAR;
        PG8_STAGE(PG8_SB(1, 0), cB + kstep, voffB); PG8_STAGE(PG8_SA(1, 0), cA + kstep, voffA); PG8_STAGE(PG8_SB(1, 1), cB + hstep + kstep, voffB);
        PG8_WAIT_V(6); PG8_BAR;
    }
    for (;;) {
        const bool has_next = S.next(ui + 1, nxt);
        const char* nA = has_next ? (const char*)g.A + (size_t)nxt.pm * tstep : cA; const char* nB = has_next ? (const char*)g.Bt + (size_t)nxt.pn * tstep : cB;
        for (int t = 0; t < nt; t += 2) {
            const bool last = (t == nt - 2);
            const char* a1 = cA + (size_t)(t + 1) * kstep;
            const char* a2 = last ? nA : cA + (size_t)(t + 2) * kstep; const char* b2 = last ? nB : cB + (size_t)(t + 2) * kstep;
            const char* a3 = a2 + kstep; const char* b3 = b2 + kstep;
            if (last && has_next) S.a_ready(nxt);
            if constexpr (SP2) {
            PG8_LDB(B0, 0, 0); PG8_LDB(B1, 0, 1); PG8_SCHED; PG8_LDA(At, 0, 0); PG8_STAGE(PG8_SA(1, 1), a1 + hstep, voffA);
            PG8_WAIT_V(8); PG8_WAIT_L(0); PG8_BAR; PG8_MMA(0, 0, At, B0); PG8_MMA(0, 1, At, B1); PG8_BAR; PG8_SCHED;
            PG8_LDA(At, 0, 1); PG8_STAGE(PG8_SB(0, 0), b2, voffB); PG8_STAGE(PG8_SB(0, 1), b2 + hstep, voffB); PG8_STAGE(PG8_SA(0, 0), a2, voffA);
            PG8_WAIT_V(8); PG8_WAIT_L(0); PG8_BAR; PG8_MMA(1, 0, At, B0); PG8_MMA(1, 1, At, B1); PG8_BAR; PG8_SCHED;
            PG8_LDB(B0, 1, 0); PG8_LDB(B1, 1, 1); PG8_SCHED; PG8_LDA(At, 1, 0); PG8_STAGE(PG8_SA(0, 1), a2 + hstep, voffA);
            PG8_WAIT_V(8); PG8_WAIT_L(0); PG8_BAR; PG8_MMA(0, 0, At, B0); PG8_MMA(0, 1, At, B1); PG8_BAR; PG8_SCHED;
            PG8_LDA(At, 1, 1); PG8_STAGE(PG8_SB(1, 0), b3, voffB); PG8_STAGE(PG8_SB(1, 1), b3 + hstep, voffB); PG8_STAGE(PG8_SA(1, 0), a3, voffA);
            PG8_WAIT_V(8); PG8_WAIT_L(0); PG8_BAR; PG8_MMA(1, 0, At, B0); PG8_MMA(1, 1, At, B1); PG8_BAR; PG8_SCHED;
            } else {
            PG8_LDB(B0, 0, 0); PG8_SCHED; PG8_LDA(At, 0, 0); PG8_STAGE(PG8_SA(1, 1), a1 + hstep, voffA);
            PG8_WAIT_L(8); PG8_BAR; PG8_WAIT_L(0); PG8_MMA(0, 0, At, B0); PG8_BAR; PG8_SCHED;
            PG8_LDB(B1, 0, 1); PG8_STAGE(PG8_SB(0, 0), b2, voffB);
            PG8_BAR; PG8_WAIT_L(0); PG8_MMA(0, 1, At, B1); PG8_BAR;
            PG8_LDA(At, 0, 1); PG8_STAGE(PG8_SA(0, 0), a2, voffA);
            PG8_BAR; PG8_WAIT_L(0); PG8_MMA(1, 0, At, B0); PG8_BAR; PG8_SCHED;
            PG8_STAGE(PG8_SB(0, 1), b2 + hstep, voffB);
            PG8_WAIT_V(6); PG8_BAR; PG8_MMA(1, 1, At, B1); PG8_BAR;
            PG8_LDB(B0, 1, 0); PG8_SCHED; PG8_LDA(At, 1, 0); PG8_STAGE(PG8_SA(0, 1), a2 + hstep, voffA);
            PG8_WAIT_L(8); PG8_BAR; PG8_WAIT_L(0); PG8_MMA(0, 0, At, B0); PG8_BAR; PG8_SCHED;
            PG8_LDB(B1, 1, 1); PG8_STAGE(PG8_SB(1, 0), b3, voffB);
            PG8_BAR; PG8_WAIT_L(0); PG8_MMA(0, 1, At, B1); PG8_BAR;
            PG8_LDA(At, 1, 1); PG8_STAGE(PG8_SA(1, 0), a3, voffA);
            PG8_BAR; PG8_WAIT_L(0); PG8_MMA(1, 0, At, B0); PG8_BAR; PG8_SCHED;
            PG8_STAGE(PG8_SB(1, 1), b3 + hstep, voffB);
            PG8_WAIT_V(6); PG8_BAR; PG8_MMA(1, 1, At, B1); PG8_BAR;
            }
        }
        if constexpr (ALIGN_EPI) { if (wr == 0) PG8_BAR; }
        if constexpr (!Epi::AFTER_DRAIN) { if constexpr (Epi::HAS_NEXT) E.run(acc, cur, has_next ? nxt : cur, wr, wc, fr, fq); else E(acc, cur, wr, wc, fr, fq); S.done(cur); }
        if (!has_next) break;
#pragma unroll
        for (int a = 0; a < 2; ++a)
#pragma unroll
            for (int b = 0; b < 2; ++b)
#pragma unroll
                for (int m = 0; m < 4; ++m)
#pragma unroll
                    for (int n = 0; n < 2; ++n) acc[a][b][m][n] = (f32x4){0.f, 0.f, 0.f, 0.f};
        cur = nxt; cA = nA; cB = nB; ++ui;
        if constexpr (ALIGN_EPI) { if (wr == 1) PG8_BAR; }
    }
    PG8_WAIT_V(0);
    if constexpr (!ALIGN_EPI) { if (wr == 0) PG8_BAR; }
    PG8_BAR;
    if constexpr (Epi::AFTER_DRAIN) { E.fused(acc, cur, wr, wc, fr, fq, lds, wid, lane); S.done(cur); }
#undef PG8_SA
#undef PG8_SB
#undef PG8_STAGE
#undef PG8_LDA
#undef PG8_LDB
#undef PG8_MMA
#undef PG8_WAIT_V
#undef PG8_WAIT_L
#undef PG8_BAR
#undef PG8_SCHED
}
}

struct Frame {
    LAS unsigned char* lds;
    int wave, G, bid;
    const float *x, *mix_norm, *ffn_norm, *final_norm, *w_in, *w_out, *rel_bias, *conv_w1, *conv_b1, *conv_dw, *conv_dw_b, *conv_ln_g, *conv_ln_b, *conv_w2, *conv_b2,
        *peer_wq, *peer_keys, *peer_u, *peer_v;
    float* out;
    unsigned char* ws;
};
#define FRAME_IDS const int f_lane = lane_id(); const int f_tid = F.wave * 64 + f_lane; (void)f_tid
DI float gamma_of(int h) { return 1.f - exp2f(-5.f - (float)h); }

DI unsigned q8x4(f32x4 v, const float sc) {
    const int a = (int)rintf(v[0] * sc), b = (int)rintf(v[1] * sc), c = (int)rintf(v[2] * sc), d = (int)rintf(v[3] * sc);
    return ((unsigned)a & 0xFFu) | (((unsigned)b & 0xFFu) << 8) | (((unsigned)c & 0xFFu) << 16) | ((unsigned)d << 24);
}
DI void p0_prep(Frame& F) {
    FRAME_IDS;
    const int gw = F.bid * NWAVES + F.wave, NGW = F.G * NWAVES;
    f32x2* rope = (f32x2*)(F.ws + WS_ROPE);
    for (int i = F.bid * NTHR + f_tid; i < SEQ * 32; i += F.G * NTHR) {
        const int s = i >> 5, j = i & 31;
        const float inv = powf(10000.f, -(float)j / 32.f);
        const float ang = (float)s * inv;
        float sn, cs; sincosf(ang, &sn, &cs);
        rope[i] = (f32x2){cs, sn};
    }
    unsigned* xq = (unsigned*)(F.ws + WS_XQ); float* rowsc = (float*)(F.ws + WS_ROWSC);
    for (int m = gw; m < T; m += NGW) {
        const f32x4* xr = (const f32x4*)(F.x + (size_t)m * DM) + f_lane;
        f32x4 v[4]; float s = 0.f, am = 0.f;
#pragma unroll
        for (int j = 0; j < 4; ++j) { v[j] = xr[64 * j]; s += v[j].x * v[j].x + v[j].y * v[j].y + v[j].z * v[j].z + v[j].w * v[j].w; am = fmaxf(am, fmaxf(fmaxf(fabsf(v[j].x), fabsf(v[j].y)), fmaxf(fabsf(v[j].z), fabsf(v[j].w)))); }
        const float r = frsq(wave_sum(s) * (1.f / DM) + EPS);
        am = wave_max(am);
        const float sc = am > 0.f ? 127.f * frcp(am) : 0.f;
#pragma unroll
        for (int j = 0; j < 4; ++j) xq[(size_t)m * (DM / 4) + f_lane + 64 * j] = q8x4(v[j], sc);
        if (f_lane == 0) { rowsc[m] = am * (1.f / 127.f) * r; rowsc[T + m] = am * (1.f / 127.f); }
    }
}
#define P0_LOAD_ITEM(wv, gv) \
    float gv[32], wv[32]; \
    if (gain) { _Pragma("unroll") for (int i = 0; i < 32; ++i) gv[i] = gain[k0 + 2 * i + (lane >> 5)] * scale; } \
    else { _Pragma("unroll") for (int i = 0; i < 32; ++i) gv[i] = scale; } \
    _Pragma("unroll") for (int i = 0; i < 32; ++i) wv[i] = W[(size_t)(k0 + 2 * i + (lane >> 5)) * N + n0 + (lane & 31)];
DI void p0_transpose_item(const float* W, int K, int N, bf16* WT, int prow0, const float* gain, float scale, LAS float* scr, int k0, int n0, int lane) {
    P0_LOAD_ITEM(wv, gv)
#pragma unroll
    for (int i = 0; i < 32; ++i) scr[(2 * i + (lane >> 5)) * 33 + (lane & 31)] = wv[i] * gv[i];
    asm volatile("s_waitcnt lgkmcnt(0)" ::: "memory");
    const int c = lane & 7;
#pragma unroll
    for (int j = 0; j < 4; ++j) { const int n = (lane >> 3) + 8 * j; const LAS float* q = scr + (8 * c) * 33 + n;
        u32x4 o; o.x = pk2(q[0 * 33], q[1 * 33]); o.y = pk2(q[2 * 33], q[3 * 33]); o.z = pk2(q[4 * 33], q[5 * 33]); o.w = pk2(q[6 * 33], q[7 * 33]);
        *(u32x4*)(WT + (size_t)(prow0 + n) * K + k0 + 8 * c) = o; }
    asm volatile("s_waitcnt lgkmcnt(0)" ::: "memory");
}
DI void p0_amax_item(const float* W, int N, unsigned* colmax, const float* gain, float scale, int k0, int n0, int lane) {
    P0_LOAD_ITEM(wv, gv)
    float am = 0.f;
#pragma unroll
    for (int i = 0; i < 32; ++i) am = fmaxf(am, fabsf(wv[i] * gv[i]));
    am = swap32_max(am);
    if (lane < 32) __hip_atomic_fetch_max(colmax + lane, __float_as_uint(am), __ATOMIC_RELAXED, __HIP_MEMORY_SCOPE_AGENT);
}
DI void p0_q8_item(const float* W, int N, unsigned char* WT, const unsigned* colmax, float* colsc, int prow0, const float* gain, float scale, LAS float* scr, int k0, int n0, int lane) {
    const float am = __uint_as_float(colmax[lane & 31]);
    const float sc = am > 0.f ? 127.f / am : 0.f;
    if (k0 == 0 && lane < 32) colsc[lane] = am * (1.f / 127.f);
    P0_LOAD_ITEM(wv, gv)
#pragma unroll
    for (int i = 0; i < 32; ++i) scr[(2 * i + (lane >> 5)) * 33 + (lane & 31)] = rintf(wv[i] * gv[i] * sc);
    asm volatile("s_waitcnt lgkmcnt(0)" ::: "memory");
    const int ch = lane & 3;
#pragma unroll
    for (int j = 0; j < 2; ++j) { const int n = (lane >> 2) + 16 * j; const LAS float* q = scr + (16 * ch) * 33 + n;
        u32x4 o;
#pragma unroll
        for (int w = 0; w < 4; ++w) o[w] = ((unsigned)(int)q[(4 * w) * 33] & 0xFFu) | (((unsigned)(int)q[(4 * w + 1) * 33] & 0xFFu) << 8) | (((unsigned)(int)q[(4 * w + 2) * 33] & 0xFFu) << 16) | ((unsigned)(int)q[(4 * w + 3) * 33] << 24);
        *(u32x4*)(WT + (size_t)(prow0 + n) * DM + k0 + 16 * ch) = o; }
    asm volatile("s_waitcnt lgkmcnt(0)" ::: "memory");
}
#undef P0_LOAD_ITEM
constexpr int CW_COLMAX = 16384;
constexpr int CS_WIN = 0, CS_WOUT = 3584, CS_W1 = 4608, CS_W2 = 6656, CS_WQ = 7680;
constexpr bool I8_WIN = true, I8_WOUT = false, I8_W1 = true, I8_W2 = true, I8_WQ = false;
DI void p0_q8_block(Frame& F, const float* W, int N, unsigned char* WT, float* colsc, int prow0, const float* gain, float scale, int n0, int lane) {
    LAS float* scr = (LAS float*)(F.lds + F.wave * 16384);
    LAS float* red = (LAS float*)(F.lds + F.wave * 16384 + 12288);
    float v[2][32];
    float am = 0.f;
#pragma unroll
    for (int s2 = 0; s2 < 2; ++s2) { const int k0 = 128 * F.wave + 64 * s2;
#pragma unroll
        for (int hb2 = 0; hb2 < 4; ++hb2) {
            float gv[8];
            if (gain) {
#pragma unroll
                for (int i = 0; i < 8; ++i) gv[i] = gain[k0 + 2 * (8 * hb2 + i) + (lane >> 5)] * scale; }
            else {
#pragma unroll
                for (int i = 0; i < 8; ++i) gv[i] = scale; }
#pragma unroll
            for (int i = 0; i < 8; ++i) v[s2][8 * hb2 + i] = W[(size_t)(k0 + 2 * (8 * hb2 + i) + (lane >> 5)) * N + n0 + (lane & 31)];
#pragma unroll
            for (int i = 0; i < 8; ++i) { v[s2][8 * hb2 + i] = v[s2][8 * hb2 + i] * gv[i]; am = fmaxf(am, fabsf(v[s2][8 * hb2 + i])); }
            __builtin_amdgcn_sched_barrier(0);
        }
    }
    am = swap32_max(am);
    __syncthreads();
    if (lane < 32) red[lane] = am;
    __syncthreads();
    float amc = 0.f;
#pragma unroll
    for (int w = 0; w < NWAVES; ++w) amc = fmaxf(amc, ((LAS float*)(F.lds + w * 16384 + 12288))[lane & 31]);
    const float sc = amc > 0.f ? 127.f / amc : 0.f;
    if (F.wave == 0 && lane < 32) colsc[lane] = amc * (1.f / 127.f);
#pragma unroll
    for (int s2 = 0; s2 < 2; ++s2) { const int k0 = 128 * F.wave + 64 * s2;
#pragma unroll
        for (int i = 0; i < 32; ++i) scr[(2 * i + (lane >> 5)) * 33 + (lane & 31)] = rintf(v[s2][i] * sc);
        asm volatile("s_waitcnt lgkmcnt(0)" ::: "memory");
        const int ch = lane & 3;
#pragma unroll
        for (int j = 0; j < 2; ++j) { const int n = (lane >> 2) + 16 * j; const LAS float* q = scr + (16 * ch) * 33 + n;
            u32x4 o;
#pragma unroll
            for (int w = 0; w < 4; ++w) o[w] = ((unsigned)(int)q[(4 * w) * 33] & 0xFFu) | (((unsigned)(int)q[(4 * w + 1) * 33] & 0xFFu) << 8) | (((unsigned)(int)q[(4 * w + 2) * 33] & 0xFFu) << 16) | ((unsigned)(int)q[(4 * w + 3) * 33] << 24);
            *(u32x4*)(WT + (size_t)(prow0 + n) * DM + k0 + 16 * ch) = o; }
        asm volatile("s_waitcnt lgkmcnt(0)" ::: "memory");
    }
}
constexpr int NQ8B = INC / 32 + DM / 32 + 2 * DM / 32;
DI void p0_q8_blocks(Frame& F) {
    FRAME_IDS;
    float* colsc = (float*)(F.ws + WS_COLSC);
    for (int bi = F.bid; bi < NQ8B; bi += F.G) {
        const float* W; const float* gain; int N, n0, prow0, cso; size_t wt; float scl = 1.f;
        if (bi < INC / 32) { n0 = bi * 32; const int type = n0 / 512, head = (n0 % 512) / 64, bj = (n0 % 64) / 32;
            W = F.w_in; N = INC; wt = WS_WIN; cso = CS_WIN; gain = F.mix_norm; prow0 = 256 * (2 * type + head / 4) + 128 * bj + 32 * (head % 4); scl = type == 0 ? 0.125f * LOG2E : (type == 4 ? 0.125f : 1.f); }
        else if (bi < INC / 32 + DM / 32) { n0 = (bi - INC / 32) * 32; W = F.conv_w2; N = DM; wt = WS_W2; cso = CS_W2; gain = nullptr; prow0 = n0; }
        else { n0 = (bi - INC / 32 - DM / 32) * 32; const int gbj = n0 / 1024, rem = n0 % 1024;
            W = F.conv_w1; N = 2 * DM; wt = WS_W1; cso = CS_W1; gain = F.mix_norm + DM; prow0 = 256 * (rem / 128) + 128 * gbj + (rem % 128); }
        p0_q8_block(F, W, N, F.ws + wt, colsc + cso + prow0, prow0, gain, scl, n0, f_lane);
    }
    __syncthreads();
}
DI void p0_weights(Frame& F, const int pass) {
    FRAME_IDS;
    LAS float* scr = (LAS float*)(F.lds + F.wave * 16384);
    unsigned* colmax = (unsigned*)(F.ws + WS_CTL) + CW_COLMAX; float* colsc = (float*)(F.ws + WS_COLSC);
    const int wb0 = (pass == 2 && F.G >= NQ8B + 64) ? NQ8B : 0;
    if (F.bid < wb0) return;
    const int gw = (F.bid - wb0) * NWAVES + F.wave, NGW = (F.G - wb0) * NWAVES;
    constexpr int I_IN = 16 * (INC / 32), I_SQ = 16 * (DM / 32), I_W1 = 16 * (2 * DM / 32);
    constexpr int NITEMS = I_IN + I_SQ + I_W1 + I_SQ + 2 * I_SQ;
#define WITEM(I8FLAG, Wp, Nn, WTb, CSo, prow0, gainp, scl, k0, n0) do { \
        if (pass == 2) { if (!(I8FLAG)) p0_transpose_item(Wp, DM, Nn, (bf16*)(WTb), prow0, gainp, scl, scr, k0, n0, f_lane); } \
        else if (pass == 0) { if (I8FLAG) p0_amax_item(Wp, Nn, colmax + (CSo) + (prow0), gainp, scl, k0, n0, f_lane); } \
        else if (I8FLAG) p0_q8_item(Wp, Nn, (unsigned char*)(WTb), colmax + (CSo) + (prow0), colsc + (CSo) + (prow0), prow0, gainp, scl, scr, k0, n0, f_lane); \
        else p0_transpose_item(Wp, DM, Nn, (bf16*)(WTb), prow0, gainp, scl, scr, k0, n0, f_lane); } while (0)
    for (int it = gw; it < NITEMS; it += NGW) {
        int r = it;
        if (r < I_IN) { const int nb = r % (INC / 32), kb = r / (INC / 32), n0 = nb * 32;
            const int type = n0 / 512, head = (n0 % 512) / 64, bj = (n0 % 64) / 32;
            const int prow0 = 256 * (2 * type + head / 4) + 128 * bj + 32 * (head % 4);
            WITEM(I8_WIN, F.w_in, INC, F.ws + WS_WIN, CS_WIN, prow0, F.mix_norm, (type == 0 ? 0.125f * LOG2E : (type == 4 ? 0.125f : 1.f)), kb * 64, n0); continue; }
        r -= I_IN;
        if (r < I_SQ) { const int nb = r % 32, kb = r / 32; WITEM(I8_WOUT, F.w_out, DM, F.ws + WS_WOUT, CS_WOUT, nb * 32, (const float*)nullptr, 1.f, kb * 64, nb * 32); continue; }
        r -= I_SQ;
        if (r < I_W1) { const int nb = r % 64, kb = r / 64, n0 = nb * 32; const int bj = n0 / 1024, rem = n0 % 1024;
            WITEM(I8_W1, F.conv_w1, 2 * DM, F.ws + WS_W1, CS_W1, 256 * (rem / 128) + 128 * bj + (rem % 128), F.mix_norm + DM, 1.f, kb * 64, n0); continue; }
        r -= I_W1;
        if (r < I_SQ) { const int nb = r % 32, kb = r / 32; WITEM(I8_W2, F.conv_w2, DM, F.ws + WS_W2, CS_W2, nb * 32, (const float*)nullptr, 1.f, kb * 64, nb * 32); continue; }
        r -= I_SQ;
        { const int layer = r / I_SQ; r %= I_SQ; const int nb = r % 32, kb = r / 32;
          WITEM(I8_WQ, F.peer_wq + (size_t)layer * DM * DM, DM, F.ws + WS_WQ + (size_t)layer * DM * DM * 2, CS_WQ + layer * DM, nb * 32, F.ffn_norm + layer * DM, 1.f, kb * 64, nb * 32); }
    }
#undef WITEM
}
DI float row_rstd(const float* part, int m) {
    const f32x4* p = (const f32x4*)(part + (size_t)m * 16);
    const f32x4 a = p[0], b = p[1], c = p[2], d = p[3];
    const float s = ((a.x + a.y) + (a.z + a.w)) + ((b.x + b.y) + (b.z + b.w)) + ((c.x + c.y) + (c.z + c.w)) + ((d.x + d.y) + (d.z + d.w));
    return frsq(s * (1.f / DM) + EPS);
}

typedef short v4i16 __attribute__((ext_vector_type(4)));
typedef __bf16 bf16x2_t __attribute__((ext_vector_type(2)));
DI unsigned cvtpk(float lo, float hi) { f32x2 v = {lo, hi}; bf16x2_t b = __builtin_convertvector(v, bf16x2_t); return __builtin_bit_cast(unsigned, b); }
DI v4i16 ds_tr16(LAS const unsigned char* p) { return __builtin_amdgcn_ds_read_tr16_b64_v4i16((LAS v4i16*)p); }
DI int crow(int r, int h) { return (r & 3) + 8 * (r >> 2) + 4 * h; }
DI bf16x8 pack_step(const f32x16& x, const int s) {
    u32x4 w = {cvtpk(x[8 * s + 0], x[8 * s + 1]), cvtpk(x[8 * s + 2], x[8 * s + 3]), cvtpk(x[8 * s + 4], x[8 * s + 5]), cvtpk(x[8 * s + 6], x[8 * s + 7])};
    return __builtin_bit_cast(bf16x8, w);
}
constexpr int AT_KB = 64 * 144, AT_VB = 8192, AT_BUF = AT_KB + AT_VB, AT_BIAS = 106496, AT_BIAS_STRIDE = 324;
DI void attn_item(Frame& F, const int it) {
    FRAME_IDS;
    const bf16* R = (const bf16*)(F.ws + WS_R); bf16* O = (bf16*)(F.ws + WS_O);
    LAS unsigned char* lds = F.lds;
    const LAS float* bias_s = (const LAS float*)(lds + AT_BIAS) + ((it / 8) % NHA) * AT_BIAS_STRIDE;
    const int q32 = f_lane & 31, h = f_lane >> 5, w = F.wave;
    const int srow = f_tid >> 3, sch = f_tid & 7;
    const int vtr_off = ((f_lane & 15) >> 2) * 64 + (16 * ((f_lane >> 4) & 1) + 4 * (f_lane & 3)) * 2;
    {
        const int b = it / (NHA * 8), hd = (it / 8) % NHA, c0 = (it % 8) * 4;
        const int c = c0 + (w >> 1), qrow0 = 32 * (w & 1);
        const size_t tq = (size_t)b * SEQ + c * 64 + qrow0 + q32;
        __syncthreads();
        bf16x8 qf[4];
#pragma unroll
        for (int ks = 0; ks < 4; ++ks) qf[ks] = *(const bf16x8*)(R + tq * INC + C_QA + hd * 64 + 16 * ks + 8 * h);
        asm volatile("" ::: "memory");
        const int t_lo = c0 - 8 < 0 ? 0 : c0 - 8, t_hi = c0 + 3, ntile = t_hi - t_lo + 1;
        const bf16* kbase = R + ((size_t)b * SEQ + srow) * INC + C_KA + hd * 64 + 8 * sch;
        const bf16* vbase = R + ((size_t)b * SEQ + srow) * INC + C_VA + hd * 64 + 8 * sch;
        u32x4 kA = *(const u32x4*)(kbase + (size_t)t_lo * 64 * INC), vA = *(const u32x4*)(vbase + (size_t)t_lo * 64 * INC);
        u32x4 kB = *(const u32x4*)(kbase + (size_t)(t_lo + 1) * 64 * INC), vB = *(const u32x4*)(vbase + (size_t)(t_lo + 1) * 64 * INC);
        *(LAS u32x4*)(lds + srow * 144 + sch * 16) = kA;
        *(LAS u32x4*)(lds + AT_KB + (sch >> 2) * 4096 + srow * 64 + (sch & 3) * 16) = vA;
        __syncthreads();
        const float bias_far = bias_s[256];
        float m = -1e30f, l = 0.f;
        f32x16 o0 = {}, o1 = {};
        auto tile_step = [&](const int i, u32x4& kL, u32x4& vL, const u32x4& kW, const u32x4& vW) __attribute__((always_inline)) {
            const int tc = t_lo + i;
            LAS unsigned char* kb = lds + (i & 1) * AT_BUF; LAS unsigned char* vb = kb + AT_KB;
            { const int tl = tc + 2 < t_hi ? tc + 2 : t_hi;
              kL = *(const u32x4*)(kbase + (size_t)tl * 64 * INC); vL = *(const u32x4*)(vbase + (size_t)tl * 64 * INC); }
            const int D = c - tc;
            if (D >= 0 && D <= 8) {
                const float init = D >= 3 ? bias_far : 0.f;
                f32x16 p0, p1;
#pragma unroll
                for (int r = 0; r < 16; ++r) { p0[r] = init; p1[r] = init; }
#pragma unroll
                for (int ks = 0; ks < 4; ++ks) {
                    const bf16x8 k0 = *(const LAS bf16x8*)(kb + q32 * 144 + (16 * ks + 8 * h) * 2);
                    const bf16x8 k1 = *(const LAS bf16x8*)(kb + (32 + q32) * 144 + (16 * ks + 8 * h) * 2);
                    p0 = __builtin_amdgcn_mfma_f32_32x32x16_bf16(k0, qf[ks], p0, 0, 0, 0);
                    p1 = __builtin_amdgcn_mfma_f32_32x32x16_bf16(k1, qf[ks], p1, 0, 0, 0);
                }
                if (D < 3) {
                    const LAS float* bb = bias_s + (D * 64 + qrow0 + q32 - 4 * h + 128 - 59);
#pragma unroll
                    for (int r = 0; r < 16; ++r) { p0[r] += bb[59 - ((r & 3) + 8 * (r >> 2))]; p1[r] += bb[27 - ((r & 3) + 8 * (r >> 2))]; }
                }
                float tm; asm("v_max_f32_e32 %0, %1, %2" : "=v"(tm) : "v"(p0[0]), "v"(p1[0]));
#pragma unroll
                for (int r = 1; r < 16; ++r) asm("v_max3_f32 %0, %1, %2, %3" : "=v"(tm) : "v"(tm), "v"(p0[r]), "v"(p1[r]));
                tm = swap32_max(tm);
                const float mn = fmaxf(m, tm), alpha = __builtin_amdgcn_exp2f(m - mn);
                m = mn;
                float ps = 0.f;
#pragma unroll
                for (int r = 0; r < 16; ++r) { p0[r] = __builtin_amdgcn_exp2f(p0[r] - mn); p1[r] = __builtin_amdgcn_exp2f(p1[r] - mn); ps += p0[r] + p1[r]; }
                l = l * alpha + ps;
                if (!__all(alpha == 1.f)) {
#pragma unroll
                    for (int r = 0; r < 16; ++r) { o0[r] *= alpha; o1[r] *= alpha; }
                }
                bf16x8 pf[4];
                pf[0] = pack_step(p0, 0); pf[1] = pack_step(p0, 1); pf[2] = pack_step(p1, 0); pf[3] = pack_step(p1, 1);
#pragma unroll
                for (int kk = 0; kk < 4; ++kk) {
                    const int key0 = 16 * kk + 4 * h;
                    const v4i16 a0l = ds_tr16(vb + key0 * 64 + vtr_off), a0h = ds_tr16(vb + (key0 + 8) * 64 + vtr_off);
                    const v4i16 a1l = ds_tr16(vb + 4096 + key0 * 64 + vtr_off), a1h = ds_tr16(vb + 4096 + (key0 + 8) * 64 + vtr_off);
                    const bf16x8 a0 = __builtin_shufflevector(a0l, a0h, 0, 1, 2, 3, 4, 5, 6, 7), a1 = __builtin_shufflevector(a1l, a1h, 0, 1, 2, 3, 4, 5, 6, 7);
                    o0 = __builtin_amdgcn_mfma_f32_32x32x16_bf16(a0, pf[kk], o0, 0, 0, 0);
                    o1 = __builtin_amdgcn_mfma_f32_32x32x16_bf16(a1, pf[kk], o1, 0, 0, 0);
                }
            }
            if (i + 1 < ntile) {
                LAS unsigned char* nb = lds + ((i + 1) & 1) * AT_BUF;
                *(LAS u32x4*)(nb + srow * 144 + sch * 16) = kW;
                *(LAS u32x4*)(nb + AT_KB + (sch >> 2) * 4096 + srow * 64 + (sch & 3) * 16) = vW;
            }
            __syncthreads();
        };
        for (int i = 0; i < ntile; i += 2) { tile_step(i, kA, vA, kB, vB); tile_step(i + 1, kB, vB, kA, vA); }
        l = swap32_add(l, l);
        const float inv = frcp(l);
        bf16* op = O + tq * DM + hd * 64 + 4 * h;
#pragma unroll
        for (int g = 0; g < 4; ++g) {
            *(u32x2*)(op + 8 * g) = (u32x2){cvtpk(o0[4 * g] * inv, o0[4 * g + 1] * inv), cvtpk(o0[4 * g + 2] * inv, o0[4 * g + 3] * inv)};
            *(u32x2*)(op + 32 + 8 * g) = (u32x2){cvtpk(o1[4 * g] * inv, o1[4 * g + 1] * inv), cvtpk(o1[4 * g + 2] * inv, o1[4 * g + 3] * inv)};
        }
    }
    __syncthreads();
}

constexpr int RT_Q = 0, RT_K = 9216, RT_KD = 18432, RT_V = 26624, RT_BUF = 34816, RT_ZS = 2 * RT_BUF, RT_ZSTR = 68, RT_CS = RT_ZS + 64 * RT_ZSTR * 4;
DI float red8(float x) {
    x += __int_as_float(DPP_MOV_I(__float_as_int(x), DPP_XOR1)); x += __int_as_float(DPP_MOV_I(__float_as_int(x), DPP_XOR2)); x += __int_as_float(DPP_MOV_I(__float_as_int(x), DPP_HMIRROR)); return x;
}
DI void ret_item(Frame& F, const int it) {
    FRAME_IDS;
    const bf16* R = (const bf16*)(F.ws + WS_R); bf16* O = (bf16*)(F.ws + WS_O);
    LAS unsigned char* lds = F.lds;
    LAS float* Zs = (LAS float*)(lds + RT_ZS); LAS float* Cs = (LAS float*)(lds + RT_CS);
    const int b = it / NHB, hd = it % NHB;
    const int q32 = f_lane & 31, h = f_lane >> 5, w = F.wave;
    const int role = w >> 2, itile = (w >> 1) & 1, etile = w & 1;
    const int srow = f_tid >> 3, sch = f_tid & 7;
    const int vtr_off = ((f_lane & 15) >> 2) * 64 + (16 * ((f_lane >> 4) & 1) + 4 * (f_lane & 3)) * 2;
    const float l2g = log2f(gamma_of(hd));
    const float cd = exp2f(l2g * 64.f), sdec = exp2f(l2g * (float)(63 - srow));
    float qdv[16];
#pragma unroll
    for (int r = 0; r < 16; ++r) qdv[r] = exp2f(l2g * (float)(32 * itile + crow(r, h) + 1));
    f32x16 xs0 = {}, xs1 = {};
    const size_t trow0 = (size_t)b * SEQ;
    const bf16* gq = R + (trow0 + srow) * INC + hd * 64 + 8 * sch;
    u32x4 qA = *(const u32x4*)(gq + C_QB), kA = *(const u32x4*)(gq + C_KB), vA = *(const u32x4*)(gq + C_VB);
    u32x4 gB = *(const u32x4*)(gq + C_GB);
    u32x4 qB = *(const u32x4*)(gq + (size_t)64 * INC + C_QB), kB = *(const u32x4*)(gq + (size_t)64 * INC + C_KB), vB = *(const u32x4*)(gq + (size_t)64 * INC + C_VB);
    u32x4 gA;
    __syncthreads();
#define RT_STAGE(bufp, qreg, kreg, vreg) do { LAS unsigned char* bp_ = (bufp); \
        *(LAS u32x4*)(bp_ + RT_Q + srow * 144 + sch * 16) = qreg; *(LAS u32x4*)(bp_ + RT_K + srow * 144 + sch * 16) = kreg; \
        *(LAS u32x4*)(bp_ + RT_V + (sch >> 2) * 4096 + srow * 64 + (sch & 3) * 16) = vreg; \
        u32x4 kd_; \
        _Pragma("unroll") for (int e_ = 0; e_ < 4; ++e_) kd_[e_] = cvtpk(__uint_as_float(kreg[e_] << 16) * sdec, __uint_as_float(kreg[e_] & 0xffff0000u) * sdec); \
        *(LAS u32x4*)(bp_ + RT_KD + (sch >> 2) * 4096 + srow * 64 + (sch & 3) * 16) = kd_; } while (0)
    RT_STAGE(lds, qA, kA, vA);
    __syncthreads();
    auto chunk_step = [&](const int n, u32x4& qL, u32x4& kL, u32x4& vL, u32x4& gL, const u32x4& qW, const u32x4& kW, const u32x4& vW, const u32x4& gC) __attribute__((always_inline)) {
        LAS unsigned char* bp = lds + (n & 1) * RT_BUF;
        { const int n2 = n + 2 < NCH ? n + 2 : NCH - 1, n1 = n + 1 < NCH ? n + 1 : NCH - 1;
          const bf16* g2 = gq + (size_t)n2 * 64 * INC; qL = *(const u32x4*)(g2 + C_QB); kL = *(const u32x4*)(g2 + C_KB); vL = *(const u32x4*)(g2 + C_VB);
          gL = *(const u32x4*)(gq + (size_t)n1 * 64 * INC + C_GB); }
        if (role == 0) {
            bf16x8 qf[4];
#pragma unroll
            for (int ks = 0; ks < 4; ++ks) qf[ks] = *(const LAS bf16x8*)(bp + RT_Q + (32 * itile + q32) * 144 + (16 * ks + 8 * h) * 2);
            f32x16 st0 = {}, st1 = {};
#pragma unroll
            for (int ks = 0; ks < 4; ++ks) {
                const bf16x8 k0 = *(const LAS bf16x8*)(bp + RT_K + q32 * 144 + (16 * ks + 8 * h) * 2);
                const bf16x8 k1 = *(const LAS bf16x8*)(bp + RT_K + (32 + q32) * 144 + (16 * ks + 8 * h) * 2);
                st0 = __builtin_amdgcn_mfma_f32_32x32x16_bf16(k0, qf[ks], st0, 0, 0, 0);
                st1 = __builtin_amdgcn_mfma_f32_32x32x16_bf16(k1, qf[ks], st1, 0, 0, 0);
            }
            const int iiv = 32 * itile + q32 - 4 * h;
#pragma unroll
            for (int r = 0; r < 16; ++r) {
                const int dd = iiv - ((r & 3) + 8 * (r >> 2));
                st0[r] *= __builtin_amdgcn_exp2f(l2g * fabsf((float)dd));
                st1[r] *= __builtin_amdgcn_exp2f(l2g * fabsf((float)(dd - 32)));
            }
            f32x16 z = {};
#pragma unroll
            for (int kk = 0; kk < 4; ++kk) {
                const int key0 = 16 * kk + 4 * h;
                const v4i16 bl = ds_tr16(bp + RT_V + etile * 4096 + key0 * 64 + vtr_off), bh = ds_tr16(bp + RT_V + etile * 4096 + (key0 + 8) * 64 + vtr_off);
                const bf16x8 vb = __builtin_shufflevector(bl, bh, 0, 1, 2, 3, 4, 5, 6, 7);
                const bf16x8 xa = (kk < 2) ? pack_step(st0, kk & 1) : pack_step(st1, kk & 1);
                z = __builtin_amdgcn_mfma_f32_32x32x16_bf16(xa, vb, z, 0, 0, 0);
            }
            int zb = (32 * itile + 4 * h) * RT_ZSTR + 32 * etile + q32; asm volatile("" : "+v"(zb));
#pragma unroll
            for (int r = 0; r < 16; ++r) Zs[zb + ((r & 3) + 8 * (r >> 2)) * RT_ZSTR] = z[r];
        } else {
            f32x16 cr = {};
#pragma unroll
            for (int kk = 0; kk < 4; ++kk) {
                const LAS unsigned char* qp = bp + RT_Q + (32 * itile + q32) * 144 + (16 * kk + 4 * h) * 2;
                const v4i16 al = *(const LAS v4i16*)qp, ah = *(const LAS v4i16*)(qp + 16);
                const bf16x8 qa = __builtin_shufflevector(al, ah, 0, 1, 2, 3, 4, 5, 6, 7);
                const bf16x8 xb = (kk < 2) ? pack_step(xs0, kk & 1) : pack_step(xs1, kk & 1);
                cr = __builtin_amdgcn_mfma_f32_32x32x16_bf16(qa, xb, cr, 0, 0, 0);
            }
            int cb = (32 * itile + 4 * h) * RT_ZSTR + 32 * etile + q32; asm volatile("" : "+v"(cb));
#pragma unroll
            for (int r = 0; r < 16; ++r) Cs[cb + ((r & 3) + 8 * (r >> 2)) * RT_ZSTR] = cr[r] * qdv[r];
#pragma unroll
            for (int r = 0; r < 16; ++r) { xs0[r] *= cd; xs1[r] *= cd; }
#pragma unroll
            for (int s4 = 0; s4 < 4; ++s4) {
                const int key0 = 16 * s4 + 8 * h;
                const v4i16 vl = ds_tr16(bp + RT_V + etile * 4096 + key0 * 64 + vtr_off), vh = ds_tr16(bp + RT_V + etile * 4096 + (key0 + 4) * 64 + vtr_off);
                const bf16x8 vb = __builtin_shufflevector(vl, vh, 0, 1, 2, 3, 4, 5, 6, 7);
                const v4i16 a0l = ds_tr16(bp + RT_KD + key0 * 64 + vtr_off), a0h = ds_tr16(bp + RT_KD + (key0 + 4) * 64 + vtr_off);
                const v4i16 a1l = ds_tr16(bp + RT_KD + 4096 + key0 * 64 + vtr_off), a1h = ds_tr16(bp + RT_KD + 4096 + (key0 + 4) * 64 + vtr_off);
                const bf16x8 ka0 = __builtin_shufflevector(a0l, a0h, 0, 1, 2, 3, 4, 5, 6, 7), ka1 = __builtin_shufflevector(a1l, a1h, 0, 1, 2, 3, 4, 5, 6, 7);
                xs0 = __builtin_amdgcn_mfma_f32_32x32x16_bf16(ka0, vb, xs0, 0, 0, 0);
                xs1 = __builtin_amdgcn_mfma_f32_32x32x16_bf16(ka1, vb, xs1, 0, 0, 0);
            }
        }
        __syncthreads();
        {
            const LAS float* zr = Zs + srow * RT_ZSTR + 8 * sch; const LAS float* cp = Cs + srow * RT_ZSTR + 8 * sch;
            f32x4 v0 = *(const LAS f32x4*)zr + *(const LAS f32x4*)cp, v1 = *(const LAS f32x4*)(zr + 4) + *(const LAS f32x4*)(cp + 4);
            const float mu = red8(((v0[0] + v0[1]) + (v0[2] + v0[3])) + ((v1[0] + v1[1]) + (v1[2] + v1[3]))) * (1.f / 64.f);
            v0 = v0 - mu; v1 = v1 - mu;
            const float var = red8(((v0[0] * v0[0] + v0[1] * v0[1]) + (v0[2] * v0[2] + v0[3] * v0[3])) + ((v1[0] * v1[0] + v1[1] * v1[1]) + (v1[2] * v1[2] + v1[3] * v1[3]))) * (1.f / 64.f);
            const float rs = frsq(var + EPS);
            float o8[8];
#pragma unroll
            for (int e = 0; e < 4; ++e) {
                const float g0 = __uint_as_float(gC[e] << 16), g1 = __uint_as_float(gC[e] & 0xffff0000u);
                const float x0 = e < 2 ? v0[2 * e] : v1[2 * e - 4], x1 = e < 2 ? v0[2 * e + 1] : v1[2 * e - 3];
                o8[2 * e] = x0 * rs * (g0 * frcp(1.f + __expf(-g0))); o8[2 * e + 1] = x1 * rs * (g1 * frcp(1.f + __expf(-g1)));
            }
            *(u32x4*)(O + (trow0 + n * 64 + srow) * DM + 512 + hd * 64 + 8 * sch) = (u32x4){cvtpk(o8[0], o8[1]), cvtpk(o8[2], o8[3]), cvtpk(o8[4], o8[5]), cvtpk(o8[6], o8[7])};
        }
        if (n + 1 < NCH) RT_STAGE(lds + ((n + 1) & 1) * RT_BUF, qW, kW, vW);
        __syncthreads();
    };
    for (int n = 0; n < NCH; n += 2) { chunk_step(n, qA, kA, vA, gA, qB, kB, vB, gB); chunk_step(n + 1, qB, kB, vB, gB, qA, kA, vA, gA); }
#undef RT_STAGE
}
DI float max3_abs(const float a, const float x, const float y) { float r; asm("v_max3_f32 %0, %1, |%2|, |%3|" : "=v"(r) : "v"(a), "v"(x), "v"(y)); return r; }
DI void int8_rows(Frame& F, const int row0, const int nrows, const int f_lane) {
    const int tab = row0 / PE, e0 = row0 % PE, layer = tab & 1, isv = tab >> 1;
    f32x4 gn[4];
    { const f32x4* gp = (const f32x4*)(F.ffn_norm + layer * DM) + f_lane;
#pragma unroll
      for (int j = 0; j < 4; ++j) gn[j] = isv ? (f32x4){1.f, 1.f, 1.f, 1.f} : gp[64 * j]; }
    const f32x4* src = (const f32x4*)((isv ? F.peer_v : F.peer_u) + ((size_t)layer * PE + e0) * DM) + f_lane;
    unsigned* dst = (unsigned*)(F.ws + (isv ? WS_V8 : WS_U8)) + (size_t)layer * 4 * PE * 32 + (size_t)e0 * 32 + (f_lane >> 1);
    float* scp = (float*)(F.ws + WS_SC) + tab * PE + e0;
    const unsigned xmask = (isv && !(f_lane & 1)) ? 0u : 0x08080808u;
    const int sh = (f_lane & 1) * 4;
    const float scmul = isv ? (1.f / 16.f) : 1.f;
    f32x4 A[4][4], B[4][4];
#define Q4_LOAD(D, r) do { _Pragma("unroll") for (int u_ = 0; u_ < 4; ++u_) _Pragma("unroll") for (int j_ = 0; j_ < 4; ++j_) D[u_][j_] = __builtin_nontemporal_load(src + (size_t)((r) + u_) * 256 + 64 * j_);     } while (0)
#define Q4_PROC(D, r) do { _Pragma("unroll") for (int u_ = 0; u_ < 4; ++u_) { \
        float a_ = 0.f; f32x4 sq_ = {0.f, 0.f, 0.f, 0.f}; \
        _Pragma("unroll") for (int j_ = 0; j_ < 4; ++j_) { D[u_][j_] = D[u_][j_] * gn[j_]; a_ = max3_abs(max3_abs(a_, D[u_][j_][0], D[u_][j_][1]), D[u_][j_][2], D[u_][j_][3]); sq_ += D[u_][j_] * D[u_][j_]; } \
        a_ = wave_max(a_); \
        const float step_ = fminf(0.355f * fsqrt(wave_sum((sq_[0] + sq_[1]) + (sq_[2] + sq_[3])) * (1.f / DM)), a_ * (1.f / 7.f)); \
        const float sc_ = step_ > 0.f ? frcp(step_) : 0.f; \
        _Pragma("unroll") for (int j_ = 0; j_ < 4; ++j_) {                  \
            const f32x4 t_ = D[u_][j_] * sc_ + 8388616.f;                   \
            const unsigned b0_ = __float_as_uint(__builtin_amdgcn_fmed3f(t_[0], 8388609.f, 8388623.f)), b1_ = __float_as_uint(__builtin_amdgcn_fmed3f(t_[1], 8388609.f, 8388623.f)); \
            const unsigned b2_ = __float_as_uint(__builtin_amdgcn_fmed3f(t_[2], 8388609.f, 8388623.f)), b3_ = __float_as_uint(__builtin_amdgcn_fmed3f(t_[3], 8388609.f, 8388623.f)); \
            unsigned w_ = __builtin_amdgcn_perm(__builtin_amdgcn_perm(b3_, b2_, 0x0c0c0400u), __builtin_amdgcn_perm(b1_, b0_, 0x0c0c0400u), 0x05040100u); \
            w_ = (w_ ^ xmask) << sh; \
            w_ |= (unsigned)DPP_MOV_I((int)w_, DPP_XOR1); \
            if (!(f_lane & 1)) dst[((size_t)j_ * PE + (r) + u_) * 32] = w_; \
        } \
        if (f_lane == 0) scp[(r) + u_] = step_ * scmul; } } while (0)
    Q4_LOAD(A, 0);
    for (int r = 0; r < nrows; r += 8) {
        Q4_LOAD(B, r + 4);
        Q4_PROC(A, r);
        { const int rn = r + 8 < nrows ? r + 8 : r + 4;
          Q4_LOAD(A, rn); }
        Q4_PROC(B, r + 4);
    }
#undef Q4_LOAD
#undef Q4_PROC
}
constexpr int Q8_ITEM_ROWS = 512, Q8_ITEMS = 4 * PE / Q8_ITEM_ROWS;
constexpr int PH_MIX_ID = 3;
DI int attn_order(const int q) { return q < 768 ? (q / 6) * 8 + (q % 6) + 2 : ((q - 768) & 127) * 8 + ((q - 768) < 128 ? 1 : 0); }
constexpr int QG = 2;
DI void mix_phase(Frame& F, const int rep) {
    FRAME_IDS;
    unsigned* ctr = (unsigned*)(F.ws + WS_CTL) + CW_QUEUE + 64 * rep;
    volatile LAS unsigned* slot = (volatile LAS unsigned*)(F.lds + MISC_OFF) + 16;
    constexpr int N_RET = NB * NHB, N_ATT = NB * NHA * 8;
    static_assert(N_ATT == 8 * Q8_ITEMS, "8 attention items per quantisation item");
    __syncthreads();
    for (int k = f_tid; k < NHA * 321; k += NTHR) { const int hd_ = k / 321, e_ = k % 321; ((LAS float*)(F.lds + AT_BIAS))[hd_ * AT_BIAS_STRIDE + e_] = F.rel_bias[hd_ * 257 + (e_ < 256 ? e_ : 256)] * LOG2E; }
    for (;;) {
        __syncthreads();
        if (f_tid == 0) slot[0] = __hip_atomic_fetch_add(ctr, 1u, __ATOMIC_RELAXED, __HIP_MEMORY_SCOPE_AGENT);
        __syncthreads();
        const int idx = (int)slot[0];
        if (idx >= N_RET + N_ATT + Q8_ITEMS) break;
        const bool probe_pass = (REP_PHASE == PH_MIX_ID && rep == 0);
        if (idx < N_RET) { if (!(probe_pass && PROBE_MODE >= 4)) ret_item(F, idx); }
        else if (probe_pass && PROBE_MODE == 3) { }
        else { const int k = idx - N_RET;
            if (k < QG * Q8_ITEMS) { const int grp = k / QG, pos = k % QG;
                if (pos == QG - 1) { if (!(probe_pass && PROBE_MODE == 5)) int8_rows(F, grp * Q8_ITEM_ROWS + F.wave * 64, 64, f_lane); }
                else if (!(probe_pass && PROBE_MODE == 6)) attn_item(F, attn_order((QG - 1) * grp + pos)); }
            else if (!(probe_pass && PROBE_MODE == 6)) attn_item(F, attn_order(k - Q8_ITEMS)); }
    }
}
DI float fmax_raw(float a, float b) { float r; asm("v_max_f32_e32 %0, %1, %2" : "=v"(r) : "v"(a), "v"(b)); return r; }
DI float fmin_raw(float a, float b) { float r; asm("v_min_f32_e32 %0, %1, %2" : "=v"(r) : "v"(a), "v"(b)); return r; }
#define CE_DESC(x, y) do { const float hi_ = fmax_raw((x), (y)), lo_ = fmin_raw((x), (y)); (x) = hi_; (y) = lo_; } while (0)
template <int N> DI void sort_desc(float* v) {
#pragma unroll
    for (int k = 2; k <= N; k <<= 1)
#pragma unroll
        for (int j = k >> 1; j > 0; j >>= 1)
#pragma unroll
            for (int i = 0; i < N; ++i) { const int l = i ^ j; if (l > i) { if ((i & k) == 0 || k == N) CE_DESC(v[i], v[l]); else CE_DESC(v[l], v[i]); } }
}
DI void merge16(float* a, const float* b) {
#pragma unroll
    for (int i = 0; i < 16; ++i) a[i] = fmax_raw(a[i], b[15 - i]);
#pragma unroll
    for (int j = 8; j > 0; j >>= 1)
#pragma unroll
        for (int i = 0; i < 16; ++i) { const int l = i ^ j; if (l > i) CE_DESC(a[i], a[l]); }
}
DI void sort16n(float* v) {
    CE_DESC(v[0], v[13]); CE_DESC(v[1], v[12]); CE_DESC(v[2], v[15]); CE_DESC(v[3], v[14]); CE_DESC(v[4], v[8]); CE_DESC(v[5], v[6]); CE_DESC(v[7], v[11]); CE_DESC(v[9], v[10]);
    CE_DESC(v[0], v[5]); CE_DESC(v[1], v[7]); CE_DESC(v[2], v[9]); CE_DESC(v[3], v[4]); CE_DESC(v[6], v[13]); CE_DESC(v[8], v[14]); CE_DESC(v[10], v[15]); CE_DESC(v[11], v[12]);
    CE_DESC(v[0], v[1]); CE_DESC(v[2], v[3]); CE_DESC(v[4], v[5]); CE_DESC(v[6], v[8]); CE_DESC(v[7], v[9]); CE_DESC(v[10], v[11]); CE_DESC(v[12], v[13]); CE_DESC(v[14], v[15]);
    CE_DESC(v[0], v[2]); CE_DESC(v[1], v[3]); CE_DESC(v[4], v[10]); CE_DESC(v[5], v[11]); CE_DESC(v[6], v[7]); CE_DESC(v[8], v[9]); CE_DESC(v[12], v[14]); CE_DESC(v[13], v[15]);
    CE_DESC(v[1], v[2]); CE_DESC(v[3], v[12]); CE_DESC(v[4], v[6]); CE_DESC(v[5], v[7]); CE_DESC(v[8], v[10]); CE_DESC(v[9], v[11]); CE_DESC(v[13], v[14]);
    CE_DESC(v[1], v[4]); CE_DESC(v[2], v[6]); CE_DESC(v[5], v[8]); CE_DESC(v[7], v[10]); CE_DESC(v[9], v[13]); CE_DESC(v[11], v[14]);
    CE_DESC(v[2], v[4]); CE_DESC(v[3], v[6]); CE_DESC(v[9], v[12]); CE_DESC(v[11], v[13]);
    CE_DESC(v[3], v[5]); CE_DESC(v[6], v[8]); CE_DESC(v[7], v[9]); CE_DESC(v[10], v[12]);
    CE_DESC(v[3], v[4]); CE_DESC(v[5], v[6]); CE_DESC(v[7], v[8]); CE_DESC(v[9], v[10]); CE_DESC(v[11], v[12]);
    CE_DESC(v[6], v[7]); CE_DESC(v[8], v[9]);
}
DI void bitonic16(float* a) {
#pragma unroll
    for (int j = 8; j > 0; j >>= 1)
#pragma unroll
        for (int i = 0; i < 16; ++i) { const int l = i ^ j; if (l > i) CE_DESC(a[i], a[l]); }
}
DI float key_pack(float v, unsigned keep_mask, unsigned idx) { return __uint_as_float((__float_as_uint(v) & keep_mask) | idx); }
DI void opt_route(Frame& F, int layer) {
    FRAME_IDS;
    const bf16* Q = (const bf16*)(F.ws + WS_Q);
    unsigned short* eidx = (unsigned short*)(F.ws + WS_EIDX); unsigned short* gate = (unsigned short*)(F.ws + WS_GATE);
    const float* keys = F.peer_keys + (size_t)layer * 2 * PK * 64;
    LAS unsigned char* kl = F.lds;
    __syncthreads();
    for (int idx = f_tid; idx < 2 * PK * 8; idx += NTHR) {
        const int row = idx >> 3, ch = idx & 7;
        const f32x4 a = *(const f32x4*)(keys + (size_t)row * 64 + ch * 8), b = *(const f32x4*)(keys + (size_t)row * 64 + ch * 8 + 4);
        *(LAS u32x4*)(kl + row * 144 + ch * 16) = (u32x4){pk2(a[0], a[1]), pk2(a[2], a[3]), pk2(b[0], b[1]), pk2(b[2], b[3])};
    }
    __syncthreads();
    LAS int* lut = (LAS int*)(F.lds + 40960 + F.wave * 8192);
    const int c = f_lane & 31, h = f_lane >> 5;
    pg8::StaticOrder SO; SO.init(T, DM, F.G, F.bid);
    pg8::Unit un;
    for (int ui = 0; SO.next(ui, un); ++ui)
    for (int k2 = F.wave; k2 < 8; k2 += NWAVES) {
        const int tile = 4 * un.pm + (k2 & 3), hh = 2 * un.pn + (k2 >> 2), t0 = tile * 64 + c, t = t0 + 32 * h;
        float tk[2][16];
#pragma unroll
        for (int side = 0; side < 2; ++side) {
            float top[2][16];
#pragma unroll
            for (int ct = 0; ct < 2; ++ct) {
                bf16x8 qf[4];
#pragma unroll
                for (int ks = 0; ks < 4; ++ks) qf[ks] = *(const bf16x8*)(Q + (size_t)(t0 + 32 * ct) * DM + hh * PQD + side * 64 + 16 * ks + 8 * h);
                float v[64];
#pragma unroll
                for (int kt = 0; kt < 4; ++kt) {
                    f32x16 acc = {};
#pragma unroll
                    for (int ks = 0; ks < 4; ++ks) {
                        const bf16x8 a = *(const LAS bf16x8*)(kl + (side * PK + 32 * kt + c) * 144 + (16 * ks + 8 * h) * 2);
                        acc = __builtin_amdgcn_mfma_f32_32x32x16_bf16(a, qf[ks], acc, 0, 0, 0);
                    }
#pragma unroll
                    for (int r = 0; r < 16; ++r) v[16 * kt + r] = key_pack(acc[r], 0xFFFFFF80u, (unsigned)(32 * kt + (r & 3) + 8 * (r >> 2) + 4 * h));
                }
                sort16n(v); sort16n(v + 16); sort16n(v + 32); sort16n(v + 48);
                merge16(v, v + 16); merge16(v + 32, v + 48); merge16(v, v + 32);
#pragma unroll
                for (int i = 0; i < 16; ++i) top[ct][i] = v[i];
                __builtin_amdgcn_sched_barrier(0);
            }
#pragma unroll
            for (int i = 0; i < 16; ++i) { const auto sw = __builtin_amdgcn_permlane32_swap(__float_as_uint(top[0][i]), __float_as_uint(top[1][i]), false, false); top[0][i] = __uint_as_float(sw[0]); top[1][i] = __uint_as_float(sw[1]); }
            merge16(top[0], top[1]);
#pragma unroll
            for (int i = 0; i < 16; ++i) { tk[side][i] = top[0][i]; lut[(side * 16 + i) * 64 + f_lane] = (int)(__float_as_uint(top[0][i]) & 0x7Fu); }
            __builtin_amdgcn_sched_barrier(0);
        }
#define CAND(a_, b_) key_pack(tk[0][a_] + tk[1][b_], 0xFFFFFF00u, (unsigned)((a_) * 16 + (b_)))
        float cd[16], cy[16], cz[16];
#pragma unroll
        for (int b = 0; b < 16; ++b) cd[b] = CAND(0, b);
#pragma unroll
        for (int b = 0; b < 8; ++b) { cy[b] = CAND(1, b); cy[8 + b] = CAND(15 - b, 0); }
        bitonic16(cy);
        cz[0] = CAND(2, 0); cz[1] = CAND(2, 1); cz[2] = CAND(2, 2); cz[3] = CAND(2, 3); cz[4] = CAND(2, 4); cz[5] = CAND(3, 0); cz[6] = CAND(3, 1); cz[7] = CAND(3, 2); cz[8] = CAND(3, 3);
        cz[9] = CAND(4, 0); cz[10] = CAND(4, 1); cz[11] = CAND(4, 2); cz[12] = CAND(5, 0); cz[13] = CAND(5, 1); cz[14] = CAND(6, 0); cz[15] = CAND(6, 1);
        sort16n(cz);
        cz[15] = fmax_raw(cz[15], CAND(7, 0)); cz[14] = fmax_raw(cz[14], CAND(7, 1));
        bitonic16(cz);
        merge16(cd, cy); merge16(cd, cz);
#undef CAND
        int ex[16]; float gv[16]; float sum = 0.f;
        const float top = __uint_as_float(__float_as_uint(cd[0]) & 0xFFFFFF00u);
#pragma unroll
        for (int i = 0; i < 16; ++i) {
            const unsigned bits = __float_as_uint(cd[i]);
            const int a = (bits >> 4) & 15, b = bits & 15;
            ex[i] = lut[a * 64 + f_lane] * PK + lut[(16 + b) * 64 + f_lane];
            gv[i] = __expf(__uint_as_float(bits & 0xFFFFFF00u) - top); sum += gv[i];
        }
        const float inv = frcp(sum);
        u32x4* ep = (u32x4*)(eidx + (size_t)t * NSEL + hh * 16);
#pragma unroll
        for (int q = 0; q < 2; ++q) ep[q] = (u32x4){(unsigned)ex[8 * q] | ((unsigned)ex[8 * q + 1] << 16), (unsigned)ex[8 * q + 2] | ((unsigned)ex[8 * q + 3] << 16), (unsigned)ex[8 * q + 4] | ((unsigned)ex[8 * q + 5] << 16), (unsigned)ex[8 * q + 6] | ((unsigned)ex[8 * q + 7] << 16)};
        u32x4* gp = (u32x4*)(gate + (size_t)t * NSEL + hh * 16);
#pragma unroll
        for (int q = 0; q < 2; ++q) gp[q] = (u32x4){cvtpk(gv[8 * q] * inv, gv[8 * q + 1] * inv), cvtpk(gv[8 * q + 2] * inv, gv[8 * q + 3] * inv), cvtpk(gv[8 * q + 4] * inv, gv[8 * q + 5] * inv), cvtpk(gv[8 * q + 6] * inv, gv[8 * q + 7] * inv)};
    }
    __syncthreads();
}
struct XInfo { int xrank, nx, rank, nloc; };
DI XInfo get_xinfo(Frame& F, const bool census) {
    FRAME_IDS;
    volatile LAS unsigned* M = (volatile LAS unsigned*)(F.lds + MISC_OFF);
    __syncthreads();
    if (f_tid == 0) {
        unsigned xr = (unsigned)F.bid & 7u, nx = 8u, rk = (unsigned)F.bid >> 3, nl = ((unsigned)F.G + 7u - ((unsigned)F.bid & 7u)) >> 3;
        if (census) {
            unsigned* bar = (unsigned*)(F.ws + WS_CTL) + CW_BAR; const unsigned x = xb_xcc_id();
            unsigned cnt = 0u, below = 0u, mine = 0u;
#pragma unroll
            for (unsigned j = 0; j < 16; ++j) { const unsigned c = xb_ld(&bar[XB_XCNT(j)]); cnt += (c > 0u); below += (c > 0u && j < x); mine = (j == x) ? c : mine; }
            if (cnt > 0u && mine > 0u) { xr = below; nx = cnt; rk = M[12]; nl = mine; }
        }
        M[20] = xr; M[21] = nx; M[22] = rk; M[23] = nl;
    }
    __syncthreads();
    XInfo xi; xi.xrank = (int)M[20]; xi.nx = (int)M[21]; xi.rank = (int)M[22]; xi.nloc = (int)M[23];
    return xi;
}
DI int comb_c(const int level, const int a, const int b, const int lane) {
    const int M = 4 >> level; const bool bit = (lane & M) != 0;
    const int send = bit ? a : b, keep = bit ? b : a;
    const int recv = level == 0 ? DPP_MOV_I(send, DPP_HMIRROR) : (level == 1 ? DPP_MOV_I(send, DPP_XOR2) : DPP_MOV_I(send, DPP_XOR1));
    return keep + recv;
}
DI int dot16_i8(const u32x4 r, const u32x4 x) {
    int s = __builtin_amdgcn_sdot4((int)r[0], (int)x[0], 0, false);
    s = __builtin_amdgcn_sdot4((int)r[1], (int)x[1], s, false); s = __builtin_amdgcn_sdot4((int)r[2], (int)x[2], s, false); s = __builtin_amdgcn_sdot4((int)r[3], (int)x[3], s, false);
    return s;
}
DI int half_dots(const u32x4 (&rows)[8], const u32x4 xq, const int lane) {
    int p[8];
#pragma unroll
    for (int i = 0; i < 8; ++i) p[i] = dot16_i8(rows[i], xq);
#pragma unroll
    for (int i = 0; i < 4; ++i) p[i] = comb_c(0, p[2 * i], p[2 * i + 1], lane);
    p[0] = comb_c(1, p[0], p[1], lane); p[1] = comb_c(1, p[2], p[3], lane);
    return comb_c(2, p[0], p[1], lane);
}
DI u32x4 xquant(const f32x4 (&hv)[4], const float rstd) {
    u32x4 o;
#pragma unroll
    for (int w = 0; w < 4; ++w) {
        const f32x4 x = hv[w] * (rstd * XQ);
        const int a = (int)rintf(__builtin_amdgcn_fmed3f(x[0], -127.f, 127.f)), b = (int)rintf(__builtin_amdgcn_fmed3f(x[1], -127.f, 127.f)), c = (int)rintf(__builtin_amdgcn_fmed3f(x[2], -127.f, 127.f)), d = (int)rintf(__builtin_amdgcn_fmed3f(x[3], -127.f, 127.f));
        o[w] = ((unsigned)a & 0xFFu) | (((unsigned)b & 0xFFu) << 8) | (((unsigned)c & 0xFFu) << 16) | ((unsigned)d << 24);
    }
    return o;
}
DI float rstd_bcast(const float* part, const int t) {
    const f32x4* p = (const f32x4*)(part + (size_t)t * 16);
    const f32x4 a = p[0], b = p[1], c = p[2], d = p[3];
    const float s = ((a[0] + a[1]) + (a[2] + a[3])) + ((b[0] + b[1]) + (b[2] + b[3])) + ((c[0] + c[1]) + (c[2] + c[3])) + ((d[0] + d[1]) + (d[2] + d[3]));
    return frsq(s * (1.f / DM) + EPS);
}
DI int dot8_z(const unsigned a, const unsigned b) { int r; asm("v_dot8_i32_i4 %0, %1, %2, 0" : "=v"(r) : "v"(a), "v"(b)); return r; }
DI int dot4_z(const unsigned a, const unsigned b) { int r; asm("v_dot4_i32_i8 %0, %1, %2, 0" : "=v"(r) : "v"(a), "v"(b)); return r; }
DI int dot4_v(const unsigned a, const unsigned b, const int c) { int r; asm("v_dot4_i32_i8 %0, %1, %2, %3" : "=v"(r) : "v"(a), "v"(b), "v"(c)); return r; }
DI int dot32_i4(const u32x4 r, const u32x4 xh, const u32x4 xl) {
    int ah = dot8_z(r[0], xh[0]);
#pragma unroll
    for (int d = 1; d < 4; ++d) ah = __builtin_amdgcn_sdot8((int)r[d], (int)xh[d], ah, false);
    int al = ah << 4;
#pragma unroll
    for (int d = 0; d < 4; ++d) al = __builtin_amdgcn_sdot8((int)r[d], (int)xl[d], al, false);
    return al;
}
DI int half_dots4(const u32x4 (&rows)[8], const u32x4 xa, const u32x4 xb, const int lane) {
    int p[8];
#pragma unroll
    for (int i = 0; i < 8; ++i) p[i] = dot32_i4(rows[i], xa, xb);
#pragma unroll
    for (int i = 0; i < 4; ++i) p[i] = comb_c(0, p[2 * i], p[2 * i + 1], lane);
    p[0] = comb_c(1, p[0], p[1], lane); p[1] = comb_c(1, p[2], p[3], lane);
    return comb_c(2, p[0], p[1], lane);
}
DI void gather_u(Frame& F, const int layer, const XInfo xi, const bool dry) {
    FRAME_IDS;
    const unsigned emask = (dry && PROBE_MODE == 2) ? 15u : ((dry && PROBE_MODE == 5) ? 4095u : 0xFFFFFFFFu);
    const unsigned short* eidx = (const unsigned short*)(F.ws + WS_EIDX); short* PU = (short*)(F.ws + (dry ? WS_R : WS_PU)); const float* part = (const float*)(F.ws + WS_PART); const bf16* hbp = (const bf16*)(F.ws + WS_XB);
    const int g = f_lane >> 3, c = f_lane & 7, c16 = c * 16;
    const int kst = 16 * g + (((c & 1) << 2) | (c & 2) | ((c & 4) >> 2));
    const int gwl = xi.rank * NWAVES + F.wave, NGWL = xi.nloc * NWAVES;
    LAS unsigned char* wl = F.lds + F.wave * 2048;
    __syncthreads();
    for (int j = xi.xrank; j < 8; j += xi.nx) {
        const int sl = j & 3, th = j >> 2;
        const __amdgpu_buffer_rsrc_t U8 = __builtin_amdgcn_make_buffer_rsrc((void*)(F.ws + WS_U8 + ((size_t)(layer * 4 + sl) * PE) * 128), 0, PE * 128, 0x00020000);
        int tt = gwl;
        if (tt >= T / 2) continue;
#define TOK(x_) (2 * (x_) + th)
#define U_LOAD(tk, ri, rh, rp) do { { const unsigned w_ = *(const unsigned*)(eidx + (size_t)(tk) * NSEL + 2 * f_lane); ri = (u32x2){w_ & 0xFFFFu, w_ >> 16} & emask; } rh = *(const u32x2*)(hbp + (size_t)(tk) * DM + 256 * sl + 4 * f_lane); \
            rp = part[(size_t)(tk) * 16 + (f_lane & 15)]; } while (0)
#define U_SPREAD(slot, ri, rh, rp, e, xa_, xb_) do { \
            float ps_ = rp; ps_ += __int_as_float(DPP_MOV_I(__float_as_int(ps_), DPP_XOR1)); ps_ += __int_as_float(DPP_MOV_I(__float_as_int(ps_), DPP_XOR2)); ps_ += __int_as_float(DPP_MOV_I(__float_as_int(ps_), DPP_HMIRROR)); ps_ += __int_as_float(DPP_MOV_I(__float_as_int(ps_), DPP_ROR8)); \
            const float rs_ = frsq(ps_ * (1.f / DM) + EPS) * XQ; \
              \
              \
            const unsigned b0_ = __float_as_uint(__builtin_amdgcn_fmed3f(__uint_as_float(rh[0] << 16) * rs_ + 12582912.f, 12582793.f, 12583031.f)), b1_ = __float_as_uint(__builtin_amdgcn_fmed3f(__uint_as_float(rh[0] & 0xffff0000u) * rs_ + 12582912.f, 12582793.f, 12583031.f)); \
            const unsigned b2_ = __float_as_uint(__builtin_amdgcn_fmed3f(__uint_as_float(rh[1] << 16) * rs_ + 12582912.f, 12582793.f, 12583031.f)), b3_ = __float_as_uint(__builtin_amdgcn_fmed3f(__uint_as_float(rh[1] & 0xffff0000u) * rs_ + 12582912.f, 12582793.f, 12583031.f)); \
            const unsigned q4_ = __builtin_amdgcn_perm(__builtin_amdgcn_perm(b3_, b2_, 0x0c0c0400u), __builtin_amdgcn_perm(b1_, b0_, 0x0c0c0400u), 0x05040100u); \
            unsigned wl_ = q4_ & 0x0F0F0F0Fu; \
            unsigned wh_ = ((((q4_ ^ 0x80808080u) + 0x08080808u) >> 4) & 0x0F0F0F0Fu) ^ 0x08080808u; \
            if (f_lane & 1) { wh_ <<= 4; wl_ <<= 4; } \
            wh_ |= (unsigned)DPP_MOV_I((int)wh_, DPP_XOR1); wl_ |= (unsigned)DPP_MOV_I((int)wl_, DPP_XOR1); \
            LAS unsigned char* sl_ = wl + (slot) * 1024; \
            *(LAS u32x2*)(sl_ + 8 * f_lane) = ri; if (!(f_lane & 1)) { *(LAS unsigned*)(sl_ + 512 + 2 * f_lane) = wh_; *(LAS unsigned*)(sl_ + 768 + 2 * f_lane) = wl_; } \
            asm volatile("s_waitcnt lgkmcnt(0)" ::: "memory"); \
            _Pragma("unroll") for (int q_ = 0; q_ < 4; ++q_) e[q_] = *(const LAS u32x4*)(sl_ + 64 * g + 16 * q_); \
            xa_ = *(const LAS u32x4*)(sl_ + 512 + 16 * c); xb_ = *(const LAS u32x4*)(sl_ + 768 + 16 * c); } while (0)
        u32x2 ri, rh; float rp;
        u32x4 e0[4], e1[4], xa, xb, xa1, xb1;
        U_LOAD(TOK(tt), ri, rh, rp); U_SPREAD(0, ri, rh, rp, e0, xa, xb);
        { const int t1 = (tt + NGWL < T / 2) ? tt + NGWL : tt; U_LOAD(TOK(t1), ri, rh, rp); U_SPREAD(1, ri, rh, rp, e1, xa1, xb1); }
        { const int t2 = (tt + 2 * NGWL < T / 2) ? tt + 2 * NGWL : tt; U_LOAD(TOK(t2), ri, rh, rp); }
        u32x4 A0[8], B0[8], A1[8], B1[8];
#pragma unroll
        for (int i = 0; i < 8; ++i) A0[i] = __builtin_amdgcn_raw_buffer_load_b128(U8, (int)e0[i >> 2][i & 3] * 128 + c16, 0, 0);
#pragma unroll
        for (int i = 0; i < 8; ++i) B0[i] = __builtin_amdgcn_raw_buffer_load_b128(U8, (int)e0[2 + (i >> 2)][i & 3] * 128 + c16, 0, 0);
#define U_ITEM(CA, CB, NA, NB, slot) do { \
            __builtin_amdgcn_sched_barrier(0); \
            _Pragma("unroll") for (int i = 0; i < 8; ++i) NA[i] = __builtin_amdgcn_raw_buffer_load_b128(U8, (int)e1[i >> 2][i & 3] * 128 + c16, 0, 0); \
            __builtin_amdgcn_sched_barrier(0); \
            const int r0 = half_dots4(CA, xa, xb, f_lane); \
            __builtin_amdgcn_sched_barrier(0); \
            _Pragma("unroll") for (int i = 0; i < 8; ++i) NB[i] = __builtin_amdgcn_raw_buffer_load_b128(U8, (int)e1[2 + (i >> 2)][i & 3] * 128 + c16, 0, 0); \
            __builtin_amdgcn_sched_barrier(0); \
            const int rr1 = half_dots4(CB, xa, xb, f_lane); \
            short* pp = PU + ((size_t)TOK(tt) * 4 + sl) * NSEL + kst; \
            pp[0] = (short)((r0 + 4) >> 3); pp[8] = (short)((rr1 + 4) >> 3); \
            xa = xa1; xb = xb1; \
            U_SPREAD(slot, ri, rh, rp, e1, xa1, xb1);                   \
            { const int t3 = (tt + 3 * NGWL < T / 2) ? tt + 3 * NGWL : tt; U_LOAD(TOK(t3), ri, rh, rp); } } while (0)
        while (tt + NGWL < T / 2) {
            U_ITEM(A0, B0, A1, B1, 0); tt += NGWL;
            U_ITEM(A1, B1, A0, B0, 1); tt += NGWL;
        }
        if (tt < T / 2) { U_ITEM(A0, B0, A1, B1, 0); }
#undef U_ITEM
#undef U_LOAD
#undef U_SPREAD
#undef TOK
    }
    __syncthreads();
}
DI void gather_r(Frame& F, const int layer) {
    FRAME_IDS;
    const short* PU = (const short*)(F.ws + WS_PU); const unsigned short* gate = (const unsigned short*)(F.ws + WS_GATE); const unsigned short* eidx = (const unsigned short*)(F.ws + WS_EIDX);
    const float* SCu = (const float*)(F.ws + WS_SC) + (size_t)layer * PE; const float* SCv = (const float*)(F.ws + WS_SC) + (size_t)(2 + layer) * PE;
    signed char* A8 = (signed char*)(F.ws + WS_A); float* SA = (float*)(F.ws + WS_SA);
    const int gw = F.bid * NWAVES + F.wave, NGW = F.G * NWAVES;
    LAS float* scu = (LAS float*)F.lds; LAS float* scv = scu + PE;
    __syncthreads();
    for (int i = f_tid; i < PE / 4; i += NTHR) { ((LAS f32x4*)scu)[i] = ((const f32x4*)SCu)[i]; ((LAS f32x4*)scv)[i] = ((const f32x4*)SCv)[i]; }
    __syncthreads();
    const int ntok = gw < T ? (T - gw + NGW - 1) / NGW : 0;
    if (layer == 0) {
        const float* part = (const float*)(F.ws + WS_PART); float* srow = (float*)(F.ws + WS_ROWSC) + 2 * T;
        for (int i = 0; i < ntok; ++i) { const int t = gw + i * NGW; float p = part[(size_t)t * 16 + (f_lane & 15)];
            p += __int_as_float(DPP_MOV_I(__float_as_int(p), DPP_XOR1)); p += __int_as_float(DPP_MOV_I(__float_as_int(p), DPP_XOR2)); p += __int_as_float(DPP_MOV_I(__float_as_int(p), DPP_HMIRROR)); p += __int_as_float(DPP_MOV_I(__float_as_int(p), DPP_ROR8));
            srow[t] = fsqrt(p * (1.f / DM) + EPS) * (8.f / 127.f); }
    }
    struct RSet { int pu[2][4]; int e[2]; float g[2], su[2], sv[2]; };
    RSet X, Y, Z;
#define R_TOK(i_) (gw + ((i_) < ntok ? (i_) : ntok - 1) * NGW)
#define R_LOAD(S, tk) do { const size_t t_ = (size_t)(tk); _Pragma("unroll") for (int hf = 0; hf < 2; ++hf) { const int k = 64 * hf + f_lane; \
        _Pragma("unroll") for (int j = 0; j < 4; ++j) S.pu[hf][j] = (int)PU[(t_ * 4 + j) * NSEL + k]; S.e[hf] = (int)eidx[t_ * NSEL + k]; S.g[hf] = bf2f(gate[t_ * NSEL + k]); } } while (0)
#define R_GATHER(S) do { _Pragma("unroll") for (int hf = 0; hf < 2; ++hf) { S.su[hf] = scu[S.e[hf]]; S.sv[hf] = scv[S.e[hf]]; } } while (0)
#define R_STEP(i_, C, N, L) do { \
        R_LOAD(L, R_TOK((i_) + 2)); \
        R_GATHER(N); \
        const int t = R_TOK(i_); float a[2]; \
        _Pragma("unroll") for (int hf = 0; hf < 2; ++hf) { \
            const int sacc = (C.pu[hf][0] + C.pu[hf][1]) + (C.pu[hf][2] + C.pu[hf][3]); \
            const float d = (float)sacc * (C.su[hf] * (8.f / XQ));         \
            a[hf] = gelu_erf(d) * C.g[hf] * C.sv[hf]; } \
        const float am = wave_max(fmaxf(fabsf(a[0]), fabsf(a[1])));         \
        const float sc = am > 0.f ? 127.f * frcp(am) : 0.f; \
        A8[(size_t)t * NSEL + f_lane] = (signed char)(int)rintf(a[0] * sc); \
        A8[(size_t)t * NSEL + 64 + f_lane] = (signed char)(int)rintf(a[1] * sc); \
        if (f_lane == 0) SA[t] = am * (1.f / 127.f); } while (0)
    if (ntok > 0) {
        R_LOAD(X, R_TOK(0)); R_LOAD(Y, R_TOK(1)); R_GATHER(X);
        for (int i = 0; i < ntok; i += 3) { R_STEP(i, X, Y, Z); R_STEP(i + 1, Y, Z, X); R_STEP(i + 2, Z, X, Y); }
    }
    __syncthreads();
#undef R_TOK
#undef R_LOAD
#undef R_GATHER
#undef R_STEP
}
DI void tr4x4(const unsigned w0, const unsigned w1, const unsigned w2, const unsigned w3, unsigned (&cdw)[4]) {
    const unsigned t01l = __builtin_amdgcn_perm(w1, w0, 0x05010400u), t01h = __builtin_amdgcn_perm(w1, w0, 0x07030602u);
    const unsigned t23l = __builtin_amdgcn_perm(w3, w2, 0x05010400u), t23h = __builtin_amdgcn_perm(w3, w2, 0x07030602u);
    cdw[0] = __builtin_amdgcn_perm(t23l, t01l, 0x05040100u); cdw[1] = __builtin_amdgcn_perm(t23l, t01l, 0x07060302u);
    cdw[2] = __builtin_amdgcn_perm(t23h, t01h, 0x05040100u); cdw[3] = __builtin_amdgcn_perm(t23h, t01h, 0x07060302u);
}
template <bool FIRST = false> DI void axpy4rows(const u32x4 r0, const u32x4 r1, const u32x4 r2, const u32x4 r3, const unsigned a4, int (&ahi)[16], int (&aall)[16], const int aall0 = 0) {
#pragma unroll
    for (int d = 0; d < 4; ++d) {
        unsigned cdw[4];
        tr4x4(r0[d], r1[d], r2[d], r3[d], cdw);
#pragma unroll
        for (int b = 0; b < 4; ++b) {
            if constexpr (FIRST) { aall[4 * d + b] = dot4_v(cdw[b], a4, aall0); ahi[4 * d + b] = dot4_z(cdw[b] & 0xF0F0F0F0u, a4); }
            else { aall[4 * d + b] = __builtin_amdgcn_sdot4((int)cdw[b], (int)a4, aall[4 * d + b], false);
                   ahi[4 * d + b] = __builtin_amdgcn_sdot4((int)(cdw[b] & 0xF0F0F0F0u), (int)a4, ahi[4 * d + b], false); }
        }
    }
}
DI void gather_v(Frame& F, const int layer, const XInfo xi, const bool dry) {
    FRAME_IDS;
    const unsigned short* eidx = (const unsigned short*)(F.ws + WS_EIDX); const unsigned char* A8 = F.ws + WS_A; const float* SA = (const float*)(F.ws + WS_SA);
    float* part_w = dry ? (float*)(F.ws + WS_R) : (float*)(F.ws + WS_PART); bf16* hb_w = dry ? (bf16*)(F.ws + WS_HID2) : (bf16*)(F.ws + WS_XB); const bf16* hbp = (const bf16*)(F.ws + WS_XB);
    const int j = f_lane >> 3, c = f_lane & 7, c16 = c * 16;
    const bool q8out = (layer == 0) && !dry; unsigned char* h8_w = F.ws + WS_XQ;
    const int gwl = xi.rank * NWAVES + F.wave, NGWL = xi.nloc * NWAVES;
    constexpr int NGRP = T / 2 / 8;
    LAS unsigned char* wl = F.lds + F.wave * 10240;
    __syncthreads();
    for (int jj = xi.xrank; jj < 8; jj += xi.nx) {
        const int sl = jj & 3, th = jj >> 2;
        const __amdgpu_buffer_rsrc_t V8 = __builtin_amdgcn_make_buffer_rsrc((void*)(F.ws + WS_V8 + ((size_t)(layer * 4 + sl) * PE) * 128), 0, PE * 128, 0x00020000);
        int gi = gwl;
        if (gi >= NGRP) continue;
#define TOKG(g_) (2 * (8 * (g_) + j) + th)
#define V_META_LOAD(g_, pe, pa) do { const size_t t_ = (size_t)TOKG(g_); const u32x4 w0_ = *(const u32x4*)(eidx + t_ * NSEL + 16 * c), w1_ = *(const u32x4*)(eidx + t_ * NSEL + 16 * c + 8); \
            pe[0] = (u32x4){w0_[0] & 0xFFFFu, w0_[0] >> 16, w0_[1] & 0xFFFFu, w0_[1] >> 16}; pe[1] = (u32x4){w0_[2] & 0xFFFFu, w0_[2] >> 16, w0_[3] & 0xFFFFu, w0_[3] >> 16}; \
            pe[2] = (u32x4){w1_[0] & 0xFFFFu, w1_[0] >> 16, w1_[1] & 0xFFFFu, w1_[1] >> 16}; pe[3] = (u32x4){w1_[2] & 0xFFFFu, w1_[2] >> 16, w1_[3] & 0xFFFFu, w1_[3] >> 16}; \
            pa = *(const u32x4*)(A8 + t_ * NSEL + 16 * c); } while (0)
#define V_META_STORE(b_, pe, pa) do { LAS unsigned char* m_ = wl + (b_) * 5120; _Pragma("unroll") for (int q_ = 0; q_ < 4; ++q_) *(LAS u32x4*)(m_ + q_ * 1024 + f_lane * 16) = pe[q_]; *(LAS u32x4*)(m_ + 4096 + f_lane * 16) = pa; } while (0)
#define V_BLK_READ(b_, blk_, e, av_) do { const LAS unsigned char* m_ = wl + (b_) * 5120 + (8 * j + (blk_)) * 16; _Pragma("unroll") for (int q_ = 0; q_ < 4; ++q_) e[q_] = *(const LAS u32x4*)(m_ + q_ * 1024); av_ = *(const LAS u32x4*)(m_ + 4096); } while (0)
        u32x4 pe[4], pa;
        V_META_LOAD(gi, pe, pa); V_META_STORE(0, pe, pa);
        asm volatile("s_waitcnt lgkmcnt(0)" ::: "memory");
        u32x4 e1[4], a1, av;
        u32x4 A0[8], B0[8], A1[8], B1[8];
        V_BLK_READ(0, 0, e1, av);
#pragma unroll
        for (int i = 0; i < 8; ++i) A0[i] = __builtin_amdgcn_raw_buffer_load_b128(V8, (int)e1[i >> 2][i & 3] * 128 + c16, 0, 0);
#pragma unroll
        for (int i = 0; i < 8; ++i) B0[i] = __builtin_amdgcn_raw_buffer_load_b128(V8, (int)e1[2 + (i >> 2)][i & 3] * 128 + c16, 0, 0);
        V_BLK_READ(0, 1, e1, a1);
        int buf = 0;
#define V_BLOCK(FIRSTB, CA, CB, NA, NB, nb_, nblk_) do { \
            __builtin_amdgcn_sched_barrier(0); \
            _Pragma("unroll") for (int i = 0; i < 8; ++i) NA[i] = __builtin_amdgcn_raw_buffer_load_b128(V8, (int)e1[i >> 2][i & 3] * 128 + c16, 0, 0); \
            __builtin_amdgcn_sched_barrier(0); \
            axpy4rows<FIRSTB>(CA[0], CA[1], CA[2], CA[3], av[0], ahi, aall, 0); axpy4rows(CA[4], CA[5], CA[6], CA[7], av[1], ahi, aall); \
            __builtin_amdgcn_sched_barrier(0); \
            _Pragma("unroll") for (int i = 0; i < 8; ++i) NB[i] = __builtin_amdgcn_raw_buffer_load_b128(V8, (int)e1[2 + (i >> 2)][i & 3] * 128 + c16, 0, 0); \
            __builtin_amdgcn_sched_barrier(0); \
            axpy4rows(CB[0], CB[1], CB[2], CB[3], av[2], ahi, aall); axpy4rows(CB[4], CB[5], CB[6], CB[7], av[3], ahi, aall); \
            sa8 = __builtin_amdgcn_sdot4(0x01010101, (int)av[0], sa8, false); sa8 = __builtin_amdgcn_sdot4(0x01010101, (int)av[1], sa8, false); sa8 = __builtin_amdgcn_sdot4(0x01010101, (int)av[2], sa8, false); sa8 = __builtin_amdgcn_sdot4(0x01010101, (int)av[3], sa8, false); \
            av = a1; \
            V_BLK_READ(nb_, nblk_, e1, a1); } while (0)
        for (; gi < NGRP; gi += NGWL, buf ^= 1) {
            const int gn = gi + NGWL < NGRP ? gi + NGWL : gi;
            const int t = TOKG(gi);
            V_META_LOAD(gn, pe, pa);
            int aall[16], ahi[16], sa8 = 0;
            V_BLOCK(true, A0, B0, A1, B1, buf, 2);
            V_META_STORE(buf ^ 1, pe, pa);
            V_BLOCK(false, A1, B1, A0, B0, buf, 3);
            V_BLOCK(false, A0, B0, A1, B1, buf, 4);
            V_BLOCK(false, A1, B1, A0, B0, buf, 5);
            V_BLOCK(false, A0, B0, A1, B1, buf, 6);
            V_BLOCK(false, A1, B1, A0, B0, buf, 7);
            u32x4 hold[4]; float sa;
#pragma unroll
            for (int q = 0; q < 4; ++q) hold[q] = *(const u32x4*)(hbp + (size_t)t * DM + 256 * sl + 32 * c + 8 * q);
            sa = SA[t];
            V_BLOCK(false, A0, B0, A1, B1, buf ^ 1, 0);
            V_BLOCK(false, A1, B1, A0, B0, buf ^ 1, 1);
            const float slo = sa * 16.f; const int off8 = 8 * sa8;
            float ss = 0.f;
            const float qinv = q8out ? frcp(((const float*)(F.ws + WS_ROWSC))[2 * T + t]) : 0.f;
#pragma unroll
            for (int d = 0; d < 4; ++d) {
                float hv[8];
#pragma unroll
                for (int b = 0; b < 4; ++b) { hv[b] = (float)(aall[4 * d + b] - ahi[4 * d + b] - off8) * slo; hv[4 + b] = (float)ahi[4 * d + b] * sa; }
#pragma unroll
                for (int p = 0; p < 4; ++p) { hv[2 * p] += __uint_as_float(hold[d][p] << 16); hv[2 * p + 1] += __uint_as_float(hold[d][p] & 0xffff0000u); }
#pragma unroll
                for (int p = 0; p < 8; ++p) ss += hv[p] * hv[p];
                *(u32x4*)(hb_w + (size_t)t * DM + 256 * sl + 32 * c + 8 * d) = (u32x4){cvtpk(hv[0], hv[1]), cvtpk(hv[2], hv[3]), cvtpk(hv[4], hv[5]), cvtpk(hv[6], hv[7])};
                if (q8out) {
                    unsigned bb[8];
#pragma unroll
                    for (int p = 0; p < 8; ++p) bb[p] = __float_as_uint(__builtin_amdgcn_fmed3f(hv[p] * qinv + 12582912.f, 12582785.f, 12583039.f));
                    *(u32x2*)(h8_w + (size_t)t * DM + 256 * sl + 32 * c + 8 * d) = (u32x2){__builtin_amdgcn_perm(__builtin_amdgcn_perm(bb[3], bb[2], 0x0c0c0400u), __builtin_amdgcn_perm(bb[1], bb[0], 0x0c0c0400u), 0x05040100u),
                                                                                           __builtin_amdgcn_perm(__builtin_amdgcn_perm(bb[7], bb[6], 0x0c0c0400u), __builtin_amdgcn_perm(bb[5], bb[4], 0x0c0c0400u), 0x05040100u)};
                }
            }
            ss = red8(ss);
            if (c == 0) part_w[(size_t)t * 16 + sl] = ss;
            if (sl == 0 && c >= 1 && c <= 3) *(f32x4*)(part_w + (size_t)t * 16 + 4 * c) = (f32x4){0.f, 0.f, 0.f, 0.f};
        }
#undef V_BLOCK
#undef V_BLK_READ
#undef V_META_LOAD
#undef V_META_STORE
#undef TOKG
    }
    __syncthreads();
}
DI void final_norm(Frame& F) {
    FRAME_IDS;
    const float* part = (const float*)(F.ws + WS_PART); const bf16* hbp = (const bf16*)(F.ws + WS_XB);
    const int gw = F.bid * NWAVES + F.wave, NGW = F.G * NWAVES;
    for (int t = gw; t < T; t += NGW) {
        const float r = rstd_bcast(part, t);
        const u32x2* hp = (const u32x2*)(hbp + (size_t)t * DM) + f_lane;
        f32x4* op = (f32x4*)(F.out + (size_t)t * DM) + f_lane;
        const f32x4* gp = (const f32x4*)F.final_norm + f_lane;
#pragma unroll
        for (int q = 0; q < 4; ++q) { const u32x2 w = hp[64 * q];
            const f32x4 h = {__uint_as_float(w[0] << 16), __uint_as_float(w[0] & 0xffff0000u), __uint_as_float(w[1] << 16), __uint_as_float(w[1] & 0xffff0000u)};
            op[64 * q] = h * r * gp[64 * q]; }
    }
}
DI void opt_conv(Frame& F) {
    FRAME_IDS;
    const bf16* G = (const bf16*)(F.ws + WS_GLU); unsigned char* H8 = F.ws + WS_HID2; float* rowsc2 = (float*)(F.ws + WS_ROWSC);
    LAS float* ys = (LAS float*)F.lds;
    f32x2 wt[CW];
#pragma unroll
    for (int j = 0; j < CW; ++j) wt[j] = *(const f32x2*)(F.conv_dw + j * DM + 2 * f_tid);
    const f32x2 bdw = *(const f32x2*)(F.conv_dw_b + 2 * f_tid);
    for (int it = F.bid; it < T / 128; it += F.G) {
        const int s0 = (it % (SEQ / 128)) * 128;
        const size_t row0 = (size_t)it * 128;
        const unsigned* gp = (const unsigned*)G + f_tid;
        f32x2 win[32];
        unsigned nx[32];
#pragma unroll
        for (int k = 1; k <= CW - 1; ++k) win[32 - k] = (f32x2){0.f, 0.f};
        if (s0 > 0) {
            unsigned hx[CW - 1];
#pragma unroll
            for (int k = 1; k <= CW - 1; ++k) hx[k - 1] = gp[(row0 - k) * 512];
#pragma unroll
            for (int k = 1; k <= CW - 1; ++k) win[32 - k] = (f32x2){__uint_as_float(hx[k - 1] << 16), __uint_as_float(hx[k - 1] & 0xffff0000u)};
        }
        win[0] = (f32x2){0.f, 0.f}; win[1] = (f32x2){0.f, 0.f};
#pragma unroll
        for (int u = 0; u < 32; ++u) nx[u] = gp[(row0 + u) * 512];
        for (int bt = 0; bt < 4; ++bt) {
            __syncthreads();
#pragma unroll
            for (int u = 0; u < 32; ++u) {
                win[u] = (f32x2){__uint_as_float(nx[u] << 16), __uint_as_float(nx[u] & 0xffff0000u)};
                f32x2 a = bdw;
#pragma unroll
                for (int j = 0; j < CW; ++j) a = wt[j] * win[(u + 2 + j) % 32] + a;
                *(LAS f32x2*)(ys + u * DM + 2 * f_tid) = a;
            }
            { const int nb = bt < 3 ? bt + 1 : 3;
#pragma unroll
              for (int u = 0; u < 32; ++u) nx[u] = gp[(row0 + 32 * nb + u) * 512]; }
            __syncthreads();
            for (int u = F.wave; u < 32; u += NWAVES) {
                const int sl = 32 * bt + u;
                f32x4 v[4]; float sm = 0.f;
#pragma unroll
                for (int k = 0; k < 4; ++k) { v[k] = *(const LAS f32x4*)(ys + u * DM + 256 * k + 4 * f_lane); sm += (v[k][0] + v[k][1]) + (v[k][2] + v[k][3]); }
                const float mu = wave_sum(sm) * (1.f / DM);
                float sq = 0.f;
#pragma unroll
                for (int k = 0; k < 4; ++k) { v[k] = v[k] - mu; sq += (v[k][0] * v[k][0] + v[k][1] * v[k][1]) + (v[k][2] * v[k][2] + v[k][3] * v[k][3]); }
                const float rs = frsq(wave_sum(sq) * (1.f / DM) + EPS);
                float am = 0.f;
                int lo4 = 4 * f_lane; asm volatile("" : "+v"(lo4));
#pragma unroll
                for (int k = 0; k < 4; ++k) {
                    f32x4 z = v[k] * rs * *(const f32x4*)(F.conv_ln_g + 256 * k + lo4) + *(const f32x4*)(F.conv_ln_b + 256 * k + lo4);
#pragma unroll
                    for (int e = 0; e < 4; ++e) z[e] = z[e] * frcp(1.f + __expf(-z[e]));
                    v[k] = z; am = max3_abs(max3_abs(am, z[0], z[1]), z[2], z[3]);
                }
                am = wave_max(am);
                const float sc = am > 0.f ? 127.f * frcp(am) : 0.f;
#pragma unroll
                for (int k = 0; k < 4; ++k) {
                    const f32x4 tq = v[k] * sc + 12582912.f;
                    *(unsigned*)(H8 + (row0 + sl) * DM + 256 * k + 4 * f_lane) = __builtin_amdgcn_perm(__builtin_amdgcn_perm(__float_as_uint(tq[3]), __float_as_uint(tq[2]), 0x0c0c0400u), __builtin_amdgcn_perm(__float_as_uint(tq[1]), __float_as_uint(tq[0]), 0x0c0c0400u), 0x05040100u);
                }
                rowsc2[row0 + sl] = am * (1.f / 127.f);
            }
        }
    }
    __syncthreads();
}
enum Phase { PH_PREP = 0, PH_PREPW, PH_PROJ, PH_MIX, PH_WOUT, PH_Q0, PH_GU0, PH_GR0, PH_GV0, PH_W1, PH_CONV, PH_W2, PH_Q1, PH_GU1, PH_GR1, PH_GV1, PH_FINAL, PH_COUNT };
struct Args { const float* in[19]; float* out; unsigned char* ws; int ph_lo, ph_hi; };
#ifndef TEST_PHASE
#define TEST_PHASE -1
#endif

__global__ void __launch_bounds__(NTHR, 2) mega_fwd(Args args) {
    extern __shared__ __attribute__((aligned(16))) unsigned char lds[];
    Frame F;
    F.lds = (LAS unsigned char*)lds;
    F.wave = __builtin_amdgcn_readfirstlane((int)threadIdx.x >> 6); FRAME_IDS;
    F.G = gridDim.x; F.bid = blockIdx.x;
    F.x = args.in[0]; F.mix_norm = args.in[1]; F.ffn_norm = args.in[2]; F.final_norm = args.in[3]; F.w_in = args.in[4]; F.w_out = args.in[5]; F.rel_bias = args.in[6];
    F.conv_w1 = args.in[7]; F.conv_b1 = args.in[8]; F.conv_dw = args.in[9]; F.conv_dw_b = args.in[10]; F.conv_ln_g = args.in[11]; F.conv_ln_b = args.in[12];
    F.conv_w2 = args.in[13]; F.conv_b2 = args.in[14]; F.peer_wq = args.in[15]; F.peer_keys = args.in[16]; F.peer_u = args.in[17]; F.peer_v = args.in[18];
    F.out = args.out; F.ws = args.ws;
    volatile LAS unsigned* MISC = (volatile LAS unsigned*)(F.lds + MISC_OFF);
    for (int u = f_tid; u < (LDS_BYTES - LDSCTL_OFF) / 4; u += NTHR) ((LAS unsigned*)(F.lds + LDSCTL_OFF))[u] = 0u;
    __syncthreads();
    const int lo = args.ph_lo, hi = args.ph_hi;
    XcdBarrier bar; bar.bar = (unsigned*)(F.ws + WS_CTL) + CW_BAR; bar.x = 0; bar.st = nullptr;
    if (hi - lo > 1) bar = xcd_barrier_post((unsigned*)(F.ws + WS_CTL) + CW_BAR, MISC + 8);
#define IN(k) ((TEST_PHASE < 0 || TEST_PHASE == (k)) && lo <= (k) && (k) < hi)
#define SEAM(k) do { if (IN(k) && IN((k) + 1)) xcd_barrier(bar, F.wave); } while (0)
#define REPS(k) for (int rep_ = ((k) == REP_PHASE ? 0 : 1); rep_ < 2; ++rep_)
#define GEMM_PHASE(EPI, Aptr, Bptr, NN, ...) do { pg8::Gemm g{(const bf16*)(Aptr), (const bf16*)(Bptr), T, (NN), DM}; pg8::StaticOrder S; S.init(T, (NN), F.G, F.bid); \
        pg8::EPI E{__VA_ARGS__}; pg8::gemm_phase<pg8::EPI, pg8::StaticOrder, true, true>(F.lds, g, S, E, F.wave); } while (0)
    bf16* XB = (bf16*)(F.ws + WS_XB);
    float* PART = (float*)(F.ws + WS_PART); const float* ROPE = (const float*)(F.ws + WS_ROPE);
    if (IN(PH_PREP)) REPS(PH_PREP) { p0_q8_blocks(F); p0_weights(F, 2); p0_prep(F); } SEAM(PH_PREP);
    if (PROBE_MODE == 9 && IN(PH_PREP) && IN(PH_PREP + 1)) { for (int xb_ = 0; xb_ < 8; ++xb_) xcd_barrier(bar, F.wave); }
    if (IN(PH_PROJ)) REPS(PH_PROJ) { { pg8::Gemm g{(const bf16*)(F.ws + WS_XQ), (const bf16*)(F.ws + WS_WIN), T, INC, DM / 2}; pg8::StaticOrder S; S.init(T, INC, F.G, F.bid); pg8::EpiProj8 E{(bf16*)(F.ws + WS_R), ROPE, (const float*)(F.ws + WS_ROWSC), (const float*)(F.ws + WS_COLSC)}; pg8::gemm_phase<pg8::EpiProj8, pg8::StaticOrder, true, true, true>(F.lds, g, S, E, F.wave); } } SEAM(PH_PROJ);
    if (IN(PH_MIX)) REPS(PH_MIX) { mix_phase(F, rep_); } SEAM(PH_MIX);
    if (IN(PH_WOUT)) REPS(PH_WOUT) { GEMM_PHASE(EpiRes<true>, F.ws + WS_O, F.ws + WS_WOUT, DM, (const float*)(F.ws + WS_XQ), XB, PART, nullptr, (const float*)(F.ws + WS_ROWSC) + T, nullptr); } SEAM(PH_WOUT);
    if (IN(PH_Q0)) REPS(PH_Q0) { GEMM_PHASE(EpiQ, XB, F.ws + WS_WQ, DM, (bf16*)(F.ws + WS_Q), PART); asm volatile("s_waitcnt vmcnt(0)" ::: "memory"); __syncthreads(); opt_route(F, 0); } SEAM(PH_Q0);
    const bool census = (hi - lo > 1);
    if (IN(PH_GU0)) REPS(PH_GU0) { gather_u(F, 0, get_xinfo(F, census), rep_ == 0); } SEAM(PH_GU0);
    if (IN(PH_GR0)) REPS(PH_GR0) { gather_r(F, 0); } SEAM(PH_GR0);
    if (IN(PH_GV0)) REPS(PH_GV0) { gather_v(F, 0, get_xinfo(F, census), rep_ == 0); } SEAM(PH_GV0);
    if (IN(PH_W1)) REPS(PH_W1) { pg8::Gemm g{(const bf16*)(F.ws + WS_XQ), (const bf16*)(F.ws + WS_W1), T, 2 * DM, DM / 2}; pg8::StaticOrder S; S.init(T, 2 * DM, F.G, F.bid);
        pg8::EpiGlu8 E{(bf16*)(F.ws + WS_GLU), PART, F.conv_b1, (const float*)(F.ws + WS_ROWSC) + 2 * T, (const float*)(F.ws + WS_COLSC) + CS_W1}; pg8::gemm_phase<pg8::EpiGlu8, pg8::StaticOrder, true, true, true>(F.lds, g, S, E, F.wave); } SEAM(PH_W1);
    if (IN(PH_CONV)) REPS(PH_CONV) { opt_conv(F); } SEAM(PH_CONV);
    if (IN(PH_W2)) { pg8::Gemm g{(const bf16*)(F.ws + WS_HID2), (const bf16*)(F.ws + WS_W2), T, DM, DM / 2}; pg8::StaticOrder S; S.init(T, DM, F.G, F.bid);
        pg8::EpiRes<false, true> E{nullptr, XB, PART, F.conv_b2, (const float*)(F.ws + WS_ROWSC), (const float*)(F.ws + WS_COLSC) + CS_W2}; pg8::gemm_phase<pg8::EpiRes<false, true>, pg8::StaticOrder, true, true, true>(F.lds, g, S, E, F.wave); } SEAM(PH_W2);
    if (IN(PH_Q1)) REPS(PH_Q1) { GEMM_PHASE(EpiQ, XB, F.ws + WS_WQ + (size_t)DM * DM * 2, DM, (bf16*)(F.ws + WS_Q), PART); asm volatile("s_waitcnt vmcnt(0)" ::: "memory"); __syncthreads(); opt_route(F, 1); } SEAM(PH_Q1);
    if (IN(PH_GU1)) REPS(PH_GU1) { gather_u(F, 1, get_xinfo(F, census), rep_ == 0); } SEAM(PH_GU1);
    if (IN(PH_GR1)) REPS(PH_GR1) { gather_r(F, 1); } SEAM(PH_GR1);
    if (IN(PH_GV1)) REPS(PH_GV1) { gather_v(F, 1, get_xinfo(F, census), rep_ == 0); } SEAM(PH_GV1);
    if (IN(PH_FINAL)) { final_norm(F); }
#undef IN
#undef SEAM
}

extern "C" void kernel_launch(void* const* d_in, const int* in_sizes, int n_in, void* d_out, int out_size, void* d_ws, size_t ws_size, hipStream_t stream) {
    static int grid = 0;
    if (grid == 0) {
        if (n_in != 19 || out_size != T * DM || ws_size < WS_END) { fprintf(stderr, "kernel_launch: unexpected shapes (n_in %d out %d ws %zu)\n", n_in, out_size, ws_size); grid = -1; return; }
        int dev = 0, cus = 0;
        if (hipGetDevice(&dev) != hipSuccess || hipDeviceGetAttribute(&cus, hipDeviceAttributeMultiprocessorCount, dev) != hipSuccess) { grid = -1; return; }
        if (hipFuncSetAttribute((const void*)mega_fwd, hipFuncAttributeMaxDynamicSharedMemorySize, LDS_BYTES) != hipSuccess) { fprintf(stderr, "kernel_launch: hipFuncSetAttribute failed\n"); grid = -1; return; }
        (void)hipGetLastError();
        grid = cus;
    }
    if (grid < 0) return;
    (void)hipMemsetAsync((char*)d_ws + WS_CTL, 0, CTL_ZERO_BYTES, stream);
    Args a{};
    for (int i = 0; i < 19; ++i) a.in[i] = (const float*)d_in[i];
    a.out = (float*)d_out; a.ws = (unsigned char*)d_ws;
#if MK_ONE_LAUNCH
    a.ph_lo = 0; a.ph_hi = PH_COUNT;
    hipLaunchKernelGGL(mega_fwd, dim3(grid), dim3(NTHR), LDS_BYTES, stream, a);
#else
    for (int p = 0; p < PH_COUNT; ++p) { a.ph_lo = p; a.ph_hi = p + 1; hipLaunchKernelGGL(mega_fwd, dim3(grid), dim3(NTHR), LDS_BYTES, stream, a); }
#endif
}
```
